# Optimizing an MI355X kernel written in HIP

```python
import math
import jax, jax.numpy as jnp
from jax import lax
import numpy as np

D_MODEL = 1024
BATCH = 8
SEQ = 2048
DEPTH = 4

GRID_W = 64
CTX_LEN = 256
N_EVEN = (DEPTH + 1) // 2
N_ODD = DEPTH // 2
EPS = 1e-6

MLA_HEADS = 8
MLA_Q_RANK = 384
MLA_KV_RANK = 256
MLA_NOPE = 64
MLA_ROPE = 32
MLA_V = 64
MLA_SCALE = (MLA_NOPE + MLA_ROPE) ** -0.5
ROPE_THETA = 10000.0
Q_BLOCK = 128
SC_WIDTH = 512
SC_K = 3
HYB_SPLITS = [MLA_Q_RANK, MLA_Q_RANK + MLA_KV_RANK, MLA_Q_RANK + MLA_KV_RANK + MLA_ROPE,
              MLA_Q_RANK + MLA_KV_RANK + MLA_ROPE + SC_WIDTH,
              MLA_Q_RANK + MLA_KV_RANK + MLA_ROPE + 2 * SC_WIDTH]
HYB_IN = MLA_Q_RANK + MLA_KV_RANK + MLA_ROPE + 3 * SC_WIDTH
HYB_MIX = MLA_HEADS * MLA_V + SC_WIDTH
SSD_INNER = 2 * D_MODEL
SSD_HEADDIM = 64
SSD_HEADS = SSD_INNER // SSD_HEADDIM
SSD_GROUPS = 4
SSD_STATE = 128
SSD_CONV_K = 3
SSD_CHUNK = 128
SSD_CONV_DIM = SSD_INNER + 2 * SSD_GROUPS * SSD_STATE
SSD_IN = SSD_INNER + SSD_CONV_DIM + 2 * SSD_HEADS
D_FF = 2816
FFN_K = 3

kernel_name = 'hybrid_mla_shortconv_ssd_convffn_prefix_dit'


def _rmsnorm(x, w):
    x32 = x.astype(jnp.float32)
    y = x32 * lax.rsqrt(jnp.mean(x32 * x32, axis=-1, keepdims=True) + EPS)
    return (y * w.astype(jnp.float32)).astype(x.dtype)


def _dwconv(u, w, b=None):
    k = w.shape[0]
    pad = k // 2
    n = u.shape[1]
    up = jnp.pad(u, ((0, 0), (pad, pad), (0, 0)))
    y = up[:, 0:n] * w[0]
    for i in range(1, k):
        y = y + up[:, i:i + n] * w[i]
    if b is not None:
        y = y + b
    return y


def _axial_angles(rows):
    row = jnp.repeat(jnp.arange(rows, dtype=jnp.float32), GRID_W)
    col = jnp.tile(jnp.arange(GRID_W, dtype=jnp.float32), rows)
    nf = MLA_ROPE // 4
    inv = ROPE_THETA ** (-jnp.arange(nf, dtype=jnp.float32) / nf)
    ang = jnp.concatenate([row[:, None] * inv, col[:, None] * inv], axis=-1)
    return jnp.cos(ang), jnp.sin(ang)


def _rope(x, cos, sin):
    half = x.shape[-1] // 2
    x1, x2 = x[..., :half], x[..., half:]
    cos = cos.astype(x.dtype)
    sin = sin.astype(x.dtype)
    return jnp.concatenate([x1 * cos - x2 * sin, x1 * sin + x2 * cos], axis=-1)


def _attend(qn, qr, kn, kr, v):
    s = jnp.einsum('bqhd,bkhd->bhqk', qn, kn) + jnp.einsum('bqhr,bkr->bhqk', qr, kr)
    p = jax.nn.softmax(s.astype(jnp.float32) * MLA_SCALE, axis=-1).astype(v.dtype)
    return jnp.einsum('bhqk,bkhd->bqhd', p, v)


def _attend_blocked(qn, qr, kn, kr, v):
    b, n, h, _ = qn.shape
    nb = n // Q_BLOCK
    qn_b = qn.reshape(b, nb, Q_BLOCK, h, MLA_NOPE).transpose(1, 0, 2, 3, 4)
    qr_b = qr.reshape(b, nb, Q_BLOCK, h, MLA_ROPE).transpose(1, 0, 2, 3, 4)
    out = lax.map(lambda qs: _attend(qs[0], qs[1], kn, kr, v), (qn_b, qr_b))
    return out.transpose(1, 0, 2, 3, 4).reshape(b, n, h, MLA_V)


def _mla_qkv(cq, ckv, kr, q_norm, kv_norm, w_uq, w_ukv, cos, sin):
    b, n, _ = cq.shape
    q = (_rmsnorm(cq, q_norm) @ w_uq).reshape(b, n, MLA_HEADS, MLA_NOPE + MLA_ROPE)
    kv = (_rmsnorm(ckv, kv_norm) @ w_ukv).reshape(b, n, MLA_HEADS, MLA_NOPE + MLA_V)
    qn, qr = q[..., :MLA_NOPE], q[..., MLA_NOPE:]
    kn, v = kv[..., :MLA_NOPE], kv[..., MLA_NOPE:]
    if cos is not None:
        qr = _rope(qr, cos[:, None, :], sin[:, None, :])
        kr = _rope(kr, cos, sin)
    return qn, qr, kn, kr, v


def _mixer_attn_conv(h_lat, h_ctx, w_in, q_norm, kv_norm, w_uq, w_ukv, sconv_w, w_out, cos, sin, need_ctx_out):
    b, n, _ = h_lat.shape
    cq_l, ckv_l, kr_l, gb_l, gc_l, xv_l = jnp.split(h_lat @ w_in, HYB_SPLITS, axis=-1)
    cq_c, ckv_c, kr_c, gb_c, gc_c, xv_c = jnp.split(h_ctx @ w_in, HYB_SPLITS, axis=-1)
    qn_l, qr_l, kn_l, kr_l, v_l = _mla_qkv(cq_l, ckv_l, kr_l, q_norm, kv_norm, w_uq, w_ukv, cos, sin)
    qn_c, qr_c, kn_c, kr_c, v_c = _mla_qkv(cq_c, ckv_c, kr_c, q_norm, kv_norm, w_uq, w_ukv, None, None)
    kn_all = jnp.concatenate([kn_c, kn_l], axis=1)
    kr_all = jnp.concatenate([kr_c, kr_l], axis=1)
    v_all = jnp.concatenate([v_c, v_l], axis=1)
    attn_l = _attend_blocked(qn_l, qr_l, kn_all, kr_all, v_all).reshape(b, n, MLA_HEADS * MLA_V)
    sc_l = gb_l * _dwconv(gc_l * xv_l, sconv_w)
    out_l = jnp.concatenate([attn_l, sc_l], axis=-1) @ w_out
    if not need_ctx_out:
        return out_l, None
    attn_c = _attend(qn_c, qr_c, kn_c, kr_c, v_c).reshape(b, h_ctx.shape[1], MLA_HEADS * MLA_V)
    sc_c = gb_c * _dwconv(gc_c * xv_c, sconv_w)
    out_c = jnp.concatenate([attn_c, sc_c], axis=-1) @ w_out
    return out_l, out_c


def _segsum(a):
    q = a.shape[-1]
    cs = jnp.cumsum(a, axis=-1)
    diff = cs[..., :, None] - cs[..., None, :]
    mask = jnp.tril(jnp.ones((q, q), dtype=bool))
    return jnp.where(mask, diff, -jnp.inf)


def _ssd_scan(xdt, a, bm, cm, h0):
    b, l, h, p = xdt.shape
    g, n = bm.shape[2], bm.shape[3]
    r = h // g
    c = l // SSD_CHUNK
    x = xdt.reshape(b, c, SSD_CHUNK, g, r, p)
    a = a.astype(jnp.float32).reshape(b, c, SSD_CHUNK, g, r).transpose(0, 1, 3, 4, 2)
    bc = bm.reshape(b, c, SSD_CHUNK, g, n)
    cc = cm.reshape(b, c, SSD_CHUNK, g, n)
    a_cum = jnp.cumsum(a, axis=-1)
    decay_in = jnp.exp(_segsum(a))
    cb = jnp.einsum('bclgn,bcsgn->bcgls', cc, bc)
    y_diag = jnp.einsum('bcgls,bcgrls,bcsgrp->bclgrp', cb, decay_in, x)
    decay_states = jnp.exp(a_cum[..., -1:] - a_cum)
    states = jnp.einsum('bcsgn,bcgrs,bcsgrp->bcgrpn', bc, decay_states, x)
    states = jnp.concatenate([h0.reshape(b, 1, g, r, p, n).astype(states.dtype), states], axis=1)
    tot = jnp.pad(a_cum[..., -1], ((0, 0), (1, 0), (0, 0), (0, 0))).transpose(0, 2, 3, 1)
    decay_chunk = jnp.exp(_segsum(tot))
    new_states = jnp.einsum('bgrzc,bcgrpn->bzgrpn', decay_chunk, states)
    states_in, final = new_states[:, :-1], new_states[:, -1]
    y_off = jnp.einsum('bclgn,bcgrpn,bcgrl->bclgrp', cc, states_in, jnp.exp(a_cum))
    y = (y_diag + y_off).reshape(b, l, h, p)
    return y, final.reshape(b, h, p, n)


def _mixer_ssd(hs, h0_f, h0_b, w_in, conv_w, conv_b, a_log, dt_bias, d_skip, norm_w, w_out, need_out):
    b, n, _ = hs.shape
    z, xbc, dt = jnp.split(hs @ w_in, [SSD_INNER, SSD_INNER + SSD_CONV_DIM], axis=-1)
    xbc = jax.nn.silu(_dwconv(xbc, conv_w, conv_b))
    xs, bm, cm = jnp.split(xbc, [SSD_INNER, SSD_INNER + SSD_GROUPS * SSD_STATE], axis=-1)
    xs = xs.reshape(b, n, SSD_HEADS, SSD_HEADDIM)
    bm = bm.reshape(b, n, SSD_GROUPS, SSD_STATE)
    cm = cm.reshape(b, n, SSD_GROUPS, SSD_STATE)
    dt = jax.nn.softplus(dt.astype(jnp.float32).reshape(b, n, 2, SSD_HEADS) + dt_bias.astype(jnp.float32))
    a = -jnp.exp(a_log.astype(jnp.float32)) * dt
    flip = lambda t: jnp.flip(t, axis=1)
    y_f, hf = _ssd_scan(xs * dt[:, :, 0, :, None], a[:, :, 0], bm, cm, h0_f)
    y_b, hb = _ssd_scan(flip(xs * dt[:, :, 1, :, None]), flip(a[:, :, 1]), flip(bm), flip(cm), h0_b)
    if not need_out:
        return None, hf, hb
    y = (y_f + flip(y_b)).astype(xs.dtype) + d_skip[:, None] * xs
    y = _rmsnorm(y.reshape(b, n, SSD_INNER) * jax.nn.silu(z), norm_w)
    return y @ w_out, hf, hb


def _conv_ffn(h, w_up, conv_w, w_down):
    u = _dwconv(h @ w_up, conv_w)
    act, gate = jnp.split(u, 2, axis=-1)
    return (jax.nn.silu(act) * gate) @ w_down


def _modulation(cond, w, b):
    return jnp.split(jax.nn.silu(cond) @ w + b, 6, axis=-1)


def setup_inputs(seed: int = 0) -> dict:
    key = jax.random.key(seed)
    ks = iter(jax.random.split(key, 40))
    nrm = lambda shape, scale: jax.random.normal(next(ks), shape, jnp.float32) * scale
    gain = lambda shape: 1.0 + 0.05 * jax.random.normal(next(ks), shape, jnp.float32)
    d = D_MODEL
    inputs = {
        'x': nrm((BATCH, SEQ, d), 1.0),
        'c': nrm((BATCH, d), 1.0),
        'ctx': nrm((BATCH, CTX_LEN, d), 1.0),
        'c_ctx': nrm((d,), 1.0),
        'mod_w': nrm((DEPTH, d, 6 * d), d ** -0.5),
        'mod_b': nrm((DEPTH, 6 * d), 0.01),
        'norm_w': gain((DEPTH, 4, d)),
        'ffn_w_up': nrm((DEPTH, d, 2 * D_FF), d ** -0.5),
        'ffn_conv_w': nrm((DEPTH, FFN_K, 2 * D_FF), FFN_K ** -0.5),
        'ffn_w_down': nrm((DEPTH, D_FF, d), D_FF ** -0.5),
        'hyb_w_in': nrm((N_EVEN, d, HYB_IN), d ** -0.5),
        'mla_q_norm': gain((N_EVEN, MLA_Q_RANK)),
        'mla_kv_norm': gain((N_EVEN, MLA_KV_RANK)),
        'mla_w_uq': nrm((N_EVEN, MLA_Q_RANK, MLA_HEADS * (MLA_NOPE + MLA_ROPE)), MLA_Q_RANK ** -0.5),
        'mla_w_ukv': nrm((N_EVEN, MLA_KV_RANK, MLA_HEADS * (MLA_NOPE + MLA_V)), MLA_KV_RANK ** -0.5),
        'sconv_w': nrm((N_EVEN, SC_K, SC_WIDTH), SC_K ** -0.5),
        'hyb_w_out': nrm((N_EVEN, HYB_MIX, d), HYB_MIX ** -0.5),
        'ssd_w_in': nrm((N_ODD, d, SSD_IN), d ** -0.5),
        'ssd_conv_w': nrm((N_ODD, SSD_CONV_K, SSD_CONV_DIM), SSD_CONV_K ** -0.5),
        'ssd_conv_b': nrm((N_ODD, SSD_CONV_DIM), 0.02),
    }
    a_log = jnp.log(jax.random.uniform(next(ks), (N_ODD, 2, SSD_HEADS), jnp.float32, 1.0, 16.0))
    dt0 = jnp.exp(jax.random.uniform(next(ks), (N_ODD, 2, SSD_HEADS), jnp.float32, math.log(1e-3), math.log(1e-1)))
    inputs['ssd_a_log'] = a_log
    inputs['ssd_dt_bias'] = dt0 + jnp.log(-jnp.expm1(-dt0))
    inputs['ssd_d'] = gain((N_ODD, SSD_HEADS))
    inputs['ssd_norm'] = gain((N_ODD, SSD_INNER))
    inputs['ssd_w_out'] = nrm((N_ODD, SSD_INNER, d), SSD_INNER ** -0.5)
    return inputs


def reference(x, c, ctx, c_ctx, mod_w, mod_b, norm_w, ffn_w_up, ffn_conv_w, ffn_w_down,
              hyb_w_in, mla_q_norm, mla_kv_norm, mla_w_uq, mla_w_ukv, sconv_w, hyb_w_out,
              ssd_w_in, ssd_conv_w, ssd_conv_b, ssd_a_log, ssd_dt_bias, ssd_d, ssd_norm, ssd_w_out):
    b = x.shape[0]
    rows = x.shape[1] // GRID_W
    cos, sin = _axial_angles(rows)
    for l in range(DEPTH):
        last = l == DEPTH - 1
        i = l // 2
        sh1, sc1, g1, sh2, sc2, g2 = _modulation(c[:, None, :], mod_w[l], mod_b[l])
        sh1c, sc1c, g1c, sh2c, sc2c, g2c = _modulation(c_ctx, mod_w[l], mod_b[l])
        h_l = _rmsnorm(x, norm_w[l, 0]) * (1.0 + sc1) + sh1
        h_c = _rmsnorm(ctx, norm_w[l, 0]) * (1.0 + sc1c) + sh1c
        if l % 2 == 0:
            m_l, m_c = _mixer_attn_conv(h_l, h_c, hyb_w_in[i], mla_q_norm[i], mla_kv_norm[i], mla_w_uq[i],
                                        mla_w_ukv[i], sconv_w[i], hyb_w_out[i], cos, sin, not last)
        else:
            zeros = jnp.zeros((b, SSD_HEADS, SSD_HEADDIM, SSD_STATE), jnp.float32)
            m_c, hf, hb = _mixer_ssd(h_c, zeros, zeros, ssd_w_in[i], ssd_conv_w[i], ssd_conv_b[i], ssd_a_log[i],
                                     ssd_dt_bias[i], ssd_d[i], ssd_norm[i], ssd_w_out[i], not last)
            m_l, _, _ = _mixer_ssd(h_l, hf, hb, ssd_w_in[i], ssd_conv_w[i], ssd_conv_b[i], ssd_a_log[i],
                                   ssd_dt_bias[i], ssd_d[i], ssd_norm[i], ssd_w_out[i], True)
        x = x + g1 * _rmsnorm(m_l, norm_w[l, 1])
        f_l = _conv_ffn(_rmsnorm(x, norm_w[l, 2]) * (1.0 + sc2) + sh2, ffn_w_up[l], ffn_conv_w[l], ffn_w_down[l])
        x = x + g2 * _rmsnorm(f_l, norm_w[l, 3])
        if not last:
            ctx = ctx + g1c * _rmsnorm(m_c, norm_w[l, 1])
            f_c = _conv_ffn(_rmsnorm(ctx, norm_w[l, 2]) * (1.0 + sc2c) + sh2c, ffn_w_up[l], ffn_conv_w[l], ffn_w_down[l])
            ctx = ctx + g2c * _rmsnorm(f_c, norm_w[l, 3])
    return x
```

```cpp
#include <hip/hip_runtime.h>
#include <hip/hip_cooperative_groups.h>
#include <cstdio>
#include <cstdint>
namespace cg = cooperative_groups;
__device__ __forceinline__ int otid() { int t = threadIdx.x; asm volatile("" : "+v"(t)); return t; }
namespace pg8 {
#define PG8_LAS __attribute__((address_space(3)))
typedef unsigned short bf16_t;
typedef short bf16x8 __attribute__((ext_vector_type(8)));
typedef float f32x4 __attribute__((ext_vector_type(4)));
typedef unsigned u32x4 __attribute__((ext_vector_type(4)));
constexpr int BM = 256, BK = 64, HALF = 128, HTB = HALF * BK * 2  , STAGE_BYTES = 8 * HTB, NXCD = 8, WGM = 8;

__host__ __device__ __forceinline__ int lds_byte(int r, int c) { const int st = (r >> 4) * 2 + (c >> 5), rr = r & 15, cc = c & 31, ob = rr * 64 + cc * 2; return st * 1024 + (ob ^ (((ob >> 9) & 1) << 5)); }
__host__ __device__ __forceinline__ void stage_rc(int b, int& R, int& C) { const int st = b / 1024, sb = b % 1024, swz = sb ^ (((sb >> 9) & 1) << 5); R = (st >> 1) * 16 + swz / 64; C = (st & 1) * 32 + (swz % 64) / 2; }
__host__ __device__ __forceinline__ int perm32(int rho) { const int n = rho >> 4, i = rho & 15; return 8 * (i >> 2) + 4 * n + (i & 3); }

struct Unit { int pm, pn; };
struct Gemm { const bf16_t* A; const bf16_t* Bt; int M, N, K; };

struct StaticOrder {
    int nM, nN, nwg, G, c;
    __host__ __device__ void init(int M, int N, int G_, int c_) { nM = M / BM; nN = N / BM; nwg = nM * nN; G = G_; c = c_; }
    __host__ __device__ bool next(int i, Unit& u) const {
        const long L = (long)i * G + c; if (L >= nwg) return false;
        int wgid = (int)L; { const int q = nwg / NXCD, r = nwg % NXCD, xcd = wgid % NXCD, off = wgid / NXCD; wgid = (xcd < r ? xcd * (q + 1) : r * (q + 1) + (xcd - r) * q) + off; }
        const int nig = WGM * nN, gid = wgid / nig, fm = gid * WGM, gsz = (nM - fm) < WGM ? (nM - fm) : WGM;
        u.pm = fm + ((wgid % nig) % gsz); u.pn = (wgid % nig) / gsz; return true;
    }
    __device__ __forceinline__ void a_ready(const Unit&) const {}
    __device__ __forceinline__ void done(const Unit&) const {}
};

__device__ __forceinline__ unsigned cvt_pk_bf16(float lo, float hi) { unsigned r; asm volatile("v_cvt_pk_bf16_f32 %0, %1, %2" : "=v"(r) : "v"(lo), "v"(hi)); return r; }
struct EpiStore {
    static constexpr bool PERM = true, AFTER_DRAIN = false;
    bf16_t* O; int ldc;
    __device__ __forceinline__ void operator()(const f32x4 (&acc)[2][2][4][2], const Unit& u, int wr, int wc, int fr, int fq) const {
        const int row0 = u.pm * BM + wr * 64 + fr; const int col0 = u.pn * BM + wc * 32 + 8 * fq;
#pragma unroll
        for (int ai = 0; ai < 2; ++ai)
#pragma unroll
            for (int m = 0; m < 4; ++m) { bf16_t* rowp = O + (size_t)(row0 + ai * HALF + m * 16) * ldc + col0;
#pragma unroll
                for (int bj = 0; bj < 2; ++bj) { const f32x4 v0 = acc[ai][bj][m][0], v1 = acc[ai][bj][m][1];
                    u32x4 w; w.x = cvt_pk_bf16(v0[0], v0[1]); w.y = cvt_pk_bf16(v0[2], v0[3]); w.z = cvt_pk_bf16(v1[0], v1[1]); w.w = cvt_pk_bf16(v1[2], v1[3]);
                    *(u32x4*)(rowp + bj * HALF) = w; } }
    }
};
template <class Epi, class Sched, bool ALIGN_EPI = false, bool SP2 = false>
__device__ __forceinline__ void gemm_phase(PG8_LAS unsigned char* lds, const Gemm g, const Sched& S, const Epi& E) {
    const int tid = otid(), wid = __builtin_amdgcn_readfirstlane(tid >> 6), lane = tid & 63, wr = wid >> 2, wc = wid & 3, fr = lane & 15, fq = lane >> 4;
    const int K = g.K, nt = K / BK;
    unsigned voffA[2], voffB[2];
#pragma unroll
    for (int i = 0; i < 2; ++i) { int R, C; stage_rc(tid * 16 + i * 8192, R, C); const int Rb = Epi::PERM ? ((R & ~31) + perm32(R & 31)) : R;
        voffA[i] = (unsigned)(R * K + C) * 2u; voffB[i] = (unsigned)(Rb * K + C) * 2u; }
    const size_t kstep = (size_t)(BK * 2);
    const size_t hstep = (size_t)HALF * K * 2;
    const size_t tstep = 2 * hstep;
    const unsigned ldsw = (unsigned)wid * 1024u;
    const int aoff = lds_byte(wr * 64 + fr, fq * 8), boff = lds_byte(wc * 32 + fr, fq * 8);
#define PG8_SA(b, h) (((b) * 2 + (h)) * HTB)
#define PG8_SB(b, h) ((4 + (b) * 2 + (h)) * HTB)
#define PG8_STAGE(bufoff, gbase, voff) do { _Pragma("unroll") for (int _i = 0; _i < 2; ++_i) \
        __builtin_amdgcn_global_load_lds((const unsigned*)((const char*)(gbase) + (voff)[_i]), (PG8_LAS unsigned*)(lds + (bufoff) + ldsw + _i * 8192), 16, 0, 0); } while (0)
#define PG8_LDA(dst, b, h) do { _Pragma("unroll") for (int m = 0; m < 4; ++m) _Pragma("unroll") for (int k = 0; k < 2; ++k) dst[m][k] = *(const PG8_LAS bf16x8*)(lds + PG8_SA(b, h) + aoff + m * 2048 + k * 1024); } while (0)
#define PG8_LDB(dst, b, h) do { _Pragma("unroll") for (int n = 0; n < 2; ++n) _Pragma("unroll") for (int k = 0; k < 2; ++k) dst[n][k] = *(const PG8_LAS bf16x8*)(lds + PG8_SB(b, h) + boff + n * 2048 + k * 1024); } while (0)
#define PG8_MMA(ai, bj, At, Bt) do { __builtin_amdgcn_s_setprio(1); _Pragma("unroll") for (int m = 0; m < 4; ++m) _Pragma("unroll") for (int n = 0; n < 2; ++n) _Pragma("unroll") for (int k = 0; k < 2; ++k) \
        acc[ai][bj][m][n] = __builtin_amdgcn_mfma_f32_16x16x32_bf16(Bt[n][k], At[m][k], acc[ai][bj][m][n], 0, 0, 0); __builtin_amdgcn_s_setprio(0); } while (0)
#define PG8_WAIT_V(n) asm volatile("s_waitcnt vmcnt(" #n ")" ::: "memory")
#define PG8_WAIT_L(n) asm volatile("s_waitcnt lgkmcnt(" #n ")" ::: "memory")
#define PG8_BAR __builtin_amdgcn_s_barrier()
#define PG8_SCHED __builtin_amdgcn_sched_barrier(0)
    Unit cur, nxt; int ui = 0;
    if (!S.next(0, cur)) return;
    f32x4 acc[2][2][4][2];
#pragma unroll
    for (int a = 0; a < 2; ++a)
#pragma unroll
        for (int b = 0; b < 2; ++b)
#pragma unroll
            for (int m = 0; m < 4; ++m)
#pragma unroll
                for (int n = 0; n < 2; ++n) acc[a][b][m][n] = (f32x4){0.f, 0.f, 0.f, 0.f};
    bf16x8 At[4][2], B0[2][2], B1[2][2];
    const char* cA = (const char*)g.A + (size_t)cur.pm * tstep; const char* cB = (const char*)g.Bt + (size_t)cur.pn * tstep;
    S.a_ready(cur);
    if constexpr (SP2) {
        PG8_STAGE(PG8_SB(0, 0), cB, voffB); PG8_STAGE(PG8_SB(0, 1), cB + hstep, voffB); PG8_STAGE(PG8_SA(0, 0), cA, voffA); PG8_STAGE(PG8_SA(0, 1), cA + hstep, voffA);
        if (wr == 1) PG8_BAR;
        PG8_WAIT_V(2); PG8_BAR;
        PG8_STAGE(PG8_SB(1, 0), cB + kstep, voffB); PG8_STAGE(PG8_SA(1, 0), cA + kstep, voffA); PG8_STAGE(PG8_SB(1, 1), cB + hstep + kstep, voffB);
        PG8_WAIT_V(6); PG8_BAR;
    } else {
        PG8_STAGE(PG8_SB(0, 0), cB, voffB); PG8_STAGE(PG8_SA(0, 0), cA, voffA); PG8_STAGE(PG8_SB(0, 1), cB + hstep, voffB); PG8_STAGE(PG8_SA(0, 1), cA + hstep, voffA);
        if (wr == 1) PG8_BAR;
        PG8_WAIT_V(4); PG8_BAR;
        PG8_STAGE(PG8_SB(1, 0), cB + kstep, voffB); PG8_STAGE(PG8_SA(1, 0), cA + kstep, voffA); PG8_STAGE(PG8_SB(1, 1), cB + hstep + kstep, voffB);
        PG8_WAIT_V(6); PG8_BAR;
    }
    for (;;) {
        const bool has_next = S.next(ui + 1, nxt);
        const char* nA = has_next ? (const char*)g.A + (size_t)nxt.pm * tstep : cA; const char* nB = has_next ? (const char*)g.Bt + (size_t)nxt.pn * tstep : cB;
        for (int t = 0; t < nt; t += 2) {
            const bool last = (t == nt - 2);
            const char* a1 = cA + (size_t)(t + 1) * kstep;
            const char* a2 = last ? nA : cA + (size_t)(t + 2) * kstep; const char* b2 = last ? nB : cB + (size_t)(t + 2) * kstep;
            const char* a3 = a2 + kstep; const char* b3 = b2 + kstep;
            if (last && has_next) S.a_ready(nxt);
            if constexpr (SP2) {
            PG8_LDB(B0, 0, 0); PG8_LDB(B1, 0, 1); PG8_SCHED; PG8_LDA(At, 0, 0); PG8_STAGE(PG8_SA(1, 1), a1 + hstep, voffA);
            PG8_WAIT_V(8); PG8_WAIT_L(0); PG8_BAR; PG8_MMA(0, 0, At, B0); PG8_MMA(0, 1, At, B1); PG8_BAR; PG8_SCHED;
            PG8_LDA(At, 0, 1); PG8_STAGE(PG8_SB(0, 0), b2, voffB); PG8_STAGE(PG8_SB(0, 1), b2 + hstep, voffB); PG8_STAGE(PG8_SA(0, 0), a2, voffA);
            PG8_WAIT_V(8); PG8_WAIT_L(0); PG8_BAR; PG8_MMA(1, 0, At, B0); PG8_MMA(1, 1, At, B1); PG8_BAR; PG8_SCHED;
            PG8_LDB(B0, 1, 0); PG8_LDB(B1, 1, 1); PG8_SCHED; PG8_LDA(At, 1, 0); PG8_STAGE(PG8_SA(0, 1), a2 + hstep, voffA);
            PG8_WAIT_V(8); PG8_WAIT_L(0); PG8_BAR; PG8_MMA(0, 0, At, B0); PG8_MMA(0, 1, At, B1); PG8_BAR; PG8_SCHED;
            PG8_LDA(At, 1, 1); PG8_STAGE(PG8_SB(1, 0), b3, voffB); PG8_STAGE(PG8_SB(1, 1), b3 + hstep, voffB); PG8_STAGE(PG8_SA(1, 0), a3, voffA);
            PG8_WAIT_V(8); PG8_WAIT_L(0); PG8_BAR; PG8_MMA(1, 0, At, B0); PG8_MMA(1, 1, At, B1); PG8_BAR; PG8_SCHED;
            } else {
            PG8_LDB(B0, 0, 0); PG8_SCHED; PG8_LDA(At, 0, 0); PG8_STAGE(PG8_SA(1, 1), a1 + hstep, voffA);
            PG8_WAIT_L(8); PG8_BAR; PG8_WAIT_L(0); PG8_MMA(0, 0, At, B0); PG8_BAR; PG8_SCHED;
            PG8_LDB(B1, 0, 1); PG8_STAGE(PG8_SB(0, 0), b2, voffB);
            PG8_BAR; PG8_WAIT_L(0); PG8_MMA(0, 1, At, B1); PG8_BAR;
            PG8_LDA(At, 0, 1); PG8_STAGE(PG8_SA(0, 0), a2, voffA);
            PG8_BAR; PG8_WAIT_L(0); PG8_MMA(1, 0, At, B0); PG8_BAR; PG8_SCHED;
            PG8_STAGE(PG8_SB(0, 1), b2 + hstep, voffB);
            PG8_WAIT_V(6); PG8_BAR; PG8_MMA(1, 1, At, B1); PG8_BAR;
            PG8_LDB(B0, 1, 0); PG8_SCHED; PG8_LDA(At, 1, 0); PG8_STAGE(PG8_SA(0, 1), a2 + hstep, voffA);
            PG8_WAIT_L(8); PG8_BAR; PG8_WAIT_L(0); PG8_MMA(0, 0, At, B0); PG8_BAR; PG8_SCHED;
            PG8_LDB(B1, 1, 1); PG8_STAGE(PG8_SB(1, 0), b3, voffB);
            PG8_BAR; PG8_WAIT_L(0); PG8_MMA(0, 1, At, B1); PG8_BAR;
            PG8_LDA(At, 1, 1); PG8_STAGE(PG8_SA(1, 0), a3, voffA);
            PG8_BAR; PG8_WAIT_L(0); PG8_MMA(1, 0, At, B0); PG8_BAR; PG8_SCHED;
            PG8_STAGE(PG8_SB(1, 1), b3 + hstep, voffB);
            PG8_WAIT_V(6); PG8_BAR; PG8_MMA(1, 1, At, B1); PG8_BAR;
            }
        }
        if constexpr (ALIGN_EPI) { if (wr == 0) PG8_BAR; }
        if constexpr (!Epi::AFTER_DRAIN) { E(acc, cur, wr, wc, fr, fq); S.done(cur); }
        if (!has_next) break;
#pragma unroll
        for (int a = 0; a < 2; ++a)
#pragma unroll
            for (int b = 0; b < 2; ++b)
#pragma unroll
                for (int m = 0; m < 4; ++m)
#pragma unroll
                    for (int n = 0; n < 2; ++n) acc[a][b][m][n] = (f32x4){0.f, 0.f, 0.f, 0.f};
        cur = nxt; cA = nA; cB = nB; ++ui;
        if constexpr (ALIGN_EPI) { if (wr == 1) PG8_BAR; }
    }
    PG8_WAIT_V(0);
    if constexpr (!ALIGN_EPI) { if (wr == 0) PG8_BAR; }
    PG8_BAR;
    if constexpr (Epi::AFTER_DRAIN) { E.fused(acc, cur, wr, wc, fr, fq, lds, wid, lane); S.done(cur); }
#undef PG8_SA
#undef PG8_SB
#undef PG8_STAGE
#undef PG8_LDA
#undef PG8_LDB
#undef PG8_MMA
#undef PG8_WAIT_V
#undef PG8_WAIT_L
#undef PG8_BAR
#undef PG8_SCHED
}
}

#define LAS __attribute__((address_space(3)))
typedef unsigned short bf16;
typedef unsigned v4u __attribute__((ext_vector_type(4)));
typedef unsigned v2u __attribute__((ext_vector_type(2)));
typedef float f32x4 __attribute__((ext_vector_type(4)));
constexpr int NWAVES = 8, NTHR = 512;
constexpr int D = 1024, NB = 8, SEQ = 2048, CTXL = 256, TL = NB * SEQ, TC = NB * CTXL, T = TL + TC;
constexpr int HYB_IN = 2208, HYB_INP = 2304, SSD_IN = 5184, SSD_INP = 5376, DFF = 2816, UPW = 5632;
constexpr int QW = 768, KVW = 1024, MODW = 6144;
constexpr float EPS = 1e-6f;
constexpr int NSTEP = 1 + 4 * 10;
constexpr float ATT_SCALE_LOG2E = 0.10206207261596577f * 1.4426950408889634f;

constexpr size_t MiB = 1u << 20;
constexpr size_t WS_CTL = 0, CTL_ZERO_BYTES = 64 * 1024;
constexpr size_t WS_MOD = 1 * MiB;
constexpr size_t WS_ROPE = 2 * MiB;
constexpr size_t W_UP = 3 * MiB;
constexpr size_t W_DN = W_UP + (size_t)UPW * D * 2;
constexpr size_t W_IN = W_DN + (size_t)D * DFF * 2;
constexpr size_t W_OUT = W_IN + (size_t)SSD_INP * D * 2;
constexpr size_t W_UQ = W_OUT + (size_t)D * 2048 * 2;
constexpr size_t W_UKV = W_UQ + (size_t)QW * 384 * 2;
constexpr size_t W_END = W_UKV + (size_t)KVW * 256 * 2;
constexpr size_t WS_XC = 36 * MiB;
constexpr size_t WS_H = 44 * MiB;
constexpr size_t WS_DT = WS_H, WS_AA = WS_H + (size_t)T * 64 * 4;
constexpr size_t WS_BIG = 80 * MiB;
constexpr size_t WS_M = WS_BIG;
constexpr size_t WS_P = WS_BIG;
constexpr size_t WS_Q = WS_BIG + 81 * MiB;
constexpr size_t WS_KV = WS_BIG + 108 * MiB;
constexpr size_t WS_KR = WS_BIG + 144 * MiB;
constexpr size_t WS_CQN = WS_BIG + 146 * MiB;
constexpr size_t WS_CKVN = WS_BIG + 160 * MiB;
constexpr size_t WS_MIX = WS_BIG + 170 * MiB;
constexpr size_t WS_U = WS_BIG;
constexpr size_t WS_G = WS_BIG + 198 * MiB;
constexpr size_t WS_ZX = WS_BIG;
constexpr size_t WS_XBC = WS_BIG + 189 * MiB;
constexpr size_t WS_END = WS_BIG + 297 * MiB;
static_assert(W_END <= WS_XC && WS_G + (size_t)T * DFF * 2 <= WS_END && WS_XBC + (size_t)T * 3072 * 2 <= WS_END && WS_ZX + (size_t)T * SSD_INP * 2 <= WS_XBC, "ws map");
static_assert(WS_AA + (size_t)T * 64 * 4 <= WS_BIG && WS_MIX + (size_t)T * D * 2 <= WS_END && WS_Q + (size_t)T * QW * 2 <= WS_KV && WS_P + (size_t)T * HYB_INP * 2 <= WS_Q, "ws map 2");
constexpr int LDS_BYTES = 147456;

struct Args { const float* in[25]; float* out; unsigned char* ws; int lo, hi; };
enum { I_X = 0, I_C, I_CTX, I_CCTX, I_MODW, I_MODB, I_NORMW, I_WUP, I_FCONV, I_WDN, I_HIN, I_QNORM, I_KVNORM, I_WUQ, I_WUKV, I_SCONV, I_HOUT, I_SIN, I_SCONVW, I_SCONVB, I_ALOG, I_DTB, I_SD, I_SNORM, I_SOUT };

__device__ __forceinline__ unsigned f2bf(float f) { unsigned u = __builtin_bit_cast(unsigned, f); return (u + 0x7fffu + ((u >> 16) & 1u)) >> 16; }
__device__ __forceinline__ unsigned pk2(float lo, float hi) { return f2bf(lo) | (f2bf(hi) << 16); }
__device__ __forceinline__ float bflo(unsigned u) { return __builtin_bit_cast(float, u << 16); }
__device__ __forceinline__ float bfhi(unsigned u) { return __builtin_bit_cast(float, u & 0xffff0000u); }
__device__ __forceinline__ float bf1(bf16 b) { return __builtin_bit_cast(float, (unsigned)b << 16); }
__device__ __forceinline__ float silu_f(float x) { return x / (1.f + __expf(-x)); }
__device__ __forceinline__ float wave_sum(float v) {
#pragma unroll
    for (int o = 1; o < 64; o <<= 1) v += __shfl_xor(v, o);
    return v;
}
__device__ __forceinline__ void unpack8(const v4u w, float (&f)[8]) { f[0] = bflo(w.x); f[1] = bfhi(w.x); f[2] = bflo(w.y); f[3] = bfhi(w.y); f[4] = bflo(w.z); f[5] = bfhi(w.z); f[6] = bflo(w.w); f[7] = bfhi(w.w); }
__device__ __forceinline__ v4u pack8(const float (&f)[8]) { v4u w; w.x = pk2(f[0], f[1]); w.y = pk2(f[2], f[3]); w.z = pk2(f[4], f[5]); w.w = pk2(f[6], f[7]); return w; }
__device__ __forceinline__ bool has_prev(int r) { return r < TL ? (r & (SEQ - 1)) != 0 : ((r - TL) & (CTXL - 1)) != 0; }
__device__ __forceinline__ bool has_next(int r) { return r < TL ? (r & (SEQ - 1)) != SEQ - 1 : ((r - TL) & (CTXL - 1)) != CTXL - 1; }

__device__ __forceinline__ void mod_compute(const Args& a, LAS unsigned char* lds) {
    LAS float* sc = (LAS float*)lds;
    LAS float* red = (LAS float*)(lds + 36864);
    const int tid = otid();
    float* MOD = (float*)(a.ws + WS_MOD);
    for (int i = tid; i < 9 * 1024; i += NTHR) { const int c = i >> 10, k = i & 1023; const float v = c < 8 ? a.in[I_C][c * 1024 + k] : a.in[I_CCTX][k]; sc[i] = silu_f(v); }
    __syncthreads();
    for (int item = blockIdx.x; item < 4 * 96; item += gridDim.x) {
        const int l = item / 96, cb = item % 96;
        const float* W = a.in[I_MODW] + (size_t)l * 1024 * MODW + cb * 64;
        const int cgp = tid & 15, kg = tid >> 4;
        float acc[9][4];
#pragma unroll
        for (int c = 0; c < 9; ++c) { acc[c][0] = 0.f; acc[c][1] = 0.f; acc[c][2] = 0.f; acc[c][3] = 0.f; }
#pragma unroll 4
        for (int kk = 0; kk < 32; ++kk) { const int k = kg * 32 + kk; const f32x4 w = *(const f32x4*)(W + (size_t)k * MODW + cgp * 4);
#pragma unroll
            for (int c = 0; c < 9; ++c) { const float s = sc[c * 1024 + k]; acc[c][0] += s * w[0]; acc[c][1] += s * w[1]; acc[c][2] += s * w[2]; acc[c][3] += s * w[3]; } }
#pragma unroll
        for (int c = 0; c < 9; ++c)
#pragma unroll
            for (int j = 0; j < 4; ++j) red[kg * 576 + c * 64 + cgp * 4 + j] = acc[c][j];
        __syncthreads();
        for (int o = tid; o < 576; o += NTHR) { float s = 0.f;
            for (int g = 0; g < 32; ++g) s += red[g * 576 + o];
            const int c = o >> 6, col = o & 63; MOD[(size_t)(l * 9 + c) * MODW + cb * 64 + col] = s + a.in[I_MODB][l * MODW + cb * 64 + col]; }
        __syncthreads();
    }
}
__device__ __forceinline__ void rope_tables(const Args& a) {
    float* ct = (float*)(a.ws + WS_ROPE); float* st = ct + SEQ * 16;
    for (int i = blockIdx.x * NTHR + otid(); i < SEQ * 16; i += gridDim.x * NTHR) {
        const int t = i >> 4, j = i & 15; const int pos = j < 8 ? (t >> 6) : (t & 63); const int f = j & 7;
        const float inv = powf(10000.0f, -(float)f / 8.0f); const float ang = (float)pos * inv;
        ct[i] = cosf(ang); st[i] = sinf(ang); }
}
__device__ __forceinline__ void transpose_item(const float* W, int K, int N, bf16* WT, LAS float* scr, int item, int lane) {
    const int nblk = N / 32, kb = item / nblk, nb = item % nblk, k0 = 64 * kb, n0 = 32 * nb;
#pragma unroll 8
    for (int i = 0; i < 32; ++i) { const int kk = 2 * i + (lane >> 5); scr[kk * 33 + (lane & 31)] = W[(size_t)(k0 + kk) * N + n0 + (lane & 31)]; }
    asm volatile("s_waitcnt lgkmcnt(0)" ::: "memory");
    const int c = lane & 7;
#pragma unroll
    for (int j = 0; j < 4; ++j) { const int n = (lane >> 3) + 8 * j; const LAS float* s = scr + (8 * c) * 33 + n;
        v4u o; o.x = pk2(s[0 * 33], s[1 * 33]); o.y = pk2(s[2 * 33], s[3 * 33]); o.z = pk2(s[4 * 33], s[5 * 33]); o.w = pk2(s[6 * 33], s[7 * 33]);
        *(v4u*)(WT + (size_t)(n0 + n) * K + k0 + 8 * c) = o; }
    asm volatile("s_waitcnt lgkmcnt(0)" ::: "memory");
}
__device__ __forceinline__ void convert_weight(const float* W, int K, int N, int Npad, bf16* WT, LAS unsigned char* lds, int rot) {
    const int wave = otid() >> 6, lane = otid() & 63; const int NGW = gridDim.x * NWAVES; const int gw = (blockIdx.x * NWAVES + wave + rot) % NGW;
    LAS float* scr = (LAS float*)(lds + wave * 16384);
    const int nitems = (K / 64) * (N / 32);
    for (int it = gw; it < nitems; it += NGW) transpose_item(W, K, N, WT, scr, it, lane);
    const size_t npadv = (size_t)(Npad - N) * K / 8;
    for (size_t i = (size_t)gw * 64 + lane; i < npadv; i += (size_t)NGW * 64) *(v4u*)(WT + (size_t)N * K + i * 8) = (v4u){0u, 0u, 0u, 0u};
}
__device__ __forceinline__ void convert_layer(const Args& a, int l, LAS unsigned char* lds) {
    const int i = l >> 1; unsigned char* ws = a.ws;
    convert_weight(a.in[I_WUP] + (size_t)l * D * UPW, D, UPW, UPW, (bf16*)(ws + W_UP), lds, 0);
    convert_weight(a.in[I_WDN] + (size_t)l * DFF * D, DFF, D, D, (bf16*)(ws + W_DN), lds, 300);
    if ((l & 1) == 0) {
        convert_weight(a.in[I_HIN] + (size_t)i * D * HYB_IN, D, HYB_IN, HYB_INP, (bf16*)(ws + W_IN), lds, 700);
        convert_weight(a.in[I_HOUT] + (size_t)i * D * D, D, D, D, (bf16*)(ws + W_OUT), lds, 1100);
        convert_weight(a.in[I_WUQ] + (size_t)i * 384 * QW, 384, QW, QW, (bf16*)(ws + W_UQ), lds, 1500);
        convert_weight(a.in[I_WUKV] + (size_t)i * 256 * KVW, 256, KVW, KVW, (bf16*)(ws + W_UKV), lds, 1700);
    } else {
        convert_weight(a.in[I_SIN] + (size_t)i * D * SSD_IN, D, SSD_IN, SSD_INP, (bf16*)(ws + W_IN), lds, 700);
        convert_weight(a.in[I_SOUT] + (size_t)i * 2048 * D, 2048, D, D, (bf16*)(ws + W_OUT), lds, 1300);
    }
}

__device__ __forceinline__ void rowwise(const float* xs_lat, const float* xs_ctx, float* xd_lat, float* xd_ctx, const bf16* Mb, const float* modg  , const float* nwA,
                                        bf16* H, const float* modh  , int sh_off, int sc_off, const float* nwB, int nrows) {
    const int wave = otid() >> 6, lane = otid() & 63; const int NGW = gridDim.x * NWAVES, gw = blockIdx.x * NWAVES + wave;
    for (int r = gw; r < nrows; r += NGW) {
        const bool lat = r < TL; const int cond = lat ? (r >> 11) : 8;
        const float* xs = lat ? xs_lat + (size_t)r * D : xs_ctx + (size_t)(r - TL) * D;
        float* xd = lat ? xd_lat + (size_t)r * D : xd_ctx + (size_t)(r - TL) * D;
        f32x4 v[4];
#pragma unroll
        for (int j = 0; j < 4; ++j) v[j] = *(const f32x4*)(xs + j * 256 + lane * 4);
        if (Mb) {
            f32x4 m[4]; float ss = 0.f;
#pragma unroll
            for (int j = 0; j < 4; ++j) { const v2u w = *(const v2u*)(Mb + (size_t)r * D + j * 256 + lane * 4); m[j] = (f32x4){bflo(w.x), bfhi(w.x), bflo(w.y), bfhi(w.y)};
                ss += (m[j][0] * m[j][0] + m[j][1] * m[j][1]) + (m[j][2] * m[j][2] + m[j][3] * m[j][3]); }
            const float rs = rsqrtf(wave_sum(ss) * (1.f / D) + EPS);
#pragma unroll
            for (int j = 0; j < 4; ++j) { const f32x4 g = *(const f32x4*)(modg + (size_t)cond * MODW + j * 256 + lane * 4); const f32x4 w = *(const f32x4*)(nwA + j * 256 + lane * 4);
                v[j] = v[j] + g * (m[j] * rs * w); }
        }
#pragma unroll
        for (int j = 0; j < 4; ++j) *(f32x4*)(xd + j * 256 + lane * 4) = v[j];
        if (H) {
            float ss = 0.f;
#pragma unroll
            for (int j = 0; j < 4; ++j) ss += (v[j][0] * v[j][0] + v[j][1] * v[j][1]) + (v[j][2] * v[j][2] + v[j][3] * v[j][3]);
            const float rs = rsqrtf(wave_sum(ss) * (1.f / D) + EPS);
#pragma unroll
            for (int j = 0; j < 4; ++j) { const int c = j * 256 + lane * 4;
                const f32x4 w = *(const f32x4*)(nwB + c); const f32x4 sc = *(const f32x4*)(modh + (size_t)cond * MODW + sc_off + c); const f32x4 sh = *(const f32x4*)(modh + (size_t)cond * MODW + sh_off + c);
                const f32x4 h = (v[j] * rs * w) * (sc + 1.0f) + sh;
                v2u o; o.x = pk2(h[0], h[1]); o.y = pk2(h[2], h[3]); *(v2u*)(H + (size_t)r * D + c) = o; }
        }
    }
}

__device__ __forceinline__ void prep_even(const Args& a, int i) {
    const int wave = otid() >> 6, lane = otid() & 63; const int NGW = gridDim.x * NWAVES, gw = blockIdx.x * NWAVES + wave;
    const bf16* P = (const bf16*)(a.ws + WS_P); bf16* CQN = (bf16*)(a.ws + WS_CQN); bf16* CKVN = (bf16*)(a.ws + WS_CKVN); bf16* KR = (bf16*)(a.ws + WS_KR); bf16* MIX = (bf16*)(a.ws + WS_MIX);
    const float* qn = a.in[I_QNORM] + i * 384; const float* kvn = a.in[I_KVNORM] + i * 256; const float* cw = a.in[I_SCONV] + i * 3 * 512;
    const float* ct = (const float*)(a.ws + WS_ROPE); const float* st = ct + SEQ * 16;
    for (int r = gw; r < T; r += NGW) {
        const bf16* p = P + (size_t)r * HYB_INP;
        {
            const unsigned* p32 = (const unsigned*)(p + lane * 6); const unsigned w0 = p32[0], w1 = p32[1], w2 = p32[2];
            float f[6] = {bflo(w0), bfhi(w0), bflo(w1), bfhi(w1), bflo(w2), bfhi(w2)}; float ss = 0.f;
#pragma unroll
            for (int j = 0; j < 6; ++j) ss += f[j] * f[j];
            const float rs = rsqrtf(wave_sum(ss) * (1.f / 384.f) + EPS);
#pragma unroll
            for (int j = 0; j < 6; ++j) f[j] = f[j] * rs * qn[lane * 6 + j];
            unsigned* o32 = (unsigned*)(CQN + (size_t)r * 384 + lane * 6); o32[0] = pk2(f[0], f[1]); o32[1] = pk2(f[2], f[3]); o32[2] = pk2(f[4], f[5]);
        }
        {
            const v2u w = *(const v2u*)(p + 384 + lane * 4); float f[4] = {bflo(w.x), bfhi(w.x), bflo(w.y), bfhi(w.y)};
            const float ss = (f[0] * f[0] + f[1] * f[1]) + (f[2] * f[2] + f[3] * f[3]);
            const float rs = rsqrtf(wave_sum(ss) * (1.f / 256.f) + EPS);
            const f32x4 g = *(const f32x4*)(kvn + lane * 4);
            v2u o; o.x = pk2(f[0] * rs * g[0], f[1] * rs * g[1]); o.y = pk2(f[2] * rs * g[2], f[3] * rs * g[3]); *(v2u*)(CKVN + (size_t)r * 256 + lane * 4) = o;
        }
        {
            const int j = lane & 31; const float v = bf1(p[640 + j]); const float o = __shfl_xor(v, 16); float res = v;
            if (r < TL) { const int t = r & (SEQ - 1); const float c = ct[t * 16 + (j & 15)], s = st[t * 16 + (j & 15)]; res = (j < 16) ? v * c - o * s : o * s + v * c; }
            if (lane < 32) KR[(size_t)r * 32 + j] = (bf16)f2bf(res);
        }
        {
            const int c0 = lane * 8; float gb[8], cur[8], acc[8], t0[8], t1[8];
            unpack8(*(const v4u*)(p + 672 + c0), gb);
            unpack8(*(const v4u*)(p + 1184 + c0), t0); unpack8(*(const v4u*)(p + 1696 + c0), t1);
#pragma unroll
            for (int j = 0; j < 8; ++j) { cur[j] = t0[j] * t1[j]; acc[j] = cw[512 + c0 + j] * cur[j]; }
            if (has_prev(r)) { unpack8(*(const v4u*)(p - HYB_INP + 1184 + c0), t0); unpack8(*(const v4u*)(p - HYB_INP + 1696 + c0), t1);
#pragma unroll
                for (int j = 0; j < 8; ++j) acc[j] += cw[c0 + j] * (t0[j] * t1[j]); }
            if (has_next(r)) { unpack8(*(const v4u*)(p + HYB_INP + 1184 + c0), t0); unpack8(*(const v4u*)(p + HYB_INP + 1696 + c0), t1);
#pragma unroll
                for (int j = 0; j < 8; ++j) acc[j] += cw[1024 + c0 + j] * (t0[j] * t1[j]); }
#pragma unroll
            for (int j = 0; j < 8; ++j) acc[j] *= gb[j];
            *(v4u*)(MIX + (size_t)r * D + 512 + c0) = pack8(acc);
        }
    }
}

__device__ __forceinline__ void convgate(const Args& a, int l, int nrows) {
    const bf16* U = (const bf16*)(a.ws + WS_U); bf16* G = (bf16*)(a.ws + WS_G); const float* cw = a.in[I_FCONV] + (size_t)l * 3 * UPW;
    const int total = nrows * (DFF / 8);
    for (int idx = blockIdx.x * NTHR + otid(); idx < total; idx += gridDim.x * NTHR) {
        const int r = idx / (DFF / 8), c0 = (idx % (DFF / 8)) * 8; const bf16* u = U + (size_t)r * UPW + c0;
        float ua[8], ug[8], act[8], gate[8];
        unpack8(*(const v4u*)u, ua); unpack8(*(const v4u*)(u + DFF), ug);
#pragma unroll
        for (int j = 0; j < 8; ++j) { act[j] = cw[UPW + c0 + j] * ua[j]; gate[j] = cw[UPW + DFF + c0 + j] * ug[j]; }
        if (has_prev(r)) { unpack8(*(const v4u*)(u - UPW), ua); unpack8(*(const v4u*)(u - UPW + DFF), ug);
#pragma unroll
            for (int j = 0; j < 8; ++j) { act[j] += cw[c0 + j] * ua[j]; gate[j] += cw[DFF + c0 + j] * ug[j]; } }
        if (has_next(r)) { unpack8(*(const v4u*)(u + UPW), ua); unpack8(*(const v4u*)(u + UPW + DFF), ug);
#pragma unroll
            for (int j = 0; j < 8; ++j) { act[j] += cw[2 * UPW + c0 + j] * ua[j]; gate[j] += cw[2 * UPW + DFF + c0 + j] * ug[j]; } }
#pragma unroll
        for (int j = 0; j < 8; ++j) act[j] = silu_f(act[j]) * gate[j];
        *(v4u*)(G + (size_t)r * DFF + c0) = pack8(act);
    }
}

__device__ __forceinline__ void ssd_conv(const Args& a, int i) {
    const bf16* ZX = (const bf16*)(a.ws + WS_ZX); bf16* XBC = (bf16*)(a.ws + WS_XBC); float* DT = (float*)(a.ws + WS_DT); float* AA = (float*)(a.ws + WS_AA);
    const float* cw = a.in[I_SCONVW] + (size_t)i * 3 * 3072; const float* cb = a.in[I_SCONVB] + (size_t)i * 3072;
    const int total = T * 384;
    for (int idx = blockIdx.x * NTHR + otid(); idx < total; idx += gridDim.x * NTHR) {
        const int r = idx / 384, c0 = (idx % 384) * 8; const bf16* u = ZX + (size_t)r * SSD_INP + 2048 + c0;
        float x[8], acc[8];
        unpack8(*(const v4u*)u, x);
#pragma unroll
        for (int j = 0; j < 8; ++j) acc[j] = cb[c0 + j] + cw[3072 + c0 + j] * x[j];
        if (has_prev(r)) { unpack8(*(const v4u*)(u - SSD_INP), x);
#pragma unroll
            for (int j = 0; j < 8; ++j) acc[j] += cw[c0 + j] * x[j]; }
        if (has_next(r)) { unpack8(*(const v4u*)(u + SSD_INP), x);
#pragma unroll
            for (int j = 0; j < 8; ++j) acc[j] += cw[2 * 3072 + c0 + j] * x[j]; }
#pragma unroll
        for (int j = 0; j < 8; ++j) acc[j] = silu_f(acc[j]);
        *(v4u*)(XBC + (size_t)r * 3072 + c0) = pack8(acc);
    }
    const float* alog = a.in[I_ALOG] + i * 64; const float* dtb = a.in[I_DTB] + i * 64;
    for (int idx = blockIdx.x * NTHR + otid(); idx < T * 64; idx += gridDim.x * NTHR) {
        const int r = idx >> 6, j = idx & 63; const float raw = bf1(ZX[(size_t)r * SSD_INP + 5120 + j]) + dtb[j];
        const float dt = raw > 20.f ? raw : log1pf(__expf(raw));
        DT[idx] = dt; AA[idx] = -__expf(alog[j]) * dt;
    }
}

__device__ __forceinline__ void gatenorm(const Args& a, int i, int nrows) {
    const int wave = otid() >> 6, lane = otid() & 63; const int NGW = gridDim.x * NWAVES, gw = blockIdx.x * NWAVES + wave;
    const bf16* ZX = (const bf16*)(a.ws + WS_ZX); bf16* YN = (bf16*)(a.ws + WS_XBC); const float* nw = a.in[I_SNORM] + i * 2048;
    for (int r = gw; r < nrows; r += NGW) {
        float v[4][8]; float ss = 0.f;
#pragma unroll
        for (int j = 0; j < 4; ++j) { float y[8], z[8]; const int c = j * 512 + lane * 8;
            unpack8(*(const v4u*)(ZX + (size_t)r * SSD_INP + 2048 + c), y); unpack8(*(const v4u*)(ZX + (size_t)r * SSD_INP + c), z);
#pragma unroll
            for (int k = 0; k < 8; ++k) { v[j][k] = y[k] * silu_f(z[k]); ss += v[j][k] * v[j][k]; } }
        const float rs = rsqrtf(wave_sum(ss) * (1.f / 2048.f) + EPS);
#pragma unroll
        for (int j = 0; j < 4; ++j) { const int c = j * 512 + lane * 8; float o[8];
#pragma unroll
            for (int k = 0; k < 8; ++k) o[k] = v[j][k] * rs * nw[c + k];
            *(v4u*)(YN + (size_t)r * 2048 + c) = pack8(o); }
    }
}

__device__ __forceinline__ void attn_naive(const Args& a, LAS unsigned char* lds) {
    const int tid = otid(), qi = tid >> 1, half = tid & 1;
    const bf16* Qb = (const bf16*)(a.ws + WS_Q); const bf16* KVb = (const bf16*)(a.ws + WS_KV); const bf16* KR = (const bf16*)(a.ws + WS_KR); bf16* MIX = (bf16*)(a.ws + WS_MIX);
    const float* ct = (const float*)(a.ws + WS_ROPE); const float* st = ct + SEQ * 16;
    LAS float* Kt = (LAS float*)lds;
    LAS float* Vt = (LAS float*)(lds + 64 * 96 * 4);
    for (int u = blockIdx.x; u < 576; u += gridDim.x) {
        const bool lat = u < 512; const int b = lat ? (u >> 6) : ((u - 512) >> 3), h = lat ? ((u >> 3) & 7) : ((u - 512) & 7);
        const int nkeys = lat ? (CTXL + SEQ) : CTXL;
        const int qrow = lat ? b * SEQ + (u & 7) * 256 + qi : TL + b * CTXL + qi;
        float q[48];
#pragma unroll
        for (int g = 0; g < 6; ++g) { float f[8]; unpack8(*(const v4u*)(Qb + (size_t)qrow * QW + h * 96 + half * 48 + g * 8), f);
#pragma unroll
            for (int j = 0; j < 8; ++j) q[g * 8 + j] = f[j]; }
        if (lat && half == 1) { const int t = qrow & (SEQ - 1);
#pragma unroll
            for (int j = 0; j < 16; ++j) { const float c = ct[t * 16 + j], s = st[t * 16 + j]; const float x1 = q[16 + j], x2 = q[32 + j]; q[16 + j] = x1 * c - x2 * s; q[32 + j] = x1 * s + x2 * c; } }
#pragma unroll
        for (int j = 0; j < 48; ++j) q[j] *= ATT_SCALE_LOG2E;
        float o[32]; float m = -1e30f, l = 0.f;
#pragma unroll
        for (int j = 0; j < 32; ++j) o[j] = 0.f;
        for (int k0 = 0; k0 < nkeys; k0 += 64) {
            __syncthreads();
            for (int g = tid; g < 768; g += NTHR) { const int key = g / 12, part = g % 12; const int kk = k0 + key; const int krow = kk < CTXL ? TL + b * CTXL + kk : b * SEQ + kk - CTXL;
                float f[8]; unpack8(part < 8 ? *(const v4u*)(KVb + (size_t)krow * KVW + h * 128 + part * 8) : *(const v4u*)(KR + (size_t)krow * 32 + (part - 8) * 8), f);
#pragma unroll
                for (int j = 0; j < 8; ++j) Kt[key * 96 + part * 8 + j] = f[j]; }
            { const int key = tid >> 3, part = tid & 7; const int kk = k0 + key; const int krow = kk < CTXL ? TL + b * CTXL + kk : b * SEQ + kk - CTXL;
                float f[8]; unpack8(*(const v4u*)(KVb + (size_t)krow * KVW + h * 128 + 64 + part * 8), f);
#pragma unroll
                for (int j = 0; j < 8; ++j) Vt[key * 64 + part * 8 + j] = f[j]; }
            __syncthreads();
            for (int kg = 0; kg < 64; kg += 8) {
                float s[8]; float gm = -1e30f;
#pragma unroll
                for (int kk = 0; kk < 8; ++kk) { float acc = 0.f; const LAS f32x4* kp = (const LAS f32x4*)(Kt + (kg + kk) * 96 + half * 48);
#pragma unroll
                    for (int d4 = 0; d4 < 12; ++d4) { const f32x4 kv = kp[d4]; acc += q[d4 * 4] * kv[0] + q[d4 * 4 + 1] * kv[1] + q[d4 * 4 + 2] * kv[2] + q[d4 * 4 + 3] * kv[3]; }
                    acc += __shfl_xor(acc, 1);
                    s[kk] = acc; gm = fmaxf(gm, acc); }
                const float mn = fmaxf(m, gm); const float alpha = exp2f(m - mn); m = mn; l *= alpha;
#pragma unroll
                for (int j = 0; j < 32; ++j) o[j] *= alpha;
#pragma unroll
                for (int kk = 0; kk < 8; ++kk) { const float p = exp2f(s[kk] - mn); l += p; const LAS f32x4* vp = (const LAS f32x4*)(Vt + (kg + kk) * 64 + half * 32);
#pragma unroll
                    for (int d4 = 0; d4 < 8; ++d4) { const f32x4 vv = vp[d4]; o[d4 * 4] += p * vv[0]; o[d4 * 4 + 1] += p * vv[1]; o[d4 * 4 + 2] += p * vv[2]; o[d4 * 4 + 3] += p * vv[3]; } }
            }
        }
        { const float inv = 1.f / l;
#pragma unroll
            for (int g = 0; g < 4; ++g) { float f[8];
#pragma unroll
                for (int j = 0; j < 8; ++j) f[j] = o[g * 8 + j] * inv;
                *(v4u*)(MIX + (size_t)qrow * D + h * 64 + half * 32 + g * 8) = pack8(f); } }
    }
}

__device__ __forceinline__ void ssd_scan_naive(const Args& a, int i, bool last, LAS unsigned char* lds) {
    const int tid = otid(), p = tid >> 3, nq = tid & 7;
    bf16* ZX = (bf16*)(a.ws + WS_ZX); const bf16* XBC = (const bf16*)(a.ws + WS_XBC); const float* DT = (const float*)(a.ws + WS_DT); const float* AA = (const float*)(a.ws + WS_AA);
    LAS float* xs = (LAS float*)lds;
    LAS float* Bs = (LAS float*)(lds + 16384);
    LAS float* Cs = (LAS float*)(lds + 16384 + 32768);
    LAS float* dts = (LAS float*)(lds + 16384 + 65536);
    LAS float* as = dts + 64;
    for (int it = blockIdx.x; it < NB * 32; it += gridDim.x) {
        const int b = it >> 5, h = it & 31, g = h >> 3; const float dsk = a.in[I_SD][i * 32 + h];
        for (int dir = 0; dir < 2; ++dir) {
            float stt[16];
#pragma unroll
            for (int n = 0; n < 16; ++n) stt[n] = 0.f;
            for (int seg = 0; seg < 2; ++seg) {
                const int len = seg == 0 ? CTXL : SEQ; const int base = seg == 0 ? TL + b * CTXL : b * SEQ; const bool want_y = !(last && seg == 0);
                for (int cc = 0; cc < len / 64; ++cc) {
                    const int t0 = dir == 0 ? cc * 64 : len - 64 - cc * 64;
                    __syncthreads();
                    { const int tt = tid >> 3, part = tid & 7; float f[8]; unpack8(*(const v4u*)(XBC + (size_t)(base + t0 + tt) * 3072 + h * 64 + part * 8), f);
#pragma unroll
                        for (int j = 0; j < 8; ++j) xs[tt * 64 + part * 8 + j] = f[j]; }
                    for (int q = tid; q < 1024; q += NTHR) { const int tt = q >> 4, part = q & 15; float f[8];
                        unpack8(*(const v4u*)(XBC + (size_t)(base + t0 + tt) * 3072 + 2048 + g * 128 + part * 8), f);
#pragma unroll
                        for (int j = 0; j < 8; ++j) Bs[tt * 128 + part * 8 + j] = f[j];
                        unpack8(*(const v4u*)(XBC + (size_t)(base + t0 + tt) * 3072 + 2560 + g * 128 + part * 8), f);
#pragma unroll
                        for (int j = 0; j < 8; ++j) Cs[tt * 128 + part * 8 + j] = f[j]; }
                    if (tid < 64) { dts[tid] = DT[(size_t)(base + t0 + tid) * 64 + dir * 32 + h]; as[tid] = AA[(size_t)(base + t0 + tid) * 64 + dir * 32 + h]; }
                    __syncthreads();
                    for (int s = 0; s < 64; ++s) {
                        const int tt = dir == 0 ? s : 63 - s;
                        const float dec = __expf(as[tt]); const float xv = xs[tt * 64 + p]; const float xd = xv * dts[tt];
                        const LAS f32x4* bp = (const LAS f32x4*)(Bs + tt * 128 + nq * 16); const LAS f32x4* cp = (const LAS f32x4*)(Cs + tt * 128 + nq * 16);
                        float acc = 0.f;
#pragma unroll
                        for (int n4 = 0; n4 < 4; ++n4) { const f32x4 bv = bp[n4], cv = cp[n4];
#pragma unroll
                            for (int k = 0; k < 4; ++k) { stt[n4 * 4 + k] = dec * stt[n4 * 4 + k] + xd * bv[k]; acc += cv[k] * stt[n4 * 4 + k]; } }
                        acc += __shfl_xor(acc, 1); acc += __shfl_xor(acc, 2); acc += __shfl_xor(acc, 4);
                        if (want_y && nq == 0) { bf16* yp = ZX + (size_t)(base + t0 + tt) * SSD_INP + 2048 + h * 64 + p;
                            const float y = dir == 0 ? acc + dsk * xv : acc + bf1(*yp);
                            *yp = (bf16)f2bf(y); }
                    }
                }
            }
            __syncthreads();
            asm volatile("s_waitcnt vmcnt(0)" ::: "memory");
        }
    }
}

#ifndef MK_SINGLE
#define MK_SINGLE 0
#endif
struct GemmDesc { const bf16* A; const bf16* Bt; int M, N, K; bf16* O; int ldc; };

__global__ void __launch_bounds__(NTHR, 2) fwd_kernel(Args a) {
    extern __shared__ __attribute__((aligned(16))) unsigned char lds_raw[];
    LAS unsigned char* lds = (LAS unsigned char*)lds_raw;
    unsigned char* ws = a.ws;
    float* XL = a.out; float* XC = (float*)(ws + WS_XC); bf16* H = (bf16*)(ws + WS_H); bf16* Mb = (bf16*)(ws + WS_M);
    const float* MOD = (const float*)(ws + WS_MOD); const float* NW = a.in[I_NORMW];
    for (int s = a.lo; s < a.hi; ++s) {
        GemmDesc g0{}, g1{}; int ng = 0;
#ifndef NO_SIMPLE
        if (s == 0) {
            mod_compute(a, lds);
            rope_tables(a);
            convert_layer(a, 0, lds);
        } else if (s == 1) {
            rowwise(a.in[I_X], a.in[I_CTX], XL, XC, nullptr, nullptr, nullptr, H, MOD, 0, 1024, NW, T);
        } else {
            const int l = (s - 2) / 10, k = (s - 2) % 10, i = l >> 1; const bool even = (l & 1) == 0, last = (l == 3);
            const int MR = last ? TL : T;
            switch (k) {
            case 0:
                if (even) { g0 = GemmDesc{H, (const bf16*)(ws + W_IN), T, HYB_INP, D, (bf16*)(ws + WS_P), HYB_INP}; ng = 1; }
                else      { g0 = GemmDesc{H, (const bf16*)(ws + W_IN), T, SSD_INP, D, (bf16*)(ws + WS_ZX), SSD_INP}; ng = 1; }
                break;
            case 1: if (even) prep_even(a, i); else ssd_conv(a, i); break;
            case 2:
                if (even) { { g0 = GemmDesc{(const bf16*)(ws + WS_CQN), (const bf16*)(ws + W_UQ), T, QW, 384, (bf16*)(ws + WS_Q), QW}; ng = 1; }
                            g1 = GemmDesc{(const bf16*)(ws + WS_CKVN), (const bf16*)(ws + W_UKV), T, KVW, 256, (bf16*)(ws + WS_KV), KVW}; ng = 2; }
                else {
#ifndef NO_SSD
 ssd_scan_naive(a, i, last, lds);
#endif
 }
                break;
            case 3: if (even) {
#ifndef NO_ATTN
 attn_naive(a, lds);
#endif
 } else gatenorm(a, i, MR); break;
            case 4:
                if (even) { g0 = GemmDesc{(const bf16*)(ws + WS_MIX), (const bf16*)(ws + W_OUT), MR, D, D, Mb, D}; ng = 1; }
                else      { g0 = GemmDesc{(const bf16*)(ws + WS_XBC), (const bf16*)(ws + W_OUT), MR, D, 2048, Mb, D}; ng = 1; }
                break;
            case 5: rowwise(XL, XC, XL, XC, Mb, MOD + (size_t)l * 9 * MODW + 2048, NW + (l * 4 + 1) * D, H, MOD + (size_t)l * 9 * MODW, 3072, 4096, NW + (l * 4 + 2) * D, MR); break;
            case 6: { g0 = GemmDesc{H, (const bf16*)(ws + W_UP), MR, UPW, D, (bf16*)(ws + WS_U), UPW}; ng = 1; } break;
            case 7: convgate(a, l, MR); break;
            case 8: { g0 = GemmDesc{(const bf16*)(ws + WS_G), (const bf16*)(ws + W_DN), MR, D, DFF, Mb, D}; ng = 1; } break;
            case 9:
                if (!last) { rowwise(XL, XC, XL, XC, Mb, MOD + (size_t)l * 9 * MODW + 5120, NW + (l * 4 + 3) * D, H, MOD + (size_t)(l + 1) * 9 * MODW, 0, 1024, NW + ((l + 1) * 4 + 0) * D, T);
                             convert_layer(a, l + 1, lds); }
                else rowwise(XL, XC, XL, XC, Mb, MOD + (size_t)l * 9 * MODW + 5120, NW + (l * 4 + 3) * D, nullptr, MOD, 0, 0, NW, TL);
                break;
            }
        }
#else
        { g0 = GemmDesc{H, (const bf16*)(ws + W_IN), T, a.hi * 256, a.lo * 128, (bf16*)(ws + WS_P), HYB_INP}; ng = 1; }
#endif
        for (int gi = 0; gi < ng; ++gi) {
            const bool f = (gi == 0);
            pg8::Gemm g{f ? g0.A : g1.A, f ? g0.Bt : g1.Bt, f ? g0.M : g1.M, f ? g0.N : g1.N, f ? g0.K : g1.K}; pg8::StaticOrder S; S.init(g.M, g.N, (int)gridDim.x, (int)blockIdx.x);
            pg8::EpiStore E{f ? g0.O : g1.O, f ? g0.ldc : g1.ldc};
#ifndef NO_GEMM
            pg8::gemm_phase<pg8::EpiStore, pg8::StaticOrder, true, true>(lds, g, S, E);
#endif
            __syncthreads();
        }
        if (s + 1 < a.hi) {
#if MK_SINGLE
            cg::this_grid().sync();
#endif
        }
    }
}

extern "C" void kernel_launch(void* const* d_in, const int* in_sizes, int n_in, void* d_out, int out_size, void* d_ws, size_t ws_size, hipStream_t stream) {
    static int grid = 0;
    if (grid == 0) {
        if (n_in != 25 || out_size != TL * D || ws_size < WS_END) { fprintf(stderr, "kernel_launch: unexpected problem (n_in %d out %d ws %zu need %zu)\n", n_in, out_size, ws_size, (size_t)WS_END); grid = -1; return; }
        if (hipFuncSetAttribute((const void*)fwd_kernel, hipFuncAttributeMaxDynamicSharedMemorySize, LDS_BYTES) != hipSuccess) { fprintf(stderr, "kernel_launch: hipFuncSetAttribute failed\n"); grid = -1; return; }
        int dev = 0, cus = 0, per_cu = 0;
        hipGetDevice(&dev); hipDeviceGetAttribute(&cus, hipDeviceAttributeMultiprocessorCount, dev);
        hipOccupancyMaxActiveBlocksPerMultiprocessor(&per_cu, (const void*)fwd_kernel, NTHR, LDS_BYTES);
        (void)hipGetLastError();
        if (per_cu < 1) { fprintf(stderr, "kernel_launch: occupancy query says %d blocks per CU\n", per_cu); }
        grid = cus;
    }
    if (grid < 0) return;
    Args a{};
    for (int i = 0; i < 25; ++i) a.in[i] = (const float*)d_in[i];
    a.out = (float*)d_out; a.ws = (unsigned char*)d_ws;
#if MK_SINGLE
    a.lo = 0; a.hi = NSTEP + 1;
    void* args[] = {&a};
    hipError_t e = hipLaunchCooperativeKernel((const void*)fwd_kernel, dim3(grid), dim3(NTHR), args, LDS_BYTES, stream);
    if (e != hipSuccess) fprintf(stderr, "cooperative launch failed: %s (grid %d)\n", hipGetErrorString(e), grid);
#else
    for (int s = 0; s < NSTEP + 1; ++s) { a.lo = s; a.hi = s + 1; hipLaunchKernelGGL(fwd_kernel, dim3(grid), dim3(NTHR), LDS_BYTES, stream, a); }
#endif
}
```

```cpp
#include <hip/hip_runtime.h>
#include <hip/hip_cooperative_groups.h>
#include <cstdio>
#include <cstdint>
namespace cg = cooperative_groups;
__device__ __forceinline__ int otid() { int t = threadIdx.x; asm volatile("" : "+v"(t)); return t; }
namespace pg8 {
#define PG8_LAS __attribute__((address_space(3)))
typedef unsigned short bf16_t;
typedef short bf16x8 __attribute__((ext_vector_type(8)));
typedef float f32x4 __attribute__((ext_vector_type(4)));
typedef unsigned u32x4 __attribute__((ext_vector_type(4)));
constexpr int BM = 256, BK = 64, HALF = 128, HTB = HALF * BK * 2  , STAGE_BYTES = 8 * HTB, NXCD = 8, WGM = 8;

__host__ __device__ __forceinline__ int lds_byte(int r, int c) { const int st = (r >> 4) * 2 + (c >> 5), rr = r & 15, cc = c & 31, ob = rr * 64 + cc * 2; return st * 1024 + (ob ^ (((ob >> 9) & 1) << 5)); }
__host__ __device__ __forceinline__ void stage_rc(int b, int& R, int& C) { const int st = b / 1024, sb = b % 1024, swz = sb ^ (((sb >> 9) & 1) << 5); R = (st >> 1) * 16 + swz / 64; C = (st & 1) * 32 + (swz % 64) / 2; }
__host__ __device__ __forceinline__ int perm32(int rho) { const int n = rho >> 4, i = rho & 15; return 8 * (i >> 2) + 4 * n + (i & 3); }

struct Unit { int pm, pn; };
struct Gemm { const bf16_t* A; const bf16_t* Bt; int M, N, K; };

struct StaticOrder {
    int nM, nN, nwg, G, c;
    __host__ __device__ void init(int M, int N, int G_, int c_) { nM = M / BM; nN = N / BM; nwg = nM * nN; G = G_; c = c_; }
    __host__ __device__ bool next(int i, Unit& u) const {
        const long L = (long)i * G + c; if (L >= nwg) return false;
        int wgid = (int)L; { const int q = nwg / NXCD, r = nwg % NXCD, xcd = wgid % NXCD, off = wgid / NXCD; wgid = (xcd < r ? xcd * (q + 1) : r * (q + 1) + (xcd - r) * q) + off; }
        const int nig = WGM * nN, gid = wgid / nig, fm = gid * WGM, gsz = (nM - fm) < WGM ? (nM - fm) : WGM;
        u.pm = fm + ((wgid % nig) % gsz); u.pn = (wgid % nig) / gsz; return true;
    }
    __device__ __forceinline__ void a_ready(const Unit&) const {}
    __device__ __forceinline__ void done(const Unit&) const {}
};

__device__ __forceinline__ unsigned cvt_pk_bf16(float lo, float hi) { unsigned r; asm volatile("v_cvt_pk_bf16_f32 %0, %1, %2" : "=v"(r) : "v"(lo), "v"(hi)); return r; }
struct EpiStore {
    static constexpr bool PERM = true, AFTER_DRAIN = false;
    bf16_t* O; int ldc;
    __device__ __forceinline__ void operator()(const f32x4 (&acc)[2][2][4][2], const Unit& u, int wr, int wc, int fr, int fq) const {
        const int row0 = u.pm * BM + wr * 64 + fr; const int col0 = u.pn * BM + wc * 32 + 8 * fq;
#pragma unroll
        for (int ai = 0; ai < 2; ++ai)
#pragma unroll
            for (int m = 0; m < 4; ++m) { bf16_t* rowp = O + (size_t)(row0 + ai * HALF + m * 16) * ldc + col0;
#pragma unroll
                for (int bj = 0; bj < 2; ++bj) { const f32x4 v0 = acc[ai][bj][m][0], v1 = acc[ai][bj][m][1];
                    u32x4 w; w.x = cvt_pk_bf16(v0[0], v0[1]); w.y = cvt_pk_bf16(v0[2], v0[3]); w.z = cvt_pk_bf16(v1[0], v1[1]); w.w = cvt_pk_bf16(v1[2], v1[3]);
                    *(u32x4*)(rowp + bj * HALF) = w; } }
    }
};
template <class Epi, class Sched, bool ALIGN_EPI = false, bool SP2 = false>
__device__ __forceinline__ void gemm_phase(PG8_LAS unsigned char* lds, const Gemm g, const Sched& S, const Epi& E) {
    const int tid = otid(), wid = __builtin_amdgcn_readfirstlane(tid >> 6), lane = tid & 63, wr = wid >> 2, wc = wid & 3, fr = lane & 15, fq = lane >> 4;
    const int K = g.K, nt = K / BK;
    unsigned voffA[2], voffB[2];
#pragma unroll
    for (int i = 0; i < 2; ++i) { int R, C; stage_rc(tid * 16 + i * 8192, R, C); const int Rb = Epi::PERM ? ((R & ~31) + perm32(R & 31)) : R;
        voffA[i] = (unsigned)(R * K + C) * 2u; voffB[i] = (unsigned)(Rb * K + C) * 2u; }
    const size_t kstep = (size_t)(BK * 2);
    const size_t hstep = (size_t)HALF * K * 2;
    const size_t tstep = 2 * hstep;
    const unsigned ldsw = (unsigned)wid * 1024u;
    const int aoff = lds_byte(wr * 64 + fr, fq * 8), boff = lds_byte(wc * 32 + fr, fq * 8);
#define PG8_SA(b, h) (((b) * 2 + (h)) * HTB)
#define PG8_SB(b, h) ((4 + (b) * 2 + (h)) * HTB)
#define PG8_STAGE(bufoff, gbase, voff) do { _Pragma("unroll") for (int _i = 0; _i < 2; ++_i) \
        __builtin_amdgcn_global_load_lds((const unsigned*)((const char*)(gbase) + (voff)[_i]), (PG8_LAS unsigned*)(lds + (bufoff) + ldsw + _i * 8192), 16, 0, 0); } while (0)
#define PG8_LDA(dst, b, h) do { _Pragma("unroll") for (int m = 0; m < 4; ++m) _Pragma("unroll") for (int k = 0; k < 2; ++k) dst[m][k] = *(const PG8_LAS bf16x8*)(lds + PG8_SA(b, h) + aoff + m * 2048 + k * 1024); } while (0)
#define PG8_LDB(dst, b, h) do { _Pragma("unroll") for (int n = 0; n < 2; ++n) _Pragma("unroll") for (int k = 0; k < 2; ++k) dst[n][k] = *(const PG8_LAS bf16x8*)(lds + PG8_SB(b, h) + boff + n * 2048 + k * 1024); } while (0)
#define PG8_MMA(ai, bj, At, Bt) do { __builtin_amdgcn_s_setprio(1); _Pragma("unroll") for (int m = 0; m < 4; ++m) _Pragma("unroll") for (int n = 0; n < 2; ++n) _Pragma("unroll") for (int k = 0; k < 2; ++k) \
        acc[ai][bj][m][n] = __builtin_amdgcn_mfma_f32_16x16x32_bf16(Bt[n][k], At[m][k], acc[ai][bj][m][n], 0, 0, 0); __builtin_amdgcn_s_setprio(0); } while (0)
#define PG8_WAIT_V(n) asm volatile("s_waitcnt vmcnt(" #n ")" ::: "memory")
#define PG8_WAIT_L(n) asm volatile("s_waitcnt lgkmcnt(" #n ")" ::: "memory")
#define PG8_BAR __builtin_amdgcn_s_barrier()
#define PG8_SCHED __builtin_amdgcn_sched_barrier(0)
    Unit cur, nxt; int ui = 0;
    if (!S.next(0, cur)) return;
    f32x4 acc[2][2][4][2];
#pragma unroll
    for (int a = 0; a < 2; ++a)
#pragma unroll
        for (int b = 0; b < 2; ++b)
#pragma unroll
            for (int m = 0; m < 4; ++m)
#pragma unroll
                for (int n = 0; n < 2; ++n) acc[a][b][m][n] = (f32x4){0.f, 0.f, 0.f, 0.f};
    bf16x8 At[4][2], B0[2][2], B1[2][2];
    const char* cA = (const char*)g.A + (size_t)cur.pm * tstep; const char* cB = (const char*)g.Bt + (size_t)cur.pn * tstep;
    S.a_ready(cur);
    if constexpr (SP2) {
        PG8_STAGE(PG8_SB(0, 0), cB, voffB); PG8_STAGE(PG8_SB(0, 1), cB + hstep, voffB); PG8_STAGE(PG8_SA(0, 0), cA, voffA); PG8_STAGE(PG8_SA(0, 1), cA + hstep, voffA);
        if (wr == 1) PG8_BAR;
        PG8_WAIT_V(2); PG8_BAR;
        PG8_STAGE(PG8_SB(1, 0), cB + kstep, voffB); PG8_STAGE(PG8_SA(1, 0), cA + kstep, voffA); PG8_STAGE(PG8_SB(1, 1), cB + hstep + kstep, voffB);
        PG8_WAIT_V(6); PG8_BAR;
    } else {
        PG8_STAGE(PG8_SB(0, 0), cB, voffB); PG8_STAGE(PG8_SA(0, 0), cA, voffA); PG8_STAGE(PG8_SB(0, 1), cB + hstep, voffB); PG8_STAGE(PG8_SA(0, 1), cA + hstep, voffA);
        if (wr == 1) PG8_BAR;
        PG8_WAIT_V(4); PG8_BAR;
        PG8_STAGE(PG8_SB(1, 0), cB + kstep, voffB); PG8_STAGE(PG8_SA(1, 0), cA + kstep, voffA); PG8_STAGE(PG8_SB(1, 1), cB + hstep + kstep, voffB);
        PG8_WAIT_V(6); PG8_BAR;
    }
    for (;;) {
        const bool has_next = S.next(ui + 1, nxt);
        const char* nA = has_next ? (const char*)g.A + (size_t)nxt.pm * tstep : cA; const char* nB = has_next ? (const char*)g.Bt + (size_t)nxt.pn * tstep : cB;
        for (int t = 0; t < nt; t += 2) {
            const bool last = (t == nt - 2);
            const char* a1 = cA + (size_t)(t + 1) * kstep;
            const char* a2 = last ? nA : cA + (size_t)(t + 2) * kstep; const char* b2 = last ? nB : cB + (size_t)(t + 2) * kstep;
            const char* a3 = a2 + kstep; const char* b3 = b2 + kstep;
            if (last && has_next) S.a_ready(nxt);
            if constexpr (SP2) {
            PG8_LDB(B0, 0, 0); PG8_LDB(B1, 0, 1); PG8_SCHED; PG8_LDA(At, 0, 0); PG8_STAGE(PG8_SA(1, 1), a1 + hstep, voffA);
            PG8_WAIT_V(8); PG8_WAIT_L(0); PG8_BAR; PG8_MMA(0, 0, At, B0); PG8_MMA(0, 1, At, B1); PG8_BAR; PG8_SCHED;
            PG8_LDA(At, 0, 1); PG8_STAGE(PG8_SB(0, 0), b2, voffB); PG8_STAGE(PG8_SB(0, 1), b2 + hstep, voffB); PG8_STAGE(PG8_SA(0, 0), a2, voffA);
            PG8_WAIT_V(8); PG8_WAIT_L(0); PG8_BAR; PG8_MMA(1, 0, At, B0); PG8_MMA(1, 1, At, B1); PG8_BAR; PG8_SCHED;
            PG8_LDB(B0, 1, 0); PG8_LDB(B1, 1, 1); PG8_SCHED; PG8_LDA(At, 1, 0); PG8_STAGE(PG8_SA(0, 1), a2 + hstep, voffA);
            PG8_WAIT_V(8); PG8_WAIT_L(0); PG8_BAR; PG8_MMA(0, 0, At, B0); PG8_MMA(0, 1, At, B1); PG8_BAR; PG8_SCHED;
            PG8_LDA(At, 1, 1); PG8_STAGE(PG8_SB(1, 0), b3, voffB); PG8_STAGE(PG8_SB(1, 1), b3 + hstep, voffB); PG8_STAGE(PG8_SA(1, 0), a3, voffA);
            PG8_WAIT_V(8); PG8_WAIT_L(0); PG8_BAR; PG8_MMA(1, 0, At, B0); PG8_MMA(1, 1, At, B1); PG8_BAR; PG8_SCHED;
            } else {
            PG8_LDB(B0, 0, 0); PG8_SCHED; PG8_LDA(At, 0, 0); PG8_STAGE(PG8_SA(1, 1), a1 + hstep, voffA);
            PG8_WAIT_L(8); PG8_BAR; PG8_WAIT_L(0); PG8_MMA(0, 0, At, B0); PG8_BAR; PG8_SCHED;
            PG8_LDB(B1, 0, 1); PG8_STAGE(PG8_SB(0, 0), b2, voffB);
            PG8_BAR; PG8_WAIT_L(0); PG8_MMA(0, 1, At, B1); PG8_BAR;
            PG8_LDA(At, 0, 1); PG8_STAGE(PG8_SA(0, 0), a2, voffA);
            PG8_BAR; PG8_WAIT_L(0); PG8_MMA(1, 0, At, B0); PG8_BAR; PG8_SCHED;
            PG8_STAGE(PG8_SB(0, 1), b2 + hstep, voffB);
            PG8_WAIT_V(6); PG8_BAR; PG8_MMA(1, 1, At, B1); PG8_BAR;
            PG8_LDB(B0, 1, 0); PG8_SCHED; PG8_LDA(At, 1, 0); PG8_STAGE(PG8_SA(0, 1), a2 + hstep, voffA);
            PG8_WAIT_L(8); PG8_BAR; PG8_WAIT_L(0); PG8_MMA(0, 0, At, B0); PG8_BAR; PG8_SCHED;
            PG8_LDB(B1, 1, 1); PG8_STAGE(PG8_SB(1, 0), b3, voffB);
            PG8_BAR; PG8_WAIT_L(0); PG8_MMA(0, 1, At, B1); PG8_BAR;
            PG8_LDA(At, 1, 1); PG8_STAGE(PG8_SA(1, 0), a3, voffA);
            PG8_BAR; PG8_WAIT_L(0); PG8_MMA(1, 0, At, B0); PG8_BAR; PG8_SCHED;
            PG8_STAGE(PG8_SB(1, 1), b3 + hstep, voffB);
            PG8_WAIT_V(6); PG8_BAR; PG8_MMA(1, 1, At, B1); PG8_BAR;
            }
        }
        if constexpr (ALIGN_EPI) { if (wr == 0) PG8_BAR; }
        if constexpr (!Epi::AFTER_DRAIN) { E(acc, cur, wr, wc, fr, fq); S.done(cur); }
        if (!has_next) break;
#pragma unroll
        for (int a = 0; a < 2; ++a)
#pragma unroll
            for (int b = 0; b < 2; ++b)
#pragma unroll
                for (int m = 0; m < 4; ++m)
#pragma unroll
                    for (int n = 0; n < 2; ++n) acc[a][b][m][n] = (f32x4){0.f, 0.f, 0.f, 0.f};
        cur = nxt; cA = nA; cB = nB; ++ui;
        if constexpr (ALIGN_EPI) { if (wr == 1) PG8_BAR; }
    }
    PG8_WAIT_V(0);
    if constexpr (!ALIGN_EPI) { if (wr == 0) PG8_BAR; }
    PG8_BAR;
    if constexpr (Epi::AFTER_DRAIN) { E.fused(acc, cur, wr, wc, fr, fq, lds, wid, lane); S.done(cur); }
#undef PG8_SA
#undef PG8_SB
#undef PG8_STAGE
#undef PG8_LDA
#undef PG8_LDB
#undef PG8_MMA
#undef PG8_WAIT_V
#undef PG8_WAIT_L
#undef PG8_BAR
#undef PG8_SCHED
}
}

#define LAS __attribute__((address_space(3)))
typedef unsigned short bf16;
typedef unsigned v4u __attribute__((ext_vector_type(4)));
typedef unsigned v2u __attribute__((ext_vector_type(2)));
typedef float f32x4 __attribute__((ext_vector_type(4)));
constexpr int NWAVES = 8, NTHR = 512;
constexpr int D = 1024, NB = 8, SEQ = 2048, CTXL = 256, TL = NB * SEQ, TC = NB * CTXL, T = TL + TC;
constexpr int HYB_IN = 2208, HYB_INP = 2304, SSD_IN = 5184, SSD_INP = 5376, DFF = 2816, UPW = 5632;
constexpr int QW = 768, KVW = 1024, MODW = 6144;
constexpr float EPS = 1e-6f;
constexpr int NSTEP = 1 + 4 * 10;
constexpr float ATT_SCALE_LOG2E = 0.10206207261596577f * 1.4426950408889634f;

constexpr size_t MiB = 1u << 20;
constexpr size_t WS_CTL = 0, CTL_ZERO_BYTES = 64 * 1024;
constexpr size_t WS_MOD = 1 * MiB;
constexpr size_t WS_ROPE = 2 * MiB;
constexpr size_t W_UP = 3 * MiB;
constexpr size_t W_DN = W_UP + (size_t)UPW * D * 2;
constexpr size_t W_IN = W_DN + (size_t)D * DFF * 2;
constexpr size_t W_OUT = W_IN + (size_t)SSD_INP * D * 2;
constexpr size_t W_UQ = W_OUT + (size_t)D * 2048 * 2;
constexpr size_t W_UKV = W_UQ + (size_t)QW * 384 * 2;
constexpr size_t W_END = W_UKV + (size_t)KVW * 256 * 2;
constexpr size_t WS_XC = 36 * MiB;
constexpr size_t WS_H = 44 * MiB;
constexpr size_t WS_DT = WS_H, WS_AA = WS_H + (size_t)T * 64 * 4;
constexpr size_t WS_BIG = 80 * MiB;
constexpr size_t WS_M = WS_BIG;
constexpr size_t WS_P = WS_BIG;
constexpr size_t WS_Q = WS_BIG + 81 * MiB;
constexpr size_t WS_KV = WS_BIG + 108 * MiB;
constexpr size_t WS_KR = WS_BIG + 144 * MiB;
constexpr size_t WS_CQN = WS_BIG + 146 * MiB;
constexpr size_t WS_CKVN = WS_BIG + 160 * MiB;
constexpr size_t WS_MIX = WS_BIG + 170 * MiB;
constexpr size_t WS_U = WS_BIG;
constexpr size_t WS_G = WS_BIG + 198 * MiB;
constexpr size_t WS_ZX = WS_BIG;
constexpr size_t WS_XBC = WS_BIG + 189 * MiB;
constexpr size_t WS_END = WS_BIG + 297 * MiB;
static_assert(W_END <= WS_XC && WS_G + (size_t)T * DFF * 2 <= WS_END && WS_XBC + (size_t)T * 3072 * 2 <= WS_END && WS_ZX + (size_t)T * SSD_INP * 2 <= WS_XBC, "ws map");
static_assert(WS_AA + (size_t)T * 64 * 4 <= WS_BIG && WS_MIX + (size_t)T * D * 2 <= WS_END && WS_Q + (size_t)T * QW * 2 <= WS_KV && WS_P + (size_t)T * HYB_INP * 2 <= WS_Q, "ws map 2");
constexpr int LDS_BYTES = 147456;

struct Args { const float* in[25]; float* out; unsigned char* ws; int lo, hi; };
enum { I_X = 0, I_C, I_CTX, I_CCTX, I_MODW, I_MODB, I_NORMW, I_WUP, I_FCONV, I_WDN, I_HIN, I_QNORM, I_KVNORM, I_WUQ, I_WUKV, I_SCONV, I_HOUT, I_SIN, I_SCONVW, I_SCONVB, I_ALOG, I_DTB, I_SD, I_SNORM, I_SOUT };

__device__ __forceinline__ unsigned f2bf(float f) { unsigned u = __builtin_bit_cast(unsigned, f); return (u + 0x7fffu + ((u >> 16) & 1u)) >> 16; }
__device__ __forceinline__ unsigned pk2(float lo, float hi) { return f2bf(lo) | (f2bf(hi) << 16); }
__device__ __forceinline__ float bflo(unsigned u) { return __builtin_bit_cast(float, u << 16); }
__device__ __forceinline__ float bfhi(unsigned u) { return __builtin_bit_cast(float, u & 0xffff0000u); }
__device__ __forceinline__ float bf1(bf16 b) { return __builtin_bit_cast(float, (unsigned)b << 16); }
__device__ __forceinline__ float silu_f(float x) { return x / (1.f + __expf(-x)); }
__device__ __forceinline__ float wave_sum(float v) {
#pragma unroll
    for (int o = 1; o < 64; o <<= 1) v += __shfl_xor(v, o);
    return v;
}
__device__ __forceinline__ void unpack8(const v4u w, float (&f)[8]) { f[0] = bflo(w.x); f[1] = bfhi(w.x); f[2] = bflo(w.y); f[3] = bfhi(w.y); f[4] = bflo(w.z); f[5] = bfhi(w.z); f[6] = bflo(w.w); f[7] = bfhi(w.w); }
__device__ __forceinline__ v4u pack8(const float (&f)[8]) { v4u w; w.x = pk2(f[0], f[1]); w.y = pk2(f[2], f[3]); w.z = pk2(f[4], f[5]); w.w = pk2(f[6], f[7]); return w; }
__device__ __forceinline__ bool has_prev(int r) { return r < TL ? (r & (SEQ - 1)) != 0 : ((r - TL) & (CTXL - 1)) != 0; }
__device__ __forceinline__ bool has_next(int r) { return r < TL ? (r & (SEQ - 1)) != SEQ - 1 : ((r - TL) & (CTXL - 1)) != CTXL - 1; }

__device__ __forceinline__ void mod_compute(const Args& a, LAS unsigned char* lds) {
    LAS float* sc = (LAS float*)lds;
    LAS float* red = (LAS float*)(lds + 36864);
    const int tid = otid();
    float* MOD = (float*)(a.ws + WS_MOD);
    for (int i = tid; i < 9 * 1024; i += NTHR) { const int c = i >> 10, k = i & 1023; const float v = c < 8 ? a.in[I_C][c * 1024 + k] : a.in[I_CCTX][k]; sc[i] = silu_f(v); }
    __syncthreads();
    for (int item = blockIdx.x; item < 4 * 96; item += gridDim.x) {
        const int l = item / 96, cb = item % 96;
        const float* W = a.in[I_MODW] + (size_t)l * 1024 * MODW + cb * 64;
        const int cgp = tid & 15, kg = tid >> 4;
        float acc[9][4];
#pragma unroll
        for (int c = 0; c < 9; ++c) { acc[c][0] = 0.f; acc[c][1] = 0.f; acc[c][2] = 0.f; acc[c][3] = 0.f; }
#pragma unroll 4
        for (int kk = 0; kk < 32; ++kk) { const int k = kg * 32 + kk; const f32x4 w = *(const f32x4*)(W + (size_t)k * MODW + cgp * 4);
#pragma unroll
            for (int c = 0; c < 9; ++c) { const float s = sc[c * 1024 + k]; acc[c][0] += s * w[0]; acc[c][1] += s * w[1]; acc[c][2] += s * w[2]; acc[c][3] += s * w[3]; } }
#pragma unroll
        for (int c = 0; c < 9; ++c)
#pragma unroll
            for (int j = 0; j < 4; ++j) red[kg * 576 + c * 64 + cgp * 4 + j] = acc[c][j];
        __syncthreads();
        for (int o = tid; o < 576; o += NTHR) { float s = 0.f;
            for (int g = 0; g < 32; ++g) s += red[g * 576 + o];
            const int c = o >> 6, col = o & 63; MOD[(size_t)(l * 9 + c) * MODW + cb * 64 + col] = s + a.in[I_MODB][l * MODW + cb * 64 + col]; }
        __syncthreads();
    }
}
__device__ __forceinline__ void rope_tables(const Args& a) {
    float* ct = (float*)(a.ws + WS_ROPE); float* st = ct + SEQ * 16;
    for (int i = blockIdx.x * NTHR + otid(); i < SEQ * 16; i += gridDim.x * NTHR) {
        const int t = i >> 4, j = i & 15; const int pos = j < 8 ? (t >> 6) : (t & 63); const int f = j & 7;
        const float inv = powf(10000.0f, -(float)f / 8.0f); const float ang = (float)pos * inv;
        ct[i] = cosf(ang); st[i] = sinf(ang); }
}
__device__ __forceinline__ void transpose_item(const float* W, int K, int N, bf16* WT, LAS float* scr, int item, int lane) {
    const int nblk = N / 32, kb = item / nblk, nb = item % nblk, k0 = 64 * kb, n0 = 32 * nb;
#pragma unroll 8
    for (int i = 0; i < 32; ++i) { const int kk = 2 * i + (lane >> 5); scr[kk * 33 + (lane & 31)] = W[(size_t)(k0 + kk) * N + n0 + (lane & 31)]; }
    asm volatile("s_waitcnt lgkmcnt(0)" ::: "memory");
    const int c = lane & 7;
#pragma unroll
    for (int j = 0; j < 4; ++j) { const int n = (lane >> 3) + 8 * j; const LAS float* s = scr + (8 * c) * 33 + n;
        v4u o; o.x = pk2(s[0 * 33], s[1 * 33]); o.y = pk2(s[2 * 33], s[3 * 33]); o.z = pk2(s[4 * 33], s[5 * 33]); o.w = pk2(s[6 * 33], s[7 * 33]);
        *(v4u*)(WT + (size_t)(n0 + n) * K + k0 + 8 * c) = o; }
    asm volatile("s_waitcnt lgkmcnt(0)" ::: "memory");
}
__device__ __forceinline__ void convert_weight(const float* W, int K, int N, int Npad, bf16* WT, LAS unsigned char* lds, int rot) {
    const int wave = otid() >> 6, lane = otid() & 63; const int NGW = gridDim.x * NWAVES; const int gw = (blockIdx.x * NWAVES + wave + rot) % NGW;
    LAS float* scr = (LAS float*)(lds + wave * 16384);
    const int nitems = (K / 64) * (N / 32);
    for (int it = gw; it < nitems; it += NGW) transpose_item(W, K, N, WT, scr, it, lane);
    const size_t npadv = (size_t)(Npad - N) * K / 8;
    for (size_t i = (size_t)gw * 64 + lane; i < npadv; i += (size_t)NGW * 64) *(v4u*)(WT + (size_t)N * K + i * 8) = (v4u){0u, 0u, 0u, 0u};
}
__device__ __forceinline__ void convert_layer(const Args& a, int l, LAS unsigned char* lds) {
    const int i = l >> 1; unsigned char* ws = a.ws;
    convert_weight(a.in[I_WUP] + (size_t)l * D * UPW, D, UPW, UPW, (bf16*)(ws + W_UP), lds, 0);
    convert_weight(a.in[I_WDN] + (size_t)l * DFF * D, DFF, D, D, (bf16*)(ws + W_DN), lds, 300);
    if ((l & 1) == 0) {
        convert_weight(a.in[I_HIN] + (size_t)i * D * HYB_IN, D, HYB_IN, HYB_INP, (bf16*)(ws + W_IN), lds, 700);
        convert_weight(a.in[I_HOUT] + (size_t)i * D * D, D, D, D, (bf16*)(ws + W_OUT), lds, 1100);
        convert_weight(a.in[I_WUQ] + (size_t)i * 384 * QW, 384, QW, QW, (bf16*)(ws + W_UQ), lds, 1500);
        convert_weight(a.in[I_WUKV] + (size_t)i * 256 * KVW, 256, KVW, KVW, (bf16*)(ws + W_UKV), lds, 1700);
    } else {
        convert_weight(a.in[I_SIN] + (size_t)i * D * SSD_IN, D, SSD_IN, SSD_INP, (bf16*)(ws + W_IN), lds, 700);
        convert_weight(a.in[I_SOUT] + (size_t)i * 2048 * D, 2048, D, D, (bf16*)(ws + W_OUT), lds, 1300);
    }
}

__device__ __forceinline__ void rowwise(const float* xs_lat, const float* xs_ctx, float* xd_lat, float* xd_ctx, const bf16* Mb, const float* modg  , const float* nwA,
                                        bf16* H, const float* modh  , int sh_off, int sc_off, const float* nwB, int nrows) {
    const int wave = otid() >> 6, lane = otid() & 63; const int NGW = gridDim.x * NWAVES, gw = blockIdx.x * NWAVES + wave;
    for (int r = gw; r < nrows; r += NGW) {
        const bool lat = r < TL; const int cond = lat ? (r >> 11) : 8;
        const float* xs = lat ? xs_lat + (size_t)r * D : xs_ctx + (size_t)(r - TL) * D;
        float* xd = lat ? xd_lat + (size_t)r * D : xd_ctx + (size_t)(r - TL) * D;
        f32x4 v[4];
#pragma unroll
        for (int j = 0; j < 4; ++j) v[j] = *(const f32x4*)(xs + j * 256 + lane * 4);
        if (Mb) {
            f32x4 m[4]; float ss = 0.f;
#pragma unroll
            for (int j = 0; j < 4; ++j) { const v2u w = *(const v2u*)(Mb + (size_t)r * D + j * 256 + lane * 4); m[j] = (f32x4){bflo(w.x), bfhi(w.x), bflo(w.y), bfhi(w.y)};
                ss += (m[j][0] * m[j][0] + m[j][1] * m[j][1]) + (m[j][2] * m[j][2] + m[j][3] * m[j][3]); }
            const float rs = rsqrtf(wave_sum(ss) * (1.f / D) + EPS);
#pragma unroll
            for (int j = 0; j < 4; ++j) { const f32x4 g = *(const f32x4*)(modg + (size_t)cond * MODW + j * 256 + lane * 4); const f32x4 w = *(const f32x4*)(nwA + j * 256 + lane * 4);
                v[j] = v[j] + g * (m[j] * rs * w); }
        }
#pragma unroll
        for (int j = 0; j < 4; ++j) *(f32x4*)(xd + j * 256 + lane * 4) = v[j];
        if (H) {
            float ss = 0.f;
#pragma unroll
            for (int j = 0; j < 4; ++j) ss += (v[j][0] * v[j][0] + v[j][1] * v[j][1]) + (v[j][2] * v[j][2] + v[j][3] * v[j][3]);
            const float rs = rsqrtf(wave_sum(ss) * (1.f / D) + EPS);
#pragma unroll
            for (int j = 0; j < 4; ++j) { const int c = j * 256 + lane * 4;
                const f32x4 w = *(const f32x4*)(nwB + c); const f32x4 sc = *(const f32x4*)(modh + (size_t)cond * MODW + sc_off + c); const f32x4 sh = *(const f32x4*)(modh + (size_t)cond * MODW + sh_off + c);
                const f32x4 h = (v[j] * rs * w) * (sc + 1.0f) + sh;
                v2u o; o.x = pk2(h[0], h[1]); o.y = pk2(h[2], h[3]); *(v2u*)(H + (size_t)r * D + c) = o; }
        }
    }
}

__device__ __forceinline__ void prep_even(const Args& a, int i) {
    const int wave = otid() >> 6, lane = otid() & 63; const int NGW = gridDim.x * NWAVES, gw = blockIdx.x * NWAVES + wave;
    const bf16* P = (const bf16*)(a.ws + WS_P); bf16* CQN = (bf16*)(a.ws + WS_CQN); bf16* CKVN = (bf16*)(a.ws + WS_CKVN); bf16* KR = (bf16*)(a.ws + WS_KR); bf16* MIX = (bf16*)(a.ws + WS_MIX);
    const float* qn = a.in[I_QNORM] + i * 384; const float* kvn = a.in[I_KVNORM] + i * 256; const float* cw = a.in[I_SCONV] + i * 3 * 512;
    const float* ct = (const float*)(a.ws + WS_ROPE); const float* st = ct + SEQ * 16;
    for (int r = gw; r < T; r += NGW) {
        const bf16* p = P + (size_t)r * HYB_INP;
        {
            const unsigned* p32 = (const unsigned*)(p + lane * 6); const unsigned w0 = p32[0], w1 = p32[1], w2 = p32[2];
            float f[6] = {bflo(w0), bfhi(w0), bflo(w1), bfhi(w1), bflo(w2), bfhi(w2)}; float ss = 0.f;
#pragma unroll
            for (int j = 0; j < 6; ++j) ss += f[j] * f[j];
            const float rs = rsqrtf(wave_sum(ss) * (1.f / 384.f) + EPS);
#pragma unroll
            for (int j = 0; j < 6; ++j) f[j] = f[j] * rs * qn[lane * 6 + j];
            unsigned* o32 = (unsigned*)(CQN + (size_t)r * 384 + lane * 6); o32[0] = pk2(f[0], f[1]); o32[1] = pk2(f[2], f[3]); o32[2] = pk2(f[4], f[5]);
        }
        {
            const v2u w = *(const v2u*)(p + 384 + lane * 4); float f[4] = {bflo(w.x), bfhi(w.x), bflo(w.y), bfhi(w.y)};
            const float ss = (f[0] * f[0] + f[1] * f[1]) + (f[2] * f[2] + f[3] * f[3]);
            const float rs = rsqrtf(wave_sum(ss) * (1.f / 256.f) + EPS);
            const f32x4 g = *(const f32x4*)(kvn + lane * 4);
            v2u o; o.x = pk2(f[0] * rs * g[0], f[1] * rs * g[1]); o.y = pk2(f[2] * rs * g[2], f[3] * rs * g[3]); *(v2u*)(CKVN + (size_t)r * 256 + lane * 4) = o;
        }
        {
            const int j = lane & 31; const float v = bf1(p[640 + j]); const float o = __shfl_xor(v, 16); float res = v;
            if (r < TL) { const int t = r & (SEQ - 1); const float c = ct[t * 16 + (j & 15)], s = st[t * 16 + (j & 15)]; res = (j < 16) ? v * c - o * s : o * s + v * c; }
            if (lane < 32) KR[(size_t)r * 32 + j] = (bf16)f2bf(res);
        }
        {
            const int c0 = lane * 8; float gb[8], cur[8], acc[8], t0[8], t1[8];
            unpack8(*(const v4u*)(p + 672 + c0), gb);
            unpack8(*(const v4u*)(p + 1184 + c0), t0); unpack8(*(const v4u*)(p + 1696 + c0), t1);
#pragma unroll
            for (int j = 0; j < 8; ++j) { cur[j] = t0[j] * t1[j]; acc[j] = cw[512 + c0 + j] * cur[j]; }
            if (has_prev(r)) { unpack8(*(const v4u*)(p - HYB_INP + 1184 + c0), t0); unpack8(*(const v4u*)(p - HYB_INP + 1696 + c0), t1);
#pragma unroll
                for (int j = 0; j < 8; ++j) acc[j] += cw[c0 + j] * (t0[j] * t1[j]); }
            if (has_next(r)) { unpack8(*(const v4u*)(p + HYB_INP + 1184 + c0), t0); unpack8(*(const v4u*)(p + HYB_INP + 1696 + c0), t1);
#pragma unroll
                for (int j = 0; j < 8; ++j) acc[j] += cw[1024 + c0 + j] * (t0[j] * t1[j]); }
#pragma unroll
            for (int j = 0; j < 8; ++j) acc[j] *= gb[j];
            *(v4u*)(MIX + (size_t)r * D + 512 + c0) = pack8(acc);
        }
    }
}

__device__ __forceinline__ void convgate(const Args& a, int l, int nrows) {
    const bf16* U = (const bf16*)(a.ws + WS_U); bf16* G = (bf16*)(a.ws + WS_G); const float* cw = a.in[I_FCONV] + (size_t)l * 3 * UPW;
    const int total = nrows * (DFF / 8);
    for (int idx = blockIdx.x * NTHR + otid(); idx < total; idx += gridDim.x * NTHR) {
        const int r = idx / (DFF / 8), c0 = (idx % (DFF / 8)) * 8; const bf16* u = U + (size_t)r * UPW + c0;
        float ua[8], ug[8], act[8], gate[8];
        unpack8(*(const v4u*)u, ua); unpack8(*(const v4u*)(u + DFF), ug);
#pragma unroll
        for (int j = 0; j < 8; ++j) { act[j] = cw[UPW + c0 + j] * ua[j]; gate[j] = cw[UPW + DFF + c0 + j] * ug[j]; }
        if (has_prev(r)) { unpack8(*(const v4u*)(u - UPW), ua); unpack8(*(const v4u*)(u - UPW + DFF), ug);
#pragma unroll
            for (int j = 0; j < 8; ++j) { act[j] += cw[c0 + j] * ua[j]; gate[j] += cw[DFF + c0 + j] * ug[j]; } }
        if (has_next(r)) { unpack8(*(const v4u*)(u + UPW), ua); unpack8(*(const v4u*)(u + UPW + DFF), ug);
#pragma unroll
            for (int j = 0; j < 8; ++j) { act[j] += cw[2 * UPW + c0 + j] * ua[j]; gate[j] += cw[2 * UPW + DFF + c0 + j] * ug[j]; } }
#pragma unroll
        for (int j = 0; j < 8; ++j) act[j] = silu_f(act[j]) * gate[j];
        *(v4u*)(G + (size_t)r * DFF + c0) = pack8(act);
    }
}

__device__ __forceinline__ void ssd_conv(const Args& a, int i) {
    const bf16* ZX = (const bf16*)(a.ws + WS_ZX); bf16* XBC = (bf16*)(a.ws + WS_XBC); float* DT = (float*)(a.ws + WS_DT); float* AA = (float*)(a.ws + WS_AA);
    const float* cw = a.in[I_SCONVW] + (size_t)i * 3 * 3072; const float* cb = a.in[I_SCONVB] + (size_t)i * 3072;
    const int total = T * 384;
    for (int idx = blockIdx.x * NTHR + otid(); idx < total; idx += gridDim.x * NTHR) {
        const int r = idx / 384, c0 = (idx % 384) * 8; const bf16* u = ZX + (size_t)r * SSD_INP + 2048 + c0;
        float x[8], acc[8];
        unpack8(*(const v4u*)u, x);
#pragma unroll
        for (int j = 0; j < 8; ++j) acc[j] = cb[c0 + j] + cw[3072 + c0 + j] * x[j];
        if (has_prev(r)) { unpack8(*(const v4u*)(u - SSD_INP), x);
#pragma unroll
            for (int j = 0; j < 8; ++j) acc[j] += cw[c0 + j] * x[j]; }
        if (has_next(r)) { unpack8(*(const v4u*)(u + SSD_INP), x);
#pragma unroll
            for (int j = 0; j < 8; ++j) acc[j] += cw[2 * 3072 + c0 + j] * x[j]; }
#pragma unroll
        for (int j = 0; j < 8; ++j) acc[j] = silu_f(acc[j]);
        *(v4u*)(XBC + (size_t)r * 3072 + c0) = pack8(acc);
    }
    const float* alog = a.in[I_ALOG] + i * 64; const float* dtb = a.in[I_DTB] + i * 64;
    for (int idx = blockIdx.x * NTHR + otid(); idx < T * 64; idx += gridDim.x * NTHR) {
        const int r = idx >> 6, j = idx & 63; const float raw = bf1(ZX[(size_t)r * SSD_INP + 5120 + j]) + dtb[j];
        const float dt = raw > 20.f ? raw : log1pf(__expf(raw));
        DT[idx] = dt; AA[idx] = -__expf(alog[j]) * dt;
    }
}

__device__ __forceinline__ void gatenorm(const Args& a, int i, int nrows) {
    const int wave = otid() >> 6, lane = otid() & 63; const int NGW = gridDim.x * NWAVES, gw = blockIdx.x * NWAVES + wave;
    const bf16* ZX = (const bf16*)(a.ws + WS_ZX); bf16* YN = (bf16*)(a.ws + WS_XBC); const float* nw = a.in[I_SNORM] + i * 2048;
    for (int r = gw; r < nrows; r += NGW) {
        float v[4][8]; float ss = 0.f;
#pragma unroll
        for (int j = 0; j < 4; ++j) { float y[8], z[8]; const int c = j * 512 + lane * 8;
            unpack8(*(const v4u*)(ZX + (size_t)r * SSD_INP + 2048 + c), y); unpack8(*(const v4u*)(ZX + (size_t)r * SSD_INP + c), z);
#pragma unroll
            for (int k = 0; k < 8; ++k) { v[j][k] = y[k] * silu_f(z[k]); ss += v[j][k] * v[j][k]; } }
        const float rs = rsqrtf(wave_sum(ss) * (1.f / 2048.f) + EPS);
#pragma unroll
        for (int j = 0; j < 4; ++j) { const int c = j * 512 + lane * 8; float o[8];
#pragma unroll
            for (int k = 0; k < 8; ++k) o[k] = v[j][k] * rs * nw[c + k];
            *(v4u*)(YN + (size_t)r * 2048 + c) = pack8(o); }
    }
}

__device__ __forceinline__ void attn_naive(const Args& a, LAS unsigned char* lds) {
    const int tid = otid(), qi = tid >> 1, half = tid & 1;
    const bf16* Qb = (const bf16*)(a.ws + WS_Q); const bf16* KVb = (const bf16*)(a.ws + WS_KV); const bf16* KR = (const bf16*)(a.ws + WS_KR); bf16* MIX = (bf16*)(a.ws + WS_MIX);
    const float* ct = (const float*)(a.ws + WS_ROPE); const float* st = ct + SEQ * 16;
    LAS float* Kt = (LAS float*)lds;
    LAS float* Vt = (LAS float*)(lds + 64 * 96 * 4);
    for (int u = blockIdx.x; u < 576; u += gridDim.x) {
        const bool lat = u < 512; const int b = lat ? (u >> 6) : ((u - 512) >> 3), h = lat ? ((u >> 3) & 7) : ((u - 512) & 7);
        const int nkeys = lat ? (CTXL + SEQ) : CTXL;
        const int qrow = lat ? b * SEQ + (u & 7) * 256 + qi : TL + b * CTXL + qi;
        float q[48];
#pragma unroll
        for (int g = 0; g < 6; ++g) { float f[8]; unpack8(*(const v4u*)(Qb + (size_t)qrow * QW + h * 96 + half * 48 + g * 8), f);
#pragma unroll
            for (int j = 0; j < 8; ++j) q[g * 8 + j] = f[j]; }
        if (lat && half == 1) { const int t = qrow & (SEQ - 1);
#pragma unroll
            for (int j = 0; j < 16; ++j) { const float c = ct[t * 16 + j], s = st[t * 16 + j]; const float x1 = q[16 + j], x2 = q[32 + j]; q[16 + j] = x1 * c - x2 * s; q[32 + j] = x1 * s + x2 * c; } }
#pragma unroll
        for (int j = 0; j < 48; ++j) q[j] *= ATT_SCALE_LOG2E;
        float o[32]; float m = -1e30f, l = 0.f;
#pragma unroll
        for (int j = 0; j < 32; ++j) o[j] = 0.f;
        for (int k0 = 0; k0 < nkeys; k0 += 64) {
            __syncthreads();
            for (int g = tid; g < 768; g += NTHR) { const int key = g / 12, part = g % 12; const int kk = k0 + key; const int krow = kk < CTXL ? TL + b * CTXL + kk : b * SEQ + kk - CTXL;
                float f[8]; unpack8(part < 8 ? *(const v4u*)(KVb + (size_t)krow * KVW + h * 128 + part * 8) : *(const v4u*)(KR + (size_t)krow * 32 + (part - 8) * 8), f);
#pragma unroll
                for (int j = 0; j < 8; ++j) Kt[key * 96 + part * 8 + j] = f[j]; }
            { const int key = tid >> 3, part = tid & 7; const int kk = k0 + key; const int krow = kk < CTXL ? TL + b * CTXL + kk : b * SEQ + kk - CTXL;
                float f[8]; unpack8(*(const v4u*)(KVb + (size_t)krow * KVW + h * 128 + 64 + part * 8), f);
#pragma unroll
                for (int j = 0; j < 8; ++j) Vt[key * 64 + part * 8 + j] = f[j]; }
            __syncthreads();
            for (int kg = 0; kg < 64; kg += 8) {
                float s[8]; float gm = -1e30f;
#pragma unroll
                for (int kk = 0; kk < 8; ++kk) { float acc = 0.f; const LAS f32x4* kp = (const LAS f32x4*)(Kt + (kg + kk) * 96 + half * 48);
#pragma unroll
                    for (int d4 = 0; d4 < 12; ++d4) { const f32x4 kv = kp[d4]; acc += q[d4 * 4] * kv[0] + q[d4 * 4 + 1] * kv[1] + q[d4 * 4 + 2] * kv[2] + q[d4 * 4 + 3] * kv[3]; }
                    acc += __shfl_xor(acc, 1);
                    s[kk] = acc; gm = fmaxf(gm, acc); }
                const float mn = fmaxf(m, gm); const float alpha = exp2f(m - mn); m = mn; l *= alpha;
#pragma unroll
                for (int j = 0; j < 32; ++j) o[j] *= alpha;
#pragma unroll
                for (int kk = 0; kk < 8; ++kk) { const float p = exp2f(s[kk] - mn); l += p; const LAS f32x4* vp = (const LAS f32x4*)(Vt + (kg + kk) * 64 + half * 32);
#pragma unroll
                    for (int d4 = 0; d4 < 8; ++d4) { const f32x4 vv = vp[d4]; o[d4 * 4] += p * vv[0]; o[d4 * 4 + 1] += p * vv[1]; o[d4 * 4 + 2] += p * vv[2]; o[d4 * 4 + 3] += p * vv[3]; } }
            }
        }
        { const float inv = 1.f / l;
#pragma unroll
            for (int g = 0; g < 4; ++g) { float f[8];
#pragma unroll
                for (int j = 0; j < 8; ++j) f[j] = o[g * 8 + j] * inv;
                *(v4u*)(MIX + (size_t)qrow * D + h * 64 + half * 32 + g * 8) = pack8(f); } }
    }
}

__device__ __forceinline__ void ssd_scan_naive(const Args& a, int i, bool last, LAS unsigned char* lds) {
    const int tid = otid(), p = tid >> 3, nq = tid & 7;
    bf16* ZX = (bf16*)(a.ws + WS_ZX); const bf16* XBC = (const bf16*)(a.ws + WS_XBC); const float* DT = (const float*)(a.ws + WS_DT); const float* AA = (const float*)(a.ws + WS_AA);
    LAS float* xs = (LAS float*)lds;
    LAS float* Bs = (LAS float*)(lds + 16384);
    LAS float* Cs = (LAS float*)(lds + 16384 + 32768);
    LAS float* dts = (LAS float*)(lds + 16384 + 65536);
    LAS float* as = dts + 64;
    for (int it = blockIdx.x; it < NB * 32; it += gridDim.x) {
        const int b = it >> 5, h = it & 31, g = h >> 3; const float dsk = a.in[I_SD][i * 32 + h];
        for (int dir = 0; dir < 2; ++dir) {
            float stt[16];
#pragma unroll
            for (int n = 0; n < 16; ++n) stt[n] = 0.f;
            for (int seg = 0; seg < 2; ++seg) {
                const int len = seg == 0 ? CTXL : SEQ; const int base = seg == 0 ? TL + b * CTXL : b * SEQ; const bool want_y = !(last && seg == 0);
                for (int cc = 0; cc < len / 64; ++cc) {
                    const int t0 = dir == 0 ? cc * 64 : len - 64 - cc * 64;
                    __syncthreads();
                    { const int tt = tid >> 3, part = tid & 7; float f[8]; unpack8(*(const v4u*)(XBC + (size_t)(base + t0 + tt) * 3072 + h * 64 + part * 8), f);
#pragma unroll
                        for (int j = 0; j < 8; ++j) xs[tt * 64 + part * 8 + j] = f[j]; }
                    for (int q = tid; q < 1024; q += NTHR) { const int tt = q >> 4, part = q & 15; float f[8];
                        unpack8(*(const v4u*)(XBC + (size_t)(base + t0 + tt) * 3072 + 2048 + g * 128 + part * 8), f);
#pragma unroll
                        for (int j = 0; j < 8; ++j) Bs[tt * 128 + part * 8 + j] = f[j];
                        unpack8(*(const v4u*)(XBC + (size_t)(base + t0 + tt) * 3072 + 2560 + g * 128 + part * 8), f);
#pragma unroll
                        for (int j = 0; j < 8; ++j) Cs[tt * 128 + part * 8 + j] = f[j]; }
                    if (tid < 64) { dts[tid] = DT[(size_t)(base + t0 + tid) * 64 + dir * 32 + h]; as[tid] = AA[(size_t)(base + t0 + tid) * 64 + dir * 32 + h]; }
                    __syncthreads();
                    for (int s = 0; s < 64; ++s) {
                        const int tt = dir == 0 ? s : 63 - s;
                        const float dec = __expf(as[tt]); const float xv = xs[tt * 64 + p]; const float xd = xv * dts[tt];
                        const LAS f32x4* bp = (const LAS f32x4*)(Bs + tt * 128 + nq * 16); const LAS f32x4* cp = (const LAS f32x4*)(Cs + tt * 128 + nq * 16);
                        float acc = 0.f;
#pragma unroll
                        for (int n4 = 0; n4 < 4; ++n4) { const f32x4 bv = bp[n4], cv = cp[n4];
#pragma unroll
                            for (int k = 0; k < 4; ++k) { stt[n4 * 4 + k] = dec * stt[n4 * 4 + k] + xd * bv[k]; acc += cv[k] * stt[n4 * 4 + k]; } }
                        acc += __shfl_xor(acc, 1); acc += __shfl_xor(acc, 2); acc += __shfl_xor(acc, 4);
                        if (want_y && nq == 0) { bf16* yp = ZX + (size_t)(base + t0 + tt) * SSD_INP + 2048 + h * 64 + p;
                            const float y = dir == 0 ? acc + dsk * xv : acc + bf1(*yp);
                            *yp = (bf16)f2bf(y); }
                    }
                }
            }
            __syncthreads();
            asm volatile("s_waitcnt vmcnt(0)" ::: "memory");
        }
    }
}

#ifndef MK_SINGLE
#define MK_SINGLE 1
#endif
struct GemmDesc { const bf16* A; const bf16* Bt; int M, N, K; bf16* O; int ldc; };

__global__ void __launch_bounds__(NTHR, 2) fwd_kernel(Args a) {
    extern __shared__ __attribute__((aligned(16))) unsigned char lds_raw[];
    LAS unsigned char* lds = (LAS unsigned char*)lds_raw;
    unsigned char* ws = a.ws;
    float* XL = a.out; float* XC = (float*)(ws + WS_XC); bf16* H = (bf16*)(ws + WS_H); bf16* Mb = (bf16*)(ws + WS_M);
    const float* MOD = (const float*)(ws + WS_MOD); const float* NW = a.in[I_NORMW];
    for (int s = a.lo; s < a.hi; ++s) {
        GemmDesc g0{}, g1{}; int ng = 0;
#ifndef NO_SIMPLE
        if (s == 0) {
            mod_compute(a, lds);
            rope_tables(a);
            convert_layer(a, 0, lds);
        } else if (s == 1) {
            rowwise(a.in[I_X], a.in[I_CTX], XL, XC, nullptr, nullptr, nullptr, H, MOD, 0, 1024, NW, T);
        } else {
            const int l = (s - 2) / 10, k = (s - 2) % 10, i = l >> 1; const bool even = (l & 1) == 0, last = (l == 3);
            const int MR = last ? TL : T;
            switch (k) {
            case 0:
                if (even) { g0 = GemmDesc{H, (const bf16*)(ws + W_IN), T, HYB_INP, D, (bf16*)(ws + WS_P), HYB_INP}; ng = 1; }
                else      { g0 = GemmDesc{H, (const bf16*)(ws + W_IN), T, SSD_INP, D, (bf16*)(ws + WS_ZX), SSD_INP}; ng = 1; }
                break;
            case 1: if (even) prep_even(a, i); else ssd_conv(a, i); break;
            case 2:
                if (even) { { g0 = GemmDesc{(const bf16*)(ws + WS_CQN), (const bf16*)(ws + W_UQ), T, QW, 384, (bf16*)(ws + WS_Q), QW}; ng = 1; }
                            g1 = GemmDesc{(const bf16*)(ws + WS_CKVN), (const bf16*)(ws + W_UKV), T, KVW, 256, (bf16*)(ws + WS_KV), KVW}; ng = 2; }
                else {
#ifndef NO_SSD
 ssd_scan_naive(a, i, last, lds);
#endif
 }
                break;
            case 3: if (even) {
#ifndef NO_ATTN
 attn_naive(a, lds);
#endif
 } else gatenorm(a, i, MR); break;
            case 4:
                if (even) { g0 = GemmDesc{(const bf16*)(ws + WS_MIX), (const bf16*)(ws + W_OUT), MR, D, D, Mb, D}; ng = 1; }
                else      { g0 = GemmDesc{(const bf16*)(ws + WS_XBC), (const bf16*)(ws + W_OUT), MR, D, 2048, Mb, D}; ng = 1; }
                break;
            case 5: rowwise(XL, XC, XL, XC, Mb, MOD + (size_t)l * 9 * MODW + 2048, NW + (l * 4 + 1) * D, H, MOD + (size_t)l * 9 * MODW, 3072, 4096, NW + (l * 4 + 2) * D, MR); break;
            case 6: { g0 = GemmDesc{H, (const bf16*)(ws + W_UP), MR, UPW, D, (bf16*)(ws + WS_U), UPW}; ng = 1; } break;
            case 7: convgate(a, l, MR); break;
            case 8: { g0 = GemmDesc{(const bf16*)(ws + WS_G), (const bf16*)(ws + W_DN), MR, D, DFF, Mb, D}; ng = 1; } break;
            case 9:
                if (!last) { rowwise(XL, XC, XL, XC, Mb, MOD + (size_t)l * 9 * MODW + 5120, NW + (l * 4 + 3) * D, H, MOD + (size_t)(l + 1) * 9 * MODW, 0, 1024, NW + ((l + 1) * 4 + 0) * D, T);
                             convert_layer(a, l + 1, lds); }
                else rowwise(XL, XC, XL, XC, Mb, MOD + (size_t)l * 9 * MODW + 5120, NW + (l * 4 + 3) * D, nullptr, MOD, 0, 0, NW, TL);
                break;
            }
        }
#else
        { g0 = GemmDesc{H, (const bf16*)(ws + W_IN), T, a.hi * 256, a.lo * 128, (bf16*)(ws + WS_P), HYB_INP}; ng = 1; }
#endif
        for (int gi = 0; gi < ng; ++gi) {
            const bool f = (gi == 0);
            pg8::Gemm g{f ? g0.A : g1.A, f ? g0.Bt : g1.Bt, f ? g0.M : g1.M, f ? g0.N : g1.N, f ? g0.K : g1.K}; pg8::StaticOrder S; S.init(g.M, g.N, (int)gridDim.x, (int)blockIdx.x);
            pg8::EpiStore E{f ? g0.O : g1.O, f ? g0.ldc : g1.ldc};
#ifndef NO_GEMM
            pg8::gemm_phase<pg8::EpiStore, pg8::StaticOrder, true, true>(lds, g, S, E);
#endif
            __syncthreads();
        }
        if (s + 1 < a.hi) {
#if MK_SINGLE
            cg::this_grid().sync();
#endif
        }
    }
}

extern "C" void kernel_launch(void* const* d_in, const int* in_sizes, int n_in, void* d_out, int out_size, void* d_ws, size_t ws_size, hipStream_t stream) {
    static int grid = 0;
    if (grid == 0) {
        if (n_in != 25 || out_size != TL * D || ws_size < WS_END) { fprintf(stderr, "kernel_launch: unexpected problem (n_in %d out %d ws %zu need %zu)\n", n_in, out_size, ws_size, (size_t)WS_END); grid = -1; return; }
        if (hipFuncSetAttribute((const void*)fwd_kernel, hipFuncAttributeMaxDynamicSharedMemorySize, LDS_BYTES) != hipSuccess) { fprintf(stderr, "kernel_launch: hipFuncSetAttribute failed\n"); grid = -1; return; }
        int dev = 0, cus = 0, per_cu = 0;
        hipGetDevice(&dev); hipDeviceGetAttribute(&cus, hipDeviceAttributeMultiprocessorCount, dev);
        hipOccupancyMaxActiveBlocksPerMultiprocessor(&per_cu, (const void*)fwd_kernel, NTHR, LDS_BYTES);
        (void)hipGetLastError();
        if (per_cu < 1) { fprintf(stderr, "kernel_launch: occupancy query says %d blocks per CU\n", per_cu); }
        grid = cus;
    }
    if (grid < 0) return;
    Args a{};
    for (int i = 0; i < 25; ++i) a.in[i] = (const float*)d_in[i];
    a.out = (float*)d_out; a.ws = (unsigned char*)d_ws;
#if MK_SINGLE
    a.lo = 0; a.hi = NSTEP + 1;
    void* args[] = {&a};
    hipError_t e = hipLaunchCooperativeKernel((const void*)fwd_kernel, dim3(grid), dim3(NTHR), args, LDS_BYTES, stream);
    if (e != hipSuccess) fprintf(stderr, "cooperative launch failed: %s (grid %d)\n", hipGetErrorString(e), grid);
#else
    for (int s = 0; s < NSTEP + 1; ++s) { a.lo = s; a.hi = s + 1; hipLaunchKernelGGL(fwd_kernel, dim3(grid), dim3(NTHR), LDS_BYTES, stream, a); }
#endif
}
```

```cpp
#include <hip/hip_runtime.h>
#include <hip/hip_cooperative_groups.h>
#include <cstdio>
#include <cstdint>
namespace cg = cooperative_groups;
__device__ __forceinline__ int otid() { int t = threadIdx.x; asm volatile("" : "+v"(t)); return t; }
__device__ __forceinline__ float shx(float v, int mask, int lane) { return __builtin_bit_cast(float, __builtin_amdgcn_ds_bpermute((lane ^ mask) << 2, __builtin_bit_cast(int, v))); }
namespace pg8 {
#define PG8_LAS __attribute__((address_space(3)))
typedef unsigned short bf16_t;
typedef short bf16x8 __attribute__((ext_vector_type(8)));
typedef float f32x4 __attribute__((ext_vector_type(4)));
typedef unsigned u32x4 __attribute__((ext_vector_type(4)));
constexpr int BM = 256, BK = 64, HALF = 128, HTB = HALF * BK * 2  , STAGE_BYTES = 8 * HTB, NXCD = 8, WGM = 8;

__host__ __device__ __forceinline__ int lds_byte(int r, int c) { const int st = (r >> 4) * 2 + (c >> 5), rr = r & 15, cc = c & 31, ob = rr * 64 + cc * 2; return st * 1024 + (ob ^ (((ob >> 9) & 1) << 5)); }
__host__ __device__ __forceinline__ void stage_rc(int b, int& R, int& C) { const int st = b / 1024, sb = b % 1024, swz = sb ^ (((sb >> 9) & 1) << 5); R = (st >> 1) * 16 + swz / 64; C = (st & 1) * 32 + (swz % 64) / 2; }
__host__ __device__ __forceinline__ int perm32(int rho) { const int n = rho >> 4, i = rho & 15; return 8 * (i >> 2) + 4 * n + (i & 3); }

struct Unit { int pm, pn; };
struct Gemm { const bf16_t* A; const bf16_t* Bt; int M, N, K; };

struct StaticOrder {
    int nM, nN, nwg, G, c;
    __host__ __device__ void init(int M, int N, int G_, int c_) { nM = M / BM; nN = N / BM; nwg = nM * nN; G = G_; c = c_; }
    __host__ __device__ bool next(int i, Unit& u) const {
        const long L = (long)i * G + c; if (L >= nwg) return false;
        int wgid = (int)L; { const int q = nwg / NXCD, r = nwg % NXCD, xcd = wgid % NXCD, off = wgid / NXCD; wgid = (xcd < r ? xcd * (q + 1) : r * (q + 1) + (xcd - r) * q) + off; }
        const int nig = WGM * nN, gid = wgid / nig, fm = gid * WGM, gsz = (nM - fm) < WGM ? (nM - fm) : WGM;
        u.pm = fm + ((wgid % nig) % gsz); u.pn = (wgid % nig) / gsz; return true;
    }
    __device__ __forceinline__ void a_ready(const Unit&) const {}
    __device__ __forceinline__ void done(const Unit&) const {}
};

__device__ __forceinline__ unsigned cvt_pk_bf16(float lo, float hi) { unsigned r; asm volatile("v_cvt_pk_bf16_f32 %0, %1, %2" : "=v"(r) : "v"(lo), "v"(hi)); return r; }
struct EpiStore {
    static constexpr bool PERM = true, AFTER_DRAIN = false;
    bf16_t* O; int ldc;
    __device__ __forceinline__ void operator()(const f32x4 (&acc)[2][2][4][2], const Unit& u, int wr, int wc, int fr, int fq) const {
        const int row0 = u.pm * BM + wr * 64 + fr; const int col0 = u.pn * BM + wc * 32 + 8 * fq;
#pragma unroll
        for (int ai = 0; ai < 2; ++ai)
#pragma unroll
            for (int m = 0; m < 4; ++m) { bf16_t* rowp = O + (size_t)(row0 + ai * HALF + m * 16) * ldc + col0;
#pragma unroll
                for (int bj = 0; bj < 2; ++bj) { const f32x4 v0 = acc[ai][bj][m][0], v1 = acc[ai][bj][m][1];
                    u32x4 w; w.x = cvt_pk_bf16(v0[0], v0[1]); w.y = cvt_pk_bf16(v0[2], v0[3]); w.z = cvt_pk_bf16(v1[0], v1[1]); w.w = cvt_pk_bf16(v1[2], v1[3]);
                    *(u32x4*)(rowp + bj * HALF) = w; } }
    }
};
template <class Epi, class Sched, bool ALIGN_EPI = false, bool SP2 = false>
__device__ __forceinline__ void gemm_phase(PG8_LAS unsigned char* lds, const Gemm g, const Sched& S, const Epi& E) {
    const int tid = otid(), wid = __builtin_amdgcn_readfirstlane(tid >> 6), lane = tid & 63, wr = wid >> 2, wc = wid & 3, fr = lane & 15, fq = lane >> 4;
    const int K = g.K, nt = K / BK;
    unsigned voffA[2], voffB[2];
#pragma unroll
    for (int i = 0; i < 2; ++i) { int R, C; stage_rc(tid * 16 + i * 8192, R, C); const int Rb = Epi::PERM ? ((R & ~31) + perm32(R & 31)) : R;
        voffA[i] = (unsigned)(R * K + C) * 2u; voffB[i] = (unsigned)(Rb * K + C) * 2u; }
    const size_t kstep = (size_t)(BK * 2);
    const size_t hstep = (size_t)HALF * K * 2;
    const size_t tstep = 2 * hstep;
    const unsigned ldsw = (unsigned)wid * 1024u;
    const int aoff = lds_byte(wr * 64 + fr, fq * 8), boff = lds_byte(wc * 32 + fr, fq * 8);
#define PG8_SA(b, h) (((b) * 2 + (h)) * HTB)
#define PG8_SB(b, h) ((4 + (b) * 2 + (h)) * HTB)
#define PG8_STAGE(bufoff, gbase, voff) do { _Pragma("unroll") for (int _i = 0; _i < 2; ++_i) \
        __builtin_amdgcn_global_load_lds((const unsigned*)((const char*)(gbase) + (voff)[_i]), (PG8_LAS unsigned*)(lds + (bufoff) + ldsw + _i * 8192), 16, 0, 0); } while (0)
#define PG8_LDA(dst, b, h) do { _Pragma("unroll") for (int m = 0; m < 4; ++m) _Pragma("unroll") for (int k = 0; k < 2; ++k) dst[m][k] = *(const PG8_LAS bf16x8*)(lds + PG8_SA(b, h) + aoff + m * 2048 + k * 1024); } while (0)
#define PG8_LDB(dst, b, h) do { _Pragma("unroll") for (int n = 0; n < 2; ++n) _Pragma("unroll") for (int k = 0; k < 2; ++k) dst[n][k] = *(const PG8_LAS bf16x8*)(lds + PG8_SB(b, h) + boff + n * 2048 + k * 1024); } while (0)
#define PG8_MMA(ai, bj, At, Bt) do { __builtin_amdgcn_s_setprio(1); _Pragma("unroll") for (int m = 0; m < 4; ++m) _Pragma("unroll") for (int n = 0; n < 2; ++n) _Pragma("unroll") for (int k = 0; k < 2; ++k) \
        acc[ai][bj][m][n] = __builtin_amdgcn_mfma_f32_16x16x32_bf16(Bt[n][k], At[m][k], acc[ai][bj][m][n], 0, 0, 0); __builtin_amdgcn_s_setprio(0); } while (0)
#define PG8_WAIT_V(n) asm volatile("s_waitcnt vmcnt(" #n ")" ::: "memory")
#define PG8_WAIT_L(n) asm volatile("s_waitcnt lgkmcnt(" #n ")" ::: "memory")
#define PG8_BAR __builtin_amdgcn_s_barrier()
#define PG8_SCHED __builtin_amdgcn_sched_barrier(0)
    Unit cur, nxt; int ui = 0;
    if (!S.next(0, cur)) return;
    f32x4 acc[2][2][4][2];
#pragma unroll
    for (int a = 0; a < 2; ++a)
#pragma unroll
        for (int b = 0; b < 2; ++b)
#pragma unroll
            for (int m = 0; m < 4; ++m)
#pragma unroll
                for (int n = 0; n < 2; ++n) acc[a][b][m][n] = (f32x4){0.f, 0.f, 0.f, 0.f};
    bf16x8 At[4][2], B0[2][2], B1[2][2];
    const char* cA = (const char*)g.A + (size_t)cur.pm * tstep; const char* cB = (const char*)g.Bt + (size_t)cur.pn * tstep;
    S.a_ready(cur);
    if constexpr (SP2) {
        PG8_STAGE(PG8_SB(0, 0), cB, voffB); PG8_STAGE(PG8_SB(0, 1), cB + hstep, voffB); PG8_STAGE(PG8_SA(0, 0), cA, voffA); PG8_STAGE(PG8_SA(0, 1), cA + hstep, voffA);
        if (wr == 1) PG8_BAR;
        PG8_WAIT_V(2); PG8_BAR;
        PG8_STAGE(PG8_SB(1, 0), cB + kstep, voffB); PG8_STAGE(PG8_SA(1, 0), cA + kstep, voffA); PG8_STAGE(PG8_SB(1, 1), cB + hstep + kstep, voffB);
        PG8_WAIT_V(6); PG8_BAR;
    } else {
        PG8_STAGE(PG8_SB(0, 0), cB, voffB); PG8_STAGE(PG8_SA(0, 0), cA, voffA); PG8_STAGE(PG8_SB(0, 1), cB + hstep, voffB); PG8_STAGE(PG8_SA(0, 1), cA + hstep, voffA);
        if (wr == 1) PG8_BAR;
        PG8_WAIT_V(4); PG8_BAR;
        PG8_STAGE(PG8_SB(1, 0), cB + kstep, voffB); PG8_STAGE(PG8_SA(1, 0), cA + kstep, voffA); PG8_STAGE(PG8_SB(1, 1), cB + hstep + kstep, voffB);
        PG8_WAIT_V(6); PG8_BAR;
    }
    for (;;) {
        const bool has_next = S.next(ui + 1, nxt);
        const char* nA = has_next ? (const char*)g.A + (size_t)nxt.pm * tstep : cA; const char* nB = has_next ? (const char*)g.Bt + (size_t)nxt.pn * tstep : cB;
        for (int t = 0; t < nt; t += 2) {
            const bool last = (t == nt - 2);
            const char* a1 = cA + (size_t)(t + 1) * kstep;
            const char* a2 = last ? nA : cA + (size_t)(t + 2) * kstep; const char* b2 = last ? nB : cB + (size_t)(t + 2) * kstep;
            const char* a3 = a2 + kstep; const char* b3 = b2 + kstep;
            if (last && has_next) S.a_ready(nxt);
            if constexpr (SP2) {
            PG8_LDB(B0, 0, 0); PG8_LDB(B1, 0, 1); PG8_SCHED; PG8_LDA(At, 0, 0); PG8_STAGE(PG8_SA(1, 1), a1 + hstep, voffA);
            PG8_WAIT_V(8); PG8_WAIT_L(0); PG8_BAR; PG8_MMA(0, 0, At, B0); PG8_MMA(0, 1, At, B1); PG8_BAR; PG8_SCHED;
            PG8_LDA(At, 0, 1); PG8_STAGE(PG8_SB(0, 0), b2, voffB); PG8_STAGE(PG8_SB(0, 1), b2 + hstep, voffB); PG8_STAGE(PG8_SA(0, 0), a2, voffA);
            PG8_WAIT_V(8); PG8_WAIT_L(0); PG8_BAR; PG8_MMA(1, 0, At, B0); PG8_MMA(1, 1, At, B1); PG8_BAR; PG8_SCHED;
            PG8_LDB(B0, 1, 0); PG8_LDB(B1, 1, 1); PG8_SCHED; PG8_LDA(At, 1, 0); PG8_STAGE(PG8_SA(0, 1), a2 + hstep, voffA);
            PG8_WAIT_V(8); PG8_WAIT_L(0); PG8_BAR; PG8_MMA(0, 0, At, B0); PG8_MMA(0, 1, At, B1); PG8_BAR; PG8_SCHED;
            PG8_LDA(At, 1, 1); PG8_STAGE(PG8_SB(1, 0), b3, voffB); PG8_STAGE(PG8_SB(1, 1), b3 + hstep, voffB); PG8_STAGE(PG8_SA(1, 0), a3, voffA);
            PG8_WAIT_V(8); PG8_WAIT_L(0); PG8_BAR; PG8_MMA(1, 0, At, B0); PG8_MMA(1, 1, At, B1); PG8_BAR; PG8_SCHED;
            } else {
            PG8_LDB(B0, 0, 0); PG8_SCHED; PG8_LDA(At, 0, 0); PG8_STAGE(PG8_SA(1, 1), a1 + hstep, voffA);
            PG8_WAIT_L(8); PG8_BAR; PG8_WAIT_L(0); PG8_MMA(0, 0, At, B0); PG8_BAR; PG8_SCHED;
            PG8_LDB(B1, 0, 1); PG8_STAGE(PG8_SB(0, 0), b2, voffB);
            PG8_BAR; PG8_WAIT_L(0); PG8_MMA(0, 1, At, B1); PG8_BAR;
            PG8_LDA(At, 0, 1); PG8_STAGE(PG8_SA(0, 0), a2, voffA);
            PG8_BAR; PG8_WAIT_L(0); PG8_MMA(1, 0, At, B0); PG8_BAR; PG8_SCHED;
            PG8_STAGE(PG8_SB(0, 1), b2 + hstep, voffB);
            PG8_WAIT_V(6); PG8_BAR; PG8_MMA(1, 1, At, B1); PG8_BAR;
            PG8_LDB(B0, 1, 0); PG8_SCHED; PG8_LDA(At, 1, 0); PG8_STAGE(PG8_SA(0, 1), a2 + hstep, voffA);
            PG8_WAIT_L(8); PG8_BAR; PG8_WAIT_L(0); PG8_MMA(0, 0, At, B0); PG8_BAR; PG8_SCHED;
            PG8_LDB(B1, 1, 1); PG8_STAGE(PG8_SB(1, 0), b3, voffB);
            PG8_BAR; PG8_WAIT_L(0); PG8_MMA(0, 1, At, B1); PG8_BAR;
            PG8_LDA(At, 1, 1); PG8_STAGE(PG8_SA(1, 0), a3, voffA);
            PG8_BAR; PG8_WAIT_L(0); PG8_MMA(1, 0, At, B0); PG8_BAR; PG8_SCHED;
            PG8_STAGE(PG8_SB(1, 1), b3 + hstep, voffB);
            PG8_WAIT_V(6); PG8_BAR; PG8_MMA(1, 1, At, B1); PG8_BAR;
            }
        }
        if constexpr (ALIGN_EPI) { if (wr == 0) PG8_BAR; }
        if constexpr (!Epi::AFTER_DRAIN) { E(acc, cur, wr, wc, fr, fq); S.done(cur); }
        if (!has_next) break;
#pragma unroll
        for (int a = 0; a < 2; ++a)
#pragma unroll
            for (int b = 0; b < 2; ++b)
#pragma unroll
                for (int m = 0; m < 4; ++m)
#pragma unroll
                    for (int n = 0; n < 2; ++n) acc[a][b][m][n] = (f32x4){0.f, 0.f, 0.f, 0.f};
        cur = nxt; cA = nA; cB = nB; ++ui;
        if constexpr (ALIGN_EPI) { if (wr == 1) PG8_BAR; }
    }
    PG8_WAIT_V(0);
    if constexpr (!ALIGN_EPI) { if (wr == 0) PG8_BAR; }
    PG8_BAR;
    if constexpr (Epi::AFTER_DRAIN) { E.fused(acc, cur, wr, wc, fr, fq, lds, wid, lane); S.done(cur); }
#undef PG8_SA
#undef PG8_SB
#undef PG8_STAGE
#undef PG8_LDA
#undef PG8_LDB
#undef PG8_MMA
#undef PG8_WAIT_V
#undef PG8_WAIT_L
#undef PG8_BAR
#undef PG8_SCHED
}
}

#define LAS __attribute__((address_space(3)))
typedef unsigned short bf16;
typedef unsigned v4u __attribute__((ext_vector_type(4)));
typedef unsigned v2u __attribute__((ext_vector_type(2)));
typedef float f32x4 __attribute__((ext_vector_type(4)));
constexpr int NWAVES = 8, NTHR = 512;
constexpr int D = 1024, NB = 8, SEQ = 2048, CTXL = 256, TL = NB * SEQ, TC = NB * CTXL, T = TL + TC;
constexpr int HYB_IN = 2208, HYB_INP = 2304, SSD_IN = 5184, SSD_INP = 5376, DFF = 2816, UPW = 5632;
constexpr int QW = 768, KVW = 1024, MODW = 6144;
constexpr float EPS = 1e-6f;
constexpr int NSTEP = 1 + 4 * 10;
constexpr float ATT_SCALE_LOG2E = 0.10206207261596577f * 1.4426950408889634f;

constexpr size_t MiB = 1u << 20;
constexpr size_t WS_CTL = 0, CTL_ZERO_BYTES = 64 * 1024;
constexpr size_t WS_MOD = 1 * MiB;
constexpr size_t WS_ROPE = 2 * MiB;
constexpr size_t W_UP = 3 * MiB;
constexpr size_t W_DN = W_UP + (size_t)UPW * D * 2;
constexpr size_t W_IN = W_DN + (size_t)D * DFF * 2;
constexpr size_t W_OUT = W_IN + (size_t)SSD_INP * D * 2;
constexpr size_t W_UQ = W_OUT + (size_t)D * 2048 * 2;
constexpr size_t W_UKV = W_UQ + (size_t)QW * 384 * 2;
constexpr size_t W_END = W_UKV + (size_t)KVW * 256 * 2;
constexpr size_t WS_XC = 36 * MiB;
constexpr size_t WS_H = 44 * MiB;
constexpr size_t WS_DT = WS_H, WS_AA = WS_H + (size_t)T * 64 * 4;
constexpr size_t WS_BIG = 80 * MiB;
constexpr size_t WS_M = WS_BIG;
constexpr size_t WS_P = WS_BIG;
constexpr size_t WS_Q = WS_BIG + 81 * MiB;
constexpr size_t WS_KV = WS_BIG + 108 * MiB;
constexpr size_t WS_KR = WS_BIG + 144 * MiB;
constexpr size_t WS_CQN = WS_BIG + 146 * MiB;
constexpr size_t WS_CKVN = WS_BIG + 160 * MiB;
constexpr size_t WS_MIX = WS_BIG + 170 * MiB;
constexpr size_t WS_U = WS_BIG;
constexpr size_t WS_G = WS_BIG + 198 * MiB;
constexpr size_t WS_ZX = WS_BIG;
constexpr size_t WS_XBC = WS_BIG + 189 * MiB;
constexpr size_t WS_END = WS_BIG + 297 * MiB;
static_assert(W_END <= WS_XC && WS_G + (size_t)T * DFF * 2 <= WS_END && WS_XBC + (size_t)T * 3072 * 2 <= WS_END && WS_ZX + (size_t)T * SSD_INP * 2 <= WS_XBC, "ws map");
static_assert(WS_AA + (size_t)T * 64 * 4 <= WS_BIG && WS_MIX + (size_t)T * D * 2 <= WS_END && WS_Q + (size_t)T * QW * 2 <= WS_KV && WS_P + (size_t)T * HYB_INP * 2 <= WS_Q, "ws map 2");
constexpr int LDS_BYTES = 147456;

struct Args { const float* in[25]; float* out; unsigned char* ws; int lo, hi; };
enum { I_X = 0, I_C, I_CTX, I_CCTX, I_MODW, I_MODB, I_NORMW, I_WUP, I_FCONV, I_WDN, I_HIN, I_QNORM, I_KVNORM, I_WUQ, I_WUKV, I_SCONV, I_HOUT, I_SIN, I_SCONVW, I_SCONVB, I_ALOG, I_DTB, I_SD, I_SNORM, I_SOUT };

__device__ __forceinline__ unsigned f2bf(float f) { unsigned u = __builtin_bit_cast(unsigned, f); return (u + 0x7fffu + ((u >> 16) & 1u)) >> 16; }
__device__ __forceinline__ unsigned pk2(float lo, float hi) { return f2bf(lo) | (f2bf(hi) << 16); }
__device__ __forceinline__ float bflo(unsigned u) { return __builtin_bit_cast(float, u << 16); }
__device__ __forceinline__ float bfhi(unsigned u) { return __builtin_bit_cast(float, u & 0xffff0000u); }
__device__ __forceinline__ float bf1(bf16 b) { return __builtin_bit_cast(float, (unsigned)b << 16); }
__device__ __forceinline__ float silu_f(float x) { return x / (1.f + __expf(-x)); }
__device__ __forceinline__ float wave_sum(float v, int lane) {
#pragma unroll
    for (int o = 1; o < 64; o <<= 1) v += shx(v, o, lane);
    return v;
}
__device__ __forceinline__ void unpack8(const v4u w, float (&f)[8]) { f[0] = bflo(w.x); f[1] = bfhi(w.x); f[2] = bflo(w.y); f[3] = bfhi(w.y); f[4] = bflo(w.z); f[5] = bfhi(w.z); f[6] = bflo(w.w); f[7] = bfhi(w.w); }
__device__ __forceinline__ v4u pack8(const float (&f)[8]) { v4u w; w.x = pk2(f[0], f[1]); w.y = pk2(f[2], f[3]); w.z = pk2(f[4], f[5]); w.w = pk2(f[6], f[7]); return w; }
__device__ __forceinline__ bool has_prev(int r) { return r < TL ? (r & (SEQ - 1)) != 0 : ((r - TL) & (CTXL - 1)) != 0; }
__device__ __forceinline__ bool has_next(int r) { return r < TL ? (r & (SEQ - 1)) != SEQ - 1 : ((r - TL) & (CTXL - 1)) != CTXL - 1; }

__device__ __forceinline__ void mod_compute(const Args& a, LAS unsigned char* lds) {
    LAS float* sc = (LAS float*)lds;
    LAS float* red = (LAS float*)(lds + 36864);
    const int tid = otid();
    float* MOD = (float*)(a.ws + WS_MOD);
    for (int i = tid; i < 9 * 1024; i += NTHR) { const int c = i >> 10, k = i & 1023; const float v = c < 8 ? a.in[I_C][c * 1024 + k] : a.in[I_CCTX][k]; sc[i] = silu_f(v); }
    __syncthreads();
    for (int item = blockIdx.x; item < 4 * 96; item += gridDim.x) {
        const int l = item / 96, cb = item % 96;
        const float* W = a.in[I_MODW] + (size_t)l * 1024 * MODW + cb * 64;
        const int cgp = tid & 15, kg = tid >> 4;
        float acc[9][4];
#pragma unroll
        for (int c = 0; c < 9; ++c) { acc[c][0] = 0.f; acc[c][1] = 0.f; acc[c][2] = 0.f; acc[c][3] = 0.f; }
#pragma unroll 4
        for (int kk = 0; kk < 32; ++kk) { const int k = kg * 32 + kk; const f32x4 w = *(const f32x4*)(W + (size_t)k * MODW + cgp * 4);
#pragma unroll
            for (int c = 0; c < 9; ++c) { const float s = sc[c * 1024 + k]; acc[c][0] += s * w[0]; acc[c][1] += s * w[1]; acc[c][2] += s * w[2]; acc[c][3] += s * w[3]; } }
#pragma unroll
        for (int c = 0; c < 9; ++c)
#pragma unroll
            for (int j = 0; j < 4; ++j) red[kg * 576 + c * 64 + cgp * 4 + j] = acc[c][j];
        __syncthreads();
        for (int o = tid; o < 576; o += NTHR) { float s = 0.f;
            for (int g = 0; g < 32; ++g) s += red[g * 576 + o];
            const int c = o >> 6, col = o & 63; MOD[(size_t)(l * 9 + c) * MODW + cb * 64 + col] = s + a.in[I_MODB][l * MODW + cb * 64 + col]; }
        __syncthreads();
    }
}
__device__ __forceinline__ void rope_tables(const Args& a) {
    float* ct = (float*)(a.ws + WS_ROPE); float* st = ct + SEQ * 16;
    for (int i = blockIdx.x * NTHR + otid(); i < SEQ * 16; i += gridDim.x * NTHR) {
        const int t = i >> 4, j = i & 15; const int pos = j < 8 ? (t >> 6) : (t & 63); const int f = j & 7;
        const float i0 = (f & 1) ? 0.31622776601683794f : 1.0f; const int e = f >> 1; const float i1 = e == 0 ? 1.0f : (e == 1 ? 0.1f : (e == 2 ? 0.01f : 0.001f));
        const float inv = i0 * i1; const float ang = (float)pos * inv;
        ct[i] = __cosf(ang); st[i] = __sinf(ang); }
}
__device__ __forceinline__ void transpose_item(const float* W, int K, int N, bf16* WT, LAS float* scr, int item, int lane) {
    const int nblk = N / 32, kb = item / nblk, nb = item % nblk, k0 = 64 * kb, n0 = 32 * nb;
#pragma unroll 8
    for (int i = 0; i < 32; ++i) { const int kk = 2 * i + (lane >> 5); scr[kk * 33 + (lane & 31)] = W[(size_t)(k0 + kk) * N + n0 + (lane & 31)]; }
    asm volatile("s_waitcnt lgkmcnt(0)" ::: "memory");
    const int c = lane & 7;
#pragma unroll
    for (int j = 0; j < 4; ++j) { const int n = (lane >> 3) + 8 * j; const LAS float* s = scr + (8 * c) * 33 + n;
        v4u o; o.x = pk2(s[0 * 33], s[1 * 33]); o.y = pk2(s[2 * 33], s[3 * 33]); o.z = pk2(s[4 * 33], s[5 * 33]); o.w = pk2(s[6 * 33], s[7 * 33]);
        *(v4u*)(WT + (size_t)(n0 + n) * K + k0 + 8 * c) = o; }
    asm volatile("s_waitcnt lgkmcnt(0)" ::: "memory");
}
__device__ __forceinline__ void convert_weight(const float* W, int K, int N, int Npad, bf16* WT, LAS unsigned char* lds, int rot) {
    const int wave = otid() >> 6, lane = otid() & 63; const int NGW = gridDim.x * NWAVES; const int gw = (blockIdx.x * NWAVES + wave + rot) % NGW;
    LAS float* scr = (LAS float*)(lds + wave * 16384);
    const int nitems = (K / 64) * (N / 32);
    for (int it = gw; it < nitems; it += NGW) transpose_item(W, K, N, WT, scr, it, lane);
    (void)Npad;
}
__device__ __forceinline__ void convert_layer(const Args& a, int l, LAS unsigned char* lds) {
    const int i = l >> 1; unsigned char* ws = a.ws;
    convert_weight(a.in[I_WUP] + (size_t)l * D * UPW, D, UPW, UPW, (bf16*)(ws + W_UP), lds, 0);
    convert_weight(a.in[I_WDN] + (size_t)l * DFF * D, DFF, D, D, (bf16*)(ws + W_DN), lds, 300);
    if ((l & 1) == 0) {
        convert_weight(a.in[I_HIN] + (size_t)i * D * HYB_IN, D, HYB_IN, HYB_INP, (bf16*)(ws + W_IN), lds, 700);
        convert_weight(a.in[I_HOUT] + (size_t)i * D * D, D, D, D, (bf16*)(ws + W_OUT), lds, 1100);
        convert_weight(a.in[I_WUQ] + (size_t)i * 384 * QW, 384, QW, QW, (bf16*)(ws + W_UQ), lds, 1500);
        convert_weight(a.in[I_WUKV] + (size_t)i * 256 * KVW, 256, KVW, KVW, (bf16*)(ws + W_UKV), lds, 1700);
    } else {
        convert_weight(a.in[I_SIN] + (size_t)i * D * SSD_IN, D, SSD_IN, SSD_INP, (bf16*)(ws + W_IN), lds, 700);
        convert_weight(a.in[I_SOUT] + (size_t)i * 2048 * D, 2048, D, D, (bf16*)(ws + W_OUT), lds, 1300);
    }
}

__device__ __forceinline__ void rowwise(const float* xs_lat, const float* xs_ctx, float* xd_lat, float* xd_ctx, const bf16* Mb, const float* modg  , const float* nwA,
                                        bf16* H, const float* modh  , int sh_off, int sc_off, const float* nwB, int nrows) {
    const int wave = otid() >> 6, lane = otid() & 63; const int NGW = gridDim.x * NWAVES, gw = blockIdx.x * NWAVES + wave;
    for (int r = gw; r < nrows; r += NGW) {
        const bool lat = r < TL; const int cond = lat ? (r >> 11) : 8;
        const float* xs = lat ? xs_lat + (size_t)r * D : xs_ctx + (size_t)(r - TL) * D;
        float* xd = lat ? xd_lat + (size_t)r * D : xd_ctx + (size_t)(r - TL) * D;
        f32x4 v[4];
#pragma unroll
        for (int j = 0; j < 4; ++j) v[j] = *(const f32x4*)(xs + j * 256 + lane * 4);
        if (Mb) {
            f32x4 m[4]; float ss = 0.f;
#pragma unroll
            for (int j = 0; j < 4; ++j) { const v2u w = *(const v2u*)(Mb + (size_t)r * D + j * 256 + lane * 4); m[j] = (f32x4){bflo(w.x), bfhi(w.x), bflo(w.y), bfhi(w.y)};
                ss += (m[j][0] * m[j][0] + m[j][1] * m[j][1]) + (m[j][2] * m[j][2] + m[j][3] * m[j][3]); }
            const float rs = rsqrtf(wave_sum(ss, lane) * (1.f / D) + EPS);
#pragma unroll
            for (int j = 0; j < 4; ++j) { const f32x4 g = *(const f32x4*)(modg + (size_t)cond * MODW + j * 256 + lane * 4); const f32x4 w = *(const f32x4*)(nwA + j * 256 + lane * 4);
                v[j] = v[j] + g * (m[j] * rs * w); }
        }
#pragma unroll
        for (int j = 0; j < 4; ++j) *(f32x4*)(xd + j * 256 + lane * 4) = v[j];
        if (H) {
            float ss = 0.f;
#pragma unroll
            for (int j = 0; j < 4; ++j) ss += (v[j][0] * v[j][0] + v[j][1] * v[j][1]) + (v[j][2] * v[j][2] + v[j][3] * v[j][3]);
            const float rs = rsqrtf(wave_sum(ss, lane) * (1.f / D) + EPS);
#pragma unroll
            for (int j = 0; j < 4; ++j) { const int c = j * 256 + lane * 4;
                const f32x4 w = *(const f32x4*)(nwB + c); const f32x4 sc = *(const f32x4*)(modh + (size_t)cond * MODW + sc_off + c); const f32x4 sh = *(const f32x4*)(modh + (size_t)cond * MODW + sh_off + c);
                const f32x4 h = (v[j] * rs * w) * (sc + 1.0f) + sh;
                v2u o; o.x = pk2(h[0], h[1]); o.y = pk2(h[2], h[3]); *(v2u*)(H + (size_t)r * D + c) = o; }
        }
    }
}

__device__ __forceinline__ void prep_even(const Args& a, int i) {
    const int wave = otid() >> 6, lane = otid() & 63; const int NGW = gridDim.x * NWAVES, gw = blockIdx.x * NWAVES + wave;
    const bf16* P = (const bf16*)(a.ws + WS_P); bf16* CQN = (bf16*)(a.ws + WS_CQN); bf16* CKVN = (bf16*)(a.ws + WS_CKVN); bf16* KR = (bf16*)(a.ws + WS_KR); bf16* MIX = (bf16*)(a.ws + WS_MIX);
    const float* qn = a.in[I_QNORM] + i * 384; const float* kvn = a.in[I_KVNORM] + i * 256; const float* cw = a.in[I_SCONV] + i * 3 * 512;
    const float* ct = (const float*)(a.ws + WS_ROPE); const float* st = ct + SEQ * 16;
    for (int r = gw; r < T; r += NGW) {
        const bf16* p = P + (size_t)r * HYB_INP;
        {
            const unsigned* p32 = (const unsigned*)(p + lane * 6); const unsigned w0 = p32[0], w1 = p32[1], w2 = p32[2];
            float f[6] = {bflo(w0), bfhi(w0), bflo(w1), bfhi(w1), bflo(w2), bfhi(w2)}; float ss = 0.f;
#pragma unroll
            for (int j = 0; j < 6; ++j) ss += f[j] * f[j];
            const float rs = rsqrtf(wave_sum(ss, lane) * (1.f / 384.f) + EPS);
#pragma unroll
            for (int j = 0; j < 6; ++j) f[j] = f[j] * rs * qn[lane * 6 + j];
            unsigned* o32 = (unsigned*)(CQN + (size_t)r * 384 + lane * 6); o32[0] = pk2(f[0], f[1]); o32[1] = pk2(f[2], f[3]); o32[2] = pk2(f[4], f[5]);
        }
        {
            const v2u w = *(const v2u*)(p + 384 + lane * 4); float f[4] = {bflo(w.x), bfhi(w.x), bflo(w.y), bfhi(w.y)};
            const float ss = (f[0] * f[0] + f[1] * f[1]) + (f[2] * f[2] + f[3] * f[3]);
            const float rs = rsqrtf(wave_sum(ss, lane) * (1.f / 256.f) + EPS);
            const f32x4 g = *(const f32x4*)(kvn + lane * 4);
            v2u o; o.x = pk2(f[0] * rs * g[0], f[1] * rs * g[1]); o.y = pk2(f[2] * rs * g[2], f[3] * rs * g[3]); *(v2u*)(CKVN + (size_t)r * 256 + lane * 4) = o;
        }
        {
            const int j = lane & 31; const float v = bf1(p[640 + j]); const float o = shx(v, 16, lane); float res = v;
            if (r < TL) { const int t = r & (SEQ - 1); const float c = ct[t * 16 + (j & 15)], s = st[t * 16 + (j & 15)]; res = (j < 16) ? v * c - o * s : o * s + v * c; }
            if (lane < 32) KR[(size_t)r * 32 + j] = (bf16)f2bf(res);
        }
        {
            const int c0 = lane * 8; float gb[8], cur[8], acc[8], t0[8], t1[8];
            unpack8(*(const v4u*)(p + 672 + c0), gb);
            unpack8(*(const v4u*)(p + 1184 + c0), t0); unpack8(*(const v4u*)(p + 1696 + c0), t1);
#pragma unroll
            for (int j = 0; j < 8; ++j) { cur[j] = t0[j] * t1[j]; acc[j] = cw[512 + c0 + j] * cur[j]; }
            if (has_prev(r)) { unpack8(*(const v4u*)(p - HYB_INP + 1184 + c0), t0); unpack8(*(const v4u*)(p - HYB_INP + 1696 + c0), t1);
#pragma unroll
                for (int j = 0; j < 8; ++j) acc[j] += cw[c0 + j] * (t0[j] * t1[j]); }
            if (has_next(r)) { unpack8(*(const v4u*)(p + HYB_INP + 1184 + c0), t0); unpack8(*(const v4u*)(p + HYB_INP + 1696 + c0), t1);
#pragma unroll
                for (int j = 0; j < 8; ++j) acc[j] += cw[1024 + c0 + j] * (t0[j] * t1[j]); }
#pragma unroll
            for (int j = 0; j < 8; ++j) acc[j] *= gb[j];
            *(v4u*)(MIX + (size_t)r * D + 512 + c0) = pack8(acc);
        }
    }
}

__device__ __forceinline__ void convgate(const Args& a, int l, int nrows) {
    const bf16* U = (const bf16*)(a.ws + WS_U); bf16* G = (bf16*)(a.ws + WS_G); const float* cw = a.in[I_FCONV] + (size_t)l * 3 * UPW;
    const int total = nrows * (DFF / 8);
    for (int idx = blockIdx.x * NTHR + otid(); idx < total; idx += gridDim.x * NTHR) {
        const int r = idx / (DFF / 8), c0 = (idx % (DFF / 8)) * 8; const bf16* u = U + (size_t)r * UPW + c0;
        float ua[8], ug[8], act[8], gate[8];
        unpack8(*(const v4u*)u, ua); unpack8(*(const v4u*)(u + DFF), ug);
#pragma unroll
        for (int j = 0; j < 8; ++j) { act[j] = cw[UPW + c0 + j] * ua[j]; gate[j] = cw[UPW + DFF + c0 + j] * ug[j]; }
        if (has_prev(r)) { unpack8(*(const v4u*)(u - UPW), ua); unpack8(*(const v4u*)(u - UPW + DFF), ug);
#pragma unroll
            for (int j = 0; j < 8; ++j) { act[j] += cw[c0 + j] * ua[j]; gate[j] += cw[DFF + c0 + j] * ug[j]; } }
        if (has_next(r)) { unpack8(*(const v4u*)(u + UPW), ua); unpack8(*(const v4u*)(u + UPW + DFF), ug);
#pragma unroll
            for (int j = 0; j < 8; ++j) { act[j] += cw[2 * UPW + c0 + j] * ua[j]; gate[j] += cw[2 * UPW + DFF + c0 + j] * ug[j]; } }
#pragma unroll
        for (int j = 0; j < 8; ++j) act[j] = silu_f(act[j]) * gate[j];
        *(v4u*)(G + (size_t)r * DFF + c0) = pack8(act);
    }
}

__device__ __forceinline__ void ssd_conv(const Args& a, int i) {
    const bf16* ZX = (const bf16*)(a.ws + WS_ZX); bf16* XBC = (bf16*)(a.ws + WS_XBC); float* DT = (float*)(a.ws + WS_DT); float* AA = (float*)(a.ws + WS_AA);
    const float* cw = a.in[I_SCONVW] + (size_t)i * 3 * 3072; const float* cb = a.in[I_SCONVB] + (size_t)i * 3072;
    const int total = T * 384;
    for (int idx = blockIdx.x * NTHR + otid(); idx < total; idx += gridDim.x * NTHR) {
        const int r = idx / 384, c0 = (idx % 384) * 8; const bf16* u = ZX + (size_t)r * SSD_INP + 2048 + c0;
        float x[8], acc[8];
        unpack8(*(const v4u*)u, x);
#pragma unroll
        for (int j = 0; j < 8; ++j) acc[j] = cb[c0 + j] + cw[3072 + c0 + j] * x[j];
        if (has_prev(r)) { unpack8(*(const v4u*)(u - SSD_INP), x);
#pragma unroll
            for (int j = 0; j < 8; ++j) acc[j] += cw[c0 + j] * x[j]; }
        if (has_next(r)) { unpack8(*(const v4u*)(u + SSD_INP), x);
#pragma unroll
            for (int j = 0; j < 8; ++j) acc[j] += cw[2 * 3072 + c0 + j] * x[j]; }
#pragma unroll
        for (int j = 0; j < 8; ++j) acc[j] = silu_f(acc[j]);
        *(v4u*)(XBC + (size_t)r * 3072 + c0) = pack8(acc);
    }
    const float* alog = a.in[I_ALOG] + i * 64; const float* dtb = a.in[I_DTB] + i * 64;
    for (int idx = blockIdx.x * NTHR + otid(); idx < T * 64; idx += gridDim.x * NTHR) {
        const int r = idx >> 6, j = idx & 63; const float raw = bf1(ZX[(size_t)r * SSD_INP + 5120 + j]) + dtb[j];
        const float dt = raw > 15.f ? raw : (raw < -15.f ? __expf(raw) : __logf(1.f + __expf(raw)));
        DT[idx] = dt; AA[idx] = -__expf(alog[j]) * dt;
    }
}

__device__ __forceinline__ void gatenorm(const Args& a, int i, int nrows) {
    const int wave = otid() >> 6, lane = otid() & 63; const int NGW = gridDim.x * NWAVES, gw = blockIdx.x * NWAVES + wave;
    const bf16* ZX = (const bf16*)(a.ws + WS_ZX); bf16* YN = (bf16*)(a.ws + WS_XBC); const float* nw = a.in[I_SNORM] + i * 2048;
    for (int r = gw; r < nrows; r += NGW) {
        float v[4][8]; float ss = 0.f;
#pragma unroll
        for (int j = 0; j < 4; ++j) { float y[8], z[8]; const int c = j * 512 + lane * 8;
            unpack8(*(const v4u*)(ZX + (size_t)r * SSD_INP + 2048 + c), y); unpack8(*(const v4u*)(ZX + (size_t)r * SSD_INP + c), z);
#pragma unroll
            for (int k = 0; k < 8; ++k) { v[j][k] = y[k] * silu_f(z[k]); ss += v[j][k] * v[j][k]; } }
        const float rs = rsqrtf(wave_sum(ss, lane) * (1.f / 2048.f) + EPS);
#pragma unroll
        for (int j = 0; j < 4; ++j) { const int c = j * 512 + lane * 8; float o[8];
#pragma unroll
            for (int k = 0; k < 8; ++k) o[k] = v[j][k] * rs * nw[c + k];
            *(v4u*)(YN + (size_t)r * 2048 + c) = pack8(o); }
    }
}

__device__ __forceinline__ void attn_naive(const Args& a, LAS unsigned char* lds) {
    const int tid = otid(), qi = tid >> 1, half = tid & 1;
    const bf16* Qb = (const bf16*)(a.ws + WS_Q); const bf16* KVb = (const bf16*)(a.ws + WS_KV); const bf16* KR = (const bf16*)(a.ws + WS_KR); bf16* MIX = (bf16*)(a.ws + WS_MIX);
    const float* ct = (const float*)(a.ws + WS_ROPE); const float* st = ct + SEQ * 16;
    LAS float* Kt = (LAS float*)lds;
    LAS float* Vt = (LAS float*)(lds + 64 * 96 * 4);
    for (int u = blockIdx.x; u < 576; u += gridDim.x) {
        const bool lat = u < 512; const int b = lat ? (u >> 6) : ((u - 512) >> 3), h = lat ? ((u >> 3) & 7) : ((u - 512) & 7);
        const int nkeys = lat ? (CTXL + SEQ) : CTXL;
        const int qrow = lat ? b * SEQ + (u & 7) * 256 + qi : TL + b * CTXL + qi;
        float q[48];
#pragma unroll
        for (int g = 0; g < 6; ++g) { float f[8]; unpack8(*(const v4u*)(Qb + (size_t)qrow * QW + h * 96 + half * 48 + g * 8), f);
#pragma unroll
            for (int j = 0; j < 8; ++j) q[g * 8 + j] = f[j]; }
        if (lat && half == 1) { const int t = qrow & (SEQ - 1);
#pragma unroll
            for (int j = 0; j < 16; ++j) { const float c = ct[t * 16 + j], s = st[t * 16 + j]; const float x1 = q[16 + j], x2 = q[32 + j]; q[16 + j] = x1 * c - x2 * s; q[32 + j] = x1 * s + x2 * c; } }
#pragma unroll
        for (int j = 0; j < 48; ++j) q[j] *= ATT_SCALE_LOG2E;
        float o[32]; float m = -1e30f, l = 0.f;
#pragma unroll
        for (int j = 0; j < 32; ++j) o[j] = 0.f;
        for (int k0 = 0; k0 < nkeys; k0 += 64) {
            __syncthreads();
            for (int g = tid; g < 768; g += NTHR) { const int key = g / 12, part = g % 12; const int kk = k0 + key; const int krow = kk < CTXL ? TL + b * CTXL + kk : b * SEQ + kk - CTXL;
                float f[8]; unpack8(part < 8 ? *(const v4u*)(KVb + (size_t)krow * KVW + h * 128 + part * 8) : *(const v4u*)(KR + (size_t)krow * 32 + (part - 8) * 8), f);
#pragma unroll
                for (int j = 0; j < 8; ++j) Kt[key * 96 + part * 8 + j] = f[j]; }
            { const int key = tid >> 3, part = tid & 7; const int kk = k0 + key; const int krow = kk < CTXL ? TL + b * CTXL + kk : b * SEQ + kk - CTXL;
                float f[8]; unpack8(*(const v4u*)(KVb + (size_t)krow * KVW + h * 128 + 64 + part * 8), f);
#pragma unroll
                for (int j = 0; j < 8; ++j) Vt[key * 64 + part * 8 + j] = f[j]; }
            __syncthreads();
            for (int kg = 0; kg < 64; kg += 8) {
                float s[8]; float gm = -1e30f;
#pragma unroll
                for (int kk = 0; kk < 8; ++kk) { float acc = 0.f; const LAS f32x4* kp = (const LAS f32x4*)(Kt + (kg + kk) * 96 + half * 48);
#pragma unroll
                    for (int d4 = 0; d4 < 12; ++d4) { const f32x4 kv = kp[d4]; acc += q[d4 * 4] * kv[0] + q[d4 * 4 + 1] * kv[1] + q[d4 * 4 + 2] * kv[2] + q[d4 * 4 + 3] * kv[3]; }
                    acc += shx(acc, 1, tid & 63);
                    s[kk] = acc; gm = fmaxf(gm, acc); }
                const float mn = fmaxf(m, gm); const float alpha = exp2f(m - mn); m = mn; l *= alpha;
#pragma unroll
                for (int j = 0; j < 32; ++j) o[j] *= alpha;
#pragma unroll
                for (int kk = 0; kk < 8; ++kk) { const float p = exp2f(s[kk] - mn); l += p; const LAS f32x4* vp = (const LAS f32x4*)(Vt + (kg + kk) * 64 + half * 32);
#pragma unroll
                    for (int d4 = 0; d4 < 8; ++d4) { const f32x4 vv = vp[d4]; o[d4 * 4] += p * vv[0]; o[d4 * 4 + 1] += p * vv[1]; o[d4 * 4 + 2] += p * vv[2]; o[d4 * 4 + 3] += p * vv[3]; } }
            }
        }
        { const float inv = 1.f / l;
#pragma unroll
            for (int g = 0; g < 4; ++g) { float f[8];
#pragma unroll
                for (int j = 0; j < 8; ++j) f[j] = o[g * 8 + j] * inv;
                *(v4u*)(MIX + (size_t)qrow * D + h * 64 + half * 32 + g * 8) = pack8(f); } }
    }
}

__device__ __forceinline__ void ssd_scan_naive(const Args& a, int i, bool last, LAS unsigned char* lds) {
    const int tid = otid(), p = tid >> 3, nq = tid & 7;
    bf16* ZX = (bf16*)(a.ws + WS_ZX); const bf16* XBC = (const bf16*)(a.ws + WS_XBC); const float* DT = (const float*)(a.ws + WS_DT); const float* AA = (const float*)(a.ws + WS_AA);
    LAS float* xs = (LAS float*)lds;
    LAS float* Bs = (LAS float*)(lds + 16384);
    LAS float* Cs = (LAS float*)(lds + 16384 + 32768);
    LAS float* dts = (LAS float*)(lds + 16384 + 65536);
    LAS float* as = dts + 64;
    for (int it = blockIdx.x; it < NB * 32; it += gridDim.x) {
        const int b = it >> 5, h = it & 31, g = h >> 3; const float dsk = a.in[I_SD][i * 32 + h];
        for (int dir = 0; dir < 2; ++dir) {
            float stt[16];
#pragma unroll
            for (int n = 0; n < 16; ++n) stt[n] = 0.f;
            for (int seg = 0; seg < 2; ++seg) {
                const int len = seg == 0 ? CTXL : SEQ; const int base = seg == 0 ? TL + b * CTXL : b * SEQ; const bool want_y = !(last && seg == 0);
                for (int cc = 0; cc < len / 64; ++cc) {
                    const int t0 = dir == 0 ? cc * 64 : len - 64 - cc * 64;
                    __syncthreads();
                    { const int tt = tid >> 3, part = tid & 7; float f[8]; unpack8(*(const v4u*)(XBC + (size_t)(base + t0 + tt) * 3072 + h * 64 + part * 8), f);
#pragma unroll
                        for (int j = 0; j < 8; ++j) xs[tt * 64 + part * 8 + j] = f[j]; }
                    for (int q = tid; q < 1024; q += NTHR) { const int tt = q >> 4, part = q & 15; float f[8];
                        unpack8(*(const v4u*)(XBC + (size_t)(base + t0 + tt) * 3072 + 2048 + g * 128 + part * 8), f);
#pragma unroll
                        for (int j = 0; j < 8; ++j) Bs[tt * 128 + part * 8 + j] = f[j];
                        unpack8(*(const v4u*)(XBC + (size_t)(base + t0 + tt) * 3072 + 2560 + g * 128 + part * 8), f);
#pragma unroll
                        for (int j = 0; j < 8; ++j) Cs[tt * 128 + part * 8 + j] = f[j]; }
                    if (tid < 64) { dts[tid] = DT[(size_t)(base + t0 + tid) * 64 + dir * 32 + h]; as[tid] = AA[(size_t)(base + t0 + tid) * 64 + dir * 32 + h]; }
                    __syncthreads();
                    for (int s = 0; s < 64; ++s) {
                        const int tt = dir == 0 ? s : 63 - s;
                        const float dec = __expf(as[tt]); const float xv = xs[tt * 64 + p]; const float xd = xv * dts[tt];
                        const LAS f32x4* bp = (const LAS f32x4*)(Bs + tt * 128 + nq * 16); const LAS f32x4* cp = (const LAS f32x4*)(Cs + tt * 128 + nq * 16);
                        float acc = 0.f;
#pragma unroll
                        for (int n4 = 0; n4 < 4; ++n4) { const f32x4 bv = bp[n4], cv = cp[n4];
#pragma unroll
                            for (int k = 0; k < 4; ++k) { stt[n4 * 4 + k] = dec * stt[n4 * 4 + k] + xd * bv[k]; acc += cv[k] * stt[n4 * 4 + k]; } }
                        acc += shx(acc, 1, tid & 63); acc += shx(acc, 2, tid & 63); acc += shx(acc, 4, tid & 63);
                        if (want_y && nq == 0) { bf16* yp = ZX + (size_t)(base + t0 + tt) * SSD_INP + 2048 + h * 64 + p;
                            const float y = dir == 0 ? acc + dsk * xv : acc + bf1(*yp);
                            *yp = (bf16)f2bf(y); }
                    }
                }
            }
            __syncthreads();
            asm volatile("s_waitcnt vmcnt(0)" ::: "memory");
        }
    }
}

typedef short bf16x8 __attribute__((ext_vector_type(8)));
typedef float f32x16 __attribute__((ext_vector_type(16)));
__device__ __forceinline__ unsigned cvtpk(float lo, float hi) { unsigned r; asm volatile("v_cvt_pk_bf16_f32 %0, %1, %2" : "=v"(r) : "v"(lo), "v"(hi)); return r; }
constexpr int ATT_KP = 208, ATT_VP = 136, ATT_KB = 64 * ATT_KP, ATT_VB = 64 * ATT_VP, ATT_BUF = ATT_KB + ATT_VB;
__device__ __forceinline__ void attn_mfma(const Args& a, LAS unsigned char* lds) {
    const int tid = otid(), wave = tid >> 6, lane = tid & 63, r32 = lane & 31, hh = lane >> 5;
    const bf16* Qb = (const bf16*)(a.ws + WS_Q); const bf16* KVb = (const bf16*)(a.ws + WS_KV); const bf16* KR = (const bf16*)(a.ws + WS_KR); bf16* MIX = (bf16*)(a.ws + WS_MIX);
    const float* ct = (const float*)(a.ws + WS_ROPE); const float* st = ct + SEQ * 16;
    const int kkey0 = tid / 12, kpart0 = tid % 12, kkey1 = (tid + NTHR) / 12, kpart1 = (tid + NTHR) % 12; const bool k1ok = tid + NTHR < 768;
    for (int u = blockIdx.x; u < 576; u += gridDim.x) {
        const bool lat = u < 512; const int b = lat ? (u >> 6) : ((u - 512) >> 3), h = lat ? ((u >> 3) & 7) : ((u - 512) & 7);
        const int ntiles = lat ? (CTXL + SEQ) / 64 : CTXL / 64;
        const int qrow = (lat ? b * SEQ + (u & 7) * 256 : TL + b * CTXL) + wave * 32 + r32;
        bf16x8 qf[6];
#pragma unroll
        for (int s = 0; s < 6; ++s) qf[s] = *(const bf16x8*)(Qb + (size_t)qrow * QW + h * 96 + 16 * s + 8 * hh);
        if (lat) { const int t = qrow & (SEQ - 1);
#pragma unroll
            for (int j = 0; j < 8; j += 2) { float x1[2], x2[2], y1[2], y2[2];
#pragma unroll
                for (int e = 0; e < 2; ++e) { x1[e] = bf1((bf16)qf[4][j + e]); x2[e] = bf1((bf16)qf[5][j + e]); const float c = ct[t * 16 + 8 * hh + j + e], s = st[t * 16 + 8 * hh + j + e];
                    y1[e] = x1[e] * c - x2[e] * s; y2[e] = x1[e] * s + x2[e] * c; }
                const unsigned w1 = pk2(y1[0], y1[1]), w2 = pk2(y2[0], y2[1]);
                qf[4][j] = (short)(w1 & 0xffff); qf[4][j + 1] = (short)(w1 >> 16); qf[5][j] = (short)(w2 & 0xffff); qf[5][j + 1] = (short)(w2 >> 16); } }
        f32x16 o0, o1;
#pragma unroll
        for (int i = 0; i < 16; ++i) { o0[i] = 0.f; o1[i] = 0.f; }
        float m = -1e30f, l = 0.f;
        v4u kreg0, kreg1, vreg;
        const bf16* kp0 = kpart0 < 8 ? KVb + (size_t)kkey0 * KVW + h * 128 + kpart0 * 8 : KR + (size_t)kkey0 * 32 + (kpart0 - 8) * 8; const int ks0 = kpart0 < 8 ? KVW : 32;
        const bf16* kp1 = kpart1 < 8 ? KVb + (size_t)kkey1 * KVW + h * 128 + kpart1 * 8 : KR + (size_t)kkey1 * 32 + (kpart1 - 8) * 8; const int ks1 = kpart1 < 8 ? KVW : 32;
        const bf16* vp0 = KVb + (size_t)lane * KVW + h * 128 + 64 + wave * 8;
#define ATT_LOAD(it) do { const int rb_ = (it) < CTXL / 64 ? TL + b * CTXL + (it) * 64 : b * SEQ + ((it) - CTXL / 64) * 64; \
            kreg0 = *(const v4u*)(kp0 + (size_t)rb_ * ks0); if (k1ok) kreg1 = *(const v4u*)(kp1 + (size_t)rb_ * ks1); vreg = *(const v4u*)(vp0 + (size_t)rb_ * KVW); } while (0)
#define ATT_WRITE(buf) do { LAS unsigned char* kb_ = lds + (buf) * ATT_BUF; LAS unsigned char* vb_ = kb_ + ATT_KB; \
            *(LAS v4u*)(kb_ + kkey0 * ATT_KP + kpart0 * 16) = kreg0; if (k1ok) *(LAS v4u*)(kb_ + kkey1 * ATT_KP + kpart1 * 16) = kreg1; \
            { LAS unsigned short* vp = (LAS unsigned short*)(vb_ + (wave * 8) * ATT_VP + lane * 2); \
              vp[0 * (ATT_VP / 2)] = (unsigned short)(vreg.x & 0xffff); vp[1 * (ATT_VP / 2)] = (unsigned short)(vreg.x >> 16); vp[2 * (ATT_VP / 2)] = (unsigned short)(vreg.y & 0xffff); vp[3 * (ATT_VP / 2)] = (unsigned short)(vreg.y >> 16); \
              vp[4 * (ATT_VP / 2)] = (unsigned short)(vreg.z & 0xffff); vp[5 * (ATT_VP / 2)] = (unsigned short)(vreg.z >> 16); vp[6 * (ATT_VP / 2)] = (unsigned short)(vreg.w & 0xffff); vp[7 * (ATT_VP / 2)] = (unsigned short)(vreg.w >> 16); } } while (0)
        __syncthreads();
        ATT_LOAD(0); ATT_WRITE(0);
        __syncthreads();
        for (int it = 0; it < ntiles; ++it) {
            if (it + 1 < ntiles) ATT_LOAD(it + 1);
            const LAS unsigned char* kb = lds + (it & 1) * ATT_BUF; const LAS unsigned char* vb = kb + ATT_KB;
            f32x16 s0, s1;
#pragma unroll
            for (int i = 0; i < 16; ++i) { s0[i] = 0.f; s1[i] = 0.f; }
#pragma unroll
            for (int s = 0; s < 6; ++s) { const bf16x8 a0 = *(const LAS bf16x8*)(kb + r32 * ATT_KP + (16 * s + 8 * hh) * 2); const bf16x8 a1 = *(const LAS bf16x8*)(kb + (32 + r32) * ATT_KP + (16 * s + 8 * hh) * 2);
                s0 = __builtin_amdgcn_mfma_f32_32x32x16_bf16(a0, qf[s], s0, 0, 0, 0); s1 = __builtin_amdgcn_mfma_f32_32x32x16_bf16(a1, qf[s], s1, 0, 0, 0); }
            float mx = s0[0];
#pragma unroll
            for (int i = 1; i < 16; ++i) mx = fmaxf(mx, s0[i]);
#pragma unroll
            for (int i = 0; i < 16; ++i) mx = fmaxf(mx, s1[i]);
            mx = fmaxf(mx, shx(mx, 32, lane));
            const float mn = fmaxf(m, mx * ATT_SCALE_LOG2E); const float alpha = __builtin_amdgcn_exp2f(m - mn); m = mn;
            float rs = 0.f;
#pragma unroll
            for (int i = 0; i < 16; ++i) { s0[i] = __builtin_amdgcn_exp2f(s0[i] * ATT_SCALE_LOG2E - mn); s1[i] = __builtin_amdgcn_exp2f(s1[i] * ATT_SCALE_LOG2E - mn); rs += s0[i] + s1[i]; }
            l = l * alpha + rs;
#pragma unroll
            for (int i = 0; i < 16; ++i) { o0[i] *= alpha; o1[i] *= alpha; }
            bf16x8 pf[2][2];
#pragma unroll
            for (int s2 = 0; s2 < 2; ++s2) { v4u w0, w1;
                w0.x = cvtpk(s0[8 * s2 + 0], s0[8 * s2 + 1]); w0.y = cvtpk(s0[8 * s2 + 2], s0[8 * s2 + 3]); w0.z = cvtpk(s0[8 * s2 + 4], s0[8 * s2 + 5]); w0.w = cvtpk(s0[8 * s2 + 6], s0[8 * s2 + 7]);
                w1.x = cvtpk(s1[8 * s2 + 0], s1[8 * s2 + 1]); w1.y = cvtpk(s1[8 * s2 + 2], s1[8 * s2 + 3]); w1.z = cvtpk(s1[8 * s2 + 4], s1[8 * s2 + 5]); w1.w = cvtpk(s1[8 * s2 + 6], s1[8 * s2 + 7]);
                pf[0][s2] = __builtin_bit_cast(bf16x8, w0); pf[1][s2] = __builtin_bit_cast(bf16x8, w1); }
#pragma unroll
            for (int t = 0; t < 2; ++t)
#pragma unroll
                for (int s2 = 0; s2 < 2; ++s2) { const int ko = t * 32 + 16 * s2 + 4 * hh;
                    { const v2u lo = *(const LAS v2u*)(vb + r32 * ATT_VP + ko * 2); const v2u hi = *(const LAS v2u*)(vb + r32 * ATT_VP + (ko + 8) * 2);
                      const v4u w = (v4u){lo.x, lo.y, hi.x, hi.y}; o0 = __builtin_amdgcn_mfma_f32_32x32x16_bf16(__builtin_bit_cast(bf16x8, w), pf[t][s2], o0, 0, 0, 0); }
                    { const v2u lo = *(const LAS v2u*)(vb + (32 + r32) * ATT_VP + ko * 2); const v2u hi = *(const LAS v2u*)(vb + (32 + r32) * ATT_VP + (ko + 8) * 2);
                      const v4u w = (v4u){lo.x, lo.y, hi.x, hi.y}; o1 = __builtin_amdgcn_mfma_f32_32x32x16_bf16(__builtin_bit_cast(bf16x8, w), pf[t][s2], o1, 0, 0, 0); } }
            if (it + 1 < ntiles) ATT_WRITE((it + 1) & 1);
            __syncthreads();
        }
#undef ATT_LOAD
#undef ATT_WRITE
        l += shx(l, 32, lane); const float inv = 1.f / l;
        bf16* orow = MIX + (size_t)qrow * D + h * 64 + 4 * hh;
#pragma unroll
        for (int g = 0; g < 4; ++g) {
            v2u w; w.x = pk2(o0[4 * g] * inv, o0[4 * g + 1] * inv); w.y = pk2(o0[4 * g + 2] * inv, o0[4 * g + 3] * inv); *(v2u*)(orow + 8 * g) = w;
            v2u x; x.x = pk2(o1[4 * g] * inv, o1[4 * g + 1] * inv); x.y = pk2(o1[4 * g + 2] * inv, o1[4 * g + 3] * inv); *(v2u*)(orow + 32 + 8 * g) = x; }
    }
}

#ifndef MK_SINGLE
#define MK_SINGLE 1
#endif
struct GemmDesc { const bf16* A; const bf16* Bt; int M, N, K; bf16* O; int ldc; };

__global__ void __launch_bounds__(NTHR, 2) fwd_kernel(Args a) {
    extern __shared__ __attribute__((aligned(16))) unsigned char lds_raw[];
    LAS unsigned char* lds = (LAS unsigned char*)lds_raw;
    unsigned char* ws = a.ws;
    float* XL = a.out; float* XC = (float*)(ws + WS_XC); bf16* H = (bf16*)(ws + WS_H); bf16* Mb = (bf16*)(ws + WS_M);
    const float* MOD = (const float*)(ws + WS_MOD); const float* NW = a.in[I_NORMW];
    for (int s = a.lo; s < a.hi; ++s) {
        GemmDesc g0{}, g1{}; int ng = 0;
#ifndef NO_SIMPLE
        if (s == 0) {
            mod_compute(a, lds);
            rope_tables(a);
            convert_layer(a, 0, lds);
        } else if (s == 1) {
            rowwise(a.in[I_X], a.in[I_CTX], XL, XC, nullptr, nullptr, nullptr, H, MOD, 0, 1024, NW, T);
        } else {
            const int l = (s - 2) / 10, k = (s - 2) % 10, i = l >> 1; const bool even = (l & 1) == 0, last = (l == 3);
            const int MR = last ? TL : T;
            switch (k) {
            case 0:
                if (even) { g0 = GemmDesc{H, (const bf16*)(ws + W_IN), T, HYB_INP, D, (bf16*)(ws + WS_P), HYB_INP}; ng = 1; }
                else      { g0 = GemmDesc{H, (const bf16*)(ws + W_IN), T, SSD_INP, D, (bf16*)(ws + WS_ZX), SSD_INP}; ng = 1; }
                break;
            case 1: if (even) prep_even(a, i); else ssd_conv(a, i); break;
            case 2:
                if (even) { { g0 = GemmDesc{(const bf16*)(ws + WS_CQN), (const bf16*)(ws + W_UQ), T, QW, 384, (bf16*)(ws + WS_Q), QW}; ng = 1; }
                            g1 = GemmDesc{(const bf16*)(ws + WS_CKVN), (const bf16*)(ws + W_UKV), T, KVW, 256, (bf16*)(ws + WS_KV), KVW}; ng = 2; }
                else {
#ifndef NO_SSD
 ssd_scan_naive(a, i, last, lds);
#endif
 }
                break;
            case 3: if (even) {
#ifdef ATTN_NAIVE
 attn_naive(a, lds);
#else
 attn_mfma(a, lds);
#endif
 } else gatenorm(a, i, MR); break;
            case 4:
                if (even) { g0 = GemmDesc{(const bf16*)(ws + WS_MIX), (const bf16*)(ws + W_OUT), MR, D, D, Mb, D}; ng = 1; }
                else      { g0 = GemmDesc{(const bf16*)(ws + WS_XBC), (const bf16*)(ws + W_OUT), MR, D, 2048, Mb, D}; ng = 1; }
                break;
            case 5: rowwise(XL, XC, XL, XC, Mb, MOD + (size_t)l * 9 * MODW + 2048, NW + (l * 4 + 1) * D, H, MOD + (size_t)l * 9 * MODW, 3072, 4096, NW + (l * 4 + 2) * D, MR); break;
            case 6: { g0 = GemmDesc{H, (const bf16*)(ws + W_UP), MR, UPW, D, (bf16*)(ws + WS_U), UPW}; ng = 1; } break;
            case 7: convgate(a, l, MR); break;
            case 8: { g0 = GemmDesc{(const bf16*)(ws + WS_G), (const bf16*)(ws + W_DN), MR, D, DFF, Mb, D}; ng = 1; } break;
            case 9:
                if (!last) { rowwise(XL, XC, XL, XC, Mb, MOD + (size_t)l * 9 * MODW + 5120, NW + (l * 4 + 3) * D, H, MOD + (size_t)(l + 1) * 9 * MODW, 0, 1024, NW + ((l + 1) * 4 + 0) * D, T);
                             convert_layer(a, l + 1, lds); }
                else rowwise(XL, XC, XL, XC, Mb, MOD + (size_t)l * 9 * MODW + 5120, NW + (l * 4 + 3) * D, nullptr, MOD, 0, 0, NW, TL);
                break;
            }
        }
#else
        { g0 = GemmDesc{H, (const bf16*)(ws + W_IN), T, a.hi * 256, a.lo * 128, (bf16*)(ws + WS_P), HYB_INP}; ng = 1; }
#endif
        for (int gi = 0; gi < ng; ++gi) {
            const bool f = (gi == 0);
            pg8::Gemm g{f ? g0.A : g1.A, f ? g0.Bt : g1.Bt, f ? g0.M : g1.M, f ? g0.N : g1.N, f ? g0.K : g1.K}; pg8::StaticOrder S; S.init(g.M, g.N, (int)gridDim.x, (int)blockIdx.x);
            pg8::EpiStore E{f ? g0.O : g1.O, f ? g0.ldc : g1.ldc};
#ifndef NO_GEMM
            pg8::gemm_phase<pg8::EpiStore, pg8::StaticOrder, true, true>(lds, g, S, E);
#endif
            __syncthreads();
        }
        if (s + 1 < a.hi) {
#if MK_SINGLE
            cg::this_grid().sync();
#endif
        }
    }
}

extern "C" void kernel_launch(void* const* d_in, const int* in_sizes, int n_in, void* d_out, int out_size, void* d_ws, size_t ws_size, hipStream_t stream) {
    static int grid = 0;
    if (grid == 0) {
        if (n_in != 25 || out_size != TL * D || ws_size < WS_END) { fprintf(stderr, "kernel_launch: unexpected problem (n_in %d out %d ws %zu need %zu)\n", n_in, out_size, ws_size, (size_t)WS_END); grid = -1; return; }
        if (hipFuncSetAttribute((const void*)fwd_kernel, hipFuncAttributeMaxDynamicSharedMemorySize, LDS_BYTES) != hipSuccess) { fprintf(stderr, "kernel_launch: hipFuncSetAttribute failed\n"); grid = -1; return; }
        int dev = 0, cus = 0, per_cu = 0;
        hipGetDevice(&dev); hipDeviceGetAttribute(&cus, hipDeviceAttributeMultiprocessorCount, dev);
        hipOccupancyMaxActiveBlocksPerMultiprocessor(&per_cu, (const void*)fwd_kernel, NTHR, LDS_BYTES);
        (void)hipGetLastError();
        if (per_cu < 1) { fprintf(stderr, "kernel_launch: occupancy query says %d blocks per CU\n", per_cu); }
        grid = cus;
    }
    if (grid < 0) return;
    Args a{};
    for (int i = 0; i < 25; ++i) a.in[i] = (const float*)d_in[i];
    a.out = (float*)d_out; a.ws = (unsigned char*)d_ws;
#if MK_SINGLE
    a.lo = 0; a.hi = NSTEP + 1;
    void* args[] = {&a};
    hipError_t e = hipLaunchCooperativeKernel((const void*)fwd_kernel, dim3(grid), dim3(NTHR), args, LDS_BYTES, stream);
    if (e != hipSuccess) fprintf(stderr, "cooperative launch failed: %s (grid %d)\n", hipGetErrorString(e), grid);
#else
    for (int s = 0; s < NSTEP + 1; ++s) { a.lo = s; a.hi = s + 1; hipLaunchKernelGGL(fwd_kernel, dim3(grid), dim3(NTHR), LDS_BYTES, stream, a); }
#endif
}
```

```cpp
#include <hip/hip_runtime.h>
#include <hip/hip_cooperative_groups.h>
#include <cstdio>
#include <cstdint>
namespace cg = cooperative_groups;
__device__ __forceinline__ int otid() { int t = threadIdx.x; asm volatile("" : "+v"(t)); return t; }
__device__ __forceinline__ float shx(float v, int mask, int lane) { return __builtin_bit_cast(float, __builtin_amdgcn_ds_bpermute((lane ^ mask) << 2, __builtin_bit_cast(int, v))); }
namespace pg8 {
#define PG8_LAS __attribute__((address_space(3)))
typedef unsigned short bf16_t;
typedef short bf16x8 __attribute__((ext_vector_type(8)));
typedef float f32x4 __attribute__((ext_vector_type(4)));
typedef unsigned u32x4 __attribute__((ext_vector_type(4)));
constexpr int BM = 256, BK = 64, HALF = 128, HTB = HALF * BK * 2  , STAGE_BYTES = 8 * HTB, NXCD = 8, WGM = 8;

__host__ __device__ __forceinline__ int lds_byte(int r, int c) { const int st = (r >> 4) * 2 + (c >> 5), rr = r & 15, cc = c & 31, ob = rr * 64 + cc * 2; return st * 1024 + (ob ^ (((ob >> 9) & 1) << 5)); }
__host__ __device__ __forceinline__ void stage_rc(int b, int& R, int& C) { const int st = b / 1024, sb = b % 1024, swz = sb ^ (((sb >> 9) & 1) << 5); R = (st >> 1) * 16 + swz / 64; C = (st & 1) * 32 + (swz % 64) / 2; }
__host__ __device__ __forceinline__ int perm32(int rho) { const int n = rho >> 4, i = rho & 15; return 8 * (i >> 2) + 4 * n + (i & 3); }

struct Unit { int pm, pn; };
struct Gemm { const bf16_t* A; const bf16_t* Bt; int M, N, K; };

struct StaticOrder {
    int nM, nN, nwg, G, c;
    __host__ __device__ void init(int M, int N, int G_, int c_) { nM = M / BM; nN = N / BM; nwg = nM * nN; G = G_; c = c_; }
    __host__ __device__ bool next(int i, Unit& u) const {
        const long L = (long)i * G + c; if (L >= nwg) return false;
        int wgid = (int)L; { const int q = nwg / NXCD, r = nwg % NXCD, xcd = wgid % NXCD, off = wgid / NXCD; wgid = (xcd < r ? xcd * (q + 1) : r * (q + 1) + (xcd - r) * q) + off; }
        const int nig = WGM * nN, gid = wgid / nig, fm = gid * WGM, gsz = (nM - fm) < WGM ? (nM - fm) : WGM;
        u.pm = fm + ((wgid % nig) % gsz); u.pn = (wgid % nig) / gsz; return true;
    }
    __device__ __forceinline__ void a_ready(const Unit&) const {}
    __device__ __forceinline__ void done(const Unit&) const {}
};

__device__ __forceinline__ unsigned cvt_pk_bf16(float lo, float hi) { unsigned r; asm volatile("v_cvt_pk_bf16_f32 %0, %1, %2" : "=v"(r) : "v"(lo), "v"(hi)); return r; }
struct EpiStore {
    static constexpr bool PERM = true, AFTER_DRAIN = false;
    bf16_t* O; int ldc;
    __device__ __forceinline__ void operator()(const f32x4 (&acc)[2][2][4][2], const Unit& u, int wr, int wc, int fr, int fq) const {
        const int row0 = u.pm * BM + wr * 64 + fr; const int col0 = u.pn * BM + wc * 32 + 8 * fq;
#pragma unroll
        for (int ai = 0; ai < 2; ++ai)
#pragma unroll
            for (int m = 0; m < 4; ++m) { bf16_t* rowp = O + (size_t)(row0 + ai * HALF + m * 16) * ldc + col0;
#pragma unroll
                for (int bj = 0; bj < 2; ++bj) { const f32x4 v0 = acc[ai][bj][m][0], v1 = acc[ai][bj][m][1];
                    u32x4 w; w.x = cvt_pk_bf16(v0[0], v0[1]); w.y = cvt_pk_bf16(v0[2], v0[3]); w.z = cvt_pk_bf16(v1[0], v1[1]); w.w = cvt_pk_bf16(v1[2], v1[3]);
                    *(u32x4*)(rowp + bj * HALF) = w; } }
    }
};
template <class Epi, class Sched, bool ALIGN_EPI = false, bool SP2 = false>
__device__ __forceinline__ void gemm_phase(PG8_LAS unsigned char* lds, const Gemm g, const Sched& S, const Epi& E) {
    const int tid = otid(), wid = __builtin_amdgcn_readfirstlane(tid >> 6), lane = tid & 63, wr = wid >> 2, wc = wid & 3, fr = lane & 15, fq = lane >> 4;
    const int K = g.K, nt = K / BK;
    unsigned voffA[2], voffB[2];
#pragma unroll
    for (int i = 0; i < 2; ++i) { int R, C; stage_rc(tid * 16 + i * 8192, R, C); const int Rb = Epi::PERM ? ((R & ~31) + perm32(R & 31)) : R;
        voffA[i] = (unsigned)(R * K + C) * 2u; voffB[i] = (unsigned)(Rb * K + C) * 2u; }
    const size_t kstep = (size_t)(BK * 2);
    const size_t hstep = (size_t)HALF * K * 2;
    const size_t tstep = 2 * hstep;
    const unsigned ldsw = (unsigned)wid * 1024u;
    const int aoff = lds_byte(wr * 64 + fr, fq * 8), boff = lds_byte(wc * 32 + fr, fq * 8);
#define PG8_SA(b, h) (((b) * 2 + (h)) * HTB)
#define PG8_SB(b, h) ((4 + (b) * 2 + (h)) * HTB)
#define PG8_STAGE(bufoff, gbase, voff) do { _Pragma("unroll") for (int _i = 0; _i < 2; ++_i) \
        __builtin_amdgcn_global_load_lds((const unsigned*)((const char*)(gbase) + (voff)[_i]), (PG8_LAS unsigned*)(lds + (bufoff) + ldsw + _i * 8192), 16, 0, 0); } while (0)
#define PG8_LDA(dst, b, h) do { _Pragma("unroll") for (int m = 0; m < 4; ++m) _Pragma("unroll") for (int k = 0; k < 2; ++k) dst[m][k] = *(const PG8_LAS bf16x8*)(lds + PG8_SA(b, h) + aoff + m * 2048 + k * 1024); } while (0)
#define PG8_LDB(dst, b, h) do { _Pragma("unroll") for (int n = 0; n < 2; ++n) _Pragma("unroll") for (int k = 0; k < 2; ++k) dst[n][k] = *(const PG8_LAS bf16x8*)(lds + PG8_SB(b, h) + boff + n * 2048 + k * 1024); } while (0)
#define PG8_MMA(ai, bj, At, Bt) do { __builtin_amdgcn_s_setprio(1); _Pragma("unroll") for (int m = 0; m < 4; ++m) _Pragma("unroll") for (int n = 0; n < 2; ++n) _Pragma("unroll") for (int k = 0; k < 2; ++k) \
        acc[ai][bj][m][n] = __builtin_amdgcn_mfma_f32_16x16x32_bf16(Bt[n][k], At[m][k], acc[ai][bj][m][n], 0, 0, 0); __builtin_amdgcn_s_setprio(0); } while (0)
#define PG8_WAIT_V(n) asm volatile("s_waitcnt vmcnt(" #n ")" ::: "memory")
#define PG8_WAIT_L(n) asm volatile("s_waitcnt lgkmcnt(" #n ")" ::: "memory")
#define PG8_BAR __builtin_amdgcn_s_barrier()
#define PG8_SCHED __builtin_amdgcn_sched_barrier(0)
    Unit cur, nxt; int ui = 0;
    if (!S.next(0, cur)) return;
    f32x4 acc[2][2][4][2];
#pragma unroll
    for (int a = 0; a < 2; ++a)
#pragma unroll
        for (int b = 0; b < 2; ++b)
#pragma unroll
            for (int m = 0; m < 4; ++m)
#pragma unroll
                for (int n = 0; n < 2; ++n) acc[a][b][m][n] = (f32x4){0.f, 0.f, 0.f, 0.f};
    bf16x8 At[4][2], B0[2][2], B1[2][2];
    const char* cA = (const char*)g.A + (size_t)cur.pm * tstep; const char* cB = (const char*)g.Bt + (size_t)cur.pn * tstep;
    S.a_ready(cur);
    if constexpr (SP2) {
        PG8_STAGE(PG8_SB(0, 0), cB, voffB); PG8_STAGE(PG8_SB(0, 1), cB + hstep, voffB); PG8_STAGE(PG8_SA(0, 0), cA, voffA); PG8_STAGE(PG8_SA(0, 1), cA + hstep, voffA);
        if (wr == 1) PG8_BAR;
        PG8_WAIT_V(2); PG8_BAR;
        PG8_STAGE(PG8_SB(1, 0), cB + kstep, voffB); PG8_STAGE(PG8_SA(1, 0), cA + kstep, voffA); PG8_STAGE(PG8_SB(1, 1), cB + hstep + kstep, voffB);
        PG8_WAIT_V(6); PG8_BAR;
    } else {
        PG8_STAGE(PG8_SB(0, 0), cB, voffB); PG8_STAGE(PG8_SA(0, 0), cA, voffA); PG8_STAGE(PG8_SB(0, 1), cB + hstep, voffB); PG8_STAGE(PG8_SA(0, 1), cA + hstep, voffA);
        if (wr == 1) PG8_BAR;
        PG8_WAIT_V(4); PG8_BAR;
        PG8_STAGE(PG8_SB(1, 0), cB + kstep, voffB); PG8_STAGE(PG8_SA(1, 0), cA + kstep, voffA); PG8_STAGE(PG8_SB(1, 1), cB + hstep + kstep, voffB);
        PG8_WAIT_V(6); PG8_BAR;
    }
    for (;;) {
        const bool has_next = S.next(ui + 1, nxt);
        const char* nA = has_next ? (const char*)g.A + (size_t)nxt.pm * tstep : cA; const char* nB = has_next ? (const char*)g.Bt + (size_t)nxt.pn * tstep : cB;
        for (int t = 0; t < nt; t += 2) {
            const bool last = (t == nt - 2);
            const char* a1 = cA + (size_t)(t + 1) * kstep;
            const char* a2 = last ? nA : cA + (size_t)(t + 2) * kstep; const char* b2 = last ? nB : cB + (size_t)(t + 2) * kstep;
            const char* a3 = a2 + kstep; const char* b3 = b2 + kstep;
            if (last && has_next) S.a_ready(nxt);
            if constexpr (SP2) {
            PG8_LDB(B0, 0, 0); PG8_LDB(B1, 0, 1); PG8_SCHED; PG8_LDA(At, 0, 0); PG8_STAGE(PG8_SA(1, 1), a1 + hstep, voffA);
            PG8_WAIT_V(8); PG8_WAIT_L(0); PG8_BAR; PG8_MMA(0, 0, At, B0); PG8_MMA(0, 1, At, B1); PG8_BAR; PG8_SCHED;
            PG8_LDA(At, 0, 1); PG8_STAGE(PG8_SB(0, 0), b2, voffB); PG8_STAGE(PG8_SB(0, 1), b2 + hstep, voffB); PG8_STAGE(PG8_SA(0, 0), a2, voffA);
            PG8_WAIT_V(8); PG8_WAIT_L(0); PG8_BAR; PG8_MMA(1, 0, At, B0); PG8_MMA(1, 1, At, B1); PG8_BAR; PG8_SCHED;
            PG8_LDB(B0, 1, 0); PG8_LDB(B1, 1, 1); PG8_SCHED; PG8_LDA(At, 1, 0); PG8_STAGE(PG8_SA(0, 1), a2 + hstep, voffA);
            PG8_WAIT_V(8); PG8_WAIT_L(0); PG8_BAR; PG8_MMA(0, 0, At, B0); PG8_MMA(0, 1, At, B1); PG8_BAR; PG8_SCHED;
            PG8_LDA(At, 1, 1); PG8_STAGE(PG8_SB(1, 0), b3, voffB); PG8_STAGE(PG8_SB(1, 1), b3 + hstep, voffB); PG8_STAGE(PG8_SA(1, 0), a3, voffA);
            PG8_WAIT_V(8); PG8_WAIT_L(0); PG8_BAR; PG8_MMA(1, 0, At, B0); PG8_MMA(1, 1, At, B1); PG8_BAR; PG8_SCHED;
            } else {
            PG8_LDB(B0, 0, 0); PG8_SCHED; PG8_LDA(At, 0, 0); PG8_STAGE(PG8_SA(1, 1), a1 + hstep, voffA);
            PG8_WAIT_L(8); PG8_BAR; PG8_WAIT_L(0); PG8_MMA(0, 0, At, B0); PG8_BAR; PG8_SCHED;
            PG8_LDB(B1, 0, 1); PG8_STAGE(PG8_SB(0, 0), b2, voffB);
            PG8_BAR; PG8_WAIT_L(0); PG8_MMA(0, 1, At, B1); PG8_BAR;
            PG8_LDA(At, 0, 1); PG8_STAGE(PG8_SA(0, 0), a2, voffA);
            PG8_BAR; PG8_WAIT_L(0); PG8_MMA(1, 0, At, B0); PG8_BAR; PG8_SCHED;
            PG8_STAGE(PG8_SB(0, 1), b2 + hstep, voffB);
            PG8_WAIT_V(6); PG8_BAR; PG8_MMA(1, 1, At, B1); PG8_BAR;
            PG8_LDB(B0, 1, 0); PG8_SCHED; PG8_LDA(At, 1, 0); PG8_STAGE(PG8_SA(0, 1), a2 + hstep, voffA);
            PG8_WAIT_L(8); PG8_BAR; PG8_WAIT_L(0); PG8_MMA(0, 0, At, B0); PG8_BAR; PG8_SCHED;
            PG8_LDB(B1, 1, 1); PG8_STAGE(PG8_SB(1, 0), b3, voffB);
            PG8_BAR; PG8_WAIT_L(0); PG8_MMA(0, 1, At, B1); PG8_BAR;
            PG8_LDA(At, 1, 1); PG8_STAGE(PG8_SA(1, 0), a3, voffA);
            PG8_BAR; PG8_WAIT_L(0); PG8_MMA(1, 0, At, B0); PG8_BAR; PG8_SCHED;
            PG8_STAGE(PG8_SB(1, 1), b3 + hstep, voffB);
            PG8_WAIT_V(6); PG8_BAR; PG8_MMA(1, 1, At, B1); PG8_BAR;
            }
        }
        if constexpr (ALIGN_EPI) { if (wr == 0) PG8_BAR; }
        if constexpr (!Epi::AFTER_DRAIN) { E(acc, cur, wr, wc, fr, fq); S.done(cur); }
        if (!has_next) break;
#pragma unroll
        for (int a = 0; a < 2; ++a)
#pragma unroll
            for (int b = 0; b < 2; ++b)
#pragma unroll
                for (int m = 0; m < 4; ++m)
#pragma unroll
                    for (int n = 0; n < 2; ++n) acc[a][b][m][n] = (f32x4){0.f, 0.f, 0.f, 0.f};
        cur = nxt; cA = nA; cB = nB; ++ui;
        if constexpr (ALIGN_EPI) { if (wr == 1) PG8_BAR; }
    }
    PG8_WAIT_V(0);
    if constexpr (!ALIGN_EPI) { if (wr == 0) PG8_BAR; }
    PG8_BAR;
    if constexpr (Epi::AFTER_DRAIN) { E.fused(acc, cur, wr, wc, fr, fq, lds, wid, lane); S.done(cur); }
#undef PG8_SA
#undef PG8_SB
#undef PG8_STAGE
#undef PG8_LDA
#undef PG8_LDB
#undef PG8_MMA
#undef PG8_WAIT_V
#undef PG8_WAIT_L
#undef PG8_BAR
#undef PG8_SCHED
}
}

#define LAS __attribute__((address_space(3)))
typedef unsigned short bf16;
typedef unsigned v4u __attribute__((ext_vector_type(4)));
typedef unsigned v2u __attribute__((ext_vector_type(2)));
typedef float f32x4 __attribute__((ext_vector_type(4)));
constexpr int NWAVES = 8, NTHR = 512;
constexpr int D = 1024, NB = 8, SEQ = 2048, CTXL = 256, TL = NB * SEQ, TC = NB * CTXL, T = TL + TC;
constexpr int HYB_IN = 2208, HYB_INP = 2304, SSD_IN = 5184, SSD_INP = 5376, DFF = 2816, UPW = 5632;
constexpr int QW = 768, KVW = 1024, MODW = 6144;
constexpr float EPS = 1e-6f;
constexpr int NSTEP = 1 + 4 * 10;
constexpr float ATT_SCALE_LOG2E = 0.10206207261596577f * 1.4426950408889634f;

constexpr size_t MiB = 1u << 20;
constexpr size_t WS_CTL = 0, CTL_ZERO_BYTES = 64 * 1024;
constexpr size_t WS_MOD = 1 * MiB;
constexpr size_t WS_ROPE = 2 * MiB;
constexpr size_t W_UP = 3 * MiB;
constexpr size_t W_DN = W_UP + (size_t)UPW * D * 2;
constexpr size_t W_IN = W_DN + (size_t)D * DFF * 2;
constexpr size_t W_OUT = W_IN + (size_t)SSD_INP * D * 2;
constexpr size_t W_UQ = W_OUT + (size_t)D * 2048 * 2;
constexpr size_t W_UKV = W_UQ + (size_t)QW * 384 * 2;
constexpr size_t W_END = W_UKV + (size_t)KVW * 256 * 2;
constexpr size_t WS_XC = 36 * MiB;
constexpr size_t WS_H = 44 * MiB;
constexpr size_t WS_DT = WS_H, WS_AA = WS_H + (size_t)T * 64 * 4;
constexpr size_t WS_BIG = 80 * MiB;
constexpr size_t WS_M = WS_BIG;
constexpr size_t WS_P = WS_BIG;
constexpr size_t WS_Q = WS_BIG + 81 * MiB;
constexpr size_t WS_KV = WS_BIG + 108 * MiB;
constexpr size_t WS_KR = WS_BIG + 144 * MiB;
constexpr size_t WS_CQN = WS_BIG + 146 * MiB;
constexpr size_t WS_CKVN = WS_BIG + 160 * MiB;
constexpr size_t WS_MIX = WS_BIG + 170 * MiB;
constexpr size_t WS_U = WS_BIG;
constexpr size_t WS_G = WS_BIG + 198 * MiB;
constexpr size_t WS_ZX = WS_BIG;
constexpr size_t WS_XBC = WS_BIG + 189 * MiB;
constexpr size_t WS_END = WS_BIG + 297 * MiB;
static_assert(W_END <= WS_XC && WS_G + (size_t)T * DFF * 2 <= WS_END && WS_XBC + (size_t)T * 3072 * 2 <= WS_END && WS_ZX + (size_t)T * SSD_INP * 2 <= WS_XBC, "ws map");
static_assert(WS_AA + (size_t)T * 64 * 4 <= WS_BIG && WS_MIX + (size_t)T * D * 2 <= WS_END && WS_Q + (size_t)T * QW * 2 <= WS_KV && WS_P + (size_t)T * HYB_INP * 2 <= WS_Q, "ws map 2");
constexpr int LDS_BYTES = 147456;

struct Args { const float* in[25]; float* out; unsigned char* ws; int lo, hi; };
enum { I_X = 0, I_C, I_CTX, I_CCTX, I_MODW, I_MODB, I_NORMW, I_WUP, I_FCONV, I_WDN, I_HIN, I_QNORM, I_KVNORM, I_WUQ, I_WUKV, I_SCONV, I_HOUT, I_SIN, I_SCONVW, I_SCONVB, I_ALOG, I_DTB, I_SD, I_SNORM, I_SOUT };

__device__ __forceinline__ unsigned f2bf(float f) { unsigned u = __builtin_bit_cast(unsigned, f); return (u + 0x7fffu + ((u >> 16) & 1u)) >> 16; }
__device__ __forceinline__ unsigned pk2(float lo, float hi) { return f2bf(lo) | (f2bf(hi) << 16); }
__device__ __forceinline__ float bflo(unsigned u) { return __builtin_bit_cast(float, u << 16); }
__device__ __forceinline__ float bfhi(unsigned u) { return __builtin_bit_cast(float, u & 0xffff0000u); }
__device__ __forceinline__ float bf1(bf16 b) { return __builtin_bit_cast(float, (unsigned)b << 16); }
__device__ __forceinline__ float silu_f(float x) { return x / (1.f + __expf(-x)); }
__device__ __forceinline__ float wave_sum(float v, int lane) {
#pragma unroll
    for (int o = 1; o < 64; o <<= 1) v += shx(v, o, lane);
    return v;
}
__device__ __forceinline__ void unpack8(const v4u w, float (&f)[8]) { f[0] = bflo(w.x); f[1] = bfhi(w.x); f[2] = bflo(w.y); f[3] = bfhi(w.y); f[4] = bflo(w.z); f[5] = bfhi(w.z); f[6] = bflo(w.w); f[7] = bfhi(w.w); }
__device__ __forceinline__ v4u pack8(const float (&f)[8]) { v4u w; w.x = pk2(f[0], f[1]); w.y = pk2(f[2], f[3]); w.z = pk2(f[4], f[5]); w.w = pk2(f[6], f[7]); return w; }
__device__ __forceinline__ bool has_prev(int r) { return r < TL ? (r & (SEQ - 1)) != 0 : ((r - TL) & (CTXL - 1)) != 0; }
__device__ __forceinline__ bool has_next(int r) { return r < TL ? (r & (SEQ - 1)) != SEQ - 1 : ((r - TL) & (CTXL - 1)) != CTXL - 1; }

__device__ __forceinline__ void mod_compute(const Args& a, LAS unsigned char* lds) {
    LAS float* sc = (LAS float*)lds;
    LAS float* red = (LAS float*)(lds + 36864);
    const int tid = otid();
    float* MOD = (float*)(a.ws + WS_MOD);
    for (int i = tid; i < 9 * 1024; i += NTHR) { const int c = i >> 10, k = i & 1023; const float v = c < 8 ? a.in[I_C][c * 1024 + k] : a.in[I_CCTX][k]; sc[i] = silu_f(v); }
    __syncthreads();
    for (int item = blockIdx.x; item < 4 * 96; item += gridDim.x) {
        const int l = item / 96, cb = item % 96;
        const float* W = a.in[I_MODW] + (size_t)l * 1024 * MODW + cb * 64;
        const int cgp = tid & 15, kg = tid >> 4;
        float acc[9][4];
#pragma unroll
        for (int c = 0; c < 9; ++c) { acc[c][0] = 0.f; acc[c][1] = 0.f; acc[c][2] = 0.f; acc[c][3] = 0.f; }
#pragma unroll 4
        for (int kk = 0; kk < 32; ++kk) { const int k = kg * 32 + kk; const f32x4 w = *(const f32x4*)(W + (size_t)k * MODW + cgp * 4);
#pragma unroll
            for (int c = 0; c < 9; ++c) { const float s = sc[c * 1024 + k]; acc[c][0] += s * w[0]; acc[c][1] += s * w[1]; acc[c][2] += s * w[2]; acc[c][3] += s * w[3]; } }
#pragma unroll
        for (int c = 0; c < 9; ++c)
#pragma unroll
            for (int j = 0; j < 4; ++j) red[kg * 576 + c * 64 + cgp * 4 + j] = acc[c][j];
        __syncthreads();
        for (int o = tid; o < 576; o += NTHR) { float s = 0.f;
            for (int g = 0; g < 32; ++g) s += red[g * 576 + o];
            const int c = o >> 6, col = o & 63; MOD[(size_t)(l * 9 + c) * MODW + cb * 64 + col] = s + a.in[I_MODB][l * MODW + cb * 64 + col]; }
        __syncthreads();
    }
}
__device__ __forceinline__ void rope_tables(const Args& a) {
    float* ct = (float*)(a.ws + WS_ROPE); float* st = ct + SEQ * 16;
    for (int i = blockIdx.x * NTHR + otid(); i < SEQ * 16; i += gridDim.x * NTHR) {
        const int t = i >> 4, j = i & 15; const int pos = j < 8 ? (t >> 6) : (t & 63); const int f = j & 7;
        const float i0 = (f & 1) ? 0.31622776601683794f : 1.0f; const int e = f >> 1; const float i1 = e == 0 ? 1.0f : (e == 1 ? 0.1f : (e == 2 ? 0.01f : 0.001f));
        const float inv = i0 * i1; const float ang = (float)pos * inv;
        ct[i] = __cosf(ang); st[i] = __sinf(ang); }
}
__device__ __forceinline__ void transpose_item(const float* W, int K, int N, bf16* WT, LAS float* scr, int item, int lane) {
    const int nblk = N / 32, kb = item / nblk, nb = item % nblk, k0 = 64 * kb, n0 = 32 * nb;
#pragma unroll 8
    for (int i = 0; i < 32; ++i) { const int kk = 2 * i + (lane >> 5); scr[kk * 33 + (lane & 31)] = W[(size_t)(k0 + kk) * N + n0 + (lane & 31)]; }
    asm volatile("s_waitcnt lgkmcnt(0)" ::: "memory");
    const int c = lane & 7;
#pragma unroll
    for (int j = 0; j < 4; ++j) { const int n = (lane >> 3) + 8 * j; const LAS float* s = scr + (8 * c) * 33 + n;
        v4u o; o.x = pk2(s[0 * 33], s[1 * 33]); o.y = pk2(s[2 * 33], s[3 * 33]); o.z = pk2(s[4 * 33], s[5 * 33]); o.w = pk2(s[6 * 33], s[7 * 33]);
        *(v4u*)(WT + (size_t)(n0 + n) * K + k0 + 8 * c) = o; }
    asm volatile("s_waitcnt lgkmcnt(0)" ::: "memory");
}
__device__ __forceinline__ void convert_weight(const float* W, int K, int N, int Npad, bf16* WT, LAS unsigned char* lds, int rot) {
    const int wave = otid() >> 6, lane = otid() & 63; const int NGW = gridDim.x * NWAVES; const int gw = (blockIdx.x * NWAVES + wave + rot) % NGW;
    LAS float* scr = (LAS float*)(lds + wave * 16384);
    const int nitems = (K / 64) * (N / 32);
    for (int it = gw; it < nitems; it += NGW) transpose_item(W, K, N, WT, scr, it, lane);
    (void)Npad;
}
__device__ __forceinline__ void convert_layer(const Args& a, int l, LAS unsigned char* lds) {
    const int i = l >> 1; unsigned char* ws = a.ws;
    convert_weight(a.in[I_WUP] + (size_t)l * D * UPW, D, UPW, UPW, (bf16*)(ws + W_UP), lds, 0);
    convert_weight(a.in[I_WDN] + (size_t)l * DFF * D, DFF, D, D, (bf16*)(ws + W_DN), lds, 300);
    if ((l & 1) == 0) {
        convert_weight(a.in[I_HIN] + (size_t)i * D * HYB_IN, D, HYB_IN, HYB_INP, (bf16*)(ws + W_IN), lds, 700);
        convert_weight(a.in[I_HOUT] + (size_t)i * D * D, D, D, D, (bf16*)(ws + W_OUT), lds, 1100);
        convert_weight(a.in[I_WUQ] + (size_t)i * 384 * QW, 384, QW, QW, (bf16*)(ws + W_UQ), lds, 1500);
        convert_weight(a.in[I_WUKV] + (size_t)i * 256 * KVW, 256, KVW, KVW, (bf16*)(ws + W_UKV), lds, 1700);
    } else {
        convert_weight(a.in[I_SIN] + (size_t)i * D * SSD_IN, D, SSD_IN, SSD_INP, (bf16*)(ws + W_IN), lds, 700);
        convert_weight(a.in[I_SOUT] + (size_t)i * 2048 * D, 2048, D, D, (bf16*)(ws + W_OUT), lds, 1300);
    }
}

__device__ __forceinline__ void rowwise(const float* xs_lat, const float* xs_ctx, float* xd_lat, float* xd_ctx, const bf16* Mb, const float* modg  , const float* nwA,
                                        bf16* H, const float* modh  , int sh_off, int sc_off, const float* nwB, int nrows) {
    const int wave = otid() >> 6, lane = otid() & 63; const int NGW = gridDim.x * NWAVES, gw = blockIdx.x * NWAVES + wave;
    for (int r = gw; r < nrows; r += NGW) {
        const bool lat = r < TL; const int cond = lat ? (r >> 11) : 8;
        const float* xs = lat ? xs_lat + (size_t)r * D : xs_ctx + (size_t)(r - TL) * D;
        float* xd = lat ? xd_lat + (size_t)r * D : xd_ctx + (size_t)(r - TL) * D;
        f32x4 v[4];
#pragma unroll
        for (int j = 0; j < 4; ++j) v[j] = *(const f32x4*)(xs + j * 256 + lane * 4);
        if (Mb) {
            f32x4 m[4]; float ss = 0.f;
#pragma unroll
            for (int j = 0; j < 4; ++j) { const v2u w = *(const v2u*)(Mb + (size_t)r * D + j * 256 + lane * 4); m[j] = (f32x4){bflo(w.x), bfhi(w.x), bflo(w.y), bfhi(w.y)};
                ss += (m[j][0] * m[j][0] + m[j][1] * m[j][1]) + (m[j][2] * m[j][2] + m[j][3] * m[j][3]); }
            const float rs = rsqrtf(wave_sum(ss, lane) * (1.f / D) + EPS);
#pragma unroll
            for (int j = 0; j < 4; ++j) { const f32x4 g = *(const f32x4*)(modg + (size_t)cond * MODW + j * 256 + lane * 4); const f32x4 w = *(const f32x4*)(nwA + j * 256 + lane * 4);
                v[j] = v[j] + g * (m[j] * rs * w); }
        }
#pragma unroll
        for (int j = 0; j < 4; ++j) *(f32x4*)(xd + j * 256 + lane * 4) = v[j];
        if (H) {
            float ss = 0.f;
#pragma unroll
            for (int j = 0; j < 4; ++j) ss += (v[j][0] * v[j][0] + v[j][1] * v[j][1]) + (v[j][2] * v[j][2] + v[j][3] * v[j][3]);
            const float rs = rsqrtf(wave_sum(ss, lane) * (1.f / D) + EPS);
#pragma unroll
            for (int j = 0; j < 4; ++j) { const int c = j * 256 + lane * 4;
                const f32x4 w = *(const f32x4*)(nwB + c); const f32x4 sc = *(const f32x4*)(modh + (size_t)cond * MODW + sc_off + c); const f32x4 sh = *(const f32x4*)(modh + (size_t)cond * MODW + sh_off + c);
                const f32x4 h = (v[j] * rs * w) * (sc + 1.0f) + sh;
                v2u o; o.x = pk2(h[0], h[1]); o.y = pk2(h[2], h[3]); *(v2u*)(H + (size_t)r * D + c) = o; }
        }
    }
}

__device__ __forceinline__ void prep_even(const Args& a, int i) {
    const int wave = otid() >> 6, lane = otid() & 63; const int NGW = gridDim.x * NWAVES, gw = blockIdx.x * NWAVES + wave;
    const bf16* P = (const bf16*)(a.ws + WS_P); bf16* CQN = (bf16*)(a.ws + WS_CQN); bf16* CKVN = (bf16*)(a.ws + WS_CKVN); bf16* KR = (bf16*)(a.ws + WS_KR); bf16* MIX = (bf16*)(a.ws + WS_MIX);
    const float* qn = a.in[I_QNORM] + i * 384; const float* kvn = a.in[I_KVNORM] + i * 256; const float* cw = a.in[I_SCONV] + i * 3 * 512;
    const float* ct = (const float*)(a.ws + WS_ROPE); const float* st = ct + SEQ * 16;
    for (int r = gw; r < T; r += NGW) {
        const bf16* p = P + (size_t)r * HYB_INP;
        {
            const unsigned* p32 = (const unsigned*)(p + lane * 6); const unsigned w0 = p32[0], w1 = p32[1], w2 = p32[2];
            float f[6] = {bflo(w0), bfhi(w0), bflo(w1), bfhi(w1), bflo(w2), bfhi(w2)}; float ss = 0.f;
#pragma unroll
            for (int j = 0; j < 6; ++j) ss += f[j] * f[j];
            const float rs = rsqrtf(wave_sum(ss, lane) * (1.f / 384.f) + EPS);
#pragma unroll
            for (int j = 0; j < 6; ++j) f[j] = f[j] * rs * qn[lane * 6 + j];
            unsigned* o32 = (unsigned*)(CQN + (size_t)r * 384 + lane * 6); o32[0] = pk2(f[0], f[1]); o32[1] = pk2(f[2], f[3]); o32[2] = pk2(f[4], f[5]);
        }
        {
            const v2u w = *(const v2u*)(p + 384 + lane * 4); float f[4] = {bflo(w.x), bfhi(w.x), bflo(w.y), bfhi(w.y)};
            const float ss = (f[0] * f[0] + f[1] * f[1]) + (f[2] * f[2] + f[3] * f[3]);
            const float rs = rsqrtf(wave_sum(ss, lane) * (1.f / 256.f) + EPS);
            const f32x4 g = *(const f32x4*)(kvn + lane * 4);
            v2u o; o.x = pk2(f[0] * rs * g[0], f[1] * rs * g[1]); o.y = pk2(f[2] * rs * g[2], f[3] * rs * g[3]); *(v2u*)(CKVN + (size_t)r * 256 + lane * 4) = o;
        }
        {
            const int j = lane & 31; const float v = bf1(p[640 + j]); const float o = shx(v, 16, lane); float res = v;
            if (r < TL) { const int t = r & (SEQ - 1); const float c = ct[t * 16 + (j & 15)], s = st[t * 16 + (j & 15)]; res = (j < 16) ? v * c - o * s : o * s + v * c; }
            if (lane < 32) KR[(size_t)r * 32 + j] = (bf16)f2bf(res);
        }
        {
            const int c0 = lane * 8; float gb[8], cur[8], acc[8], t0[8], t1[8];
            unpack8(*(const v4u*)(p + 672 + c0), gb);
            unpack8(*(const v4u*)(p + 1184 + c0), t0); unpack8(*(const v4u*)(p + 1696 + c0), t1);
#pragma unroll
            for (int j = 0; j < 8; ++j) { cur[j] = t0[j] * t1[j]; acc[j] = cw[512 + c0 + j] * cur[j]; }
            if (has_prev(r)) { unpack8(*(const v4u*)(p - HYB_INP + 1184 + c0), t0); unpack8(*(const v4u*)(p - HYB_INP + 1696 + c0), t1);
#pragma unroll
                for (int j = 0; j < 8; ++j) acc[j] += cw[c0 + j] * (t0[j] * t1[j]); }
            if (has_next(r)) { unpack8(*(const v4u*)(p + HYB_INP + 1184 + c0), t0); unpack8(*(const v4u*)(p + HYB_INP + 1696 + c0), t1);
#pragma unroll
                for (int j = 0; j < 8; ++j) acc[j] += cw[1024 + c0 + j] * (t0[j] * t1[j]); }
#pragma unroll
            for (int j = 0; j < 8; ++j) acc[j] *= gb[j];
            *(v4u*)(MIX + (size_t)r * D + 512 + c0) = pack8(acc);
        }
    }
}

__device__ __forceinline__ void convgate(const Args& a, int l, int nrows) {
    const bf16* U = (const bf16*)(a.ws + WS_U); bf16* G = (bf16*)(a.ws + WS_G); const float* cw = a.in[I_FCONV] + (size_t)l * 3 * UPW;
    const int total = nrows * (DFF / 8);
    for (int idx = blockIdx.x * NTHR + otid(); idx < total; idx += gridDim.x * NTHR) {
        const int r = idx / (DFF / 8), c0 = (idx % (DFF / 8)) * 8; const bf16* u = U + (size_t)r * UPW + c0;
        float ua[8], ug[8], act[8], gate[8];
        unpack8(*(const v4u*)u, ua); unpack8(*(const v4u*)(u + DFF), ug);
#pragma unroll
        for (int j = 0; j < 8; ++j) { act[j] = cw[UPW + c0 + j] * ua[j]; gate[j] = cw[UPW + DFF + c0 + j] * ug[j]; }
        if (has_prev(r)) { unpack8(*(const v4u*)(u - UPW), ua); unpack8(*(const v4u*)(u - UPW + DFF), ug);
#pragma unroll
            for (int j = 0; j < 8; ++j) { act[j] += cw[c0 + j] * ua[j]; gate[j] += cw[DFF + c0 + j] * ug[j]; } }
        if (has_next(r)) { unpack8(*(const v4u*)(u + UPW), ua); unpack8(*(const v4u*)(u + UPW + DFF), ug);
#pragma unroll
            for (int j = 0; j < 8; ++j) { act[j] += cw[2 * UPW + c0 + j] * ua[j]; gate[j] += cw[2 * UPW + DFF + c0 + j] * ug[j]; } }
#pragma unroll
        for (int j = 0; j < 8; ++j) act[j] = silu_f(act[j]) * gate[j];
        *(v4u*)(G + (size_t)r * DFF + c0) = pack8(act);
    }
}

__device__ __forceinline__ void ssd_conv(const Args& a, int i) {
    const bf16* ZX = (const bf16*)(a.ws + WS_ZX); bf16* XBC = (bf16*)(a.ws + WS_XBC); float* DT = (float*)(a.ws + WS_DT); float* AA = (float*)(a.ws + WS_AA);
    const float* cw = a.in[I_SCONVW] + (size_t)i * 3 * 3072; const float* cb = a.in[I_SCONVB] + (size_t)i * 3072;
    const int total = T * 384;
    for (int idx = blockIdx.x * NTHR + otid(); idx < total; idx += gridDim.x * NTHR) {
        const int r = idx / 384, c0 = (idx % 384) * 8; const bf16* u = ZX + (size_t)r * SSD_INP + 2048 + c0;
        float x[8], acc[8];
        unpack8(*(const v4u*)u, x);
#pragma unroll
        for (int j = 0; j < 8; ++j) acc[j] = cb[c0 + j] + cw[3072 + c0 + j] * x[j];
        if (has_prev(r)) { unpack8(*(const v4u*)(u - SSD_INP), x);
#pragma unroll
            for (int j = 0; j < 8; ++j) acc[j] += cw[c0 + j] * x[j]; }
        if (has_next(r)) { unpack8(*(const v4u*)(u + SSD_INP), x);
#pragma unroll
            for (int j = 0; j < 8; ++j) acc[j] += cw[2 * 3072 + c0 + j] * x[j]; }
#pragma unroll
        for (int j = 0; j < 8; ++j) acc[j] = silu_f(acc[j]);
        *(v4u*)(XBC + (size_t)r * 3072 + c0) = pack8(acc);
    }
    const float* alog = a.in[I_ALOG] + i * 64; const float* dtb = a.in[I_DTB] + i * 64;
    for (int idx = blockIdx.x * NTHR + otid(); idx < T * 64; idx += gridDim.x * NTHR) {
        const int r = idx >> 6, j = idx & 63; const float raw = bf1(ZX[(size_t)r * SSD_INP + 5120 + j]) + dtb[j];
        const float dt = raw > 15.f ? raw : (raw < -15.f ? __expf(raw) : __logf(1.f + __expf(raw)));
        DT[idx] = dt; AA[idx] = -__expf(alog[j]) * dt;
    }
}

__device__ __forceinline__ void gatenorm(const Args& a, int i, int nrows) {
    const int wave = otid() >> 6, lane = otid() & 63; const int NGW = gridDim.x * NWAVES, gw = blockIdx.x * NWAVES + wave;
    const bf16* ZX = (const bf16*)(a.ws + WS_ZX); bf16* YN = (bf16*)(a.ws + WS_XBC); const float* nw = a.in[I_SNORM] + i * 2048;
    for (int r = gw; r < nrows; r += NGW) {
        float v[4][8]; float ss = 0.f;
#pragma unroll
        for (int j = 0; j < 4; ++j) { float y[8], z[8]; const int c = j * 512 + lane * 8;
            unpack8(*(const v4u*)(ZX + (size_t)r * SSD_INP + 2048 + c), y); unpack8(*(const v4u*)(ZX + (size_t)r * SSD_INP + c), z);
#pragma unroll
            for (int k = 0; k < 8; ++k) { v[j][k] = y[k] * silu_f(z[k]); ss += v[j][k] * v[j][k]; } }
        const float rs = rsqrtf(wave_sum(ss, lane) * (1.f / 2048.f) + EPS);
#pragma unroll
        for (int j = 0; j < 4; ++j) { const int c = j * 512 + lane * 8; float o[8];
#pragma unroll
            for (int k = 0; k < 8; ++k) o[k] = v[j][k] * rs * nw[c + k];
            *(v4u*)(YN + (size_t)r * 2048 + c) = pack8(o); }
    }
}

__device__ __forceinline__ void attn_naive(const Args& a, LAS unsigned char* lds) {
    const int tid = otid(), qi = tid >> 1, half = tid & 1;
    const bf16* Qb = (const bf16*)(a.ws + WS_Q); const bf16* KVb = (const bf16*)(a.ws + WS_KV); const bf16* KR = (const bf16*)(a.ws + WS_KR); bf16* MIX = (bf16*)(a.ws + WS_MIX);
    const float* ct = (const float*)(a.ws + WS_ROPE); const float* st = ct + SEQ * 16;
    LAS float* Kt = (LAS float*)lds;
    LAS float* Vt = (LAS float*)(lds + 64 * 96 * 4);
    for (int u = blockIdx.x; u < 576; u += gridDim.x) {
        const bool lat = u < 512; const int b = lat ? (u >> 6) : ((u - 512) >> 3), h = lat ? ((u >> 3) & 7) : ((u - 512) & 7);
        const int nkeys = lat ? (CTXL + SEQ) : CTXL;
        const int qrow = lat ? b * SEQ + (u & 7) * 256 + qi : TL + b * CTXL + qi;
        float q[48];
#pragma unroll
        for (int g = 0; g < 6; ++g) { float f[8]; unpack8(*(const v4u*)(Qb + (size_t)qrow * QW + h * 96 + half * 48 + g * 8), f);
#pragma unroll
            for (int j = 0; j < 8; ++j) q[g * 8 + j] = f[j]; }
        if (lat && half == 1) { const int t = qrow & (SEQ - 1);
#pragma unroll
            for (int j = 0; j < 16; ++j) { const float c = ct[t * 16 + j], s = st[t * 16 + j]; const float x1 = q[16 + j], x2 = q[32 + j]; q[16 + j] = x1 * c - x2 * s; q[32 + j] = x1 * s + x2 * c; } }
#pragma unroll
        for (int j = 0; j < 48; ++j) q[j] *= ATT_SCALE_LOG2E;
        float o[32]; float m = -1e30f, l = 0.f;
#pragma unroll
        for (int j = 0; j < 32; ++j) o[j] = 0.f;
        for (int k0 = 0; k0 < nkeys; k0 += 64) {
            __syncthreads();
            for (int g = tid; g < 768; g += NTHR) { const int key = g / 12, part = g % 12; const int kk = k0 + key; const int krow = kk < CTXL ? TL + b * CTXL + kk : b * SEQ + kk - CTXL;
                float f[8]; unpack8(part < 8 ? *(const v4u*)(KVb + (size_t)krow * KVW + h * 128 + part * 8) : *(const v4u*)(KR + (size_t)krow * 32 + (part - 8) * 8), f);
#pragma unroll
                for (int j = 0; j < 8; ++j) Kt[key * 96 + part * 8 + j] = f[j]; }
            { const int key = tid >> 3, part = tid & 7; const int kk = k0 + key; const int krow = kk < CTXL ? TL + b * CTXL + kk : b * SEQ + kk - CTXL;
                float f[8]; unpack8(*(const v4u*)(KVb + (size_t)krow * KVW + h * 128 + 64 + part * 8), f);
#pragma unroll
                for (int j = 0; j < 8; ++j) Vt[key * 64 + part * 8 + j] = f[j]; }
            __syncthreads();
            for (int kg = 0; kg < 64; kg += 8) {
                float s[8]; float gm = -1e30f;
#pragma unroll
                for (int kk = 0; kk < 8; ++kk) { float acc = 0.f; const LAS f32x4* kp = (const LAS f32x4*)(Kt + (kg + kk) * 96 + half * 48);
#pragma unroll
                    for (int d4 = 0; d4 < 12; ++d4) { const f32x4 kv = kp[d4]; acc += q[d4 * 4] * kv[0] + q[d4 * 4 + 1] * kv[1] + q[d4 * 4 + 2] * kv[2] + q[d4 * 4 + 3] * kv[3]; }
                    acc += shx(acc, 1, tid & 63);
                    s[kk] = acc; gm = fmaxf(gm, acc); }
                const float mn = fmaxf(m, gm); const float alpha = exp2f(m - mn); m = mn; l *= alpha;
#pragma unroll
                for (int j = 0; j < 32; ++j) o[j] *= alpha;
#pragma unroll
                for (int kk = 0; kk < 8; ++kk) { const float p = exp2f(s[kk] - mn); l += p; const LAS f32x4* vp = (const LAS f32x4*)(Vt + (kg + kk) * 64 + half * 32);
#pragma unroll
                    for (int d4 = 0; d4 < 8; ++d4) { const f32x4 vv = vp[d4]; o[d4 * 4] += p * vv[0]; o[d4 * 4 + 1] += p * vv[1]; o[d4 * 4 + 2] += p * vv[2]; o[d4 * 4 + 3] += p * vv[3]; } }
            }
        }
        { const float inv = 1.f / l;
#pragma unroll
            for (int g = 0; g < 4; ++g) { float f[8];
#pragma unroll
                for (int j = 0; j < 8; ++j) f[j] = o[g * 8 + j] * inv;
                *(v4u*)(MIX + (size_t)qrow * D + h * 64 + half * 32 + g * 8) = pack8(f); } }
    }
}

__device__ __forceinline__ void ssd_scan_naive(const Args& a, int i, bool last, LAS unsigned char* lds) {
    const int tid = otid(), p = tid >> 3, nq = tid & 7;
    bf16* ZX = (bf16*)(a.ws + WS_ZX); const bf16* XBC = (const bf16*)(a.ws + WS_XBC); const float* DT = (const float*)(a.ws + WS_DT); const float* AA = (const float*)(a.ws + WS_AA);
    LAS float* xs = (LAS float*)lds;
    LAS float* Bs = (LAS float*)(lds + 16384);
    LAS float* Cs = (LAS float*)(lds + 16384 + 32768);
    LAS float* dts = (LAS float*)(lds + 16384 + 65536);
    LAS float* as = dts + 64;
    for (int it = blockIdx.x; it < NB * 32; it += gridDim.x) {
        const int b = it >> 5, h = it & 31, g = h >> 3; const float dsk = a.in[I_SD][i * 32 + h];
        for (int dir = 0; dir < 2; ++dir) {
            float stt[16];
#pragma unroll
            for (int n = 0; n < 16; ++n) stt[n] = 0.f;
            for (int seg = 0; seg < 2; ++seg) {
                const int len = seg == 0 ? CTXL : SEQ; const int base = seg == 0 ? TL + b * CTXL : b * SEQ; const bool want_y = !(last && seg == 0);
                for (int cc = 0; cc < len / 64; ++cc) {
                    const int t0 = dir == 0 ? cc * 64 : len - 64 - cc * 64;
                    __syncthreads();
                    { const int tt = tid >> 3, part = tid & 7; float f[8]; unpack8(*(const v4u*)(XBC + (size_t)(base + t0 + tt) * 3072 + h * 64 + part * 8), f);
#pragma unroll
                        for (int j = 0; j < 8; ++j) xs[tt * 64 + part * 8 + j] = f[j]; }
                    for (int q = tid; q < 1024; q += NTHR) { const int tt = q >> 4, part = q & 15; float f[8];
                        unpack8(*(const v4u*)(XBC + (size_t)(base + t0 + tt) * 3072 + 2048 + g * 128 + part * 8), f);
#pragma unroll
                        for (int j = 0; j < 8; ++j) Bs[tt * 128 + part * 8 + j] = f[j];
                        unpack8(*(const v4u*)(XBC + (size_t)(base + t0 + tt) * 3072 + 2560 + g * 128 + part * 8), f);
#pragma unroll
                        for (int j = 0; j < 8; ++j) Cs[tt * 128 + part * 8 + j] = f[j]; }
                    if (tid < 64) { dts[tid] = DT[(size_t)(base + t0 + tid) * 64 + dir * 32 + h]; as[tid] = AA[(size_t)(base + t0 + tid) * 64 + dir * 32 + h]; }
                    __syncthreads();
                    for (int s = 0; s < 64; ++s) {
                        const int tt = dir == 0 ? s : 63 - s;
                        const float dec = __expf(as[tt]); const float xv = xs[tt * 64 + p]; const float xd = xv * dts[tt];
                        const LAS f32x4* bp = (const LAS f32x4*)(Bs + tt * 128 + nq * 16); const LAS f32x4* cp = (const LAS f32x4*)(Cs + tt * 128 + nq * 16);
                        float acc = 0.f;
#pragma unroll
                        for (int n4 = 0; n4 < 4; ++n4) { const f32x4 bv = bp[n4], cv = cp[n4];
#pragma unroll
                            for (int k = 0; k < 4; ++k) { stt[n4 * 4 + k] = dec * stt[n4 * 4 + k] + xd * bv[k]; acc += cv[k] * stt[n4 * 4 + k]; } }
                        acc += shx(acc, 1, tid & 63); acc += shx(acc, 2, tid & 63); acc += shx(acc, 4, tid & 63);
                        if (want_y && nq == 0) { bf16* yp = ZX + (size_t)(base + t0 + tt) * SSD_INP + 2048 + h * 64 + p;
                            const float y = dir == 0 ? acc + dsk * xv : acc + bf1(*yp);
                            *yp = (bf16)f2bf(y); }
                    }
                }
            }
            __syncthreads();
            asm volatile("s_waitcnt vmcnt(0)" ::: "memory");
        }
    }
}

typedef short bf16x8 __attribute__((ext_vector_type(8)));
typedef float f32x16 __attribute__((ext_vector_type(16)));
__device__ __forceinline__ unsigned cvtpk(float lo, float hi) { unsigned r; asm volatile("v_cvt_pk_bf16_f32 %0, %1, %2" : "=v"(r) : "v"(lo), "v"(hi)); return r; }
constexpr int ATT_KP = 208, ATT_VP = 136, ATT_KB = 64 * ATT_KP, ATT_VB = 64 * ATT_VP, ATT_BUF = ATT_KB + ATT_VB;
__device__ __forceinline__ void attn_mfma(const Args& a, LAS unsigned char* lds) {
    const int tid = otid(), wave = tid >> 6, lane = tid & 63, r32 = lane & 31, hh = lane >> 5;
    const bf16* Qb = (const bf16*)(a.ws + WS_Q); const bf16* KVb = (const bf16*)(a.ws + WS_KV); const bf16* KR = (const bf16*)(a.ws + WS_KR); bf16* MIX = (bf16*)(a.ws + WS_MIX);
    const float* ct = (const float*)(a.ws + WS_ROPE); const float* st = ct + SEQ * 16;
    const int kkey0 = tid / 12, kpart0 = tid % 12, kkey1 = (tid + NTHR) / 12, kpart1 = (tid + NTHR) % 12; const bool k1ok = tid + NTHR < 768;
    for (int u = blockIdx.x; u < 576; u += gridDim.x) {
        const bool lat = u < 512; const int b = lat ? (u >> 6) : ((u - 512) >> 3), h = lat ? ((u >> 3) & 7) : ((u - 512) & 7);
        const int ntiles = lat ? (CTXL + SEQ) / 64 : CTXL / 64;
        const int qrow = (lat ? b * SEQ + (u & 7) * 256 : TL + b * CTXL) + wave * 32 + r32;
        bf16x8 qf[6];
#pragma unroll
        for (int s = 0; s < 6; ++s) qf[s] = *(const bf16x8*)(Qb + (size_t)qrow * QW + h * 96 + 16 * s + 8 * hh);
        if (lat) { const int t = qrow & (SEQ - 1);
#pragma unroll
            for (int j = 0; j < 8; j += 2) { float x1[2], x2[2], y1[2], y2[2];
#pragma unroll
                for (int e = 0; e < 2; ++e) { x1[e] = bf1((bf16)qf[4][j + e]); x2[e] = bf1((bf16)qf[5][j + e]); const float c = ct[t * 16 + 8 * hh + j + e], s = st[t * 16 + 8 * hh + j + e];
                    y1[e] = x1[e] * c - x2[e] * s; y2[e] = x1[e] * s + x2[e] * c; }
                const unsigned w1 = pk2(y1[0], y1[1]), w2 = pk2(y2[0], y2[1]);
                qf[4][j] = (short)(w1 & 0xffff); qf[4][j + 1] = (short)(w1 >> 16); qf[5][j] = (short)(w2 & 0xffff); qf[5][j + 1] = (short)(w2 >> 16); } }
        f32x16 o0, o1;
#pragma unroll
        for (int i = 0; i < 16; ++i) { o0[i] = 0.f; o1[i] = 0.f; }
        float m = -1e30f, l = 0.f;
        v4u kreg0, kreg1, vreg;
        const bf16* kp0 = kpart0 < 8 ? KVb + (size_t)kkey0 * KVW + h * 128 + kpart0 * 8 : KR + (size_t)kkey0 * 32 + (kpart0 - 8) * 8; const int ks0 = kpart0 < 8 ? KVW : 32;
        const bf16* kp1 = kpart1 < 8 ? KVb + (size_t)kkey1 * KVW + h * 128 + kpart1 * 8 : KR + (size_t)kkey1 * 32 + (kpart1 - 8) * 8; const int ks1 = kpart1 < 8 ? KVW : 32;
        const bf16* vp0 = KVb + (size_t)lane * KVW + h * 128 + 64 + wave * 8;
#define ATT_LOAD(it) do { const int rb_ = (it) < CTXL / 64 ? TL + b * CTXL + (it) * 64 : b * SEQ + ((it) - CTXL / 64) * 64; \
            kreg0 = *(const v4u*)(kp0 + (size_t)rb_ * ks0); if (k1ok) kreg1 = *(const v4u*)(kp1 + (size_t)rb_ * ks1); vreg = *(const v4u*)(vp0 + (size_t)rb_ * KVW); } while (0)
#define ATT_WRITE(buf) do { LAS unsigned char* kb_ = lds + (buf) * ATT_BUF; LAS unsigned char* vb_ = kb_ + ATT_KB; \
            *(LAS v4u*)(kb_ + kkey0 * ATT_KP + kpart0 * 16) = kreg0; if (k1ok) *(LAS v4u*)(kb_ + kkey1 * ATT_KP + kpart1 * 16) = kreg1; \
            { LAS unsigned short* vp = (LAS unsigned short*)(vb_ + (wave * 8) * ATT_VP + lane * 2); \
              vp[0 * (ATT_VP / 2)] = (unsigned short)(vreg.x & 0xffff); vp[1 * (ATT_VP / 2)] = (unsigned short)(vreg.x >> 16); vp[2 * (ATT_VP / 2)] = (unsigned short)(vreg.y & 0xffff); vp[3 * (ATT_VP / 2)] = (unsigned short)(vreg.y >> 16); \
              vp[4 * (ATT_VP / 2)] = (unsigned short)(vreg.z & 0xffff); vp[5 * (ATT_VP / 2)] = (unsigned short)(vreg.z >> 16); vp[6 * (ATT_VP / 2)] = (unsigned short)(vreg.w & 0xffff); vp[7 * (ATT_VP / 2)] = (unsigned short)(vreg.w >> 16); } } while (0)
        __syncthreads();
        ATT_LOAD(0); ATT_WRITE(0);
        __syncthreads();
        for (int it = 0; it < ntiles; ++it) {
            if (it + 1 < ntiles) ATT_LOAD(it + 1);
            const LAS unsigned char* kb = lds + (it & 1) * ATT_BUF; const LAS unsigned char* vb = kb + ATT_KB;
            f32x16 s0, s1;
#pragma unroll
            for (int i = 0; i < 16; ++i) { s0[i] = 0.f; s1[i] = 0.f; }
#pragma unroll
            for (int s = 0; s < 6; ++s) { const bf16x8 a0 = *(const LAS bf16x8*)(kb + r32 * ATT_KP + (16 * s + 8 * hh) * 2); const bf16x8 a1 = *(const LAS bf16x8*)(kb + (32 + r32) * ATT_KP + (16 * s + 8 * hh) * 2);
                s0 = __builtin_amdgcn_mfma_f32_32x32x16_bf16(a0, qf[s], s0, 0, 0, 0); s1 = __builtin_amdgcn_mfma_f32_32x32x16_bf16(a1, qf[s], s1, 0, 0, 0); }
            float mx = s0[0];
#pragma unroll
            for (int i = 1; i < 16; ++i) mx = fmaxf(mx, s0[i]);
#pragma unroll
            for (int i = 0; i < 16; ++i) mx = fmaxf(mx, s1[i]);
            mx = fmaxf(mx, shx(mx, 32, lane));
            const float mn = fmaxf(m, mx * ATT_SCALE_LOG2E); const float alpha = __builtin_amdgcn_exp2f(m - mn); m = mn;
            float rs = 0.f;
#pragma unroll
            for (int i = 0; i < 16; ++i) { s0[i] = __builtin_amdgcn_exp2f(s0[i] * ATT_SCALE_LOG2E - mn); s1[i] = __builtin_amdgcn_exp2f(s1[i] * ATT_SCALE_LOG2E - mn); rs += s0[i] + s1[i]; }
            l = l * alpha + rs;
#pragma unroll
            for (int i = 0; i < 16; ++i) { o0[i] *= alpha; o1[i] *= alpha; }
            bf16x8 pf[2][2];
#pragma unroll
            for (int s2 = 0; s2 < 2; ++s2) { v4u w0, w1;
                w0.x = cvtpk(s0[8 * s2 + 0], s0[8 * s2 + 1]); w0.y = cvtpk(s0[8 * s2 + 2], s0[8 * s2 + 3]); w0.z = cvtpk(s0[8 * s2 + 4], s0[8 * s2 + 5]); w0.w = cvtpk(s0[8 * s2 + 6], s0[8 * s2 + 7]);
                w1.x = cvtpk(s1[8 * s2 + 0], s1[8 * s2 + 1]); w1.y = cvtpk(s1[8 * s2 + 2], s1[8 * s2 + 3]); w1.z = cvtpk(s1[8 * s2 + 4], s1[8 * s2 + 5]); w1.w = cvtpk(s1[8 * s2 + 6], s1[8 * s2 + 7]);
                pf[0][s2] = __builtin_bit_cast(bf16x8, w0); pf[1][s2] = __builtin_bit_cast(bf16x8, w1); }
#pragma unroll
            for (int t = 0; t < 2; ++t)
#pragma unroll
                for (int s2 = 0; s2 < 2; ++s2) { const int ko = t * 32 + 16 * s2 + 4 * hh;
                    { const v2u lo = *(const LAS v2u*)(vb + r32 * ATT_VP + ko * 2); const v2u hi = *(const LAS v2u*)(vb + r32 * ATT_VP + (ko + 8) * 2);
                      const v4u w = (v4u){lo.x, lo.y, hi.x, hi.y}; o0 = __builtin_amdgcn_mfma_f32_32x32x16_bf16(__builtin_bit_cast(bf16x8, w), pf[t][s2], o0, 0, 0, 0); }
                    { const v2u lo = *(const LAS v2u*)(vb + (32 + r32) * ATT_VP + ko * 2); const v2u hi = *(const LAS v2u*)(vb + (32 + r32) * ATT_VP + (ko + 8) * 2);
                      const v4u w = (v4u){lo.x, lo.y, hi.x, hi.y}; o1 = __builtin_amdgcn_mfma_f32_32x32x16_bf16(__builtin_bit_cast(bf16x8, w), pf[t][s2], o1, 0, 0, 0); } }
            if (it + 1 < ntiles) ATT_WRITE((it + 1) & 1);
            __syncthreads();
        }
#undef ATT_LOAD
#undef ATT_WRITE
        l += shx(l, 32, lane); const float inv = 1.f / l;
        bf16* orow = MIX + (size_t)qrow * D + h * 64 + 4 * hh;
#pragma unroll
        for (int g = 0; g < 4; ++g) {
            v2u w; w.x = pk2(o0[4 * g] * inv, o0[4 * g + 1] * inv); w.y = pk2(o0[4 * g + 2] * inv, o0[4 * g + 3] * inv); *(v2u*)(orow + 8 * g) = w;
            v2u x; x.x = pk2(o1[4 * g] * inv, o1[4 * g + 1] * inv); x.y = pk2(o1[4 * g + 2] * inv, o1[4 * g + 3] * inv); *(v2u*)(orow + 32 + 8 * g) = x; }
    }
}

typedef short v4i16_t __attribute__((ext_vector_type(4)));
__device__ __forceinline__ v2u trread(const LAS unsigned char* p) { return __builtin_bit_cast(v2u, __builtin_amdgcn_ds_read_tr16_b64_v4i16((LAS v4i16_t*)p)); }
constexpr int SP_B = 272, SP_X = 192;
constexpr int SO_B = 0, SO_C = SO_B + 128 * SP_B, SO_XD = SO_C + 128 * SP_B, SO_XW = SO_XD + 128 * SP_X, SO_S = SO_XW + 128 * SP_X, SO_V = SO_S + 64 * SP_B;
static_assert(SO_V + 2 * 2048 <= LDS_BYTES, "ssd lds map");
__device__ __forceinline__ void ssd_scan_mfma(const Args& a, int i, bool last, LAS unsigned char* lds) {
    const int tid = otid(), wave = tid >> 6, lane = tid & 63, r32 = lane & 31, hh = lane >> 5;
    const int pt = wave & 1, lt = wave >> 1;
    const int tq = (lane >> 2) & 3, tp = lane & 3, tblk = (lane >> 4) & 1;
    bf16* ZX = (bf16*)(a.ws + WS_ZX); const bf16* XBC = (const bf16*)(a.ws + WS_XBC); const float* DT = (const float*)(a.ws + WS_DT); const float* AA = (const float*)(a.ws + WS_AA);
    LAS unsigned char* Bl = lds + SO_B; LAS unsigned char* Cl = lds + SO_C; LAS unsigned char* XDl = lds + SO_XD; LAS unsigned char* XWl = lds + SO_XW; LAS unsigned char* Sl = lds + SO_S;
    const int brow = tid >> 4, bpart = tid & 15, xrow = tid >> 3, xpart = tid & 7;
    for (int it = blockIdx.x; it < NB * 32; it += gridDim.x) {
        const int b = it >> 5, h = it & 31, g = h >> 3; const float dsk = a.in[I_SD][i * 32 + h];
        for (int dir = 0; dir < 2; ++dir) {
            f32x16 sacc;
#pragma unroll
            for (int k = 0; k < 16; ++k) sacc[k] = 0.f;
            v4u bq[4], cq[4], xq[2]; float pa0 = 0.f, pa1 = 0.f, pd0 = 0.f, pd1 = 0.f;
#define SSD_ROWBASE(c) ((c) < 2 ? TL + b * CTXL + (dir == 0 ? (c) : 1 - (c)) * 128 : b * SEQ + (dir == 0 ? (c) - 2 : 17 - (c)) * 128)
#define SSD_PF(c) do { const int rb_ = SSD_ROWBASE(c); \
                _Pragma("unroll") for (int k_ = 0; k_ < 4; ++k_) { const bf16* src_ = XBC + (size_t)(rb_ + brow + 32 * k_) * 3072 + 2048 + g * 128 + bpart * 8; bq[k_] = *(const v4u*)src_; cq[k_] = *(const v4u*)(src_ + 512); } \
                _Pragma("unroll") for (int k_ = 0; k_ < 2; ++k_) xq[k_] = *(const v4u*)(XBC + (size_t)(rb_ + xrow + 64 * k_) * 3072 + h * 64 + xpart * 8); \
                if (wave == 0) { const size_t o_ = (size_t)(rb_ + 2 * lane) * 64 + dir * 32 + h; pa0 = AA[o_]; pa1 = AA[o_ + 64]; pd0 = DT[o_]; pd1 = DT[o_ + 64]; } } while (0)
#define SSD_SCAN(vb_) do { if (wave == 0) { LAS float* V_ = (LAS float*)(lds + SO_V + (vb_) * 2048); const float pair_ = pa0 + pa1; float ps_ = pair_; \
                _Pragma("unroll") for (int d_ = 1; d_ < 64; d_ <<= 1) { const int src_ = dir == 0 ? lane - d_ : lane + d_; const float t_ = __builtin_bit_cast(float, __builtin_amdgcn_ds_bpermute((src_ & 63) << 2, __builtin_bit_cast(int, ps_))); if (src_ >= 0 && src_ < 64) ps_ += t_; } \
                const float tot_ = __builtin_bit_cast(float, __builtin_amdgcn_ds_bpermute((dir == 0 ? 63 : 0) << 2, __builtin_bit_cast(int, ps_))); const float ex_ = ps_ - pair_; \
                float c0_, c1_; if (dir == 0) { c0_ = ex_ + pa0; c1_ = c0_ + pa1; } else { c1_ = ex_ + pa1; c0_ = c1_ + pa0; } \
                V_[2 * lane] = c0_; V_[2 * lane + 1] = c1_; V_[128 + 2 * lane] = pd0; V_[128 + 2 * lane + 1] = pd1; V_[256 + 2 * lane] = pd0 * __expf(tot_ - c0_); V_[256 + 2 * lane + 1] = pd1 * __expf(tot_ - c1_); \
                if (lane == 0) V_[384] = tot_; } } while (0)
#define SSD_WRITE(vb_) do { const LAS float* V_ = (const LAS float*)(lds + SO_V + (vb_) * 2048); \
                _Pragma("unroll") for (int k_ = 0; k_ < 4; ++k_) { *(LAS v4u*)(Bl + (brow + 32 * k_) * SP_B + bpart * 16) = bq[k_]; *(LAS v4u*)(Cl + (brow + 32 * k_) * SP_B + bpart * 16) = cq[k_]; } \
                _Pragma("unroll") for (int k_ = 0; k_ < 2; ++k_) { const int s_ = xrow + 64 * k_; const float dt_ = V_[128 + s_], w_ = V_[256 + s_]; float f_[8], g_[8]; unpack8(xq[k_], f_); \
                    _Pragma("unroll") for (int j_ = 0; j_ < 8; ++j_) { g_[j_] = f_[j_] * w_; f_[j_] *= dt_; } \
                    *(LAS v4u*)(XDl + s_ * SP_X + xpart * 16) = pack8(f_); *(LAS v4u*)(XWl + s_ * SP_X + xpart * 16) = pack8(g_); } } while (0)
            __syncthreads();
            SSD_PF(0); SSD_SCAN(0);
            __syncthreads();
            SSD_WRITE(0);
            { LAS v2u* sp = (LAS v2u*)(Sl + (32 * pt + r32) * SP_B + (32 * lt + 4 * hh) * 2);
#pragma unroll
              for (int q = 0; q < 4; ++q) sp[2 * q] = (v2u){0u, 0u}; }
            __syncthreads();
            for (int c = 0; c < 18; ++c) {
                const int cur = c & 1; const LAS float* V = (const LAS float*)(lds + SO_V + cur * 2048);
                const int rowbase = SSD_ROWBASE(c); const bool want_y = !(last && c < 2);
                if (c + 1 < 18) SSD_PF(c + 1);
                if (want_y) {
                    const int l = 32 * lt + r32; const float cl = V[l];
                    bf16* yptr = ZX + (size_t)(rowbase + l) * SSD_INP + 2048 + h * 64 + 32 * pt + 4 * hh;
                    const bf16* xptr = XBC + (size_t)(rowbase + l) * 3072 + h * 64 + 32 * pt + 4 * hh;
                    v2u add[4];
#pragma unroll
                    for (int q = 0; q < 4; ++q) add[q] = dir == 0 ? *(const v2u*)(xptr + 8 * q) : *(const v2u*)(yptr + 8 * q);
                    bf16x8 cf[8];
#pragma unroll
                    for (int ks = 0; ks < 8; ++ks) cf[ks] = *(const LAS bf16x8*)(Cl + l * SP_B + (16 * ks + 8 * hh) * 2);
                    f32x16 y1, y2;
#pragma unroll
                    for (int k = 0; k < 16; ++k) { y1[k] = 0.f; y2[k] = 0.f; }
                    const int st_lo = dir == 0 ? 0 : lt, st_hi = dir == 0 ? lt : 3;
                    for (int st = st_lo; st <= st_hi; ++st) {
                        f32x16 X;
#pragma unroll
                        for (int k = 0; k < 16; ++k) X[k] = 0.f;
#pragma unroll
                        for (int ks = 0; ks < 8; ++ks) { const bf16x8 af = *(const LAS bf16x8*)(Bl + (32 * st + r32) * SP_B + (16 * ks + 8 * hh) * 2); X = __builtin_amdgcn_mfma_f32_32x32x16_bf16(af, cf[ks], X, 0, 0, 0); }
#pragma unroll
                        for (int q = 0; q < 4; ++q) { const f32x4 cs = *(const LAS f32x4*)(V + 32 * st + 8 * q + 4 * hh);
#pragma unroll
                            for (int e = 0; e < 4; ++e) { const int s = 32 * st + 8 * q + 4 * hh + e; const bool ok = dir == 0 ? (s <= l) : (s >= l);
                                const float dec = __expf(fminf(cl - cs[e], 0.f)); X[4 * q + e] = ok ? X[4 * q + e] * dec : 0.f; } }
#pragma unroll
                        for (int ks2 = 0; ks2 < 2; ++ks2) { v4u w; w.x = cvtpk(X[8 * ks2 + 0], X[8 * ks2 + 1]); w.y = cvtpk(X[8 * ks2 + 2], X[8 * ks2 + 3]); w.z = cvtpk(X[8 * ks2 + 4], X[8 * ks2 + 5]); w.w = cvtpk(X[8 * ks2 + 6], X[8 * ks2 + 7]);
                            const LAS unsigned char* tb = XDl + (32 * st + 16 * ks2 + 4 * hh + tq) * SP_X + (32 * pt + 16 * tblk + 4 * tp) * 2;
                            const v2u lo = trread(tb), hi = trread(tb + 8 * SP_X);
                            y1 = __builtin_amdgcn_mfma_f32_32x32x16_bf16(__builtin_bit_cast(bf16x8, (v4u){lo.x, lo.y, hi.x, hi.y}), __builtin_bit_cast(bf16x8, w), y1, 0, 0, 0); }
                    }
#pragma unroll
                    for (int ks = 0; ks < 8; ++ks) { const bf16x8 sf = *(const LAS bf16x8*)(Sl + (32 * pt + r32) * SP_B + (16 * ks + 8 * hh) * 2); y2 = __builtin_amdgcn_mfma_f32_32x32x16_bf16(sf, cf[ks], y2, 0, 0, 0); }
                    const float el = __expf(cl);
#pragma unroll
                    for (int q = 0; q < 4; ++q) { float o[4];
#pragma unroll
                        for (int e = 0; e < 4; ++e) o[e] = y1[4 * q + e] + el * y2[4 * q + e];
                        const float a0 = bflo(add[q].x), a1 = bfhi(add[q].x), a2 = bflo(add[q].y), a3 = bfhi(add[q].y);
                        if (dir == 0) { o[0] += dsk * a0; o[1] += dsk * a1; o[2] += dsk * a2; o[3] += dsk * a3; } else { o[0] += a0; o[1] += a1; o[2] += a2; o[3] += a3; }
                        v2u w; w.x = pk2(o[0], o[1]); w.y = pk2(o[2], o[3]); *(v2u*)(yptr + 8 * q) = w; }
                }
                if (c + 1 < 18) {
                    const float etot = __expf(V[384]);
#pragma unroll
                    for (int k = 0; k < 16; ++k) sacc[k] *= etot;
#pragma unroll
                    for (int ks = 0; ks < 8; ++ks) {
                        const LAS unsigned char* ta = Bl + (16 * ks + 8 * hh + tq) * SP_B + (32 * lt + 16 * tblk + 4 * tp) * 2;
                        const LAS unsigned char* tb = XWl + (16 * ks + 8 * hh + tq) * SP_X + (32 * pt + 16 * tblk + 4 * tp) * 2;
                        const v2u alo = trread(ta), ahi = trread(ta + 4 * SP_B), blo = trread(tb), bhi = trread(tb + 4 * SP_X);
                        sacc = __builtin_amdgcn_mfma_f32_32x32x16_bf16(__builtin_bit_cast(bf16x8, (v4u){alo.x, alo.y, ahi.x, ahi.y}), __builtin_bit_cast(bf16x8, (v4u){blo.x, blo.y, bhi.x, bhi.y}), sacc, 0, 0, 0); }
                    SSD_SCAN(cur ^ 1);
                }
                __syncthreads();
                if (c + 1 < 18) {
                    LAS v2u* sp = (LAS v2u*)(Sl + (32 * pt + r32) * SP_B + (32 * lt + 4 * hh) * 2);
#pragma unroll
                    for (int q = 0; q < 4; ++q) { v2u w; w.x = cvtpk(sacc[4 * q], sacc[4 * q + 1]); w.y = cvtpk(sacc[4 * q + 2], sacc[4 * q + 3]); sp[2 * q] = w; }
                    SSD_WRITE(cur ^ 1);
                }
                __syncthreads();
            }
#undef SSD_ROWBASE
#undef SSD_PF
#undef SSD_SCAN
#undef SSD_WRITE
            asm volatile("s_waitcnt vmcnt(0)" ::: "memory");
        }
    }
}

#ifndef MK_SINGLE
#define MK_SINGLE 1
#endif
struct GemmDesc { const bf16* A; const bf16* Bt; int M, N, K; bf16* O; int ldc; };

__global__ void __launch_bounds__(NTHR, 2) fwd_kernel(Args a) {
    extern __shared__ __attribute__((aligned(16))) unsigned char lds_raw[];
    LAS unsigned char* lds = (LAS unsigned char*)lds_raw;
    unsigned char* ws = a.ws;
    float* XL = a.out; float* XC = (float*)(ws + WS_XC); bf16* H = (bf16*)(ws + WS_H); bf16* Mb = (bf16*)(ws + WS_M);
    const float* MOD = (const float*)(ws + WS_MOD); const float* NW = a.in[I_NORMW];
    for (int s = a.lo; s < a.hi; ++s) {
        GemmDesc g0{}, g1{}; int ng = 0;
#ifndef NO_SIMPLE
        if (s == 0) {
            mod_compute(a, lds);
            rope_tables(a);
            convert_layer(a, 0, lds);
        } else if (s == 1) {
            rowwise(a.in[I_X], a.in[I_CTX], XL, XC, nullptr, nullptr, nullptr, H, MOD, 0, 1024, NW, T);
        } else {
            const int l = (s - 2) / 10, k = (s - 2) % 10, i = l >> 1; const bool even = (l & 1) == 0, last = (l == 3);
            const int MR = last ? TL : T;
            switch (k) {
            case 0:
                if (even) { g0 = GemmDesc{H, (const bf16*)(ws + W_IN), T, HYB_INP, D, (bf16*)(ws + WS_P), HYB_INP}; ng = 1; }
                else      { g0 = GemmDesc{H, (const bf16*)(ws + W_IN), T, SSD_INP, D, (bf16*)(ws + WS_ZX), SSD_INP}; ng = 1; }
                break;
            case 1: if (even) prep_even(a, i); else ssd_conv(a, i); break;
            case 2:
                if (even) { { g0 = GemmDesc{(const bf16*)(ws + WS_CQN), (const bf16*)(ws + W_UQ), T, QW, 384, (bf16*)(ws + WS_Q), QW}; ng = 1; }
                            g1 = GemmDesc{(const bf16*)(ws + WS_CKVN), (const bf16*)(ws + W_UKV), T, KVW, 256, (bf16*)(ws + WS_KV), KVW}; ng = 2; }
                else {
#ifdef SSD_NAIVE
 ssd_scan_naive(a, i, last, lds);
#else
 ssd_scan_mfma(a, i, last, lds);
#endif
 }
                break;
            case 3: if (even) {
#ifdef ATTN_NAIVE
 attn_naive(a, lds);
#else
 attn_mfma(a, lds);
#endif
 } else gatenorm(a, i, MR); break;
            case 4:
                if (even) { g0 = GemmDesc{(const bf16*)(ws + WS_MIX), (const bf16*)(ws + W_OUT), MR, D, D, Mb, D}; ng = 1; }
                else      { g0 = GemmDesc{(const bf16*)(ws + WS_XBC), (const bf16*)(ws + W_OUT), MR, D, 2048, Mb, D}; ng = 1; }
                break;
            case 5: rowwise(XL, XC, XL, XC, Mb, MOD + (size_t)l * 9 * MODW + 2048, NW + (l * 4 + 1) * D, H, MOD + (size_t)l * 9 * MODW, 3072, 4096, NW + (l * 4 + 2) * D, MR); break;
            case 6: { g0 = GemmDesc{H, (const bf16*)(ws + W_UP), MR, UPW, D, (bf16*)(ws + WS_U), UPW}; ng = 1; } break;
            case 7: convgate(a, l, MR); break;
            case 8: { g0 = GemmDesc{(const bf16*)(ws + WS_G), (const bf16*)(ws + W_DN), MR, D, DFF, Mb, D}; ng = 1; } break;
            case 9:
                if (!last) { rowwise(XL, XC, XL, XC, Mb, MOD + (size_t)l * 9 * MODW + 5120, NW + (l * 4 + 3) * D, H, MOD + (size_t)(l + 1) * 9 * MODW, 0, 1024, NW + ((l + 1) * 4 + 0) * D, T);
                             convert_layer(a, l + 1, lds); }
                else rowwise(XL, XC, XL, XC, Mb, MOD + (size_t)l * 9 * MODW + 5120, NW + (l * 4 + 3) * D, nullptr, MOD, 0, 0, NW, TL);
                break;
            }
        }
#else
        { g0 = GemmDesc{H, (const bf16*)(ws + W_IN), T, a.hi * 256, a.lo * 128, (bf16*)(ws + WS_P), HYB_INP}; ng = 1; }
#endif
        for (int gi = 0; gi < ng; ++gi) {
            const bool f = (gi == 0);
            pg8::Gemm g{f ? g0.A : g1.A, f ? g0.Bt : g1.Bt, f ? g0.M : g1.M, f ? g0.N : g1.N, f ? g0.K : g1.K}; pg8::StaticOrder S; S.init(g.M, g.N, (int)gridDim.x, (int)blockIdx.x);
            pg8::EpiStore E{f ? g0.O : g1.O, f ? g0.ldc : g1.ldc};
#ifndef NO_GEMM
            pg8::gemm_phase<pg8::EpiStore, pg8::StaticOrder, true, true>(lds, g, S, E);
#endif
            __syncthreads();
        }
        if (s + 1 < a.hi) {
#if MK_SINGLE
            cg::this_grid().sync();
#endif
        }
    }
}

extern "C" void kernel_launch(void* const* d_in, const int* in_sizes, int n_in, void* d_out, int out_size, void* d_ws, size_t ws_size, hipStream_t stream) {
    static int grid = 0;
    if (grid == 0) {
        if (n_in != 25 || out_size != TL * D || ws_size < WS_END) { fprintf(stderr, "kernel_launch: unexpected problem (n_in %d out %d ws %zu need %zu)\n", n_in, out_size, ws_size, (size_t)WS_END); grid = -1; return; }
        if (hipFuncSetAttribute((const void*)fwd_kernel, hipFuncAttributeMaxDynamicSharedMemorySize, LDS_BYTES) != hipSuccess) { fprintf(stderr, "kernel_launch: hipFuncSetAttribute failed\n"); grid = -1; return; }
        int dev = 0, cus = 0, per_cu = 0;
        hipGetDevice(&dev); hipDeviceGetAttribute(&cus, hipDeviceAttributeMultiprocessorCount, dev);
        hipOccupancyMaxActiveBlocksPerMultiprocessor(&per_cu, (const void*)fwd_kernel, NTHR, LDS_BYTES);
        (void)hipGetLastError();
        if (per_cu < 1) { fprintf(stderr, "kernel_launch: occupancy query says %d blocks per CU\n", per_cu); }
        grid = cus;
    }
    if (grid < 0) return;
    Args a{};
    for (int i = 0; i < 25; ++i) a.in[i] = (const float*)d_in[i];
    a.out = (float*)d_out; a.ws = (unsigned char*)d_ws;
#if MK_SINGLE
    a.lo = 0; a.hi = NSTEP + 1;
    void* args[] = {&a};
    hipError_t e = hipLaunchCooperativeKernel((const void*)fwd_kernel, dim3(grid), dim3(NTHR), args, LDS_BYTES, stream);
    if (e != hipSuccess) fprintf(stderr, "cooperative launch failed: %s (grid %d)\n", hipGetErrorString(e), grid);
#else
    for (int s = 0; s < NSTEP + 1; ++s) { a.lo = s; a.hi = s + 1; hipLaunchKernelGGL(fwd_kernel, dim3(grid), dim3(NTHR), LDS_BYTES, stream, a); }
#endif
}
```

```cpp
#include <hip/hip_runtime.h>
#include <hip/hip_cooperative_groups.h>
#include <cstdio>
#include <cstdint>
namespace cg = cooperative_groups;
__device__ __forceinline__ int otid() { int t = threadIdx.x; asm volatile("" : "+v"(t)); return t; }
__device__ __forceinline__ float shx(float v, int mask, int lane) { return __builtin_bit_cast(float, __builtin_amdgcn_ds_bpermute((lane ^ mask) << 2, __builtin_bit_cast(int, v))); }
#define LAS __attribute__((address_space(3)))
#define XB_TMO      128
#define XB_XCNT(j)  (256  + 64 * (j))
#define XB_XSUB(j)  (1280 + 64 * (j))
#define XB_XGEN(j)  (2304 + 64 * (j))
#define XB_TOP      3328
#define XB_TOPGEN   3392
#define XCD_BAR_WORDS 3456
#define XB_SPIN_CAP (1u << 18)

__device__ __forceinline__ unsigned xb_ld(unsigned* p)              { return __hip_atomic_load(p, __ATOMIC_RELAXED, __HIP_MEMORY_SCOPE_AGENT); }
__device__ __forceinline__ unsigned xb_add(unsigned* p, unsigned v) { return __hip_atomic_fetch_add(p, v, __ATOMIC_RELAXED, __HIP_MEMORY_SCOPE_AGENT); }
__device__ __forceinline__ unsigned xb_xcc_id() { return (unsigned)__builtin_amdgcn_s_getreg((3 << 11) | 20) & 0xFu; }
#define XB_SPIN(cond, bar) do { unsigned _sp = 0; while (cond) { __builtin_amdgcn_s_sleep(1); \
    if ((++_sp & 255u) == 0u) { if (xb_ld(&(bar)[XB_TMO])) break; if (_sp > XB_SPIN_CAP) { atomicAdd(&(bar)[XB_TMO], 1u); break; } } } } while (0)

struct XcdBarrier {
    unsigned* bar; unsigned x;
    volatile LAS unsigned* st;
};

__device__ __forceinline__ XcdBarrier xcd_barrier_post(unsigned* bar, volatile LAS unsigned* st) {
    XcdBarrier b; b.bar = bar; b.x = xb_xcc_id(); b.st = st;
    if (otid() == 0) (void)xb_add(&bar[XB_XCNT(b.x)], 1u);
    return b;
}
__device__ __forceinline__ void xcd_barrier_complete(unsigned* bar, unsigned x, unsigned& nloc, unsigned& nx) {
    const unsigned G = gridDim.x * gridDim.y * gridDim.z;
    unsigned sum, cnt, mine, sp = 0u;
    for (;;) {
        sum = 0u; cnt = 0u; mine = 0u;
#pragma unroll
        for (unsigned j = 0; j < 16; ++j) { const unsigned c = xb_ld(&bar[XB_XCNT(j)]); sum += c; cnt += (c > 0u) ? 1u : 0u; mine = (j == x) ? c : mine; }
        if (sum == G) break;
        __builtin_amdgcn_s_sleep(1);
        if ((++sp & 255u) == 0u) { if (xb_ld(&bar[XB_TMO])) break; if (sp > XB_SPIN_CAP) { atomicAdd(&bar[XB_TMO], 1u); break; } }
    }
    nloc = mine > 0u ? mine : 1u; nx = cnt > 0u ? cnt : 1u;
}

__device__ __forceinline__ void xcd_barrier(const XcdBarrier& b) {
    asm volatile("s_waitcnt vmcnt(0)" ::: "memory");
    __syncthreads();
    if (otid() == 0) {
        unsigned* bar = b.bar;
        __builtin_amdgcn_s_waitcnt(0);
        unsigned nloc = b.st[0], nx = b.st[1];
        if (nloc == 0u) { xcd_barrier_complete(bar, b.x, nloc, nx); b.st[0] = nloc; b.st[1] = nx; }
        const unsigned old = xb_add(&bar[XB_XSUB(b.x)], 1u);
        const unsigned gen = old / nloc;
        if (old + 1u == (gen + 1u) * nloc) {
            __builtin_amdgcn_fence(__ATOMIC_RELEASE, "agent");
            asm volatile("s_waitcnt vmcnt(0)" ::: "memory");
            const unsigned og = xb_add(&bar[XB_TOP], 1u);
            const unsigned tg = og / nx;
            if (og + 1u == (tg + 1u) * nx) xb_add(&bar[XB_TOPGEN], 1u);
            else XB_SPIN(xb_ld(&bar[XB_TOPGEN]) == tg, bar);
            __builtin_amdgcn_fence(__ATOMIC_ACQUIRE, "agent");
            xb_add(&bar[XB_XGEN(b.x)], 1u);
            asm volatile("s_waitcnt vmcnt(0)" ::: "memory");
        } else {
            XB_SPIN(xb_ld(&bar[XB_XGEN(b.x)]) == gen, bar);
            __builtin_amdgcn_fence(__ATOMIC_ACQUIRE, "agent");
            asm volatile("s_waitcnt vmcnt(0)" ::: "memory");
        }
    }
    __syncthreads();
}
namespace pg8 {
#define PG8_LAS __attribute__((address_space(3)))
typedef unsigned short bf16_t;
typedef short bf16x8 __attribute__((ext_vector_type(8)));
typedef float f32x4 __attribute__((ext_vector_type(4)));
typedef unsigned u32x4 __attribute__((ext_vector_type(4)));
constexpr int BM = 256, BK = 64, HALF = 128, HTB = HALF * BK * 2  , STAGE_BYTES = 8 * HTB, NXCD = 8, WGM = 8;

__host__ __device__ __forceinline__ int lds_byte(int r, int c) { const int st = (r >> 4) * 2 + (c >> 5), rr = r & 15, cc = c & 31, ob = rr * 64 + cc * 2; return st * 1024 + (ob ^ (((ob >> 9) & 1) << 5)); }
__host__ __device__ __forceinline__ void stage_rc(int b, int& R, int& C) { const int st = b / 1024, sb = b % 1024, swz = sb ^ (((sb >> 9) & 1) << 5); R = (st >> 1) * 16 + swz / 64; C = (st & 1) * 32 + (swz % 64) / 2; }
__host__ __device__ __forceinline__ int perm32(int rho) { const int n = rho >> 4, i = rho & 15; return 8 * (i >> 2) + 4 * n + (i & 3); }

struct Unit { int pm, pn; };
struct Gemm { const bf16_t* A; const bf16_t* Bt; int M, N, K; };

struct StaticOrder {
    int nM, nN, nwg, G, c;
    __host__ __device__ void init(int M, int N, int G_, int c_) { nM = M / BM; nN = N / BM; nwg = nM * nN; G = G_; c = c_; }
    __host__ __device__ bool next(int i, Unit& u) const {
        const long L = (long)i * G + c; if (L >= nwg) return false;
        int wgid = (int)L; { const int q = nwg / NXCD, r = nwg % NXCD, xcd = wgid % NXCD, off = wgid / NXCD; wgid = (xcd < r ? xcd * (q + 1) : r * (q + 1) + (xcd - r) * q) + off; }
        const int nig = WGM * nN, gid = wgid / nig, fm = gid * WGM, gsz = (nM - fm) < WGM ? (nM - fm) : WGM;
        u.pm = fm + ((wgid % nig) % gsz); u.pn = (wgid % nig) / gsz; return true;
    }
    __device__ __forceinline__ void a_ready(const Unit&) const {}
    __device__ __forceinline__ void done(const Unit&) const {}
};

__device__ __forceinline__ unsigned cvt_pk_bf16(float lo, float hi) { unsigned r; asm volatile("v_cvt_pk_bf16_f32 %0, %1, %2" : "=v"(r) : "v"(lo), "v"(hi)); return r; }
struct EpiStore {
    static constexpr bool PERM = true, AFTER_DRAIN = false;
    bf16_t* O; int ldc;
    __device__ __forceinline__ void operator()(const f32x4 (&acc)[2][2][4][2], const Unit& u, int wr, int wc, int fr, int fq) const {
        const int row0 = u.pm * BM + wr * 64 + fr; const int col0 = u.pn * BM + wc * 32 + 8 * fq;
#pragma unroll
        for (int ai = 0; ai < 2; ++ai)
#pragma unroll
            for (int m = 0; m < 4; ++m) { bf16_t* rowp = O + (size_t)(row0 + ai * HALF + m * 16) * ldc + col0;
#pragma unroll
                for (int bj = 0; bj < 2; ++bj) { const f32x4 v0 = acc[ai][bj][m][0], v1 = acc[ai][bj][m][1];
                    u32x4 w; w.x = cvt_pk_bf16(v0[0], v0[1]); w.y = cvt_pk_bf16(v0[2], v0[3]); w.z = cvt_pk_bf16(v1[0], v1[1]); w.w = cvt_pk_bf16(v1[2], v1[3]);
                    *(u32x4*)(rowp + bj * HALF) = w; } }
    }
};
template <class Epi, class Sched, bool ALIGN_EPI = false, bool SP2 = false>
__device__ __forceinline__ void gemm_phase(PG8_LAS unsigned char* lds, const Gemm g, const Sched& S, const Epi& E) {
    const int tid = otid(), wid = __builtin_amdgcn_readfirstlane(tid >> 6), lane = tid & 63, wr = wid >> 2, wc = wid & 3, fr = lane & 15, fq = lane >> 4;
    const int K = g.K, nt = K / BK;
    unsigned voffA[2], voffB[2];
#pragma unroll
    for (int i = 0; i < 2; ++i) { int R, C; stage_rc(tid * 16 + i * 8192, R, C); const int Rb = Epi::PERM ? ((R & ~31) + perm32(R & 31)) : R;
        voffA[i] = (unsigned)(R * K + C) * 2u; voffB[i] = (unsigned)(Rb * K + C) * 2u; }
    const size_t kstep = (size_t)(BK * 2);
    const size_t hstep = (size_t)HALF * K * 2;
    const size_t tstep = 2 * hstep;
    const unsigned ldsw = (unsigned)wid * 1024u;
    const int aoff = lds_byte(wr * 64 + fr, fq * 8), boff = lds_byte(wc * 32 + fr, fq * 8);
#define PG8_SA(b, h) (((b) * 2 + (h)) * HTB)
#define PG8_SB(b, h) ((4 + (b) * 2 + (h)) * HTB)
#define PG8_STAGE(bufoff, gbase, voff) do { _Pragma("unroll") for (int _i = 0; _i < 2; ++_i) \
        __builtin_amdgcn_global_load_lds((const unsigned*)((const char*)(gbase) + (voff)[_i]), (PG8_LAS unsigned*)(lds + (bufoff) + ldsw + _i * 8192), 16, 0, 0); } while (0)
#define PG8_LDA(dst, b, h) do { _Pragma("unroll") for (int m = 0; m < 4; ++m) _Pragma("unroll") for (int k = 0; k < 2; ++k) dst[m][k] = *(const PG8_LAS bf16x8*)(lds + PG8_SA(b, h) + aoff + m * 2048 + k * 1024); } while (0)
#define PG8_LDB(dst, b, h) do { _Pragma("unroll") for (int n = 0; n < 2; ++n) _Pragma("unroll") for (int k = 0; k < 2; ++k) dst[n][k] = *(const PG8_LAS bf16x8*)(lds + PG8_SB(b, h) + boff + n * 2048 + k * 1024); } while (0)
#define PG8_MMA(ai, bj, At, Bt) do { __builtin_amdgcn_s_setprio(1); _Pragma("unroll") for (int m = 0; m < 4; ++m) _Pragma("unroll") for (int n = 0; n < 2; ++n) _Pragma("unroll") for (int k = 0; k < 2; ++k) \
        acc[ai][bj][m][n] = __builtin_amdgcn_mfma_f32_16x16x32_bf16(Bt[n][k], At[m][k], acc[ai][bj][m][n], 0, 0, 0); __builtin_amdgcn_s_setprio(0); } while (0)
#define PG8_WAIT_V(n) asm volatile("s_waitcnt vmcnt(" #n ")" ::: "memory")
#define PG8_WAIT_L(n) asm volatile("s_waitcnt lgkmcnt(" #n ")" ::: "memory")
#define PG8_BAR __builtin_amdgcn_s_barrier()
#define PG8_SCHED __builtin_amdgcn_sched_barrier(0)
    Unit cur, nxt; int ui = 0;
    if (!S.next(0, cur)) return;
    f32x4 acc[2][2][4][2];
#pragma unroll
    for (int a = 0; a < 2; ++a)
#pragma unroll
        for (int b = 0; b < 2; ++b)
#pragma unroll
            for (int m = 0; m < 4; ++m)
#pragma unroll
                for (int n = 0; n < 2; ++n) acc[a][b][m][n] = (f32x4){0.f, 0.f, 0.f, 0.f};
    bf16x8 At[4][2], B0[2][2], B1[2][2];
    const char* cA = (const char*)g.A + (size_t)cur.pm * tstep; const char* cB = (const char*)g.Bt + (size_t)cur.pn * tstep;
    S.a_ready(cur);
    if constexpr (SP2) {
        PG8_STAGE(PG8_SB(0, 0), cB, voffB); PG8_STAGE(PG8_SB(0, 1), cB + hstep, voffB); PG8_STAGE(PG8_SA(0, 0), cA, voffA); PG8_STAGE(PG8_SA(0, 1), cA + hstep, voffA);
        if (wr == 1) PG8_BAR;
        PG8_WAIT_V(2); PG8_BAR;
        PG8_STAGE(PG8_SB(1, 0), cB + kstep, voffB); PG8_STAGE(PG8_SA(1, 0), cA + kstep, voffA); PG8_STAGE(PG8_SB(1, 1), cB + hstep + kstep, voffB);
        PG8_WAIT_V(6); PG8_BAR;
    } else {
        PG8_STAGE(PG8_SB(0, 0), cB, voffB); PG8_STAGE(PG8_SA(0, 0), cA, voffA); PG8_STAGE(PG8_SB(0, 1), cB + hstep, voffB); PG8_STAGE(PG8_SA(0, 1), cA + hstep, voffA);
        if (wr == 1) PG8_BAR;
        PG8_WAIT_V(4); PG8_BAR;
        PG8_STAGE(PG8_SB(1, 0), cB + kstep, voffB); PG8_STAGE(PG8_SA(1, 0), cA + kstep, voffA); PG8_STAGE(PG8_SB(1, 1), cB + hstep + kstep, voffB);
        PG8_WAIT_V(6); PG8_BAR;
    }
    for (;;) {
        const bool has_next = S.next(ui + 1, nxt);
        const char* nA = has_next ? (const char*)g.A + (size_t)nxt.pm * tstep : cA; const char* nB = has_next ? (const char*)g.Bt + (size_t)nxt.pn * tstep : cB;
        for (int t = 0; t < nt; t += 2) {
            const bool last = (t == nt - 2);
            const char* a1 = cA + (size_t)(t + 1) * kstep;
            const char* a2 = last ? nA : cA + (size_t)(t + 2) * kstep; const char* b2 = last ? nB : cB + (size_t)(t + 2) * kstep;
            const char* a3 = a2 + kstep; const char* b3 = b2 + kstep;
            if (last && has_next) S.a_ready(nxt);
            if constexpr (SP2) {
            PG8_LDB(B0, 0, 0); PG8_LDB(B1, 0, 1); PG8_SCHED; PG8_LDA(At, 0, 0); PG8_STAGE(PG8_SA(1, 1), a1 + hstep, voffA);
            PG8_WAIT_V(8); PG8_WAIT_L(0); PG8_BAR; PG8_MMA(0, 0, At, B0); PG8_MMA(0, 1, At, B1); PG8_BAR; PG8_SCHED;
            PG8_LDA(At, 0, 1); PG8_STAGE(PG8_SB(0, 0), b2, voffB); PG8_STAGE(PG8_SB(0, 1), b2 + hstep, voffB); PG8_STAGE(PG8_SA(0, 0), a2, voffA);
            PG8_WAIT_V(8); PG8_WAIT_L(0); PG8_BAR; PG8_MMA(1, 0, At, B0); PG8_MMA(1, 1, At, B1); PG8_BAR; PG8_SCHED;
            PG8_LDB(B0, 1, 0); PG8_LDB(B1, 1, 1); PG8_SCHED; PG8_LDA(At, 1, 0); PG8_STAGE(PG8_SA(0, 1), a2 + hstep, voffA);
            PG8_WAIT_V(8); PG8_WAIT_L(0); PG8_BAR; PG8_MMA(0, 0, At, B0); PG8_MMA(0, 1, At, B1); PG8_BAR; PG8_SCHED;
            PG8_LDA(At, 1, 1); PG8_STAGE(PG8_SB(1, 0), b3, voffB); PG8_STAGE(PG8_SB(1, 1), b3 + hstep, voffB); PG8_STAGE(PG8_SA(1, 0), a3, voffA);
            PG8_WAIT_V(8); PG8_WAIT_L(0); PG8_BAR; PG8_MMA(1, 0, At, B0); PG8_MMA(1, 1, At, B1); PG8_BAR; PG8_SCHED;
            } else {
            PG8_LDB(B0, 0, 0); PG8_SCHED; PG8_LDA(At, 0, 0); PG8_STAGE(PG8_SA(1, 1), a1 + hstep, voffA);
            PG8_WAIT_L(8); PG8_BAR; PG8_WAIT_L(0); PG8_MMA(0, 0, At, B0); PG8_BAR; PG8_SCHED;
            PG8_LDB(B1, 0, 1); PG8_STAGE(PG8_SB(0, 0), b2, voffB);
            PG8_BAR; PG8_WAIT_L(0); PG8_MMA(0, 1, At, B1); PG8_BAR;
            PG8_LDA(At, 0, 1); PG8_STAGE(PG8_SA(0, 0), a2, voffA);
            PG8_BAR; PG8_WAIT_L(0); PG8_MMA(1, 0, At, B0); PG8_BAR; PG8_SCHED;
            PG8_STAGE(PG8_SB(0, 1), b2 + hstep, voffB);
            PG8_WAIT_V(6); PG8_BAR; PG8_MMA(1, 1, At, B1); PG8_BAR;
            PG8_LDB(B0, 1, 0); PG8_SCHED; PG8_LDA(At, 1, 0); PG8_STAGE(PG8_SA(0, 1), a2 + hstep, voffA);
            PG8_WAIT_L(8); PG8_BAR; PG8_WAIT_L(0); PG8_MMA(0, 0, At, B0); PG8_BAR; PG8_SCHED;
            PG8_LDB(B1, 1, 1); PG8_STAGE(PG8_SB(1, 0), b3, voffB);
            PG8_BAR; PG8_WAIT_L(0); PG8_MMA(0, 1, At, B1); PG8_BAR;
            PG8_LDA(At, 1, 1); PG8_STAGE(PG8_SA(1, 0), a3, voffA);
            PG8_BAR; PG8_WAIT_L(0); PG8_MMA(1, 0, At, B0); PG8_BAR; PG8_SCHED;
            PG8_STAGE(PG8_SB(1, 1), b3 + hstep, voffB);
            PG8_WAIT_V(6); PG8_BAR; PG8_MMA(1, 1, At, B1); PG8_BAR;
            }
        }
        if constexpr (ALIGN_EPI) { if (wr == 0) PG8_BAR; }
        if constexpr (!Epi::AFTER_DRAIN) { E(acc, cur, wr, wc, fr, fq); S.done(cur); }
        if (!has_next) break;
#pragma unroll
        for (int a = 0; a < 2; ++a)
#pragma unroll
            for (int b = 0; b < 2; ++b)
#pragma unroll
                for (int m = 0; m < 4; ++m)
#pragma unroll
                    for (int n = 0; n < 2; ++n) acc[a][b][m][n] = (f32x4){0.f, 0.f, 0.f, 0.f};
        cur = nxt; cA = nA; cB = nB; ++ui;
        if constexpr (ALIGN_EPI) { if (wr == 1) PG8_BAR; }
    }
    PG8_WAIT_V(0);
    if constexpr (!ALIGN_EPI) { if (wr == 0) PG8_BAR; }
    PG8_BAR;
    if constexpr (Epi::AFTER_DRAIN) { E.fused(acc, cur, wr, wc, fr, fq, lds, wid, lane); S.done(cur); }
#undef PG8_SA
#undef PG8_SB
#undef PG8_STAGE
#undef PG8_LDA
#undef PG8_LDB
#undef PG8_MMA
#undef PG8_WAIT_V
#undef PG8_WAIT_L
#undef PG8_BAR
#undef PG8_SCHED
}
}

typedef unsigned short bf16;
typedef unsigned v4u __attribute__((ext_vector_type(4)));
typedef unsigned v2u __attribute__((ext_vector_type(2)));
typedef float f32x4 __attribute__((ext_vector_type(4)));
constexpr int NWAVES = 8, NTHR = 512;
constexpr int D = 1024, NB = 8, SEQ = 2048, CTXL = 256, TL = NB * SEQ, TC = NB * CTXL, T = TL + TC;
constexpr int HYB_IN = 2208, HYB_INP = 2304, SSD_IN = 5184, SSD_INP = 5376, DFF = 2816, UPW = 5632;
constexpr int QW = 768, KVW = 1024, MODW = 6144;
constexpr float EPS = 1e-6f;
constexpr int NSTEP = 1 + 4 * 10;
constexpr float ATT_SCALE_LOG2E = 0.10206207261596577f * 1.4426950408889634f;

constexpr size_t MiB = 1u << 20;
constexpr size_t WS_CTL = 0, CTL_ZERO_BYTES = 64 * 1024;
constexpr size_t WS_MOD = 1 * MiB;
constexpr size_t WS_ROPE = 2 * MiB;
constexpr size_t W_UP = 3 * MiB;
constexpr size_t W_DN = W_UP + (size_t)UPW * D * 2;
constexpr size_t W_IN = W_DN + (size_t)D * DFF * 2;
constexpr size_t W_OUT = W_IN + (size_t)SSD_INP * D * 2;
constexpr size_t W_UQ = W_OUT + (size_t)D * 2048 * 2;
constexpr size_t W_UKV = W_UQ + (size_t)QW * 384 * 2;
constexpr size_t W_END = W_UKV + (size_t)KVW * 256 * 2;
constexpr size_t WS_XC = 36 * MiB;
constexpr size_t WS_H = 44 * MiB;
constexpr size_t WS_DT = WS_H, WS_AA = WS_H + (size_t)T * 64 * 4;
constexpr size_t WS_BIG = 80 * MiB;
constexpr size_t WS_M = WS_BIG;
constexpr size_t WS_P = WS_BIG;
constexpr size_t WS_Q = WS_BIG + 81 * MiB;
constexpr size_t WS_KV = WS_BIG + 108 * MiB;
constexpr size_t WS_KR = WS_BIG + 144 * MiB;
constexpr size_t WS_CQN = WS_BIG + 146 * MiB;
constexpr size_t WS_CKVN = WS_BIG + 160 * MiB;
constexpr size_t WS_MIX = WS_BIG + 170 * MiB;
constexpr size_t WS_U = WS_BIG;
constexpr size_t WS_G = WS_BIG + 198 * MiB;
constexpr size_t WS_ZX = WS_BIG;
constexpr size_t WS_XBC = WS_BIG + 189 * MiB;
constexpr size_t WS_END = WS_BIG + 297 * MiB;
static_assert(W_END <= WS_XC && WS_G + (size_t)T * DFF * 2 <= WS_END && WS_XBC + (size_t)T * 3072 * 2 <= WS_END && WS_ZX + (size_t)T * SSD_INP * 2 <= WS_XBC, "ws map");
static_assert(WS_AA + (size_t)T * 64 * 4 <= WS_BIG && WS_MIX + (size_t)T * D * 2 <= WS_END && WS_Q + (size_t)T * QW * 2 <= WS_KV && WS_P + (size_t)T * HYB_INP * 2 <= WS_Q, "ws map 2");
constexpr int LDS_BYTES = 147456;

struct Args { const float* in[25]; float* out; unsigned char* ws; int lo, hi; };
enum { I_X = 0, I_C, I_CTX, I_CCTX, I_MODW, I_MODB, I_NORMW, I_WUP, I_FCONV, I_WDN, I_HIN, I_QNORM, I_KVNORM, I_WUQ, I_WUKV, I_SCONV, I_HOUT, I_SIN, I_SCONVW, I_SCONVB, I_ALOG, I_DTB, I_SD, I_SNORM, I_SOUT };

__device__ __forceinline__ unsigned f2bf(float f) { unsigned u = __builtin_bit_cast(unsigned, f); return (u + 0x7fffu + ((u >> 16) & 1u)) >> 16; }
__device__ __forceinline__ unsigned pk2(float lo, float hi) { return f2bf(lo) | (f2bf(hi) << 16); }
__device__ __forceinline__ float bflo(unsigned u) { return __builtin_bit_cast(float, u << 16); }
__device__ __forceinline__ float bfhi(unsigned u) { return __builtin_bit_cast(float, u & 0xffff0000u); }
__device__ __forceinline__ float bf1(bf16 b) { return __builtin_bit_cast(float, (unsigned)b << 16); }
__device__ __forceinline__ float silu_f(float x) { return x / (1.f + __expf(-x)); }
__device__ __forceinline__ float wave_sum(float v, int lane) {
#pragma unroll
    for (int o = 1; o < 64; o <<= 1) v += shx(v, o, lane);
    return v;
}
__device__ __forceinline__ void unpack8(const v4u w, float (&f)[8]) { f[0] = bflo(w.x); f[1] = bfhi(w.x); f[2] = bflo(w.y); f[3] = bfhi(w.y); f[4] = bflo(w.z); f[5] = bfhi(w.z); f[6] = bflo(w.w); f[7] = bfhi(w.w); }
__device__ __forceinline__ v4u pack8(const float (&f)[8]) { v4u w; w.x = pk2(f[0], f[1]); w.y = pk2(f[2], f[3]); w.z = pk2(f[4], f[5]); w.w = pk2(f[6], f[7]); return w; }
__device__ __forceinline__ bool has_prev(int r) { return r < TL ? (r & (SEQ - 1)) != 0 : ((r - TL) & (CTXL - 1)) != 0; }
__device__ __forceinline__ bool has_next(int r) { return r < TL ? (r & (SEQ - 1)) != SEQ - 1 : ((r - TL) & (CTXL - 1)) != CTXL - 1; }

__device__ __forceinline__ void mod_compute(const Args& a, LAS unsigned char* lds) {
    LAS float* sc = (LAS float*)lds;
    LAS float* red = (LAS float*)(lds + 36864);
    const int tid = otid();
    float* MOD = (float*)(a.ws + WS_MOD);
    for (int i = tid; i < 9 * 1024; i += NTHR) { const int c = i >> 10, k = i & 1023; const float v = c < 8 ? a.in[I_C][c * 1024 + k] : a.in[I_CCTX][k]; sc[i] = silu_f(v); }
    __syncthreads();
    for (int item = blockIdx.x; item < 4 * 96; item += gridDim.x) {
        const int l = item / 96, cb = item % 96;
        const float* W = a.in[I_MODW] + (size_t)l * 1024 * MODW + cb * 64;
        const int cgp = tid & 15, kg = tid >> 4;
        float acc[9][4];
#pragma unroll
        for (int c = 0; c < 9; ++c) { acc[c][0] = 0.f; acc[c][1] = 0.f; acc[c][2] = 0.f; acc[c][3] = 0.f; }
#pragma unroll 4
        for (int kk = 0; kk < 32; ++kk) { const int k = kg * 32 + kk; const f32x4 w = *(const f32x4*)(W + (size_t)k * MODW + cgp * 4);
#pragma unroll
            for (int c = 0; c < 9; ++c) { const float s = sc[c * 1024 + k]; acc[c][0] += s * w[0]; acc[c][1] += s * w[1]; acc[c][2] += s * w[2]; acc[c][3] += s * w[3]; } }
#pragma unroll
        for (int c = 0; c < 9; ++c)
#pragma unroll
            for (int j = 0; j < 4; ++j) red[kg * 576 + c * 64 + cgp * 4 + j] = acc[c][j];
        __syncthreads();
        for (int o = tid; o < 576; o += NTHR) { float s = 0.f;
            for (int g = 0; g < 32; ++g) s += red[g * 576 + o];
            const int c = o >> 6, col = o & 63; MOD[(size_t)(l * 9 + c) * MODW + cb * 64 + col] = s + a.in[I_MODB][l * MODW + cb * 64 + col]; }
        __syncthreads();
    }
}
__device__ __forceinline__ void rope_tables(const Args& a) {
    float* ct = (float*)(a.ws + WS_ROPE); float* st = ct + SEQ * 16;
    for (int i = blockIdx.x * NTHR + otid(); i < SEQ * 16; i += gridDim.x * NTHR) {
        const int t = i >> 4, j = i & 15; const int pos = j < 8 ? (t >> 6) : (t & 63); const int f = j & 7;
        const float i0 = (f & 1) ? 0.31622776601683794f : 1.0f; const int e = f >> 1; const float i1 = e == 0 ? 1.0f : (e == 1 ? 0.1f : (e == 2 ? 0.01f : 0.001f));
        const float inv = i0 * i1; const float ang = (float)pos * inv;
        ct[i] = __cosf(ang); st[i] = __sinf(ang); }
}
__device__ __forceinline__ void transpose_item(const float* W, int K, int N, bf16* WT, LAS float* scr, int item, int lane) {
    const int nblk = N / 32, kb = item / nblk, nb = item % nblk, k0 = 64 * kb, n0 = 32 * nb;
#pragma unroll 8
    for (int i = 0; i < 32; ++i) { const int kk = 2 * i + (lane >> 5); scr[kk * 33 + (lane & 31)] = W[(size_t)(k0 + kk) * N + n0 + (lane & 31)]; }
    asm volatile("s_waitcnt lgkmcnt(0)" ::: "memory");
    const int c = lane & 7;
#pragma unroll
    for (int j = 0; j < 4; ++j) { const int n = (lane >> 3) + 8 * j; const LAS float* s = scr + (8 * c) * 33 + n;
        v4u o; o.x = pk2(s[0 * 33], s[1 * 33]); o.y = pk2(s[2 * 33], s[3 * 33]); o.z = pk2(s[4 * 33], s[5 * 33]); o.w = pk2(s[6 * 33], s[7 * 33]);
        *(v4u*)(WT + (size_t)(n0 + n) * K + k0 + 8 * c) = o; }
    asm volatile("s_waitcnt lgkmcnt(0)" ::: "memory");
}
__device__ __forceinline__ void convert_weight(const float* W, int K, int N, int Npad, bf16* WT, LAS unsigned char* lds, int rot) {
    const int wave = otid() >> 6, lane = otid() & 63; const int NGW = gridDim.x * NWAVES; const int gw = (blockIdx.x * NWAVES + wave + rot) % NGW;
    LAS float* scr = (LAS float*)(lds + wave * 16384);
    const int nitems = (K / 64) * (N / 32);
    for (int it = gw; it < nitems; it += NGW) transpose_item(W, K, N, WT, scr, it, lane);
    (void)Npad;
}
__device__ __forceinline__ void convert_layer(const Args& a, int l, LAS unsigned char* lds) {
    const int i = l >> 1; unsigned char* ws = a.ws;
    convert_weight(a.in[I_WUP] + (size_t)l * D * UPW, D, UPW, UPW, (bf16*)(ws + W_UP), lds, 0);
    convert_weight(a.in[I_WDN] + (size_t)l * DFF * D, DFF, D, D, (bf16*)(ws + W_DN), lds, 300);
    if ((l & 1) == 0) {
        convert_weight(a.in[I_HIN] + (size_t)i * D * HYB_IN, D, HYB_IN, HYB_INP, (bf16*)(ws + W_IN), lds, 700);
        convert_weight(a.in[I_HOUT] + (size_t)i * D * D, D, D, D, (bf16*)(ws + W_OUT), lds, 1100);
        convert_weight(a.in[I_WUQ] + (size_t)i * 384 * QW, 384, QW, QW, (bf16*)(ws + W_UQ), lds, 1500);
        convert_weight(a.in[I_WUKV] + (size_t)i * 256 * KVW, 256, KVW, KVW, (bf16*)(ws + W_UKV), lds, 1700);
    } else {
        convert_weight(a.in[I_SIN] + (size_t)i * D * SSD_IN, D, SSD_IN, SSD_INP, (bf16*)(ws + W_IN), lds, 700);
        convert_weight(a.in[I_SOUT] + (size_t)i * 2048 * D, 2048, D, D, (bf16*)(ws + W_OUT), lds, 1300);
    }
}

__device__ __forceinline__ void rowwise(const float* xs_lat, const float* xs_ctx, float* xd_lat, float* xd_ctx, const bf16* Mb, const float* modg  , const float* nwA,
                                        bf16* H, const float* modh  , int sh_off, int sc_off, const float* nwB, int nrows) {
    const int wave = otid() >> 6, lane = otid() & 63; const int NGW = gridDim.x * NWAVES, gw = blockIdx.x * NWAVES + wave;
    for (int r = gw; r < nrows; r += NGW) {
        const bool lat = r < TL; const int cond = lat ? (r >> 11) : 8;
        const float* xs = lat ? xs_lat + (size_t)r * D : xs_ctx + (size_t)(r - TL) * D;
        float* xd = lat ? xd_lat + (size_t)r * D : xd_ctx + (size_t)(r - TL) * D;
        f32x4 v[4];
#pragma unroll
        for (int j = 0; j < 4; ++j) v[j] = *(const f32x4*)(xs + j * 256 + lane * 4);
        if (Mb) {
            f32x4 m[4]; float ss = 0.f;
#pragma unroll
            for (int j = 0; j < 4; ++j) { const v2u w = *(const v2u*)(Mb + (size_t)r * D + j * 256 + lane * 4); m[j] = (f32x4){bflo(w.x), bfhi(w.x), bflo(w.y), bfhi(w.y)};
                ss += (m[j][0] * m[j][0] + m[j][1] * m[j][1]) + (m[j][2] * m[j][2] + m[j][3] * m[j][3]); }
            const float rs = rsqrtf(wave_sum(ss, lane) * (1.f / D) + EPS);
#pragma unroll
            for (int j = 0; j < 4; ++j) { const f32x4 g = *(const f32x4*)(modg + (size_t)cond * MODW + j * 256 + lane * 4); const f32x4 w = *(const f32x4*)(nwA + j * 256 + lane * 4);
                v[j] = v[j] + g * (m[j] * rs * w); }
        }
#pragma unroll
        for (int j = 0; j < 4; ++j) *(f32x4*)(xd + j * 256 + lane * 4) = v[j];
        if (H) {
            float ss = 0.f;
#pragma unroll
            for (int j = 0; j < 4; ++j) ss += (v[j][0] * v[j][0] + v[j][1] * v[j][1]) + (v[j][2] * v[j][2] + v[j][3] * v[j][3]);
            const float rs = rsqrtf(wave_sum(ss, lane) * (1.f / D) + EPS);
#pragma unroll
            for (int j = 0; j < 4; ++j) { const int c = j * 256 + lane * 4;
                const f32x4 w = *(const f32x4*)(nwB + c); const f32x4 sc = *(const f32x4*)(modh + (size_t)cond * MODW + sc_off + c); const f32x4 sh = *(const f32x4*)(modh + (size_t)cond * MODW + sh_off + c);
                const f32x4 h = (v[j] * rs * w) * (sc + 1.0f) + sh;
                v2u o; o.x = pk2(h[0], h[1]); o.y = pk2(h[2], h[3]); *(v2u*)(H + (size_t)r * D + c) = o; }
        }
    }
}

__device__ __forceinline__ void prep_even(const Args& a, int i) {
    const int wave = otid() >> 6, lane = otid() & 63; const int NGW = gridDim.x * NWAVES, gw = blockIdx.x * NWAVES + wave;
    const bf16* P = (const bf16*)(a.ws + WS_P); bf16* CQN = (bf16*)(a.ws + WS_CQN); bf16* CKVN = (bf16*)(a.ws + WS_CKVN); bf16* KR = (bf16*)(a.ws + WS_KR); bf16* MIX = (bf16*)(a.ws + WS_MIX);
    const float* qn = a.in[I_QNORM] + i * 384; const float* kvn = a.in[I_KVNORM] + i * 256; const float* cw = a.in[I_SCONV] + i * 3 * 512;
    const float* ct = (const float*)(a.ws + WS_ROPE); const float* st = ct + SEQ * 16;
    for (int r = gw; r < T; r += NGW) {
        const bf16* p = P + (size_t)r * HYB_INP;
        {
            const unsigned* p32 = (const unsigned*)(p + lane * 6); const unsigned w0 = p32[0], w1 = p32[1], w2 = p32[2];
            float f[6] = {bflo(w0), bfhi(w0), bflo(w1), bfhi(w1), bflo(w2), bfhi(w2)}; float ss = 0.f;
#pragma unroll
            for (int j = 0; j < 6; ++j) ss += f[j] * f[j];
            const float rs = rsqrtf(wave_sum(ss, lane) * (1.f / 384.f) + EPS);
#pragma unroll
            for (int j = 0; j < 6; ++j) f[j] = f[j] * rs * qn[lane * 6 + j];
            unsigned* o32 = (unsigned*)(CQN + (size_t)r * 384 + lane * 6); o32[0] = pk2(f[0], f[1]); o32[1] = pk2(f[2], f[3]); o32[2] = pk2(f[4], f[5]);
        }
        {
            const v2u w = *(const v2u*)(p + 384 + lane * 4); float f[4] = {bflo(w.x), bfhi(w.x), bflo(w.y), bfhi(w.y)};
            const float ss = (f[0] * f[0] + f[1] * f[1]) + (f[2] * f[2] + f[3] * f[3]);
            const float rs = rsqrtf(wave_sum(ss, lane) * (1.f / 256.f) + EPS);
            const f32x4 g = *(const f32x4*)(kvn + lane * 4);
            v2u o; o.x = pk2(f[0] * rs * g[0], f[1] * rs * g[1]); o.y = pk2(f[2] * rs * g[2], f[3] * rs * g[3]); *(v2u*)(CKVN + (size_t)r * 256 + lane * 4) = o;
        }
        {
            const int j = lane & 31; const float v = bf1(p[640 + j]); const float o = shx(v, 16, lane); float res = v;
            if (r < TL) { const int t = r & (SEQ - 1); const float c = ct[t * 16 + (j & 15)], s = st[t * 16 + (j & 15)]; res = (j < 16) ? v * c - o * s : o * s + v * c; }
            if (lane < 32) KR[(size_t)r * 32 + j] = (bf16)f2bf(res);
        }
        {
            const int c0 = lane * 8; float gb[8], cur[8], acc[8], t0[8], t1[8];
            unpack8(*(const v4u*)(p + 672 + c0), gb);
            unpack8(*(const v4u*)(p + 1184 + c0), t0); unpack8(*(const v4u*)(p + 1696 + c0), t1);
#pragma unroll
            for (int j = 0; j < 8; ++j) { cur[j] = t0[j] * t1[j]; acc[j] = cw[512 + c0 + j] * cur[j]; }
            if (has_prev(r)) { unpack8(*(const v4u*)(p - HYB_INP + 1184 + c0), t0); unpack8(*(const v4u*)(p - HYB_INP + 1696 + c0), t1);
#pragma unroll
                for (int j = 0; j < 8; ++j) acc[j] += cw[c0 + j] * (t0[j] * t1[j]); }
            if (has_next(r)) { unpack8(*(const v4u*)(p + HYB_INP + 1184 + c0), t0); unpack8(*(const v4u*)(p + HYB_INP + 1696 + c0), t1);
#pragma unroll
                for (int j = 0; j < 8; ++j) acc[j] += cw[1024 + c0 + j] * (t0[j] * t1[j]); }
#pragma unroll
            for (int j = 0; j < 8; ++j) acc[j] *= gb[j];
            *(v4u*)(MIX + (size_t)r * D + 512 + c0) = pack8(acc);
        }
    }
}

__device__ __forceinline__ void convgate(const Args& a, int l, int nrows) {
    const bf16* U = (const bf16*)(a.ws + WS_U); bf16* G = (bf16*)(a.ws + WS_G); const float* cw = a.in[I_FCONV] + (size_t)l * 3 * UPW;
    const int total = nrows * (DFF / 8);
    for (int idx = blockIdx.x * NTHR + otid(); idx < total; idx += gridDim.x * NTHR) {
        const int r = idx / (DFF / 8), c0 = (idx % (DFF / 8)) * 8; const bf16* u = U + (size_t)r * UPW + c0;
        float ua[8], ug[8], act[8], gate[8];
        unpack8(*(const v4u*)u, ua); unpack8(*(const v4u*)(u + DFF), ug);
#pragma unroll
        for (int j = 0; j < 8; ++j) { act[j] = cw[UPW + c0 + j] * ua[j]; gate[j] = cw[UPW + DFF + c0 + j] * ug[j]; }
        if (has_prev(r)) { unpack8(*(const v4u*)(u - UPW), ua); unpack8(*(const v4u*)(u - UPW + DFF), ug);
#pragma unroll
            for (int j = 0; j < 8; ++j) { act[j] += cw[c0 + j] * ua[j]; gate[j] += cw[DFF + c0 + j] * ug[j]; } }
        if (has_next(r)) { unpack8(*(const v4u*)(u + UPW), ua); unpack8(*(const v4u*)(u + UPW + DFF), ug);
#pragma unroll
            for (int j = 0; j < 8; ++j) { act[j] += cw[2 * UPW + c0 + j] * ua[j]; gate[j] += cw[2 * UPW + DFF + c0 + j] * ug[j]; } }
#pragma unroll
        for (int j = 0; j < 8; ++j) act[j] = silu_f(act[j]) * gate[j];
        *(v4u*)(G + (size_t)r * DFF + c0) = pack8(act);
    }
}

__device__ __forceinline__ void ssd_conv(const Args& a, int i) {
    const bf16* ZX = (const bf16*)(a.ws + WS_ZX); bf16* XBC = (bf16*)(a.ws + WS_XBC); float* DT = (float*)(a.ws + WS_DT); float* AA = (float*)(a.ws + WS_AA);
    const float* cw = a.in[I_SCONVW] + (size_t)i * 3 * 3072; const float* cb = a.in[I_SCONVB] + (size_t)i * 3072;
    const int total = T * 384;
    for (int idx = blockIdx.x * NTHR + otid(); idx < total; idx += gridDim.x * NTHR) {
        const int r = idx / 384, c0 = (idx % 384) * 8; const bf16* u = ZX + (size_t)r * SSD_INP + 2048 + c0;
        float x[8], acc[8];
        unpack8(*(const v4u*)u, x);
#pragma unroll
        for (int j = 0; j < 8; ++j) acc[j] = cb[c0 + j] + cw[3072 + c0 + j] * x[j];
        if (has_prev(r)) { unpack8(*(const v4u*)(u - SSD_INP), x);
#pragma unroll
            for (int j = 0; j < 8; ++j) acc[j] += cw[c0 + j] * x[j]; }
        if (has_next(r)) { unpack8(*(const v4u*)(u + SSD_INP), x);
#pragma unroll
            for (int j = 0; j < 8; ++j) acc[j] += cw[2 * 3072 + c0 + j] * x[j]; }
#pragma unroll
        for (int j = 0; j < 8; ++j) acc[j] = silu_f(acc[j]);
        *(v4u*)(XBC + (size_t)r * 3072 + c0) = pack8(acc);
    }
    const float* alog = a.in[I_ALOG] + i * 64; const float* dtb = a.in[I_DTB] + i * 64;
    for (int idx = blockIdx.x * NTHR + otid(); idx < T * 64; idx += gridDim.x * NTHR) {
        const int r = idx >> 6, j = idx & 63; const float raw = bf1(ZX[(size_t)r * SSD_INP + 5120 + j]) + dtb[j];
        const float dt = raw > 15.f ? raw : (raw < -15.f ? __expf(raw) : __logf(1.f + __expf(raw)));
        DT[idx] = dt; AA[idx] = -__expf(alog[j]) * dt;
    }
}

__device__ __forceinline__ void gatenorm(const Args& a, int i, int nrows) {
    const int wave = otid() >> 6, lane = otid() & 63; const int NGW = gridDim.x * NWAVES, gw = blockIdx.x * NWAVES + wave;
    const bf16* ZX = (const bf16*)(a.ws + WS_ZX); bf16* YN = (bf16*)(a.ws + WS_XBC); const float* nw = a.in[I_SNORM] + i * 2048;
    for (int r = gw; r < nrows; r += NGW) {
        float v[4][8]; float ss = 0.f;
#pragma unroll
        for (int j = 0; j < 4; ++j) { float y[8], z[8]; const int c = j * 512 + lane * 8;
            unpack8(*(const v4u*)(ZX + (size_t)r * SSD_INP + 2048 + c), y); unpack8(*(const v4u*)(ZX + (size_t)r * SSD_INP + c), z);
#pragma unroll
            for (int k = 0; k < 8; ++k) { v[j][k] = y[k] * silu_f(z[k]); ss += v[j][k] * v[j][k]; } }
        const float rs = rsqrtf(wave_sum(ss, lane) * (1.f / 2048.f) + EPS);
#pragma unroll
        for (int j = 0; j < 4; ++j) { const int c = j * 512 + lane * 8; float o[8];
#pragma unroll
            for (int k = 0; k < 8; ++k) o[k] = v[j][k] * rs * nw[c + k];
            *(v4u*)(YN + (size_t)r * 2048 + c) = pack8(o); }
    }
}

__device__ __forceinline__ void attn_naive(const Args& a, LAS unsigned char* lds) {
    const int tid = otid(), qi = tid >> 1, half = tid & 1;
    const bf16* Qb = (const bf16*)(a.ws + WS_Q); const bf16* KVb = (const bf16*)(a.ws + WS_KV); const bf16* KR = (const bf16*)(a.ws + WS_KR); bf16* MIX = (bf16*)(a.ws + WS_MIX);
    const float* ct = (const float*)(a.ws + WS_ROPE); const float* st = ct + SEQ * 16;
    LAS float* Kt = (LAS float*)lds;
    LAS float* Vt = (LAS float*)(lds + 64 * 96 * 4);
    for (int u = blockIdx.x; u < 576; u += gridDim.x) {
        const bool lat = u < 512; const int b = lat ? (u >> 6) : ((u - 512) >> 3), h = lat ? ((u >> 3) & 7) : ((u - 512) & 7);
        const int nkeys = lat ? (CTXL + SEQ) : CTXL;
        const int qrow = lat ? b * SEQ + (u & 7) * 256 + qi : TL + b * CTXL + qi;
        float q[48];
#pragma unroll
        for (int g = 0; g < 6; ++g) { float f[8]; unpack8(*(const v4u*)(Qb + (size_t)qrow * QW + h * 96 + half * 48 + g * 8), f);
#pragma unroll
            for (int j = 0; j < 8; ++j) q[g * 8 + j] = f[j]; }
        if (lat && half == 1) { const int t = qrow & (SEQ - 1);
#pragma unroll
            for (int j = 0; j < 16; ++j) { const float c = ct[t * 16 + j], s = st[t * 16 + j]; const float x1 = q[16 + j], x2 = q[32 + j]; q[16 + j] = x1 * c - x2 * s; q[32 + j] = x1 * s + x2 * c; } }
#pragma unroll
        for (int j = 0; j < 48; ++j) q[j] *= ATT_SCALE_LOG2E;
        float o[32]; float m = -1e30f, l = 0.f;
#pragma unroll
        for (int j = 0; j < 32; ++j) o[j] = 0.f;
        for (int k0 = 0; k0 < nkeys; k0 += 64) {
            __syncthreads();
            for (int g = tid; g < 768; g += NTHR) { const int key = g / 12, part = g % 12; const int kk = k0 + key; const int krow = kk < CTXL ? TL + b * CTXL + kk : b * SEQ + kk - CTXL;
                float f[8]; unpack8(part < 8 ? *(const v4u*)(KVb + (size_t)krow * KVW + h * 128 + part * 8) : *(const v4u*)(KR + (size_t)krow * 32 + (part - 8) * 8), f);
#pragma unroll
                for (int j = 0; j < 8; ++j) Kt[key * 96 + part * 8 + j] = f[j]; }
            { const int key = tid >> 3, part = tid & 7; const int kk = k0 + key; const int krow = kk < CTXL ? TL + b * CTXL + kk : b * SEQ + kk - CTXL;
                float f[8]; unpack8(*(const v4u*)(KVb + (size_t)krow * KVW + h * 128 + 64 + part * 8), f);
#pragma unroll
                for (int j = 0; j < 8; ++j) Vt[key * 64 + part * 8 + j] = f[j]; }
            __syncthreads();
            for (int kg = 0; kg < 64; kg += 8) {
                float s[8]; float gm = -1e30f;
#pragma unroll
                for (int kk = 0; kk < 8; ++kk) { float acc = 0.f; const LAS f32x4* kp = (const LAS f32x4*)(Kt + (kg + kk) * 96 + half * 48);
#pragma unroll
                    for (int d4 = 0; d4 < 12; ++d4) { const f32x4 kv = kp[d4]; acc += q[d4 * 4] * kv[0] + q[d4 * 4 + 1] * kv[1] + q[d4 * 4 + 2] * kv[2] + q[d4 * 4 + 3] * kv[3]; }
                    acc += shx(acc, 1, tid & 63);
                    s[kk] = acc; gm = fmaxf(gm, acc); }
                const float mn = fmaxf(m, gm); const float alpha = exp2f(m - mn); m = mn; l *= alpha;
#pragma unroll
                for (int j = 0; j < 32; ++j) o[j] *= alpha;
#pragma unroll
                for (int kk = 0; kk < 8; ++kk) { const float p = exp2f(s[kk] - mn); l += p; const LAS f32x4* vp = (const LAS f32x4*)(Vt + (kg + kk) * 64 + half * 32);
#pragma unroll
                    for (int d4 = 0; d4 < 8; ++d4) { const f32x4 vv = vp[d4]; o[d4 * 4] += p * vv[0]; o[d4 * 4 + 1] += p * vv[1]; o[d4 * 4 + 2] += p * vv[2]; o[d4 * 4 + 3] += p * vv[3]; } }
            }
        }
        { const float inv = 1.f / l;
#pragma unroll
            for (int g = 0; g < 4; ++g) { float f[8];
#pragma unroll
                for (int j = 0; j < 8; ++j) f[j] = o[g * 8 + j] * inv;
                *(v4u*)(MIX + (size_t)qrow * D + h * 64 + half * 32 + g * 8) = pack8(f); } }
    }
}

__device__ __forceinline__ void ssd_scan_naive(const Args& a, int i, bool last, LAS unsigned char* lds) {
    const int tid = otid(), p = tid >> 3, nq = tid & 7;
    bf16* ZX = (bf16*)(a.ws + WS_ZX); const bf16* XBC = (const bf16*)(a.ws + WS_XBC); const float* DT = (const float*)(a.ws + WS_DT); const float* AA = (const float*)(a.ws + WS_AA);
    LAS float* xs = (LAS float*)lds;
    LAS float* Bs = (LAS float*)(lds + 16384);
    LAS float* Cs = (LAS float*)(lds + 16384 + 32768);
    LAS float* dts = (LAS float*)(lds + 16384 + 65536);
    LAS float* as = dts + 64;
    for (int it = blockIdx.x; it < NB * 32; it += gridDim.x) {
        const int b = it >> 5, h = it & 31, g = h >> 3; const float dsk = a.in[I_SD][i * 32 + h];
        for (int dir = 0; dir < 2; ++dir) {
            float stt[16];
#pragma unroll
            for (int n = 0; n < 16; ++n) stt[n] = 0.f;
            for (int seg = 0; seg < 2; ++seg) {
                const int len = seg == 0 ? CTXL : SEQ; const int base = seg == 0 ? TL + b * CTXL : b * SEQ; const bool want_y = !(last && seg == 0);
                for (int cc = 0; cc < len / 64; ++cc) {
                    const int t0 = dir == 0 ? cc * 64 : len - 64 - cc * 64;
                    __syncthreads();
                    { const int tt = tid >> 3, part = tid & 7; float f[8]; unpack8(*(const v4u*)(XBC + (size_t)(base + t0 + tt) * 3072 + h * 64 + part * 8), f);
#pragma unroll
                        for (int j = 0; j < 8; ++j) xs[tt * 64 + part * 8 + j] = f[j]; }
                    for (int q = tid; q < 1024; q += NTHR) { const int tt = q >> 4, part = q & 15; float f[8];
                        unpack8(*(const v4u*)(XBC + (size_t)(base + t0 + tt) * 3072 + 2048 + g * 128 + part * 8), f);
#pragma unroll
                        for (int j = 0; j < 8; ++j) Bs[tt * 128 + part * 8 + j] = f[j];
                        unpack8(*(const v4u*)(XBC + (size_t)(base + t0 + tt) * 3072 + 2560 + g * 128 + part * 8), f);
#pragma unroll
                        for (int j = 0; j < 8; ++j) Cs[tt * 128 + part * 8 + j] = f[j]; }
                    if (tid < 64) { dts[tid] = DT[(size_t)(base + t0 + tid) * 64 + dir * 32 + h]; as[tid] = AA[(size_t)(base + t0 + tid) * 64 + dir * 32 + h]; }
                    __syncthreads();
                    for (int s = 0; s < 64; ++s) {
                        const int tt = dir == 0 ? s : 63 - s;
                        const float dec = __expf(as[tt]); const float xv = xs[tt * 64 + p]; const float xd = xv * dts[tt];
                        const LAS f32x4* bp = (const LAS f32x4*)(Bs + tt * 128 + nq * 16); const LAS f32x4* cp = (const LAS f32x4*)(Cs + tt * 128 + nq * 16);
                        float acc = 0.f;
#pragma unroll
                        for (int n4 = 0; n4 < 4; ++n4) { const f32x4 bv = bp[n4], cv = cp[n4];
#pragma unroll
                            for (int k = 0; k < 4; ++k) { stt[n4 * 4 + k] = dec * stt[n4 * 4 + k] + xd * bv[k]; acc += cv[k] * stt[n4 * 4 + k]; } }
                        acc += shx(acc, 1, tid & 63); acc += shx(acc, 2, tid & 63); acc += shx(acc, 4, tid & 63);
                        if (want_y && nq == 0) { bf16* yp = ZX + (size_t)(base + t0 + tt) * SSD_INP + 2048 + h * 64 + p;
                            const float y = dir == 0 ? acc + dsk * xv : acc + bf1(*yp);
                            *yp = (bf16)f2bf(y); }
                    }
                }
            }
            __syncthreads();
            asm volatile("s_waitcnt vmcnt(0)" ::: "memory");
        }
    }
}

typedef short bf16x8 __attribute__((ext_vector_type(8)));
typedef float f32x16 __attribute__((ext_vector_type(16)));
__device__ __forceinline__ unsigned cvtpk(float lo, float hi) { unsigned r; asm volatile("v_cvt_pk_bf16_f32 %0, %1, %2" : "=v"(r) : "v"(lo), "v"(hi)); return r; }
constexpr int ATT_KP = 208, ATT_VP = 136, ATT_KB = 64 * ATT_KP, ATT_VB = 64 * ATT_VP, ATT_BUF = ATT_KB + ATT_VB;
__device__ __forceinline__ void attn_mfma(const Args& a, LAS unsigned char* lds) {
    const int tid = otid(), wave = tid >> 6, lane = tid & 63, r32 = lane & 31, hh = lane >> 5;
    const bf16* Qb = (const bf16*)(a.ws + WS_Q); const bf16* KVb = (const bf16*)(a.ws + WS_KV); const bf16* KR = (const bf16*)(a.ws + WS_KR); bf16* MIX = (bf16*)(a.ws + WS_MIX);
    const float* ct = (const float*)(a.ws + WS_ROPE); const float* st = ct + SEQ * 16;
    const int kkey0 = tid / 12, kpart0 = tid % 12, kkey1 = (tid + NTHR) / 12, kpart1 = (tid + NTHR) % 12; const bool k1ok = tid + NTHR < 768;
    for (int u = blockIdx.x; u < 576; u += gridDim.x) {
        const bool lat = u < 512; const int b = lat ? (u >> 6) : ((u - 512) >> 3), h = lat ? ((u >> 3) & 7) : ((u - 512) & 7);
        const int ntiles = lat ? (CTXL + SEQ) / 64 : CTXL / 64;
        const int qrow = (lat ? b * SEQ + (u & 7) * 256 : TL + b * CTXL) + wave * 32 + r32;
        bf16x8 qf[6];
#pragma unroll
        for (int s = 0; s < 6; ++s) qf[s] = *(const bf16x8*)(Qb + (size_t)qrow * QW + h * 96 + 16 * s + 8 * hh);
        if (lat) { const int t = qrow & (SEQ - 1);
#pragma unroll
            for (int j = 0; j < 8; j += 2) { float x1[2], x2[2], y1[2], y2[2];
#pragma unroll
                for (int e = 0; e < 2; ++e) { x1[e] = bf1((bf16)qf[4][j + e]); x2[e] = bf1((bf16)qf[5][j + e]); const float c = ct[t * 16 + 8 * hh + j + e], s = st[t * 16 + 8 * hh + j + e];
                    y1[e] = x1[e] * c - x2[e] * s; y2[e] = x1[e] * s + x2[e] * c; }
                const unsigned w1 = pk2(y1[0], y1[1]), w2 = pk2(y2[0], y2[1]);
                qf[4][j] = (short)(w1 & 0xffff); qf[4][j + 1] = (short)(w1 >> 16); qf[5][j] = (short)(w2 & 0xffff); qf[5][j + 1] = (short)(w2 >> 16); } }
        f32x16 o0, o1;
#pragma unroll
        for (int i = 0; i < 16; ++i) { o0[i] = 0.f; o1[i] = 0.f; }
        float m = -1e30f, l = 0.f;
        v4u kreg0, kreg1, vreg;
        const bf16* kp0 = kpart0 < 8 ? KVb + (size_t)kkey0 * KVW + h * 128 + kpart0 * 8 : KR + (size_t)kkey0 * 32 + (kpart0 - 8) * 8; const int ks0 = kpart0 < 8 ? KVW : 32;
        const bf16* kp1 = kpart1 < 8 ? KVb + (size_t)kkey1 * KVW + h * 128 + kpart1 * 8 : KR + (size_t)kkey1 * 32 + (kpart1 - 8) * 8; const int ks1 = kpart1 < 8 ? KVW : 32;
        const bf16* vp0 = KVb + (size_t)lane * KVW + h * 128 + 64 + wave * 8;
#define ATT_LOAD(it) do { const int rb_ = (it) < CTXL / 64 ? TL + b * CTXL + (it) * 64 : b * SEQ + ((it) - CTXL / 64) * 64; \
            kreg0 = *(const v4u*)(kp0 + (size_t)rb_ * ks0); if (k1ok) kreg1 = *(const v4u*)(kp1 + (size_t)rb_ * ks1); vreg = *(const v4u*)(vp0 + (size_t)rb_ * KVW); } while (0)
#define ATT_WRITE(buf) do { LAS unsigned char* kb_ = lds + (buf) * ATT_BUF; LAS unsigned char* vb_ = kb_ + ATT_KB; \
            *(LAS v4u*)(kb_ + kkey0 * ATT_KP + kpart0 * 16) = kreg0; if (k1ok) *(LAS v4u*)(kb_ + kkey1 * ATT_KP + kpart1 * 16) = kreg1; \
            { LAS unsigned short* vp = (LAS unsigned short*)(vb_ + (wave * 8) * ATT_VP + lane * 2); \
              vp[0 * (ATT_VP / 2)] = (unsigned short)(vreg.x & 0xffff); vp[1 * (ATT_VP / 2)] = (unsigned short)(vreg.x >> 16); vp[2 * (ATT_VP / 2)] = (unsigned short)(vreg.y & 0xffff); vp[3 * (ATT_VP / 2)] = (unsigned short)(vreg.y >> 16); \
              vp[4 * (ATT_VP / 2)] = (unsigned short)(vreg.z & 0xffff); vp[5 * (ATT_VP / 2)] = (unsigned short)(vreg.z >> 16); vp[6 * (ATT_VP / 2)] = (unsigned short)(vreg.w & 0xffff); vp[7 * (ATT_VP / 2)] = (unsigned short)(vreg.w >> 16); } } while (0)
        __syncthreads();
        ATT_LOAD(0); ATT_WRITE(0);
        __syncthreads();
        for (int it = 0; it < ntiles; ++it) {
            if (it + 1 < ntiles) ATT_LOAD(it + 1);
            const LAS unsigned char* kb = lds + (it & 1) * ATT_BUF; const LAS unsigned char* vb = kb + ATT_KB;
            f32x16 s0, s1;
#pragma unroll
            for (int i = 0; i < 16; ++i) { s0[i] = 0.f; s1[i] = 0.f; }
#pragma unroll
            for (int s = 0; s < 6; ++s) { const bf16x8 a0 = *(const LAS bf16x8*)(kb + r32 * ATT_KP + (16 * s + 8 * hh) * 2); const bf16x8 a1 = *(const LAS bf16x8*)(kb + (32 + r32) * ATT_KP + (16 * s + 8 * hh) * 2);
                s0 = __builtin_amdgcn_mfma_f32_32x32x16_bf16(a0, qf[s], s0, 0, 0, 0); s1 = __builtin_amdgcn_mfma_f32_32x32x16_bf16(a1, qf[s], s1, 0, 0, 0); }
            float mx = s0[0];
#pragma unroll
            for (int i = 1; i < 16; ++i) mx = fmaxf(mx, s0[i]);
#pragma unroll
            for (int i = 0; i < 16; ++i) mx = fmaxf(mx, s1[i]);
            mx = fmaxf(mx, shx(mx, 32, lane));
            const float mn = fmaxf(m, mx * ATT_SCALE_LOG2E); const float alpha = __builtin_amdgcn_exp2f(m - mn); m = mn;
            float rs = 0.f;
#pragma unroll
            for (int i = 0; i < 16; ++i) { s0[i] = __builtin_amdgcn_exp2f(s0[i] * ATT_SCALE_LOG2E - mn); s1[i] = __builtin_amdgcn_exp2f(s1[i] * ATT_SCALE_LOG2E - mn); rs += s0[i] + s1[i]; }
            l = l * alpha + rs;
#pragma unroll
            for (int i = 0; i < 16; ++i) { o0[i] *= alpha; o1[i] *= alpha; }
            bf16x8 pf[2][2];
#pragma unroll
            for (int s2 = 0; s2 < 2; ++s2) { v4u w0, w1;
                w0.x = cvtpk(s0[8 * s2 + 0], s0[8 * s2 + 1]); w0.y = cvtpk(s0[8 * s2 + 2], s0[8 * s2 + 3]); w0.z = cvtpk(s0[8 * s2 + 4], s0[8 * s2 + 5]); w0.w = cvtpk(s0[8 * s2 + 6], s0[8 * s2 + 7]);
                w1.x = cvtpk(s1[8 * s2 + 0], s1[8 * s2 + 1]); w1.y = cvtpk(s1[8 * s2 + 2], s1[8 * s2 + 3]); w1.z = cvtpk(s1[8 * s2 + 4], s1[8 * s2 + 5]); w1.w = cvtpk(s1[8 * s2 + 6], s1[8 * s2 + 7]);
                pf[0][s2] = __builtin_bit_cast(bf16x8, w0); pf[1][s2] = __builtin_bit_cast(bf16x8, w1); }
#pragma unroll
            for (int t = 0; t < 2; ++t)
#pragma unroll
                for (int s2 = 0; s2 < 2; ++s2) { const int ko = t * 32 + 16 * s2 + 4 * hh;
                    { const v2u lo = *(const LAS v2u*)(vb + r32 * ATT_VP + ko * 2); const v2u hi = *(const LAS v2u*)(vb + r32 * ATT_VP + (ko + 8) * 2);
                      const v4u w = (v4u){lo.x, lo.y, hi.x, hi.y}; o0 = __builtin_amdgcn_mfma_f32_32x32x16_bf16(__builtin_bit_cast(bf16x8, w), pf[t][s2], o0, 0, 0, 0); }
                    { const v2u lo = *(const LAS v2u*)(vb + (32 + r32) * ATT_VP + ko * 2); const v2u hi = *(const LAS v2u*)(vb + (32 + r32) * ATT_VP + (ko + 8) * 2);
                      const v4u w = (v4u){lo.x, lo.y, hi.x, hi.y}; o1 = __builtin_amdgcn_mfma_f32_32x32x16_bf16(__builtin_bit_cast(bf16x8, w), pf[t][s2], o1, 0, 0, 0); } }
            if (it + 1 < ntiles) ATT_WRITE((it + 1) & 1);
            __syncthreads();
        }
#undef ATT_LOAD
#undef ATT_WRITE
        l += shx(l, 32, lane); const float inv = 1.f / l;
        bf16* orow = MIX + (size_t)qrow * D + h * 64 + 4 * hh;
#pragma unroll
        for (int g = 0; g < 4; ++g) {
            v2u w; w.x = pk2(o0[4 * g] * inv, o0[4 * g + 1] * inv); w.y = pk2(o0[4 * g + 2] * inv, o0[4 * g + 3] * inv); *(v2u*)(orow + 8 * g) = w;
            v2u x; x.x = pk2(o1[4 * g] * inv, o1[4 * g + 1] * inv); x.y = pk2(o1[4 * g + 2] * inv, o1[4 * g + 3] * inv); *(v2u*)(orow + 32 + 8 * g) = x; }
    }
}

typedef short v4i16_t __attribute__((ext_vector_type(4)));
__device__ __forceinline__ v2u trread(const LAS unsigned char* p) { return __builtin_bit_cast(v2u, __builtin_amdgcn_ds_read_tr16_b64_v4i16((LAS v4i16_t*)p)); }
constexpr int SP_B = 272, SP_X = 192;
constexpr int SO_B = 0, SO_C = SO_B + 128 * SP_B, SO_XD = SO_C + 128 * SP_B, SO_XW = SO_XD + 128 * SP_X, SO_S = SO_XW + 128 * SP_X, SO_V = SO_S + 64 * SP_B;
static_assert(SO_V + 2 * 2048 <= LDS_BYTES, "ssd lds map");
__device__ __forceinline__ void ssd_scan_mfma(const Args& a, int i, bool last, LAS unsigned char* lds) {
    const int tid = otid(), wave = tid >> 6, lane = tid & 63, r32 = lane & 31, hh = lane >> 5;
    const int pt = wave & 1, lt = wave >> 1;
    const int tq = (lane >> 2) & 3, tp = lane & 3, tblk = (lane >> 4) & 1;
    bf16* ZX = (bf16*)(a.ws + WS_ZX); const bf16* XBC = (const bf16*)(a.ws + WS_XBC); const float* DT = (const float*)(a.ws + WS_DT); const float* AA = (const float*)(a.ws + WS_AA);
    LAS unsigned char* Bl = lds + SO_B; LAS unsigned char* Cl = lds + SO_C; LAS unsigned char* XDl = lds + SO_XD; LAS unsigned char* XWl = lds + SO_XW; LAS unsigned char* Sl = lds + SO_S;
    const int brow = tid >> 4, bpart = tid & 15, xrow = tid >> 3, xpart = tid & 7;
    for (int it = blockIdx.x; it < NB * 32; it += gridDim.x) {
        const int b = it >> 5, h = it & 31, g = h >> 3; const float dsk = a.in[I_SD][i * 32 + h];
        for (int dir = 0; dir < 2; ++dir) {
            f32x16 sacc;
#pragma unroll
            for (int k = 0; k < 16; ++k) sacc[k] = 0.f;
            v4u bq[4], cq[4], xq[2]; float pa0 = 0.f, pa1 = 0.f, pd0 = 0.f, pd1 = 0.f;
#define SSD_ROWBASE(c) ((c) < 2 ? TL + b * CTXL + (dir == 0 ? (c) : 1 - (c)) * 128 : b * SEQ + (dir == 0 ? (c) - 2 : 17 - (c)) * 128)
#define SSD_PF(c) do { const int rb_ = SSD_ROWBASE(c); \
                _Pragma("unroll") for (int k_ = 0; k_ < 4; ++k_) { const bf16* src_ = XBC + (size_t)(rb_ + brow + 32 * k_) * 3072 + 2048 + g * 128 + bpart * 8; bq[k_] = *(const v4u*)src_; cq[k_] = *(const v4u*)(src_ + 512); } \
                _Pragma("unroll") for (int k_ = 0; k_ < 2; ++k_) xq[k_] = *(const v4u*)(XBC + (size_t)(rb_ + xrow + 64 * k_) * 3072 + h * 64 + xpart * 8); \
                if (wave == 0) { const size_t o_ = (size_t)(rb_ + 2 * lane) * 64 + dir * 32 + h; pa0 = AA[o_]; pa1 = AA[o_ + 64]; pd0 = DT[o_]; pd1 = DT[o_ + 64]; } } while (0)
#define SSD_SCAN(vb_) do { if (wave == 0) { LAS float* V_ = (LAS float*)(lds + SO_V + (vb_) * 2048); const float pair_ = pa0 + pa1; float ps_ = pair_; \
                _Pragma("unroll") for (int d_ = 1; d_ < 64; d_ <<= 1) { const int src_ = dir == 0 ? lane - d_ : lane + d_; const float t_ = __builtin_bit_cast(float, __builtin_amdgcn_ds_bpermute((src_ & 63) << 2, __builtin_bit_cast(int, ps_))); if (src_ >= 0 && src_ < 64) ps_ += t_; } \
                const float tot_ = __builtin_bit_cast(float, __builtin_amdgcn_ds_bpermute((dir == 0 ? 63 : 0) << 2, __builtin_bit_cast(int, ps_))); const float ex_ = ps_ - pair_; \
                float c0_, c1_; if (dir == 0) { c0_ = ex_ + pa0; c1_ = c0_ + pa1; } else { c1_ = ex_ + pa1; c0_ = c1_ + pa0; } \
                V_[2 * lane] = c0_; V_[2 * lane + 1] = c1_; V_[128 + 2 * lane] = pd0; V_[128 + 2 * lane + 1] = pd1; V_[256 + 2 * lane] = pd0 * __expf(tot_ - c0_); V_[256 + 2 * lane + 1] = pd1 * __expf(tot_ - c1_); \
                if (lane == 0) V_[384] = tot_; } } while (0)
#define SSD_WRITE(vb_) do { const LAS float* V_ = (const LAS float*)(lds + SO_V + (vb_) * 2048); \
                _Pragma("unroll") for (int k_ = 0; k_ < 4; ++k_) { *(LAS v4u*)(Bl + (brow + 32 * k_) * SP_B + bpart * 16) = bq[k_]; *(LAS v4u*)(Cl + (brow + 32 * k_) * SP_B + bpart * 16) = cq[k_]; } \
                _Pragma("unroll") for (int k_ = 0; k_ < 2; ++k_) { const int s_ = xrow + 64 * k_; const float dt_ = V_[128 + s_], w_ = V_[256 + s_]; float f_[8], g_[8]; unpack8(xq[k_], f_); \
                    _Pragma("unroll") for (int j_ = 0; j_ < 8; ++j_) { g_[j_] = f_[j_] * w_; f_[j_] *= dt_; } \
                    *(LAS v4u*)(XDl + s_ * SP_X + xpart * 16) = pack8(f_); *(LAS v4u*)(XWl + s_ * SP_X + xpart * 16) = pack8(g_); } } while (0)
            __syncthreads();
            SSD_PF(0); SSD_SCAN(0);
            __syncthreads();
            SSD_WRITE(0);
            { LAS v2u* sp = (LAS v2u*)(Sl + (32 * pt + r32) * SP_B + (32 * lt + 4 * hh) * 2);
#pragma unroll
              for (int q = 0; q < 4; ++q) sp[2 * q] = (v2u){0u, 0u}; }
            __syncthreads();
            for (int c = 0; c < 18; ++c) {
                const int cur = c & 1; const LAS float* V = (const LAS float*)(lds + SO_V + cur * 2048);
                const int rowbase = SSD_ROWBASE(c); const bool want_y = !(last && c < 2);
                if (c + 1 < 18) SSD_PF(c + 1);
                if (want_y) {
                    const int l = 32 * lt + r32; const float cl = V[l];
                    bf16* yptr = ZX + (size_t)(rowbase + l) * SSD_INP + 2048 + h * 64 + 32 * pt + 4 * hh;
                    const bf16* xptr = XBC + (size_t)(rowbase + l) * 3072 + h * 64 + 32 * pt + 4 * hh;
                    v2u add[4];
#pragma unroll
                    for (int q = 0; q < 4; ++q) add[q] = dir == 0 ? *(const v2u*)(xptr + 8 * q) : *(const v2u*)(yptr + 8 * q);
                    bf16x8 cf[8];
#pragma unroll
                    for (int ks = 0; ks < 8; ++ks) cf[ks] = *(const LAS bf16x8*)(Cl + l * SP_B + (16 * ks + 8 * hh) * 2);
                    f32x16 y1, y2;
#pragma unroll
                    for (int k = 0; k < 16; ++k) { y1[k] = 0.f; y2[k] = 0.f; }
                    const int st_lo = dir == 0 ? 0 : lt, st_hi = dir == 0 ? lt : 3;
                    for (int st = st_lo; st <= st_hi; ++st) {
                        f32x16 X;
#pragma unroll
                        for (int k = 0; k < 16; ++k) X[k] = 0.f;
#pragma unroll
                        for (int ks = 0; ks < 8; ++ks) { const bf16x8 af = *(const LAS bf16x8*)(Bl + (32 * st + r32) * SP_B + (16 * ks + 8 * hh) * 2); X = __builtin_amdgcn_mfma_f32_32x32x16_bf16(af, cf[ks], X, 0, 0, 0); }
#pragma unroll
                        for (int q = 0; q < 4; ++q) { const f32x4 cs = *(const LAS f32x4*)(V + 32 * st + 8 * q + 4 * hh);
#pragma unroll
                            for (int e = 0; e < 4; ++e) { const int s = 32 * st + 8 * q + 4 * hh + e; const bool ok = dir == 0 ? (s <= l) : (s >= l);
                                const float dec = __expf(fminf(cl - cs[e], 0.f)); X[4 * q + e] = ok ? X[4 * q + e] * dec : 0.f; } }
#pragma unroll
                        for (int ks2 = 0; ks2 < 2; ++ks2) { v4u w; w.x = cvtpk(X[8 * ks2 + 0], X[8 * ks2 + 1]); w.y = cvtpk(X[8 * ks2 + 2], X[8 * ks2 + 3]); w.z = cvtpk(X[8 * ks2 + 4], X[8 * ks2 + 5]); w.w = cvtpk(X[8 * ks2 + 6], X[8 * ks2 + 7]);
                            const LAS unsigned char* tb = XDl + (32 * st + 16 * ks2 + 4 * hh + tq) * SP_X + (32 * pt + 16 * tblk + 4 * tp) * 2;
                            const v2u lo = trread(tb), hi = trread(tb + 8 * SP_X);
                            y1 = __builtin_amdgcn_mfma_f32_32x32x16_bf16(__builtin_bit_cast(bf16x8, (v4u){lo.x, lo.y, hi.x, hi.y}), __builtin_bit_cast(bf16x8, w), y1, 0, 0, 0); }
                    }
#pragma unroll
                    for (int ks = 0; ks < 8; ++ks) { const bf16x8 sf = *(const LAS bf16x8*)(Sl + (32 * pt + r32) * SP_B + (16 * ks + 8 * hh) * 2); y2 = __builtin_amdgcn_mfma_f32_32x32x16_bf16(sf, cf[ks], y2, 0, 0, 0); }
                    const float el = __expf(cl);
#pragma unroll
                    for (int q = 0; q < 4; ++q) { float o[4];
#pragma unroll
                        for (int e = 0; e < 4; ++e) o[e] = y1[4 * q + e] + el * y2[4 * q + e];
                        const float a0 = bflo(add[q].x), a1 = bfhi(add[q].x), a2 = bflo(add[q].y), a3 = bfhi(add[q].y);
                        if (dir == 0) { o[0] += dsk * a0; o[1] += dsk * a1; o[2] += dsk * a2; o[3] += dsk * a3; } else { o[0] += a0; o[1] += a1; o[2] += a2; o[3] += a3; }
                        v2u w; w.x = pk2(o[0], o[1]); w.y = pk2(o[2], o[3]); *(v2u*)(yptr + 8 * q) = w; }
                }
                if (c + 1 < 18) {
                    const float etot = __expf(V[384]);
#pragma unroll
                    for (int k = 0; k < 16; ++k) sacc[k] *= etot;
#pragma unroll
                    for (int ks = 0; ks < 8; ++ks) {
                        const LAS unsigned char* ta = Bl + (16 * ks + 8 * hh + tq) * SP_B + (32 * lt + 16 * tblk + 4 * tp) * 2;
                        const LAS unsigned char* tb = XWl + (16 * ks + 8 * hh + tq) * SP_X + (32 * pt + 16 * tblk + 4 * tp) * 2;
                        const v2u alo = trread(ta), ahi = trread(ta + 4 * SP_B), blo = trread(tb), bhi = trread(tb + 4 * SP_X);
                        sacc = __builtin_amdgcn_mfma_f32_32x32x16_bf16(__builtin_bit_cast(bf16x8, (v4u){alo.x, alo.y, ahi.x, ahi.y}), __builtin_bit_cast(bf16x8, (v4u){blo.x, blo.y, bhi.x, bhi.y}), sacc, 0, 0, 0); }
                    SSD_SCAN(cur ^ 1);
                }
                __syncthreads();
                if (c + 1 < 18) {
                    LAS v2u* sp = (LAS v2u*)(Sl + (32 * pt + r32) * SP_B + (32 * lt + 4 * hh) * 2);
#pragma unroll
                    for (int q = 0; q < 4; ++q) { v2u w; w.x = cvtpk(sacc[4 * q], sacc[4 * q + 1]); w.y = cvtpk(sacc[4 * q + 2], sacc[4 * q + 3]); sp[2 * q] = w; }
                    SSD_WRITE(cur ^ 1);
                }
                __syncthreads();
            }
#undef SSD_ROWBASE
#undef SSD_PF
#undef SSD_SCAN
#undef SSD_WRITE
            asm volatile("s_waitcnt vmcnt(0)" ::: "memory");
        }
    }
}

#ifndef MK_SINGLE
#define MK_SINGLE 1
#endif
struct GemmDesc { const bf16* A; const bf16* Bt; int M, N, K; bf16* O; int ldc; };

__global__ void __launch_bounds__(NTHR, 2) fwd_kernel(Args a) {
    extern __shared__ __attribute__((aligned(16))) unsigned char lds_raw[];
    LAS unsigned char* lds = (LAS unsigned char*)lds_raw;
    unsigned char* ws = a.ws;
    float* XL = a.out; float* XC = (float*)(ws + WS_XC); bf16* H = (bf16*)(ws + WS_H); bf16* Mb = (bf16*)(ws + WS_M);
    const float* MOD = (const float*)(ws + WS_MOD); const float* NW = a.in[I_NORMW];
#if MK_SINGLE == 1
    volatile LAS unsigned* bst = (volatile LAS unsigned*)(lds + LDS_BYTES - 64);
    { const int t0 = otid(); if (t0 < 16) bst[t0] = 0u; }
    __syncthreads();
    const XcdBarrier xbar = xcd_barrier_post((unsigned*)(ws + WS_CTL), bst);
#endif
    for (int s = a.lo; s < a.hi; ++s) {
        GemmDesc g0{}, g1{}; int ng = 0;
#ifndef NO_SIMPLE
        if (s == 0) {
            mod_compute(a, lds);
            rope_tables(a);
            convert_layer(a, 0, lds);
        } else if (s == 1) {
            rowwise(a.in[I_X], a.in[I_CTX], XL, XC, nullptr, nullptr, nullptr, H, MOD, 0, 1024, NW, T);
        } else {
            const int l = (s - 2) / 10, k = (s - 2) % 10, i = l >> 1; const bool even = (l & 1) == 0, last = (l == 3);
            const int MR = last ? TL : T;
            switch (k) {
            case 0:
                if (even) { g0 = GemmDesc{H, (const bf16*)(ws + W_IN), T, HYB_INP, D, (bf16*)(ws + WS_P), HYB_INP}; ng = 1; }
                else      { g0 = GemmDesc{H, (const bf16*)(ws + W_IN), T, SSD_INP, D, (bf16*)(ws + WS_ZX), SSD_INP}; ng = 1; }
                break;
            case 1: if (even) prep_even(a, i); else ssd_conv(a, i); break;
            case 2:
                if (even) { { g0 = GemmDesc{(const bf16*)(ws + WS_CQN), (const bf16*)(ws + W_UQ), T, QW, 384, (bf16*)(ws + WS_Q), QW}; ng = 1; }
                            g1 = GemmDesc{(const bf16*)(ws + WS_CKVN), (const bf16*)(ws + W_UKV), T, KVW, 256, (bf16*)(ws + WS_KV), KVW}; ng = 2; }
                else {
#ifdef SSD_NAIVE
 ssd_scan_naive(a, i, last, lds);
#else
 ssd_scan_mfma(a, i, last, lds);
#endif
 }
                break;
            case 3: if (even) {
#ifdef ATTN_NAIVE
 attn_naive(a, lds);
#else
 attn_mfma(a, lds);
#endif
 } else gatenorm(a, i, MR); break;
            case 4:
                if (even) { g0 = GemmDesc{(const bf16*)(ws + WS_MIX), (const bf16*)(ws + W_OUT), MR, D, D, Mb, D}; ng = 1; }
                else      { g0 = GemmDesc{(const bf16*)(ws + WS_XBC), (const bf16*)(ws + W_OUT), MR, D, 2048, Mb, D}; ng = 1; }
                break;
            case 5: rowwise(XL, XC, XL, XC, Mb, MOD + (size_t)l * 9 * MODW + 2048, NW + (l * 4 + 1) * D, H, MOD + (size_t)l * 9 * MODW, 3072, 4096, NW + (l * 4 + 2) * D, MR); break;
            case 6: { g0 = GemmDesc{H, (const bf16*)(ws + W_UP), MR, UPW, D, (bf16*)(ws + WS_U), UPW}; ng = 1; } break;
            case 7: convgate(a, l, MR); break;
            case 8: { g0 = GemmDesc{(const bf16*)(ws + WS_G), (const bf16*)(ws + W_DN), MR, D, DFF, Mb, D}; ng = 1; } break;
            case 9:
                if (!last) { rowwise(XL, XC, XL, XC, Mb, MOD + (size_t)l * 9 * MODW + 5120, NW + (l * 4 + 3) * D, H, MOD + (size_t)(l + 1) * 9 * MODW, 0, 1024, NW + ((l + 1) * 4 + 0) * D, T);
                             convert_layer(a, l + 1, lds); }
                else rowwise(XL, XC, XL, XC, Mb, MOD + (size_t)l * 9 * MODW + 5120, NW + (l * 4 + 3) * D, nullptr, MOD, 0, 0, NW, TL);
                break;
            }
        }
#else
        { g0 = GemmDesc{H, (const bf16*)(ws + W_IN), T, a.hi * 256, a.lo * 128, (bf16*)(ws + WS_P), HYB_INP}; ng = 1; }
#endif
        for (int gi = 0; gi < ng; ++gi) {
            const bool f = (gi == 0);
            pg8::Gemm g{f ? g0.A : g1.A, f ? g0.Bt : g1.Bt, f ? g0.M : g1.M, f ? g0.N : g1.N, f ? g0.K : g1.K}; pg8::StaticOrder S; S.init(g.M, g.N, (int)gridDim.x, (int)blockIdx.x);
            pg8::EpiStore E{f ? g0.O : g1.O, f ? g0.ldc : g1.ldc};
#ifndef NO_GEMM
            pg8::gemm_phase<pg8::EpiStore, pg8::StaticOrder, true, true>(lds, g, S, E);
#endif
            __syncthreads();
        }
        if (s + 1 < a.hi) {
#if MK_SINGLE == 1
            xcd_barrier(xbar);
#elif MK_SINGLE == 2
            cg::this_grid().sync();
#endif
        }
    }
}

extern "C" void kernel_launch(void* const* d_in, const int* in_sizes, int n_in, void* d_out, int out_size, void* d_ws, size_t ws_size, hipStream_t stream) {
    static int grid = 0;
    if (grid == 0) {
        if (n_in != 25 || out_size != TL * D || ws_size < WS_END) { fprintf(stderr, "kernel_launch: unexpected problem (n_in %d out %d ws %zu need %zu)\n", n_in, out_size, ws_size, (size_t)WS_END); grid = -1; return; }
        if (hipFuncSetAttribute((const void*)fwd_kernel, hipFuncAttributeMaxDynamicSharedMemorySize, LDS_BYTES) != hipSuccess) { fprintf(stderr, "kernel_launch: hipFuncSetAttribute failed\n"); grid = -1; return; }
        int dev = 0, cus = 0, per_cu = 0;
        hipGetDevice(&dev); hipDeviceGetAttribute(&cus, hipDeviceAttributeMultiprocessorCount, dev);
        hipOccupancyMaxActiveBlocksPerMultiprocessor(&per_cu, (const void*)fwd_kernel, NTHR, LDS_BYTES);
        (void)hipGetLastError();
        if (per_cu < 1) { fprintf(stderr, "kernel_launch: occupancy query says %d blocks per CU\n", per_cu); }
        grid = cus;
    }
    if (grid < 0) return;
#if MK_SINGLE == 1
    if (hipMemsetAsync((char*)d_ws + WS_CTL, 0, CTL_ZERO_BYTES, stream) != hipSuccess) { fprintf(stderr, "kernel_launch: memset failed\n"); return; }
#endif
    Args a{};
    for (int i = 0; i < 25; ++i) a.in[i] = (const float*)d_in[i];
    a.out = (float*)d_out; a.ws = (unsigned char*)d_ws;
#if MK_SINGLE
    a.lo = 0; a.hi = NSTEP + 1;
    void* args[] = {&a};
    hipError_t e = hipLaunchCooperativeKernel((const void*)fwd_kernel, dim3(grid), dim3(NTHR), args, LDS_BYTES, stream);
    if (e != hipSuccess) fprintf(stderr, "cooperative launch failed: %s (grid %d)\n", hipGetErrorString(e), grid);
#else
    for (int s = 0; s < NSTEP + 1; ++s) { a.lo = s; a.hi = s + 1; hipLaunchKernelGGL(fwd_kernel, dim3(grid), dim3(NTHR), LDS_BYTES, stream, a); }
#endif
}
```

```cpp
#include <hip/hip_runtime.h>
#include <hip/hip_cooperative_groups.h>
#include <cstdio>
#include <cstdint>
namespace cg = cooperative_groups;
__device__ __forceinline__ int otid() { int t = threadIdx.x; asm volatile("" : "+v"(t)); return t; }
__device__ __forceinline__ float shx(float v, int mask, int lane) { return __builtin_bit_cast(float, __builtin_amdgcn_ds_bpermute((lane ^ mask) << 2, __builtin_bit_cast(int, v))); }
#define LAS __attribute__((address_space(3)))
#define XB_TMO      128
#define XB_XCNT(j)  (256  + 64 * (j))
#define XB_XSUB(j)  (1280 + 64 * (j))
#define XB_XGEN(j)  (2304 + 64 * (j))
#define XB_TOP      3328
#define XB_TOPGEN   3392
#define XCD_BAR_WORDS 3456
#define XB_SPIN_CAP (1u << 18)

__device__ __forceinline__ unsigned xb_ld(unsigned* p)              { return __hip_atomic_load(p, __ATOMIC_RELAXED, __HIP_MEMORY_SCOPE_AGENT); }
__device__ __forceinline__ unsigned xb_add(unsigned* p, unsigned v) { return __hip_atomic_fetch_add(p, v, __ATOMIC_RELAXED, __HIP_MEMORY_SCOPE_AGENT); }
__device__ __forceinline__ unsigned xb_xcc_id() { return (unsigned)__builtin_amdgcn_s_getreg((3 << 11) | 20) & 0xFu; }
#define XB_SPIN(cond, bar) do { unsigned _sp = 0; while (cond) { __builtin_amdgcn_s_sleep(1); \
    if ((++_sp & 255u) == 0u) { if (xb_ld(&(bar)[XB_TMO])) break; if (_sp > XB_SPIN_CAP) { atomicAdd(&(bar)[XB_TMO], 1u); break; } } } } while (0)

struct XcdBarrier {
    unsigned* bar; unsigned x;
    volatile LAS unsigned* st;
};

__device__ __forceinline__ XcdBarrier xcd_barrier_post(unsigned* bar, volatile LAS unsigned* st) {
    XcdBarrier b; b.bar = bar; b.x = xb_xcc_id(); b.st = st;
    if (otid() == 0) (void)xb_add(&bar[XB_XCNT(b.x)], 1u);
    return b;
}
__device__ __forceinline__ void xcd_barrier_complete(unsigned* bar, unsigned x, unsigned& nloc, unsigned& nx) {
    const unsigned G = gridDim.x * gridDim.y * gridDim.z;
    unsigned sum, cnt, mine, sp = 0u;
    for (;;) {
        sum = 0u; cnt = 0u; mine = 0u;
#pragma unroll
        for (unsigned j = 0; j < 16; ++j) { const unsigned c = xb_ld(&bar[XB_XCNT(j)]); sum += c; cnt += (c > 0u) ? 1u : 0u; mine = (j == x) ? c : mine; }
        if (sum == G) break;
        __builtin_amdgcn_s_sleep(1);
        if ((++sp & 255u) == 0u) { if (xb_ld(&bar[XB_TMO])) break; if (sp > XB_SPIN_CAP) { atomicAdd(&bar[XB_TMO], 1u); break; } }
    }
    nloc = mine > 0u ? mine : 1u; nx = cnt > 0u ? cnt : 1u;
}

__device__ __forceinline__ void xcd_barrier(const XcdBarrier& b) {
    asm volatile("s_waitcnt vmcnt(0)" ::: "memory");
    __syncthreads();
    if (otid() == 0) {
        unsigned* bar = b.bar;
        __builtin_amdgcn_s_waitcnt(0);
        unsigned nloc = b.st[0], nx = b.st[1];
        if (nloc == 0u) { xcd_barrier_complete(bar, b.x, nloc, nx); b.st[0] = nloc; b.st[1] = nx; }
        const unsigned old = xb_add(&bar[XB_XSUB(b.x)], 1u);
        const unsigned gen = old / nloc;
        if (old + 1u == (gen + 1u) * nloc) {
            __builtin_amdgcn_fence(__ATOMIC_RELEASE, "agent");
            asm volatile("s_waitcnt vmcnt(0)" ::: "memory");
            const unsigned og = xb_add(&bar[XB_TOP], 1u);
            const unsigned tg = og / nx;
            if (og + 1u == (tg + 1u) * nx) xb_add(&bar[XB_TOPGEN], 1u);
            else XB_SPIN(xb_ld(&bar[XB_TOPGEN]) == tg, bar);
            __builtin_amdgcn_fence(__ATOMIC_ACQUIRE, "agent");
            xb_add(&bar[XB_XGEN(b.x)], 1u);
            asm volatile("s_waitcnt vmcnt(0)" ::: "memory");
        } else {
            XB_SPIN(xb_ld(&bar[XB_XGEN(b.x)]) == gen, bar);
            __builtin_amdgcn_fence(__ATOMIC_ACQUIRE, "agent");
            asm volatile("s_waitcnt vmcnt(0)" ::: "memory");
        }
    }
    __syncthreads();
}
namespace pg8 {
#define PG8_LAS __attribute__((address_space(3)))
typedef unsigned short bf16_t;
typedef short bf16x8 __attribute__((ext_vector_type(8)));
typedef float f32x4 __attribute__((ext_vector_type(4)));
typedef unsigned u32x4 __attribute__((ext_vector_type(4)));
constexpr int BM = 256, BK = 64, HALF = 128, HTB = HALF * BK * 2  , STAGE_BYTES = 8 * HTB, NXCD = 8, WGM = 8;

__host__ __device__ __forceinline__ int lds_byte(int r, int c) { const int st = (r >> 4) * 2 + (c >> 5), rr = r & 15, cc = c & 31, ob = rr * 64 + cc * 2; return st * 1024 + (ob ^ (((ob >> 9) & 1) << 5)); }
__host__ __device__ __forceinline__ void stage_rc(int b, int& R, int& C) { const int st = b / 1024, sb = b % 1024, swz = sb ^ (((sb >> 9) & 1) << 5); R = (st >> 1) * 16 + swz / 64; C = (st & 1) * 32 + (swz % 64) / 2; }
__host__ __device__ __forceinline__ int perm32(int rho) { const int n = rho >> 4, i = rho & 15; return 8 * (i >> 2) + 4 * n + (i & 3); }

struct Unit { int pm, pn; };
struct Gemm { const bf16_t* A; const bf16_t* Bt; int M, N, K; };

struct StaticOrder {
    int nM, nN, nwg, G, c;
    __host__ __device__ void init(int M, int N, int G_, int c_) { nM = M / BM; nN = N / BM; nwg = nM * nN; G = G_; c = c_; }
    __host__ __device__ bool next(int i, Unit& u) const {
        const long L = (long)i * G + c; if (L >= nwg) return false;
        int wgid = (int)L; { const int q = nwg / NXCD, r = nwg % NXCD, xcd = wgid % NXCD, off = wgid / NXCD; wgid = (xcd < r ? xcd * (q + 1) : r * (q + 1) + (xcd - r) * q) + off; }
        const int nig = WGM * nN, gid = wgid / nig, fm = gid * WGM, gsz = (nM - fm) < WGM ? (nM - fm) : WGM;
        u.pm = fm + ((wgid % nig) % gsz); u.pn = (wgid % nig) / gsz; return true;
    }
    __device__ __forceinline__ void a_ready(const Unit&) const {}
    __device__ __forceinline__ void done(const Unit&) const {}
};

__device__ __forceinline__ unsigned cvt_pk_bf16(float lo, float hi) { unsigned r; asm volatile("v_cvt_pk_bf16_f32 %0, %1, %2" : "=v"(r) : "v"(lo), "v"(hi)); return r; }
struct EpiStore {
    static constexpr bool PERM = true, AFTER_DRAIN = false;
    bf16_t* O; int ldc;
    __device__ __forceinline__ void operator()(const f32x4 (&acc)[2][2][4][2], const Unit& u, int wr, int wc, int fr, int fq) const {
        const int row0 = u.pm * BM + wr * 64 + fr; const int col0 = u.pn * BM + wc * 32 + 8 * fq;
#pragma unroll
        for (int ai = 0; ai < 2; ++ai)
#pragma unroll
            for (int m = 0; m < 4; ++m) { bf16_t* rowp = O + (size_t)(row0 + ai * HALF + m * 16) * ldc + col0;
#pragma unroll
                for (int bj = 0; bj < 2; ++bj) { const f32x4 v0 = acc[ai][bj][m][0], v1 = acc[ai][bj][m][1];
                    u32x4 w; w.x = cvt_pk_bf16(v0[0], v0[1]); w.y = cvt_pk_bf16(v0[2], v0[3]); w.z = cvt_pk_bf16(v1[0], v1[1]); w.w = cvt_pk_bf16(v1[2], v1[3]);
                    *(u32x4*)(rowp + bj * HALF) = w; } }
    }
};
template <class Epi, class Sched, bool ALIGN_EPI = false, bool SP2 = false>
__device__ __forceinline__ void gemm_phase(PG8_LAS unsigned char* lds, const Gemm g, const Sched& S, const Epi& E) {
    const int tid = otid(), wid = __builtin_amdgcn_readfirstlane(tid >> 6), lane = tid & 63, wr = wid >> 2, wc = wid & 3, fr = lane & 15, fq = lane >> 4;
    const int K = g.K, nt = K / BK;
    unsigned voffA[2], voffB[2];
#pragma unroll
    for (int i = 0; i < 2; ++i) { int R, C; stage_rc(tid * 16 + i * 8192, R, C); const int Rb = Epi::PERM ? ((R & ~31) + perm32(R & 31)) : R;
        voffA[i] = (unsigned)(R * K + C) * 2u; voffB[i] = (unsigned)(Rb * K + C) * 2u; }
    const size_t kstep = (size_t)(BK * 2);
    const size_t hstep = (size_t)HALF * K * 2;
    const size_t tstep = 2 * hstep;
    const unsigned ldsw = (unsigned)wid * 1024u;
    const int aoff = lds_byte(wr * 64 + fr, fq * 8), boff = lds_byte(wc * 32 + fr, fq * 8);
#define PG8_SA(b, h) (((b) * 2 + (h)) * HTB)
#define PG8_SB(b, h) ((4 + (b) * 2 + (h)) * HTB)
#define PG8_STAGE(bufoff, gbase, voff) do { _Pragma("unroll") for (int _i = 0; _i < 2; ++_i) \
        __builtin_amdgcn_global_load_lds((const unsigned*)((const char*)(gbase) + (voff)[_i]), (PG8_LAS unsigned*)(lds + (bufoff) + ldsw + _i * 8192), 16, 0, 0); } while (0)
#define PG8_LDA(dst, b, h) do { _Pragma("unroll") for (int m = 0; m < 4; ++m) _Pragma("unroll") for (int k = 0; k < 2; ++k) dst[m][k] = *(const PG8_LAS bf16x8*)(lds + PG8_SA(b, h) + aoff + m * 2048 + k * 1024); } while (0)
#define PG8_LDB(dst, b, h) do { _Pragma("unroll") for (int n = 0; n < 2; ++n) _Pragma("unroll") for (int k = 0; k < 2; ++k) dst[n][k] = *(const PG8_LAS bf16x8*)(lds + PG8_SB(b, h) + boff + n * 2048 + k * 1024); } while (0)
#define PG8_MMA(ai, bj, At, Bt) do { __builtin_amdgcn_s_setprio(1); _Pragma("unroll") for (int m = 0; m < 4; ++m) _Pragma("unroll") for (int n = 0; n < 2; ++n) _Pragma("unroll") for (int k = 0; k < 2; ++k) \
        acc[ai][bj][m][n] = __builtin_amdgcn_mfma_f32_16x16x32_bf16(Bt[n][k], At[m][k], acc[ai][bj][m][n], 0, 0, 0); __builtin_amdgcn_s_setprio(0); } while (0)
#define PG8_WAIT_V(n) asm volatile("s_waitcnt vmcnt(" #n ")" ::: "memory")
#define PG8_WAIT_L(n) asm volatile("s_waitcnt lgkmcnt(" #n ")" ::: "memory")
#define PG8_BAR __builtin_amdgcn_s_barrier()
#define PG8_SCHED __builtin_amdgcn_sched_barrier(0)
    Unit cur, nxt; int ui = 0;
    if (!S.next(0, cur)) return;
    f32x4 acc[2][2][4][2];
#pragma unroll
    for (int a = 0; a < 2; ++a)
#pragma unroll
        for (int b = 0; b < 2; ++b)
#pragma unroll
            for (int m = 0; m < 4; ++m)
#pragma unroll
                for (int n = 0; n < 2; ++n) acc[a][b][m][n] = (f32x4){0.f, 0.f, 0.f, 0.f};
    bf16x8 At[4][2], B0[2][2], B1[2][2];
    const char* cA = (const char*)g.A + (size_t)cur.pm * tstep; const char* cB = (const char*)g.Bt + (size_t)cur.pn * tstep;
    S.a_ready(cur);
    if constexpr (SP2) {
        PG8_STAGE(PG8_SB(0, 0), cB, voffB); PG8_STAGE(PG8_SB(0, 1), cB + hstep, voffB); PG8_STAGE(PG8_SA(0, 0), cA, voffA); PG8_STAGE(PG8_SA(0, 1), cA + hstep, voffA);
        if (wr == 1) PG8_BAR;
        PG8_WAIT_V(2); PG8_BAR;
        PG8_STAGE(PG8_SB(1, 0), cB + kstep, voffB); PG8_STAGE(PG8_SA(1, 0), cA + kstep, voffA); PG8_STAGE(PG8_SB(1, 1), cB + hstep + kstep, voffB);
        PG8_WAIT_V(6); PG8_BAR;
    } else {
        PG8_STAGE(PG8_SB(0, 0), cB, voffB); PG8_STAGE(PG8_SA(0, 0), cA, voffA); PG8_STAGE(PG8_SB(0, 1), cB + hstep, voffB); PG8_STAGE(PG8_SA(0, 1), cA + hstep, voffA);
        if (wr == 1) PG8_BAR;
        PG8_WAIT_V(4); PG8_BAR;
        PG8_STAGE(PG8_SB(1, 0), cB + kstep, voffB); PG8_STAGE(PG8_SA(1, 0), cA + kstep, voffA); PG8_STAGE(PG8_SB(1, 1), cB + hstep + kstep, voffB);
        PG8_WAIT_V(6); PG8_BAR;
    }
    for (;;) {
        const bool has_next = S.next(ui + 1, nxt);
        const char* nA = has_next ? (const char*)g.A + (size_t)nxt.pm * tstep : cA; const char* nB = has_next ? (const char*)g.Bt + (size_t)nxt.pn * tstep : cB;
        for (int t = 0; t < nt; t += 2) {
            const bool last = (t == nt - 2);
            const char* a1 = cA + (size_t)(t + 1) * kstep;
            const char* a2 = last ? nA : cA + (size_t)(t + 2) * kstep; const char* b2 = last ? nB : cB + (size_t)(t + 2) * kstep;
            const char* a3 = a2 + kstep; const char* b3 = b2 + kstep;
            if (last && has_next) S.a_ready(nxt);
            if constexpr (SP2) {
            PG8_LDB(B0, 0, 0); PG8_LDB(B1, 0, 1); PG8_SCHED; PG8_LDA(At, 0, 0); PG8_STAGE(PG8_SA(1, 1), a1 + hstep, voffA);
            PG8_WAIT_V(8); PG8_WAIT_L(0); PG8_BAR; PG8_MMA(0, 0, At, B0); PG8_MMA(0, 1, At, B1); PG8_BAR; PG8_SCHED;
            PG8_LDA(At, 0, 1); PG8_STAGE(PG8_SB(0, 0), b2, voffB); PG8_STAGE(PG8_SB(0, 1), b2 + hstep, voffB); PG8_STAGE(PG8_SA(0, 0), a2, voffA);
            PG8_WAIT_V(8); PG8_WAIT_L(0); PG8_BAR; PG8_MMA(1, 0, At, B0); PG8_MMA(1, 1, At, B1); PG8_BAR; PG8_SCHED;
            PG8_LDB(B0, 1, 0); PG8_LDB(B1, 1, 1); PG8_SCHED; PG8_LDA(At, 1, 0); PG8_STAGE(PG8_SA(0, 1), a2 + hstep, voffA);
            PG8_WAIT_V(8); PG8_WAIT_L(0); PG8_BAR; PG8_MMA(0, 0, At, B0); PG8_MMA(0, 1, At, B1); PG8_BAR; PG8_SCHED;
            PG8_LDA(At, 1, 1); PG8_STAGE(PG8_SB(1, 0), b3, voffB); PG8_STAGE(PG8_SB(1, 1), b3 + hstep, voffB); PG8_STAGE(PG8_SA(1, 0), a3, voffA);
            PG8_WAIT_V(8); PG8_WAIT_L(0); PG8_BAR; PG8_MMA(1, 0, At, B0); PG8_MMA(1, 1, At, B1); PG8_BAR; PG8_SCHED;
            } else {
            PG8_LDB(B0, 0, 0); PG8_SCHED; PG8_LDA(At, 0, 0); PG8_STAGE(PG8_SA(1, 1), a1 + hstep, voffA);
            PG8_WAIT_L(8); PG8_BAR; PG8_WAIT_L(0); PG8_MMA(0, 0, At, B0); PG8_BAR; PG8_SCHED;
            PG8_LDB(B1, 0, 1); PG8_STAGE(PG8_SB(0, 0), b2, voffB);
            PG8_BAR; PG8_WAIT_L(0); PG8_MMA(0, 1, At, B1); PG8_BAR;
            PG8_LDA(At, 0, 1); PG8_STAGE(PG8_SA(0, 0), a2, voffA);
            PG8_BAR; PG8_WAIT_L(0); PG8_MMA(1, 0, At, B0); PG8_BAR; PG8_SCHED;
            PG8_STAGE(PG8_SB(0, 1), b2 + hstep, voffB);
            PG8_WAIT_V(6); PG8_BAR; PG8_MMA(1, 1, At, B1); PG8_BAR;
            PG8_LDB(B0, 1, 0); PG8_SCHED; PG8_LDA(At, 1, 0); PG8_STAGE(PG8_SA(0, 1), a2 + hstep, voffA);
            PG8_WAIT_L(8); PG8_BAR; PG8_WAIT_L(0); PG8_MMA(0, 0, At, B0); PG8_BAR; PG8_SCHED;
            PG8_LDB(B1, 1, 1); PG8_STAGE(PG8_SB(1, 0), b3, voffB);
            PG8_BAR; PG8_WAIT_L(0); PG8_MMA(0, 1, At, B1); PG8_BAR;
            PG8_LDA(At, 1, 1); PG8_STAGE(PG8_SA(1, 0), a3, voffA);
            PG8_BAR; PG8_WAIT_L(0); PG8_MMA(1, 0, At, B0); PG8_BAR; PG8_SCHED;
            PG8_STAGE(PG8_SB(1, 1), b3 + hstep, voffB);
            PG8_WAIT_V(6); PG8_BAR; PG8_MMA(1, 1, At, B1); PG8_BAR;
            }
        }
        if constexpr (ALIGN_EPI) { if (wr == 0) PG8_BAR; }
        if constexpr (!Epi::AFTER_DRAIN) { E(acc, cur, wr, wc, fr, fq); S.done(cur); }
        if (!has_next) break;
#pragma unroll
        for (int a = 0; a < 2; ++a)
#pragma unroll
            for (int b = 0; b < 2; ++b)
#pragma unroll
                for (int m = 0; m < 4; ++m)
#pragma unroll
                    for (int n = 0; n < 2; ++n) acc[a][b][m][n] = (f32x4){0.f, 0.f, 0.f, 0.f};
        cur = nxt; cA = nA; cB = nB; ++ui;
        if constexpr (ALIGN_EPI) { if (wr == 1) PG8_BAR; }
    }
    PG8_WAIT_V(0);
    if constexpr (!ALIGN_EPI) { if (wr == 0) PG8_BAR; }
    PG8_BAR;
    if constexpr (Epi::AFTER_DRAIN) { E.fused(acc, cur, wr, wc, fr, fq, lds, wid, lane); S.done(cur); }
#undef PG8_SA
#undef PG8_SB
#undef PG8_STAGE
#undef PG8_LDA
#undef PG8_LDB
#undef PG8_MMA
#undef PG8_WAIT_V
#undef PG8_WAIT_L
#undef PG8_BAR
#undef PG8_SCHED
}
}

typedef unsigned short bf16;
typedef unsigned v4u __attribute__((ext_vector_type(4)));
typedef unsigned v2u __attribute__((ext_vector_type(2)));
typedef float f32x4 __attribute__((ext_vector_type(4)));
constexpr int NWAVES = 8, NTHR = 512;
constexpr int D = 1024, NB = 8, SEQ = 2048, CTXL = 256, TL = NB * SEQ, TC = NB * CTXL, T = TL + TC;
constexpr int HYB_IN = 2208, HYB_INP = 2304, SSD_IN = 5184, SSD_INP = 5376, DFF = 2816, UPW = 5632;
constexpr int QW = 768, KVW = 1024, MODW = 6144;
constexpr float EPS = 1e-6f;
constexpr int NSTEP = 1 + 4 * 10;
constexpr float ATT_SCALE_LOG2E = 0.10206207261596577f * 1.4426950408889634f;

constexpr size_t MiB = 1u << 20;
constexpr size_t WS_CTL = 0, CTL_ZERO_BYTES = 64 * 1024;
constexpr size_t WS_MOD = 1 * MiB;
constexpr size_t WS_ROPE = 2 * MiB;
constexpr size_t W_UP = 3 * MiB;
constexpr size_t W_DN = W_UP + (size_t)UPW * D * 2;
constexpr size_t W_IN = W_DN + (size_t)D * DFF * 2;
constexpr size_t W_OUT = W_IN + (size_t)SSD_INP * D * 2;
constexpr size_t W_UQ = W_OUT + (size_t)D * 2048 * 2;
constexpr size_t W_UKV = W_UQ + (size_t)QW * 384 * 2;
constexpr size_t W_END = W_UKV + (size_t)KVW * 256 * 2;
constexpr size_t WS_XC = 36 * MiB;
constexpr size_t WS_H = 44 * MiB;
constexpr size_t WS_DT = WS_H, WS_AA = WS_H + (size_t)T * 64 * 4;
constexpr size_t WS_BIG = 80 * MiB;
constexpr size_t WS_M = WS_BIG;
constexpr size_t WS_P = WS_BIG;
constexpr size_t WS_Q = WS_BIG + 81 * MiB;
constexpr size_t WS_KV = WS_BIG + 108 * MiB;
constexpr size_t WS_KR = WS_BIG + 144 * MiB;
constexpr size_t WS_CQN = WS_BIG + 146 * MiB;
constexpr size_t WS_CKVN = WS_BIG + 160 * MiB;
constexpr size_t WS_MIX = WS_BIG + 170 * MiB;
constexpr size_t WS_U = WS_BIG;
constexpr size_t WS_G = WS_BIG + 198 * MiB;
constexpr size_t WS_ZX = WS_BIG;
constexpr size_t WS_XBC = WS_BIG + 189 * MiB;
constexpr size_t WS_END = WS_BIG + 297 * MiB;
static_assert(W_END <= WS_XC && WS_G + (size_t)T * DFF * 2 <= WS_END && WS_XBC + (size_t)T * 3072 * 2 <= WS_END && WS_ZX + (size_t)T * SSD_INP * 2 <= WS_XBC, "ws map");
static_assert(WS_AA + (size_t)T * 64 * 4 <= WS_BIG && WS_MIX + (size_t)T * D * 2 <= WS_END && WS_Q + (size_t)T * QW * 2 <= WS_KV && WS_P + (size_t)T * HYB_INP * 2 <= WS_Q, "ws map 2");
constexpr int LDS_BYTES = 147456;

struct Args { const float* in[25]; float* out; unsigned char* ws; int lo, hi; };
enum { I_X = 0, I_C, I_CTX, I_CCTX, I_MODW, I_MODB, I_NORMW, I_WUP, I_FCONV, I_WDN, I_HIN, I_QNORM, I_KVNORM, I_WUQ, I_WUKV, I_SCONV, I_HOUT, I_SIN, I_SCONVW, I_SCONVB, I_ALOG, I_DTB, I_SD, I_SNORM, I_SOUT };

__device__ __forceinline__ unsigned f2bf(float f) { unsigned u = __builtin_bit_cast(unsigned, f); return (u + 0x7fffu + ((u >> 16) & 1u)) >> 16; }
__device__ __forceinline__ unsigned pk2(float lo, float hi) { return f2bf(lo) | (f2bf(hi) << 16); }
__device__ __forceinline__ float bflo(unsigned u) { return __builtin_bit_cast(float, u << 16); }
__device__ __forceinline__ float bfhi(unsigned u) { return __builtin_bit_cast(float, u & 0xffff0000u); }
__device__ __forceinline__ float bf1(bf16 b) { return __builtin_bit_cast(float, (unsigned)b << 16); }
__device__ __forceinline__ float silu_f(float x) { return x / (1.f + __expf(-x)); }
__device__ __forceinline__ float wave_sum(float v, int lane) {
#pragma unroll
    for (int o = 1; o < 64; o <<= 1) v += shx(v, o, lane);
    return v;
}
__device__ __forceinline__ void unpack8(const v4u w, float (&f)[8]) { f[0] = bflo(w.x); f[1] = bfhi(w.x); f[2] = bflo(w.y); f[3] = bfhi(w.y); f[4] = bflo(w.z); f[5] = bfhi(w.z); f[6] = bflo(w.w); f[7] = bfhi(w.w); }
__device__ __forceinline__ v4u pack8(const float (&f)[8]) { v4u w; w.x = pk2(f[0], f[1]); w.y = pk2(f[2], f[3]); w.z = pk2(f[4], f[5]); w.w = pk2(f[6], f[7]); return w; }
__device__ __forceinline__ bool has_prev(int r) { return r < TL ? (r & (SEQ - 1)) != 0 : ((r - TL) & (CTXL - 1)) != 0; }
__device__ __forceinline__ bool has_next(int r) { return r < TL ? (r & (SEQ - 1)) != SEQ - 1 : ((r - TL) & (CTXL - 1)) != CTXL - 1; }

__device__ __forceinline__ void mod_compute(const Args& a, LAS unsigned char* lds) {
    LAS float* sc = (LAS float*)lds;
    LAS float* red = (LAS float*)(lds + 36864);
    const int tid = otid();
    float* MOD = (float*)(a.ws + WS_MOD);
    for (int i = tid; i < 9 * 1024; i += NTHR) { const int c = i >> 10, k = i & 1023; const float v = c < 8 ? a.in[I_C][c * 1024 + k] : a.in[I_CCTX][k]; sc[i] = silu_f(v); }
    __syncthreads();
    for (int item = blockIdx.x; item < 4 * 96; item += gridDim.x) {
        const int l = item / 96, cb = item % 96;
        const float* W = a.in[I_MODW] + (size_t)l * 1024 * MODW + cb * 64;
        const int cgp = tid & 15, kg = tid >> 4;
        float acc[9][4];
#pragma unroll
        for (int c = 0; c < 9; ++c) { acc[c][0] = 0.f; acc[c][1] = 0.f; acc[c][2] = 0.f; acc[c][3] = 0.f; }
#pragma unroll 4
        for (int kk = 0; kk < 32; ++kk) { const int k = kg * 32 + kk; const f32x4 w = *(const f32x4*)(W + (size_t)k * MODW + cgp * 4);
#pragma unroll
            for (int c = 0; c < 9; ++c) { const float s = sc[c * 1024 + k]; acc[c][0] += s * w[0]; acc[c][1] += s * w[1]; acc[c][2] += s * w[2]; acc[c][3] += s * w[3]; } }
#pragma unroll
        for (int c = 0; c < 9; ++c)
#pragma unroll
            for (int j = 0; j < 4; ++j) red[kg * 576 + c * 64 + cgp * 4 + j] = acc[c][j];
        __syncthreads();
        for (int o = tid; o < 576; o += NTHR) { float s = 0.f;
            for (int g = 0; g < 32; ++g) s += red[g * 576 + o];
            const int c = o >> 6, col = o & 63; MOD[(size_t)(l * 9 + c) * MODW + cb * 64 + col] = s + a.in[I_MODB][l * MODW + cb * 64 + col]; }
        __syncthreads();
    }
}
__device__ __forceinline__ void rope_tables(const Args& a) {
    float* ct = (float*)(a.ws + WS_ROPE); float* st = ct + SEQ * 16;
    for (int i = blockIdx.x * NTHR + otid(); i < SEQ * 16; i += gridDim.x * NTHR) {
        const int t = i >> 4, j = i & 15; const int pos = j < 8 ? (t >> 6) : (t & 63); const int f = j & 7;
        const float i0 = (f & 1) ? 0.31622776601683794f : 1.0f; const int e = f >> 1; const float i1 = e == 0 ? 1.0f : (e == 1 ? 0.1f : (e == 2 ? 0.01f : 0.001f));
        const float inv = i0 * i1; const float ang = (float)pos * inv;
        ct[i] = __cosf(ang); st[i] = __sinf(ang); }
}
__device__ __forceinline__ void transpose_item(const float* W, int K, int N, bf16* WT, LAS float* scr, int item, int lane) {
    const int nblk = N / 32, kb = item / nblk, nb = item % nblk, k0 = 64 * kb, n0 = 32 * nb;
#pragma unroll 8
    for (int i = 0; i < 32; ++i) { const int kk = 2 * i + (lane >> 5); scr[kk * 33 + (lane & 31)] = W[(size_t)(k0 + kk) * N + n0 + (lane & 31)]; }
    asm volatile("s_waitcnt lgkmcnt(0)" ::: "memory");
    const int c = lane & 7;
#pragma unroll
    for (int j = 0; j < 4; ++j) { const int n = (lane >> 3) + 8 * j; const LAS float* s = scr + (8 * c) * 33 + n;
        v4u o; o.x = pk2(s[0 * 33], s[1 * 33]); o.y = pk2(s[2 * 33], s[3 * 33]); o.z = pk2(s[4 * 33], s[5 * 33]); o.w = pk2(s[6 * 33], s[7 * 33]);
        *(v4u*)(WT + (size_t)(n0 + n) * K + k0 + 8 * c) = o; }
    asm volatile("s_waitcnt lgkmcnt(0)" ::: "memory");
}
__device__ __forceinline__ void convert_weight(const float* W, int K, int N, int Npad, bf16* WT, LAS unsigned char* lds, int rot) {
    const int wave = otid() >> 6, lane = otid() & 63; const int NGW = gridDim.x * NWAVES; const int gw = (blockIdx.x * NWAVES + wave + rot) % NGW;
    LAS float* scr = (LAS float*)(lds + wave * 16384);
    const int nitems = (K / 64) * (N / 32);
    for (int it = gw; it < nitems; it += NGW) transpose_item(W, K, N, WT, scr, it, lane);
    (void)Npad;
}
__device__ __forceinline__ void convert_layer(const Args& a, int l, LAS unsigned char* lds) {
    const int i = l >> 1; unsigned char* ws = a.ws;
    convert_weight(a.in[I_WUP] + (size_t)l * D * UPW, D, UPW, UPW, (bf16*)(ws + W_UP), lds, 0);
    convert_weight(a.in[I_WDN] + (size_t)l * DFF * D, DFF, D, D, (bf16*)(ws + W_DN), lds, 300);
    if ((l & 1) == 0) {
        convert_weight(a.in[I_HIN] + (size_t)i * D * HYB_IN, D, HYB_IN, HYB_INP, (bf16*)(ws + W_IN), lds, 700);
        convert_weight(a.in[I_HOUT] + (size_t)i * D * D, D, D, D, (bf16*)(ws + W_OUT), lds, 1100);
        convert_weight(a.in[I_WUQ] + (size_t)i * 384 * QW, 384, QW, QW, (bf16*)(ws + W_UQ), lds, 1500);
        convert_weight(a.in[I_WUKV] + (size_t)i * 256 * KVW, 256, KVW, KVW, (bf16*)(ws + W_UKV), lds, 1700);
    } else {
        convert_weight(a.in[I_SIN] + (size_t)i * D * SSD_IN, D, SSD_IN, SSD_INP, (bf16*)(ws + W_IN), lds, 700);
        convert_weight(a.in[I_SOUT] + (size_t)i * 2048 * D, 2048, D, D, (bf16*)(ws + W_OUT), lds, 1300);
    }
}

__device__ __forceinline__ void rowwise(const float* xs_lat, const float* xs_ctx, float* xd_lat, float* xd_ctx, const bf16* Mb, const float* modg  , const float* nwA,
                                        bf16* H, const float* modh  , int sh_off, int sc_off, const float* nwB, int nrows) {
    const int wave = otid() >> 6, lane = otid() & 63; const int NGW = gridDim.x * NWAVES, gw = blockIdx.x * NWAVES + wave;
    for (int r = gw; r < nrows; r += NGW) {
        const bool lat = r < TL; const int cond = lat ? (r >> 11) : 8;
        const float* xs = lat ? xs_lat + (size_t)r * D : xs_ctx + (size_t)(r - TL) * D;
        float* xd = lat ? xd_lat + (size_t)r * D : xd_ctx + (size_t)(r - TL) * D;
        f32x4 v[4];
#pragma unroll
        for (int j = 0; j < 4; ++j) v[j] = *(const f32x4*)(xs + j * 256 + lane * 4);
        if (Mb) {
            f32x4 m[4]; float ss = 0.f;
#pragma unroll
            for (int j = 0; j < 4; ++j) { const v2u w = *(const v2u*)(Mb + (size_t)r * D + j * 256 + lane * 4); m[j] = (f32x4){bflo(w.x), bfhi(w.x), bflo(w.y), bfhi(w.y)};
                ss += (m[j][0] * m[j][0] + m[j][1] * m[j][1]) + (m[j][2] * m[j][2] + m[j][3] * m[j][3]); }
            const float rs = rsqrtf(wave_sum(ss, lane) * (1.f / D) + EPS);
#pragma unroll
            for (int j = 0; j < 4; ++j) { const f32x4 g = *(const f32x4*)(modg + (size_t)cond * MODW + j * 256 + lane * 4); const f32x4 w = *(const f32x4*)(nwA + j * 256 + lane * 4);
                v[j] = v[j] + g * (m[j] * rs * w); }
        }
#pragma unroll
        for (int j = 0; j < 4; ++j) *(f32x4*)(xd + j * 256 + lane * 4) = v[j];
        if (H) {
            float ss = 0.f;
#pragma unroll
            for (int j = 0; j < 4; ++j) ss += (v[j][0] * v[j][0] + v[j][1] * v[j][1]) + (v[j][2] * v[j][2] + v[j][3] * v[j][3]);
            const float rs = rsqrtf(wave_sum(ss, lane) * (1.f / D) + EPS);
#pragma unroll
            for (int j = 0; j < 4; ++j) { const int c = j * 256 + lane * 4;
                const f32x4 w = *(const f32x4*)(nwB + c); const f32x4 sc = *(const f32x4*)(modh + (size_t)cond * MODW + sc_off + c); const f32x4 sh = *(const f32x4*)(modh + (size_t)cond * MODW + sh_off + c);
                const f32x4 h = (v[j] * rs * w) * (sc + 1.0f) + sh;
                v2u o; o.x = pk2(h[0], h[1]); o.y = pk2(h[2], h[3]); *(v2u*)(H + (size_t)r * D + c) = o; }
        }
    }
}

__device__ __forceinline__ void prep_even(const Args& a, int i) {
    const int wave = otid() >> 6, lane = otid() & 63; const int NGW = gridDim.x * NWAVES, gw = blockIdx.x * NWAVES + wave;
    const bf16* P = (const bf16*)(a.ws + WS_P); bf16* CQN = (bf16*)(a.ws + WS_CQN); bf16* CKVN = (bf16*)(a.ws + WS_CKVN); bf16* KR = (bf16*)(a.ws + WS_KR); bf16* MIX = (bf16*)(a.ws + WS_MIX);
    const float* qn = a.in[I_QNORM] + i * 384; const float* kvn = a.in[I_KVNORM] + i * 256; const float* cw = a.in[I_SCONV] + i * 3 * 512;
    const float* ct = (const float*)(a.ws + WS_ROPE); const float* st = ct + SEQ * 16;
    for (int r = gw; r < T; r += NGW) {
        const bf16* p = P + (size_t)r * HYB_INP;
        {
            const unsigned* p32 = (const unsigned*)(p + lane * 6); const unsigned w0 = p32[0], w1 = p32[1], w2 = p32[2];
            float f[6] = {bflo(w0), bfhi(w0), bflo(w1), bfhi(w1), bflo(w2), bfhi(w2)}; float ss = 0.f;
#pragma unroll
            for (int j = 0; j < 6; ++j) ss += f[j] * f[j];
            const float rs = rsqrtf(wave_sum(ss, lane) * (1.f / 384.f) + EPS);
#pragma unroll
            for (int j = 0; j < 6; ++j) f[j] = f[j] * rs * qn[lane * 6 + j];
            unsigned* o32 = (unsigned*)(CQN + (size_t)r * 384 + lane * 6); o32[0] = pk2(f[0], f[1]); o32[1] = pk2(f[2], f[3]); o32[2] = pk2(f[4], f[5]);
        }
        {
            const v2u w = *(const v2u*)(p + 384 + lane * 4); float f[4] = {bflo(w.x), bfhi(w.x), bflo(w.y), bfhi(w.y)};
            const float ss = (f[0] * f[0] + f[1] * f[1]) + (f[2] * f[2] + f[3] * f[3]);
            const float rs = rsqrtf(wave_sum(ss, lane) * (1.f / 256.f) + EPS);
            const f32x4 g = *(const f32x4*)(kvn + lane * 4);
            v2u o; o.x = pk2(f[0] * rs * g[0], f[1] * rs * g[1]); o.y = pk2(f[2] * rs * g[2], f[3] * rs * g[3]); *(v2u*)(CKVN + (size_t)r * 256 + lane * 4) = o;
        }
        {
            const int j = lane & 31; const float v = bf1(p[640 + j]); const float o = shx(v, 16, lane); float res = v;
            if (r < TL) { const int t = r & (SEQ - 1); const float c = ct[t * 16 + (j & 15)], s = st[t * 16 + (j & 15)]; res = (j < 16) ? v * c - o * s : o * s + v * c; }
            if (lane < 32) KR[(size_t)r * 32 + j] = (bf16)f2bf(res);
        }
        {
            const int c0 = lane * 8; float gb[8], cur[8], acc[8], t0[8], t1[8];
            unpack8(*(const v4u*)(p + 672 + c0), gb);
            unpack8(*(const v4u*)(p + 1184 + c0), t0); unpack8(*(const v4u*)(p + 1696 + c0), t1);
#pragma unroll
            for (int j = 0; j < 8; ++j) { cur[j] = t0[j] * t1[j]; acc[j] = cw[512 + c0 + j] * cur[j]; }
            if (has_prev(r)) { unpack8(*(const v4u*)(p - HYB_INP + 1184 + c0), t0); unpack8(*(const v4u*)(p - HYB_INP + 1696 + c0), t1);
#pragma unroll
                for (int j = 0; j < 8; ++j) acc[j] += cw[c0 + j] * (t0[j] * t1[j]); }
            if (has_next(r)) { unpack8(*(const v4u*)(p + HYB_INP + 1184 + c0), t0); unpack8(*(const v4u*)(p + HYB_INP + 1696 + c0), t1);
#pragma unroll
                for (int j = 0; j < 8; ++j) acc[j] += cw[1024 + c0 + j] * (t0[j] * t1[j]); }
#pragma unroll
            for (int j = 0; j < 8; ++j) acc[j] *= gb[j];
            *(v4u*)(MIX + (size_t)r * D + 512 + c0) = pack8(acc);
        }
    }
}

__device__ __forceinline__ void convgate(const Args& a, int l, int nrows) {
    const bf16* U = (const bf16*)(a.ws + WS_U); bf16* G = (bf16*)(a.ws + WS_G); const float* cw = a.in[I_FCONV] + (size_t)l * 3 * UPW;
    const int total = nrows * (DFF / 8);
    for (int idx = blockIdx.x * NTHR + otid(); idx < total; idx += gridDim.x * NTHR) {
        const int r = idx / (DFF / 8), c0 = (idx % (DFF / 8)) * 8; const bf16* u = U + (size_t)r * UPW + c0;
        float ua[8], ug[8], act[8], gate[8];
        unpack8(*(const v4u*)u, ua); unpack8(*(const v4u*)(u + DFF), ug);
#pragma unroll
        for (int j = 0; j < 8; ++j) { act[j] = cw[UPW + c0 + j] * ua[j]; gate[j] = cw[UPW + DFF + c0 + j] * ug[j]; }
        if (has_prev(r)) { unpack8(*(const v4u*)(u - UPW), ua); unpack8(*(const v4u*)(u - UPW + DFF), ug);
#pragma unroll
            for (int j = 0; j < 8; ++j) { act[j] += cw[c0 + j] * ua[j]; gate[j] += cw[DFF + c0 + j] * ug[j]; } }
        if (has_next(r)) { unpack8(*(const v4u*)(u + UPW), ua); unpack8(*(const v4u*)(u + UPW + DFF), ug);
#pragma unroll
            for (int j = 0; j < 8; ++j) { act[j] += cw[2 * UPW + c0 + j] * ua[j]; gate[j] += cw[2 * UPW + DFF + c0 + j] * ug[j]; } }
#pragma unroll
        for (int j = 0; j < 8; ++j) act[j] = silu_f(act[j]) * gate[j];
        *(v4u*)(G + (size_t)r * DFF + c0) = pack8(act);
    }
}

__device__ __forceinline__ void ssd_conv(const Args& a, int i) {
    const bf16* ZX = (const bf16*)(a.ws + WS_ZX); bf16* XBC = (bf16*)(a.ws + WS_XBC); float* DT = (float*)(a.ws + WS_DT); float* AA = (float*)(a.ws + WS_AA);
    const float* cw = a.in[I_SCONVW] + (size_t)i * 3 * 3072; const float* cb = a.in[I_SCONVB] + (size_t)i * 3072;
    const int total = T * 384;
    for (int idx = blockIdx.x * NTHR + otid(); idx < total; idx += gridDim.x * NTHR) {
        const int r = idx / 384, c0 = (idx % 384) * 8; const bf16* u = ZX + (size_t)r * SSD_INP + 2048 + c0;
        float x[8], acc[8];
        unpack8(*(const v4u*)u, x);
#pragma unroll
        for (int j = 0; j < 8; ++j) acc[j] = cb[c0 + j] + cw[3072 + c0 + j] * x[j];
        if (has_prev(r)) { unpack8(*(const v4u*)(u - SSD_INP), x);
#pragma unroll
            for (int j = 0; j < 8; ++j) acc[j] += cw[c0 + j] * x[j]; }
        if (has_next(r)) { unpack8(*(const v4u*)(u + SSD_INP), x);
#pragma unroll
            for (int j = 0; j < 8; ++j) acc[j] += cw[2 * 3072 + c0 + j] * x[j]; }
#pragma unroll
        for (int j = 0; j < 8; ++j) acc[j] = silu_f(acc[j]);
        *(v4u*)(XBC + (size_t)r * 3072 + c0) = pack8(acc);
    }
    const float* alog = a.in[I_ALOG] + i * 64; const float* dtb = a.in[I_DTB] + i * 64;
    for (int idx = blockIdx.x * NTHR + otid(); idx < T * 64; idx += gridDim.x * NTHR) {
        const int r = idx >> 6, j = idx & 63; const float raw = bf1(ZX[(size_t)r * SSD_INP + 5120 + j]) + dtb[j];
        const float dt = raw > 15.f ? raw : (raw < -15.f ? __expf(raw) : __logf(1.f + __expf(raw)));
        DT[idx] = dt; AA[idx] = -__expf(alog[j]) * dt;
    }
}

__device__ __forceinline__ void gatenorm(const Args& a, int i, int nrows) {
    const int wave = otid() >> 6, lane = otid() & 63; const int NGW = gridDim.x * NWAVES, gw = blockIdx.x * NWAVES + wave;
    const bf16* ZX = (const bf16*)(a.ws + WS_ZX); bf16* YN = (bf16*)(a.ws + WS_XBC); const float* nw = a.in[I_SNORM] + i * 2048;
    for (int r = gw; r < nrows; r += NGW) {
        float v[4][8]; float ss = 0.f;
#pragma unroll
        for (int j = 0; j < 4; ++j) { float y[8], z[8]; const int c = j * 512 + lane * 8;
            unpack8(*(const v4u*)(ZX + (size_t)r * SSD_INP + 2048 + c), y); unpack8(*(const v4u*)(ZX + (size_t)r * SSD_INP + c), z);
#pragma unroll
            for (int k = 0; k < 8; ++k) { v[j][k] = y[k] * silu_f(z[k]); ss += v[j][k] * v[j][k]; } }
        const float rs = rsqrtf(wave_sum(ss, lane) * (1.f / 2048.f) + EPS);
#pragma unroll
        for (int j = 0; j < 4; ++j) { const int c = j * 512 + lane * 8; float o[8];
#pragma unroll
            for (int k = 0; k < 8; ++k) o[k] = v[j][k] * rs * nw[c + k];
            *(v4u*)(YN + (size_t)r * 2048 + c) = pack8(o); }
    }
}

__device__ __forceinline__ void attn_naive(const Args& a, LAS unsigned char* lds) {
    const int tid = otid(), qi = tid >> 1, half = tid & 1;
    const bf16* Qb = (const bf16*)(a.ws + WS_Q); const bf16* KVb = (const bf16*)(a.ws + WS_KV); const bf16* KR = (const bf16*)(a.ws + WS_KR); bf16* MIX = (bf16*)(a.ws + WS_MIX);
    const float* ct = (const float*)(a.ws + WS_ROPE); const float* st = ct + SEQ * 16;
    LAS float* Kt = (LAS float*)lds;
    LAS float* Vt = (LAS float*)(lds + 64 * 96 * 4);
    for (int u = blockIdx.x; u < 576; u += gridDim.x) {
        const bool lat = u < 512; const int b = lat ? (u >> 6) : ((u - 512) >> 3), h = lat ? ((u >> 3) & 7) : ((u - 512) & 7);
        const int nkeys = lat ? (CTXL + SEQ) : CTXL;
        const int qrow = lat ? b * SEQ + (u & 7) * 256 + qi : TL + b * CTXL + qi;
        float q[48];
#pragma unroll
        for (int g = 0; g < 6; ++g) { float f[8]; unpack8(*(const v4u*)(Qb + (size_t)qrow * QW + h * 96 + half * 48 + g * 8), f);
#pragma unroll
            for (int j = 0; j < 8; ++j) q[g * 8 + j] = f[j]; }
        if (lat && half == 1) { const int t = qrow & (SEQ - 1);
#pragma unroll
            for (int j = 0; j < 16; ++j) { const float c = ct[t * 16 + j], s = st[t * 16 + j]; const float x1 = q[16 + j], x2 = q[32 + j]; q[16 + j] = x1 * c - x2 * s; q[32 + j] = x1 * s + x2 * c; } }
#pragma unroll
        for (int j = 0; j < 48; ++j) q[j] *= ATT_SCALE_LOG2E;
        float o[32]; float m = -1e30f, l = 0.f;
#pragma unroll
        for (int j = 0; j < 32; ++j) o[j] = 0.f;
        for (int k0 = 0; k0 < nkeys; k0 += 64) {
            __syncthreads();
            for (int g = tid; g < 768; g += NTHR) { const int key = g / 12, part = g % 12; const int kk = k0 + key; const int krow = kk < CTXL ? TL + b * CTXL + kk : b * SEQ + kk - CTXL;
                float f[8]; unpack8(part < 8 ? *(const v4u*)(KVb + (size_t)krow * KVW + h * 128 + part * 8) : *(const v4u*)(KR + (size_t)krow * 32 + (part - 8) * 8), f);
#pragma unroll
                for (int j = 0; j < 8; ++j) Kt[key * 96 + part * 8 + j] = f[j]; }
            { const int key = tid >> 3, part = tid & 7; const int kk = k0 + key; const int krow = kk < CTXL ? TL + b * CTXL + kk : b * SEQ + kk - CTXL;
                float f[8]; unpack8(*(const v4u*)(KVb + (size_t)krow * KVW + h * 128 + 64 + part * 8), f);
#pragma unroll
                for (int j = 0; j < 8; ++j) Vt[key * 64 + part * 8 + j] = f[j]; }
            __syncthreads();
            for (int kg = 0; kg < 64; kg += 8) {
                float s[8]; float gm = -1e30f;
#pragma unroll
                for (int kk = 0; kk < 8; ++kk) { float acc = 0.f; const LAS f32x4* kp = (const LAS f32x4*)(Kt + (kg + kk) * 96 + half * 48);
#pragma unroll
                    for (int d4 = 0; d4 < 12; ++d4) { const f32x4 kv = kp[d4]; acc += q[d4 * 4] * kv[0] + q[d4 * 4 + 1] * kv[1] + q[d4 * 4 + 2] * kv[2] + q[d4 * 4 + 3] * kv[3]; }
                    acc += shx(acc, 1, tid & 63);
                    s[kk] = acc; gm = fmaxf(gm, acc); }
                const float mn = fmaxf(m, gm); const float alpha = exp2f(m - mn); m = mn; l *= alpha;
#pragma unroll
                for (int j = 0; j < 32; ++j) o[j] *= alpha;
#pragma unroll
                for (int kk = 0; kk < 8; ++kk) { const float p = exp2f(s[kk] - mn); l += p; const LAS f32x4* vp = (const LAS f32x4*)(Vt + (kg + kk) * 64 + half * 32);
#pragma unroll
                    for (int d4 = 0; d4 < 8; ++d4) { const f32x4 vv = vp[d4]; o[d4 * 4] += p * vv[0]; o[d4 * 4 + 1] += p * vv[1]; o[d4 * 4 + 2] += p * vv[2]; o[d4 * 4 + 3] += p * vv[3]; } }
            }
        }
        { const float inv = 1.f / l;
#pragma unroll
            for (int g = 0; g < 4; ++g) { float f[8];
#pragma unroll
                for (int j = 0; j < 8; ++j) f[j] = o[g * 8 + j] * inv;
                *(v4u*)(MIX + (size_t)qrow * D + h * 64 + half * 32 + g * 8) = pack8(f); } }
    }
}

__device__ __forceinline__ void ssd_scan_naive(const Args& a, int i, bool last, LAS unsigned char* lds) {
    const int tid = otid(), p = tid >> 3, nq = tid & 7;
    bf16* ZX = (bf16*)(a.ws + WS_ZX); const bf16* XBC = (const bf16*)(a.ws + WS_XBC); const float* DT = (const float*)(a.ws + WS_DT); const float* AA = (const float*)(a.ws + WS_AA);
    LAS float* xs = (LAS float*)lds;
    LAS float* Bs = (LAS float*)(lds + 16384);
    LAS float* Cs = (LAS float*)(lds + 16384 + 32768);
    LAS float* dts = (LAS float*)(lds + 16384 + 65536);
    LAS float* as = dts + 64;
    for (int it = blockIdx.x; it < NB * 32; it += gridDim.x) {
        const int b = it >> 5, h = it & 31, g = h >> 3; const float dsk = a.in[I_SD][i * 32 + h];
        for (int dir = 0; dir < 2; ++dir) {
            float stt[16];
#pragma unroll
            for (int n = 0; n < 16; ++n) stt[n] = 0.f;
            for (int seg = 0; seg < 2; ++seg) {
                const int len = seg == 0 ? CTXL : SEQ; const int base = seg == 0 ? TL + b * CTXL : b * SEQ; const bool want_y = !(last && seg == 0);
                for (int cc = 0; cc < len / 64; ++cc) {
                    const int t0 = dir == 0 ? cc * 64 : len - 64 - cc * 64;
                    __syncthreads();
                    { const int tt = tid >> 3, part = tid & 7; float f[8]; unpack8(*(const v4u*)(XBC + (size_t)(base + t0 + tt) * 3072 + h * 64 + part * 8), f);
#pragma unroll
                        for (int j = 0; j < 8; ++j) xs[tt * 64 + part * 8 + j] = f[j]; }
                    for (int q = tid; q < 1024; q += NTHR) { const int tt = q >> 4, part = q & 15; float f[8];
                        unpack8(*(const v4u*)(XBC + (size_t)(base + t0 + tt) * 3072 + 2048 + g * 128 + part * 8), f);
#pragma unroll
                        for (int j = 0; j < 8; ++j) Bs[tt * 128 + part * 8 + j] = f[j];
                        unpack8(*(const v4u*)(XBC + (size_t)(base + t0 + tt) * 3072 + 2560 + g * 128 + part * 8), f);
#pragma unroll
                        for (int j = 0; j < 8; ++j) Cs[tt * 128 + part * 8 + j] = f[j]; }
                    if (tid < 64) { dts[tid] = DT[(size_t)(base + t0 + tid) * 64 + dir * 32 + h]; as[tid] = AA[(size_t)(base + t0 + tid) * 64 + dir * 32 + h]; }
                    __syncthreads();
                    for (int s = 0; s < 64; ++s) {
                        const int tt = dir == 0 ? s : 63 - s;
                        const float dec = __expf(as[tt]); const float xv = xs[tt * 64 + p]; const float xd = xv * dts[tt];
                        const LAS f32x4* bp = (const LAS f32x4*)(Bs + tt * 128 + nq * 16); const LAS f32x4* cp = (const LAS f32x4*)(Cs + tt * 128 + nq * 16);
                        float acc = 0.f;
#pragma unroll
                        for (int n4 = 0; n4 < 4; ++n4) { const f32x4 bv = bp[n4], cv = cp[n4];
#pragma unroll
                            for (int k = 0; k < 4; ++k) { stt[n4 * 4 + k] = dec * stt[n4 * 4 + k] + xd * bv[k]; acc += cv[k] * stt[n4 * 4 + k]; } }
                        acc += shx(acc, 1, tid & 63); acc += shx(acc, 2, tid & 63); acc += shx(acc, 4, tid & 63);
                        if (want_y && nq == 0) { bf16* yp = ZX + (size_t)(base + t0 + tt) * SSD_INP + 2048 + h * 64 + p;
                            const float y = dir == 0 ? acc + dsk * xv : acc + bf1(*yp);
                            *yp = (bf16)f2bf(y); }
                    }
                }
            }
            __syncthreads();
            asm volatile("s_waitcnt vmcnt(0)" ::: "memory");
        }
    }
}

typedef short bf16x8 __attribute__((ext_vector_type(8)));
typedef float f32x16 __attribute__((ext_vector_type(16)));
__device__ __forceinline__ unsigned cvtpk(float lo, float hi) { unsigned r; asm volatile("v_cvt_pk_bf16_f32 %0, %1, %2" : "=v"(r) : "v"(lo), "v"(hi)); return r; }
constexpr int ATT_KP = 208, ATT_VP = 136, ATT_KB = 64 * ATT_KP, ATT_VB = 64 * ATT_VP, ATT_BUF = ATT_KB + ATT_VB;
__device__ __forceinline__ void attn_mfma(const Args& a, LAS unsigned char* lds) {
    const int tid = otid(), wave = tid >> 6, lane = tid & 63, r32 = lane & 31, hh = lane >> 5;
    const bf16* Qb = (const bf16*)(a.ws + WS_Q); const bf16* KVb = (const bf16*)(a.ws + WS_KV); const bf16* KR = (const bf16*)(a.ws + WS_KR); bf16* MIX = (bf16*)(a.ws + WS_MIX);
    const float* ct = (const float*)(a.ws + WS_ROPE); const float* st = ct + SEQ * 16;
    const int kkey0 = tid / 12, kpart0 = tid % 12, kkey1 = (tid + NTHR) / 12, kpart1 = (tid + NTHR) % 12; const bool k1ok = tid + NTHR < 768;
    for (int u = blockIdx.x; u < 576; u += gridDim.x) {
        const bool lat = u < 512; const int b = lat ? (u >> 6) : ((u - 512) >> 3), h = lat ? ((u >> 3) & 7) : ((u - 512) & 7);
        const int ntiles = lat ? (CTXL + SEQ) / 64 : CTXL / 64;
        const int qrow = (lat ? b * SEQ + (u & 7) * 256 : TL + b * CTXL) + wave * 32 + r32;
        bf16x8 qf[6];
#pragma unroll
        for (int s = 0; s < 6; ++s) qf[s] = *(const bf16x8*)(Qb + (size_t)qrow * QW + h * 96 + 16 * s + 8 * hh);
        if (lat) { const int t = qrow & (SEQ - 1);
#pragma unroll
            for (int j = 0; j < 8; j += 2) { float x1[2], x2[2], y1[2], y2[2];
#pragma unroll
                for (int e = 0; e < 2; ++e) { x1[e] = bf1((bf16)qf[4][j + e]); x2[e] = bf1((bf16)qf[5][j + e]); const float c = ct[t * 16 + 8 * hh + j + e], s = st[t * 16 + 8 * hh + j + e];
                    y1[e] = x1[e] * c - x2[e] * s; y2[e] = x1[e] * s + x2[e] * c; }
                const unsigned w1 = pk2(y1[0], y1[1]), w2 = pk2(y2[0], y2[1]);
                qf[4][j] = (short)(w1 & 0xffff); qf[4][j + 1] = (short)(w1 >> 16); qf[5][j] = (short)(w2 & 0xffff); qf[5][j + 1] = (short)(w2 >> 16); } }
        f32x16 o0, o1;
#pragma unroll
        for (int i = 0; i < 16; ++i) { o0[i] = 0.f; o1[i] = 0.f; }
        float m = -1e30f, l = 0.f;
        v4u kreg0, kreg1, vreg;
        const bf16* kp0 = kpart0 < 8 ? KVb + (size_t)kkey0 * KVW + h * 128 + kpart0 * 8 : KR + (size_t)kkey0 * 32 + (kpart0 - 8) * 8; const int ks0 = kpart0 < 8 ? KVW : 32;
        const bf16* kp1 = kpart1 < 8 ? KVb + (size_t)kkey1 * KVW + h * 128 + kpart1 * 8 : KR + (size_t)kkey1 * 32 + (kpart1 - 8) * 8; const int ks1 = kpart1 < 8 ? KVW : 32;
        const bf16* vp0 = KVb + (size_t)lane * KVW + h * 128 + 64 + wave * 8;
#define ATT_LOAD(it) do { const int rb_ = (it) < CTXL / 64 ? TL + b * CTXL + (it) * 64 : b * SEQ + ((it) - CTXL / 64) * 64; \
            kreg0 = *(const v4u*)(kp0 + (size_t)rb_ * ks0); if (k1ok) kreg1 = *(const v4u*)(kp1 + (size_t)rb_ * ks1); vreg = *(const v4u*)(vp0 + (size_t)rb_ * KVW); } while (0)
#define ATT_WRITE(buf) do { LAS unsigned char* kb_ = lds + (buf) * ATT_BUF; LAS unsigned char* vb_ = kb_ + ATT_KB; \
            *(LAS v4u*)(kb_ + kkey0 * ATT_KP + kpart0 * 16) = kreg0; if (k1ok) *(LAS v4u*)(kb_ + kkey1 * ATT_KP + kpart1 * 16) = kreg1; \
            { LAS unsigned short* vp = (LAS unsigned short*)(vb_ + (wave * 8) * ATT_VP + lane * 2); \
              vp[0 * (ATT_VP / 2)] = (unsigned short)(vreg.x & 0xffff); vp[1 * (ATT_VP / 2)] = (unsigned short)(vreg.x >> 16); vp[2 * (ATT_VP / 2)] = (unsigned short)(vreg.y & 0xffff); vp[3 * (ATT_VP / 2)] = (unsigned short)(vreg.y >> 16); \
              vp[4 * (ATT_VP / 2)] = (unsigned short)(vreg.z & 0xffff); vp[5 * (ATT_VP / 2)] = (unsigned short)(vreg.z >> 16); vp[6 * (ATT_VP / 2)] = (unsigned short)(vreg.w & 0xffff); vp[7 * (ATT_VP / 2)] = (unsigned short)(vreg.w >> 16); } } while (0)
        __syncthreads();
        ATT_LOAD(0); ATT_WRITE(0);
        __syncthreads();
        for (int it = 0; it < ntiles; ++it) {
            if (it + 1 < ntiles) ATT_LOAD(it + 1);
            const LAS unsigned char* kb = lds + (it & 1) * ATT_BUF; const LAS unsigned char* vb = kb + ATT_KB;
            f32x16 s0, s1;
#pragma unroll
            for (int i = 0; i < 16; ++i) { s0[i] = 0.f; s1[i] = 0.f; }
#pragma unroll
            for (int s = 0; s < 6; ++s) { const bf16x8 a0 = *(const LAS bf16x8*)(kb + r32 * ATT_KP + (16 * s + 8 * hh) * 2); const bf16x8 a1 = *(const LAS bf16x8*)(kb + (32 + r32) * ATT_KP + (16 * s + 8 * hh) * 2);
                s0 = __builtin_amdgcn_mfma_f32_32x32x16_bf16(a0, qf[s], s0, 0, 0, 0); s1 = __builtin_amdgcn_mfma_f32_32x32x16_bf16(a1, qf[s], s1, 0, 0, 0); }
            float mx = s0[0];
#pragma unroll
            for (int i = 1; i < 16; ++i) mx = fmaxf(mx, s0[i]);
#pragma unroll
            for (int i = 0; i < 16; ++i) mx = fmaxf(mx, s1[i]);
            mx = fmaxf(mx, shx(mx, 32, lane));
            const float mn = fmaxf(m, mx * ATT_SCALE_LOG2E); const float alpha = __builtin_amdgcn_exp2f(m - mn); m = mn;
            float rs = 0.f;
#pragma unroll
            for (int i = 0; i < 16; ++i) { s0[i] = __builtin_amdgcn_exp2f(s0[i] * ATT_SCALE_LOG2E - mn); s1[i] = __builtin_amdgcn_exp2f(s1[i] * ATT_SCALE_LOG2E - mn); rs += s0[i] + s1[i]; }
            l = l * alpha + rs;
#pragma unroll
            for (int i = 0; i < 16; ++i) { o0[i] *= alpha; o1[i] *= alpha; }
            bf16x8 pf[2][2];
#pragma unroll
            for (int s2 = 0; s2 < 2; ++s2) { v4u w0, w1;
                w0.x = cvtpk(s0[8 * s2 + 0], s0[8 * s2 + 1]); w0.y = cvtpk(s0[8 * s2 + 2], s0[8 * s2 + 3]); w0.z = cvtpk(s0[8 * s2 + 4], s0[8 * s2 + 5]); w0.w = cvtpk(s0[8 * s2 + 6], s0[8 * s2 + 7]);
                w1.x = cvtpk(s1[8 * s2 + 0], s1[8 * s2 + 1]); w1.y = cvtpk(s1[8 * s2 + 2], s1[8 * s2 + 3]); w1.z = cvtpk(s1[8 * s2 + 4], s1[8 * s2 + 5]); w1.w = cvtpk(s1[8 * s2 + 6], s1[8 * s2 + 7]);
                pf[0][s2] = __builtin_bit_cast(bf16x8, w0); pf[1][s2] = __builtin_bit_cast(bf16x8, w1); }
#pragma unroll
            for (int t = 0; t < 2; ++t)
#pragma unroll
                for (int s2 = 0; s2 < 2; ++s2) { const int ko = t * 32 + 16 * s2 + 4 * hh;
                    { const v2u lo = *(const LAS v2u*)(vb + r32 * ATT_VP + ko * 2); const v2u hi = *(const LAS v2u*)(vb + r32 * ATT_VP + (ko + 8) * 2);
                      const v4u w = (v4u){lo.x, lo.y, hi.x, hi.y}; o0 = __builtin_amdgcn_mfma_f32_32x32x16_bf16(__builtin_bit_cast(bf16x8, w), pf[t][s2], o0, 0, 0, 0); }
                    { const v2u lo = *(const LAS v2u*)(vb + (32 + r32) * ATT_VP + ko * 2); const v2u hi = *(const LAS v2u*)(vb + (32 + r32) * ATT_VP + (ko + 8) * 2);
                      const v4u w = (v4u){lo.x, lo.y, hi.x, hi.y}; o1 = __builtin_amdgcn_mfma_f32_32x32x16_bf16(__builtin_bit_cast(bf16x8, w), pf[t][s2], o1, 0, 0, 0); } }
            if (it + 1 < ntiles) ATT_WRITE((it + 1) & 1);
            __syncthreads();
        }
#undef ATT_LOAD
#undef ATT_WRITE
        l += shx(l, 32, lane); const float inv = 1.f / l;
        bf16* orow = MIX + (size_t)qrow * D + h * 64 + 4 * hh;
#pragma unroll
        for (int g = 0; g < 4; ++g) {
            v2u w; w.x = pk2(o0[4 * g] * inv, o0[4 * g + 1] * inv); w.y = pk2(o0[4 * g + 2] * inv, o0[4 * g + 3] * inv); *(v2u*)(orow + 8 * g) = w;
            v2u x; x.x = pk2(o1[4 * g] * inv, o1[4 * g + 1] * inv); x.y = pk2(o1[4 * g + 2] * inv, o1[4 * g + 3] * inv); *(v2u*)(orow + 32 + 8 * g) = x; }
    }
}

typedef short v4i16_t __attribute__((ext_vector_type(4)));
__device__ __forceinline__ v2u trread(const LAS unsigned char* p) { return __builtin_bit_cast(v2u, __builtin_amdgcn_ds_read_tr16_b64_v4i16((LAS v4i16_t*)p)); }
constexpr int SP_B = 272, SP_X = 192;
constexpr int SO_B = 0, SO_C = SO_B + 128 * SP_B, SO_XD = SO_C + 128 * SP_B, SO_XW = SO_XD + 128 * SP_X, SO_S = SO_XW + 128 * SP_X, SO_V = SO_S + 64 * SP_B;
static_assert(SO_V + 2 * 2048 <= LDS_BYTES, "ssd lds map");
__device__ __forceinline__ void ssd_scan_mfma(const Args& a, int i, bool last, LAS unsigned char* lds) {
    const int tid = otid(), wave = tid >> 6, lane = tid & 63, r32 = lane & 31, hh = lane >> 5;
    const int pt = wave & 1, lt = wave >> 1;
    const int tq = (lane >> 2) & 3, tp = lane & 3, tblk = (lane >> 4) & 1;
    bf16* ZX = (bf16*)(a.ws + WS_ZX); const bf16* XBC = (const bf16*)(a.ws + WS_XBC); const float* DT = (const float*)(a.ws + WS_DT); const float* AA = (const float*)(a.ws + WS_AA);
    LAS unsigned char* Bl = lds + SO_B; LAS unsigned char* Cl = lds + SO_C; LAS unsigned char* XDl = lds + SO_XD; LAS unsigned char* XWl = lds + SO_XW; LAS unsigned char* Sl = lds + SO_S;
    const int brow = tid >> 4, bpart = tid & 15, xrow = tid >> 3, xpart = tid & 7;
    for (int it = blockIdx.x; it < NB * 32; it += gridDim.x) {
        const int b = it >> 5, h = it & 31, g = h >> 3; const float dsk = a.in[I_SD][i * 32 + h];
        for (int dir = 0; dir < 2; ++dir) {
            f32x16 sacc;
#pragma unroll
            for (int k = 0; k < 16; ++k) sacc[k] = 0.f;
            v4u bq[4], cq[4], xq[2]; float pa0 = 0.f, pa1 = 0.f, pd0 = 0.f, pd1 = 0.f;
#define SSD_ROWBASE(c) ((c) < 2 ? TL + b * CTXL + (dir == 0 ? (c) : 1 - (c)) * 128 : b * SEQ + (dir == 0 ? (c) - 2 : 17 - (c)) * 128)
#define SSD_PF(c) do { const int rb_ = SSD_ROWBASE(c); \
                _Pragma("unroll") for (int k_ = 0; k_ < 4; ++k_) { const bf16* src_ = XBC + (size_t)(rb_ + brow + 32 * k_) * 3072 + 2048 + g * 128 + bpart * 8; bq[k_] = *(const v4u*)src_; cq[k_] = *(const v4u*)(src_ + 512); } \
                _Pragma("unroll") for (int k_ = 0; k_ < 2; ++k_) xq[k_] = *(const v4u*)(XBC + (size_t)(rb_ + xrow + 64 * k_) * 3072 + h * 64 + xpart * 8); \
                if (wave == 0) { const size_t o_ = (size_t)(rb_ + 2 * lane) * 64 + dir * 32 + h; pa0 = AA[o_]; pa1 = AA[o_ + 64]; pd0 = DT[o_]; pd1 = DT[o_ + 64]; } } while (0)
#define SSD_SCAN(vb_) do { if (wave == 0) { LAS float* V_ = (LAS float*)(lds + SO_V + (vb_) * 2048); const float pair_ = pa0 + pa1; float ps_ = pair_; \
                _Pragma("unroll") for (int d_ = 1; d_ < 64; d_ <<= 1) { const int src_ = dir == 0 ? lane - d_ : lane + d_; const float t_ = __builtin_bit_cast(float, __builtin_amdgcn_ds_bpermute((src_ & 63) << 2, __builtin_bit_cast(int, ps_))); if (src_ >= 0 && src_ < 64) ps_ += t_; } \
                const float tot_ = __builtin_bit_cast(float, __builtin_amdgcn_ds_bpermute((dir == 0 ? 63 : 0) << 2, __builtin_bit_cast(int, ps_))); const float ex_ = ps_ - pair_; \
                float c0_, c1_; if (dir == 0) { c0_ = ex_ + pa0; c1_ = c0_ + pa1; } else { c1_ = ex_ + pa1; c0_ = c1_ + pa0; } \
                V_[2 * lane] = c0_; V_[2 * lane + 1] = c1_; V_[128 + 2 * lane] = pd0; V_[128 + 2 * lane + 1] = pd1; V_[256 + 2 * lane] = pd0 * __expf(tot_ - c0_); V_[256 + 2 * lane + 1] = pd1 * __expf(tot_ - c1_); \
                if (lane == 0) V_[384] = tot_; } } while (0)
#define SSD_WRITE(vb_) do { const LAS float* V_ = (const LAS float*)(lds + SO_V + (vb_) * 2048); \
                _Pragma("unroll") for (int k_ = 0; k_ < 4; ++k_) { *(LAS v4u*)(Bl + (brow + 32 * k_) * SP_B + bpart * 16) = bq[k_]; *(LAS v4u*)(Cl + (brow + 32 * k_) * SP_B + bpart * 16) = cq[k_]; } \
                _Pragma("unroll") for (int k_ = 0; k_ < 2; ++k_) { const int s_ = xrow + 64 * k_; const float dt_ = V_[128 + s_], w_ = V_[256 + s_]; float f_[8], g_[8]; unpack8(xq[k_], f_); \
                    _Pragma("unroll") for (int j_ = 0; j_ < 8; ++j_) { g_[j_] = f_[j_] * w_; f_[j_] *= dt_; } \
                    *(LAS v4u*)(XDl + s_ * SP_X + xpart * 16) = pack8(f_); *(LAS v4u*)(XWl + s_ * SP_X + xpart * 16) = pack8(g_); } } while (0)
            __syncthreads();
            SSD_PF(0); SSD_SCAN(0);
            __syncthreads();
            SSD_WRITE(0);
            { LAS v2u* sp = (LAS v2u*)(Sl + (32 * pt + r32) * SP_B + (32 * lt + 4 * hh) * 2);
#pragma unroll
              for (int q = 0; q < 4; ++q) sp[2 * q] = (v2u){0u, 0u}; }
            __syncthreads();
            for (int c = 0; c < 18; ++c) {
                const int cur = c & 1; const LAS float* V = (const LAS float*)(lds + SO_V + cur * 2048);
                const int rowbase = SSD_ROWBASE(c); const bool want_y = !(last && c < 2);
                if (c + 1 < 18) SSD_PF(c + 1);
                if (want_y) {
                    const int l = 32 * lt + r32; const float cl = V[l];
                    bf16* yptr = ZX + (size_t)(rowbase + l) * SSD_INP + 2048 + h * 64 + 32 * pt + 4 * hh;
                    const bf16* xptr = XBC + (size_t)(rowbase + l) * 3072 + h * 64 + 32 * pt + 4 * hh;
                    v2u add[4];
#pragma unroll
                    for (int q = 0; q < 4; ++q) add[q] = dir == 0 ? *(const v2u*)(xptr + 8 * q) : *(const v2u*)(yptr + 8 * q);
                    bf16x8 cf[8];
#pragma unroll
                    for (int ks = 0; ks < 8; ++ks) cf[ks] = *(const LAS bf16x8*)(Cl + l * SP_B + (16 * ks + 8 * hh) * 2);
                    f32x16 y1, y2;
#pragma unroll
                    for (int k = 0; k < 16; ++k) { y1[k] = 0.f; y2[k] = 0.f; }
                    const int st_lo = dir == 0 ? 0 : lt, st_hi = dir == 0 ? lt : 3;
                    for (int st = st_lo; st <= st_hi; ++st) {
                        f32x16 X;
#pragma unroll
                        for (int k = 0; k < 16; ++k) X[k] = 0.f;
#pragma unroll
                        for (int ks = 0; ks < 8; ++ks) { const bf16x8 af = *(const LAS bf16x8*)(Bl + (32 * st + r32) * SP_B + (16 * ks + 8 * hh) * 2); X = __builtin_amdgcn_mfma_f32_32x32x16_bf16(af, cf[ks], X, 0, 0, 0); }
#pragma unroll
                        for (int q = 0; q < 4; ++q) { const f32x4 cs = *(const LAS f32x4*)(V + 32 * st + 8 * q + 4 * hh);
#pragma unroll
                            for (int e = 0; e < 4; ++e) { const int s = 32 * st + 8 * q + 4 * hh + e; const bool ok = dir == 0 ? (s <= l) : (s >= l);
                                const float dec = __expf(fminf(cl - cs[e], 0.f)); X[4 * q + e] = ok ? X[4 * q + e] * dec : 0.f; } }
#pragma unroll
                        for (int ks2 = 0; ks2 < 2; ++ks2) { v4u w; w.x = cvtpk(X[8 * ks2 + 0], X[8 * ks2 + 1]); w.y = cvtpk(X[8 * ks2 + 2], X[8 * ks2 + 3]); w.z = cvtpk(X[8 * ks2 + 4], X[8 * ks2 + 5]); w.w = cvtpk(X[8 * ks2 + 6], X[8 * ks2 + 7]);
                            const LAS unsigned char* tb = XDl + (32 * st + 16 * ks2 + 4 * hh + tq) * SP_X + (32 * pt + 16 * tblk + 4 * tp) * 2;
                            const v2u lo = trread(tb), hi = trread(tb + 8 * SP_X);
                            y1 = __builtin_amdgcn_mfma_f32_32x32x16_bf16(__builtin_bit_cast(bf16x8, (v4u){lo.x, lo.y, hi.x, hi.y}), __builtin_bit_cast(bf16x8, w), y1, 0, 0, 0); }
                    }
#pragma unroll
                    for (int ks = 0; ks < 8; ++ks) { const bf16x8 sf = *(const LAS bf16x8*)(Sl + (32 * pt + r32) * SP_B + (16 * ks + 8 * hh) * 2); y2 = __builtin_amdgcn_mfma_f32_32x32x16_bf16(sf, cf[ks], y2, 0, 0, 0); }
                    const float el = __expf(cl);
#pragma unroll
                    for (int q = 0; q < 4; ++q) { float o[4];
#pragma unroll
                        for (int e = 0; e < 4; ++e) o[e] = y1[4 * q + e] + el * y2[4 * q + e];
                        const float a0 = bflo(add[q].x), a1 = bfhi(add[q].x), a2 = bflo(add[q].y), a3 = bfhi(add[q].y);
                        if (dir == 0) { o[0] += dsk * a0; o[1] += dsk * a1; o[2] += dsk * a2; o[3] += dsk * a3; } else { o[0] += a0; o[1] += a1; o[2] += a2; o[3] += a3; }
                        v2u w; w.x = pk2(o[0], o[1]); w.y = pk2(o[2], o[3]); *(v2u*)(yptr + 8 * q) = w; }
                }
                if (c + 1 < 18) {
                    const float etot = __expf(V[384]);
#pragma unroll
                    for (int k = 0; k < 16; ++k) sacc[k] *= etot;
#pragma unroll
                    for (int ks = 0; ks < 8; ++ks) {
                        const LAS unsigned char* ta = Bl + (16 * ks + 8 * hh + tq) * SP_B + (32 * lt + 16 * tblk + 4 * tp) * 2;
                        const LAS unsigned char* tb = XWl + (16 * ks + 8 * hh + tq) * SP_X + (32 * pt + 16 * tblk + 4 * tp) * 2;
                        const v2u alo = trread(ta), ahi = trread(ta + 4 * SP_B), blo = trread(tb), bhi = trread(tb + 4 * SP_X);
                        sacc = __builtin_amdgcn_mfma_f32_32x32x16_bf16(__builtin_bit_cast(bf16x8, (v4u){alo.x, alo.y, ahi.x, ahi.y}), __builtin_bit_cast(bf16x8, (v4u){blo.x, blo.y, bhi.x, bhi.y}), sacc, 0, 0, 0); }
                    SSD_SCAN(cur ^ 1);
                }
                __syncthreads();
                if (c + 1 < 18) {
                    LAS v2u* sp = (LAS v2u*)(Sl + (32 * pt + r32) * SP_B + (32 * lt + 4 * hh) * 2);
#pragma unroll
                    for (int q = 0; q < 4; ++q) { v2u w; w.x = cvtpk(sacc[4 * q], sacc[4 * q + 1]); w.y = cvtpk(sacc[4 * q + 2], sacc[4 * q + 3]); sp[2 * q] = w; }
                    SSD_WRITE(cur ^ 1);
                }
                __syncthreads();
            }
#undef SSD_ROWBASE
#undef SSD_PF
#undef SSD_SCAN
#undef SSD_WRITE
            asm volatile("s_waitcnt vmcnt(0)" ::: "memory");
        }
    }
}

template <int R>
__device__ __forceinline__ void rowwise2(const float* xs_lat, const float* xs_ctx, float* xd_lat, float* xd_ctx, const bf16* Mb, const float* modg, const float* nwA,
                                         bf16* H, const float* modh, int sh_off, int sc_off, const float* nwB, int nrows) {
    const int tid = otid(), wave = tid >> 6, lane = tid & 63; const int NGW = gridDim.x * NWAVES, gw = blockIdx.x * NWAVES + wave;
    const int rpw = (nrows + NGW - 1) / NGW; const int rbeg = gw * rpw, rend = min(rbeg + rpw, nrows);
    for (int r0 = rbeg; r0 < rend; r0 += R) {
        f32x4 v[R][4]; v2u mm[R][4];
#pragma unroll
        for (int j = 0; j < R; ++j) { const int r = min(r0 + j, rend - 1); const float* xs = r < TL ? xs_lat + (size_t)r * D : xs_ctx + (size_t)(r - TL) * D;
#pragma unroll
            for (int q = 0; q < 4; ++q) v[j][q] = *(const f32x4*)(xs + q * 256 + lane * 4);
            if (Mb) {
#pragma unroll
                for (int q = 0; q < 4; ++q) mm[j][q] = *(const v2u*)(Mb + (size_t)r * D + q * 256 + lane * 4); } }
#pragma unroll
        for (int j = 0; j < R; ++j) { const int r = r0 + j; if (r < rend) {
            const bool lat = r < TL; const int cond = lat ? (r >> 11) : 8; float* xd = lat ? xd_lat + (size_t)r * D : xd_ctx + (size_t)(r - TL) * D;
            if (Mb) {
                f32x4 m[4]; float ss = 0.f;
#pragma unroll
                for (int q = 0; q < 4; ++q) { const v2u w = mm[j][q]; m[q] = (f32x4){bflo(w.x), bfhi(w.x), bflo(w.y), bfhi(w.y)}; ss += (m[q][0] * m[q][0] + m[q][1] * m[q][1]) + (m[q][2] * m[q][2] + m[q][3] * m[q][3]); }
                const float rs = rsqrtf(wave_sum(ss, lane) * (1.f / D) + EPS);
#pragma unroll
                for (int q = 0; q < 4; ++q) { const f32x4 g = *(const f32x4*)(modg + (size_t)cond * MODW + q * 256 + lane * 4); const f32x4 w = *(const f32x4*)(nwA + q * 256 + lane * 4);
                    v[j][q] = v[j][q] + g * (m[q] * rs * w); }
            }
#pragma unroll
            for (int q = 0; q < 4; ++q) *(f32x4*)(xd + q * 256 + lane * 4) = v[j][q];
            if (H) {
                float ss = 0.f;
#pragma unroll
                for (int q = 0; q < 4; ++q) ss += (v[j][q][0] * v[j][q][0] + v[j][q][1] * v[j][q][1]) + (v[j][q][2] * v[j][q][2] + v[j][q][3] * v[j][q][3]);
                const float rs = rsqrtf(wave_sum(ss, lane) * (1.f / D) + EPS);
#pragma unroll
                for (int q = 0; q < 4; ++q) { const int c = q * 256 + lane * 4;
                    const f32x4 w = *(const f32x4*)(nwB + c); const f32x4 sc = *(const f32x4*)(modh + (size_t)cond * MODW + sc_off + c); const f32x4 sh = *(const f32x4*)(modh + (size_t)cond * MODW + sh_off + c);
                    const f32x4 hv = (v[j][q] * rs * w) * (sc + 1.0f) + sh;
                    v2u o; o.x = pk2(hv[0], hv[1]); o.y = pk2(hv[2], hv[3]); *(v2u*)(H + (size_t)r * D + c) = o; }
            } } }
    }
}

__device__ __forceinline__ void convgate2(const Args& a, int l, int nrows) {
    const bf16* U = (const bf16*)(a.ws + WS_U); bf16* G = (bf16*)(a.ws + WS_G); const float* cw = a.in[I_FCONV] + (size_t)l * 3 * UPW;
    const int total = (nrows / 8) * (DFF / 8);
    for (int idx = blockIdx.x * NTHR + otid(); idx < total; idx += gridDim.x * NTHR) {
        const int r0 = (idx / (DFF / 8)) * 8, c0 = (idx % (DFF / 8)) * 8; const bf16* u = U + (size_t)r0 * UPW + c0;
        const bool hp = has_prev(r0), hn = has_next(r0 + 7);
        v4u ua[10], ug[10];
#pragma unroll
        for (int j = 0; j < 10; ++j) { const int rr = (j == 0 && !hp) ? 0 : ((j == 9 && !hn) ? 7 : j - 1); ua[j] = *(const v4u*)(u + (ptrdiff_t)rr * UPW); ug[j] = *(const v4u*)(u + (ptrdiff_t)rr * UPW + DFF); }
        float wa[3][8], wg[3][8];
#pragma unroll
        for (int t = 0; t < 3; ++t)
#pragma unroll
            for (int j = 0; j < 8; ++j) { wa[t][j] = cw[t * UPW + c0 + j]; wg[t][j] = cw[t * UPW + DFF + c0 + j]; }
        if (!hp) { ua[0] = (v4u){0u, 0u, 0u, 0u}; ug[0] = ua[0]; }
        if (!hn) { ua[9] = (v4u){0u, 0u, 0u, 0u}; ug[9] = ua[9]; }
        float pa[8], ca[8], na[8], pg[8], cg_[8], ng[8];
        unpack8(ua[0], pa); unpack8(ug[0], pg); unpack8(ua[1], ca); unpack8(ug[1], cg_);
#pragma unroll
        for (int j = 0; j < 8; ++j) {
            unpack8(ua[j + 2], na); unpack8(ug[j + 2], ng);
            float o[8];
#pragma unroll
            for (int k = 0; k < 8; ++k) { const float act = wa[0][k] * pa[k] + wa[1][k] * ca[k] + wa[2][k] * na[k]; const float gate = wg[0][k] * pg[k] + wg[1][k] * cg_[k] + wg[2][k] * ng[k]; o[k] = silu_f(act) * gate; }
            *(v4u*)(G + (size_t)(r0 + j) * DFF + c0) = pack8(o);
#pragma unroll
            for (int k = 0; k < 8; ++k) { pa[k] = ca[k]; ca[k] = na[k]; pg[k] = cg_[k]; cg_[k] = ng[k]; }
        }
    }
}

__device__ __forceinline__ void ssd_conv2(const Args& a, int i) {
    const bf16* ZX = (const bf16*)(a.ws + WS_ZX); bf16* XBC = (bf16*)(a.ws + WS_XBC); float* DT = (float*)(a.ws + WS_DT); float* AA = (float*)(a.ws + WS_AA);
    const float* cw = a.in[I_SCONVW] + (size_t)i * 3 * 3072; const float* cb = a.in[I_SCONVB] + (size_t)i * 3072;
    const int total = (T / 8) * 384;
    for (int idx = blockIdx.x * NTHR + otid(); idx < total; idx += gridDim.x * NTHR) {
        const int r0 = (idx / 384) * 8, c0 = (idx % 384) * 8; const bf16* u = ZX + (size_t)r0 * SSD_INP + 2048 + c0;
        const bool hp = has_prev(r0), hn = has_next(r0 + 7);
        v4u ux[10];
#pragma unroll
        for (int j = 0; j < 10; ++j) { const int rr = (j == 0 && !hp) ? 0 : ((j == 9 && !hn) ? 7 : j - 1); ux[j] = *(const v4u*)(u + (ptrdiff_t)rr * SSD_INP); }
        float w[3][8], bias[8];
#pragma unroll
        for (int j = 0; j < 8; ++j) { w[0][j] = cw[c0 + j]; w[1][j] = cw[3072 + c0 + j]; w[2][j] = cw[2 * 3072 + c0 + j]; bias[j] = cb[c0 + j]; }
        if (!hp) ux[0] = (v4u){0u, 0u, 0u, 0u};
        if (!hn) ux[9] = (v4u){0u, 0u, 0u, 0u};
        float p[8], c[8], n[8];
        unpack8(ux[0], p); unpack8(ux[1], c);
#pragma unroll
        for (int j = 0; j < 8; ++j) {
            unpack8(ux[j + 2], n); float o[8];
#pragma unroll
            for (int k = 0; k < 8; ++k) o[k] = silu_f(bias[k] + w[0][k] * p[k] + w[1][k] * c[k] + w[2][k] * n[k]);
            *(v4u*)(XBC + (size_t)(r0 + j) * 3072 + c0) = pack8(o);
#pragma unroll
            for (int k = 0; k < 8; ++k) { p[k] = c[k]; c[k] = n[k]; }
        }
    }
    const float* alog = a.in[I_ALOG] + i * 64; const float* dtb = a.in[I_DTB] + i * 64;
    for (int idx = blockIdx.x * NTHR + otid(); idx < T * 64; idx += gridDim.x * NTHR) {
        const int r = idx >> 6, j = idx & 63; const float raw = bf1(ZX[(size_t)r * SSD_INP + 5120 + j]) + dtb[j];
        const float dt = raw > 15.f ? raw : (raw < -15.f ? __expf(raw) : __logf(1.f + __expf(raw)));
        DT[idx] = dt; AA[idx] = -__expf(alog[j]) * dt;
    }
}

__device__ __forceinline__ void gatenorm2(const Args& a, int i, int nrows) {
    const int tid = otid(), wave = tid >> 6, lane = tid & 63; const int NGW = gridDim.x * NWAVES, gw = blockIdx.x * NWAVES + wave;
    const bf16* ZX = (const bf16*)(a.ws + WS_ZX); bf16* YN = (bf16*)(a.ws + WS_XBC); const float* nw = a.in[I_SNORM] + i * 2048;
    const int rpw = (nrows + NGW - 1) / NGW; const int rbeg = gw * rpw, rend = min(rbeg + rpw, nrows);
    constexpr int R = 3;
    for (int r0 = rbeg; r0 < rend; r0 += R) {
        v4u yv[R][4], zv[R][4];
#pragma unroll
        for (int j = 0; j < R; ++j) { const int r = min(r0 + j, rend - 1);
#pragma unroll
            for (int q = 0; q < 4; ++q) { const int c = q * 512 + lane * 8; yv[j][q] = *(const v4u*)(ZX + (size_t)r * SSD_INP + 2048 + c); zv[j][q] = *(const v4u*)(ZX + (size_t)r * SSD_INP + c); } }
#pragma unroll
        for (int j = 0; j < R; ++j) { const int r = r0 + j; if (r < rend) {
            float v[4][8]; float ss = 0.f;
#pragma unroll
            for (int q = 0; q < 4; ++q) { float y[8], z[8]; unpack8(yv[j][q], y); unpack8(zv[j][q], z);
#pragma unroll
                for (int k = 0; k < 8; ++k) { v[q][k] = y[k] * silu_f(z[k]); ss += v[q][k] * v[q][k]; } }
            const float rs = rsqrtf(wave_sum(ss, lane) * (1.f / 2048.f) + EPS);
#pragma unroll
            for (int q = 0; q < 4; ++q) { const int c = q * 512 + lane * 8; float o[8];
#pragma unroll
                for (int k = 0; k < 8; ++k) o[k] = v[q][k] * rs * nw[c + k];
                *(v4u*)(YN + (size_t)r * 2048 + c) = pack8(o); } } }
    }
}

#ifndef MK_SINGLE
#define MK_SINGLE 1
#endif
struct GemmDesc { const bf16* A; const bf16* Bt; int M, N, K; bf16* O; int ldc; };

__global__ void __launch_bounds__(NTHR, 2) fwd_kernel(Args a_in) {
    extern __shared__ __attribute__((aligned(16))) unsigned char lds_raw[];
    LAS unsigned char* lds = (LAS unsigned char*)lds_raw;
#if MK_SINGLE == 1
    volatile LAS unsigned* bst = (volatile LAS unsigned*)(lds + LDS_BYTES - 64);
    { const int t0 = otid(); if (t0 < 16) bst[t0] = 0u; }
    __syncthreads();
    const XcdBarrier xbar = xcd_barrier_post((unsigned*)(a_in.ws + WS_CTL), bst);
#endif
    const Args& a0 = a_in;
    for (int s = a0.lo; s < a0.hi; ++s) {
        Args a = a0;
        { long oz; asm volatile("s_mov_b64 %0, 0" : "=s"(oz));
#pragma unroll
          for (int q = 0; q < 25; ++q) a.in[q] = (const float*)((const char*)a0.in[q] + oz);
          a.out = (float*)((char*)a0.out + oz); a.ws = a0.ws + oz; }
        unsigned char* ws = a.ws;
        float* XL = a.out; float* XC = (float*)(ws + WS_XC); bf16* H = (bf16*)(ws + WS_H); bf16* Mb = (bf16*)(ws + WS_M);
        const float* MOD = (const float*)(ws + WS_MOD); const float* NW = a.in[I_NORMW];
        int nrep = 1;
#ifdef PROBE_MASK
        if (s >= 2) { const int pk = (s - 2) % 10, ppar = ((s - 2) / 10) & 1; if ((PROBE_MASK >> (pk + 10 * ppar)) & 1u) nrep = 2; }
#endif
        for (int rep = 0; rep < nrep; ++rep) {
        GemmDesc g0{}, g1{}; int ng = 0;
#ifndef NO_SIMPLE
        if (s == 0) {
            mod_compute(a, lds);
            rope_tables(a);
            convert_layer(a, 0, lds);
        } else if (s == 1) {
            rowwise2<3>(a.in[I_X], a.in[I_CTX], XL, XC, nullptr, nullptr, nullptr, H, MOD, 0, 1024, NW, T);
        } else {
            const int l = (s - 2) / 10, k = (s - 2) % 10, i = l >> 1; const bool even = (l & 1) == 0, last = (l == 3);
            const int MR = last ? TL : T;
            switch (k) {
            case 0:
                if (even) { g0 = GemmDesc{H, (const bf16*)(ws + W_IN), T, HYB_INP, D, (bf16*)(ws + WS_P), HYB_INP}; ng = 1; }
                else      { g0 = GemmDesc{H, (const bf16*)(ws + W_IN), T, SSD_INP, D, (bf16*)(ws + WS_ZX), SSD_INP}; ng = 1; }
                break;
            case 1: if (even) prep_even(a, i); else ssd_conv2(a, i); break;
            case 2:
                if (even) { { g0 = GemmDesc{(const bf16*)(ws + WS_CQN), (const bf16*)(ws + W_UQ), T, QW, 384, (bf16*)(ws + WS_Q), QW}; ng = 1; }
                            g1 = GemmDesc{(const bf16*)(ws + WS_CKVN), (const bf16*)(ws + W_UKV), T, KVW, 256, (bf16*)(ws + WS_KV), KVW}; ng = 2; }
                else {
#ifdef SSD_NAIVE
 ssd_scan_naive(a, i, last, lds);
#else
 ssd_scan_mfma(a, i, last, lds);
#endif
 }
                break;
            case 3: if (even) {
#ifdef ATTN_NAIVE
 attn_naive(a, lds);
#else
 attn_mfma(a, lds);
#endif
 } else gatenorm2(a, i, MR); break;
            case 4:
                if (even) { g0 = GemmDesc{(const bf16*)(ws + WS_MIX), (const bf16*)(ws + W_OUT), MR, D, D, Mb, D}; ng = 1; }
                else      { g0 = GemmDesc{(const bf16*)(ws + WS_XBC), (const bf16*)(ws + W_OUT), MR, D, 2048, Mb, D}; ng = 1; }
                break;
            case 5: rowwise2<3>(XL, XC, XL, XC, Mb, MOD + (size_t)l * 9 * MODW + 2048, NW + (l * 4 + 1) * D, H, MOD + (size_t)l * 9 * MODW, 3072, 4096, NW + (l * 4 + 2) * D, MR); break;
            case 6: { g0 = GemmDesc{H, (const bf16*)(ws + W_UP), MR, UPW, D, (bf16*)(ws + WS_U), UPW}; ng = 1; } break;
            case 7: convgate2(a, l, MR); break;
            case 8: { g0 = GemmDesc{(const bf16*)(ws + WS_G), (const bf16*)(ws + W_DN), MR, D, DFF, Mb, D}; ng = 1; } break;
            case 9:
                if (!last) { rowwise2<3>(XL, XC, XL, XC, Mb, MOD + (size_t)l * 9 * MODW + 5120, NW + (l * 4 + 3) * D, H, MOD + (size_t)(l + 1) * 9 * MODW, 0, 1024, NW + ((l + 1) * 4 + 0) * D, T);
                             convert_layer(a, l + 1, lds); }
                else rowwise2<3>(XL, XC, XL, XC, Mb, MOD + (size_t)l * 9 * MODW + 5120, NW + (l * 4 + 3) * D, nullptr, MOD, 0, 0, NW, TL);
                break;
            }
        }
#else
        { g0 = GemmDesc{H, (const bf16*)(ws + W_IN), T, a.hi * 256, a.lo * 128, (bf16*)(ws + WS_P), HYB_INP}; ng = 1; }
#endif
        for (int gi = 0; gi < ng; ++gi) {
            const bool f = (gi == 0);
            pg8::Gemm g{f ? g0.A : g1.A, f ? g0.Bt : g1.Bt, f ? g0.M : g1.M, f ? g0.N : g1.N, f ? g0.K : g1.K}; pg8::StaticOrder S; S.init(g.M, g.N, (int)gridDim.x, (int)blockIdx.x);
            pg8::EpiStore E{f ? g0.O : g1.O, f ? g0.ldc : g1.ldc};
#ifndef NO_GEMM
            pg8::gemm_phase<pg8::EpiStore, pg8::StaticOrder, true, true>(lds, g, S, E);
#endif
            __syncthreads();
        }
        if (rep + 1 < nrep) __syncthreads();
        }
        if (s + 1 < a0.hi) {
#if MK_SINGLE == 1
            xcd_barrier(xbar);
#elif MK_SINGLE == 2
            cg::this_grid().sync();
#endif
        }
    }
}

extern "C" void kernel_launch(void* const* d_in, const int* in_sizes, int n_in, void* d_out, int out_size, void* d_ws, size_t ws_size, hipStream_t stream) {
    static int grid = 0;
    if (grid == 0) {
        if (n_in != 25 || out_size != TL * D || ws_size < WS_END) { fprintf(stderr, "kernel_launch: unexpected problem (n_in %d out %d ws %zu need %zu)\n", n_in, out_size, ws_size, (size_t)WS_END); grid = -1; return; }
        if (hipFuncSetAttribute((const void*)fwd_kernel, hipFuncAttributeMaxDynamicSharedMemorySize, LDS_BYTES) != hipSuccess) { fprintf(stderr, "kernel_launch: hipFuncSetAttribute failed\n"); grid = -1; return; }
        int dev = 0, cus = 0, per_cu = 0;
        hipGetDevice(&dev); hipDeviceGetAttribute(&cus, hipDeviceAttributeMultiprocessorCount, dev);
        hipOccupancyMaxActiveBlocksPerMultiprocessor(&per_cu, (const void*)fwd_kernel, NTHR, LDS_BYTES);
        (void)hipGetLastError();
        if (per_cu < 1) { fprintf(stderr, "kernel_launch: occupancy query says %d blocks per CU\n", per_cu); }
        grid = cus;
    }
    if (grid < 0) return;
#if MK_SINGLE == 1
    if (hipMemsetAsync((char*)d_ws + WS_CTL, 0, CTL_ZERO_BYTES, stream) != hipSuccess) { fprintf(stderr, "kernel_launch: memset failed\n"); return; }
#endif
    Args a{};
    for (int i = 0; i < 25; ++i) a.in[i] = (const float*)d_in[i];
    a.out = (float*)d_out; a.ws = (unsigned char*)d_ws;
#if MK_SINGLE
    a.lo = 0; a.hi = NSTEP + 1;
    void* args[] = {&a};
    hipError_t e = hipLaunchCooperativeKernel((const void*)fwd_kernel, dim3(grid), dim3(NTHR), args, LDS_BYTES, stream);
    if (e != hipSuccess) fprintf(stderr, "cooperative launch failed: %s (grid %d)\n", hipGetErrorString(e), grid);
#else
    for (int s = 0; s < NSTEP + 1; ++s) { a.lo = s; a.hi = s + 1; hipLaunchKernelGGL(fwd_kernel, dim3(grid), dim3(NTHR), LDS_BYTES, stream, a); }
#endif
}
```

```cpp
#include <hip/hip_runtime.h>
#include <hip/hip_cooperative_groups.h>
#include <cstdio>
#include <cstdint>
namespace cg = cooperative_groups;
__device__ __forceinline__ int otid(int wv) { int l; asm volatile("v_mbcnt_lo_u32_b32 %0, -1, 0\n\tv_mbcnt_hi_u32_b32 %0, -1, %0" : "=v"(l)); return (wv << 6) | l; }
__device__ __forceinline__ float shx(float v, int mask, int lane) { return __builtin_bit_cast(float, __builtin_amdgcn_ds_bpermute((lane ^ mask) << 2, __builtin_bit_cast(int, v))); }
#define LAS __attribute__((address_space(3)))
#define XB_TMO      128
#define XB_XCNT(j)  (256  + 64 * (j))
#define XB_XSUB(j)  (1280 + 64 * (j))
#define XB_XGEN(j)  (2304 + 64 * (j))
#define XB_TOP      3328
#define XB_TOPGEN   3392
#define XCD_BAR_WORDS 3456
#define XB_SPIN_CAP (1u << 18)

__device__ __forceinline__ unsigned xb_ld(unsigned* p)              { return __hip_atomic_load(p, __ATOMIC_RELAXED, __HIP_MEMORY_SCOPE_AGENT); }
__device__ __forceinline__ unsigned xb_add(unsigned* p, unsigned v) { return __hip_atomic_fetch_add(p, v, __ATOMIC_RELAXED, __HIP_MEMORY_SCOPE_AGENT); }
__device__ __forceinline__ unsigned xb_xcc_id() { return (unsigned)__builtin_amdgcn_s_getreg((3 << 11) | 20) & 0xFu; }
#define XB_SPIN(cond, bar) do { unsigned _sp = 0; while (cond) { __builtin_amdgcn_s_sleep(1); \
    if ((++_sp & 255u) == 0u) { if (xb_ld(&(bar)[XB_TMO])) break; if (_sp > XB_SPIN_CAP) { atomicAdd(&(bar)[XB_TMO], 1u); break; } } } } while (0)

struct XcdBarrier {
    unsigned* bar; unsigned x; int wv;
    volatile LAS unsigned* st;
};

__device__ __forceinline__ XcdBarrier xcd_barrier_post(unsigned* bar, volatile LAS unsigned* st, int wv) {
    XcdBarrier b; b.bar = bar; b.x = xb_xcc_id(); b.st = st; b.wv = wv;
    if (otid(wv) == 0) (void)xb_add(&bar[XB_XCNT(b.x)], 1u);
    return b;
}
__device__ __forceinline__ void xcd_barrier_complete(unsigned* bar, unsigned x, unsigned& nloc, unsigned& nx) {
    const unsigned G = gridDim.x * gridDim.y * gridDim.z;
    unsigned sum, cnt, mine, sp = 0u;
    for (;;) {
        sum = 0u; cnt = 0u; mine = 0u;
#pragma unroll
        for (unsigned j = 0; j < 16; ++j) { const unsigned c = xb_ld(&bar[XB_XCNT(j)]); sum += c; cnt += (c > 0u) ? 1u : 0u; mine = (j == x) ? c : mine; }
        if (sum == G) break;
        __builtin_amdgcn_s_sleep(1);
        if ((++sp & 255u) == 0u) { if (xb_ld(&bar[XB_TMO])) break; if (sp > XB_SPIN_CAP) { atomicAdd(&bar[XB_TMO], 1u); break; } }
    }
    nloc = mine > 0u ? mine : 1u; nx = cnt > 0u ? cnt : 1u;
}

__device__ __forceinline__ void xcd_barrier(const XcdBarrier& b) {
    asm volatile("s_waitcnt vmcnt(0)" ::: "memory");
    __syncthreads();
    if (otid(b.wv) == 0) {
        unsigned* bar = b.bar;
        __builtin_amdgcn_s_waitcnt(0);
        unsigned nloc = b.st[0], nx = b.st[1];
        if (nloc == 0u) { xcd_barrier_complete(bar, b.x, nloc, nx); b.st[0] = nloc; b.st[1] = nx; }
        const unsigned old = xb_add(&bar[XB_XSUB(b.x)], 1u);
        const unsigned gen = old / nloc;
        if (old + 1u == (gen + 1u) * nloc) {
            __builtin_amdgcn_fence(__ATOMIC_RELEASE, "agent");
            asm volatile("s_waitcnt vmcnt(0)" ::: "memory");
            const unsigned og = xb_add(&bar[XB_TOP], 1u);
            const unsigned tg = og / nx;
            if (og + 1u == (tg + 1u) * nx) xb_add(&bar[XB_TOPGEN], 1u);
            else XB_SPIN(xb_ld(&bar[XB_TOPGEN]) == tg, bar);
            __builtin_amdgcn_fence(__ATOMIC_ACQUIRE, "agent");
            xb_add(&bar[XB_XGEN(b.x)], 1u);
            asm volatile("s_waitcnt vmcnt(0)" ::: "memory");
        } else {
            XB_SPIN(xb_ld(&bar[XB_XGEN(b.x)]) == gen, bar);
            __builtin_amdgcn_fence(__ATOMIC_ACQUIRE, "agent");
            asm volatile("s_waitcnt vmcnt(0)" ::: "memory");
        }
    }
    __syncthreads();
}
namespace pg8 {
#define PG8_LAS __attribute__((address_space(3)))
typedef unsigned short bf16_t;
typedef short bf16x8 __attribute__((ext_vector_type(8)));
typedef float f32x4 __attribute__((ext_vector_type(4)));
typedef unsigned u32x4 __attribute__((ext_vector_type(4)));
constexpr int BM = 256, BK = 64, HALF = 128, HTB = HALF * BK * 2  , STAGE_BYTES = 8 * HTB, NXCD = 8, WGM = 8;

__host__ __device__ __forceinline__ int lds_byte(int r, int c) { const int st = (r >> 4) * 2 + (c >> 5), rr = r & 15, cc = c & 31, ob = rr * 64 + cc * 2; return st * 1024 + (ob ^ (((ob >> 9) & 1) << 5)); }
__host__ __device__ __forceinline__ void stage_rc(int b, int& R, int& C) { const int st = b / 1024, sb = b % 1024, swz = sb ^ (((sb >> 9) & 1) << 5); R = (st >> 1) * 16 + swz / 64; C = (st & 1) * 32 + (swz % 64) / 2; }
__host__ __device__ __forceinline__ int perm32(int rho) { const int n = rho >> 4, i = rho & 15; return 8 * (i >> 2) + 4 * n + (i & 3); }

struct Unit { int pm, pn; };
struct Gemm { const bf16_t* A; const bf16_t* Bt; int M, N, K, wv; };

struct StaticOrder {
    int nM, nN, nwg, G, c;
    __host__ __device__ void init(int M, int N, int G_, int c_) { nM = M / BM; nN = N / BM; nwg = nM * nN; G = G_; c = c_; }
    __host__ __device__ bool next(int i, Unit& u) const {
        const long L = (long)i * G + c; if (L >= nwg) return false;
        int wgid = (int)L; { const int q = nwg / NXCD, r = nwg % NXCD, xcd = wgid % NXCD, off = wgid / NXCD; wgid = (xcd < r ? xcd * (q + 1) : r * (q + 1) + (xcd - r) * q) + off; }
        const int nig = WGM * nN, gid = wgid / nig, fm = gid * WGM, gsz = (nM - fm) < WGM ? (nM - fm) : WGM;
        u.pm = fm + ((wgid % nig) % gsz); u.pn = (wgid % nig) / gsz; return true;
    }
    __device__ __forceinline__ void a_ready(const Unit&) const {}
    __device__ __forceinline__ void done(const Unit&) const {}
};

__device__ __forceinline__ unsigned cvt_pk_bf16(float lo, float hi) { unsigned r; asm volatile("v_cvt_pk_bf16_f32 %0, %1, %2" : "=v"(r) : "v"(lo), "v"(hi)); return r; }
struct EpiStore {
    static constexpr bool PERM = true, AFTER_DRAIN = false;
    bf16_t* O; int ldc;
    __device__ __forceinline__ void operator()(const f32x4 (&acc)[2][2][4][2], const Unit& u, int wr, int wc, int fr, int fq) const {
        const int row0 = u.pm * BM + wr * 64 + fr; const int col0 = u.pn * BM + wc * 32 + 8 * fq;
#pragma unroll
        for (int ai = 0; ai < 2; ++ai)
#pragma unroll
            for (int m = 0; m < 4; ++m) { bf16_t* rowp = O + (size_t)(row0 + ai * HALF + m * 16) * ldc + col0;
#pragma unroll
                for (int bj = 0; bj < 2; ++bj) { const f32x4 v0 = acc[ai][bj][m][0], v1 = acc[ai][bj][m][1];
                    u32x4 w; w.x = cvt_pk_bf16(v0[0], v0[1]); w.y = cvt_pk_bf16(v0[2], v0[3]); w.z = cvt_pk_bf16(v1[0], v1[1]); w.w = cvt_pk_bf16(v1[2], v1[3]);
                    *(u32x4*)(rowp + bj * HALF) = w; } }
    }
};
template <class Epi, class Sched, bool ALIGN_EPI = false, bool SP2 = false>
__device__ __forceinline__ void gemm_phase(PG8_LAS unsigned char* lds, const Gemm g, const Sched& S, const Epi& E) {
    const int tid = otid(g.wv), wid = g.wv, lane = tid & 63, wr = wid >> 2, wc = wid & 3, fr = lane & 15, fq = lane >> 4;
    const int K = g.K, nt = K / BK;
    unsigned voffA[2], voffB[2];
#pragma unroll
    for (int i = 0; i < 2; ++i) { int R, C; stage_rc(tid * 16 + i * 8192, R, C); const int Rb = Epi::PERM ? ((R & ~31) + perm32(R & 31)) : R;
        voffA[i] = (unsigned)(R * K + C) * 2u; voffB[i] = (unsigned)(Rb * K + C) * 2u; }
    const size_t kstep = (size_t)(BK * 2);
    const size_t hstep = (size_t)HALF * K * 2;
    const size_t tstep = 2 * hstep;
    const unsigned ldsw = (unsigned)wid * 1024u;
    const int aoff = lds_byte(wr * 64 + fr, fq * 8), boff = lds_byte(wc * 32 + fr, fq * 8);
#define PG8_SA(b, h) (((b) * 2 + (h)) * HTB)
#define PG8_SB(b, h) ((4 + (b) * 2 + (h)) * HTB)
#define PG8_STAGE(bufoff, gbase, voff) do { _Pragma("unroll") for (int _i = 0; _i < 2; ++_i) \
        __builtin_amdgcn_global_load_lds((const unsigned*)((const char*)(gbase) + (voff)[_i]), (PG8_LAS unsigned*)(lds + (bufoff) + ldsw + _i * 8192), 16, 0, 0); } while (0)
#define PG8_LDA(dst, b, h) do { _Pragma("unroll") for (int m = 0; m < 4; ++m) _Pragma("unroll") for (int k = 0; k < 2; ++k) dst[m][k] = *(const PG8_LAS bf16x8*)(lds + PG8_SA(b, h) + aoff + m * 2048 + k * 1024); } while (0)
#define PG8_LDB(dst, b, h) do { _Pragma("unroll") for (int n = 0; n < 2; ++n) _Pragma("unroll") for (int k = 0; k < 2; ++k) dst[n][k] = *(const PG8_LAS bf16x8*)(lds + PG8_SB(b, h) + boff + n * 2048 + k * 1024); } while (0)
#define PG8_MMA(ai, bj, At, Bt) do { __builtin_amdgcn_s_setprio(1); _Pragma("unroll") for (int m = 0; m < 4; ++m) _Pragma("unroll") for (int n = 0; n < 2; ++n) _Pragma("unroll") for (int k = 0; k < 2; ++k) \
        acc[ai][bj][m][n] = __builtin_amdgcn_mfma_f32_16x16x32_bf16(Bt[n][k], At[m][k], acc[ai][bj][m][n], 0, 0, 0); __builtin_amdgcn_s_setprio(0); } while (0)
#define PG8_WAIT_V(n) asm volatile("s_waitcnt vmcnt(" #n ")" ::: "memory")
#define PG8_WAIT_L(n) asm volatile("s_waitcnt lgkmcnt(" #n ")" ::: "memory")
#define PG8_BAR __builtin_amdgcn_s_barrier()
#define PG8_SCHED __builtin_amdgcn_sched_barrier(0)
    Unit cur, nxt; int ui = 0;
    if (!S.next(0, cur)) return;
    f32x4 acc[2][2][4][2];
#pragma unroll
    for (int a = 0; a < 2; ++a)
#pragma unroll
        for (int b = 0; b < 2; ++b)
#pragma unroll
            for (int m = 0; m < 4; ++m)
#pragma unroll
                for (int n = 0; n < 2; ++n) acc[a][b][m][n] = (f32x4){0.f, 0.f, 0.f, 0.f};
    bf16x8 At[4][2], B0[2][2], B1[2][2];
    const char* cA = (const char*)g.A + (size_t)cur.pm * tstep; const char* cB = (const char*)g.Bt + (size_t)cur.pn * tstep;
    S.a_ready(cur);
    if constexpr (SP2) {
        PG8_STAGE(PG8_SB(0, 0), cB, voffB); PG8_STAGE(PG8_SB(0, 1), cB + hstep, voffB); PG8_STAGE(PG8_SA(0, 0), cA, voffA); PG8_STAGE(PG8_SA(0, 1), cA + hstep, voffA);
        if (wr == 1) PG8_BAR;
        PG8_WAIT_V(2); PG8_BAR;
        PG8_STAGE(PG8_SB(1, 0), cB + kstep, voffB); PG8_STAGE(PG8_SA(1, 0), cA + kstep, voffA); PG8_STAGE(PG8_SB(1, 1), cB + hstep + kstep, voffB);
        PG8_WAIT_V(6); PG8_BAR;
    } else {
        PG8_STAGE(PG8_SB(0, 0), cB, voffB); PG8_STAGE(PG8_SA(0, 0), cA, voffA); PG8_STAGE(PG8_SB(0, 1), cB + hstep, voffB); PG8_STAGE(PG8_SA(0, 1), cA + hstep, voffA);
        if (wr == 1) PG8_BAR;
        PG8_WAIT_V(4); PG8_BAR;
        PG8_STAGE(PG8_SB(1, 0), cB + kstep, voffB); PG8_STAGE(PG8_SA(1, 0), cA + kstep, voffA); PG8_STAGE(PG8_SB(1, 1), cB + hstep + kstep, voffB);
        PG8_WAIT_V(6); PG8_BAR;
    }
    for (;;) {
        const bool has_next = S.next(ui + 1, nxt);
        const char* nA = has_next ? (const char*)g.A + (size_t)nxt.pm * tstep : cA; const char* nB = has_next ? (const char*)g.Bt + (size_t)nxt.pn * tstep : cB;
        for (int t = 0; t < nt; t += 2) {
            const bool last = (t == nt - 2);
            const char* a1 = cA + (size_t)(t + 1) * kstep;
            const char* a2 = last ? nA : cA + (size_t)(t + 2) * kstep; const char* b2 = last ? nB : cB + (size_t)(t + 2) * kstep;
            const char* a3 = a2 + kstep; const char* b3 = b2 + kstep;
            if (last && has_next) S.a_ready(nxt);
            if constexpr (SP2) {
            PG8_LDB(B0, 0, 0); PG8_LDB(B1, 0, 1); PG8_SCHED; PG8_LDA(At, 0, 0); PG8_STAGE(PG8_SA(1, 1), a1 + hstep, voffA);
            PG8_WAIT_V(8); PG8_WAIT_L(0); PG8_BAR; PG8_MMA(0, 0, At, B0); PG8_MMA(0, 1, At, B1); PG8_BAR; PG8_SCHED;
            PG8_LDA(At, 0, 1); PG8_STAGE(PG8_SB(0, 0), b2, voffB); PG8_STAGE(PG8_SB(0, 1), b2 + hstep, voffB); PG8_STAGE(PG8_SA(0, 0), a2, voffA);
            PG8_WAIT_V(8); PG8_WAIT_L(0); PG8_BAR; PG8_MMA(1, 0, At, B0); PG8_MMA(1, 1, At, B1); PG8_BAR; PG8_SCHED;
            PG8_LDB(B0, 1, 0); PG8_LDB(B1, 1, 1); PG8_SCHED; PG8_LDA(At, 1, 0); PG8_STAGE(PG8_SA(0, 1), a2 + hstep, voffA);
            PG8_WAIT_V(8); PG8_WAIT_L(0); PG8_BAR; PG8_MMA(0, 0, At, B0); PG8_MMA(0, 1, At, B1); PG8_BAR; PG8_SCHED;
            PG8_LDA(At, 1, 1); PG8_STAGE(PG8_SB(1, 0), b3, voffB); PG8_STAGE(PG8_SB(1, 1), b3 + hstep, voffB); PG8_STAGE(PG8_SA(1, 0), a3, voffA);
            PG8_WAIT_V(8); PG8_WAIT_L(0); PG8_BAR; PG8_MMA(1, 0, At, B0); PG8_MMA(1, 1, At, B1); PG8_BAR; PG8_SCHED;
            } else {
            PG8_LDB(B0, 0, 0); PG8_SCHED; PG8_LDA(At, 0, 0); PG8_STAGE(PG8_SA(1, 1), a1 + hstep, voffA);
            PG8_WAIT_L(8); PG8_BAR; PG8_WAIT_L(0); PG8_MMA(0, 0, At, B0); PG8_BAR; PG8_SCHED;
            PG8_LDB(B1, 0, 1); PG8_STAGE(PG8_SB(0, 0), b2, voffB);
            PG8_BAR; PG8_WAIT_L(0); PG8_MMA(0, 1, At, B1); PG8_BAR;
            PG8_LDA(At, 0, 1); PG8_STAGE(PG8_SA(0, 0), a2, voffA);
            PG8_BAR; PG8_WAIT_L(0); PG8_MMA(1, 0, At, B0); PG8_BAR; PG8_SCHED;
            PG8_STAGE(PG8_SB(0, 1), b2 + hstep, voffB);
            PG8_WAIT_V(6); PG8_BAR; PG8_MMA(1, 1, At, B1); PG8_BAR;
            PG8_LDB(B0, 1, 0); PG8_SCHED; PG8_LDA(At, 1, 0); PG8_STAGE(PG8_SA(0, 1), a2 + hstep, voffA);
            PG8_WAIT_L(8); PG8_BAR; PG8_WAIT_L(0); PG8_MMA(0, 0, At, B0); PG8_BAR; PG8_SCHED;
            PG8_LDB(B1, 1, 1); PG8_STAGE(PG8_SB(1, 0), b3, voffB);
            PG8_BAR; PG8_WAIT_L(0); PG8_MMA(0, 1, At, B1); PG8_BAR;
            PG8_LDA(At, 1, 1); PG8_STAGE(PG8_SA(1, 0), a3, voffA);
            PG8_BAR; PG8_WAIT_L(0); PG8_MMA(1, 0, At, B0); PG8_BAR; PG8_SCHED;
            PG8_STAGE(PG8_SB(1, 1), b3 + hstep, voffB);
            PG8_WAIT_V(6); PG8_BAR; PG8_MMA(1, 1, At, B1); PG8_BAR;
            }
        }
        if constexpr (ALIGN_EPI) { if (wr == 0) PG8_BAR; }
        if constexpr (!Epi::AFTER_DRAIN) { E(acc, cur, wr, wc, fr, fq); S.done(cur); }
        if (!has_next) break;
#pragma unroll
        for (int a = 0; a < 2; ++a)
#pragma unroll
            for (int b = 0; b < 2; ++b)
#pragma unroll
                for (int m = 0; m < 4; ++m)
#pragma unroll
                    for (int n = 0; n < 2; ++n) acc[a][b][m][n] = (f32x4){0.f, 0.f, 0.f, 0.f};
        cur = nxt; cA = nA; cB = nB; ++ui;
        if constexpr (ALIGN_EPI) { if (wr == 1) PG8_BAR; }
    }
    PG8_WAIT_V(0);
    if constexpr (!ALIGN_EPI) { if (wr == 0) PG8_BAR; }
    PG8_BAR;
    if constexpr (Epi::AFTER_DRAIN) { E.fused(acc, cur, wr, wc, fr, fq, lds, wid, lane); S.done(cur); }
#undef PG8_SA
#undef PG8_SB
#undef PG8_STAGE
#undef PG8_LDA
#undef PG8_LDB
#undef PG8_MMA
#undef PG8_WAIT_V
#undef PG8_WAIT_L
#undef PG8_BAR
#undef PG8_SCHED
}
}

typedef unsigned short bf16;
typedef unsigned v4u __attribute__((ext_vector_type(4)));
typedef unsigned v2u __attribute__((ext_vector_type(2)));
typedef float f32x4 __attribute__((ext_vector_type(4)));
constexpr int NWAVES = 8, NTHR = 512;
constexpr int D = 1024, NB = 8, SEQ = 2048, CTXL = 256, TL = NB * SEQ, TC = NB * CTXL, T = TL + TC;
constexpr int HYB_IN = 2208, HYB_INP = 2304, SSD_IN = 5184, SSD_INP = 5376, DFF = 2816, UPW = 5632;
constexpr int QW = 768, KVW = 1024, MODW = 6144;
constexpr float EPS = 1e-6f;
constexpr int NSTEP = 1 + 4 * 10;
constexpr float ATT_SCALE_LOG2E = 0.10206207261596577f * 1.4426950408889634f;

constexpr size_t MiB = 1u << 20;
constexpr size_t WS_CTL = 0, CTL_ZERO_BYTES = 64 * 1024;
constexpr size_t WS_MOD = 1 * MiB;
constexpr size_t WS_ROPE = 2 * MiB;
constexpr size_t W_UP = 3 * MiB;
constexpr size_t W_DN = W_UP + (size_t)UPW * D * 2;
constexpr size_t W_IN = W_DN + (size_t)D * DFF * 2;
constexpr size_t W_OUT = W_IN + (size_t)SSD_INP * D * 2;
constexpr size_t W_UQ = W_OUT + (size_t)D * 2048 * 2;
constexpr size_t W_UKV = W_UQ + (size_t)QW * 384 * 2;
constexpr size_t W_END = W_UKV + (size_t)KVW * 256 * 2;
constexpr size_t WS_XC = 36 * MiB;
constexpr size_t WS_H = 44 * MiB;
constexpr size_t WS_DT = WS_H, WS_AA = WS_H + (size_t)T * 64 * 4;
constexpr size_t WS_BIG = 80 * MiB;
constexpr size_t WS_M = WS_BIG;
constexpr size_t WS_P = WS_BIG;
constexpr size_t WS_Q = WS_BIG + 81 * MiB;
constexpr size_t WS_KV = WS_BIG + 108 * MiB;
constexpr size_t WS_KR = WS_BIG + 144 * MiB;
constexpr size_t WS_CQN = WS_BIG + 146 * MiB;
constexpr size_t WS_CKVN = WS_BIG + 160 * MiB;
constexpr size_t WS_MIX = WS_BIG + 170 * MiB;
constexpr size_t WS_U = WS_BIG;
constexpr size_t WS_G = WS_BIG + 198 * MiB;
constexpr size_t WS_ZX = WS_BIG;
constexpr size_t WS_XBC = WS_BIG + 189 * MiB;
constexpr size_t WS_END = WS_BIG + 297 * MiB;
static_assert(W_END <= WS_XC && WS_G + (size_t)T * DFF * 2 <= WS_END && WS_XBC + (size_t)T * 3072 * 2 <= WS_END && WS_ZX + (size_t)T * SSD_INP * 2 <= WS_XBC, "ws map");
static_assert(WS_AA + (size_t)T * 64 * 4 <= WS_BIG && WS_MIX + (size_t)T * D * 2 <= WS_END && WS_Q + (size_t)T * QW * 2 <= WS_KV && WS_P + (size_t)T * HYB_INP * 2 <= WS_Q, "ws map 2");
constexpr int LDS_BYTES = 147456;

struct Args { const float* in[25]; float* out; unsigned char* ws; int lo, hi; int wv, pad; };
enum { I_X = 0, I_C, I_CTX, I_CCTX, I_MODW, I_MODB, I_NORMW, I_WUP, I_FCONV, I_WDN, I_HIN, I_QNORM, I_KVNORM, I_WUQ, I_WUKV, I_SCONV, I_HOUT, I_SIN, I_SCONVW, I_SCONVB, I_ALOG, I_DTB, I_SD, I_SNORM, I_SOUT };

__device__ __forceinline__ unsigned f2bf(float f) { unsigned u = __builtin_bit_cast(unsigned, f); return (u + 0x7fffu + ((u >> 16) & 1u)) >> 16; }
__device__ __forceinline__ unsigned pk2(float lo, float hi) { return f2bf(lo) | (f2bf(hi) << 16); }
__device__ __forceinline__ float bflo(unsigned u) { return __builtin_bit_cast(float, u << 16); }
__device__ __forceinline__ float bfhi(unsigned u) { return __builtin_bit_cast(float, u & 0xffff0000u); }
__device__ __forceinline__ float bf1(bf16 b) { return __builtin_bit_cast(float, (unsigned)b << 16); }
__device__ __forceinline__ float silu_f(float x) { return x / (1.f + __expf(-x)); }
__device__ __forceinline__ float wave_sum(float v, int lane) {
#pragma unroll
    for (int o = 1; o < 64; o <<= 1) v += shx(v, o, lane);
    return v;
}
__device__ __forceinline__ void unpack8(const v4u w, float (&f)[8]) { f[0] = bflo(w.x); f[1] = bfhi(w.x); f[2] = bflo(w.y); f[3] = bfhi(w.y); f[4] = bflo(w.z); f[5] = bfhi(w.z); f[6] = bflo(w.w); f[7] = bfhi(w.w); }
__device__ __forceinline__ v4u pack8(const float (&f)[8]) { v4u w; w.x = pk2(f[0], f[1]); w.y = pk2(f[2], f[3]); w.z = pk2(f[4], f[5]); w.w = pk2(f[6], f[7]); return w; }
__device__ __forceinline__ bool has_prev(int r) { return r < TL ? (r & (SEQ - 1)) != 0 : ((r - TL) & (CTXL - 1)) != 0; }
__device__ __forceinline__ bool has_next(int r) { return r < TL ? (r & (SEQ - 1)) != SEQ - 1 : ((r - TL) & (CTXL - 1)) != CTXL - 1; }

__device__ __forceinline__ void mod_compute(const Args& a, LAS unsigned char* lds) {
    LAS float* sc = (LAS float*)lds;
    LAS float* red = (LAS float*)(lds + 36864);
    const int tid = otid(a.wv);
    float* MOD = (float*)(a.ws + WS_MOD);
    for (int i = tid; i < 9 * 1024; i += NTHR) { const int c = i >> 10, k = i & 1023; const float v = c < 8 ? a.in[I_C][c * 1024 + k] : a.in[I_CCTX][k]; sc[i] = silu_f(v); }
    __syncthreads();
    for (int item = blockIdx.x; item < 4 * 96; item += gridDim.x) {
        const int l = item / 96, cb = item % 96;
        const float* W = a.in[I_MODW] + (size_t)l * 1024 * MODW + cb * 64;
        const int cgp = tid & 15, kg = tid >> 4;
        float acc[9][4];
#pragma unroll
        for (int c = 0; c < 9; ++c) { acc[c][0] = 0.f; acc[c][1] = 0.f; acc[c][2] = 0.f; acc[c][3] = 0.f; }
#pragma unroll 4
        for (int kk = 0; kk < 32; ++kk) { const int k = kg * 32 + kk; const f32x4 w = *(const f32x4*)(W + (size_t)k * MODW + cgp * 4);
#pragma unroll
            for (int c = 0; c < 9; ++c) { const float s = sc[c * 1024 + k]; acc[c][0] += s * w[0]; acc[c][1] += s * w[1]; acc[c][2] += s * w[2]; acc[c][3] += s * w[3]; } }
#pragma unroll
        for (int c = 0; c < 9; ++c)
#pragma unroll
            for (int j = 0; j < 4; ++j) red[kg * 576 + c * 64 + cgp * 4 + j] = acc[c][j];
        __syncthreads();
        for (int o = tid; o < 576; o += NTHR) { float s = 0.f;
            for (int g = 0; g < 32; ++g) s += red[g * 576 + o];
            const int c = o >> 6, col = o & 63; MOD[(size_t)(l * 9 + c) * MODW + cb * 64 + col] = s + a.in[I_MODB][l * MODW + cb * 64 + col]; }
        __syncthreads();
    }
}
__device__ __forceinline__ void rope_tables(const Args& a) {
    float* ct = (float*)(a.ws + WS_ROPE); float* st = ct + SEQ * 16;
    for (int i = blockIdx.x * NTHR + otid(a.wv); i < SEQ * 16; i += gridDim.x * NTHR) {
        const int t = i >> 4, j = i & 15; const int pos = j < 8 ? (t >> 6) : (t & 63); const int f = j & 7;
        const float i0 = (f & 1) ? 0.31622776601683794f : 1.0f; const int e = f >> 1; const float i1 = e == 0 ? 1.0f : (e == 1 ? 0.1f : (e == 2 ? 0.01f : 0.001f));
        const float inv = i0 * i1; const float ang = (float)pos * inv;
        ct[i] = __cosf(ang); st[i] = __sinf(ang); }
}
__device__ __forceinline__ void transpose_item(const float* W, int K, int N, bf16* WT, LAS float* scr, int item, int lane) {
    const int nblk = N / 32, kb = item / nblk, nb = item % nblk, k0 = 64 * kb, n0 = 32 * nb;
#pragma unroll 8
    for (int i = 0; i < 32; ++i) { const int kk = 2 * i + (lane >> 5); scr[kk * 33 + (lane & 31)] = W[(size_t)(k0 + kk) * N + n0 + (lane & 31)]; }
    asm volatile("s_waitcnt lgkmcnt(0)" ::: "memory");
    const int c = lane & 7;
#pragma unroll
    for (int j = 0; j < 4; ++j) { const int n = (lane >> 3) + 8 * j; const LAS float* s = scr + (8 * c) * 33 + n;
        v4u o; o.x = pk2(s[0 * 33], s[1 * 33]); o.y = pk2(s[2 * 33], s[3 * 33]); o.z = pk2(s[4 * 33], s[5 * 33]); o.w = pk2(s[6 * 33], s[7 * 33]);
        *(v4u*)(WT + (size_t)(n0 + n) * K + k0 + 8 * c) = o; }
    asm volatile("s_waitcnt lgkmcnt(0)" ::: "memory");
}
__device__ __forceinline__ void convert_weight(const float* W, int K, int N, int Npad, bf16* WT, LAS unsigned char* lds, int rot, int wv) {
    const int wave = wv, lane = otid(wv) & 63; const int NGW = gridDim.x * NWAVES; const int gw = (blockIdx.x * NWAVES + wave + rot) % NGW;
    LAS float* scr = (LAS float*)(lds + wave * 16384);
    const int nitems = (K / 64) * (N / 32);
    for (int it = gw; it < nitems; it += NGW) transpose_item(W, K, N, WT, scr, it, lane);
    (void)Npad;
}
__device__ __forceinline__ void convert_layer(const Args& a, int l, LAS unsigned char* lds) {
    const int i = l >> 1; unsigned char* ws = a.ws;
    convert_weight(a.in[I_WUP] + (size_t)l * D * UPW, D, UPW, UPW, (bf16*)(ws + W_UP), lds, 0, a.wv);
    convert_weight(a.in[I_WDN] + (size_t)l * DFF * D, DFF, D, D, (bf16*)(ws + W_DN), lds, 300, a.wv);
    if ((l & 1) == 0) {
        convert_weight(a.in[I_HIN] + (size_t)i * D * HYB_IN, D, HYB_IN, HYB_INP, (bf16*)(ws + W_IN), lds, 700, a.wv);
        convert_weight(a.in[I_HOUT] + (size_t)i * D * D, D, D, D, (bf16*)(ws + W_OUT), lds, 1100, a.wv);
        convert_weight(a.in[I_WUQ] + (size_t)i * 384 * QW, 384, QW, QW, (bf16*)(ws + W_UQ), lds, 1500, a.wv);
        convert_weight(a.in[I_WUKV] + (size_t)i * 256 * KVW, 256, KVW, KVW, (bf16*)(ws + W_UKV), lds, 1700, a.wv);
    } else {
        convert_weight(a.in[I_SIN] + (size_t)i * D * SSD_IN, D, SSD_IN, SSD_INP, (bf16*)(ws + W_IN), lds, 700, a.wv);
        convert_weight(a.in[I_SOUT] + (size_t)i * 2048 * D, 2048, D, D, (bf16*)(ws + W_OUT), lds, 1300, a.wv);
    }
}

__device__ __forceinline__ void prep_even(const Args& a, int i) {
    const int wave = otid(a.wv) >> 6, lane = otid(a.wv) & 63; const int NGW = gridDim.x * NWAVES, gw = blockIdx.x * NWAVES + wave;
    const bf16* P = (const bf16*)(a.ws + WS_P); bf16* CQN = (bf16*)(a.ws + WS_CQN); bf16* CKVN = (bf16*)(a.ws + WS_CKVN); bf16* KR = (bf16*)(a.ws + WS_KR); bf16* MIX = (bf16*)(a.ws + WS_MIX);
    const float* qn = a.in[I_QNORM] + i * 384; const float* kvn = a.in[I_KVNORM] + i * 256; const float* cw = a.in[I_SCONV] + i * 3 * 512;
    const float* ct = (const float*)(a.ws + WS_ROPE); const float* st = ct + SEQ * 16;
    for (int r = gw; r < T; r += NGW) {
        const bf16* p = P + (size_t)r * HYB_INP;
        {
            const unsigned* p32 = (const unsigned*)(p + lane * 6); const unsigned w0 = p32[0], w1 = p32[1], w2 = p32[2];
            float f[6] = {bflo(w0), bfhi(w0), bflo(w1), bfhi(w1), bflo(w2), bfhi(w2)}; float ss = 0.f;
#pragma unroll
            for (int j = 0; j < 6; ++j) ss += f[j] * f[j];
            const float rs = rsqrtf(wave_sum(ss, lane) * (1.f / 384.f) + EPS);
#pragma unroll
            for (int j = 0; j < 6; ++j) f[j] = f[j] * rs * qn[lane * 6 + j];
            unsigned* o32 = (unsigned*)(CQN + (size_t)r * 384 + lane * 6); o32[0] = pk2(f[0], f[1]); o32[1] = pk2(f[2], f[3]); o32[2] = pk2(f[4], f[5]);
        }
        {
            const v2u w = *(const v2u*)(p + 384 + lane * 4); float f[4] = {bflo(w.x), bfhi(w.x), bflo(w.y), bfhi(w.y)};
            const float ss = (f[0] * f[0] + f[1] * f[1]) + (f[2] * f[2] + f[3] * f[3]);
            const float rs = rsqrtf(wave_sum(ss, lane) * (1.f / 256.f) + EPS);
            const f32x4 g = *(const f32x4*)(kvn + lane * 4);
            v2u o; o.x = pk2(f[0] * rs * g[0], f[1] * rs * g[1]); o.y = pk2(f[2] * rs * g[2], f[3] * rs * g[3]); *(v2u*)(CKVN + (size_t)r * 256 + lane * 4) = o;
        }
        {
            const int j = lane & 31; const float v = bf1(p[640 + j]); const float o = shx(v, 16, lane); float res = v;
            if (r < TL) { const int t = r & (SEQ - 1); const float c = ct[t * 16 + (j & 15)], s = st[t * 16 + (j & 15)]; res = (j < 16) ? v * c - o * s : o * s + v * c; }
            if (lane < 32) KR[(size_t)r * 32 + j] = (bf16)f2bf(res);
        }
        {
            const int c0 = lane * 8; float gb[8], cur[8], acc[8], t0[8], t1[8];
            unpack8(*(const v4u*)(p + 672 + c0), gb);
            unpack8(*(const v4u*)(p + 1184 + c0), t0); unpack8(*(const v4u*)(p + 1696 + c0), t1);
#pragma unroll
            for (int j = 0; j < 8; ++j) { cur[j] = t0[j] * t1[j]; acc[j] = cw[512 + c0 + j] * cur[j]; }
            if (has_prev(r)) { unpack8(*(const v4u*)(p - HYB_INP + 1184 + c0), t0); unpack8(*(const v4u*)(p - HYB_INP + 1696 + c0), t1);
#pragma unroll
                for (int j = 0; j < 8; ++j) acc[j] += cw[c0 + j] * (t0[j] * t1[j]); }
            if (has_next(r)) { unpack8(*(const v4u*)(p + HYB_INP + 1184 + c0), t0); unpack8(*(const v4u*)(p + HYB_INP + 1696 + c0), t1);
#pragma unroll
                for (int j = 0; j < 8; ++j) acc[j] += cw[1024 + c0 + j] * (t0[j] * t1[j]); }
#pragma unroll
            for (int j = 0; j < 8; ++j) acc[j] *= gb[j];
            *(v4u*)(MIX + (size_t)r * D + 512 + c0) = pack8(acc);
        }
    }
}

__device__ __forceinline__ void convgate(const Args& a, int l, int nrows) {
    const bf16* U = (const bf16*)(a.ws + WS_U); bf16* G = (bf16*)(a.ws + WS_G); const float* cw = a.in[I_FCONV] + (size_t)l * 3 * UPW;
    const int total = nrows * (DFF / 8);
    for (int idx = blockIdx.x * NTHR + otid(a.wv); idx < total; idx += gridDim.x * NTHR) {
        const int r = idx / (DFF / 8), c0 = (idx % (DFF / 8)) * 8; const bf16* u = U + (size_t)r * UPW + c0;
        float ua[8], ug[8], act[8], gate[8];
        unpack8(*(const v4u*)u, ua); unpack8(*(const v4u*)(u + DFF), ug);
#pragma unroll
        for (int j = 0; j < 8; ++j) { act[j] = cw[UPW + c0 + j] * ua[j]; gate[j] = cw[UPW + DFF + c0 + j] * ug[j]; }
        if (has_prev(r)) { unpack8(*(const v4u*)(u - UPW), ua); unpack8(*(const v4u*)(u - UPW + DFF), ug);
#pragma unroll
            for (int j = 0; j < 8; ++j) { act[j] += cw[c0 + j] * ua[j]; gate[j] += cw[DFF + c0 + j] * ug[j]; } }
        if (has_next(r)) { unpack8(*(const v4u*)(u + UPW), ua); unpack8(*(const v4u*)(u + UPW + DFF), ug);
#pragma unroll
            for (int j = 0; j < 8; ++j) { act[j] += cw[2 * UPW + c0 + j] * ua[j]; gate[j] += cw[2 * UPW + DFF + c0 + j] * ug[j]; } }
#pragma unroll
        for (int j = 0; j < 8; ++j) act[j] = silu_f(act[j]) * gate[j];
        *(v4u*)(G + (size_t)r * DFF + c0) = pack8(act);
    }
}

__device__ __forceinline__ void ssd_conv(const Args& a, int i) {
    const bf16* ZX = (const bf16*)(a.ws + WS_ZX); bf16* XBC = (bf16*)(a.ws + WS_XBC); float* DT = (float*)(a.ws + WS_DT); float* AA = (float*)(a.ws + WS_AA);
    const float* cw = a.in[I_SCONVW] + (size_t)i * 3 * 3072; const float* cb = a.in[I_SCONVB] + (size_t)i * 3072;
    const int total = T * 384;
    for (int idx = blockIdx.x * NTHR + otid(a.wv); idx < total; idx += gridDim.x * NTHR) {
        const int r = idx / 384, c0 = (idx % 384) * 8; const bf16* u = ZX + (size_t)r * SSD_INP + 2048 + c0;
        float x[8], acc[8];
        unpack8(*(const v4u*)u, x);
#pragma unroll
        for (int j = 0; j < 8; ++j) acc[j] = cb[c0 + j] + cw[3072 + c0 + j] * x[j];
        if (has_prev(r)) { unpack8(*(const v4u*)(u - SSD_INP), x);
#pragma unroll
            for (int j = 0; j < 8; ++j) acc[j] += cw[c0 + j] * x[j]; }
        if (has_next(r)) { unpack8(*(const v4u*)(u + SSD_INP), x);
#pragma unroll
            for (int j = 0; j < 8; ++j) acc[j] += cw[2 * 3072 + c0 + j] * x[j]; }
#pragma unroll
        for (int j = 0; j < 8; ++j) acc[j] = silu_f(acc[j]);
        *(v4u*)(XBC + (size_t)r * 3072 + c0) = pack8(acc);
    }
    const float* alog = a.in[I_ALOG] + i * 64; const float* dtb = a.in[I_DTB] + i * 64;
    for (int idx = blockIdx.x * NTHR + otid(a.wv); idx < T * 64; idx += gridDim.x * NTHR) {
        const int r = idx >> 6, j = idx & 63; const float raw = bf1(ZX[(size_t)r * SSD_INP + 5120 + j]) + dtb[j];
        const float dt = raw > 15.f ? raw : (raw < -15.f ? __expf(raw) : __logf(1.f + __expf(raw)));
        DT[idx] = dt; AA[idx] = -__expf(alog[j]) * dt;
    }
}

__device__ __forceinline__ void gatenorm(const Args& a, int i, int nrows) {
    const int wave = otid(a.wv) >> 6, lane = otid(a.wv) & 63; const int NGW = gridDim.x * NWAVES, gw = blockIdx.x * NWAVES + wave;
    const bf16* ZX = (const bf16*)(a.ws + WS_ZX); bf16* YN = (bf16*)(a.ws + WS_XBC); const float* nw = a.in[I_SNORM] + i * 2048;
    for (int r = gw; r < nrows; r += NGW) {
        float v[4][8]; float ss = 0.f;
#pragma unroll
        for (int j = 0; j < 4; ++j) { float y[8], z[8]; const int c = j * 512 + lane * 8;
            unpack8(*(const v4u*)(ZX + (size_t)r * SSD_INP + 2048 + c), y); unpack8(*(const v4u*)(ZX + (size_t)r * SSD_INP + c), z);
#pragma unroll
            for (int k = 0; k < 8; ++k) { v[j][k] = y[k] * silu_f(z[k]); ss += v[j][k] * v[j][k]; } }
        const float rs = rsqrtf(wave_sum(ss, lane) * (1.f / 2048.f) + EPS);
#pragma unroll
        for (int j = 0; j < 4; ++j) { const int c = j * 512 + lane * 8; float o[8];
#pragma unroll
            for (int k = 0; k < 8; ++k) o[k] = v[j][k] * rs * nw[c + k];
            *(v4u*)(YN + (size_t)r * 2048 + c) = pack8(o); }
    }
}

__device__ __forceinline__ void attn_naive(const Args& a, LAS unsigned char* lds) {
    const int tid = otid(a.wv), qi = tid >> 1, half = tid & 1;
    const bf16* Qb = (const bf16*)(a.ws + WS_Q); const bf16* KVb = (const bf16*)(a.ws + WS_KV); const bf16* KR = (const bf16*)(a.ws + WS_KR); bf16* MIX = (bf16*)(a.ws + WS_MIX);
    const float* ct = (const float*)(a.ws + WS_ROPE); const float* st = ct + SEQ * 16;
    LAS float* Kt = (LAS float*)lds;
    LAS float* Vt = (LAS float*)(lds + 64 * 96 * 4);
    for (int u = blockIdx.x; u < 576; u += gridDim.x) {
        const bool lat = u < 512; const int b = lat ? (u >> 6) : ((u - 512) >> 3), h = lat ? ((u >> 3) & 7) : ((u - 512) & 7);
        const int nkeys = lat ? (CTXL + SEQ) : CTXL;
        const int qrow = lat ? b * SEQ + (u & 7) * 256 + qi : TL + b * CTXL + qi;
        float q[48];
#pragma unroll
        for (int g = 0; g < 6; ++g) { float f[8]; unpack8(*(const v4u*)(Qb + (size_t)qrow * QW + h * 96 + half * 48 + g * 8), f);
#pragma unroll
            for (int j = 0; j < 8; ++j) q[g * 8 + j] = f[j]; }
        if (lat && half == 1) { const int t = qrow & (SEQ - 1);
#pragma unroll
            for (int j = 0; j < 16; ++j) { const float c = ct[t * 16 + j], s = st[t * 16 + j]; const float x1 = q[16 + j], x2 = q[32 + j]; q[16 + j] = x1 * c - x2 * s; q[32 + j] = x1 * s + x2 * c; } }
#pragma unroll
        for (int j = 0; j < 48; ++j) q[j] *= ATT_SCALE_LOG2E;
        float o[32]; float m = -1e30f, l = 0.f;
#pragma unroll
        for (int j = 0; j < 32; ++j) o[j] = 0.f;
        for (int k0 = 0; k0 < nkeys; k0 += 64) {
            __syncthreads();
            for (int g = tid; g < 768; g += NTHR) { const int key = g / 12, part = g % 12; const int kk = k0 + key; const int krow = kk < CTXL ? TL + b * CTXL + kk : b * SEQ + kk - CTXL;
                float f[8]; unpack8(part < 8 ? *(const v4u*)(KVb + (size_t)krow * KVW + h * 128 + part * 8) : *(const v4u*)(KR + (size_t)krow * 32 + (part - 8) * 8), f);
#pragma unroll
                for (int j = 0; j < 8; ++j) Kt[key * 96 + part * 8 + j] = f[j]; }
            { const int key = tid >> 3, part = tid & 7; const int kk = k0 + key; const int krow = kk < CTXL ? TL + b * CTXL + kk : b * SEQ + kk - CTXL;
                float f[8]; unpack8(*(const v4u*)(KVb + (size_t)krow * KVW + h * 128 + 64 + part * 8), f);
#pragma unroll
                for (int j = 0; j < 8; ++j) Vt[key * 64 + part * 8 + j] = f[j]; }
            __syncthreads();
            for (int kg = 0; kg < 64; kg += 8) {
                float s[8]; float gm = -1e30f;
#pragma unroll
                for (int kk = 0; kk < 8; ++kk) { float acc = 0.f; const LAS f32x4* kp = (const LAS f32x4*)(Kt + (kg + kk) * 96 + half * 48);
#pragma unroll
                    for (int d4 = 0; d4 < 12; ++d4) { const f32x4 kv = kp[d4]; acc += q[d4 * 4] * kv[0] + q[d4 * 4 + 1] * kv[1] + q[d4 * 4 + 2] * kv[2] + q[d4 * 4 + 3] * kv[3]; }
                    acc += shx(acc, 1, tid & 63);
                    s[kk] = acc; gm = fmaxf(gm, acc); }
                const float mn = fmaxf(m, gm); const float alpha = exp2f(m - mn); m = mn; l *= alpha;
#pragma unroll
                for (int j = 0; j < 32; ++j) o[j] *= alpha;
#pragma unroll
                for (int kk = 0; kk < 8; ++kk) { const float p = exp2f(s[kk] - mn); l += p; const LAS f32x4* vp = (const LAS f32x4*)(Vt + (kg + kk) * 64 + half * 32);
#pragma unroll
                    for (int d4 = 0; d4 < 8; ++d4) { const f32x4 vv = vp[d4]; o[d4 * 4] += p * vv[0]; o[d4 * 4 + 1] += p * vv[1]; o[d4 * 4 + 2] += p * vv[2]; o[d4 * 4 + 3] += p * vv[3]; } }
            }
        }
        { const float inv = 1.f / l;
#pragma unroll
            for (int g = 0; g < 4; ++g) { float f[8];
#pragma unroll
                for (int j = 0; j < 8; ++j) f[j] = o[g * 8 + j] * inv;
                *(v4u*)(MIX + (size_t)qrow * D + h * 64 + half * 32 + g * 8) = pack8(f); } }
    }
}

__device__ __forceinline__ void ssd_scan_naive(const Args& a, int i, bool last, LAS unsigned char* lds) {
    const int tid = otid(a.wv), p = tid >> 3, nq = tid & 7;
    bf16* ZX = (bf16*)(a.ws + WS_ZX); const bf16* XBC = (const bf16*)(a.ws + WS_XBC); const float* DT = (const float*)(a.ws + WS_DT); const float* AA = (const float*)(a.ws + WS_AA);
    LAS float* xs = (LAS float*)lds;
    LAS float* Bs = (LAS float*)(lds + 16384);
    LAS float* Cs = (LAS float*)(lds + 16384 + 32768);
    LAS float* dts = (LAS float*)(lds + 16384 + 65536);
    LAS float* as = dts + 64;
    for (int it = blockIdx.x; it < NB * 32; it += gridDim.x) {
        const int b = it >> 5, h = it & 31, g = h >> 3; const float dsk = a.in[I_SD][i * 32 + h];
        for (int dir = 0; dir < 2; ++dir) {
            float stt[16];
#pragma unroll
            for (int n = 0; n < 16; ++n) stt[n] = 0.f;
            for (int seg = 0; seg < 2; ++seg) {
                const int len = seg == 0 ? CTXL : SEQ; const int base = seg == 0 ? TL + b * CTXL : b * SEQ; const bool want_y = !(last && seg == 0);
                for (int cc = 0; cc < len / 64; ++cc) {
                    const int t0 = dir == 0 ? cc * 64 : len - 64 - cc * 64;
                    __syncthreads();
                    { const int tt = tid >> 3, part = tid & 7; float f[8]; unpack8(*(const v4u*)(XBC + (size_t)(base + t0 + tt) * 3072 + h * 64 + part * 8), f);
#pragma unroll
                        for (int j = 0; j < 8; ++j) xs[tt * 64 + part * 8 + j] = f[j]; }
                    for (int q = tid; q < 1024; q += NTHR) { const int tt = q >> 4, part = q & 15; float f[8];
                        unpack8(*(const v4u*)(XBC + (size_t)(base + t0 + tt) * 3072 + 2048 + g * 128 + part * 8), f);
#pragma unroll
                        for (int j = 0; j < 8; ++j) Bs[tt * 128 + part * 8 + j] = f[j];
                        unpack8(*(const v4u*)(XBC + (size_t)(base + t0 + tt) * 3072 + 2560 + g * 128 + part * 8), f);
#pragma unroll
                        for (int j = 0; j < 8; ++j) Cs[tt * 128 + part * 8 + j] = f[j]; }
                    if (tid < 64) { dts[tid] = DT[(size_t)(base + t0 + tid) * 64 + dir * 32 + h]; as[tid] = AA[(size_t)(base + t0 + tid) * 64 + dir * 32 + h]; }
                    __syncthreads();
                    for (int s = 0; s < 64; ++s) {
                        const int tt = dir == 0 ? s : 63 - s;
                        const float dec = __expf(as[tt]); const float xv = xs[tt * 64 + p]; const float xd = xv * dts[tt];
                        const LAS f32x4* bp = (const LAS f32x4*)(Bs + tt * 128 + nq * 16); const LAS f32x4* cp = (const LAS f32x4*)(Cs + tt * 128 + nq * 16);
                        float acc = 0.f;
#pragma unroll
                        for (int n4 = 0; n4 < 4; ++n4) { const f32x4 bv = bp[n4], cv = cp[n4];
#pragma unroll
                            for (int k = 0; k < 4; ++k) { stt[n4 * 4 + k] = dec * stt[n4 * 4 + k] + xd * bv[k]; acc += cv[k] * stt[n4 * 4 + k]; } }
                        acc += shx(acc, 1, tid & 63); acc += shx(acc, 2, tid & 63); acc += shx(acc, 4, tid & 63);
                        if (want_y && nq == 0) { bf16* yp = ZX + (size_t)(base + t0 + tt) * SSD_INP + 2048 + h * 64 + p;
                            const float y = dir == 0 ? acc + dsk * xv : acc + bf1(*yp);
                            *yp = (bf16)f2bf(y); }
                    }
                }
            }
            __syncthreads();
            asm volatile("s_waitcnt vmcnt(0)" ::: "memory");
        }
    }
}

typedef short bf16x8 __attribute__((ext_vector_type(8)));
typedef float f32x16 __attribute__((ext_vector_type(16)));
typedef short v4i16_t __attribute__((ext_vector_type(4)));
__device__ __forceinline__ v2u trread(const LAS unsigned char* p) { return __builtin_bit_cast(v2u, __builtin_amdgcn_ds_read_tr16_b64_v4i16((LAS v4i16_t*)p)); }
__device__ __forceinline__ unsigned cvtpk(float lo, float hi) { unsigned r; asm volatile("v_cvt_pk_bf16_f32 %0, %1, %2" : "=v"(r) : "v"(lo), "v"(hi)); return r; }
constexpr int ATT_KP = 208, ATT_VP = 192, ATT_KB = 64 * ATT_KP, ATT_VB = 64 * ATT_VP, ATT_BUF = ATT_KB + ATT_VB;
#ifndef ATT_NQ
#define ATT_NQ 2
#endif
template <int NQ>
__device__ __forceinline__ void attn_unit3(const Args& a, LAS unsigned char* lds, const int b, const int h, const int q0, const int ntiles, const bool lat) {
    const int tid = otid(a.wv), wave = tid >> 6, lane = tid & 63, r32 = lane & 31, hh = lane >> 5;
    const int tq = (lane >> 2) & 3, tp = lane & 3, tblk = (lane >> 4) & 1;
    const bf16* Qb = (const bf16*)(a.ws + WS_Q); const bf16* KVb = (const bf16*)(a.ws + WS_KV); const bf16* KR = (const bf16*)(a.ws + WS_KR); bf16* MIX = (bf16*)(a.ws + WS_MIX);
    const float* ct = (const float*)(a.ws + WS_ROPE); const float* st = ct + SEQ * 16;
    bf16x8 qf[NQ][6];
#pragma unroll
    for (int nq = 0; nq < NQ; ++nq) { const int qrow = q0 + wave * (32 * NQ) + nq * 32 + r32;
#pragma unroll
        for (int s = 0; s < 6; ++s) qf[nq][s] = *(const bf16x8*)(Qb + (size_t)qrow * QW + h * 96 + 16 * s + 8 * hh);
        if (lat) { const int t = qrow & (SEQ - 1);
#pragma unroll
            for (int j = 0; j < 8; j += 2) { float x1[2], x2[2], y1[2], y2[2];
#pragma unroll
                for (int e = 0; e < 2; ++e) { x1[e] = bf1((bf16)qf[nq][4][j + e]); x2[e] = bf1((bf16)qf[nq][5][j + e]); const float c = ct[t * 16 + 8 * hh + j + e], s = st[t * 16 + 8 * hh + j + e];
                    y1[e] = x1[e] * c - x2[e] * s; y2[e] = x1[e] * s + x2[e] * c; }
                const unsigned w1 = pk2(y1[0], y1[1]), w2 = pk2(y2[0], y2[1]);
                qf[nq][4][j] = (short)(w1 & 0xffff); qf[nq][4][j + 1] = (short)(w1 >> 16); qf[nq][5][j] = (short)(w2 & 0xffff); qf[nq][5][j + 1] = (short)(w2 >> 16); } } }
    f32x16 o0[NQ], o1[NQ]; float m[NQ], l[NQ];
#pragma unroll
    for (int nq = 0; nq < NQ; ++nq) { m[nq] = -1e30f; l[nq] = 0.f;
#pragma unroll
        for (int i = 0; i < 16; ++i) { o0[nq][i] = 0.f; o1[nq][i] = 0.f; } }
    v4u kreg0, kreg1, vreg;
#define ATT_LOAD(it) do { const int rb_ = (it) < CTXL / 64 ? TL + b * CTXL + (it) * 64 : b * SEQ + ((it) - CTXL / 64) * 64; \
        const char* kvb_ = (const char*)(KVb + (size_t)rb_ * KVW); const char* krb_ = (const char*)(KR + (size_t)rb_ * 32); \
        kreg0 = *(const v4u*)(kvb_ + (tid >> 3) * 2048 + h * 256 + (tid & 7) * 16); if (tid < 256) kreg1 = *(const v4u*)(krb_ + (tid >> 2) * 64 + (tid & 3) * 16); vreg = *(const v4u*)(kvb_ + (tid >> 3) * 2048 + h * 256 + 128 + (tid & 7) * 16); } while (0)
#define ATT_WRITE(buf) do { LAS unsigned char* kb_ = lds + (buf) * ATT_BUF; LAS unsigned char* vb_ = kb_ + ATT_KB; \
        *(LAS v4u*)(kb_ + (tid >> 3) * ATT_KP + (tid & 7) * 16) = kreg0; if (tid < 256) *(LAS v4u*)(kb_ + (tid >> 2) * ATT_KP + 128 + (tid & 3) * 16) = kreg1; \
        *(LAS v4u*)(vb_ + (tid >> 3) * ATT_VP + (tid & 7) * 16) = vreg; } while (0)
    __syncthreads();
    ATT_LOAD(0); ATT_WRITE(0);
    __syncthreads();
    for (int it = 0; it < ntiles; ++it) {
#ifndef ATT_LOADMID
        if (it + 1 < ntiles) ATT_LOAD(it + 1);
#endif
#ifdef ATT_TZ
        int tz = tid; asm volatile("" : "+v"(tz));
        const int lane = tz & 63, r32 = lane & 31, hh = lane >> 5, tq = (lane >> 2) & 3, tp = lane & 3, tblk = (lane >> 4) & 1;
#endif
        const LAS unsigned char* kb = lds + (it & 1) * ATT_BUF; const LAS unsigned char* vb = kb + ATT_KB;
#pragma unroll
        for (int t = 0; t < 2; ++t) {
            f32x16 sc[NQ]; bf16x8 pf[NQ][2];
#pragma unroll
            for (int nq = 0; nq < NQ; ++nq)
#pragma unroll
                for (int i = 0; i < 16; ++i) sc[nq][i] = 0.f;
#pragma unroll
            for (int s = 0; s < 6; ++s) { const bf16x8 a0 = *(const LAS bf16x8*)(kb + (32 * t + r32) * ATT_KP + (16 * s + 8 * hh) * 2);
#pragma unroll
                for (int nq = 0; nq < NQ; ++nq) sc[nq] = __builtin_amdgcn_mfma_f32_32x32x16_bf16(a0, qf[nq][s], sc[nq], 0, 0, 0); }
#ifdef ATT_LOADMID
            if (t == 0 && it + 1 < ntiles) ATT_LOAD(it + 1);
#endif
#pragma unroll
            for (int nq = 0; nq < NQ; ++nq) {
                float mx = sc[nq][0];
#pragma unroll
                for (int i = 1; i < 16; ++i) mx = fmaxf(mx, sc[nq][i]);
                mx = fmaxf(mx, shx(mx, 32, lane));
                const float mn = fmaxf(m[nq], mx * ATT_SCALE_LOG2E); const float alpha = __builtin_amdgcn_exp2f(m[nq] - mn); m[nq] = mn;
                float rs = 0.f;
#pragma unroll
                for (int i = 0; i < 16; ++i) { sc[nq][i] = __builtin_amdgcn_exp2f(sc[nq][i] * ATT_SCALE_LOG2E - mn); rs += sc[nq][i]; }
                l[nq] = l[nq] * alpha + rs;
#pragma unroll
                for (int i = 0; i < 16; ++i) { o0[nq][i] *= alpha; o1[nq][i] *= alpha; }
#pragma unroll
                for (int s2 = 0; s2 < 2; ++s2) { v4u w0;
                    w0.x = cvtpk(sc[nq][8 * s2 + 0], sc[nq][8 * s2 + 1]); w0.y = cvtpk(sc[nq][8 * s2 + 2], sc[nq][8 * s2 + 3]); w0.z = cvtpk(sc[nq][8 * s2 + 4], sc[nq][8 * s2 + 5]); w0.w = cvtpk(sc[nq][8 * s2 + 6], sc[nq][8 * s2 + 7]);
                    pf[nq][s2] = __builtin_bit_cast(bf16x8, w0); }
            }
#pragma unroll
            for (int s2 = 0; s2 < 2; ++s2) { const int ko = t * 32 + 16 * s2 + 4 * hh;
                { const LAS unsigned char* tb = vb + (ko + tq) * ATT_VP + (16 * tblk + 4 * tp) * 2; const v2u lo = trread(tb), hi = trread(tb + 8 * ATT_VP); const bf16x8 vf = __builtin_bit_cast(bf16x8, (v4u){lo.x, lo.y, hi.x, hi.y});
#pragma unroll
                  for (int nq = 0; nq < NQ; ++nq) o0[nq] = __builtin_amdgcn_mfma_f32_32x32x16_bf16(vf, pf[nq][s2], o0[nq], 0, 0, 0); }
                { const LAS unsigned char* tb = vb + (ko + tq) * ATT_VP + (32 + 16 * tblk + 4 * tp) * 2; const v2u lo = trread(tb), hi = trread(tb + 8 * ATT_VP); const bf16x8 vf = __builtin_bit_cast(bf16x8, (v4u){lo.x, lo.y, hi.x, hi.y});
#pragma unroll
                  for (int nq = 0; nq < NQ; ++nq) o1[nq] = __builtin_amdgcn_mfma_f32_32x32x16_bf16(vf, pf[nq][s2], o1[nq], 0, 0, 0); } }
        }
        if (it + 1 < ntiles) ATT_WRITE((it + 1) & 1);
        __syncthreads();
    }
#undef ATT_LOAD
#undef ATT_WRITE
#pragma unroll
    for (int nq = 0; nq < NQ; ++nq) { const int qrow = q0 + wave * (32 * NQ) + nq * 32 + r32;
        const float lsum = l[nq] + shx(l[nq], 32, lane); const float inv = 1.f / lsum;
        bf16* orow = MIX + (size_t)qrow * D + h * 64 + 4 * hh;
#pragma unroll
        for (int g = 0; g < 4; ++g) {
            v2u w; w.x = pk2(o0[nq][4 * g] * inv, o0[nq][4 * g + 1] * inv); w.y = pk2(o0[nq][4 * g + 2] * inv, o0[nq][4 * g + 3] * inv); *(v2u*)(orow + 8 * g) = w;
            v2u x; x.x = pk2(o1[nq][4 * g] * inv, o1[nq][4 * g + 1] * inv); x.y = pk2(o1[nq][4 * g + 2] * inv, o1[nq][4 * g + 3] * inv); *(v2u*)(orow + 32 + 8 * g) = x; } }
}
__device__ __forceinline__ void attn_mfma(const Args& a, LAS unsigned char* lds) {
#if ATT_NQ == 2
    for (int u = blockIdx.x; u < 256; u += gridDim.x) attn_unit3<2>(a, lds, u >> 5, (u >> 2) & 7, (u >> 5) * SEQ + (u & 3) * 512, (CTXL + SEQ) / 64, true);
#else
    for (int u = blockIdx.x; u < 512; u += gridDim.x) attn_unit3<1>(a, lds, u >> 6, (u >> 3) & 7, (u >> 6) * SEQ + (u & 7) * 256, (CTXL + SEQ) / 64, true);
#endif
    for (int u = blockIdx.x; u < 64; u += gridDim.x) attn_unit3<1>(a, lds, u >> 3, u & 7, TL + (u >> 3) * CTXL, CTXL / 64, false);
}

#ifndef SSD_YREP
#define SSD_YREP 1
#endif
#ifndef SSD_WREP
#define SSD_WREP 1
#endif
constexpr int SP_B = 272, SP_X = 192;
constexpr int SO_B = 0, SO_C = SO_B + 128 * SP_B, SO_XD = SO_C + 128 * SP_B, SO_XW = SO_XD + 128 * SP_X, SO_S = SO_XW + 128 * SP_X, SO_V = SO_S + 64 * SP_B;
static_assert(SO_V + 2 * 2048 <= LDS_BYTES, "ssd lds map");
#ifdef SSD_DIAG
#define SSD_T(v) long long v = clock64()
#define SSD_ACC(k, v) do { const long long n_ = clock64(); dacc[k] += n_ - v; v = n_; } while (0)
#else
#define SSD_T(v) do {} while (0)
#define SSD_ACC(k, v) do {} while (0)
#endif
__device__ __forceinline__ void ssd_scan_mfma(const Args& a, int i, bool last, LAS unsigned char* lds) {
#ifdef SSD_DIAG
    long long dacc[8] = {0, 0, 0, 0, 0, 0, 0, 0};
#endif
    const int tid = otid(a.wv), wave = tid >> 6, lane = tid & 63, r32 = lane & 31, hh = lane >> 5;
    const int pt = wave >> 2, lt = pt ? 3 - (wave & 3) : (wave & 3);
    const int tq = (lane >> 2) & 3, tp = lane & 3, tblk = (lane >> 4) & 1;
    bf16* ZX = (bf16*)(a.ws + WS_ZX); const bf16* XBC = (const bf16*)(a.ws + WS_XBC); const float* DT = (const float*)(a.ws + WS_DT); const float* AA = (const float*)(a.ws + WS_AA);
    LAS unsigned char* Bl = lds + SO_B; LAS unsigned char* Cl = lds + SO_C; LAS unsigned char* XDl = lds + SO_XD; LAS unsigned char* XWl = lds + SO_XW; LAS unsigned char* Sl = lds + SO_S;
    const int brow = tid >> 4, bpart = tid & 15, xrow = tid >> 3, xpart = tid & 7;
    for (int it = blockIdx.x; it < NB * 32; it += gridDim.x) {
        const int b = it >> 5, h = it & 31, g = h >> 3; const float dsk = a.in[I_SD][i * 32 + h];
        for (int dir = 0; dir < 2; ++dir) {
            const int scanw = dir == 0 ? 0 : 3;
            f32x16 sacc;
#pragma unroll
            for (int k = 0; k < 16; ++k) sacc[k] = 0.f;
            SSD_T(tprev);
            v4u bq[4], cq[4], xq[2]; float pa0 = 0.f, pa1 = 0.f, pd0 = 0.f, pd1 = 0.f, qa0 = 0.f, qa1 = 0.f, qd0 = 0.f, qd1 = 0.f; v2u add[4], addn[4];
#define SSD_ROWBASE(c) ((c) < 2 ? TL + b * CTXL + (dir == 0 ? (c) : 1 - (c)) * 128 : b * SEQ + (dir == 0 ? (c) - 2 : 17 - (c)) * 128)
#define SSD_PF(c) do { const int rb_ = SSD_ROWBASE(c); \
                _Pragma("unroll") for (int k_ = 0; k_ < 4; ++k_) { const bf16* src_ = XBC + (size_t)(rb_ + brow + 32 * k_) * 3072 + 2048 + g * 128 + bpart * 8; bq[k_] = *(const v4u*)src_; cq[k_] = *(const v4u*)(src_ + 512); } \
                _Pragma("unroll") for (int k_ = 0; k_ < 2; ++k_) xq[k_] = *(const v4u*)(XBC + (size_t)(rb_ + xrow + 64 * k_) * 3072 + h * 64 + xpart * 8); \
                } while (0)
#define SSD_PFV(c) do { if (wave == scanw) { const int rb_ = SSD_ROWBASE(c); const size_t o_ = (size_t)(rb_ + 2 * lane) * 64 + dir * 32 + h; qa0 = AA[o_]; qa1 = AA[o_ + 64]; qd0 = DT[o_]; qd1 = DT[o_ + 64]; } } while (0)
#define SSD_PFY(c) do { const int rb_ = SSD_ROWBASE(c); const size_t r_ = (size_t)(rb_ + 32 * lt + r32); \
                _Pragma("unroll") for (int q_ = 0; q_ < 4; ++q_) addn[q_] = dir == 0 ? *(const v2u*)(XBC + r_ * 3072 + h * 64 + 32 * pt + 4 * hh + 8 * q_) : *(const v2u*)(ZX + r_ * SSD_INP + 2048 + h * 64 + 32 * pt + 4 * hh + 8 * q_); } while (0)
#define SSD_SCAN(vb_) do { if (wave == scanw) { LAS float* V_ = (LAS float*)(lds + SO_V + (vb_) * 2048); const float pair_ = pa0 + pa1; float ps_ = pair_; \
                _Pragma("unroll") for (int d_ = 1; d_ < 64; d_ <<= 1) { const int src_ = dir == 0 ? lane - d_ : lane + d_; const float t_ = __builtin_bit_cast(float, __builtin_amdgcn_ds_bpermute((src_ & 63) << 2, __builtin_bit_cast(int, ps_))); if (src_ >= 0 && src_ < 64) ps_ += t_; } \
                const float tot_ = __builtin_bit_cast(float, __builtin_amdgcn_ds_bpermute((dir == 0 ? 63 : 0) << 2, __builtin_bit_cast(int, ps_))); const float ex_ = ps_ - pair_; \
                float c0_, c1_; if (dir == 0) { c0_ = ex_ + pa0; c1_ = c0_ + pa1; } else { c1_ = ex_ + pa1; c0_ = c1_ + pa0; } \
                V_[2 * lane] = c0_; V_[2 * lane + 1] = c1_; V_[128 + 2 * lane] = pd0; V_[128 + 2 * lane + 1] = pd1; V_[256 + 2 * lane] = pd0 * __expf(tot_ - c0_); V_[256 + 2 * lane + 1] = pd1 * __expf(tot_ - c1_); \
                if (lane == 0) V_[384] = tot_; } } while (0)
#define SSD_WRITE(vb_) do { const LAS float* V_ = (const LAS float*)(lds + SO_V + (vb_) * 2048); \
                _Pragma("unroll") for (int k_ = 0; k_ < 4; ++k_) { *(LAS v4u*)(Bl + (brow + 32 * k_) * SP_B + bpart * 16) = bq[k_]; *(LAS v4u*)(Cl + (brow + 32 * k_) * SP_B + bpart * 16) = cq[k_]; } \
                _Pragma("unroll") for (int k_ = 0; k_ < 2; ++k_) { const int s_ = xrow + 64 * k_; const float dt_ = V_[128 + s_], w_ = V_[256 + s_]; float f_[8], g_[8]; unpack8(xq[k_], f_); \
                    _Pragma("unroll") for (int j_ = 0; j_ < 8; ++j_) { g_[j_] = f_[j_] * w_; f_[j_] *= dt_; } \
                    *(LAS v4u*)(XDl + s_ * SP_X + xpart * 16) = pack8(f_); *(LAS v4u*)(XWl + s_ * SP_X + xpart * 16) = pack8(g_); } } while (0)
            __syncthreads();
            SSD_PFV(0); pa0 = qa0; pa1 = qa1; pd0 = qd0; pd1 = qd1; SSD_PFV(1); SSD_PFY(0); SSD_PF(0);
            { const float t0_ = qa0, t1_ = qa1, t2_ = qd0, t3_ = qd1; SSD_SCAN(0); pa0 = t0_; pa1 = t1_; pd0 = t2_; pd1 = t3_; }
#pragma unroll
            for (int q = 0; q < 4; ++q) add[q] = addn[q];
            __syncthreads();
            SSD_WRITE(0);
            { LAS v2u* sp = (LAS v2u*)(Sl + (32 * pt + r32) * SP_B + (32 * lt + 4 * hh) * 2);
#pragma unroll
              for (int q = 0; q < 4; ++q) sp[2 * q] = (v2u){0u, 0u}; }
            __syncthreads();
            SSD_ACC(0, tprev);
            for (int c = 0; c < 18; ++c) {
                const int cur = c & 1; const LAS float* V = (const LAS float*)(lds + SO_V + cur * 2048);
                const int rowbase = SSD_ROWBASE(c); const bool want_y = !(last && c < 2);
                if (c + 1 < 18) { if (!(last && c + 1 < 2)) SSD_PFY(c + 1); if (c + 2 < 18) SSD_PFV(c + 2); SSD_PF(c + 1); }
                SSD_ACC(1, tprev);
                for (int yrep = 0; yrep < SSD_YREP; ++yrep)
                if (want_y) {
                    const int l = 32 * lt + r32; const float cl = V[l];
                    bf16* yptr = ZX + (size_t)(rowbase + l) * SSD_INP + 2048 + h * 64 + 32 * pt + 4 * hh;
                    bf16x8 cf[8];
#pragma unroll
                    for (int ks = 0; ks < 8; ++ks) cf[ks] = *(const LAS bf16x8*)(Cl + l * SP_B + (16 * ks + 8 * hh) * 2);
                    f32x16 y1, y2;
#pragma unroll
                    for (int k = 0; k < 16; ++k) { y1[k] = 0.f; y2[k] = 0.f; }
                    const int st_lo = dir == 0 ? 0 : lt, st_hi = dir == 0 ? lt : 3;
#pragma unroll
                    for (int st = 0; st < 4; ++st) if (st >= st_lo && st <= st_hi) {
                        f32x16 X;
#pragma unroll
                        for (int k = 0; k < 16; ++k) X[k] = 0.f;
#pragma unroll
                        for (int ks = 0; ks < 8; ++ks) { const bf16x8 af = *(const LAS bf16x8*)(Bl + (32 * st + r32) * SP_B + (16 * ks + 8 * hh) * 2); X = __builtin_amdgcn_mfma_f32_32x32x16_bf16(af, cf[ks], X, 0, 0, 0); }
#pragma unroll
                        for (int q = 0; q < 4; ++q) { const f32x4 cs = *(const LAS f32x4*)(V + 32 * st + 8 * q + 4 * hh);
#pragma unroll
                            for (int e = 0; e < 4; ++e) { const int s = 32 * st + 8 * q + 4 * hh + e; const bool ok = dir == 0 ? (s <= l) : (s >= l);
                                const float dec = __expf(fminf(cl - cs[e], 0.f)); X[4 * q + e] = ok ? X[4 * q + e] * dec : 0.f; } }
#pragma unroll
                        for (int ks2 = 0; ks2 < 2; ++ks2) { v4u w; w.x = cvtpk(X[8 * ks2 + 0], X[8 * ks2 + 1]); w.y = cvtpk(X[8 * ks2 + 2], X[8 * ks2 + 3]); w.z = cvtpk(X[8 * ks2 + 4], X[8 * ks2 + 5]); w.w = cvtpk(X[8 * ks2 + 6], X[8 * ks2 + 7]);
                            const LAS unsigned char* tb = XDl + (32 * st + 16 * ks2 + 4 * hh + tq) * SP_X + (32 * pt + 16 * tblk + 4 * tp) * 2;
                            const v2u lo = trread(tb), hi = trread(tb + 8 * SP_X);
                            y1 = __builtin_amdgcn_mfma_f32_32x32x16_bf16(__builtin_bit_cast(bf16x8, (v4u){lo.x, lo.y, hi.x, hi.y}), __builtin_bit_cast(bf16x8, w), y1, 0, 0, 0); }
                    }
#pragma unroll
                    for (int ks = 0; ks < 8; ++ks) { const bf16x8 sf = *(const LAS bf16x8*)(Sl + (32 * pt + r32) * SP_B + (16 * ks + 8 * hh) * 2); y2 = __builtin_amdgcn_mfma_f32_32x32x16_bf16(sf, cf[ks], y2, 0, 0, 0); }
                    const float el = __expf(cl);
#pragma unroll
                    for (int q = 0; q < 4; ++q) { float o[4];
#pragma unroll
                        for (int e = 0; e < 4; ++e) o[e] = y1[4 * q + e] + el * y2[4 * q + e];
                        const float a0 = bflo(add[q].x), a1 = bfhi(add[q].x), a2 = bflo(add[q].y), a3 = bfhi(add[q].y);
                        if (dir == 0) { o[0] += dsk * a0; o[1] += dsk * a1; o[2] += dsk * a2; o[3] += dsk * a3; } else { o[0] += a0; o[1] += a1; o[2] += a2; o[3] += a3; }
                        v2u w; w.x = pk2(o[0], o[1]); w.y = pk2(o[2], o[3]); *(v2u*)(yptr + 8 * q) = w; }
                }
                SSD_ACC(2, tprev);
                if (c + 1 < 18) {
                    const float etot = __expf(V[384]);
#pragma unroll
                    for (int k = 0; k < 16; ++k) sacc[k] *= etot;
#pragma unroll
                    for (int ks = 0; ks < 8; ++ks) {
                        const LAS unsigned char* ta = Bl + (16 * ks + 8 * hh + tq) * SP_B + (32 * lt + 16 * tblk + 4 * tp) * 2;
                        const LAS unsigned char* tb = XWl + (16 * ks + 8 * hh + tq) * SP_X + (32 * pt + 16 * tblk + 4 * tp) * 2;
                        const v2u alo = trread(ta), ahi = trread(ta + 4 * SP_B), blo = trread(tb), bhi = trread(tb + 4 * SP_X);
                        sacc = __builtin_amdgcn_mfma_f32_32x32x16_bf16(__builtin_bit_cast(bf16x8, (v4u){alo.x, alo.y, ahi.x, ahi.y}), __builtin_bit_cast(bf16x8, (v4u){blo.x, blo.y, bhi.x, bhi.y}), sacc, 0, 0, 0); }
                    SSD_SCAN(cur ^ 1); pa0 = qa0; pa1 = qa1; pd0 = qd0; pd1 = qd1;
                }
                SSD_ACC(3, tprev);
                __syncthreads();
                SSD_ACC(4, tprev);
                if (c + 1 < 18) {
                    LAS v2u* sp = (LAS v2u*)(Sl + (32 * pt + r32) * SP_B + (32 * lt + 4 * hh) * 2);
#pragma unroll
                    for (int q = 0; q < 4; ++q) { v2u w; w.x = cvtpk(sacc[4 * q], sacc[4 * q + 1]); w.y = cvtpk(sacc[4 * q + 2], sacc[4 * q + 3]); sp[2 * q] = w; }
                    for (int wrep = 0; wrep < SSD_WREP; ++wrep) { SSD_WRITE(cur ^ 1); }
#pragma unroll
                    for (int q = 0; q < 4; ++q) add[q] = addn[q];
                }
                SSD_ACC(5, tprev);
                __syncthreads();
                SSD_ACC(6, tprev);
            }
#undef SSD_ROWBASE
#undef SSD_PF
#undef SSD_PFV
#undef SSD_PFY
#undef SSD_SCAN
#undef SSD_WRITE
            asm volatile("s_waitcnt vmcnt(0)" ::: "memory");
        }
    }
#ifdef SSD_DIAG
    if (blockIdx.x == 0 && wave == SSD_DIAG_WAVE && lane == 0 && i == 0) { float* dg = (float*)(a.ws + WS_MOD + 900 * 1024); long long tot = 0;
        for (int k = 0; k < 7; ++k) tot += dacc[k];
        for (int k = 0; k < 7; ++k) dg[k] = (float)dacc[k]; dg[7] = (float)tot; }
#endif
}

constexpr int AT2_KP = 208, AT2_VP = 192, AT2_KB = 64 * AT2_KP, AT2_VB = 64 * AT2_VP, AT2_BUF = AT2_KB + AT2_VB;
template <int NQ>
__device__ __forceinline__ void attn_unit2(const Args& a, LAS unsigned char* lds, int b, int h, int q0, int ntiles, bool lat) {
    const int tid = otid(a.wv), wave = tid >> 6, lane = tid & 63, r32 = lane & 31, hh = lane >> 5;
    const int tq = (lane >> 2) & 3, tp = lane & 3, tblk = (lane >> 4) & 1;
    const bf16* Qb = (const bf16*)(a.ws + WS_Q); const bf16* KVb = (const bf16*)(a.ws + WS_KV); const bf16* KR = (const bf16*)(a.ws + WS_KR); bf16* MIX = (bf16*)(a.ws + WS_MIX);
    const float* ct = (const float*)(a.ws + WS_ROPE); const float* st = ct + SEQ * 16;
    bf16x8 qf[NQ][6];
#pragma unroll
    for (int nq = 0; nq < NQ; ++nq) { const int qrow = q0 + wave * (32 * NQ) + nq * 32 + r32;
#pragma unroll
        for (int s = 0; s < 6; ++s) qf[nq][s] = *(const bf16x8*)(Qb + (size_t)qrow * QW + h * 96 + 16 * s + 8 * hh);
        if (lat) { const int t = qrow & (SEQ - 1);
#pragma unroll
            for (int j = 0; j < 8; j += 2) { float y1[2], y2[2];
#pragma unroll
                for (int e = 0; e < 2; ++e) { const float x1 = bf1((bf16)qf[nq][4][j + e]), x2 = bf1((bf16)qf[nq][5][j + e]); const float c = ct[t * 16 + 8 * hh + j + e], s = st[t * 16 + 8 * hh + j + e];
                    y1[e] = x1 * c - x2 * s; y2[e] = x1 * s + x2 * c; }
                const unsigned w1 = pk2(y1[0], y1[1]), w2 = pk2(y2[0], y2[1]);
                qf[nq][4][j] = (short)(w1 & 0xffff); qf[nq][4][j + 1] = (short)(w1 >> 16); qf[nq][5][j] = (short)(w2 & 0xffff); qf[nq][5][j + 1] = (short)(w2 >> 16); } }
        asm volatile("" : "+v"(qf[nq][0]), "+v"(qf[nq][1]), "+v"(qf[nq][2]), "+v"(qf[nq][3]), "+v"(qf[nq][4]), "+v"(qf[nq][5]) :: "memory"); }
    f32x16 o[NQ][2]; float m[NQ], l[NQ];
#pragma unroll
    for (int nq = 0; nq < NQ; ++nq) { m[nq] = -1e30f; l[nq] = 0.f;
#pragma unroll
        for (int i = 0; i < 16; ++i) { o[nq][0][i] = 0.f; o[nq][1][i] = 0.f; } }
    v4u kreg0, kreg1, vreg;
#define AT2_LOAD(it, tt) do { const unsigned off_kv = (unsigned)(((tt) >> 3) * (KVW * 2) + h * 256 + ((tt) & 7) * 16), off_kr = (unsigned)(((tt) >> 2) * 64 + ((tt) & 3) * 16); const bool k1ok = (tt) < 256; const int rb_ = (it) < CTXL / 64 ? TL + b * CTXL + (it) * 64 : b * SEQ + ((it) - CTXL / 64) * 64; \
        const char* kvb_ = (const char*)(KVb + (size_t)rb_ * KVW); const char* krb_ = (const char*)(KR + (size_t)rb_ * 32); \
        kreg0 = *(const v4u*)(kvb_ + off_kv); vreg = *(const v4u*)(kvb_ + off_kv + 128); if (k1ok) kreg1 = *(const v4u*)(krb_ + off_kr); } while (0)
#define AT2_WRITE(buf, tt) do { LAS unsigned char* kb_ = lds + (buf) * AT2_BUF; \
        *(LAS v4u*)(kb_ + ((tt) >> 3) * AT2_KP + ((tt) & 7) * 16) = kreg0; if ((tt) < 256) *(LAS v4u*)(kb_ + ((tt) >> 2) * AT2_KP + 128 + ((tt) & 3) * 16) = kreg1; \
        *(LAS v4u*)(kb_ + AT2_KB + ((tt) >> 3) * AT2_VP + ((tt) & 7) * 16) = vreg; } while (0)
    __syncthreads();
    AT2_LOAD(0, tid); AT2_WRITE(0, tid);
    __syncthreads();
    for (int it = 0; it < ntiles; ++it) {
        int tz = tid; asm volatile("" : "+v"(tz));
        const int lane_ = tz & 63, r32_ = lane_ & 31, hh_ = lane_ >> 5, tq_ = (lane_ >> 2) & 3, tp_ = lane_ & 3, tblk_ = (lane_ >> 4) & 1;
#ifdef ATT_LOADTOP
        if (it + 1 < ntiles) AT2_LOAD(it + 1, tz);
#endif
        const LAS unsigned char* kb = lds + (it & 1) * AT2_BUF; const LAS unsigned char* vb = kb + AT2_KB;
        bf16x8 pf[NQ][2][2];
        f32x16 sc[NQ][2];
#pragma unroll
        for (int nq = 0; nq < NQ; ++nq)
#pragma unroll
            for (int i = 0; i < 16; ++i) { sc[nq][0][i] = 0.f; sc[nq][1][i] = 0.f; }
#pragma unroll
        for (int s = 0; s < 6; ++s) { const bf16x8 a0 = *(const LAS bf16x8*)(kb + r32_ * AT2_KP + (16 * s + 8 * hh_) * 2); const bf16x8 a1 = *(const LAS bf16x8*)(kb + (32 + r32_) * AT2_KP + (16 * s + 8 * hh_) * 2);
#pragma unroll
            for (int nq = 0; nq < NQ; ++nq) { sc[nq][0] = __builtin_amdgcn_mfma_f32_32x32x16_bf16(a0, qf[nq][s], sc[nq][0], 0, 0, 0); sc[nq][1] = __builtin_amdgcn_mfma_f32_32x32x16_bf16(a1, qf[nq][s], sc[nq][1], 0, 0, 0); } }
#pragma unroll
        for (int nq = 0; nq < NQ; ++nq) {
            f32x16& s0 = sc[nq][0]; f32x16& s1 = sc[nq][1];
            float mx = s0[0];
#pragma unroll
            for (int i = 1; i < 16; ++i) mx = fmaxf(mx, s0[i]);
#pragma unroll
            for (int i = 0; i < 16; ++i) mx = fmaxf(mx, s1[i]);
            mx = fmaxf(mx, shx(mx, 32, lane_));
            const float mn = fmaxf(m[nq], mx * ATT_SCALE_LOG2E); const float alpha = __builtin_amdgcn_exp2f(m[nq] - mn); m[nq] = mn;
            float rs = 0.f;
#pragma unroll
            for (int i = 0; i < 16; ++i) { s0[i] = __builtin_amdgcn_exp2f(s0[i] * ATT_SCALE_LOG2E - mn); s1[i] = __builtin_amdgcn_exp2f(s1[i] * ATT_SCALE_LOG2E - mn); rs += s0[i] + s1[i]; }
            l[nq] = l[nq] * alpha + rs;
#pragma unroll
            for (int i = 0; i < 16; ++i) { o[nq][0][i] *= alpha; o[nq][1][i] *= alpha; }
#pragma unroll
            for (int s2 = 0; s2 < 2; ++s2) { v4u w0, w1;
                w0.x = cvtpk(s0[8 * s2 + 0], s0[8 * s2 + 1]); w0.y = cvtpk(s0[8 * s2 + 2], s0[8 * s2 + 3]); w0.z = cvtpk(s0[8 * s2 + 4], s0[8 * s2 + 5]); w0.w = cvtpk(s0[8 * s2 + 6], s0[8 * s2 + 7]);
                w1.x = cvtpk(s1[8 * s2 + 0], s1[8 * s2 + 1]); w1.y = cvtpk(s1[8 * s2 + 2], s1[8 * s2 + 3]); w1.z = cvtpk(s1[8 * s2 + 4], s1[8 * s2 + 5]); w1.w = cvtpk(s1[8 * s2 + 6], s1[8 * s2 + 7]);
                pf[nq][0][s2] = __builtin_bit_cast(bf16x8, w0); pf[nq][1][s2] = __builtin_bit_cast(bf16x8, w1); }
        }
#ifndef ATT_LOADTOP
        if (it + 1 < ntiles) AT2_LOAD(it + 1, tz);
#endif
#pragma unroll
        for (int t = 0; t < 2; ++t)
#pragma unroll
            for (int s2 = 0; s2 < 2; ++s2)
#pragma unroll
                for (int dt = 0; dt < 2; ++dt) {
                    const LAS unsigned char* tb = vb + (t * 32 + 16 * s2 + 4 * hh_ + tq_) * AT2_VP + (32 * dt + 16 * tblk_ + 4 * tp_) * 2;
#ifdef ATT_NOTR
                    bf16x8 vf; { const LAS unsigned short* vp_ = (const LAS unsigned short*)(vb + (t * 32 + 16 * s2 + 4 * hh_) * AT2_VP + (32 * dt + r32_) * 2);
#pragma unroll
                      for (int j_ = 0; j_ < 8; ++j_) vf[j_] = (short)vp_[((j_ & 3) + 8 * (j_ >> 2)) * (AT2_VP / 2)]; }
#else
                    const v2u lo = trread(tb), hi = trread(tb + 8 * AT2_VP); const bf16x8 vf = __builtin_bit_cast(bf16x8, (v4u){lo.x, lo.y, hi.x, hi.y});
#endif
#pragma unroll
                    for (int nq = 0; nq < NQ; ++nq) o[nq][dt] = __builtin_amdgcn_mfma_f32_32x32x16_bf16(vf, pf[nq][t][s2], o[nq][dt], 0, 0, 0); }
        if (it + 1 < ntiles) AT2_WRITE((it + 1) & 1, tz);
        __syncthreads();
    }
#undef AT2_LOAD
#undef AT2_WRITE
#pragma unroll
    for (int nq = 0; nq < NQ; ++nq) { int qrow = q0 + wave * (32 * NQ) + nq * 32 + r32; asm volatile("" : "+v"(qrow));
        const float lt = l[nq] + shx(l[nq], 32, lane); const float inv = 1.f / lt;
        bf16* orow = MIX + (size_t)qrow * D + h * 64 + 4 * hh;
#pragma unroll
        for (int g = 0; g < 4; ++g) {
            v2u w; w.x = pk2(o[nq][0][4 * g] * inv, o[nq][0][4 * g + 1] * inv); w.y = pk2(o[nq][0][4 * g + 2] * inv, o[nq][0][4 * g + 3] * inv); *(v2u*)(orow + 8 * g) = w;
            v2u x; x.x = pk2(o[nq][1][4 * g] * inv, o[nq][1][4 * g + 1] * inv); x.y = pk2(o[nq][1][4 * g + 2] * inv, o[nq][1][4 * g + 3] * inv); *(v2u*)(orow + 32 + 8 * g) = x; } }
}
__device__ __forceinline__ void attn_mfma2(const Args& a, LAS unsigned char* lds) {
#ifdef ATT_NQ1
    for (int u = blockIdx.x; u < 512; u += gridDim.x) attn_unit2<1>(a, lds, u >> 6, (u >> 3) & 7, (u >> 6) * SEQ + (u & 7) * 256, (CTXL + SEQ) / 64, true);
#else
    for (int u = blockIdx.x; u < 256; u += gridDim.x) attn_unit2<2>(a, lds, u >> 5, (u >> 2) & 7, (u >> 5) * SEQ + (u & 3) * 512, (CTXL + SEQ) / 64, true);
#endif
    for (int u = blockIdx.x; u < 64; u += gridDim.x) attn_unit2<1>(a, lds, u >> 3, u & 7, TL + (u >> 3) * CTXL, CTXL / 64, false);
}

template <int R>
__device__ __forceinline__ void rowwise2(const float* xs_lat, const float* xs_ctx, float* xd_lat, float* xd_ctx, const bf16* Mb, const float* modg, const float* nwA,
                                         bf16* H, const float* modh, int sh_off, int sc_off, const float* nwB, int nrows, int wv) {
    const int tid = otid(wv), wave = wv, lane = tid & 63; const int NGW = gridDim.x * NWAVES, gw = blockIdx.x * NWAVES + wave;
    const int rpw = (nrows + NGW - 1) / NGW; const int rbeg = gw * rpw, rend = min(rbeg + rpw, nrows);
    for (int r0 = rbeg; r0 < rend; r0 += R) {
        f32x4 v[R][4]; v2u mm[R][4];
#pragma unroll
        for (int j = 0; j < R; ++j) { const int r = min(r0 + j, rend - 1); const float* xs = r < TL ? xs_lat + (size_t)r * D : xs_ctx + (size_t)(r - TL) * D;
#pragma unroll
            for (int q = 0; q < 4; ++q) v[j][q] = *(const f32x4*)(xs + q * 256 + lane * 4);
            if (Mb) {
#pragma unroll
                for (int q = 0; q < 4; ++q) mm[j][q] = *(const v2u*)(Mb + (size_t)r * D + q * 256 + lane * 4); } }
#pragma unroll
        for (int j = 0; j < R; ++j) { const int r = r0 + j; if (r < rend) {
            const bool lat = r < TL; const int cond = lat ? (r >> 11) : 8; float* xd = lat ? xd_lat + (size_t)r * D : xd_ctx + (size_t)(r - TL) * D;
            if (Mb) {
                f32x4 m[4]; float ss = 0.f;
#pragma unroll
                for (int q = 0; q < 4; ++q) { const v2u w = mm[j][q]; m[q] = (f32x4){bflo(w.x), bfhi(w.x), bflo(w.y), bfhi(w.y)}; ss += (m[q][0] * m[q][0] + m[q][1] * m[q][1]) + (m[q][2] * m[q][2] + m[q][3] * m[q][3]); }
                const float rs = rsqrtf(wave_sum(ss, lane) * (1.f / D) + EPS);
#pragma unroll
                for (int q = 0; q < 4; ++q) { const f32x4 g = *(const f32x4*)(modg + (size_t)cond * MODW + q * 256 + lane * 4); const f32x4 w = *(const f32x4*)(nwA + q * 256 + lane * 4);
                    v[j][q] = v[j][q] + g * (m[q] * rs * w); }
            }
#pragma unroll
            for (int q = 0; q < 4; ++q) *(f32x4*)(xd + q * 256 + lane * 4) = v[j][q];
            if (H) {
                float ss = 0.f;
#pragma unroll
                for (int q = 0; q < 4; ++q) ss += (v[j][q][0] * v[j][q][0] + v[j][q][1] * v[j][q][1]) + (v[j][q][2] * v[j][q][2] + v[j][q][3] * v[j][q][3]);
                const float rs = rsqrtf(wave_sum(ss, lane) * (1.f / D) + EPS);
#pragma unroll
                for (int q = 0; q < 4; ++q) { const int c = q * 256 + lane * 4;
                    const f32x4 w = *(const f32x4*)(nwB + c); const f32x4 sc = *(const f32x4*)(modh + (size_t)cond * MODW + sc_off + c); const f32x4 sh = *(const f32x4*)(modh + (size_t)cond * MODW + sh_off + c);
                    const f32x4 hv = (v[j][q] * rs * w) * (sc + 1.0f) + sh;
                    v2u o; o.x = pk2(hv[0], hv[1]); o.y = pk2(hv[2], hv[3]); *(v2u*)(H + (size_t)r * D + c) = o; }
            } } }
    }
}

__device__ __forceinline__ void convgate2(const Args& a, int l, int nrows) {
    const bf16* U = (const bf16*)(a.ws + WS_U); bf16* G = (bf16*)(a.ws + WS_G); const float* cw = a.in[I_FCONV] + (size_t)l * 3 * UPW;
    const int total = (nrows / 8) * (DFF / 8);
    for (int idx = blockIdx.x * NTHR + otid(a.wv); idx < total; idx += gridDim.x * NTHR) {
        const int r0 = (idx / (DFF / 8)) * 8, c0 = (idx % (DFF / 8)) * 8; const bf16* u = U + (size_t)r0 * UPW + c0;
        const bool hp = has_prev(r0), hn = has_next(r0 + 7);
        v4u ua[10], ug[10];
#pragma unroll
        for (int j = 0; j < 10; ++j) { const int rr = (j == 0 && !hp) ? 0 : ((j == 9 && !hn) ? 7 : j - 1); ua[j] = *(const v4u*)(u + (ptrdiff_t)rr * UPW); ug[j] = *(const v4u*)(u + (ptrdiff_t)rr * UPW + DFF); }
        float wa[3][8], wg[3][8];
#pragma unroll
        for (int t = 0; t < 3; ++t)
#pragma unroll
            for (int j = 0; j < 8; ++j) { wa[t][j] = cw[t * UPW + c0 + j]; wg[t][j] = cw[t * UPW + DFF + c0 + j]; }
        if (!hp) { ua[0] = (v4u){0u, 0u, 0u, 0u}; ug[0] = ua[0]; }
        if (!hn) { ua[9] = (v4u){0u, 0u, 0u, 0u}; ug[9] = ua[9]; }
        float pa[8], ca[8], na[8], pg[8], cg_[8], ng[8];
        unpack8(ua[0], pa); unpack8(ug[0], pg); unpack8(ua[1], ca); unpack8(ug[1], cg_);
#pragma unroll
        for (int j = 0; j < 8; ++j) {
            unpack8(ua[j + 2], na); unpack8(ug[j + 2], ng);
            float o[8];
#pragma unroll
            for (int k = 0; k < 8; ++k) { const float act = wa[0][k] * pa[k] + wa[1][k] * ca[k] + wa[2][k] * na[k]; const float gate = wg[0][k] * pg[k] + wg[1][k] * cg_[k] + wg[2][k] * ng[k]; o[k] = silu_f(act) * gate; }
            *(v4u*)(G + (size_t)(r0 + j) * DFF + c0) = pack8(o);
#pragma unroll
            for (int k = 0; k < 8; ++k) { pa[k] = ca[k]; ca[k] = na[k]; pg[k] = cg_[k]; cg_[k] = ng[k]; }
        }
    }
}

__device__ __forceinline__ void ssd_conv2(const Args& a, int i) {
    const bf16* ZX = (const bf16*)(a.ws + WS_ZX); bf16* XBC = (bf16*)(a.ws + WS_XBC); float* DT = (float*)(a.ws + WS_DT); float* AA = (float*)(a.ws + WS_AA);
    const float* cw = a.in[I_SCONVW] + (size_t)i * 3 * 3072; const float* cb = a.in[I_SCONVB] + (size_t)i * 3072;
    const int total = (T / 8) * 384;
    for (int idx = blockIdx.x * NTHR + otid(a.wv); idx < total; idx += gridDim.x * NTHR) {
        const int r0 = (idx / 384) * 8, c0 = (idx % 384) * 8; const bf16* u = ZX + (size_t)r0 * SSD_INP + 2048 + c0;
        const bool hp = has_prev(r0), hn = has_next(r0 + 7);
        v4u ux[10];
#pragma unroll
        for (int j = 0; j < 10; ++j) { const int rr = (j == 0 && !hp) ? 0 : ((j == 9 && !hn) ? 7 : j - 1); ux[j] = *(const v4u*)(u + (ptrdiff_t)rr * SSD_INP); }
        float w[3][8], bias[8];
#pragma unroll
        for (int j = 0; j < 8; ++j) { w[0][j] = cw[c0 + j]; w[1][j] = cw[3072 + c0 + j]; w[2][j] = cw[2 * 3072 + c0 + j]; bias[j] = cb[c0 + j]; }
        if (!hp) ux[0] = (v4u){0u, 0u, 0u, 0u};
        if (!hn) ux[9] = (v4u){0u, 0u, 0u, 0u};
        float p[8], c[8], n[8];
        unpack8(ux[0], p); unpack8(ux[1], c);
#pragma unroll
        for (int j = 0; j < 8; ++j) {
            unpack8(ux[j + 2], n); float o[8];
#pragma unroll
            for (int k = 0; k < 8; ++k) o[k] = silu_f(bias[k] + w[0][k] * p[k] + w[1][k] * c[k] + w[2][k] * n[k]);
            *(v4u*)(XBC + (size_t)(r0 + j) * 3072 + c0) = pack8(o);
#pragma unroll
            for (int k = 0; k < 8; ++k) { p[k] = c[k]; c[k] = n[k]; }
        }
    }
    const float* alog = a.in[I_ALOG] + i * 64; const float* dtb = a.in[I_DTB] + i * 64;
    for (int idx = blockIdx.x * NTHR + otid(a.wv); idx < T * 64; idx += gridDim.x * NTHR) {
        const int r = idx >> 6, j = idx & 63; const float raw = bf1(ZX[(size_t)r * SSD_INP + 5120 + j]) + dtb[j];
        const float dt = raw > 15.f ? raw : (raw < -15.f ? __expf(raw) : __logf(1.f + __expf(raw)));
        DT[idx] = dt; AA[idx] = -__expf(alog[j]) * dt;
    }
}

__device__ __forceinline__ void gatenorm2(const Args& a, int i, int nrows) {
    const int tid = otid(a.wv), wave = a.wv, lane = tid & 63; const int NGW = gridDim.x * NWAVES, gw = blockIdx.x * NWAVES + wave;
    const bf16* ZX = (const bf16*)(a.ws + WS_ZX); bf16* YN = (bf16*)(a.ws + WS_XBC); const float* nw = a.in[I_SNORM] + i * 2048;
    const int rpw = (nrows + NGW - 1) / NGW; const int rbeg = gw * rpw, rend = min(rbeg + rpw, nrows);
    constexpr int R = 3;
    for (int r0 = rbeg; r0 < rend; r0 += R) {
        v4u yv[R][4], zv[R][4];
#pragma unroll
        for (int j = 0; j < R; ++j) { const int r = min(r0 + j, rend - 1);
#pragma unroll
            for (int q = 0; q < 4; ++q) { const int c = q * 512 + lane * 8; yv[j][q] = *(const v4u*)(ZX + (size_t)r * SSD_INP + 2048 + c); zv[j][q] = *(const v4u*)(ZX + (size_t)r * SSD_INP + c); } }
#pragma unroll
        for (int j = 0; j < R; ++j) { const int r = r0 + j; if (r < rend) {
            float v[4][8]; float ss = 0.f;
#pragma unroll
            for (int q = 0; q < 4; ++q) { float y[8], z[8]; unpack8(yv[j][q], y); unpack8(zv[j][q], z);
#pragma unroll
                for (int k = 0; k < 8; ++k) { v[q][k] = y[k] * silu_f(z[k]); ss += v[q][k] * v[q][k]; } }
            const float rs = rsqrtf(wave_sum(ss, lane) * (1.f / 2048.f) + EPS);
#pragma unroll
            for (int q = 0; q < 4; ++q) { const int c = q * 512 + lane * 8; float o[8];
#pragma unroll
                for (int k = 0; k < 8; ++k) o[k] = v[q][k] * rs * nw[c + k];
                *(v4u*)(YN + (size_t)r * 2048 + c) = pack8(o); } } }
    }
}

#ifndef MK_SINGLE
#define MK_SINGLE 1
#endif
struct GemmDesc { const bf16* A; const bf16* Bt; int M, N, K; bf16* O; int ldc; };

__global__ void __launch_bounds__(NTHR, 2) fwd_kernel(Args a_in) {
    extern __shared__ __attribute__((aligned(16))) unsigned char lds_raw[];
    LAS unsigned char* lds = (LAS unsigned char*)lds_raw;
#if MK_SINGLE == 1
    volatile LAS unsigned* bst = (volatile LAS unsigned*)(lds + LDS_BYTES - 64);
    const int wv0 = __builtin_amdgcn_readfirstlane((int)threadIdx.x >> 6);
    { const int t0 = otid(wv0); if (t0 < 16) bst[t0] = 0u; }
    __syncthreads();
    const XcdBarrier xbar = xcd_barrier_post((unsigned*)(a_in.ws + WS_CTL), bst, wv0);
#endif
    const Args& a0 = a_in;
    for (int s = a0.lo; s < a0.hi; ++s) {
        Args a = a0;
        { long oz; asm volatile("s_mov_b64 %0, 0" : "=s"(oz));
#pragma unroll
          for (int q = 0; q < 25; ++q) a.in[q] = (const float*)((const char*)a0.in[q] + oz);
          a.out = (float*)((char*)a0.out + oz); a.ws = a0.ws + oz; a.wv = wv0; }
        unsigned char* ws = a.ws;
        float* XL = a.out; float* XC = (float*)(ws + WS_XC); bf16* H = (bf16*)(ws + WS_H); bf16* Mb = (bf16*)(ws + WS_M);
        const float* MOD = (const float*)(ws + WS_MOD); const float* NW = a.in[I_NORMW];
        int nrep = 1;
#ifdef PROBE_MASK
        if (s == 0 && (PROBE_MASK >> 20 & 1u)) nrep = 2;
        if (s >= 2) { const int pk = (s - 2) % 10, ppar = ((s - 2) / 10) & 1; if ((PROBE_MASK >> (pk + 10 * ppar)) & 1u) nrep = 2; }
#endif
        for (int rep = 0; rep < nrep; ++rep) {
        GemmDesc g0{}, g1{}; int ng = 0;
#ifndef NO_SIMPLE
        if (s == 0) {
            mod_compute(a, lds);
            rope_tables(a);
            convert_layer(a, 0, lds);
        } else if (s == 1) {
            rowwise2<3>(a.in[I_X], a.in[I_CTX], XL, XC, nullptr, nullptr, nullptr, H, MOD, 0, 1024, NW, T, a.wv);
        } else {
            const int l = (s - 2) / 10, k = (s - 2) % 10, i = l >> 1; const bool even = (l & 1) == 0, last = (l == 3);
            const int MR = last ? TL : T;
            switch (k) {
            case 0:
                if (even) { g0 = GemmDesc{H, (const bf16*)(ws + W_IN), T, HYB_INP, D, (bf16*)(ws + WS_P), HYB_INP}; ng = 1; }
                else      { g0 = GemmDesc{H, (const bf16*)(ws + W_IN), T, SSD_INP, D, (bf16*)(ws + WS_ZX), SSD_INP}; ng = 1; }
                break;
            case 1: if (even) prep_even(a, i); else ssd_conv2(a, i); break;
            case 2:
                if (even) { { g0 = GemmDesc{(const bf16*)(ws + WS_CQN), (const bf16*)(ws + W_UQ), T, QW, 384, (bf16*)(ws + WS_Q), QW}; ng = 1; }
                            g1 = GemmDesc{(const bf16*)(ws + WS_CKVN), (const bf16*)(ws + W_UKV), T, KVW, 256, (bf16*)(ws + WS_KV), KVW}; ng = 2; }
                else {
#ifdef SSD_NAIVE
 ssd_scan_naive(a, i, last, lds);
#else
 ssd_scan_mfma(a, i, last, lds);
#endif
 }
                break;
            case 3: if (even) {
#ifdef ATTN_NAIVE
 attn_naive(a, lds);
#else
 attn_mfma(a, lds);
#endif
 } else gatenorm2(a, i, MR); break;
            case 4:
                if (even) { g0 = GemmDesc{(const bf16*)(ws + WS_MIX), (const bf16*)(ws + W_OUT), MR, D, D, Mb, D}; ng = 1; }
                else      { g0 = GemmDesc{(const bf16*)(ws + WS_XBC), (const bf16*)(ws + W_OUT), MR, D, 2048, Mb, D}; ng = 1; }
                break;
            case 5:
#ifdef PROBE_ROW2
                if (l > 0) rowwise2<3>(XL, XC, XL, XC, nullptr, nullptr, nullptr, H, MOD + (size_t)l * 9 * MODW, 0, 1024, NW + (l * 4 + 0) * D, MR, a.wv);
#endif
                rowwise2<3>(XL, XC, XL, XC, Mb, MOD + (size_t)l * 9 * MODW + 2048, NW + (l * 4 + 1) * D, H, MOD + (size_t)l * 9 * MODW, 3072, 4096, NW + (l * 4 + 2) * D, MR, a.wv); break;
            case 6: { g0 = GemmDesc{H, (const bf16*)(ws + W_UP), MR, UPW, D, (bf16*)(ws + WS_U), UPW}; ng = 1; } break;
            case 7: convgate2(a, l, MR); break;
            case 8: { g0 = GemmDesc{(const bf16*)(ws + WS_G), (const bf16*)(ws + W_DN), MR, D, DFF, Mb, D}; ng = 1; } break;
            case 9:
                if (!last) { rowwise2<3>(XL, XC, XL, XC, Mb, MOD + (size_t)l * 9 * MODW + 5120, NW + (l * 4 + 3) * D, H, MOD + (size_t)(l + 1) * 9 * MODW, 0, 1024, NW + ((l + 1) * 4 + 0) * D, T, a.wv);
                             convert_layer(a, l + 1, lds); }
                else rowwise2<3>(XL, XC, XL, XC, Mb, MOD + (size_t)l * 9 * MODW + 5120, NW + (l * 4 + 3) * D, nullptr, MOD, 0, 0, NW, TL, a.wv);
                break;
            }
        }
#else
        { g0 = GemmDesc{H, (const bf16*)(ws + W_IN), T, a.hi * 256, a.lo * 128, (bf16*)(ws + WS_P), HYB_INP}; ng = 1; }
#endif
        for (int gi = 0; gi < ng; ++gi) {
            const bool f = (gi == 0);
            pg8::Gemm g{f ? g0.A : g1.A, f ? g0.Bt : g1.Bt, f ? g0.M : g1.M, f ? g0.N : g1.N, f ? g0.K : g1.K, a.wv}; pg8::StaticOrder S; S.init(g.M, g.N, (int)gridDim.x, (int)blockIdx.x);
            pg8::EpiStore E{f ? g0.O : g1.O, f ? g0.ldc : g1.ldc};
#ifndef NO_GEMM
            pg8::gemm_phase<pg8::EpiStore, pg8::StaticOrder, true, true>(lds, g, S, E);
#endif
            __syncthreads();
        }
        if (rep + 1 < nrep) __syncthreads();
        }
#ifdef SSD_DIAG
        if (s + 1 == a0.hi) { __syncthreads(); asm volatile("s_waitcnt vmcnt(0)" ::: "memory"); if (blockIdx.x == 0 && otid(wv0) == 0) { const float* dg = (const float*)(a0.ws + WS_MOD + 900 * 1024); a0.out[0] = SSD_DIAG_SEL == 7 ? dg[7] : 1.0e4f * dg[SSD_DIAG_SEL] / dg[7]; } }
#endif
        if (s + 1 < a0.hi) {
#if MK_SINGLE == 1
            xcd_barrier(xbar);
#ifdef PROBE_BAR2
            xcd_barrier(xbar);
#endif
#elif MK_SINGLE == 2
            cg::this_grid().sync();
#endif
        }
    }
}

extern "C" void kernel_launch(void* const* d_in, const int* in_sizes, int n_in, void* d_out, int out_size, void* d_ws, size_t ws_size, hipStream_t stream) {
    static int grid = 0;
    if (grid == 0) {
        if (n_in != 25 || out_size != TL * D || ws_size < WS_END) { fprintf(stderr, "kernel_launch: unexpected problem (n_in %d out %d ws %zu need %zu)\n", n_in, out_size, ws_size, (size_t)WS_END); grid = -1; return; }
        if (hipFuncSetAttribute((const void*)fwd_kernel, hipFuncAttributeMaxDynamicSharedMemorySize, LDS_BYTES) != hipSuccess) { fprintf(stderr, "kernel_launch: hipFuncSetAttribute failed\n"); grid = -1; return; }
        int dev = 0, cus = 0, per_cu = 0;
        hipGetDevice(&dev); hipDeviceGetAttribute(&cus, hipDeviceAttributeMultiprocessorCount, dev);
        hipOccupancyMaxActiveBlocksPerMultiprocessor(&per_cu, (const void*)fwd_kernel, NTHR, LDS_BYTES);
        (void)hipGetLastError();
        if (per_cu < 1) { fprintf(stderr, "kernel_launch: occupancy query says %d blocks per CU\n", per_cu); }
        grid = cus;
    }
    if (grid < 0) return;
#if MK_SINGLE == 1
    if (hipMemsetAsync((char*)d_ws + WS_CTL, 0, CTL_ZERO_BYTES, stream) != hipSuccess) { fprintf(stderr, "kernel_launch: memset failed\n"); return; }
#endif
    Args a{};
    for (int i = 0; i < 25; ++i) a.in[i] = (const float*)d_in[i];
    a.out = (float*)d_out; a.ws = (unsigned char*)d_ws;
#if MK_SINGLE
    a.lo = 0; a.hi = NSTEP + 1;
    void* args[] = {&a};
    hipError_t e = hipLaunchCooperativeKernel((const void*)fwd_kernel, dim3(grid), dim3(NTHR), args, LDS_BYTES, stream);
    if (e != hipSuccess) fprintf(stderr, "cooperative launch failed: %s (grid %d)\n", hipGetErrorString(e), grid);
#else
    for (int s = 0; s < NSTEP + 1; ++s) { a.lo = s; a.hi = s + 1; hipLaunchKernelGGL(fwd_kernel, dim3(grid), dim3(NTHR), LDS_BYTES, stream, a); }
#endif
}
```

```cpp
#include <hip/hip_runtime.h>
#include <hip/hip_cooperative_groups.h>
#include <cstdio>
#include <cstdint>
namespace cg = cooperative_groups;
__device__ __forceinline__ int otid(int wv) { int l; asm volatile("v_mbcnt_lo_u32_b32 %0, -1, 0\n\tv_mbcnt_hi_u32_b32 %0, -1, %0" : "=v"(l)); return (wv << 6) | l; }
__device__ __forceinline__ float shx(float v, int mask, int lane) { return __builtin_bit_cast(float, __builtin_amdgcn_ds_bpermute((lane ^ mask) << 2, __builtin_bit_cast(int, v))); }
#define LAS __attribute__((address_space(3)))
#define XB_TMO      128
#define XB_XCNT(j)  (256  + 64 * (j))
#define XB_XSUB(j)  (1280 + 64 * (j))
#define XB_XGEN(j)  (2304 + 64 * (j))
#define XB_TOP      3328
#define XB_TOPGEN   3392
#define XCD_BAR_WORDS 3456
#define XB_SPIN_CAP (1u << 18)

__device__ __forceinline__ unsigned xb_ld(unsigned* p)              { return __hip_atomic_load(p, __ATOMIC_RELAXED, __HIP_MEMORY_SCOPE_AGENT); }
__device__ __forceinline__ unsigned xb_add(unsigned* p, unsigned v) { return __hip_atomic_fetch_add(p, v, __ATOMIC_RELAXED, __HIP_MEMORY_SCOPE_AGENT); }
__device__ __forceinline__ unsigned xb_xcc_id() { return (unsigned)__builtin_amdgcn_s_getreg((3 << 11) | 20) & 0xFu; }
#define XB_SPIN(cond, bar) do { unsigned _sp = 0; while (cond) { __builtin_amdgcn_s_sleep(1); \
    if ((++_sp & 255u) == 0u) { if (xb_ld(&(bar)[XB_TMO])) break; if (_sp > XB_SPIN_CAP) { atomicAdd(&(bar)[XB_TMO], 1u); break; } } } } while (0)

struct XcdBarrier {
    unsigned* bar; unsigned x; int wv;
    volatile LAS unsigned* st;
};

__device__ __forceinline__ XcdBarrier xcd_barrier_post(unsigned* bar, volatile LAS unsigned* st, int wv) {
    XcdBarrier b; b.bar = bar; b.x = xb_xcc_id(); b.st = st; b.wv = wv;
    if (otid(wv) == 0) (void)xb_add(&bar[XB_XCNT(b.x)], 1u);
    return b;
}
__device__ __forceinline__ void xcd_barrier_complete(unsigned* bar, unsigned x, unsigned& nloc, unsigned& nx) {
    const unsigned G = gridDim.x * gridDim.y * gridDim.z;
    unsigned sum, cnt, mine, sp = 0u;
    for (;;) {
        sum = 0u; cnt = 0u; mine = 0u;
#pragma unroll
        for (unsigned j = 0; j < 16; ++j) { const unsigned c = xb_ld(&bar[XB_XCNT(j)]); sum += c; cnt += (c > 0u) ? 1u : 0u; mine = (j == x) ? c : mine; }
        if (sum == G) break;
        __builtin_amdgcn_s_sleep(1);
        if ((++sp & 255u) == 0u) { if (xb_ld(&bar[XB_TMO])) break; if (sp > XB_SPIN_CAP) { atomicAdd(&bar[XB_TMO], 1u); break; } }
    }
    nloc = mine > 0u ? mine : 1u; nx = cnt > 0u ? cnt : 1u;
}

__device__ __forceinline__ void xcd_barrier(const XcdBarrier& b) {
    asm volatile("s_waitcnt vmcnt(0)" ::: "memory");
    __syncthreads();
    if (otid(b.wv) == 0) {
        unsigned* bar = b.bar;
        __builtin_amdgcn_s_waitcnt(0);
        unsigned nloc = b.st[0], nx = b.st[1];
        if (nloc == 0u) { xcd_barrier_complete(bar, b.x, nloc, nx); b.st[0] = nloc; b.st[1] = nx; }
        const unsigned old = xb_add(&bar[XB_XSUB(b.x)], 1u);
        const unsigned gen = old / nloc;
        if (old + 1u == (gen + 1u) * nloc) {
            __builtin_amdgcn_fence(__ATOMIC_RELEASE, "agent");
            asm volatile("s_waitcnt vmcnt(0)" ::: "memory");
            const unsigned og = xb_add(&bar[XB_TOP], 1u);
            const unsigned tg = og / nx;
            if (og + 1u == (tg + 1u) * nx) xb_add(&bar[XB_TOPGEN], 1u);
            else XB_SPIN(xb_ld(&bar[XB_TOPGEN]) == tg, bar);
            __builtin_amdgcn_fence(__ATOMIC_ACQUIRE, "agent");
            xb_add(&bar[XB_XGEN(b.x)], 1u);
            asm volatile("s_waitcnt vmcnt(0)" ::: "memory");
        } else {
            XB_SPIN(xb_ld(&bar[XB_XGEN(b.x)]) == gen, bar);
            __builtin_amdgcn_fence(__ATOMIC_ACQUIRE, "agent");
            asm volatile("s_waitcnt vmcnt(0)" ::: "memory");
        }
    }
    __syncthreads();
}
namespace pg8 {
#define PG8_LAS __attribute__((address_space(3)))
typedef unsigned short bf16_t;
typedef short bf16x8 __attribute__((ext_vector_type(8)));
typedef float f32x4 __attribute__((ext_vector_type(4)));
typedef unsigned u32x4 __attribute__((ext_vector_type(4)));
constexpr int BM = 256, BK = 64, HALF = 128, HTB = HALF * BK * 2  , STAGE_BYTES = 8 * HTB, NXCD = 8, WGM = 8;

__host__ __device__ __forceinline__ int lds_byte(int r, int c) { const int st = (r >> 4) * 2 + (c >> 5), rr = r & 15, cc = c & 31, ob = rr * 64 + cc * 2; return st * 1024 + (ob ^ (((ob >> 9) & 1) << 5)); }
__host__ __device__ __forceinline__ void stage_rc(int b, int& R, int& C) { const int st = b / 1024, sb = b % 1024, swz = sb ^ (((sb >> 9) & 1) << 5); R = (st >> 1) * 16 + swz / 64; C = (st & 1) * 32 + (swz % 64) / 2; }
__host__ __device__ __forceinline__ int perm32(int rho) { const int n = rho >> 4, i = rho & 15; return 8 * (i >> 2) + 4 * n + (i & 3); }

struct Unit { int pm, pn; };
struct Gemm { const bf16_t* A; const bf16_t* Bt; int M, N, K, wv; };

struct StaticOrder {
    int nM, nN, nwg, G, c;
    __host__ __device__ void init(int M, int N, int G_, int c_) { nM = M / BM; nN = N / BM; nwg = nM * nN; G = G_; c = c_; }
    __host__ __device__ bool next(int i, Unit& u) const {
        const long L = (long)i * G + c; if (L >= nwg) return false;
        int wgid = (int)L; { const int q = nwg / NXCD, r = nwg % NXCD, xcd = wgid % NXCD, off = wgid / NXCD; wgid = (xcd < r ? xcd * (q + 1) : r * (q + 1) + (xcd - r) * q) + off; }
        const int nig = WGM * nN, gid = wgid / nig, fm = gid * WGM, gsz = (nM - fm) < WGM ? (nM - fm) : WGM;
        u.pm = fm + ((wgid % nig) % gsz); u.pn = (wgid % nig) / gsz; return true;
    }
    __device__ __forceinline__ void a_ready(const Unit&) const {}
    __device__ __forceinline__ void done(const Unit&) const {}
};

__device__ __forceinline__ unsigned cvt_pk_bf16(float lo, float hi) { unsigned r; asm volatile("v_cvt_pk_bf16_f32 %0, %1, %2" : "=v"(r) : "v"(lo), "v"(hi)); return r; }
struct EpiStore {
    static constexpr bool PERM = true, AFTER_DRAIN = false;
    bf16_t* O; int ldc;
    __device__ __forceinline__ void operator()(const f32x4 (&acc)[2][2][4][2], const Unit& u, int wr, int wc, int fr, int fq) const {
        const int row0 = u.pm * BM + wr * 64 + fr; const int col0 = u.pn * BM + wc * 32 + 8 * fq;
#pragma unroll
        for (int ai = 0; ai < 2; ++ai)
#pragma unroll
            for (int m = 0; m < 4; ++m) { bf16_t* rowp = O + (size_t)(row0 + ai * HALF + m * 16) * ldc + col0;
#pragma unroll
                for (int bj = 0; bj < 2; ++bj) { const f32x4 v0 = acc[ai][bj][m][0], v1 = acc[ai][bj][m][1];
                    u32x4 w; w.x = cvt_pk_bf16(v0[0], v0[1]); w.y = cvt_pk_bf16(v0[2], v0[3]); w.z = cvt_pk_bf16(v1[0], v1[1]); w.w = cvt_pk_bf16(v1[2], v1[3]);
                    *(u32x4*)(rowp + bj * HALF) = w; } }
    }
};

template <int CTRL> __device__ __forceinline__ float dppf(float old, float src) { return __builtin_bit_cast(float, __builtin_amdgcn_update_dpp(__builtin_bit_cast(int, old), __builtin_bit_cast(int, src), CTRL, 0xf, 0xf, false)); }
#define PG8_DPP4(dst, oldv, srcv, ctrl) do { dst[0] = dppf<ctrl>(oldv[0], srcv[0]); dst[1] = dppf<ctrl>(oldv[1], srcv[1]); dst[2] = dppf<ctrl>(oldv[2], srcv[2]); dst[3] = dppf<ctrl>(oldv[3], srcv[3]); } while (0)
struct EpiFfn {
    static constexpr bool PERM = true, AFTER_DRAIN = false;
    bf16_t* O; int ldc; int mode;
    bf16_t* Ue; const float* cw; PG8_LAS f32x4* ex;
    __device__ __forceinline__ void operator()(const f32x4 (&acc)[2][2][4][2], const Unit& u, int wr, int wc, int fr, int fq) const {
        if (mode == 0) {
            const int row0 = u.pm * BM + wr * 64 + fr; const int col0 = u.pn * BM + wc * 32 + 8 * fq;
#pragma unroll
            for (int ai = 0; ai < 2; ++ai)
#pragma unroll
                for (int m = 0; m < 4; ++m) { bf16_t* rowp = O + (size_t)(row0 + ai * HALF + m * 16) * ldc + col0;
#pragma unroll
                    for (int bj = 0; bj < 2; ++bj) { const f32x4 v0 = acc[ai][bj][m][0], v1 = acc[ai][bj][m][1];
                        u32x4 w; w.x = cvt_pk_bf16(v0[0], v0[1]); w.y = cvt_pk_bf16(v0[2], v0[3]); w.z = cvt_pk_bf16(v1[0], v1[1]); w.w = cvt_pk_bf16(v1[2], v1[3]);
                        *(u32x4*)(rowp + bj * HALF) = w; } }
            return;
        }
        const int chl = wc * 32 + 8 * fq, ch = u.pn * 128 + chl;
        f32x4 wA[3][2], wG[3][2];
#pragma unroll
        for (int t = 0; t < 3; ++t)
#pragma unroll
            for (int n = 0; n < 2; ++n) { wA[t][n] = *(const f32x4*)(cw + t * 5632 + ch + 4 * n); wG[t][n] = *(const f32x4*)(cw + t * 5632 + 2816 + ch + 4 * n); }
#define PG8_EX(blk, fl, bj, n) ex[((((blk) * 2 + (fl)) * 2 + (bj)) * 2 + (n)) * 16 + wc * 4 + fq]
#pragma unroll
        for (int ai = 0; ai < 2; ++ai) { const int blk = ai * 2 + wr;
            if (fr == 0) {
#pragma unroll
                for (int bj = 0; bj < 2; ++bj)
#pragma unroll
                    for (int n = 0; n < 2; ++n) PG8_EX(blk, 0, bj, n) = acc[ai][bj][0][n]; }
            if (fr == 15) {
#pragma unroll
                for (int bj = 0; bj < 2; ++bj)
#pragma unroll
                    for (int n = 0; n < 2; ++n) PG8_EX(blk, 1, bj, n) = acc[ai][bj][3][n]; } }
        asm volatile("s_waitcnt lgkmcnt(0)" ::: "memory"); __builtin_amdgcn_s_barrier(); asm volatile("" ::: "memory");
        const f32x4 zero4 = (f32x4){0.f, 0.f, 0.f, 0.f};
#pragma unroll
        for (int ai = 0; ai < 2; ++ai) { const int blk = ai * 2 + wr;
            f32x4 pb[2][2], nb[2][2];
#pragma unroll
            for (int bj = 0; bj < 2; ++bj)
#pragma unroll
                for (int n = 0; n < 2; ++n) { pb[bj][n] = blk > 0 ? PG8_EX(blk - 1, 1, bj, n) : zero4; nb[bj][n] = blk < 3 ? PG8_EX(blk + 1, 0, bj, n) : zero4; }
#pragma unroll
            for (int m = 0; m < 4; ++m) {
                f32x4 cv[2][2];
#pragma unroll
                for (int bj = 0; bj < 2; ++bj)
#pragma unroll
                    for (int n = 0; n < 2; ++n) { const f32x4 cur = acc[ai][bj][m][n]; f32x4 bp, bn, prev, next;
                        if (m == 0) bp = pb[bj][n]; else PG8_DPP4(bp, cur, acc[ai][bj][m > 0 ? m - 1 : 0][n], 0x121);
                        if (m == 3) bn = nb[bj][n]; else PG8_DPP4(bn, cur, acc[ai][bj][m < 3 ? m + 1 : 3][n], 0x12F);
                        PG8_DPP4(prev, bp, cur, 0x111);
                        PG8_DPP4(next, bn, cur, 0x101);
                        const f32x4 w0 = bj ? wG[0][n] : wA[0][n], w1 = bj ? wG[1][n] : wA[1][n], w2 = bj ? wG[2][n] : wA[2][n];
                        cv[bj][n] = w0 * prev + w1 * cur + w2 * next; }
                u32x4 w; float g[8];
#pragma unroll
                for (int n = 0; n < 2; ++n)
#pragma unroll
                    for (int e = 0; e < 4; ++e) { const float av = cv[0][n][e]; g[4 * n + e] = av * __builtin_amdgcn_rcpf(1.f + __expf(-av)) * cv[1][n][e]; }
                w.x = cvt_pk_bf16(g[0], g[1]); w.y = cvt_pk_bf16(g[2], g[3]); w.z = cvt_pk_bf16(g[4], g[5]); w.w = cvt_pk_bf16(g[6], g[7]);
                *(u32x4*)(O + (size_t)(u.pm * BM + ai * HALF + wr * 64 + m * 16 + fr) * 2816 + ch) = w;
            } }
#undef PG8_EX
        { const int slot = (wr == 0) ? (fr == 0 ? 0 : (fr == 1 ? 1 : -1)) : (fr == 14 ? 2 : (fr == 15 ? 3 : -1));
          if (slot >= 0) { bf16_t* up = Ue + ((size_t)(u.pm * 4 + slot) * 5632) + u.pn * 256 + chl;
#pragma unroll
              for (int bj = 0; bj < 2; ++bj) { const f32x4 v0 = wr ? acc[1][bj][3][0] : acc[0][bj][0][0], v1 = wr ? acc[1][bj][3][1] : acc[0][bj][0][1];
                  u32x4 w; w.x = cvt_pk_bf16(v0[0], v0[1]); w.y = cvt_pk_bf16(v0[2], v0[3]); w.z = cvt_pk_bf16(v1[0], v1[1]); w.w = cvt_pk_bf16(v1[2], v1[3]);
                  *(u32x4*)(up + bj * HALF) = w; } } }
    }
};
template <class Epi, class Sched, bool ALIGN_EPI = false, bool SP2 = false>
__device__ __forceinline__ void gemm_phase(PG8_LAS unsigned char* lds, const Gemm g, const Sched& S, const Epi& E) {
    const int tid = otid(g.wv), wid = g.wv, lane = tid & 63, wr = wid >> 2, wc = wid & 3, fr = lane & 15, fq = lane >> 4;
    const int K = g.K, nt = K / BK;
    unsigned voffA[2], voffB[2];
#pragma unroll
    for (int i = 0; i < 2; ++i) { int R, C; stage_rc(tid * 16 + i * 8192, R, C); const int Rb = Epi::PERM ? ((R & ~31) + perm32(R & 31)) : R;
        voffA[i] = (unsigned)(R * K + C) * 2u; voffB[i] = (unsigned)(Rb * K + C) * 2u; }
    const size_t kstep = (size_t)(BK * 2);
    const size_t hstep = (size_t)HALF * K * 2;
    const size_t tstep = 2 * hstep;
    const unsigned ldsw = (unsigned)wid * 1024u;
    const int aoff = lds_byte(wr * 64 + fr, fq * 8), boff = lds_byte(wc * 32 + fr, fq * 8);
#define PG8_SA(b, h) (((b) * 2 + (h)) * HTB)
#define PG8_SB(b, h) ((4 + (b) * 2 + (h)) * HTB)
#define PG8_STAGE(bufoff, gbase, voff) do { _Pragma("unroll") for (int _i = 0; _i < 2; ++_i) \
        __builtin_amdgcn_global_load_lds((const unsigned*)((const char*)(gbase) + (voff)[_i]), (PG8_LAS unsigned*)(lds + (bufoff) + ldsw + _i * 8192), 16, 0, 0); } while (0)
#define PG8_LDA(dst, b, h) do { _Pragma("unroll") for (int m = 0; m < 4; ++m) _Pragma("unroll") for (int k = 0; k < 2; ++k) dst[m][k] = *(const PG8_LAS bf16x8*)(lds + PG8_SA(b, h) + aoff + m * 2048 + k * 1024); } while (0)
#define PG8_LDB(dst, b, h) do { _Pragma("unroll") for (int n = 0; n < 2; ++n) _Pragma("unroll") for (int k = 0; k < 2; ++k) dst[n][k] = *(const PG8_LAS bf16x8*)(lds + PG8_SB(b, h) + boff + n * 2048 + k * 1024); } while (0)
#define PG8_MMA(ai, bj, At, Bt) do { __builtin_amdgcn_s_setprio(1); _Pragma("unroll") for (int m = 0; m < 4; ++m) _Pragma("unroll") for (int n = 0; n < 2; ++n) _Pragma("unroll") for (int k = 0; k < 2; ++k) \
        acc[ai][bj][m][n] = __builtin_amdgcn_mfma_f32_16x16x32_bf16(Bt[n][k], At[m][k], acc[ai][bj][m][n], 0, 0, 0); __builtin_amdgcn_s_setprio(0); } while (0)
#define PG8_WAIT_V(n) asm volatile("s_waitcnt vmcnt(" #n ")" ::: "memory")
#define PG8_WAIT_L(n) asm volatile("s_waitcnt lgkmcnt(" #n ")" ::: "memory")
#define PG8_BAR __builtin_amdgcn_s_barrier()
#define PG8_SCHED __builtin_amdgcn_sched_barrier(0)
    Unit cur, nxt; int ui = 0;
    if (!S.next(0, cur)) return;
    f32x4 acc[2][2][4][2];
#pragma unroll
    for (int a = 0; a < 2; ++a)
#pragma unroll
        for (int b = 0; b < 2; ++b)
#pragma unroll
            for (int m = 0; m < 4; ++m)
#pragma unroll
                for (int n = 0; n < 2; ++n) acc[a][b][m][n] = (f32x4){0.f, 0.f, 0.f, 0.f};
    bf16x8 At[4][2], B0[2][2], B1[2][2];
    const char* cA = (const char*)g.A + (size_t)cur.pm * tstep; const char* cB = (const char*)g.Bt + (size_t)cur.pn * tstep;
    S.a_ready(cur);
    if constexpr (SP2) {
        PG8_STAGE(PG8_SB(0, 0), cB, voffB); PG8_STAGE(PG8_SB(0, 1), cB + hstep, voffB); PG8_STAGE(PG8_SA(0, 0), cA, voffA); PG8_STAGE(PG8_SA(0, 1), cA + hstep, voffA);
        if (wr == 1) PG8_BAR;
        PG8_WAIT_V(2); PG8_BAR;
        PG8_STAGE(PG8_SB(1, 0), cB + kstep, voffB); PG8_STAGE(PG8_SA(1, 0), cA + kstep, voffA); PG8_STAGE(PG8_SB(1, 1), cB + hstep + kstep, voffB);
        PG8_WAIT_V(6); PG8_BAR;
    } else {
        PG8_STAGE(PG8_SB(0, 0), cB, voffB); PG8_STAGE(PG8_SA(0, 0), cA, voffA); PG8_STAGE(PG8_SB(0, 1), cB + hstep, voffB); PG8_STAGE(PG8_SA(0, 1), cA + hstep, voffA);
        if (wr == 1) PG8_BAR;
        PG8_WAIT_V(4); PG8_BAR;
        PG8_STAGE(PG8_SB(1, 0), cB + kstep, voffB); PG8_STAGE(PG8_SA(1, 0), cA + kstep, voffA); PG8_STAGE(PG8_SB(1, 1), cB + hstep + kstep, voffB);
        PG8_WAIT_V(6); PG8_BAR;
    }
    for (;;) {
        const bool has_next = S.next(ui + 1, nxt);
        const char* nA = has_next ? (const char*)g.A + (size_t)nxt.pm * tstep : cA; const char* nB = has_next ? (const char*)g.Bt + (size_t)nxt.pn * tstep : cB;
        for (int t = 0; t < nt; t += 2) {
            const bool last = (t == nt - 2);
            const char* a1 = cA + (size_t)(t + 1) * kstep;
            const char* a2 = last ? nA : cA + (size_t)(t + 2) * kstep; const char* b2 = last ? nB : cB + (size_t)(t + 2) * kstep;
            const char* a3 = a2 + kstep; const char* b3 = b2 + kstep;
            if (last && has_next) S.a_ready(nxt);
            if constexpr (SP2) {
            PG8_LDB(B0, 0, 0); PG8_LDB(B1, 0, 1); PG8_SCHED; PG8_LDA(At, 0, 0); PG8_STAGE(PG8_SA(1, 1), a1 + hstep, voffA);
            PG8_WAIT_V(8); PG8_WAIT_L(0); PG8_BAR; PG8_MMA(0, 0, At, B0); PG8_MMA(0, 1, At, B1); PG8_BAR; PG8_SCHED;
            PG8_LDA(At, 0, 1); PG8_STAGE(PG8_SB(0, 0), b2, voffB); PG8_STAGE(PG8_SB(0, 1), b2 + hstep, voffB); PG8_STAGE(PG8_SA(0, 0), a2, voffA);
            PG8_WAIT_V(8); PG8_WAIT_L(0); PG8_BAR; PG8_MMA(1, 0, At, B0); PG8_MMA(1, 1, At, B1); PG8_BAR; PG8_SCHED;
            PG8_LDB(B0, 1, 0); PG8_LDB(B1, 1, 1); PG8_SCHED; PG8_LDA(At, 1, 0); PG8_STAGE(PG8_SA(0, 1), a2 + hstep, voffA);
            PG8_WAIT_V(8); PG8_WAIT_L(0); PG8_BAR; PG8_MMA(0, 0, At, B0); PG8_MMA(0, 1, At, B1); PG8_BAR; PG8_SCHED;
            PG8_LDA(At, 1, 1); PG8_STAGE(PG8_SB(1, 0), b3, voffB); PG8_STAGE(PG8_SB(1, 1), b3 + hstep, voffB); PG8_STAGE(PG8_SA(1, 0), a3, voffA);
            PG8_WAIT_V(8); PG8_WAIT_L(0); PG8_BAR; PG8_MMA(1, 0, At, B0); PG8_MMA(1, 1, At, B1); PG8_BAR; PG8_SCHED;
            } else {
            PG8_LDB(B0, 0, 0); PG8_SCHED; PG8_LDA(At, 0, 0); PG8_STAGE(PG8_SA(1, 1), a1 + hstep, voffA);
            PG8_WAIT_L(8); PG8_BAR; PG8_WAIT_L(0); PG8_MMA(0, 0, At, B0); PG8_BAR; PG8_SCHED;
            PG8_LDB(B1, 0, 1); PG8_STAGE(PG8_SB(0, 0), b2, voffB);
            PG8_BAR; PG8_WAIT_L(0); PG8_MMA(0, 1, At, B1); PG8_BAR;
            PG8_LDA(At, 0, 1); PG8_STAGE(PG8_SA(0, 0), a2, voffA);
            PG8_BAR; PG8_WAIT_L(0); PG8_MMA(1, 0, At, B0); PG8_BAR; PG8_SCHED;
            PG8_STAGE(PG8_SB(0, 1), b2 + hstep, voffB);
            PG8_WAIT_V(6); PG8_BAR; PG8_MMA(1, 1, At, B1); PG8_BAR;
            PG8_LDB(B0, 1, 0); PG8_SCHED; PG8_LDA(At, 1, 0); PG8_STAGE(PG8_SA(0, 1), a2 + hstep, voffA);
            PG8_WAIT_L(8); PG8_BAR; PG8_WAIT_L(0); PG8_MMA(0, 0, At, B0); PG8_BAR; PG8_SCHED;
            PG8_LDB(B1, 1, 1); PG8_STAGE(PG8_SB(1, 0), b3, voffB);
            PG8_BAR; PG8_WAIT_L(0); PG8_MMA(0, 1, At, B1); PG8_BAR;
            PG8_LDA(At, 1, 1); PG8_STAGE(PG8_SA(1, 0), a3, voffA);
            PG8_BAR; PG8_WAIT_L(0); PG8_MMA(1, 0, At, B0); PG8_BAR; PG8_SCHED;
            PG8_STAGE(PG8_SB(1, 1), b3 + hstep, voffB);
            PG8_WAIT_V(6); PG8_BAR; PG8_MMA(1, 1, At, B1); PG8_BAR;
            }
        }
        if constexpr (ALIGN_EPI) { if (wr == 0) PG8_BAR; }
        if constexpr (!Epi::AFTER_DRAIN) { E(acc, cur, wr, wc, fr, fq); S.done(cur); }
        if (!has_next) break;
#pragma unroll
        for (int a = 0; a < 2; ++a)
#pragma unroll
            for (int b = 0; b < 2; ++b)
#pragma unroll
                for (int m = 0; m < 4; ++m)
#pragma unroll
                    for (int n = 0; n < 2; ++n) acc[a][b][m][n] = (f32x4){0.f, 0.f, 0.f, 0.f};
        cur = nxt; cA = nA; cB = nB; ++ui;
        if constexpr (ALIGN_EPI) { if (wr == 1) PG8_BAR; }
    }
    PG8_WAIT_V(0);
    if constexpr (!ALIGN_EPI) { if (wr == 0) PG8_BAR; }
    PG8_BAR;
    if constexpr (Epi::AFTER_DRAIN) { E.fused(acc, cur, wr, wc, fr, fq, lds, wid, lane); S.done(cur); }
#undef PG8_SA
#undef PG8_SB
#undef PG8_STAGE
#undef PG8_LDA
#undef PG8_LDB
#undef PG8_MMA
#undef PG8_WAIT_V
#undef PG8_WAIT_L
#undef PG8_BAR
#undef PG8_SCHED
}
}

typedef unsigned short bf16;
typedef unsigned v4u __attribute__((ext_vector_type(4)));
typedef unsigned v2u __attribute__((ext_vector_type(2)));
typedef float f32x4 __attribute__((ext_vector_type(4)));
constexpr int NWAVES = 8, NTHR = 512;
constexpr int D = 1024, NB = 8, SEQ = 2048, CTXL = 256, TL = NB * SEQ, TC = NB * CTXL, T = TL + TC;
constexpr int HYB_IN = 2208, HYB_INP = 2304, SSD_IN = 5184, SSD_INP = 5376, DFF = 2816, UPW = 5632;
constexpr int QW = 768, KVW = 1024, MODW = 6144;
constexpr float EPS = 1e-6f;
constexpr int NSTEP = 1 + 4 * 10;
constexpr float ATT_SCALE_LOG2E = 0.10206207261596577f * 1.4426950408889634f;

constexpr size_t MiB = 1u << 20;
constexpr size_t WS_CTL = 0, CTL_ZERO_BYTES = 64 * 1024;
constexpr size_t WS_MOD = 1 * MiB;
constexpr size_t WS_ROPE = 2 * MiB;
constexpr size_t W_UP = 3 * MiB;
constexpr size_t W_DN = W_UP + (size_t)UPW * D * 2;
constexpr size_t W_IN = W_DN + (size_t)D * DFF * 2;
constexpr size_t W_OUT = W_IN + (size_t)SSD_INP * D * 2;
constexpr size_t W_UQ = W_OUT + (size_t)D * 2048 * 2;
constexpr size_t W_UKV = W_UQ + (size_t)QW * 384 * 2;
constexpr size_t W_END = W_UKV + (size_t)KVW * 256 * 2;
constexpr size_t WS_XC = 36 * MiB;
constexpr size_t WS_H = 44 * MiB;
constexpr size_t WS_DT = WS_H, WS_AA = WS_H + (size_t)T * 64 * 4;
constexpr size_t WS_BIG = 80 * MiB;
constexpr size_t WS_M = WS_BIG;
constexpr size_t WS_P = WS_BIG;
constexpr size_t WS_Q = WS_BIG + 81 * MiB;
constexpr size_t WS_KV = WS_BIG + 108 * MiB;
constexpr size_t WS_KR = WS_BIG + 144 * MiB;
constexpr size_t WS_CQN = WS_BIG + 146 * MiB;
constexpr size_t WS_CKVN = WS_BIG + 160 * MiB;
constexpr size_t WS_MIX = WS_BIG + 170 * MiB;
constexpr size_t WS_U = WS_BIG;
constexpr size_t WS_G = WS_BIG + 198 * MiB;
constexpr size_t WS_ZX = WS_BIG;
constexpr size_t WS_XBC = WS_BIG + 189 * MiB;
constexpr size_t WS_UE = WS_BIG + 297 * MiB;
constexpr size_t WS_END = WS_UE + 4 * MiB;
static_assert(W_END <= WS_XC && WS_G + (size_t)T * DFF * 2 <= WS_END && WS_XBC + (size_t)T * 3072 * 2 <= WS_END && WS_ZX + (size_t)T * SSD_INP * 2 <= WS_XBC, "ws map");
static_assert(WS_AA + (size_t)T * 64 * 4 <= WS_BIG && WS_MIX + (size_t)T * D * 2 <= WS_END && WS_Q + (size_t)T * QW * 2 <= WS_KV && WS_P + (size_t)T * HYB_INP * 2 <= WS_Q, "ws map 2");
constexpr int LDS_BYTES = 147456;

struct Args { const float* in[25]; float* out; unsigned char* ws; int lo, hi; int wv, pad; };
enum { I_X = 0, I_C, I_CTX, I_CCTX, I_MODW, I_MODB, I_NORMW, I_WUP, I_FCONV, I_WDN, I_HIN, I_QNORM, I_KVNORM, I_WUQ, I_WUKV, I_SCONV, I_HOUT, I_SIN, I_SCONVW, I_SCONVB, I_ALOG, I_DTB, I_SD, I_SNORM, I_SOUT };

__device__ __forceinline__ unsigned f2bf(float f) { unsigned u = __builtin_bit_cast(unsigned, f); return (u + 0x7fffu + ((u >> 16) & 1u)) >> 16; }
__device__ __forceinline__ unsigned pk2(float lo, float hi) { return f2bf(lo) | (f2bf(hi) << 16); }
__device__ __forceinline__ float bflo(unsigned u) { return __builtin_bit_cast(float, u << 16); }
__device__ __forceinline__ float bfhi(unsigned u) { return __builtin_bit_cast(float, u & 0xffff0000u); }
__device__ __forceinline__ float bf1(bf16 b) { return __builtin_bit_cast(float, (unsigned)b << 16); }
__device__ __forceinline__ float silu_f(float x) { return x / (1.f + __expf(-x)); }
__device__ __forceinline__ float wave_sum(float v, int lane) {
#pragma unroll
    for (int o = 1; o < 64; o <<= 1) v += shx(v, o, lane);
    return v;
}
__device__ __forceinline__ void unpack8(const v4u w, float (&f)[8]) { f[0] = bflo(w.x); f[1] = bfhi(w.x); f[2] = bflo(w.y); f[3] = bfhi(w.y); f[4] = bflo(w.z); f[5] = bfhi(w.z); f[6] = bflo(w.w); f[7] = bfhi(w.w); }
__device__ __forceinline__ v4u pack8(const float (&f)[8]) { v4u w; w.x = pk2(f[0], f[1]); w.y = pk2(f[2], f[3]); w.z = pk2(f[4], f[5]); w.w = pk2(f[6], f[7]); return w; }
__device__ __forceinline__ bool has_prev(int r) { return r < TL ? (r & (SEQ - 1)) != 0 : ((r - TL) & (CTXL - 1)) != 0; }
__device__ __forceinline__ bool has_next(int r) { return r < TL ? (r & (SEQ - 1)) != SEQ - 1 : ((r - TL) & (CTXL - 1)) != CTXL - 1; }

__device__ __forceinline__ void mod_compute(const Args& a, LAS unsigned char* lds) {
    LAS float* sc = (LAS float*)lds;
    LAS float* red = (LAS float*)(lds + 36864);
    const int tid = otid(a.wv);
    float* MOD = (float*)(a.ws + WS_MOD);
    for (int i = tid; i < 9 * 1024; i += NTHR) { const int c = i >> 10, k = i & 1023; const float v = c < 8 ? a.in[I_C][c * 1024 + k] : a.in[I_CCTX][k]; sc[i] = silu_f(v); }
    __syncthreads();
    for (int item = blockIdx.x; item < 4 * 96; item += gridDim.x) {
        const int l = item / 96, cb = item % 96;
        const float* W = a.in[I_MODW] + (size_t)l * 1024 * MODW + cb * 64;
        const int cgp = tid & 15, kg = tid >> 4;
        float acc[9][4];
#pragma unroll
        for (int c = 0; c < 9; ++c) { acc[c][0] = 0.f; acc[c][1] = 0.f; acc[c][2] = 0.f; acc[c][3] = 0.f; }
#pragma unroll 4
        for (int kk = 0; kk < 32; ++kk) { const int k = kg * 32 + kk; const f32x4 w = *(const f32x4*)(W + (size_t)k * MODW + cgp * 4);
#pragma unroll
            for (int c = 0; c < 9; ++c) { const float s = sc[c * 1024 + k]; acc[c][0] += s * w[0]; acc[c][1] += s * w[1]; acc[c][2] += s * w[2]; acc[c][3] += s * w[3]; } }
#pragma unroll
        for (int c = 0; c < 9; ++c)
#pragma unroll
            for (int j = 0; j < 4; ++j) red[kg * 576 + c * 64 + cgp * 4 + j] = acc[c][j];
        __syncthreads();
        for (int o = tid; o < 576; o += NTHR) { float s = 0.f;
            for (int g = 0; g < 32; ++g) s += red[g * 576 + o];
            const int c = o >> 6, col = o & 63; MOD[(size_t)(l * 9 + c) * MODW + cb * 64 + col] = s + a.in[I_MODB][l * MODW + cb * 64 + col]; }
        __syncthreads();
    }
}
__device__ __forceinline__ void rope_tables(const Args& a) {
    float* ct = (float*)(a.ws + WS_ROPE); float* st = ct + SEQ * 16;
    for (int i = blockIdx.x * NTHR + otid(a.wv); i < SEQ * 16; i += gridDim.x * NTHR) {
        const int t = i >> 4, j = i & 15; const int pos = j < 8 ? (t >> 6) : (t & 63); const int f = j & 7;
        const float i0 = (f & 1) ? 0.31622776601683794f : 1.0f; const int e = f >> 1; const float i1 = e == 0 ? 1.0f : (e == 1 ? 0.1f : (e == 2 ? 0.01f : 0.001f));
        const float inv = i0 * i1; const float ang = (float)pos * inv;
        ct[i] = __cosf(ang); st[i] = __sinf(ang); }
}
__device__ __forceinline__ void transpose_item(const float* W, int K, int N, bf16* WT, LAS float* scr, int item, int lane, bool ffn_perm) {
    const int nblk = N / 32, kb = item / nblk, nb = item % nblk, k0 = 64 * kb, n0 = 32 * nb;
    const int o0 = ffn_perm ? ((n0 % DFF) / 128) * 256 + (n0 / DFF) * 128 + (n0 % 128) : n0;
#pragma unroll 8
    for (int i = 0; i < 32; ++i) { const int kk = 2 * i + (lane >> 5); scr[kk * 33 + (lane & 31)] = W[(size_t)(k0 + kk) * N + n0 + (lane & 31)]; }
    asm volatile("s_waitcnt lgkmcnt(0)" ::: "memory");
    const int c = lane & 7;
#pragma unroll
    for (int j = 0; j < 4; ++j) { const int n = (lane >> 3) + 8 * j; const LAS float* s = scr + (8 * c) * 33 + n;
        v4u o; o.x = pk2(s[0 * 33], s[1 * 33]); o.y = pk2(s[2 * 33], s[3 * 33]); o.z = pk2(s[4 * 33], s[5 * 33]); o.w = pk2(s[6 * 33], s[7 * 33]);
        *(v4u*)(WT + (size_t)(o0 + n) * K + k0 + 8 * c) = o; }
    asm volatile("s_waitcnt lgkmcnt(0)" ::: "memory");
}
__device__ __forceinline__ void convert_weight(const float* W, int K, int N, int Npad, bf16* WT, LAS unsigned char* lds, int rot, int wv, bool ffn_perm = false) {
    const int wave = wv, lane = otid(wv) & 63; const int NGW = gridDim.x * NWAVES; const int gw = (blockIdx.x * NWAVES + wave + rot) % NGW;
    LAS float* scr = (LAS float*)(lds + wave * 16384);
    const int nitems = (K / 64) * (N / 32);
    for (int it = gw; it < nitems; it += NGW) transpose_item(W, K, N, WT, scr, it, lane, ffn_perm);
    (void)Npad;
}
__device__ __forceinline__ void convert_layer(const Args& a, int l, LAS unsigned char* lds) {
    const int i = l >> 1; unsigned char* ws = a.ws;
    convert_weight(a.in[I_WUP] + (size_t)l * D * UPW, D, UPW, UPW, (bf16*)(ws + W_UP), lds, 0, a.wv, true);
    convert_weight(a.in[I_WDN] + (size_t)l * DFF * D, DFF, D, D, (bf16*)(ws + W_DN), lds, 300, a.wv);
    if ((l & 1) == 0) {
        convert_weight(a.in[I_HIN] + (size_t)i * D * HYB_IN, D, HYB_IN, HYB_INP, (bf16*)(ws + W_IN), lds, 700, a.wv);
        convert_weight(a.in[I_HOUT] + (size_t)i * D * D, D, D, D, (bf16*)(ws + W_OUT), lds, 1100, a.wv);
        convert_weight(a.in[I_WUQ] + (size_t)i * 384 * QW, 384, QW, QW, (bf16*)(ws + W_UQ), lds, 1500, a.wv);
        convert_weight(a.in[I_WUKV] + (size_t)i * 256 * KVW, 256, KVW, KVW, (bf16*)(ws + W_UKV), lds, 1700, a.wv);
    } else {
        convert_weight(a.in[I_SIN] + (size_t)i * D * SSD_IN, D, SSD_IN, SSD_INP, (bf16*)(ws + W_IN), lds, 700, a.wv);
        convert_weight(a.in[I_SOUT] + (size_t)i * 2048 * D, 2048, D, D, (bf16*)(ws + W_OUT), lds, 1300, a.wv);
    }
}

__device__ __forceinline__ void prep_even(const Args& a, int i) {
    const int wave = otid(a.wv) >> 6, lane = otid(a.wv) & 63; const int NGW = gridDim.x * NWAVES, gw = blockIdx.x * NWAVES + wave;
    const bf16* P = (const bf16*)(a.ws + WS_P); bf16* CQN = (bf16*)(a.ws + WS_CQN); bf16* CKVN = (bf16*)(a.ws + WS_CKVN); bf16* KR = (bf16*)(a.ws + WS_KR); bf16* MIX = (bf16*)(a.ws + WS_MIX);
    const float* qn = a.in[I_QNORM] + i * 384; const float* kvn = a.in[I_KVNORM] + i * 256; const float* cw = a.in[I_SCONV] + i * 3 * 512;
    const float* ct = (const float*)(a.ws + WS_ROPE); const float* st = ct + SEQ * 16;
    for (int r = gw; r < T; r += NGW) {
        const bf16* p = P + (size_t)r * HYB_INP;
        {
            const unsigned* p32 = (const unsigned*)(p + lane * 6); const unsigned w0 = p32[0], w1 = p32[1], w2 = p32[2];
            float f[6] = {bflo(w0), bfhi(w0), bflo(w1), bfhi(w1), bflo(w2), bfhi(w2)}; float ss = 0.f;
#pragma unroll
            for (int j = 0; j < 6; ++j) ss += f[j] * f[j];
            const float rs = rsqrtf(wave_sum(ss, lane) * (1.f / 384.f) + EPS);
#pragma unroll
            for (int j = 0; j < 6; ++j) f[j] = f[j] * rs * qn[lane * 6 + j];
            unsigned* o32 = (unsigned*)(CQN + (size_t)r * 384 + lane * 6); o32[0] = pk2(f[0], f[1]); o32[1] = pk2(f[2], f[3]); o32[2] = pk2(f[4], f[5]);
        }
        {
            const v2u w = *(const v2u*)(p + 384 + lane * 4); float f[4] = {bflo(w.x), bfhi(w.x), bflo(w.y), bfhi(w.y)};
            const float ss = (f[0] * f[0] + f[1] * f[1]) + (f[2] * f[2] + f[3] * f[3]);
            const float rs = rsqrtf(wave_sum(ss, lane) * (1.f / 256.f) + EPS);
            const f32x4 g = *(const f32x4*)(kvn + lane * 4);
            v2u o; o.x = pk2(f[0] * rs * g[0], f[1] * rs * g[1]); o.y = pk2(f[2] * rs * g[2], f[3] * rs * g[3]); *(v2u*)(CKVN + (size_t)r * 256 + lane * 4) = o;
        }
        {
            const int j = lane & 31; const float v = bf1(p[640 + j]); const float o = shx(v, 16, lane); float res = v;
            if (r < TL) { const int t = r & (SEQ - 1); const float c = ct[t * 16 + (j & 15)], s = st[t * 16 + (j & 15)]; res = (j < 16) ? v * c - o * s : o * s + v * c; }
            if (lane < 32) KR[(size_t)r * 32 + j] = (bf16)f2bf(res);
        }
        {
            const int c0 = lane * 8; float gb[8], cur[8], acc[8], t0[8], t1[8];
            unpack8(*(const v4u*)(p + 672 + c0), gb);
            unpack8(*(const v4u*)(p + 1184 + c0), t0); unpack8(*(const v4u*)(p + 1696 + c0), t1);
#pragma unroll
            for (int j = 0; j < 8; ++j) { cur[j] = t0[j] * t1[j]; acc[j] = cw[512 + c0 + j] * cur[j]; }
            if (has_prev(r)) { unpack8(*(const v4u*)(p - HYB_INP + 1184 + c0), t0); unpack8(*(const v4u*)(p - HYB_INP + 1696 + c0), t1);
#pragma unroll
                for (int j = 0; j < 8; ++j) acc[j] += cw[c0 + j] * (t0[j] * t1[j]); }
            if (has_next(r)) { unpack8(*(const v4u*)(p + HYB_INP + 1184 + c0), t0); unpack8(*(const v4u*)(p + HYB_INP + 1696 + c0), t1);
#pragma unroll
                for (int j = 0; j < 8; ++j) acc[j] += cw[1024 + c0 + j] * (t0[j] * t1[j]); }
#pragma unroll
            for (int j = 0; j < 8; ++j) acc[j] *= gb[j];
            *(v4u*)(MIX + (size_t)r * D + 512 + c0) = pack8(acc);
        }
    }
}

__device__ __forceinline__ void convgate(const Args& a, int l, int nrows) {
    const bf16* U = (const bf16*)(a.ws + WS_U); bf16* G = (bf16*)(a.ws + WS_G); const float* cw = a.in[I_FCONV] + (size_t)l * 3 * UPW;
    const int total = nrows * (DFF / 8);
    for (int idx = blockIdx.x * NTHR + otid(a.wv); idx < total; idx += gridDim.x * NTHR) {
        const int r = idx / (DFF / 8), c0 = (idx % (DFF / 8)) * 8; const bf16* u = U + (size_t)r * UPW + c0;
        float ua[8], ug[8], act[8], gate[8];
        unpack8(*(const v4u*)u, ua); unpack8(*(const v4u*)(u + DFF), ug);
#pragma unroll
        for (int j = 0; j < 8; ++j) { act[j] = cw[UPW + c0 + j] * ua[j]; gate[j] = cw[UPW + DFF + c0 + j] * ug[j]; }
        if (has_prev(r)) { unpack8(*(const v4u*)(u - UPW), ua); unpack8(*(const v4u*)(u - UPW + DFF), ug);
#pragma unroll
            for (int j = 0; j < 8; ++j) { act[j] += cw[c0 + j] * ua[j]; gate[j] += cw[DFF + c0 + j] * ug[j]; } }
        if (has_next(r)) { unpack8(*(const v4u*)(u + UPW), ua); unpack8(*(const v4u*)(u + UPW + DFF), ug);
#pragma unroll
            for (int j = 0; j < 8; ++j) { act[j] += cw[2 * UPW + c0 + j] * ua[j]; gate[j] += cw[2 * UPW + DFF + c0 + j] * ug[j]; } }
#pragma unroll
        for (int j = 0; j < 8; ++j) act[j] = silu_f(act[j]) * gate[j];
        *(v4u*)(G + (size_t)r * DFF + c0) = pack8(act);
    }
}

__device__ __forceinline__ void ssd_conv(const Args& a, int i) {
    const bf16* ZX = (const bf16*)(a.ws + WS_ZX); bf16* XBC = (bf16*)(a.ws + WS_XBC); float* DT = (float*)(a.ws + WS_DT); float* AA = (float*)(a.ws + WS_AA);
    const float* cw = a.in[I_SCONVW] + (size_t)i * 3 * 3072; const float* cb = a.in[I_SCONVB] + (size_t)i * 3072;
    const int total = T * 384;
    for (int idx = blockIdx.x * NTHR + otid(a.wv); idx < total; idx += gridDim.x * NTHR) {
        const int r = idx / 384, c0 = (idx % 384) * 8; const bf16* u = ZX + (size_t)r * SSD_INP + 2048 + c0;
        float x[8], acc[8];
        unpack8(*(const v4u*)u, x);
#pragma unroll
        for (int j = 0; j < 8; ++j) acc[j] = cb[c0 + j] + cw[3072 + c0 + j] * x[j];
        if (has_prev(r)) { unpack8(*(const v4u*)(u - SSD_INP), x);
#pragma unroll
            for (int j = 0; j < 8; ++j) acc[j] += cw[c0 + j] * x[j]; }
        if (has_next(r)) { unpack8(*(const v4u*)(u + SSD_INP), x);
#pragma unroll
            for (int j = 0; j < 8; ++j) acc[j] += cw[2 * 3072 + c0 + j] * x[j]; }
#pragma unroll
        for (int j = 0; j < 8; ++j) acc[j] = silu_f(acc[j]);
        *(v4u*)(XBC + (size_t)r * 3072 + c0) = pack8(acc);
    }
    const float* alog = a.in[I_ALOG] + i * 64; const float* dtb = a.in[I_DTB] + i * 64;
    for (int idx = blockIdx.x * NTHR + otid(a.wv); idx < T * 64; idx += gridDim.x * NTHR) {
        const int r = idx >> 6, j = idx & 63; const float raw = bf1(ZX[(size_t)r * SSD_INP + 5120 + j]) + dtb[j];
        const float dt = raw > 15.f ? raw : (raw < -15.f ? __expf(raw) : __logf(1.f + __expf(raw)));
        DT[idx] = dt; AA[idx] = -__expf(alog[j]) * dt;
    }
}

__device__ __forceinline__ void gatenorm(const Args& a, int i, int nrows) {
    const int wave = otid(a.wv) >> 6, lane = otid(a.wv) & 63; const int NGW = gridDim.x * NWAVES, gw = blockIdx.x * NWAVES + wave;
    const bf16* ZX = (const bf16*)(a.ws + WS_ZX); bf16* YN = (bf16*)(a.ws + WS_XBC); const float* nw = a.in[I_SNORM] + i * 2048;
    for (int r = gw; r < nrows; r += NGW) {
        float v[4][8]; float ss = 0.f;
#pragma unroll
        for (int j = 0; j < 4; ++j) { float y[8], z[8]; const int c = j * 512 + lane * 8;
            unpack8(*(const v4u*)(ZX + (size_t)r * SSD_INP + 2048 + c), y); unpack8(*(const v4u*)(ZX + (size_t)r * SSD_INP + c), z);
#pragma unroll
            for (int k = 0; k < 8; ++k) { v[j][k] = y[k] * silu_f(z[k]); ss += v[j][k] * v[j][k]; } }
        const float rs = rsqrtf(wave_sum(ss, lane) * (1.f / 2048.f) + EPS);
#pragma unroll
        for (int j = 0; j < 4; ++j) { const int c = j * 512 + lane * 8; float o[8];
#pragma unroll
            for (int k = 0; k < 8; ++k) o[k] = v[j][k] * rs * nw[c + k];
            *(v4u*)(YN + (size_t)r * 2048 + c) = pack8(o); }
    }
}

__device__ __forceinline__ void attn_naive(const Args& a, LAS unsigned char* lds) {
    const int tid = otid(a.wv), qi = tid >> 1, half = tid & 1;
    const bf16* Qb = (const bf16*)(a.ws + WS_Q); const bf16* KVb = (const bf16*)(a.ws + WS_KV); const bf16* KR = (const bf16*)(a.ws + WS_KR); bf16* MIX = (bf16*)(a.ws + WS_MIX);
    const float* ct = (const float*)(a.ws + WS_ROPE); const float* st = ct + SEQ * 16;
    LAS float* Kt = (LAS float*)lds;
    LAS float* Vt = (LAS float*)(lds + 64 * 96 * 4);
    for (int u = blockIdx.x; u < 576; u += gridDim.x) {
        const bool lat = u < 512; const int b = lat ? (u >> 6) : ((u - 512) >> 3), h = lat ? ((u >> 3) & 7) : ((u - 512) & 7);
        const int nkeys = lat ? (CTXL + SEQ) : CTXL;
        const int qrow = lat ? b * SEQ + (u & 7) * 256 + qi : TL + b * CTXL + qi;
        float q[48];
#pragma unroll
        for (int g = 0; g < 6; ++g) { float f[8]; unpack8(*(const v4u*)(Qb + (size_t)qrow * QW + h * 96 + half * 48 + g * 8), f);
#pragma unroll
            for (int j = 0; j < 8; ++j) q[g * 8 + j] = f[j]; }
        if (lat && half == 1) { const int t = qrow & (SEQ - 1);
#pragma unroll
            for (int j = 0; j < 16; ++j) { const float c = ct[t * 16 + j], s = st[t * 16 + j]; const float x1 = q[16 + j], x2 = q[32 + j]; q[16 + j] = x1 * c - x2 * s; q[32 + j] = x1 * s + x2 * c; } }
#pragma unroll
        for (int j = 0; j < 48; ++j) q[j] *= ATT_SCALE_LOG2E;
        float o[32]; float m = -1e30f, l = 0.f;
#pragma unroll
        for (int j = 0; j < 32; ++j) o[j] = 0.f;
        for (int k0 = 0; k0 < nkeys; k0 += 64) {
            __syncthreads();
            for (int g = tid; g < 768; g += NTHR) { const int key = g / 12, part = g % 12; const int kk = k0 + key; const int krow = kk < CTXL ? TL + b * CTXL + kk : b * SEQ + kk - CTXL;
                float f[8]; unpack8(part < 8 ? *(const v4u*)(KVb + (size_t)krow * KVW + h * 128 + part * 8) : *(const v4u*)(KR + (size_t)krow * 32 + (part - 8) * 8), f);
#pragma unroll
                for (int j = 0; j < 8; ++j) Kt[key * 96 + part * 8 + j] = f[j]; }
            { const int key = tid >> 3, part = tid & 7; const int kk = k0 + key; const int krow = kk < CTXL ? TL + b * CTXL + kk : b * SEQ + kk - CTXL;
                float f[8]; unpack8(*(const v4u*)(KVb + (size_t)krow * KVW + h * 128 + 64 + part * 8), f);
#pragma unroll
                for (int j = 0; j < 8; ++j) Vt[key * 64 + part * 8 + j] = f[j]; }
            __syncthreads();
            for (int kg = 0; kg < 64; kg += 8) {
                float s[8]; float gm = -1e30f;
#pragma unroll
                for (int kk = 0; kk < 8; ++kk) { float acc = 0.f; const LAS f32x4* kp = (const LAS f32x4*)(Kt + (kg + kk) * 96 + half * 48);
#pragma unroll
                    for (int d4 = 0; d4 < 12; ++d4) { const f32x4 kv = kp[d4]; acc += q[d4 * 4] * kv[0] + q[d4 * 4 + 1] * kv[1] + q[d4 * 4 + 2] * kv[2] + q[d4 * 4 + 3] * kv[3]; }
                    acc += shx(acc, 1, tid & 63);
                    s[kk] = acc; gm = fmaxf(gm, acc); }
                const float mn = fmaxf(m, gm); const float alpha = exp2f(m - mn); m = mn; l *= alpha;
#pragma unroll
                for (int j = 0; j < 32; ++j) o[j] *= alpha;
#pragma unroll
                for (int kk = 0; kk < 8; ++kk) { const float p = exp2f(s[kk] - mn); l += p; const LAS f32x4* vp = (const LAS f32x4*)(Vt + (kg + kk) * 64 + half * 32);
#pragma unroll
                    for (int d4 = 0; d4 < 8; ++d4) { const f32x4 vv = vp[d4]; o[d4 * 4] += p * vv[0]; o[d4 * 4 + 1] += p * vv[1]; o[d4 * 4 + 2] += p * vv[2]; o[d4 * 4 + 3] += p * vv[3]; } }
            }
        }
        { const float inv = 1.f / l;
#pragma unroll
            for (int g = 0; g < 4; ++g) { float f[8];
#pragma unroll
                for (int j = 0; j < 8; ++j) f[j] = o[g * 8 + j] * inv;
                *(v4u*)(MIX + (size_t)qrow * D + h * 64 + half * 32 + g * 8) = pack8(f); } }
    }
}

__device__ __forceinline__ void ssd_scan_naive(const Args& a, int i, bool last, LAS unsigned char* lds) {
    const int tid = otid(a.wv), p = tid >> 3, nq = tid & 7;
    bf16* ZX = (bf16*)(a.ws + WS_ZX); const bf16* XBC = (const bf16*)(a.ws + WS_XBC); const float* DT = (const float*)(a.ws + WS_DT); const float* AA = (const float*)(a.ws + WS_AA);
    LAS float* xs = (LAS float*)lds;
    LAS float* Bs = (LAS float*)(lds + 16384);
    LAS float* Cs = (LAS float*)(lds + 16384 + 32768);
    LAS float* dts = (LAS float*)(lds + 16384 + 65536);
    LAS float* as = dts + 64;
    for (int it = blockIdx.x; it < NB * 32; it += gridDim.x) {
        const int b = it >> 5, h = it & 31, g = h >> 3; const float dsk = a.in[I_SD][i * 32 + h];
        for (int dir = 0; dir < 2; ++dir) {
            float stt[16];
#pragma unroll
            for (int n = 0; n < 16; ++n) stt[n] = 0.f;
            for (int seg = 0; seg < 2; ++seg) {
                const int len = seg == 0 ? CTXL : SEQ; const int base = seg == 0 ? TL + b * CTXL : b * SEQ; const bool want_y = !(last && seg == 0);
                for (int cc = 0; cc < len / 64; ++cc) {
                    const int t0 = dir == 0 ? cc * 64 : len - 64 - cc * 64;
                    __syncthreads();
                    { const int tt = tid >> 3, part = tid & 7; float f[8]; unpack8(*(const v4u*)(XBC + (size_t)(base + t0 + tt) * 3072 + h * 64 + part * 8), f);
#pragma unroll
                        for (int j = 0; j < 8; ++j) xs[tt * 64 + part * 8 + j] = f[j]; }
                    for (int q = tid; q < 1024; q += NTHR) { const int tt = q >> 4, part = q & 15; float f[8];
                        unpack8(*(const v4u*)(XBC + (size_t)(base + t0 + tt) * 3072 + 2048 + g * 128 + part * 8), f);
#pragma unroll
                        for (int j = 0; j < 8; ++j) Bs[tt * 128 + part * 8 + j] = f[j];
                        unpack8(*(const v4u*)(XBC + (size_t)(base + t0 + tt) * 3072 + 2560 + g * 128 + part * 8), f);
#pragma unroll
                        for (int j = 0; j < 8; ++j) Cs[tt * 128 + part * 8 + j] = f[j]; }
                    if (tid < 64) { dts[tid] = DT[(size_t)(base + t0 + tid) * 64 + dir * 32 + h]; as[tid] = AA[(size_t)(base + t0 + tid) * 64 + dir * 32 + h]; }
                    __syncthreads();
                    for (int s = 0; s < 64; ++s) {
                        const int tt = dir == 0 ? s : 63 - s;
                        const float dec = __expf(as[tt]); const float xv = xs[tt * 64 + p]; const float xd = xv * dts[tt];
                        const LAS f32x4* bp = (const LAS f32x4*)(Bs + tt * 128 + nq * 16); const LAS f32x4* cp = (const LAS f32x4*)(Cs + tt * 128 + nq * 16);
                        float acc = 0.f;
#pragma unroll
                        for (int n4 = 0; n4 < 4; ++n4) { const f32x4 bv = bp[n4], cv = cp[n4];
#pragma unroll
                            for (int k = 0; k < 4; ++k) { stt[n4 * 4 + k] = dec * stt[n4 * 4 + k] + xd * bv[k]; acc += cv[k] * stt[n4 * 4 + k]; } }
                        acc += shx(acc, 1, tid & 63); acc += shx(acc, 2, tid & 63); acc += shx(acc, 4, tid & 63);
                        if (want_y && nq == 0) { bf16* yp = ZX + (size_t)(base + t0 + tt) * SSD_INP + 2048 + h * 64 + p;
                            const float y = dir == 0 ? acc + dsk * xv : acc + bf1(*yp);
                            *yp = (bf16)f2bf(y); }
                    }
                }
            }
            __syncthreads();
            asm volatile("s_waitcnt vmcnt(0)" ::: "memory");
        }
    }
}

typedef short bf16x8 __attribute__((ext_vector_type(8)));
typedef float f32x16 __attribute__((ext_vector_type(16)));
typedef short v4i16_t __attribute__((ext_vector_type(4)));
__device__ __forceinline__ v2u trread(const LAS unsigned char* p) { return __builtin_bit_cast(v2u, __builtin_amdgcn_ds_read_tr16_b64_v4i16((LAS v4i16_t*)p)); }
__device__ __forceinline__ unsigned cvtpk(float lo, float hi) { unsigned r; asm volatile("v_cvt_pk_bf16_f32 %0, %1, %2" : "=v"(r) : "v"(lo), "v"(hi)); return r; }
constexpr int ATT_KP = 208, ATT_VP = 192, ATT_KB = 64 * ATT_KP, ATT_VB = 64 * ATT_VP, ATT_BUF = ATT_KB + ATT_VB;
#ifndef ATT_NQ
#define ATT_NQ 2
#endif
template <int NQ>
__device__ __forceinline__ void attn_unit3(const Args& a, LAS unsigned char* lds, const int b, const int h, const int q0, const int ntiles, const bool lat) {
    const int tid = otid(a.wv), wave = tid >> 6, lane = tid & 63, r32 = lane & 31, hh = lane >> 5;
    const int tq = (lane >> 2) & 3, tp = lane & 3, tblk = (lane >> 4) & 1;
    const bf16* Qb = (const bf16*)(a.ws + WS_Q); const bf16* KVb = (const bf16*)(a.ws + WS_KV); const bf16* KR = (const bf16*)(a.ws + WS_KR); bf16* MIX = (bf16*)(a.ws + WS_MIX);
    const float* ct = (const float*)(a.ws + WS_ROPE); const float* st = ct + SEQ * 16;
    bf16x8 qf[NQ][6];
#pragma unroll
    for (int nq = 0; nq < NQ; ++nq) { const int qrow = q0 + wave * (32 * NQ) + nq * 32 + r32;
#pragma unroll
        for (int s = 0; s < 6; ++s) qf[nq][s] = *(const bf16x8*)(Qb + (size_t)qrow * QW + h * 96 + 16 * s + 8 * hh);
        if (lat) { const int t = qrow & (SEQ - 1);
#pragma unroll
            for (int j = 0; j < 8; j += 2) { float x1[2], x2[2], y1[2], y2[2];
#pragma unroll
                for (int e = 0; e < 2; ++e) { x1[e] = bf1((bf16)qf[nq][4][j + e]); x2[e] = bf1((bf16)qf[nq][5][j + e]); const float c = ct[t * 16 + 8 * hh + j + e], s = st[t * 16 + 8 * hh + j + e];
                    y1[e] = x1[e] * c - x2[e] * s; y2[e] = x1[e] * s + x2[e] * c; }
                const unsigned w1 = pk2(y1[0], y1[1]), w2 = pk2(y2[0], y2[1]);
                qf[nq][4][j] = (short)(w1 & 0xffff); qf[nq][4][j + 1] = (short)(w1 >> 16); qf[nq][5][j] = (short)(w2 & 0xffff); qf[nq][5][j + 1] = (short)(w2 >> 16); } } }
    f32x16 o0[NQ], o1[NQ]; float m[NQ], l[NQ];
#pragma unroll
    for (int nq = 0; nq < NQ; ++nq) { m[nq] = -1e30f; l[nq] = 0.f;
#pragma unroll
        for (int i = 0; i < 16; ++i) { o0[nq][i] = 0.f; o1[nq][i] = 0.f; } }
    v4u kreg0, kreg1, vreg;
#define ATT_LOAD(it) do { const int rb_ = (it) < CTXL / 64 ? TL + b * CTXL + (it) * 64 : b * SEQ + ((it) - CTXL / 64) * 64; \
        const char* kvb_ = (const char*)(KVb + (size_t)rb_ * KVW); const char* krb_ = (const char*)(KR + (size_t)rb_ * 32); \
        kreg0 = *(const v4u*)(kvb_ + (tid >> 3) * 2048 + h * 256 + (tid & 7) * 16); if (tid < 256) kreg1 = *(const v4u*)(krb_ + (tid >> 2) * 64 + (tid & 3) * 16); vreg = *(const v4u*)(kvb_ + (tid >> 3) * 2048 + h * 256 + 128 + (tid & 7) * 16); } while (0)
#define ATT_WRITE(buf) do { LAS unsigned char* kb_ = lds + (buf) * ATT_BUF; LAS unsigned char* vb_ = kb_ + ATT_KB; \
        *(LAS v4u*)(kb_ + (tid >> 3) * ATT_KP + (tid & 7) * 16) = kreg0; if (tid < 256) *(LAS v4u*)(kb_ + (tid >> 2) * ATT_KP + 128 + (tid & 3) * 16) = kreg1; \
        *(LAS v4u*)(vb_ + (tid >> 3) * ATT_VP + (tid & 7) * 16) = vreg; } while (0)
    __syncthreads();
    ATT_LOAD(0); ATT_WRITE(0);
    __syncthreads();
    for (int it = 0; it < ntiles; ++it) {
#ifndef ATT_LOADMID
        if (it + 1 < ntiles) ATT_LOAD(it + 1);
#endif
#ifdef ATT_TZ
        int tz = tid; asm volatile("" : "+v"(tz));
        const int lane = tz & 63, r32 = lane & 31, hh = lane >> 5, tq = (lane >> 2) & 3, tp = lane & 3, tblk = (lane >> 4) & 1;
#endif
        const LAS unsigned char* kb = lds + (it & 1) * ATT_BUF; const LAS unsigned char* vb = kb + ATT_KB;
#pragma unroll
        for (int t = 0; t < 2; ++t) {
            f32x16 sc[NQ]; bf16x8 pf[NQ][2];
#pragma unroll
            for (int nq = 0; nq < NQ; ++nq)
#pragma unroll
                for (int i = 0; i < 16; ++i) sc[nq][i] = 0.f;
#pragma unroll
            for (int s = 0; s < 6; ++s) { const bf16x8 a0 = *(const LAS bf16x8*)(kb + (32 * t + r32) * ATT_KP + (16 * s + 8 * hh) * 2);
#pragma unroll
                for (int nq = 0; nq < NQ; ++nq) sc[nq] = __builtin_amdgcn_mfma_f32_32x32x16_bf16(a0, qf[nq][s], sc[nq], 0, 0, 0); }
#ifdef ATT_LOADMID
            if (t == 0 && it + 1 < ntiles) ATT_LOAD(it + 1);
#endif
#pragma unroll
            for (int nq = 0; nq < NQ; ++nq) {
                float mx = sc[nq][0];
#pragma unroll
                for (int i = 1; i < 16; ++i) mx = fmaxf(mx, sc[nq][i]);
                mx = fmaxf(mx, shx(mx, 32, lane));
                const float mn = fmaxf(m[nq], mx * ATT_SCALE_LOG2E); const float alpha = __builtin_amdgcn_exp2f(m[nq] - mn); m[nq] = mn;
                float rs = 0.f;
#pragma unroll
                for (int i = 0; i < 16; ++i) { sc[nq][i] = __builtin_amdgcn_exp2f(sc[nq][i] * ATT_SCALE_LOG2E - mn); rs += sc[nq][i]; }
                l[nq] = l[nq] * alpha + rs;
#pragma unroll
                for (int i = 0; i < 16; ++i) { o0[nq][i] *= alpha; o1[nq][i] *= alpha; }
#pragma unroll
                for (int s2 = 0; s2 < 2; ++s2) { v4u w0;
                    w0.x = cvtpk(sc[nq][8 * s2 + 0], sc[nq][8 * s2 + 1]); w0.y = cvtpk(sc[nq][8 * s2 + 2], sc[nq][8 * s2 + 3]); w0.z = cvtpk(sc[nq][8 * s2 + 4], sc[nq][8 * s2 + 5]); w0.w = cvtpk(sc[nq][8 * s2 + 6], sc[nq][8 * s2 + 7]);
                    pf[nq][s2] = __builtin_bit_cast(bf16x8, w0); }
            }
#pragma unroll
            for (int s2 = 0; s2 < 2; ++s2) { const int ko = t * 32 + 16 * s2 + 4 * hh;
                { const LAS unsigned char* tb = vb + (ko + tq) * ATT_VP + (16 * tblk + 4 * tp) * 2; const v2u lo = trread(tb), hi = trread(tb + 8 * ATT_VP); const bf16x8 vf = __builtin_bit_cast(bf16x8, (v4u){lo.x, lo.y, hi.x, hi.y});
#pragma unroll
                  for (int nq = 0; nq < NQ; ++nq) o0[nq] = __builtin_amdgcn_mfma_f32_32x32x16_bf16(vf, pf[nq][s2], o0[nq], 0, 0, 0); }
                { const LAS unsigned char* tb = vb + (ko + tq) * ATT_VP + (32 + 16 * tblk + 4 * tp) * 2; const v2u lo = trread(tb), hi = trread(tb + 8 * ATT_VP); const bf16x8 vf = __builtin_bit_cast(bf16x8, (v4u){lo.x, lo.y, hi.x, hi.y});
#pragma unroll
                  for (int nq = 0; nq < NQ; ++nq) o1[nq] = __builtin_amdgcn_mfma_f32_32x32x16_bf16(vf, pf[nq][s2], o1[nq], 0, 0, 0); } }
        }
        if (it + 1 < ntiles) ATT_WRITE((it + 1) & 1);
        __syncthreads();
    }
#undef ATT_LOAD
#undef ATT_WRITE
#pragma unroll
    for (int nq = 0; nq < NQ; ++nq) { const int qrow = q0 + wave * (32 * NQ) + nq * 32 + r32;
        const float lsum = l[nq] + shx(l[nq], 32, lane); const float inv = 1.f / lsum;
        bf16* orow = MIX + (size_t)qrow * D + h * 64 + 4 * hh;
#pragma unroll
        for (int g = 0; g < 4; ++g) {
            v2u w; w.x = pk2(o0[nq][4 * g] * inv, o0[nq][4 * g + 1] * inv); w.y = pk2(o0[nq][4 * g + 2] * inv, o0[nq][4 * g + 3] * inv); *(v2u*)(orow + 8 * g) = w;
            v2u x; x.x = pk2(o1[nq][4 * g] * inv, o1[nq][4 * g + 1] * inv); x.y = pk2(o1[nq][4 * g + 2] * inv, o1[nq][4 * g + 3] * inv); *(v2u*)(orow + 32 + 8 * g) = x; } }
}
__device__ __forceinline__ void attn_mfma(const Args& a, LAS unsigned char* lds) {
#if ATT_NQ == 2
    for (int u = blockIdx.x; u < 256; u += gridDim.x) attn_unit3<2>(a, lds, u >> 5, (u >> 2) & 7, (u >> 5) * SEQ + (u & 3) * 512, (CTXL + SEQ) / 64, true);
#else
    for (int u = blockIdx.x; u < 512; u += gridDim.x) attn_unit3<1>(a, lds, u >> 6, (u >> 3) & 7, (u >> 6) * SEQ + (u & 7) * 256, (CTXL + SEQ) / 64, true);
#endif
    for (int u = blockIdx.x; u < 64; u += gridDim.x) attn_unit3<1>(a, lds, u >> 3, u & 7, TL + (u >> 3) * CTXL, CTXL / 64, false);
}

#ifndef SSD_YREP
#define SSD_YREP 1
#endif
#ifndef SSD_WREP
#define SSD_WREP 1
#endif
constexpr int SP_B = 272, SP_X = 192;
constexpr int SO_B = 0, SO_C = SO_B + 128 * SP_B, SO_XD = SO_C + 128 * SP_B, SO_XW = SO_XD + 128 * SP_X, SO_S = SO_XW + 128 * SP_X, SO_V = SO_S + 64 * SP_B;
static_assert(SO_V + 2 * 2048 <= LDS_BYTES, "ssd lds map");
#ifdef SSD_DIAG
#define SSD_T(v) long long v = clock64()
#define SSD_ACC(k, v) do { const long long n_ = clock64(); dacc[k] += n_ - v; v = n_; } while (0)
#else
#define SSD_T(v) do {} while (0)
#define SSD_ACC(k, v) do {} while (0)
#endif
__device__ __forceinline__ void ssd_scan_mfma(const Args& a, int i, bool last, LAS unsigned char* lds) {
#ifdef SSD_DIAG
    long long dacc[8] = {0, 0, 0, 0, 0, 0, 0, 0};
#endif
    const int tid = otid(a.wv), wave = tid >> 6, lane = tid & 63, r32 = lane & 31, hh = lane >> 5;
    const int pt = wave >> 2, lt = pt ? 3 - (wave & 3) : (wave & 3);
    const int tq = (lane >> 2) & 3, tp = lane & 3, tblk = (lane >> 4) & 1;
    bf16* ZX = (bf16*)(a.ws + WS_ZX); const bf16* XBC = (const bf16*)(a.ws + WS_XBC); const float* DT = (const float*)(a.ws + WS_DT); const float* AA = (const float*)(a.ws + WS_AA);
    LAS unsigned char* Bl = lds + SO_B; LAS unsigned char* Cl = lds + SO_C; LAS unsigned char* XDl = lds + SO_XD; LAS unsigned char* XWl = lds + SO_XW; LAS unsigned char* Sl = lds + SO_S;
    const int brow = tid >> 4, bpart = tid & 15, xrow = tid >> 3, xpart = tid & 7;
    for (int it = blockIdx.x; it < NB * 32; it += gridDim.x) {
        const int b = it >> 5, h = it & 31, g = h >> 3; const float dsk = a.in[I_SD][i * 32 + h];
        for (int dir = 0; dir < 2; ++dir) {
            const int scanw = dir == 0 ? 0 : 3;
            f32x16 sacc;
#pragma unroll
            for (int k = 0; k < 16; ++k) sacc[k] = 0.f;
            SSD_T(tprev);
            v4u bq[4], cq[4], xq[2]; float pa0 = 0.f, pa1 = 0.f, pd0 = 0.f, pd1 = 0.f, qa0 = 0.f, qa1 = 0.f, qd0 = 0.f, qd1 = 0.f; v2u add[4], addn[4];
#define SSD_ROWBASE(c) ((c) < 2 ? TL + b * CTXL + (dir == 0 ? (c) : 1 - (c)) * 128 : b * SEQ + (dir == 0 ? (c) - 2 : 17 - (c)) * 128)
#define SSD_PF(c) do { const int rb_ = SSD_ROWBASE(c); \
                _Pragma("unroll") for (int k_ = 0; k_ < 4; ++k_) { const bf16* src_ = XBC + (size_t)(rb_ + brow + 32 * k_) * 3072 + 2048 + g * 128 + bpart * 8; bq[k_] = *(const v4u*)src_; cq[k_] = *(const v4u*)(src_ + 512); } \
                _Pragma("unroll") for (int k_ = 0; k_ < 2; ++k_) xq[k_] = *(const v4u*)(XBC + (size_t)(rb_ + xrow + 64 * k_) * 3072 + h * 64 + xpart * 8); \
                } while (0)
#define SSD_PFV(c) do { if (wave == scanw) { const int rb_ = SSD_ROWBASE(c); const size_t o_ = (size_t)(rb_ + 2 * lane) * 64 + dir * 32 + h; qa0 = AA[o_]; qa1 = AA[o_ + 64]; qd0 = DT[o_]; qd1 = DT[o_ + 64]; } } while (0)
#define SSD_PFY(c) do { const int rb_ = SSD_ROWBASE(c); const size_t r_ = (size_t)(rb_ + 32 * lt + r32); \
                _Pragma("unroll") for (int q_ = 0; q_ < 4; ++q_) addn[q_] = dir == 0 ? *(const v2u*)(XBC + r_ * 3072 + h * 64 + 32 * pt + 4 * hh + 8 * q_) : *(const v2u*)(ZX + r_ * SSD_INP + 2048 + h * 64 + 32 * pt + 4 * hh + 8 * q_); } while (0)
#define SSD_SCAN(vb_) do { if (wave == scanw) { LAS float* V_ = (LAS float*)(lds + SO_V + (vb_) * 2048); const float pair_ = pa0 + pa1; float ps_ = pair_; \
                _Pragma("unroll") for (int d_ = 1; d_ < 64; d_ <<= 1) { const int src_ = dir == 0 ? lane - d_ : lane + d_; const float t_ = __builtin_bit_cast(float, __builtin_amdgcn_ds_bpermute((src_ & 63) << 2, __builtin_bit_cast(int, ps_))); if (src_ >= 0 && src_ < 64) ps_ += t_; } \
                const float tot_ = __builtin_bit_cast(float, __builtin_amdgcn_ds_bpermute((dir == 0 ? 63 : 0) << 2, __builtin_bit_cast(int, ps_))); const float ex_ = ps_ - pair_; \
                float c0_, c1_; if (dir == 0) { c0_ = ex_ + pa0; c1_ = c0_ + pa1; } else { c1_ = ex_ + pa1; c0_ = c1_ + pa0; } \
                V_[2 * lane] = c0_; V_[2 * lane + 1] = c1_; V_[128 + 2 * lane] = pd0; V_[128 + 2 * lane + 1] = pd1; V_[256 + 2 * lane] = pd0 * __expf(tot_ - c0_); V_[256 + 2 * lane + 1] = pd1 * __expf(tot_ - c1_); \
                if (lane == 0) V_[384] = tot_; } } while (0)
#define SSD_WRITE(vb_) do { const LAS float* V_ = (const LAS float*)(lds + SO_V + (vb_) * 2048); \
                _Pragma("unroll") for (int k_ = 0; k_ < 4; ++k_) { *(LAS v4u*)(Bl + (brow + 32 * k_) * SP_B + bpart * 16) = bq[k_]; *(LAS v4u*)(Cl + (brow + 32 * k_) * SP_B + bpart * 16) = cq[k_]; } \
                _Pragma("unroll") for (int k_ = 0; k_ < 2; ++k_) { const int s_ = xrow + 64 * k_; const float dt_ = V_[128 + s_], w_ = V_[256 + s_]; float f_[8], g_[8]; unpack8(xq[k_], f_); \
                    _Pragma("unroll") for (int j_ = 0; j_ < 8; ++j_) { g_[j_] = f_[j_] * w_; f_[j_] *= dt_; } \
                    *(LAS v4u*)(XDl + s_ * SP_X + xpart * 16) = pack8(f_); *(LAS v4u*)(XWl + s_ * SP_X + xpart * 16) = pack8(g_); } } while (0)
            __syncthreads();
            SSD_PFV(0); pa0 = qa0; pa1 = qa1; pd0 = qd0; pd1 = qd1; SSD_PFV(1); SSD_PFY(0); SSD_PF(0);
            { const float t0_ = qa0, t1_ = qa1, t2_ = qd0, t3_ = qd1; SSD_SCAN(0); pa0 = t0_; pa1 = t1_; pd0 = t2_; pd1 = t3_; }
#pragma unroll
            for (int q = 0; q < 4; ++q) add[q] = addn[q];
            __syncthreads();
            SSD_WRITE(0);
            { LAS v2u* sp = (LAS v2u*)(Sl + (32 * pt + r32) * SP_B + (32 * lt + 4 * hh) * 2);
#pragma unroll
              for (int q = 0; q < 4; ++q) sp[2 * q] = (v2u){0u, 0u}; }
            __syncthreads();
            SSD_ACC(0, tprev);
            for (int c = 0; c < 18; ++c) {
                const int cur = c & 1; const LAS float* V = (const LAS float*)(lds + SO_V + cur * 2048);
                const int rowbase = SSD_ROWBASE(c); const bool want_y = !(last && c < 2);
                if (c + 1 < 18) { if (!(last && c + 1 < 2)) SSD_PFY(c + 1); if (c + 2 < 18) SSD_PFV(c + 2); SSD_PF(c + 1); }
                SSD_ACC(1, tprev);
                for (int yrep = 0; yrep < SSD_YREP; ++yrep)
                if (want_y) {
                    const int l = 32 * lt + r32; const float cl = V[l];
                    bf16* yptr = ZX + (size_t)(rowbase + l) * SSD_INP + 2048 + h * 64 + 32 * pt + 4 * hh;
                    bf16x8 cf[8];
#pragma unroll
                    for (int ks = 0; ks < 8; ++ks) cf[ks] = *(const LAS bf16x8*)(Cl + l * SP_B + (16 * ks + 8 * hh) * 2);
                    f32x16 y1, y2;
#pragma unroll
                    for (int k = 0; k < 16; ++k) { y1[k] = 0.f; y2[k] = 0.f; }
                    const int st_lo = dir == 0 ? 0 : lt, st_hi = dir == 0 ? lt : 3;
#pragma unroll
                    for (int st = 0; st < 4; ++st) if (st >= st_lo && st <= st_hi) {
                        f32x16 X;
#pragma unroll
                        for (int k = 0; k < 16; ++k) X[k] = 0.f;
#pragma unroll
                        for (int ks = 0; ks < 8; ++ks) { const bf16x8 af = *(const LAS bf16x8*)(Bl + (32 * st + r32) * SP_B + (16 * ks + 8 * hh) * 2); X = __builtin_amdgcn_mfma_f32_32x32x16_bf16(af, cf[ks], X, 0, 0, 0); }
#pragma unroll
                        for (int q = 0; q < 4; ++q) { const f32x4 cs = *(const LAS f32x4*)(V + 32 * st + 8 * q + 4 * hh);
#pragma unroll
                            for (int e = 0; e < 4; ++e) { const int s = 32 * st + 8 * q + 4 * hh + e; const bool ok = dir == 0 ? (s <= l) : (s >= l);
                                const float dec = __expf(fminf(cl - cs[e], 0.f)); X[4 * q + e] = ok ? X[4 * q + e] * dec : 0.f; } }
#pragma unroll
                        for (int ks2 = 0; ks2 < 2; ++ks2) { v4u w; w.x = cvtpk(X[8 * ks2 + 0], X[8 * ks2 + 1]); w.y = cvtpk(X[8 * ks2 + 2], X[8 * ks2 + 3]); w.z = cvtpk(X[8 * ks2 + 4], X[8 * ks2 + 5]); w.w = cvtpk(X[8 * ks2 + 6], X[8 * ks2 + 7]);
                            const LAS unsigned char* tb = XDl + (32 * st + 16 * ks2 + 4 * hh + tq) * SP_X + (32 * pt + 16 * tblk + 4 * tp) * 2;
                            const v2u lo = trread(tb), hi = trread(tb + 8 * SP_X);
                            y1 = __builtin_amdgcn_mfma_f32_32x32x16_bf16(__builtin_bit_cast(bf16x8, (v4u){lo.x, lo.y, hi.x, hi.y}), __builtin_bit_cast(bf16x8, w), y1, 0, 0, 0); }
                    }
#pragma unroll
                    for (int ks = 0; ks < 8; ++ks) { const bf16x8 sf = *(const LAS bf16x8*)(Sl + (32 * pt + r32) * SP_B + (16 * ks + 8 * hh) * 2); y2 = __builtin_amdgcn_mfma_f32_32x32x16_bf16(sf, cf[ks], y2, 0, 0, 0); }
                    const float el = __expf(cl);
#pragma unroll
                    for (int q = 0; q < 4; ++q) { float o[4];
#pragma unroll
                        for (int e = 0; e < 4; ++e) o[e] = y1[4 * q + e] + el * y2[4 * q + e];
                        const float a0 = bflo(add[q].x), a1 = bfhi(add[q].x), a2 = bflo(add[q].y), a3 = bfhi(add[q].y);
                        if (dir == 0) { o[0] += dsk * a0; o[1] += dsk * a1; o[2] += dsk * a2; o[3] += dsk * a3; } else { o[0] += a0; o[1] += a1; o[2] += a2; o[3] += a3; }
                        v2u w; w.x = pk2(o[0], o[1]); w.y = pk2(o[2], o[3]); *(v2u*)(yptr + 8 * q) = w; }
                }
                SSD_ACC(2, tprev);
                if (c + 1 < 18) {
                    const float etot = __expf(V[384]);
#pragma unroll
                    for (int k = 0; k < 16; ++k) sacc[k] *= etot;
#pragma unroll
                    for (int ks = 0; ks < 8; ++ks) {
                        const LAS unsigned char* ta = Bl + (16 * ks + 8 * hh + tq) * SP_B + (32 * lt + 16 * tblk + 4 * tp) * 2;
                        const LAS unsigned char* tb = XWl + (16 * ks + 8 * hh + tq) * SP_X + (32 * pt + 16 * tblk + 4 * tp) * 2;
                        const v2u alo = trread(ta), ahi = trread(ta + 4 * SP_B), blo = trread(tb), bhi = trread(tb + 4 * SP_X);
                        sacc = __builtin_amdgcn_mfma_f32_32x32x16_bf16(__builtin_bit_cast(bf16x8, (v4u){alo.x, alo.y, ahi.x, ahi.y}), __builtin_bit_cast(bf16x8, (v4u){blo.x, blo.y, bhi.x, bhi.y}), sacc, 0, 0, 0); }
                    SSD_SCAN(cur ^ 1); pa0 = qa0; pa1 = qa1; pd0 = qd0; pd1 = qd1;
                }
                SSD_ACC(3, tprev);
                __syncthreads();
                SSD_ACC(4, tprev);
                if (c + 1 < 18) {
                    LAS v2u* sp = (LAS v2u*)(Sl + (32 * pt + r32) * SP_B + (32 * lt + 4 * hh) * 2);
#pragma unroll
                    for (int q = 0; q < 4; ++q) { v2u w; w.x = cvtpk(sacc[4 * q], sacc[4 * q + 1]); w.y = cvtpk(sacc[4 * q + 2], sacc[4 * q + 3]); sp[2 * q] = w; }
                    for (int wrep = 0; wrep < SSD_WREP; ++wrep) { SSD_WRITE(cur ^ 1); }
#pragma unroll
                    for (int q = 0; q < 4; ++q) add[q] = addn[q];
                }
                SSD_ACC(5, tprev);
                __syncthreads();
                SSD_ACC(6, tprev);
            }
#undef SSD_ROWBASE
#undef SSD_PF
#undef SSD_PFV
#undef SSD_PFY
#undef SSD_SCAN
#undef SSD_WRITE
            asm volatile("s_waitcnt vmcnt(0)" ::: "memory");
        }
    }
#ifdef SSD_DIAG
    if (blockIdx.x == 0 && wave == SSD_DIAG_WAVE && lane == 0 && i == 0) { float* dg = (float*)(a.ws + WS_MOD + 900 * 1024); long long tot = 0;
        for (int k = 0; k < 7; ++k) tot += dacc[k];
        for (int k = 0; k < 7; ++k) dg[k] = (float)dacc[k]; dg[7] = (float)tot; }
#endif
}

constexpr int AT2_KP = 208, AT2_VP = 192, AT2_KB = 64 * AT2_KP, AT2_VB = 64 * AT2_VP, AT2_BUF = AT2_KB + AT2_VB;
template <int NQ>
__device__ __forceinline__ void attn_unit2(const Args& a, LAS unsigned char* lds, int b, int h, int q0, int ntiles, bool lat) {
    const int tid = otid(a.wv), wave = tid >> 6, lane = tid & 63, r32 = lane & 31, hh = lane >> 5;
    const int tq = (lane >> 2) & 3, tp = lane & 3, tblk = (lane >> 4) & 1;
    const bf16* Qb = (const bf16*)(a.ws + WS_Q); const bf16* KVb = (const bf16*)(a.ws + WS_KV); const bf16* KR = (const bf16*)(a.ws + WS_KR); bf16* MIX = (bf16*)(a.ws + WS_MIX);
    const float* ct = (const float*)(a.ws + WS_ROPE); const float* st = ct + SEQ * 16;
    bf16x8 qf[NQ][6];
#pragma unroll
    for (int nq = 0; nq < NQ; ++nq) { const int qrow = q0 + wave * (32 * NQ) + nq * 32 + r32;
#pragma unroll
        for (int s = 0; s < 6; ++s) qf[nq][s] = *(const bf16x8*)(Qb + (size_t)qrow * QW + h * 96 + 16 * s + 8 * hh);
        if (lat) { const int t = qrow & (SEQ - 1);
#pragma unroll
            for (int j = 0; j < 8; j += 2) { float y1[2], y2[2];
#pragma unroll
                for (int e = 0; e < 2; ++e) { const float x1 = bf1((bf16)qf[nq][4][j + e]), x2 = bf1((bf16)qf[nq][5][j + e]); const float c = ct[t * 16 + 8 * hh + j + e], s = st[t * 16 + 8 * hh + j + e];
                    y1[e] = x1 * c - x2 * s; y2[e] = x1 * s + x2 * c; }
                const unsigned w1 = pk2(y1[0], y1[1]), w2 = pk2(y2[0], y2[1]);
                qf[nq][4][j] = (short)(w1 & 0xffff); qf[nq][4][j + 1] = (short)(w1 >> 16); qf[nq][5][j] = (short)(w2 & 0xffff); qf[nq][5][j + 1] = (short)(w2 >> 16); } }
        asm volatile("" : "+v"(qf[nq][0]), "+v"(qf[nq][1]), "+v"(qf[nq][2]), "+v"(qf[nq][3]), "+v"(qf[nq][4]), "+v"(qf[nq][5]) :: "memory"); }
    f32x16 o[NQ][2]; float m[NQ], l[NQ];
#pragma unroll
    for (int nq = 0; nq < NQ; ++nq) { m[nq] = -1e30f; l[nq] = 0.f;
#pragma unroll
        for (int i = 0; i < 16; ++i) { o[nq][0][i] = 0.f; o[nq][1][i] = 0.f; } }
    v4u kreg0, kreg1, vreg;
#define AT2_LOAD(it, tt) do { const unsigned off_kv = (unsigned)(((tt) >> 3) * (KVW * 2) + h * 256 + ((tt) & 7) * 16), off_kr = (unsigned)(((tt) >> 2) * 64 + ((tt) & 3) * 16); const bool k1ok = (tt) < 256; const int rb_ = (it) < CTXL / 64 ? TL + b * CTXL + (it) * 64 : b * SEQ + ((it) - CTXL / 64) * 64; \
        const char* kvb_ = (const char*)(KVb + (size_t)rb_ * KVW); const char* krb_ = (const char*)(KR + (size_t)rb_ * 32); \
        kreg0 = *(const v4u*)(kvb_ + off_kv); vreg = *(const v4u*)(kvb_ + off_kv + 128); if (k1ok) kreg1 = *(const v4u*)(krb_ + off_kr); } while (0)
#define AT2_WRITE(buf, tt) do { LAS unsigned char* kb_ = lds + (buf) * AT2_BUF; \
        *(LAS v4u*)(kb_ + ((tt) >> 3) * AT2_KP + ((tt) & 7) * 16) = kreg0; if ((tt) < 256) *(LAS v4u*)(kb_ + ((tt) >> 2) * AT2_KP + 128 + ((tt) & 3) * 16) = kreg1; \
        *(LAS v4u*)(kb_ + AT2_KB + ((tt) >> 3) * AT2_VP + ((tt) & 7) * 16) = vreg; } while (0)
    __syncthreads();
    AT2_LOAD(0, tid); AT2_WRITE(0, tid);
    __syncthreads();
    for (int it = 0; it < ntiles; ++it) {
        int tz = tid; asm volatile("" : "+v"(tz));
        const int lane_ = tz & 63, r32_ = lane_ & 31, hh_ = lane_ >> 5, tq_ = (lane_ >> 2) & 3, tp_ = lane_ & 3, tblk_ = (lane_ >> 4) & 1;
#ifdef ATT_LOADTOP
        if (it + 1 < ntiles) AT2_LOAD(it + 1, tz);
#endif
        const LAS unsigned char* kb = lds + (it & 1) * AT2_BUF; const LAS unsigned char* vb = kb + AT2_KB;
        bf16x8 pf[NQ][2][2];
        f32x16 sc[NQ][2];
#pragma unroll
        for (int nq = 0; nq < NQ; ++nq)
#pragma unroll
            for (int i = 0; i < 16; ++i) { sc[nq][0][i] = 0.f; sc[nq][1][i] = 0.f; }
#pragma unroll
        for (int s = 0; s < 6; ++s) { const bf16x8 a0 = *(const LAS bf16x8*)(kb + r32_ * AT2_KP + (16 * s + 8 * hh_) * 2); const bf16x8 a1 = *(const LAS bf16x8*)(kb + (32 + r32_) * AT2_KP + (16 * s + 8 * hh_) * 2);
#pragma unroll
            for (int nq = 0; nq < NQ; ++nq) { sc[nq][0] = __builtin_amdgcn_mfma_f32_32x32x16_bf16(a0, qf[nq][s], sc[nq][0], 0, 0, 0); sc[nq][1] = __builtin_amdgcn_mfma_f32_32x32x16_bf16(a1, qf[nq][s], sc[nq][1], 0, 0, 0); } }
#pragma unroll
        for (int nq = 0; nq < NQ; ++nq) {
            f32x16& s0 = sc[nq][0]; f32x16& s1 = sc[nq][1];
            float mx = s0[0];
#pragma unroll
            for (int i = 1; i < 16; ++i) mx = fmaxf(mx, s0[i]);
#pragma unroll
            for (int i = 0; i < 16; ++i) mx = fmaxf(mx, s1[i]);
            mx = fmaxf(mx, shx(mx, 32, lane_));
            const float mn = fmaxf(m[nq], mx * ATT_SCALE_LOG2E); const float alpha = __builtin_amdgcn_exp2f(m[nq] - mn); m[nq] = mn;
            float rs = 0.f;
#pragma unroll
            for (int i = 0; i < 16; ++i) { s0[i] = __builtin_amdgcn_exp2f(s0[i] * ATT_SCALE_LOG2E - mn); s1[i] = __builtin_amdgcn_exp2f(s1[i] * ATT_SCALE_LOG2E - mn); rs += s0[i] + s1[i]; }
            l[nq] = l[nq] * alpha + rs;
#pragma unroll
            for (int i = 0; i < 16; ++i) { o[nq][0][i] *= alpha; o[nq][1][i] *= alpha; }
#pragma unroll
            for (int s2 = 0; s2 < 2; ++s2) { v4u w0, w1;
                w0.x = cvtpk(s0[8 * s2 + 0], s0[8 * s2 + 1]); w0.y = cvtpk(s0[8 * s2 + 2], s0[8 * s2 + 3]); w0.z = cvtpk(s0[8 * s2 + 4], s0[8 * s2 + 5]); w0.w = cvtpk(s0[8 * s2 + 6], s0[8 * s2 + 7]);
                w1.x = cvtpk(s1[8 * s2 + 0], s1[8 * s2 + 1]); w1.y = cvtpk(s1[8 * s2 + 2], s1[8 * s2 + 3]); w1.z = cvtpk(s1[8 * s2 + 4], s1[8 * s2 + 5]); w1.w = cvtpk(s1[8 * s2 + 6], s1[8 * s2 + 7]);
                pf[nq][0][s2] = __builtin_bit_cast(bf16x8, w0); pf[nq][1][s2] = __builtin_bit_cast(bf16x8, w1); }
        }
#ifndef ATT_LOADTOP
        if (it + 1 < ntiles) AT2_LOAD(it + 1, tz);
#endif
#pragma unroll
        for (int t = 0; t < 2; ++t)
#pragma unroll
            for (int s2 = 0; s2 < 2; ++s2)
#pragma unroll
                for (int dt = 0; dt < 2; ++dt) {
                    const LAS unsigned char* tb = vb + (t * 32 + 16 * s2 + 4 * hh_ + tq_) * AT2_VP + (32 * dt + 16 * tblk_ + 4 * tp_) * 2;
#ifdef ATT_NOTR
                    bf16x8 vf; { const LAS unsigned short* vp_ = (const LAS unsigned short*)(vb + (t * 32 + 16 * s2 + 4 * hh_) * AT2_VP + (32 * dt + r32_) * 2);
#pragma unroll
                      for (int j_ = 0; j_ < 8; ++j_) vf[j_] = (short)vp_[((j_ & 3) + 8 * (j_ >> 2)) * (AT2_VP / 2)]; }
#else
                    const v2u lo = trread(tb), hi = trread(tb + 8 * AT2_VP); const bf16x8 vf = __builtin_bit_cast(bf16x8, (v4u){lo.x, lo.y, hi.x, hi.y});
#endif
#pragma unroll
                    for (int nq = 0; nq < NQ; ++nq) o[nq][dt] = __builtin_amdgcn_mfma_f32_32x32x16_bf16(vf, pf[nq][t][s2], o[nq][dt], 0, 0, 0); }
        if (it + 1 < ntiles) AT2_WRITE((it + 1) & 1, tz);
        __syncthreads();
    }
#undef AT2_LOAD
#undef AT2_WRITE
#pragma unroll
    for (int nq = 0; nq < NQ; ++nq) { int qrow = q0 + wave * (32 * NQ) + nq * 32 + r32; asm volatile("" : "+v"(qrow));
        const float lt = l[nq] + shx(l[nq], 32, lane); const float inv = 1.f / lt;
        bf16* orow = MIX + (size_t)qrow * D + h * 64 + 4 * hh;
#pragma unroll
        for (int g = 0; g < 4; ++g) {
            v2u w; w.x = pk2(o[nq][0][4 * g] * inv, o[nq][0][4 * g + 1] * inv); w.y = pk2(o[nq][0][4 * g + 2] * inv, o[nq][0][4 * g + 3] * inv); *(v2u*)(orow + 8 * g) = w;
            v2u x; x.x = pk2(o[nq][1][4 * g] * inv, o[nq][1][4 * g + 1] * inv); x.y = pk2(o[nq][1][4 * g + 2] * inv, o[nq][1][4 * g + 3] * inv); *(v2u*)(orow + 32 + 8 * g) = x; } }
}
__device__ __forceinline__ void attn_mfma2(const Args& a, LAS unsigned char* lds) {
#ifdef ATT_NQ1
    for (int u = blockIdx.x; u < 512; u += gridDim.x) attn_unit2<1>(a, lds, u >> 6, (u >> 3) & 7, (u >> 6) * SEQ + (u & 7) * 256, (CTXL + SEQ) / 64, true);
#else
    for (int u = blockIdx.x; u < 256; u += gridDim.x) attn_unit2<2>(a, lds, u >> 5, (u >> 2) & 7, (u >> 5) * SEQ + (u & 3) * 512, (CTXL + SEQ) / 64, true);
#endif
    for (int u = blockIdx.x; u < 64; u += gridDim.x) attn_unit2<1>(a, lds, u >> 3, u & 7, TL + (u >> 3) * CTXL, CTXL / 64, false);
}

template <int R>
__device__ __forceinline__ void rowwise2(const float* xs_lat, const float* xs_ctx, float* xd_lat, float* xd_ctx, const bf16* Mb, const float* modg, const float* nwA,
                                         bf16* H, const float* modh, int sh_off, int sc_off, const float* nwB, int nrows, int wv) {
    const int tid = otid(wv), wave = wv, lane = tid & 63; const int NGW = gridDim.x * NWAVES, gw = blockIdx.x * NWAVES + wave;
    const int rpw = (nrows + NGW - 1) / NGW; const int rbeg = gw * rpw, rend = min(rbeg + rpw, nrows);
    for (int r0 = rbeg; r0 < rend; r0 += R) {
        f32x4 v[R][4]; v2u mm[R][4];
#pragma unroll
        for (int j = 0; j < R; ++j) { const int r = min(r0 + j, rend - 1); const float* xs = r < TL ? xs_lat + (size_t)r * D : xs_ctx + (size_t)(r - TL) * D;
#pragma unroll
            for (int q = 0; q < 4; ++q) v[j][q] = *(const f32x4*)(xs + q * 256 + lane * 4);
            if (Mb) {
#pragma unroll
                for (int q = 0; q < 4; ++q) mm[j][q] = *(const v2u*)(Mb + (size_t)r * D + q * 256 + lane * 4); } }
#pragma unroll
        for (int j = 0; j < R; ++j) { const int r = r0 + j; if (r < rend) {
            const bool lat = r < TL; const int cond = lat ? (r >> 11) : 8; float* xd = lat ? xd_lat + (size_t)r * D : xd_ctx + (size_t)(r - TL) * D;
            if (Mb) {
                f32x4 m[4]; float ss = 0.f;
#pragma unroll
                for (int q = 0; q < 4; ++q) { const v2u w = mm[j][q]; m[q] = (f32x4){bflo(w.x), bfhi(w.x), bflo(w.y), bfhi(w.y)}; ss += (m[q][0] * m[q][0] + m[q][1] * m[q][1]) + (m[q][2] * m[q][2] + m[q][3] * m[q][3]); }
                const float rs = rsqrtf(wave_sum(ss, lane) * (1.f / D) + EPS);
#pragma unroll
                for (int q = 0; q < 4; ++q) { const f32x4 g = *(const f32x4*)(modg + (size_t)cond * MODW + q * 256 + lane * 4); const f32x4 w = *(const f32x4*)(nwA + q * 256 + lane * 4);
                    v[j][q] = v[j][q] + g * (m[q] * rs * w); }
            }
#pragma unroll
            for (int q = 0; q < 4; ++q) *(f32x4*)(xd + q * 256 + lane * 4) = v[j][q];
            if (H) {
                float ss = 0.f;
#pragma unroll
                for (int q = 0; q < 4; ++q) ss += (v[j][q][0] * v[j][q][0] + v[j][q][1] * v[j][q][1]) + (v[j][q][2] * v[j][q][2] + v[j][q][3] * v[j][q][3]);
                const float rs = rsqrtf(wave_sum(ss, lane) * (1.f / D) + EPS);
#pragma unroll
                for (int q = 0; q < 4; ++q) { const int c = q * 256 + lane * 4;
                    const f32x4 w = *(const f32x4*)(nwB + c); const f32x4 sc = *(const f32x4*)(modh + (size_t)cond * MODW + sc_off + c); const f32x4 sh = *(const f32x4*)(modh + (size_t)cond * MODW + sh_off + c);
                    const f32x4 hv = (v[j][q] * rs * w) * (sc + 1.0f) + sh;
                    v2u o; o.x = pk2(hv[0], hv[1]); o.y = pk2(hv[2], hv[3]); *(v2u*)(H + (size_t)r * D + c) = o; }
            } } }
    }
}

__device__ __forceinline__ void convgate2(const Args& a, int l, int nrows) {
    const bf16* U = (const bf16*)(a.ws + WS_U); bf16* G = (bf16*)(a.ws + WS_G); const float* cw = a.in[I_FCONV] + (size_t)l * 3 * UPW;
    const int total = (nrows / 8) * (DFF / 8);
    for (int idx = blockIdx.x * NTHR + otid(a.wv); idx < total; idx += gridDim.x * NTHR) {
        const int r0 = (idx / (DFF / 8)) * 8, c0 = (idx % (DFF / 8)) * 8; const bf16* u = U + (size_t)r0 * UPW + c0;
        const bool hp = has_prev(r0), hn = has_next(r0 + 7);
        v4u ua[10], ug[10];
#pragma unroll
        for (int j = 0; j < 10; ++j) { const int rr = (j == 0 && !hp) ? 0 : ((j == 9 && !hn) ? 7 : j - 1); ua[j] = *(const v4u*)(u + (ptrdiff_t)rr * UPW); ug[j] = *(const v4u*)(u + (ptrdiff_t)rr * UPW + DFF); }
        float wa[3][8], wg[3][8];
#pragma unroll
        for (int t = 0; t < 3; ++t)
#pragma unroll
            for (int j = 0; j < 8; ++j) { wa[t][j] = cw[t * UPW + c0 + j]; wg[t][j] = cw[t * UPW + DFF + c0 + j]; }
        if (!hp) { ua[0] = (v4u){0u, 0u, 0u, 0u}; ug[0] = ua[0]; }
        if (!hn) { ua[9] = (v4u){0u, 0u, 0u, 0u}; ug[9] = ua[9]; }
        float pa[8], ca[8], na[8], pg[8], cg_[8], ng[8];
        unpack8(ua[0], pa); unpack8(ug[0], pg); unpack8(ua[1], ca); unpack8(ug[1], cg_);
#pragma unroll
        for (int j = 0; j < 8; ++j) {
            unpack8(ua[j + 2], na); unpack8(ug[j + 2], ng);
            float o[8];
#pragma unroll
            for (int k = 0; k < 8; ++k) { const float act = wa[0][k] * pa[k] + wa[1][k] * ca[k] + wa[2][k] * na[k]; const float gate = wg[0][k] * pg[k] + wg[1][k] * cg_[k] + wg[2][k] * ng[k]; o[k] = silu_f(act) * gate; }
            *(v4u*)(G + (size_t)(r0 + j) * DFF + c0) = pack8(o);
#pragma unroll
            for (int k = 0; k < 8; ++k) { pa[k] = ca[k]; ca[k] = na[k]; pg[k] = cg_[k]; cg_[k] = ng[k]; }
        }
    }
}

__device__ __forceinline__ void ssd_conv2(const Args& a, int i) {
    const bf16* ZX = (const bf16*)(a.ws + WS_ZX); bf16* XBC = (bf16*)(a.ws + WS_XBC); float* DT = (float*)(a.ws + WS_DT); float* AA = (float*)(a.ws + WS_AA);
    const float* cw = a.in[I_SCONVW] + (size_t)i * 3 * 3072; const float* cb = a.in[I_SCONVB] + (size_t)i * 3072;
    const int total = (T / 8) * 384;
    for (int idx = blockIdx.x * NTHR + otid(a.wv); idx < total; idx += gridDim.x * NTHR) {
        const int r0 = (idx / 384) * 8, c0 = (idx % 384) * 8; const bf16* u = ZX + (size_t)r0 * SSD_INP + 2048 + c0;
        const bool hp = has_prev(r0), hn = has_next(r0 + 7);
        v4u ux[10];
#pragma unroll
        for (int j = 0; j < 10; ++j) { const int rr = (j == 0 && !hp) ? 0 : ((j == 9 && !hn) ? 7 : j - 1); ux[j] = *(const v4u*)(u + (ptrdiff_t)rr * SSD_INP); }
        float w[3][8], bias[8];
#pragma unroll
        for (int j = 0; j < 8; ++j) { w[0][j] = cw[c0 + j]; w[1][j] = cw[3072 + c0 + j]; w[2][j] = cw[2 * 3072 + c0 + j]; bias[j] = cb[c0 + j]; }
        if (!hp) ux[0] = (v4u){0u, 0u, 0u, 0u};
        if (!hn) ux[9] = (v4u){0u, 0u, 0u, 0u};
        float p[8], c[8], n[8];
        unpack8(ux[0], p); unpack8(ux[1], c);
#pragma unroll
        for (int j = 0; j < 8; ++j) {
            unpack8(ux[j + 2], n); float o[8];
#pragma unroll
            for (int k = 0; k < 8; ++k) o[k] = silu_f(bias[k] + w[0][k] * p[k] + w[1][k] * c[k] + w[2][k] * n[k]);
            *(v4u*)(XBC + (size_t)(r0 + j) * 3072 + c0) = pack8(o);
#pragma unroll
            for (int k = 0; k < 8; ++k) { p[k] = c[k]; c[k] = n[k]; }
        }
    }
    const float* alog = a.in[I_ALOG] + i * 64; const float* dtb = a.in[I_DTB] + i * 64;
    for (int idx = blockIdx.x * NTHR + otid(a.wv); idx < T * 64; idx += gridDim.x * NTHR) {
        const int r = idx >> 6, j = idx & 63; const float raw = bf1(ZX[(size_t)r * SSD_INP + 5120 + j]) + dtb[j];
        const float dt = raw > 15.f ? raw : (raw < -15.f ? __expf(raw) : __logf(1.f + __expf(raw)));
        DT[idx] = dt; AA[idx] = -__expf(alog[j]) * dt;
    }
}

__device__ __forceinline__ void gatenorm2(const Args& a, int i, int nrows) {
    const int tid = otid(a.wv), wave = a.wv, lane = tid & 63; const int NGW = gridDim.x * NWAVES, gw = blockIdx.x * NWAVES + wave;
    const bf16* ZX = (const bf16*)(a.ws + WS_ZX); bf16* YN = (bf16*)(a.ws + WS_XBC); const float* nw = a.in[I_SNORM] + i * 2048;
    const int rpw = (nrows + NGW - 1) / NGW; const int rbeg = gw * rpw, rend = min(rbeg + rpw, nrows);
    constexpr int R = 3;
    for (int r0 = rbeg; r0 < rend; r0 += R) {
        v4u yv[R][4], zv[R][4];
#pragma unroll
        for (int j = 0; j < R; ++j) { const int r = min(r0 + j, rend - 1);
#pragma unroll
            for (int q = 0; q < 4; ++q) { const int c = q * 512 + lane * 8; yv[j][q] = *(const v4u*)(ZX + (size_t)r * SSD_INP + 2048 + c); zv[j][q] = *(const v4u*)(ZX + (size_t)r * SSD_INP + c); } }
#pragma unroll
        for (int j = 0; j < R; ++j) { const int r = r0 + j; if (r < rend) {
            float v[4][8]; float ss = 0.f;
#pragma unroll
            for (int q = 0; q < 4; ++q) { float y[8], z[8]; unpack8(yv[j][q], y); unpack8(zv[j][q], z);
#pragma unroll
                for (int k = 0; k < 8; ++k) { v[q][k] = y[k] * silu_f(z[k]); ss += v[q][k] * v[q][k]; } }
            const float rs = rsqrtf(wave_sum(ss, lane) * (1.f / 2048.f) + EPS);
#pragma unroll
            for (int q = 0; q < 4; ++q) { const int c = q * 512 + lane * 8; float o[8];
#pragma unroll
                for (int k = 0; k < 8; ++k) o[k] = v[q][k] * rs * nw[c + k];
                *(v4u*)(YN + (size_t)r * 2048 + c) = pack8(o); } } }
    }
}

__device__ __forceinline__ void ffn_fixup(const Args& a, int l, int nrows) {
    const bf16* Ue = (const bf16*)(a.ws + WS_UE); bf16* G = (bf16*)(a.ws + WS_G); const float* cw = a.in[I_FCONV] + (size_t)l * 3 * UPW;
    const int total = (nrows / 256) * 2 * (DFF / 8);
    for (int idx = blockIdx.x * NTHR + otid(a.wv); idx < total; idx += gridDim.x * NTHR) {
        const int cg = idx % (DFF / 8), which = (idx / (DFF / 8)) & 1, pm = idx / (2 * (DFF / 8)); const int c0 = cg * 8; const int col = (c0 / 128) * 256 + (c0 % 128);
        const int r = pm * 256 + (which ? 255 : 0);
        const bf16* e0 = Ue + (size_t)(pm * 4) * UPW + col;
        const bf16* pp = which ? e0 + 2 * UPW : e0 - UPW;
        const bf16* pc = which ? e0 + 3 * UPW : e0;
        const bf16* pn = which ? e0 + 4 * UPW : e0 + UPW;
        const bool hp = which ? true : has_prev(r), hn = which ? has_next(r) : true;
        float pa[8], pg[8], ca[8], cg_[8], na[8], ng[8];
        unpack8(*(const v4u*)pc, ca); unpack8(*(const v4u*)(pc + 128), cg_);
        if (hp) { unpack8(*(const v4u*)pp, pa); unpack8(*(const v4u*)(pp + 128), pg); } else {
#pragma unroll
            for (int k = 0; k < 8; ++k) { pa[k] = 0.f; pg[k] = 0.f; } }
        if (hn) { unpack8(*(const v4u*)pn, na); unpack8(*(const v4u*)(pn + 128), ng); } else {
#pragma unroll
            for (int k = 0; k < 8; ++k) { na[k] = 0.f; ng[k] = 0.f; } }
        float o[8];
#pragma unroll
        for (int k = 0; k < 8; ++k) { const float act = cw[c0 + k] * pa[k] + cw[UPW + c0 + k] * ca[k] + cw[2 * UPW + c0 + k] * na[k];
            const float gate = cw[DFF + c0 + k] * pg[k] + cw[UPW + DFF + c0 + k] * cg_[k] + cw[2 * UPW + DFF + c0 + k] * ng[k]; o[k] = silu_f(act) * gate; }
        *(v4u*)(G + (size_t)r * DFF + c0) = pack8(o);
    }
}

#ifndef MK_SINGLE
#define MK_SINGLE 1
#endif
struct GemmDesc { const bf16* A; const bf16* Bt; int M, N, K; bf16* O; int ldc; int mode; };

__global__ void __launch_bounds__(NTHR, 2) fwd_kernel(Args a_in) {
    extern __shared__ __attribute__((aligned(16))) unsigned char lds_raw[];
    LAS unsigned char* lds = (LAS unsigned char*)lds_raw;
#if MK_SINGLE == 1
    volatile LAS unsigned* bst = (volatile LAS unsigned*)(lds + LDS_BYTES - 64);
    const int wv0 = __builtin_amdgcn_readfirstlane((int)threadIdx.x >> 6);
    { const int t0 = otid(wv0); if (t0 < 16) bst[t0] = 0u; }
    __syncthreads();
    const XcdBarrier xbar = xcd_barrier_post((unsigned*)(a_in.ws + WS_CTL), bst, wv0);
#endif
    const Args& a0 = a_in;
    for (int s = a0.lo; s < a0.hi; ++s) {
        Args a = a0;
        { long oz; asm volatile("s_mov_b64 %0, 0" : "=s"(oz));
#pragma unroll
          for (int q = 0; q < 25; ++q) a.in[q] = (const float*)((const char*)a0.in[q] + oz);
          a.out = (float*)((char*)a0.out + oz); a.ws = a0.ws + oz; a.wv = wv0; }
        unsigned char* ws = a.ws;
        float* XL = a.out; float* XC = (float*)(ws + WS_XC); bf16* H = (bf16*)(ws + WS_H); bf16* Mb = (bf16*)(ws + WS_M);
        const float* MOD = (const float*)(ws + WS_MOD); const float* NW = a.in[I_NORMW];
        int nrep = 1;
#ifdef PROBE_MASK
        if (s == 0 && (PROBE_MASK >> 20 & 1u)) nrep = 2;
        if (s >= 2) { const int pk = (s - 2) % 10, ppar = ((s - 2) / 10) & 1; if ((PROBE_MASK >> (pk + 10 * ppar)) & 1u) nrep = 2; }
#endif
        for (int rep = 0; rep < nrep; ++rep) {
        GemmDesc g0{}, g1{}; int ng = 0;
#ifndef NO_SIMPLE
        if (s == 0) {
            mod_compute(a, lds);
            rope_tables(a);
            convert_layer(a, 0, lds);
        } else if (s == 1) {
            rowwise2<3>(a.in[I_X], a.in[I_CTX], XL, XC, nullptr, nullptr, nullptr, H, MOD, 0, 1024, NW, T, a.wv);
        } else {
            const int l = (s - 2) / 10, k = (s - 2) % 10, i = l >> 1; const bool even = (l & 1) == 0, last = (l == 3);
            const int MR = last ? TL : T;
            switch (k) {
            case 0:
                if (even) { g0 = GemmDesc{H, (const bf16*)(ws + W_IN), T, HYB_INP, D, (bf16*)(ws + WS_P), HYB_INP}; ng = 1; }
                else      { g0 = GemmDesc{H, (const bf16*)(ws + W_IN), T, SSD_INP, D, (bf16*)(ws + WS_ZX), SSD_INP}; ng = 1; }
                break;
            case 1: if (even) prep_even(a, i); else ssd_conv2(a, i); break;
            case 2:
                if (even) { { g0 = GemmDesc{(const bf16*)(ws + WS_CQN), (const bf16*)(ws + W_UQ), T, QW, 384, (bf16*)(ws + WS_Q), QW}; ng = 1; }
                            g1 = GemmDesc{(const bf16*)(ws + WS_CKVN), (const bf16*)(ws + W_UKV), T, KVW, 256, (bf16*)(ws + WS_KV), KVW}; ng = 2; }
                else {
#ifdef SSD_NAIVE
 ssd_scan_naive(a, i, last, lds);
#else
 ssd_scan_mfma(a, i, last, lds);
#endif
 }
                break;
            case 3: if (even) {
#ifdef ATTN_NAIVE
 attn_naive(a, lds);
#else
 attn_mfma(a, lds);
#endif
 } else gatenorm2(a, i, MR); break;
            case 4:
                if (even) { g0 = GemmDesc{(const bf16*)(ws + WS_MIX), (const bf16*)(ws + W_OUT), MR, D, D, Mb, D}; ng = 1; }
                else      { g0 = GemmDesc{(const bf16*)(ws + WS_XBC), (const bf16*)(ws + W_OUT), MR, D, 2048, Mb, D}; ng = 1; }
                break;
            case 5:
#ifdef PROBE_ROW2
                if (l > 0) rowwise2<3>(XL, XC, XL, XC, nullptr, nullptr, nullptr, H, MOD + (size_t)l * 9 * MODW, 0, 1024, NW + (l * 4 + 0) * D, MR, a.wv);
#endif
                rowwise2<3>(XL, XC, XL, XC, Mb, MOD + (size_t)l * 9 * MODW + 2048, NW + (l * 4 + 1) * D, H, MOD + (size_t)l * 9 * MODW, 3072, 4096, NW + (l * 4 + 2) * D, MR, a.wv); break;
            case 6: { g0 = GemmDesc{H, (const bf16*)(ws + W_UP), MR, UPW, D, (bf16*)(ws + WS_G), DFF, 1}; ng = 1; } break;
            case 7: ffn_fixup(a, l, MR); break;
            case 8: { g0 = GemmDesc{(const bf16*)(ws + WS_G), (const bf16*)(ws + W_DN), MR, D, DFF, Mb, D}; ng = 1; } break;
            case 9:
                if (!last) { rowwise2<3>(XL, XC, XL, XC, Mb, MOD + (size_t)l * 9 * MODW + 5120, NW + (l * 4 + 3) * D, H, MOD + (size_t)(l + 1) * 9 * MODW, 0, 1024, NW + ((l + 1) * 4 + 0) * D, T, a.wv);
                             convert_layer(a, l + 1, lds); }
                else rowwise2<3>(XL, XC, XL, XC, Mb, MOD + (size_t)l * 9 * MODW + 5120, NW + (l * 4 + 3) * D, nullptr, MOD, 0, 0, NW, TL, a.wv);
                break;
            }
        }
#else
        { g0 = GemmDesc{H, (const bf16*)(ws + W_IN), T, a.hi * 256, a.lo * 128, (bf16*)(ws + WS_P), HYB_INP}; ng = 1; }
#endif
        for (int gi = 0; gi < ng; ++gi) {
            const bool f = (gi == 0);
            pg8::Gemm g{f ? g0.A : g1.A, f ? g0.Bt : g1.Bt, f ? g0.M : g1.M, f ? g0.N : g1.N, f ? g0.K : g1.K, a.wv}; pg8::StaticOrder S; S.init(g.M, g.N, (int)gridDim.x, (int)blockIdx.x);
            pg8::EpiFfn E{f ? g0.O : g1.O, f ? g0.ldc : g1.ldc, f ? g0.mode : 0, (bf16*)(ws + WS_UE), a.in[I_FCONV] + (size_t)((s - 2) / 10) * 3 * UPW, (LAS pg8::f32x4*)(lds + 131072)};
#ifndef NO_GEMM
            pg8::gemm_phase<pg8::EpiFfn, pg8::StaticOrder, true, true>(lds, g, S, E);
#endif
            __syncthreads();
        }
        if (rep + 1 < nrep) __syncthreads();
        }
#ifdef SSD_DIAG
        if (s + 1 == a0.hi) { __syncthreads(); asm volatile("s_waitcnt vmcnt(0)" ::: "memory"); if (blockIdx.x == 0 && otid(wv0) == 0) { const float* dg = (const float*)(a0.ws + WS_MOD + 900 * 1024); a0.out[0] = SSD_DIAG_SEL == 7 ? dg[7] : 1.0e4f * dg[SSD_DIAG_SEL] / dg[7]; } }
#endif
        if (s + 1 < a0.hi) {
#if MK_SINGLE == 1
            xcd_barrier(xbar);
#ifdef PROBE_BAR2
            xcd_barrier(xbar);
#endif
#elif MK_SINGLE == 2
            cg::this_grid().sync();
#endif
        }
    }
}

extern "C" void kernel_launch(void* const* d_in, const int* in_sizes, int n_in, void* d_out, int out_size, void* d_ws, size_t ws_size, hipStream_t stream) {
    static int grid = 0;
    if (grid == 0) {
        if (n_in != 25 || out_size != TL * D || ws_size < WS_END) { fprintf(stderr, "kernel_launch: unexpected problem (n_in %d out %d ws %zu need %zu)\n", n_in, out_size, ws_size, (size_t)WS_END); grid = -1; return; }
        if (hipFuncSetAttribute((const void*)fwd_kernel, hipFuncAttributeMaxDynamicSharedMemorySize, LDS_BYTES) != hipSuccess) { fprintf(stderr, "kernel_launch: hipFuncSetAttribute failed\n"); grid = -1; return; }
        int dev = 0, cus = 0, per_cu = 0;
        hipGetDevice(&dev); hipDeviceGetAttribute(&cus, hipDeviceAttributeMultiprocessorCount, dev);
        hipOccupancyMaxActiveBlocksPerMultiprocessor(&per_cu, (const void*)fwd_kernel, NTHR, LDS_BYTES);
        (void)hipGetLastError();
        if (per_cu < 1) { fprintf(stderr, "kernel_launch: occupancy query says %d blocks per CU\n", per_cu); }
        grid = cus;
    }
    if (grid < 0) return;
#if MK_SINGLE == 1
    if (hipMemsetAsync((char*)d_ws + WS_CTL, 0, CTL_ZERO_BYTES, stream) != hipSuccess) { fprintf(stderr, "kernel_launch: memset failed\n"); return; }
#endif
    Args a{};
    for (int i = 0; i < 25; ++i) a.in[i] = (const float*)d_in[i];
    a.out = (float*)d_out; a.ws = (unsigned char*)d_ws;
#if MK_SINGLE
    a.lo = 0; a.hi = NSTEP + 1;
    void* args[] = {&a};
    hipError_t e = hipLaunchCooperativeKernel((const void*)fwd_kernel, dim3(grid), dim3(NTHR), args, LDS_BYTES, stream);
    if (e != hipSuccess) fprintf(stderr, "cooperative launch failed: %s (grid %d)\n", hipGetErrorString(e), grid);
#else
    for (int s = 0; s < NSTEP + 1; ++s) { a.lo = s; a.hi = s + 1; hipLaunchKernelGGL(fwd_kernel, dim3(grid), dim3(NTHR), LDS_BYTES, stream, a); }
#endif
}
```

```cpp
#include <hip/hip_runtime.h>
#include <hip/hip_cooperative_groups.h>
#include <cstdio>
#include <cstdint>
namespace cg = cooperative_groups;
__device__ __forceinline__ int otid(int wv) { int l; asm volatile("v_mbcnt_lo_u32_b32 %0, -1, 0\n\tv_mbcnt_hi_u32_b32 %0, -1, %0" : "=v"(l)); return (wv << 6) | l; }
__device__ __forceinline__ float shx(float v, int mask, int lane) { return __builtin_bit_cast(float, __builtin_amdgcn_ds_bpermute((lane ^ mask) << 2, __builtin_bit_cast(int, v))); }
#define LAS __attribute__((address_space(3)))
#define XB_TMO      128
#define XB_XCNT(j)  (256  + 64 * (j))
#define XB_XSUB(j)  (1280 + 64 * (j))
#define XB_XGEN(j)  (2304 + 64 * (j))
#define XB_TOP      3328
#define XB_TOPGEN   3392
#define XCD_BAR_WORDS 3456
#define XB_SPIN_CAP (1u << 18)

__device__ __forceinline__ unsigned xb_ld(unsigned* p)              { return __hip_atomic_load(p, __ATOMIC_RELAXED, __HIP_MEMORY_SCOPE_AGENT); }
__device__ __forceinline__ unsigned xb_add(unsigned* p, unsigned v) { return __hip_atomic_fetch_add(p, v, __ATOMIC_RELAXED, __HIP_MEMORY_SCOPE_AGENT); }
__device__ __forceinline__ unsigned xb_xcc_id() { return (unsigned)__builtin_amdgcn_s_getreg((3 << 11) | 20) & 0xFu; }
#define XB_SPIN(cond, bar) do { unsigned _sp = 0; while (cond) { __builtin_amdgcn_s_sleep(1); \
    if ((++_sp & 255u) == 0u) { if (xb_ld(&(bar)[XB_TMO])) break; if (_sp > XB_SPIN_CAP) { atomicAdd(&(bar)[XB_TMO], 1u); break; } } } } while (0)

struct XcdBarrier {
    unsigned* bar; unsigned x; int wv;
    volatile LAS unsigned* st;
};

__device__ __forceinline__ XcdBarrier xcd_barrier_post(unsigned* bar, volatile LAS unsigned* st, int wv) {
    XcdBarrier b; b.bar = bar; b.x = xb_xcc_id(); b.st = st; b.wv = wv;
    if (otid(wv) == 0) (void)xb_add(&bar[XB_XCNT(b.x)], 1u);
    return b;
}
__device__ __forceinline__ void xcd_barrier_complete(unsigned* bar, unsigned x, unsigned& nloc, unsigned& nx) {
    const unsigned G = gridDim.x * gridDim.y * gridDim.z;
    unsigned sum, cnt, mine, sp = 0u;
    for (;;) {
        sum = 0u; cnt = 0u; mine = 0u;
#pragma unroll
        for (unsigned j = 0; j < 16; ++j) { const unsigned c = xb_ld(&bar[XB_XCNT(j)]); sum += c; cnt += (c > 0u) ? 1u : 0u; mine = (j == x) ? c : mine; }
        if (sum == G) break;
        __builtin_amdgcn_s_sleep(1);
        if ((++sp & 255u) == 0u) { if (xb_ld(&bar[XB_TMO])) break; if (sp > XB_SPIN_CAP) { atomicAdd(&bar[XB_TMO], 1u); break; } }
    }
    nloc = mine > 0u ? mine : 1u; nx = cnt > 0u ? cnt : 1u;
}

__device__ __forceinline__ void xcd_barrier(const XcdBarrier& b) {
    asm volatile("s_waitcnt vmcnt(0)" ::: "memory");
    __syncthreads();
    if (otid(b.wv) == 0) {
        unsigned* bar = b.bar;
        __builtin_amdgcn_s_waitcnt(0);
        unsigned nloc = b.st[0], nx = b.st[1];
        if (nloc == 0u) { xcd_barrier_complete(bar, b.x, nloc, nx); b.st[0] = nloc; b.st[1] = nx; }
        const unsigned old = xb_add(&bar[XB_XSUB(b.x)], 1u);
        const unsigned gen = old / nloc;
        if (old + 1u == (gen + 1u) * nloc) {
            __builtin_amdgcn_fence(__ATOMIC_RELEASE, "agent");
            asm volatile("s_waitcnt vmcnt(0)" ::: "memory");
            const unsigned og = xb_add(&bar[XB_TOP], 1u);
            const unsigned tg = og / nx;
            if (og + 1u == (tg + 1u) * nx) xb_add(&bar[XB_TOPGEN], 1u);
            else XB_SPIN(xb_ld(&bar[XB_TOPGEN]) == tg, bar);
            __builtin_amdgcn_fence(__ATOMIC_ACQUIRE, "agent");
            xb_add(&bar[XB_XGEN(b.x)], 1u);
            asm volatile("s_waitcnt vmcnt(0)" ::: "memory");
        } else {
            XB_SPIN(xb_ld(&bar[XB_XGEN(b.x)]) == gen, bar);
            __builtin_amdgcn_fence(__ATOMIC_ACQUIRE, "agent");
            asm volatile("s_waitcnt vmcnt(0)" ::: "memory");
        }
    }
    __syncthreads();
}
namespace pg8 {
#define PG8_LAS __attribute__((address_space(3)))
typedef unsigned short bf16_t;
typedef short bf16x8 __attribute__((ext_vector_type(8)));
typedef float f32x4 __attribute__((ext_vector_type(4)));
typedef unsigned u32x4 __attribute__((ext_vector_type(4)));
constexpr int BM = 256, BK = 64, HALF = 128, HTB = HALF * BK * 2  , STAGE_BYTES = 8 * HTB, NXCD = 8, WGM = 8;

__host__ __device__ __forceinline__ int lds_byte(int r, int c) { const int st = (r >> 4) * 2 + (c >> 5), rr = r & 15, cc = c & 31, ob = rr * 64 + cc * 2; return st * 1024 + (ob ^ (((ob >> 9) & 1) << 5)); }
__host__ __device__ __forceinline__ void stage_rc(int b, int& R, int& C) { const int st = b / 1024, sb = b % 1024, swz = sb ^ (((sb >> 9) & 1) << 5); R = (st >> 1) * 16 + swz / 64; C = (st & 1) * 32 + (swz % 64) / 2; }
__host__ __device__ __forceinline__ int perm32(int rho) { const int n = rho >> 4, i = rho & 15; return 8 * (i >> 2) + 4 * n + (i & 3); }

struct Unit { int pm, pn; };
struct Gemm { const bf16_t* A; const bf16_t* Bt; int M, N, K, wv; };

struct StaticOrder {
    int nM, nN, nwg, G, c;
    __host__ __device__ void init(int M, int N, int G_, int c_) { nM = M / BM; nN = N / BM; nwg = nM * nN; G = G_; c = c_; }
    __host__ __device__ bool next(int i, Unit& u) const {
        const long L = (long)i * G + c; if (L >= nwg) return false;
        int wgid = (int)L; { const int q = nwg / NXCD, r = nwg % NXCD, xcd = wgid % NXCD, off = wgid / NXCD; wgid = (xcd < r ? xcd * (q + 1) : r * (q + 1) + (xcd - r) * q) + off; }
        const int nig = WGM * nN, gid = wgid / nig, fm = gid * WGM, gsz = (nM - fm) < WGM ? (nM - fm) : WGM;
        u.pm = fm + ((wgid % nig) % gsz); u.pn = (wgid % nig) / gsz; return true;
    }
    __device__ __forceinline__ void a_ready(const Unit&) const {}
    __device__ __forceinline__ void done(const Unit&) const {}
};

__device__ __forceinline__ unsigned cvt_pk_bf16(float lo, float hi) { unsigned r; asm volatile("v_cvt_pk_bf16_f32 %0, %1, %2" : "=v"(r) : "v"(lo), "v"(hi)); return r; }
struct EpiStore {
    static constexpr bool PERM = true, AFTER_DRAIN = false;
    bf16_t* O; int ldc;
    __device__ __forceinline__ void operator()(const f32x4 (&acc)[2][2][4][2], const Unit& u, int wr, int wc, int fr, int fq) const {
        const int row0 = u.pm * BM + wr * 64 + fr; const int col0 = u.pn * BM + wc * 32 + 8 * fq;
#pragma unroll
        for (int ai = 0; ai < 2; ++ai)
#pragma unroll
            for (int m = 0; m < 4; ++m) { bf16_t* rowp = O + (size_t)(row0 + ai * HALF + m * 16) * ldc + col0;
#pragma unroll
                for (int bj = 0; bj < 2; ++bj) { const f32x4 v0 = acc[ai][bj][m][0], v1 = acc[ai][bj][m][1];
                    u32x4 w; w.x = cvt_pk_bf16(v0[0], v0[1]); w.y = cvt_pk_bf16(v0[2], v0[3]); w.z = cvt_pk_bf16(v1[0], v1[1]); w.w = cvt_pk_bf16(v1[2], v1[3]);
                    *(u32x4*)(rowp + bj * HALF) = w; } }
    }
};

template <int CTRL> __device__ __forceinline__ float dppf(float old, float src) { return __builtin_bit_cast(float, __builtin_amdgcn_update_dpp(__builtin_bit_cast(int, old), __builtin_bit_cast(int, src), CTRL, 0xf, 0xf, false)); }
#define PG8_DPP4(dst, oldv, srcv, ctrl) do { dst[0] = dppf<ctrl>(oldv[0], srcv[0]); dst[1] = dppf<ctrl>(oldv[1], srcv[1]); dst[2] = dppf<ctrl>(oldv[2], srcv[2]); dst[3] = dppf<ctrl>(oldv[3], srcv[3]); } while (0)
struct EpiFfn {
    static constexpr bool PERM = true, AFTER_DRAIN = false;
    bf16_t* O; int ldc; int mode;
    bf16_t* Ue; const float* cw; PG8_LAS f32x4* ex;
    __device__ __forceinline__ void operator()(const f32x4 (&acc)[2][2][4][2], const Unit& u, int wr, int wc, int fr, int fq) const {
        if (mode == 0) {
            const int row0 = u.pm * BM + wr * 64 + fr; const int col0 = u.pn * BM + wc * 32 + 8 * fq;
#pragma unroll
            for (int ai = 0; ai < 2; ++ai)
#pragma unroll
                for (int m = 0; m < 4; ++m) { bf16_t* rowp = O + (size_t)(row0 + ai * HALF + m * 16) * ldc + col0;
#pragma unroll
                    for (int bj = 0; bj < 2; ++bj) { const f32x4 v0 = acc[ai][bj][m][0], v1 = acc[ai][bj][m][1];
                        u32x4 w; w.x = cvt_pk_bf16(v0[0], v0[1]); w.y = cvt_pk_bf16(v0[2], v0[3]); w.z = cvt_pk_bf16(v1[0], v1[1]); w.w = cvt_pk_bf16(v1[2], v1[3]);
                        *(u32x4*)(rowp + bj * HALF) = w; } }
            return;
        }
        const int chl = wc * 32 + 8 * fq, ch = u.pn * 128 + chl;
        f32x4 wA[3][2], wG[3][2];
#pragma unroll
        for (int t = 0; t < 3; ++t)
#pragma unroll
            for (int n = 0; n < 2; ++n) { wA[t][n] = *(const f32x4*)(cw + t * 5632 + ch + 4 * n); wG[t][n] = *(const f32x4*)(cw + t * 5632 + 2816 + ch + 4 * n); }
#define PG8_EX(blk, fl, bj, n) ex[((((blk) * 2 + (fl)) * 2 + (bj)) * 2 + (n)) * 16 + wc * 4 + fq]
#pragma unroll
        for (int ai = 0; ai < 2; ++ai) { const int blk = ai * 2 + wr;
            if (fr == 0) {
#pragma unroll
                for (int bj = 0; bj < 2; ++bj)
#pragma unroll
                    for (int n = 0; n < 2; ++n) PG8_EX(blk, 0, bj, n) = acc[ai][bj][0][n]; }
            if (fr == 15) {
#pragma unroll
                for (int bj = 0; bj < 2; ++bj)
#pragma unroll
                    for (int n = 0; n < 2; ++n) PG8_EX(blk, 1, bj, n) = acc[ai][bj][3][n]; } }
        asm volatile("s_waitcnt lgkmcnt(0)" ::: "memory"); __builtin_amdgcn_s_barrier(); asm volatile("" ::: "memory");
        const f32x4 zero4 = (f32x4){0.f, 0.f, 0.f, 0.f};
#pragma unroll
        for (int ai = 0; ai < 2; ++ai) { const int blk = ai * 2 + wr;
            f32x4 pb[2][2], nb[2][2];
#pragma unroll
            for (int bj = 0; bj < 2; ++bj)
#pragma unroll
                for (int n = 0; n < 2; ++n) { pb[bj][n] = blk > 0 ? PG8_EX(blk - 1, 1, bj, n) : zero4; nb[bj][n] = blk < 3 ? PG8_EX(blk + 1, 0, bj, n) : zero4; }
#pragma unroll
            for (int m = 0; m < 4; ++m) {
                f32x4 cv[2][2];
#pragma unroll
                for (int bj = 0; bj < 2; ++bj)
#pragma unroll
                    for (int n = 0; n < 2; ++n) { const f32x4 cur = acc[ai][bj][m][n]; f32x4 bp, bn, prev, next;
                        if (m == 0) bp = pb[bj][n]; else PG8_DPP4(bp, cur, acc[ai][bj][m > 0 ? m - 1 : 0][n], 0x121);
                        if (m == 3) bn = nb[bj][n]; else PG8_DPP4(bn, cur, acc[ai][bj][m < 3 ? m + 1 : 3][n], 0x12F);
                        PG8_DPP4(prev, bp, cur, 0x111);
                        PG8_DPP4(next, bn, cur, 0x101);
                        const f32x4 w0 = bj ? wG[0][n] : wA[0][n], w1 = bj ? wG[1][n] : wA[1][n], w2 = bj ? wG[2][n] : wA[2][n];
                        cv[bj][n] = w0 * prev + w1 * cur + w2 * next; }
                u32x4 w; float g[8];
#pragma unroll
                for (int n = 0; n < 2; ++n)
#pragma unroll
                    for (int e = 0; e < 4; ++e) { const float av = cv[0][n][e]; g[4 * n + e] = av * __builtin_amdgcn_rcpf(1.f + __expf(-av)) * cv[1][n][e]; }
                w.x = cvt_pk_bf16(g[0], g[1]); w.y = cvt_pk_bf16(g[2], g[3]); w.z = cvt_pk_bf16(g[4], g[5]); w.w = cvt_pk_bf16(g[6], g[7]);
                *(u32x4*)(O + (size_t)(u.pm * BM + ai * HALF + wr * 64 + m * 16 + fr) * 2816 + ch) = w;
            } }
#undef PG8_EX
        { const int slot = (wr == 0) ? (fr == 0 ? 0 : (fr == 1 ? 1 : -1)) : (fr == 14 ? 2 : (fr == 15 ? 3 : -1));
          if (slot >= 0) { bf16_t* up = Ue + ((size_t)(u.pm * 4 + slot) * 5632) + u.pn * 256 + chl;
#pragma unroll
              for (int bj = 0; bj < 2; ++bj) { const f32x4 v0 = wr ? acc[1][bj][3][0] : acc[0][bj][0][0], v1 = wr ? acc[1][bj][3][1] : acc[0][bj][0][1];
                  u32x4 w; w.x = cvt_pk_bf16(v0[0], v0[1]); w.y = cvt_pk_bf16(v0[2], v0[3]); w.z = cvt_pk_bf16(v1[0], v1[1]); w.w = cvt_pk_bf16(v1[2], v1[3]);
                  *(u32x4*)(up + bj * HALF) = w; } } }
    }
};
template <class Epi, class Sched, bool ALIGN_EPI = false, bool SP2 = false>
__device__ __forceinline__ void gemm_phase(PG8_LAS unsigned char* lds, const Gemm g, const Sched& S, const Epi& E) {
    const int tid = otid(g.wv), wid = g.wv, lane = tid & 63, wr = wid >> 2, wc = wid & 3, fr = lane & 15, fq = lane >> 4;
    const int K = g.K, nt = K / BK;
    unsigned voffA[2], voffB[2];
#pragma unroll
    for (int i = 0; i < 2; ++i) { int R, C; stage_rc(tid * 16 + i * 8192, R, C); const int Rb = Epi::PERM ? ((R & ~31) + perm32(R & 31)) : R;
        voffA[i] = (unsigned)(R * K + C) * 2u; voffB[i] = (unsigned)(Rb * K + C) * 2u; }
    const size_t kstep = (size_t)(BK * 2);
    const size_t hstep = (size_t)HALF * K * 2;
    const size_t tstep = 2 * hstep;
    const unsigned ldsw = (unsigned)wid * 1024u;
    const int aoff = lds_byte(wr * 64 + fr, fq * 8), boff = lds_byte(wc * 32 + fr, fq * 8);
#define PG8_SA(b, h) (((b) * 2 + (h)) * HTB)
#define PG8_SB(b, h) ((4 + (b) * 2 + (h)) * HTB)
#define PG8_STAGE(bufoff, gbase, voff) do { _Pragma("unroll") for (int _i = 0; _i < 2; ++_i) \
        __builtin_amdgcn_global_load_lds((const unsigned*)((const char*)(gbase) + (voff)[_i]), (PG8_LAS unsigned*)(lds + (bufoff) + ldsw + _i * 8192), 16, 0, 0); } while (0)
#define PG8_LDA(dst, b, h) do { _Pragma("unroll") for (int m = 0; m < 4; ++m) _Pragma("unroll") for (int k = 0; k < 2; ++k) dst[m][k] = *(const PG8_LAS bf16x8*)(lds + PG8_SA(b, h) + aoff + m * 2048 + k * 1024); } while (0)
#define PG8_LDB(dst, b, h) do { _Pragma("unroll") for (int n = 0; n < 2; ++n) _Pragma("unroll") for (int k = 0; k < 2; ++k) dst[n][k] = *(const PG8_LAS bf16x8*)(lds + PG8_SB(b, h) + boff + n * 2048 + k * 1024); } while (0)
#define PG8_MMA(ai, bj, At, Bt) do { __builtin_amdgcn_s_setprio(1); _Pragma("unroll") for (int m = 0; m < 4; ++m) _Pragma("unroll") for (int n = 0; n < 2; ++n) _Pragma("unroll") for (int k = 0; k < 2; ++k) \
        acc[ai][bj][m][n] = __builtin_amdgcn_mfma_f32_16x16x32_bf16(Bt[n][k], At[m][k], acc[ai][bj][m][n], 0, 0, 0); __builtin_amdgcn_s_setprio(0); } while (0)
#define PG8_WAIT_V(n) asm volatile("s_waitcnt vmcnt(" #n ")" ::: "memory")
#define PG8_WAIT_L(n) asm volatile("s_waitcnt lgkmcnt(" #n ")" ::: "memory")
#define PG8_BAR __builtin_amdgcn_s_barrier()
#define PG8_SCHED __builtin_amdgcn_sched_barrier(0)
    Unit cur, nxt; int ui = 0;
    if (!S.next(0, cur)) return;
    f32x4 acc[2][2][4][2];
#pragma unroll
    for (int a = 0; a < 2; ++a)
#pragma unroll
        for (int b = 0; b < 2; ++b)
#pragma unroll
            for (int m = 0; m < 4; ++m)
#pragma unroll
                for (int n = 0; n < 2; ++n) acc[a][b][m][n] = (f32x4){0.f, 0.f, 0.f, 0.f};
    bf16x8 At[4][2], B0[2][2], B1[2][2];
    const char* cA = (const char*)g.A + (size_t)cur.pm * tstep; const char* cB = (const char*)g.Bt + (size_t)cur.pn * tstep;
    S.a_ready(cur);
    if constexpr (SP2) {
        PG8_STAGE(PG8_SB(0, 0), cB, voffB); PG8_STAGE(PG8_SB(0, 1), cB + hstep, voffB); PG8_STAGE(PG8_SA(0, 0), cA, voffA); PG8_STAGE(PG8_SA(0, 1), cA + hstep, voffA);
        if (wr == 1) PG8_BAR;
        PG8_WAIT_V(2); PG8_BAR;
        PG8_STAGE(PG8_SB(1, 0), cB + kstep, voffB); PG8_STAGE(PG8_SA(1, 0), cA + kstep, voffA); PG8_STAGE(PG8_SB(1, 1), cB + hstep + kstep, voffB);
        PG8_WAIT_V(6); PG8_BAR;
    } else {
        PG8_STAGE(PG8_SB(0, 0), cB, voffB); PG8_STAGE(PG8_SA(0, 0), cA, voffA); PG8_STAGE(PG8_SB(0, 1), cB + hstep, voffB); PG8_STAGE(PG8_SA(0, 1), cA + hstep, voffA);
        if (wr == 1) PG8_BAR;
        PG8_WAIT_V(4); PG8_BAR;
        PG8_STAGE(PG8_SB(1, 0), cB + kstep, voffB); PG8_STAGE(PG8_SA(1, 0), cA + kstep, voffA); PG8_STAGE(PG8_SB(1, 1), cB + hstep + kstep, voffB);
        PG8_WAIT_V(6); PG8_BAR;
    }
    for (;;) {
        const bool has_next = S.next(ui + 1, nxt);
        const char* nA = has_next ? (const char*)g.A + (size_t)nxt.pm * tstep : cA; const char* nB = has_next ? (const char*)g.Bt + (size_t)nxt.pn * tstep : cB;
        for (int t = 0; t < nt; t += 2) {
            const bool last = (t == nt - 2);
            const char* a1 = cA + (size_t)(t + 1) * kstep;
            const char* a2 = last ? nA : cA + (size_t)(t + 2) * kstep; const char* b2 = last ? nB : cB + (size_t)(t + 2) * kstep;
            const char* a3 = a2 + kstep; const char* b3 = b2 + kstep;
            if (last && has_next) S.a_ready(nxt);
            if constexpr (SP2) {
            PG8_LDB(B0, 0, 0); PG8_LDB(B1, 0, 1); PG8_SCHED; PG8_LDA(At, 0, 0); PG8_STAGE(PG8_SA(1, 1), a1 + hstep, voffA);
            PG8_WAIT_V(8); PG8_WAIT_L(0); PG8_BAR; PG8_MMA(0, 0, At, B0); PG8_MMA(0, 1, At, B1); PG8_BAR; PG8_SCHED;
            PG8_LDA(At, 0, 1); PG8_STAGE(PG8_SB(0, 0), b2, voffB); PG8_STAGE(PG8_SB(0, 1), b2 + hstep, voffB); PG8_STAGE(PG8_SA(0, 0), a2, voffA);
            PG8_WAIT_V(8); PG8_WAIT_L(0); PG8_BAR; PG8_MMA(1, 0, At, B0); PG8_MMA(1, 1, At, B1); PG8_BAR; PG8_SCHED;
            PG8_LDB(B0, 1, 0); PG8_LDB(B1, 1, 1); PG8_SCHED; PG8_LDA(At, 1, 0); PG8_STAGE(PG8_SA(0, 1), a2 + hstep, voffA);
            PG8_WAIT_V(8); PG8_WAIT_L(0); PG8_BAR; PG8_MMA(0, 0, At, B0); PG8_MMA(0, 1, At, B1); PG8_BAR; PG8_SCHED;
            PG8_LDA(At, 1, 1); PG8_STAGE(PG8_SB(1, 0), b3, voffB); PG8_STAGE(PG8_SB(1, 1), b3 + hstep, voffB); PG8_STAGE(PG8_SA(1, 0), a3, voffA);
            PG8_WAIT_V(8); PG8_WAIT_L(0); PG8_BAR; PG8_MMA(1, 0, At, B0); PG8_MMA(1, 1, At, B1); PG8_BAR; PG8_SCHED;
            } else {
            PG8_LDB(B0, 0, 0); PG8_SCHED; PG8_LDA(At, 0, 0); PG8_STAGE(PG8_SA(1, 1), a1 + hstep, voffA);
            PG8_WAIT_L(8); PG8_BAR; PG8_WAIT_L(0); PG8_MMA(0, 0, At, B0); PG8_BAR; PG8_SCHED;
            PG8_LDB(B1, 0, 1); PG8_STAGE(PG8_SB(0, 0), b2, voffB);
            PG8_BAR; PG8_WAIT_L(0); PG8_MMA(0, 1, At, B1); PG8_BAR;
            PG8_LDA(At, 0, 1); PG8_STAGE(PG8_SA(0, 0), a2, voffA);
            PG8_BAR; PG8_WAIT_L(0); PG8_MMA(1, 0, At, B0); PG8_BAR; PG8_SCHED;
            PG8_STAGE(PG8_SB(0, 1), b2 + hstep, voffB);
            PG8_WAIT_V(6); PG8_BAR; PG8_MMA(1, 1, At, B1); PG8_BAR;
            PG8_LDB(B0, 1, 0); PG8_SCHED; PG8_LDA(At, 1, 0); PG8_STAGE(PG8_SA(0, 1), a2 + hstep, voffA);
            PG8_WAIT_L(8); PG8_BAR; PG8_WAIT_L(0); PG8_MMA(0, 0, At, B0); PG8_BAR; PG8_SCHED;
            PG8_LDB(B1, 1, 1); PG8_STAGE(PG8_SB(1, 0), b3, voffB);
            PG8_BAR; PG8_WAIT_L(0); PG8_MMA(0, 1, At, B1); PG8_BAR;
            PG8_LDA(At, 1, 1); PG8_STAGE(PG8_SA(1, 0), a3, voffA);
            PG8_BAR; PG8_WAIT_L(0); PG8_MMA(1, 0, At, B0); PG8_BAR; PG8_SCHED;
            PG8_STAGE(PG8_SB(1, 1), b3 + hstep, voffB);
            PG8_WAIT_V(6); PG8_BAR; PG8_MMA(1, 1, At, B1); PG8_BAR;
            }
        }
        if constexpr (ALIGN_EPI) { if (wr == 0) PG8_BAR; }
        if constexpr (!Epi::AFTER_DRAIN) { E(acc, cur, wr, wc, fr, fq); S.done(cur); }
        if (!has_next) break;
#pragma unroll
        for (int a = 0; a < 2; ++a)
#pragma unroll
            for (int b = 0; b < 2; ++b)
#pragma unroll
                for (int m = 0; m < 4; ++m)
#pragma unroll
                    for (int n = 0; n < 2; ++n) acc[a][b][m][n] = (f32x4){0.f, 0.f, 0.f, 0.f};
        cur = nxt; cA = nA; cB = nB; ++ui;
        if constexpr (ALIGN_EPI) { if (wr == 1) PG8_BAR; }
    }
    PG8_WAIT_V(0);
    if constexpr (!ALIGN_EPI) { if (wr == 0) PG8_BAR; }
    PG8_BAR;
    if constexpr (Epi::AFTER_DRAIN) { E.fused(acc, cur, wr, wc, fr, fq, lds, wid, lane); S.done(cur); }
#undef PG8_SA
#undef PG8_SB
#undef PG8_STAGE
#undef PG8_LDA
#undef PG8_LDB
#undef PG8_MMA
#undef PG8_WAIT_V
#undef PG8_WAIT_L
#undef PG8_BAR
#undef PG8_SCHED
}
}

typedef unsigned short bf16;
typedef unsigned v4u __attribute__((ext_vector_type(4)));
typedef unsigned v2u __attribute__((ext_vector_type(2)));
typedef float f32x4 __attribute__((ext_vector_type(4)));
constexpr int NWAVES = 8, NTHR = 512;
constexpr int D = 1024, NB = 8, SEQ = 2048, CTXL = 256, TL = NB * SEQ, TC = NB * CTXL, T = TL + TC;
constexpr int HYB_IN = 2208, HYB_INP = 2304, SSD_IN = 5184, SSD_INP = 5376, DFF = 2816, UPW = 5632;
constexpr int QW = 768, KVW = 1024, MODW = 6144;
constexpr float EPS = 1e-6f;
constexpr int NSTEP = 1 + 4 * 10;
constexpr float ATT_SCALE_LOG2E = 0.10206207261596577f * 1.4426950408889634f;

constexpr size_t MiB = 1u << 20;
constexpr size_t WS_CTL = 0, CTL_ZERO_BYTES = 64 * 1024;
constexpr size_t WS_MOD = 1 * MiB;
constexpr size_t WS_ROPE = 2 * MiB;
constexpr size_t W_UP = 3 * MiB;
constexpr size_t W_DN = W_UP + (size_t)UPW * D * 2;
constexpr size_t W_IN = W_DN + (size_t)D * DFF * 2;
constexpr size_t W_OUT = W_IN + (size_t)SSD_INP * D * 2;
constexpr size_t W_UQ = W_OUT + (size_t)D * 2048 * 2;
constexpr size_t W_UKV = W_UQ + (size_t)QW * 384 * 2;
constexpr size_t W_END = W_UKV + (size_t)KVW * 256 * 2;
constexpr size_t WS_XC = 36 * MiB;
constexpr size_t WS_H = 44 * MiB;
constexpr size_t WS_DT = WS_H, WS_AA = WS_H + (size_t)T * 64 * 4;
constexpr size_t WS_BIG = 80 * MiB;
constexpr size_t WS_M = WS_BIG;
constexpr size_t WS_P = WS_BIG;
constexpr size_t WS_Q = WS_BIG + 81 * MiB;
constexpr size_t WS_KV = WS_BIG + 108 * MiB;
constexpr size_t WS_KR = WS_BIG + 144 * MiB;
constexpr size_t WS_CQN = WS_BIG + 146 * MiB;
constexpr size_t WS_CKVN = WS_BIG + 160 * MiB;
constexpr size_t WS_MIX = WS_BIG + 170 * MiB;
constexpr size_t WS_U = WS_BIG;
constexpr size_t WS_G = WS_BIG + 198 * MiB;
constexpr size_t WS_ZX = WS_BIG;
constexpr size_t WS_XBC = WS_BIG + 189 * MiB;
constexpr size_t WS_UE = WS_BIG + 297 * MiB;
constexpr size_t WS_END = WS_UE + 4 * MiB;
static_assert(W_END <= WS_XC && WS_G + (size_t)T * DFF * 2 <= WS_END && WS_XBC + (size_t)T * 3072 * 2 <= WS_END && WS_ZX + (size_t)T * SSD_INP * 2 <= WS_XBC, "ws map");
static_assert(WS_AA + (size_t)T * 64 * 4 <= WS_BIG && WS_MIX + (size_t)T * D * 2 <= WS_END && WS_Q + (size_t)T * QW * 2 <= WS_KV && WS_P + (size_t)T * HYB_INP * 2 <= WS_Q, "ws map 2");
constexpr int LDS_BYTES = 147456;

struct Args { const float* in[25]; float* out; unsigned char* ws; int lo, hi; int wv, pad; };
enum { I_X = 0, I_C, I_CTX, I_CCTX, I_MODW, I_MODB, I_NORMW, I_WUP, I_FCONV, I_WDN, I_HIN, I_QNORM, I_KVNORM, I_WUQ, I_WUKV, I_SCONV, I_HOUT, I_SIN, I_SCONVW, I_SCONVB, I_ALOG, I_DTB, I_SD, I_SNORM, I_SOUT };

__device__ __forceinline__ unsigned f2bf(float f) { unsigned u = __builtin_bit_cast(unsigned, f); return (u + 0x7fffu + ((u >> 16) & 1u)) >> 16; }
__device__ __forceinline__ unsigned pk2(float lo, float hi) { return f2bf(lo) | (f2bf(hi) << 16); }
__device__ __forceinline__ float bflo(unsigned u) { return __builtin_bit_cast(float, u << 16); }
__device__ __forceinline__ float bfhi(unsigned u) { return __builtin_bit_cast(float, u & 0xffff0000u); }
__device__ __forceinline__ float bf1(bf16 b) { return __builtin_bit_cast(float, (unsigned)b << 16); }
__device__ __forceinline__ float silu_f(float x) { return x / (1.f + __expf(-x)); }
__device__ __forceinline__ float wave_sum(float v, int lane) {
#pragma unroll
    for (int o = 1; o < 64; o <<= 1) v += shx(v, o, lane);
    return v;
}
__device__ __forceinline__ void unpack8(const v4u w, float (&f)[8]) { f[0] = bflo(w.x); f[1] = bfhi(w.x); f[2] = bflo(w.y); f[3] = bfhi(w.y); f[4] = bflo(w.z); f[5] = bfhi(w.z); f[6] = bflo(w.w); f[7] = bfhi(w.w); }
__device__ __forceinline__ v4u pack8(const float (&f)[8]) { v4u w; w.x = pk2(f[0], f[1]); w.y = pk2(f[2], f[3]); w.z = pk2(f[4], f[5]); w.w = pk2(f[6], f[7]); return w; }
__device__ __forceinline__ bool has_prev(int r) { return r < TL ? (r & (SEQ - 1)) != 0 : ((r - TL) & (CTXL - 1)) != 0; }
__device__ __forceinline__ bool has_next(int r) { return r < TL ? (r & (SEQ - 1)) != SEQ - 1 : ((r - TL) & (CTXL - 1)) != CTXL - 1; }

__device__ __forceinline__ void mod_compute(const Args& a, LAS unsigned char* lds) {
    LAS float* sc = (LAS float*)lds;
    LAS float* red = (LAS float*)(lds + 36864);
    const int tid = otid(a.wv);
    float* MOD = (float*)(a.ws + WS_MOD);
    for (int i = tid; i < 9 * 1024; i += NTHR) { const int c = i >> 10, k = i & 1023; const float v = c < 8 ? a.in[I_C][c * 1024 + k] : a.in[I_CCTX][k]; sc[i] = silu_f(v); }
    __syncthreads();
    for (int item = blockIdx.x; item < 4 * 96; item += gridDim.x) {
        const int l = item / 96, cb = item % 96;
        const float* W = a.in[I_MODW] + (size_t)l * 1024 * MODW + cb * 64;
        const int cgp = tid & 15, kg = tid >> 4;
        float acc[9][4];
#pragma unroll
        for (int c = 0; c < 9; ++c) { acc[c][0] = 0.f; acc[c][1] = 0.f; acc[c][2] = 0.f; acc[c][3] = 0.f; }
#pragma unroll 8
        for (int kk = 0; kk < 32; ++kk) { const int k = kg * 32 + kk; const f32x4 w = *(const f32x4*)(W + (size_t)k * MODW + cgp * 4);
#pragma unroll
            for (int c = 0; c < 9; ++c) { const float s = sc[c * 1024 + k]; acc[c][0] += s * w[0]; acc[c][1] += s * w[1]; acc[c][2] += s * w[2]; acc[c][3] += s * w[3]; } }
#pragma unroll
        for (int c = 0; c < 9; ++c)
#pragma unroll
            for (int j = 0; j < 4; ++j) red[kg * 576 + c * 64 + cgp * 4 + j] = acc[c][j];
        __syncthreads();
        for (int o = tid; o < 576; o += NTHR) { float s = 0.f;
            for (int g = 0; g < 32; ++g) s += red[g * 576 + o];
            const int c = o >> 6, col = o & 63; MOD[(size_t)(l * 9 + c) * MODW + cb * 64 + col] = s + a.in[I_MODB][l * MODW + cb * 64 + col]; }
        __syncthreads();
    }
}
__device__ __forceinline__ void rope_tables(const Args& a) {
    float* ct = (float*)(a.ws + WS_ROPE); float* st = ct + SEQ * 16;
    for (int i = blockIdx.x * NTHR + otid(a.wv); i < SEQ * 16; i += gridDim.x * NTHR) {
        const int t = i >> 4, j = i & 15; const int pos = j < 8 ? (t >> 6) : (t & 63); const int f = j & 7;
        const float i0 = (f & 1) ? 0.31622776601683794f : 1.0f; const int e = f >> 1; const float i1 = e == 0 ? 1.0f : (e == 1 ? 0.1f : (e == 2 ? 0.01f : 0.001f));
        const float inv = i0 * i1; const float ang = (float)pos * inv;
        ct[i] = __cosf(ang); st[i] = __sinf(ang); }
}
__device__ __forceinline__ void transpose_item(const float* W, int K, int N, bf16* WT, LAS float* scr, int item, int lane, bool ffn_perm) {
    const int nblk = N / 32, kb = item / nblk, nb = item % nblk, k0 = 64 * kb, n0 = 32 * nb;
    const int o0 = ffn_perm ? ((n0 % DFF) / 128) * 256 + (n0 / DFF) * 128 + (n0 % 128) : n0;
    float wv_[32];
#pragma unroll
    for (int i = 0; i < 32; ++i) wv_[i] = W[(size_t)(k0 + 2 * i + (lane >> 5)) * N + n0 + (lane & 31)];
#pragma unroll
    for (int i = 0; i < 32; ++i) scr[(2 * i + (lane >> 5)) * 33 + (lane & 31)] = wv_[i];
    asm volatile("s_waitcnt lgkmcnt(0)" ::: "memory");
    const int c = lane & 7;
#pragma unroll
    for (int j = 0; j < 4; ++j) { const int n = (lane >> 3) + 8 * j; const LAS float* s = scr + (8 * c) * 33 + n;
        v4u o; o.x = pk2(s[0 * 33], s[1 * 33]); o.y = pk2(s[2 * 33], s[3 * 33]); o.z = pk2(s[4 * 33], s[5 * 33]); o.w = pk2(s[6 * 33], s[7 * 33]);
        *(v4u*)(WT + (size_t)(o0 + n) * K + k0 + 8 * c) = o; }
    asm volatile("s_waitcnt lgkmcnt(0)" ::: "memory");
}
__device__ __forceinline__ void convert_weight(const float* W, int K, int N, int Npad, bf16* WT, LAS unsigned char* lds, int rot, int wv, bool ffn_perm = false) {
    const int wave = wv, lane = otid(wv) & 63; const int NGW = gridDim.x * NWAVES; const int gw = (blockIdx.x * NWAVES + wave + rot) % NGW;
    LAS float* scr = (LAS float*)(lds + wave * 16384);
    const int nitems = (K / 64) * (N / 32);
    for (int it = gw; it < nitems; it += NGW) transpose_item(W, K, N, WT, scr, it, lane, ffn_perm);
    (void)Npad;
}
__device__ __forceinline__ void convert_layer(const Args& a, int l, LAS unsigned char* lds) {
    const int i = l >> 1; unsigned char* ws = a.ws;
    convert_weight(a.in[I_WUP] + (size_t)l * D * UPW, D, UPW, UPW, (bf16*)(ws + W_UP), lds, 0, a.wv, true);
    convert_weight(a.in[I_WDN] + (size_t)l * DFF * D, DFF, D, D, (bf16*)(ws + W_DN), lds, 300, a.wv);
    if ((l & 1) == 0) {
        convert_weight(a.in[I_HIN] + (size_t)i * D * HYB_IN, D, HYB_IN, HYB_INP, (bf16*)(ws + W_IN), lds, 700, a.wv);
        convert_weight(a.in[I_HOUT] + (size_t)i * D * D, D, D, D, (bf16*)(ws + W_OUT), lds, 1100, a.wv);
        convert_weight(a.in[I_WUQ] + (size_t)i * 384 * QW, 384, QW, QW, (bf16*)(ws + W_UQ), lds, 1500, a.wv);
        convert_weight(a.in[I_WUKV] + (size_t)i * 256 * KVW, 256, KVW, KVW, (bf16*)(ws + W_UKV), lds, 1700, a.wv);
    } else {
        convert_weight(a.in[I_SIN] + (size_t)i * D * SSD_IN, D, SSD_IN, SSD_INP, (bf16*)(ws + W_IN), lds, 700, a.wv);
        convert_weight(a.in[I_SOUT] + (size_t)i * 2048 * D, 2048, D, D, (bf16*)(ws + W_OUT), lds, 1300, a.wv);
    }
}

__device__ __forceinline__ void prep_even(const Args& a, int i) {
    const int wave = otid(a.wv) >> 6, lane = otid(a.wv) & 63; const int NGW = gridDim.x * NWAVES, gw = blockIdx.x * NWAVES + wave;
    const bf16* P = (const bf16*)(a.ws + WS_P); bf16* CQN = (bf16*)(a.ws + WS_CQN); bf16* CKVN = (bf16*)(a.ws + WS_CKVN); bf16* KR = (bf16*)(a.ws + WS_KR); bf16* MIX = (bf16*)(a.ws + WS_MIX);
    const float* qn = a.in[I_QNORM] + i * 384; const float* kvn = a.in[I_KVNORM] + i * 256; const float* cw = a.in[I_SCONV] + i * 3 * 512;
    const float* ct = (const float*)(a.ws + WS_ROPE); const float* st = ct + SEQ * 16;
    for (int r = gw; r < T; r += NGW) {
        const bf16* p = P + (size_t)r * HYB_INP;
        {
            const unsigned* p32 = (const unsigned*)(p + lane * 6); const unsigned w0 = p32[0], w1 = p32[1], w2 = p32[2];
            float f[6] = {bflo(w0), bfhi(w0), bflo(w1), bfhi(w1), bflo(w2), bfhi(w2)}; float ss = 0.f;
#pragma unroll
            for (int j = 0; j < 6; ++j) ss += f[j] * f[j];
            const float rs = rsqrtf(wave_sum(ss, lane) * (1.f / 384.f) + EPS);
#pragma unroll
            for (int j = 0; j < 6; ++j) f[j] = f[j] * rs * qn[lane * 6 + j];
            unsigned* o32 = (unsigned*)(CQN + (size_t)r * 384 + lane * 6); o32[0] = pk2(f[0], f[1]); o32[1] = pk2(f[2], f[3]); o32[2] = pk2(f[4], f[5]);
        }
        {
            const v2u w = *(const v2u*)(p + 384 + lane * 4); float f[4] = {bflo(w.x), bfhi(w.x), bflo(w.y), bfhi(w.y)};
            const float ss = (f[0] * f[0] + f[1] * f[1]) + (f[2] * f[2] + f[3] * f[3]);
            const float rs = rsqrtf(wave_sum(ss, lane) * (1.f / 256.f) + EPS);
            const f32x4 g = *(const f32x4*)(kvn + lane * 4);
            v2u o; o.x = pk2(f[0] * rs * g[0], f[1] * rs * g[1]); o.y = pk2(f[2] * rs * g[2], f[3] * rs * g[3]); *(v2u*)(CKVN + (size_t)r * 256 + lane * 4) = o;
        }
        {
            const int j = lane & 31; const float v = bf1(p[640 + j]); const float o = shx(v, 16, lane); float res = v;
            if (r < TL) { const int t = r & (SEQ - 1); const float c = ct[t * 16 + (j & 15)], s = st[t * 16 + (j & 15)]; res = (j < 16) ? v * c - o * s : o * s + v * c; }
            if (lane < 32) KR[(size_t)r * 32 + j] = (bf16)f2bf(res);
        }
        {
            const int c0 = lane * 8; float gb[8], cur[8], acc[8], t0[8], t1[8];
            unpack8(*(const v4u*)(p + 672 + c0), gb);
            unpack8(*(const v4u*)(p + 1184 + c0), t0); unpack8(*(const v4u*)(p + 1696 + c0), t1);
#pragma unroll
            for (int j = 0; j < 8; ++j) { cur[j] = t0[j] * t1[j]; acc[j] = cw[512 + c0 + j] * cur[j]; }
            if (has_prev(r)) { unpack8(*(const v4u*)(p - HYB_INP + 1184 + c0), t0); unpack8(*(const v4u*)(p - HYB_INP + 1696 + c0), t1);
#pragma unroll
                for (int j = 0; j < 8; ++j) acc[j] += cw[c0 + j] * (t0[j] * t1[j]); }
            if (has_next(r)) { unpack8(*(const v4u*)(p + HYB_INP + 1184 + c0), t0); unpack8(*(const v4u*)(p + HYB_INP + 1696 + c0), t1);
#pragma unroll
                for (int j = 0; j < 8; ++j) acc[j] += cw[1024 + c0 + j] * (t0[j] * t1[j]); }
#pragma unroll
            for (int j = 0; j < 8; ++j) acc[j] *= gb[j];
            *(v4u*)(MIX + (size_t)r * D + 512 + c0) = pack8(acc);
        }
    }
}

__device__ __forceinline__ void convgate(const Args& a, int l, int nrows) {
    const bf16* U = (const bf16*)(a.ws + WS_U); bf16* G = (bf16*)(a.ws + WS_G); const float* cw = a.in[I_FCONV] + (size_t)l * 3 * UPW;
    const int total = nrows * (DFF / 8);
    for (int idx = blockIdx.x * NTHR + otid(a.wv); idx < total; idx += gridDim.x * NTHR) {
        const int r = idx / (DFF / 8), c0 = (idx % (DFF / 8)) * 8; const bf16* u = U + (size_t)r * UPW + c0;
        float ua[8], ug[8], act[8], gate[8];
        unpack8(*(const v4u*)u, ua); unpack8(*(const v4u*)(u + DFF), ug);
#pragma unroll
        for (int j = 0; j < 8; ++j) { act[j] = cw[UPW + c0 + j] * ua[j]; gate[j] = cw[UPW + DFF + c0 + j] * ug[j]; }
        if (has_prev(r)) { unpack8(*(const v4u*)(u - UPW), ua); unpack8(*(const v4u*)(u - UPW + DFF), ug);
#pragma unroll
            for (int j = 0; j < 8; ++j) { act[j] += cw[c0 + j] * ua[j]; gate[j] += cw[DFF + c0 + j] * ug[j]; } }
        if (has_next(r)) { unpack8(*(const v4u*)(u + UPW), ua); unpack8(*(const v4u*)(u + UPW + DFF), ug);
#pragma unroll
            for (int j = 0; j < 8; ++j) { act[j] += cw[2 * UPW + c0 + j] * ua[j]; gate[j] += cw[2 * UPW + DFF + c0 + j] * ug[j]; } }
#pragma unroll
        for (int j = 0; j < 8; ++j) act[j] = silu_f(act[j]) * gate[j];
        *(v4u*)(G + (size_t)r * DFF + c0) = pack8(act);
    }
}

__device__ __forceinline__ void ssd_conv(const Args& a, int i) {
    const bf16* ZX = (const bf16*)(a.ws + WS_ZX); bf16* XBC = (bf16*)(a.ws + WS_XBC); float* DT = (float*)(a.ws + WS_DT); float* AA = (float*)(a.ws + WS_AA);
    const float* cw = a.in[I_SCONVW] + (size_t)i * 3 * 3072; const float* cb = a.in[I_SCONVB] + (size_t)i * 3072;
    const int total = T * 384;
    for (int idx = blockIdx.x * NTHR + otid(a.wv); idx < total; idx += gridDim.x * NTHR) {
        const int r = idx / 384, c0 = (idx % 384) * 8; const bf16* u = ZX + (size_t)r * SSD_INP + 2048 + c0;
        float x[8], acc[8];
        unpack8(*(const v4u*)u, x);
#pragma unroll
        for (int j = 0; j < 8; ++j) acc[j] = cb[c0 + j] + cw[3072 + c0 + j] * x[j];
        if (has_prev(r)) { unpack8(*(const v4u*)(u - SSD_INP), x);
#pragma unroll
            for (int j = 0; j < 8; ++j) acc[j] += cw[c0 + j] * x[j]; }
        if (has_next(r)) { unpack8(*(const v4u*)(u + SSD_INP), x);
#pragma unroll
            for (int j = 0; j < 8; ++j) acc[j] += cw[2 * 3072 + c0 + j] * x[j]; }
#pragma unroll
        for (int j = 0; j < 8; ++j) acc[j] = silu_f(acc[j]);
        *(v4u*)(XBC + (size_t)r * 3072 + c0) = pack8(acc);
    }
    const float* alog = a.in[I_ALOG] + i * 64; const float* dtb = a.in[I_DTB] + i * 64;
    for (int idx = blockIdx.x * NTHR + otid(a.wv); idx < T * 64; idx += gridDim.x * NTHR) {
        const int r = idx >> 6, j = idx & 63; const float raw = bf1(ZX[(size_t)r * SSD_INP + 5120 + j]) + dtb[j];
        const float dt = raw > 15.f ? raw : (raw < -15.f ? __expf(raw) : __logf(1.f + __expf(raw)));
        DT[idx] = dt; AA[idx] = -__expf(alog[j]) * dt;
    }
}

__device__ __forceinline__ void gatenorm(const Args& a, int i, int nrows) {
    const int wave = otid(a.wv) >> 6, lane = otid(a.wv) & 63; const int NGW = gridDim.x * NWAVES, gw = blockIdx.x * NWAVES + wave;
    const bf16* ZX = (const bf16*)(a.ws + WS_ZX); bf16* YN = (bf16*)(a.ws + WS_XBC); const float* nw = a.in[I_SNORM] + i * 2048;
    for (int r = gw; r < nrows; r += NGW) {
        float v[4][8]; float ss = 0.f;
#pragma unroll
        for (int j = 0; j < 4; ++j) { float y[8], z[8]; const int c = j * 512 + lane * 8;
            unpack8(*(const v4u*)(ZX + (size_t)r * SSD_INP + 2048 + c), y); unpack8(*(const v4u*)(ZX + (size_t)r * SSD_INP + c), z);
#pragma unroll
            for (int k = 0; k < 8; ++k) { v[j][k] = y[k] * silu_f(z[k]); ss += v[j][k] * v[j][k]; } }
        const float rs = rsqrtf(wave_sum(ss, lane) * (1.f / 2048.f) + EPS);
#pragma unroll
        for (int j = 0; j < 4; ++j) { const int c = j * 512 + lane * 8; float o[8];
#pragma unroll
            for (int k = 0; k < 8; ++k) o[k] = v[j][k] * rs * nw[c + k];
            *(v4u*)(YN + (size_t)r * 2048 + c) = pack8(o); }
    }
}

__device__ __forceinline__ void attn_naive(const Args& a, LAS unsigned char* lds) {
    const int tid = otid(a.wv), qi = tid >> 1, half = tid & 1;
    const bf16* Qb = (const bf16*)(a.ws + WS_Q); const bf16* KVb = (const bf16*)(a.ws + WS_KV); const bf16* KR = (const bf16*)(a.ws + WS_KR); bf16* MIX = (bf16*)(a.ws + WS_MIX);
    const float* ct = (const float*)(a.ws + WS_ROPE); const float* st = ct + SEQ * 16;
    LAS float* Kt = (LAS float*)lds;
    LAS float* Vt = (LAS float*)(lds + 64 * 96 * 4);
    for (int u = blockIdx.x; u < 576; u += gridDim.x) {
        const bool lat = u < 512; const int b = lat ? (u >> 6) : ((u - 512) >> 3), h = lat ? ((u >> 3) & 7) : ((u - 512) & 7);
        const int nkeys = lat ? (CTXL + SEQ) : CTXL;
        const int qrow = lat ? b * SEQ + (u & 7) * 256 + qi : TL + b * CTXL + qi;
        float q[48];
#pragma unroll
        for (int g = 0; g < 6; ++g) { float f[8]; unpack8(*(const v4u*)(Qb + (size_t)qrow * QW + h * 96 + half * 48 + g * 8), f);
#pragma unroll
            for (int j = 0; j < 8; ++j) q[g * 8 + j] = f[j]; }
        if (lat && half == 1) { const int t = qrow & (SEQ - 1);
#pragma unroll
            for (int j = 0; j < 16; ++j) { const float c = ct[t * 16 + j], s = st[t * 16 + j]; const float x1 = q[16 + j], x2 = q[32 + j]; q[16 + j] = x1 * c - x2 * s; q[32 + j] = x1 * s + x2 * c; } }
#pragma unroll
        for (int j = 0; j < 48; ++j) q[j] *= ATT_SCALE_LOG2E;
        float o[32]; float m = -1e30f, l = 0.f;
#pragma unroll
        for (int j = 0; j < 32; ++j) o[j] = 0.f;
        for (int k0 = 0; k0 < nkeys; k0 += 64) {
            __syncthreads();
            for (int g = tid; g < 768; g += NTHR) { const int key = g / 12, part = g % 12; const int kk = k0 + key; const int krow = kk < CTXL ? TL + b * CTXL + kk : b * SEQ + kk - CTXL;
                float f[8]; unpack8(part < 8 ? *(const v4u*)(KVb + (size_t)krow * KVW + h * 128 + part * 8) : *(const v4u*)(KR + (size_t)krow * 32 + (part - 8) * 8), f);
#pragma unroll
                for (int j = 0; j < 8; ++j) Kt[key * 96 + part * 8 + j] = f[j]; }
            { const int key = tid >> 3, part = tid & 7; const int kk = k0 + key; const int krow = kk < CTXL ? TL + b * CTXL + kk : b * SEQ + kk - CTXL;
                float f[8]; unpack8(*(const v4u*)(KVb + (size_t)krow * KVW + h * 128 + 64 + part * 8), f);
#pragma unroll
                for (int j = 0; j < 8; ++j) Vt[key * 64 + part * 8 + j] = f[j]; }
            __syncthreads();
            for (int kg = 0; kg < 64; kg += 8) {
                float s[8]; float gm = -1e30f;
#pragma unroll
                for (int kk = 0; kk < 8; ++kk) { float acc = 0.f; const LAS f32x4* kp = (const LAS f32x4*)(Kt + (kg + kk) * 96 + half * 48);
#pragma unroll
                    for (int d4 = 0; d4 < 12; ++d4) { const f32x4 kv = kp[d4]; acc += q[d4 * 4] * kv[0] + q[d4 * 4 + 1] * kv[1] + q[d4 * 4 + 2] * kv[2] + q[d4 * 4 + 3] * kv[3]; }
                    acc += shx(acc, 1, tid & 63);
                    s[kk] = acc; gm = fmaxf(gm, acc); }
                const float mn = fmaxf(m, gm); const float alpha = exp2f(m - mn); m = mn; l *= alpha;
#pragma unroll
                for (int j = 0; j < 32; ++j) o[j] *= alpha;
#pragma unroll
                for (int kk = 0; kk < 8; ++kk) { const float p = exp2f(s[kk] - mn); l += p; const LAS f32x4* vp = (const LAS f32x4*)(Vt + (kg + kk) * 64 + half * 32);
#pragma unroll
                    for (int d4 = 0; d4 < 8; ++d4) { const f32x4 vv = vp[d4]; o[d4 * 4] += p * vv[0]; o[d4 * 4 + 1] += p * vv[1]; o[d4 * 4 + 2] += p * vv[2]; o[d4 * 4 + 3] += p * vv[3]; } }
            }
        }
        { const float inv = 1.f / l;
#pragma unroll
            for (int g = 0; g < 4; ++g) { float f[8];
#pragma unroll
                for (int j = 0; j < 8; ++j) f[j] = o[g * 8 + j] * inv;
                *(v4u*)(MIX + (size_t)qrow * D + h * 64 + half * 32 + g * 8) = pack8(f); } }
    }
}

__device__ __forceinline__ void ssd_scan_naive(const Args& a, int i, bool last, LAS unsigned char* lds) {
    const int tid = otid(a.wv), p = tid >> 3, nq = tid & 7;
    bf16* ZX = (bf16*)(a.ws + WS_ZX); const bf16* XBC = (const bf16*)(a.ws + WS_XBC); const float* DT = (const float*)(a.ws + WS_DT); const float* AA = (const float*)(a.ws + WS_AA);
    LAS float* xs = (LAS float*)lds;
    LAS float* Bs = (LAS float*)(lds + 16384);
    LAS float* Cs = (LAS float*)(lds + 16384 + 32768);
    LAS float* dts = (LAS float*)(lds + 16384 + 65536);
    LAS float* as = dts + 64;
    for (int it = blockIdx.x; it < NB * 32; it += gridDim.x) {
        const int b = it >> 5, h = it & 31, g = h >> 3; const float dsk = a.in[I_SD][i * 32 + h];
        for (int dir = 0; dir < 2; ++dir) {
            float stt[16];
#pragma unroll
            for (int n = 0; n < 16; ++n) stt[n] = 0.f;
            for (int seg = 0; seg < 2; ++seg) {
                const int len = seg == 0 ? CTXL : SEQ; const int base = seg == 0 ? TL + b * CTXL : b * SEQ; const bool want_y = !(last && seg == 0);
                for (int cc = 0; cc < len / 64; ++cc) {
                    const int t0 = dir == 0 ? cc * 64 : len - 64 - cc * 64;
                    __syncthreads();
                    { const int tt = tid >> 3, part = tid & 7; float f[8]; unpack8(*(const v4u*)(XBC + (size_t)(base + t0 + tt) * 3072 + h * 64 + part * 8), f);
#pragma unroll
                        for (int j = 0; j < 8; ++j) xs[tt * 64 + part * 8 + j] = f[j]; }
                    for (int q = tid; q < 1024; q += NTHR) { const int tt = q >> 4, part = q & 15; float f[8];
                        unpack8(*(const v4u*)(XBC + (size_t)(base + t0 + tt) * 3072 + 2048 + g * 128 + part * 8), f);
#pragma unroll
                        for (int j = 0; j < 8; ++j) Bs[tt * 128 + part * 8 + j] = f[j];
                        unpack8(*(const v4u*)(XBC + (size_t)(base + t0 + tt) * 3072 + 2560 + g * 128 + part * 8), f);
#pragma unroll
                        for (int j = 0; j < 8; ++j) Cs[tt * 128 + part * 8 + j] = f[j]; }
                    if (tid < 64) { dts[tid] = DT[(size_t)(base + t0 + tid) * 64 + dir * 32 + h]; as[tid] = AA[(size_t)(base + t0 + tid) * 64 + dir * 32 + h]; }
                    __syncthreads();
                    for (int s = 0; s < 64; ++s) {
                        const int tt = dir == 0 ? s : 63 - s;
                        const float dec = __expf(as[tt]); const float xv = xs[tt * 64 + p]; const float xd = xv * dts[tt];
                        const LAS f32x4* bp = (const LAS f32x4*)(Bs + tt * 128 + nq * 16); const LAS f32x4* cp = (const LAS f32x4*)(Cs + tt * 128 + nq * 16);
                        float acc = 0.f;
#pragma unroll
                        for (int n4 = 0; n4 < 4; ++n4) { const f32x4 bv = bp[n4], cv = cp[n4];
#pragma unroll
                            for (int k = 0; k < 4; ++k) { stt[n4 * 4 + k] = dec * stt[n4 * 4 + k] + xd * bv[k]; acc += cv[k] * stt[n4 * 4 + k]; } }
                        acc += shx(acc, 1, tid & 63); acc += shx(acc, 2, tid & 63); acc += shx(acc, 4, tid & 63);
                        if (want_y && nq == 0) { bf16* yp = ZX + (size_t)(base + t0 + tt) * SSD_INP + 2048 + h * 64 + p;
                            const float y = dir == 0 ? acc + dsk * xv : acc + bf1(*yp);
                            *yp = (bf16)f2bf(y); }
                    }
                }
            }
            __syncthreads();
            asm volatile("s_waitcnt vmcnt(0)" ::: "memory");
        }
    }
}

typedef short bf16x8 __attribute__((ext_vector_type(8)));
typedef float f32x16 __attribute__((ext_vector_type(16)));
typedef short v4i16_t __attribute__((ext_vector_type(4)));
__device__ __forceinline__ v2u trread(const LAS unsigned char* p) { return __builtin_bit_cast(v2u, __builtin_amdgcn_ds_read_tr16_b64_v4i16((LAS v4i16_t*)p)); }
__device__ __forceinline__ unsigned cvtpk(float lo, float hi) { unsigned r; asm volatile("v_cvt_pk_bf16_f32 %0, %1, %2" : "=v"(r) : "v"(lo), "v"(hi)); return r; }
constexpr int ATT_KP = 208, ATT_VP = 192, ATT_KB = 64 * ATT_KP, ATT_VB = 64 * ATT_VP, ATT_BUF = ATT_KB + ATT_VB;
#ifndef ATT_NQ
#define ATT_NQ 2
#endif
template <int NQ>
__device__ __forceinline__ void attn_unit3(const Args& a, LAS unsigned char* lds, const int b, const int h, const int q0, const int ntiles, const bool lat) {
    const int tid = otid(a.wv), wave = tid >> 6, lane = tid & 63, r32 = lane & 31, hh = lane >> 5;
    const int tq = (lane >> 2) & 3, tp = lane & 3, tblk = (lane >> 4) & 1;
    const bf16* Qb = (const bf16*)(a.ws + WS_Q); const bf16* KVb = (const bf16*)(a.ws + WS_KV); const bf16* KR = (const bf16*)(a.ws + WS_KR); bf16* MIX = (bf16*)(a.ws + WS_MIX);
    const float* ct = (const float*)(a.ws + WS_ROPE); const float* st = ct + SEQ * 16;
    bf16x8 qf[NQ][6];
#pragma unroll
    for (int nq = 0; nq < NQ; ++nq) { const int qrow = q0 + wave * (32 * NQ) + nq * 32 + r32;
#pragma unroll
        for (int s = 0; s < 6; ++s) qf[nq][s] = *(const bf16x8*)(Qb + (size_t)qrow * QW + h * 96 + 16 * s + 8 * hh);
        if (lat) { const int t = qrow & (SEQ - 1);
#pragma unroll
            for (int j = 0; j < 8; j += 2) { float x1[2], x2[2], y1[2], y2[2];
#pragma unroll
                for (int e = 0; e < 2; ++e) { x1[e] = bf1((bf16)qf[nq][4][j + e]); x2[e] = bf1((bf16)qf[nq][5][j + e]); const float c = ct[t * 16 + 8 * hh + j + e], s = st[t * 16 + 8 * hh + j + e];
                    y1[e] = x1[e] * c - x2[e] * s; y2[e] = x1[e] * s + x2[e] * c; }
                const unsigned w1 = pk2(y1[0], y1[1]), w2 = pk2(y2[0], y2[1]);
                qf[nq][4][j] = (short)(w1 & 0xffff); qf[nq][4][j + 1] = (short)(w1 >> 16); qf[nq][5][j] = (short)(w2 & 0xffff); qf[nq][5][j + 1] = (short)(w2 >> 16); } } }
    f32x16 o0[NQ], o1[NQ]; float m[NQ], l[NQ];
#pragma unroll
    for (int nq = 0; nq < NQ; ++nq) { m[nq] = -1e30f; l[nq] = 0.f;
#pragma unroll
        for (int i = 0; i < 16; ++i) { o0[nq][i] = 0.f; o1[nq][i] = 0.f; } }
    v4u kreg0, kreg1, vreg;
#define ATT_LOAD(it) do { const int rb_ = (it) < CTXL / 64 ? TL + b * CTXL + (it) * 64 : b * SEQ + ((it) - CTXL / 64) * 64; \
        const char* kvb_ = (const char*)(KVb + (size_t)rb_ * KVW); const char* krb_ = (const char*)(KR + (size_t)rb_ * 32); \
        kreg0 = *(const v4u*)(kvb_ + (tid >> 3) * 2048 + h * 256 + (tid & 7) * 16); if (tid < 256) kreg1 = *(const v4u*)(krb_ + (tid >> 2) * 64 + (tid & 3) * 16); vreg = *(const v4u*)(kvb_ + (tid >> 3) * 2048 + h * 256 + 128 + (tid & 7) * 16); } while (0)
#define ATT_WRITE(buf) do { LAS unsigned char* kb_ = lds + (buf) * ATT_BUF; LAS unsigned char* vb_ = kb_ + ATT_KB; \
        *(LAS v4u*)(kb_ + (tid >> 3) * ATT_KP + (tid & 7) * 16) = kreg0; if (tid < 256) *(LAS v4u*)(kb_ + (tid >> 2) * ATT_KP + 128 + (tid & 3) * 16) = kreg1; \
        *(LAS v4u*)(vb_ + (tid >> 3) * ATT_VP + (tid & 7) * 16) = vreg; } while (0)
    __syncthreads();
    ATT_LOAD(0); ATT_WRITE(0);
    __syncthreads();
    for (int it = 0; it < ntiles; ++it) {
#ifndef ATT_LOADMID
        if (it + 1 < ntiles) ATT_LOAD(it + 1);
#endif
#ifdef ATT_TZ
        int tz = tid; asm volatile("" : "+v"(tz));
        const int lane = tz & 63, r32 = lane & 31, hh = lane >> 5, tq = (lane >> 2) & 3, tp = lane & 3, tblk = (lane >> 4) & 1;
#endif
        const LAS unsigned char* kb = lds + (it & 1) * ATT_BUF; const LAS unsigned char* vb = kb + ATT_KB;
#pragma unroll
        for (int t = 0; t < 2; ++t) {
            f32x16 sc[NQ]; bf16x8 pf[NQ][2];
#pragma unroll
            for (int nq = 0; nq < NQ; ++nq)
#pragma unroll
                for (int i = 0; i < 16; ++i) sc[nq][i] = 0.f;
#pragma unroll
            for (int s = 0; s < 6; ++s) { const bf16x8 a0 = *(const LAS bf16x8*)(kb + (32 * t + r32) * ATT_KP + (16 * s + 8 * hh) * 2);
#pragma unroll
                for (int nq = 0; nq < NQ; ++nq) sc[nq] = __builtin_amdgcn_mfma_f32_32x32x16_bf16(a0, qf[nq][s], sc[nq], 0, 0, 0); }
#ifdef ATT_LOADMID
            if (t == 0 && it + 1 < ntiles) ATT_LOAD(it + 1);
#endif
#pragma unroll
            for (int nq = 0; nq < NQ; ++nq) {
                float mx = sc[nq][0];
#pragma unroll
                for (int i = 1; i < 16; ++i) mx = fmaxf(mx, sc[nq][i]);
                mx = fmaxf(mx, shx(mx, 32, lane));
                const float mn = fmaxf(m[nq], mx * ATT_SCALE_LOG2E); const float alpha = __builtin_amdgcn_exp2f(m[nq] - mn); m[nq] = mn;
                float rs = 0.f;
#pragma unroll
                for (int i = 0; i < 16; ++i) { sc[nq][i] = __builtin_amdgcn_exp2f(sc[nq][i] * ATT_SCALE_LOG2E - mn); rs += sc[nq][i]; }
                l[nq] = l[nq] * alpha + rs;
#pragma unroll
                for (int i = 0; i < 16; ++i) { o0[nq][i] *= alpha; o1[nq][i] *= alpha; }
#pragma unroll
                for (int s2 = 0; s2 < 2; ++s2) { v4u w0;
                    w0.x = cvtpk(sc[nq][8 * s2 + 0], sc[nq][8 * s2 + 1]); w0.y = cvtpk(sc[nq][8 * s2 + 2], sc[nq][8 * s2 + 3]); w0.z = cvtpk(sc[nq][8 * s2 + 4], sc[nq][8 * s2 + 5]); w0.w = cvtpk(sc[nq][8 * s2 + 6], sc[nq][8 * s2 + 7]);
                    pf[nq][s2] = __builtin_bit_cast(bf16x8, w0); }
            }
#pragma unroll
            for (int s2 = 0; s2 < 2; ++s2) { const int ko = t * 32 + 16 * s2 + 4 * hh;
                { const LAS unsigned char* tb = vb + (ko + tq) * ATT_VP + (16 * tblk + 4 * tp) * 2; const v2u lo = trread(tb), hi = trread(tb + 8 * ATT_VP); const bf16x8 vf = __builtin_bit_cast(bf16x8, (v4u){lo.x, lo.y, hi.x, hi.y});
#pragma unroll
                  for (int nq = 0; nq < NQ; ++nq) o0[nq] = __builtin_amdgcn_mfma_f32_32x32x16_bf16(vf, pf[nq][s2], o0[nq], 0, 0, 0); }
                { const LAS unsigned char* tb = vb + (ko + tq) * ATT_VP + (32 + 16 * tblk + 4 * tp) * 2; const v2u lo = trread(tb), hi = trread(tb + 8 * ATT_VP); const bf16x8 vf = __builtin_bit_cast(bf16x8, (v4u){lo.x, lo.y, hi.x, hi.y});
#pragma unroll
                  for (int nq = 0; nq < NQ; ++nq) o1[nq] = __builtin_amdgcn_mfma_f32_32x32x16_bf16(vf, pf[nq][s2], o1[nq], 0, 0, 0); } }
        }
        if (it + 1 < ntiles) ATT_WRITE((it + 1) & 1);
        __syncthreads();
    }
#undef ATT_LOAD
#undef ATT_WRITE
#pragma unroll
    for (int nq = 0; nq < NQ; ++nq) { const int qrow = q0 + wave * (32 * NQ) + nq * 32 + r32;
        const float lsum = l[nq] + shx(l[nq], 32, lane); const float inv = 1.f / lsum;
        bf16* orow = MIX + (size_t)qrow * D + h * 64 + 4 * hh;
#pragma unroll
        for (int g = 0; g < 4; ++g) {
            v2u w; w.x = pk2(o0[nq][4 * g] * inv, o0[nq][4 * g + 1] * inv); w.y = pk2(o0[nq][4 * g + 2] * inv, o0[nq][4 * g + 3] * inv); *(v2u*)(orow + 8 * g) = w;
            v2u x; x.x = pk2(o1[nq][4 * g] * inv, o1[nq][4 * g + 1] * inv); x.y = pk2(o1[nq][4 * g + 2] * inv, o1[nq][4 * g + 3] * inv); *(v2u*)(orow + 32 + 8 * g) = x; } }
}
__device__ __forceinline__ void attn_mfma(const Args& a, LAS unsigned char* lds) {
#if ATT_NQ == 2
    for (int u = blockIdx.x; u < 256; u += gridDim.x) attn_unit3<2>(a, lds, u >> 5, (u >> 2) & 7, (u >> 5) * SEQ + (u & 3) * 512, (CTXL + SEQ) / 64, true);
#else
    for (int u = blockIdx.x; u < 512; u += gridDim.x) attn_unit3<1>(a, lds, u >> 6, (u >> 3) & 7, (u >> 6) * SEQ + (u & 7) * 256, (CTXL + SEQ) / 64, true);
#endif
    for (int u = blockIdx.x; u < 64; u += gridDim.x) attn_unit3<1>(a, lds, u >> 3, u & 7, TL + (u >> 3) * CTXL, CTXL / 64, false);
}

#ifndef SSD_YREP
#define SSD_YREP 1
#endif
#ifndef SSD_WREP
#define SSD_WREP 1
#endif
constexpr int SP_B = 272, SP_X = 192;
constexpr int SO_B = 0, SO_C = SO_B + 128 * SP_B, SO_XD = SO_C + 128 * SP_B, SO_XW = SO_XD + 128 * SP_X, SO_S = SO_XW + 128 * SP_X, SO_V = SO_S + 64 * SP_B;
static_assert(SO_V + 2 * 2048 <= LDS_BYTES, "ssd lds map");
#ifdef SSD_DIAG
#define SSD_T(v) long long v = clock64()
#define SSD_ACC(k, v) do { const long long n_ = clock64(); dacc[k] += n_ - v; v = n_; } while (0)
#else
#define SSD_T(v) do {} while (0)
#define SSD_ACC(k, v) do {} while (0)
#endif
__device__ __forceinline__ void ssd_scan_mfma(const Args& a, int i, bool last, LAS unsigned char* lds) {
#ifdef SSD_DIAG
    long long dacc[8] = {0, 0, 0, 0, 0, 0, 0, 0};
#endif
    const int tid = otid(a.wv), wave = tid >> 6, lane = tid & 63, r32 = lane & 31, hh = lane >> 5;
    const int pt = wave >> 2, lt = pt ? 3 - (wave & 3) : (wave & 3);
    const int tq = (lane >> 2) & 3, tp = lane & 3, tblk = (lane >> 4) & 1;
    bf16* ZX = (bf16*)(a.ws + WS_ZX); const bf16* XBC = (const bf16*)(a.ws + WS_XBC); const float* DT = (const float*)(a.ws + WS_DT); const float* AA = (const float*)(a.ws + WS_AA);
    LAS unsigned char* Bl = lds + SO_B; LAS unsigned char* Cl = lds + SO_C; LAS unsigned char* XDl = lds + SO_XD; LAS unsigned char* XWl = lds + SO_XW; LAS unsigned char* Sl = lds + SO_S;
    const int brow = tid >> 4, bpart = tid & 15, xrow = tid >> 3, xpart = tid & 7;
    for (int it = blockIdx.x; it < NB * 32; it += gridDim.x) {
        const int b = it >> 5, h = it & 31, g = h >> 3; const float dsk = a.in[I_SD][i * 32 + h];
        for (int dir = 0; dir < 2; ++dir) {
            const int scanw = dir == 0 ? 0 : 3;
            f32x16 sacc;
#pragma unroll
            for (int k = 0; k < 16; ++k) sacc[k] = 0.f;
            SSD_T(tprev);
            v4u bq[4], cq[4], xq[2]; float pa0 = 0.f, pa1 = 0.f, pd0 = 0.f, pd1 = 0.f, qa0 = 0.f, qa1 = 0.f, qd0 = 0.f, qd1 = 0.f; v2u add[4], addn[4];
#define SSD_ROWBASE(c) ((c) < 2 ? TL + b * CTXL + (dir == 0 ? (c) : 1 - (c)) * 128 : b * SEQ + (dir == 0 ? (c) - 2 : 17 - (c)) * 128)
#define SSD_PF(c) do { const int rb_ = SSD_ROWBASE(c); \
                _Pragma("unroll") for (int k_ = 0; k_ < 4; ++k_) { const bf16* src_ = XBC + (size_t)(rb_ + brow + 32 * k_) * 3072 + 2048 + g * 128 + bpart * 8; bq[k_] = *(const v4u*)src_; cq[k_] = *(const v4u*)(src_ + 512); } \
                _Pragma("unroll") for (int k_ = 0; k_ < 2; ++k_) xq[k_] = *(const v4u*)(XBC + (size_t)(rb_ + xrow + 64 * k_) * 3072 + h * 64 + xpart * 8); \
                } while (0)
#define SSD_PFV(c) do { if (wave == scanw) { const int rb_ = SSD_ROWBASE(c); const size_t o_ = (size_t)(rb_ + 2 * lane) * 64 + dir * 32 + h; qa0 = AA[o_]; qa1 = AA[o_ + 64]; qd0 = DT[o_]; qd1 = DT[o_ + 64]; } } while (0)
#define SSD_PFY(c) do { const int rb_ = SSD_ROWBASE(c); const size_t r_ = (size_t)(rb_ + 32 * lt + r32); \
                _Pragma("unroll") for (int q_ = 0; q_ < 4; ++q_) addn[q_] = dir == 0 ? *(const v2u*)(XBC + r_ * 3072 + h * 64 + 32 * pt + 4 * hh + 8 * q_) : *(const v2u*)(ZX + r_ * SSD_INP + 2048 + h * 64 + 32 * pt + 4 * hh + 8 * q_); } while (0)
#define SSD_SCAN(vb_) do { if (wave == scanw) { LAS float* V_ = (LAS float*)(lds + SO_V + (vb_) * 2048); const float pair_ = pa0 + pa1; float ps_ = pair_; \
                _Pragma("unroll") for (int d_ = 1; d_ < 64; d_ <<= 1) { const int src_ = dir == 0 ? lane - d_ : lane + d_; const float t_ = __builtin_bit_cast(float, __builtin_amdgcn_ds_bpermute((src_ & 63) << 2, __builtin_bit_cast(int, ps_))); if (src_ >= 0 && src_ < 64) ps_ += t_; } \
                const float tot_ = __builtin_bit_cast(float, __builtin_amdgcn_ds_bpermute((dir == 0 ? 63 : 0) << 2, __builtin_bit_cast(int, ps_))); const float ex_ = ps_ - pair_; \
                float c0_, c1_; if (dir == 0) { c0_ = ex_ + pa0; c1_ = c0_ + pa1; } else { c1_ = ex_ + pa1; c0_ = c1_ + pa0; } \
                V_[2 * lane] = c0_; V_[2 * lane + 1] = c1_; V_[128 + 2 * lane] = pd0; V_[128 + 2 * lane + 1] = pd1; V_[256 + 2 * lane] = pd0 * __expf(tot_ - c0_); V_[256 + 2 * lane + 1] = pd1 * __expf(tot_ - c1_); \
                if (lane == 0) V_[384] = tot_; } } while (0)
#define SSD_WRITE(vb_) do { const LAS float* V_ = (const LAS float*)(lds + SO_V + (vb_) * 2048); \
                _Pragma("unroll") for (int k_ = 0; k_ < 4; ++k_) { *(LAS v4u*)(Bl + (brow + 32 * k_) * SP_B + bpart * 16) = bq[k_]; *(LAS v4u*)(Cl + (brow + 32 * k_) * SP_B + bpart * 16) = cq[k_]; } \
                _Pragma("unroll") for (int k_ = 0; k_ < 2; ++k_) { const int s_ = xrow + 64 * k_; const float dt_ = V_[128 + s_], w_ = V_[256 + s_]; float f_[8], g_[8]; unpack8(xq[k_], f_); \
                    _Pragma("unroll") for (int j_ = 0; j_ < 8; ++j_) { g_[j_] = f_[j_] * w_; f_[j_] *= dt_; } \
                    *(LAS v4u*)(XDl + s_ * SP_X + xpart * 16) = pack8(f_); *(LAS v4u*)(XWl + s_ * SP_X + xpart * 16) = pack8(g_); } } while (0)
            __syncthreads();
            SSD_PFV(0); pa0 = qa0; pa1 = qa1; pd0 = qd0; pd1 = qd1; SSD_PFV(1); SSD_PFY(0); SSD_PF(0);
            { const float t0_ = qa0, t1_ = qa1, t2_ = qd0, t3_ = qd1; SSD_SCAN(0); pa0 = t0_; pa1 = t1_; pd0 = t2_; pd1 = t3_; }
#pragma unroll
            for (int q = 0; q < 4; ++q) add[q] = addn[q];
            __syncthreads();
            SSD_WRITE(0);
            { LAS v2u* sp = (LAS v2u*)(Sl + (32 * pt + r32) * SP_B + (32 * lt + 4 * hh) * 2);
#pragma unroll
              for (int q = 0; q < 4; ++q) sp[2 * q] = (v2u){0u, 0u}; }
            __syncthreads();
            SSD_ACC(0, tprev);
            for (int c = 0; c < 18; ++c) {
                const int cur = c & 1; const LAS float* V = (const LAS float*)(lds + SO_V + cur * 2048);
                const int rowbase = SSD_ROWBASE(c); const bool want_y = !(last && c < 2);
                if (c + 1 < 18) { if (!(last && c + 1 < 2)) SSD_PFY(c + 1); if (c + 2 < 18) SSD_PFV(c + 2); SSD_PF(c + 1); }
                SSD_ACC(1, tprev);
                for (int yrep = 0; yrep < SSD_YREP; ++yrep)
                if (want_y) {
                    const int l = 32 * lt + r32; const float cl = V[l];
                    bf16* yptr = ZX + (size_t)(rowbase + l) * SSD_INP + 2048 + h * 64 + 32 * pt + 4 * hh;
                    bf16x8 cf[8];
#pragma unroll
                    for (int ks = 0; ks < 8; ++ks) cf[ks] = *(const LAS bf16x8*)(Cl + l * SP_B + (16 * ks + 8 * hh) * 2);
                    f32x16 y1, y2;
#pragma unroll
                    for (int k = 0; k < 16; ++k) { y1[k] = 0.f; y2[k] = 0.f; }
                    const int st_lo = dir == 0 ? 0 : lt, st_hi = dir == 0 ? lt : 3;
#pragma unroll
                    for (int st = 0; st < 4; ++st) if (st >= st_lo && st <= st_hi) {
                        f32x16 X;
#pragma unroll
                        for (int k = 0; k < 16; ++k) X[k] = 0.f;
#pragma unroll
                        for (int ks = 0; ks < 8; ++ks) { const bf16x8 af = *(const LAS bf16x8*)(Bl + (32 * st + r32) * SP_B + (16 * ks + 8 * hh) * 2); X = __builtin_amdgcn_mfma_f32_32x32x16_bf16(af, cf[ks], X, 0, 0, 0); }
#pragma unroll
                        for (int q = 0; q < 4; ++q) { const f32x4 cs = *(const LAS f32x4*)(V + 32 * st + 8 * q + 4 * hh);
#pragma unroll
                            for (int e = 0; e < 4; ++e) { const int s = 32 * st + 8 * q + 4 * hh + e; const bool ok = dir == 0 ? (s <= l) : (s >= l);
                                const float dec = __expf(fminf(cl - cs[e], 0.f)); X[4 * q + e] = ok ? X[4 * q + e] * dec : 0.f; } }
#pragma unroll
                        for (int ks2 = 0; ks2 < 2; ++ks2) { v4u w; w.x = cvtpk(X[8 * ks2 + 0], X[8 * ks2 + 1]); w.y = cvtpk(X[8 * ks2 + 2], X[8 * ks2 + 3]); w.z = cvtpk(X[8 * ks2 + 4], X[8 * ks2 + 5]); w.w = cvtpk(X[8 * ks2 + 6], X[8 * ks2 + 7]);
                            const LAS unsigned char* tb = XDl + (32 * st + 16 * ks2 + 4 * hh + tq) * SP_X + (32 * pt + 16 * tblk + 4 * tp) * 2;
                            const v2u lo = trread(tb), hi = trread(tb + 8 * SP_X);
                            y1 = __builtin_amdgcn_mfma_f32_32x32x16_bf16(__builtin_bit_cast(bf16x8, (v4u){lo.x, lo.y, hi.x, hi.y}), __builtin_bit_cast(bf16x8, w), y1, 0, 0, 0); }
                    }
#pragma unroll
                    for (int ks = 0; ks < 8; ++ks) { const bf16x8 sf = *(const LAS bf16x8*)(Sl + (32 * pt + r32) * SP_B + (16 * ks + 8 * hh) * 2); y2 = __builtin_amdgcn_mfma_f32_32x32x16_bf16(sf, cf[ks], y2, 0, 0, 0); }
                    const float el = __expf(cl);
#pragma unroll
                    for (int q = 0; q < 4; ++q) { float o[4];
#pragma unroll
                        for (int e = 0; e < 4; ++e) o[e] = y1[4 * q + e] + el * y2[4 * q + e];
                        const float a0 = bflo(add[q].x), a1 = bfhi(add[q].x), a2 = bflo(add[q].y), a3 = bfhi(add[q].y);
                        if (dir == 0) { o[0] += dsk * a0; o[1] += dsk * a1; o[2] += dsk * a2; o[3] += dsk * a3; } else { o[0] += a0; o[1] += a1; o[2] += a2; o[3] += a3; }
                        v2u w; w.x = pk2(o[0], o[1]); w.y = pk2(o[2], o[3]); *(v2u*)(yptr + 8 * q) = w; }
                }
                SSD_ACC(2, tprev);
                if (c + 1 < 18) {
                    const float etot = __expf(V[384]);
#pragma unroll
                    for (int k = 0; k < 16; ++k) sacc[k] *= etot;
#pragma unroll
                    for (int ks = 0; ks < 8; ++ks) {
                        const LAS unsigned char* ta = Bl + (16 * ks + 8 * hh + tq) * SP_B + (32 * lt + 16 * tblk + 4 * tp) * 2;
                        const LAS unsigned char* tb = XWl + (16 * ks + 8 * hh + tq) * SP_X + (32 * pt + 16 * tblk + 4 * tp) * 2;
                        const v2u alo = trread(ta), ahi = trread(ta + 4 * SP_B), blo = trread(tb), bhi = trread(tb + 4 * SP_X);
                        sacc = __builtin_amdgcn_mfma_f32_32x32x16_bf16(__builtin_bit_cast(bf16x8, (v4u){alo.x, alo.y, ahi.x, ahi.y}), __builtin_bit_cast(bf16x8, (v4u){blo.x, blo.y, bhi.x, bhi.y}), sacc, 0, 0, 0); }
                    SSD_SCAN(cur ^ 1); pa0 = qa0; pa1 = qa1; pd0 = qd0; pd1 = qd1;
                }
                SSD_ACC(3, tprev);
                __syncthreads();
                SSD_ACC(4, tprev);
                if (c + 1 < 18) {
                    LAS v2u* sp = (LAS v2u*)(Sl + (32 * pt + r32) * SP_B + (32 * lt + 4 * hh) * 2);
#pragma unroll
                    for (int q = 0; q < 4; ++q) { v2u w; w.x = cvtpk(sacc[4 * q], sacc[4 * q + 1]); w.y = cvtpk(sacc[4 * q + 2], sacc[4 * q + 3]); sp[2 * q] = w; }
                    for (int wrep = 0; wrep < SSD_WREP; ++wrep) { SSD_WRITE(cur ^ 1); }
#pragma unroll
                    for (int q = 0; q < 4; ++q) add[q] = addn[q];
                }
                SSD_ACC(5, tprev);
                __syncthreads();
                SSD_ACC(6, tprev);
            }
#undef SSD_ROWBASE
#undef SSD_PF
#undef SSD_PFV
#undef SSD_PFY
#undef SSD_SCAN
#undef SSD_WRITE
            asm volatile("s_waitcnt vmcnt(0)" ::: "memory");
        }
    }
#ifdef SSD_DIAG
    if (blockIdx.x == 0 && wave == SSD_DIAG_WAVE && lane == 0 && i == 0) { float* dg = (float*)(a.ws + WS_MOD + 900 * 1024); long long tot = 0;
        for (int k = 0; k < 7; ++k) tot += dacc[k];
        for (int k = 0; k < 7; ++k) dg[k] = (float)dacc[k]; dg[7] = (float)tot; }
#endif
}

constexpr int AT2_KP = 208, AT2_VP = 192, AT2_KB = 64 * AT2_KP, AT2_VB = 64 * AT2_VP, AT2_BUF = AT2_KB + AT2_VB;
template <int NQ>
__device__ __forceinline__ void attn_unit2(const Args& a, LAS unsigned char* lds, int b, int h, int q0, int ntiles, bool lat) {
    const int tid = otid(a.wv), wave = tid >> 6, lane = tid & 63, r32 = lane & 31, hh = lane >> 5;
    const int tq = (lane >> 2) & 3, tp = lane & 3, tblk = (lane >> 4) & 1;
    const bf16* Qb = (const bf16*)(a.ws + WS_Q); const bf16* KVb = (const bf16*)(a.ws + WS_KV); const bf16* KR = (const bf16*)(a.ws + WS_KR); bf16* MIX = (bf16*)(a.ws + WS_MIX);
    const float* ct = (const float*)(a.ws + WS_ROPE); const float* st = ct + SEQ * 16;
    bf16x8 qf[NQ][6];
#pragma unroll
    for (int nq = 0; nq < NQ; ++nq) { const int qrow = q0 + wave * (32 * NQ) + nq * 32 + r32;
#pragma unroll
        for (int s = 0; s < 6; ++s) qf[nq][s] = *(const bf16x8*)(Qb + (size_t)qrow * QW + h * 96 + 16 * s + 8 * hh);
        if (lat) { const int t = qrow & (SEQ - 1);
#pragma unroll
            for (int j = 0; j < 8; j += 2) { float y1[2], y2[2];
#pragma unroll
                for (int e = 0; e < 2; ++e) { const float x1 = bf1((bf16)qf[nq][4][j + e]), x2 = bf1((bf16)qf[nq][5][j + e]); const float c = ct[t * 16 + 8 * hh + j + e], s = st[t * 16 + 8 * hh + j + e];
                    y1[e] = x1 * c - x2 * s; y2[e] = x1 * s + x2 * c; }
                const unsigned w1 = pk2(y1[0], y1[1]), w2 = pk2(y2[0], y2[1]);
                qf[nq][4][j] = (short)(w1 & 0xffff); qf[nq][4][j + 1] = (short)(w1 >> 16); qf[nq][5][j] = (short)(w2 & 0xffff); qf[nq][5][j + 1] = (short)(w2 >> 16); } }
        asm volatile("" : "+v"(qf[nq][0]), "+v"(qf[nq][1]), "+v"(qf[nq][2]), "+v"(qf[nq][3]), "+v"(qf[nq][4]), "+v"(qf[nq][5]) :: "memory"); }
    f32x16 o[NQ][2]; float m[NQ], l[NQ];
#pragma unroll
    for (int nq = 0; nq < NQ; ++nq) { m[nq] = -1e30f; l[nq] = 0.f;
#pragma unroll
        for (int i = 0; i < 16; ++i) { o[nq][0][i] = 0.f; o[nq][1][i] = 0.f; } }
    v4u kreg0, kreg1, vreg;
#define AT2_LOAD(it, tt) do { const unsigned off_kv = (unsigned)(((tt) >> 3) * (KVW * 2) + h * 256 + ((tt) & 7) * 16), off_kr = (unsigned)(((tt) >> 2) * 64 + ((tt) & 3) * 16); const bool k1ok = (tt) < 256; const int rb_ = (it) < CTXL / 64 ? TL + b * CTXL + (it) * 64 : b * SEQ + ((it) - CTXL / 64) * 64; \
        const char* kvb_ = (const char*)(KVb + (size_t)rb_ * KVW); const char* krb_ = (const char*)(KR + (size_t)rb_ * 32); \
        kreg0 = *(const v4u*)(kvb_ + off_kv); vreg = *(const v4u*)(kvb_ + off_kv + 128); if (k1ok) kreg1 = *(const v4u*)(krb_ + off_kr); } while (0)
#define AT2_WRITE(buf, tt) do { LAS unsigned char* kb_ = lds + (buf) * AT2_BUF; \
        *(LAS v4u*)(kb_ + ((tt) >> 3) * AT2_KP + ((tt) & 7) * 16) = kreg0; if ((tt) < 256) *(LAS v4u*)(kb_ + ((tt) >> 2) * AT2_KP + 128 + ((tt) & 3) * 16) = kreg1; \
        *(LAS v4u*)(kb_ + AT2_KB + ((tt) >> 3) * AT2_VP + ((tt) & 7) * 16) = vreg; } while (0)
    __syncthreads();
    AT2_LOAD(0, tid); AT2_WRITE(0, tid);
    __syncthreads();
    for (int it = 0; it < ntiles; ++it) {
        int tz = tid; asm volatile("" : "+v"(tz));
        const int lane_ = tz & 63, r32_ = lane_ & 31, hh_ = lane_ >> 5, tq_ = (lane_ >> 2) & 3, tp_ = lane_ & 3, tblk_ = (lane_ >> 4) & 1;
#ifdef ATT_LOADTOP
        if (it + 1 < ntiles) AT2_LOAD(it + 1, tz);
#endif
        const LAS unsigned char* kb = lds + (it & 1) * AT2_BUF; const LAS unsigned char* vb = kb + AT2_KB;
        bf16x8 pf[NQ][2][2];
        f32x16 sc[NQ][2];
#pragma unroll
        for (int nq = 0; nq < NQ; ++nq)
#pragma unroll
            for (int i = 0; i < 16; ++i) { sc[nq][0][i] = 0.f; sc[nq][1][i] = 0.f; }
#pragma unroll
        for (int s = 0; s < 6; ++s) { const bf16x8 a0 = *(const LAS bf16x8*)(kb + r32_ * AT2_KP + (16 * s + 8 * hh_) * 2); const bf16x8 a1 = *(const LAS bf16x8*)(kb + (32 + r32_) * AT2_KP + (16 * s + 8 * hh_) * 2);
#pragma unroll
            for (int nq = 0; nq < NQ; ++nq) { sc[nq][0] = __builtin_amdgcn_mfma_f32_32x32x16_bf16(a0, qf[nq][s], sc[nq][0], 0, 0, 0); sc[nq][1] = __builtin_amdgcn_mfma_f32_32x32x16_bf16(a1, qf[nq][s], sc[nq][1], 0, 0, 0); } }
#pragma unroll
        for (int nq = 0; nq < NQ; ++nq) {
            f32x16& s0 = sc[nq][0]; f32x16& s1 = sc[nq][1];
            float mx = s0[0];
#pragma unroll
            for (int i = 1; i < 16; ++i) mx = fmaxf(mx, s0[i]);
#pragma unroll
            for (int i = 0; i < 16; ++i) mx = fmaxf(mx, s1[i]);
            mx = fmaxf(mx, shx(mx, 32, lane_));
            const float mn = fmaxf(m[nq], mx * ATT_SCALE_LOG2E); const float alpha = __builtin_amdgcn_exp2f(m[nq] - mn); m[nq] = mn;
            float rs = 0.f;
#pragma unroll
            for (int i = 0; i < 16; ++i) { s0[i] = __builtin_amdgcn_exp2f(s0[i] * ATT_SCALE_LOG2E - mn); s1[i] = __builtin_amdgcn_exp2f(s1[i] * ATT_SCALE_LOG2E - mn); rs += s0[i] + s1[i]; }
            l[nq] = l[nq] * alpha + rs;
#pragma unroll
            for (int i = 0; i < 16; ++i) { o[nq][0][i] *= alpha; o[nq][1][i] *= alpha; }
#pragma unroll
            for (int s2 = 0; s2 < 2; ++s2) { v4u w0, w1;
                w0.x = cvtpk(s0[8 * s2 + 0], s0[8 * s2 + 1]); w0.y = cvtpk(s0[8 * s2 + 2], s0[8 * s2 + 3]); w0.z = cvtpk(s0[8 * s2 + 4], s0[8 * s2 + 5]); w0.w = cvtpk(s0[8 * s2 + 6], s0[8 * s2 + 7]);
                w1.x = cvtpk(s1[8 * s2 + 0], s1[8 * s2 + 1]); w1.y = cvtpk(s1[8 * s2 + 2], s1[8 * s2 + 3]); w1.z = cvtpk(s1[8 * s2 + 4], s1[8 * s2 + 5]); w1.w = cvtpk(s1[8 * s2 + 6], s1[8 * s2 + 7]);
                pf[nq][0][s2] = __builtin_bit_cast(bf16x8, w0); pf[nq][1][s2] = __builtin_bit_cast(bf16x8, w1); }
        }
#ifndef ATT_LOADTOP
        if (it + 1 < ntiles) AT2_LOAD(it + 1, tz);
#endif
#pragma unroll
        for (int t = 0; t < 2; ++t)
#pragma unroll
            for (int s2 = 0; s2 < 2; ++s2)
#pragma unroll
                for (int dt = 0; dt < 2; ++dt) {
                    const LAS unsigned char* tb = vb + (t * 32 + 16 * s2 + 4 * hh_ + tq_) * AT2_VP + (32 * dt + 16 * tblk_ + 4 * tp_) * 2;
#ifdef ATT_NOTR
                    bf16x8 vf; { const LAS unsigned short* vp_ = (const LAS unsigned short*)(vb + (t * 32 + 16 * s2 + 4 * hh_) * AT2_VP + (32 * dt + r32_) * 2);
#pragma unroll
                      for (int j_ = 0; j_ < 8; ++j_) vf[j_] = (short)vp_[((j_ & 3) + 8 * (j_ >> 2)) * (AT2_VP / 2)]; }
#else
                    const v2u lo = trread(tb), hi = trread(tb + 8 * AT2_VP); const bf16x8 vf = __builtin_bit_cast(bf16x8, (v4u){lo.x, lo.y, hi.x, hi.y});
#endif
#pragma unroll
                    for (int nq = 0; nq < NQ; ++nq) o[nq][dt] = __builtin_amdgcn_mfma_f32_32x32x16_bf16(vf, pf[nq][t][s2], o[nq][dt], 0, 0, 0); }
        if (it + 1 < ntiles) AT2_WRITE((it + 1) & 1, tz);
        __syncthreads();
    }
#undef AT2_LOAD
#undef AT2_WRITE
#pragma unroll
    for (int nq = 0; nq < NQ; ++nq) { int qrow = q0 + wave * (32 * NQ) + nq * 32 + r32; asm volatile("" : "+v"(qrow));
        const float lt = l[nq] + shx(l[nq], 32, lane); const float inv = 1.f / lt;
        bf16* orow = MIX + (size_t)qrow * D + h * 64 + 4 * hh;
#pragma unroll
        for (int g = 0; g < 4; ++g) {
            v2u w; w.x = pk2(o[nq][0][4 * g] * inv, o[nq][0][4 * g + 1] * inv); w.y = pk2(o[nq][0][4 * g + 2] * inv, o[nq][0][4 * g + 3] * inv); *(v2u*)(orow + 8 * g) = w;
            v2u x; x.x = pk2(o[nq][1][4 * g] * inv, o[nq][1][4 * g + 1] * inv); x.y = pk2(o[nq][1][4 * g + 2] * inv, o[nq][1][4 * g + 3] * inv); *(v2u*)(orow + 32 + 8 * g) = x; } }
}
__device__ __forceinline__ void attn_mfma2(const Args& a, LAS unsigned char* lds) {
#ifdef ATT_NQ1
    for (int u = blockIdx.x; u < 512; u += gridDim.x) attn_unit2<1>(a, lds, u >> 6, (u >> 3) & 7, (u >> 6) * SEQ + (u & 7) * 256, (CTXL + SEQ) / 64, true);
#else
    for (int u = blockIdx.x; u < 256; u += gridDim.x) attn_unit2<2>(a, lds, u >> 5, (u >> 2) & 7, (u >> 5) * SEQ + (u & 3) * 512, (CTXL + SEQ) / 64, true);
#endif
    for (int u = blockIdx.x; u < 64; u += gridDim.x) attn_unit2<1>(a, lds, u >> 3, u & 7, TL + (u >> 3) * CTXL, CTXL / 64, false);
}

template <int R>
__device__ __forceinline__ void rowwise2(const float* xs_lat, const float* xs_ctx, float* xd_lat, float* xd_ctx, const bf16* Mb, const float* modg, const float* nwA,
                                         bf16* H, const float* modh, int sh_off, int sc_off, const float* nwB, int nrows, int wv) {
    const int tid = otid(wv), wave = wv, lane = tid & 63; const int NGW = gridDim.x * NWAVES, gw = blockIdx.x * NWAVES + wave;
    const int rpw = (nrows + NGW - 1) / NGW; const int rbeg = gw * rpw, rend = min(rbeg + rpw, nrows);
    for (int r0 = rbeg; r0 < rend; r0 += R) {
        f32x4 v[R][4]; v2u mm[R][4];
#pragma unroll
        for (int j = 0; j < R; ++j) { const int r = min(r0 + j, rend - 1); const float* xs = r < TL ? xs_lat + (size_t)r * D : xs_ctx + (size_t)(r - TL) * D;
#pragma unroll
            for (int q = 0; q < 4; ++q) v[j][q] = *(const f32x4*)(xs + q * 256 + lane * 4);
            if (Mb) {
#pragma unroll
                for (int q = 0; q < 4; ++q) mm[j][q] = *(const v2u*)(Mb + (size_t)r * D + q * 256 + lane * 4); } }
#pragma unroll
        for (int j = 0; j < R; ++j) { const int r = r0 + j; if (r < rend) {
            const bool lat = r < TL; const int cond = lat ? (r >> 11) : 8; float* xd = lat ? xd_lat + (size_t)r * D : xd_ctx + (size_t)(r - TL) * D;
            if (Mb) {
                f32x4 m[4]; float ss = 0.f;
#pragma unroll
                for (int q = 0; q < 4; ++q) { const v2u w = mm[j][q]; m[q] = (f32x4){bflo(w.x), bfhi(w.x), bflo(w.y), bfhi(w.y)}; ss += (m[q][0] * m[q][0] + m[q][1] * m[q][1]) + (m[q][2] * m[q][2] + m[q][3] * m[q][3]); }
                const float rs = rsqrtf(wave_sum(ss, lane) * (1.f / D) + EPS);
#pragma unroll
                for (int q = 0; q < 4; ++q) { const f32x4 g = *(const f32x4*)(modg + (size_t)cond * MODW + q * 256 + lane * 4); const f32x4 w = *(const f32x4*)(nwA + q * 256 + lane * 4);
                    v[j][q] = v[j][q] + g * (m[q] * rs * w); }
            }
#pragma unroll
            for (int q = 0; q < 4; ++q) *(f32x4*)(xd + q * 256 + lane * 4) = v[j][q];
            if (H) {
                float ss = 0.f;
#pragma unroll
                for (int q = 0; q < 4; ++q) ss += (v[j][q][0] * v[j][q][0] + v[j][q][1] * v[j][q][1]) + (v[j][q][2] * v[j][q][2] + v[j][q][3] * v[j][q][3]);
                const float rs = rsqrtf(wave_sum(ss, lane) * (1.f / D) + EPS);
#pragma unroll
                for (int q = 0; q < 4; ++q) { const int c = q * 256 + lane * 4;
                    const f32x4 w = *(const f32x4*)(nwB + c); const f32x4 sc = *(const f32x4*)(modh + (size_t)cond * MODW + sc_off + c); const f32x4 sh = *(const f32x4*)(modh + (size_t)cond * MODW + sh_off + c);
                    const f32x4 hv = (v[j][q] * rs * w) * (sc + 1.0f) + sh;
                    v2u o; o.x = pk2(hv[0], hv[1]); o.y = pk2(hv[2], hv[3]); *(v2u*)(H + (size_t)r * D + c) = o; }
            } } }
    }
}

__device__ __forceinline__ void convgate2(const Args& a, int l, int nrows) {
    const bf16* U = (const bf16*)(a.ws + WS_U); bf16* G = (bf16*)(a.ws + WS_G); const float* cw = a.in[I_FCONV] + (size_t)l * 3 * UPW;
    const int total = (nrows / 8) * (DFF / 8);
    for (int idx = blockIdx.x * NTHR + otid(a.wv); idx < total; idx += gridDim.x * NTHR) {
        const int r0 = (idx / (DFF / 8)) * 8, c0 = (idx % (DFF / 8)) * 8; const bf16* u = U + (size_t)r0 * UPW + c0;
        const bool hp = has_prev(r0), hn = has_next(r0 + 7);
        v4u ua[10], ug[10];
#pragma unroll
        for (int j = 0; j < 10; ++j) { const int rr = (j == 0 && !hp) ? 0 : ((j == 9 && !hn) ? 7 : j - 1); ua[j] = *(const v4u*)(u + (ptrdiff_t)rr * UPW); ug[j] = *(const v4u*)(u + (ptrdiff_t)rr * UPW + DFF); }
        float wa[3][8], wg[3][8];
#pragma unroll
        for (int t = 0; t < 3; ++t)
#pragma unroll
            for (int j = 0; j < 8; ++j) { wa[t][j] = cw[t * UPW + c0 + j]; wg[t][j] = cw[t * UPW + DFF + c0 + j]; }
        if (!hp) { ua[0] = (v4u){0u, 0u, 0u, 0u}; ug[0] = ua[0]; }
        if (!hn) { ua[9] = (v4u){0u, 0u, 0u, 0u}; ug[9] = ua[9]; }
        float pa[8], ca[8], na[8], pg[8], cg_[8], ng[8];
        unpack8(ua[0], pa); unpack8(ug[0], pg); unpack8(ua[1], ca); unpack8(ug[1], cg_);
#pragma unroll
        for (int j = 0; j < 8; ++j) {
            unpack8(ua[j + 2], na); unpack8(ug[j + 2], ng);
            float o[8];
#pragma unroll
            for (int k = 0; k < 8; ++k) { const float act = wa[0][k] * pa[k] + wa[1][k] * ca[k] + wa[2][k] * na[k]; const float gate = wg[0][k] * pg[k] + wg[1][k] * cg_[k] + wg[2][k] * ng[k]; o[k] = silu_f(act) * gate; }
            *(v4u*)(G + (size_t)(r0 + j) * DFF + c0) = pack8(o);
#pragma unroll
            for (int k = 0; k < 8; ++k) { pa[k] = ca[k]; ca[k] = na[k]; pg[k] = cg_[k]; cg_[k] = ng[k]; }
        }
    }
}

__device__ __forceinline__ void ssd_conv2(const Args& a, int i) {
    const bf16* ZX = (const bf16*)(a.ws + WS_ZX); bf16* XBC = (bf16*)(a.ws + WS_XBC); float* DT = (float*)(a.ws + WS_DT); float* AA = (float*)(a.ws + WS_AA);
    const float* cw = a.in[I_SCONVW] + (size_t)i * 3 * 3072; const float* cb = a.in[I_SCONVB] + (size_t)i * 3072;
    const int total = (T / 8) * 384;
    for (int idx = blockIdx.x * NTHR + otid(a.wv); idx < total; idx += gridDim.x * NTHR) {
        const int r0 = (idx / 384) * 8, c0 = (idx % 384) * 8; const bf16* u = ZX + (size_t)r0 * SSD_INP + 2048 + c0;
        const bool hp = has_prev(r0), hn = has_next(r0 + 7);
        v4u ux[10];
#pragma unroll
        for (int j = 0; j < 10; ++j) { const int rr = (j == 0 && !hp) ? 0 : ((j == 9 && !hn) ? 7 : j - 1); ux[j] = *(const v4u*)(u + (ptrdiff_t)rr * SSD_INP); }
        float w[3][8], bias[8];
#pragma unroll
        for (int j = 0; j < 8; ++j) { w[0][j] = cw[c0 + j]; w[1][j] = cw[3072 + c0 + j]; w[2][j] = cw[2 * 3072 + c0 + j]; bias[j] = cb[c0 + j]; }
        if (!hp) ux[0] = (v4u){0u, 0u, 0u, 0u};
        if (!hn) ux[9] = (v4u){0u, 0u, 0u, 0u};
        float p[8], c[8], n[8];
        unpack8(ux[0], p); unpack8(ux[1], c);
#pragma unroll
        for (int j = 0; j < 8; ++j) {
            unpack8(ux[j + 2], n); float o[8];
#pragma unroll
            for (int k = 0; k < 8; ++k) o[k] = silu_f(bias[k] + w[0][k] * p[k] + w[1][k] * c[k] + w[2][k] * n[k]);
            *(v4u*)(XBC + (size_t)(r0 + j) * 3072 + c0) = pack8(o);
#pragma unroll
            for (int k = 0; k < 8; ++k) { p[k] = c[k]; c[k] = n[k]; }
        }
    }
    const float* alog = a.in[I_ALOG] + i * 64; const float* dtb = a.in[I_DTB] + i * 64;
    for (int idx = blockIdx.x * NTHR + otid(a.wv); idx < T * 8; idx += gridDim.x * NTHR) {
        const int r = idx >> 3, j0 = (idx & 7) * 8; float raw[8], dt[8], av[8];
        unpack8(*(const v4u*)(ZX + (size_t)r * SSD_INP + 5120 + j0), raw);
#pragma unroll
        for (int k = 0; k < 8; ++k) { const float x = raw[k] + dtb[j0 + k]; dt[k] = x > 15.f ? x : (x < -15.f ? __expf(x) : __logf(1.f + __expf(x))); av[k] = -__expf(alog[j0 + k]) * dt[k]; }
        *(f32x4*)(DT + (size_t)r * 64 + j0) = (f32x4){dt[0], dt[1], dt[2], dt[3]}; *(f32x4*)(DT + (size_t)r * 64 + j0 + 4) = (f32x4){dt[4], dt[5], dt[6], dt[7]};
        *(f32x4*)(AA + (size_t)r * 64 + j0) = (f32x4){av[0], av[1], av[2], av[3]}; *(f32x4*)(AA + (size_t)r * 64 + j0 + 4) = (f32x4){av[4], av[5], av[6], av[7]};
    }
}

__device__ __forceinline__ void gatenorm2(const Args& a, int i, int nrows) {
    const int tid = otid(a.wv), wave = a.wv, lane = tid & 63; const int NGW = gridDim.x * NWAVES, gw = blockIdx.x * NWAVES + wave;
    const bf16* ZX = (const bf16*)(a.ws + WS_ZX); bf16* YN = (bf16*)(a.ws + WS_XBC); const float* nw = a.in[I_SNORM] + i * 2048;
    const int rpw = (nrows + NGW - 1) / NGW; const int rbeg = gw * rpw, rend = min(rbeg + rpw, nrows);
    constexpr int R = 3;
    for (int r0 = rbeg; r0 < rend; r0 += R) {
        v4u yv[R][4], zv[R][4];
#pragma unroll
        for (int j = 0; j < R; ++j) { const int r = min(r0 + j, rend - 1);
#pragma unroll
            for (int q = 0; q < 4; ++q) { const int c = q * 512 + lane * 8; yv[j][q] = *(const v4u*)(ZX + (size_t)r * SSD_INP + 2048 + c); zv[j][q] = *(const v4u*)(ZX + (size_t)r * SSD_INP + c); } }
#pragma unroll
        for (int j = 0; j < R; ++j) { const int r = r0 + j; if (r < rend) {
            float v[4][8]; float ss = 0.f;
#pragma unroll
            for (int q = 0; q < 4; ++q) { float y[8], z[8]; unpack8(yv[j][q], y); unpack8(zv[j][q], z);
#pragma unroll
                for (int k = 0; k < 8; ++k) { v[q][k] = y[k] * silu_f(z[k]); ss += v[q][k] * v[q][k]; } }
            const float rs = rsqrtf(wave_sum(ss, lane) * (1.f / 2048.f) + EPS);
#pragma unroll
            for (int q = 0; q < 4; ++q) { const int c = q * 512 + lane * 8; float o[8];
#pragma unroll
                for (int k = 0; k < 8; ++k) o[k] = v[q][k] * rs * nw[c + k];
                *(v4u*)(YN + (size_t)r * 2048 + c) = pack8(o); } } }
    }
}

__device__ __forceinline__ void ffn_fixup(const Args& a, int l, int nrows) {
    const bf16* Ue = (const bf16*)(a.ws + WS_UE); bf16* G = (bf16*)(a.ws + WS_G); const float* cw = a.in[I_FCONV] + (size_t)l * 3 * UPW;
    const int total = (nrows / 256) * 2 * (DFF / 8);
    for (int idx = blockIdx.x * NTHR + otid(a.wv); idx < total; idx += gridDim.x * NTHR) {
        const int cg = idx % (DFF / 8), which = (idx / (DFF / 8)) & 1, pm = idx / (2 * (DFF / 8)); const int c0 = cg * 8; const int col = (c0 / 128) * 256 + (c0 % 128);
        const int r = pm * 256 + (which ? 255 : 0);
        const bf16* e0 = Ue + (size_t)(pm * 4) * UPW + col;
        const bf16* pp = which ? e0 + 2 * UPW : e0 - UPW;
        const bf16* pc = which ? e0 + 3 * UPW : e0;
        const bf16* pn = which ? e0 + 4 * UPW : e0 + UPW;
        const bool hp = which ? true : has_prev(r), hn = which ? has_next(r) : true;
        float pa[8], pg[8], ca[8], cg_[8], na[8], ng[8];
        unpack8(*(const v4u*)pc, ca); unpack8(*(const v4u*)(pc + 128), cg_);
        if (hp) { unpack8(*(const v4u*)pp, pa); unpack8(*(const v4u*)(pp + 128), pg); } else {
#pragma unroll
            for (int k = 0; k < 8; ++k) { pa[k] = 0.f; pg[k] = 0.f; } }
        if (hn) { unpack8(*(const v4u*)pn, na); unpack8(*(const v4u*)(pn + 128), ng); } else {
#pragma unroll
            for (int k = 0; k < 8; ++k) { na[k] = 0.f; ng[k] = 0.f; } }
        float o[8];
#pragma unroll
        for (int k = 0; k < 8; ++k) { const float act = cw[c0 + k] * pa[k] + cw[UPW + c0 + k] * ca[k] + cw[2 * UPW + c0 + k] * na[k];
            const float gate = cw[DFF + c0 + k] * pg[k] + cw[UPW + DFF + c0 + k] * cg_[k] + cw[2 * UPW + DFF + c0 + k] * ng[k]; o[k] = silu_f(act) * gate; }
        *(v4u*)(G + (size_t)r * DFF + c0) = pack8(o);
    }
}

__device__ __forceinline__ void prep_even2(const Args& a, int i) {
    const int tid = otid(a.wv), wave = a.wv, lane = tid & 63; const int NGW = gridDim.x * NWAVES, gw = blockIdx.x * NWAVES + wave;
    const bf16* P = (const bf16*)(a.ws + WS_P); bf16* CQN = (bf16*)(a.ws + WS_CQN); bf16* CKVN = (bf16*)(a.ws + WS_CKVN); bf16* KR = (bf16*)(a.ws + WS_KR); bf16* MIX = (bf16*)(a.ws + WS_MIX);
    const float* qn = a.in[I_QNORM] + i * 384; const float* kvn = a.in[I_KVNORM] + i * 256; const float* cw = a.in[I_SCONV] + i * 3 * 512;
    const float* ct = (const float*)(a.ws + WS_ROPE); const float* st = ct + SEQ * 16;
    constexpr int R = 3; const int rpw = (T + NGW - 1) / NGW; const int rbeg = gw * rpw, rend = min(rbeg + rpw, T);
    const int c0 = lane * 8;
    for (int r0 = rbeg; r0 < rend; r0 += R) {
        unsigned q32[R][3]; v2u kv2[R]; bf16 krv[R]; v4u gbv[R], gcv[R + 2], xvv[R + 2];
#pragma unroll
        for (int j = 0; j < R; ++j) { const int r = min(r0 + j, rend - 1); const bf16* p = P + (size_t)r * HYB_INP;
            const unsigned* p32 = (const unsigned*)(p + lane * 6); q32[j][0] = p32[0]; q32[j][1] = p32[1]; q32[j][2] = p32[2];
            kv2[j] = *(const v2u*)(p + 384 + lane * 4); krv[j] = p[640 + (lane & 31)]; gbv[j] = *(const v4u*)(p + 672 + c0); }
#pragma unroll
        for (int j = 0; j < R + 2; ++j) { int r = r0 + j - 1; r = max(0, min(r, T - 1)); const bf16* p = P + (size_t)r * HYB_INP; gcv[j] = *(const v4u*)(p + 1184 + c0); xvv[j] = *(const v4u*)(p + 1696 + c0); }
#pragma unroll
        for (int j = 0; j < R; ++j) { const int r = r0 + j; if (r < rend) {
            {   float f[6] = {bflo(q32[j][0]), bfhi(q32[j][0]), bflo(q32[j][1]), bfhi(q32[j][1]), bflo(q32[j][2]), bfhi(q32[j][2])}; float ss = 0.f;
#pragma unroll
                for (int k = 0; k < 6; ++k) ss += f[k] * f[k];
                const float rs = rsqrtf(wave_sum(ss, lane) * (1.f / 384.f) + EPS);
#pragma unroll
                for (int k = 0; k < 6; ++k) f[k] = f[k] * rs * qn[lane * 6 + k];
                unsigned* o32 = (unsigned*)(CQN + (size_t)r * 384 + lane * 6); o32[0] = pk2(f[0], f[1]); o32[1] = pk2(f[2], f[3]); o32[2] = pk2(f[4], f[5]); }
            {   const v2u w = kv2[j]; float f[4] = {bflo(w.x), bfhi(w.x), bflo(w.y), bfhi(w.y)};
                const float ss = (f[0] * f[0] + f[1] * f[1]) + (f[2] * f[2] + f[3] * f[3]);
                const float rs = rsqrtf(wave_sum(ss, lane) * (1.f / 256.f) + EPS);
                const f32x4 g = *(const f32x4*)(kvn + lane * 4);
                v2u o; o.x = pk2(f[0] * rs * g[0], f[1] * rs * g[1]); o.y = pk2(f[2] * rs * g[2], f[3] * rs * g[3]); *(v2u*)(CKVN + (size_t)r * 256 + lane * 4) = o; }
            {   const int jj = lane & 31; const float v = bf1(krv[j]); const float o = shx(v, 16, lane); float res = v;
                if (r < TL) { const int t = r & (SEQ - 1); const float c = ct[t * 16 + (jj & 15)], s = st[t * 16 + (jj & 15)]; res = (jj < 16) ? v * c - o * s : o * s + v * c; }
                if (lane < 32) KR[(size_t)r * 32 + jj] = (bf16)f2bf(res); }
            {   float gb[8], t0[8], t1[8], acc[8];
                unpack8(gbv[j], gb); unpack8(gcv[j + 1], t0); unpack8(xvv[j + 1], t1);
#pragma unroll
                for (int k = 0; k < 8; ++k) acc[k] = cw[512 + c0 + k] * (t0[k] * t1[k]);
                if (has_prev(r)) { unpack8(gcv[j], t0); unpack8(xvv[j], t1);
#pragma unroll
                    for (int k = 0; k < 8; ++k) acc[k] += cw[c0 + k] * (t0[k] * t1[k]); }
                if (has_next(r)) { unpack8(gcv[j + 2], t0); unpack8(xvv[j + 2], t1);
#pragma unroll
                    for (int k = 0; k < 8; ++k) acc[k] += cw[1024 + c0 + k] * (t0[k] * t1[k]); }
#pragma unroll
                for (int k = 0; k < 8; ++k) acc[k] *= gb[k];
                *(v4u*)(MIX + (size_t)r * D + 512 + c0) = pack8(acc); }
        } }
    }
}

#ifndef MK_SINGLE
#define MK_SINGLE 1
#endif
struct GemmDesc { const bf16* A; const bf16* Bt; int M, N, K; bf16* O; int ldc; int mode; };

__global__ void __launch_bounds__(NTHR, 2) fwd_kernel(Args a_in) {
    extern __shared__ __attribute__((aligned(16))) unsigned char lds_raw[];
    LAS unsigned char* lds = (LAS unsigned char*)lds_raw;
#if MK_SINGLE == 1
    volatile LAS unsigned* bst = (volatile LAS unsigned*)(lds + LDS_BYTES - 64);
    const int wv0 = __builtin_amdgcn_readfirstlane((int)threadIdx.x >> 6);
    { const int t0 = otid(wv0); if (t0 < 16) bst[t0] = 0u; }
    __syncthreads();
    const XcdBarrier xbar = xcd_barrier_post((unsigned*)(a_in.ws + WS_CTL), bst, wv0);
#endif
    const Args& a0 = a_in;
    for (int s = a0.lo; s < a0.hi; ++s) {
        Args a = a0;
        { long oz; asm volatile("s_mov_b64 %0, 0" : "=s"(oz));
#pragma unroll
          for (int q = 0; q < 25; ++q) a.in[q] = (const float*)((const char*)a0.in[q] + oz);
          a.out = (float*)((char*)a0.out + oz); a.ws = a0.ws + oz; a.wv = wv0; }
        unsigned char* ws = a.ws;
        float* XL = a.out; float* XC = (float*)(ws + WS_XC); bf16* H = (bf16*)(ws + WS_H); bf16* Mb = (bf16*)(ws + WS_M);
        const float* MOD = (const float*)(ws + WS_MOD); const float* NW = a.in[I_NORMW];
        int nrep = 1;
#ifdef PROBE_MASK
        if (s == 0 && (PROBE_MASK >> 20 & 1u)) nrep = 2;
        if (s >= 2) { const int pk = (s - 2) % 10, ppar = ((s - 2) / 10) & 1; if ((PROBE_MASK >> (pk + 10 * ppar)) & 1u) nrep = 2; }
#endif
        for (int rep = 0; rep < nrep; ++rep) {
        GemmDesc g0{}, g1{}; int ng = 0;
#ifndef NO_SIMPLE
        if (s == 0) {
            mod_compute(a, lds);
            rope_tables(a);
            convert_layer(a, 0, lds);
        } else if (s == 1) {
            rowwise2<3>(a.in[I_X], a.in[I_CTX], XL, XC, nullptr, nullptr, nullptr, H, MOD, 0, 1024, NW, T, a.wv);
        } else {
            const int l = (s - 2) / 10, k = (s - 2) % 10, i = l >> 1; const bool even = (l & 1) == 0, last = (l == 3);
            const int MR = last ? TL : T;
            switch (k) {
            case 0:
                if (even) { g0 = GemmDesc{H, (const bf16*)(ws + W_IN), T, HYB_INP, D, (bf16*)(ws + WS_P), HYB_INP}; ng = 1; }
                else      { g0 = GemmDesc{H, (const bf16*)(ws + W_IN), T, SSD_INP, D, (bf16*)(ws + WS_ZX), SSD_INP}; ng = 1; }
                break;
            case 1: if (even) prep_even2(a, i); else ssd_conv2(a, i); break;
            case 2:
                if (even) { { g0 = GemmDesc{(const bf16*)(ws + WS_CQN), (const bf16*)(ws + W_UQ), T, QW, 384, (bf16*)(ws + WS_Q), QW}; ng = 1; }
                            g1 = GemmDesc{(const bf16*)(ws + WS_CKVN), (const bf16*)(ws + W_UKV), T, KVW, 256, (bf16*)(ws + WS_KV), KVW}; ng = 2; }
                else {
#ifdef SSD_NAIVE
 ssd_scan_naive(a, i, last, lds);
#else
 ssd_scan_mfma(a, i, last, lds);
#endif
 }
                break;
            case 3: if (even) {
#ifdef ATTN_NAIVE
 attn_naive(a, lds);
#else
 attn_mfma(a, lds);
#endif
 } else gatenorm2(a, i, MR); break;
            case 4:
                if (even) { g0 = GemmDesc{(const bf16*)(ws + WS_MIX), (const bf16*)(ws + W_OUT), MR, D, D, Mb, D}; ng = 1; }
                else      { g0 = GemmDesc{(const bf16*)(ws + WS_XBC), (const bf16*)(ws + W_OUT), MR, D, 2048, Mb, D}; ng = 1; }
                break;
            case 5:
#ifdef PROBE_ROW2
                if (l > 0) rowwise2<3>(XL, XC, XL, XC, nullptr, nullptr, nullptr, H, MOD + (size_t)l * 9 * MODW, 0, 1024, NW + (l * 4 + 0) * D, MR, a.wv);
#endif
                rowwise2<3>(XL, XC, XL, XC, Mb, MOD + (size_t)l * 9 * MODW + 2048, NW + (l * 4 + 1) * D, H, MOD + (size_t)l * 9 * MODW, 3072, 4096, NW + (l * 4 + 2) * D, MR, a.wv); break;
            case 6: { g0 = GemmDesc{H, (const bf16*)(ws + W_UP), MR, UPW, D, (bf16*)(ws + WS_G), DFF, 1}; ng = 1; } break;
            case 7: ffn_fixup(a, l, MR); break;
            case 8: { g0 = GemmDesc{(const bf16*)(ws + WS_G), (const bf16*)(ws + W_DN), MR, D, DFF, Mb, D}; ng = 1; } break;
            case 9:
                if (!last) { rowwise2<3>(XL, XC, XL, XC, Mb, MOD + (size_t)l * 9 * MODW + 5120, NW + (l * 4 + 3) * D, H, MOD + (size_t)(l + 1) * 9 * MODW, 0, 1024, NW + ((l + 1) * 4 + 0) * D, T, a.wv);
                             convert_layer(a, l + 1, lds); }
                else rowwise2<3>(XL, XC, XL, XC, Mb, MOD + (size_t)l * 9 * MODW + 5120, NW + (l * 4 + 3) * D, nullptr, MOD, 0, 0, NW, TL, a.wv);
                break;
            }
        }
#else
        { g0 = GemmDesc{H, (const bf16*)(ws + W_IN), T, a.hi * 256, a.lo * 128, (bf16*)(ws + WS_P), HYB_INP}; ng = 1; }
#endif
        for (int gi = 0; gi < ng; ++gi) {
            const bool f = (gi == 0);
            pg8::Gemm g{f ? g0.A : g1.A, f ? g0.Bt : g1.Bt, f ? g0.M : g1.M, f ? g0.N : g1.N, f ? g0.K : g1.K, a.wv}; pg8::StaticOrder S; S.init(g.M, g.N, (int)gridDim.x, (int)blockIdx.x);
            pg8::EpiFfn E{f ? g0.O : g1.O, f ? g0.ldc : g1.ldc, f ? g0.mode : 0, (bf16*)(ws + WS_UE), a.in[I_FCONV] + (size_t)((s - 2) / 10) * 3 * UPW, (LAS pg8::f32x4*)(lds + 131072)};
#ifndef NO_GEMM
            pg8::gemm_phase<pg8::EpiFfn, pg8::StaticOrder, true, true>(lds, g, S, E);
#endif
            __syncthreads();
        }
        if (rep + 1 < nrep) __syncthreads();
        }
#ifdef SSD_DIAG
        if (s + 1 == a0.hi) { __syncthreads(); asm volatile("s_waitcnt vmcnt(0)" ::: "memory"); if (blockIdx.x == 0 && otid(wv0) == 0) { const float* dg = (const float*)(a0.ws + WS_MOD + 900 * 1024); a0.out[0] = SSD_DIAG_SEL == 7 ? dg[7] : 1.0e4f * dg[SSD_DIAG_SEL] / dg[7]; } }
#endif
        if (s + 1 < a0.hi) {
#if MK_SINGLE == 1
            xcd_barrier(xbar);
#ifdef PROBE_BAR2
            xcd_barrier(xbar);
#endif
#elif MK_SINGLE == 2
            cg::this_grid().sync();
#endif
        }
    }
}

extern "C" void kernel_launch(void* const* d_in, const int* in_sizes, int n_in, void* d_out, int out_size, void* d_ws, size_t ws_size, hipStream_t stream) {
    static int grid = 0;
    if (grid == 0) {
        if (n_in != 25 || out_size != TL * D || ws_size < WS_END) { fprintf(stderr, "kernel_launch: unexpected problem (n_in %d out %d ws %zu need %zu)\n", n_in, out_size, ws_size, (size_t)WS_END); grid = -1; return; }
        if (hipFuncSetAttribute((const void*)fwd_kernel, hipFuncAttributeMaxDynamicSharedMemorySize, LDS_BYTES) != hipSuccess) { fprintf(stderr, "kernel_launch: hipFuncSetAttribute failed\n"); grid = -1; return; }
        int dev = 0, cus = 0, per_cu = 0;
        hipGetDevice(&dev); hipDeviceGetAttribute(&cus, hipDeviceAttributeMultiprocessorCount, dev);
        hipOccupancyMaxActiveBlocksPerMultiprocessor(&per_cu, (const void*)fwd_kernel, NTHR, LDS_BYTES);
        (void)hipGetLastError();
        if (per_cu < 1) { fprintf(stderr, "kernel_launch: occupancy query says %d blocks per CU\n", per_cu); }
        grid = cus;
    }
    if (grid < 0) return;
#if MK_SINGLE == 1
    if (hipMemsetAsync((char*)d_ws + WS_CTL, 0, CTL_ZERO_BYTES, stream) != hipSuccess) { fprintf(stderr, "kernel_launch: memset failed\n"); return; }
#endif
    Args a{};
    for (int i = 0; i < 25; ++i) a.in[i] = (const float*)d_in[i];
    a.out = (float*)d_out; a.ws = (unsigned char*)d_ws;
#if MK_SINGLE
    a.lo = 0; a.hi = NSTEP + 1;
    void* args[] = {&a};
    hipError_t e = hipLaunchCooperativeKernel((const void*)fwd_kernel, dim3(grid), dim3(NTHR), args, LDS_BYTES, stream);
    if (e != hipSuccess) fprintf(stderr, "cooperative launch failed: %s (grid %d)\n", hipGetErrorString(e), grid);
#else
    for (int s = 0; s < NSTEP + 1; ++s) { a.lo = s; a.hi = s + 1; hipLaunchKernelGGL(fwd_kernel, dim3(grid), dim3(NTHR), LDS_BYTES, stream, a); }
#endif
}
```

```cpp
#include <hip/hip_runtime.h>
#include <hip/hip_cooperative_groups.h>
#include <cstdio>
#include <cstdint>
namespace cg = cooperative_groups;
__device__ __forceinline__ int otid(int wv) { int l; asm volatile("v_mbcnt_lo_u32_b32 %0, -1, 0\n\tv_mbcnt_hi_u32_b32 %0, -1, %0" : "=v"(l)); return (wv << 6) | l; }
__device__ __forceinline__ float shx(float v, int mask, int lane) { return __builtin_bit_cast(float, __builtin_amdgcn_ds_bpermute((lane ^ mask) << 2, __builtin_bit_cast(int, v))); }
#define LAS __attribute__((address_space(3)))
#define XB_TMO      128
#define XB_XCNT(j)  (256  + 64 * (j))
#define XB_XSUB(j)  (1280 + 64 * (j))
#define XB_XGEN(j)  (2304 + 64 * (j))
#define XB_TOP      3328
#define XB_TOPGEN   3392
#define XCD_BAR_WORDS 3456
#define XB_SPIN_CAP (1u << 18)

__device__ __forceinline__ unsigned xb_ld(unsigned* p)              { return __hip_atomic_load(p, __ATOMIC_RELAXED, __HIP_MEMORY_SCOPE_AGENT); }
__device__ __forceinline__ unsigned xb_add(unsigned* p, unsigned v) { return __hip_atomic_fetch_add(p, v, __ATOMIC_RELAXED, __HIP_MEMORY_SCOPE_AGENT); }
__device__ __forceinline__ unsigned xb_xcc_id() { return (unsigned)__builtin_amdgcn_s_getreg((3 << 11) | 20) & 0xFu; }
#define XB_SPIN(cond, bar) do { unsigned _sp = 0; while (cond) { __builtin_amdgcn_s_sleep(1); \
    if ((++_sp & 255u) == 0u) { if (xb_ld(&(bar)[XB_TMO])) break; if (_sp > XB_SPIN_CAP) { atomicAdd(&(bar)[XB_TMO], 1u); break; } } } } while (0)

struct XcdBarrier {
    unsigned* bar; unsigned x; int wv;
    volatile LAS unsigned* st;
};

__device__ __forceinline__ XcdBarrier xcd_barrier_post(unsigned* bar, volatile LAS unsigned* st, int wv) {
    XcdBarrier b; b.bar = bar; b.x = xb_xcc_id(); b.st = st; b.wv = wv;
    if (otid(wv) == 0) (void)xb_add(&bar[XB_XCNT(b.x)], 1u);
    return b;
}
__device__ __forceinline__ void xcd_barrier_complete(unsigned* bar, unsigned x, unsigned& nloc, unsigned& nx) {
    const unsigned G = gridDim.x * gridDim.y * gridDim.z;
    unsigned sum, cnt, mine, sp = 0u;
    for (;;) {
        sum = 0u; cnt = 0u; mine = 0u;
#pragma unroll
        for (unsigned j = 0; j < 16; ++j) { const unsigned c = xb_ld(&bar[XB_XCNT(j)]); sum += c; cnt += (c > 0u) ? 1u : 0u; mine = (j == x) ? c : mine; }
        if (sum == G) break;
        __builtin_amdgcn_s_sleep(1);
        if ((++sp & 255u) == 0u) { if (xb_ld(&bar[XB_TMO])) break; if (sp > XB_SPIN_CAP) { atomicAdd(&bar[XB_TMO], 1u); break; } }
    }
    nloc = mine > 0u ? mine : 1u; nx = cnt > 0u ? cnt : 1u;
}

__device__ __forceinline__ void xcd_barrier(const XcdBarrier& b) {
    asm volatile("s_waitcnt vmcnt(0)" ::: "memory");
    __syncthreads();
    if (otid(b.wv) == 0) {
        unsigned* bar = b.bar;
        __builtin_amdgcn_s_waitcnt(0);
        unsigned nloc = b.st[0], nx = b.st[1];
        if (nloc == 0u) { xcd_barrier_complete(bar, b.x, nloc, nx); b.st[0] = nloc; b.st[1] = nx; }
        const unsigned old = xb_add(&bar[XB_XSUB(b.x)], 1u);
        const unsigned gen = old / nloc;
        if (old + 1u == (gen + 1u) * nloc) {
            __builtin_amdgcn_fence(__ATOMIC_RELEASE, "agent");
            asm volatile("s_waitcnt vmcnt(0)" ::: "memory");
            const unsigned og = xb_add(&bar[XB_TOP], 1u);
            const unsigned tg = og / nx;
            if (og + 1u == (tg + 1u) * nx) xb_add(&bar[XB_TOPGEN], 1u);
            else XB_SPIN(xb_ld(&bar[XB_TOPGEN]) == tg, bar);
            __builtin_amdgcn_fence(__ATOMIC_ACQUIRE, "agent");
            xb_add(&bar[XB_XGEN(b.x)], 1u);
            asm volatile("s_waitcnt vmcnt(0)" ::: "memory");
        } else {
            XB_SPIN(xb_ld(&bar[XB_XGEN(b.x)]) == gen, bar);
            __builtin_amdgcn_fence(__ATOMIC_ACQUIRE, "agent");
            asm volatile("s_waitcnt vmcnt(0)" ::: "memory");
        }
    }
    __syncthreads();
}
namespace pg8 {
#define PG8_LAS __attribute__((address_space(3)))
typedef unsigned short bf16_t;
typedef short bf16x8 __attribute__((ext_vector_type(8)));
typedef float f32x4 __attribute__((ext_vector_type(4)));
typedef unsigned u32x4 __attribute__((ext_vector_type(4)));
constexpr int BM = 256, BK = 64, HALF = 128, HTB = HALF * BK * 2  , STAGE_BYTES = 8 * HTB, NXCD = 8, WGM = 8;

__host__ __device__ __forceinline__ int lds_byte(int r, int c) { const int st = (r >> 4) * 2 + (c >> 5), rr = r & 15, cc = c & 31, ob = rr * 64 + cc * 2; return st * 1024 + (ob ^ (((ob >> 9) & 1) << 5)); }
__host__ __device__ __forceinline__ void stage_rc(int b, int& R, int& C) { const int st = b / 1024, sb = b % 1024, swz = sb ^ (((sb >> 9) & 1) << 5); R = (st >> 1) * 16 + swz / 64; C = (st & 1) * 32 + (swz % 64) / 2; }
__host__ __device__ __forceinline__ int perm32(int rho) { const int n = rho >> 4, i = rho & 15; return 8 * (i >> 2) + 4 * n + (i & 3); }

struct Unit { int pm, pn; };
struct Gemm { const bf16_t* A; const bf16_t* Bt; int M, N, K, wv; float* dg; };

struct StaticOrder {
    int nM, nN, nwg, G, c;
    __host__ __device__ void init(int M, int N, int G_, int c_) { nM = M / BM; nN = N / BM; nwg = nM * nN; G = G_; c = c_; }
    __host__ __device__ bool next(int i, Unit& u) const {
        const long L = (long)i * G + c; if (L >= nwg) return false;
        int wgid = (int)L; { const int q = nwg / NXCD, r = nwg % NXCD, xcd = wgid % NXCD, off = wgid / NXCD; wgid = (xcd < r ? xcd * (q + 1) : r * (q + 1) + (xcd - r) * q) + off; }
        const int nig = WGM * nN, gid = wgid / nig, fm = gid * WGM, gsz = (nM - fm) < WGM ? (nM - fm) : WGM;
        u.pm = fm + ((wgid % nig) % gsz); u.pn = (wgid % nig) / gsz; return true;
    }
    __device__ __forceinline__ void a_ready(const Unit&) const {}
    __device__ __forceinline__ void done(const Unit&) const {}
};

__device__ __forceinline__ unsigned cvt_pk_bf16(float lo, float hi) { unsigned r; asm volatile("v_cvt_pk_bf16_f32 %0, %1, %2" : "=v"(r) : "v"(lo), "v"(hi)); return r; }
struct EpiStore {
    static constexpr bool PERM = true, AFTER_DRAIN = false;
    bf16_t* O; int ldc;
    __device__ __forceinline__ void operator()(const f32x4 (&acc)[2][2][4][2], const Unit& u, int wr, int wc, int fr, int fq) const {
        const int row0 = u.pm * BM + wr * 64 + fr; const int col0 = u.pn * BM + wc * 32 + 8 * fq;
#pragma unroll
        for (int ai = 0; ai < 2; ++ai)
#pragma unroll
            for (int m = 0; m < 4; ++m) { bf16_t* rowp = O + (size_t)(row0 + ai * HALF + m * 16) * ldc + col0;
#pragma unroll
                for (int bj = 0; bj < 2; ++bj) { const f32x4 v0 = acc[ai][bj][m][0], v1 = acc[ai][bj][m][1];
                    u32x4 w; w.x = cvt_pk_bf16(v0[0], v0[1]); w.y = cvt_pk_bf16(v0[2], v0[3]); w.z = cvt_pk_bf16(v1[0], v1[1]); w.w = cvt_pk_bf16(v1[2], v1[3]);
                    *(u32x4*)(rowp + bj * HALF) = w; } }
    }
};

template <int CTRL> __device__ __forceinline__ float dpprot(float src) { return __builtin_bit_cast(float, __builtin_amdgcn_mov_dpp(__builtin_bit_cast(int, src), CTRL, 0xf, 0xf, true)); }
template <int CTRL> __device__ __forceinline__ float dppf(float old, float src) { return __builtin_bit_cast(float, __builtin_amdgcn_update_dpp(__builtin_bit_cast(int, old), __builtin_bit_cast(int, src), CTRL, 0xf, 0xf, false)); }
#define PG8_DPP4(dst, oldv, srcv, ctrl) do { dst[0] = dppf<ctrl>(oldv[0], srcv[0]); dst[1] = dppf<ctrl>(oldv[1], srcv[1]); dst[2] = dppf<ctrl>(oldv[2], srcv[2]); dst[3] = dppf<ctrl>(oldv[3], srcv[3]); } while (0)
struct EpiFfn {
    static constexpr bool PERM = true, AFTER_DRAIN = false;
    bf16_t* O; int ldc; int mode;
    bf16_t* Ue; const float* cw; PG8_LAS f32x4* ex; int wv;
    __device__ __forceinline__ void operator()(const f32x4 (&acc)[2][2][4][2], const Unit& u, int wr, int wc, int fr_in, int fq_in) const {
        (void)fr_in; (void)fq_in; const int lane_e = otid(wv) & 63; const int fr = lane_e & 15, fq = lane_e >> 4;
        if (mode == 0) {
            const int row0 = u.pm * BM + wr * 64 + fr; const int col0 = u.pn * BM + wc * 32 + 8 * fq;
#pragma unroll
            for (int ai = 0; ai < 2; ++ai)
#pragma unroll
                for (int m = 0; m < 4; ++m) { bf16_t* rowp = O + (size_t)(row0 + ai * HALF + m * 16) * ldc + col0;
#pragma unroll
                    for (int bj = 0; bj < 2; ++bj) { const f32x4 v0 = acc[ai][bj][m][0], v1 = acc[ai][bj][m][1];
                        u32x4 w; w.x = cvt_pk_bf16(v0[0], v0[1]); w.y = cvt_pk_bf16(v0[2], v0[3]); w.z = cvt_pk_bf16(v1[0], v1[1]); w.w = cvt_pk_bf16(v1[2], v1[3]);
                        *(u32x4*)(rowp + bj * HALF) = w; } }
            return;
        }
        const int chl = wc * 32 + 8 * fq, ch = u.pn * 128 + chl;
        f32x4 wA[3][2], wG[3][2];
#pragma unroll
        for (int t = 0; t < 3; ++t)
#pragma unroll
            for (int n = 0; n < 2; ++n) { wA[t][n] = *(const f32x4*)(cw + t * 5632 + ch + 4 * n); wG[t][n] = *(const f32x4*)(cw + t * 5632 + 2816 + ch + 4 * n); }
#define PG8_EX(blk, fl, bj, n) ex[((((blk) * 2 + (fl)) * 2 + (bj)) * 2 + (n)) * 16 + wc * 4 + fq]
#pragma unroll
        for (int ai = 0; ai < 2; ++ai) { const int blk = ai * 2 + wr;
            if (fr == 0) {
#pragma unroll
                for (int bj = 0; bj < 2; ++bj)
#pragma unroll
                    for (int n = 0; n < 2; ++n) PG8_EX(blk, 0, bj, n) = acc[ai][bj][0][n]; }
            if (fr == 15) {
#pragma unroll
                for (int bj = 0; bj < 2; ++bj)
#pragma unroll
                    for (int n = 0; n < 2; ++n) PG8_EX(blk, 1, bj, n) = acc[ai][bj][3][n]; } }
        asm volatile("s_waitcnt lgkmcnt(0)" ::: "memory"); __builtin_amdgcn_s_barrier(); asm volatile("" ::: "memory");
        const f32x4 zero4 = (f32x4){0.f, 0.f, 0.f, 0.f}; const bool is15 = fr == 15, is0 = fr == 0;
#pragma unroll
        for (int ai = 0; ai < 2; ++ai) { const int blk = ai * 2 + wr;
            f32x4 pb[2][2], nb[2][2];
#pragma unroll
            for (int bj = 0; bj < 2; ++bj)
#pragma unroll
                for (int n = 0; n < 2; ++n) { pb[bj][n] = blk > 0 ? PG8_EX(blk - 1, 1, bj, n) : zero4; nb[bj][n] = blk < 3 ? PG8_EX(blk + 1, 0, bj, n) : zero4; }
#pragma unroll
            for (int m = 0; m < 4; ++m) {
                f32x4 cv[2][2];
#pragma unroll
                for (int bj = 0; bj < 2; ++bj)
#pragma unroll
                    for (int n = 0; n < 2; ++n) { const f32x4 cur = acc[ai][bj][m][n];
                        const f32x4 lo = (m == 0) ? pb[bj][n] : acc[ai][bj][m > 0 ? m - 1 : 0][n];
                        const f32x4 hi = (m == 3) ? nb[bj][n] : acc[ai][bj][m < 3 ? m + 1 : 3][n];
                        f32x4 prev, next;
#pragma unroll
                        for (int e = 0; e < 4; ++e) { prev[e] = dpprot<0x121>(is15 ? lo[e] : cur[e]);
                                                      next[e] = dpprot<0x12F>(is0 ? hi[e] : cur[e]); }
                        const f32x4 w0 = bj ? wG[0][n] : wA[0][n], w1 = bj ? wG[1][n] : wA[1][n], w2 = bj ? wG[2][n] : wA[2][n];
                        cv[bj][n] = w0 * prev + w1 * cur + w2 * next; }
                u32x4 w; float g[8];
#pragma unroll
                for (int n = 0; n < 2; ++n)
#pragma unroll
                    for (int e = 0; e < 4; ++e) { const float av = cv[0][n][e]; g[4 * n + e] = av * __builtin_amdgcn_rcpf(1.f + __expf(-av)) * cv[1][n][e]; }
                w.x = cvt_pk_bf16(g[0], g[1]); w.y = cvt_pk_bf16(g[2], g[3]); w.z = cvt_pk_bf16(g[4], g[5]); w.w = cvt_pk_bf16(g[6], g[7]);
                *(u32x4*)(O + (size_t)(u.pm * BM + ai * HALF + wr * 64 + m * 16 + fr) * 2816 + ch) = w;
            } }
#undef PG8_EX
        { const int slot = (wr == 0) ? (fr == 0 ? 0 : (fr == 1 ? 1 : -1)) : (fr == 14 ? 2 : (fr == 15 ? 3 : -1));
          if (slot >= 0) { bf16_t* up = Ue + ((size_t)(u.pm * 4 + slot) * 5632) + u.pn * 256 + chl;
#pragma unroll
              for (int bj = 0; bj < 2; ++bj) { const f32x4 v0 = wr ? acc[1][bj][3][0] : acc[0][bj][0][0], v1 = wr ? acc[1][bj][3][1] : acc[0][bj][0][1];
                  u32x4 w; w.x = cvt_pk_bf16(v0[0], v0[1]); w.y = cvt_pk_bf16(v0[2], v0[3]); w.z = cvt_pk_bf16(v1[0], v1[1]); w.w = cvt_pk_bf16(v1[2], v1[3]);
                  *(u32x4*)(up + bj * HALF) = w; } } }
    }
};
template <class Epi, class Sched, bool ALIGN_EPI = false, bool SP2 = false>
__device__ __forceinline__ void gemm_phase(PG8_LAS unsigned char* lds, const Gemm g, const Sched& S, const Epi& E) {
    const int tid = otid(g.wv), wid = g.wv, lane = tid & 63, wr = wid >> 2, wc = wid & 3, fr = lane & 15, fq = lane >> 4;
    const int K = g.K, nt = K / BK;
    unsigned voffA[2], voffB[2];
#pragma unroll
    for (int i = 0; i < 2; ++i) { int R, C; stage_rc(tid * 16 + i * 8192, R, C); const int Rb = Epi::PERM ? ((R & ~31) + perm32(R & 31)) : R;
        voffA[i] = (unsigned)(R * K + C) * 2u; voffB[i] = (unsigned)(Rb * K + C) * 2u; }
    const size_t kstep = (size_t)(BK * 2);
    const size_t hstep = (size_t)HALF * K * 2;
    const size_t tstep = 2 * hstep;
    const unsigned ldsw = (unsigned)wid * 1024u;
    const int aoff = lds_byte(wr * 64 + fr, fq * 8), boff = lds_byte(wc * 32 + fr, fq * 8);
#define PG8_SA(b, h) (((b) * 2 + (h)) * HTB)
#define PG8_SB(b, h) ((4 + (b) * 2 + (h)) * HTB)
#define PG8_STAGE(bufoff, gbase, voff) do { _Pragma("unroll") for (int _i = 0; _i < 2; ++_i) \
        __builtin_amdgcn_global_load_lds((const unsigned*)((const char*)(gbase) + (voff)[_i]), (PG8_LAS unsigned*)(lds + (bufoff) + ldsw + _i * 8192), 16, 0, 0); } while (0)
#define PG8_LDA(dst, b, h) do { _Pragma("unroll") for (int m = 0; m < 4; ++m) _Pragma("unroll") for (int k = 0; k < 2; ++k) dst[m][k] = *(const PG8_LAS bf16x8*)(lds + PG8_SA(b, h) + aoff + m * 2048 + k * 1024); } while (0)
#define PG8_LDB(dst, b, h) do { _Pragma("unroll") for (int n = 0; n < 2; ++n) _Pragma("unroll") for (int k = 0; k < 2; ++k) dst[n][k] = *(const PG8_LAS bf16x8*)(lds + PG8_SB(b, h) + boff + n * 2048 + k * 1024); } while (0)
#define PG8_MMA(ai, bj, At, Bt) do { __builtin_amdgcn_s_setprio(1); _Pragma("unroll") for (int m = 0; m < 4; ++m) _Pragma("unroll") for (int n = 0; n < 2; ++n) _Pragma("unroll") for (int k = 0; k < 2; ++k) \
        acc[ai][bj][m][n] = __builtin_amdgcn_mfma_f32_16x16x32_bf16(Bt[n][k], At[m][k], acc[ai][bj][m][n], 0, 0, 0); __builtin_amdgcn_s_setprio(0); } while (0)
#define PG8_WAIT_V(n) asm volatile("s_waitcnt vmcnt(" #n ")" ::: "memory")
#define PG8_WAIT_L(n) asm volatile("s_waitcnt lgkmcnt(" #n ")" ::: "memory")
#define PG8_BAR __builtin_amdgcn_s_barrier()
#define PG8_SCHED __builtin_amdgcn_sched_barrier(0)
    Unit cur, nxt; int ui = 0;
#ifdef GDIAG
    unsigned gd0 = 0, gd1 = 0, gd2 = 0; const unsigned gstart = (unsigned)__builtin_amdgcn_s_memtime();
#endif
    if (!S.next(0, cur)) return;
    f32x4 acc[2][2][4][2];
#pragma unroll
    for (int a = 0; a < 2; ++a)
#pragma unroll
        for (int b = 0; b < 2; ++b)
#pragma unroll
            for (int m = 0; m < 4; ++m)
#pragma unroll
                for (int n = 0; n < 2; ++n) acc[a][b][m][n] = (f32x4){0.f, 0.f, 0.f, 0.f};
    bf16x8 At[4][2], B0[2][2], B1[2][2];
    const char* cA = (const char*)g.A + (size_t)cur.pm * tstep; const char* cB = (const char*)g.Bt + (size_t)cur.pn * tstep;
    S.a_ready(cur);
    if constexpr (SP2) {
        PG8_STAGE(PG8_SB(0, 0), cB, voffB); PG8_STAGE(PG8_SB(0, 1), cB + hstep, voffB); PG8_STAGE(PG8_SA(0, 0), cA, voffA); PG8_STAGE(PG8_SA(0, 1), cA + hstep, voffA);
        if (wr == 1) PG8_BAR;
        PG8_WAIT_V(2); PG8_BAR;
        PG8_STAGE(PG8_SB(1, 0), cB + kstep, voffB); PG8_STAGE(PG8_SA(1, 0), cA + kstep, voffA); PG8_STAGE(PG8_SB(1, 1), cB + hstep + kstep, voffB);
        PG8_WAIT_V(6); PG8_BAR;
    } else {
        PG8_STAGE(PG8_SB(0, 0), cB, voffB); PG8_STAGE(PG8_SA(0, 0), cA, voffA); PG8_STAGE(PG8_SB(0, 1), cB + hstep, voffB); PG8_STAGE(PG8_SA(0, 1), cA + hstep, voffA);
        if (wr == 1) PG8_BAR;
        PG8_WAIT_V(4); PG8_BAR;
        PG8_STAGE(PG8_SB(1, 0), cB + kstep, voffB); PG8_STAGE(PG8_SA(1, 0), cA + kstep, voffA); PG8_STAGE(PG8_SB(1, 1), cB + hstep + kstep, voffB);
        PG8_WAIT_V(6); PG8_BAR;
    }
    for (;;) {
        const bool has_next = S.next(ui + 1, nxt);
        const char* nA = has_next ? (const char*)g.A + (size_t)nxt.pm * tstep : cA; const char* nB = has_next ? (const char*)g.Bt + (size_t)nxt.pn * tstep : cB;
#ifdef GDIAG
        unsigned gt0 = (unsigned)__builtin_amdgcn_s_memtime();
#endif
        for (int t = 0; t < nt; t += 2) {
            const bool last = (t == nt - 2);
            const char* a1 = cA + (size_t)(t + 1) * kstep;
            const char* a2 = last ? nA : cA + (size_t)(t + 2) * kstep; const char* b2 = last ? nB : cB + (size_t)(t + 2) * kstep;
            const char* a3 = a2 + kstep; const char* b3 = b2 + kstep;
            if (last && has_next) S.a_ready(nxt);
            if constexpr (SP2) {
            PG8_LDB(B0, 0, 0); PG8_LDB(B1, 0, 1); PG8_SCHED; PG8_LDA(At, 0, 0); PG8_STAGE(PG8_SA(1, 1), a1 + hstep, voffA);
            PG8_WAIT_V(8); PG8_WAIT_L(0); PG8_BAR; PG8_MMA(0, 0, At, B0); PG8_MMA(0, 1, At, B1); PG8_BAR; PG8_SCHED;
            PG8_LDA(At, 0, 1); PG8_STAGE(PG8_SB(0, 0), b2, voffB); PG8_STAGE(PG8_SB(0, 1), b2 + hstep, voffB); PG8_STAGE(PG8_SA(0, 0), a2, voffA);
            PG8_WAIT_V(8); PG8_WAIT_L(0); PG8_BAR; PG8_MMA(1, 0, At, B0); PG8_MMA(1, 1, At, B1); PG8_BAR; PG8_SCHED;
            PG8_LDB(B0, 1, 0); PG8_LDB(B1, 1, 1); PG8_SCHED; PG8_LDA(At, 1, 0); PG8_STAGE(PG8_SA(0, 1), a2 + hstep, voffA);
            PG8_WAIT_V(8); PG8_WAIT_L(0); PG8_BAR; PG8_MMA(0, 0, At, B0); PG8_MMA(0, 1, At, B1); PG8_BAR; PG8_SCHED;
            PG8_LDA(At, 1, 1); PG8_STAGE(PG8_SB(1, 0), b3, voffB); PG8_STAGE(PG8_SB(1, 1), b3 + hstep, voffB); PG8_STAGE(PG8_SA(1, 0), a3, voffA);
            PG8_WAIT_V(8); PG8_WAIT_L(0); PG8_BAR; PG8_MMA(1, 0, At, B0); PG8_MMA(1, 1, At, B1); PG8_BAR; PG8_SCHED;
            } else {
            PG8_LDB(B0, 0, 0); PG8_SCHED; PG8_LDA(At, 0, 0); PG8_STAGE(PG8_SA(1, 1), a1 + hstep, voffA);
            PG8_WAIT_L(8); PG8_BAR; PG8_WAIT_L(0); PG8_MMA(0, 0, At, B0); PG8_BAR; PG8_SCHED;
            PG8_LDB(B1, 0, 1); PG8_STAGE(PG8_SB(0, 0), b2, voffB);
            PG8_BAR; PG8_WAIT_L(0); PG8_MMA(0, 1, At, B1); PG8_BAR;
            PG8_LDA(At, 0, 1); PG8_STAGE(PG8_SA(0, 0), a2, voffA);
            PG8_BAR; PG8_WAIT_L(0); PG8_MMA(1, 0, At, B0); PG8_BAR; PG8_SCHED;
            PG8_STAGE(PG8_SB(0, 1), b2 + hstep, voffB);
            PG8_WAIT_V(6); PG8_BAR; PG8_MMA(1, 1, At, B1); PG8_BAR;
            PG8_LDB(B0, 1, 0); PG8_SCHED; PG8_LDA(At, 1, 0); PG8_STAGE(PG8_SA(0, 1), a2 + hstep, voffA);
            PG8_WAIT_L(8); PG8_BAR; PG8_WAIT_L(0); PG8_MMA(0, 0, At, B0); PG8_BAR; PG8_SCHED;
            PG8_LDB(B1, 1, 1); PG8_STAGE(PG8_SB(1, 0), b3, voffB);
            PG8_BAR; PG8_WAIT_L(0); PG8_MMA(0, 1, At, B1); PG8_BAR;
            PG8_LDA(At, 1, 1); PG8_STAGE(PG8_SA(1, 0), a3, voffA);
            PG8_BAR; PG8_WAIT_L(0); PG8_MMA(1, 0, At, B0); PG8_BAR; PG8_SCHED;
            PG8_STAGE(PG8_SB(1, 1), b3 + hstep, voffB);
            PG8_WAIT_V(6); PG8_BAR; PG8_MMA(1, 1, At, B1); PG8_BAR;
            }
        }
#ifdef GDIAG
        { const unsigned n_ = (unsigned)__builtin_amdgcn_s_memtime(); gd0 += n_ - gt0; gt0 = n_; }
#endif
        if constexpr (ALIGN_EPI) { if (wr == 0) PG8_BAR; }
#ifdef GDIAG
        { const unsigned n_ = (unsigned)__builtin_amdgcn_s_memtime(); gd1 += n_ - gt0; gt0 = n_; }
#endif
        if constexpr (!Epi::AFTER_DRAIN) { E(acc, cur, wr, wc, fr, fq); S.done(cur); }
#ifdef GDIAG
        { const unsigned n_ = (unsigned)__builtin_amdgcn_s_memtime(); gd2 += n_ - gt0; gt0 = n_; }
#endif
        if (!has_next) break;
#pragma unroll
        for (int a = 0; a < 2; ++a)
#pragma unroll
            for (int b = 0; b < 2; ++b)
#pragma unroll
                for (int m = 0; m < 4; ++m)
#pragma unroll
                    for (int n = 0; n < 2; ++n) acc[a][b][m][n] = (f32x4){0.f, 0.f, 0.f, 0.f};
        cur = nxt; cA = nA; cB = nB; ++ui;
        if constexpr (ALIGN_EPI) { if (wr == 1) PG8_BAR; }
    }
#ifdef GDIAG
    if (g.dg && blockIdx.x == 0 && wid == GDIAG_WAVE && lane == 0) { const unsigned tot = (unsigned)__builtin_amdgcn_s_memtime() - gstart; g.dg[0] = (float)gd0; g.dg[1] = (float)gd1; g.dg[2] = (float)gd2; g.dg[3] = (float)tot; }
#endif
    PG8_WAIT_V(0);
    if constexpr (!ALIGN_EPI) { if (wr == 0) PG8_BAR; }
    PG8_BAR;
    if constexpr (Epi::AFTER_DRAIN) { E.fused(acc, cur, wr, wc, fr, fq, lds, wid, lane); S.done(cur); }
#undef PG8_SA
#undef PG8_SB
#undef PG8_STAGE
#undef PG8_LDA
#undef PG8_LDB
#undef PG8_MMA
#undef PG8_WAIT_V
#undef PG8_WAIT_L
#undef PG8_BAR
#undef PG8_SCHED
}
}

typedef unsigned short bf16;
typedef unsigned v4u __attribute__((ext_vector_type(4)));
typedef unsigned v2u __attribute__((ext_vector_type(2)));
typedef float f32x4 __attribute__((ext_vector_type(4)));
constexpr int NWAVES = 8, NTHR = 512;
constexpr int D = 1024, NB = 8, SEQ = 2048, CTXL = 256, TL = NB * SEQ, TC = NB * CTXL, T = TL + TC;
constexpr int HYB_IN = 2208, HYB_INP = 2304, SSD_IN = 5184, SSD_INP = 5376, DFF = 2816, UPW = 5632;
constexpr int QW = 768, KVW = 1024, MODW = 6144;
constexpr float EPS = 1e-6f;
constexpr int NSTEP = 1 + 4 * 10;
constexpr float ATT_SCALE_LOG2E = 0.10206207261596577f * 1.4426950408889634f;

constexpr size_t MiB = 1u << 20;
constexpr size_t WS_CTL = 0, CTL_ZERO_BYTES = 64 * 1024;
constexpr size_t WS_MOD = 1 * MiB;
constexpr size_t WS_ROPE = 2 * MiB;
constexpr size_t W_UP = 3 * MiB;
constexpr size_t W_DN = W_UP + (size_t)UPW * D * 2;
constexpr size_t W_IN = W_DN + (size_t)D * DFF * 2;
constexpr size_t W_OUT = W_IN + (size_t)SSD_INP * D * 2;
constexpr size_t W_UQ = W_OUT + (size_t)D * 2048 * 2;
constexpr size_t W_UKV = W_UQ + (size_t)QW * 384 * 2;
constexpr size_t W_END = W_UKV + (size_t)KVW * 256 * 2;
constexpr size_t WS_XC = 36 * MiB;
constexpr size_t WS_H = 44 * MiB;
constexpr size_t WS_DT = WS_H, WS_AA = WS_H + (size_t)T * 64 * 4;
constexpr size_t WS_BIG = 80 * MiB;
constexpr size_t WS_M = WS_BIG;
constexpr size_t WS_P = WS_BIG;
constexpr size_t WS_Q = WS_BIG + 81 * MiB;
constexpr size_t WS_KV = WS_BIG + 108 * MiB;
constexpr size_t WS_KR = WS_BIG + 144 * MiB;
constexpr size_t WS_CQN = WS_BIG + 146 * MiB;
constexpr size_t WS_CKVN = WS_BIG + 160 * MiB;
constexpr size_t WS_MIX = WS_BIG + 170 * MiB;
constexpr size_t WS_U = WS_BIG;
constexpr size_t WS_G = WS_BIG + 198 * MiB;
constexpr size_t WS_ZX = WS_BIG;
constexpr size_t WS_XBC = WS_BIG + 189 * MiB;
constexpr size_t WS_UE = WS_BIG + 297 * MiB;
constexpr size_t WS_END = WS_UE + 4 * MiB;
static_assert(W_END <= WS_XC && WS_G + (size_t)T * DFF * 2 <= WS_END && WS_XBC + (size_t)T * 3072 * 2 <= WS_END && WS_ZX + (size_t)T * SSD_INP * 2 <= WS_XBC, "ws map");
static_assert(WS_AA + (size_t)T * 64 * 4 <= WS_BIG && WS_MIX + (size_t)T * D * 2 <= WS_END && WS_Q + (size_t)T * QW * 2 <= WS_KV && WS_P + (size_t)T * HYB_INP * 2 <= WS_Q, "ws map 2");
constexpr int LDS_BYTES = 147456;

struct Args { const float* in[25]; float* out; unsigned char* ws; int lo, hi; int wv, pad; };
enum { I_X = 0, I_C, I_CTX, I_CCTX, I_MODW, I_MODB, I_NORMW, I_WUP, I_FCONV, I_WDN, I_HIN, I_QNORM, I_KVNORM, I_WUQ, I_WUKV, I_SCONV, I_HOUT, I_SIN, I_SCONVW, I_SCONVB, I_ALOG, I_DTB, I_SD, I_SNORM, I_SOUT };

__device__ __forceinline__ unsigned f2bf(float f) { unsigned u = __builtin_bit_cast(unsigned, f); return (u + 0x7fffu + ((u >> 16) & 1u)) >> 16; }
__device__ __forceinline__ unsigned pk2(float lo, float hi) { return f2bf(lo) | (f2bf(hi) << 16); }
__device__ __forceinline__ float bflo(unsigned u) { return __builtin_bit_cast(float, u << 16); }
__device__ __forceinline__ float bfhi(unsigned u) { return __builtin_bit_cast(float, u & 0xffff0000u); }
__device__ __forceinline__ float bf1(bf16 b) { return __builtin_bit_cast(float, (unsigned)b << 16); }
__device__ __forceinline__ float silu_f(float x) { return x * __builtin_amdgcn_rcpf(1.f + __expf(-x)); }
__device__ __forceinline__ float wave_sum(float v, int lane) {
#pragma unroll
    for (int o = 1; o < 64; o <<= 1) v += shx(v, o, lane);
    return v;
}
__device__ __forceinline__ void unpack8(const v4u w, float (&f)[8]) { f[0] = bflo(w.x); f[1] = bfhi(w.x); f[2] = bflo(w.y); f[3] = bfhi(w.y); f[4] = bflo(w.z); f[5] = bfhi(w.z); f[6] = bflo(w.w); f[7] = bfhi(w.w); }
__device__ __forceinline__ v4u pack8(const float (&f)[8]) { v4u w; w.x = pk2(f[0], f[1]); w.y = pk2(f[2], f[3]); w.z = pk2(f[4], f[5]); w.w = pk2(f[6], f[7]); return w; }
__device__ __forceinline__ bool has_prev(int r) { return r < TL ? (r & (SEQ - 1)) != 0 : ((r - TL) & (CTXL - 1)) != 0; }
__device__ __forceinline__ bool has_next(int r) { return r < TL ? (r & (SEQ - 1)) != SEQ - 1 : ((r - TL) & (CTXL - 1)) != CTXL - 1; }

__device__ __forceinline__ void mod_compute(const Args& a, LAS unsigned char* lds) {
    LAS float* sc = (LAS float*)lds;
    LAS float* red = (LAS float*)(lds + 36864);
    const int tid = otid(a.wv);
    float* MOD = (float*)(a.ws + WS_MOD);
    for (int i = tid; i < 9 * 1024; i += NTHR) { const int c = i >> 10, k = i & 1023; const float v = c < 8 ? a.in[I_C][c * 1024 + k] : a.in[I_CCTX][k]; sc[i] = silu_f(v); }
    __syncthreads();
    for (int item = blockIdx.x; item < 4 * 96; item += gridDim.x) {
        const int l = item / 96, cb = item % 96;
        const float* W = a.in[I_MODW] + (size_t)l * 1024 * MODW + cb * 64;
        const int cgp = tid & 15, kg = tid >> 4;
        float acc[9][4];
#pragma unroll
        for (int c = 0; c < 9; ++c) { acc[c][0] = 0.f; acc[c][1] = 0.f; acc[c][2] = 0.f; acc[c][3] = 0.f; }
#pragma unroll 8
        for (int kk = 0; kk < 32; ++kk) { const int k = kg * 32 + kk; const f32x4 w = *(const f32x4*)(W + (size_t)k * MODW + cgp * 4);
#pragma unroll
            for (int c = 0; c < 9; ++c) { const float s = sc[c * 1024 + k]; acc[c][0] += s * w[0]; acc[c][1] += s * w[1]; acc[c][2] += s * w[2]; acc[c][3] += s * w[3]; } }
#pragma unroll
        for (int c = 0; c < 9; ++c)
#pragma unroll
            for (int j = 0; j < 4; ++j) red[kg * 576 + c * 64 + cgp * 4 + j] = acc[c][j];
        __syncthreads();
        for (int o = tid; o < 576; o += NTHR) { float s = 0.f;
            for (int g = 0; g < 32; ++g) s += red[g * 576 + o];
            const int c = o >> 6, col = o & 63; MOD[(size_t)(l * 9 + c) * MODW + cb * 64 + col] = s + a.in[I_MODB][l * MODW + cb * 64 + col]; }
        __syncthreads();
    }
}
__device__ __forceinline__ void rope_tables(const Args& a) {
    float* ct = (float*)(a.ws + WS_ROPE); float* st = ct + SEQ * 16;
    for (int i = blockIdx.x * NTHR + otid(a.wv); i < SEQ * 16; i += gridDim.x * NTHR) {
        const int t = i >> 4, j = i & 15; const int pos = j < 8 ? (t >> 6) : (t & 63); const int f = j & 7;
        const float i0 = (f & 1) ? 0.31622776601683794f : 1.0f; const int e = f >> 1; const float i1 = e == 0 ? 1.0f : (e == 1 ? 0.1f : (e == 2 ? 0.01f : 0.001f));
        const float inv = i0 * i1; const float ang = (float)pos * inv;
        ct[i] = __cosf(ang); st[i] = __sinf(ang); }
}
__device__ __forceinline__ void transpose_item(const float* W, int K, int N, bf16* WT, LAS float* scr, int item, int lane, bool ffn_perm) {
    const int nblk = N / 32, kb = item / nblk, nb = item % nblk, k0 = 64 * kb, n0 = 32 * nb;
    const int o0 = ffn_perm ? ((n0 % DFF) / 128) * 256 + (n0 / DFF) * 128 + (n0 % 128) : n0;
    float wv_[32];
#pragma unroll
    for (int i = 0; i < 32; ++i) wv_[i] = W[(size_t)(k0 + 2 * i + (lane >> 5)) * N + n0 + (lane & 31)];
#pragma unroll
    for (int i = 0; i < 32; ++i) scr[(2 * i + (lane >> 5)) * 33 + (lane & 31)] = wv_[i];
    asm volatile("s_waitcnt lgkmcnt(0)" ::: "memory");
    const int c = lane & 7;
#pragma unroll
    for (int j = 0; j < 4; ++j) { const int n = (lane >> 3) + 8 * j; const LAS float* s = scr + (8 * c) * 33 + n;
        v4u o; o.x = pk2(s[0 * 33], s[1 * 33]); o.y = pk2(s[2 * 33], s[3 * 33]); o.z = pk2(s[4 * 33], s[5 * 33]); o.w = pk2(s[6 * 33], s[7 * 33]);
        *(v4u*)(WT + (size_t)(o0 + n) * K + k0 + 8 * c) = o; }
    asm volatile("s_waitcnt lgkmcnt(0)" ::: "memory");
}
__device__ __forceinline__ void convert_weight(const float* W, int K, int N, int Npad, bf16* WT, LAS unsigned char* lds, int rot, int wv, bool ffn_perm = false) {
    const int wave = wv, lane = otid(wv) & 63; const int NGW = gridDim.x * NWAVES; const int gw = (blockIdx.x * NWAVES + wave + rot) % NGW;
    LAS float* scr = (LAS float*)(lds + wave * 16384);
    const int nitems = (K / 64) * (N / 32);
    for (int it = gw; it < nitems; it += NGW) transpose_item(W, K, N, WT, scr, it, lane, ffn_perm);
    (void)Npad;
}
__device__ __forceinline__ void convert_layer(const Args& a, int l, LAS unsigned char* lds) {
    const int i = l >> 1; unsigned char* ws = a.ws;
    convert_weight(a.in[I_WUP] + (size_t)l * D * UPW, D, UPW, UPW, (bf16*)(ws + W_UP), lds, 0, a.wv, true);
    convert_weight(a.in[I_WDN] + (size_t)l * DFF * D, DFF, D, D, (bf16*)(ws + W_DN), lds, 300, a.wv);
    if ((l & 1) == 0) {
        convert_weight(a.in[I_HIN] + (size_t)i * D * HYB_IN, D, HYB_IN, HYB_INP, (bf16*)(ws + W_IN), lds, 700, a.wv);
        convert_weight(a.in[I_HOUT] + (size_t)i * D * D, D, D, D, (bf16*)(ws + W_OUT), lds, 1100, a.wv);
        convert_weight(a.in[I_WUQ] + (size_t)i * 384 * QW, 384, QW, QW, (bf16*)(ws + W_UQ), lds, 1500, a.wv);
        convert_weight(a.in[I_WUKV] + (size_t)i * 256 * KVW, 256, KVW, KVW, (bf16*)(ws + W_UKV), lds, 1700, a.wv);
    } else {
        convert_weight(a.in[I_SIN] + (size_t)i * D * SSD_IN, D, SSD_IN, SSD_INP, (bf16*)(ws + W_IN), lds, 700, a.wv);
        convert_weight(a.in[I_SOUT] + (size_t)i * 2048 * D, 2048, D, D, (bf16*)(ws + W_OUT), lds, 1300, a.wv);
    }
}

__device__ __forceinline__ void prep_even(const Args& a, int i) {
    const int wave = otid(a.wv) >> 6, lane = otid(a.wv) & 63; const int NGW = gridDim.x * NWAVES, gw = blockIdx.x * NWAVES + wave;
    const bf16* P = (const bf16*)(a.ws + WS_P); bf16* CQN = (bf16*)(a.ws + WS_CQN); bf16* CKVN = (bf16*)(a.ws + WS_CKVN); bf16* KR = (bf16*)(a.ws + WS_KR); bf16* MIX = (bf16*)(a.ws + WS_MIX);
    const float* qn = a.in[I_QNORM] + i * 384; const float* kvn = a.in[I_KVNORM] + i * 256; const float* cw = a.in[I_SCONV] + i * 3 * 512;
    const float* ct = (const float*)(a.ws + WS_ROPE); const float* st = ct + SEQ * 16;
    for (int r = gw; r < T; r += NGW) {
        const bf16* p = P + (size_t)r * HYB_INP;
        {
            const unsigned* p32 = (const unsigned*)(p + lane * 6); const unsigned w0 = p32[0], w1 = p32[1], w2 = p32[2];
            float f[6] = {bflo(w0), bfhi(w0), bflo(w1), bfhi(w1), bflo(w2), bfhi(w2)}; float ss = 0.f;
#pragma unroll
            for (int j = 0; j < 6; ++j) ss += f[j] * f[j];
            const float rs = rsqrtf(wave_sum(ss, lane) * (1.f / 384.f) + EPS);
#pragma unroll
            for (int j = 0; j < 6; ++j) f[j] = f[j] * rs * qn[lane * 6 + j];
            unsigned* o32 = (unsigned*)(CQN + (size_t)r * 384 + lane * 6); o32[0] = pk2(f[0], f[1]); o32[1] = pk2(f[2], f[3]); o32[2] = pk2(f[4], f[5]);
        }
        {
            const v2u w = *(const v2u*)(p + 384 + lane * 4); float f[4] = {bflo(w.x), bfhi(w.x), bflo(w.y), bfhi(w.y)};
            const float ss = (f[0] * f[0] + f[1] * f[1]) + (f[2] * f[2] + f[3] * f[3]);
            const float rs = rsqrtf(wave_sum(ss, lane) * (1.f / 256.f) + EPS);
            const f32x4 g = *(const f32x4*)(kvn + lane * 4);
            v2u o; o.x = pk2(f[0] * rs * g[0], f[1] * rs * g[1]); o.y = pk2(f[2] * rs * g[2], f[3] * rs * g[3]); *(v2u*)(CKVN + (size_t)r * 256 + lane * 4) = o;
        }
        {
            const int j = lane & 31; const float v = bf1(p[640 + j]); const float o = shx(v, 16, lane); float res = v;
            if (r < TL) { const int t = r & (SEQ - 1); const float c = ct[t * 16 + (j & 15)], s = st[t * 16 + (j & 15)]; res = (j < 16) ? v * c - o * s : o * s + v * c; }
            if (lane < 32) KR[(size_t)r * 32 + j] = (bf16)f2bf(res);
        }
        {
            const int c0 = lane * 8; float gb[8], cur[8], acc[8], t0[8], t1[8];
            unpack8(*(const v4u*)(p + 672 + c0), gb);
            unpack8(*(const v4u*)(p + 1184 + c0), t0); unpack8(*(const v4u*)(p + 1696 + c0), t1);
#pragma unroll
            for (int j = 0; j < 8; ++j) { cur[j] = t0[j] * t1[j]; acc[j] = cw[512 + c0 + j] * cur[j]; }
            if (has_prev(r)) { unpack8(*(const v4u*)(p - HYB_INP + 1184 + c0), t0); unpack8(*(const v4u*)(p - HYB_INP + 1696 + c0), t1);
#pragma unroll
                for (int j = 0; j < 8; ++j) acc[j] += cw[c0 + j] * (t0[j] * t1[j]); }
            if (has_next(r)) { unpack8(*(const v4u*)(p + HYB_INP + 1184 + c0), t0); unpack8(*(const v4u*)(p + HYB_INP + 1696 + c0), t1);
#pragma unroll
                for (int j = 0; j < 8; ++j) acc[j] += cw[1024 + c0 + j] * (t0[j] * t1[j]); }
#pragma unroll
            for (int j = 0; j < 8; ++j) acc[j] *= gb[j];
            *(v4u*)(MIX + (size_t)r * D + 512 + c0) = pack8(acc);
        }
    }
}

__device__ __forceinline__ void convgate(const Args& a, int l, int nrows) {
    const bf16* U = (const bf16*)(a.ws + WS_U); bf16* G = (bf16*)(a.ws + WS_G); const float* cw = a.in[I_FCONV] + (size_t)l * 3 * UPW;
    const int total = nrows * (DFF / 8);
    for (int idx = blockIdx.x * NTHR + otid(a.wv); idx < total; idx += gridDim.x * NTHR) {
        const int r = idx / (DFF / 8), c0 = (idx % (DFF / 8)) * 8; const bf16* u = U + (size_t)r * UPW + c0;
        float ua[8], ug[8], act[8], gate[8];
        unpack8(*(const v4u*)u, ua); unpack8(*(const v4u*)(u + DFF), ug);
#pragma unroll
        for (int j = 0; j < 8; ++j) { act[j] = cw[UPW + c0 + j] * ua[j]; gate[j] = cw[UPW + DFF + c0 + j] * ug[j]; }
        if (has_prev(r)) { unpack8(*(const v4u*)(u - UPW), ua); unpack8(*(const v4u*)(u - UPW + DFF), ug);
#pragma unroll
            for (int j = 0; j < 8; ++j) { act[j] += cw[c0 + j] * ua[j]; gate[j] += cw[DFF + c0 + j] * ug[j]; } }
        if (has_next(r)) { unpack8(*(const v4u*)(u + UPW), ua); unpack8(*(const v4u*)(u + UPW + DFF), ug);
#pragma unroll
            for (int j = 0; j < 8; ++j) { act[j] += cw[2 * UPW + c0 + j] * ua[j]; gate[j] += cw[2 * UPW + DFF + c0 + j] * ug[j]; } }
#pragma unroll
        for (int j = 0; j < 8; ++j) act[j] = silu_f(act[j]) * gate[j];
        *(v4u*)(G + (size_t)r * DFF + c0) = pack8(act);
    }
}

__device__ __forceinline__ void ssd_conv(const Args& a, int i) {
    const bf16* ZX = (const bf16*)(a.ws + WS_ZX); bf16* XBC = (bf16*)(a.ws + WS_XBC); float* DT = (float*)(a.ws + WS_DT); float* AA = (float*)(a.ws + WS_AA);
    const float* cw = a.in[I_SCONVW] + (size_t)i * 3 * 3072; const float* cb = a.in[I_SCONVB] + (size_t)i * 3072;
    const int total = T * 384;
    for (int idx = blockIdx.x * NTHR + otid(a.wv); idx < total; idx += gridDim.x * NTHR) {
        const int r = idx / 384, c0 = (idx % 384) * 8; const bf16* u = ZX + (size_t)r * SSD_INP + 2048 + c0;
        float x[8], acc[8];
        unpack8(*(const v4u*)u, x);
#pragma unroll
        for (int j = 0; j < 8; ++j) acc[j] = cb[c0 + j] + cw[3072 + c0 + j] * x[j];
        if (has_prev(r)) { unpack8(*(const v4u*)(u - SSD_INP), x);
#pragma unroll
            for (int j = 0; j < 8; ++j) acc[j] += cw[c0 + j] * x[j]; }
        if (has_next(r)) { unpack8(*(const v4u*)(u + SSD_INP), x);
#pragma unroll
            for (int j = 0; j < 8; ++j) acc[j] += cw[2 * 3072 + c0 + j] * x[j]; }
#pragma unroll
        for (int j = 0; j < 8; ++j) acc[j] = silu_f(acc[j]);
        *(v4u*)(XBC + (size_t)r * 3072 + c0) = pack8(acc);
    }
    const float* alog = a.in[I_ALOG] + i * 64; const float* dtb = a.in[I_DTB] + i * 64;
    for (int idx = blockIdx.x * NTHR + otid(a.wv); idx < T * 64; idx += gridDim.x * NTHR) {
        const int r = idx >> 6, j = idx & 63; const float raw = bf1(ZX[(size_t)r * SSD_INP + 5120 + j]) + dtb[j];
        const float dt = raw > 15.f ? raw : (raw < -15.f ? __expf(raw) : __logf(1.f + __expf(raw)));
        DT[idx] = dt; AA[idx] = -__expf(alog[j]) * dt;
    }
}

__device__ __forceinline__ void gatenorm(const Args& a, int i, int nrows) {
    const int wave = otid(a.wv) >> 6, lane = otid(a.wv) & 63; const int NGW = gridDim.x * NWAVES, gw = blockIdx.x * NWAVES + wave;
    const bf16* ZX = (const bf16*)(a.ws + WS_ZX); bf16* YN = (bf16*)(a.ws + WS_XBC); const float* nw = a.in[I_SNORM] + i * 2048;
    for (int r = gw; r < nrows; r += NGW) {
        float v[4][8]; float ss = 0.f;
#pragma unroll
        for (int j = 0; j < 4; ++j) { float y[8], z[8]; const int c = j * 512 + lane * 8;
            unpack8(*(const v4u*)(ZX + (size_t)r * SSD_INP + 2048 + c), y); unpack8(*(const v4u*)(ZX + (size_t)r * SSD_INP + c), z);
#pragma unroll
            for (int k = 0; k < 8; ++k) { v[j][k] = y[k] * silu_f(z[k]); ss += v[j][k] * v[j][k]; } }
        const float rs = rsqrtf(wave_sum(ss, lane) * (1.f / 2048.f) + EPS);
#pragma unroll
        for (int j = 0; j < 4; ++j) { const int c = j * 512 + lane * 8; float o[8];
#pragma unroll
            for (int k = 0; k < 8; ++k) o[k] = v[j][k] * rs * nw[c + k];
            *(v4u*)(YN + (size_t)r * 2048 + c) = pack8(o); }
    }
}

__device__ __forceinline__ void attn_naive(const Args& a, LAS unsigned char* lds) {
    const int tid = otid(a.wv), qi = tid >> 1, half = tid & 1;
    const bf16* Qb = (const bf16*)(a.ws + WS_Q); const bf16* KVb = (const bf16*)(a.ws + WS_KV); const bf16* KR = (const bf16*)(a.ws + WS_KR); bf16* MIX = (bf16*)(a.ws + WS_MIX);
    const float* ct = (const float*)(a.ws + WS_ROPE); const float* st = ct + SEQ * 16;
    LAS float* Kt = (LAS float*)lds;
    LAS float* Vt = (LAS float*)(lds + 64 * 96 * 4);
    for (int u = blockIdx.x; u < 576; u += gridDim.x) {
        const bool lat = u < 512; const int b = lat ? (u >> 6) : ((u - 512) >> 3), h = lat ? ((u >> 3) & 7) : ((u - 512) & 7);
        const int nkeys = lat ? (CTXL + SEQ) : CTXL;
        const int qrow = lat ? b * SEQ + (u & 7) * 256 + qi : TL + b * CTXL + qi;
        float q[48];
#pragma unroll
        for (int g = 0; g < 6; ++g) { float f[8]; unpack8(*(const v4u*)(Qb + (size_t)qrow * QW + h * 96 + half * 48 + g * 8), f);
#pragma unroll
            for (int j = 0; j < 8; ++j) q[g * 8 + j] = f[j]; }
        if (lat && half == 1) { const int t = qrow & (SEQ - 1);
#pragma unroll
            for (int j = 0; j < 16; ++j) { const float c = ct[t * 16 + j], s = st[t * 16 + j]; const float x1 = q[16 + j], x2 = q[32 + j]; q[16 + j] = x1 * c - x2 * s; q[32 + j] = x1 * s + x2 * c; } }
#pragma unroll
        for (int j = 0; j < 48; ++j) q[j] *= ATT_SCALE_LOG2E;
        float o[32]; float m = -1e30f, l = 0.f;
#pragma unroll
        for (int j = 0; j < 32; ++j) o[j] = 0.f;
        for (int k0 = 0; k0 < nkeys; k0 += 64) {
            __syncthreads();
            for (int g = tid; g < 768; g += NTHR) { const int key = g / 12, part = g % 12; const int kk = k0 + key; const int krow = kk < CTXL ? TL + b * CTXL + kk : b * SEQ + kk - CTXL;
                float f[8]; unpack8(part < 8 ? *(const v4u*)(KVb + (size_t)krow * KVW + h * 128 + part * 8) : *(const v4u*)(KR + (size_t)krow * 32 + (part - 8) * 8), f);
#pragma unroll
                for (int j = 0; j < 8; ++j) Kt[key * 96 + part * 8 + j] = f[j]; }
            { const int key = tid >> 3, part = tid & 7; const int kk = k0 + key; const int krow = kk < CTXL ? TL + b * CTXL + kk : b * SEQ + kk - CTXL;
                float f[8]; unpack8(*(const v4u*)(KVb + (size_t)krow * KVW + h * 128 + 64 + part * 8), f);
#pragma unroll
                for (int j = 0; j < 8; ++j) Vt[key * 64 + part * 8 + j] = f[j]; }
            __syncthreads();
            for (int kg = 0; kg < 64; kg += 8) {
                float s[8]; float gm = -1e30f;
#pragma unroll
                for (int kk = 0; kk < 8; ++kk) { float acc = 0.f; const LAS f32x4* kp = (const LAS f32x4*)(Kt + (kg + kk) * 96 + half * 48);
#pragma unroll
                    for (int d4 = 0; d4 < 12; ++d4) { const f32x4 kv = kp[d4]; acc += q[d4 * 4] * kv[0] + q[d4 * 4 + 1] * kv[1] + q[d4 * 4 + 2] * kv[2] + q[d4 * 4 + 3] * kv[3]; }
                    acc += shx(acc, 1, tid & 63);
                    s[kk] = acc; gm = fmaxf(gm, acc); }
                const float mn = fmaxf(m, gm); const float alpha = exp2f(m - mn); m = mn; l *= alpha;
#pragma unroll
                for (int j = 0; j < 32; ++j) o[j] *= alpha;
#pragma unroll
                for (int kk = 0; kk < 8; ++kk) { const float p = exp2f(s[kk] - mn); l += p; const LAS f32x4* vp = (const LAS f32x4*)(Vt + (kg + kk) * 64 + half * 32);
#pragma unroll
                    for (int d4 = 0; d4 < 8; ++d4) { const f32x4 vv = vp[d4]; o[d4 * 4] += p * vv[0]; o[d4 * 4 + 1] += p * vv[1]; o[d4 * 4 + 2] += p * vv[2]; o[d4 * 4 + 3] += p * vv[3]; } }
            }
        }
        { const float inv = 1.f / l;
#pragma unroll
            for (int g = 0; g < 4; ++g) { float f[8];
#pragma unroll
                for (int j = 0; j < 8; ++j) f[j] = o[g * 8 + j] * inv;
                *(v4u*)(MIX + (size_t)qrow * D + h * 64 + half * 32 + g * 8) = pack8(f); } }
    }
}

__device__ __forceinline__ void ssd_scan_naive(const Args& a, int i, bool last, LAS unsigned char* lds) {
    const int tid = otid(a.wv), p = tid >> 3, nq = tid & 7;
    bf16* ZX = (bf16*)(a.ws + WS_ZX); const bf16* XBC = (const bf16*)(a.ws + WS_XBC); const float* DT = (const float*)(a.ws + WS_DT); const float* AA = (const float*)(a.ws + WS_AA);
    LAS float* xs = (LAS float*)lds;
    LAS float* Bs = (LAS float*)(lds + 16384);
    LAS float* Cs = (LAS float*)(lds + 16384 + 32768);
    LAS float* dts = (LAS float*)(lds + 16384 + 65536);
    LAS float* as = dts + 64;
    for (int it = blockIdx.x; it < NB * 32; it += gridDim.x) {
        const int b = it >> 5, h = it & 31, g = h >> 3; const float dsk = a.in[I_SD][i * 32 + h];
        for (int dir = 0; dir < 2; ++dir) {
            float stt[16];
#pragma unroll
            for (int n = 0; n < 16; ++n) stt[n] = 0.f;
            for (int seg = 0; seg < 2; ++seg) {
                const int len = seg == 0 ? CTXL : SEQ; const int base = seg == 0 ? TL + b * CTXL : b * SEQ; const bool want_y = !(last && seg == 0);
                for (int cc = 0; cc < len / 64; ++cc) {
                    const int t0 = dir == 0 ? cc * 64 : len - 64 - cc * 64;
                    __syncthreads();
                    { const int tt = tid >> 3, part = tid & 7; float f[8]; unpack8(*(const v4u*)(XBC + (size_t)(base + t0 + tt) * 3072 + h * 64 + part * 8), f);
#pragma unroll
                        for (int j = 0; j < 8; ++j) xs[tt * 64 + part * 8 + j] = f[j]; }
                    for (int q = tid; q < 1024; q += NTHR) { const int tt = q >> 4, part = q & 15; float f[8];
                        unpack8(*(const v4u*)(XBC + (size_t)(base + t0 + tt) * 3072 + 2048 + g * 128 + part * 8), f);
#pragma unroll
                        for (int j = 0; j < 8; ++j) Bs[tt * 128 + part * 8 + j] = f[j];
                        unpack8(*(const v4u*)(XBC + (size_t)(base + t0 + tt) * 3072 + 2560 + g * 128 + part * 8), f);
#pragma unroll
                        for (int j = 0; j < 8; ++j) Cs[tt * 128 + part * 8 + j] = f[j]; }
                    if (tid < 64) { dts[tid] = DT[(size_t)(base + t0 + tid) * 64 + dir * 32 + h]; as[tid] = AA[(size_t)(base + t0 + tid) * 64 + dir * 32 + h]; }
                    __syncthreads();
                    for (int s = 0; s < 64; ++s) {
                        const int tt = dir == 0 ? s : 63 - s;
                        const float dec = __expf(as[tt]); const float xv = xs[tt * 64 + p]; const float xd = xv * dts[tt];
                        const LAS f32x4* bp = (const LAS f32x4*)(Bs + tt * 128 + nq * 16); const LAS f32x4* cp = (const LAS f32x4*)(Cs + tt * 128 + nq * 16);
                        float acc = 0.f;
#pragma unroll
                        for (int n4 = 0; n4 < 4; ++n4) { const f32x4 bv = bp[n4], cv = cp[n4];
#pragma unroll
                            for (int k = 0; k < 4; ++k) { stt[n4 * 4 + k] = dec * stt[n4 * 4 + k] + xd * bv[k]; acc += cv[k] * stt[n4 * 4 + k]; } }
                        acc += shx(acc, 1, tid & 63); acc += shx(acc, 2, tid & 63); acc += shx(acc, 4, tid & 63);
                        if (want_y && nq == 0) { bf16* yp = ZX + (size_t)(base + t0 + tt) * SSD_INP + 2048 + h * 64 + p;
                            const float y = dir == 0 ? acc + dsk * xv : acc + bf1(*yp);
                            *yp = (bf16)f2bf(y); }
                    }
                }
            }
            __syncthreads();
            asm volatile("s_waitcnt vmcnt(0)" ::: "memory");
        }
    }
}

typedef short bf16x8 __attribute__((ext_vector_type(8)));
typedef float f32x16 __attribute__((ext_vector_type(16)));
typedef short v4i16_t __attribute__((ext_vector_type(4)));
__device__ __forceinline__ v2u trread(const LAS unsigned char* p) { return __builtin_bit_cast(v2u, __builtin_amdgcn_ds_read_tr16_b64_v4i16((LAS v4i16_t*)p)); }
__device__ __forceinline__ unsigned cvtpk(float lo, float hi) { unsigned r; asm volatile("v_cvt_pk_bf16_f32 %0, %1, %2" : "=v"(r) : "v"(lo), "v"(hi)); return r; }
constexpr int ATT_KP = 208, ATT_VP = 192, ATT_KB = 64 * ATT_KP, ATT_VB = 64 * ATT_VP, ATT_BUF = ATT_KB + ATT_VB;
#ifndef ATT_NQ
#define ATT_NQ 2
#endif
template <int NQ>
__device__ __forceinline__ void attn_unit3(const Args& a, LAS unsigned char* lds, const int b, const int h, const int q0, const int ntiles, const bool lat) {
    const int tid = otid(a.wv), wave = a.wv, lane = tid & 63, r32 = lane & 31, hh = lane >> 5;
    const int tq = (lane >> 2) & 3, tp = lane & 3, tblk = (lane >> 4) & 1;
    const bf16* Qb = (const bf16*)(a.ws + WS_Q); const bf16* KVb = (const bf16*)(a.ws + WS_KV); const bf16* KR = (const bf16*)(a.ws + WS_KR); bf16* MIX = (bf16*)(a.ws + WS_MIX);
    const float* ct = (const float*)(a.ws + WS_ROPE); const float* st = ct + SEQ * 16;
    bf16x8 qf[NQ][6];
#pragma unroll
    for (int nq = 0; nq < NQ; ++nq) { const int qrow = q0 + wave * (32 * NQ) + nq * 32 + r32;
#pragma unroll
        for (int s = 0; s < 6; ++s) qf[nq][s] = *(const bf16x8*)(Qb + (size_t)qrow * QW + h * 96 + 16 * s + 8 * hh);
        if (lat) { const int t = qrow & (SEQ - 1);
#pragma unroll
            for (int j = 0; j < 8; j += 2) { float x1[2], x2[2], y1[2], y2[2];
#pragma unroll
                for (int e = 0; e < 2; ++e) { x1[e] = bf1((bf16)qf[nq][4][j + e]); x2[e] = bf1((bf16)qf[nq][5][j + e]); const float c = ct[t * 16 + 8 * hh + j + e], s = st[t * 16 + 8 * hh + j + e];
                    y1[e] = x1[e] * c - x2[e] * s; y2[e] = x1[e] * s + x2[e] * c; }
                const unsigned w1 = pk2(y1[0], y1[1]), w2 = pk2(y2[0], y2[1]);
                qf[nq][4][j] = (short)(w1 & 0xffff); qf[nq][4][j + 1] = (short)(w1 >> 16); qf[nq][5][j] = (short)(w2 & 0xffff); qf[nq][5][j + 1] = (short)(w2 >> 16); } } }
    f32x16 o0[NQ], o1[NQ]; float m[NQ], l[NQ];
#pragma unroll
    for (int nq = 0; nq < NQ; ++nq) { m[nq] = -1e30f; l[nq] = 0.f;
#pragma unroll
        for (int i = 0; i < 16; ++i) { o0[nq][i] = 0.f; o1[nq][i] = 0.f; } }
    v4u kreg0, kreg1, vreg;
#define ATT_LOAD(it) do { const int rb_ = (it) < CTXL / 64 ? TL + b * CTXL + (it) * 64 : b * SEQ + ((it) - CTXL / 64) * 64; \
        const char* kvb_ = (const char*)(KVb + (size_t)rb_ * KVW); const char* krb_ = (const char*)(KR + (size_t)rb_ * 32); \
        kreg0 = *(const v4u*)(kvb_ + (tid >> 3) * 2048 + h * 256 + (tid & 7) * 16); if (tid < 256) kreg1 = *(const v4u*)(krb_ + (tid >> 2) * 64 + (tid & 3) * 16); vreg = *(const v4u*)(kvb_ + (tid >> 3) * 2048 + h * 256 + 128 + (tid & 7) * 16); } while (0)
#define ATT_WRITE(buf) do { LAS unsigned char* kb_ = lds + (buf) * ATT_BUF; LAS unsigned char* vb_ = kb_ + ATT_KB; \
        *(LAS v4u*)(kb_ + (tid >> 3) * ATT_KP + (tid & 7) * 16) = kreg0; if (tid < 256) *(LAS v4u*)(kb_ + (tid >> 2) * ATT_KP + 128 + (tid & 3) * 16) = kreg1; \
        *(LAS v4u*)(vb_ + (tid >> 3) * ATT_VP + (tid & 7) * 16) = vreg; } while (0)
    __syncthreads();
    ATT_LOAD(0); ATT_WRITE(0);
    __syncthreads();
    for (int it = 0; it < ntiles; ++it) {
#ifndef ATT_LOADMID
        if (it + 1 < ntiles) ATT_LOAD(it + 1);
#endif
#ifdef ATT_TZ
        int tz = tid; asm volatile("" : "+v"(tz));
        const int lane = tz & 63, r32 = lane & 31, hh = lane >> 5, tq = (lane >> 2) & 3, tp = lane & 3, tblk = (lane >> 4) & 1;
#endif
        const LAS unsigned char* kb = lds + (it & 1) * ATT_BUF; const LAS unsigned char* vb = kb + ATT_KB;
#pragma unroll
        for (int t = 0; t < 2; ++t) {
            f32x16 sc[NQ]; bf16x8 pf[NQ][2];
#pragma unroll
            for (int nq = 0; nq < NQ; ++nq)
#pragma unroll
                for (int i = 0; i < 16; ++i) sc[nq][i] = 0.f;
            bf16x8 kf[6];
#pragma unroll
            for (int s = 0; s < 6; ++s) kf[s] = *(const LAS bf16x8*)(kb + (32 * t + r32) * ATT_KP + (16 * s + 8 * hh) * 2);
            asm volatile("" : "+v"(kf[0]), "+v"(kf[1]), "+v"(kf[2]), "+v"(kf[3]), "+v"(kf[4]), "+v"(kf[5]));
#pragma unroll
            for (int s = 0; s < 6; ++s)
#pragma unroll
                for (int nq = 0; nq < NQ; ++nq) sc[nq] = __builtin_amdgcn_mfma_f32_32x32x16_bf16(kf[s], qf[nq][s], sc[nq], 0, 0, 0);
#ifdef ATT_LOADMID
            if (t == 0 && it + 1 < ntiles) ATT_LOAD(it + 1);
#endif
#pragma unroll
            for (int nq = 0; nq < NQ; ++nq) {
                float mx = sc[nq][0];
#pragma unroll
                for (int i = 1; i < 16; ++i) mx = fmaxf(mx, sc[nq][i]);
                mx = fmaxf(mx, shx(mx, 32, lane));
                const float mn = fmaxf(m[nq], mx * ATT_SCALE_LOG2E); const float alpha = __builtin_amdgcn_exp2f(m[nq] - mn); m[nq] = mn;
                float rs = 0.f;
#pragma unroll
                for (int i = 0; i < 16; ++i) { sc[nq][i] = __builtin_amdgcn_exp2f(sc[nq][i] * ATT_SCALE_LOG2E - mn); rs += sc[nq][i]; }
                l[nq] = l[nq] * alpha + rs;
#pragma unroll
                for (int i = 0; i < 16; ++i) { o0[nq][i] *= alpha; o1[nq][i] *= alpha; }
#pragma unroll
                for (int s2 = 0; s2 < 2; ++s2) { v4u w0;
                    w0.x = cvtpk(sc[nq][8 * s2 + 0], sc[nq][8 * s2 + 1]); w0.y = cvtpk(sc[nq][8 * s2 + 2], sc[nq][8 * s2 + 3]); w0.z = cvtpk(sc[nq][8 * s2 + 4], sc[nq][8 * s2 + 5]); w0.w = cvtpk(sc[nq][8 * s2 + 6], sc[nq][8 * s2 + 7]);
                    pf[nq][s2] = __builtin_bit_cast(bf16x8, w0); }
            }
#pragma unroll
            for (int s2 = 0; s2 < 2; ++s2) { const int ko = t * 32 + 16 * s2 + 4 * hh;
                { const LAS unsigned char* tb = vb + (ko + tq) * ATT_VP + (16 * tblk + 4 * tp) * 2; const v2u lo = trread(tb), hi = trread(tb + 8 * ATT_VP); const bf16x8 vf = __builtin_bit_cast(bf16x8, (v4u){lo.x, lo.y, hi.x, hi.y});
#pragma unroll
                  for (int nq = 0; nq < NQ; ++nq) o0[nq] = __builtin_amdgcn_mfma_f32_32x32x16_bf16(vf, pf[nq][s2], o0[nq], 0, 0, 0); }
                { const LAS unsigned char* tb = vb + (ko + tq) * ATT_VP + (32 + 16 * tblk + 4 * tp) * 2; const v2u lo = trread(tb), hi = trread(tb + 8 * ATT_VP); const bf16x8 vf = __builtin_bit_cast(bf16x8, (v4u){lo.x, lo.y, hi.x, hi.y});
#pragma unroll
                  for (int nq = 0; nq < NQ; ++nq) o1[nq] = __builtin_amdgcn_mfma_f32_32x32x16_bf16(vf, pf[nq][s2], o1[nq], 0, 0, 0); } }
        }
        if (it + 1 < ntiles) ATT_WRITE((it + 1) & 1);
        __syncthreads();
    }
#undef ATT_LOAD
#undef ATT_WRITE
#pragma unroll
    for (int nq = 0; nq < NQ; ++nq) { const int qrow = q0 + wave * (32 * NQ) + nq * 32 + r32;
        const float lsum = l[nq] + shx(l[nq], 32, lane); const float inv = 1.f / lsum;
        bf16* orow = MIX + (size_t)qrow * D + h * 64 + 4 * hh;
#pragma unroll
        for (int g = 0; g < 4; ++g) {
            v2u w; w.x = pk2(o0[nq][4 * g] * inv, o0[nq][4 * g + 1] * inv); w.y = pk2(o0[nq][4 * g + 2] * inv, o0[nq][4 * g + 3] * inv); *(v2u*)(orow + 8 * g) = w;
            v2u x; x.x = pk2(o1[nq][4 * g] * inv, o1[nq][4 * g + 1] * inv); x.y = pk2(o1[nq][4 * g + 2] * inv, o1[nq][4 * g + 3] * inv); *(v2u*)(orow + 32 + 8 * g) = x; } }
}
__device__ __forceinline__ void attn_mfma(const Args& a, LAS unsigned char* lds) {
#if ATT_NQ == 2
    for (int u = blockIdx.x; u < 256; u += gridDim.x) attn_unit3<2>(a, lds, u >> 5, (u >> 2) & 7, (u >> 5) * SEQ + (u & 3) * 512, (CTXL + SEQ) / 64, true);
#else
    for (int u = blockIdx.x; u < 512; u += gridDim.x) attn_unit3<1>(a, lds, u >> 6, (u >> 3) & 7, (u >> 6) * SEQ + (u & 7) * 256, (CTXL + SEQ) / 64, true);
#endif
    for (int u = blockIdx.x; u < 64; u += gridDim.x) attn_unit3<1>(a, lds, u >> 3, u & 7, TL + (u >> 3) * CTXL, CTXL / 64, false);
}

#ifndef SSD_YREP
#define SSD_YREP 1
#endif
#ifndef SSD_WREP
#define SSD_WREP 1
#endif
constexpr int SP_B = 272, SP_X = 192;
constexpr int SO_B = 0, SO_C = SO_B + 128 * SP_B, SO_XD = SO_C + 128 * SP_B, SO_XW = SO_XD + 128 * SP_X, SO_S = SO_XW + 128 * SP_X, SO_V = SO_S + 64 * SP_B;
static_assert(SO_V + 2 * 2048 <= LDS_BYTES, "ssd lds map");
#ifdef SSD_DIAG
#define SSD_T(v) long long v = clock64()
#define SSD_ACC(k, v) do { const long long n_ = clock64(); dacc[k] += n_ - v; v = n_; } while (0)
#else
#define SSD_T(v) do {} while (0)
#define SSD_ACC(k, v) do {} while (0)
#endif
__device__ __forceinline__ void ssd_scan_mfma(const Args& a, int i, bool last, LAS unsigned char* lds) {
#ifdef SSD_DIAG
    long long dacc[12] = {0, 0, 0, 0, 0, 0, 0, 0, 0, 0, 0, 0};
#endif
    const int tid = otid(a.wv), wave = a.wv, lane = tid & 63, r32 = lane & 31, hh = lane >> 5;
    const int pt = wave >> 2, lt = pt ? 3 - (wave & 3) : (wave & 3);
    const int tq = (lane >> 2) & 3, tp = lane & 3, tblk = (lane >> 4) & 1;
    bf16* ZX = (bf16*)(a.ws + WS_ZX); const bf16* XBC = (const bf16*)(a.ws + WS_XBC); const float* DT = (const float*)(a.ws + WS_DT); const float* AA = (const float*)(a.ws + WS_AA);
    LAS unsigned char* Bl = lds + SO_B; LAS unsigned char* Cl = lds + SO_C; LAS unsigned char* XDl = lds + SO_XD; LAS unsigned char* XWl = lds + SO_XW; LAS unsigned char* Sl = lds + SO_S;
    const int brow = tid >> 4, bpart = tid & 15, xrow = tid >> 3, xpart = tid & 7;
    for (int it = blockIdx.x; it < NB * 32; it += gridDim.x) {
        const int b = it >> 5, h = it & 31, g = h >> 3; const float dsk = a.in[I_SD][i * 32 + h];
        for (int dir = 0; dir < 2; ++dir) {
            const int scanw = dir == 0 ? 0 : 3;
            f32x16 sacc;
#pragma unroll
            for (int k = 0; k < 16; ++k) sacc[k] = 0.f;
            SSD_T(tprev);
            v4u bq[4], cq[4], xq[2]; float pa0 = 0.f, pa1 = 0.f, pd0 = 0.f, pd1 = 0.f, qa0 = 0.f, qa1 = 0.f, qd0 = 0.f, qd1 = 0.f; v2u add[4];
#define SSD_ROWBASE(c) ((c) < 2 ? TL + b * CTXL + (dir == 0 ? (c) : 1 - (c)) * 128 : b * SEQ + (dir == 0 ? (c) - 2 : 17 - (c)) * 128)
#define SSD_PFB(c) do { const int rb_ = SSD_ROWBASE(c); _Pragma("unroll") for (int k_ = 0; k_ < 4; ++k_) bq[k_] = *(const v4u*)(XBC + (size_t)(rb_ + brow + 32 * k_) * 3072 + 2048 + g * 128 + bpart * 8); } while (0)
#define SSD_PFC(c) do { const int rb_ = SSD_ROWBASE(c); _Pragma("unroll") for (int k_ = 0; k_ < 4; ++k_) cq[k_] = *(const v4u*)(XBC + (size_t)(rb_ + brow + 32 * k_) * 3072 + 2560 + g * 128 + bpart * 8); } while (0)
#define SSD_PFX(c) do { const int rb_ = SSD_ROWBASE(c); _Pragma("unroll") for (int k_ = 0; k_ < 2; ++k_) xq[k_] = *(const v4u*)(XBC + (size_t)(rb_ + xrow + 64 * k_) * 3072 + h * 64 + xpart * 8); } while (0)
#define SSD_PF(c) do { SSD_PFB(c); SSD_PFC(c); SSD_PFX(c); } while (0)
#define SSD_PFV(c) do { if (wave == scanw) { const int rb_ = SSD_ROWBASE(c); const size_t o_ = (size_t)(rb_ + 2 * lane) * 64 + dir * 32 + h; qa0 = AA[o_]; qa1 = AA[o_ + 64]; qd0 = DT[o_]; qd1 = DT[o_ + 64]; } } while (0)
#define SSD_PFY(c) do { const int rb_ = SSD_ROWBASE(c); const size_t r_ = (size_t)(rb_ + 32 * lt + r32); \
                _Pragma("unroll") for (int q_ = 0; q_ < 4; ++q_) add[q_] = dir == 0 ? *(const v2u*)(XBC + r_ * 3072 + h * 64 + 32 * pt + 4 * hh + 8 * q_) : *(const v2u*)(ZX + r_ * SSD_INP + 2048 + h * 64 + 32 * pt + 4 * hh + 8 * q_); } while (0)
#define SSD_SCAN(vb_) do { if (wave == scanw) { LAS float* V_ = (LAS float*)(lds + SO_V + (vb_) * 2048); const float pair_ = pa0 + pa1; float ps_ = pair_; \
                _Pragma("unroll") for (int d_ = 1; d_ < 64; d_ <<= 1) { const int src_ = dir == 0 ? lane - d_ : lane + d_; const float t_ = __builtin_bit_cast(float, __builtin_amdgcn_ds_bpermute((src_ & 63) << 2, __builtin_bit_cast(int, ps_))); if (src_ >= 0 && src_ < 64) ps_ += t_; } \
                const float tot_ = __builtin_bit_cast(float, __builtin_amdgcn_ds_bpermute((dir == 0 ? 63 : 0) << 2, __builtin_bit_cast(int, ps_))); const float ex_ = ps_ - pair_; \
                float c0_, c1_; if (dir == 0) { c0_ = ex_ + pa0; c1_ = c0_ + pa1; } else { c1_ = ex_ + pa1; c0_ = c1_ + pa0; } \
                V_[2 * lane] = c0_; V_[2 * lane + 1] = c1_; V_[128 + 2 * lane] = pd0; V_[128 + 2 * lane + 1] = pd1; V_[256 + 2 * lane] = pd0 * __expf(tot_ - c0_); V_[256 + 2 * lane + 1] = pd1 * __expf(tot_ - c1_); \
                if (lane == 0) V_[384] = tot_; } } while (0)
#define SSD_WRITE(vb_) do { const LAS float* V_ = (const LAS float*)(lds + SO_V + (vb_) * 2048); \
                _Pragma("unroll") for (int k_ = 0; k_ < 4; ++k_) { *(LAS v4u*)(Bl + (brow + 32 * k_) * SP_B + bpart * 16) = bq[k_]; *(LAS v4u*)(Cl + (brow + 32 * k_) * SP_B + bpart * 16) = cq[k_]; } \
                _Pragma("unroll") for (int k_ = 0; k_ < 2; ++k_) { const int s_ = xrow + 64 * k_; const float dt_ = V_[128 + s_], w_ = V_[256 + s_]; float f_[8], g_[8]; unpack8(xq[k_], f_); \
                    _Pragma("unroll") for (int j_ = 0; j_ < 8; ++j_) { g_[j_] = f_[j_] * w_; f_[j_] *= dt_; } \
                    *(LAS v4u*)(XDl + s_ * SP_X + xpart * 16) = pack8(f_); *(LAS v4u*)(XWl + s_ * SP_X + xpart * 16) = pack8(g_); } } while (0)
            __syncthreads();
            SSD_PFV(0); pa0 = qa0; pa1 = qa1; pd0 = qd0; pd1 = qd1; SSD_PFV(1); SSD_PFY(0); SSD_PF(0);
            { const float t0_ = qa0, t1_ = qa1, t2_ = qd0, t3_ = qd1; SSD_SCAN(0); pa0 = t0_; pa1 = t1_; pd0 = t2_; pd1 = t3_; }
            __syncthreads();
            SSD_WRITE(0);
            { LAS v2u* sp = (LAS v2u*)(Sl + (32 * pt + r32) * SP_B + (32 * lt + 4 * hh) * 2);
#pragma unroll
              for (int q = 0; q < 4; ++q) sp[2 * q] = (v2u){0u, 0u}; }
            __syncthreads();
            SSD_ACC(0, tprev);
            for (int c = 0; c < 18; ++c) {
                const int cur = c & 1; const LAS float* V = (const LAS float*)(lds + SO_V + cur * 2048);
                const int rowbase = SSD_ROWBASE(c); const bool want_y = !(last && c < 2);
                if (c > 0 && want_y) SSD_PFY(c);
                if (c + 1 < 18) { if (c + 2 < 18) SSD_PFV(c + 2); }
                SSD_ACC(1, tprev);
                for (int yrep = 0; yrep < SSD_YREP; ++yrep)
                if (!want_y && c + 1 < 18) { SSD_PFB(c + 1); SSD_PFC(c + 1); SSD_PFX(c + 1); }
                if (want_y) {
                    const int l = 32 * lt + r32; const float cl = V[l];
                    bf16* yptr = ZX + (size_t)(rowbase + l) * SSD_INP + 2048 + h * 64 + 32 * pt + 4 * hh;
                    bf16x8 cf[8];
#pragma unroll
                    for (int ks = 0; ks < 8; ++ks) cf[ks] = *(const LAS bf16x8*)(Cl + l * SP_B + (16 * ks + 8 * hh) * 2);
                    SSD_ACC(8, tprev);
                    f32x16 y1;
#pragma unroll
                    for (int k = 0; k < 16; ++k) y1[k] = 0.f;
#pragma unroll
                    for (int ks = 0; ks < 8; ++ks) { const bf16x8 sf = *(const LAS bf16x8*)(Sl + (32 * pt + r32) * SP_B + (16 * ks + 8 * hh) * 2); y1 = __builtin_amdgcn_mfma_f32_32x32x16_bf16(sf, cf[ks], y1, 0, 0, 0); }
                    { const float el = __expf(cl);
#pragma unroll
                      for (int k = 0; k < 16; ++k) y1[k] *= el; }
                    SSD_ACC(10, tprev);
                    const int st_lo = dir == 0 ? 0 : lt, st_hi = dir == 0 ? lt : 3;
#pragma unroll
                    for (int st = 0; st < 4; ++st) { if (c + 1 < 18) { if (st == 1) SSD_PFB(c + 1); if (st == 2) SSD_PFC(c + 1); if (st == 3) SSD_PFX(c + 1); }
                      if (st >= st_lo && st <= st_hi) {
                        f32x16 X;
#pragma unroll
                        for (int k = 0; k < 16; ++k) X[k] = 0.f;
#pragma unroll
                        for (int ks = 0; ks < 8; ++ks) { const bf16x8 af = *(const LAS bf16x8*)(Bl + (32 * st + r32) * SP_B + (16 * ks + 8 * hh) * 2); X = __builtin_amdgcn_mfma_f32_32x32x16_bf16(af, cf[ks], X, 0, 0, 0); }
                        if (st == lt) {
#pragma unroll
                            for (int q = 0; q < 4; ++q) { const f32x4 cs = *(const LAS f32x4*)(V + 32 * st + 8 * q + 4 * hh);
#pragma unroll
                                for (int e = 0; e < 4; ++e) { const int sl = 8 * q + 4 * hh + e; const bool ok = dir == 0 ? (sl <= r32) : (sl >= r32);
                                    X[4 * q + e] *= __expf(ok ? fminf(cl - cs[e], 0.f) : -1.0e30f); } }
                        } else {
#pragma unroll
                            for (int q = 0; q < 4; ++q) { const f32x4 cs = *(const LAS f32x4*)(V + 32 * st + 8 * q + 4 * hh);
#pragma unroll
                                for (int e = 0; e < 4; ++e) X[4 * q + e] *= __expf(fminf(cl - cs[e], 0.f)); }
                        }
#pragma unroll
                        for (int ks2 = 0; ks2 < 2; ++ks2) { v4u w; w.x = cvtpk(X[8 * ks2 + 0], X[8 * ks2 + 1]); w.y = cvtpk(X[8 * ks2 + 2], X[8 * ks2 + 3]); w.z = cvtpk(X[8 * ks2 + 4], X[8 * ks2 + 5]); w.w = cvtpk(X[8 * ks2 + 6], X[8 * ks2 + 7]);
                            const LAS unsigned char* tb = XDl + (32 * st + 16 * ks2 + 4 * hh + tq) * SP_X + (32 * pt + 16 * tblk + 4 * tp) * 2;
                            const v2u lo = trread(tb), hi = trread(tb + 8 * SP_X);
                            y1 = __builtin_amdgcn_mfma_f32_32x32x16_bf16(__builtin_bit_cast(bf16x8, (v4u){lo.x, lo.y, hi.x, hi.y}), __builtin_bit_cast(bf16x8, w), y1, 0, 0, 0); }
                    } }
                    asm volatile("" : "+v"(y1)); SSD_ACC(9, tprev);
#pragma unroll
                    for (int q = 0; q < 4; ++q) { float o[4];
#pragma unroll
                        for (int e = 0; e < 4; ++e) o[e] = y1[4 * q + e];
                        const float a0 = bflo(add[q].x), a1 = bfhi(add[q].x), a2 = bflo(add[q].y), a3 = bfhi(add[q].y);
                        if (dir == 0) { o[0] += dsk * a0; o[1] += dsk * a1; o[2] += dsk * a2; o[3] += dsk * a3; } else { o[0] += a0; o[1] += a1; o[2] += a2; o[3] += a3; }
                        v2u w; w.x = pk2(o[0], o[1]); w.y = pk2(o[2], o[3]); *(v2u*)(yptr + 8 * q) = w; }
                }
                SSD_ACC(2, tprev);
                if (c + 1 < 18) {
                    const float etot = __expf(V[384]);
#pragma unroll
                    for (int k = 0; k < 16; ++k) sacc[k] *= etot;
#pragma unroll
                    for (int ks = 0; ks < 8; ++ks) {
                        const LAS unsigned char* ta = Bl + (16 * ks + 8 * hh + tq) * SP_B + (32 * lt + 16 * tblk + 4 * tp) * 2;
                        const LAS unsigned char* tb = XWl + (16 * ks + 8 * hh + tq) * SP_X + (32 * pt + 16 * tblk + 4 * tp) * 2;
                        const v2u alo = trread(ta), ahi = trread(ta + 4 * SP_B), blo = trread(tb), bhi = trread(tb + 4 * SP_X);
                        sacc = __builtin_amdgcn_mfma_f32_32x32x16_bf16(__builtin_bit_cast(bf16x8, (v4u){alo.x, alo.y, ahi.x, ahi.y}), __builtin_bit_cast(bf16x8, (v4u){blo.x, blo.y, bhi.x, bhi.y}), sacc, 0, 0, 0); }
                    SSD_SCAN(cur ^ 1); pa0 = qa0; pa1 = qa1; pd0 = qd0; pd1 = qd1;
                }
                SSD_ACC(3, tprev);
                __syncthreads();
                SSD_ACC(4, tprev);
                if (c + 1 < 18) {
                    LAS v2u* sp = (LAS v2u*)(Sl + (32 * pt + r32) * SP_B + (32 * lt + 4 * hh) * 2);
#pragma unroll
                    for (int q = 0; q < 4; ++q) { v2u w; w.x = cvtpk(sacc[4 * q], sacc[4 * q + 1]); w.y = cvtpk(sacc[4 * q + 2], sacc[4 * q + 3]); sp[2 * q] = w; }
                    for (int wrep = 0; wrep < SSD_WREP; ++wrep) { SSD_WRITE(cur ^ 1); }
                }
                SSD_ACC(5, tprev);
                __syncthreads();
                SSD_ACC(6, tprev);
            }
#undef SSD_ROWBASE
#undef SSD_PF
#undef SSD_PFV
#undef SSD_PFY
#undef SSD_SCAN
#undef SSD_WRITE
            asm volatile("s_waitcnt vmcnt(0)" ::: "memory");
        }
    }
#ifdef SSD_DIAG
    if (blockIdx.x == 0 && wave == SSD_DIAG_WAVE && lane == 0 && i == 0) { float* dg = (float*)(a.ws + WS_MOD + 900 * 1024); long long tot = 0;
        for (int k = 0; k < 7; ++k) tot += dacc[k];
        tot += dacc[8] + dacc[9] + dacc[10];
        for (int k = 0; k < 12; ++k) dg[k] = (float)dacc[k]; dg[7] = (float)tot; }
#endif
}

constexpr int AT2_KP = 208, AT2_VP = 192, AT2_KB = 64 * AT2_KP, AT2_VB = 64 * AT2_VP, AT2_BUF = AT2_KB + AT2_VB;
template <int NQ>
__device__ __forceinline__ void attn_unit2(const Args& a, LAS unsigned char* lds, int b, int h, int q0, int ntiles, bool lat) {
    const int tid = otid(a.wv), wave = tid >> 6, lane = tid & 63, r32 = lane & 31, hh = lane >> 5;
    const int tq = (lane >> 2) & 3, tp = lane & 3, tblk = (lane >> 4) & 1;
    const bf16* Qb = (const bf16*)(a.ws + WS_Q); const bf16* KVb = (const bf16*)(a.ws + WS_KV); const bf16* KR = (const bf16*)(a.ws + WS_KR); bf16* MIX = (bf16*)(a.ws + WS_MIX);
    const float* ct = (const float*)(a.ws + WS_ROPE); const float* st = ct + SEQ * 16;
    bf16x8 qf[NQ][6];
#pragma unroll
    for (int nq = 0; nq < NQ; ++nq) { const int qrow = q0 + wave * (32 * NQ) + nq * 32 + r32;
#pragma unroll
        for (int s = 0; s < 6; ++s) qf[nq][s] = *(const bf16x8*)(Qb + (size_t)qrow * QW + h * 96 + 16 * s + 8 * hh);
        if (lat) { const int t = qrow & (SEQ - 1);
#pragma unroll
            for (int j = 0; j < 8; j += 2) { float y1[2], y2[2];
#pragma unroll
                for (int e = 0; e < 2; ++e) { const float x1 = bf1((bf16)qf[nq][4][j + e]), x2 = bf1((bf16)qf[nq][5][j + e]); const float c = ct[t * 16 + 8 * hh + j + e], s = st[t * 16 + 8 * hh + j + e];
                    y1[e] = x1 * c - x2 * s; y2[e] = x1 * s + x2 * c; }
                const unsigned w1 = pk2(y1[0], y1[1]), w2 = pk2(y2[0], y2[1]);
                qf[nq][4][j] = (short)(w1 & 0xffff); qf[nq][4][j + 1] = (short)(w1 >> 16); qf[nq][5][j] = (short)(w2 & 0xffff); qf[nq][5][j + 1] = (short)(w2 >> 16); } }
        asm volatile("" : "+v"(qf[nq][0]), "+v"(qf[nq][1]), "+v"(qf[nq][2]), "+v"(qf[nq][3]), "+v"(qf[nq][4]), "+v"(qf[nq][5]) :: "memory"); }
    f32x16 o[NQ][2]; float m[NQ], l[NQ];
#pragma unroll
    for (int nq = 0; nq < NQ; ++nq) { m[nq] = -1e30f; l[nq] = 0.f;
#pragma unroll
        for (int i = 0; i < 16; ++i) { o[nq][0][i] = 0.f; o[nq][1][i] = 0.f; } }
    v4u kreg0, kreg1, vreg;
#define AT2_LOAD(it, tt) do { const unsigned off_kv = (unsigned)(((tt) >> 3) * (KVW * 2) + h * 256 + ((tt) & 7) * 16), off_kr = (unsigned)(((tt) >> 2) * 64 + ((tt) & 3) * 16); const bool k1ok = (tt) < 256; const int rb_ = (it) < CTXL / 64 ? TL + b * CTXL + (it) * 64 : b * SEQ + ((it) - CTXL / 64) * 64; \
        const char* kvb_ = (const char*)(KVb + (size_t)rb_ * KVW); const char* krb_ = (const char*)(KR + (size_t)rb_ * 32); \
        kreg0 = *(const v4u*)(kvb_ + off_kv); vreg = *(const v4u*)(kvb_ + off_kv + 128); if (k1ok) kreg1 = *(const v4u*)(krb_ + off_kr); } while (0)
#define AT2_WRITE(buf, tt) do { LAS unsigned char* kb_ = lds + (buf) * AT2_BUF; \
        *(LAS v4u*)(kb_ + ((tt) >> 3) * AT2_KP + ((tt) & 7) * 16) = kreg0; if ((tt) < 256) *(LAS v4u*)(kb_ + ((tt) >> 2) * AT2_KP + 128 + ((tt) & 3) * 16) = kreg1; \
        *(LAS v4u*)(kb_ + AT2_KB + ((tt) >> 3) * AT2_VP + ((tt) & 7) * 16) = vreg; } while (0)
    __syncthreads();
    AT2_LOAD(0, tid); AT2_WRITE(0, tid);
    __syncthreads();
    for (int it = 0; it < ntiles; ++it) {
        int tz = tid; asm volatile("" : "+v"(tz));
        const int lane_ = tz & 63, r32_ = lane_ & 31, hh_ = lane_ >> 5, tq_ = (lane_ >> 2) & 3, tp_ = lane_ & 3, tblk_ = (lane_ >> 4) & 1;
#ifdef ATT_LOADTOP
        if (it + 1 < ntiles) AT2_LOAD(it + 1, tz);
#endif
        const LAS unsigned char* kb = lds + (it & 1) * AT2_BUF; const LAS unsigned char* vb = kb + AT2_KB;
        bf16x8 pf[NQ][2][2];
        f32x16 sc[NQ][2];
#pragma unroll
        for (int nq = 0; nq < NQ; ++nq)
#pragma unroll
            for (int i = 0; i < 16; ++i) { sc[nq][0][i] = 0.f; sc[nq][1][i] = 0.f; }
#pragma unroll
        for (int s = 0; s < 6; ++s) { const bf16x8 a0 = *(const LAS bf16x8*)(kb + r32_ * AT2_KP + (16 * s + 8 * hh_) * 2); const bf16x8 a1 = *(const LAS bf16x8*)(kb + (32 + r32_) * AT2_KP + (16 * s + 8 * hh_) * 2);
#pragma unroll
            for (int nq = 0; nq < NQ; ++nq) { sc[nq][0] = __builtin_amdgcn_mfma_f32_32x32x16_bf16(a0, qf[nq][s], sc[nq][0], 0, 0, 0); sc[nq][1] = __builtin_amdgcn_mfma_f32_32x32x16_bf16(a1, qf[nq][s], sc[nq][1], 0, 0, 0); } }
#pragma unroll
        for (int nq = 0; nq < NQ; ++nq) {
            f32x16& s0 = sc[nq][0]; f32x16& s1 = sc[nq][1];
            float mx = s0[0];
#pragma unroll
            for (int i = 1; i < 16; ++i) mx = fmaxf(mx, s0[i]);
#pragma unroll
            for (int i = 0; i < 16; ++i) mx = fmaxf(mx, s1[i]);
            mx = fmaxf(mx, shx(mx, 32, lane_));
            const float mn = fmaxf(m[nq], mx * ATT_SCALE_LOG2E); const float alpha = __builtin_amdgcn_exp2f(m[nq] - mn); m[nq] = mn;
            float rs = 0.f;
#pragma unroll
            for (int i = 0; i < 16; ++i) { s0[i] = __builtin_amdgcn_exp2f(s0[i] * ATT_SCALE_LOG2E - mn); s1[i] = __builtin_amdgcn_exp2f(s1[i] * ATT_SCALE_LOG2E - mn); rs += s0[i] + s1[i]; }
            l[nq] = l[nq] * alpha + rs;
#pragma unroll
            for (int i = 0; i < 16; ++i) { o[nq][0][i] *= alpha; o[nq][1][i] *= alpha; }
#pragma unroll
            for (int s2 = 0; s2 < 2; ++s2) { v4u w0, w1;
                w0.x = cvtpk(s0[8 * s2 + 0], s0[8 * s2 + 1]); w0.y = cvtpk(s0[8 * s2 + 2], s0[8 * s2 + 3]); w0.z = cvtpk(s0[8 * s2 + 4], s0[8 * s2 + 5]); w0.w = cvtpk(s0[8 * s2 + 6], s0[8 * s2 + 7]);
                w1.x = cvtpk(s1[8 * s2 + 0], s1[8 * s2 + 1]); w1.y = cvtpk(s1[8 * s2 + 2], s1[8 * s2 + 3]); w1.z = cvtpk(s1[8 * s2 + 4], s1[8 * s2 + 5]); w1.w = cvtpk(s1[8 * s2 + 6], s1[8 * s2 + 7]);
                pf[nq][0][s2] = __builtin_bit_cast(bf16x8, w0); pf[nq][1][s2] = __builtin_bit_cast(bf16x8, w1); }
        }
#ifndef ATT_LOADTOP
        if (it + 1 < ntiles) AT2_LOAD(it + 1, tz);
#endif
#pragma unroll
        for (int t = 0; t < 2; ++t)
#pragma unroll
            for (int s2 = 0; s2 < 2; ++s2)
#pragma unroll
                for (int dt = 0; dt < 2; ++dt) {
                    const LAS unsigned char* tb = vb + (t * 32 + 16 * s2 + 4 * hh_ + tq_) * AT2_VP + (32 * dt + 16 * tblk_ + 4 * tp_) * 2;
#ifdef ATT_NOTR
                    bf16x8 vf; { const LAS unsigned short* vp_ = (const LAS unsigned short*)(vb + (t * 32 + 16 * s2 + 4 * hh_) * AT2_VP + (32 * dt + r32_) * 2);
#pragma unroll
                      for (int j_ = 0; j_ < 8; ++j_) vf[j_] = (short)vp_[((j_ & 3) + 8 * (j_ >> 2)) * (AT2_VP / 2)]; }
#else
                    const v2u lo = trread(tb), hi = trread(tb + 8 * AT2_VP); const bf16x8 vf = __builtin_bit_cast(bf16x8, (v4u){lo.x, lo.y, hi.x, hi.y});
#endif
#pragma unroll
                    for (int nq = 0; nq < NQ; ++nq) o[nq][dt] = __builtin_amdgcn_mfma_f32_32x32x16_bf16(vf, pf[nq][t][s2], o[nq][dt], 0, 0, 0); }
        if (it + 1 < ntiles) AT2_WRITE((it + 1) & 1, tz);
        __syncthreads();
    }
#undef AT2_LOAD
#undef AT2_WRITE
#pragma unroll
    for (int nq = 0; nq < NQ; ++nq) { int qrow = q0 + wave * (32 * NQ) + nq * 32 + r32; asm volatile("" : "+v"(qrow));
        const float lt = l[nq] + shx(l[nq], 32, lane); const float inv = 1.f / lt;
        bf16* orow = MIX + (size_t)qrow * D + h * 64 + 4 * hh;
#pragma unroll
        for (int g = 0; g < 4; ++g) {
            v2u w; w.x = pk2(o[nq][0][4 * g] * inv, o[nq][0][4 * g + 1] * inv); w.y = pk2(o[nq][0][4 * g + 2] * inv, o[nq][0][4 * g + 3] * inv); *(v2u*)(orow + 8 * g) = w;
            v2u x; x.x = pk2(o[nq][1][4 * g] * inv, o[nq][1][4 * g + 1] * inv); x.y = pk2(o[nq][1][4 * g + 2] * inv, o[nq][1][4 * g + 3] * inv); *(v2u*)(orow + 32 + 8 * g) = x; } }
}
__device__ __forceinline__ void attn_mfma2(const Args& a, LAS unsigned char* lds) {
#ifdef ATT_NQ1
    for (int u = blockIdx.x; u < 512; u += gridDim.x) attn_unit2<1>(a, lds, u >> 6, (u >> 3) & 7, (u >> 6) * SEQ + (u & 7) * 256, (CTXL + SEQ) / 64, true);
#else
    for (int u = blockIdx.x; u < 256; u += gridDim.x) attn_unit2<2>(a, lds, u >> 5, (u >> 2) & 7, (u >> 5) * SEQ + (u & 3) * 512, (CTXL + SEQ) / 64, true);
#endif
    for (int u = blockIdx.x; u < 64; u += gridDim.x) attn_unit2<1>(a, lds, u >> 3, u & 7, TL + (u >> 3) * CTXL, CTXL / 64, false);
}

template <int R>
__device__ __forceinline__ void rowwise2(const float* xs_lat, const float* xs_ctx, float* xd_lat, float* xd_ctx, const bf16* Mb, const float* modg, const float* nwA,
                                         bf16* H, const float* modh, int sh_off, int sc_off, const float* nwB, int nrows, int wv) {
    const int tid = otid(wv), wave = wv, lane = tid & 63; const int NGW = gridDim.x * NWAVES, gw = blockIdx.x * NWAVES + wave;
    const int rpw = (nrows + NGW - 1) / NGW; const int rbeg = gw * rpw, rend = min(rbeg + rpw, nrows);
    for (int r0 = rbeg; r0 < rend; r0 += R) {
        f32x4 v[R][4]; v2u mm[R][4];
#pragma unroll
        for (int j = 0; j < R; ++j) { const int r = min(r0 + j, rend - 1); const float* xs = r < TL ? xs_lat + (size_t)r * D : xs_ctx + (size_t)(r - TL) * D;
#pragma unroll
            for (int q = 0; q < 4; ++q) v[j][q] = *(const f32x4*)(xs + q * 256 + lane * 4);
            if (Mb) {
#pragma unroll
                for (int q = 0; q < 4; ++q) mm[j][q] = *(const v2u*)(Mb + (size_t)r * D + q * 256 + lane * 4); } }
#pragma unroll
        for (int j = 0; j < R; ++j) { const int r = r0 + j; if (r < rend) {
            const bool lat = r < TL; const int cond = lat ? (r >> 11) : 8; float* xd = lat ? xd_lat + (size_t)r * D : xd_ctx + (size_t)(r - TL) * D;
            if (Mb) {
                f32x4 m[4]; float ss = 0.f;
#pragma unroll
                for (int q = 0; q < 4; ++q) { const v2u w = mm[j][q]; m[q] = (f32x4){bflo(w.x), bfhi(w.x), bflo(w.y), bfhi(w.y)}; ss += (m[q][0] * m[q][0] + m[q][1] * m[q][1]) + (m[q][2] * m[q][2] + m[q][3] * m[q][3]); }
                const float rs = rsqrtf(wave_sum(ss, lane) * (1.f / D) + EPS);
#pragma unroll
                for (int q = 0; q < 4; ++q) { const f32x4 g = *(const f32x4*)(modg + (size_t)cond * MODW + q * 256 + lane * 4); const f32x4 w = *(const f32x4*)(nwA + q * 256 + lane * 4);
                    v[j][q] = v[j][q] + g * (m[q] * rs * w); }
            }
#pragma unroll
            for (int q = 0; q < 4; ++q) *(f32x4*)(xd + q * 256 + lane * 4) = v[j][q];
            if (H) {
                float ss = 0.f;
#pragma unroll
                for (int q = 0; q < 4; ++q) ss += (v[j][q][0] * v[j][q][0] + v[j][q][1] * v[j][q][1]) + (v[j][q][2] * v[j][q][2] + v[j][q][3] * v[j][q][3]);
                const float rs = rsqrtf(wave_sum(ss, lane) * (1.f / D) + EPS);
#pragma unroll
                for (int q = 0; q < 4; ++q) { const int c = q * 256 + lane * 4;
                    const f32x4 w = *(const f32x4*)(nwB + c); const f32x4 sc = *(const f32x4*)(modh + (size_t)cond * MODW + sc_off + c); const f32x4 sh = *(const f32x4*)(modh + (size_t)cond * MODW + sh_off + c);
                    const f32x4 hv = (v[j][q] * rs * w) * (sc + 1.0f) + sh;
                    v2u o; o.x = pk2(hv[0], hv[1]); o.y = pk2(hv[2], hv[3]); *(v2u*)(H + (size_t)r * D + c) = o; }
            } } }
    }
}

__device__ __forceinline__ void convgate2(const Args& a, int l, int nrows) {
    const bf16* U = (const bf16*)(a.ws + WS_U); bf16* G = (bf16*)(a.ws + WS_G); const float* cw = a.in[I_FCONV] + (size_t)l * 3 * UPW;
    const int total = (nrows / 8) * (DFF / 8);
    for (int idx = blockIdx.x * NTHR + otid(a.wv); idx < total; idx += gridDim.x * NTHR) {
        const int r0 = (idx / (DFF / 8)) * 8, c0 = (idx % (DFF / 8)) * 8; const bf16* u = U + (size_t)r0 * UPW + c0;
        const bool hp = has_prev(r0), hn = has_next(r0 + 7);
        v4u ua[10], ug[10];
#pragma unroll
        for (int j = 0; j < 10; ++j) { const int rr = (j == 0 && !hp) ? 0 : ((j == 9 && !hn) ? 7 : j - 1); ua[j] = *(const v4u*)(u + (ptrdiff_t)rr * UPW); ug[j] = *(const v4u*)(u + (ptrdiff_t)rr * UPW + DFF); }
        float wa[3][8], wg[3][8];
#pragma unroll
        for (int t = 0; t < 3; ++t)
#pragma unroll
            for (int j = 0; j < 8; ++j) { wa[t][j] = cw[t * UPW + c0 + j]; wg[t][j] = cw[t * UPW + DFF + c0 + j]; }
        if (!hp) { ua[0] = (v4u){0u, 0u, 0u, 0u}; ug[0] = ua[0]; }
        if (!hn) { ua[9] = (v4u){0u, 0u, 0u, 0u}; ug[9] = ua[9]; }
        float pa[8], ca[8], na[8], pg[8], cg_[8], ng[8];
        unpack8(ua[0], pa); unpack8(ug[0], pg); unpack8(ua[1], ca); unpack8(ug[1], cg_);
#pragma unroll
        for (int j = 0; j < 8; ++j) {
            unpack8(ua[j + 2], na); unpack8(ug[j + 2], ng);
            float o[8];
#pragma unroll
            for (int k = 0; k < 8; ++k) { const float act = wa[0][k] * pa[k] + wa[1][k] * ca[k] + wa[2][k] * na[k]; const float gate = wg[0][k] * pg[k] + wg[1][k] * cg_[k] + wg[2][k] * ng[k]; o[k] = silu_f(act) * gate; }
            *(v4u*)(G + (size_t)(r0 + j) * DFF + c0) = pack8(o);
#pragma unroll
            for (int k = 0; k < 8; ++k) { pa[k] = ca[k]; ca[k] = na[k]; pg[k] = cg_[k]; cg_[k] = ng[k]; }
        }
    }
}

__device__ __forceinline__ void ssd_conv2(const Args& a, int i) {
    const bf16* ZX = (const bf16*)(a.ws + WS_ZX); bf16* XBC = (bf16*)(a.ws + WS_XBC); float* DT = (float*)(a.ws + WS_DT); float* AA = (float*)(a.ws + WS_AA);
    const float* cw = a.in[I_SCONVW] + (size_t)i * 3 * 3072; const float* cb = a.in[I_SCONVB] + (size_t)i * 3072;
    const int total = (T / 8) * 384;
    for (int idx = blockIdx.x * NTHR + otid(a.wv); idx < total; idx += gridDim.x * NTHR) {
        const int r0 = (idx / 384) * 8, c0 = (idx % 384) * 8; const bf16* u = ZX + (size_t)r0 * SSD_INP + 2048 + c0;
        const bool hp = has_prev(r0), hn = has_next(r0 + 7);
        v4u ux[10];
#pragma unroll
        for (int j = 0; j < 10; ++j) { const int rr = (j == 0 && !hp) ? 0 : ((j == 9 && !hn) ? 7 : j - 1); ux[j] = *(const v4u*)(u + (ptrdiff_t)rr * SSD_INP); }
        float w[3][8], bias[8];
#pragma unroll
        for (int j = 0; j < 8; ++j) { w[0][j] = cw[c0 + j]; w[1][j] = cw[3072 + c0 + j]; w[2][j] = cw[2 * 3072 + c0 + j]; bias[j] = cb[c0 + j]; }
        if (!hp) ux[0] = (v4u){0u, 0u, 0u, 0u};
        if (!hn) ux[9] = (v4u){0u, 0u, 0u, 0u};
        float p[8], c[8], n[8];
        unpack8(ux[0], p); unpack8(ux[1], c);
#pragma unroll
        for (int j = 0; j < 8; ++j) {
            unpack8(ux[j + 2], n); float o[8];
#pragma unroll
            for (int k = 0; k < 8; ++k) o[k] = silu_f(bias[k] + w[0][k] * p[k] + w[1][k] * c[k] + w[2][k] * n[k]);
            *(v4u*)(XBC + (size_t)(r0 + j) * 3072 + c0) = pack8(o);
#pragma unroll
            for (int k = 0; k < 8; ++k) { p[k] = c[k]; c[k] = n[k]; }
        }
    }
    const float* alog = a.in[I_ALOG] + i * 64; const float* dtb = a.in[I_DTB] + i * 64;
    for (int idx = blockIdx.x * NTHR + otid(a.wv); idx < T * 8; idx += gridDim.x * NTHR) {
        const int r = idx >> 3, j0 = (idx & 7) * 8; float raw[8], dt[8], av[8];
        unpack8(*(const v4u*)(ZX + (size_t)r * SSD_INP + 5120 + j0), raw);
#pragma unroll
        for (int k = 0; k < 8; ++k) { const float x = raw[k] + dtb[j0 + k]; dt[k] = x > 15.f ? x : (x < -15.f ? __expf(x) : __logf(1.f + __expf(x))); av[k] = -__expf(alog[j0 + k]) * dt[k]; }
        *(f32x4*)(DT + (size_t)r * 64 + j0) = (f32x4){dt[0], dt[1], dt[2], dt[3]}; *(f32x4*)(DT + (size_t)r * 64 + j0 + 4) = (f32x4){dt[4], dt[5], dt[6], dt[7]};
        *(f32x4*)(AA + (size_t)r * 64 + j0) = (f32x4){av[0], av[1], av[2], av[3]}; *(f32x4*)(AA + (size_t)r * 64 + j0 + 4) = (f32x4){av[4], av[5], av[6], av[7]};
    }
}

__device__ __forceinline__ void gatenorm2(const Args& a, int i, int nrows) {
    const int tid = otid(a.wv), wave = a.wv, lane = tid & 63; const int NGW = gridDim.x * NWAVES, gw = blockIdx.x * NWAVES + wave;
    const bf16* ZX = (const bf16*)(a.ws + WS_ZX); bf16* YN = (bf16*)(a.ws + WS_XBC); const float* nw = a.in[I_SNORM] + i * 2048;
    const int rpw = (nrows + NGW - 1) / NGW; const int rbeg = gw * rpw, rend = min(rbeg + rpw, nrows);
    constexpr int R = 3;
    for (int r0 = rbeg; r0 < rend; r0 += R) {
        v4u yv[R][4], zv[R][4];
#pragma unroll
        for (int j = 0; j < R; ++j) { const int r = min(r0 + j, rend - 1);
#pragma unroll
            for (int q = 0; q < 4; ++q) { const int c = q * 512 + lane * 8; yv[j][q] = *(const v4u*)(ZX + (size_t)r * SSD_INP + 2048 + c); zv[j][q] = *(const v4u*)(ZX + (size_t)r * SSD_INP + c); } }
#pragma unroll
        for (int j = 0; j < R; ++j) { const int r = r0 + j; if (r < rend) {
            float v[4][8]; float ss = 0.f;
#pragma unroll
            for (int q = 0; q < 4; ++q) { float y[8], z[8]; unpack8(yv[j][q], y); unpack8(zv[j][q], z);
#pragma unroll
                for (int k = 0; k < 8; ++k) { v[q][k] = y[k] * silu_f(z[k]); ss += v[q][k] * v[q][k]; } }
            const float rs = rsqrtf(wave_sum(ss, lane) * (1.f / 2048.f) + EPS);
#pragma unroll
            for (int q = 0; q < 4; ++q) { const int c = q * 512 + lane * 8; float o[8];
#pragma unroll
                for (int k = 0; k < 8; ++k) o[k] = v[q][k] * rs * nw[c + k];
                *(v4u*)(YN + (size_t)r * 2048 + c) = pack8(o); } } }
    }
}

__device__ __forceinline__ void ffn_fixup(const Args& a, int l, int nrows) {
    const bf16* Ue = (const bf16*)(a.ws + WS_UE); bf16* G = (bf16*)(a.ws + WS_G); const float* cw = a.in[I_FCONV] + (size_t)l * 3 * UPW;
    const int total = (nrows / 256) * 2 * (DFF / 8);
    for (int idx = blockIdx.x * NTHR + otid(a.wv); idx < total; idx += gridDim.x * NTHR) {
        const int cg = idx % (DFF / 8), which = (idx / (DFF / 8)) & 1, pm = idx / (2 * (DFF / 8)); const int c0 = cg * 8; const int col = (c0 / 128) * 256 + (c0 % 128);
        const int r = pm * 256 + (which ? 255 : 0);
        const bf16* e0 = Ue + (size_t)(pm * 4) * UPW + col;
        const bf16* pp = which ? e0 + 2 * UPW : e0 - UPW;
        const bf16* pc = which ? e0 + 3 * UPW : e0;
        const bf16* pn = which ? e0 + 4 * UPW : e0 + UPW;
        const bool hp = which ? true : has_prev(r), hn = which ? has_next(r) : true;
        float pa[8], pg[8], ca[8], cg_[8], na[8], ng[8];
        unpack8(*(const v4u*)pc, ca); unpack8(*(const v4u*)(pc + 128), cg_);
        if (hp) { unpack8(*(const v4u*)pp, pa); unpack8(*(const v4u*)(pp + 128), pg); } else {
#pragma unroll
            for (int k = 0; k < 8; ++k) { pa[k] = 0.f; pg[k] = 0.f; } }
        if (hn) { unpack8(*(const v4u*)pn, na); unpack8(*(const v4u*)(pn + 128), ng); } else {
#pragma unroll
            for (int k = 0; k < 8; ++k) { na[k] = 0.f; ng[k] = 0.f; } }
        float o[8];
#pragma unroll
        for (int k = 0; k < 8; ++k) { const float act = cw[c0 + k] * pa[k] + cw[UPW + c0 + k] * ca[k] + cw[2 * UPW + c0 + k] * na[k];
            const float gate = cw[DFF + c0 + k] * pg[k] + cw[UPW + DFF + c0 + k] * cg_[k] + cw[2 * UPW + DFF + c0 + k] * ng[k]; o[k] = silu_f(act) * gate; }
        *(v4u*)(G + (size_t)r * DFF + c0) = pack8(o);
    }
}

__device__ __forceinline__ void prep_even2(const Args& a, int i) {
    const int tid = otid(a.wv), wave = a.wv, lane = tid & 63; const int NGW = gridDim.x * NWAVES, gw = blockIdx.x * NWAVES + wave;
    const bf16* P = (const bf16*)(a.ws + WS_P); bf16* CQN = (bf16*)(a.ws + WS_CQN); bf16* CKVN = (bf16*)(a.ws + WS_CKVN); bf16* KR = (bf16*)(a.ws + WS_KR); bf16* MIX = (bf16*)(a.ws + WS_MIX);
    const float* qn = a.in[I_QNORM] + i * 384; const float* kvn = a.in[I_KVNORM] + i * 256; const float* cw = a.in[I_SCONV] + i * 3 * 512;
    const float* ct = (const float*)(a.ws + WS_ROPE); const float* st = ct + SEQ * 16;
    constexpr int R = 3; const int rpw = (T + NGW - 1) / NGW; const int rbeg = gw * rpw, rend = min(rbeg + rpw, T);
    const int c0 = lane * 8;
    for (int r0 = rbeg; r0 < rend; r0 += R) {
        unsigned q32[R][3]; v2u kv2[R]; bf16 krv[R]; v4u gbv[R], gcv[R + 2], xvv[R + 2];
#pragma unroll
        for (int j = 0; j < R; ++j) { const int r = min(r0 + j, rend - 1); const bf16* p = P + (size_t)r * HYB_INP;
            const unsigned* p32 = (const unsigned*)(p + lane * 6); q32[j][0] = p32[0]; q32[j][1] = p32[1]; q32[j][2] = p32[2];
            kv2[j] = *(const v2u*)(p + 384 + lane * 4); krv[j] = p[640 + (lane & 31)]; gbv[j] = *(const v4u*)(p + 672 + c0); }
#pragma unroll
        for (int j = 0; j < R + 2; ++j) { int r = r0 + j - 1; r = max(0, min(r, T - 1)); const bf16* p = P + (size_t)r * HYB_INP; gcv[j] = *(const v4u*)(p + 1184 + c0); xvv[j] = *(const v4u*)(p + 1696 + c0); }
#pragma unroll
        for (int j = 0; j < R; ++j) { const int r = r0 + j; if (r < rend) {
            {   float f[6] = {bflo(q32[j][0]), bfhi(q32[j][0]), bflo(q32[j][1]), bfhi(q32[j][1]), bflo(q32[j][2]), bfhi(q32[j][2])}; float ss = 0.f;
#pragma unroll
                for (int k = 0; k < 6; ++k) ss += f[k] * f[k];
                const float rs = rsqrtf(wave_sum(ss, lane) * (1.f / 384.f) + EPS);
#pragma unroll
                for (int k = 0; k < 6; ++k) f[k] = f[k] * rs * qn[lane * 6 + k];
                unsigned* o32 = (unsigned*)(CQN + (size_t)r * 384 + lane * 6); o32[0] = pk2(f[0], f[1]); o32[1] = pk2(f[2], f[3]); o32[2] = pk2(f[4], f[5]); }
            {   const v2u w = kv2[j]; float f[4] = {bflo(w.x), bfhi(w.x), bflo(w.y), bfhi(w.y)};
                const float ss = (f[0] * f[0] + f[1] * f[1]) + (f[2] * f[2] + f[3] * f[3]);
                const float rs = rsqrtf(wave_sum(ss, lane) * (1.f / 256.f) + EPS);
                const f32x4 g = *(const f32x4*)(kvn + lane * 4);
                v2u o; o.x = pk2(f[0] * rs * g[0], f[1] * rs * g[1]); o.y = pk2(f[2] * rs * g[2], f[3] * rs * g[3]); *(v2u*)(CKVN + (size_t)r * 256 + lane * 4) = o; }
            {   const int jj = lane & 31; const float v = bf1(krv[j]); const float o = shx(v, 16, lane); float res = v;
                if (r < TL) { const int t = r & (SEQ - 1); const float c = ct[t * 16 + (jj & 15)], s = st[t * 16 + (jj & 15)]; res = (jj < 16) ? v * c - o * s : o * s + v * c; }
                if (lane < 32) KR[(size_t)r * 32 + jj] = (bf16)f2bf(res); }
            {   float gb[8], t0[8], t1[8], acc[8];
                unpack8(gbv[j], gb); unpack8(gcv[j + 1], t0); unpack8(xvv[j + 1], t1);
#pragma unroll
                for (int k = 0; k < 8; ++k) acc[k] = cw[512 + c0 + k] * (t0[k] * t1[k]);
                if (has_prev(r)) { unpack8(gcv[j], t0); unpack8(xvv[j], t1);
#pragma unroll
                    for (int k = 0; k < 8; ++k) acc[k] += cw[c0 + k] * (t0[k] * t1[k]); }
                if (has_next(r)) { unpack8(gcv[j + 2], t0); unpack8(xvv[j + 2], t1);
#pragma unroll
                    for (int k = 0; k < 8; ++k) acc[k] += cw[1024 + c0 + k] * (t0[k] * t1[k]); }
#pragma unroll
                for (int k = 0; k < 8; ++k) acc[k] *= gb[k];
                *(v4u*)(MIX + (size_t)r * D + 512 + c0) = pack8(acc); }
        } }
    }
}

#ifndef MK_SINGLE
#define MK_SINGLE 1
#endif
struct GemmDesc { const bf16* A; const bf16* Bt; int M, N, K; bf16* O; int ldc; int mode; };

__global__ void __launch_bounds__(NTHR, 2) fwd_kernel(Args a_in) {
    extern __shared__ __attribute__((aligned(16))) unsigned char lds_raw[];
    LAS unsigned char* lds = (LAS unsigned char*)lds_raw;
#if MK_SINGLE == 1
    volatile LAS unsigned* bst = (volatile LAS unsigned*)(lds + LDS_BYTES - 64);
    const int wv0 = __builtin_amdgcn_readfirstlane((int)threadIdx.x >> 6);
    { const int t0 = otid(wv0); if (t0 < 16) bst[t0] = 0u; }
    __syncthreads();
    const XcdBarrier xbar = xcd_barrier_post((unsigned*)(a_in.ws + WS_CTL), bst, wv0);
#endif
    const Args& a0 = a_in;
#ifdef TDIAG
    unsigned long long tcat[6] = {0, 0, 0, 0, 0, 0}; unsigned long long tlast = __builtin_amdgcn_s_memrealtime();
#endif
    for (int s = a0.lo; s < a0.hi; ++s) {
        Args a = a0;
        { long oz; asm volatile("s_mov_b64 %0, 0" : "=s"(oz));
#pragma unroll
          for (int q = 0; q < 25; ++q) a.in[q] = (const float*)((const char*)a0.in[q] + oz);
          a.out = (float*)((char*)a0.out + oz); a.ws = a0.ws + oz; a.wv = wv0; }
        unsigned char* ws = a.ws;
        float* XL = a.out; float* XC = (float*)(ws + WS_XC); bf16* H = (bf16*)(ws + WS_H); bf16* Mb = (bf16*)(ws + WS_M);
        const float* MOD = (const float*)(ws + WS_MOD); const float* NW = a.in[I_NORMW];
        int nrep = 1;
#ifdef PROBE_MASK
        if (s == 0 && (PROBE_MASK >> 20 & 1u)) nrep = 2;
        if (s >= 2) { const int pk = (s - 2) % 10, ppar = ((s - 2) / 10) & 1; if ((PROBE_MASK >> (pk + 10 * ppar)) & 1u) nrep = 2; }
#endif
        for (int rep = 0; rep < nrep; ++rep) {
        GemmDesc g0{}, g1{}; int ng = 0;
#ifndef NO_SIMPLE
        if (s == 0) {
            mod_compute(a, lds);
            rope_tables(a);
            convert_layer(a, 0, lds);
        } else if (s == 1) {
            rowwise2<3>(a.in[I_X], a.in[I_CTX], XL, XC, nullptr, nullptr, nullptr, H, MOD, 0, 1024, NW, T, a.wv);
        } else {
            const int l = (s - 2) / 10, k = (s - 2) % 10, i = l >> 1; const bool even = (l & 1) == 0, last = (l == 3);
            const int MR = last ? TL : T;
            switch (k) {
            case 0:
                if (even) { g0 = GemmDesc{H, (const bf16*)(ws + W_IN), T, HYB_INP, D, (bf16*)(ws + WS_P), HYB_INP}; ng = 1; }
                else      { g0 = GemmDesc{H, (const bf16*)(ws + W_IN), T, SSD_INP, D, (bf16*)(ws + WS_ZX), SSD_INP}; ng = 1; }
                break;
            case 1: if (even) prep_even2(a, i); else ssd_conv2(a, i); break;
            case 2:
                if (even) { { g0 = GemmDesc{(const bf16*)(ws + WS_CQN), (const bf16*)(ws + W_UQ), T, QW, 384, (bf16*)(ws + WS_Q), QW}; ng = 1; }
                            g1 = GemmDesc{(const bf16*)(ws + WS_CKVN), (const bf16*)(ws + W_UKV), T, KVW, 256, (bf16*)(ws + WS_KV), KVW}; ng = 2; }
                else {
#ifdef SSD_NAIVE
 ssd_scan_naive(a, i, last, lds);
#else
 ssd_scan_mfma(a, i, last, lds);
#endif
 }
                break;
            case 3: if (even) {
#ifdef ATTN_NAIVE
 attn_naive(a, lds);
#else
 attn_mfma(a, lds);
#endif
 } else gatenorm2(a, i, MR); break;
            case 4:
                if (even) { g0 = GemmDesc{(const bf16*)(ws + WS_MIX), (const bf16*)(ws + W_OUT), MR, D, D, Mb, D}; ng = 1; }
                else      { g0 = GemmDesc{(const bf16*)(ws + WS_XBC), (const bf16*)(ws + W_OUT), MR, D, 2048, Mb, D}; ng = 1; }
                break;
            case 5:
#ifdef PROBE_ROW2
                if (l > 0) rowwise2<3>(XL, XC, XL, XC, nullptr, nullptr, nullptr, H, MOD + (size_t)l * 9 * MODW, 0, 1024, NW + (l * 4 + 0) * D, MR, a.wv);
#endif
                rowwise2<3>(XL, XC, XL, XC, Mb, MOD + (size_t)l * 9 * MODW + 2048, NW + (l * 4 + 1) * D, H, MOD + (size_t)l * 9 * MODW, 3072, 4096, NW + (l * 4 + 2) * D, MR, a.wv); break;
            case 6: { g0 = GemmDesc{H, (const bf16*)(ws + W_UP), MR, UPW, D, (bf16*)(ws + WS_G), DFF, 1}; ng = 1; } break;
            case 7: ffn_fixup(a, l, MR); break;
            case 8: { g0 = GemmDesc{(const bf16*)(ws + WS_G), (const bf16*)(ws + W_DN), MR, D, DFF, Mb, D}; ng = 1; } break;
            case 9:
                if (!last) { rowwise2<3>(XL, XC, XL, XC, Mb, MOD + (size_t)l * 9 * MODW + 5120, NW + (l * 4 + 3) * D, H, MOD + (size_t)(l + 1) * 9 * MODW, 0, 1024, NW + ((l + 1) * 4 + 0) * D, T, a.wv);
                             convert_layer(a, l + 1, lds); }
                else rowwise2<3>(XL, XC, XL, XC, Mb, MOD + (size_t)l * 9 * MODW + 5120, NW + (l * 4 + 3) * D, nullptr, MOD, 0, 0, NW, TL, a.wv);
                break;
            }
        }
#else
        { g0 = GemmDesc{H, (const bf16*)(ws + W_IN), T, a.hi * 256, a.lo * 128, (bf16*)(ws + WS_P), HYB_INP}; ng = 1; }
#endif
        for (int gi = 0; gi < ng; ++gi) {
            const bool f = (gi == 0);
            pg8::Gemm g{f ? g0.A : g1.A, f ? g0.Bt : g1.Bt, f ? g0.M : g1.M, f ? g0.N : g1.N, f ? g0.K : g1.K, a.wv,
#ifdef GDIAG
                (s == GDIAG_STEP) ? (float*)(a0.ws + WS_MOD + 900 * 1024) : nullptr
#else
                nullptr
#endif
            }; pg8::StaticOrder S; S.init(g.M, g.N, (int)gridDim.x, (int)blockIdx.x);
            pg8::EpiFfn E{f ? g0.O : g1.O, f ? g0.ldc : g1.ldc, f ? g0.mode : 0, (bf16*)(ws + WS_UE), a.in[I_FCONV] + (size_t)((s - 2) / 10) * 3 * UPW, (LAS pg8::f32x4*)(lds + 131072), a.wv};
#ifndef NO_GEMM
            pg8::gemm_phase<pg8::EpiFfn, pg8::StaticOrder, true, true>(lds, g, S, E);
#endif
            __syncthreads();
        }
        if (rep + 1 < nrep) __syncthreads();
        }
#ifdef GDIAG
        if (s + 1 == a0.hi) { __syncthreads(); asm volatile("s_waitcnt vmcnt(0)" ::: "memory"); if (blockIdx.x == 0 && otid(wv0) == 0) { const float* dg = (const float*)(a0.ws + WS_MOD + 900 * 1024); a0.out[0] += 25.0f * dg[GDIAG_SEL] / dg[3]; } }
#endif
#ifdef SSD_DIAG
        if (s + 1 == a0.hi) { __syncthreads(); asm volatile("s_waitcnt vmcnt(0)" ::: "memory"); if (blockIdx.x == 0 && otid(wv0) == 0) { const float* dg = (const float*)(a0.ws + WS_MOD + 900 * 1024); a0.out[0] += 25.0f * dg[SSD_DIAG_SEL] / dg[7]; } }
#endif
#ifdef TDIAG
        if (s + 1 == a0.hi) { __syncthreads(); }
#endif
        if (s + 1 < a0.hi) {
#if MK_SINGLE == 1
            xcd_barrier(xbar);
#ifdef PROBE_BAR2
            xcd_barrier(xbar);
#endif
#elif MK_SINGLE == 2
            cg::this_grid().sync();
#endif
        }
#ifdef TDIAG
        { const unsigned long long tn = __builtin_amdgcn_s_memrealtime(); int cat = 0;
          if (s >= 2) { const int k = (s - 2) % 10, par = ((s - 2) / 10) & 1; cat = (k == 0 || k == 4 || k == 6 || k == 8 || (k == 2 && par == 0)) ? 1 : ((k == 5 || k == 9) ? 2 : ((k == 3 && par == 0) ? 4 : ((k == 2 && par == 1) ? 5 : 3)));
#ifdef TDIAG_K
              cat = (k == TDIAG_K && (TDIAG_PAR == 2 || par == TDIAG_PAR)) ? 1 : 3;
#endif
          }
#pragma unroll
          for (int q = 0; q < 6; ++q) if (q == cat) tcat[q] += tn - tlast;
          tlast = tn;
          if (s + 1 == a0.hi) { asm volatile("s_waitcnt vmcnt(0)" ::: "memory"); if (blockIdx.x == 0 && otid(wv0) == 0) { unsigned long long tt = 0;
#pragma unroll
              for (int q = 0; q < 6; ++q) tt += tcat[q];
              a0.out[0] += (TDIAG == 6) ? (float)tt * (1.0f / 20000.0f) : 25.0f * (float)tcat[TDIAG < 6 ? TDIAG : 0] / (float)tt; } } }
#endif
    }
}

extern "C" void kernel_launch(void* const* d_in, const int* in_sizes, int n_in, void* d_out, int out_size, void* d_ws, size_t ws_size, hipStream_t stream) {
    static int grid = 0;
    if (grid == 0) {
        if (n_in != 25 || out_size != TL * D || ws_size < WS_END) { fprintf(stderr, "kernel_launch: unexpected problem (n_in %d out %d ws %zu need %zu)\n", n_in, out_size, ws_size, (size_t)WS_END); grid = -1; return; }
        if (hipFuncSetAttribute((const void*)fwd_kernel, hipFuncAttributeMaxDynamicSharedMemorySize, LDS_BYTES) != hipSuccess) { fprintf(stderr, "kernel_launch: hipFuncSetAttribute failed\n"); grid = -1; return; }
        int dev = 0, cus = 0, per_cu = 0;
        hipGetDevice(&dev); hipDeviceGetAttribute(&cus, hipDeviceAttributeMultiprocessorCount, dev);
        hipOccupancyMaxActiveBlocksPerMultiprocessor(&per_cu, (const void*)fwd_kernel, NTHR, LDS_BYTES);
        (void)hipGetLastError();
        if (per_cu < 1) { fprintf(stderr, "kernel_launch: occupancy query says %d blocks per CU\n", per_cu); }
        grid = cus;
    }
    if (grid < 0) return;
#if MK_SINGLE == 1
    if (hipMemsetAsync((char*)d_ws + WS_CTL, 0, CTL_ZERO_BYTES, stream) != hipSuccess) { fprintf(stderr, "kernel_launch: memset failed\n"); return; }
#endif
    Args a{};
    for (int i = 0; i < 25; ++i) a.in[i] = (const float*)d_in[i];
    a.out = (float*)d_out; a.ws = (unsigned char*)d_ws;
#if MK_SINGLE
    a.lo = 0; a.hi = NSTEP + 1;
    void* args[] = {&a};
    hipError_t e = hipLaunchCooperativeKernel((const void*)fwd_kernel, dim3(grid), dim3(NTHR), args, LDS_BYTES, stream);
    if (e != hipSuccess) fprintf(stderr, "cooperative launch failed: %s (grid %d)\n", hipGetErrorString(e), grid);
#else
    for (int s = 0; s < NSTEP + 1; ++s) { a.lo = s; a.hi = s + 1; hipLaunchKernelGGL(fwd_kernel, dim3(grid), dim3(NTHR), LDS_BYTES, stream, a); }
#endif
}
```

```cpp
#include <hip/hip_runtime.h>
#include <hip/hip_cooperative_groups.h>
#include <cstdio>
#include <cstdint>
namespace cg = cooperative_groups;
__device__ __forceinline__ int otid(int wv) { int l; asm volatile("v_mbcnt_lo_u32_b32 %0, -1, 0\n\tv_mbcnt_hi_u32_b32 %0, -1, %0" : "=v"(l)); return (wv << 6) | l; }
__device__ __forceinline__ float shx(float v, int mask, int lane) { return __builtin_bit_cast(float, __builtin_amdgcn_ds_bpermute((lane ^ mask) << 2, __builtin_bit_cast(int, v))); }
#define LAS __attribute__((address_space(3)))
#define XB_TMO      128
#define XB_XCNT(j)  (256  + 64 * (j))
#define XB_XSUB(j)  (1280 + 64 * (j))
#define XB_XGEN(j)  (2304 + 64 * (j))
#define XB_TOP      3328
#define XB_TOPGEN   3392
#define XCD_BAR_WORDS 3456
#define XB_SPIN_CAP (1u << 18)

__device__ __forceinline__ unsigned xb_ld(unsigned* p)              { return __hip_atomic_load(p, __ATOMIC_RELAXED, __HIP_MEMORY_SCOPE_AGENT); }
__device__ __forceinline__ unsigned xb_add(unsigned* p, unsigned v) { return __hip_atomic_fetch_add(p, v, __ATOMIC_RELAXED, __HIP_MEMORY_SCOPE_AGENT); }
__device__ __forceinline__ unsigned xb_xcc_id() { return (unsigned)__builtin_amdgcn_s_getreg((3 << 11) | 20) & 0xFu; }
#define XB_SPIN(cond, bar) do { unsigned _sp = 0; while (cond) { __builtin_amdgcn_s_sleep(1); \
    if ((++_sp & 255u) == 0u) { if (xb_ld(&(bar)[XB_TMO])) break; if (_sp > XB_SPIN_CAP) { atomicAdd(&(bar)[XB_TMO], 1u); break; } } } } while (0)

struct XcdBarrier {
    unsigned* bar; unsigned x; int wv;
    volatile LAS unsigned* st;
};

__device__ __forceinline__ XcdBarrier xcd_barrier_post(unsigned* bar, volatile LAS unsigned* st, int wv) {
    XcdBarrier b; b.bar = bar; b.x = xb_xcc_id(); b.st = st; b.wv = wv;
    if (otid(wv) == 0) (void)xb_add(&bar[XB_XCNT(b.x)], 1u);
    return b;
}
__device__ __forceinline__ void xcd_barrier_complete(unsigned* bar, unsigned x, unsigned& nloc, unsigned& nx) {
    const unsigned G = gridDim.x * gridDim.y * gridDim.z;
    unsigned sum, cnt, mine, sp = 0u;
    for (;;) {
        sum = 0u; cnt = 0u; mine = 0u;
#pragma unroll
        for (unsigned j = 0; j < 16; ++j) { const unsigned c = xb_ld(&bar[XB_XCNT(j)]); sum += c; cnt += (c > 0u) ? 1u : 0u; mine = (j == x) ? c : mine; }
        if (sum == G) break;
        __builtin_amdgcn_s_sleep(1);
        if ((++sp & 255u) == 0u) { if (xb_ld(&bar[XB_TMO])) break; if (sp > XB_SPIN_CAP) { atomicAdd(&bar[XB_TMO], 1u); break; } }
    }
    nloc = mine > 0u ? mine : 1u; nx = cnt > 0u ? cnt : 1u;
}

__device__ __forceinline__ void xcd_barrier(const XcdBarrier& b) {
    asm volatile("s_waitcnt vmcnt(0)" ::: "memory");
    __syncthreads();
    if (otid(b.wv) == 0) {
        unsigned* bar = b.bar;
        __builtin_amdgcn_s_waitcnt(0);
        unsigned nloc = b.st[0], nx = b.st[1];
        if (nloc == 0u) { xcd_barrier_complete(bar, b.x, nloc, nx); b.st[0] = nloc; b.st[1] = nx; }
        const unsigned old = xb_add(&bar[XB_XSUB(b.x)], 1u);
        const unsigned gen = old / nloc;
        if (old + 1u == (gen + 1u) * nloc) {
            __builtin_amdgcn_fence(__ATOMIC_RELEASE, "agent");
            asm volatile("s_waitcnt vmcnt(0)" ::: "memory");
            const unsigned og = xb_add(&bar[XB_TOP], 1u);
            const unsigned tg = og / nx;
            if (og + 1u == (tg + 1u) * nx) xb_add(&bar[XB_TOPGEN], 1u);
            else XB_SPIN(xb_ld(&bar[XB_TOPGEN]) == tg, bar);
            __builtin_amdgcn_fence(__ATOMIC_ACQUIRE, "agent");
            xb_add(&bar[XB_XGEN(b.x)], 1u);
            asm volatile("s_waitcnt vmcnt(0)" ::: "memory");
        } else {
            XB_SPIN(xb_ld(&bar[XB_XGEN(b.x)]) == gen, bar);
            __builtin_amdgcn_fence(__ATOMIC_ACQUIRE, "agent");
            asm volatile("s_waitcnt vmcnt(0)" ::: "memory");
        }
    }
    __syncthreads();
}
namespace pg8 {
#define PG8_LAS __attribute__((address_space(3)))
typedef unsigned short bf16_t;
typedef short bf16x8 __attribute__((ext_vector_type(8)));
typedef float f32x4 __attribute__((ext_vector_type(4)));
typedef unsigned u32x4 __attribute__((ext_vector_type(4)));
constexpr int BM = 256, BK = 64, HALF = 128, HTB = HALF * BK * 2  , STAGE_BYTES = 8 * HTB, NXCD = 8, WGM = 8;

__host__ __device__ __forceinline__ int lds_byte(int r, int c) { const int st = (r >> 4) * 2 + (c >> 5), rr = r & 15, cc = c & 31, ob = rr * 64 + cc * 2; return st * 1024 + (ob ^ (((ob >> 9) & 1) << 5)); }
__host__ __device__ __forceinline__ void stage_rc(int b, int& R, int& C) { const int st = b / 1024, sb = b % 1024, swz = sb ^ (((sb >> 9) & 1) << 5); R = (st >> 1) * 16 + swz / 64; C = (st & 1) * 32 + (swz % 64) / 2; }
__host__ __device__ __forceinline__ int perm32(int rho) { const int n = rho >> 4, i = rho & 15; return 8 * (i >> 2) + 4 * n + (i & 3); }

struct Unit { int pm, pn; };
struct Gemm { const bf16_t* A; const bf16_t* Bt; int M, N, K, wv; float* dg; };

struct StaticOrder {
    int nM, nN, nwg, G, c;
    __host__ __device__ void init(int M, int N, int G_, int c_) { nM = M / BM; nN = N / BM; nwg = nM * nN; G = G_; c = c_; }
    __host__ __device__ bool next(int i, Unit& u) const {
        const long L = (long)i * G + c; if (L >= nwg) return false;
        int wgid = (int)L; { const int q = nwg / NXCD, r = nwg % NXCD, xcd = wgid % NXCD, off = wgid / NXCD; wgid = (xcd < r ? xcd * (q + 1) : r * (q + 1) + (xcd - r) * q) + off; }
        const int nig = WGM * nN, gid = wgid / nig, fm = gid * WGM, gsz = (nM - fm) < WGM ? (nM - fm) : WGM;
        u.pm = fm + ((wgid % nig) % gsz); u.pn = (wgid % nig) / gsz; return true;
    }
    __device__ __forceinline__ void a_ready(const Unit&) const {}
    __device__ __forceinline__ void done(const Unit&) const {}
};

__device__ __forceinline__ unsigned cvt_pk_bf16(float lo, float hi) { unsigned r; asm volatile("v_cvt_pk_bf16_f32 %0, %1, %2" : "=v"(r) : "v"(lo), "v"(hi)); return r; }
struct EpiStore {
    static constexpr bool PERM = true, AFTER_DRAIN = false;
    bf16_t* O; int ldc;
    __device__ __forceinline__ void operator()(const f32x4 (&acc)[2][2][4][2], const Unit& u, int wr, int wc, int fr, int fq) const {
        const int row0 = u.pm * BM + wr * 64 + fr; const int col0 = u.pn * BM + wc * 32 + 8 * fq;
#pragma unroll
        for (int ai = 0; ai < 2; ++ai)
#pragma unroll
            for (int m = 0; m < 4; ++m) { bf16_t* rowp = O + (size_t)(row0 + ai * HALF + m * 16) * ldc + col0;
#pragma unroll
                for (int bj = 0; bj < 2; ++bj) { const f32x4 v0 = acc[ai][bj][m][0], v1 = acc[ai][bj][m][1];
                    u32x4 w; w.x = cvt_pk_bf16(v0[0], v0[1]); w.y = cvt_pk_bf16(v0[2], v0[3]); w.z = cvt_pk_bf16(v1[0], v1[1]); w.w = cvt_pk_bf16(v1[2], v1[3]);
                    *(u32x4*)(rowp + bj * HALF) = w; } }
    }
};

template <int CTRL> __device__ __forceinline__ float dpprot(float src) { return __builtin_bit_cast(float, __builtin_amdgcn_mov_dpp(__builtin_bit_cast(int, src), CTRL, 0xf, 0xf, true)); }
template <int CTRL> __device__ __forceinline__ float dppf(float old, float src) { return __builtin_bit_cast(float, __builtin_amdgcn_update_dpp(__builtin_bit_cast(int, old), __builtin_bit_cast(int, src), CTRL, 0xf, 0xf, false)); }
#define PG8_DPP4(dst, oldv, srcv, ctrl) do { dst[0] = dppf<ctrl>(oldv[0], srcv[0]); dst[1] = dppf<ctrl>(oldv[1], srcv[1]); dst[2] = dppf<ctrl>(oldv[2], srcv[2]); dst[3] = dppf<ctrl>(oldv[3], srcv[3]); } while (0)
struct EpiFfn {
    static constexpr bool PERM = true, AFTER_DRAIN = false;
    bf16_t* O; int ldc; int mode;
    bf16_t* Ue; const float* cw; PG8_LAS f32x4* ex; int wv;
    __device__ __forceinline__ void operator()(const f32x4 (&acc)[2][2][4][2], const Unit& u, int wr, int wc, int fr_in, int fq_in) const {
        (void)fr_in; (void)fq_in; const int lane_e = otid(wv) & 63; const int fr = lane_e & 15, fq = lane_e >> 4;
        if (mode == 0) {
            const int row0 = u.pm * BM + wr * 64 + fr; const int col0 = u.pn * BM + wc * 32 + 8 * fq;
#pragma unroll
            for (int ai = 0; ai < 2; ++ai)
#pragma unroll
                for (int m = 0; m < 4; ++m) { bf16_t* rowp = O + (size_t)(row0 + ai * HALF + m * 16) * ldc + col0;
#pragma unroll
                    for (int bj = 0; bj < 2; ++bj) { const f32x4 v0 = acc[ai][bj][m][0], v1 = acc[ai][bj][m][1];
                        u32x4 w; w.x = cvt_pk_bf16(v0[0], v0[1]); w.y = cvt_pk_bf16(v0[2], v0[3]); w.z = cvt_pk_bf16(v1[0], v1[1]); w.w = cvt_pk_bf16(v1[2], v1[3]);
                        *(u32x4*)(rowp + bj * HALF) = w; } }
            return;
        }
        const int chl = wc * 32 + 8 * fq, ch = u.pn * 128 + chl;
        f32x4 wA[3][2], wG[3][2];
#pragma unroll
        for (int t = 0; t < 3; ++t)
#pragma unroll
            for (int n = 0; n < 2; ++n) { wA[t][n] = *(const f32x4*)(cw + t * 5632 + ch + 4 * n); wG[t][n] = *(const f32x4*)(cw + t * 5632 + 2816 + ch + 4 * n); }
#define PG8_EX(blk, fl, bj, n) ex[((((blk) * 2 + (fl)) * 2 + (bj)) * 2 + (n)) * 16 + wc * 4 + fq]
#pragma unroll
        for (int ai = 0; ai < 2; ++ai) { const int blk = ai * 2 + wr;
            if (fr == 0) {
#pragma unroll
                for (int bj = 0; bj < 2; ++bj)
#pragma unroll
                    for (int n = 0; n < 2; ++n) PG8_EX(blk, 0, bj, n) = acc[ai][bj][0][n]; }
            if (fr == 15) {
#pragma unroll
                for (int bj = 0; bj < 2; ++bj)
#pragma unroll
                    for (int n = 0; n < 2; ++n) PG8_EX(blk, 1, bj, n) = acc[ai][bj][3][n]; } }
        asm volatile("s_waitcnt lgkmcnt(0)" ::: "memory"); __builtin_amdgcn_s_barrier(); asm volatile("" ::: "memory");
        const f32x4 zero4 = (f32x4){0.f, 0.f, 0.f, 0.f}; const bool is15 = fr == 15, is0 = fr == 0;
#pragma unroll
        for (int ai = 0; ai < 2; ++ai) { const int blk = ai * 2 + wr;
            f32x4 pb[2][2], nb[2][2];
#pragma unroll
            for (int bj = 0; bj < 2; ++bj)
#pragma unroll
                for (int n = 0; n < 2; ++n) { pb[bj][n] = blk > 0 ? PG8_EX(blk - 1, 1, bj, n) : zero4; nb[bj][n] = blk < 3 ? PG8_EX(blk + 1, 0, bj, n) : zero4; }
#pragma unroll
            for (int m = 0; m < 4; ++m) {
                f32x4 cv[2][2];
#pragma unroll
                for (int bj = 0; bj < 2; ++bj)
#pragma unroll
                    for (int n = 0; n < 2; ++n) { const f32x4 cur = acc[ai][bj][m][n];
                        const f32x4 lo = (m == 0) ? pb[bj][n] : acc[ai][bj][m > 0 ? m - 1 : 0][n];
                        const f32x4 hi = (m == 3) ? nb[bj][n] : acc[ai][bj][m < 3 ? m + 1 : 3][n];
                        f32x4 prev, next;
#pragma unroll
                        for (int e = 0; e < 4; ++e) { prev[e] = dpprot<0x121>(is15 ? lo[e] : cur[e]);
                                                      next[e] = dpprot<0x12F>(is0 ? hi[e] : cur[e]); }
                        const f32x4 w0 = bj ? wG[0][n] : wA[0][n], w1 = bj ? wG[1][n] : wA[1][n], w2 = bj ? wG[2][n] : wA[2][n];
                        cv[bj][n] = w0 * prev + w1 * cur + w2 * next; }
                u32x4 w; float g[8];
#pragma unroll
                for (int n = 0; n < 2; ++n)
#pragma unroll
                    for (int e = 0; e < 4; ++e) { const float av = cv[0][n][e]; g[4 * n + e] = av * __builtin_amdgcn_rcpf(1.f + __expf(-av)) * cv[1][n][e]; }
                w.x = cvt_pk_bf16(g[0], g[1]); w.y = cvt_pk_bf16(g[2], g[3]); w.z = cvt_pk_bf16(g[4], g[5]); w.w = cvt_pk_bf16(g[6], g[7]);
                *(u32x4*)(O + (size_t)(u.pm * BM + ai * HALF + wr * 64 + m * 16 + fr) * 2816 + ch) = w;
            } }
#undef PG8_EX
        { const int slot = (wr == 0) ? (fr == 0 ? 0 : (fr == 1 ? 1 : -1)) : (fr == 14 ? 2 : (fr == 15 ? 3 : -1));
          if (slot >= 0) { bf16_t* up = Ue + ((size_t)(u.pm * 4 + slot) * 5632) + u.pn * 256 + chl;
#pragma unroll
              for (int bj = 0; bj < 2; ++bj) { const f32x4 v0 = wr ? acc[1][bj][3][0] : acc[0][bj][0][0], v1 = wr ? acc[1][bj][3][1] : acc[0][bj][0][1];
                  u32x4 w; w.x = cvt_pk_bf16(v0[0], v0[1]); w.y = cvt_pk_bf16(v0[2], v0[3]); w.z = cvt_pk_bf16(v1[0], v1[1]); w.w = cvt_pk_bf16(v1[2], v1[3]);
                  *(u32x4*)(up + bj * HALF) = w; } } }
    }
};
template <class Epi, class Sched, bool ALIGN_EPI = false, bool SP2 = false>
__device__ __forceinline__ void gemm_phase(PG8_LAS unsigned char* lds, const Gemm g, const Sched& S, const Epi& E) {
    const int tid = otid(g.wv), wid = g.wv, lane = tid & 63, wr = wid >> 2, wc = wid & 3, fr = lane & 15, fq = lane >> 4;
    const int K = g.K, nt = K / BK;
    unsigned voffA[2], voffB[2];
#pragma unroll
    for (int i = 0; i < 2; ++i) { int R, C; stage_rc(tid * 16 + i * 8192, R, C); const int Rb = Epi::PERM ? ((R & ~31) + perm32(R & 31)) : R;
        voffA[i] = (unsigned)(R * K + C) * 2u; voffB[i] = (unsigned)(Rb * K + C) * 2u; }
    const size_t kstep = (size_t)(BK * 2);
    const size_t hstep = (size_t)HALF * K * 2;
    const size_t tstep = 2 * hstep;
    const unsigned ldsw = (unsigned)wid * 1024u;
    const int aoff = lds_byte(wr * 64 + fr, fq * 8), boff = lds_byte(wc * 32 + fr, fq * 8);
#define PG8_SA(b, h) (((b) * 2 + (h)) * HTB)
#define PG8_SB(b, h) ((4 + (b) * 2 + (h)) * HTB)
#define PG8_STAGE(bufoff, gbase, voff) do { _Pragma("unroll") for (int _i = 0; _i < 2; ++_i) \
        __builtin_amdgcn_global_load_lds((const unsigned*)((const char*)(gbase) + (voff)[_i]), (PG8_LAS unsigned*)(lds + (bufoff) + ldsw + _i * 8192), 16, 0, 0); } while (0)
#define PG8_LDA(dst, b, h) do { _Pragma("unroll") for (int m = 0; m < 4; ++m) _Pragma("unroll") for (int k = 0; k < 2; ++k) dst[m][k] = *(const PG8_LAS bf16x8*)(lds + PG8_SA(b, h) + aoff + m * 2048 + k * 1024); } while (0)
#define PG8_LDB(dst, b, h) do { _Pragma("unroll") for (int n = 0; n < 2; ++n) _Pragma("unroll") for (int k = 0; k < 2; ++k) dst[n][k] = *(const PG8_LAS bf16x8*)(lds + PG8_SB(b, h) + boff + n * 2048 + k * 1024); } while (0)
#define PG8_MMA(ai, bj, At, Bt) do { __builtin_amdgcn_s_setprio(1); _Pragma("unroll") for (int m = 0; m < 4; ++m) _Pragma("unroll") for (int n = 0; n < 2; ++n) _Pragma("unroll") for (int k = 0; k < 2; ++k) \
        acc[ai][bj][m][n] = __builtin_amdgcn_mfma_f32_16x16x32_bf16(Bt[n][k], At[m][k], acc[ai][bj][m][n], 0, 0, 0); __builtin_amdgcn_s_setprio(0); } while (0)
#define PG8_WAIT_V(n) asm volatile("s_waitcnt vmcnt(" #n ")" ::: "memory")
#define PG8_WAIT_L(n) asm volatile("s_waitcnt lgkmcnt(" #n ")" ::: "memory")
#define PG8_BAR __builtin_amdgcn_s_barrier()
#define PG8_SCHED __builtin_amdgcn_sched_barrier(0)
    Unit cur, nxt; int ui = 0;
#ifdef GDIAG
    unsigned gd0 = 0, gd1 = 0, gd2 = 0; const unsigned gstart = (unsigned)__builtin_amdgcn_s_memtime();
#endif
    if (!S.next(0, cur)) return;
    f32x4 acc[2][2][4][2];
#pragma unroll
    for (int a = 0; a < 2; ++a)
#pragma unroll
        for (int b = 0; b < 2; ++b)
#pragma unroll
            for (int m = 0; m < 4; ++m)
#pragma unroll
                for (int n = 0; n < 2; ++n) acc[a][b][m][n] = (f32x4){0.f, 0.f, 0.f, 0.f};
    bf16x8 At[4][2], B0[2][2], B1[2][2];
    const char* cA = (const char*)g.A + (size_t)cur.pm * tstep; const char* cB = (const char*)g.Bt + (size_t)cur.pn * tstep;
    S.a_ready(cur);
    if constexpr (SP2) {
        PG8_STAGE(PG8_SB(0, 0), cB, voffB); PG8_STAGE(PG8_SB(0, 1), cB + hstep, voffB); PG8_STAGE(PG8_SA(0, 0), cA, voffA); PG8_STAGE(PG8_SA(0, 1), cA + hstep, voffA);
        if (wr == 1) PG8_BAR;
        PG8_WAIT_V(2); PG8_BAR;
        PG8_STAGE(PG8_SB(1, 0), cB + kstep, voffB); PG8_STAGE(PG8_SA(1, 0), cA + kstep, voffA); PG8_STAGE(PG8_SB(1, 1), cB + hstep + kstep, voffB);
        PG8_WAIT_V(6); PG8_BAR;
    } else {
        PG8_STAGE(PG8_SB(0, 0), cB, voffB); PG8_STAGE(PG8_SA(0, 0), cA, voffA); PG8_STAGE(PG8_SB(0, 1), cB + hstep, voffB); PG8_STAGE(PG8_SA(0, 1), cA + hstep, voffA);
        if (wr == 1) PG8_BAR;
        PG8_WAIT_V(4); PG8_BAR;
        PG8_STAGE(PG8_SB(1, 0), cB + kstep, voffB); PG8_STAGE(PG8_SA(1, 0), cA + kstep, voffA); PG8_STAGE(PG8_SB(1, 1), cB + hstep + kstep, voffB);
        PG8_WAIT_V(6); PG8_BAR;
    }
    for (;;) {
        const bool has_next = S.next(ui + 1, nxt);
        const char* nA = has_next ? (const char*)g.A + (size_t)nxt.pm * tstep : cA; const char* nB = has_next ? (const char*)g.Bt + (size_t)nxt.pn * tstep : cB;
#ifdef GDIAG
        unsigned gt0 = (unsigned)__builtin_amdgcn_s_memtime();
#endif
        for (int t = 0; t < nt; t += 2) {
            const bool last = (t == nt - 2);
            const char* a1 = cA + (size_t)(t + 1) * kstep;
            const char* a2 = last ? nA : cA + (size_t)(t + 2) * kstep; const char* b2 = last ? nB : cB + (size_t)(t + 2) * kstep;
            const char* a3 = a2 + kstep; const char* b3 = b2 + kstep;
            if (last && has_next) S.a_ready(nxt);
            if constexpr (SP2) {
            PG8_LDB(B0, 0, 0); PG8_LDB(B1, 0, 1); PG8_SCHED; PG8_LDA(At, 0, 0); PG8_STAGE(PG8_SA(1, 1), a1 + hstep, voffA);
            PG8_WAIT_V(8); PG8_WAIT_L(0); PG8_BAR; PG8_MMA(0, 0, At, B0); PG8_MMA(0, 1, At, B1); PG8_BAR; PG8_SCHED;
            PG8_LDA(At, 0, 1); PG8_STAGE(PG8_SB(0, 0), b2, voffB); PG8_STAGE(PG8_SB(0, 1), b2 + hstep, voffB); PG8_STAGE(PG8_SA(0, 0), a2, voffA);
            PG8_WAIT_V(8); PG8_WAIT_L(0); PG8_BAR; PG8_MMA(1, 0, At, B0); PG8_MMA(1, 1, At, B1); PG8_BAR; PG8_SCHED;
            PG8_LDB(B0, 1, 0); PG8_LDB(B1, 1, 1); PG8_SCHED; PG8_LDA(At, 1, 0); PG8_STAGE(PG8_SA(0, 1), a2 + hstep, voffA);
            PG8_WAIT_V(8); PG8_WAIT_L(0); PG8_BAR; PG8_MMA(0, 0, At, B0); PG8_MMA(0, 1, At, B1); PG8_BAR; PG8_SCHED;
            PG8_LDA(At, 1, 1); PG8_STAGE(PG8_SB(1, 0), b3, voffB); PG8_STAGE(PG8_SB(1, 1), b3 + hstep, voffB); PG8_STAGE(PG8_SA(1, 0), a3, voffA);
            PG8_WAIT_V(8); PG8_WAIT_L(0); PG8_BAR; PG8_MMA(1, 0, At, B0); PG8_MMA(1, 1, At, B1); PG8_BAR; PG8_SCHED;
            } else {
            PG8_LDB(B0, 0, 0); PG8_SCHED; PG8_LDA(At, 0, 0); PG8_STAGE(PG8_SA(1, 1), a1 + hstep, voffA);
            PG8_WAIT_L(8); PG8_BAR; PG8_WAIT_L(0); PG8_MMA(0, 0, At, B0); PG8_BAR; PG8_SCHED;
            PG8_LDB(B1, 0, 1); PG8_STAGE(PG8_SB(0, 0), b2, voffB);
            PG8_BAR; PG8_WAIT_L(0); PG8_MMA(0, 1, At, B1); PG8_BAR;
            PG8_LDA(At, 0, 1); PG8_STAGE(PG8_SA(0, 0), a2, voffA);
            PG8_BAR; PG8_WAIT_L(0); PG8_MMA(1, 0, At, B0); PG8_BAR; PG8_SCHED;
            PG8_STAGE(PG8_SB(0, 1), b2 + hstep, voffB);
            PG8_WAIT_V(6); PG8_BAR; PG8_MMA(1, 1, At, B1); PG8_BAR;
            PG8_LDB(B0, 1, 0); PG8_SCHED; PG8_LDA(At, 1, 0); PG8_STAGE(PG8_SA(0, 1), a2 + hstep, voffA);
            PG8_WAIT_L(8); PG8_BAR; PG8_WAIT_L(0); PG8_MMA(0, 0, At, B0); PG8_BAR; PG8_SCHED;
            PG8_LDB(B1, 1, 1); PG8_STAGE(PG8_SB(1, 0), b3, voffB);
            PG8_BAR; PG8_WAIT_L(0); PG8_MMA(0, 1, At, B1); PG8_BAR;
            PG8_LDA(At, 1, 1); PG8_STAGE(PG8_SA(1, 0), a3, voffA);
            PG8_BAR; PG8_WAIT_L(0); PG8_MMA(1, 0, At, B0); PG8_BAR; PG8_SCHED;
            PG8_STAGE(PG8_SB(1, 1), b3 + hstep, voffB);
            PG8_WAIT_V(6); PG8_BAR; PG8_MMA(1, 1, At, B1); PG8_BAR;
            }
        }
#ifdef GDIAG
        { const unsigned n_ = (unsigned)__builtin_amdgcn_s_memtime(); gd0 += n_ - gt0; gt0 = n_; }
#endif
        if constexpr (ALIGN_EPI) { if (wr == 0) PG8_BAR; }
#ifdef GDIAG
        { const unsigned n_ = (unsigned)__builtin_amdgcn_s_memtime(); gd1 += n_ - gt0; gt0 = n_; }
#endif
        if constexpr (!Epi::AFTER_DRAIN) { E(acc, cur, wr, wc, fr, fq); S.done(cur); }
#ifdef GDIAG
        { const unsigned n_ = (unsigned)__builtin_amdgcn_s_memtime(); gd2 += n_ - gt0; gt0 = n_; }
#endif
        if (!has_next) break;
#pragma unroll
        for (int a = 0; a < 2; ++a)
#pragma unroll
            for (int b = 0; b < 2; ++b)
#pragma unroll
                for (int m = 0; m < 4; ++m)
#pragma unroll
                    for (int n = 0; n < 2; ++n) acc[a][b][m][n] = (f32x4){0.f, 0.f, 0.f, 0.f};
        cur = nxt; cA = nA; cB = nB; ++ui;
        if constexpr (ALIGN_EPI) { if (wr == 1) PG8_BAR; }
    }
#ifdef GDIAG
    if (g.dg && blockIdx.x == 0 && wid == GDIAG_WAVE && lane == 0) { const unsigned tot = (unsigned)__builtin_amdgcn_s_memtime() - gstart; g.dg[0] = (float)gd0; g.dg[1] = (float)gd1; g.dg[2] = (float)gd2; g.dg[3] = (float)tot; }
#endif
    PG8_WAIT_V(0);
    if constexpr (!ALIGN_EPI) { if (wr == 0) PG8_BAR; }
    PG8_BAR;
    if constexpr (Epi::AFTER_DRAIN) { E.fused(acc, cur, wr, wc, fr, fq, lds, wid, lane); S.done(cur); }
#undef PG8_SA
#undef PG8_SB
#undef PG8_STAGE
#undef PG8_LDA
#undef PG8_LDB
#undef PG8_MMA
#undef PG8_WAIT_V
#undef PG8_WAIT_L
#undef PG8_BAR
#undef PG8_SCHED
}
}

typedef unsigned short bf16;
typedef unsigned v4u __attribute__((ext_vector_type(4)));
typedef unsigned v2u __attribute__((ext_vector_type(2)));
typedef float f32x4 __attribute__((ext_vector_type(4)));
constexpr int NWAVES = 8, NTHR = 512;
constexpr int D = 1024, NB = 8, SEQ = 2048, CTXL = 256, TL = NB * SEQ, TC = NB * CTXL, T = TL + TC;
constexpr int HYB_IN = 2208, HYB_INP = 2304, SSD_IN = 5184, SSD_INP = 5376, DFF = 2816, UPW = 5632;
constexpr int QW = 768, KVW = 1024, MODW = 6144;
constexpr float EPS = 1e-6f;
constexpr int NSTEP = 1 + 4 * 10;
constexpr float ATT_SCALE_LOG2E = 0.10206207261596577f * 1.4426950408889634f;

constexpr size_t MiB = 1u << 20;
constexpr size_t WS_CTL = 0, CTL_ZERO_BYTES = 64 * 1024;
constexpr size_t WS_MOD = 1 * MiB;
constexpr size_t WS_ROPE = 2 * MiB;
constexpr size_t W_UP = 3 * MiB;
constexpr size_t W_DN = W_UP + (size_t)UPW * D * 2;
constexpr size_t W_IN = W_DN + (size_t)D * DFF * 2;
constexpr size_t W_OUT = W_IN + (size_t)SSD_INP * D * 2;
constexpr size_t W_UQ = W_OUT + (size_t)D * 2048 * 2;
constexpr size_t W_UKV = W_UQ + (size_t)QW * 384 * 2;
constexpr size_t W_END = W_UKV + (size_t)KVW * 256 * 2;
constexpr size_t WS_XC = 36 * MiB;
constexpr size_t WS_H = 44 * MiB;
constexpr size_t WS_DT = WS_H, WS_AA = WS_H + (size_t)T * 64 * 4;
constexpr size_t WS_BIG = 80 * MiB;
constexpr size_t WS_M = WS_BIG;
constexpr size_t WS_P = WS_BIG;
constexpr size_t WS_Q = WS_BIG + 81 * MiB;
constexpr size_t WS_KV = WS_BIG + 108 * MiB;
constexpr size_t WS_KR = WS_BIG + 144 * MiB;
constexpr size_t WS_CQN = WS_BIG + 146 * MiB;
constexpr size_t WS_CKVN = WS_BIG + 160 * MiB;
constexpr size_t WS_MIX = WS_BIG + 170 * MiB;
constexpr size_t WS_U = WS_BIG;
constexpr size_t WS_G = WS_BIG + 198 * MiB;
constexpr size_t WS_ZX = WS_BIG;
constexpr size_t WS_XBC = WS_BIG + 189 * MiB;
constexpr size_t WS_UE = WS_BIG + 297 * MiB;
constexpr size_t WS_END = WS_UE + 4 * MiB;
static_assert(W_END <= WS_XC && WS_G + (size_t)T * DFF * 2 <= WS_END && WS_XBC + (size_t)T * 3072 * 2 <= WS_END && WS_ZX + (size_t)T * SSD_INP * 2 <= WS_XBC, "ws map");
static_assert(WS_AA + (size_t)T * 64 * 4 <= WS_BIG && WS_MIX + (size_t)T * D * 2 <= WS_END && WS_Q + (size_t)T * QW * 2 <= WS_KV && WS_P + (size_t)T * HYB_INP * 2 <= WS_Q, "ws map 2");
constexpr int LDS_BYTES = 147456;

struct Args { const float* in[25]; float* out; unsigned char* ws; int lo, hi; int wv, pad; };
enum { I_X = 0, I_C, I_CTX, I_CCTX, I_MODW, I_MODB, I_NORMW, I_WUP, I_FCONV, I_WDN, I_HIN, I_QNORM, I_KVNORM, I_WUQ, I_WUKV, I_SCONV, I_HOUT, I_SIN, I_SCONVW, I_SCONVB, I_ALOG, I_DTB, I_SD, I_SNORM, I_SOUT };

__device__ __forceinline__ unsigned f2bf(float f) { unsigned u = __builtin_bit_cast(unsigned, f); return (u + 0x7fffu + ((u >> 16) & 1u)) >> 16; }
__device__ __forceinline__ unsigned pk2(float lo, float hi) { unsigned r; asm("v_cvt_pk_bf16_f32 %0, %1, %2" : "=v"(r) : "v"(lo), "v"(hi)); return r; }
__device__ __forceinline__ float bflo(unsigned u) { return __builtin_bit_cast(float, u << 16); }
__device__ __forceinline__ float bfhi(unsigned u) { return __builtin_bit_cast(float, u & 0xffff0000u); }
__device__ __forceinline__ float bf1(bf16 b) { return __builtin_bit_cast(float, (unsigned)b << 16); }
__device__ __forceinline__ float silu_f(float x) { return x * __builtin_amdgcn_rcpf(1.f + __expf(-x)); }
__device__ __forceinline__ float wave_sum(float v, int lane) {
#pragma unroll
    for (int o = 1; o < 64; o <<= 1) v += shx(v, o, lane);
    return v;
}
__device__ __forceinline__ void unpack8(const v4u w, float (&f)[8]) { f[0] = bflo(w.x); f[1] = bfhi(w.x); f[2] = bflo(w.y); f[3] = bfhi(w.y); f[4] = bflo(w.z); f[5] = bfhi(w.z); f[6] = bflo(w.w); f[7] = bfhi(w.w); }
__device__ __forceinline__ v4u pack8(const float (&f)[8]) { v4u w; w.x = pk2(f[0], f[1]); w.y = pk2(f[2], f[3]); w.z = pk2(f[4], f[5]); w.w = pk2(f[6], f[7]); return w; }
__device__ __forceinline__ bool has_prev(int r) { return r < TL ? (r & (SEQ - 1)) != 0 : ((r - TL) & (CTXL - 1)) != 0; }
__device__ __forceinline__ bool has_next(int r) { return r < TL ? (r & (SEQ - 1)) != SEQ - 1 : ((r - TL) & (CTXL - 1)) != CTXL - 1; }

__device__ __forceinline__ void mod_compute(const Args& a, LAS unsigned char* lds) {
    LAS float* sc = (LAS float*)lds;
    LAS float* red = (LAS float*)(lds + 36864);
    const int tid = otid(a.wv);
    float* MOD = (float*)(a.ws + WS_MOD);
    for (int i = tid; i < 9 * 1024; i += NTHR) { const int c = i >> 10, k = i & 1023; const float v = c < 8 ? a.in[I_C][c * 1024 + k] : a.in[I_CCTX][k]; sc[i] = silu_f(v); }
    __syncthreads();
    for (int item = blockIdx.x; item < 4 * 96; item += gridDim.x) {
        const int l = item / 96, cb = item % 96;
        const float* W = a.in[I_MODW] + (size_t)l * 1024 * MODW + cb * 64;
        const int cgp = tid & 15, kg = tid >> 4;
        float acc[9][4];
#pragma unroll
        for (int c = 0; c < 9; ++c) { acc[c][0] = 0.f; acc[c][1] = 0.f; acc[c][2] = 0.f; acc[c][3] = 0.f; }
#pragma unroll 8
        for (int kk = 0; kk < 32; ++kk) { const int k = kg * 32 + kk; const f32x4 w = *(const f32x4*)(W + (size_t)k * MODW + cgp * 4);
#pragma unroll
            for (int c = 0; c < 9; ++c) { const float s = sc[c * 1024 + k]; acc[c][0] += s * w[0]; acc[c][1] += s * w[1]; acc[c][2] += s * w[2]; acc[c][3] += s * w[3]; } }
#pragma unroll
        for (int c = 0; c < 9; ++c)
#pragma unroll
            for (int j = 0; j < 4; ++j) red[kg * 576 + c * 64 + cgp * 4 + j] = acc[c][j];
        __syncthreads();
        for (int o = tid; o < 576; o += NTHR) { float s = 0.f;
            for (int g = 0; g < 32; ++g) s += red[g * 576 + o];
            const int c = o >> 6, col = o & 63; MOD[(size_t)(l * 9 + c) * MODW + cb * 64 + col] = s + a.in[I_MODB][l * MODW + cb * 64 + col]; }
        __syncthreads();
    }
}
__device__ __forceinline__ void rope_tables(const Args& a) {
    float* ct = (float*)(a.ws + WS_ROPE); float* st = ct + SEQ * 16;
    for (int i = blockIdx.x * NTHR + otid(a.wv); i < SEQ * 16; i += gridDim.x * NTHR) {
        const int t = i >> 4, j = i & 15; const int pos = j < 8 ? (t >> 6) : (t & 63); const int f = j & 7;
        const float i0 = (f & 1) ? 0.31622776601683794f : 1.0f; const int e = f >> 1; const float i1 = e == 0 ? 1.0f : (e == 1 ? 0.1f : (e == 2 ? 0.01f : 0.001f));
        const float inv = i0 * i1; const float ang = (float)pos * inv;
        ct[i] = __cosf(ang); st[i] = __sinf(ang); }
}
__device__ __forceinline__ void transpose_item(const float* W, int K, int N, bf16* WT, LAS float* scr, int item, int lane, bool ffn_perm) {
    const int nblk = N / 32, kb = item / nblk, nb = item % nblk, k0 = 64 * kb, n0 = 32 * nb;
    const int o0 = ffn_perm ? ((n0 % DFF) / 128) * 256 + (n0 / DFF) * 128 + (n0 % 128) : n0;
    float wv_[32];
#pragma unroll
    for (int i = 0; i < 32; ++i) wv_[i] = W[(size_t)(k0 + 2 * i + (lane >> 5)) * N + n0 + (lane & 31)];
#pragma unroll
    for (int i = 0; i < 32; ++i) scr[(2 * i + (lane >> 5)) * 33 + (lane & 31)] = wv_[i];
    asm volatile("s_waitcnt lgkmcnt(0)" ::: "memory");
    const int c = lane & 7;
#pragma unroll
    for (int j = 0; j < 4; ++j) { const int n = (lane >> 3) + 8 * j; const LAS float* s = scr + (8 * c) * 33 + n;
        v4u o; o.x = pk2(s[0 * 33], s[1 * 33]); o.y = pk2(s[2 * 33], s[3 * 33]); o.z = pk2(s[4 * 33], s[5 * 33]); o.w = pk2(s[6 * 33], s[7 * 33]);
        *(v4u*)(WT + (size_t)(o0 + n) * K + k0 + 8 * c) = o; }
    asm volatile("s_waitcnt lgkmcnt(0)" ::: "memory");
}
__device__ __forceinline__ void convert_weight(const float* W, int K, int N, int Npad, bf16* WT, LAS unsigned char* lds, int rot, int wv, bool ffn_perm = false) {
    const int wave = wv, lane = otid(wv) & 63; const int NGW = gridDim.x * NWAVES; const int gw = (blockIdx.x * NWAVES + wave + rot) % NGW;
    LAS float* scr = (LAS float*)(lds + wave * 16384);
    const int nitems = (K / 64) * (N / 32);
    for (int it = gw; it < nitems; it += NGW) transpose_item(W, K, N, WT, scr, it, lane, ffn_perm);
    (void)Npad;
}
__device__ __forceinline__ void convert_layer(const Args& a, int l, LAS unsigned char* lds) {
    const int i = l >> 1; unsigned char* ws = a.ws;
    convert_weight(a.in[I_WUP] + (size_t)l * D * UPW, D, UPW, UPW, (bf16*)(ws + W_UP), lds, 0, a.wv, true);
    convert_weight(a.in[I_WDN] + (size_t)l * DFF * D, DFF, D, D, (bf16*)(ws + W_DN), lds, 300, a.wv);
    if ((l & 1) == 0) {
        convert_weight(a.in[I_HIN] + (size_t)i * D * HYB_IN, D, HYB_IN, HYB_INP, (bf16*)(ws + W_IN), lds, 700, a.wv);
        convert_weight(a.in[I_HOUT] + (size_t)i * D * D, D, D, D, (bf16*)(ws + W_OUT), lds, 1100, a.wv);
        convert_weight(a.in[I_WUQ] + (size_t)i * 384 * QW, 384, QW, QW, (bf16*)(ws + W_UQ), lds, 1500, a.wv);
        convert_weight(a.in[I_WUKV] + (size_t)i * 256 * KVW, 256, KVW, KVW, (bf16*)(ws + W_UKV), lds, 1700, a.wv);
    } else {
        convert_weight(a.in[I_SIN] + (size_t)i * D * SSD_IN, D, SSD_IN, SSD_INP, (bf16*)(ws + W_IN), lds, 700, a.wv);
        convert_weight(a.in[I_SOUT] + (size_t)i * 2048 * D, 2048, D, D, (bf16*)(ws + W_OUT), lds, 1300, a.wv);
    }
}

__device__ __forceinline__ void prep_even(const Args& a, int i) {
    const int wave = otid(a.wv) >> 6, lane = otid(a.wv) & 63; const int NGW = gridDim.x * NWAVES, gw = blockIdx.x * NWAVES + wave;
    const bf16* P = (const bf16*)(a.ws + WS_P); bf16* CQN = (bf16*)(a.ws + WS_CQN); bf16* CKVN = (bf16*)(a.ws + WS_CKVN); bf16* KR = (bf16*)(a.ws + WS_KR); bf16* MIX = (bf16*)(a.ws + WS_MIX);
    const float* qn = a.in[I_QNORM] + i * 384; const float* kvn = a.in[I_KVNORM] + i * 256; const float* cw = a.in[I_SCONV] + i * 3 * 512;
    const float* ct = (const float*)(a.ws + WS_ROPE); const float* st = ct + SEQ * 16;
    for (int r = gw; r < T; r += NGW) {
        const bf16* p = P + (size_t)r * HYB_INP;
        {
            const unsigned* p32 = (const unsigned*)(p + lane * 6); const unsigned w0 = p32[0], w1 = p32[1], w2 = p32[2];
            float f[6] = {bflo(w0), bfhi(w0), bflo(w1), bfhi(w1), bflo(w2), bfhi(w2)}; float ss = 0.f;
#pragma unroll
            for (int j = 0; j < 6; ++j) ss += f[j] * f[j];
            const float rs = rsqrtf(wave_sum(ss, lane) * (1.f / 384.f) + EPS);
#pragma unroll
            for (int j = 0; j < 6; ++j) f[j] = f[j] * rs * qn[lane * 6 + j];
            unsigned* o32 = (unsigned*)(CQN + (size_t)r * 384 + lane * 6); o32[0] = pk2(f[0], f[1]); o32[1] = pk2(f[2], f[3]); o32[2] = pk2(f[4], f[5]);
        }
        {
            const v2u w = *(const v2u*)(p + 384 + lane * 4); float f[4] = {bflo(w.x), bfhi(w.x), bflo(w.y), bfhi(w.y)};
            const float ss = (f[0] * f[0] + f[1] * f[1]) + (f[2] * f[2] + f[3] * f[3]);
            const float rs = rsqrtf(wave_sum(ss, lane) * (1.f / 256.f) + EPS);
            const f32x4 g = *(const f32x4*)(kvn + lane * 4);
            v2u o; o.x = pk2(f[0] * rs * g[0], f[1] * rs * g[1]); o.y = pk2(f[2] * rs * g[2], f[3] * rs * g[3]); *(v2u*)(CKVN + (size_t)r * 256 + lane * 4) = o;
        }
        {
            const int j = lane & 31; const float v = bf1(p[640 + j]); const float o = shx(v, 16, lane); float res = v;
            if (r < TL) { const int t = r & (SEQ - 1); const float c = ct[t * 16 + (j & 15)], s = st[t * 16 + (j & 15)]; res = (j < 16) ? v * c - o * s : o * s + v * c; }
            if (lane < 32) KR[(size_t)r * 32 + j] = (bf16)f2bf(res);
        }
        {
            const int c0 = lane * 8; float gb[8], cur[8], acc[8], t0[8], t1[8];
            unpack8(*(const v4u*)(p + 672 + c0), gb);
            unpack8(*(const v4u*)(p + 1184 + c0), t0); unpack8(*(const v4u*)(p + 1696 + c0), t1);
#pragma unroll
            for (int j = 0; j < 8; ++j) { cur[j] = t0[j] * t1[j]; acc[j] = cw[512 + c0 + j] * cur[j]; }
            if (has_prev(r)) { unpack8(*(const v4u*)(p - HYB_INP + 1184 + c0), t0); unpack8(*(const v4u*)(p - HYB_INP + 1696 + c0), t1);
#pragma unroll
                for (int j = 0; j < 8; ++j) acc[j] += cw[c0 + j] * (t0[j] * t1[j]); }
            if (has_next(r)) { unpack8(*(const v4u*)(p + HYB_INP + 1184 + c0), t0); unpack8(*(const v4u*)(p + HYB_INP + 1696 + c0), t1);
#pragma unroll
                for (int j = 0; j < 8; ++j) acc[j] += cw[1024 + c0 + j] * (t0[j] * t1[j]); }
#pragma unroll
            for (int j = 0; j < 8; ++j) acc[j] *= gb[j];
            *(v4u*)(MIX + (size_t)r * D + 512 + c0) = pack8(acc);
        }
    }
}

__device__ __forceinline__ void convgate(const Args& a, int l, int nrows) {
    const bf16* U = (const bf16*)(a.ws + WS_U); bf16* G = (bf16*)(a.ws + WS_G); const float* cw = a.in[I_FCONV] + (size_t)l * 3 * UPW;
    const int total = nrows * (DFF / 8);
    for (int idx = blockIdx.x * NTHR + otid(a.wv); idx < total; idx += gridDim.x * NTHR) {
        const int r = idx / (DFF / 8), c0 = (idx % (DFF / 8)) * 8; const bf16* u = U + (size_t)r * UPW + c0;
        float ua[8], ug[8], act[8], gate[8];
        unpack8(*(const v4u*)u, ua); unpack8(*(const v4u*)(u + DFF), ug);
#pragma unroll
        for (int j = 0; j < 8; ++j) { act[j] = cw[UPW + c0 + j] * ua[j]; gate[j] = cw[UPW + DFF + c0 + j] * ug[j]; }
        if (has_prev(r)) { unpack8(*(const v4u*)(u - UPW), ua); unpack8(*(const v4u*)(u - UPW + DFF), ug);
#pragma unroll
            for (int j = 0; j < 8; ++j) { act[j] += cw[c0 + j] * ua[j]; gate[j] += cw[DFF + c0 + j] * ug[j]; } }
        if (has_next(r)) { unpack8(*(const v4u*)(u + UPW), ua); unpack8(*(const v4u*)(u + UPW + DFF), ug);
#pragma unroll
            for (int j = 0; j < 8; ++j) { act[j] += cw[2 * UPW + c0 + j] * ua[j]; gate[j] += cw[2 * UPW + DFF + c0 + j] * ug[j]; } }
#pragma unroll
        for (int j = 0; j < 8; ++j) act[j] = silu_f(act[j]) * gate[j];
        *(v4u*)(G + (size_t)r * DFF + c0) = pack8(act);
    }
}

__device__ __forceinline__ void ssd_conv(const Args& a, int i) {
    const bf16* ZX = (const bf16*)(a.ws + WS_ZX); bf16* XBC = (bf16*)(a.ws + WS_XBC); float* DT = (float*)(a.ws + WS_DT); float* AA = (float*)(a.ws + WS_AA);
    const float* cw = a.in[I_SCONVW] + (size_t)i * 3 * 3072; const float* cb = a.in[I_SCONVB] + (size_t)i * 3072;
    const int total = T * 384;
    for (int idx = blockIdx.x * NTHR + otid(a.wv); idx < total; idx += gridDim.x * NTHR) {
        const int r = idx / 384, c0 = (idx % 384) * 8; const bf16* u = ZX + (size_t)r * SSD_INP + 2048 + c0;
        float x[8], acc[8];
        unpack8(*(const v4u*)u, x);
#pragma unroll
        for (int j = 0; j < 8; ++j) acc[j] = cb[c0 + j] + cw[3072 + c0 + j] * x[j];
        if (has_prev(r)) { unpack8(*(const v4u*)(u - SSD_INP), x);
#pragma unroll
            for (int j = 0; j < 8; ++j) acc[j] += cw[c0 + j] * x[j]; }
        if (has_next(r)) { unpack8(*(const v4u*)(u + SSD_INP), x);
#pragma unroll
            for (int j = 0; j < 8; ++j) acc[j] += cw[2 * 3072 + c0 + j] * x[j]; }
#pragma unroll
        for (int j = 0; j < 8; ++j) acc[j] = silu_f(acc[j]);
        *(v4u*)(XBC + (size_t)r * 3072 + c0) = pack8(acc);
    }
    const float* alog = a.in[I_ALOG] + i * 64; const float* dtb = a.in[I_DTB] + i * 64;
    for (int idx = blockIdx.x * NTHR + otid(a.wv); idx < T * 64; idx += gridDim.x * NTHR) {
        const int r = idx >> 6, j = idx & 63; const float raw = bf1(ZX[(size_t)r * SSD_INP + 5120 + j]) + dtb[j];
        const float dt = raw > 15.f ? raw : (raw < -15.f ? __expf(raw) : __logf(1.f + __expf(raw)));
        DT[idx] = dt; AA[idx] = -__expf(alog[j]) * dt;
    }
}

__device__ __forceinline__ void gatenorm(const Args& a, int i, int nrows) {
    const int wave = otid(a.wv) >> 6, lane = otid(a.wv) & 63; const int NGW = gridDim.x * NWAVES, gw = blockIdx.x * NWAVES + wave;
    const bf16* ZX = (const bf16*)(a.ws + WS_ZX); bf16* YN = (bf16*)(a.ws + WS_XBC); const float* nw = a.in[I_SNORM] + i * 2048;
    for (int r = gw; r < nrows; r += NGW) {
        float v[4][8]; float ss = 0.f;
#pragma unroll
        for (int j = 0; j < 4; ++j) { float y[8], z[8]; const int c = j * 512 + lane * 8;
            unpack8(*(const v4u*)(ZX + (size_t)r * SSD_INP + 2048 + c), y); unpack8(*(const v4u*)(ZX + (size_t)r * SSD_INP + c), z);
#pragma unroll
            for (int k = 0; k < 8; ++k) { v[j][k] = y[k] * silu_f(z[k]); ss += v[j][k] * v[j][k]; } }
        const float rs = rsqrtf(wave_sum(ss, lane) * (1.f / 2048.f) + EPS);
#pragma unroll
        for (int j = 0; j < 4; ++j) { const int c = j * 512 + lane * 8; float o[8];
#pragma unroll
            for (int k = 0; k < 8; ++k) o[k] = v[j][k] * rs * nw[c + k];
            *(v4u*)(YN + (size_t)r * 2048 + c) = pack8(o); }
    }
}

__device__ __forceinline__ void attn_naive(const Args& a, LAS unsigned char* lds) {
    const int tid = otid(a.wv), qi = tid >> 1, half = tid & 1;
    const bf16* Qb = (const bf16*)(a.ws + WS_Q); const bf16* KVb = (const bf16*)(a.ws + WS_KV); const bf16* KR = (const bf16*)(a.ws + WS_KR); bf16* MIX = (bf16*)(a.ws + WS_MIX);
    const float* ct = (const float*)(a.ws + WS_ROPE); const float* st = ct + SEQ * 16;
    LAS float* Kt = (LAS float*)lds;
    LAS float* Vt = (LAS float*)(lds + 64 * 96 * 4);
    for (int u = blockIdx.x; u < 576; u += gridDim.x) {
        const bool lat = u < 512; const int b = lat ? (u >> 6) : ((u - 512) >> 3), h = lat ? ((u >> 3) & 7) : ((u - 512) & 7);
        const int nkeys = lat ? (CTXL + SEQ) : CTXL;
        const int qrow = lat ? b * SEQ + (u & 7) * 256 + qi : TL + b * CTXL + qi;
        float q[48];
#pragma unroll
        for (int g = 0; g < 6; ++g) { float f[8]; unpack8(*(const v4u*)(Qb + (size_t)qrow * QW + h * 96 + half * 48 + g * 8), f);
#pragma unroll
            for (int j = 0; j < 8; ++j) q[g * 8 + j] = f[j]; }
        if (lat && half == 1) { const int t = qrow & (SEQ - 1);
#pragma unroll
            for (int j = 0; j < 16; ++j) { const float c = ct[t * 16 + j], s = st[t * 16 + j]; const float x1 = q[16 + j], x2 = q[32 + j]; q[16 + j] = x1 * c - x2 * s; q[32 + j] = x1 * s + x2 * c; } }
#pragma unroll
        for (int j = 0; j < 48; ++j) q[j] *= ATT_SCALE_LOG2E;
        float o[32]; float m = -1e30f, l = 0.f;
#pragma unroll
        for (int j = 0; j < 32; ++j) o[j] = 0.f;
        for (int k0 = 0; k0 < nkeys; k0 += 64) {
            __syncthreads();
            for (int g = tid; g < 768; g += NTHR) { const int key = g / 12, part = g % 12; const int kk = k0 + key; const int krow = kk < CTXL ? TL + b * CTXL + kk : b * SEQ + kk - CTXL;
                float f[8]; unpack8(part < 8 ? *(const v4u*)(KVb + (size_t)krow * KVW + h * 128 + part * 8) : *(const v4u*)(KR + (size_t)krow * 32 + (part - 8) * 8), f);
#pragma unroll
                for (int j = 0; j < 8; ++j) Kt[key * 96 + part * 8 + j] = f[j]; }
            { const int key = tid >> 3, part = tid & 7; const int kk = k0 + key; const int krow = kk < CTXL ? TL + b * CTXL + kk : b * SEQ + kk - CTXL;
                float f[8]; unpack8(*(const v4u*)(KVb + (size_t)krow * KVW + h * 128 + 64 + part * 8), f);
#pragma unroll
                for (int j = 0; j < 8; ++j) Vt[key * 64 + part * 8 + j] = f[j]; }
            __syncthreads();
            for (int kg = 0; kg < 64; kg += 8) {
                float s[8]; float gm = -1e30f;
#pragma unroll
                for (int kk = 0; kk < 8; ++kk) { float acc = 0.f; const LAS f32x4* kp = (const LAS f32x4*)(Kt + (kg + kk) * 96 + half * 48);
#pragma unroll
                    for (int d4 = 0; d4 < 12; ++d4) { const f32x4 kv = kp[d4]; acc += q[d4 * 4] * kv[0] + q[d4 * 4 + 1] * kv[1] + q[d4 * 4 + 2] * kv[2] + q[d4 * 4 + 3] * kv[3]; }
                    acc += shx(acc, 1, tid & 63);
                    s[kk] = acc; gm = fmaxf(gm, acc); }
                const float mn = fmaxf(m, gm); const float alpha = exp2f(m - mn); m = mn; l *= alpha;
#pragma unroll
                for (int j = 0; j < 32; ++j) o[j] *= alpha;
#pragma unroll
                for (int kk = 0; kk < 8; ++kk) { const float p = exp2f(s[kk] - mn); l += p; const LAS f32x4* vp = (const LAS f32x4*)(Vt + (kg + kk) * 64 + half * 32);
#pragma unroll
                    for (int d4 = 0; d4 < 8; ++d4) { const f32x4 vv = vp[d4]; o[d4 * 4] += p * vv[0]; o[d4 * 4 + 1] += p * vv[1]; o[d4 * 4 + 2] += p * vv[2]; o[d4 * 4 + 3] += p * vv[3]; } }
            }
        }
        { const float inv = 1.f / l;
#pragma unroll
            for (int g = 0; g < 4; ++g) { float f[8];
#pragma unroll
                for (int j = 0; j < 8; ++j) f[j] = o[g * 8 + j] * inv;
                *(v4u*)(MIX + (size_t)qrow * D + h * 64 + half * 32 + g * 8) = pack8(f); } }
    }
}

__device__ __forceinline__ void ssd_scan_naive(const Args& a, int i, bool last, LAS unsigned char* lds) {
    const int tid = otid(a.wv), p = tid >> 3, nq = tid & 7;
    bf16* ZX = (bf16*)(a.ws + WS_ZX); const bf16* XBC = (const bf16*)(a.ws + WS_XBC); const float* DT = (const float*)(a.ws + WS_DT); const float* AA = (const float*)(a.ws + WS_AA);
    LAS float* xs = (LAS float*)lds;
    LAS float* Bs = (LAS float*)(lds + 16384);
    LAS float* Cs = (LAS float*)(lds + 16384 + 32768);
    LAS float* dts = (LAS float*)(lds + 16384 + 65536);
    LAS float* as = dts + 64;
    for (int it = blockIdx.x; it < NB * 32; it += gridDim.x) {
        const int b = it >> 5, h = it & 31, g = h >> 3; const float dsk = a.in[I_SD][i * 32 + h];
        for (int dir = 0; dir < 2; ++dir) {
            float stt[16];
#pragma unroll
            for (int n = 0; n < 16; ++n) stt[n] = 0.f;
            for (int seg = 0; seg < 2; ++seg) {
                const int len = seg == 0 ? CTXL : SEQ; const int base = seg == 0 ? TL + b * CTXL : b * SEQ; const bool want_y = !(last && seg == 0);
                for (int cc = 0; cc < len / 64; ++cc) {
                    const int t0 = dir == 0 ? cc * 64 : len - 64 - cc * 64;
                    __syncthreads();
                    { const int tt = tid >> 3, part = tid & 7; float f[8]; unpack8(*(const v4u*)(XBC + (size_t)(base + t0 + tt) * 3072 + h * 64 + part * 8), f);
#pragma unroll
                        for (int j = 0; j < 8; ++j) xs[tt * 64 + part * 8 + j] = f[j]; }
                    for (int q = tid; q < 1024; q += NTHR) { const int tt = q >> 4, part = q & 15; float f[8];
                        unpack8(*(const v4u*)(XBC + (size_t)(base + t0 + tt) * 3072 + 2048 + g * 128 + part * 8), f);
#pragma unroll
                        for (int j = 0; j < 8; ++j) Bs[tt * 128 + part * 8 + j] = f[j];
                        unpack8(*(const v4u*)(XBC + (size_t)(base + t0 + tt) * 3072 + 2560 + g * 128 + part * 8), f);
#pragma unroll
                        for (int j = 0; j < 8; ++j) Cs[tt * 128 + part * 8 + j] = f[j]; }
                    if (tid < 64) { dts[tid] = DT[(size_t)(base + t0 + tid) * 64 + dir * 32 + h]; as[tid] = AA[(size_t)(base + t0 + tid) * 64 + dir * 32 + h]; }
                    __syncthreads();
                    for (int s = 0; s < 64; ++s) {
                        const int tt = dir == 0 ? s : 63 - s;
                        const float dec = __expf(as[tt]); const float xv = xs[tt * 64 + p]; const float xd = xv * dts[tt];
                        const LAS f32x4* bp = (const LAS f32x4*)(Bs + tt * 128 + nq * 16); const LAS f32x4* cp = (const LAS f32x4*)(Cs + tt * 128 + nq * 16);
                        float acc = 0.f;
#pragma unroll
                        for (int n4 = 0; n4 < 4; ++n4) { const f32x4 bv = bp[n4], cv = cp[n4];
#pragma unroll
                            for (int k = 0; k < 4; ++k) { stt[n4 * 4 + k] = dec * stt[n4 * 4 + k] + xd * bv[k]; acc += cv[k] * stt[n4 * 4 + k]; } }
                        acc += shx(acc, 1, tid & 63); acc += shx(acc, 2, tid & 63); acc += shx(acc, 4, tid & 63);
                        if (want_y && nq == 0) { bf16* yp = ZX + (size_t)(base + t0 + tt) * SSD_INP + 2048 + h * 64 + p;
                            const float y = dir == 0 ? acc + dsk * xv : acc + bf1(*yp);
                            *yp = (bf16)f2bf(y); }
                    }
                }
            }
            __syncthreads();
            asm volatile("s_waitcnt vmcnt(0)" ::: "memory");
        }
    }
}

typedef short bf16x8 __attribute__((ext_vector_type(8)));
typedef float f32x16 __attribute__((ext_vector_type(16)));
typedef short v4i16_t __attribute__((ext_vector_type(4)));
__device__ __forceinline__ v2u trread(const LAS unsigned char* p) { return __builtin_bit_cast(v2u, __builtin_amdgcn_ds_read_tr16_b64_v4i16((LAS v4i16_t*)p)); }
__device__ __forceinline__ unsigned cvtpk(float lo, float hi) { unsigned r; asm volatile("v_cvt_pk_bf16_f32 %0, %1, %2" : "=v"(r) : "v"(lo), "v"(hi)); return r; }
constexpr int ATT_KP = 208, ATT_VP = 192, ATT_KB = 64 * ATT_KP, ATT_VB = 64 * ATT_VP, ATT_BUF = ATT_KB + ATT_VB;
#ifndef ATT_NQ
#define ATT_NQ 2
#endif
template <int NQ>
__device__ __forceinline__ void attn_unit3(const Args& a, LAS unsigned char* lds, const int b, const int h, const int q0, const int ntiles, const bool lat) {
    const int tid = otid(a.wv), wave = a.wv, lane = tid & 63, r32 = lane & 31, hh = lane >> 5;
    const int tq = (lane >> 2) & 3, tp = lane & 3, tblk = (lane >> 4) & 1;
    const bf16* Qb = (const bf16*)(a.ws + WS_Q); const bf16* KVb = (const bf16*)(a.ws + WS_KV); const bf16* KR = (const bf16*)(a.ws + WS_KR); bf16* MIX = (bf16*)(a.ws + WS_MIX);
    const float* ct = (const float*)(a.ws + WS_ROPE); const float* st = ct + SEQ * 16;
    bf16x8 qf[NQ][6];
#pragma unroll
    for (int nq = 0; nq < NQ; ++nq) { const int qrow = q0 + wave * (32 * NQ) + nq * 32 + r32;
#pragma unroll
        for (int s = 0; s < 6; ++s) qf[nq][s] = *(const bf16x8*)(Qb + (size_t)qrow * QW + h * 96 + 16 * s + 8 * hh);
        if (lat) { const int t = qrow & (SEQ - 1);
#pragma unroll
            for (int j = 0; j < 8; j += 2) { float x1[2], x2[2], y1[2], y2[2];
#pragma unroll
                for (int e = 0; e < 2; ++e) { x1[e] = bf1((bf16)qf[nq][4][j + e]); x2[e] = bf1((bf16)qf[nq][5][j + e]); const float c = ct[t * 16 + 8 * hh + j + e], s = st[t * 16 + 8 * hh + j + e];
                    y1[e] = x1[e] * c - x2[e] * s; y2[e] = x1[e] * s + x2[e] * c; }
                const unsigned w1 = pk2(y1[0], y1[1]), w2 = pk2(y2[0], y2[1]);
                qf[nq][4][j] = (short)(w1 & 0xffff); qf[nq][4][j + 1] = (short)(w1 >> 16); qf[nq][5][j] = (short)(w2 & 0xffff); qf[nq][5][j + 1] = (short)(w2 >> 16); } } }
    f32x16 o0[NQ], o1[NQ]; float m[NQ], l[NQ];
#pragma unroll
    for (int nq = 0; nq < NQ; ++nq) { m[nq] = -1e30f; l[nq] = 0.f;
#pragma unroll
        for (int i = 0; i < 16; ++i) { o0[nq][i] = 0.f; o1[nq][i] = 0.f; } }
    v4u kreg0, kreg1, vreg;
#define ATT_LOAD(it) do { const int rb_ = (it) < CTXL / 64 ? TL + b * CTXL + (it) * 64 : b * SEQ + ((it) - CTXL / 64) * 64; \
        const char* kvb_ = (const char*)(KVb + (size_t)rb_ * KVW); const char* krb_ = (const char*)(KR + (size_t)rb_ * 32); \
        kreg0 = *(const v4u*)(kvb_ + (tid >> 3) * 2048 + h * 256 + (tid & 7) * 16); if (tid < 256) kreg1 = *(const v4u*)(krb_ + (tid >> 2) * 64 + (tid & 3) * 16); vreg = *(const v4u*)(kvb_ + (tid >> 3) * 2048 + h * 256 + 128 + (tid & 7) * 16); } while (0)
#define ATT_WRITE(buf) do { LAS unsigned char* kb_ = lds + (buf) * ATT_BUF; LAS unsigned char* vb_ = kb_ + ATT_KB; \
        *(LAS v4u*)(kb_ + (tid >> 3) * ATT_KP + (tid & 7) * 16) = kreg0; if (tid < 256) *(LAS v4u*)(kb_ + (tid >> 2) * ATT_KP + 128 + (tid & 3) * 16) = kreg1; \
        *(LAS v4u*)(vb_ + (tid >> 3) * ATT_VP + (tid & 7) * 16) = vreg; } while (0)
    __syncthreads();
    ATT_LOAD(0); ATT_WRITE(0);
    __syncthreads();
    for (int it = 0; it < ntiles; ++it) {
#ifndef ATT_LOADMID
        if (it + 1 < ntiles) ATT_LOAD(it + 1);
#endif
#ifdef ATT_TZ
        int tz = tid; asm volatile("" : "+v"(tz));
        const int lane = tz & 63, r32 = lane & 31, hh = lane >> 5, tq = (lane >> 2) & 3, tp = lane & 3, tblk = (lane >> 4) & 1;
#endif
        const LAS unsigned char* kb = lds + (it & 1) * ATT_BUF; const LAS unsigned char* vb = kb + ATT_KB;
#pragma unroll
        for (int t = 0; t < 2; ++t) {
            f32x16 sc[NQ]; bf16x8 pf[NQ][2];
#pragma unroll
            for (int nq = 0; nq < NQ; ++nq)
#pragma unroll
                for (int i = 0; i < 16; ++i) sc[nq][i] = 0.f;
            bf16x8 kf[6];
#pragma unroll
            for (int s = 0; s < 6; ++s) kf[s] = *(const LAS bf16x8*)(kb + (32 * t + r32) * ATT_KP + (16 * s + 8 * hh) * 2);
            asm volatile("" : "+v"(kf[0]), "+v"(kf[1]), "+v"(kf[2]), "+v"(kf[3]), "+v"(kf[4]), "+v"(kf[5]));
#pragma unroll
            for (int s = 0; s < 6; ++s)
#pragma unroll
                for (int nq = 0; nq < NQ; ++nq) sc[nq] = __builtin_amdgcn_mfma_f32_32x32x16_bf16(kf[s], qf[nq][s], sc[nq], 0, 0, 0);
#ifdef ATT_LOADMID
            if (t == 0 && it + 1 < ntiles) ATT_LOAD(it + 1);
#endif
#pragma unroll
            for (int nq = 0; nq < NQ; ++nq) {
                float mx = sc[nq][0];
#pragma unroll
                for (int i = 1; i < 16; ++i) mx = fmaxf(mx, sc[nq][i]);
                mx = fmaxf(mx, shx(mx, 32, lane));
                const float mn = fmaxf(m[nq], mx * ATT_SCALE_LOG2E); const float alpha = __builtin_amdgcn_exp2f(m[nq] - mn); m[nq] = mn;
                float rs = 0.f;
#pragma unroll
                for (int i = 0; i < 16; ++i) { sc[nq][i] = __builtin_amdgcn_exp2f(sc[nq][i] * ATT_SCALE_LOG2E - mn); rs += sc[nq][i]; }
                l[nq] = l[nq] * alpha + rs;
#pragma unroll
                for (int i = 0; i < 16; ++i) { o0[nq][i] *= alpha; o1[nq][i] *= alpha; }
#pragma unroll
                for (int s2 = 0; s2 < 2; ++s2) { v4u w0;
                    w0.x = cvtpk(sc[nq][8 * s2 + 0], sc[nq][8 * s2 + 1]); w0.y = cvtpk(sc[nq][8 * s2 + 2], sc[nq][8 * s2 + 3]); w0.z = cvtpk(sc[nq][8 * s2 + 4], sc[nq][8 * s2 + 5]); w0.w = cvtpk(sc[nq][8 * s2 + 6], sc[nq][8 * s2 + 7]);
                    pf[nq][s2] = __builtin_bit_cast(bf16x8, w0); }
            }
#pragma unroll
            for (int s2 = 0; s2 < 2; ++s2) { const int ko = t * 32 + 16 * s2 + 4 * hh;
                { const LAS unsigned char* tb = vb + (ko + tq) * ATT_VP + (16 * tblk + 4 * tp) * 2; const v2u lo = trread(tb), hi = trread(tb + 8 * ATT_VP); const bf16x8 vf = __builtin_bit_cast(bf16x8, (v4u){lo.x, lo.y, hi.x, hi.y});
#pragma unroll
                  for (int nq = 0; nq < NQ; ++nq) o0[nq] = __builtin_amdgcn_mfma_f32_32x32x16_bf16(vf, pf[nq][s2], o0[nq], 0, 0, 0); }
                { const LAS unsigned char* tb = vb + (ko + tq) * ATT_VP + (32 + 16 * tblk + 4 * tp) * 2; const v2u lo = trread(tb), hi = trread(tb + 8 * ATT_VP); const bf16x8 vf = __builtin_bit_cast(bf16x8, (v4u){lo.x, lo.y, hi.x, hi.y});
#pragma unroll
                  for (int nq = 0; nq < NQ; ++nq) o1[nq] = __builtin_amdgcn_mfma_f32_32x32x16_bf16(vf, pf[nq][s2], o1[nq], 0, 0, 0); } }
        }
        if (it + 1 < ntiles) ATT_WRITE((it + 1) & 1);
        __syncthreads();
    }
#undef ATT_LOAD
#undef ATT_WRITE
#pragma unroll
    for (int nq = 0; nq < NQ; ++nq) { const int qrow = q0 + wave * (32 * NQ) + nq * 32 + r32;
        const float lsum = l[nq] + shx(l[nq], 32, lane); const float inv = 1.f / lsum;
        bf16* orow = MIX + (size_t)qrow * D + h * 64 + 4 * hh;
#pragma unroll
        for (int g = 0; g < 4; ++g) {
            v2u w; w.x = pk2(o0[nq][4 * g] * inv, o0[nq][4 * g + 1] * inv); w.y = pk2(o0[nq][4 * g + 2] * inv, o0[nq][4 * g + 3] * inv); *(v2u*)(orow + 8 * g) = w;
            v2u x; x.x = pk2(o1[nq][4 * g] * inv, o1[nq][4 * g + 1] * inv); x.y = pk2(o1[nq][4 * g + 2] * inv, o1[nq][4 * g + 3] * inv); *(v2u*)(orow + 32 + 8 * g) = x; } }
}
__device__ __forceinline__ void attn_mfma(const Args& a, LAS unsigned char* lds) {
#if ATT_NQ == 2
    for (int u = blockIdx.x; u < 256; u += gridDim.x) attn_unit3<2>(a, lds, u >> 5, (u >> 2) & 7, (u >> 5) * SEQ + (u & 3) * 512, (CTXL + SEQ) / 64, true);
#else
    for (int u = blockIdx.x; u < 512; u += gridDim.x) attn_unit3<1>(a, lds, u >> 6, (u >> 3) & 7, (u >> 6) * SEQ + (u & 7) * 256, (CTXL + SEQ) / 64, true);
#endif
    for (int u = blockIdx.x; u < 64; u += gridDim.x) attn_unit3<1>(a, lds, u >> 3, u & 7, TL + (u >> 3) * CTXL, CTXL / 64, false);
}

#ifndef SSD_YREP
#define SSD_YREP 1
#endif
#ifndef SSD_WREP
#define SSD_WREP 1
#endif
constexpr int SP_B = 272, SP_X = 192;
constexpr int SO_B = 0, SO_C = SO_B + 128 * SP_B, SO_XD = SO_C + 128 * SP_B, SO_XW = SO_XD + 128 * SP_X, SO_S = SO_XW + 128 * SP_X, SO_V = SO_S + 64 * SP_B;
static_assert(SO_V + 2 * 2048 <= LDS_BYTES, "ssd lds map");
#ifdef SSD_DIAG
#define SSD_T(v) long long v = clock64()
#define SSD_ACC(k, v) do { const long long n_ = clock64(); dacc[k] += n_ - v; v = n_; } while (0)
#else
#define SSD_T(v) do {} while (0)
#define SSD_ACC(k, v) do {} while (0)
#endif
__device__ __forceinline__ void ssd_scan_mfma(const Args& a, int i, bool last, LAS unsigned char* lds) {
#ifdef SSD_DIAG
    long long dacc[12] = {0, 0, 0, 0, 0, 0, 0, 0, 0, 0, 0, 0};
#endif
    const int tid = otid(a.wv), wave = a.wv, lane = tid & 63, r32 = lane & 31, hh = lane >> 5;
    const int pt = wave >> 2, lt = pt ? 3 - (wave & 3) : (wave & 3);
    const int tq = (lane >> 2) & 3, tp = lane & 3, tblk = (lane >> 4) & 1;
    bf16* ZX = (bf16*)(a.ws + WS_ZX); const bf16* XBC = (const bf16*)(a.ws + WS_XBC); const float* DT = (const float*)(a.ws + WS_DT); const float* AA = (const float*)(a.ws + WS_AA);
    LAS unsigned char* Bl = lds + SO_B; LAS unsigned char* Cl = lds + SO_C; LAS unsigned char* XDl = lds + SO_XD; LAS unsigned char* XWl = lds + SO_XW; LAS unsigned char* Sl = lds + SO_S;
    const int brow = tid >> 4, bpart = tid & 15, xrow = tid >> 3, xpart = tid & 7;
    for (int it = blockIdx.x; it < NB * 32; it += gridDim.x) {
        const int b = it >> 5, h = it & 31, g = h >> 3; const float dsk = a.in[I_SD][i * 32 + h];
        for (int dir = 0; dir < 2; ++dir) {
            const int scanw = dir == 0 ? 0 : 3;
            f32x16 sacc;
#pragma unroll
            for (int k = 0; k < 16; ++k) sacc[k] = 0.f;
            SSD_T(tprev);
            v4u bq[4], cq[4], xq[2]; float pa0 = 0.f, pa1 = 0.f, pd0 = 0.f, pd1 = 0.f, qa0 = 0.f, qa1 = 0.f, qd0 = 0.f, qd1 = 0.f; v2u add[4];
#define SSD_ROWBASE(c) ((c) < 2 ? TL + b * CTXL + (dir == 0 ? (c) : 1 - (c)) * 128 : b * SEQ + (dir == 0 ? (c) - 2 : 17 - (c)) * 128)
#define SSD_PFB(c) do { const int rb_ = SSD_ROWBASE(c); _Pragma("unroll") for (int k_ = 0; k_ < 4; ++k_) bq[k_] = *(const v4u*)(XBC + (size_t)(rb_ + brow + 32 * k_) * 3072 + 2048 + g * 128 + bpart * 8); } while (0)
#define SSD_PFC(c) do { const int rb_ = SSD_ROWBASE(c); _Pragma("unroll") for (int k_ = 0; k_ < 4; ++k_) cq[k_] = *(const v4u*)(XBC + (size_t)(rb_ + brow + 32 * k_) * 3072 + 2560 + g * 128 + bpart * 8); } while (0)
#define SSD_PFX(c) do { const int rb_ = SSD_ROWBASE(c); _Pragma("unroll") for (int k_ = 0; k_ < 2; ++k_) xq[k_] = *(const v4u*)(XBC + (size_t)(rb_ + xrow + 64 * k_) * 3072 + h * 64 + xpart * 8); } while (0)
#define SSD_PF(c) do { SSD_PFB(c); SSD_PFC(c); SSD_PFX(c); } while (0)
#define SSD_PFV(c) do { if (wave == scanw) { const int rb_ = SSD_ROWBASE(c); const size_t o_ = (size_t)(rb_ + 2 * lane) * 64 + dir * 32 + h; qa0 = AA[o_]; qa1 = AA[o_ + 64]; qd0 = DT[o_]; qd1 = DT[o_ + 64]; } } while (0)
#define SSD_PFY(c) do { const int rb_ = SSD_ROWBASE(c); const size_t r_ = (size_t)(rb_ + 32 * lt + r32); \
                _Pragma("unroll") for (int q_ = 0; q_ < 4; ++q_) add[q_] = dir == 0 ? *(const v2u*)(XBC + r_ * 3072 + h * 64 + 32 * pt + 4 * hh + 8 * q_) : *(const v2u*)(ZX + r_ * SSD_INP + 2048 + h * 64 + 32 * pt + 4 * hh + 8 * q_); } while (0)
#define SSD_SCAN(vb_) do { if (wave == scanw) { LAS float* V_ = (LAS float*)(lds + SO_V + (vb_) * 2048); const float pair_ = pa0 + pa1; float ps_ = pair_; \
                _Pragma("unroll") for (int d_ = 1; d_ < 64; d_ <<= 1) { const int src_ = dir == 0 ? lane - d_ : lane + d_; const float t_ = __builtin_bit_cast(float, __builtin_amdgcn_ds_bpermute((src_ & 63) << 2, __builtin_bit_cast(int, ps_))); if (src_ >= 0 && src_ < 64) ps_ += t_; } \
                const float tot_ = __builtin_bit_cast(float, __builtin_amdgcn_ds_bpermute((dir == 0 ? 63 : 0) << 2, __builtin_bit_cast(int, ps_))); const float ex_ = ps_ - pair_; \
                float c0_, c1_; if (dir == 0) { c0_ = ex_ + pa0; c1_ = c0_ + pa1; } else { c1_ = ex_ + pa1; c0_ = c1_ + pa0; } \
                V_[2 * lane] = c0_; V_[2 * lane + 1] = c1_; V_[128 + 2 * lane] = pd0; V_[128 + 2 * lane + 1] = pd1; V_[256 + 2 * lane] = pd0 * __expf(tot_ - c0_); V_[256 + 2 * lane + 1] = pd1 * __expf(tot_ - c1_); \
                if (lane == 0) V_[384] = tot_; } } while (0)
#define SSD_WRITE(vb_) do { const LAS float* V_ = (const LAS float*)(lds + SO_V + (vb_) * 2048); \
                _Pragma("unroll") for (int k_ = 0; k_ < 4; ++k_) { *(LAS v4u*)(Bl + (brow + 32 * k_) * SP_B + bpart * 16) = bq[k_]; *(LAS v4u*)(Cl + (brow + 32 * k_) * SP_B + bpart * 16) = cq[k_]; } \
                _Pragma("unroll") for (int k_ = 0; k_ < 2; ++k_) { const int s_ = xrow + 64 * k_; const float dt_ = V_[128 + s_], w_ = V_[256 + s_]; float f_[8], g_[8]; unpack8(xq[k_], f_); \
                    _Pragma("unroll") for (int j_ = 0; j_ < 8; ++j_) { g_[j_] = f_[j_] * w_; f_[j_] *= dt_; } \
                    *(LAS v4u*)(XDl + s_ * SP_X + xpart * 16) = pack8(f_); *(LAS v4u*)(XWl + s_ * SP_X + xpart * 16) = pack8(g_); } } while (0)
            __syncthreads();
            SSD_PFV(0); pa0 = qa0; pa1 = qa1; pd0 = qd0; pd1 = qd1; SSD_PFV(1); SSD_PFY(0); SSD_PF(0);
            { const float t0_ = qa0, t1_ = qa1, t2_ = qd0, t3_ = qd1; SSD_SCAN(0); pa0 = t0_; pa1 = t1_; pd0 = t2_; pd1 = t3_; }
            __syncthreads();
            SSD_WRITE(0);
            { LAS v2u* sp = (LAS v2u*)(Sl + (32 * pt + r32) * SP_B + (32 * lt + 4 * hh) * 2);
#pragma unroll
              for (int q = 0; q < 4; ++q) sp[2 * q] = (v2u){0u, 0u}; }
            __syncthreads();
            SSD_ACC(0, tprev);
            for (int c = 0; c < 18; ++c) {
                const int cur = c & 1; const LAS float* V = (const LAS float*)(lds + SO_V + cur * 2048);
                const int rowbase = SSD_ROWBASE(c); const bool want_y = !(last && c < 2);
                if (c > 0 && want_y) SSD_PFY(c);
                if (c + 1 < 18) { if (c + 2 < 18) SSD_PFV(c + 2); }
                SSD_ACC(1, tprev);
                for (int yrep = 0; yrep < SSD_YREP; ++yrep)
                if (!want_y && c + 1 < 18) { SSD_PFB(c + 1); SSD_PFC(c + 1); SSD_PFX(c + 1); }
                if (want_y) {
                    const int l = 32 * lt + r32; const float cl = V[l];
                    bf16* yptr = ZX + (size_t)(rowbase + l) * SSD_INP + 2048 + h * 64 + 32 * pt + 4 * hh;
                    bf16x8 cf[8];
#pragma unroll
                    for (int ks = 0; ks < 8; ++ks) cf[ks] = *(const LAS bf16x8*)(Cl + l * SP_B + (16 * ks + 8 * hh) * 2);
                    SSD_ACC(8, tprev);
                    f32x16 y1;
#pragma unroll
                    for (int k = 0; k < 16; ++k) y1[k] = 0.f;
#pragma unroll
                    for (int ks = 0; ks < 8; ++ks) { const bf16x8 sf = *(const LAS bf16x8*)(Sl + (32 * pt + r32) * SP_B + (16 * ks + 8 * hh) * 2); y1 = __builtin_amdgcn_mfma_f32_32x32x16_bf16(sf, cf[ks], y1, 0, 0, 0); }
                    { const float el = __expf(cl);
#pragma unroll
                      for (int k = 0; k < 16; ++k) y1[k] *= el; }
                    SSD_ACC(10, tprev);
                    const int st_lo = dir == 0 ? 0 : lt, st_hi = dir == 0 ? lt : 3;
#pragma unroll
                    for (int st = 0; st < 4; ++st) { if (c + 1 < 18) { if (st == 1) SSD_PFB(c + 1); if (st == 2) SSD_PFC(c + 1); if (st == 3) SSD_PFX(c + 1); }
                      if (st >= st_lo && st <= st_hi) {
                        f32x16 X;
#pragma unroll
                        for (int k = 0; k < 16; ++k) X[k] = 0.f;
#pragma unroll
                        for (int ks = 0; ks < 8; ++ks) { const bf16x8 af = *(const LAS bf16x8*)(Bl + (32 * st + r32) * SP_B + (16 * ks + 8 * hh) * 2); X = __builtin_amdgcn_mfma_f32_32x32x16_bf16(af, cf[ks], X, 0, 0, 0); }
                        if (st == lt) {
#pragma unroll
                            for (int q = 0; q < 4; ++q) { const f32x4 cs = *(const LAS f32x4*)(V + 32 * st + 8 * q + 4 * hh);
#pragma unroll
                                for (int e = 0; e < 4; ++e) { const int sl = 8 * q + 4 * hh + e; const bool ok = dir == 0 ? (sl <= r32) : (sl >= r32);
                                    X[4 * q + e] *= __expf(ok ? fminf(cl - cs[e], 0.f) : -1.0e30f); } }
                        } else {
#pragma unroll
                            for (int q = 0; q < 4; ++q) { const f32x4 cs = *(const LAS f32x4*)(V + 32 * st + 8 * q + 4 * hh);
#pragma unroll
                                for (int e = 0; e < 4; ++e) X[4 * q + e] *= __expf(fminf(cl - cs[e], 0.f)); }
                        }
#pragma unroll
                        for (int ks2 = 0; ks2 < 2; ++ks2) { v4u w; w.x = cvtpk(X[8 * ks2 + 0], X[8 * ks2 + 1]); w.y = cvtpk(X[8 * ks2 + 2], X[8 * ks2 + 3]); w.z = cvtpk(X[8 * ks2 + 4], X[8 * ks2 + 5]); w.w = cvtpk(X[8 * ks2 + 6], X[8 * ks2 + 7]);
                            const LAS unsigned char* tb = XDl + (32 * st + 16 * ks2 + 4 * hh + tq) * SP_X + (32 * pt + 16 * tblk + 4 * tp) * 2;
                            const v2u lo = trread(tb), hi = trread(tb + 8 * SP_X);
                            y1 = __builtin_amdgcn_mfma_f32_32x32x16_bf16(__builtin_bit_cast(bf16x8, (v4u){lo.x, lo.y, hi.x, hi.y}), __builtin_bit_cast(bf16x8, w), y1, 0, 0, 0); }
                    } }
                    asm volatile("" : "+v"(y1)); SSD_ACC(9, tprev);
#pragma unroll
                    for (int q = 0; q < 4; ++q) { float o[4];
#pragma unroll
                        for (int e = 0; e < 4; ++e) o[e] = y1[4 * q + e];
                        const float a0 = bflo(add[q].x), a1 = bfhi(add[q].x), a2 = bflo(add[q].y), a3 = bfhi(add[q].y);
                        if (dir == 0) { o[0] += dsk * a0; o[1] += dsk * a1; o[2] += dsk * a2; o[3] += dsk * a3; } else { o[0] += a0; o[1] += a1; o[2] += a2; o[3] += a3; }
                        v2u w; w.x = cvtpk(o[0], o[1]); w.y = cvtpk(o[2], o[3]); *(v2u*)(yptr + 8 * q) = w; }
                }
                SSD_ACC(2, tprev);
                if (c + 1 < 18) {
                    const float etot = __expf(V[384]);
#pragma unroll
                    for (int k = 0; k < 16; ++k) sacc[k] *= etot;
#pragma unroll
                    for (int kh = 0; kh < 2; ++kh) {
                        v2u alo[4], ahi[4], blo[4], bhi[4];
#pragma unroll
                        for (int k4 = 0; k4 < 4; ++k4) { const int ks = 4 * kh + k4;
                            const LAS unsigned char* ta = Bl + (16 * ks + 8 * hh + tq) * SP_B + (32 * lt + 16 * tblk + 4 * tp) * 2;
                            const LAS unsigned char* tb = XWl + (16 * ks + 8 * hh + tq) * SP_X + (32 * pt + 16 * tblk + 4 * tp) * 2;
                            alo[k4] = trread(ta); ahi[k4] = trread(ta + 4 * SP_B); blo[k4] = trread(tb); bhi[k4] = trread(tb + 4 * SP_X); }
                        asm volatile("" : "+v"(alo[0]), "+v"(alo[1]), "+v"(alo[2]), "+v"(alo[3]), "+v"(bhi[0]), "+v"(bhi[1]), "+v"(bhi[2]), "+v"(bhi[3]));
#pragma unroll
                        for (int k4 = 0; k4 < 4; ++k4)
                            sacc = __builtin_amdgcn_mfma_f32_32x32x16_bf16(__builtin_bit_cast(bf16x8, (v4u){alo[k4].x, alo[k4].y, ahi[k4].x, ahi[k4].y}), __builtin_bit_cast(bf16x8, (v4u){blo[k4].x, blo[k4].y, bhi[k4].x, bhi[k4].y}), sacc, 0, 0, 0); }
                    SSD_SCAN(cur ^ 1); pa0 = qa0; pa1 = qa1; pd0 = qd0; pd1 = qd1;
                }
                SSD_ACC(3, tprev);
                __syncthreads();
                SSD_ACC(4, tprev);
                if (c + 1 < 18) {
                    LAS v2u* sp = (LAS v2u*)(Sl + (32 * pt + r32) * SP_B + (32 * lt + 4 * hh) * 2);
#pragma unroll
                    for (int q = 0; q < 4; ++q) { v2u w; w.x = cvtpk(sacc[4 * q], sacc[4 * q + 1]); w.y = cvtpk(sacc[4 * q + 2], sacc[4 * q + 3]); sp[2 * q] = w; }
                    for (int wrep = 0; wrep < SSD_WREP; ++wrep) { SSD_WRITE(cur ^ 1); }
                }
                SSD_ACC(5, tprev);
                __syncthreads();
                SSD_ACC(6, tprev);
            }
#undef SSD_ROWBASE
#undef SSD_PF
#undef SSD_PFV
#undef SSD_PFY
#undef SSD_SCAN
#undef SSD_WRITE
            asm volatile("s_waitcnt vmcnt(0)" ::: "memory");
        }
    }
#ifdef SSD_DIAG
    if (blockIdx.x == 0 && wave == SSD_DIAG_WAVE && lane == 0 && i == 0) { float* dg = (float*)(a.ws + WS_MOD + 900 * 1024); long long tot = 0;
        for (int k = 0; k < 7; ++k) tot += dacc[k];
        tot += dacc[8] + dacc[9] + dacc[10];
        for (int k = 0; k < 12; ++k) dg[k] = (float)dacc[k]; dg[7] = (float)tot; }
#endif
}

constexpr int AT2_KP = 208, AT2_VP = 192, AT2_KB = 64 * AT2_KP, AT2_VB = 64 * AT2_VP, AT2_BUF = AT2_KB + AT2_VB;
template <int NQ>
__device__ __forceinline__ void attn_unit2(const Args& a, LAS unsigned char* lds, int b, int h, int q0, int ntiles, bool lat) {
    const int tid = otid(a.wv), wave = tid >> 6, lane = tid & 63, r32 = lane & 31, hh = lane >> 5;
    const int tq = (lane >> 2) & 3, tp = lane & 3, tblk = (lane >> 4) & 1;
    const bf16* Qb = (const bf16*)(a.ws + WS_Q); const bf16* KVb = (const bf16*)(a.ws + WS_KV); const bf16* KR = (const bf16*)(a.ws + WS_KR); bf16* MIX = (bf16*)(a.ws + WS_MIX);
    const float* ct = (const float*)(a.ws + WS_ROPE); const float* st = ct + SEQ * 16;
    bf16x8 qf[NQ][6];
#pragma unroll
    for (int nq = 0; nq < NQ; ++nq) { const int qrow = q0 + wave * (32 * NQ) + nq * 32 + r32;
#pragma unroll
        for (int s = 0; s < 6; ++s) qf[nq][s] = *(const bf16x8*)(Qb + (size_t)qrow * QW + h * 96 + 16 * s + 8 * hh);
        if (lat) { const int t = qrow & (SEQ - 1);
#pragma unroll
            for (int j = 0; j < 8; j += 2) { float y1[2], y2[2];
#pragma unroll
                for (int e = 0; e < 2; ++e) { const float x1 = bf1((bf16)qf[nq][4][j + e]), x2 = bf1((bf16)qf[nq][5][j + e]); const float c = ct[t * 16 + 8 * hh + j + e], s = st[t * 16 + 8 * hh + j + e];
                    y1[e] = x1 * c - x2 * s; y2[e] = x1 * s + x2 * c; }
                const unsigned w1 = pk2(y1[0], y1[1]), w2 = pk2(y2[0], y2[1]);
                qf[nq][4][j] = (short)(w1 & 0xffff); qf[nq][4][j + 1] = (short)(w1 >> 16); qf[nq][5][j] = (short)(w2 & 0xffff); qf[nq][5][j + 1] = (short)(w2 >> 16); } }
        asm volatile("" : "+v"(qf[nq][0]), "+v"(qf[nq][1]), "+v"(qf[nq][2]), "+v"(qf[nq][3]), "+v"(qf[nq][4]), "+v"(qf[nq][5]) :: "memory"); }
    f32x16 o[NQ][2]; float m[NQ], l[NQ];
#pragma unroll
    for (int nq = 0; nq < NQ; ++nq) { m[nq] = -1e30f; l[nq] = 0.f;
#pragma unroll
        for (int i = 0; i < 16; ++i) { o[nq][0][i] = 0.f; o[nq][1][i] = 0.f; } }
    v4u kreg0, kreg1, vreg;
#define AT2_LOAD(it, tt) do { const unsigned off_kv = (unsigned)(((tt) >> 3) * (KVW * 2) + h * 256 + ((tt) & 7) * 16), off_kr = (unsigned)(((tt) >> 2) * 64 + ((tt) & 3) * 16); const bool k1ok = (tt) < 256; const int rb_ = (it) < CTXL / 64 ? TL + b * CTXL + (it) * 64 : b * SEQ + ((it) - CTXL / 64) * 64; \
        const char* kvb_ = (const char*)(KVb + (size_t)rb_ * KVW); const char* krb_ = (const char*)(KR + (size_t)rb_ * 32); \
        kreg0 = *(const v4u*)(kvb_ + off_kv); vreg = *(const v4u*)(kvb_ + off_kv + 128); if (k1ok) kreg1 = *(const v4u*)(krb_ + off_kr); } while (0)
#define AT2_WRITE(buf, tt) do { LAS unsigned char* kb_ = lds + (buf) * AT2_BUF; \
        *(LAS v4u*)(kb_ + ((tt) >> 3) * AT2_KP + ((tt) & 7) * 16) = kreg0; if ((tt) < 256) *(LAS v4u*)(kb_ + ((tt) >> 2) * AT2_KP + 128 + ((tt) & 3) * 16) = kreg1; \
        *(LAS v4u*)(kb_ + AT2_KB + ((tt) >> 3) * AT2_VP + ((tt) & 7) * 16) = vreg; } while (0)
    __syncthreads();
    AT2_LOAD(0, tid); AT2_WRITE(0, tid);
    __syncthreads();
    for (int it = 0; it < ntiles; ++it) {
        int tz = tid; asm volatile("" : "+v"(tz));
        const int lane_ = tz & 63, r32_ = lane_ & 31, hh_ = lane_ >> 5, tq_ = (lane_ >> 2) & 3, tp_ = lane_ & 3, tblk_ = (lane_ >> 4) & 1;
#ifdef ATT_LOADTOP
        if (it + 1 < ntiles) AT2_LOAD(it + 1, tz);
#endif
        const LAS unsigned char* kb = lds + (it & 1) * AT2_BUF; const LAS unsigned char* vb = kb + AT2_KB;
        bf16x8 pf[NQ][2][2];
        f32x16 sc[NQ][2];
#pragma unroll
        for (int nq = 0; nq < NQ; ++nq)
#pragma unroll
            for (int i = 0; i < 16; ++i) { sc[nq][0][i] = 0.f; sc[nq][1][i] = 0.f; }
#pragma unroll
        for (int s = 0; s < 6; ++s) { const bf16x8 a0 = *(const LAS bf16x8*)(kb + r32_ * AT2_KP + (16 * s + 8 * hh_) * 2); const bf16x8 a1 = *(const LAS bf16x8*)(kb + (32 + r32_) * AT2_KP + (16 * s + 8 * hh_) * 2);
#pragma unroll
            for (int nq = 0; nq < NQ; ++nq) { sc[nq][0] = __builtin_amdgcn_mfma_f32_32x32x16_bf16(a0, qf[nq][s], sc[nq][0], 0, 0, 0); sc[nq][1] = __builtin_amdgcn_mfma_f32_32x32x16_bf16(a1, qf[nq][s], sc[nq][1], 0, 0, 0); } }
#pragma unroll
        for (int nq = 0; nq < NQ; ++nq) {
            f32x16& s0 = sc[nq][0]; f32x16& s1 = sc[nq][1];
            float mx = s0[0];
#pragma unroll
            for (int i = 1; i < 16; ++i) mx = fmaxf(mx, s0[i]);
#pragma unroll
            for (int i = 0; i < 16; ++i) mx = fmaxf(mx, s1[i]);
            mx = fmaxf(mx, shx(mx, 32, lane_));
            const float mn = fmaxf(m[nq], mx * ATT_SCALE_LOG2E); const float alpha = __builtin_amdgcn_exp2f(m[nq] - mn); m[nq] = mn;
            float rs = 0.f;
#pragma unroll
            for (int i = 0; i < 16; ++i) { s0[i] = __builtin_amdgcn_exp2f(s0[i] * ATT_SCALE_LOG2E - mn); s1[i] = __builtin_amdgcn_exp2f(s1[i] * ATT_SCALE_LOG2E - mn); rs += s0[i] + s1[i]; }
            l[nq] = l[nq] * alpha + rs;
#pragma unroll
            for (int i = 0; i < 16; ++i) { o[nq][0][i] *= alpha; o[nq][1][i] *= alpha; }
#pragma unroll
            for (int s2 = 0; s2 < 2; ++s2) { v4u w0, w1;
                w0.x = cvtpk(s0[8 * s2 + 0], s0[8 * s2 + 1]); w0.y = cvtpk(s0[8 * s2 + 2], s0[8 * s2 + 3]); w0.z = cvtpk(s0[8 * s2 + 4], s0[8 * s2 + 5]); w0.w = cvtpk(s0[8 * s2 + 6], s0[8 * s2 + 7]);
                w1.x = cvtpk(s1[8 * s2 + 0], s1[8 * s2 + 1]); w1.y = cvtpk(s1[8 * s2 + 2], s1[8 * s2 + 3]); w1.z = cvtpk(s1[8 * s2 + 4], s1[8 * s2 + 5]); w1.w = cvtpk(s1[8 * s2 + 6], s1[8 * s2 + 7]);
                pf[nq][0][s2] = __builtin_bit_cast(bf16x8, w0); pf[nq][1][s2] = __builtin_bit_cast(bf16x8, w1); }
        }
#ifndef ATT_LOADTOP
        if (it + 1 < ntiles) AT2_LOAD(it + 1, tz);
#endif
#pragma unroll
        for (int t = 0; t < 2; ++t)
#pragma unroll
            for (int s2 = 0; s2 < 2; ++s2)
#pragma unroll
                for (int dt = 0; dt < 2; ++dt) {
                    const LAS unsigned char* tb = vb + (t * 32 + 16 * s2 + 4 * hh_ + tq_) * AT2_VP + (32 * dt + 16 * tblk_ + 4 * tp_) * 2;
#ifdef ATT_NOTR
                    bf16x8 vf; { const LAS unsigned short* vp_ = (const LAS unsigned short*)(vb + (t * 32 + 16 * s2 + 4 * hh_) * AT2_VP + (32 * dt + r32_) * 2);
#pragma unroll
                      for (int j_ = 0; j_ < 8; ++j_) vf[j_] = (short)vp_[((j_ & 3) + 8 * (j_ >> 2)) * (AT2_VP / 2)]; }
#else
                    const v2u lo = trread(tb), hi = trread(tb + 8 * AT2_VP); const bf16x8 vf = __builtin_bit_cast(bf16x8, (v4u){lo.x, lo.y, hi.x, hi.y});
#endif
#pragma unroll
                    for (int nq = 0; nq < NQ; ++nq) o[nq][dt] = __builtin_amdgcn_mfma_f32_32x32x16_bf16(vf, pf[nq][t][s2], o[nq][dt], 0, 0, 0); }
        if (it + 1 < ntiles) AT2_WRITE((it + 1) & 1, tz);
        __syncthreads();
    }
#undef AT2_LOAD
#undef AT2_WRITE
#pragma unroll
    for (int nq = 0; nq < NQ; ++nq) { int qrow = q0 + wave * (32 * NQ) + nq * 32 + r32; asm volatile("" : "+v"(qrow));
        const float lt = l[nq] + shx(l[nq], 32, lane); const float inv = 1.f / lt;
        bf16* orow = MIX + (size_t)qrow * D + h * 64 + 4 * hh;
#pragma unroll
        for (int g = 0; g < 4; ++g) {
            v2u w; w.x = pk2(o[nq][0][4 * g] * inv, o[nq][0][4 * g + 1] * inv); w.y = pk2(o[nq][0][4 * g + 2] * inv, o[nq][0][4 * g + 3] * inv); *(v2u*)(orow + 8 * g) = w;
            v2u x; x.x = pk2(o[nq][1][4 * g] * inv, o[nq][1][4 * g + 1] * inv); x.y = pk2(o[nq][1][4 * g + 2] * inv, o[nq][1][4 * g + 3] * inv); *(v2u*)(orow + 32 + 8 * g) = x; } }
}
__device__ __forceinline__ void attn_mfma2(const Args& a, LAS unsigned char* lds) {
#ifdef ATT_NQ1
    for (int u = blockIdx.x; u < 512; u += gridDim.x) attn_unit2<1>(a, lds, u >> 6, (u >> 3) & 7, (u >> 6) * SEQ + (u & 7) * 256, (CTXL + SEQ) / 64, true);
#else
    for (int u = blockIdx.x; u < 256; u += gridDim.x) attn_unit2<2>(a, lds, u >> 5, (u >> 2) & 7, (u >> 5) * SEQ + (u & 3) * 512, (CTXL + SEQ) / 64, true);
#endif
    for (int u = blockIdx.x; u < 64; u += gridDim.x) attn_unit2<1>(a, lds, u >> 3, u & 7, TL + (u >> 3) * CTXL, CTXL / 64, false);
}

template <int R>
__device__ __forceinline__ void rowwise2(const float* xs_lat, const float* xs_ctx, float* xd_lat, float* xd_ctx, const bf16* Mb, const float* modg, const float* nwA,
                                         bf16* H, const float* modh, int sh_off, int sc_off, const float* nwB, int nrows, int wv) {
    const int tid = otid(wv), wave = wv, lane = tid & 63; const int NGW = gridDim.x * NWAVES, gw = blockIdx.x * NWAVES + wave;
    const int rpw = (nrows + NGW - 1) / NGW; const int rbeg = gw * rpw, rend = min(rbeg + rpw, nrows);
    for (int r0 = rbeg; r0 < rend; r0 += R) {
        f32x4 v[R][4]; v2u mm[R][4];
#pragma unroll
        for (int j = 0; j < R; ++j) { const int r = min(r0 + j, rend - 1); const float* xs = r < TL ? xs_lat + (size_t)r * D : xs_ctx + (size_t)(r - TL) * D;
#pragma unroll
            for (int q = 0; q < 4; ++q) v[j][q] = *(const f32x4*)(xs + q * 256 + lane * 4);
            if (Mb) {
#pragma unroll
                for (int q = 0; q < 4; ++q) mm[j][q] = *(const v2u*)(Mb + (size_t)r * D + q * 256 + lane * 4); } }
#pragma unroll
        for (int j = 0; j < R; ++j) { const int r = r0 + j; if (r < rend) {
            const bool lat = r < TL; const int cond = lat ? (r >> 11) : 8; float* xd = lat ? xd_lat + (size_t)r * D : xd_ctx + (size_t)(r - TL) * D;
            if (Mb) {
                f32x4 m[4]; float ss = 0.f;
#pragma unroll
                for (int q = 0; q < 4; ++q) { const v2u w = mm[j][q]; m[q] = (f32x4){bflo(w.x), bfhi(w.x), bflo(w.y), bfhi(w.y)}; ss += (m[q][0] * m[q][0] + m[q][1] * m[q][1]) + (m[q][2] * m[q][2] + m[q][3] * m[q][3]); }
                const float rs = rsqrtf(wave_sum(ss, lane) * (1.f / D) + EPS);
#pragma unroll
                for (int q = 0; q < 4; ++q) { const f32x4 g = *(const f32x4*)(modg + (size_t)cond * MODW + q * 256 + lane * 4); const f32x4 w = *(const f32x4*)(nwA + q * 256 + lane * 4);
                    v[j][q] = v[j][q] + g * (m[q] * rs * w); }
            }
#pragma unroll
            for (int q = 0; q < 4; ++q) *(f32x4*)(xd + q * 256 + lane * 4) = v[j][q];
            if (H) {
                float ss = 0.f;
#pragma unroll
                for (int q = 0; q < 4; ++q) ss += (v[j][q][0] * v[j][q][0] + v[j][q][1] * v[j][q][1]) + (v[j][q][2] * v[j][q][2] + v[j][q][3] * v[j][q][3]);
                const float rs = rsqrtf(wave_sum(ss, lane) * (1.f / D) + EPS);
#pragma unroll
                for (int q = 0; q < 4; ++q) { const int c = q * 256 + lane * 4;
                    const f32x4 w = *(const f32x4*)(nwB + c); const f32x4 sc = *(const f32x4*)(modh + (size_t)cond * MODW + sc_off + c); const f32x4 sh = *(const f32x4*)(modh + (size_t)cond * MODW + sh_off + c);
                    const f32x4 hv = (v[j][q] * rs * w) * (sc + 1.0f) + sh;
                    v2u o; o.x = pk2(hv[0], hv[1]); o.y = pk2(hv[2], hv[3]); *(v2u*)(H + (size_t)r * D + c) = o; }
            } } }
    }
}

__device__ __forceinline__ void convgate2(const Args& a, int l, int nrows) {
    const bf16* U = (const bf16*)(a.ws + WS_U); bf16* G = (bf16*)(a.ws + WS_G); const float* cw = a.in[I_FCONV] + (size_t)l * 3 * UPW;
    const int total = (nrows / 8) * (DFF / 8);
    for (int idx = blockIdx.x * NTHR + otid(a.wv); idx < total; idx += gridDim.x * NTHR) {
        const int r0 = (idx / (DFF / 8)) * 8, c0 = (idx % (DFF / 8)) * 8; const bf16* u = U + (size_t)r0 * UPW + c0;
        const bool hp = has_prev(r0), hn = has_next(r0 + 7);
        v4u ua[10], ug[10];
#pragma unroll
        for (int j = 0; j < 10; ++j) { const int rr = (j == 0 && !hp) ? 0 : ((j == 9 && !hn) ? 7 : j - 1); ua[j] = *(const v4u*)(u + (ptrdiff_t)rr * UPW); ug[j] = *(const v4u*)(u + (ptrdiff_t)rr * UPW + DFF); }
        float wa[3][8], wg[3][8];
#pragma unroll
        for (int t = 0; t < 3; ++t)
#pragma unroll
            for (int j = 0; j < 8; ++j) { wa[t][j] = cw[t * UPW + c0 + j]; wg[t][j] = cw[t * UPW + DFF + c0 + j]; }
        if (!hp) { ua[0] = (v4u){0u, 0u, 0u, 0u}; ug[0] = ua[0]; }
        if (!hn) { ua[9] = (v4u){0u, 0u, 0u, 0u}; ug[9] = ua[9]; }
        float pa[8], ca[8], na[8], pg[8], cg_[8], ng[8];
        unpack8(ua[0], pa); unpack8(ug[0], pg); unpack8(ua[1], ca); unpack8(ug[1], cg_);
#pragma unroll
        for (int j = 0; j < 8; ++j) {
            unpack8(ua[j + 2], na); unpack8(ug[j + 2], ng);
            float o[8];
#pragma unroll
            for (int k = 0; k < 8; ++k) { const float act = wa[0][k] * pa[k] + wa[1][k] * ca[k] + wa[2][k] * na[k]; const float gate = wg[0][k] * pg[k] + wg[1][k] * cg_[k] + wg[2][k] * ng[k]; o[k] = silu_f(act) * gate; }
            *(v4u*)(G + (size_t)(r0 + j) * DFF + c0) = pack8(o);
#pragma unroll
            for (int k = 0; k < 8; ++k) { pa[k] = ca[k]; ca[k] = na[k]; pg[k] = cg_[k]; cg_[k] = ng[k]; }
        }
    }
}

__device__ __forceinline__ void ssd_conv2(const Args& a, int i) {
    const bf16* ZX = (const bf16*)(a.ws + WS_ZX); bf16* XBC = (bf16*)(a.ws + WS_XBC); float* DT = (float*)(a.ws + WS_DT); float* AA = (float*)(a.ws + WS_AA);
    const float* cw = a.in[I_SCONVW] + (size_t)i * 3 * 3072; const float* cb = a.in[I_SCONVB] + (size_t)i * 3072;
    const int total = (T / 8) * 384;
    for (int idx = blockIdx.x * NTHR + otid(a.wv); idx < total; idx += gridDim.x * NTHR) {
        const int r0 = (idx / 384) * 8, c0 = (idx % 384) * 8; const bf16* u = ZX + (size_t)r0 * SSD_INP + 2048 + c0;
        const bool hp = has_prev(r0), hn = has_next(r0 + 7);
        v4u ux[10];
#pragma unroll
        for (int j = 0; j < 10; ++j) { const int rr = (j == 0 && !hp) ? 0 : ((j == 9 && !hn) ? 7 : j - 1); ux[j] = *(const v4u*)(u + (ptrdiff_t)rr * SSD_INP); }
        float w[3][8], bias[8];
#pragma unroll
        for (int j = 0; j < 8; ++j) { w[0][j] = cw[c0 + j]; w[1][j] = cw[3072 + c0 + j]; w[2][j] = cw[2 * 3072 + c0 + j]; bias[j] = cb[c0 + j]; }
        if (!hp) ux[0] = (v4u){0u, 0u, 0u, 0u};
        if (!hn) ux[9] = (v4u){0u, 0u, 0u, 0u};
        float p[8], c[8], n[8];
        unpack8(ux[0], p); unpack8(ux[1], c);
#pragma unroll
        for (int j = 0; j < 8; ++j) {
            unpack8(ux[j + 2], n); float o[8];
#pragma unroll
            for (int k = 0; k < 8; ++k) o[k] = silu_f(bias[k] + w[0][k] * p[k] + w[1][k] * c[k] + w[2][k] * n[k]);
            *(v4u*)(XBC + (size_t)(r0 + j) * 3072 + c0) = pack8(o);
#pragma unroll
            for (int k = 0; k < 8; ++k) { p[k] = c[k]; c[k] = n[k]; }
        }
    }
    const float* alog = a.in[I_ALOG] + i * 64; const float* dtb = a.in[I_DTB] + i * 64;
    for (int idx = blockIdx.x * NTHR + otid(a.wv); idx < T * 8; idx += gridDim.x * NTHR) {
        const int r = idx >> 3, j0 = (idx & 7) * 8; float raw[8], dt[8], av[8];
        unpack8(*(const v4u*)(ZX + (size_t)r * SSD_INP + 5120 + j0), raw);
#pragma unroll
        for (int k = 0; k < 8; ++k) { const float x = raw[k] + dtb[j0 + k]; dt[k] = x > 15.f ? x : (x < -15.f ? __expf(x) : __logf(1.f + __expf(x))); av[k] = -__expf(alog[j0 + k]) * dt[k]; }
        *(f32x4*)(DT + (size_t)r * 64 + j0) = (f32x4){dt[0], dt[1], dt[2], dt[3]}; *(f32x4*)(DT + (size_t)r * 64 + j0 + 4) = (f32x4){dt[4], dt[5], dt[6], dt[7]};
        *(f32x4*)(AA + (size_t)r * 64 + j0) = (f32x4){av[0], av[1], av[2], av[3]}; *(f32x4*)(AA + (size_t)r * 64 + j0 + 4) = (f32x4){av[4], av[5], av[6], av[7]};
    }
}

__device__ __forceinline__ void gatenorm2(const Args& a, int i, int nrows) {
    const int tid = otid(a.wv), wave = a.wv, lane = tid & 63; const int NGW = gridDim.x * NWAVES, gw = blockIdx.x * NWAVES + wave;
    const bf16* ZX = (const bf16*)(a.ws + WS_ZX); bf16* YN = (bf16*)(a.ws + WS_XBC); const float* nw = a.in[I_SNORM] + i * 2048;
    const int rpw = (nrows + NGW - 1) / NGW; const int rbeg = gw * rpw, rend = min(rbeg + rpw, nrows);
    constexpr int R = 3;
    for (int r0 = rbeg; r0 < rend; r0 += R) {
        v4u yv[R][4], zv[R][4];
#pragma unroll
        for (int j = 0; j < R; ++j) { const int r = min(r0 + j, rend - 1);
#pragma unroll
            for (int q = 0; q < 4; ++q) { const int c = q * 512 + lane * 8; yv[j][q] = *(const v4u*)(ZX + (size_t)r * SSD_INP + 2048 + c); zv[j][q] = *(const v4u*)(ZX + (size_t)r * SSD_INP + c); } }
#pragma unroll
        for (int j = 0; j < R; ++j) { const int r = r0 + j; if (r < rend) {
            float v[4][8]; float ss = 0.f;
#pragma unroll
            for (int q = 0; q < 4; ++q) { float y[8], z[8]; unpack8(yv[j][q], y); unpack8(zv[j][q], z);
#pragma unroll
                for (int k = 0; k < 8; ++k) { v[q][k] = y[k] * silu_f(z[k]); ss += v[q][k] * v[q][k]; } }
            const float rs = rsqrtf(wave_sum(ss, lane) * (1.f / 2048.f) + EPS);
#pragma unroll
            for (int q = 0; q < 4; ++q) { const int c = q * 512 + lane * 8; float o[8];
#pragma unroll
                for (int k = 0; k < 8; ++k) o[k] = v[q][k] * rs * nw[c + k];
                *(v4u*)(YN + (size_t)r * 2048 + c) = pack8(o); } } }
    }
}

__device__ __forceinline__ void ffn_fixup(const Args& a, int l, int nrows) {
    const bf16* Ue = (const bf16*)(a.ws + WS_UE); bf16* G = (bf16*)(a.ws + WS_G); const float* cw = a.in[I_FCONV] + (size_t)l * 3 * UPW;
    const int total = (nrows / 256) * 2 * (DFF / 8);
    for (int idx = blockIdx.x * NTHR + otid(a.wv); idx < total; idx += gridDim.x * NTHR) {
        const int cg = idx % (DFF / 8), which = (idx / (DFF / 8)) & 1, pm = idx / (2 * (DFF / 8)); const int c0 = cg * 8; const int col = (c0 / 128) * 256 + (c0 % 128);
        const int r = pm * 256 + (which ? 255 : 0);
        const bf16* e0 = Ue + (size_t)(pm * 4) * UPW + col;
        const bf16* pp = which ? e0 + 2 * UPW : e0 - UPW;
        const bf16* pc = which ? e0 + 3 * UPW : e0;
        const bf16* pn = which ? e0 + 4 * UPW : e0 + UPW;
        const bool hp = which ? true : has_prev(r), hn = which ? has_next(r) : true;
        float pa[8], pg[8], ca[8], cg_[8], na[8], ng[8];
        unpack8(*(const v4u*)pc, ca); unpack8(*(const v4u*)(pc + 128), cg_);
        if (hp) { unpack8(*(const v4u*)pp, pa); unpack8(*(const v4u*)(pp + 128), pg); } else {
#pragma unroll
            for (int k = 0; k < 8; ++k) { pa[k] = 0.f; pg[k] = 0.f; } }
        if (hn) { unpack8(*(const v4u*)pn, na); unpack8(*(const v4u*)(pn + 128), ng); } else {
#pragma unroll
            for (int k = 0; k < 8; ++k) { na[k] = 0.f; ng[k] = 0.f; } }
        float o[8];
#pragma unroll
        for (int k = 0; k < 8; ++k) { const float act = cw[c0 + k] * pa[k] + cw[UPW + c0 + k] * ca[k] + cw[2 * UPW + c0 + k] * na[k];
            const float gate = cw[DFF + c0 + k] * pg[k] + cw[UPW + DFF + c0 + k] * cg_[k] + cw[2 * UPW + DFF + c0 + k] * ng[k]; o[k] = silu_f(act) * gate; }
        *(v4u*)(G + (size_t)r * DFF + c0) = pack8(o);
    }
}

__device__ __forceinline__ void prep_even2(const Args& a, int i) {
    const int tid = otid(a.wv), wave = a.wv, lane = tid & 63; const int NGW = gridDim.x * NWAVES, gw = blockIdx.x * NWAVES + wave;
    const bf16* P = (const bf16*)(a.ws + WS_P); bf16* CQN = (bf16*)(a.ws + WS_CQN); bf16* CKVN = (bf16*)(a.ws + WS_CKVN); bf16* KR = (bf16*)(a.ws + WS_KR); bf16* MIX = (bf16*)(a.ws + WS_MIX);
    const float* qn = a.in[I_QNORM] + i * 384; const float* kvn = a.in[I_KVNORM] + i * 256; const float* cw = a.in[I_SCONV] + i * 3 * 512;
    const float* ct = (const float*)(a.ws + WS_ROPE); const float* st = ct + SEQ * 16;
    constexpr int R = 3; const int rpw = (T + NGW - 1) / NGW; const int rbeg = gw * rpw, rend = min(rbeg + rpw, T);
    const int c0 = lane * 8;
    for (int r0 = rbeg; r0 < rend; r0 += R) {
        unsigned q32[R][3]; v2u kv2[R]; bf16 krv[R]; v4u gbv[R], gcv[R + 2], xvv[R + 2];
#pragma unroll
        for (int j = 0; j < R; ++j) { const int r = min(r0 + j, rend - 1); const bf16* p = P + (size_t)r * HYB_INP;
            const unsigned* p32 = (const unsigned*)(p + lane * 6); q32[j][0] = p32[0]; q32[j][1] = p32[1]; q32[j][2] = p32[2];
            kv2[j] = *(const v2u*)(p + 384 + lane * 4); krv[j] = p[640 + (lane & 31)]; gbv[j] = *(const v4u*)(p + 672 + c0); }
#pragma unroll
        for (int j = 0; j < R + 2; ++j) { int r = r0 + j - 1; r = max(0, min(r, T - 1)); const bf16* p = P + (size_t)r * HYB_INP; gcv[j] = *(const v4u*)(p + 1184 + c0); xvv[j] = *(const v4u*)(p + 1696 + c0); }
#pragma unroll
        for (int j = 0; j < R; ++j) { const int r = r0 + j; if (r < rend) {
            {   float f[6] = {bflo(q32[j][0]), bfhi(q32[j][0]), bflo(q32[j][1]), bfhi(q32[j][1]), bflo(q32[j][2]), bfhi(q32[j][2])}; float ss = 0.f;
#pragma unroll
                for (int k = 0; k < 6; ++k) ss += f[k] * f[k];
                const float rs = rsqrtf(wave_sum(ss, lane) * (1.f / 384.f) + EPS);
#pragma unroll
                for (int k = 0; k < 6; ++k) f[k] = f[k] * rs * qn[lane * 6 + k];
                unsigned* o32 = (unsigned*)(CQN + (size_t)r * 384 + lane * 6); o32[0] = pk2(f[0], f[1]); o32[1] = pk2(f[2], f[3]); o32[2] = pk2(f[4], f[5]); }
            {   const v2u w = kv2[j]; float f[4] = {bflo(w.x), bfhi(w.x), bflo(w.y), bfhi(w.y)};
                const float ss = (f[0] * f[0] + f[1] * f[1]) + (f[2] * f[2] + f[3] * f[3]);
                const float rs = rsqrtf(wave_sum(ss, lane) * (1.f / 256.f) + EPS);
                const f32x4 g = *(const f32x4*)(kvn + lane * 4);
                v2u o; o.x = pk2(f[0] * rs * g[0], f[1] * rs * g[1]); o.y = pk2(f[2] * rs * g[2], f[3] * rs * g[3]); *(v2u*)(CKVN + (size_t)r * 256 + lane * 4) = o; }
            {   const int jj = lane & 31; const float v = bf1(krv[j]); const float o = shx(v, 16, lane); float res = v;
                if (r < TL) { const int t = r & (SEQ - 1); const float c = ct[t * 16 + (jj & 15)], s = st[t * 16 + (jj & 15)]; res = (jj < 16) ? v * c - o * s : o * s + v * c; }
                if (lane < 32) KR[(size_t)r * 32 + jj] = (bf16)f2bf(res); }
            {   float gb[8], t0[8], t1[8], acc[8];
                unpack8(gbv[j], gb); unpack8(gcv[j + 1], t0); unpack8(xvv[j + 1], t1);
#pragma unroll
                for (int k = 0; k < 8; ++k) acc[k] = cw[512 + c0 + k] * (t0[k] * t1[k]);
                if (has_prev(r)) { unpack8(gcv[j], t0); unpack8(xvv[j], t1);
#pragma unroll
                    for (int k = 0; k < 8; ++k) acc[k] += cw[c0 + k] * (t0[k] * t1[k]); }
                if (has_next(r)) { unpack8(gcv[j + 2], t0); unpack8(xvv[j + 2], t1);
#pragma unroll
                    for (int k = 0; k < 8; ++k) acc[k] += cw[1024 + c0 + k] * (t0[k] * t1[k]); }
#pragma unroll
                for (int k = 0; k < 8; ++k) acc[k] *= gb[k];
                *(v4u*)(MIX + (size_t)r * D + 512 + c0) = pack8(acc); }
        } }
    }
}

#ifndef MK_SINGLE
#define MK_SINGLE 1
#endif
struct GemmDesc { const bf16* A; const bf16* Bt; int M, N, K; bf16* O; int ldc; int mode; };

__global__ void __launch_bounds__(NTHR, 2) fwd_kernel(Args a_in) {
    extern __shared__ __attribute__((aligned(16))) unsigned char lds_raw[];
    LAS unsigned char* lds = (LAS unsigned char*)lds_raw;
#if MK_SINGLE == 1
    volatile LAS unsigned* bst = (volatile LAS unsigned*)(lds + LDS_BYTES - 64);
    const int wv0 = __builtin_amdgcn_readfirstlane((int)threadIdx.x >> 6);
    { const int t0 = otid(wv0); if (t0 < 16) bst[t0] = 0u; }
    __syncthreads();
    const XcdBarrier xbar = xcd_barrier_post((unsigned*)(a_in.ws + WS_CTL), bst, wv0);
#endif
    const Args& a0 = a_in;
#ifdef TDIAG
    unsigned long long tcat[6] = {0, 0, 0, 0, 0, 0}; unsigned long long tlast = __builtin_amdgcn_s_memrealtime();
#endif
    for (int s = a0.lo; s < a0.hi; ++s) {
        Args a = a0;
        { long oz; asm volatile("s_mov_b64 %0, 0" : "=s"(oz));
#pragma unroll
          for (int q = 0; q < 25; ++q) a.in[q] = (const float*)((const char*)a0.in[q] + oz);
          a.out = (float*)((char*)a0.out + oz); a.ws = a0.ws + oz; a.wv = wv0; }
        unsigned char* ws = a.ws;
        float* XL = a.out; float* XC = (float*)(ws + WS_XC); bf16* H = (bf16*)(ws + WS_H); bf16* Mb = (bf16*)(ws + WS_M);
        const float* MOD = (const float*)(ws + WS_MOD); const float* NW = a.in[I_NORMW];
        int nrep = 1;
#ifdef PROBE_MASK
        if (s == 0 && (PROBE_MASK >> 20 & 1u)) nrep = 2;
        if (s >= 2) { const int pk = (s - 2) % 10, ppar = ((s - 2) / 10) & 1; if ((PROBE_MASK >> (pk + 10 * ppar)) & 1u) nrep = 2; }
#endif
        for (int rep = 0; rep < nrep; ++rep) {
        GemmDesc g0{}, g1{}; int ng = 0;
#ifndef NO_SIMPLE
        if (s == 0) {
            mod_compute(a, lds);
            rope_tables(a);
            convert_layer(a, 0, lds);
        } else if (s == 1) {
            rowwise2<3>(a.in[I_X], a.in[I_CTX], XL, XC, nullptr, nullptr, nullptr, H, MOD, 0, 1024, NW, T, a.wv);
        } else {
            const int l = (s - 2) / 10, k = (s - 2) % 10, i = l >> 1; const bool even = (l & 1) == 0, last = (l == 3);
            const int MR = last ? TL : T;
            switch (k) {
            case 0:
                if (even) { g0 = GemmDesc{H, (const bf16*)(ws + W_IN), T, HYB_INP, D, (bf16*)(ws + WS_P), HYB_INP}; ng = 1; }
                else      { g0 = GemmDesc{H, (const bf16*)(ws + W_IN), T, SSD_INP, D, (bf16*)(ws + WS_ZX), SSD_INP}; ng = 1; }
                break;
            case 1: if (even) prep_even2(a, i); else ssd_conv2(a, i); break;
            case 2:
                if (even) { { g0 = GemmDesc{(const bf16*)(ws + WS_CQN), (const bf16*)(ws + W_UQ), T, QW, 384, (bf16*)(ws + WS_Q), QW}; ng = 1; }
                            g1 = GemmDesc{(const bf16*)(ws + WS_CKVN), (const bf16*)(ws + W_UKV), T, KVW, 256, (bf16*)(ws + WS_KV), KVW}; ng = 2; }
                else {
#ifdef SSD_NAIVE
 ssd_scan_naive(a, i, last, lds);
#else
 ssd_scan_mfma(a, i, last, lds);
#endif
 }
                break;
            case 3: if (even) {
#ifdef ATTN_NAIVE
 attn_naive(a, lds);
#else
 attn_mfma(a, lds);
#endif
 } else gatenorm2(a, i, MR); break;
            case 4:
                if (even) { g0 = GemmDesc{(const bf16*)(ws + WS_MIX), (const bf16*)(ws + W_OUT), MR, D, D, Mb, D}; ng = 1; }
                else      { g0 = GemmDesc{(const bf16*)(ws + WS_XBC), (const bf16*)(ws + W_OUT), MR, D, 2048, Mb, D}; ng = 1; }
                break;
            case 5:
#ifdef PROBE_ROW2
                if (l > 0) rowwise2<3>(XL, XC, XL, XC, nullptr, nullptr, nullptr, H, MOD + (size_t)l * 9 * MODW, 0, 1024, NW + (l * 4 + 0) * D, MR, a.wv);
#endif
                rowwise2<3>(XL, XC, XL, XC, Mb, MOD + (size_t)l * 9 * MODW + 2048, NW + (l * 4 + 1) * D, H, MOD + (size_t)l * 9 * MODW, 3072, 4096, NW + (l * 4 + 2) * D, MR, a.wv); break;
            case 6: { g0 = GemmDesc{H, (const bf16*)(ws + W_UP), MR, UPW, D, (bf16*)(ws + WS_G), DFF, 1}; ng = 1; } break;
            case 7: ffn_fixup(a, l, MR); break;
            case 8: { g0 = GemmDesc{(const bf16*)(ws + WS_G), (const bf16*)(ws + W_DN), MR, D, DFF, Mb, D}; ng = 1; } break;
            case 9:
                if (!last) { rowwise2<3>(XL, XC, XL, XC, Mb, MOD + (size_t)l * 9 * MODW + 5120, NW + (l * 4 + 3) * D, H, MOD + (size_t)(l + 1) * 9 * MODW, 0, 1024, NW + ((l + 1) * 4 + 0) * D, T, a.wv);
                             convert_layer(a, l + 1, lds); }
                else rowwise2<3>(XL, XC, XL, XC, Mb, MOD + (size_t)l * 9 * MODW + 5120, NW + (l * 4 + 3) * D, nullptr, MOD, 0, 0, NW, TL, a.wv);
                break;
            }
        }
#else
        { g0 = GemmDesc{H, (const bf16*)(ws + W_IN), T, a.hi * 256, a.lo * 128, (bf16*)(ws + WS_P), HYB_INP}; ng = 1; }
#endif
        for (int gi = 0; gi < ng; ++gi) {
            const bool f = (gi == 0);
            pg8::Gemm g{f ? g0.A : g1.A, f ? g0.Bt : g1.Bt, f ? g0.M : g1.M, f ? g0.N : g1.N, f ? g0.K : g1.K, a.wv,
#ifdef GDIAG
                (s == GDIAG_STEP) ? (float*)(a0.ws + WS_MOD + 900 * 1024) : nullptr
#else
                nullptr
#endif
            }; pg8::StaticOrder S; S.init(g.M, g.N, (int)gridDim.x, (int)blockIdx.x);
            pg8::EpiFfn E{f ? g0.O : g1.O, f ? g0.ldc : g1.ldc, f ? g0.mode : 0, (bf16*)(ws + WS_UE), a.in[I_FCONV] + (size_t)((s - 2) / 10) * 3 * UPW, (LAS pg8::f32x4*)(lds + 131072), a.wv};
#ifndef NO_GEMM
            pg8::gemm_phase<pg8::EpiFfn, pg8::StaticOrder, true, true>(lds, g, S, E);
#endif
            __syncthreads();
        }
        if (rep + 1 < nrep) __syncthreads();
        }
#ifdef GDIAG
        if (s + 1 == a0.hi) { __syncthreads(); asm volatile("s_waitcnt vmcnt(0)" ::: "memory"); if (blockIdx.x == 0 && otid(wv0) == 0) { const float* dg = (const float*)(a0.ws + WS_MOD + 900 * 1024); a0.out[0] += 25.0f * dg[GDIAG_SEL] / dg[3]; } }
#endif
#ifdef SSD_DIAG
        if (s + 1 == a0.hi) { __syncthreads(); asm volatile("s_waitcnt vmcnt(0)" ::: "memory"); if (blockIdx.x == 0 && otid(wv0) == 0) { const float* dg = (const float*)(a0.ws + WS_MOD + 900 * 1024); a0.out[0] += 25.0f * dg[SSD_DIAG_SEL] / dg[7]; } }
#endif
#ifdef TDIAG
        if (s + 1 == a0.hi) { __syncthreads(); }
#endif
        if (s + 1 < a0.hi) {
#if MK_SINGLE == 1
            xcd_barrier(xbar);
#ifdef PROBE_BAR2
            xcd_barrier(xbar);
#endif
#elif MK_SINGLE == 2
            cg::this_grid().sync();
#endif
        }
#ifdef TDIAG
        { const unsigned long long tn = __builtin_amdgcn_s_memrealtime(); int cat = 0;
          if (s >= 2) { const int k = (s - 2) % 10, par = ((s - 2) / 10) & 1; cat = (k == 0 || k == 4 || k == 6 || k == 8 || (k == 2 && par == 0)) ? 1 : ((k == 5 || k == 9) ? 2 : ((k == 3 && par == 0) ? 4 : ((k == 2 && par == 1) ? 5 : 3)));
#ifdef TDIAG_K
              cat = (k == TDIAG_K && (TDIAG_PAR == 2 || par == TDIAG_PAR)) ? 1 : 3;
#endif
          }
#pragma unroll
          for (int q = 0; q < 6; ++q) if (q == cat) tcat[q] += tn - tlast;
          tlast = tn;
          if (s + 1 == a0.hi) { asm volatile("s_waitcnt vmcnt(0)" ::: "memory"); if (blockIdx.x == 0 && otid(wv0) == 0) { unsigned long long tt = 0;
#pragma unroll
              for (int q = 0; q < 6; ++q) tt += tcat[q];
              a0.out[0] += (TDIAG == 6) ? (float)tt * (1.0f / 20000.0f) : 25.0f * (float)tcat[TDIAG < 6 ? TDIAG : 0] / (float)tt; } } }
#endif
    }
}

extern "C" void kernel_launch(void* const* d_in, const int* in_sizes, int n_in, void* d_out, int out_size, void* d_ws, size_t ws_size, hipStream_t stream) {
    static int grid = 0;
    if (grid == 0) {
        if (n_in != 25 || out_size != TL * D || ws_size < WS_END) { fprintf(stderr, "kernel_launch: unexpected problem (n_in %d out %d ws %zu need %zu)\n", n_in, out_size, ws_size, (size_t)WS_END); grid = -1; return; }
        if (hipFuncSetAttribute((const void*)fwd_kernel, hipFuncAttributeMaxDynamicSharedMemorySize, LDS_BYTES) != hipSuccess) { fprintf(stderr, "kernel_launch: hipFuncSetAttribute failed\n"); grid = -1; return; }
        int dev = 0, cus = 0, per_cu = 0;
        hipGetDevice(&dev); hipDeviceGetAttribute(&cus, hipDeviceAttributeMultiprocessorCount, dev);
        hipOccupancyMaxActiveBlocksPerMultiprocessor(&per_cu, (const void*)fwd_kernel, NTHR, LDS_BYTES);
        (void)hipGetLastError();
        if (per_cu < 1) { fprintf(stderr, "kernel_launch: occupancy query says %d blocks per CU\n", per_cu); }
        grid = cus;
    }
    if (grid < 0) return;
#if MK_SINGLE == 1
    if (hipMemsetAsync((char*)d_ws + WS_CTL, 0, CTL_ZERO_BYTES, stream) != hipSuccess) { fprintf(stderr, "kernel_launch: memset failed\n"); return; }
#endif
    Args a{};
    for (int i = 0; i < 25; ++i) a.in[i] = (const float*)d_in[i];
    a.out = (float*)d_out; a.ws = (unsigned char*)d_ws;
#if MK_SINGLE
    a.lo = 0; a.hi = NSTEP + 1;
    void* args[] = {&a};
    hipError_t e = hipLaunchCooperativeKernel((const void*)fwd_kernel, dim3(grid), dim3(NTHR), args, LDS_BYTES, stream);
    if (e != hipSuccess) fprintf(stderr, "cooperative launch failed: %s (grid %d)\n", hipGetErrorString(e), grid);
#else
    for (int s = 0; s < NSTEP + 1; ++s) { a.lo = s; a.hi = s + 1; hipLaunchKernelGGL(fwd_kernel, dim3(grid), dim3(NTHR), LDS_BYTES, stream, a); }
#endif
}
```

```cpp
#include <hip/hip_runtime.h>
#include <hip/hip_cooperative_groups.h>
#include <cstdio>
#include <cstdint>
namespace cg = cooperative_groups;
__device__ __forceinline__ int otid(int wv) { int l; asm volatile("v_mbcnt_lo_u32_b32 %0, -1, 0\n\tv_mbcnt_hi_u32_b32 %0, -1, %0" : "=v"(l)); return (wv << 6) | l; }
__device__ __forceinline__ float shx(float v, int mask, int lane) { return __builtin_bit_cast(float, __builtin_amdgcn_ds_bpermute((lane ^ mask) << 2, __builtin_bit_cast(int, v))); }
#define LAS __attribute__((address_space(3)))
#define XB_TMO      128
#define XB_XCNT(j)  (256  + 64 * (j))
#define XB_XSUB(j)  (1280 + 64 * (j))
#define XB_XGEN(j)  (2304 + 64 * (j))
#define XB_TOP      3328
#define XB_TOPGEN   3392
#define XCD_BAR_WORDS 3456
#define XB_SPIN_CAP (1u << 18)

__device__ __forceinline__ unsigned xb_ld(unsigned* p)              { return __hip_atomic_load(p, __ATOMIC_RELAXED, __HIP_MEMORY_SCOPE_AGENT); }
__device__ __forceinline__ unsigned xb_add(unsigned* p, unsigned v) { return __hip_atomic_fetch_add(p, v, __ATOMIC_RELAXED, __HIP_MEMORY_SCOPE_AGENT); }
__device__ __forceinline__ unsigned xb_xcc_id() { return (unsigned)__builtin_amdgcn_s_getreg((3 << 11) | 20) & 0xFu; }
#define XB_SPIN(cond, bar) do { unsigned _sp = 0; while (cond) { __builtin_amdgcn_s_sleep(1); \
    if ((++_sp & 255u) == 0u) { if (xb_ld(&(bar)[XB_TMO])) break; if (_sp > XB_SPIN_CAP) { atomicAdd(&(bar)[XB_TMO], 1u); break; } } } } while (0)

struct XcdBarrier {
    unsigned* bar; unsigned x; int wv;
    volatile LAS unsigned* st;
};

__device__ __forceinline__ XcdBarrier xcd_barrier_post(unsigned* bar, volatile LAS unsigned* st, int wv) {
    XcdBarrier b; b.bar = bar; b.x = xb_xcc_id(); b.st = st; b.wv = wv;
    if (otid(wv) == 0) (void)xb_add(&bar[XB_XCNT(b.x)], 1u);
    return b;
}
__device__ __forceinline__ void xcd_barrier_complete(unsigned* bar, unsigned x, unsigned& nloc, unsigned& nx) {
    const unsigned G = gridDim.x * gridDim.y * gridDim.z;
    unsigned sum, cnt, mine, sp = 0u;
    for (;;) {
        sum = 0u; cnt = 0u; mine = 0u;
#pragma unroll
        for (unsigned j = 0; j < 16; ++j) { const unsigned c = xb_ld(&bar[XB_XCNT(j)]); sum += c; cnt += (c > 0u) ? 1u : 0u; mine = (j == x) ? c : mine; }
        if (sum == G) break;
        __builtin_amdgcn_s_sleep(1);
        if ((++sp & 255u) == 0u) { if (xb_ld(&bar[XB_TMO])) break; if (sp > XB_SPIN_CAP) { atomicAdd(&bar[XB_TMO], 1u); break; } }
    }
    nloc = mine > 0u ? mine : 1u; nx = cnt > 0u ? cnt : 1u;
}

__device__ __forceinline__ void xcd_barrier(const XcdBarrier& b) {
    asm volatile("s_waitcnt vmcnt(0)" ::: "memory");
    __syncthreads();
    if (otid(b.wv) == 0) {
        unsigned* bar = b.bar;
        __builtin_amdgcn_s_waitcnt(0);
        unsigned nloc = b.st[0], nx = b.st[1];
        if (nloc == 0u) { xcd_barrier_complete(bar, b.x, nloc, nx); b.st[0] = nloc; b.st[1] = nx; }
        const unsigned old = xb_add(&bar[XB_XSUB(b.x)], 1u);
        const unsigned gen = old / nloc;
        if (old + 1u == (gen + 1u) * nloc) {
            __builtin_amdgcn_fence(__ATOMIC_RELEASE, "agent");
            asm volatile("s_waitcnt vmcnt(0)" ::: "memory");
            const unsigned og = xb_add(&bar[XB_TOP], 1u);
            const unsigned tg = og / nx;
            if (og + 1u == (tg + 1u) * nx) xb_add(&bar[XB_TOPGEN], 1u);
            else XB_SPIN(xb_ld(&bar[XB_TOPGEN]) == tg, bar);
            __builtin_amdgcn_fence(__ATOMIC_ACQUIRE, "agent");
            xb_add(&bar[XB_XGEN(b.x)], 1u);
            asm volatile("s_waitcnt vmcnt(0)" ::: "memory");
        } else {
            XB_SPIN(xb_ld(&bar[XB_XGEN(b.x)]) == gen, bar);
            __builtin_amdgcn_fence(__ATOMIC_ACQUIRE, "agent");
            asm volatile("s_waitcnt vmcnt(0)" ::: "memory");
        }
    }
    __syncthreads();
}
namespace pg8 {
#define PG8_LAS __attribute__((address_space(3)))
typedef unsigned short bf16_t;
typedef short bf16x8 __attribute__((ext_vector_type(8)));
typedef float f32x4 __attribute__((ext_vector_type(4)));
typedef unsigned u32x4 __attribute__((ext_vector_type(4)));
constexpr int BM = 256, BK = 64, HALF = 128, HTB = HALF * BK * 2  , STAGE_BYTES = 8 * HTB, NXCD = 8, WGM = 8;

__host__ __device__ __forceinline__ int lds_byte(int r, int c) { const int st = (r >> 4) * 2 + (c >> 5), rr = r & 15, cc = c & 31, ob = rr * 64 + cc * 2; return st * 1024 + (ob ^ (((ob >> 9) & 1) << 5)); }
__host__ __device__ __forceinline__ void stage_rc(int b, int& R, int& C) { const int st = b / 1024, sb = b % 1024, swz = sb ^ (((sb >> 9) & 1) << 5); R = (st >> 1) * 16 + swz / 64; C = (st & 1) * 32 + (swz % 64) / 2; }
__host__ __device__ __forceinline__ int perm32(int rho) { const int n = rho >> 4, i = rho & 15; return 8 * (i >> 2) + 4 * n + (i & 3); }

struct Unit { int pm, pn; };
struct Gemm { const bf16_t* A; const bf16_t* Bt; int M, N, K, wv; float* dg; };

struct StaticOrder {
    int nM, nN, nwg, G, c;
    __host__ __device__ void init(int M, int N, int G_, int c_) { nM = M / BM; nN = N / BM; nwg = nM * nN; G = G_; c = c_; }
    __host__ __device__ bool next(int i, Unit& u) const {
        const long L = (long)i * G + c; if (L >= nwg) return false;
        int wgid = (int)L; { const int q = nwg / NXCD, r = nwg % NXCD, xcd = wgid % NXCD, off = wgid / NXCD; wgid = (xcd < r ? xcd * (q + 1) : r * (q + 1) + (xcd - r) * q) + off; }
        const int nig = WGM * nN, gid = wgid / nig, fm = gid * WGM, gsz = (nM - fm) < WGM ? (nM - fm) : WGM;
        u.pm = fm + ((wgid % nig) % gsz); u.pn = (wgid % nig) / gsz; return true;
    }
    __device__ __forceinline__ void a_ready(const Unit&) const {}
    __device__ __forceinline__ void done(const Unit&) const {}
};

__device__ __forceinline__ unsigned cvt_pk_bf16(float lo, float hi) { unsigned r; asm volatile("v_cvt_pk_bf16_f32 %0, %1, %2" : "=v"(r) : "v"(lo), "v"(hi)); return r; }
struct EpiStore {
    static constexpr bool PERM = true, AFTER_DRAIN = false;
    bf16_t* O; int ldc;
    __device__ __forceinline__ void operator()(const f32x4 (&acc)[2][2][4][2], const Unit& u, int wr, int wc, int fr, int fq) const {
        const int row0 = u.pm * BM + wr * 64 + fr; const int col0 = u.pn * BM + wc * 32 + 8 * fq;
#pragma unroll
        for (int ai = 0; ai < 2; ++ai)
#pragma unroll
            for (int m = 0; m < 4; ++m) { bf16_t* rowp = O + (size_t)(row0 + ai * HALF + m * 16) * ldc + col0;
#pragma unroll
                for (int bj = 0; bj < 2; ++bj) { const f32x4 v0 = acc[ai][bj][m][0], v1 = acc[ai][bj][m][1];
                    u32x4 w; w.x = cvt_pk_bf16(v0[0], v0[1]); w.y = cvt_pk_bf16(v0[2], v0[3]); w.z = cvt_pk_bf16(v1[0], v1[1]); w.w = cvt_pk_bf16(v1[2], v1[3]);
                    *(u32x4*)(rowp + bj * HALF) = w; } }
    }
};

template <int CTRL> __device__ __forceinline__ float dpprot(float src) { return __builtin_bit_cast(float, __builtin_amdgcn_mov_dpp(__builtin_bit_cast(int, src), CTRL, 0xf, 0xf, true)); }
template <int CTRL> __device__ __forceinline__ float dppf(float old, float src) { return __builtin_bit_cast(float, __builtin_amdgcn_update_dpp(__builtin_bit_cast(int, old), __builtin_bit_cast(int, src), CTRL, 0xf, 0xf, false)); }
#define PG8_DPP4(dst, oldv, srcv, ctrl) do { dst[0] = dppf<ctrl>(oldv[0], srcv[0]); dst[1] = dppf<ctrl>(oldv[1], srcv[1]); dst[2] = dppf<ctrl>(oldv[2], srcv[2]); dst[3] = dppf<ctrl>(oldv[3], srcv[3]); } while (0)
struct EpiFfn {
    static constexpr bool PERM = true, AFTER_DRAIN = false;
    bf16_t* O; int ldc; int mode;
    bf16_t* Ue; const float* cw; PG8_LAS f32x4* ex; int wv;
    __device__ __forceinline__ void operator()(const f32x4 (&acc)[2][2][4][2], const Unit& u, int wr, int wc, int fr_in, int fq_in) const {
        (void)fr_in; (void)fq_in; const int lane_e = otid(wv) & 63; const int fr = lane_e & 15, fq = lane_e >> 4;
        if (mode == 0) {
            const int row0 = u.pm * BM + wr * 64 + fr; const int col0 = u.pn * BM + wc * 32 + 8 * fq;
#pragma unroll
            for (int ai = 0; ai < 2; ++ai)
#pragma unroll
                for (int m = 0; m < 4; ++m) { bf16_t* rowp = O + (size_t)(row0 + ai * HALF + m * 16) * ldc + col0;
#pragma unroll
                    for (int bj = 0; bj < 2; ++bj) { const f32x4 v0 = acc[ai][bj][m][0], v1 = acc[ai][bj][m][1];
                        u32x4 w; w.x = cvt_pk_bf16(v0[0], v0[1]); w.y = cvt_pk_bf16(v0[2], v0[3]); w.z = cvt_pk_bf16(v1[0], v1[1]); w.w = cvt_pk_bf16(v1[2], v1[3]);
                        *(u32x4*)(rowp + bj * HALF) = w; } }
            return;
        }
        const int chl = wc * 32 + 8 * fq, ch = u.pn * 128 + chl;
        f32x4 wA[3][2], wG[3][2];
#pragma unroll
        for (int t = 0; t < 3; ++t)
#pragma unroll
            for (int n = 0; n < 2; ++n) { wA[t][n] = *(const f32x4*)(cw + t * 5632 + ch + 4 * n); wG[t][n] = *(const f32x4*)(cw + t * 5632 + 2816 + ch + 4 * n); }
#define PG8_EX(blk, fl, bj, n) ex[((((blk) * 2 + (fl)) * 2 + (bj)) * 2 + (n)) * 16 + wc * 4 + fq]
#pragma unroll
        for (int ai = 0; ai < 2; ++ai) { const int blk = ai * 2 + wr;
            if (fr == 0) {
#pragma unroll
                for (int bj = 0; bj < 2; ++bj)
#pragma unroll
                    for (int n = 0; n < 2; ++n) PG8_EX(blk, 0, bj, n) = acc[ai][bj][0][n]; }
            if (fr == 15) {
#pragma unroll
                for (int bj = 0; bj < 2; ++bj)
#pragma unroll
                    for (int n = 0; n < 2; ++n) PG8_EX(blk, 1, bj, n) = acc[ai][bj][3][n]; } }
        asm volatile("s_waitcnt lgkmcnt(0)" ::: "memory"); __builtin_amdgcn_s_barrier(); asm volatile("" ::: "memory");
        const f32x4 zero4 = (f32x4){0.f, 0.f, 0.f, 0.f}; const bool is15 = fr == 15, is0 = fr == 0;
#pragma unroll
        for (int ai = 0; ai < 2; ++ai) { const int blk = ai * 2 + wr;
            f32x4 pb[2][2], nb[2][2];
#pragma unroll
            for (int bj = 0; bj < 2; ++bj)
#pragma unroll
                for (int n = 0; n < 2; ++n) { pb[bj][n] = blk > 0 ? PG8_EX(blk - 1, 1, bj, n) : zero4; nb[bj][n] = blk < 3 ? PG8_EX(blk + 1, 0, bj, n) : zero4; }
#pragma unroll
            for (int m = 0; m < 4; ++m) {
                f32x4 cv[2][2];
#pragma unroll
                for (int bj = 0; bj < 2; ++bj)
#pragma unroll
                    for (int n = 0; n < 2; ++n) { const f32x4 cur = acc[ai][bj][m][n];
                        const f32x4 lo = (m == 0) ? pb[bj][n] : acc[ai][bj][m > 0 ? m - 1 : 0][n];
                        const f32x4 hi = (m == 3) ? nb[bj][n] : acc[ai][bj][m < 3 ? m + 1 : 3][n];
                        f32x4 prev, next;
#pragma unroll
                        for (int e = 0; e < 4; ++e) { prev[e] = dpprot<0x121>(is15 ? lo[e] : cur[e]);
                                                      next[e] = dpprot<0x12F>(is0 ? hi[e] : cur[e]); }
                        const f32x4 w0 = bj ? wG[0][n] : wA[0][n], w1 = bj ? wG[1][n] : wA[1][n], w2 = bj ? wG[2][n] : wA[2][n];
                        cv[bj][n] = w0 * prev + w1 * cur + w2 * next; }
                u32x4 w; float g[8];
#pragma unroll
                for (int n = 0; n < 2; ++n)
#pragma unroll
                    for (int e = 0; e < 4; ++e) { const float av = cv[0][n][e]; g[4 * n + e] = av * __builtin_amdgcn_rcpf(1.f + __expf(-av)) * cv[1][n][e]; }
                w.x = cvt_pk_bf16(g[0], g[1]); w.y = cvt_pk_bf16(g[2], g[3]); w.z = cvt_pk_bf16(g[4], g[5]); w.w = cvt_pk_bf16(g[6], g[7]);
                *(u32x4*)(O + (size_t)(u.pm * BM + ai * HALF + wr * 64 + m * 16 + fr) * 2816 + ch) = w;
            } }
#undef PG8_EX
        { const int slot = (wr == 0) ? (fr == 0 ? 0 : (fr == 1 ? 1 : -1)) : (fr == 14 ? 2 : (fr == 15 ? 3 : -1));
          if (slot >= 0) { bf16_t* up = Ue + ((size_t)(u.pm * 4 + slot) * 5632) + u.pn * 256 + chl;
#pragma unroll
              for (int bj = 0; bj < 2; ++bj) { const f32x4 v0 = wr ? acc[1][bj][3][0] : acc[0][bj][0][0], v1 = wr ? acc[1][bj][3][1] : acc[0][bj][0][1];
                  u32x4 w; w.x = cvt_pk_bf16(v0[0], v0[1]); w.y = cvt_pk_bf16(v0[2], v0[3]); w.z = cvt_pk_bf16(v1[0], v1[1]); w.w = cvt_pk_bf16(v1[2], v1[3]);
                  *(u32x4*)(up + bj * HALF) = w; } } }
    }
};
template <class Epi, class Sched, bool ALIGN_EPI = false, bool SP2 = false>
__device__ __forceinline__ void gemm_phase(PG8_LAS unsigned char* lds, const Gemm g, const Sched& S, const Epi& E) {
    const int tid = otid(g.wv), wid = g.wv, lane = tid & 63, wr = wid >> 2, wc = wid & 3, fr = lane & 15, fq = lane >> 4;
    const int K = g.K, nt = K / BK;
    unsigned voffA[2], voffB[2];
#pragma unroll
    for (int i = 0; i < 2; ++i) { int R, C; stage_rc(tid * 16 + i * 8192, R, C); const int Rb = Epi::PERM ? ((R & ~31) + perm32(R & 31)) : R;
        voffA[i] = (unsigned)(R * K + C) * 2u; voffB[i] = (unsigned)(Rb * K + C) * 2u; }
    const size_t kstep = (size_t)(BK * 2);
    const size_t hstep = (size_t)HALF * K * 2;
    const size_t tstep = 2 * hstep;
    const unsigned ldsw = (unsigned)wid * 1024u;
    const int aoff = lds_byte(wr * 64 + fr, fq * 8), boff = lds_byte(wc * 32 + fr, fq * 8);
#define PG8_SA(b, h) (((b) * 2 + (h)) * HTB)
#define PG8_SB(b, h) ((4 + (b) * 2 + (h)) * HTB)
#define PG8_STAGE(bufoff, gbase, voff) do { _Pragma("unroll") for (int _i = 0; _i < 2; ++_i) \
        __builtin_amdgcn_global_load_lds((const unsigned*)((const char*)(gbase) + (voff)[_i]), (PG8_LAS unsigned*)(lds + (bufoff) + ldsw + _i * 8192), 16, 0, 0); } while (0)
#define PG8_LDA(dst, b, h) do { _Pragma("unroll") for (int m = 0; m < 4; ++m) _Pragma("unroll") for (int k = 0; k < 2; ++k) dst[m][k] = *(const PG8_LAS bf16x8*)(lds + PG8_SA(b, h) + aoff + m * 2048 + k * 1024); } while (0)
#define PG8_LDB(dst, b, h) do { _Pragma("unroll") for (int n = 0; n < 2; ++n) _Pragma("unroll") for (int k = 0; k < 2; ++k) dst[n][k] = *(const PG8_LAS bf16x8*)(lds + PG8_SB(b, h) + boff + n * 2048 + k * 1024); } while (0)
#define PG8_MMA(ai, bj, At, Bt) do { __builtin_amdgcn_s_setprio(1); _Pragma("unroll") for (int m = 0; m < 4; ++m) _Pragma("unroll") for (int n = 0; n < 2; ++n) _Pragma("unroll") for (int k = 0; k < 2; ++k) \
        acc[ai][bj][m][n] = __builtin_amdgcn_mfma_f32_16x16x32_bf16(Bt[n][k], At[m][k], acc[ai][bj][m][n], 0, 0, 0); __builtin_amdgcn_s_setprio(0); } while (0)
#define PG8_WAIT_V(n) asm volatile("s_waitcnt vmcnt(" #n ")" ::: "memory")
#define PG8_WAIT_L(n) asm volatile("s_waitcnt lgkmcnt(" #n ")" ::: "memory")
#define PG8_BAR __builtin_amdgcn_s_barrier()
#define PG8_SCHED __builtin_amdgcn_sched_barrier(0)
    Unit cur, nxt; int ui = 0;
#ifdef GDIAG
    unsigned gd0 = 0, gd1 = 0, gd2 = 0; const unsigned gstart = (unsigned)__builtin_amdgcn_s_memtime();
#endif
    if (!S.next(0, cur)) return;
    f32x4 acc[2][2][4][2];
#pragma unroll
    for (int a = 0; a < 2; ++a)
#pragma unroll
        for (int b = 0; b < 2; ++b)
#pragma unroll
            for (int m = 0; m < 4; ++m)
#pragma unroll
                for (int n = 0; n < 2; ++n) acc[a][b][m][n] = (f32x4){0.f, 0.f, 0.f, 0.f};
    bf16x8 At[4][2], B0[2][2], B1[2][2];
    const char* cA = (const char*)g.A + (size_t)cur.pm * tstep; const char* cB = (const char*)g.Bt + (size_t)cur.pn * tstep;
    S.a_ready(cur);
    if constexpr (SP2) {
        PG8_STAGE(PG8_SB(0, 0), cB, voffB); PG8_STAGE(PG8_SB(0, 1), cB + hstep, voffB); PG8_STAGE(PG8_SA(0, 0), cA, voffA); PG8_STAGE(PG8_SA(0, 1), cA + hstep, voffA);
        if (wr == 1) PG8_BAR;
        PG8_WAIT_V(2); PG8_BAR;
        PG8_STAGE(PG8_SB(1, 0), cB + kstep, voffB); PG8_STAGE(PG8_SA(1, 0), cA + kstep, voffA); PG8_STAGE(PG8_SB(1, 1), cB + hstep + kstep, voffB);
        PG8_WAIT_V(6); PG8_BAR;
    } else {
        PG8_STAGE(PG8_SB(0, 0), cB, voffB); PG8_STAGE(PG8_SA(0, 0), cA, voffA); PG8_STAGE(PG8_SB(0, 1), cB + hstep, voffB); PG8_STAGE(PG8_SA(0, 1), cA + hstep, voffA);
        if (wr == 1) PG8_BAR;
        PG8_WAIT_V(4); PG8_BAR;
        PG8_STAGE(PG8_SB(1, 0), cB + kstep, voffB); PG8_STAGE(PG8_SA(1, 0), cA + kstep, voffA); PG8_STAGE(PG8_SB(1, 1), cB + hstep + kstep, voffB);
        PG8_WAIT_V(6); PG8_BAR;
    }
    for (;;) {
        const bool has_next = S.next(ui + 1, nxt);
        const char* nA = has_next ? (const char*)g.A + (size_t)nxt.pm * tstep : cA; const char* nB = has_next ? (const char*)g.Bt + (size_t)nxt.pn * tstep : cB;
#ifdef GDIAG
        unsigned gt0 = (unsigned)__builtin_amdgcn_s_memtime();
#endif
        for (int t = 0; t < nt; t += 2) {
            const bool last = (t == nt - 2);
            const char* a1 = cA + (size_t)(t + 1) * kstep;
            const char* a2 = last ? nA : cA + (size_t)(t + 2) * kstep; const char* b2 = last ? nB : cB + (size_t)(t + 2) * kstep;
            const char* a3 = a2 + kstep; const char* b3 = b2 + kstep;
            if (last && has_next) S.a_ready(nxt);
            if constexpr (SP2) {
            PG8_LDB(B0, 0, 0); PG8_LDB(B1, 0, 1); PG8_SCHED; PG8_LDA(At, 0, 0); PG8_STAGE(PG8_SA(1, 1), a1 + hstep, voffA);
            PG8_WAIT_V(8); PG8_WAIT_L(0); PG8_BAR; PG8_MMA(0, 0, At, B0); PG8_MMA(0, 1, At, B1); PG8_BAR; PG8_SCHED;
            PG8_LDA(At, 0, 1); PG8_STAGE(PG8_SB(0, 0), b2, voffB); PG8_STAGE(PG8_SB(0, 1), b2 + hstep, voffB); PG8_STAGE(PG8_SA(0, 0), a2, voffA);
            PG8_WAIT_V(8); PG8_WAIT_L(0); PG8_BAR; PG8_MMA(1, 0, At, B0); PG8_MMA(1, 1, At, B1); PG8_BAR; PG8_SCHED;
            PG8_LDB(B0, 1, 0); PG8_LDB(B1, 1, 1); PG8_SCHED; PG8_LDA(At, 1, 0); PG8_STAGE(PG8_SA(0, 1), a2 + hstep, voffA);
            PG8_WAIT_V(8); PG8_WAIT_L(0); PG8_BAR; PG8_MMA(0, 0, At, B0); PG8_MMA(0, 1, At, B1); PG8_BAR; PG8_SCHED;
            PG8_LDA(At, 1, 1); PG8_STAGE(PG8_SB(1, 0), b3, voffB); PG8_STAGE(PG8_SB(1, 1), b3 + hstep, voffB); PG8_STAGE(PG8_SA(1, 0), a3, voffA);
            PG8_WAIT_V(8); PG8_WAIT_L(0); PG8_BAR; PG8_MMA(1, 0, At, B0); PG8_MMA(1, 1, At, B1); PG8_BAR; PG8_SCHED;
            } else {
            PG8_LDB(B0, 0, 0); PG8_SCHED; PG8_LDA(At, 0, 0); PG8_STAGE(PG8_SA(1, 1), a1 + hstep, voffA);
            PG8_WAIT_L(8); PG8_BAR; PG8_WAIT_L(0); PG8_MMA(0, 0, At, B0); PG8_BAR; PG8_SCHED;
            PG8_LDB(B1, 0, 1); PG8_STAGE(PG8_SB(0, 0), b2, voffB);
            PG8_BAR; PG8_WAIT_L(0); PG8_MMA(0, 1, At, B1); PG8_BAR;
            PG8_LDA(At, 0, 1); PG8_STAGE(PG8_SA(0, 0), a2, voffA);
            PG8_BAR; PG8_WAIT_L(0); PG8_MMA(1, 0, At, B0); PG8_BAR; PG8_SCHED;
            PG8_STAGE(PG8_SB(0, 1), b2 + hstep, voffB);
            PG8_WAIT_V(6); PG8_BAR; PG8_MMA(1, 1, At, B1); PG8_BAR;
            PG8_LDB(B0, 1, 0); PG8_SCHED; PG8_LDA(At, 1, 0); PG8_STAGE(PG8_SA(0, 1), a2 + hstep, voffA);
            PG8_WAIT_L(8); PG8_BAR; PG8_WAIT_L(0); PG8_MMA(0, 0, At, B0); PG8_BAR; PG8_SCHED;
            PG8_LDB(B1, 1, 1); PG8_STAGE(PG8_SB(1, 0), b3, voffB);
            PG8_BAR; PG8_WAIT_L(0); PG8_MMA(0, 1, At, B1); PG8_BAR;
            PG8_LDA(At, 1, 1); PG8_STAGE(PG8_SA(1, 0), a3, voffA);
            PG8_BAR; PG8_WAIT_L(0); PG8_MMA(1, 0, At, B0); PG8_BAR; PG8_SCHED;
            PG8_STAGE(PG8_SB(1, 1), b3 + hstep, voffB);
            PG8_WAIT_V(6); PG8_BAR; PG8_MMA(1, 1, At, B1); PG8_BAR;
            }
        }
#ifdef GDIAG
        { const unsigned n_ = (unsigned)__builtin_amdgcn_s_memtime(); gd0 += n_ - gt0; gt0 = n_; }
#endif
        if constexpr (ALIGN_EPI) { if (wr == 0) PG8_BAR; }
#ifdef GDIAG
        { const unsigned n_ = (unsigned)__builtin_amdgcn_s_memtime(); gd1 += n_ - gt0; gt0 = n_; }
#endif
        if constexpr (!Epi::AFTER_DRAIN) { E(acc, cur, wr, wc, fr, fq); S.done(cur); }
#ifdef GDIAG
        { const unsigned n_ = (unsigned)__builtin_amdgcn_s_memtime(); gd2 += n_ - gt0; gt0 = n_; }
#endif
        if (!has_next) break;
#pragma unroll
        for (int a = 0; a < 2; ++a)
#pragma unroll
            for (int b = 0; b < 2; ++b)
#pragma unroll
                for (int m = 0; m < 4; ++m)
#pragma unroll
                    for (int n = 0; n < 2; ++n) acc[a][b][m][n] = (f32x4){0.f, 0.f, 0.f, 0.f};
        cur = nxt; cA = nA; cB = nB; ++ui;
        if constexpr (ALIGN_EPI) { if (wr == 1) PG8_BAR; }
    }
#ifdef GDIAG
    if (g.dg && blockIdx.x == 0 && wid == GDIAG_WAVE && lane == 0) { const unsigned tot = (unsigned)__builtin_amdgcn_s_memtime() - gstart; g.dg[0] = (float)gd0; g.dg[1] = (float)gd1; g.dg[2] = (float)gd2; g.dg[3] = (float)tot; }
#endif
    PG8_WAIT_V(0);
    if constexpr (!ALIGN_EPI) { if (wr == 0) PG8_BAR; }
    PG8_BAR;
    if constexpr (Epi::AFTER_DRAIN) { E.fused(acc, cur, wr, wc, fr, fq, lds, wid, lane); S.done(cur); }
#undef PG8_SA
#undef PG8_SB
#undef PG8_STAGE
#undef PG8_LDA
#undef PG8_LDB
#undef PG8_MMA
#undef PG8_WAIT_V
#undef PG8_WAIT_L
#undef PG8_BAR
#undef PG8_SCHED
}
}

typedef unsigned short bf16;
typedef unsigned v4u __attribute__((ext_vector_type(4)));
typedef unsigned v2u __attribute__((ext_vector_type(2)));
typedef float f32x4 __attribute__((ext_vector_type(4)));
constexpr int NWAVES = 8, NTHR = 512;
constexpr int D = 1024, NB = 8, SEQ = 2048, CTXL = 256, TL = NB * SEQ, TC = NB * CTXL, T = TL + TC;
constexpr int HYB_IN = 2208, HYB_INP = 2304, SSD_IN = 5184, SSD_INP = 5376, DFF = 2816, UPW = 5632;
constexpr int QW = 768, KVW = 1024, MODW = 6144;
constexpr float EPS = 1e-6f;
constexpr int NSTEP = 1 + 4 * 10;
constexpr float ATT_SCALE_LOG2E = 0.10206207261596577f * 1.4426950408889634f;

constexpr size_t MiB = 1u << 20;
constexpr size_t WS_CTL = 0, CTL_ZERO_BYTES = 64 * 1024;
constexpr size_t WS_MOD = 1 * MiB;
constexpr size_t WS_ROPE = 2 * MiB;
constexpr size_t W_UP = 3 * MiB;
constexpr size_t W_DN = W_UP + (size_t)UPW * D * 2;
constexpr size_t W_IN = W_DN + (size_t)D * DFF * 2;
constexpr size_t W_OUT = W_IN + (size_t)SSD_INP * D * 2;
constexpr size_t W_UQ = W_OUT + (size_t)D * 2048 * 2;
constexpr size_t W_UKV = W_UQ + (size_t)QW * 384 * 2;
constexpr size_t W_END = W_UKV + (size_t)KVW * 256 * 2;
constexpr size_t WS_XC = 36 * MiB;
constexpr size_t WS_H = 44 * MiB;
constexpr size_t WS_DT = WS_H, WS_AA = WS_H + (size_t)T * 64 * 4;
constexpr size_t WS_BIG = 80 * MiB;
constexpr size_t WS_M = WS_BIG;
constexpr size_t WS_P = WS_BIG;
constexpr size_t WS_Q = WS_BIG + 81 * MiB;
constexpr size_t WS_KV = WS_BIG + 108 * MiB;
constexpr size_t WS_KR = WS_BIG + 144 * MiB;
constexpr size_t WS_CQN = WS_BIG + 146 * MiB;
constexpr size_t WS_CKVN = WS_BIG + 160 * MiB;
constexpr size_t WS_MIX = WS_BIG + 170 * MiB;
constexpr size_t WS_U = WS_BIG;
constexpr size_t WS_G = WS_BIG + 198 * MiB;
constexpr size_t WS_ZX = WS_BIG;
constexpr size_t WS_XBC = WS_BIG + 189 * MiB;
constexpr size_t WS_UE = WS_BIG + 297 * MiB;
constexpr size_t WS_END = WS_UE + 4 * MiB;
static_assert(W_END <= WS_XC && WS_G + (size_t)T * DFF * 2 <= WS_END && WS_XBC + (size_t)T * 3072 * 2 <= WS_END && WS_ZX + (size_t)T * SSD_INP * 2 <= WS_XBC, "ws map");
static_assert(WS_AA + (size_t)T * 64 * 4 <= WS_BIG && WS_MIX + (size_t)T * D * 2 <= WS_END && WS_Q + (size_t)T * QW * 2 <= WS_KV && WS_P + (size_t)T * HYB_INP * 2 <= WS_Q, "ws map 2");
constexpr int LDS_BYTES = 147456;

struct Args { const float* in[25]; float* out; unsigned char* ws; int lo, hi; int wv, pad; };
enum { I_X = 0, I_C, I_CTX, I_CCTX, I_MODW, I_MODB, I_NORMW, I_WUP, I_FCONV, I_WDN, I_HIN, I_QNORM, I_KVNORM, I_WUQ, I_WUKV, I_SCONV, I_HOUT, I_SIN, I_SCONVW, I_SCONVB, I_ALOG, I_DTB, I_SD, I_SNORM, I_SOUT };

__device__ __forceinline__ unsigned f2bf(float f) { unsigned u = __builtin_bit_cast(unsigned, f); return (u + 0x7fffu + ((u >> 16) & 1u)) >> 16; }
__device__ __forceinline__ unsigned pk2(float lo, float hi) { unsigned r; asm("v_cvt_pk_bf16_f32 %0, %1, %2" : "=v"(r) : "v"(lo), "v"(hi)); return r; }
__device__ __forceinline__ float bflo(unsigned u) { return __builtin_bit_cast(float, u << 16); }
__device__ __forceinline__ float bfhi(unsigned u) { return __builtin_bit_cast(float, u & 0xffff0000u); }
__device__ __forceinline__ float bf1(bf16 b) { return __builtin_bit_cast(float, (unsigned)b << 16); }
__device__ __forceinline__ float silu_f(float x) { return x * __builtin_amdgcn_rcpf(1.f + __expf(-x)); }
__device__ __forceinline__ float wave_sum(float v, int lane) {
#pragma unroll
    for (int o = 1; o < 64; o <<= 1) v += shx(v, o, lane);
    return v;
}
__device__ __forceinline__ void unpack8(const v4u w, float (&f)[8]) { f[0] = bflo(w.x); f[1] = bfhi(w.x); f[2] = bflo(w.y); f[3] = bfhi(w.y); f[4] = bflo(w.z); f[5] = bfhi(w.z); f[6] = bflo(w.w); f[7] = bfhi(w.w); }
__device__ __forceinline__ v4u pack8(const float (&f)[8]) { v4u w; w.x = pk2(f[0], f[1]); w.y = pk2(f[2], f[3]); w.z = pk2(f[4], f[5]); w.w = pk2(f[6], f[7]); return w; }
__device__ __forceinline__ bool has_prev(int r) { return r < TL ? (r & (SEQ - 1)) != 0 : ((r - TL) & (CTXL - 1)) != 0; }
__device__ __forceinline__ bool has_next(int r) { return r < TL ? (r & (SEQ - 1)) != SEQ - 1 : ((r - TL) & (CTXL - 1)) != CTXL - 1; }

__device__ __forceinline__ void mod_compute(const Args& a, LAS unsigned char* lds) {
    LAS float* sc = (LAS float*)lds;
    LAS float* red = (LAS float*)(lds + 36864);
    const int tid = otid(a.wv);
    float* MOD = (float*)(a.ws + WS_MOD);
    for (int i = tid; i < 9 * 1024; i += NTHR) { const int c = i >> 10, k = i & 1023; const float v = c < 8 ? a.in[I_C][c * 1024 + k] : a.in[I_CCTX][k]; sc[i] = silu_f(v); }
    __syncthreads();
    for (int item = blockIdx.x; item < 4 * 96; item += gridDim.x) {
        const int l = item / 96, cb = item % 96;
        const float* W = a.in[I_MODW] + (size_t)l * 1024 * MODW + cb * 64;
        const int cgp = tid & 15, kg = tid >> 4;
        float acc[9][4];
#pragma unroll
        for (int c = 0; c < 9; ++c) { acc[c][0] = 0.f; acc[c][1] = 0.f; acc[c][2] = 0.f; acc[c][3] = 0.f; }
#pragma unroll 8
        for (int kk = 0; kk < 32; ++kk) { const int k = kg * 32 + kk; const f32x4 w = *(const f32x4*)(W + (size_t)k * MODW + cgp * 4);
#pragma unroll
            for (int c = 0; c < 9; ++c) { const float s = sc[c * 1024 + k]; acc[c][0] += s * w[0]; acc[c][1] += s * w[1]; acc[c][2] += s * w[2]; acc[c][3] += s * w[3]; } }
#pragma unroll
        for (int c = 0; c < 9; ++c)
#pragma unroll
            for (int j = 0; j < 4; ++j) red[kg * 576 + c * 64 + cgp * 4 + j] = acc[c][j];
        __syncthreads();
        for (int o = tid; o < 576; o += NTHR) { float s = 0.f;
            for (int g = 0; g < 32; ++g) s += red[g * 576 + o];
            const int c = o >> 6, col = o & 63; MOD[(size_t)(l * 9 + c) * MODW + cb * 64 + col] = s + a.in[I_MODB][l * MODW + cb * 64 + col]; }
        __syncthreads();
    }
}
__device__ __forceinline__ void rope_tables(const Args& a) {
    float* ct = (float*)(a.ws + WS_ROPE); float* st = ct + SEQ * 16;
    for (int i = blockIdx.x * NTHR + otid(a.wv); i < SEQ * 16; i += gridDim.x * NTHR) {
        const int t = i >> 4, j = i & 15; const int pos = j < 8 ? (t >> 6) : (t & 63); const int f = j & 7;
        const float i0 = (f & 1) ? 0.31622776601683794f : 1.0f; const int e = f >> 1; const float i1 = e == 0 ? 1.0f : (e == 1 ? 0.1f : (e == 2 ? 0.01f : 0.001f));
        const float inv = i0 * i1; const float ang = (float)pos * inv;
        ct[i] = __cosf(ang); st[i] = __sinf(ang); }
}
__device__ __forceinline__ void transpose_item(const float* W, int K, int N, bf16* WT, LAS float* scr, int item, int lane, bool ffn_perm) {
    const int nblk = N / 32, kb = item / nblk, nb = item % nblk, k0 = 64 * kb, n0 = 32 * nb;
    const int o0 = ffn_perm ? ((n0 % DFF) / 128) * 256 + (n0 / DFF) * 128 + (n0 % 128) : n0;
    float wv_[32];
#pragma unroll
    for (int i = 0; i < 32; ++i) wv_[i] = W[(size_t)(k0 + 2 * i + (lane >> 5)) * N + n0 + (lane & 31)];
#pragma unroll
    for (int i = 0; i < 32; ++i) scr[(2 * i + (lane >> 5)) * 33 + (lane & 31)] = wv_[i];
    asm volatile("s_waitcnt lgkmcnt(0)" ::: "memory");
    const int c = lane & 7;
#pragma unroll
    for (int j = 0; j < 4; ++j) { const int n = (lane >> 3) + 8 * j; const LAS float* s = scr + (8 * c) * 33 + n;
        v4u o; o.x = pk2(s[0 * 33], s[1 * 33]); o.y = pk2(s[2 * 33], s[3 * 33]); o.z = pk2(s[4 * 33], s[5 * 33]); o.w = pk2(s[6 * 33], s[7 * 33]);
        *(v4u*)(WT + (size_t)(o0 + n) * K + k0 + 8 * c) = o; }
    asm volatile("s_waitcnt lgkmcnt(0)" ::: "memory");
}
__device__ __forceinline__ void convert_weight(const float* W, int K, int N, int Npad, bf16* WT, LAS unsigned char* lds, int rot, int wv, bool ffn_perm = false) {
    const int wave = wv, lane = otid(wv) & 63; const int NGW = gridDim.x * NWAVES; const int gw = (blockIdx.x * NWAVES + wave + rot) % NGW;
    LAS float* scr = (LAS float*)(lds + wave * 16384);
    const int nitems = (K / 64) * (N / 32);
    for (int it = gw; it < nitems; it += NGW) transpose_item(W, K, N, WT, scr, it, lane, ffn_perm);
    (void)Npad;
}
__device__ __forceinline__ void convert_layer(const Args& a, int l, LAS unsigned char* lds) {
    const int i = l >> 1; unsigned char* ws = a.ws;
    convert_weight(a.in[I_WUP] + (size_t)l * D * UPW, D, UPW, UPW, (bf16*)(ws + W_UP), lds, 0, a.wv, true);
    convert_weight(a.in[I_WDN] + (size_t)l * DFF * D, DFF, D, D, (bf16*)(ws + W_DN), lds, 300, a.wv);
    if ((l & 1) == 0) {
        convert_weight(a.in[I_HIN] + (size_t)i * D * HYB_IN, D, HYB_IN, HYB_INP, (bf16*)(ws + W_IN), lds, 700, a.wv);
        convert_weight(a.in[I_HOUT] + (size_t)i * D * D, D, D, D, (bf16*)(ws + W_OUT), lds, 1100, a.wv);
        convert_weight(a.in[I_WUQ] + (size_t)i * 384 * QW, 384, QW, QW, (bf16*)(ws + W_UQ), lds, 1500, a.wv);
        convert_weight(a.in[I_WUKV] + (size_t)i * 256 * KVW, 256, KVW, KVW, (bf16*)(ws + W_UKV), lds, 1700, a.wv);
    } else {
        convert_weight(a.in[I_SIN] + (size_t)i * D * SSD_IN, D, SSD_IN, SSD_INP, (bf16*)(ws + W_IN), lds, 700, a.wv);
        convert_weight(a.in[I_SOUT] + (size_t)i * 2048 * D, 2048, D, D, (bf16*)(ws + W_OUT), lds, 1300, a.wv);
    }
}

__device__ __forceinline__ void prep_even(const Args& a, int i) {
    const int wave = otid(a.wv) >> 6, lane = otid(a.wv) & 63; const int NGW = gridDim.x * NWAVES, gw = blockIdx.x * NWAVES + wave;
    const bf16* P = (const bf16*)(a.ws + WS_P); bf16* CQN = (bf16*)(a.ws + WS_CQN); bf16* CKVN = (bf16*)(a.ws + WS_CKVN); bf16* KR = (bf16*)(a.ws + WS_KR); bf16* MIX = (bf16*)(a.ws + WS_MIX);
    const float* qn = a.in[I_QNORM] + i * 384; const float* kvn = a.in[I_KVNORM] + i * 256; const float* cw = a.in[I_SCONV] + i * 3 * 512;
    const float* ct = (const float*)(a.ws + WS_ROPE); const float* st = ct + SEQ * 16;
    for (int r = gw; r < T; r += NGW) {
        const bf16* p = P + (size_t)r * HYB_INP;
        {
            const unsigned* p32 = (const unsigned*)(p + lane * 6); const unsigned w0 = p32[0], w1 = p32[1], w2 = p32[2];
            float f[6] = {bflo(w0), bfhi(w0), bflo(w1), bfhi(w1), bflo(w2), bfhi(w2)}; float ss = 0.f;
#pragma unroll
            for (int j = 0; j < 6; ++j) ss += f[j] * f[j];
            const float rs = rsqrtf(wave_sum(ss, lane) * (1.f / 384.f) + EPS);
#pragma unroll
            for (int j = 0; j < 6; ++j) f[j] = f[j] * rs * qn[lane * 6 + j];
            unsigned* o32 = (unsigned*)(CQN + (size_t)r * 384 + lane * 6); o32[0] = pk2(f[0], f[1]); o32[1] = pk2(f[2], f[3]); o32[2] = pk2(f[4], f[5]);
        }
        {
            const v2u w = *(const v2u*)(p + 384 + lane * 4); float f[4] = {bflo(w.x), bfhi(w.x), bflo(w.y), bfhi(w.y)};
            const float ss = (f[0] * f[0] + f[1] * f[1]) + (f[2] * f[2] + f[3] * f[3]);
            const float rs = rsqrtf(wave_sum(ss, lane) * (1.f / 256.f) + EPS);
            const f32x4 g = *(const f32x4*)(kvn + lane * 4);
            v2u o; o.x = pk2(f[0] * rs * g[0], f[1] * rs * g[1]); o.y = pk2(f[2] * rs * g[2], f[3] * rs * g[3]); *(v2u*)(CKVN + (size_t)r * 256 + lane * 4) = o;
        }
        {
            const int j = lane & 31; const float v = bf1(p[640 + j]); const float o = shx(v, 16, lane); float res = v;
            if (r < TL) { const int t = r & (SEQ - 1); const float c = ct[t * 16 + (j & 15)], s = st[t * 16 + (j & 15)]; res = (j < 16) ? v * c - o * s : o * s + v * c; }
            if (lane < 32) KR[(size_t)r * 32 + j] = (bf16)f2bf(res);
        }
        {
            const int c0 = lane * 8; float gb[8], cur[8], acc[8], t0[8], t1[8];
            unpack8(*(const v4u*)(p + 672 + c0), gb);
            unpack8(*(const v4u*)(p + 1184 + c0), t0); unpack8(*(const v4u*)(p + 1696 + c0), t1);
#pragma unroll
            for (int j = 0; j < 8; ++j) { cur[j] = t0[j] * t1[j]; acc[j] = cw[512 + c0 + j] * cur[j]; }
            if (has_prev(r)) { unpack8(*(const v4u*)(p - HYB_INP + 1184 + c0), t0); unpack8(*(const v4u*)(p - HYB_INP + 1696 + c0), t1);
#pragma unroll
                for (int j = 0; j < 8; ++j) acc[j] += cw[c0 + j] * (t0[j] * t1[j]); }
            if (has_next(r)) { unpack8(*(const v4u*)(p + HYB_INP + 1184 + c0), t0); unpack8(*(const v4u*)(p + HYB_INP + 1696 + c0), t1);
#pragma unroll
                for (int j = 0; j < 8; ++j) acc[j] += cw[1024 + c0 + j] * (t0[j] * t1[j]); }
#pragma unroll
            for (int j = 0; j < 8; ++j) acc[j] *= gb[j];
            *(v4u*)(MIX + (size_t)r * D + 512 + c0) = pack8(acc);
        }
    }
}

__device__ __forceinline__ void convgate(const Args& a, int l, int nrows) {
    const bf16* U = (const bf16*)(a.ws + WS_U); bf16* G = (bf16*)(a.ws + WS_G); const float* cw = a.in[I_FCONV] + (size_t)l * 3 * UPW;
    const int total = nrows * (DFF / 8);
    for (int idx = blockIdx.x * NTHR + otid(a.wv); idx < total; idx += gridDim.x * NTHR) {
        const int r = idx / (DFF / 8), c0 = (idx % (DFF / 8)) * 8; const bf16* u = U + (size_t)r * UPW + c0;
        float ua[8], ug[8], act[8], gate[8];
        unpack8(*(const v4u*)u, ua); unpack8(*(const v4u*)(u + DFF), ug);
#pragma unroll
        for (int j = 0; j < 8; ++j) { act[j] = cw[UPW + c0 + j] * ua[j]; gate[j] = cw[UPW + DFF + c0 + j] * ug[j]; }
        if (has_prev(r)) { unpack8(*(const v4u*)(u - UPW), ua); unpack8(*(const v4u*)(u - UPW + DFF), ug);
#pragma unroll
            for (int j = 0; j < 8; ++j) { act[j] += cw[c0 + j] * ua[j]; gate[j] += cw[DFF + c0 + j] * ug[j]; } }
        if (has_next(r)) { unpack8(*(const v4u*)(u + UPW), ua); unpack8(*(const v4u*)(u + UPW + DFF), ug);
#pragma unroll
            for (int j = 0; j < 8; ++j) { act[j] += cw[2 * UPW + c0 + j] * ua[j]; gate[j] += cw[2 * UPW + DFF + c0 + j] * ug[j]; } }
#pragma unroll
        for (int j = 0; j < 8; ++j) act[j] = silu_f(act[j]) * gate[j];
        *(v4u*)(G + (size_t)r * DFF + c0) = pack8(act);
    }
}

__device__ __forceinline__ void ssd_conv(const Args& a, int i) {
    const bf16* ZX = (const bf16*)(a.ws + WS_ZX); bf16* XBC = (bf16*)(a.ws + WS_XBC); float* DT = (float*)(a.ws + WS_DT); float* AA = (float*)(a.ws + WS_AA);
    const float* cw = a.in[I_SCONVW] + (size_t)i * 3 * 3072; const float* cb = a.in[I_SCONVB] + (size_t)i * 3072;
    const int total = T * 384;
    for (int idx = blockIdx.x * NTHR + otid(a.wv); idx < total; idx += gridDim.x * NTHR) {
        const int r = idx / 384, c0 = (idx % 384) * 8; const bf16* u = ZX + (size_t)r * SSD_INP + 2048 + c0;
        float x[8], acc[8];
        unpack8(*(const v4u*)u, x);
#pragma unroll
        for (int j = 0; j < 8; ++j) acc[j] = cb[c0 + j] + cw[3072 + c0 + j] * x[j];
        if (has_prev(r)) { unpack8(*(const v4u*)(u - SSD_INP), x);
#pragma unroll
            for (int j = 0; j < 8; ++j) acc[j] += cw[c0 + j] * x[j]; }
        if (has_next(r)) { unpack8(*(const v4u*)(u + SSD_INP), x);
#pragma unroll
            for (int j = 0; j < 8; ++j) acc[j] += cw[2 * 3072 + c0 + j] * x[j]; }
#pragma unroll
        for (int j = 0; j < 8; ++j) acc[j] = silu_f(acc[j]);
        *(v4u*)(XBC + (size_t)r * 3072 + c0) = pack8(acc);
    }
    const float* alog = a.in[I_ALOG] + i * 64; const float* dtb = a.in[I_DTB] + i * 64;
    for (int idx = blockIdx.x * NTHR + otid(a.wv); idx < T * 64; idx += gridDim.x * NTHR) {
        const int r = idx >> 6, j = idx & 63; const float raw = bf1(ZX[(size_t)r * SSD_INP + 5120 + j]) + dtb[j];
        const float dt = raw > 15.f ? raw : (raw < -15.f ? __expf(raw) : __logf(1.f + __expf(raw)));
        DT[idx] = dt; AA[idx] = -__expf(alog[j]) * dt;
    }
}

__device__ __forceinline__ void gatenorm(const Args& a, int i, int nrows) {
    const int wave = otid(a.wv) >> 6, lane = otid(a.wv) & 63; const int NGW = gridDim.x * NWAVES, gw = blockIdx.x * NWAVES + wave;
    const bf16* ZX = (const bf16*)(a.ws + WS_ZX); bf16* YN = (bf16*)(a.ws + WS_XBC); const float* nw = a.in[I_SNORM] + i * 2048;
    for (int r = gw; r < nrows; r += NGW) {
        float v[4][8]; float ss = 0.f;
#pragma unroll
        for (int j = 0; j < 4; ++j) { float y[8], z[8]; const int c = j * 512 + lane * 8;
            unpack8(*(const v4u*)(ZX + (size_t)r * SSD_INP + 2048 + c), y); unpack8(*(const v4u*)(ZX + (size_t)r * SSD_INP + c), z);
#pragma unroll
            for (int k = 0; k < 8; ++k) { v[j][k] = y[k] * silu_f(z[k]); ss += v[j][k] * v[j][k]; } }
        const float rs = rsqrtf(wave_sum(ss, lane) * (1.f / 2048.f) + EPS);
#pragma unroll
        for (int j = 0; j < 4; ++j) { const int c = j * 512 + lane * 8; float o[8];
#pragma unroll
            for (int k = 0; k < 8; ++k) o[k] = v[j][k] * rs * nw[c + k];
            *(v4u*)(YN + (size_t)r * 2048 + c) = pack8(o); }
    }
}

__device__ __forceinline__ void attn_naive(const Args& a, LAS unsigned char* lds) {
    const int tid = otid(a.wv), qi = tid >> 1, half = tid & 1;
    const bf16* Qb = (const bf16*)(a.ws + WS_Q); const bf16* KVb = (const bf16*)(a.ws + WS_KV); const bf16* KR = (const bf16*)(a.ws + WS_KR); bf16* MIX = (bf16*)(a.ws + WS_MIX);
    const float* ct = (const float*)(a.ws + WS_ROPE); const float* st = ct + SEQ * 16;
    LAS float* Kt = (LAS float*)lds;
    LAS float* Vt = (LAS float*)(lds + 64 * 96 * 4);
    for (int u = blockIdx.x; u < 576; u += gridDim.x) {
        const bool lat = u < 512; const int b = lat ? (u >> 6) : ((u - 512) >> 3), h = lat ? ((u >> 3) & 7) : ((u - 512) & 7);
        const int nkeys = lat ? (CTXL + SEQ) : CTXL;
        const int qrow = lat ? b * SEQ + (u & 7) * 256 + qi : TL + b * CTXL + qi;
        float q[48];
#pragma unroll
        for (int g = 0; g < 6; ++g) { float f[8]; unpack8(*(const v4u*)(Qb + (size_t)qrow * QW + h * 96 + half * 48 + g * 8), f);
#pragma unroll
            for (int j = 0; j < 8; ++j) q[g * 8 + j] = f[j]; }
        if (lat && half == 1) { const int t = qrow & (SEQ - 1);
#pragma unroll
            for (int j = 0; j < 16; ++j) { const float c = ct[t * 16 + j], s = st[t * 16 + j]; const float x1 = q[16 + j], x2 = q[32 + j]; q[16 + j] = x1 * c - x2 * s; q[32 + j] = x1 * s + x2 * c; } }
#pragma unroll
        for (int j = 0; j < 48; ++j) q[j] *= ATT_SCALE_LOG2E;
        float o[32]; float m = -1e30f, l = 0.f;
#pragma unroll
        for (int j = 0; j < 32; ++j) o[j] = 0.f;
        for (int k0 = 0; k0 < nkeys; k0 += 64) {
            __syncthreads();
            for (int g = tid; g < 768; g += NTHR) { const int key = g / 12, part = g % 12; const int kk = k0 + key; const int krow = kk < CTXL ? TL + b * CTXL + kk : b * SEQ + kk - CTXL;
                float f[8]; unpack8(part < 8 ? *(const v4u*)(KVb + (size_t)krow * KVW + h * 128 + part * 8) : *(const v4u*)(KR + (size_t)krow * 32 + (part - 8) * 8), f);
#pragma unroll
                for (int j = 0; j < 8; ++j) Kt[key * 96 + part * 8 + j] = f[j]; }
            { const int key = tid >> 3, part = tid & 7; const int kk = k0 + key; const int krow = kk < CTXL ? TL + b * CTXL + kk : b * SEQ + kk - CTXL;
                float f[8]; unpack8(*(const v4u*)(KVb + (size_t)krow * KVW + h * 128 + 64 + part * 8), f);
#pragma unroll
                for (int j = 0; j < 8; ++j) Vt[key * 64 + part * 8 + j] = f[j]; }
            __syncthreads();
            for (int kg = 0; kg < 64; kg += 8) {
                float s[8]; float gm = -1e30f;
#pragma unroll
                for (int kk = 0; kk < 8; ++kk) { float acc = 0.f; const LAS f32x4* kp = (const LAS f32x4*)(Kt + (kg + kk) * 96 + half * 48);
#pragma unroll
                    for (int d4 = 0; d4 < 12; ++d4) { const f32x4 kv = kp[d4]; acc += q[d4 * 4] * kv[0] + q[d4 * 4 + 1] * kv[1] + q[d4 * 4 + 2] * kv[2] + q[d4 * 4 + 3] * kv[3]; }
                    acc += shx(acc, 1, tid & 63);
                    s[kk] = acc; gm = fmaxf(gm, acc); }
                const float mn = fmaxf(m, gm); const float alpha = exp2f(m - mn); m = mn; l *= alpha;
#pragma unroll
                for (int j = 0; j < 32; ++j) o[j] *= alpha;
#pragma unroll
                for (int kk = 0; kk < 8; ++kk) { const float p = exp2f(s[kk] - mn); l += p; const LAS f32x4* vp = (const LAS f32x4*)(Vt + (kg + kk) * 64 + half * 32);
#pragma unroll
                    for (int d4 = 0; d4 < 8; ++d4) { const f32x4 vv = vp[d4]; o[d4 * 4] += p * vv[0]; o[d4 * 4 + 1] += p * vv[1]; o[d4 * 4 + 2] += p * vv[2]; o[d4 * 4 + 3] += p * vv[3]; } }
            }
        }
        { const float inv = 1.f / l;
#pragma unroll
            for (int g = 0; g < 4; ++g) { float f[8];
#pragma unroll
                for (int j = 0; j < 8; ++j) f[j] = o[g * 8 + j] * inv;
                *(v4u*)(MIX + (size_t)qrow * D + h * 64 + half * 32 + g * 8) = pack8(f); } }
    }
}

__device__ __forceinline__ void ssd_scan_naive(const Args& a, int i, bool last, LAS unsigned char* lds) {
    const int tid = otid(a.wv), p = tid >> 3, nq = tid & 7;
    bf16* ZX = (bf16*)(a.ws + WS_ZX); const bf16* XBC = (const bf16*)(a.ws + WS_XBC); const float* DT = (const float*)(a.ws + WS_DT); const float* AA = (const float*)(a.ws + WS_AA);
    LAS float* xs = (LAS float*)lds;
    LAS float* Bs = (LAS float*)(lds + 16384);
    LAS float* Cs = (LAS float*)(lds + 16384 + 32768);
    LAS float* dts = (LAS float*)(lds + 16384 + 65536);
    LAS float* as = dts + 64;
    for (int it = blockIdx.x; it < NB * 32; it += gridDim.x) {
        const int b = it >> 5, h = it & 31, g = h >> 3; const float dsk = a.in[I_SD][i * 32 + h];
        for (int dir = 0; dir < 2; ++dir) {
            float stt[16];
#pragma unroll
            for (int n = 0; n < 16; ++n) stt[n] = 0.f;
            for (int seg = 0; seg < 2; ++seg) {
                const int len = seg == 0 ? CTXL : SEQ; const int base = seg == 0 ? TL + b * CTXL : b * SEQ; const bool want_y = !(last && seg == 0);
                for (int cc = 0; cc < len / 64; ++cc) {
                    const int t0 = dir == 0 ? cc * 64 : len - 64 - cc * 64;
                    __syncthreads();
                    { const int tt = tid >> 3, part = tid & 7; float f[8]; unpack8(*(const v4u*)(XBC + (size_t)(base + t0 + tt) * 3072 + h * 64 + part * 8), f);
#pragma unroll
                        for (int j = 0; j < 8; ++j) xs[tt * 64 + part * 8 + j] = f[j]; }
                    for (int q = tid; q < 1024; q += NTHR) { const int tt = q >> 4, part = q & 15; float f[8];
                        unpack8(*(const v4u*)(XBC + (size_t)(base + t0 + tt) * 3072 + 2048 + g * 128 + part * 8), f);
#pragma unroll
                        for (int j = 0; j < 8; ++j) Bs[tt * 128 + part * 8 + j] = f[j];
                        unpack8(*(const v4u*)(XBC + (size_t)(base + t0 + tt) * 3072 + 2560 + g * 128 + part * 8), f);
#pragma unroll
                        for (int j = 0; j < 8; ++j) Cs[tt * 128 + part * 8 + j] = f[j]; }
                    if (tid < 64) { dts[tid] = DT[(size_t)(base + t0 + tid) * 64 + dir * 32 + h]; as[tid] = AA[(size_t)(base + t0 + tid) * 64 + dir * 32 + h]; }
                    __syncthreads();
                    for (int s = 0; s < 64; ++s) {
                        const int tt = dir == 0 ? s : 63 - s;
                        const float dec = __expf(as[tt]); const float xv = xs[tt * 64 + p]; const float xd = xv * dts[tt];
                        const LAS f32x4* bp = (const LAS f32x4*)(Bs + tt * 128 + nq * 16); const LAS f32x4* cp = (const LAS f32x4*)(Cs + tt * 128 + nq * 16);
                        float acc = 0.f;
#pragma unroll
                        for (int n4 = 0; n4 < 4; ++n4) { const f32x4 bv = bp[n4], cv = cp[n4];
#pragma unroll
                            for (int k = 0; k < 4; ++k) { stt[n4 * 4 + k] = dec * stt[n4 * 4 + k] + xd * bv[k]; acc += cv[k] * stt[n4 * 4 + k]; } }
                        acc += shx(acc, 1, tid & 63); acc += shx(acc, 2, tid & 63); acc += shx(acc, 4, tid & 63);
                        if (want_y && nq == 0) { bf16* yp = ZX + (size_t)(base + t0 + tt) * SSD_INP + 2048 + h * 64 + p;
                            const float y = dir == 0 ? acc + dsk * xv : acc + bf1(*yp);
                            *yp = (bf16)f2bf(y); }
                    }
                }
            }
            __syncthreads();
            asm volatile("s_waitcnt vmcnt(0)" ::: "memory");
        }
    }
}

typedef short bf16x8 __attribute__((ext_vector_type(8)));
typedef float f32x16 __attribute__((ext_vector_type(16)));
typedef short v4i16_t __attribute__((ext_vector_type(4)));
__device__ __forceinline__ v2u trread(const LAS unsigned char* p) { return __builtin_bit_cast(v2u, __builtin_amdgcn_ds_read_tr16_b64_v4i16((LAS v4i16_t*)p)); }
__device__ __forceinline__ unsigned cvtpk(float lo, float hi) { unsigned r; asm volatile("v_cvt_pk_bf16_f32 %0, %1, %2" : "=v"(r) : "v"(lo), "v"(hi)); return r; }
constexpr int ATT_KP = 208, ATT_VP = 192, ATT_KB = 64 * ATT_KP, ATT_VB = 64 * ATT_VP, ATT_BUF = ATT_KB + ATT_VB;
#ifndef ATT_NQ
#define ATT_NQ 2
#endif
template <int NQ>
__device__ __forceinline__ void attn_unit3(const Args& a, LAS unsigned char* lds, const int b, const int h, const int q0, const int ntiles, const bool lat) {
    const int tid = otid(a.wv), wave = a.wv, lane = tid & 63, r32 = lane & 31, hh = lane >> 5;
    const int tq = (lane >> 2) & 3, tp = lane & 3, tblk = (lane >> 4) & 1;
    const bf16* Qb = (const bf16*)(a.ws + WS_Q); const bf16* KVb = (const bf16*)(a.ws + WS_KV); const bf16* KR = (const bf16*)(a.ws + WS_KR); bf16* MIX = (bf16*)(a.ws + WS_MIX);
    const float* ct = (const float*)(a.ws + WS_ROPE); const float* st = ct + SEQ * 16;
    bf16x8 qf[NQ][6];
#pragma unroll
    for (int nq = 0; nq < NQ; ++nq) { const int qrow = q0 + wave * (32 * NQ) + nq * 32 + r32;
#pragma unroll
        for (int s = 0; s < 6; ++s) qf[nq][s] = *(const bf16x8*)(Qb + (size_t)qrow * QW + h * 96 + 16 * s + 8 * hh);
        if (lat) { const int t = qrow & (SEQ - 1);
#pragma unroll
            for (int j = 0; j < 8; j += 2) { float x1[2], x2[2], y1[2], y2[2];
#pragma unroll
                for (int e = 0; e < 2; ++e) { x1[e] = bf1((bf16)qf[nq][4][j + e]); x2[e] = bf1((bf16)qf[nq][5][j + e]); const float c = ct[t * 16 + 8 * hh + j + e], s = st[t * 16 + 8 * hh + j + e];
                    y1[e] = x1[e] * c - x2[e] * s; y2[e] = x1[e] * s + x2[e] * c; }
                const unsigned w1 = pk2(y1[0], y1[1]), w2 = pk2(y2[0], y2[1]);
                qf[nq][4][j] = (short)(w1 & 0xffff); qf[nq][4][j + 1] = (short)(w1 >> 16); qf[nq][5][j] = (short)(w2 & 0xffff); qf[nq][5][j + 1] = (short)(w2 >> 16); } } }
    f32x16 o0[NQ], o1[NQ]; float m[NQ], l[NQ];
#pragma unroll
    for (int nq = 0; nq < NQ; ++nq) { m[nq] = -1e30f; l[nq] = 0.f;
#pragma unroll
        for (int i = 0; i < 16; ++i) { o0[nq][i] = 0.f; o1[nq][i] = 0.f; } }
    v4u kreg0, kreg1, vreg;
#define ATT_LOAD(it) do { const int rb_ = (it) < CTXL / 64 ? TL + b * CTXL + (it) * 64 : b * SEQ + ((it) - CTXL / 64) * 64; \
        const char* kvb_ = (const char*)(KVb + (size_t)rb_ * KVW); const char* krb_ = (const char*)(KR + (size_t)rb_ * 32); \
        kreg0 = *(const v4u*)(kvb_ + (tid >> 3) * 2048 + h * 256 + (tid & 7) * 16); if (tid < 256) kreg1 = *(const v4u*)(krb_ + (tid >> 2) * 64 + (tid & 3) * 16); vreg = *(const v4u*)(kvb_ + (tid >> 3) * 2048 + h * 256 + 128 + (tid & 7) * 16); } while (0)
#define ATT_WRITE(buf) do { LAS unsigned char* kb_ = lds + (buf) * ATT_BUF; LAS unsigned char* vb_ = kb_ + ATT_KB; \
        *(LAS v4u*)(kb_ + (tid >> 3) * ATT_KP + (tid & 7) * 16) = kreg0; if (tid < 256) *(LAS v4u*)(kb_ + (tid >> 2) * ATT_KP + 128 + (tid & 3) * 16) = kreg1; \
        *(LAS v4u*)(vb_ + (tid >> 3) * ATT_VP + (tid & 7) * 16) = vreg; } while (0)
    __syncthreads();
    ATT_LOAD(0); ATT_WRITE(0);
    __syncthreads();
    for (int it = 0; it < ntiles; ++it) {
#ifndef ATT_LOADMID
        if (it + 1 < ntiles) ATT_LOAD(it + 1);
#endif
#ifdef ATT_TZ
        int tz = tid; asm volatile("" : "+v"(tz));
        const int lane = tz & 63, r32 = lane & 31, hh = lane >> 5, tq = (lane >> 2) & 3, tp = lane & 3, tblk = (lane >> 4) & 1;
#endif
        const LAS unsigned char* kb = lds + (it & 1) * ATT_BUF; const LAS unsigned char* vb = kb + ATT_KB;
#pragma unroll
        for (int t = 0; t < 2; ++t) {
            f32x16 sc[NQ]; bf16x8 pf[NQ][2];
#pragma unroll
            for (int nq = 0; nq < NQ; ++nq)
#pragma unroll
                for (int i = 0; i < 16; ++i) sc[nq][i] = 0.f;
            bf16x8 kf[6];
#pragma unroll
            for (int s = 0; s < 6; ++s) kf[s] = *(const LAS bf16x8*)(kb + (32 * t + r32) * ATT_KP + (16 * s + 8 * hh) * 2);
            asm volatile("" : "+v"(kf[0]), "+v"(kf[1]), "+v"(kf[2]), "+v"(kf[3]), "+v"(kf[4]), "+v"(kf[5]));
#pragma unroll
            for (int s = 0; s < 6; ++s)
#pragma unroll
                for (int nq = 0; nq < NQ; ++nq) sc[nq] = __builtin_amdgcn_mfma_f32_32x32x16_bf16(kf[s], qf[nq][s], sc[nq], 0, 0, 0);
#ifdef ATT_LOADMID
            if (t == 0 && it + 1 < ntiles) ATT_LOAD(it + 1);
#endif
#pragma unroll
            for (int nq = 0; nq < NQ; ++nq) {
                float mx = sc[nq][0];
#pragma unroll
                for (int i = 1; i < 16; ++i) mx = fmaxf(mx, sc[nq][i]);
                mx = fmaxf(mx, shx(mx, 32, lane));
                const float mn = fmaxf(m[nq], mx * ATT_SCALE_LOG2E); const float alpha = __builtin_amdgcn_exp2f(m[nq] - mn); m[nq] = mn;
                float rs = 0.f;
#pragma unroll
                for (int i = 0; i < 16; ++i) { sc[nq][i] = __builtin_amdgcn_exp2f(sc[nq][i] * ATT_SCALE_LOG2E - mn); rs += sc[nq][i]; }
                l[nq] = l[nq] * alpha + rs;
#pragma unroll
                for (int i = 0; i < 16; ++i) { o0[nq][i] *= alpha; o1[nq][i] *= alpha; }
#pragma unroll
                for (int s2 = 0; s2 < 2; ++s2) { v4u w0;
                    w0.x = cvtpk(sc[nq][8 * s2 + 0], sc[nq][8 * s2 + 1]); w0.y = cvtpk(sc[nq][8 * s2 + 2], sc[nq][8 * s2 + 3]); w0.z = cvtpk(sc[nq][8 * s2 + 4], sc[nq][8 * s2 + 5]); w0.w = cvtpk(sc[nq][8 * s2 + 6], sc[nq][8 * s2 + 7]);
                    pf[nq][s2] = __builtin_bit_cast(bf16x8, w0); }
            }
#pragma unroll
            for (int s2 = 0; s2 < 2; ++s2) { const int ko = t * 32 + 16 * s2 + 4 * hh;
                { const LAS unsigned char* tb = vb + (ko + tq) * ATT_VP + (16 * tblk + 4 * tp) * 2; const v2u lo = trread(tb), hi = trread(tb + 8 * ATT_VP); const bf16x8 vf = __builtin_bit_cast(bf16x8, (v4u){lo.x, lo.y, hi.x, hi.y});
#pragma unroll
                  for (int nq = 0; nq < NQ; ++nq) o0[nq] = __builtin_amdgcn_mfma_f32_32x32x16_bf16(vf, pf[nq][s2], o0[nq], 0, 0, 0); }
                { const LAS unsigned char* tb = vb + (ko + tq) * ATT_VP + (32 + 16 * tblk + 4 * tp) * 2; const v2u lo = trread(tb), hi = trread(tb + 8 * ATT_VP); const bf16x8 vf = __builtin_bit_cast(bf16x8, (v4u){lo.x, lo.y, hi.x, hi.y});
#pragma unroll
                  for (int nq = 0; nq < NQ; ++nq) o1[nq] = __builtin_amdgcn_mfma_f32_32x32x16_bf16(vf, pf[nq][s2], o1[nq], 0, 0, 0); } }
        }
        if (it + 1 < ntiles) ATT_WRITE((it + 1) & 1);
        __syncthreads();
    }
#undef ATT_LOAD
#undef ATT_WRITE
#pragma unroll
    for (int nq = 0; nq < NQ; ++nq) { const int qrow = q0 + wave * (32 * NQ) + nq * 32 + r32;
        const float lsum = l[nq] + shx(l[nq], 32, lane); const float inv = 1.f / lsum;
        bf16* orow = MIX + (size_t)qrow * D + h * 64 + 4 * hh;
#pragma unroll
        for (int g = 0; g < 4; ++g) {
            v2u w; w.x = pk2(o0[nq][4 * g] * inv, o0[nq][4 * g + 1] * inv); w.y = pk2(o0[nq][4 * g + 2] * inv, o0[nq][4 * g + 3] * inv); *(v2u*)(orow + 8 * g) = w;
            v2u x; x.x = pk2(o1[nq][4 * g] * inv, o1[nq][4 * g + 1] * inv); x.y = pk2(o1[nq][4 * g + 2] * inv, o1[nq][4 * g + 3] * inv); *(v2u*)(orow + 32 + 8 * g) = x; } }
}
__device__ __forceinline__ void attn_mfma(const Args& a, LAS unsigned char* lds) {
#if ATT_NQ == 2
    for (int u = blockIdx.x; u < 256; u += gridDim.x) attn_unit3<2>(a, lds, u >> 5, (u >> 2) & 7, (u >> 5) * SEQ + (u & 3) * 512, (CTXL + SEQ) / 64, true);
#else
    for (int u = blockIdx.x; u < 512; u += gridDim.x) attn_unit3<1>(a, lds, u >> 6, (u >> 3) & 7, (u >> 6) * SEQ + (u & 7) * 256, (CTXL + SEQ) / 64, true);
#endif
    for (int u = blockIdx.x; u < 64; u += gridDim.x) attn_unit3<1>(a, lds, u >> 3, u & 7, TL + (u >> 3) * CTXL, CTXL / 64, false);
}

#ifndef SSD_YREP
#define SSD_YREP 1
#endif
#ifndef SSD_WREP
#define SSD_WREP 1
#endif
constexpr int SP_B = 272, SP_X = 192;
constexpr int SO_B = 0, SO_C = SO_B + 128 * SP_B, SO_XD = SO_C + 128 * SP_B, SO_XW = SO_XD + 128 * SP_X, SO_S = SO_XW + 128 * SP_X, SO_V = SO_S + 64 * SP_B;
static_assert(SO_V + 2 * 2048 <= LDS_BYTES, "ssd lds map");
#ifdef SSD_DIAG
#define SSD_T(v) long long v = clock64()
#define SSD_ACC(k, v) do { const long long n_ = clock64(); dacc[k] += n_ - v; v = n_; } while (0)
#else
#define SSD_T(v) do {} while (0)
#define SSD_ACC(k, v) do {} while (0)
#endif
__device__ __forceinline__ void ssd_scan_mfma(const Args& a, int i, bool last, LAS unsigned char* lds) {
#ifdef SSD_DIAG
    long long dacc[12] = {0, 0, 0, 0, 0, 0, 0, 0, 0, 0, 0, 0};
#endif
    const int tid = otid(a.wv), wave = a.wv, lane = tid & 63, r32 = lane & 31, hh = lane >> 5;
    const int pt = wave >> 2, lt = pt ? 3 - (wave & 3) : (wave & 3);
    const int tq = (lane >> 2) & 3, tp = lane & 3, tblk = (lane >> 4) & 1;
    bf16* ZX = (bf16*)(a.ws + WS_ZX); const bf16* XBC = (const bf16*)(a.ws + WS_XBC); const float* DT = (const float*)(a.ws + WS_DT); const float* AA = (const float*)(a.ws + WS_AA);
    LAS unsigned char* Bl = lds + SO_B; LAS unsigned char* Cl = lds + SO_C; LAS unsigned char* XDl = lds + SO_XD; LAS unsigned char* XWl = lds + SO_XW; LAS unsigned char* Sl = lds + SO_S;
    const int brow = tid >> 4, bpart = tid & 15, xrow = tid >> 3, xpart = tid & 7;
    for (int it = blockIdx.x; it < NB * 32; it += gridDim.x) {
        const int b = it >> 5, h = it & 31, g = h >> 3; const float dsk = a.in[I_SD][i * 32 + h];
        for (int dir = 0; dir < 2; ++dir) {
            const int scanw = dir == 0 ? 0 : 3;
            f32x16 sacc;
#pragma unroll
            for (int k = 0; k < 16; ++k) sacc[k] = 0.f;
            SSD_T(tprev);
            v4u bq[4], cq[4], xq[2]; float pa0 = 0.f, pa1 = 0.f, pd0 = 0.f, pd1 = 0.f, qa0 = 0.f, qa1 = 0.f, qd0 = 0.f, qd1 = 0.f; v2u add[4];
#define SSD_ROWBASE(c) ((c) < 2 ? TL + b * CTXL + (dir == 0 ? (c) : 1 - (c)) * 128 : b * SEQ + (dir == 0 ? (c) - 2 : 17 - (c)) * 128)
#define SSD_PFB(c) do { const int rb_ = SSD_ROWBASE(c); _Pragma("unroll") for (int k_ = 0; k_ < 4; ++k_) bq[k_] = *(const v4u*)(XBC + (size_t)(rb_ + brow + 32 * k_) * 3072 + 2048 + g * 128 + bpart * 8); } while (0)
#define SSD_PFC(c) do { const int rb_ = SSD_ROWBASE(c); _Pragma("unroll") for (int k_ = 0; k_ < 4; ++k_) cq[k_] = *(const v4u*)(XBC + (size_t)(rb_ + brow + 32 * k_) * 3072 + 2560 + g * 128 + bpart * 8); } while (0)
#define SSD_PFX(c) do { const int rb_ = SSD_ROWBASE(c); _Pragma("unroll") for (int k_ = 0; k_ < 2; ++k_) xq[k_] = *(const v4u*)(XBC + (size_t)(rb_ + xrow + 64 * k_) * 3072 + h * 64 + xpart * 8); } while (0)
#define SSD_PF(c) do { SSD_PFB(c); SSD_PFC(c); SSD_PFX(c); } while (0)
#define SSD_PFV(c) do { if (wave == scanw) { const int rb_ = SSD_ROWBASE(c); const size_t o_ = (size_t)(rb_ + 2 * lane) * 64 + dir * 32 + h; qa0 = AA[o_]; qa1 = AA[o_ + 64]; qd0 = DT[o_]; qd1 = DT[o_ + 64]; } } while (0)
#define SSD_PFY(c) do { const int rb_ = SSD_ROWBASE(c); const size_t r_ = (size_t)(rb_ + 32 * lt + r32); \
                _Pragma("unroll") for (int q_ = 0; q_ < 4; ++q_) add[q_] = dir == 0 ? *(const v2u*)(XBC + r_ * 3072 + h * 64 + 32 * pt + 4 * hh + 8 * q_) : *(const v2u*)(ZX + r_ * SSD_INP + 2048 + h * 64 + 32 * pt + 4 * hh + 8 * q_); } while (0)
#define SSD_SCAN(vb_) do { if (wave == scanw) { LAS float* V_ = (LAS float*)(lds + SO_V + (vb_) * 2048); const float pair_ = pa0 + pa1; float ps_ = pair_; \
                _Pragma("unroll") for (int d_ = 1; d_ < 64; d_ <<= 1) { const int src_ = dir == 0 ? lane - d_ : lane + d_; const float t_ = __builtin_bit_cast(float, __builtin_amdgcn_ds_bpermute((src_ & 63) << 2, __builtin_bit_cast(int, ps_))); if (src_ >= 0 && src_ < 64) ps_ += t_; } \
                const float tot_ = __builtin_bit_cast(float, __builtin_amdgcn_ds_bpermute((dir == 0 ? 63 : 0) << 2, __builtin_bit_cast(int, ps_))); const float ex_ = ps_ - pair_; \
                float c0_, c1_; if (dir == 0) { c0_ = ex_ + pa0; c1_ = c0_ + pa1; } else { c1_ = ex_ + pa1; c0_ = c1_ + pa0; } \
                V_[2 * lane] = c0_; V_[2 * lane + 1] = c1_; V_[128 + 2 * lane] = pd0; V_[128 + 2 * lane + 1] = pd1; V_[256 + 2 * lane] = pd0 * __expf(tot_ - c0_); V_[256 + 2 * lane + 1] = pd1 * __expf(tot_ - c1_); \
                if (lane == 0) V_[384] = tot_; } } while (0)
#define SSD_WRITE(vb_) do { const LAS float* V_ = (const LAS float*)(lds + SO_V + (vb_) * 2048); \
                _Pragma("unroll") for (int k_ = 0; k_ < 4; ++k_) { *(LAS v4u*)(Bl + (brow + 32 * k_) * SP_B + bpart * 16) = bq[k_]; *(LAS v4u*)(Cl + (brow + 32 * k_) * SP_B + bpart * 16) = cq[k_]; } \
                _Pragma("unroll") for (int k_ = 0; k_ < 2; ++k_) { const int s_ = xrow + 64 * k_; const float dt_ = V_[128 + s_], w_ = V_[256 + s_]; float f_[8], g_[8]; unpack8(xq[k_], f_); \
                    _Pragma("unroll") for (int j_ = 0; j_ < 8; ++j_) { g_[j_] = f_[j_] * w_; f_[j_] *= dt_; } \
                    *(LAS v4u*)(XDl + s_ * SP_X + xpart * 16) = pack8(f_); *(LAS v4u*)(XWl + s_ * SP_X + xpart * 16) = pack8(g_); } } while (0)
            __syncthreads();
            SSD_PFV(0); pa0 = qa0; pa1 = qa1; pd0 = qd0; pd1 = qd1; SSD_PFV(1); SSD_PFY(0); SSD_PF(0);
            { const float t0_ = qa0, t1_ = qa1, t2_ = qd0, t3_ = qd1; SSD_SCAN(0); pa0 = t0_; pa1 = t1_; pd0 = t2_; pd1 = t3_; }
            __syncthreads();
            SSD_WRITE(0);
            { LAS v2u* sp = (LAS v2u*)(Sl + (32 * pt + r32) * SP_B + (32 * lt + 4 * hh) * 2);
#pragma unroll
              for (int q = 0; q < 4; ++q) sp[2 * q] = (v2u){0u, 0u}; }
            __syncthreads();
            SSD_ACC(0, tprev);
            for (int c = 0; c < 18; ++c) {
                const int cur = c & 1; const LAS float* V = (const LAS float*)(lds + SO_V + cur * 2048);
                const int rowbase = SSD_ROWBASE(c); const bool want_y = !(last && c < 2);
                if (c > 0 && want_y) SSD_PFY(c);
                if (c + 1 < 18) { if (c + 2 < 18) SSD_PFV(c + 2); }
                SSD_ACC(1, tprev);
                for (int yrep = 0; yrep < SSD_YREP; ++yrep)
                if (!want_y && c + 1 < 18) { SSD_PFB(c + 1); SSD_PFC(c + 1); SSD_PFX(c + 1); }
                if (want_y) {
                    const int l = 32 * lt + r32; const float cl = V[l];
                    bf16* yptr = ZX + (size_t)(rowbase + l) * SSD_INP + 2048 + h * 64 + 32 * pt + 4 * hh;
                    bf16x8 cf[8];
#pragma unroll
                    for (int ks = 0; ks < 8; ++ks) cf[ks] = *(const LAS bf16x8*)(Cl + l * SP_B + (16 * ks + 8 * hh) * 2);
                    SSD_ACC(8, tprev);
                    f32x16 y1;
#pragma unroll
                    for (int k = 0; k < 16; ++k) y1[k] = 0.f;
#pragma unroll
                    for (int ks = 0; ks < 8; ++ks) { const bf16x8 sf = *(const LAS bf16x8*)(Sl + (32 * pt + r32) * SP_B + (16 * ks + 8 * hh) * 2); y1 = __builtin_amdgcn_mfma_f32_32x32x16_bf16(sf, cf[ks], y1, 0, 0, 0); }
                    { const float el = __expf(cl);
#pragma unroll
                      for (int k = 0; k < 16; ++k) y1[k] *= el; }
                    SSD_ACC(10, tprev);
                    const int st_lo = dir == 0 ? 0 : lt, st_hi = dir == 0 ? lt : 3;
#pragma unroll
                    for (int st = 0; st < 4; ++st) { if (c + 1 < 18) { if (st == 1) SSD_PFB(c + 1); if (st == 2) SSD_PFC(c + 1); if (st == 3) SSD_PFX(c + 1); }
                      if (st >= st_lo && st <= st_hi) {
                        f32x16 X;
#pragma unroll
                        for (int k = 0; k < 16; ++k) X[k] = 0.f;
#pragma unroll
                        for (int ks = 0; ks < 8; ++ks) { const bf16x8 af = *(const LAS bf16x8*)(Bl + (32 * st + r32) * SP_B + (16 * ks + 8 * hh) * 2); X = __builtin_amdgcn_mfma_f32_32x32x16_bf16(af, cf[ks], X, 0, 0, 0); }
                        if (st == lt) {
#pragma unroll
                            for (int q = 0; q < 4; ++q) { const f32x4 cs = *(const LAS f32x4*)(V + 32 * st + 8 * q + 4 * hh);
#pragma unroll
                                for (int e = 0; e < 4; ++e) { const int sl = 8 * q + 4 * hh + e; const bool ok = dir == 0 ? (sl <= r32) : (sl >= r32);
                                    X[4 * q + e] *= __expf(ok ? fminf(cl - cs[e], 0.f) : -1.0e30f); } }
                        } else {
#pragma unroll
                            for (int q = 0; q < 4; ++q) { const f32x4 cs = *(const LAS f32x4*)(V + 32 * st + 8 * q + 4 * hh);
#pragma unroll
                                for (int e = 0; e < 4; ++e) X[4 * q + e] *= __expf(fminf(cl - cs[e], 0.f)); }
                        }
#pragma unroll
                        for (int ks2 = 0; ks2 < 2; ++ks2) { v4u w; w.x = cvtpk(X[8 * ks2 + 0], X[8 * ks2 + 1]); w.y = cvtpk(X[8 * ks2 + 2], X[8 * ks2 + 3]); w.z = cvtpk(X[8 * ks2 + 4], X[8 * ks2 + 5]); w.w = cvtpk(X[8 * ks2 + 6], X[8 * ks2 + 7]);
                            const LAS unsigned char* tb = XDl + (32 * st + 16 * ks2 + 4 * hh + tq) * SP_X + (32 * pt + 16 * tblk + 4 * tp) * 2;
                            const v2u lo = trread(tb), hi = trread(tb + 8 * SP_X);
                            y1 = __builtin_amdgcn_mfma_f32_32x32x16_bf16(__builtin_bit_cast(bf16x8, (v4u){lo.x, lo.y, hi.x, hi.y}), __builtin_bit_cast(bf16x8, w), y1, 0, 0, 0); }
                    } }
                    asm volatile("" : "+v"(y1)); SSD_ACC(9, tprev);
#pragma unroll
                    for (int q = 0; q < 4; ++q) { float o[4];
#pragma unroll
                        for (int e = 0; e < 4; ++e) o[e] = y1[4 * q + e];
                        const float a0 = bflo(add[q].x), a1 = bfhi(add[q].x), a2 = bflo(add[q].y), a3 = bfhi(add[q].y);
                        if (dir == 0) { o[0] += dsk * a0; o[1] += dsk * a1; o[2] += dsk * a2; o[3] += dsk * a3; } else { o[0] += a0; o[1] += a1; o[2] += a2; o[3] += a3; }
                        v2u w; w.x = cvtpk(o[0], o[1]); w.y = cvtpk(o[2], o[3]); *(v2u*)(yptr + 8 * q) = w; }
                }
                SSD_ACC(2, tprev);
                if (c + 1 < 18) {
                    const float etot = __expf(V[384]);
#pragma unroll
                    for (int k = 0; k < 16; ++k) sacc[k] *= etot;
#pragma unroll
                    for (int kh = 0; kh < 2; ++kh) {
                        v2u alo[4], ahi[4], blo[4], bhi[4];
#pragma unroll
                        for (int k4 = 0; k4 < 4; ++k4) { const int ks = 4 * kh + k4;
                            const LAS unsigned char* ta = Bl + (16 * ks + 8 * hh + tq) * SP_B + (32 * lt + 16 * tblk + 4 * tp) * 2;
                            const LAS unsigned char* tb = XWl + (16 * ks + 8 * hh + tq) * SP_X + (32 * pt + 16 * tblk + 4 * tp) * 2;
                            alo[k4] = trread(ta); ahi[k4] = trread(ta + 4 * SP_B); blo[k4] = trread(tb); bhi[k4] = trread(tb + 4 * SP_X); }
                        asm volatile("" : "+v"(alo[0]), "+v"(alo[1]), "+v"(alo[2]), "+v"(alo[3]), "+v"(bhi[0]), "+v"(bhi[1]), "+v"(bhi[2]), "+v"(bhi[3]));
#pragma unroll
                        for (int k4 = 0; k4 < 4; ++k4)
                            sacc = __builtin_amdgcn_mfma_f32_32x32x16_bf16(__builtin_bit_cast(bf16x8, (v4u){alo[k4].x, alo[k4].y, ahi[k4].x, ahi[k4].y}), __builtin_bit_cast(bf16x8, (v4u){blo[k4].x, blo[k4].y, bhi[k4].x, bhi[k4].y}), sacc, 0, 0, 0); }
                    SSD_SCAN(cur ^ 1); pa0 = qa0; pa1 = qa1; pd0 = qd0; pd1 = qd1;
                }
                SSD_ACC(3, tprev);
                __syncthreads();
                SSD_ACC(4, tprev);
                if (c + 1 < 18) {
                    LAS v2u* sp = (LAS v2u*)(Sl + (32 * pt + r32) * SP_B + (32 * lt + 4 * hh) * 2);
#pragma unroll
                    for (int q = 0; q < 4; ++q) { v2u w; w.x = cvtpk(sacc[4 * q], sacc[4 * q + 1]); w.y = cvtpk(sacc[4 * q + 2], sacc[4 * q + 3]); sp[2 * q] = w; }
                    for (int wrep = 0; wrep < SSD_WREP; ++wrep) { SSD_WRITE(cur ^ 1); }
                }
                SSD_ACC(5, tprev);
                __syncthreads();
                SSD_ACC(6, tprev);
            }
#undef SSD_ROWBASE
#undef SSD_PF
#undef SSD_PFV
#undef SSD_PFY
#undef SSD_SCAN
#undef SSD_WRITE
            asm volatile("s_waitcnt vmcnt(0)" ::: "memory");
        }
    }
#ifdef SSD_DIAG
    if (blockIdx.x == 0 && wave == SSD_DIAG_WAVE && lane == 0 && i == 0) { float* dg = (float*)(a.ws + WS_MOD + 900 * 1024); long long tot = 0;
        for (int k = 0; k < 7; ++k) tot += dacc[k];
        tot += dacc[8] + dacc[9] + dacc[10];
        for (int k = 0; k < 12; ++k) dg[k] = (float)dacc[k]; dg[7] = (float)tot; }
#endif
}

constexpr int AT2_KP = 208, AT2_VP = 192, AT2_KB = 64 * AT2_KP, AT2_VB = 64 * AT2_VP, AT2_BUF = AT2_KB + AT2_VB;
template <int NQ>
__device__ __forceinline__ void attn_unit2(const Args& a, LAS unsigned char* lds, int b, int h, int q0, int ntiles, bool lat) {
    const int tid = otid(a.wv), wave = tid >> 6, lane = tid & 63, r32 = lane & 31, hh = lane >> 5;
    const int tq = (lane >> 2) & 3, tp = lane & 3, tblk = (lane >> 4) & 1;
    const bf16* Qb = (const bf16*)(a.ws + WS_Q); const bf16* KVb = (const bf16*)(a.ws + WS_KV); const bf16* KR = (const bf16*)(a.ws + WS_KR); bf16* MIX = (bf16*)(a.ws + WS_MIX);
    const float* ct = (const float*)(a.ws + WS_ROPE); const float* st = ct + SEQ * 16;
    bf16x8 qf[NQ][6];
#pragma unroll
    for (int nq = 0; nq < NQ; ++nq) { const int qrow = q0 + wave * (32 * NQ) + nq * 32 + r32;
#pragma unroll
        for (int s = 0; s < 6; ++s) qf[nq][s] = *(const bf16x8*)(Qb + (size_t)qrow * QW + h * 96 + 16 * s + 8 * hh);
        if (lat) { const int t = qrow & (SEQ - 1);
#pragma unroll
            for (int j = 0; j < 8; j += 2) { float y1[2], y2[2];
#pragma unroll
                for (int e = 0; e < 2; ++e) { const float x1 = bf1((bf16)qf[nq][4][j + e]), x2 = bf1((bf16)qf[nq][5][j + e]); const float c = ct[t * 16 + 8 * hh + j + e], s = st[t * 16 + 8 * hh + j + e];
                    y1[e] = x1 * c - x2 * s; y2[e] = x1 * s + x2 * c; }
                const unsigned w1 = pk2(y1[0], y1[1]), w2 = pk2(y2[0], y2[1]);
                qf[nq][4][j] = (short)(w1 & 0xffff); qf[nq][4][j + 1] = (short)(w1 >> 16); qf[nq][5][j] = (short)(w2 & 0xffff); qf[nq][5][j + 1] = (short)(w2 >> 16); } }
        asm volatile("" : "+v"(qf[nq][0]), "+v"(qf[nq][1]), "+v"(qf[nq][2]), "+v"(qf[nq][3]), "+v"(qf[nq][4]), "+v"(qf[nq][5]) :: "memory"); }
    f32x16 o[NQ][2]; float m[NQ], l[NQ];
#pragma unroll
    for (int nq = 0; nq < NQ; ++nq) { m[nq] = -1e30f; l[nq] = 0.f;
#pragma unroll
        for (int i = 0; i < 16; ++i) { o[nq][0][i] = 0.f; o[nq][1][i] = 0.f; } }
    v4u kreg0, kreg1, vreg;
#define AT2_LOAD(it, tt) do { const unsigned off_kv = (unsigned)(((tt) >> 3) * (KVW * 2) + h * 256 + ((tt) & 7) * 16), off_kr = (unsigned)(((tt) >> 2) * 64 + ((tt) & 3) * 16); const bool k1ok = (tt) < 256; const int rb_ = (it) < CTXL / 64 ? TL + b * CTXL + (it) * 64 : b * SEQ + ((it) - CTXL / 64) * 64; \
        const char* kvb_ = (const char*)(KVb + (size_t)rb_ * KVW); const char* krb_ = (const char*)(KR + (size_t)rb_ * 32); \
        kreg0 = *(const v4u*)(kvb_ + off_kv); vreg = *(const v4u*)(kvb_ + off_kv + 128); if (k1ok) kreg1 = *(const v4u*)(krb_ + off_kr); } while (0)
#define AT2_WRITE(buf, tt) do { LAS unsigned char* kb_ = lds + (buf) * AT2_BUF; \
        *(LAS v4u*)(kb_ + ((tt) >> 3) * AT2_KP + ((tt) & 7) * 16) = kreg0; if ((tt) < 256) *(LAS v4u*)(kb_ + ((tt) >> 2) * AT2_KP + 128 + ((tt) & 3) * 16) = kreg1; \
        *(LAS v4u*)(kb_ + AT2_KB + ((tt) >> 3) * AT2_VP + ((tt) & 7) * 16) = vreg; } while (0)
    __syncthreads();
    AT2_LOAD(0, tid); AT2_WRITE(0, tid);
    __syncthreads();
    for (int it = 0; it < ntiles; ++it) {
        int tz = tid; asm volatile("" : "+v"(tz));
        const int lane_ = tz & 63, r32_ = lane_ & 31, hh_ = lane_ >> 5, tq_ = (lane_ >> 2) & 3, tp_ = lane_ & 3, tblk_ = (lane_ >> 4) & 1;
#ifdef ATT_LOADTOP
        if (it + 1 < ntiles) AT2_LOAD(it + 1, tz);
#endif
        const LAS unsigned char* kb = lds + (it & 1) * AT2_BUF; const LAS unsigned char* vb = kb + AT2_KB;
        bf16x8 pf[NQ][2][2];
        f32x16 sc[NQ][2];
#pragma unroll
        for (int nq = 0; nq < NQ; ++nq)
#pragma unroll
            for (int i = 0; i < 16; ++i) { sc[nq][0][i] = 0.f; sc[nq][1][i] = 0.f; }
#pragma unroll
        for (int s = 0; s < 6; ++s) { const bf16x8 a0 = *(const LAS bf16x8*)(kb + r32_ * AT2_KP + (16 * s + 8 * hh_) * 2); const bf16x8 a1 = *(const LAS bf16x8*)(kb + (32 + r32_) * AT2_KP + (16 * s + 8 * hh_) * 2);
#pragma unroll
            for (int nq = 0; nq < NQ; ++nq) { sc[nq][0] = __builtin_amdgcn_mfma_f32_32x32x16_bf16(a0, qf[nq][s], sc[nq][0], 0, 0, 0); sc[nq][1] = __builtin_amdgcn_mfma_f32_32x32x16_bf16(a1, qf[nq][s], sc[nq][1], 0, 0, 0); } }
#pragma unroll
        for (int nq = 0; nq < NQ; ++nq) {
            f32x16& s0 = sc[nq][0]; f32x16& s1 = sc[nq][1];
            float mx = s0[0];
#pragma unroll
            for (int i = 1; i < 16; ++i) mx = fmaxf(mx, s0[i]);
#pragma unroll
            for (int i = 0; i < 16; ++i) mx = fmaxf(mx, s1[i]);
            mx = fmaxf(mx, shx(mx, 32, lane_));
            const float mn = fmaxf(m[nq], mx * ATT_SCALE_LOG2E); const float alpha = __builtin_amdgcn_exp2f(m[nq] - mn); m[nq] = mn;
            float rs = 0.f;
#pragma unroll
            for (int i = 0; i < 16; ++i) { s0[i] = __builtin_amdgcn_exp2f(s0[i] * ATT_SCALE_LOG2E - mn); s1[i] = __builtin_amdgcn_exp2f(s1[i] * ATT_SCALE_LOG2E - mn); rs += s0[i] + s1[i]; }
            l[nq] = l[nq] * alpha + rs;
#pragma unroll
            for (int i = 0; i < 16; ++i) { o[nq][0][i] *= alpha; o[nq][1][i] *= alpha; }
#pragma unroll
            for (int s2 = 0; s2 < 2; ++s2) { v4u w0, w1;
                w0.x = cvtpk(s0[8 * s2 + 0], s0[8 * s2 + 1]); w0.y = cvtpk(s0[8 * s2 + 2], s0[8 * s2 + 3]); w0.z = cvtpk(s0[8 * s2 + 4], s0[8 * s2 + 5]); w0.w = cvtpk(s0[8 * s2 + 6], s0[8 * s2 + 7]);
                w1.x = cvtpk(s1[8 * s2 + 0], s1[8 * s2 + 1]); w1.y = cvtpk(s1[8 * s2 + 2], s1[8 * s2 + 3]); w1.z = cvtpk(s1[8 * s2 + 4], s1[8 * s2 + 5]); w1.w = cvtpk(s1[8 * s2 + 6], s1[8 * s2 + 7]);
                pf[nq][0][s2] = __builtin_bit_cast(bf16x8, w0); pf[nq][1][s2] = __builtin_bit_cast(bf16x8, w1); }
        }
#ifndef ATT_LOADTOP
        if (it + 1 < ntiles) AT2_LOAD(it + 1, tz);
#endif
#pragma unroll
        for (int t = 0; t < 2; ++t)
#pragma unroll
            for (int s2 = 0; s2 < 2; ++s2)
#pragma unroll
                for (int dt = 0; dt < 2; ++dt) {
                    const LAS unsigned char* tb = vb + (t * 32 + 16 * s2 + 4 * hh_ + tq_) * AT2_VP + (32 * dt + 16 * tblk_ + 4 * tp_) * 2;
#ifdef ATT_NOTR
                    bf16x8 vf; { const LAS unsigned short* vp_ = (const LAS unsigned short*)(vb + (t * 32 + 16 * s2 + 4 * hh_) * AT2_VP + (32 * dt + r32_) * 2);
#pragma unroll
                      for (int j_ = 0; j_ < 8; ++j_) vf[j_] = (short)vp_[((j_ & 3) + 8 * (j_ >> 2)) * (AT2_VP / 2)]; }
#else
                    const v2u lo = trread(tb), hi = trread(tb + 8 * AT2_VP); const bf16x8 vf = __builtin_bit_cast(bf16x8, (v4u){lo.x, lo.y, hi.x, hi.y});
#endif
#pragma unroll
                    for (int nq = 0; nq < NQ; ++nq) o[nq][dt] = __builtin_amdgcn_mfma_f32_32x32x16_bf16(vf, pf[nq][t][s2], o[nq][dt], 0, 0, 0); }
        if (it + 1 < ntiles) AT2_WRITE((it + 1) & 1, tz);
        __syncthreads();
    }
#undef AT2_LOAD
#undef AT2_WRITE
#pragma unroll
    for (int nq = 0; nq < NQ; ++nq) { int qrow = q0 + wave * (32 * NQ) + nq * 32 + r32; asm volatile("" : "+v"(qrow));
        const float lt = l[nq] + shx(l[nq], 32, lane); const float inv = 1.f / lt;
        bf16* orow = MIX + (size_t)qrow * D + h * 64 + 4 * hh;
#pragma unroll
        for (int g = 0; g < 4; ++g) {
            v2u w; w.x = pk2(o[nq][0][4 * g] * inv, o[nq][0][4 * g + 1] * inv); w.y = pk2(o[nq][0][4 * g + 2] * inv, o[nq][0][4 * g + 3] * inv); *(v2u*)(orow + 8 * g) = w;
            v2u x; x.x = pk2(o[nq][1][4 * g] * inv, o[nq][1][4 * g + 1] * inv); x.y = pk2(o[nq][1][4 * g + 2] * inv, o[nq][1][4 * g + 3] * inv); *(v2u*)(orow + 32 + 8 * g) = x; } }
}
__device__ __forceinline__ void attn_mfma2(const Args& a, LAS unsigned char* lds) {
#ifdef ATT_NQ1
    for (int u = blockIdx.x; u < 512; u += gridDim.x) attn_unit2<1>(a, lds, u >> 6, (u >> 3) & 7, (u >> 6) * SEQ + (u & 7) * 256, (CTXL + SEQ) / 64, true);
#else
    for (int u = blockIdx.x; u < 256; u += gridDim.x) attn_unit2<2>(a, lds, u >> 5, (u >> 2) & 7, (u >> 5) * SEQ + (u & 3) * 512, (CTXL + SEQ) / 64, true);
#endif
    for (int u = blockIdx.x; u < 64; u += gridDim.x) attn_unit2<1>(a, lds, u >> 3, u & 7, TL + (u >> 3) * CTXL, CTXL / 64, false);
}

template <int R>
__device__ __forceinline__ void rowwise2(const float* xs_lat, const float* xs_ctx, float* xd_lat, float* xd_ctx, const bf16* Mb, const float* modg, const float* nwA,
                                         bf16* H, const float* modh, int sh_off, int sc_off, const float* nwB, int nrows, int wv) {
    const int tid = otid(wv), wave = wv, lane = tid & 63; const int NGW = gridDim.x * NWAVES, gw = blockIdx.x * NWAVES + wave;
    const int rpw = (nrows + NGW - 1) / NGW; const int rbeg = gw * rpw, rend = min(rbeg + rpw, nrows);
    for (int r0 = rbeg; r0 < rend; r0 += R) {
        f32x4 v[R][4]; v2u mm[R][4];
#pragma unroll
        for (int j = 0; j < R; ++j) { const int r = min(r0 + j, rend - 1); const float* xs = r < TL ? xs_lat + (size_t)r * D : xs_ctx + (size_t)(r - TL) * D;
#pragma unroll
            for (int q = 0; q < 4; ++q) v[j][q] = *(const f32x4*)(xs + q * 256 + lane * 4);
            if (Mb) {
#pragma unroll
                for (int q = 0; q < 4; ++q) mm[j][q] = *(const v2u*)(Mb + (size_t)r * D + q * 256 + lane * 4); } }
#pragma unroll
        for (int j = 0; j < R; ++j) { const int r = r0 + j; if (r < rend) {
            const bool lat = r < TL; const int cond = lat ? (r >> 11) : 8; float* xd = lat ? xd_lat + (size_t)r * D : xd_ctx + (size_t)(r - TL) * D;
            if (Mb) {
                f32x4 m[4]; float ss = 0.f;
#pragma unroll
                for (int q = 0; q < 4; ++q) { const v2u w = mm[j][q]; m[q] = (f32x4){bflo(w.x), bfhi(w.x), bflo(w.y), bfhi(w.y)}; ss += (m[q][0] * m[q][0] + m[q][1] * m[q][1]) + (m[q][2] * m[q][2] + m[q][3] * m[q][3]); }
                const float rs = rsqrtf(wave_sum(ss, lane) * (1.f / D) + EPS);
#pragma unroll
                for (int q = 0; q < 4; ++q) { const f32x4 g = *(const f32x4*)(modg + (size_t)cond * MODW + q * 256 + lane * 4); const f32x4 w = *(const f32x4*)(nwA + q * 256 + lane * 4);
                    v[j][q] = v[j][q] + g * (m[q] * rs * w); }
            }
#pragma unroll
            for (int q = 0; q < 4; ++q) *(f32x4*)(xd + q * 256 + lane * 4) = v[j][q];
            if (H) {
                float ss = 0.f;
#pragma unroll
                for (int q = 0; q < 4; ++q) ss += (v[j][q][0] * v[j][q][0] + v[j][q][1] * v[j][q][1]) + (v[j][q][2] * v[j][q][2] + v[j][q][3] * v[j][q][3]);
                const float rs = rsqrtf(wave_sum(ss, lane) * (1.f / D) + EPS);
#pragma unroll
                for (int q = 0; q < 4; ++q) { const int c = q * 256 + lane * 4;
                    const f32x4 w = *(const f32x4*)(nwB + c); const f32x4 sc = *(const f32x4*)(modh + (size_t)cond * MODW + sc_off + c); const f32x4 sh = *(const f32x4*)(modh + (size_t)cond * MODW + sh_off + c);
                    const f32x4 hv = (v[j][q] * rs * w) * (sc + 1.0f) + sh;
                    v2u o; o.x = pk2(hv[0], hv[1]); o.y = pk2(hv[2], hv[3]); *(v2u*)(H + (size_t)r * D + c) = o; }
            } } }
    }
}

__device__ __forceinline__ void convgate2(const Args& a, int l, int nrows) {
    const bf16* U = (const bf16*)(a.ws + WS_U); bf16* G = (bf16*)(a.ws + WS_G); const float* cw = a.in[I_FCONV] + (size_t)l * 3 * UPW;
    const int total = (nrows / 8) * (DFF / 8);
    for (int idx = blockIdx.x * NTHR + otid(a.wv); idx < total; idx += gridDim.x * NTHR) {
        const int r0 = (idx / (DFF / 8)) * 8, c0 = (idx % (DFF / 8)) * 8; const bf16* u = U + (size_t)r0 * UPW + c0;
        const bool hp = has_prev(r0), hn = has_next(r0 + 7);
        v4u ua[10], ug[10];
#pragma unroll
        for (int j = 0; j < 10; ++j) { const int rr = (j == 0 && !hp) ? 0 : ((j == 9 && !hn) ? 7 : j - 1); ua[j] = *(const v4u*)(u + (ptrdiff_t)rr * UPW); ug[j] = *(const v4u*)(u + (ptrdiff_t)rr * UPW + DFF); }
        float wa[3][8], wg[3][8];
#pragma unroll
        for (int t = 0; t < 3; ++t)
#pragma unroll
            for (int j = 0; j < 8; ++j) { wa[t][j] = cw[t * UPW + c0 + j]; wg[t][j] = cw[t * UPW + DFF + c0 + j]; }
        if (!hp) { ua[0] = (v4u){0u, 0u, 0u, 0u}; ug[0] = ua[0]; }
        if (!hn) { ua[9] = (v4u){0u, 0u, 0u, 0u}; ug[9] = ua[9]; }
        float pa[8], ca[8], na[8], pg[8], cg_[8], ng[8];
        unpack8(ua[0], pa); unpack8(ug[0], pg); unpack8(ua[1], ca); unpack8(ug[1], cg_);
#pragma unroll
        for (int j = 0; j < 8; ++j) {
            unpack8(ua[j + 2], na); unpack8(ug[j + 2], ng);
            float o[8];
#pragma unroll
            for (int k = 0; k < 8; ++k) { const float act = wa[0][k] * pa[k] + wa[1][k] * ca[k] + wa[2][k] * na[k]; const float gate = wg[0][k] * pg[k] + wg[1][k] * cg_[k] + wg[2][k] * ng[k]; o[k] = silu_f(act) * gate; }
            *(v4u*)(G + (size_t)(r0 + j) * DFF + c0) = pack8(o);
#pragma unroll
            for (int k = 0; k < 8; ++k) { pa[k] = ca[k]; ca[k] = na[k]; pg[k] = cg_[k]; cg_[k] = ng[k]; }
        }
    }
}

__device__ __forceinline__ void ssd_conv2(const Args& a, int i) {
    const bf16* ZX = (const bf16*)(a.ws + WS_ZX); bf16* XBC = (bf16*)(a.ws + WS_XBC); float* DT = (float*)(a.ws + WS_DT); float* AA = (float*)(a.ws + WS_AA);
    const float* cw = a.in[I_SCONVW] + (size_t)i * 3 * 3072; const float* cb = a.in[I_SCONVB] + (size_t)i * 3072;
    const int total = (T / 8) * 384;
    for (int idx = blockIdx.x * NTHR + otid(a.wv); idx < total; idx += gridDim.x * NTHR) {
        const int r0 = (idx / 384) * 8, c0 = (idx % 384) * 8; const bf16* u = ZX + (size_t)r0 * SSD_INP + 2048 + c0;
        const bool hp = has_prev(r0), hn = has_next(r0 + 7);
        v4u ux[10];
#pragma unroll
        for (int j = 0; j < 10; ++j) { const int rr = (j == 0 && !hp) ? 0 : ((j == 9 && !hn) ? 7 : j - 1); ux[j] = *(const v4u*)(u + (ptrdiff_t)rr * SSD_INP); }
        float w[3][8], bias[8];
#pragma unroll
        for (int j = 0; j < 8; ++j) { w[0][j] = cw[c0 + j]; w[1][j] = cw[3072 + c0 + j]; w[2][j] = cw[2 * 3072 + c0 + j]; bias[j] = cb[c0 + j]; }
        if (!hp) ux[0] = (v4u){0u, 0u, 0u, 0u};
        if (!hn) ux[9] = (v4u){0u, 0u, 0u, 0u};
        float p[8], c[8], n[8];
        unpack8(ux[0], p); unpack8(ux[1], c);
#pragma unroll
        for (int j = 0; j < 8; ++j) {
            unpack8(ux[j + 2], n); float o[8];
#pragma unroll
            for (int k = 0; k < 8; ++k) o[k] = silu_f(bias[k] + w[0][k] * p[k] + w[1][k] * c[k] + w[2][k] * n[k]);
            *(v4u*)(XBC + (size_t)(r0 + j) * 3072 + c0) = pack8(o);
#pragma unroll
            for (int k = 0; k < 8; ++k) { p[k] = c[k]; c[k] = n[k]; }
        }
    }
    const float* alog = a.in[I_ALOG] + i * 64; const float* dtb = a.in[I_DTB] + i * 64;
    for (int idx = blockIdx.x * NTHR + otid(a.wv); idx < T * 8; idx += gridDim.x * NTHR) {
        const int r = idx >> 3, j0 = (idx & 7) * 8; float raw[8], dt[8], av[8];
        unpack8(*(const v4u*)(ZX + (size_t)r * SSD_INP + 5120 + j0), raw);
#pragma unroll
        for (int k = 0; k < 8; ++k) { const float x = raw[k] + dtb[j0 + k]; dt[k] = x > 15.f ? x : (x < -15.f ? __expf(x) : __logf(1.f + __expf(x))); av[k] = -__expf(alog[j0 + k]) * dt[k]; }
        *(f32x4*)(DT + (size_t)r * 64 + j0) = (f32x4){dt[0], dt[1], dt[2], dt[3]}; *(f32x4*)(DT + (size_t)r * 64 + j0 + 4) = (f32x4){dt[4], dt[5], dt[6], dt[7]};
        *(f32x4*)(AA + (size_t)r * 64 + j0) = (f32x4){av[0], av[1], av[2], av[3]}; *(f32x4*)(AA + (size_t)r * 64 + j0 + 4) = (f32x4){av[4], av[5], av[6], av[7]};
    }
}

__device__ __forceinline__ void gatenorm2(const Args& a, int i, int nrows) {
    const int tid = otid(a.wv), wave = a.wv, lane = tid & 63; const int NGW = gridDim.x * NWAVES, gw = blockIdx.x * NWAVES + wave;
    const bf16* ZX = (const bf16*)(a.ws + WS_ZX); bf16* YN = (bf16*)(a.ws + WS_XBC); const float* nw = a.in[I_SNORM] + i * 2048;
    const int rpw = (nrows + NGW - 1) / NGW; const int rbeg = gw * rpw, rend = min(rbeg + rpw, nrows);
    constexpr int R = 3;
    for (int r0 = rbeg; r0 < rend; r0 += R) {
        v4u yv[R][4], zv[R][4];
#pragma unroll
        for (int j = 0; j < R; ++j) { const int r = min(r0 + j, rend - 1);
#pragma unroll
            for (int q = 0; q < 4; ++q) { const int c = q * 512 + lane * 8; yv[j][q] = *(const v4u*)(ZX + (size_t)r * SSD_INP + 2048 + c); zv[j][q] = *(const v4u*)(ZX + (size_t)r * SSD_INP + c); } }
#pragma unroll
        for (int j = 0; j < R; ++j) { const int r = r0 + j; if (r < rend) {
            float v[4][8]; float ss = 0.f;
#pragma unroll
            for (int q = 0; q < 4; ++q) { float y[8], z[8]; unpack8(yv[j][q], y); unpack8(zv[j][q], z);
#pragma unroll
                for (int k = 0; k < 8; ++k) { v[q][k] = y[k] * silu_f(z[k]); ss += v[q][k] * v[q][k]; } }
            const float rs = rsqrtf(wave_sum(ss, lane) * (1.f / 2048.f) + EPS);
#pragma unroll
            for (int q = 0; q < 4; ++q) { const int c = q * 512 + lane * 8; float o[8];
#pragma unroll
                for (int k = 0; k < 8; ++k) o[k] = v[q][k] * rs * nw[c + k];
                *(v4u*)(YN + (size_t)r * 2048 + c) = pack8(o); } } }
    }
}

__device__ __forceinline__ void ffn_fixup(const Args& a, int l, int nrows) {
    const bf16* Ue = (const bf16*)(a.ws + WS_UE); bf16* G = (bf16*)(a.ws + WS_G); const float* cw = a.in[I_FCONV] + (size_t)l * 3 * UPW;
    const int total = (nrows / 256) * 2 * (DFF / 8);
    for (int idx = blockIdx.x * NTHR + otid(a.wv); idx < total; idx += gridDim.x * NTHR) {
        const int cg = idx % (DFF / 8), which = (idx / (DFF / 8)) & 1, pm = idx / (2 * (DFF / 8)); const int c0 = cg * 8; const int col = (c0 / 128) * 256 + (c0 % 128);
        const int r = pm * 256 + (which ? 255 : 0);
        const bf16* e0 = Ue + (size_t)(pm * 4) * UPW + col;
        const bf16* pp = which ? e0 + 2 * UPW : e0 - UPW;
        const bf16* pc = which ? e0 + 3 * UPW : e0;
        const bf16* pn = which ? e0 + 4 * UPW : e0 + UPW;
        const bool hp = which ? true : has_prev(r), hn = which ? has_next(r) : true;
        float pa[8], pg[8], ca[8], cg_[8], na[8], ng[8];
        unpack8(*(const v4u*)pc, ca); unpack8(*(const v4u*)(pc + 128), cg_);
        if (hp) { unpack8(*(const v4u*)pp, pa); unpack8(*(const v4u*)(pp + 128), pg); } else {
#pragma unroll
            for (int k = 0; k < 8; ++k) { pa[k] = 0.f; pg[k] = 0.f; } }
        if (hn) { unpack8(*(const v4u*)pn, na); unpack8(*(const v4u*)(pn + 128), ng); } else {
#pragma unroll
            for (int k = 0; k < 8; ++k) { na[k] = 0.f; ng[k] = 0.f; } }
        float o[8];
#pragma unroll
        for (int k = 0; k < 8; ++k) { const float act = cw[c0 + k] * pa[k] + cw[UPW + c0 + k] * ca[k] + cw[2 * UPW + c0 + k] * na[k];
            const float gate = cw[DFF + c0 + k] * pg[k] + cw[UPW + DFF + c0 + k] * cg_[k] + cw[2 * UPW + DFF + c0 + k] * ng[k]; o[k] = silu_f(act) * gate; }
        *(v4u*)(G + (size_t)r * DFF + c0) = pack8(o);
    }
}

__device__ __forceinline__ void prep_even2(const Args& a, int i) {
    const int tid = otid(a.wv), wave = a.wv, lane = tid & 63; const int NGW = gridDim.x * NWAVES, gw = blockIdx.x * NWAVES + wave;
    const bf16* P = (const bf16*)(a.ws + WS_P); bf16* CQN = (bf16*)(a.ws + WS_CQN); bf16* CKVN = (bf16*)(a.ws + WS_CKVN); bf16* KR = (bf16*)(a.ws + WS_KR); bf16* MIX = (bf16*)(a.ws + WS_MIX);
    const float* qn = a.in[I_QNORM] + i * 384; const float* kvn = a.in[I_KVNORM] + i * 256; const float* cw = a.in[I_SCONV] + i * 3 * 512;
    const float* ct = (const float*)(a.ws + WS_ROPE); const float* st = ct + SEQ * 16;
    constexpr int R = 3; const int rpw = (T + NGW - 1) / NGW; const int rbeg = gw * rpw, rend = min(rbeg + rpw, T);
    const int c0 = lane * 8;
    for (int r0 = rbeg; r0 < rend; r0 += R) {
        unsigned q32[R][3]; v2u kv2[R]; bf16 krv[R]; v4u gbv[R], gcv[R + 2], xvv[R + 2];
#pragma unroll
        for (int j = 0; j < R; ++j) { const int r = min(r0 + j, rend - 1); const bf16* p = P + (size_t)r * HYB_INP;
            const unsigned* p32 = (const unsigned*)(p + lane * 6); q32[j][0] = p32[0]; q32[j][1] = p32[1]; q32[j][2] = p32[2];
            kv2[j] = *(const v2u*)(p + 384 + lane * 4); krv[j] = p[640 + (lane & 31)]; gbv[j] = *(const v4u*)(p + 672 + c0); }
#pragma unroll
        for (int j = 0; j < R + 2; ++j) { int r = r0 + j - 1; r = max(0, min(r, T - 1)); const bf16* p = P + (size_t)r * HYB_INP; gcv[j] = *(const v4u*)(p + 1184 + c0); xvv[j] = *(const v4u*)(p + 1696 + c0); }
#pragma unroll
        for (int j = 0; j < R; ++j) { const int r = r0 + j; if (r < rend) {
            {   float f[6] = {bflo(q32[j][0]), bfhi(q32[j][0]), bflo(q32[j][1]), bfhi(q32[j][1]), bflo(q32[j][2]), bfhi(q32[j][2])}; float ss = 0.f;
#pragma unroll
                for (int k = 0; k < 6; ++k) ss += f[k] * f[k];
                const float rs = rsqrtf(wave_sum(ss, lane) * (1.f / 384.f) + EPS);
#pragma unroll
                for (int k = 0; k < 6; ++k) f[k] = f[k] * rs * qn[lane * 6 + k];
                unsigned* o32 = (unsigned*)(CQN + (size_t)r * 384 + lane * 6); o32[0] = pk2(f[0], f[1]); o32[1] = pk2(f[2], f[3]); o32[2] = pk2(f[4], f[5]); }
            {   const v2u w = kv2[j]; float f[4] = {bflo(w.x), bfhi(w.x), bflo(w.y), bfhi(w.y)};
                const float ss = (f[0] * f[0] + f[1] * f[1]) + (f[2] * f[2] + f[3] * f[3]);
                const float rs = rsqrtf(wave_sum(ss, lane) * (1.f / 256.f) + EPS);
                const f32x4 g = *(const f32x4*)(kvn + lane * 4);
                v2u o; o.x = pk2(f[0] * rs * g[0], f[1] * rs * g[1]); o.y = pk2(f[2] * rs * g[2], f[3] * rs * g[3]); *(v2u*)(CKVN + (size_t)r * 256 + lane * 4) = o; }
            {   const int jj = lane & 31; const float v = bf1(krv[j]); const float o = shx(v, 16, lane); float res = v;
                if (r < TL) { const int t = r & (SEQ - 1); const float c = ct[t * 16 + (jj & 15)], s = st[t * 16 + (jj & 15)]; res = (jj < 16) ? v * c - o * s : o * s + v * c; }
                if (lane < 32) KR[(size_t)r * 32 + jj] = (bf16)f2bf(res); }
            {   float gb[8], t0[8], t1[8], acc[8];
                unpack8(gbv[j], gb); unpack8(gcv[j + 1], t0); unpack8(xvv[j + 1], t1);
#pragma unroll
                for (int k = 0; k < 8; ++k) acc[k] = cw[512 + c0 + k] * (t0[k] * t1[k]);
                if (has_prev(r)) { unpack8(gcv[j], t0); unpack8(xvv[j], t1);
#pragma unroll
                    for (int k = 0; k < 8; ++k) acc[k] += cw[c0 + k] * (t0[k] * t1[k]); }
                if (has_next(r)) { unpack8(gcv[j + 2], t0); unpack8(xvv[j + 2], t1);
#pragma unroll
                    for (int k = 0; k < 8; ++k) acc[k] += cw[1024 + c0 + k] * (t0[k] * t1[k]); }
#pragma unroll
                for (int k = 0; k < 8; ++k) acc[k] *= gb[k];
                *(v4u*)(MIX + (size_t)r * D + 512 + c0) = pack8(acc); }
        } }
    }
}

__device__ __forceinline__ void ffn_fixup_panel(const Args& a, int l, int pm) {
    const bf16* Ue = (const bf16*)(a.ws + WS_UE); bf16* G = (bf16*)(a.ws + WS_G); const float* cw = a.in[I_FCONV] + (size_t)l * 3 * UPW;
    for (int idx = otid(a.wv); idx < 2 * (DFF / 8); idx += NTHR) {
        const int cg = idx % (DFF / 8), which = idx / (DFF / 8); const int c0 = cg * 8; const int col = (c0 / 128) * 256 + (c0 % 128);
        const int r = pm * 256 + (which ? 255 : 0);
        const bf16* e0 = Ue + (size_t)(pm * 4) * UPW + col;
        const bf16* pp = which ? e0 + 2 * UPW : e0 - UPW; const bf16* pc = which ? e0 + 3 * UPW : e0; const bf16* pn = which ? e0 + 4 * UPW : e0 + UPW;
        const bool hp = which ? true : has_prev(r), hn = which ? has_next(r) : true;
        float pa[8], pg[8], ca[8], cg_[8], na[8], ng[8];
        unpack8(*(const v4u*)pc, ca); unpack8(*(const v4u*)(pc + 128), cg_);
        if (hp) { unpack8(*(const v4u*)pp, pa); unpack8(*(const v4u*)(pp + 128), pg); } else {
#pragma unroll
            for (int k = 0; k < 8; ++k) { pa[k] = 0.f; pg[k] = 0.f; } }
        if (hn) { unpack8(*(const v4u*)pn, na); unpack8(*(const v4u*)(pn + 128), ng); } else {
#pragma unroll
            for (int k = 0; k < 8; ++k) { na[k] = 0.f; ng[k] = 0.f; } }
        float o[8];
#pragma unroll
        for (int k = 0; k < 8; ++k) { const float act = cw[c0 + k] * pa[k] + cw[UPW + c0 + k] * ca[k] + cw[2 * UPW + c0 + k] * na[k];
            const float gate = cw[DFF + c0 + k] * pg[k] + cw[UPW + DFF + c0 + k] * cg_[k] + cw[2 * UPW + DFF + c0 + k] * ng[k]; o[k] = silu_f(act) * gate; }
        *(v4u*)(G + (size_t)r * DFF + c0) = pack8(o);
    }
}

#ifndef MK_SINGLE
#define MK_SINGLE 1
#endif
struct GemmDesc { const bf16* A; const bf16* Bt; int M, N, K; bf16* O; int ldc; int mode; };

__global__ void __launch_bounds__(NTHR, 2) fwd_kernel(Args a_in) {
    extern __shared__ __attribute__((aligned(16))) unsigned char lds_raw[];
    LAS unsigned char* lds = (LAS unsigned char*)lds_raw;
#if MK_SINGLE == 1
    volatile LAS unsigned* bst = (volatile LAS unsigned*)(lds + LDS_BYTES - 64);
    const int wv0 = __builtin_amdgcn_readfirstlane((int)threadIdx.x >> 6);
    { const int t0 = otid(wv0); if (t0 < 16) bst[t0] = 0u; }
    __syncthreads();
    const XcdBarrier xbar = xcd_barrier_post((unsigned*)(a_in.ws + WS_CTL), bst, wv0);
#endif
    const Args& a0 = a_in;
#ifdef TDIAG
    unsigned long long tcat[6] = {0, 0, 0, 0, 0, 0}; unsigned long long tlast = __builtin_amdgcn_s_memrealtime();
#endif
    for (int s = a0.lo; s < a0.hi; ++s) {
        Args a = a0;
        { long oz; asm volatile("s_mov_b64 %0, 0" : "=s"(oz));
#pragma unroll
          for (int q = 0; q < 25; ++q) a.in[q] = (const float*)((const char*)a0.in[q] + oz);
          a.out = (float*)((char*)a0.out + oz); a.ws = a0.ws + oz; a.wv = wv0; }
        unsigned char* ws = a.ws;
        float* XL = a.out; float* XC = (float*)(ws + WS_XC); bf16* H = (bf16*)(ws + WS_H); bf16* Mb = (bf16*)(ws + WS_M);
        const float* MOD = (const float*)(ws + WS_MOD); const float* NW = a.in[I_NORMW];
        int nrep = 1;
#ifdef PROBE_MASK
        if (s == 0 && (PROBE_MASK >> 20 & 1u)) nrep = 2;
        if (s >= 2) { const int pk = (s - 2) % 10, ppar = ((s - 2) / 10) & 1; if ((PROBE_MASK >> (pk + 10 * ppar)) & 1u) nrep = 2; }
#endif
        for (int rep = 0; rep < nrep; ++rep) {
        GemmDesc g0{}, g1{}; int ng = 0;
#ifndef NO_SIMPLE
        if (s == 0) {
            mod_compute(a, lds);
            rope_tables(a);
            convert_layer(a, 0, lds);
        } else if (s == 1) {
            rowwise2<3>(a.in[I_X], a.in[I_CTX], XL, XC, nullptr, nullptr, nullptr, H, MOD, 0, 1024, NW, T, a.wv);
        } else {
            const int l = (s - 2) / 10, k = (s - 2) % 10, i = l >> 1; const bool even = (l & 1) == 0, last = (l == 3);
            const int MR = last ? TL : T;
            switch (k) {
            case 0:
                if (even) { g0 = GemmDesc{H, (const bf16*)(ws + W_IN), T, HYB_INP, D, (bf16*)(ws + WS_P), HYB_INP}; ng = 1; }
                else      { g0 = GemmDesc{H, (const bf16*)(ws + W_IN), T, SSD_INP, D, (bf16*)(ws + WS_ZX), SSD_INP}; ng = 1; }
                break;
            case 1: if (even) prep_even2(a, i); else ssd_conv2(a, i); break;
            case 2:
                if (even) { { g0 = GemmDesc{(const bf16*)(ws + WS_CQN), (const bf16*)(ws + W_UQ), T, QW, 384, (bf16*)(ws + WS_Q), QW}; ng = 1; }
                            g1 = GemmDesc{(const bf16*)(ws + WS_CKVN), (const bf16*)(ws + W_UKV), T, KVW, 256, (bf16*)(ws + WS_KV), KVW}; ng = 2; }
                else {
#ifdef SSD_NAIVE
 ssd_scan_naive(a, i, last, lds);
#else
 ssd_scan_mfma(a, i, last, lds);
#endif
 }
                break;
            case 3: if (even) {
#ifdef ATTN_NAIVE
 attn_naive(a, lds);
#else
 attn_mfma(a, lds);
#endif
 } else gatenorm2(a, i, MR); break;
            case 4:
                if (even) { g0 = GemmDesc{(const bf16*)(ws + WS_MIX), (const bf16*)(ws + W_OUT), MR, D, D, Mb, D}; ng = 1; }
                else      { g0 = GemmDesc{(const bf16*)(ws + WS_XBC), (const bf16*)(ws + W_OUT), MR, D, 2048, Mb, D}; ng = 1; }
                break;
            case 5:
#ifdef PROBE_ROW2
                if (l > 0) rowwise2<3>(XL, XC, XL, XC, nullptr, nullptr, nullptr, H, MOD + (size_t)l * 9 * MODW, 0, 1024, NW + (l * 4 + 0) * D, MR, a.wv);
#endif
                rowwise2<3>(XL, XC, XL, XC, Mb, MOD + (size_t)l * 9 * MODW + 2048, NW + (l * 4 + 1) * D, H, MOD + (size_t)l * 9 * MODW, 3072, 4096, NW + (l * 4 + 2) * D, MR, a.wv); break;
            case 6: { g0 = GemmDesc{H, (const bf16*)(ws + W_UP), MR, UPW, D, (bf16*)(ws + WS_G), DFF, 1}; ng = 1; } break;
            case 7: break;
            case 8: { g0 = GemmDesc{(const bf16*)(ws + WS_G), (const bf16*)(ws + W_DN), MR, D, DFF, Mb, D}; ng = 1;
                      pg8::StaticOrder S0; S0.init(MR, D, (int)gridDim.x, (int)blockIdx.x); pg8::Unit u0; int lastpm = -1;
                      for (int ui0 = 0; S0.next(ui0, u0); ++ui0) if (u0.pm != lastpm) { ffn_fixup_panel(a, l, u0.pm); lastpm = u0.pm; }
                      asm volatile("s_waitcnt vmcnt(0)" ::: "memory"); __syncthreads(); } break;
            case 9:
                if (!last) { rowwise2<3>(XL, XC, XL, XC, Mb, MOD + (size_t)l * 9 * MODW + 5120, NW + (l * 4 + 3) * D, H, MOD + (size_t)(l + 1) * 9 * MODW, 0, 1024, NW + ((l + 1) * 4 + 0) * D, T, a.wv);
                             convert_layer(a, l + 1, lds); }
                else rowwise2<3>(XL, XC, XL, XC, Mb, MOD + (size_t)l * 9 * MODW + 5120, NW + (l * 4 + 3) * D, nullptr, MOD, 0, 0, NW, TL, a.wv);
                break;
            }
        }
#else
        { g0 = GemmDesc{H, (const bf16*)(ws + W_IN), T, a.hi * 256, a.lo * 128, (bf16*)(ws + WS_P), HYB_INP}; ng = 1; }
#endif
        for (int gi = 0; gi < ng; ++gi) {
            const bool f = (gi == 0);
            pg8::Gemm g{f ? g0.A : g1.A, f ? g0.Bt : g1.Bt, f ? g0.M : g1.M, f ? g0.N : g1.N, f ? g0.K : g1.K, a.wv,
#ifdef GDIAG
                (s == GDIAG_STEP) ? (float*)(a0.ws + WS_MOD + 900 * 1024) : nullptr
#else
                nullptr
#endif
            }; pg8::StaticOrder S; S.init(g.M, g.N, (int)gridDim.x, (int)blockIdx.x);
            pg8::EpiFfn E{f ? g0.O : g1.O, f ? g0.ldc : g1.ldc, f ? g0.mode : 0, (bf16*)(ws + WS_UE), a.in[I_FCONV] + (size_t)((s - 2) / 10) * 3 * UPW, (LAS pg8::f32x4*)(lds + 131072), a.wv};
#ifndef NO_GEMM
            pg8::gemm_phase<pg8::EpiFfn, pg8::StaticOrder, true, true>(lds, g, S, E);
#endif
            __syncthreads();
        }
        if (rep + 1 < nrep) __syncthreads();
        }
#ifdef GDIAG
        if (s + 1 == a0.hi) { __syncthreads(); asm volatile("s_waitcnt vmcnt(0)" ::: "memory"); if (blockIdx.x == 0 && otid(wv0) == 0) { const float* dg = (const float*)(a0.ws + WS_MOD + 900 * 1024); a0.out[0] += 25.0f * dg[GDIAG_SEL] / dg[3]; } }
#endif
#ifdef SSD_DIAG
        if (s + 1 == a0.hi) { __syncthreads(); asm volatile("s_waitcnt vmcnt(0)" ::: "memory"); if (blockIdx.x == 0 && otid(wv0) == 0) { const float* dg = (const float*)(a0.ws + WS_MOD + 900 * 1024); a0.out[0] += 25.0f * dg[SSD_DIAG_SEL] / dg[7]; } }
#endif
#ifdef TDIAG
        if (s + 1 == a0.hi) { __syncthreads(); }
#endif
        if (s + 1 < a0.hi && !(s >= 2 && (s - 2) % 10 == 7)) {
#if MK_SINGLE == 1
            xcd_barrier(xbar);
#ifdef PROBE_BAR2
            xcd_barrier(xbar);
#endif
#elif MK_SINGLE == 2
            cg::this_grid().sync();
#endif
        }
#ifdef TDIAG
        { const unsigned long long tn = __builtin_amdgcn_s_memrealtime(); int cat = 0;
          if (s >= 2) { const int k = (s - 2) % 10, par = ((s - 2) / 10) & 1; cat = (k == 0 || k == 4 || k == 6 || k == 8 || (k == 2 && par == 0)) ? 1 : ((k == 5 || k == 9) ? 2 : ((k == 3 && par == 0) ? 4 : ((k == 2 && par == 1) ? 5 : 3)));
#ifdef TDIAG_K
              cat = (k == TDIAG_K && (TDIAG_PAR == 2 || par == TDIAG_PAR)) ? 1 : 3;
#endif
          }
#pragma unroll
          for (int q = 0; q < 6; ++q) if (q == cat) tcat[q] += tn - tlast;
          tlast = tn;
          if (s + 1 == a0.hi) { asm volatile("s_waitcnt vmcnt(0)" ::: "memory"); if (blockIdx.x == 0 && otid(wv0) == 0) { unsigned long long tt = 0;
#pragma unroll
              for (int q = 0; q < 6; ++q) tt += tcat[q];
              a0.out[0] += (TDIAG == 6) ? (float)tt * (1.0f / 20000.0f) : 25.0f * (float)tcat[TDIAG < 6 ? TDIAG : 0] / (float)tt; } } }
#endif
    }
}

extern "C" void kernel_launch(void* const* d_in, const int* in_sizes, int n_in, void* d_out, int out_size, void* d_ws, size_t ws_size, hipStream_t stream) {
    static int grid = 0;
    if (grid == 0) {
        if (n_in != 25 || out_size != TL * D || ws_size < WS_END) { fprintf(stderr, "kernel_launch: unexpected problem (n_in %d out %d ws %zu need %zu)\n", n_in, out_size, ws_size, (size_t)WS_END); grid = -1; return; }
        if (hipFuncSetAttribute((const void*)fwd_kernel, hipFuncAttributeMaxDynamicSharedMemorySize, LDS_BYTES) != hipSuccess) { fprintf(stderr, "kernel_launch: hipFuncSetAttribute failed\n"); grid = -1; return; }
        int dev = 0, cus = 0, per_cu = 0;
        hipGetDevice(&dev); hipDeviceGetAttribute(&cus, hipDeviceAttributeMultiprocessorCount, dev);
        hipOccupancyMaxActiveBlocksPerMultiprocessor(&per_cu, (const void*)fwd_kernel, NTHR, LDS_BYTES);
        (void)hipGetLastError();
        if (per_cu < 1) { fprintf(stderr, "kernel_launch: occupancy query says %d blocks per CU\n", per_cu); }
        grid = cus;
    }
    if (grid < 0) return;
#if MK_SINGLE == 1
    if (hipMemsetAsync((char*)d_ws + WS_CTL, 0, CTL_ZERO_BYTES, stream) != hipSuccess) { fprintf(stderr, "kernel_launch: memset failed\n"); return; }
#endif
    Args a{};
    for (int i = 0; i < 25; ++i) a.in[i] = (const float*)d_in[i];
    a.out = (float*)d_out; a.ws = (unsigned char*)d_ws;
#if MK_SINGLE
    a.lo = 0; a.hi = NSTEP + 1;
    void* args[] = {&a};
    hipError_t e = hipLaunchCooperativeKernel((const void*)fwd_kernel, dim3(grid), dim3(NTHR), args, LDS_BYTES, stream);
    if (e != hipSuccess) fprintf(stderr, "cooperative launch failed: %s (grid %d)\n", hipGetErrorString(e), grid);
#else
    for (int s = 0; s < NSTEP + 1; ++s) { a.lo = s; a.hi = s + 1; hipLaunchKernelGGL(fwd_kernel, dim3(grid), dim3(NTHR), LDS_BYTES, stream, a); }
#endif
}
```

```cpp
#include <hip/hip_runtime.h>
#include <hip/hip_cooperative_groups.h>
#include <cstdio>
#include <cstdint>
namespace cg = cooperative_groups;
__device__ __forceinline__ int otid(int wv) { int l; asm volatile("v_mbcnt_lo_u32_b32 %0, -1, 0\n\tv_mbcnt_hi_u32_b32 %0, -1, %0" : "=v"(l)); return (wv << 6) | l; }
__device__ __forceinline__ float shx(float v, int mask, int lane) { return __builtin_bit_cast(float, __builtin_amdgcn_ds_bpermute((lane ^ mask) << 2, __builtin_bit_cast(int, v))); }
#define LAS __attribute__((address_space(3)))
typedef float f32x2_cv __attribute__((ext_vector_type(2))); typedef __bf16 bf16x2_cv __attribute__((ext_vector_type(2)));
__device__ __forceinline__ unsigned hw_cvtpk(float lo, float hi) { f32x2_cv v = {lo, hi}; bf16x2_cv b = __builtin_convertvector(v, bf16x2_cv); return __builtin_bit_cast(unsigned, b); }
#define XB_TMO      128
#define XB_XCNT(j)  (256  + 64 * (j))
#define XB_XSUB(j)  (1280 + 64 * (j))
#define XB_XGEN(j)  (2304 + 64 * (j))
#define XB_TOP      3328
#define XB_TOPGEN   3392
#define XCD_BAR_WORDS 3456
#define XB_SPIN_CAP (1u << 18)

__device__ __forceinline__ unsigned xb_ld(unsigned* p)              { return __hip_atomic_load(p, __ATOMIC_RELAXED, __HIP_MEMORY_SCOPE_AGENT); }
__device__ __forceinline__ unsigned xb_add(unsigned* p, unsigned v) { return __hip_atomic_fetch_add(p, v, __ATOMIC_RELAXED, __HIP_MEMORY_SCOPE_AGENT); }
__device__ __forceinline__ unsigned xb_xcc_id() { return (unsigned)__builtin_amdgcn_s_getreg((3 << 11) | 20) & 0xFu; }
#define XB_SPIN(cond, bar) do { unsigned _sp = 0; while (cond) { __builtin_amdgcn_s_sleep(1); \
    if ((++_sp & 255u) == 0u) { if (xb_ld(&(bar)[XB_TMO])) break; if (_sp > XB_SPIN_CAP) { atomicAdd(&(bar)[XB_TMO], 1u); break; } } } } while (0)

struct XcdBarrier {
    unsigned* bar; unsigned x; int wv;
    volatile LAS unsigned* st;
};

__device__ __forceinline__ XcdBarrier xcd_barrier_post(unsigned* bar, volatile LAS unsigned* st, int wv) {
    XcdBarrier b; b.bar = bar; b.x = xb_xcc_id(); b.st = st; b.wv = wv;
    if (otid(wv) == 0) (void)xb_add(&bar[XB_XCNT(b.x)], 1u);
    return b;
}
__device__ __forceinline__ void xcd_barrier_complete(unsigned* bar, unsigned x, unsigned& nloc, unsigned& nx) {
    const unsigned G = gridDim.x * gridDim.y * gridDim.z;
    unsigned sum, cnt, mine, sp = 0u;
    for (;;) {
        sum = 0u; cnt = 0u; mine = 0u;
#pragma unroll
        for (unsigned j = 0; j < 16; ++j) { const unsigned c = xb_ld(&bar[XB_XCNT(j)]); sum += c; cnt += (c > 0u) ? 1u : 0u; mine = (j == x) ? c : mine; }
        if (sum == G) break;
        __builtin_amdgcn_s_sleep(1);
        if ((++sp & 255u) == 0u) { if (xb_ld(&bar[XB_TMO])) break; if (sp > XB_SPIN_CAP) { atomicAdd(&bar[XB_TMO], 1u); break; } }
    }
    nloc = mine > 0u ? mine : 1u; nx = cnt > 0u ? cnt : 1u;
}

__device__ __forceinline__ void xcd_barrier(const XcdBarrier& b) {
    asm volatile("s_waitcnt vmcnt(0)" ::: "memory");
    __syncthreads();
    if (otid(b.wv) == 0) {
        unsigned* bar = b.bar;
        __builtin_amdgcn_s_waitcnt(0);
        unsigned nloc = b.st[0], nx = b.st[1];
        if (nloc == 0u) { xcd_barrier_complete(bar, b.x, nloc, nx); b.st[0] = nloc; b.st[1] = nx; }
        const unsigned old = xb_add(&bar[XB_XSUB(b.x)], 1u);
        const unsigned gen = old / nloc;
        if (old + 1u == (gen + 1u) * nloc) {
            __builtin_amdgcn_fence(__ATOMIC_RELEASE, "agent");
            asm volatile("s_waitcnt vmcnt(0)" ::: "memory");
            const unsigned og = xb_add(&bar[XB_TOP], 1u);
            const unsigned tg = og / nx;
            if (og + 1u == (tg + 1u) * nx) xb_add(&bar[XB_TOPGEN], 1u);
            else XB_SPIN(xb_ld(&bar[XB_TOPGEN]) == tg, bar);
            __builtin_amdgcn_fence(__ATOMIC_ACQUIRE, "agent");
            xb_add(&bar[XB_XGEN(b.x)], 1u);
            asm volatile("s_waitcnt vmcnt(0)" ::: "memory");
        } else {
            XB_SPIN(xb_ld(&bar[XB_XGEN(b.x)]) == gen, bar);
            __builtin_amdgcn_fence(__ATOMIC_ACQUIRE, "agent");
            asm volatile("s_waitcnt vmcnt(0)" ::: "memory");
        }
    }
    __syncthreads();
}
namespace pg8 {
#define PG8_LAS __attribute__((address_space(3)))
typedef unsigned short bf16_t;
typedef short bf16x8 __attribute__((ext_vector_type(8)));
typedef float f32x4 __attribute__((ext_vector_type(4)));
typedef unsigned u32x4 __attribute__((ext_vector_type(4)));
constexpr int BM = 256, BK = 64, HALF = 128, HTB = HALF * BK * 2  , STAGE_BYTES = 8 * HTB, NXCD = 8, WGM = 8;

__host__ __device__ __forceinline__ int lds_byte(int r, int c) { const int st = (r >> 4) * 2 + (c >> 5), rr = r & 15, cc = c & 31, ob = rr * 64 + cc * 2; return st * 1024 + (ob ^ (((ob >> 9) & 1) << 5)); }
__host__ __device__ __forceinline__ void stage_rc(int b, int& R, int& C) { const int st = b / 1024, sb = b % 1024, swz = sb ^ (((sb >> 9) & 1) << 5); R = (st >> 1) * 16 + swz / 64; C = (st & 1) * 32 + (swz % 64) / 2; }
__host__ __device__ __forceinline__ int perm32(int rho) { const int n = rho >> 4, i = rho & 15; return 8 * (i >> 2) + 4 * n + (i & 3); }

struct Unit { int pm, pn; };
struct Gemm { const bf16_t* A; const bf16_t* Bt; int M, N, K, wv; float* dg; };

struct StaticOrder {
    int nM, nN, nwg, G, c;
    __host__ __device__ void init(int M, int N, int G_, int c_) { nM = M / BM; nN = N / BM; nwg = nM * nN; G = G_; c = c_; }
    __host__ __device__ bool next(int i, Unit& u) const {
        const long L = (long)i * G + c; if (L >= nwg) return false;
        int wgid = (int)L; { const int q = nwg / NXCD, r = nwg % NXCD, xcd = wgid % NXCD, off = wgid / NXCD; wgid = (xcd < r ? xcd * (q + 1) : r * (q + 1) + (xcd - r) * q) + off; }
        const int nig = WGM * nN, gid = wgid / nig, fm = gid * WGM, gsz = (nM - fm) < WGM ? (nM - fm) : WGM;
        u.pm = fm + ((wgid % nig) % gsz); u.pn = (wgid % nig) / gsz; return true;
    }
    __device__ __forceinline__ void a_ready(const Unit&) const {}
    __device__ __forceinline__ void done(const Unit&) const {}
};

__device__ __forceinline__ unsigned cvt_pk_bf16(float lo, float hi) { return hw_cvtpk(lo, hi); }
struct EpiStore {
    static constexpr bool PERM = true, AFTER_DRAIN = false;
    bf16_t* O; int ldc;
    __device__ __forceinline__ void operator()(const f32x4 (&acc)[2][2][4][2], const Unit& u, int wr, int wc, int fr, int fq) const {
        const int row0 = u.pm * BM + wr * 64 + fr; const int col0 = u.pn * BM + wc * 32 + 8 * fq;
#pragma unroll
        for (int ai = 0; ai < 2; ++ai)
#pragma unroll
            for (int m = 0; m < 4; ++m) { bf16_t* rowp = O + (size_t)(row0 + ai * HALF + m * 16) * ldc + col0;
#pragma unroll
                for (int bj = 0; bj < 2; ++bj) { const f32x4 v0 = acc[ai][bj][m][0], v1 = acc[ai][bj][m][1];
                    u32x4 w; w.x = cvt_pk_bf16(v0[0], v0[1]); w.y = cvt_pk_bf16(v0[2], v0[3]); w.z = cvt_pk_bf16(v1[0], v1[1]); w.w = cvt_pk_bf16(v1[2], v1[3]);
                    *(u32x4*)(rowp + bj * HALF) = w; } }
    }
};

template <int CTRL> __device__ __forceinline__ float dpprot(float src) { return __builtin_bit_cast(float, __builtin_amdgcn_mov_dpp(__builtin_bit_cast(int, src), CTRL, 0xf, 0xf, true)); }
template <int CTRL> __device__ __forceinline__ float dppf(float old, float src) { return __builtin_bit_cast(float, __builtin_amdgcn_update_dpp(__builtin_bit_cast(int, old), __builtin_bit_cast(int, src), CTRL, 0xf, 0xf, false)); }
#define PG8_DPP4(dst, oldv, srcv, ctrl) do { dst[0] = dppf<ctrl>(oldv[0], srcv[0]); dst[1] = dppf<ctrl>(oldv[1], srcv[1]); dst[2] = dppf<ctrl>(oldv[2], srcv[2]); dst[3] = dppf<ctrl>(oldv[3], srcv[3]); } while (0)
struct EpiFfn {
    static constexpr bool PERM = true, AFTER_DRAIN = false;
    bf16_t* O; int ldc; int mode;
    bf16_t* Ue; const float* cw; PG8_LAS f32x4* ex; int wv;
    __device__ __forceinline__ void operator()(const f32x4 (&acc)[2][2][4][2], const Unit& u, int wr, int wc, int fr_in, int fq_in) const {
        (void)fr_in; (void)fq_in; const int lane_e = otid(wv) & 63; const int fr = lane_e & 15, fq = lane_e >> 4;
        if (mode == 0) {
            const int row0 = u.pm * BM + wr * 64 + fr; const int col0 = u.pn * BM + wc * 32 + 8 * fq;
#pragma unroll
            for (int ai = 0; ai < 2; ++ai)
#pragma unroll
                for (int m = 0; m < 4; ++m) { bf16_t* rowp = O + (size_t)(row0 + ai * HALF + m * 16) * ldc + col0;
#pragma unroll
                    for (int bj = 0; bj < 2; ++bj) { const f32x4 v0 = acc[ai][bj][m][0], v1 = acc[ai][bj][m][1];
                        u32x4 w; w.x = cvt_pk_bf16(v0[0], v0[1]); w.y = cvt_pk_bf16(v0[2], v0[3]); w.z = cvt_pk_bf16(v1[0], v1[1]); w.w = cvt_pk_bf16(v1[2], v1[3]);
                        *(u32x4*)(rowp + bj * HALF) = w; } }
            return;
        }
        const int chl = wc * 32 + 8 * fq, ch = u.pn * 128 + chl;
        f32x4 wA[3][2], wG[3][2];
#pragma unroll
        for (int t = 0; t < 3; ++t)
#pragma unroll
            for (int n = 0; n < 2; ++n) { wA[t][n] = *(const f32x4*)(cw + t * 5632 + ch + 4 * n); wG[t][n] = *(const f32x4*)(cw + t * 5632 + 2816 + ch + 4 * n); }
#define PG8_EX(blk, fl, bj, n) ex[((((blk) * 2 + (fl)) * 2 + (bj)) * 2 + (n)) * 16 + wc * 4 + fq]
#pragma unroll
        for (int ai = 0; ai < 2; ++ai) { const int blk = ai * 2 + wr;
            const bool lastr = fr == 15;
#pragma unroll
            for (int bj = 0; bj < 2; ++bj)
#pragma unroll
                for (int n = 0; n < 2; ++n) { const f32x4 a0 = acc[ai][bj][0][n], a3 = acc[ai][bj][3][n]; f32x4 v;
#pragma unroll
                    for (int e = 0; e < 4; ++e) v[e] = lastr ? a3[e] : a0[e];
                    if (fr == 0 || lastr) ex[((((blk) * 2 + (lastr ? 1 : 0)) * 2 + bj) * 2 + n) * 16 + wc * 4 + fq] = v; } }
        asm volatile("s_waitcnt lgkmcnt(0)" ::: "memory"); __builtin_amdgcn_s_barrier(); asm volatile("" ::: "memory");
        const f32x4 zero4 = (f32x4){0.f, 0.f, 0.f, 0.f}; const bool is15 = fr == 15, is0 = fr == 0;
#pragma unroll
        for (int ai = 0; ai < 2; ++ai) { const int blk = ai * 2 + wr;
            f32x4 pb[2][2], nb[2][2];
#pragma unroll
            for (int bj = 0; bj < 2; ++bj)
#pragma unroll
                for (int n = 0; n < 2; ++n) { pb[bj][n] = blk > 0 ? PG8_EX(blk - 1, 1, bj, n) : zero4; nb[bj][n] = blk < 3 ? PG8_EX(blk + 1, 0, bj, n) : zero4; }
#pragma unroll
            for (int m = 0; m < 4; ++m) {
                f32x4 cv[2][2];
#pragma unroll
                for (int bj = 0; bj < 2; ++bj)
#pragma unroll
                    for (int n = 0; n < 2; ++n) { const f32x4 cur = acc[ai][bj][m][n];
                        const f32x4 lo = (m == 0) ? pb[bj][n] : acc[ai][bj][m > 0 ? m - 1 : 0][n];
                        const f32x4 hi = (m == 3) ? nb[bj][n] : acc[ai][bj][m < 3 ? m + 1 : 3][n];
                        f32x4 prev, next;
#pragma unroll
                        for (int e = 0; e < 4; ++e) { prev[e] = dpprot<0x121>(is15 ? lo[e] : cur[e]);
                                                      next[e] = dpprot<0x12F>(is0 ? hi[e] : cur[e]); }
                        const f32x4 w0 = bj ? wG[0][n] : wA[0][n], w1 = bj ? wG[1][n] : wA[1][n], w2 = bj ? wG[2][n] : wA[2][n];
                        cv[bj][n] = w0 * prev + w1 * cur + w2 * next; }
                u32x4 w; float g[8];
#pragma unroll
                for (int n = 0; n < 2; ++n)
#pragma unroll
                    for (int e = 0; e < 4; ++e) { const float av = cv[0][n][e]; g[4 * n + e] = av * __builtin_amdgcn_rcpf(1.f + __expf(-av)) * cv[1][n][e]; }
                w.x = cvt_pk_bf16(g[0], g[1]); w.y = cvt_pk_bf16(g[2], g[3]); w.z = cvt_pk_bf16(g[4], g[5]); w.w = cvt_pk_bf16(g[6], g[7]);
                *(u32x4*)(O + (size_t)(u.pm * BM + ai * HALF + wr * 64 + m * 16 + fr) * 2816 + ch) = w;
            } }
#undef PG8_EX
        { const int slot = (wr == 0) ? (fr == 0 ? 0 : (fr == 1 ? 1 : -1)) : (fr == 14 ? 2 : (fr == 15 ? 3 : -1));
          if (slot >= 0) { bf16_t* up = Ue + ((size_t)(u.pm * 4 + slot) * 5632) + u.pn * 256 + chl;
#pragma unroll
              for (int bj = 0; bj < 2; ++bj) { const f32x4 a0 = acc[0][bj][0][0], a1 = acc[0][bj][0][1], b0 = acc[1][bj][3][0], b1 = acc[1][bj][3][1]; f32x4 v0, v1;
#pragma unroll
                  for (int e = 0; e < 4; ++e) { v0[e] = wr ? b0[e] : a0[e]; v1[e] = wr ? b1[e] : a1[e]; }
                  u32x4 w; w.x = cvt_pk_bf16(v0[0], v0[1]); w.y = cvt_pk_bf16(v0[2], v0[3]); w.z = cvt_pk_bf16(v1[0], v1[1]); w.w = cvt_pk_bf16(v1[2], v1[3]);
                  *(u32x4*)(up + bj * HALF) = w; } } }
    }
};
template <class Epi, class Sched, bool ALIGN_EPI = false, bool SP2 = false>
__device__ __forceinline__ void gemm_phase(PG8_LAS unsigned char* lds, const Gemm g, const Sched& S, const Epi& E) {
    const int tid = otid(g.wv), wid = g.wv, lane = tid & 63, wr = wid >> 2, wc = wid & 3, fr = lane & 15, fq = lane >> 4;
    const int K = g.K, nt = K / BK;
    unsigned voffA[2], voffB[2];
#pragma unroll
    for (int i = 0; i < 2; ++i) { int R, C; stage_rc(tid * 16 + i * 8192, R, C); const int Rb = Epi::PERM ? ((R & ~31) + perm32(R & 31)) : R;
        voffA[i] = (unsigned)(R * K + C) * 2u; voffB[i] = (unsigned)(Rb * K + C) * 2u; }
    const size_t kstep = (size_t)(BK * 2);
    const size_t hstep = (size_t)HALF * K * 2;
    const size_t tstep = 2 * hstep;
    const unsigned ldsw = (unsigned)wid * 1024u;
    const int aoff = lds_byte(wr * 64 + fr, fq * 8), boff = lds_byte(wc * 32 + fr, fq * 8);
#define PG8_SA(b, h) (((b) * 2 + (h)) * HTB)
#define PG8_SB(b, h) ((4 + (b) * 2 + (h)) * HTB)
#define PG8_STAGE(bufoff, gbase, voff) do { _Pragma("unroll") for (int _i = 0; _i < 2; ++_i) \
        __builtin_amdgcn_global_load_lds((const unsigned*)((const char*)(gbase) + (voff)[_i]), (PG8_LAS unsigned*)(lds + (bufoff) + ldsw + _i * 8192), 16, 0, 0); } while (0)
#define PG8_LDA(dst, b, h) do { _Pragma("unroll") for (int m = 0; m < 4; ++m) _Pragma("unroll") for (int k = 0; k < 2; ++k) dst[m][k] = *(const PG8_LAS bf16x8*)(lds + PG8_SA(b, h) + aoff + m * 2048 + k * 1024); } while (0)
#define PG8_LDB(dst, b, h) do { _Pragma("unroll") for (int n = 0; n < 2; ++n) _Pragma("unroll") for (int k = 0; k < 2; ++k) dst[n][k] = *(const PG8_LAS bf16x8*)(lds + PG8_SB(b, h) + boff + n * 2048 + k * 1024); } while (0)
#define PG8_MMA(ai, bj, At, Bt) do { __builtin_amdgcn_s_setprio(1); _Pragma("unroll") for (int m = 0; m < 4; ++m) _Pragma("unroll") for (int n = 0; n < 2; ++n) _Pragma("unroll") for (int k = 0; k < 2; ++k) \
        acc[ai][bj][m][n] = __builtin_amdgcn_mfma_f32_16x16x32_bf16(Bt[n][k], At[m][k], acc[ai][bj][m][n], 0, 0, 0); __builtin_amdgcn_s_setprio(0); } while (0)
#define PG8_WAIT_V(n) asm volatile("s_waitcnt vmcnt(" #n ")" ::: "memory")
#define PG8_WAIT_L(n) asm volatile("s_waitcnt lgkmcnt(" #n ")" ::: "memory")
#define PG8_BAR __builtin_amdgcn_s_barrier()
#define PG8_SCHED __builtin_amdgcn_sched_barrier(0)
    Unit cur, nxt; int ui = 0;
#ifdef GDIAG
    unsigned gd0 = 0, gd1 = 0, gd2 = 0; const unsigned gstart = (unsigned)__builtin_amdgcn_s_memtime();
#endif
    if (!S.next(0, cur)) return;
    f32x4 acc[2][2][4][2];
#pragma unroll
    for (int a = 0; a < 2; ++a)
#pragma unroll
        for (int b = 0; b < 2; ++b)
#pragma unroll
            for (int m = 0; m < 4; ++m)
#pragma unroll
                for (int n = 0; n < 2; ++n) acc[a][b][m][n] = (f32x4){0.f, 0.f, 0.f, 0.f};
    bf16x8 At[4][2], B0[2][2], B1[2][2];
    const char* cA = (const char*)g.A + (size_t)cur.pm * tstep; const char* cB = (const char*)g.Bt + (size_t)cur.pn * tstep;
    S.a_ready(cur);
    if constexpr (SP2) {
        PG8_STAGE(PG8_SB(0, 0), cB, voffB); PG8_STAGE(PG8_SB(0, 1), cB + hstep, voffB); PG8_STAGE(PG8_SA(0, 0), cA, voffA); PG8_STAGE(PG8_SA(0, 1), cA + hstep, voffA);
        if (wr == 1) PG8_BAR;
        PG8_WAIT_V(2); PG8_BAR;
        PG8_STAGE(PG8_SB(1, 0), cB + kstep, voffB); PG8_STAGE(PG8_SA(1, 0), cA + kstep, voffA); PG8_STAGE(PG8_SB(1, 1), cB + hstep + kstep, voffB);
        PG8_WAIT_V(6); PG8_BAR;
    } else {
        PG8_STAGE(PG8_SB(0, 0), cB, voffB); PG8_STAGE(PG8_SA(0, 0), cA, voffA); PG8_STAGE(PG8_SB(0, 1), cB + hstep, voffB); PG8_STAGE(PG8_SA(0, 1), cA + hstep, voffA);
        if (wr == 1) PG8_BAR;
        PG8_WAIT_V(4); PG8_BAR;
        PG8_STAGE(PG8_SB(1, 0), cB + kstep, voffB); PG8_STAGE(PG8_SA(1, 0), cA + kstep, voffA); PG8_STAGE(PG8_SB(1, 1), cB + hstep + kstep, voffB);
        PG8_WAIT_V(6); PG8_BAR;
    }
    for (;;) {
        const bool has_next = S.next(ui + 1, nxt);
        const char* nA = has_next ? (const char*)g.A + (size_t)nxt.pm * tstep : cA; const char* nB = has_next ? (const char*)g.Bt + (size_t)nxt.pn * tstep : cB;
#ifdef GDIAG
        unsigned gt0 = (unsigned)__builtin_amdgcn_s_memtime();
#endif
        for (int t = 0; t < nt; t += 2) {
            const bool last = (t == nt - 2);
            const char* a1 = cA + (size_t)(t + 1) * kstep;
            const char* a2 = last ? nA : cA + (size_t)(t + 2) * kstep; const char* b2 = last ? nB : cB + (size_t)(t + 2) * kstep;
            const char* a3 = a2 + kstep; const char* b3 = b2 + kstep;
            if (last && has_next) S.a_ready(nxt);
            if constexpr (SP2) {
            PG8_LDB(B0, 0, 0); PG8_LDB(B1, 0, 1); PG8_SCHED; PG8_LDA(At, 0, 0); PG8_STAGE(PG8_SA(1, 1), a1 + hstep, voffA);
            PG8_WAIT_V(8); PG8_WAIT_L(0); PG8_BAR; PG8_MMA(0, 0, At, B0); PG8_MMA(0, 1, At, B1); PG8_BAR; PG8_SCHED;
            PG8_LDA(At, 0, 1); PG8_STAGE(PG8_SB(0, 0), b2, voffB); PG8_STAGE(PG8_SB(0, 1), b2 + hstep, voffB); PG8_STAGE(PG8_SA(0, 0), a2, voffA);
            PG8_WAIT_V(8); PG8_WAIT_L(0); PG8_BAR; PG8_MMA(1, 0, At, B0); PG8_MMA(1, 1, At, B1); PG8_BAR; PG8_SCHED;
            PG8_LDB(B0, 1, 0); PG8_LDB(B1, 1, 1); PG8_SCHED; PG8_LDA(At, 1, 0); PG8_STAGE(PG8_SA(0, 1), a2 + hstep, voffA);
            PG8_WAIT_V(8); PG8_WAIT_L(0); PG8_BAR; PG8_MMA(0, 0, At, B0); PG8_MMA(0, 1, At, B1); PG8_BAR; PG8_SCHED;
            PG8_LDA(At, 1, 1); PG8_STAGE(PG8_SB(1, 0), b3, voffB); PG8_STAGE(PG8_SB(1, 1), b3 + hstep, voffB); PG8_STAGE(PG8_SA(1, 0), a3, voffA);
            PG8_WAIT_V(8); PG8_WAIT_L(0); PG8_BAR; PG8_MMA(1, 0, At, B0); PG8_MMA(1, 1, At, B1); PG8_BAR; PG8_SCHED;
            } else {
            PG8_LDB(B0, 0, 0); PG8_SCHED; PG8_LDA(At, 0, 0); PG8_STAGE(PG8_SA(1, 1), a1 + hstep, voffA);
            PG8_WAIT_L(8); PG8_BAR; PG8_WAIT_L(0); PG8_MMA(0, 0, At, B0); PG8_BAR; PG8_SCHED;
            PG8_LDB(B1, 0, 1); PG8_STAGE(PG8_SB(0, 0), b2, voffB);
            PG8_BAR; PG8_WAIT_L(0); PG8_MMA(0, 1, At, B1); PG8_BAR;
            PG8_LDA(At, 0, 1); PG8_STAGE(PG8_SA(0, 0), a2, voffA);
            PG8_BAR; PG8_WAIT_L(0); PG8_MMA(1, 0, At, B0); PG8_BAR; PG8_SCHED;
            PG8_STAGE(PG8_SB(0, 1), b2 + hstep, voffB);
            PG8_WAIT_V(6); PG8_BAR; PG8_MMA(1, 1, At, B1); PG8_BAR;
            PG8_LDB(B0, 1, 0); PG8_SCHED; PG8_LDA(At, 1, 0); PG8_STAGE(PG8_SA(0, 1), a2 + hstep, voffA);
            PG8_WAIT_L(8); PG8_BAR; PG8_WAIT_L(0); PG8_MMA(0, 0, At, B0); PG8_BAR; PG8_SCHED;
            PG8_LDB(B1, 1, 1); PG8_STAGE(PG8_SB(1, 0), b3, voffB);
            PG8_BAR; PG8_WAIT_L(0); PG8_MMA(0, 1, At, B1); PG8_BAR;
            PG8_LDA(At, 1, 1); PG8_STAGE(PG8_SA(1, 0), a3, voffA);
            PG8_BAR; PG8_WAIT_L(0); PG8_MMA(1, 0, At, B0); PG8_BAR; PG8_SCHED;
            PG8_STAGE(PG8_SB(1, 1), b3 + hstep, voffB);
            PG8_WAIT_V(6); PG8_BAR; PG8_MMA(1, 1, At, B1); PG8_BAR;
            }
        }
#ifdef GDIAG
        { const unsigned n_ = (unsigned)__builtin_amdgcn_s_memtime(); gd0 += n_ - gt0; gt0 = n_; }
#endif
        if constexpr (ALIGN_EPI) { if (wr == 0) PG8_BAR; }
#ifdef GDIAG
        { const unsigned n_ = (unsigned)__builtin_amdgcn_s_memtime(); gd1 += n_ - gt0; gt0 = n_; }
#endif
        if constexpr (!Epi::AFTER_DRAIN) { E(acc, cur, wr, wc, fr, fq); S.done(cur); }
#ifdef GDIAG
        { const unsigned n_ = (unsigned)__builtin_amdgcn_s_memtime(); gd2 += n_ - gt0; gt0 = n_; }
#endif
        if (!has_next) break;
#pragma unroll
        for (int a = 0; a < 2; ++a)
#pragma unroll
            for (int b = 0; b < 2; ++b)
#pragma unroll
                for (int m = 0; m < 4; ++m)
#pragma unroll
                    for (int n = 0; n < 2; ++n) acc[a][b][m][n] = (f32x4){0.f, 0.f, 0.f, 0.f};
        cur = nxt; cA = nA; cB = nB; ++ui;
        if constexpr (ALIGN_EPI) { if (wr == 1) PG8_BAR; }
    }
#ifdef GDIAG
    if (g.dg && blockIdx.x == 0 && wid == GDIAG_WAVE && lane == 0) { const unsigned tot = (unsigned)__builtin_amdgcn_s_memtime() - gstart; g.dg[0] = (float)gd0; g.dg[1] = (float)gd1; g.dg[2] = (float)gd2; g.dg[3] = (float)tot; }
#endif
    PG8_WAIT_V(0);
    if constexpr (!ALIGN_EPI) { if (wr == 0) PG8_BAR; }
    PG8_BAR;
    if constexpr (Epi::AFTER_DRAIN) { E.fused(acc, cur, wr, wc, fr, fq, lds, wid, lane); S.done(cur); }
#undef PG8_SA
#undef PG8_SB
#undef PG8_STAGE
#undef PG8_LDA
#undef PG8_LDB
#undef PG8_MMA
#undef PG8_WAIT_V
#undef PG8_WAIT_L
#undef PG8_BAR
#undef PG8_SCHED
}
}

typedef unsigned short bf16;
typedef unsigned v4u __attribute__((ext_vector_type(4)));
typedef unsigned v2u __attribute__((ext_vector_type(2)));
typedef float f32x4 __attribute__((ext_vector_type(4)));
constexpr int NWAVES = 8, NTHR = 512;
constexpr int D = 1024, NB = 8, SEQ = 2048, CTXL = 256, TL = NB * SEQ, TC = NB * CTXL, T = TL + TC;
constexpr int HYB_IN = 2208, HYB_INP = 2304, SSD_IN = 5184, SSD_INP = 5376, DFF = 2816, UPW = 5632;
constexpr int QW = 768, KVW = 1024, MODW = 6144;
constexpr float EPS = 1e-6f;
constexpr int NSTEP = 1 + 4 * 10;
constexpr float ATT_SCALE_LOG2E = 0.10206207261596577f * 1.4426950408889634f;

constexpr size_t MiB = 1u << 20;
constexpr size_t WS_CTL = 0, CTL_ZERO_BYTES = 64 * 1024;
constexpr size_t WS_MOD = 1 * MiB;
constexpr size_t WS_ROPE = 2 * MiB;
constexpr size_t W_UP = 3 * MiB;
constexpr size_t W_DN = W_UP + (size_t)UPW * D * 2;
constexpr size_t W_IN = W_DN + (size_t)D * DFF * 2;
constexpr size_t W_OUT = W_IN + (size_t)SSD_INP * D * 2;
constexpr size_t W_UQ = W_OUT + (size_t)D * 2048 * 2;
constexpr size_t W_UKV = W_UQ + (size_t)QW * 384 * 2;
constexpr size_t W_END = W_UKV + (size_t)KVW * 256 * 2;
constexpr size_t WS_XC = 36 * MiB;
constexpr size_t WS_H = 44 * MiB;
constexpr size_t WS_DT = WS_H, WS_AA = WS_H + (size_t)T * 64 * 4;
constexpr size_t WS_BIG = 80 * MiB;
constexpr size_t WS_M = WS_BIG;
constexpr size_t WS_P = WS_BIG;
constexpr size_t WS_Q = WS_BIG + 81 * MiB;
constexpr size_t WS_KV = WS_BIG + 108 * MiB;
constexpr size_t WS_KR = WS_BIG + 144 * MiB;
constexpr size_t WS_CQN = WS_BIG + 146 * MiB;
constexpr size_t WS_CKVN = WS_BIG + 160 * MiB;
constexpr size_t WS_MIX = WS_BIG + 170 * MiB;
constexpr size_t WS_U = WS_BIG;
constexpr size_t WS_G = WS_BIG + 198 * MiB;
constexpr size_t WS_ZX = WS_BIG;
constexpr size_t WS_XBC = WS_BIG + 189 * MiB;
constexpr size_t WS_UE = WS_BIG + 297 * MiB;
constexpr size_t WS_END = WS_UE + 4 * MiB;
static_assert(W_END <= WS_XC && WS_G + (size_t)T * DFF * 2 <= WS_END && WS_XBC + (size_t)T * 3072 * 2 <= WS_END && WS_ZX + (size_t)T * SSD_INP * 2 <= WS_XBC, "ws map");
static_assert(WS_AA + (size_t)T * 64 * 4 <= WS_BIG && WS_MIX + (size_t)T * D * 2 <= WS_END && WS_Q + (size_t)T * QW * 2 <= WS_KV && WS_P + (size_t)T * HYB_INP * 2 <= WS_Q, "ws map 2");
constexpr int LDS_BYTES = 147456;

struct Args { const float* in[25]; float* out; unsigned char* ws; int lo, hi; int wv, pad; };
enum { I_X = 0, I_C, I_CTX, I_CCTX, I_MODW, I_MODB, I_NORMW, I_WUP, I_FCONV, I_WDN, I_HIN, I_QNORM, I_KVNORM, I_WUQ, I_WUKV, I_SCONV, I_HOUT, I_SIN, I_SCONVW, I_SCONVB, I_ALOG, I_DTB, I_SD, I_SNORM, I_SOUT };

__device__ __forceinline__ unsigned f2bf(float f) { unsigned u = __builtin_bit_cast(unsigned, f); return (u + 0x7fffu + ((u >> 16) & 1u)) >> 16; }
__device__ __forceinline__ unsigned pk2(float lo, float hi) { return hw_cvtpk(lo, hi); }
__device__ __forceinline__ float bflo(unsigned u) { return __builtin_bit_cast(float, u << 16); }
__device__ __forceinline__ float bfhi(unsigned u) { return __builtin_bit_cast(float, u & 0xffff0000u); }
__device__ __forceinline__ float bf1(bf16 b) { return __builtin_bit_cast(float, (unsigned)b << 16); }
__device__ __forceinline__ float silu_f(float x) { return x * __builtin_amdgcn_rcpf(1.f + __expf(-x)); }
__device__ __forceinline__ float wave_sum(float v, int lane) {
#pragma unroll
    for (int o = 1; o < 64; o <<= 1) v += shx(v, o, lane);
    return v;
}
__device__ __forceinline__ void unpack8(const v4u w, float (&f)[8]) { f[0] = bflo(w.x); f[1] = bfhi(w.x); f[2] = bflo(w.y); f[3] = bfhi(w.y); f[4] = bflo(w.z); f[5] = bfhi(w.z); f[6] = bflo(w.w); f[7] = bfhi(w.w); }
__device__ __forceinline__ v4u pack8(const float (&f)[8]) { v4u w; w.x = pk2(f[0], f[1]); w.y = pk2(f[2], f[3]); w.z = pk2(f[4], f[5]); w.w = pk2(f[6], f[7]); return w; }
__device__ __forceinline__ bool has_prev(int r) { return r < TL ? (r & (SEQ - 1)) != 0 : ((r - TL) & (CTXL - 1)) != 0; }
__device__ __forceinline__ bool has_next(int r) { return r < TL ? (r & (SEQ - 1)) != SEQ - 1 : ((r - TL) & (CTXL - 1)) != CTXL - 1; }

__device__ __forceinline__ void mod_compute(const Args& a, LAS unsigned char* lds) {
    LAS float* sc = (LAS float*)lds;
    LAS float* red = (LAS float*)(lds + 36864);
    const int tid = otid(a.wv);
    float* MOD = (float*)(a.ws + WS_MOD);
    for (int i = tid; i < 9 * 1024; i += NTHR) { const int c = i >> 10, k = i & 1023; const float v = c < 8 ? a.in[I_C][c * 1024 + k] : a.in[I_CCTX][k]; sc[i] = silu_f(v); }
    __syncthreads();
    for (int item = blockIdx.x; item < 4 * 96; item += gridDim.x) {
        const int l = item / 96, cb = item % 96;
        const float* W = a.in[I_MODW] + (size_t)l * 1024 * MODW + cb * 64;
        const int cgp = tid & 15, kg = tid >> 4;
        float acc[9][4];
#pragma unroll
        for (int c = 0; c < 9; ++c) { acc[c][0] = 0.f; acc[c][1] = 0.f; acc[c][2] = 0.f; acc[c][3] = 0.f; }
#pragma unroll 8
        for (int kk = 0; kk < 32; ++kk) { const int k = kg * 32 + kk; const f32x4 w = *(const f32x4*)(W + (size_t)k * MODW + cgp * 4);
#pragma unroll
            for (int c = 0; c < 9; ++c) { const float s = sc[c * 1024 + k]; acc[c][0] += s * w[0]; acc[c][1] += s * w[1]; acc[c][2] += s * w[2]; acc[c][3] += s * w[3]; } }
#pragma unroll
        for (int c = 0; c < 9; ++c)
#pragma unroll
            for (int j = 0; j < 4; ++j) red[kg * 576 + c * 64 + cgp * 4 + j] = acc[c][j];
        __syncthreads();
        for (int o = tid; o < 576; o += NTHR) { float s = 0.f;
            for (int g = 0; g < 32; ++g) s += red[g * 576 + o];
            const int c = o >> 6, col = o & 63; MOD[(size_t)(l * 9 + c) * MODW + cb * 64 + col] = s + a.in[I_MODB][l * MODW + cb * 64 + col]; }
        __syncthreads();
    }
}
__device__ __forceinline__ void rope_tables(const Args& a) {
    float* ct = (float*)(a.ws + WS_ROPE); float* st = ct + SEQ * 16;
    for (int i = blockIdx.x * NTHR + otid(a.wv); i < SEQ * 16; i += gridDim.x * NTHR) {
        const int t = i >> 4, j = i & 15; const int pos = j < 8 ? (t >> 6) : (t & 63); const int f = j & 7;
        const float i0 = (f & 1) ? 0.31622776601683794f : 1.0f; const int e = f >> 1; const float i1 = e == 0 ? 1.0f : (e == 1 ? 0.1f : (e == 2 ? 0.01f : 0.001f));
        const float inv = i0 * i1; const float ang = (float)pos * inv;
        ct[i] = __cosf(ang); st[i] = __sinf(ang); }
}
__device__ __forceinline__ void transpose_item(const float* W, int K, int N, bf16* WT, LAS float* scr, int item, int lane, bool ffn_perm) {
    const int nblk = N / 32, kb = item / nblk, nb = item % nblk, k0 = 64 * kb, n0 = 32 * nb;
    const int o0 = ffn_perm ? ((n0 % DFF) / 128) * 256 + (n0 / DFF) * 128 + (n0 % 128) : n0;
    float wv_[32];
#pragma unroll
    for (int i = 0; i < 32; ++i) wv_[i] = W[(size_t)(k0 + 2 * i + (lane >> 5)) * N + n0 + (lane & 31)];
#pragma unroll
    for (int i = 0; i < 32; ++i) scr[(2 * i + (lane >> 5)) * 33 + (lane & 31)] = wv_[i];
    asm volatile("s_waitcnt lgkmcnt(0)" ::: "memory");
    const int c = lane & 7;
#pragma unroll
    for (int j = 0; j < 4; ++j) { const int n = (lane >> 3) + 8 * j; const LAS float* s = scr + (8 * c) * 33 + n;
        v4u o; o.x = pk2(s[0 * 33], s[1 * 33]); o.y = pk2(s[2 * 33], s[3 * 33]); o.z = pk2(s[4 * 33], s[5 * 33]); o.w = pk2(s[6 * 33], s[7 * 33]);
        *(v4u*)(WT + (size_t)(o0 + n) * K + k0 + 8 * c) = o; }
    asm volatile("s_waitcnt lgkmcnt(0)" ::: "memory");
}
__device__ __forceinline__ void convert_weight(const float* W, int K, int N, int Npad, bf16* WT, LAS unsigned char* lds, int rot, int wv, bool ffn_perm = false) {
    const int wave = wv, lane = otid(wv) & 63; const int NGW = gridDim.x * NWAVES; const int gw = (blockIdx.x * NWAVES + wave + rot) % NGW;
    LAS float* scr = (LAS float*)(lds + wave * 16384);
    const int nitems = (K / 64) * (N / 32);
    for (int it = gw; it < nitems; it += NGW) transpose_item(W, K, N, WT, scr, it, lane, ffn_perm);
    (void)Npad;
}
__device__ __forceinline__ void convert_layer(const Args& a, int l, LAS unsigned char* lds) {
    const int i = l >> 1; unsigned char* ws = a.ws;
    convert_weight(a.in[I_WUP] + (size_t)l * D * UPW, D, UPW, UPW, (bf16*)(ws + W_UP), lds, 0, a.wv, true);
    convert_weight(a.in[I_WDN] + (size_t)l * DFF * D, DFF, D, D, (bf16*)(ws + W_DN), lds, 300, a.wv);
    if ((l & 1) == 0) {
        convert_weight(a.in[I_HIN] + (size_t)i * D * HYB_IN, D, HYB_IN, HYB_INP, (bf16*)(ws + W_IN), lds, 700, a.wv);
        convert_weight(a.in[I_HOUT] + (size_t)i * D * D, D, D, D, (bf16*)(ws + W_OUT), lds, 1100, a.wv);
        convert_weight(a.in[I_WUQ] + (size_t)i * 384 * QW, 384, QW, QW, (bf16*)(ws + W_UQ), lds, 1500, a.wv);
        convert_weight(a.in[I_WUKV] + (size_t)i * 256 * KVW, 256, KVW, KVW, (bf16*)(ws + W_UKV), lds, 1700, a.wv);
    } else {
        convert_weight(a.in[I_SIN] + (size_t)i * D * SSD_IN, D, SSD_IN, SSD_INP, (bf16*)(ws + W_IN), lds, 700, a.wv);
        convert_weight(a.in[I_SOUT] + (size_t)i * 2048 * D, 2048, D, D, (bf16*)(ws + W_OUT), lds, 1300, a.wv);
    }
}

__device__ __forceinline__ void prep_even(const Args& a, int i) {
    const int wave = otid(a.wv) >> 6, lane = otid(a.wv) & 63; const int NGW = gridDim.x * NWAVES, gw = blockIdx.x * NWAVES + wave;
    const bf16* P = (const bf16*)(a.ws + WS_P); bf16* CQN = (bf16*)(a.ws + WS_CQN); bf16* CKVN = (bf16*)(a.ws + WS_CKVN); bf16* KR = (bf16*)(a.ws + WS_KR); bf16* MIX = (bf16*)(a.ws + WS_MIX);
    const float* qn = a.in[I_QNORM] + i * 384; const float* kvn = a.in[I_KVNORM] + i * 256; const float* cw = a.in[I_SCONV] + i * 3 * 512;
    const float* ct = (const float*)(a.ws + WS_ROPE); const float* st = ct + SEQ * 16;
    for (int r = gw; r < T; r += NGW) {
        const bf16* p = P + (size_t)r * HYB_INP;
        {
            const unsigned* p32 = (const unsigned*)(p + lane * 6); const unsigned w0 = p32[0], w1 = p32[1], w2 = p32[2];
            float f[6] = {bflo(w0), bfhi(w0), bflo(w1), bfhi(w1), bflo(w2), bfhi(w2)}; float ss = 0.f;
#pragma unroll
            for (int j = 0; j < 6; ++j) ss += f[j] * f[j];
            const float rs = rsqrtf(wave_sum(ss, lane) * (1.f / 384.f) + EPS);
#pragma unroll
            for (int j = 0; j < 6; ++j) f[j] = f[j] * rs * qn[lane * 6 + j];
            unsigned* o32 = (unsigned*)(CQN + (size_t)r * 384 + lane * 6); o32[0] = pk2(f[0], f[1]); o32[1] = pk2(f[2], f[3]); o32[2] = pk2(f[4], f[5]);
        }
        {
            const v2u w = *(const v2u*)(p + 384 + lane * 4); float f[4] = {bflo(w.x), bfhi(w.x), bflo(w.y), bfhi(w.y)};
            const float ss = (f[0] * f[0] + f[1] * f[1]) + (f[2] * f[2] + f[3] * f[3]);
            const float rs = rsqrtf(wave_sum(ss, lane) * (1.f / 256.f) + EPS);
            const f32x4 g = *(const f32x4*)(kvn + lane * 4);
            v2u o; o.x = pk2(f[0] * rs * g[0], f[1] * rs * g[1]); o.y = pk2(f[2] * rs * g[2], f[3] * rs * g[3]); *(v2u*)(CKVN + (size_t)r * 256 + lane * 4) = o;
        }
        {
            const int j = lane & 31; const float v = bf1(p[640 + j]); const float o = shx(v, 16, lane); float res = v;
            if (r < TL) { const int t = r & (SEQ - 1); const float c = ct[t * 16 + (j & 15)], s = st[t * 16 + (j & 15)]; res = (j < 16) ? v * c - o * s : o * s + v * c; }
            if (lane < 32) KR[(size_t)r * 32 + j] = (bf16)f2bf(res);
        }
        {
            const int c0 = lane * 8; float gb[8], cur[8], acc[8], t0[8], t1[8];
            unpack8(*(const v4u*)(p + 672 + c0), gb);
            unpack8(*(const v4u*)(p + 1184 + c0), t0); unpack8(*(const v4u*)(p + 1696 + c0), t1);
#pragma unroll
            for (int j = 0; j < 8; ++j) { cur[j] = t0[j] * t1[j]; acc[j] = cw[512 + c0 + j] * cur[j]; }
            if (has_prev(r)) { unpack8(*(const v4u*)(p - HYB_INP + 1184 + c0), t0); unpack8(*(const v4u*)(p - HYB_INP + 1696 + c0), t1);
#pragma unroll
                for (int j = 0; j < 8; ++j) acc[j] += cw[c0 + j] * (t0[j] * t1[j]); }
            if (has_next(r)) { unpack8(*(const v4u*)(p + HYB_INP + 1184 + c0), t0); unpack8(*(const v4u*)(p + HYB_INP + 1696 + c0), t1);
#pragma unroll
                for (int j = 0; j < 8; ++j) acc[j] += cw[1024 + c0 + j] * (t0[j] * t1[j]); }
#pragma unroll
            for (int j = 0; j < 8; ++j) acc[j] *= gb[j];
            *(v4u*)(MIX + (size_t)r * D + 512 + c0) = pack8(acc);
        }
    }
}

__device__ __forceinline__ void convgate(const Args& a, int l, int nrows) {
    const bf16* U = (const bf16*)(a.ws + WS_U); bf16* G = (bf16*)(a.ws + WS_G); const float* cw = a.in[I_FCONV] + (size_t)l * 3 * UPW;
    const int total = nrows * (DFF / 8);
    for (int idx = blockIdx.x * NTHR + otid(a.wv); idx < total; idx += gridDim.x * NTHR) {
        const int r = idx / (DFF / 8), c0 = (idx % (DFF / 8)) * 8; const bf16* u = U + (size_t)r * UPW + c0;
        float ua[8], ug[8], act[8], gate[8];
        unpack8(*(const v4u*)u, ua); unpack8(*(const v4u*)(u + DFF), ug);
#pragma unroll
        for (int j = 0; j < 8; ++j) { act[j] = cw[UPW + c0 + j] * ua[j]; gate[j] = cw[UPW + DFF + c0 + j] * ug[j]; }
        if (has_prev(r)) { unpack8(*(const v4u*)(u - UPW), ua); unpack8(*(const v4u*)(u - UPW + DFF), ug);
#pragma unroll
            for (int j = 0; j < 8; ++j) { act[j] += cw[c0 + j] * ua[j]; gate[j] += cw[DFF + c0 + j] * ug[j]; } }
        if (has_next(r)) { unpack8(*(const v4u*)(u + UPW), ua); unpack8(*(const v4u*)(u + UPW + DFF), ug);
#pragma unroll
            for (int j = 0; j < 8; ++j) { act[j] += cw[2 * UPW + c0 + j] * ua[j]; gate[j] += cw[2 * UPW + DFF + c0 + j] * ug[j]; } }
#pragma unroll
        for (int j = 0; j < 8; ++j) act[j] = silu_f(act[j]) * gate[j];
        *(v4u*)(G + (size_t)r * DFF + c0) = pack8(act);
    }
}

__device__ __forceinline__ void ssd_conv(const Args& a, int i) {
    const bf16* ZX = (const bf16*)(a.ws + WS_ZX); bf16* XBC = (bf16*)(a.ws + WS_XBC); float* DT = (float*)(a.ws + WS_DT); float* AA = (float*)(a.ws + WS_AA);
    const float* cw = a.in[I_SCONVW] + (size_t)i * 3 * 3072; const float* cb = a.in[I_SCONVB] + (size_t)i * 3072;
    const int total = T * 384;
    for (int idx = blockIdx.x * NTHR + otid(a.wv); idx < total; idx += gridDim.x * NTHR) {
        const int r = idx / 384, c0 = (idx % 384) * 8; const bf16* u = ZX + (size_t)r * SSD_INP + 2048 + c0;
        float x[8], acc[8];
        unpack8(*(const v4u*)u, x);
#pragma unroll
        for (int j = 0; j < 8; ++j) acc[j] = cb[c0 + j] + cw[3072 + c0 + j] * x[j];
        if (has_prev(r)) { unpack8(*(const v4u*)(u - SSD_INP), x);
#pragma unroll
            for (int j = 0; j < 8; ++j) acc[j] += cw[c0 + j] * x[j]; }
        if (has_next(r)) { unpack8(*(const v4u*)(u + SSD_INP), x);
#pragma unroll
            for (int j = 0; j < 8; ++j) acc[j] += cw[2 * 3072 + c0 + j] * x[j]; }
#pragma unroll
        for (int j = 0; j < 8; ++j) acc[j] = silu_f(acc[j]);
        *(v4u*)(XBC + (size_t)r * 3072 + c0) = pack8(acc);
    }
    const float* alog = a.in[I_ALOG] + i * 64; const float* dtb = a.in[I_DTB] + i * 64;
    for (int idx = blockIdx.x * NTHR + otid(a.wv); idx < T * 64; idx += gridDim.x * NTHR) {
        const int r = idx >> 6, j = idx & 63; const float raw = bf1(ZX[(size_t)r * SSD_INP + 5120 + j]) + dtb[j];
        const float dt = raw > 15.f ? raw : (raw < -15.f ? __expf(raw) : __logf(1.f + __expf(raw)));
        DT[idx] = dt; AA[idx] = -__expf(alog[j]) * dt;
    }
}

__device__ __forceinline__ void gatenorm(const Args& a, int i, int nrows) {
    const int wave = otid(a.wv) >> 6, lane = otid(a.wv) & 63; const int NGW = gridDim.x * NWAVES, gw = blockIdx.x * NWAVES + wave;
    const bf16* ZX = (const bf16*)(a.ws + WS_ZX); bf16* YN = (bf16*)(a.ws + WS_XBC); const float* nw = a.in[I_SNORM] + i * 2048;
    for (int r = gw; r < nrows; r += NGW) {
        float v[4][8]; float ss = 0.f;
#pragma unroll
        for (int j = 0; j < 4; ++j) { float y[8], z[8]; const int c = j * 512 + lane * 8;
            unpack8(*(const v4u*)(ZX + (size_t)r * SSD_INP + 2048 + c), y); unpack8(*(const v4u*)(ZX + (size_t)r * SSD_INP + c), z);
#pragma unroll
            for (int k = 0; k < 8; ++k) { v[j][k] = y[k] * silu_f(z[k]); ss += v[j][k] * v[j][k]; } }
        const float rs = rsqrtf(wave_sum(ss, lane) * (1.f / 2048.f) + EPS);
#pragma unroll
        for (int j = 0; j < 4; ++j) { const int c = j * 512 + lane * 8; float o[8];
#pragma unroll
            for (int k = 0; k < 8; ++k) o[k] = v[j][k] * rs * nw[c + k];
            *(v4u*)(YN + (size_t)r * 2048 + c) = pack8(o); }
    }
}

__device__ __forceinline__ void attn_naive(const Args& a, LAS unsigned char* lds) {
    const int tid = otid(a.wv), qi = tid >> 1, half = tid & 1;
    const bf16* Qb = (const bf16*)(a.ws + WS_Q); const bf16* KVb = (const bf16*)(a.ws + WS_KV); const bf16* KR = (const bf16*)(a.ws + WS_KR); bf16* MIX = (bf16*)(a.ws + WS_MIX);
    const float* ct = (const float*)(a.ws + WS_ROPE); const float* st = ct + SEQ * 16;
    LAS float* Kt = (LAS float*)lds;
    LAS float* Vt = (LAS float*)(lds + 64 * 96 * 4);
    for (int u = blockIdx.x; u < 576; u += gridDim.x) {
        const bool lat = u < 512; const int b = lat ? (u >> 6) : ((u - 512) >> 3), h = lat ? ((u >> 3) & 7) : ((u - 512) & 7);
        const int nkeys = lat ? (CTXL + SEQ) : CTXL;
        const int qrow = lat ? b * SEQ + (u & 7) * 256 + qi : TL + b * CTXL + qi;
        float q[48];
#pragma unroll
        for (int g = 0; g < 6; ++g) { float f[8]; unpack8(*(const v4u*)(Qb + (size_t)qrow * QW + h * 96 + half * 48 + g * 8), f);
#pragma unroll
            for (int j = 0; j < 8; ++j) q[g * 8 + j] = f[j]; }
        if (lat && half == 1) { const int t = qrow & (SEQ - 1);
#pragma unroll
            for (int j = 0; j < 16; ++j) { const float c = ct[t * 16 + j], s = st[t * 16 + j]; const float x1 = q[16 + j], x2 = q[32 + j]; q[16 + j] = x1 * c - x2 * s; q[32 + j] = x1 * s + x2 * c; } }
#pragma unroll
        for (int j = 0; j < 48; ++j) q[j] *= ATT_SCALE_LOG2E;
        float o[32]; float m = -1e30f, l = 0.f;
#pragma unroll
        for (int j = 0; j < 32; ++j) o[j] = 0.f;
        for (int k0 = 0; k0 < nkeys; k0 += 64) {
            __syncthreads();
            for (int g = tid; g < 768; g += NTHR) { const int key = g / 12, part = g % 12; const int kk = k0 + key; const int krow = kk < CTXL ? TL + b * CTXL + kk : b * SEQ + kk - CTXL;
                float f[8]; unpack8(part < 8 ? *(const v4u*)(KVb + (size_t)krow * KVW + h * 128 + part * 8) : *(const v4u*)(KR + (size_t)krow * 32 + (part - 8) * 8), f);
#pragma unroll
                for (int j = 0; j < 8; ++j) Kt[key * 96 + part * 8 + j] = f[j]; }
            { const int key = tid >> 3, part = tid & 7; const int kk = k0 + key; const int krow = kk < CTXL ? TL + b * CTXL + kk : b * SEQ + kk - CTXL;
                float f[8]; unpack8(*(const v4u*)(KVb + (size_t)krow * KVW + h * 128 + 64 + part * 8), f);
#pragma unroll
                for (int j = 0; j < 8; ++j) Vt[key * 64 + part * 8 + j] = f[j]; }
            __syncthreads();
            for (int kg = 0; kg < 64; kg += 8) {
                float s[8]; float gm = -1e30f;
#pragma unroll
                for (int kk = 0; kk < 8; ++kk) { float acc = 0.f; const LAS f32x4* kp = (const LAS f32x4*)(Kt + (kg + kk) * 96 + half * 48);
#pragma unroll
                    for (int d4 = 0; d4 < 12; ++d4) { const f32x4 kv = kp[d4]; acc += q[d4 * 4] * kv[0] + q[d4 * 4 + 1] * kv[1] + q[d4 * 4 + 2] * kv[2] + q[d4 * 4 + 3] * kv[3]; }
                    acc += shx(acc, 1, tid & 63);
                    s[kk] = acc; gm = fmaxf(gm, acc); }
                const float mn = fmaxf(m, gm); const float alpha = exp2f(m - mn); m = mn; l *= alpha;
#pragma unroll
                for (int j = 0; j < 32; ++j) o[j] *= alpha;
#pragma unroll
                for (int kk = 0; kk < 8; ++kk) { const float p = exp2f(s[kk] - mn); l += p; const LAS f32x4* vp = (const LAS f32x4*)(Vt + (kg + kk) * 64 + half * 32);
#pragma unroll
                    for (int d4 = 0; d4 < 8; ++d4) { const f32x4 vv = vp[d4]; o[d4 * 4] += p * vv[0]; o[d4 * 4 + 1] += p * vv[1]; o[d4 * 4 + 2] += p * vv[2]; o[d4 * 4 + 3] += p * vv[3]; } }
            }
        }
        { const float inv = 1.f / l;
#pragma unroll
            for (int g = 0; g < 4; ++g) { float f[8];
#pragma unroll
                for (int j = 0; j < 8; ++j) f[j] = o[g * 8 + j] * inv;
                *(v4u*)(MIX + (size_t)qrow * D + h * 64 + half * 32 + g * 8) = pack8(f); } }
    }
}

__device__ __forceinline__ void ssd_scan_naive(const Args& a, int i, bool last, LAS unsigned char* lds) {
    const int tid = otid(a.wv), p = tid >> 3, nq = tid & 7;
    bf16* ZX = (bf16*)(a.ws + WS_ZX); const bf16* XBC = (const bf16*)(a.ws + WS_XBC); const float* DT = (const float*)(a.ws + WS_DT); const float* AA = (const float*)(a.ws + WS_AA);
    LAS float* xs = (LAS float*)lds;
    LAS float* Bs = (LAS float*)(lds + 16384);
    LAS float* Cs = (LAS float*)(lds + 16384 + 32768);
    LAS float* dts = (LAS float*)(lds + 16384 + 65536);
    LAS float* as = dts + 64;
    for (int it = blockIdx.x; it < NB * 32; it += gridDim.x) {
        const int b = it >> 5, h = it & 31, g = h >> 3; const float dsk = a.in[I_SD][i * 32 + h];
        for (int dir = 0; dir < 2; ++dir) {
            float stt[16];
#pragma unroll
            for (int n = 0; n < 16; ++n) stt[n] = 0.f;
            for (int seg = 0; seg < 2; ++seg) {
                const int len = seg == 0 ? CTXL : SEQ; const int base = seg == 0 ? TL + b * CTXL : b * SEQ; const bool want_y = !(last && seg == 0);
                for (int cc = 0; cc < len / 64; ++cc) {
                    const int t0 = dir == 0 ? cc * 64 : len - 64 - cc * 64;
                    __syncthreads();
                    { const int tt = tid >> 3, part = tid & 7; float f[8]; unpack8(*(const v4u*)(XBC + (size_t)(base + t0 + tt) * 3072 + h * 64 + part * 8), f);
#pragma unroll
                        for (int j = 0; j < 8; ++j) xs[tt * 64 + part * 8 + j] = f[j]; }
                    for (int q = tid; q < 1024; q += NTHR) { const int tt = q >> 4, part = q & 15; float f[8];
                        unpack8(*(const v4u*)(XBC + (size_t)(base + t0 + tt) * 3072 + 2048 + g * 128 + part * 8), f);
#pragma unroll
                        for (int j = 0; j < 8; ++j) Bs[tt * 128 + part * 8 + j] = f[j];
                        unpack8(*(const v4u*)(XBC + (size_t)(base + t0 + tt) * 3072 + 2560 + g * 128 + part * 8), f);
#pragma unroll
                        for (int j = 0; j < 8; ++j) Cs[tt * 128 + part * 8 + j] = f[j]; }
                    if (tid < 64) { dts[tid] = DT[(size_t)(base + t0 + tid) * 64 + dir * 32 + h]; as[tid] = AA[(size_t)(base + t0 + tid) * 64 + dir * 32 + h]; }
                    __syncthreads();
                    for (int s = 0; s < 64; ++s) {
                        const int tt = dir == 0 ? s : 63 - s;
                        const float dec = __expf(as[tt]); const float xv = xs[tt * 64 + p]; const float xd = xv * dts[tt];
                        const LAS f32x4* bp = (const LAS f32x4*)(Bs + tt * 128 + nq * 16); const LAS f32x4* cp = (const LAS f32x4*)(Cs + tt * 128 + nq * 16);
                        float acc = 0.f;
#pragma unroll
                        for (int n4 = 0; n4 < 4; ++n4) { const f32x4 bv = bp[n4], cv = cp[n4];
#pragma unroll
                            for (int k = 0; k < 4; ++k) { stt[n4 * 4 + k] = dec * stt[n4 * 4 + k] + xd * bv[k]; acc += cv[k] * stt[n4 * 4 + k]; } }
                        acc += shx(acc, 1, tid & 63); acc += shx(acc, 2, tid & 63); acc += shx(acc, 4, tid & 63);
                        if (want_y && nq == 0) { bf16* yp = ZX + (size_t)(base + t0 + tt) * SSD_INP + 2048 + h * 64 + p;
                            const float y = dir == 0 ? acc + dsk * xv : acc + bf1(*yp);
                            *yp = (bf16)f2bf(y); }
                    }
                }
            }
            __syncthreads();
            asm volatile("s_waitcnt vmcnt(0)" ::: "memory");
        }
    }
}

typedef short bf16x8 __attribute__((ext_vector_type(8)));
typedef float f32x16 __attribute__((ext_vector_type(16)));
typedef short v4i16_t __attribute__((ext_vector_type(4)));
__device__ __forceinline__ v2u trread(const LAS unsigned char* p) { return __builtin_bit_cast(v2u, __builtin_amdgcn_ds_read_tr16_b64_v4i16((LAS v4i16_t*)p)); }
__device__ __forceinline__ unsigned cvtpk(float lo, float hi) { return hw_cvtpk(lo, hi); }
constexpr int ATT_KP = 208, ATT_VP = 192, ATT_KB = 64 * ATT_KP, ATT_VB = 64 * ATT_VP, ATT_BUF = ATT_KB + ATT_VB;
#ifndef ATT_NQ
#define ATT_NQ 2
#endif
template <int NQ>
__device__ __forceinline__ void attn_unit3(const Args& a, LAS unsigned char* lds, const int b, const int h, const int q0, const int ntiles, const bool lat) {
    const int tid = otid(a.wv), wave = a.wv, lane = tid & 63, r32 = lane & 31, hh = lane >> 5;
    const int tq = (lane >> 2) & 3, tp = lane & 3, tblk = (lane >> 4) & 1;
    const bf16* Qb = (const bf16*)(a.ws + WS_Q); const bf16* KVb = (const bf16*)(a.ws + WS_KV); const bf16* KR = (const bf16*)(a.ws + WS_KR); bf16* MIX = (bf16*)(a.ws + WS_MIX);
    const float* ct = (const float*)(a.ws + WS_ROPE); const float* st = ct + SEQ * 16;
    bf16x8 qf[NQ][6];
#pragma unroll
    for (int nq = 0; nq < NQ; ++nq) { const int qrow = q0 + wave * (32 * NQ) + nq * 32 + r32;
#pragma unroll
        for (int s = 0; s < 6; ++s) qf[nq][s] = *(const bf16x8*)(Qb + (size_t)qrow * QW + h * 96 + 16 * s + 8 * hh);
        if (lat) { const int t = qrow & (SEQ - 1);
#pragma unroll
            for (int j = 0; j < 8; j += 2) { float x1[2], x2[2], y1[2], y2[2];
#pragma unroll
                for (int e = 0; e < 2; ++e) { x1[e] = bf1((bf16)qf[nq][4][j + e]); x2[e] = bf1((bf16)qf[nq][5][j + e]); const float c = ct[t * 16 + 8 * hh + j + e], s = st[t * 16 + 8 * hh + j + e];
                    y1[e] = x1[e] * c - x2[e] * s; y2[e] = x1[e] * s + x2[e] * c; }
                const unsigned w1 = pk2(y1[0], y1[1]), w2 = pk2(y2[0], y2[1]);
                qf[nq][4][j] = (short)(w1 & 0xffff); qf[nq][4][j + 1] = (short)(w1 >> 16); qf[nq][5][j] = (short)(w2 & 0xffff); qf[nq][5][j + 1] = (short)(w2 >> 16); } } }
    f32x16 o0[NQ], o1[NQ]; float m[NQ], l[NQ];
#pragma unroll
    for (int nq = 0; nq < NQ; ++nq) { m[nq] = -1e30f; l[nq] = 0.f;
#pragma unroll
        for (int i = 0; i < 16; ++i) { o0[nq][i] = 0.f; o1[nq][i] = 0.f; } }
    v4u kreg0, kreg1, vreg;
#define ATT_LOAD(it) do { const int rb_ = (it) < CTXL / 64 ? TL + b * CTXL + (it) * 64 : b * SEQ + ((it) - CTXL / 64) * 64; \
        const char* kvb_ = (const char*)(KVb + (size_t)rb_ * KVW); const char* krb_ = (const char*)(KR + (size_t)rb_ * 32); \
        kreg0 = *(const v4u*)(kvb_ + (tid >> 3) * 2048 + h * 256 + (tid & 7) * 16); if (tid < 256) kreg1 = *(const v4u*)(krb_ + (tid >> 2) * 64 + (tid & 3) * 16); vreg = *(const v4u*)(kvb_ + (tid >> 3) * 2048 + h * 256 + 128 + (tid & 7) * 16); } while (0)
#define ATT_WRITE(buf) do { LAS unsigned char* kb_ = lds + (buf) * ATT_BUF; LAS unsigned char* vb_ = kb_ + ATT_KB; \
        *(LAS v4u*)(kb_ + (tid >> 3) * ATT_KP + (tid & 7) * 16) = kreg0; if (tid < 256) *(LAS v4u*)(kb_ + (tid >> 2) * ATT_KP + 128 + (tid & 3) * 16) = kreg1; \
        *(LAS v4u*)(vb_ + (tid >> 3) * ATT_VP + (tid & 7) * 16) = vreg; } while (0)
    __syncthreads();
    ATT_LOAD(0); ATT_WRITE(0);
    __syncthreads();
    for (int it = 0; it < ntiles; ++it) {
#ifdef ATT_JITTER
        if (wave == ((it * 5 + (int)blockIdx.x) & 7)) __builtin_amdgcn_s_sleep(100);
#endif
#ifndef ATT_LOADMID
        if (it + 1 < ntiles) ATT_LOAD(it + 1);
#endif
#ifdef ATT_TZ
        int tz = tid; asm volatile("" : "+v"(tz));
        const int lane = tz & 63, r32 = lane & 31, hh = lane >> 5, tq = (lane >> 2) & 3, tp = lane & 3, tblk = (lane >> 4) & 1;
#endif
        const LAS unsigned char* kb = lds + (it & 1) * ATT_BUF; const LAS unsigned char* vb = kb + ATT_KB;
#pragma unroll
        for (int t = 0; t < 2; ++t) {
            f32x16 sc[NQ]; bf16x8 pf[NQ][2];
#pragma unroll
            for (int nq = 0; nq < NQ; ++nq)
#pragma unroll
                for (int i = 0; i < 16; ++i) sc[nq][i] = 0.f;
            bf16x8 kf[6];
#pragma unroll
            for (int s = 0; s < 6; ++s) kf[s] = *(const LAS bf16x8*)(kb + (32 * t + r32) * ATT_KP + (16 * s + 8 * hh) * 2);
            asm volatile("" : "+v"(kf[0]), "+v"(kf[1]), "+v"(kf[2]), "+v"(kf[3]), "+v"(kf[4]), "+v"(kf[5]));
#pragma unroll
            for (int s = 0; s < 6; ++s)
#pragma unroll
                for (int nq = 0; nq < NQ; ++nq) sc[nq] = __builtin_amdgcn_mfma_f32_32x32x16_bf16(kf[s], qf[nq][s], sc[nq], 0, 0, 0);
#ifdef ATT_LOADMID
            if (t == 0 && it + 1 < ntiles) ATT_LOAD(it + 1);
#endif
#pragma unroll
            for (int nq = 0; nq < NQ; ++nq) {
                float mx = sc[nq][0];
#pragma unroll
                for (int i = 1; i < 16; ++i) mx = fmaxf(mx, sc[nq][i]);
                mx = fmaxf(mx, shx(mx, 32, lane));
                const float mn = fmaxf(m[nq], mx * ATT_SCALE_LOG2E); const float alpha = __builtin_amdgcn_exp2f(m[nq] - mn); m[nq] = mn;
                float rs = 0.f;
#pragma unroll
                for (int i = 0; i < 16; ++i) { sc[nq][i] = __builtin_amdgcn_exp2f(sc[nq][i] * ATT_SCALE_LOG2E - mn); rs += sc[nq][i]; }
                l[nq] = l[nq] * alpha + rs;
#ifdef ATT_SKIPRS
                if (__builtin_amdgcn_ballot_w64(alpha != 1.0f) != 0ull)
#endif
                {
#pragma unroll
                    for (int i = 0; i < 16; ++i) { o0[nq][i] *= alpha; o1[nq][i] *= alpha; } }
#pragma unroll
                for (int s2 = 0; s2 < 2; ++s2) { v4u w0;
                    w0.x = cvtpk(sc[nq][8 * s2 + 0], sc[nq][8 * s2 + 1]); w0.y = cvtpk(sc[nq][8 * s2 + 2], sc[nq][8 * s2 + 3]); w0.z = cvtpk(sc[nq][8 * s2 + 4], sc[nq][8 * s2 + 5]); w0.w = cvtpk(sc[nq][8 * s2 + 6], sc[nq][8 * s2 + 7]);
                    pf[nq][s2] = __builtin_bit_cast(bf16x8, w0); }
            }
#pragma unroll
            for (int s2 = 0; s2 < 2; ++s2) { const int ko = t * 32 + 16 * s2 + 4 * hh;
                { const LAS unsigned char* tb = vb + (ko + tq) * ATT_VP + (16 * tblk + 4 * tp) * 2; const v2u lo = trread(tb), hi = trread(tb + 8 * ATT_VP); const bf16x8 vf = __builtin_bit_cast(bf16x8, (v4u){lo.x, lo.y, hi.x, hi.y});
#pragma unroll
                  for (int nq = 0; nq < NQ; ++nq) o0[nq] = __builtin_amdgcn_mfma_f32_32x32x16_bf16(vf, pf[nq][s2], o0[nq], 0, 0, 0); }
                { const LAS unsigned char* tb = vb + (ko + tq) * ATT_VP + (32 + 16 * tblk + 4 * tp) * 2; const v2u lo = trread(tb), hi = trread(tb + 8 * ATT_VP); const bf16x8 vf = __builtin_bit_cast(bf16x8, (v4u){lo.x, lo.y, hi.x, hi.y});
#pragma unroll
                  for (int nq = 0; nq < NQ; ++nq) o1[nq] = __builtin_amdgcn_mfma_f32_32x32x16_bf16(vf, pf[nq][s2], o1[nq], 0, 0, 0); } }
        }
        if (it + 1 < ntiles) ATT_WRITE((it + 1) & 1);
        __syncthreads();
    }
#undef ATT_LOAD
#undef ATT_WRITE
#pragma unroll
    for (int nq = 0; nq < NQ; ++nq) { const int qrow = q0 + wave * (32 * NQ) + nq * 32 + r32;
        const float lsum = l[nq] + shx(l[nq], 32, lane); const float inv = 1.f / lsum;
        bf16* orow = MIX + (size_t)qrow * D + h * 64 + 4 * hh;
#pragma unroll
        for (int g = 0; g < 4; ++g) {
            v2u w; w.x = pk2(o0[nq][4 * g] * inv, o0[nq][4 * g + 1] * inv); w.y = pk2(o0[nq][4 * g + 2] * inv, o0[nq][4 * g + 3] * inv); *(v2u*)(orow + 8 * g) = w;
            v2u x; x.x = pk2(o1[nq][4 * g] * inv, o1[nq][4 * g + 1] * inv); x.y = pk2(o1[nq][4 * g + 2] * inv, o1[nq][4 * g + 3] * inv); *(v2u*)(orow + 32 + 8 * g) = x; } }
}
__device__ __forceinline__ void attn_mfma(const Args& a, LAS unsigned char* lds) {
#if ATT_NQ == 2
    for (int u = blockIdx.x; u < 256; u += gridDim.x) attn_unit3<2>(a, lds, u >> 5, (u >> 2) & 7, (u >> 5) * SEQ + (u & 3) * 512, (CTXL + SEQ) / 64, true);
#else
    for (int u = blockIdx.x; u < 512; u += gridDim.x) attn_unit3<1>(a, lds, u >> 6, (u >> 3) & 7, (u >> 6) * SEQ + (u & 7) * 256, (CTXL + SEQ) / 64, true);
#endif
    for (int u = blockIdx.x; u < 64; u += gridDim.x) attn_unit3<1>(a, lds, u >> 3, u & 7, TL + (u >> 3) * CTXL, CTXL / 64, false);
}

#ifndef SSD_YREP
#define SSD_YREP 1
#endif
#ifndef SSD_WREP
#define SSD_WREP 1
#endif
constexpr int SP_B = 272, SP_X = 192;
constexpr int SO_B = 0, SO_C = SO_B + 128 * SP_B, SO_XD = SO_C + 128 * SP_B, SO_XW = SO_XD + 128 * SP_X, SO_S = SO_XW + 128 * SP_X, SO_V = SO_S + 64 * SP_B;
static_assert(SO_V + 2 * 2048 <= LDS_BYTES, "ssd lds map");
#ifdef SSD_DIAG
#define SSD_T(v) long long v = clock64()
#define SSD_ACC(k, v) do { const long long n_ = clock64(); dacc[k] += n_ - v; v = n_; } while (0)
#else
#define SSD_T(v) do {} while (0)
#define SSD_ACC(k, v) do {} while (0)
#endif
__device__ __forceinline__ void ssd_scan_mfma(const Args& a, int i, bool last, LAS unsigned char* lds) {
#ifdef SSD_DIAG
    long long dacc[12] = {0, 0, 0, 0, 0, 0, 0, 0, 0, 0, 0, 0};
#endif
    const int tid = otid(a.wv), wave = a.wv, lane = tid & 63, r32 = lane & 31, hh = lane >> 5;
    const int pt = wave >> 2, lt = pt ? 3 - (wave & 3) : (wave & 3);
    const int tq = (lane >> 2) & 3, tp = lane & 3, tblk = (lane >> 4) & 1;
    bf16* ZX = (bf16*)(a.ws + WS_ZX); const bf16* XBC = (const bf16*)(a.ws + WS_XBC); const float* DT = (const float*)(a.ws + WS_DT); const float* AA = (const float*)(a.ws + WS_AA);
    LAS unsigned char* Bl = lds + SO_B; LAS unsigned char* Cl = lds + SO_C; LAS unsigned char* XDl = lds + SO_XD; LAS unsigned char* XWl = lds + SO_XW; LAS unsigned char* Sl = lds + SO_S;
    const int brow = tid >> 4, bpart = tid & 15, xrow = tid >> 3, xpart = tid & 7;
    for (int it = blockIdx.x; it < NB * 32; it += gridDim.x) {
        const int b = it >> 5, h = it & 31, g = h >> 3; const float dsk = a.in[I_SD][i * 32 + h];
        for (int dir = 0; dir < 2; ++dir) {
            const int scanw = dir == 0 ? 0 : 3;
            f32x16 sacc;
#pragma unroll
            for (int k = 0; k < 16; ++k) sacc[k] = 0.f;
            SSD_T(tprev);
            v4u bq[4], cq[4], xq[2]; float pa0 = 0.f, pa1 = 0.f, pd0 = 0.f, pd1 = 0.f, qa0 = 0.f, qa1 = 0.f, qd0 = 0.f, qd1 = 0.f; v2u add[4];
#define SSD_ROWBASE(c) ((c) < 2 ? TL + b * CTXL + (dir == 0 ? (c) : 1 - (c)) * 128 : b * SEQ + (dir == 0 ? (c) - 2 : 17 - (c)) * 128)
#define SSD_PFB(c) do { const int rb_ = SSD_ROWBASE(c); _Pragma("unroll") for (int k_ = 0; k_ < 4; ++k_) bq[k_] = *(const v4u*)(XBC + (size_t)(rb_ + brow + 32 * k_) * 3072 + 2048 + g * 128 + bpart * 8); } while (0)
#define SSD_PFC(c) do { const int rb_ = SSD_ROWBASE(c); _Pragma("unroll") for (int k_ = 0; k_ < 4; ++k_) cq[k_] = *(const v4u*)(XBC + (size_t)(rb_ + brow + 32 * k_) * 3072 + 2560 + g * 128 + bpart * 8); } while (0)
#define SSD_PFX(c) do { const int rb_ = SSD_ROWBASE(c); _Pragma("unroll") for (int k_ = 0; k_ < 2; ++k_) xq[k_] = *(const v4u*)(XBC + (size_t)(rb_ + xrow + 64 * k_) * 3072 + h * 64 + xpart * 8); } while (0)
#define SSD_PF(c) do { SSD_PFB(c); SSD_PFC(c); SSD_PFX(c); } while (0)
#define SSD_PFV(c) do { if (wave == scanw) { const int rb_ = SSD_ROWBASE(c); const size_t o_ = (size_t)(rb_ + 2 * lane) * 64 + dir * 32 + h; qa0 = AA[o_]; qa1 = AA[o_ + 64]; qd0 = DT[o_]; qd1 = DT[o_ + 64]; } } while (0)
#define SSD_PFY(c) do { const int rb_ = SSD_ROWBASE(c); const size_t r_ = (size_t)(rb_ + 32 * lt + r32); \
                _Pragma("unroll") for (int q_ = 0; q_ < 4; ++q_) add[q_] = dir == 0 ? *(const v2u*)(XBC + r_ * 3072 + h * 64 + 32 * pt + 4 * hh + 8 * q_) : *(const v2u*)(ZX + r_ * SSD_INP + 2048 + h * 64 + 32 * pt + 4 * hh + 8 * q_); } while (0)
#define SSD_SCAN(vb_) do { if (wave == scanw) { LAS float* V_ = (LAS float*)(lds + SO_V + (vb_) * 2048); const float pair_ = pa0 + pa1; float ps_ = pair_; \
                _Pragma("unroll") for (int d_ = 1; d_ < 64; d_ <<= 1) { const int src_ = dir == 0 ? lane - d_ : lane + d_; const float t_ = __builtin_bit_cast(float, __builtin_amdgcn_ds_bpermute((src_ & 63) << 2, __builtin_bit_cast(int, ps_))); if (src_ >= 0 && src_ < 64) ps_ += t_; } \
                const float tot_ = __builtin_bit_cast(float, __builtin_amdgcn_ds_bpermute((dir == 0 ? 63 : 0) << 2, __builtin_bit_cast(int, ps_))); const float ex_ = ps_ - pair_; \
                float c0_, c1_; if (dir == 0) { c0_ = ex_ + pa0; c1_ = c0_ + pa1; } else { c1_ = ex_ + pa1; c0_ = c1_ + pa0; } \
                V_[2 * lane] = c0_; V_[2 * lane + 1] = c1_; V_[128 + 2 * lane] = pd0; V_[128 + 2 * lane + 1] = pd1; V_[256 + 2 * lane] = pd0 * __expf(tot_ - c0_); V_[256 + 2 * lane + 1] = pd1 * __expf(tot_ - c1_); \
                if (lane == 0) V_[384] = tot_; } } while (0)
#define SSD_WRITE(vb_) do { const LAS float* V_ = (const LAS float*)(lds + SO_V + (vb_) * 2048); \
                _Pragma("unroll") for (int k_ = 0; k_ < 4; ++k_) { *(LAS v4u*)(Bl + (brow + 32 * k_) * SP_B + bpart * 16) = bq[k_]; *(LAS v4u*)(Cl + (brow + 32 * k_) * SP_B + bpart * 16) = cq[k_]; } \
                _Pragma("unroll") for (int k_ = 0; k_ < 2; ++k_) { const int s_ = xrow + 64 * k_; const float dt_ = V_[128 + s_], w_ = V_[256 + s_]; float f_[8], g_[8]; unpack8(xq[k_], f_); \
                    _Pragma("unroll") for (int j_ = 0; j_ < 8; ++j_) { g_[j_] = f_[j_] * w_; f_[j_] *= dt_; } \
                    *(LAS v4u*)(XDl + s_ * SP_X + xpart * 16) = pack8(f_); *(LAS v4u*)(XWl + s_ * SP_X + xpart * 16) = pack8(g_); } } while (0)
            __syncthreads();
            SSD_PFV(0); pa0 = qa0; pa1 = qa1; pd0 = qd0; pd1 = qd1; SSD_PFV(1); SSD_PFY(0); SSD_PF(0);
            { const float t0_ = qa0, t1_ = qa1, t2_ = qd0, t3_ = qd1; SSD_SCAN(0); pa0 = t0_; pa1 = t1_; pd0 = t2_; pd1 = t3_; }
            __syncthreads();
            SSD_WRITE(0);
            { LAS v2u* sp = (LAS v2u*)(Sl + (32 * pt + r32) * SP_B + (32 * lt + 4 * hh) * 2);
#pragma unroll
              for (int q = 0; q < 4; ++q) sp[2 * q] = (v2u){0u, 0u}; }
            __syncthreads();
            SSD_ACC(0, tprev);
            for (int c = 0; c < 18; ++c) {
                const int cur = c & 1; const LAS float* V = (const LAS float*)(lds + SO_V + cur * 2048);
                const int rowbase = SSD_ROWBASE(c); const bool want_y = !(last && c < 2);
                if (c > 0 && want_y) SSD_PFY(c);
                if (c + 1 < 18) { if (c + 2 < 18) SSD_PFV(c + 2); }
                SSD_ACC(1, tprev);
                for (int yrep = 0; yrep < SSD_YREP; ++yrep)
                if (!want_y && c + 1 < 18) { SSD_PFB(c + 1); SSD_PFC(c + 1); SSD_PFX(c + 1); }
                if (want_y) {
                    const int l = 32 * lt + r32; const float cl = V[l];
                    bf16* yptr = ZX + (size_t)(rowbase + l) * SSD_INP + 2048 + h * 64 + 32 * pt + 4 * hh;
                    bf16x8 cf[8];
#pragma unroll
                    for (int ks = 0; ks < 8; ++ks) cf[ks] = *(const LAS bf16x8*)(Cl + l * SP_B + (16 * ks + 8 * hh) * 2);
                    SSD_ACC(8, tprev);
                    f32x16 y1;
#pragma unroll
                    for (int k = 0; k < 16; ++k) y1[k] = 0.f;
#pragma unroll
                    for (int ks = 0; ks < 8; ++ks) { const bf16x8 sf = *(const LAS bf16x8*)(Sl + (32 * pt + r32) * SP_B + (16 * ks + 8 * hh) * 2); y1 = __builtin_amdgcn_mfma_f32_32x32x16_bf16(sf, cf[ks], y1, 0, 0, 0); }
                    { const float el = __expf(cl);
#pragma unroll
                      for (int k = 0; k < 16; ++k) y1[k] *= el; }
                    SSD_ACC(10, tprev);
                    const int st_lo = dir == 0 ? 0 : lt, st_hi = dir == 0 ? lt : 3;
#pragma unroll
                    for (int st = 0; st < 4; ++st) { if (c + 1 < 18) { if (st == 1) SSD_PFB(c + 1); if (st == 2) SSD_PFC(c + 1); if (st == 3) SSD_PFX(c + 1); }
                      if (st >= st_lo && st <= st_hi) {
                        f32x16 X;
#pragma unroll
                        for (int k = 0; k < 16; ++k) X[k] = 0.f;
#pragma unroll
                        for (int ks = 0; ks < 8; ++ks) { const bf16x8 af = *(const LAS bf16x8*)(Bl + (32 * st + r32) * SP_B + (16 * ks + 8 * hh) * 2); X = __builtin_amdgcn_mfma_f32_32x32x16_bf16(af, cf[ks], X, 0, 0, 0); }
                        if (st == lt) {
#pragma unroll
                            for (int q = 0; q < 4; ++q) { const f32x4 cs = *(const LAS f32x4*)(V + 32 * st + 8 * q + 4 * hh);
#pragma unroll
                                for (int e = 0; e < 4; ++e) { const int sl = 8 * q + 4 * hh + e; const bool ok = dir == 0 ? (sl <= r32) : (sl >= r32);
                                    X[4 * q + e] *= __expf(ok ? fminf(cl - cs[e], 0.f) : -1.0e30f); } }
                        } else {
#pragma unroll
                            for (int q = 0; q < 4; ++q) { const f32x4 cs = *(const LAS f32x4*)(V + 32 * st + 8 * q + 4 * hh);
#pragma unroll
                                for (int e = 0; e < 4; ++e) X[4 * q + e] *= __expf(fminf(cl - cs[e], 0.f)); }
                        }
#pragma unroll
                        for (int ks2 = 0; ks2 < 2; ++ks2) { v4u w; w.x = cvtpk(X[8 * ks2 + 0], X[8 * ks2 + 1]); w.y = cvtpk(X[8 * ks2 + 2], X[8 * ks2 + 3]); w.z = cvtpk(X[8 * ks2 + 4], X[8 * ks2 + 5]); w.w = cvtpk(X[8 * ks2 + 6], X[8 * ks2 + 7]);
                            const LAS unsigned char* tb = XDl + (32 * st + 16 * ks2 + 4 * hh + tq) * SP_X + (32 * pt + 16 * tblk + 4 * tp) * 2;
                            const v2u lo = trread(tb), hi = trread(tb + 8 * SP_X);
                            y1 = __builtin_amdgcn_mfma_f32_32x32x16_bf16(__builtin_bit_cast(bf16x8, (v4u){lo.x, lo.y, hi.x, hi.y}), __builtin_bit_cast(bf16x8, w), y1, 0, 0, 0); }
                    } }
                    asm volatile("" : "+v"(y1)); SSD_ACC(9, tprev);
#pragma unroll
                    for (int q = 0; q < 4; ++q) { float o[4];
#pragma unroll
                        for (int e = 0; e < 4; ++e) o[e] = y1[4 * q + e];
                        const float a0 = bflo(add[q].x), a1 = bfhi(add[q].x), a2 = bflo(add[q].y), a3 = bfhi(add[q].y);
                        if (dir == 0) { o[0] += dsk * a0; o[1] += dsk * a1; o[2] += dsk * a2; o[3] += dsk * a3; } else { o[0] += a0; o[1] += a1; o[2] += a2; o[3] += a3; }
                        v2u w; w.x = cvtpk(o[0], o[1]); w.y = cvtpk(o[2], o[3]); *(v2u*)(yptr + 8 * q) = w; }
                }
                SSD_ACC(2, tprev);
                if (c + 1 < 18) {
                    const float etot = __expf(V[384]);
#pragma unroll
                    for (int k = 0; k < 16; ++k) sacc[k] *= etot;
#pragma unroll
                    for (int kh = 0; kh < 2; ++kh) {
                        v2u alo[4], ahi[4], blo[4], bhi[4];
#pragma unroll
                        for (int k4 = 0; k4 < 4; ++k4) { const int ks = 4 * kh + k4;
                            const LAS unsigned char* ta = Bl + (16 * ks + 8 * hh + tq) * SP_B + (32 * lt + 16 * tblk + 4 * tp) * 2;
                            const LAS unsigned char* tb = XWl + (16 * ks + 8 * hh + tq) * SP_X + (32 * pt + 16 * tblk + 4 * tp) * 2;
                            alo[k4] = trread(ta); ahi[k4] = trread(ta + 4 * SP_B); blo[k4] = trread(tb); bhi[k4] = trread(tb + 4 * SP_X); }
                        asm volatile("" : "+v"(alo[0]), "+v"(alo[1]), "+v"(alo[2]), "+v"(alo[3]), "+v"(bhi[0]), "+v"(bhi[1]), "+v"(bhi[2]), "+v"(bhi[3]));
#pragma unroll
                        for (int k4 = 0; k4 < 4; ++k4)
                            sacc = __builtin_amdgcn_mfma_f32_32x32x16_bf16(__builtin_bit_cast(bf16x8, (v4u){alo[k4].x, alo[k4].y, ahi[k4].x, ahi[k4].y}), __builtin_bit_cast(bf16x8, (v4u){blo[k4].x, blo[k4].y, bhi[k4].x, bhi[k4].y}), sacc, 0, 0, 0); }
                    SSD_SCAN(cur ^ 1); pa0 = qa0; pa1 = qa1; pd0 = qd0; pd1 = qd1;
                }
                SSD_ACC(3, tprev);
                __syncthreads();
                SSD_ACC(4, tprev);
                if (c + 1 < 18) {
                    LAS v2u* sp = (LAS v2u*)(Sl + (32 * pt + r32) * SP_B + (32 * lt + 4 * hh) * 2);
#pragma unroll
                    for (int q = 0; q < 4; ++q) { v2u w; w.x = cvtpk(sacc[4 * q], sacc[4 * q + 1]); w.y = cvtpk(sacc[4 * q + 2], sacc[4 * q + 3]); sp[2 * q] = w; }
                    for (int wrep = 0; wrep < SSD_WREP; ++wrep) { SSD_WRITE(cur ^ 1); }
                }
                SSD_ACC(5, tprev);
                __syncthreads();
                SSD_ACC(6, tprev);
            }
#undef SSD_ROWBASE
#undef SSD_PF
#undef SSD_PFV
#undef SSD_PFY
#undef SSD_SCAN
#undef SSD_WRITE
            asm volatile("s_waitcnt vmcnt(0)" ::: "memory");
        }
    }
#ifdef SSD_DIAG
    if (blockIdx.x == 0 && wave == SSD_DIAG_WAVE && lane == 0 && i == 0) { float* dg = (float*)(a.ws + WS_MOD + 900 * 1024); long long tot = 0;
        for (int k = 0; k < 7; ++k) tot += dacc[k];
        tot += dacc[8] + dacc[9] + dacc[10];
        for (int k = 0; k < 12; ++k) dg[k] = (float)dacc[k]; dg[7] = (float)tot; }
#endif
}

constexpr int AT2_KP = 208, AT2_VP = 192, AT2_KB = 64 * AT2_KP, AT2_VB = 64 * AT2_VP, AT2_BUF = AT2_KB + AT2_VB;
template <int NQ>
__device__ __forceinline__ void attn_unit2(const Args& a, LAS unsigned char* lds, int b, int h, int q0, int ntiles, bool lat) {
    const int tid = otid(a.wv), wave = tid >> 6, lane = tid & 63, r32 = lane & 31, hh = lane >> 5;
    const int tq = (lane >> 2) & 3, tp = lane & 3, tblk = (lane >> 4) & 1;
    const bf16* Qb = (const bf16*)(a.ws + WS_Q); const bf16* KVb = (const bf16*)(a.ws + WS_KV); const bf16* KR = (const bf16*)(a.ws + WS_KR); bf16* MIX = (bf16*)(a.ws + WS_MIX);
    const float* ct = (const float*)(a.ws + WS_ROPE); const float* st = ct + SEQ * 16;
    bf16x8 qf[NQ][6];
#pragma unroll
    for (int nq = 0; nq < NQ; ++nq) { const int qrow = q0 + wave * (32 * NQ) + nq * 32 + r32;
#pragma unroll
        for (int s = 0; s < 6; ++s) qf[nq][s] = *(const bf16x8*)(Qb + (size_t)qrow * QW + h * 96 + 16 * s + 8 * hh);
        if (lat) { const int t = qrow & (SEQ - 1);
#pragma unroll
            for (int j = 0; j < 8; j += 2) { float y1[2], y2[2];
#pragma unroll
                for (int e = 0; e < 2; ++e) { const float x1 = bf1((bf16)qf[nq][4][j + e]), x2 = bf1((bf16)qf[nq][5][j + e]); const float c = ct[t * 16 + 8 * hh + j + e], s = st[t * 16 + 8 * hh + j + e];
                    y1[e] = x1 * c - x2 * s; y2[e] = x1 * s + x2 * c; }
                const unsigned w1 = pk2(y1[0], y1[1]), w2 = pk2(y2[0], y2[1]);
                qf[nq][4][j] = (short)(w1 & 0xffff); qf[nq][4][j + 1] = (short)(w1 >> 16); qf[nq][5][j] = (short)(w2 & 0xffff); qf[nq][5][j + 1] = (short)(w2 >> 16); } }
        asm volatile("" : "+v"(qf[nq][0]), "+v"(qf[nq][1]), "+v"(qf[nq][2]), "+v"(qf[nq][3]), "+v"(qf[nq][4]), "+v"(qf[nq][5]) :: "memory"); }
    f32x16 o[NQ][2]; float m[NQ], l[NQ];
#pragma unroll
    for (int nq = 0; nq < NQ; ++nq) { m[nq] = -1e30f; l[nq] = 0.f;
#pragma unroll
        for (int i = 0; i < 16; ++i) { o[nq][0][i] = 0.f; o[nq][1][i] = 0.f; } }
    v4u kreg0, kreg1, vreg;
#define AT2_LOAD(it, tt) do { const unsigned off_kv = (unsigned)(((tt) >> 3) * (KVW * 2) + h * 256 + ((tt) & 7) * 16), off_kr = (unsigned)(((tt) >> 2) * 64 + ((tt) & 3) * 16); const bool k1ok = (tt) < 256; const int rb_ = (it) < CTXL / 64 ? TL + b * CTXL + (it) * 64 : b * SEQ + ((it) - CTXL / 64) * 64; \
        const char* kvb_ = (const char*)(KVb + (size_t)rb_ * KVW); const char* krb_ = (const char*)(KR + (size_t)rb_ * 32); \
        kreg0 = *(const v4u*)(kvb_ + off_kv); vreg = *(const v4u*)(kvb_ + off_kv + 128); if (k1ok) kreg1 = *(const v4u*)(krb_ + off_kr); } while (0)
#define AT2_WRITE(buf, tt) do { LAS unsigned char* kb_ = lds + (buf) * AT2_BUF; \
        *(LAS v4u*)(kb_ + ((tt) >> 3) * AT2_KP + ((tt) & 7) * 16) = kreg0; if ((tt) < 256) *(LAS v4u*)(kb_ + ((tt) >> 2) * AT2_KP + 128 + ((tt) & 3) * 16) = kreg1; \
        *(LAS v4u*)(kb_ + AT2_KB + ((tt) >> 3) * AT2_VP + ((tt) & 7) * 16) = vreg; } while (0)
    __syncthreads();
    AT2_LOAD(0, tid); AT2_WRITE(0, tid);
    __syncthreads();
    for (int it = 0; it < ntiles; ++it) {
        int tz = tid; asm volatile("" : "+v"(tz));
        const int lane_ = tz & 63, r32_ = lane_ & 31, hh_ = lane_ >> 5, tq_ = (lane_ >> 2) & 3, tp_ = lane_ & 3, tblk_ = (lane_ >> 4) & 1;
#ifdef ATT_LOADTOP
        if (it + 1 < ntiles) AT2_LOAD(it + 1, tz);
#endif
        const LAS unsigned char* kb = lds + (it & 1) * AT2_BUF; const LAS unsigned char* vb = kb + AT2_KB;
        bf16x8 pf[NQ][2][2];
        f32x16 sc[NQ][2];
#pragma unroll
        for (int nq = 0; nq < NQ; ++nq)
#pragma unroll
            for (int i = 0; i < 16; ++i) { sc[nq][0][i] = 0.f; sc[nq][1][i] = 0.f; }
#pragma unroll
        for (int s = 0; s < 6; ++s) { const bf16x8 a0 = *(const LAS bf16x8*)(kb + r32_ * AT2_KP + (16 * s + 8 * hh_) * 2); const bf16x8 a1 = *(const LAS bf16x8*)(kb + (32 + r32_) * AT2_KP + (16 * s + 8 * hh_) * 2);
#pragma unroll
            for (int nq = 0; nq < NQ; ++nq) { sc[nq][0] = __builtin_amdgcn_mfma_f32_32x32x16_bf16(a0, qf[nq][s], sc[nq][0], 0, 0, 0); sc[nq][1] = __builtin_amdgcn_mfma_f32_32x32x16_bf16(a1, qf[nq][s], sc[nq][1], 0, 0, 0); } }
#pragma unroll
        for (int nq = 0; nq < NQ; ++nq) {
            f32x16& s0 = sc[nq][0]; f32x16& s1 = sc[nq][1];
            float mx = s0[0];
#pragma unroll
            for (int i = 1; i < 16; ++i) mx = fmaxf(mx, s0[i]);
#pragma unroll
            for (int i = 0; i < 16; ++i) mx = fmaxf(mx, s1[i]);
            mx = fmaxf(mx, shx(mx, 32, lane_));
            const float mn = fmaxf(m[nq], mx * ATT_SCALE_LOG2E); const float alpha = __builtin_amdgcn_exp2f(m[nq] - mn); m[nq] = mn;
            float rs = 0.f;
#pragma unroll
            for (int i = 0; i < 16; ++i) { s0[i] = __builtin_amdgcn_exp2f(s0[i] * ATT_SCALE_LOG2E - mn); s1[i] = __builtin_amdgcn_exp2f(s1[i] * ATT_SCALE_LOG2E - mn); rs += s0[i] + s1[i]; }
            l[nq] = l[nq] * alpha + rs;
#pragma unroll
            for (int i = 0; i < 16; ++i) { o[nq][0][i] *= alpha; o[nq][1][i] *= alpha; }
#pragma unroll
            for (int s2 = 0; s2 < 2; ++s2) { v4u w0, w1;
                w0.x = cvtpk(s0[8 * s2 + 0], s0[8 * s2 + 1]); w0.y = cvtpk(s0[8 * s2 + 2], s0[8 * s2 + 3]); w0.z = cvtpk(s0[8 * s2 + 4], s0[8 * s2 + 5]); w0.w = cvtpk(s0[8 * s2 + 6], s0[8 * s2 + 7]);
                w1.x = cvtpk(s1[8 * s2 + 0], s1[8 * s2 + 1]); w1.y = cvtpk(s1[8 * s2 + 2], s1[8 * s2 + 3]); w1.z = cvtpk(s1[8 * s2 + 4], s1[8 * s2 + 5]); w1.w = cvtpk(s1[8 * s2 + 6], s1[8 * s2 + 7]);
                pf[nq][0][s2] = __builtin_bit_cast(bf16x8, w0); pf[nq][1][s2] = __builtin_bit_cast(bf16x8, w1); }
        }
#ifndef ATT_LOADTOP
        if (it + 1 < ntiles) AT2_LOAD(it + 1, tz);
#endif
#pragma unroll
        for (int t = 0; t < 2; ++t)
#pragma unroll
            for (int s2 = 0; s2 < 2; ++s2)
#pragma unroll
                for (int dt = 0; dt < 2; ++dt) {
                    const LAS unsigned char* tb = vb + (t * 32 + 16 * s2 + 4 * hh_ + tq_) * AT2_VP + (32 * dt + 16 * tblk_ + 4 * tp_) * 2;
#ifdef ATT_NOTR
                    bf16x8 vf; { const LAS unsigned short* vp_ = (const LAS unsigned short*)(vb + (t * 32 + 16 * s2 + 4 * hh_) * AT2_VP + (32 * dt + r32_) * 2);
#pragma unroll
                      for (int j_ = 0; j_ < 8; ++j_) vf[j_] = (short)vp_[((j_ & 3) + 8 * (j_ >> 2)) * (AT2_VP / 2)]; }
#else
                    const v2u lo = trread(tb), hi = trread(tb + 8 * AT2_VP); const bf16x8 vf = __builtin_bit_cast(bf16x8, (v4u){lo.x, lo.y, hi.x, hi.y});
#endif
#pragma unroll
                    for (int nq = 0; nq < NQ; ++nq) o[nq][dt] = __builtin_amdgcn_mfma_f32_32x32x16_bf16(vf, pf[nq][t][s2], o[nq][dt], 0, 0, 0); }
        if (it + 1 < ntiles) AT2_WRITE((it + 1) & 1, tz);
        __syncthreads();
    }
#undef AT2_LOAD
#undef AT2_WRITE
#pragma unroll
    for (int nq = 0; nq < NQ; ++nq) { int qrow = q0 + wave * (32 * NQ) + nq * 32 + r32; asm volatile("" : "+v"(qrow));
        const float lt = l[nq] + shx(l[nq], 32, lane); const float inv = 1.f / lt;
        bf16* orow = MIX + (size_t)qrow * D + h * 64 + 4 * hh;
#pragma unroll
        for (int g = 0; g < 4; ++g) {
            v2u w; w.x = pk2(o[nq][0][4 * g] * inv, o[nq][0][4 * g + 1] * inv); w.y = pk2(o[nq][0][4 * g + 2] * inv, o[nq][0][4 * g + 3] * inv); *(v2u*)(orow + 8 * g) = w;
            v2u x; x.x = pk2(o[nq][1][4 * g] * inv, o[nq][1][4 * g + 1] * inv); x.y = pk2(o[nq][1][4 * g + 2] * inv, o[nq][1][4 * g + 3] * inv); *(v2u*)(orow + 32 + 8 * g) = x; } }
}
__device__ __forceinline__ void attn_mfma2(const Args& a, LAS unsigned char* lds) {
#ifdef ATT_NQ1
    for (int u = blockIdx.x; u < 512; u += gridDim.x) attn_unit2<1>(a, lds, u >> 6, (u >> 3) & 7, (u >> 6) * SEQ + (u & 7) * 256, (CTXL + SEQ) / 64, true);
#else
    for (int u = blockIdx.x; u < 256; u += gridDim.x) attn_unit2<2>(a, lds, u >> 5, (u >> 2) & 7, (u >> 5) * SEQ + (u & 3) * 512, (CTXL + SEQ) / 64, true);
#endif
    for (int u = blockIdx.x; u < 64; u += gridDim.x) attn_unit2<1>(a, lds, u >> 3, u & 7, TL + (u >> 3) * CTXL, CTXL / 64, false);
}

template <int R>
__device__ __forceinline__ void rowwise2(const float* xs_lat, const float* xs_ctx, float* xd_lat, float* xd_ctx, const bf16* Mb, const float* modg, const float* nwA,
                                         bf16* H, const float* modh, int sh_off, int sc_off, const float* nwB, int nrows, int wv) {
    const int tid = otid(wv), wave = wv, lane = tid & 63; const int NGW = gridDim.x * NWAVES, gw = blockIdx.x * NWAVES + wave;
    const int rpw = (nrows + NGW - 1) / NGW; const int rbeg = gw * rpw, rend = min(rbeg + rpw, nrows);
    for (int r0 = rbeg; r0 < rend; r0 += R) {
        f32x4 v[R][4]; v2u mm[R][4];
#pragma unroll
        for (int j = 0; j < R; ++j) { const int r = min(r0 + j, rend - 1); const float* xs = r < TL ? xs_lat + (size_t)r * D : xs_ctx + (size_t)(r - TL) * D;
#pragma unroll
            for (int q = 0; q < 4; ++q) v[j][q] = *(const f32x4*)(xs + q * 256 + lane * 4);
            if (Mb) {
#pragma unroll
                for (int q = 0; q < 4; ++q) mm[j][q] = *(const v2u*)(Mb + (size_t)r * D + q * 256 + lane * 4); } }
#pragma unroll
        for (int j = 0; j < R; ++j) { const int r = r0 + j; if (r < rend) {
            const bool lat = r < TL; const int cond = lat ? (r >> 11) : 8; float* xd = lat ? xd_lat + (size_t)r * D : xd_ctx + (size_t)(r - TL) * D;
            if (Mb) {
                f32x4 m[4]; float ss = 0.f;
#pragma unroll
                for (int q = 0; q < 4; ++q) { const v2u w = mm[j][q]; m[q] = (f32x4){bflo(w.x), bfhi(w.x), bflo(w.y), bfhi(w.y)}; ss += (m[q][0] * m[q][0] + m[q][1] * m[q][1]) + (m[q][2] * m[q][2] + m[q][3] * m[q][3]); }
                const float rs = rsqrtf(wave_sum(ss, lane) * (1.f / D) + EPS);
#pragma unroll
                for (int q = 0; q < 4; ++q) { const f32x4 g = *(const f32x4*)(modg + (size_t)cond * MODW + q * 256 + lane * 4); const f32x4 w = *(const f32x4*)(nwA + q * 256 + lane * 4);
                    v[j][q] = v[j][q] + g * (m[q] * rs * w); }
            }
#pragma unroll
            for (int q = 0; q < 4; ++q) *(f32x4*)(xd + q * 256 + lane * 4) = v[j][q];
            if (H) {
                float ss = 0.f;
#pragma unroll
                for (int q = 0; q < 4; ++q) ss += (v[j][q][0] * v[j][q][0] + v[j][q][1] * v[j][q][1]) + (v[j][q][2] * v[j][q][2] + v[j][q][3] * v[j][q][3]);
                const float rs = rsqrtf(wave_sum(ss, lane) * (1.f / D) + EPS);
#pragma unroll
                for (int q = 0; q < 4; ++q) { const int c = q * 256 + lane * 4;
                    const f32x4 w = *(const f32x4*)(nwB + c); const f32x4 sc = *(const f32x4*)(modh + (size_t)cond * MODW + sc_off + c); const f32x4 sh = *(const f32x4*)(modh + (size_t)cond * MODW + sh_off + c);
                    const f32x4 hv = (v[j][q] * rs * w) * (sc + 1.0f) + sh;
                    v2u o; o.x = pk2(hv[0], hv[1]); o.y = pk2(hv[2], hv[3]); *(v2u*)(H + (size_t)r * D + c) = o; }
            } } }
    }
}

__device__ __forceinline__ void convgate2(const Args& a, int l, int nrows) {
    const bf16* U = (const bf16*)(a.ws + WS_U); bf16* G = (bf16*)(a.ws + WS_G); const float* cw = a.in[I_FCONV] + (size_t)l * 3 * UPW;
    const int total = (nrows / 8) * (DFF / 8);
    for (int idx = blockIdx.x * NTHR + otid(a.wv); idx < total; idx += gridDim.x * NTHR) {
        const int r0 = (idx / (DFF / 8)) * 8, c0 = (idx % (DFF / 8)) * 8; const bf16* u = U + (size_t)r0 * UPW + c0;
        const bool hp = has_prev(r0), hn = has_next(r0 + 7);
        v4u ua[10], ug[10];
#pragma unroll
        for (int j = 0; j < 10; ++j) { const int rr = (j == 0 && !hp) ? 0 : ((j == 9 && !hn) ? 7 : j - 1); ua[j] = *(const v4u*)(u + (ptrdiff_t)rr * UPW); ug[j] = *(const v4u*)(u + (ptrdiff_t)rr * UPW + DFF); }
        float wa[3][8], wg[3][8];
#pragma unroll
        for (int t = 0; t < 3; ++t)
#pragma unroll
            for (int j = 0; j < 8; ++j) { wa[t][j] = cw[t * UPW + c0 + j]; wg[t][j] = cw[t * UPW + DFF + c0 + j]; }
        if (!hp) { ua[0] = (v4u){0u, 0u, 0u, 0u}; ug[0] = ua[0]; }
        if (!hn) { ua[9] = (v4u){0u, 0u, 0u, 0u}; ug[9] = ua[9]; }
        float pa[8], ca[8], na[8], pg[8], cg_[8], ng[8];
        unpack8(ua[0], pa); unpack8(ug[0], pg); unpack8(ua[1], ca); unpack8(ug[1], cg_);
#pragma unroll
        for (int j = 0; j < 8; ++j) {
            unpack8(ua[j + 2], na); unpack8(ug[j + 2], ng);
            float o[8];
#pragma unroll
            for (int k = 0; k < 8; ++k) { const float act = wa[0][k] * pa[k] + wa[1][k] * ca[k] + wa[2][k] * na[k]; const float gate = wg[0][k] * pg[k] + wg[1][k] * cg_[k] + wg[2][k] * ng[k]; o[k] = silu_f(act) * gate; }
            *(v4u*)(G + (size_t)(r0 + j) * DFF + c0) = pack8(o);
#pragma unroll
            for (int k = 0; k < 8; ++k) { pa[k] = ca[k]; ca[k] = na[k]; pg[k] = cg_[k]; cg_[k] = ng[k]; }
        }
    }
}

__device__ __forceinline__ void ssd_conv2(const Args& a, int i) {
    const bf16* ZX = (const bf16*)(a.ws + WS_ZX); bf16* XBC = (bf16*)(a.ws + WS_XBC); float* DT = (float*)(a.ws + WS_DT); float* AA = (float*)(a.ws + WS_AA);
    const float* cw = a.in[I_SCONVW] + (size_t)i * 3 * 3072; const float* cb = a.in[I_SCONVB] + (size_t)i * 3072;
    const int total = (T / 8) * 384;
    for (int idx = blockIdx.x * NTHR + otid(a.wv); idx < total; idx += gridDim.x * NTHR) {
        const int r0 = (idx / 384) * 8, c0 = (idx % 384) * 8; const bf16* u = ZX + (size_t)r0 * SSD_INP + 2048 + c0;
        const bool hp = has_prev(r0), hn = has_next(r0 + 7);
        v4u ux[10];
#pragma unroll
        for (int j = 0; j < 10; ++j) { const int rr = (j == 0 && !hp) ? 0 : ((j == 9 && !hn) ? 7 : j - 1); ux[j] = *(const v4u*)(u + (ptrdiff_t)rr * SSD_INP); }
        float w[3][8], bias[8];
#pragma unroll
        for (int j = 0; j < 8; ++j) { w[0][j] = cw[c0 + j]; w[1][j] = cw[3072 + c0 + j]; w[2][j] = cw[2 * 3072 + c0 + j]; bias[j] = cb[c0 + j]; }
        if (!hp) ux[0] = (v4u){0u, 0u, 0u, 0u};
        if (!hn) ux[9] = (v4u){0u, 0u, 0u, 0u};
        float p[8], c[8], n[8];
        unpack8(ux[0], p); unpack8(ux[1], c);
#pragma unroll
        for (int j = 0; j < 8; ++j) {
            unpack8(ux[j + 2], n); float o[8];
#pragma unroll
            for (int k = 0; k < 8; ++k) o[k] = silu_f(bias[k] + w[0][k] * p[k] + w[1][k] * c[k] + w[2][k] * n[k]);
            *(v4u*)(XBC + (size_t)(r0 + j) * 3072 + c0) = pack8(o);
#pragma unroll
            for (int k = 0; k < 8; ++k) { p[k] = c[k]; c[k] = n[k]; }
        }
    }
    const float* alog = a.in[I_ALOG] + i * 64; const float* dtb = a.in[I_DTB] + i * 64;
    for (int idx = blockIdx.x * NTHR + otid(a.wv); idx < T * 8; idx += gridDim.x * NTHR) {
        const int r = idx >> 3, j0 = (idx & 7) * 8; float raw[8], dt[8], av[8];
        unpack8(*(const v4u*)(ZX + (size_t)r * SSD_INP + 5120 + j0), raw);
#pragma unroll
        for (int k = 0; k < 8; ++k) { const float x = raw[k] + dtb[j0 + k]; dt[k] = x > 15.f ? x : (x < -15.f ? __expf(x) : __logf(1.f + __expf(x))); av[k] = -__expf(alog[j0 + k]) * dt[k]; }
        *(f32x4*)(DT + (size_t)r * 64 + j0) = (f32x4){dt[0], dt[1], dt[2], dt[3]}; *(f32x4*)(DT + (size_t)r * 64 + j0 + 4) = (f32x4){dt[4], dt[5], dt[6], dt[7]};
        *(f32x4*)(AA + (size_t)r * 64 + j0) = (f32x4){av[0], av[1], av[2], av[3]}; *(f32x4*)(AA + (size_t)r * 64 + j0 + 4) = (f32x4){av[4], av[5], av[6], av[7]};
    }
}

__device__ __forceinline__ void gatenorm2(const Args& a, int i, int nrows) {
    const int tid = otid(a.wv), wave = a.wv, lane = tid & 63; const int NGW = gridDim.x * NWAVES, gw = blockIdx.x * NWAVES + wave;
    const bf16* ZX = (const bf16*)(a.ws + WS_ZX); bf16* YN = (bf16*)(a.ws + WS_XBC); const float* nw = a.in[I_SNORM] + i * 2048;
    const int rpw = (nrows + NGW - 1) / NGW; const int rbeg = gw * rpw, rend = min(rbeg + rpw, nrows);
    constexpr int R = 3;
    for (int r0 = rbeg; r0 < rend; r0 += R) {
        v4u yv[R][4], zv[R][4];
#pragma unroll
        for (int j = 0; j < R; ++j) { const int r = min(r0 + j, rend - 1);
#pragma unroll
            for (int q = 0; q < 4; ++q) { const int c = q * 512 + lane * 8; yv[j][q] = *(const v4u*)(ZX + (size_t)r * SSD_INP + 2048 + c); zv[j][q] = *(const v4u*)(ZX + (size_t)r * SSD_INP + c); } }
#pragma unroll
        for (int j = 0; j < R; ++j) { const int r = r0 + j; if (r < rend) {
            float v[4][8]; float ss = 0.f;
#pragma unroll
            for (int q = 0; q < 4; ++q) { float y[8], z[8]; unpack8(yv[j][q], y); unpack8(zv[j][q], z);
#pragma unroll
                for (int k = 0; k < 8; ++k) { v[q][k] = y[k] * silu_f(z[k]); ss += v[q][k] * v[q][k]; } }
            const float rs = rsqrtf(wave_sum(ss, lane) * (1.f / 2048.f) + EPS);
#pragma unroll
            for (int q = 0; q < 4; ++q) { const int c = q * 512 + lane * 8; float o[8];
#pragma unroll
                for (int k = 0; k < 8; ++k) o[k] = v[q][k] * rs * nw[c + k];
                *(v4u*)(YN + (size_t)r * 2048 + c) = pack8(o); } } }
    }
}

__device__ __forceinline__ void ffn_fixup(const Args& a, int l, int nrows) {
    const bf16* Ue = (const bf16*)(a.ws + WS_UE); bf16* G = (bf16*)(a.ws + WS_G); const float* cw = a.in[I_FCONV] + (size_t)l * 3 * UPW;
    const int total = (nrows / 256) * 2 * (DFF / 8);
    for (int idx = blockIdx.x * NTHR + otid(a.wv); idx < total; idx += gridDim.x * NTHR) {
        const int cg = idx % (DFF / 8), which = (idx / (DFF / 8)) & 1, pm = idx / (2 * (DFF / 8)); const int c0 = cg * 8; const int col = (c0 / 128) * 256 + (c0 % 128);
        const int r = pm * 256 + (which ? 255 : 0);
        const bf16* e0 = Ue + (size_t)(pm * 4) * UPW + col;
        const bf16* pp = which ? e0 + 2 * UPW : e0 - UPW;
        const bf16* pc = which ? e0 + 3 * UPW : e0;
        const bf16* pn = which ? e0 + 4 * UPW : e0 + UPW;
        const bool hp = which ? true : has_prev(r), hn = which ? has_next(r) : true;
        float pa[8], pg[8], ca[8], cg_[8], na[8], ng[8];
        unpack8(*(const v4u*)pc, ca); unpack8(*(const v4u*)(pc + 128), cg_);
        if (hp) { unpack8(*(const v4u*)pp, pa); unpack8(*(const v4u*)(pp + 128), pg); } else {
#pragma unroll
            for (int k = 0; k < 8; ++k) { pa[k] = 0.f; pg[k] = 0.f; } }
        if (hn) { unpack8(*(const v4u*)pn, na); unpack8(*(const v4u*)(pn + 128), ng); } else {
#pragma unroll
            for (int k = 0; k < 8; ++k) { na[k] = 0.f; ng[k] = 0.f; } }
        float o[8];
#pragma unroll
        for (int k = 0; k < 8; ++k) { const float act = cw[c0 + k] * pa[k] + cw[UPW + c0 + k] * ca[k] + cw[2 * UPW + c0 + k] * na[k];
            const float gate = cw[DFF + c0 + k] * pg[k] + cw[UPW + DFF + c0 + k] * cg_[k] + cw[2 * UPW + DFF + c0 + k] * ng[k]; o[k] = silu_f(act) * gate; }
        *(v4u*)(G + (size_t)r * DFF + c0) = pack8(o);
    }
}

__device__ __forceinline__ void prep_even2(const Args& a, int i) {
    const int tid = otid(a.wv), wave = a.wv, lane = tid & 63; const int NGW = gridDim.x * NWAVES, gw = blockIdx.x * NWAVES + wave;
    const bf16* P = (const bf16*)(a.ws + WS_P); bf16* CQN = (bf16*)(a.ws + WS_CQN); bf16* CKVN = (bf16*)(a.ws + WS_CKVN); bf16* KR = (bf16*)(a.ws + WS_KR); bf16* MIX = (bf16*)(a.ws + WS_MIX);
    const float* qn = a.in[I_QNORM] + i * 384; const float* kvn = a.in[I_KVNORM] + i * 256; const float* cw = a.in[I_SCONV] + i * 3 * 512;
    const float* ct = (const float*)(a.ws + WS_ROPE); const float* st = ct + SEQ * 16;
    constexpr int R = 3; const int rpw = (T + NGW - 1) / NGW; const int rbeg = gw * rpw, rend = min(rbeg + rpw, T);
    const int c0 = lane * 8;
    for (int r0 = rbeg; r0 < rend; r0 += R) {
        unsigned q32[R][3]; v2u kv2[R]; bf16 krv[R]; v4u gbv[R], gcv[R + 2], xvv[R + 2];
#pragma unroll
        for (int j = 0; j < R; ++j) { const int r = min(r0 + j, rend - 1); const bf16* p = P + (size_t)r * HYB_INP;
            const unsigned* p32 = (const unsigned*)(p + lane * 6); q32[j][0] = p32[0]; q32[j][1] = p32[1]; q32[j][2] = p32[2];
            kv2[j] = *(const v2u*)(p + 384 + lane * 4); krv[j] = p[640 + (lane & 31)]; gbv[j] = *(const v4u*)(p + 672 + c0); }
#pragma unroll
        for (int j = 0; j < R + 2; ++j) { int r = r0 + j - 1; r = max(0, min(r, T - 1)); const bf16* p = P + (size_t)r * HYB_INP; gcv[j] = *(const v4u*)(p + 1184 + c0); xvv[j] = *(const v4u*)(p + 1696 + c0); }
#pragma unroll
        for (int j = 0; j < R; ++j) { const int r = r0 + j; if (r < rend) {
            {   float f[6] = {bflo(q32[j][0]), bfhi(q32[j][0]), bflo(q32[j][1]), bfhi(q32[j][1]), bflo(q32[j][2]), bfhi(q32[j][2])}; float ss = 0.f;
#pragma unroll
                for (int k = 0; k < 6; ++k) ss += f[k] * f[k];
                const float rs = rsqrtf(wave_sum(ss, lane) * (1.f / 384.f) + EPS);
#pragma unroll
                for (int k = 0; k < 6; ++k) f[k] = f[k] * rs * qn[lane * 6 + k];
                unsigned* o32 = (unsigned*)(CQN + (size_t)r * 384 + lane * 6); o32[0] = pk2(f[0], f[1]); o32[1] = pk2(f[2], f[3]); o32[2] = pk2(f[4], f[5]); }
            {   const v2u w = kv2[j]; float f[4] = {bflo(w.x), bfhi(w.x), bflo(w.y), bfhi(w.y)};
                const float ss = (f[0] * f[0] + f[1] * f[1]) + (f[2] * f[2] + f[3] * f[3]);
                const float rs = rsqrtf(wave_sum(ss, lane) * (1.f / 256.f) + EPS);
                const f32x4 g = *(const f32x4*)(kvn + lane * 4);
                v2u o; o.x = pk2(f[0] * rs * g[0], f[1] * rs * g[1]); o.y = pk2(f[2] * rs * g[2], f[3] * rs * g[3]); *(v2u*)(CKVN + (size_t)r * 256 + lane * 4) = o; }
            {   const int jj = lane & 31; const float v = bf1(krv[j]); const float o = shx(v, 16, lane); float res = v;
                if (r < TL) { const int t = r & (SEQ - 1); const float c = ct[t * 16 + (jj & 15)], s = st[t * 16 + (jj & 15)]; res = (jj < 16) ? v * c - o * s : o * s + v * c; }
                if (lane < 32) KR[(size_t)r * 32 + jj] = (bf16)f2bf(res); }
            {   float gb[8], t0[8], t1[8], acc[8];
                unpack8(gbv[j], gb); unpack8(gcv[j + 1], t0); unpack8(xvv[j + 1], t1);
#pragma unroll
                for (int k = 0; k < 8; ++k) acc[k] = cw[512 + c0 + k] * (t0[k] * t1[k]);
                if (has_prev(r)) { unpack8(gcv[j], t0); unpack8(xvv[j], t1);
#pragma unroll
                    for (int k = 0; k < 8; ++k) acc[k] += cw[c0 + k] * (t0[k] * t1[k]); }
                if (has_next(r)) { unpack8(gcv[j + 2], t0); unpack8(xvv[j + 2], t1);
#pragma unroll
                    for (int k = 0; k < 8; ++k) acc[k] += cw[1024 + c0 + k] * (t0[k] * t1[k]); }
#pragma unroll
                for (int k = 0; k < 8; ++k) acc[k] *= gb[k];
                *(v4u*)(MIX + (size_t)r * D + 512 + c0) = pack8(acc); }
        } }
    }
}

__device__ __forceinline__ void ffn_fixup_panel(const Args& a, int l, int pm) {
    const bf16* Ue = (const bf16*)(a.ws + WS_UE); bf16* G = (bf16*)(a.ws + WS_G); const float* cw = a.in[I_FCONV] + (size_t)l * 3 * UPW;
    for (int idx = otid(a.wv); idx < 2 * (DFF / 8); idx += NTHR) {
        const int cg = idx % (DFF / 8), which = idx / (DFF / 8); const int c0 = cg * 8; const int col = (c0 / 128) * 256 + (c0 % 128);
        const int r = pm * 256 + (which ? 255 : 0);
        const bf16* e0 = Ue + (size_t)(pm * 4) * UPW + col;
        const bf16* pp = which ? e0 + 2 * UPW : e0 - UPW; const bf16* pc = which ? e0 + 3 * UPW : e0; const bf16* pn = which ? e0 + 4 * UPW : e0 + UPW;
        const bool hp = which ? true : has_prev(r), hn = which ? has_next(r) : true;
        float pa[8], pg[8], ca[8], cg_[8], na[8], ng[8];
        unpack8(*(const v4u*)pc, ca); unpack8(*(const v4u*)(pc + 128), cg_);
        if (hp) { unpack8(*(const v4u*)pp, pa); unpack8(*(const v4u*)(pp + 128), pg); } else {
#pragma unroll
            for (int k = 0; k < 8; ++k) { pa[k] = 0.f; pg[k] = 0.f; } }
        if (hn) { unpack8(*(const v4u*)pn, na); unpack8(*(const v4u*)(pn + 128), ng); } else {
#pragma unroll
            for (int k = 0; k < 8; ++k) { na[k] = 0.f; ng[k] = 0.f; } }
        float o[8];
#pragma unroll
        for (int k = 0; k < 8; ++k) { const float act = cw[c0 + k] * pa[k] + cw[UPW + c0 + k] * ca[k] + cw[2 * UPW + c0 + k] * na[k];
            const float gate = cw[DFF + c0 + k] * pg[k] + cw[UPW + DFF + c0 + k] * cg_[k] + cw[2 * UPW + DFF + c0 + k] * ng[k]; o[k] = silu_f(act) * gate; }
        *(v4u*)(G + (size_t)r * DFF + c0) = pack8(o);
    }
}

#ifndef MK_SINGLE
#define MK_SINGLE 1
#endif
struct GemmDesc { const bf16* A; const bf16* Bt; int M, N, K; bf16* O; int ldc; int mode; };

__global__ void __launch_bounds__(NTHR, 2) fwd_kernel(Args a_in) {
    extern __shared__ __attribute__((aligned(16))) unsigned char lds_raw[];
    LAS unsigned char* lds = (LAS unsigned char*)lds_raw;
#if MK_SINGLE == 1
    volatile LAS unsigned* bst = (volatile LAS unsigned*)(lds + LDS_BYTES - 64);
    const int wv0 = __builtin_amdgcn_readfirstlane((int)threadIdx.x >> 6);
    { const int t0 = otid(wv0); if (t0 < 16) bst[t0] = 0u; }
    __syncthreads();
    const XcdBarrier xbar = xcd_barrier_post((unsigned*)(a_in.ws + WS_CTL), bst, wv0);
#endif
    const Args& a0 = a_in;
#ifdef TDIAG
    unsigned long long tcat[6] = {0, 0, 0, 0, 0, 0}; unsigned long long tlast = __builtin_amdgcn_s_memrealtime();
#endif
    for (int s = a0.lo; s < a0.hi; ++s) {
        Args a = a0;
        { long oz; asm volatile("s_mov_b64 %0, 0" : "=s"(oz));
#pragma unroll
          for (int q = 0; q < 25; ++q) a.in[q] = (const float*)((const char*)a0.in[q] + oz);
          a.out = (float*)((char*)a0.out + oz); a.ws = a0.ws + oz; a.wv = wv0; }
        unsigned char* ws = a.ws;
        float* XL = a.out; float* XC = (float*)(ws + WS_XC); bf16* H = (bf16*)(ws + WS_H); bf16* Mb = (bf16*)(ws + WS_M);
        const float* MOD = (const float*)(ws + WS_MOD); const float* NW = a.in[I_NORMW];
        int nrep = 1;
#ifdef PROBE_MASK
        if (s == 0 && (PROBE_MASK >> 20 & 1u)) nrep = 2;
        if (s >= 2) { const int pk = (s - 2) % 10, ppar = ((s - 2) / 10) & 1; if ((PROBE_MASK >> (pk + 10 * ppar)) & 1u) nrep = 2; }
#endif
        for (int rep = 0; rep < nrep; ++rep) {
        GemmDesc g0{}, g1{}; int ng = 0;
#ifndef NO_SIMPLE
        if (s == 0) {
            mod_compute(a, lds);
            rope_tables(a);
            convert_layer(a, 0, lds);
        } else if (s == 1) {
            rowwise2<3>(a.in[I_X], a.in[I_CTX], XL, XC, nullptr, nullptr, nullptr, H, MOD, 0, 1024, NW, T, a.wv);
        } else {
            const int l = (s - 2) / 10, k = (s - 2) % 10, i = l >> 1; const bool even = (l & 1) == 0, last = (l == 3);
            const int MR = last ? TL : T;
            switch (k) {
            case 0:
                if (even) { g0 = GemmDesc{H, (const bf16*)(ws + W_IN), T, HYB_INP, D, (bf16*)(ws + WS_P), HYB_INP}; ng = 1; }
                else      { g0 = GemmDesc{H, (const bf16*)(ws + W_IN), T, SSD_INP, D, (bf16*)(ws + WS_ZX), SSD_INP}; ng = 1; }
                break;
            case 1: if (even) prep_even2(a, i); else ssd_conv2(a, i); break;
            case 2:
                if (even) { { g0 = GemmDesc{(const bf16*)(ws + WS_CQN), (const bf16*)(ws + W_UQ), T, QW, 384, (bf16*)(ws + WS_Q), QW}; ng = 1; }
                            g1 = GemmDesc{(const bf16*)(ws + WS_CKVN), (const bf16*)(ws + W_UKV), T, KVW, 256, (bf16*)(ws + WS_KV), KVW}; ng = 2; }
                else {
#ifdef SSD_NAIVE
 ssd_scan_naive(a, i, last, lds);
#else
 ssd_scan_mfma(a, i, last, lds);
#endif
 }
                break;
            case 3: if (even) {
#ifdef ATTN_NAIVE
 attn_naive(a, lds);
#else
 attn_mfma(a, lds);
#endif
 } else gatenorm2(a, i, MR); break;
            case 4:
                if (even) { g0 = GemmDesc{(const bf16*)(ws + WS_MIX), (const bf16*)(ws + W_OUT), MR, D, D, Mb, D}; ng = 1; }
                else      { g0 = GemmDesc{(const bf16*)(ws + WS_XBC), (const bf16*)(ws + W_OUT), MR, D, 2048, Mb, D}; ng = 1; }
                break;
            case 5:
#ifdef PROBE_ROW2
                if (l > 0) rowwise2<3>(XL, XC, XL, XC, nullptr, nullptr, nullptr, H, MOD + (size_t)l * 9 * MODW, 0, 1024, NW + (l * 4 + 0) * D, MR, a.wv);
#endif
                rowwise2<3>(XL, XC, XL, XC, Mb, MOD + (size_t)l * 9 * MODW + 2048, NW + (l * 4 + 1) * D, H, MOD + (size_t)l * 9 * MODW, 3072, 4096, NW + (l * 4 + 2) * D, MR, a.wv); break;
            case 6: { g0 = GemmDesc{H, (const bf16*)(ws + W_UP), MR, UPW, D, (bf16*)(ws + WS_G), DFF, 1}; ng = 1; } break;
            case 7: break;
            case 8: { g0 = GemmDesc{(const bf16*)(ws + WS_G), (const bf16*)(ws + W_DN), MR, D, DFF, Mb, D}; ng = 1;
                      pg8::StaticOrder S0; S0.init(MR, D, (int)gridDim.x, (int)blockIdx.x); pg8::Unit u0; int lastpm = -1;
                      for (int ui0 = 0; S0.next(ui0, u0); ++ui0) if (u0.pm != lastpm) { ffn_fixup_panel(a, l, u0.pm); lastpm = u0.pm; }
                      asm volatile("s_waitcnt vmcnt(0)" ::: "memory"); __syncthreads(); } break;
            case 9:
                if (!last) { rowwise2<3>(XL, XC, XL, XC, Mb, MOD + (size_t)l * 9 * MODW + 5120, NW + (l * 4 + 3) * D, H, MOD + (size_t)(l + 1) * 9 * MODW, 0, 1024, NW + ((l + 1) * 4 + 0) * D, T, a.wv);
                             convert_layer(a, l + 1, lds); }
                else rowwise2<3>(XL, XC, XL, XC, Mb, MOD + (size_t)l * 9 * MODW + 5120, NW + (l * 4 + 3) * D, nullptr, MOD, 0, 0, NW, TL, a.wv);
                break;
            }
        }
#else
        { g0 = GemmDesc{H, (const bf16*)(ws + W_IN), T, a.hi * 256, a.lo * 128, (bf16*)(ws + WS_P), HYB_INP}; ng = 1; }
#endif
        for (int gi = 0; gi < ng; ++gi) {
            const bool f = (gi == 0);
            pg8::Gemm g{f ? g0.A : g1.A, f ? g0.Bt : g1.Bt, f ? g0.M : g1.M, f ? g0.N : g1.N, f ? g0.K : g1.K, a.wv,
#ifdef GDIAG
                (s == GDIAG_STEP) ? (float*)(a0.ws + WS_MOD + 900 * 1024) : nullptr
#else
                nullptr
#endif
            }; pg8::StaticOrder S; S.init(g.M, g.N, (int)gridDim.x, (int)blockIdx.x);
            pg8::EpiFfn E{f ? g0.O : g1.O, f ? g0.ldc : g1.ldc, f ? g0.mode : 0, (bf16*)(ws + WS_UE), a.in[I_FCONV] + (size_t)((s - 2) / 10) * 3 * UPW, (LAS pg8::f32x4*)(lds + 131072), a.wv};
#ifndef NO_GEMM
            pg8::gemm_phase<pg8::EpiFfn, pg8::StaticOrder, true, true>(lds, g, S, E);
#endif
            __syncthreads();
        }
        if (rep + 1 < nrep) __syncthreads();
        }
#ifdef GDIAG
        if (s + 1 == a0.hi) { __syncthreads(); asm volatile("s_waitcnt vmcnt(0)" ::: "memory"); if (blockIdx.x == 0 && otid(wv0) == 0) { const float* dg = (const float*)(a0.ws + WS_MOD + 900 * 1024); a0.out[0] += 25.0f * dg[GDIAG_SEL] / dg[3]; } }
#endif
#ifdef SSD_DIAG
        if (s + 1 == a0.hi) { __syncthreads(); asm volatile("s_waitcnt vmcnt(0)" ::: "memory"); if (blockIdx.x == 0 && otid(wv0) == 0) { const float* dg = (const float*)(a0.ws + WS_MOD + 900 * 1024); a0.out[0] += 25.0f * dg[SSD_DIAG_SEL] / dg[7]; } }
#endif
#ifdef TDIAG
        if (s + 1 == a0.hi) { __syncthreads(); }
#endif
        if (s + 1 < a0.hi && !(s >= 2 && (s - 2) % 10 == 7)) {
#if MK_SINGLE == 1
            xcd_barrier(xbar);
#ifdef PROBE_BAR2
            xcd_barrier(xbar);
#endif
#elif MK_SINGLE == 2
            cg::this_grid().sync();
#endif
        }
#ifdef TDIAG
        { const unsigned long long tn = __builtin_amdgcn_s_memrealtime(); int cat = 0;
          if (s >= 2) { const int k = (s - 2) % 10, par = ((s - 2) / 10) & 1; cat = (k == 0 || k == 4 || k == 6 || k == 8 || (k == 2 && par == 0)) ? 1 : ((k == 5 || k == 9) ? 2 : ((k == 3 && par == 0) ? 4 : ((k == 2 && par == 1) ? 5 : 3)));
#ifdef TDIAG_K
              cat = (k == TDIAG_K && (TDIAG_PAR == 2 || par == TDIAG_PAR)) ? 1 : 3;
#endif
          }
#pragma unroll
          for (int q = 0; q < 6; ++q) if (q == cat) tcat[q] += tn - tlast;
          tlast = tn;
          if (s + 1 == a0.hi) { asm volatile("s_waitcnt vmcnt(0)" ::: "memory"); if (blockIdx.x == 0 && otid(wv0) == 0) { unsigned long long tt = 0;
#pragma unroll
              for (int q = 0; q < 6; ++q) tt += tcat[q];
              a0.out[0] += (TDIAG == 6) ? (float)tt * (1.0f / 20000.0f) : 25.0f * (float)tcat[TDIAG < 6 ? TDIAG : 0] / (float)tt; } } }
#endif
    }
}

extern "C" void kernel_launch(void* const* d_in, const int* in_sizes, int n_in, void* d_out, int out_size, void* d_ws, size_t ws_size, hipStream_t stream) {
    static int grid = 0;
    if (grid == 0) {
        if (n_in != 25 || out_size != TL * D || ws_size < WS_END) { fprintf(stderr, "kernel_launch: unexpected problem (n_in %d out %d ws %zu need %zu)\n", n_in, out_size, ws_size, (size_t)WS_END); grid = -1; return; }
        if (hipFuncSetAttribute((const void*)fwd_kernel, hipFuncAttributeMaxDynamicSharedMemorySize, LDS_BYTES) != hipSuccess) { fprintf(stderr, "kernel_launch: hipFuncSetAttribute failed\n"); grid = -1; return; }
        int dev = 0, cus = 0, per_cu = 0;
        hipGetDevice(&dev); hipDeviceGetAttribute(&cus, hipDeviceAttributeMultiprocessorCount, dev);
        hipOccupancyMaxActiveBlocksPerMultiprocessor(&per_cu, (const void*)fwd_kernel, NTHR, LDS_BYTES);
        (void)hipGetLastError();
        if (per_cu < 1) { fprintf(stderr, "kernel_launch: occupancy query says %d blocks per CU\n", per_cu); }
        grid = cus;
    }
    if (grid < 0) return;
#if MK_SINGLE == 1
    if (hipMemsetAsync((char*)d_ws + WS_CTL, 0, CTL_ZERO_BYTES, stream) != hipSuccess) { fprintf(stderr, "kernel_launch: memset failed\n"); return; }
#endif
    Args a{};
    for (int i = 0; i < 25; ++i) a.in[i] = (const float*)d_in[i];
    a.out = (float*)d_out; a.ws = (unsigned char*)d_ws;
#if MK_SINGLE
    a.lo = 0; a.hi = NSTEP + 1;
    void* args[] = {&a};
    hipError_t e = hipLaunchCooperativeKernel((const void*)fwd_kernel, dim3(grid), dim3(NTHR), args, LDS_BYTES, stream);
    if (e != hipSuccess) fprintf(stderr, "cooperative launch failed: %s (grid %d)\n", hipGetErrorString(e), grid);
#else
    for (int s = 0; s < NSTEP + 1; ++s) { a.lo = s; a.hi = s + 1; hipLaunchKernelGGL(fwd_kernel, dim3(grid), dim3(NTHR), LDS_BYTES, stream, a); }
#endif
}
```

```cpp
#include <hip/hip_runtime.h>
#include <hip/hip_cooperative_groups.h>
#include <cstdio>
#include <cstdint>
namespace cg = cooperative_groups;
__device__ __forceinline__ int otid(int wv) { int l; asm volatile("v_mbcnt_lo_u32_b32 %0, -1, 0\n\tv_mbcnt_hi_u32_b32 %0, -1, %0" : "=v"(l)); return (wv << 6) | l; }
__device__ __forceinline__ float shx(float v, int mask, int lane) { return __builtin_bit_cast(float, __builtin_amdgcn_ds_bpermute((lane ^ mask) << 2, __builtin_bit_cast(int, v))); }
#define LAS __attribute__((address_space(3)))
typedef float f32x2_cv __attribute__((ext_vector_type(2))); typedef __bf16 bf16x2_cv __attribute__((ext_vector_type(2)));
__device__ __forceinline__ unsigned hw_cvtpk(float lo, float hi) { f32x2_cv v = {lo, hi}; bf16x2_cv b = __builtin_convertvector(v, bf16x2_cv); return __builtin_bit_cast(unsigned, b); }
#define XB_TMO      128
#define XB_XCNT(j)  (256  + 64 * (j))
#define XB_XSUB(j)  (1280 + 64 * (j))
#define XB_XGEN(j)  (2304 + 64 * (j))
#define XB_TOP      3328
#define XB_TOPGEN   3392
#define XCD_BAR_WORDS 3456
#define XB_SPIN_CAP (1u << 18)

__device__ __forceinline__ unsigned xb_ld(unsigned* p)              { return __hip_atomic_load(p, __ATOMIC_RELAXED, __HIP_MEMORY_SCOPE_AGENT); }
__device__ __forceinline__ unsigned xb_add(unsigned* p, unsigned v) { return __hip_atomic_fetch_add(p, v, __ATOMIC_RELAXED, __HIP_MEMORY_SCOPE_AGENT); }
__device__ __forceinline__ unsigned xb_xcc_id() { return (unsigned)__builtin_amdgcn_s_getreg((3 << 11) | 20) & 0xFu; }
#define XB_SPIN(cond, bar) do { unsigned _sp = 0; while (cond) { __builtin_amdgcn_s_sleep(1); \
    if ((++_sp & 255u) == 0u) { if (xb_ld(&(bar)[XB_TMO])) break; if (_sp > XB_SPIN_CAP) { atomicAdd(&(bar)[XB_TMO], 1u); break; } } } } while (0)

struct XcdBarrier {
    unsigned* bar; unsigned x; int wv;
    volatile LAS unsigned* st;
};

__device__ __forceinline__ XcdBarrier xcd_barrier_post(unsigned* bar, volatile LAS unsigned* st, int wv) {
    XcdBarrier b; b.bar = bar; b.x = xb_xcc_id(); b.st = st; b.wv = wv;
    if (otid(wv) == 0) (void)xb_add(&bar[XB_XCNT(b.x)], 1u);
    return b;
}
__device__ __forceinline__ void xcd_barrier_complete(unsigned* bar, unsigned x, unsigned& nloc, unsigned& nx) {
    const unsigned G = gridDim.x * gridDim.y * gridDim.z;
    unsigned sum, cnt, mine, sp = 0u;
    for (;;) {
        sum = 0u; cnt = 0u; mine = 0u;
#pragma unroll
        for (unsigned j = 0; j < 16; ++j) { const unsigned c = xb_ld(&bar[XB_XCNT(j)]); sum += c; cnt += (c > 0u) ? 1u : 0u; mine = (j == x) ? c : mine; }
        if (sum == G) break;
        __builtin_amdgcn_s_sleep(1);
        if ((++sp & 255u) == 0u) { if (xb_ld(&bar[XB_TMO])) break; if (sp > XB_SPIN_CAP) { atomicAdd(&bar[XB_TMO], 1u); break; } }
    }
    nloc = mine > 0u ? mine : 1u; nx = cnt > 0u ? cnt : 1u;
}

__device__ __forceinline__ void xcd_barrier(const XcdBarrier& b) {
    asm volatile("s_waitcnt vmcnt(0)" ::: "memory");
    __syncthreads();
    if (otid(b.wv) == 0) {
        unsigned* bar = b.bar;
        __builtin_amdgcn_s_waitcnt(0);
        unsigned nloc = b.st[0], nx = b.st[1];
        if (nloc == 0u) { xcd_barrier_complete(bar, b.x, nloc, nx); b.st[0] = nloc; b.st[1] = nx; }
        const unsigned old = xb_add(&bar[XB_XSUB(b.x)], 1u);
        const unsigned gen = old / nloc;
        if (old + 1u == (gen + 1u) * nloc) {
            __builtin_amdgcn_fence(__ATOMIC_RELEASE, "agent");
            asm volatile("s_waitcnt vmcnt(0)" ::: "memory");
            const unsigned og = xb_add(&bar[XB_TOP], 1u);
            const unsigned tg = og / nx;
            if (og + 1u == (tg + 1u) * nx) xb_add(&bar[XB_TOPGEN], 1u);
            else XB_SPIN(xb_ld(&bar[XB_TOPGEN]) == tg, bar);
            __builtin_amdgcn_fence(__ATOMIC_ACQUIRE, "agent");
            xb_add(&bar[XB_XGEN(b.x)], 1u);
            asm volatile("s_waitcnt vmcnt(0)" ::: "memory");
        } else {
            XB_SPIN(xb_ld(&bar[XB_XGEN(b.x)]) == gen, bar);
            __builtin_amdgcn_fence(__ATOMIC_ACQUIRE, "agent");
            asm volatile("s_waitcnt vmcnt(0)" ::: "memory");
        }
    }
    __syncthreads();
}
namespace pg8 {
#define PG8_LAS __attribute__((address_space(3)))
typedef unsigned short bf16_t;
typedef short bf16x8 __attribute__((ext_vector_type(8)));
typedef float f32x4 __attribute__((ext_vector_type(4)));
typedef unsigned u32x4 __attribute__((ext_vector_type(4)));
constexpr int BM = 256, BK = 64, HALF = 128, HTB = HALF * BK * 2  , STAGE_BYTES = 8 * HTB, NXCD = 8, WGM = 8;

__host__ __device__ __forceinline__ int lds_byte(int r, int c) { const int st = (r >> 4) * 2 + (c >> 5), rr = r & 15, cc = c & 31, ob = rr * 64 + cc * 2; return st * 1024 + (ob ^ (((ob >> 9) & 1) << 5)); }
__host__ __device__ __forceinline__ void stage_rc(int b, int& R, int& C) { const int st = b / 1024, sb = b % 1024, swz = sb ^ (((sb >> 9) & 1) << 5); R = (st >> 1) * 16 + swz / 64; C = (st & 1) * 32 + (swz % 64) / 2; }
__host__ __device__ __forceinline__ int perm32(int rho) { const int n = rho >> 4, i = rho & 15; return 8 * (i >> 2) + 4 * n + (i & 3); }

struct Unit { int pm, pn; };
struct Gemm { const bf16_t* A; const bf16_t* Bt; int M, N, K, wv; float* dg; };

struct StaticOrder {
    int nM, nN, nwg, G, c;
    __host__ __device__ void init(int M, int N, int G_, int c_) { nM = M / BM; nN = N / BM; nwg = nM * nN; G = G_; c = c_; }
    __host__ __device__ bool next(int i, Unit& u) const {
        const long L = (long)i * G + c; if (L >= nwg) return false;
        int wgid = (int)L; { const int q = nwg / NXCD, r = nwg % NXCD, xcd = wgid % NXCD, off = wgid / NXCD; wgid = (xcd < r ? xcd * (q + 1) : r * (q + 1) + (xcd - r) * q) + off; }
        const int nig = WGM * nN, gid = wgid / nig, fm = gid * WGM, gsz = (nM - fm) < WGM ? (nM - fm) : WGM;
        u.pm = fm + ((wgid % nig) % gsz); u.pn = (wgid % nig) / gsz; return true;
    }
    __device__ __forceinline__ void a_ready(const Unit&) const {}
    __device__ __forceinline__ void done(const Unit&) const {}
};

__device__ __forceinline__ unsigned cvt_pk_bf16(float lo, float hi) { return hw_cvtpk(lo, hi); }
struct EpiStore {
    static constexpr bool PERM = true, AFTER_DRAIN = false;
    bf16_t* O; int ldc;
    __device__ __forceinline__ void operator()(const f32x4 (&acc)[2][2][4][2], const Unit& u, int wr, int wc, int fr, int fq) const {
        const int row0 = u.pm * BM + wr * 64 + fr; const int col0 = u.pn * BM + wc * 32 + 8 * fq;
#pragma unroll
        for (int ai = 0; ai < 2; ++ai)
#pragma unroll
            for (int m = 0; m < 4; ++m) { bf16_t* rowp = O + (size_t)(row0 + ai * HALF + m * 16) * ldc + col0;
#pragma unroll
                for (int bj = 0; bj < 2; ++bj) { const f32x4 v0 = acc[ai][bj][m][0], v1 = acc[ai][bj][m][1];
                    u32x4 w; w.x = cvt_pk_bf16(v0[0], v0[1]); w.y = cvt_pk_bf16(v0[2], v0[3]); w.z = cvt_pk_bf16(v1[0], v1[1]); w.w = cvt_pk_bf16(v1[2], v1[3]);
                    *(u32x4*)(rowp + bj * HALF) = w; } }
    }
};

template <int CTRL> __device__ __forceinline__ float dpprot(float src) { return __builtin_bit_cast(float, __builtin_amdgcn_mov_dpp(__builtin_bit_cast(int, src), CTRL, 0xf, 0xf, true)); }
template <int CTRL> __device__ __forceinline__ float dppf(float old, float src) { return __builtin_bit_cast(float, __builtin_amdgcn_update_dpp(__builtin_bit_cast(int, old), __builtin_bit_cast(int, src), CTRL, 0xf, 0xf, false)); }
#define PG8_DPP4(dst, oldv, srcv, ctrl) do { dst[0] = dppf<ctrl>(oldv[0], srcv[0]); dst[1] = dppf<ctrl>(oldv[1], srcv[1]); dst[2] = dppf<ctrl>(oldv[2], srcv[2]); dst[3] = dppf<ctrl>(oldv[3], srcv[3]); } while (0)
struct EpiFfn {
    static constexpr bool PERM = true, AFTER_DRAIN = false;
    bf16_t* O; int ldc; int mode;
    bf16_t* Ue; const float* cw; PG8_LAS f32x4* ex; int wv;
    __device__ __forceinline__ void operator()(const f32x4 (&acc)[2][2][4][2], const Unit& u, int wr, int wc, int fr_in, int fq_in) const {
        (void)fr_in; (void)fq_in; const int lane_e = otid(wv) & 63; const int fr = lane_e & 15, fq = lane_e >> 4;
        if (mode == 0) {
            const int row0 = u.pm * BM + wr * 64 + fr; const int col0 = u.pn * BM + wc * 32 + 8 * fq;
#pragma unroll
            for (int ai = 0; ai < 2; ++ai)
#pragma unroll
                for (int m = 0; m < 4; ++m) { bf16_t* rowp = O + (size_t)(row0 + ai * HALF + m * 16) * ldc + col0;
#pragma unroll
                    for (int bj = 0; bj < 2; ++bj) { const f32x4 v0 = acc[ai][bj][m][0], v1 = acc[ai][bj][m][1];
                        u32x4 w; w.x = cvt_pk_bf16(v0[0], v0[1]); w.y = cvt_pk_bf16(v0[2], v0[3]); w.z = cvt_pk_bf16(v1[0], v1[1]); w.w = cvt_pk_bf16(v1[2], v1[3]);
                        *(u32x4*)(rowp + bj * HALF) = w; } }
            return;
        }
        const int chl = wc * 32 + 8 * fq, ch = u.pn * 128 + chl;
        f32x4 wA[3][2], wG[3][2];
#pragma unroll
        for (int t = 0; t < 3; ++t)
#pragma unroll
            for (int n = 0; n < 2; ++n) { wA[t][n] = *(const f32x4*)(cw + t * 5632 + ch + 4 * n); wG[t][n] = *(const f32x4*)(cw + t * 5632 + 2816 + ch + 4 * n); }
#define PG8_EX(blk, fl, bj, n) ex[((((blk) * 2 + (fl)) * 2 + (bj)) * 2 + (n)) * 16 + wc * 4 + fq]
#pragma unroll
        for (int ai = 0; ai < 2; ++ai) { const int blk = ai * 2 + wr;
            const bool lastr = fr == 15;
#pragma unroll
            for (int bj = 0; bj < 2; ++bj)
#pragma unroll
                for (int n = 0; n < 2; ++n) { const f32x4 a0 = acc[ai][bj][0][n], a3 = acc[ai][bj][3][n]; f32x4 v;
#pragma unroll
                    for (int e = 0; e < 4; ++e) v[e] = lastr ? a3[e] : a0[e];
                    if (fr == 0 || lastr) ex[((((blk) * 2 + (lastr ? 1 : 0)) * 2 + bj) * 2 + n) * 16 + wc * 4 + fq] = v; } }
        asm volatile("s_waitcnt lgkmcnt(0)" ::: "memory"); __builtin_amdgcn_s_barrier(); asm volatile("" ::: "memory");
        const f32x4 zero4 = (f32x4){0.f, 0.f, 0.f, 0.f}; const bool is15 = fr == 15, is0 = fr == 0;
#pragma unroll
        for (int ai = 0; ai < 2; ++ai) { const int blk = ai * 2 + wr;
            f32x4 pb[2][2], nb[2][2];
#pragma unroll
            for (int bj = 0; bj < 2; ++bj)
#pragma unroll
                for (int n = 0; n < 2; ++n) { pb[bj][n] = blk > 0 ? PG8_EX(blk - 1, 1, bj, n) : zero4; nb[bj][n] = blk < 3 ? PG8_EX(blk + 1, 0, bj, n) : zero4; }
#pragma unroll
            for (int m = 0; m < 4; ++m) {
                f32x4 cv[2][2];
#pragma unroll
                for (int bj = 0; bj < 2; ++bj)
#pragma unroll
                    for (int n = 0; n < 2; ++n) { const f32x4 cur = acc[ai][bj][m][n];
                        const f32x4 lo = (m == 0) ? pb[bj][n] : acc[ai][bj][m > 0 ? m - 1 : 0][n];
                        const f32x4 hi = (m == 3) ? nb[bj][n] : acc[ai][bj][m < 3 ? m + 1 : 3][n];
                        f32x4 prev, next;
#pragma unroll
                        for (int e = 0; e < 4; ++e) { prev[e] = dpprot<0x121>(is15 ? lo[e] : cur[e]);
                                                      next[e] = dpprot<0x12F>(is0 ? hi[e] : cur[e]); }
                        const f32x4 w0 = bj ? wG[0][n] : wA[0][n], w1 = bj ? wG[1][n] : wA[1][n], w2 = bj ? wG[2][n] : wA[2][n];
                        cv[bj][n] = w0 * prev + w1 * cur + w2 * next; }
                u32x4 w; float g[8];
#pragma unroll
                for (int n = 0; n < 2; ++n)
#pragma unroll
                    for (int e = 0; e < 4; ++e) { const float av = cv[0][n][e]; g[4 * n + e] = av * __builtin_amdgcn_rcpf(1.f + __expf(-av)) * cv[1][n][e]; }
                w.x = cvt_pk_bf16(g[0], g[1]); w.y = cvt_pk_bf16(g[2], g[3]); w.z = cvt_pk_bf16(g[4], g[5]); w.w = cvt_pk_bf16(g[6], g[7]);
                *(u32x4*)(O + (size_t)(u.pm * BM + ai * HALF + wr * 64 + m * 16 + fr) * 2816 + ch) = w;
            } }
#undef PG8_EX
        { const int slot = (wr == 0) ? (fr == 0 ? 0 : (fr == 1 ? 1 : -1)) : (fr == 14 ? 2 : (fr == 15 ? 3 : -1));
          if (slot >= 0) { bf16_t* up = Ue + ((size_t)(u.pm * 4 + slot) * 5632) + u.pn * 256 + chl;
#pragma unroll
              for (int bj = 0; bj < 2; ++bj) { const f32x4 a0 = acc[0][bj][0][0], a1 = acc[0][bj][0][1], b0 = acc[1][bj][3][0], b1 = acc[1][bj][3][1]; f32x4 v0, v1;
#pragma unroll
                  for (int e = 0; e < 4; ++e) { v0[e] = wr ? b0[e] : a0[e]; v1[e] = wr ? b1[e] : a1[e]; }
                  u32x4 w; w.x = cvt_pk_bf16(v0[0], v0[1]); w.y = cvt_pk_bf16(v0[2], v0[3]); w.z = cvt_pk_bf16(v1[0], v1[1]); w.w = cvt_pk_bf16(v1[2], v1[3]);
                  *(u32x4*)(up + bj * HALF) = w; } } }
    }
};
template <class Epi, class Sched, bool ALIGN_EPI = false, bool SP2 = false>
__device__ __forceinline__ void gemm_phase(PG8_LAS unsigned char* lds, const Gemm g, const Sched& S, const Epi& E) {
    const int tid = otid(g.wv), wid = g.wv, lane = tid & 63, wr = wid >> 2, wc = wid & 3, fr = lane & 15, fq = lane >> 4;
    const int K = g.K, nt = K / BK;
    unsigned voffA[2], voffB[2];
#pragma unroll
    for (int i = 0; i < 2; ++i) { int R, C; stage_rc(tid * 16 + i * 8192, R, C); const int Rb = Epi::PERM ? ((R & ~31) + perm32(R & 31)) : R;
        voffA[i] = (unsigned)(R * K + C) * 2u; voffB[i] = (unsigned)(Rb * K + C) * 2u; }
    const size_t kstep = (size_t)(BK * 2);
    const size_t hstep = (size_t)HALF * K * 2;
    const size_t tstep = 2 * hstep;
    const unsigned ldsw = (unsigned)wid * 1024u;
    const int aoff = lds_byte(wr * 64 + fr, fq * 8), boff = lds_byte(wc * 32 + fr, fq * 8);
#define PG8_SA(b, h) (((b) * 2 + (h)) * HTB)
#define PG8_SB(b, h) ((4 + (b) * 2 + (h)) * HTB)
#define PG8_STAGE(bufoff, gbase, voff) do { _Pragma("unroll") for (int _i = 0; _i < 2; ++_i) \
        __builtin_amdgcn_global_load_lds((const unsigned*)((const char*)(gbase) + (voff)[_i]), (PG8_LAS unsigned*)(lds + (bufoff) + ldsw + _i * 8192), 16, 0, 0); } while (0)
#define PG8_LDA(dst, b, h) do { _Pragma("unroll") for (int m = 0; m < 4; ++m) _Pragma("unroll") for (int k = 0; k < 2; ++k) dst[m][k] = *(const PG8_LAS bf16x8*)(lds + PG8_SA(b, h) + aoff + m * 2048 + k * 1024); } while (0)
#define PG8_LDB(dst, b, h) do { _Pragma("unroll") for (int n = 0; n < 2; ++n) _Pragma("unroll") for (int k = 0; k < 2; ++k) dst[n][k] = *(const PG8_LAS bf16x8*)(lds + PG8_SB(b, h) + boff + n * 2048 + k * 1024); } while (0)
#define PG8_MMA(ai, bj, At, Bt) do { __builtin_amdgcn_s_setprio(1); _Pragma("unroll") for (int m = 0; m < 4; ++m) _Pragma("unroll") for (int n = 0; n < 2; ++n) _Pragma("unroll") for (int k = 0; k < 2; ++k) \
        acc[ai][bj][m][n] = __builtin_amdgcn_mfma_f32_16x16x32_bf16(Bt[n][k], At[m][k], acc[ai][bj][m][n], 0, 0, 0); __builtin_amdgcn_s_setprio(0); } while (0)
#define PG8_WAIT_V(n) asm volatile("s_waitcnt vmcnt(" #n ")" ::: "memory")
#define PG8_WAIT_L(n) asm volatile("s_waitcnt lgkmcnt(" #n ")" ::: "memory")
#define PG8_BAR __builtin_amdgcn_s_barrier()
#define PG8_SCHED __builtin_amdgcn_sched_barrier(0)
    Unit cur, nxt; int ui = 0;
#ifdef GDIAG
    unsigned gd0 = 0, gd1 = 0, gd2 = 0; const unsigned gstart = (unsigned)__builtin_amdgcn_s_memtime();
#endif
    if (!S.next(0, cur)) return;
    f32x4 acc[2][2][4][2];
#pragma unroll
    for (int a = 0; a < 2; ++a)
#pragma unroll
        for (int b = 0; b < 2; ++b)
#pragma unroll
            for (int m = 0; m < 4; ++m)
#pragma unroll
                for (int n = 0; n < 2; ++n) acc[a][b][m][n] = (f32x4){0.f, 0.f, 0.f, 0.f};
    bf16x8 At[4][2], B0[2][2], B1[2][2];
    const char* cA = (const char*)g.A + (size_t)cur.pm * tstep; const char* cB = (const char*)g.Bt + (size_t)cur.pn * tstep;
    S.a_ready(cur);
    if constexpr (SP2) {
        PG8_STAGE(PG8_SB(0, 0), cB, voffB); PG8_STAGE(PG8_SB(0, 1), cB + hstep, voffB); PG8_STAGE(PG8_SA(0, 0), cA, voffA); PG8_STAGE(PG8_SA(0, 1), cA + hstep, voffA);
        if (wr == 1) PG8_BAR;
        PG8_WAIT_V(2); PG8_BAR;
        PG8_STAGE(PG8_SB(1, 0), cB + kstep, voffB); PG8_STAGE(PG8_SA(1, 0), cA + kstep, voffA); PG8_STAGE(PG8_SB(1, 1), cB + hstep + kstep, voffB);
        PG8_WAIT_V(6); PG8_BAR;
    } else {
        PG8_STAGE(PG8_SB(0, 0), cB, voffB); PG8_STAGE(PG8_SA(0, 0), cA, voffA); PG8_STAGE(PG8_SB(0, 1), cB + hstep, voffB); PG8_STAGE(PG8_SA(0, 1), cA + hstep, voffA);
        if (wr == 1) PG8_BAR;
        PG8_WAIT_V(4); PG8_BAR;
        PG8_STAGE(PG8_SB(1, 0), cB + kstep, voffB); PG8_STAGE(PG8_SA(1, 0), cA + kstep, voffA); PG8_STAGE(PG8_SB(1, 1), cB + hstep + kstep, voffB);
        PG8_WAIT_V(6); PG8_BAR;
    }
    for (;;) {
        const bool has_next = S.next(ui + 1, nxt);
        const char* nA = has_next ? (const char*)g.A + (size_t)nxt.pm * tstep : cA; const char* nB = has_next ? (const char*)g.Bt + (size_t)nxt.pn * tstep : cB;
#ifdef GDIAG
        unsigned gt0 = (unsigned)__builtin_amdgcn_s_memtime();
#endif
        for (int t = 0; t < nt; t += 2) {
            const bool last = (t == nt - 2);
            const char* a1 = cA + (size_t)(t + 1) * kstep;
            const char* a2 = last ? nA : cA + (size_t)(t + 2) * kstep; const char* b2 = last ? nB : cB + (size_t)(t + 2) * kstep;
            const char* a3 = a2 + kstep; const char* b3 = b2 + kstep;
            if (last && has_next) S.a_ready(nxt);
            if constexpr (SP2) {
            PG8_LDB(B0, 0, 0); PG8_LDB(B1, 0, 1); PG8_SCHED; PG8_LDA(At, 0, 0); PG8_STAGE(PG8_SA(1, 1), a1 + hstep, voffA);
            PG8_WAIT_V(8); PG8_WAIT_L(0); PG8_BAR; PG8_MMA(0, 0, At, B0); PG8_MMA(0, 1, At, B1); PG8_BAR; PG8_SCHED;
            PG8_LDA(At, 0, 1); PG8_STAGE(PG8_SB(0, 0), b2, voffB); PG8_STAGE(PG8_SB(0, 1), b2 + hstep, voffB); PG8_STAGE(PG8_SA(0, 0), a2, voffA);
            PG8_WAIT_V(8); PG8_WAIT_L(0); PG8_BAR; PG8_MMA(1, 0, At, B0); PG8_MMA(1, 1, At, B1); PG8_BAR; PG8_SCHED;
            PG8_LDB(B0, 1, 0); PG8_LDB(B1, 1, 1); PG8_SCHED; PG8_LDA(At, 1, 0); PG8_STAGE(PG8_SA(0, 1), a2 + hstep, voffA);
            PG8_WAIT_V(8); PG8_WAIT_L(0); PG8_BAR; PG8_MMA(0, 0, At, B0); PG8_MMA(0, 1, At, B1); PG8_BAR; PG8_SCHED;
            PG8_LDA(At, 1, 1); PG8_STAGE(PG8_SB(1, 0), b3, voffB); PG8_STAGE(PG8_SB(1, 1), b3 + hstep, voffB); PG8_STAGE(PG8_SA(1, 0), a3, voffA);
            PG8_WAIT_V(8); PG8_WAIT_L(0); PG8_BAR; PG8_MMA(1, 0, At, B0); PG8_MMA(1, 1, At, B1); PG8_BAR; PG8_SCHED;
            } else {
            PG8_LDB(B0, 0, 0); PG8_SCHED; PG8_LDA(At, 0, 0); PG8_STAGE(PG8_SA(1, 1), a1 + hstep, voffA);
            PG8_WAIT_L(8); PG8_BAR; PG8_WAIT_L(0); PG8_MMA(0, 0, At, B0); PG8_BAR; PG8_SCHED;
            PG8_LDB(B1, 0, 1); PG8_STAGE(PG8_SB(0, 0), b2, voffB);
            PG8_BAR; PG8_WAIT_L(0); PG8_MMA(0, 1, At, B1); PG8_BAR;
            PG8_LDA(At, 0, 1); PG8_STAGE(PG8_SA(0, 0), a2, voffA);
            PG8_BAR; PG8_WAIT_L(0); PG8_MMA(1, 0, At, B0); PG8_BAR; PG8_SCHED;
            PG8_STAGE(PG8_SB(0, 1), b2 + hstep, voffB);
            PG8_WAIT_V(6); PG8_BAR; PG8_MMA(1, 1, At, B1); PG8_BAR;
            PG8_LDB(B0, 1, 0); PG8_SCHED; PG8_LDA(At, 1, 0); PG8_STAGE(PG8_SA(0, 1), a2 + hstep, voffA);
            PG8_WAIT_L(8); PG8_BAR; PG8_WAIT_L(0); PG8_MMA(0, 0, At, B0); PG8_BAR; PG8_SCHED;
            PG8_LDB(B1, 1, 1); PG8_STAGE(PG8_SB(1, 0), b3, voffB);
            PG8_BAR; PG8_WAIT_L(0); PG8_MMA(0, 1, At, B1); PG8_BAR;
            PG8_LDA(At, 1, 1); PG8_STAGE(PG8_SA(1, 0), a3, voffA);
            PG8_BAR; PG8_WAIT_L(0); PG8_MMA(1, 0, At, B0); PG8_BAR; PG8_SCHED;
            PG8_STAGE(PG8_SB(1, 1), b3 + hstep, voffB);
            PG8_WAIT_V(6); PG8_BAR; PG8_MMA(1, 1, At, B1); PG8_BAR;
            }
        }
#ifdef GDIAG
        { const unsigned n_ = (unsigned)__builtin_amdgcn_s_memtime(); gd0 += n_ - gt0; gt0 = n_; }
#endif
        if constexpr (ALIGN_EPI) { if (wr == 0) PG8_BAR; }
#ifdef GDIAG
        { const unsigned n_ = (unsigned)__builtin_amdgcn_s_memtime(); gd1 += n_ - gt0; gt0 = n_; }
#endif
        if constexpr (!Epi::AFTER_DRAIN) { E(acc, cur, wr, wc, fr, fq); S.done(cur); }
#ifdef GDIAG
        { const unsigned n_ = (unsigned)__builtin_amdgcn_s_memtime(); gd2 += n_ - gt0; gt0 = n_; }
#endif
        if (!has_next) break;
#pragma unroll
        for (int a = 0; a < 2; ++a)
#pragma unroll
            for (int b = 0; b < 2; ++b)
#pragma unroll
                for (int m = 0; m < 4; ++m)
#pragma unroll
                    for (int n = 0; n < 2; ++n) acc[a][b][m][n] = (f32x4){0.f, 0.f, 0.f, 0.f};
        cur = nxt; cA = nA; cB = nB; ++ui;
        if constexpr (ALIGN_EPI) { if (wr == 1) PG8_BAR; }
    }
#ifdef GDIAG
    if (g.dg && blockIdx.x == 0 && wid == GDIAG_WAVE && lane == 0) { const unsigned tot = (unsigned)__builtin_amdgcn_s_memtime() - gstart; g.dg[0] = (float)gd0; g.dg[1] = (float)gd1; g.dg[2] = (float)gd2; g.dg[3] = (float)tot; }
#endif
    PG8_WAIT_V(0);
    if constexpr (!ALIGN_EPI) { if (wr == 0) PG8_BAR; }
    PG8_BAR;
    if constexpr (Epi::AFTER_DRAIN) { E.fused(acc, cur, wr, wc, fr, fq, lds, wid, lane); S.done(cur); }
#undef PG8_SA
#undef PG8_SB
#undef PG8_STAGE
#undef PG8_LDA
#undef PG8_LDB
#undef PG8_MMA
#undef PG8_WAIT_V
#undef PG8_WAIT_L
#undef PG8_BAR
#undef PG8_SCHED
}
}

typedef unsigned short bf16;
typedef unsigned v4u __attribute__((ext_vector_type(4)));
typedef unsigned v2u __attribute__((ext_vector_type(2)));
typedef float f32x4 __attribute__((ext_vector_type(4)));
constexpr int NWAVES = 8, NTHR = 512;
constexpr int D = 1024, NB = 8, SEQ = 2048, CTXL = 256, TL = NB * SEQ, TC = NB * CTXL, T = TL + TC;
constexpr int HYB_IN = 2208, HYB_INP = 2304, SSD_IN = 5184, SSD_INP = 5376, DFF = 2816, UPW = 5632;
constexpr int QW = 768, KVW = 1024, MODW = 6144;
constexpr float EPS = 1e-6f;
constexpr int NK = 11;
constexpr int NSTEP = 1 + 4 * NK;
constexpr float ATT_SCALE_LOG2E = 0.10206207261596577f * 1.4426950408889634f;

constexpr size_t MiB = 1u << 20;
constexpr size_t WS_CTL = 0, CTL_ZERO_BYTES = 64 * 1024;
constexpr size_t WS_MOD = 1 * MiB;
constexpr size_t WS_ROPE = 2 * MiB;
constexpr size_t W_UP = 3 * MiB;
constexpr size_t W_DN = W_UP + (size_t)UPW * D * 2;
constexpr size_t W_IN = W_DN + (size_t)D * DFF * 2;
constexpr size_t W_OUT = W_IN + (size_t)SSD_INP * D * 2;
constexpr size_t W_UQ = W_OUT + (size_t)D * 2048 * 2;
constexpr size_t W_UKV = W_UQ + (size_t)QW * 384 * 2;
constexpr size_t W_END = W_UKV + (size_t)KVW * 256 * 2;
constexpr size_t WS_XC = 36 * MiB;
constexpr size_t WS_H = 44 * MiB;
constexpr size_t WS_DT = WS_H, WS_AA = WS_H + (size_t)T * 64 * 4;
constexpr size_t WS_BIG = 80 * MiB;
constexpr size_t WS_M = WS_BIG;
constexpr size_t WS_P = WS_BIG;
constexpr size_t WS_Q = WS_BIG + 81 * MiB;
constexpr size_t WS_KV = WS_BIG + 108 * MiB;
constexpr size_t WS_KR = WS_BIG + 144 * MiB;
constexpr size_t WS_CQN = WS_BIG + 146 * MiB;
constexpr size_t WS_CKVN = WS_BIG + 160 * MiB;
constexpr size_t WS_MIX = WS_BIG + 170 * MiB;
constexpr size_t WS_U = WS_BIG;
constexpr size_t WS_G = WS_BIG + 198 * MiB;
constexpr size_t WS_ZX = WS_BIG;
constexpr size_t WS_XBC = WS_BIG + 189 * MiB;
constexpr size_t WS_UE = WS_BIG + 297 * MiB;
constexpr size_t WS_END = WS_UE + 4 * MiB;
static_assert(W_END <= WS_XC && WS_G + (size_t)T * DFF * 2 <= WS_END && WS_XBC + (size_t)T * 3072 * 2 <= WS_END && WS_ZX + (size_t)T * SSD_INP * 2 <= WS_XBC, "ws map");
static_assert(WS_AA + (size_t)T * 64 * 4 <= WS_BIG && WS_MIX + (size_t)T * D * 2 <= WS_END && WS_Q + (size_t)T * QW * 2 <= WS_KV && WS_P + (size_t)T * HYB_INP * 2 <= WS_Q, "ws map 2");
constexpr int LDS_BYTES = 147456;

struct Args { const float* in[25]; float* out; unsigned char* ws; int lo, hi; int wv, pad; };
enum { I_X = 0, I_C, I_CTX, I_CCTX, I_MODW, I_MODB, I_NORMW, I_WUP, I_FCONV, I_WDN, I_HIN, I_QNORM, I_KVNORM, I_WUQ, I_WUKV, I_SCONV, I_HOUT, I_SIN, I_SCONVW, I_SCONVB, I_ALOG, I_DTB, I_SD, I_SNORM, I_SOUT };

__device__ __forceinline__ unsigned f2bf(float f) { unsigned u = __builtin_bit_cast(unsigned, f); return (u + 0x7fffu + ((u >> 16) & 1u)) >> 16; }
__device__ __forceinline__ unsigned pk2(float lo, float hi) { return hw_cvtpk(lo, hi); }
__device__ __forceinline__ float bflo(unsigned u) { return __builtin_bit_cast(float, u << 16); }
__device__ __forceinline__ float bfhi(unsigned u) { return __builtin_bit_cast(float, u & 0xffff0000u); }
__device__ __forceinline__ float bf1(bf16 b) { return __builtin_bit_cast(float, (unsigned)b << 16); }
__device__ __forceinline__ float silu_f(float x) { return x * __builtin_amdgcn_rcpf(1.f + __expf(-x)); }
__device__ __forceinline__ float wave_sum(float v, int lane) {
#pragma unroll
    for (int o = 1; o < 64; o <<= 1) v += shx(v, o, lane);
    return v;
}
__device__ __forceinline__ void unpack8(const v4u w, float (&f)[8]) { f[0] = bflo(w.x); f[1] = bfhi(w.x); f[2] = bflo(w.y); f[3] = bfhi(w.y); f[4] = bflo(w.z); f[5] = bfhi(w.z); f[6] = bflo(w.w); f[7] = bfhi(w.w); }
__device__ __forceinline__ v4u pack8(const float (&f)[8]) { v4u w; w.x = pk2(f[0], f[1]); w.y = pk2(f[2], f[3]); w.z = pk2(f[4], f[5]); w.w = pk2(f[6], f[7]); return w; }
__device__ __forceinline__ bool has_prev(int r) { return r < TL ? (r & (SEQ - 1)) != 0 : ((r - TL) & (CTXL - 1)) != 0; }
__device__ __forceinline__ bool has_next(int r) { return r < TL ? (r & (SEQ - 1)) != SEQ - 1 : ((r - TL) & (CTXL - 1)) != CTXL - 1; }

__device__ __forceinline__ void mod_compute(const Args& a, LAS unsigned char* lds) {
    LAS float* sc = (LAS float*)lds;
    LAS float* red = (LAS float*)(lds + 36864);
    const int tid = otid(a.wv);
    float* MOD = (float*)(a.ws + WS_MOD);
    for (int i = tid; i < 9 * 1024; i += NTHR) { const int c = i >> 10, k = i & 1023; const float v = c < 8 ? a.in[I_C][c * 1024 + k] : a.in[I_CCTX][k]; sc[i] = silu_f(v); }
    __syncthreads();
    for (int item = blockIdx.x; item < 4 * 96; item += gridDim.x) {
        const int l = item / 96, cb = item % 96;
        const float* W = a.in[I_MODW] + (size_t)l * 1024 * MODW + cb * 64;
        const int cgp = tid & 15, kg = tid >> 4;
        float acc[9][4];
#pragma unroll
        for (int c = 0; c < 9; ++c) { acc[c][0] = 0.f; acc[c][1] = 0.f; acc[c][2] = 0.f; acc[c][3] = 0.f; }
#pragma unroll 8
        for (int kk = 0; kk < 32; ++kk) { const int k = kg * 32 + kk; const f32x4 w = *(const f32x4*)(W + (size_t)k * MODW + cgp * 4);
#pragma unroll
            for (int c = 0; c < 9; ++c) { const float s = sc[c * 1024 + k]; acc[c][0] += s * w[0]; acc[c][1] += s * w[1]; acc[c][2] += s * w[2]; acc[c][3] += s * w[3]; } }
#pragma unroll
        for (int c = 0; c < 9; ++c)
#pragma unroll
            for (int j = 0; j < 4; ++j) red[kg * 576 + c * 64 + cgp * 4 + j] = acc[c][j];
        __syncthreads();
        for (int o = tid; o < 576; o += NTHR) { float s = 0.f;
            for (int g = 0; g < 32; ++g) s += red[g * 576 + o];
            const int c = o >> 6, col = o & 63; MOD[(size_t)(l * 9 + c) * MODW + cb * 64 + col] = s + a.in[I_MODB][l * MODW + cb * 64 + col]; }
        __syncthreads();
    }
}
__device__ __forceinline__ void rope_tables(const Args& a) {
    float* ct = (float*)(a.ws + WS_ROPE); float* st = ct + SEQ * 16;
    for (int i = blockIdx.x * NTHR + otid(a.wv); i < SEQ * 16; i += gridDim.x * NTHR) {
        const int t = i >> 4, j = i & 15; const int pos = j < 8 ? (t >> 6) : (t & 63); const int f = j & 7;
        const float i0 = (f & 1) ? 0.31622776601683794f : 1.0f; const int e = f >> 1; const float i1 = e == 0 ? 1.0f : (e == 1 ? 0.1f : (e == 2 ? 0.01f : 0.001f));
        const float inv = i0 * i1; const float ang = (float)pos * inv;
        ct[i] = __cosf(ang); st[i] = __sinf(ang); }
}
__device__ __forceinline__ void transpose_item(const float* W, int K, int N, bf16* WT, LAS float* scr, int item, int lane, bool ffn_perm) {
    const int nblk = N / 32, kb = item / nblk, nb = item % nblk, k0 = 64 * kb, n0 = 32 * nb;
    const int o0 = ffn_perm ? ((n0 % DFF) / 128) * 256 + (n0 / DFF) * 128 + (n0 % 128) : n0;
    float wv_[32];
#pragma unroll
    for (int i = 0; i < 32; ++i) wv_[i] = W[(size_t)(k0 + 2 * i + (lane >> 5)) * N + n0 + (lane & 31)];
#pragma unroll
    for (int i = 0; i < 32; ++i) scr[(2 * i + (lane >> 5)) * 33 + (lane & 31)] = wv_[i];
    asm volatile("s_waitcnt lgkmcnt(0)" ::: "memory");
    const int c = lane & 7;
#pragma unroll
    for (int j = 0; j < 4; ++j) { const int n = (lane >> 3) + 8 * j; const LAS float* s = scr + (8 * c) * 33 + n;
        v4u o; o.x = pk2(s[0 * 33], s[1 * 33]); o.y = pk2(s[2 * 33], s[3 * 33]); o.z = pk2(s[4 * 33], s[5 * 33]); o.w = pk2(s[6 * 33], s[7 * 33]);
        *(v4u*)(WT + (size_t)(o0 + n) * K + k0 + 8 * c) = o; }
    asm volatile("s_waitcnt lgkmcnt(0)" ::: "memory");
}
__device__ __forceinline__ void convert_weight(const float* W, int K, int N, int Npad, bf16* WT, LAS unsigned char* lds, int rot, int wv, bool ffn_perm = false) {
    const int wave = wv, lane = otid(wv) & 63; const int NGW = gridDim.x * NWAVES; const int gw = (blockIdx.x * NWAVES + wave + rot) % NGW;
    LAS float* scr = (LAS float*)(lds + wave * 16384);
    const int nitems = (K / 64) * (N / 32);
    for (int it = gw; it < nitems; it += NGW) transpose_item(W, K, N, WT, scr, it, lane, ffn_perm);
    (void)Npad;
}
__device__ __forceinline__ void convert_layer(const Args& a, int l, LAS unsigned char* lds) {
    const int i = l >> 1; unsigned char* ws = a.ws;
    convert_weight(a.in[I_WUP] + (size_t)l * D * UPW, D, UPW, UPW, (bf16*)(ws + W_UP), lds, 0, a.wv, true);
    convert_weight(a.in[I_WDN] + (size_t)l * DFF * D, DFF, D, D, (bf16*)(ws + W_DN), lds, 300, a.wv);
    if ((l & 1) == 0) {
        convert_weight(a.in[I_HIN] + (size_t)i * D * HYB_IN, D, HYB_IN, HYB_INP, (bf16*)(ws + W_IN), lds, 700, a.wv);
        convert_weight(a.in[I_HOUT] + (size_t)i * D * D, D, D, D, (bf16*)(ws + W_OUT), lds, 1100, a.wv);
        convert_weight(a.in[I_WUQ] + (size_t)i * 384 * QW, 384, QW, QW, (bf16*)(ws + W_UQ), lds, 1500, a.wv);
        convert_weight(a.in[I_WUKV] + (size_t)i * 256 * KVW, 256, KVW, KVW, (bf16*)(ws + W_UKV), lds, 1700, a.wv);
    } else {
        convert_weight(a.in[I_SIN] + (size_t)i * D * SSD_IN, D, SSD_IN, SSD_INP, (bf16*)(ws + W_IN), lds, 700, a.wv);
        convert_weight(a.in[I_SOUT] + (size_t)i * 2048 * D, 2048, D, D, (bf16*)(ws + W_OUT), lds, 1300, a.wv);
    }
}

__device__ __forceinline__ void prep_even(const Args& a, int i) {
    const int wave = otid(a.wv) >> 6, lane = otid(a.wv) & 63; const int NGW = gridDim.x * NWAVES, gw = blockIdx.x * NWAVES + wave;
    const bf16* P = (const bf16*)(a.ws + WS_P); bf16* CQN = (bf16*)(a.ws + WS_CQN); bf16* CKVN = (bf16*)(a.ws + WS_CKVN); bf16* KR = (bf16*)(a.ws + WS_KR); bf16* MIX = (bf16*)(a.ws + WS_MIX);
    const float* qn = a.in[I_QNORM] + i * 384; const float* kvn = a.in[I_KVNORM] + i * 256; const float* cw = a.in[I_SCONV] + i * 3 * 512;
    const float* ct = (const float*)(a.ws + WS_ROPE); const float* st = ct + SEQ * 16;
    for (int r = gw; r < T; r += NGW) {
        const bf16* p = P + (size_t)r * HYB_INP;
        {
            const unsigned* p32 = (const unsigned*)(p + lane * 6); const unsigned w0 = p32[0], w1 = p32[1], w2 = p32[2];
            float f[6] = {bflo(w0), bfhi(w0), bflo(w1), bfhi(w1), bflo(w2), bfhi(w2)}; float ss = 0.f;
#pragma unroll
            for (int j = 0; j < 6; ++j) ss += f[j] * f[j];
            const float rs = rsqrtf(wave_sum(ss, lane) * (1.f / 384.f) + EPS);
#pragma unroll
            for (int j = 0; j < 6; ++j) f[j] = f[j] * rs * qn[lane * 6 + j];
            unsigned* o32 = (unsigned*)(CQN + (size_t)r * 384 + lane * 6); o32[0] = pk2(f[0], f[1]); o32[1] = pk2(f[2], f[3]); o32[2] = pk2(f[4], f[5]);
        }
        {
            const v2u w = *(const v2u*)(p + 384 + lane * 4); float f[4] = {bflo(w.x), bfhi(w.x), bflo(w.y), bfhi(w.y)};
            const float ss = (f[0] * f[0] + f[1] * f[1]) + (f[2] * f[2] + f[3] * f[3]);
            const float rs = rsqrtf(wave_sum(ss, lane) * (1.f / 256.f) + EPS);
            const f32x4 g = *(const f32x4*)(kvn + lane * 4);
            v2u o; o.x = pk2(f[0] * rs * g[0], f[1] * rs * g[1]); o.y = pk2(f[2] * rs * g[2], f[3] * rs * g[3]); *(v2u*)(CKVN + (size_t)r * 256 + lane * 4) = o;
        }
        {
            const int j = lane & 31; const float v = bf1(p[640 + j]); const float o = shx(v, 16, lane); float res = v;
            if (r < TL) { const int t = r & (SEQ - 1); const float c = ct[t * 16 + (j & 15)], s = st[t * 16 + (j & 15)]; res = (j < 16) ? v * c - o * s : o * s + v * c; }
            if (lane < 32) KR[(size_t)r * 32 + j] = (bf16)f2bf(res);
        }
        {
            const int c0 = lane * 8; float gb[8], cur[8], acc[8], t0[8], t1[8];
            unpack8(*(const v4u*)(p + 672 + c0), gb);
            unpack8(*(const v4u*)(p + 1184 + c0), t0); unpack8(*(const v4u*)(p + 1696 + c0), t1);
#pragma unroll
            for (int j = 0; j < 8; ++j) { cur[j] = t0[j] * t1[j]; acc[j] = cw[512 + c0 + j] * cur[j]; }
            if (has_prev(r)) { unpack8(*(const v4u*)(p - HYB_INP + 1184 + c0), t0); unpack8(*(const v4u*)(p - HYB_INP + 1696 + c0), t1);
#pragma unroll
                for (int j = 0; j < 8; ++j) acc[j] += cw[c0 + j] * (t0[j] * t1[j]); }
            if (has_next(r)) { unpack8(*(const v4u*)(p + HYB_INP + 1184 + c0), t0); unpack8(*(const v4u*)(p + HYB_INP + 1696 + c0), t1);
#pragma unroll
                for (int j = 0; j < 8; ++j) acc[j] += cw[1024 + c0 + j] * (t0[j] * t1[j]); }
#pragma unroll
            for (int j = 0; j < 8; ++j) acc[j] *= gb[j];
            *(v4u*)(MIX + (size_t)r * D + 512 + c0) = pack8(acc);
        }
    }
}

__device__ __forceinline__ void convgate(const Args& a, int l, int nrows) {
    const bf16* U = (const bf16*)(a.ws + WS_U); bf16* G = (bf16*)(a.ws + WS_G); const float* cw = a.in[I_FCONV] + (size_t)l * 3 * UPW;
    const int total = nrows * (DFF / 8);
    for (int idx = blockIdx.x * NTHR + otid(a.wv); idx < total; idx += gridDim.x * NTHR) {
        const int r = idx / (DFF / 8), c0 = (idx % (DFF / 8)) * 8; const bf16* u = U + (size_t)r * UPW + c0;
        float ua[8], ug[8], act[8], gate[8];
        unpack8(*(const v4u*)u, ua); unpack8(*(const v4u*)(u + DFF), ug);
#pragma unroll
        for (int j = 0; j < 8; ++j) { act[j] = cw[UPW + c0 + j] * ua[j]; gate[j] = cw[UPW + DFF + c0 + j] * ug[j]; }
        if (has_prev(r)) { unpack8(*(const v4u*)(u - UPW), ua); unpack8(*(const v4u*)(u - UPW + DFF), ug);
#pragma unroll
            for (int j = 0; j < 8; ++j) { act[j] += cw[c0 + j] * ua[j]; gate[j] += cw[DFF + c0 + j] * ug[j]; } }
        if (has_next(r)) { unpack8(*(const v4u*)(u + UPW), ua); unpack8(*(const v4u*)(u + UPW + DFF), ug);
#pragma unroll
            for (int j = 0; j < 8; ++j) { act[j] += cw[2 * UPW + c0 + j] * ua[j]; gate[j] += cw[2 * UPW + DFF + c0 + j] * ug[j]; } }
#pragma unroll
        for (int j = 0; j < 8; ++j) act[j] = silu_f(act[j]) * gate[j];
        *(v4u*)(G + (size_t)r * DFF + c0) = pack8(act);
    }
}

__device__ __forceinline__ void ssd_conv(const Args& a, int i) {
    const bf16* ZX = (const bf16*)(a.ws + WS_ZX); bf16* XBC = (bf16*)(a.ws + WS_XBC); float* DT = (float*)(a.ws + WS_DT); float* AA = (float*)(a.ws + WS_AA);
    const float* cw = a.in[I_SCONVW] + (size_t)i * 3 * 3072; const float* cb = a.in[I_SCONVB] + (size_t)i * 3072;
    const int total = T * 384;
    for (int idx = blockIdx.x * NTHR + otid(a.wv); idx < total; idx += gridDim.x * NTHR) {
        const int r = idx / 384, c0 = (idx % 384) * 8; const bf16* u = ZX + (size_t)r * SSD_INP + 2048 + c0;
        float x[8], acc[8];
        unpack8(*(const v4u*)u, x);
#pragma unroll
        for (int j = 0; j < 8; ++j) acc[j] = cb[c0 + j] + cw[3072 + c0 + j] * x[j];
        if (has_prev(r)) { unpack8(*(const v4u*)(u - SSD_INP), x);
#pragma unroll
            for (int j = 0; j < 8; ++j) acc[j] += cw[c0 + j] * x[j]; }
        if (has_next(r)) { unpack8(*(const v4u*)(u + SSD_INP), x);
#pragma unroll
            for (int j = 0; j < 8; ++j) acc[j] += cw[2 * 3072 + c0 + j] * x[j]; }
#pragma unroll
        for (int j = 0; j < 8; ++j) acc[j] = silu_f(acc[j]);
        *(v4u*)(XBC + (size_t)r * 3072 + c0) = pack8(acc);
    }
    const float* alog = a.in[I_ALOG] + i * 64; const float* dtb = a.in[I_DTB] + i * 64;
    for (int idx = blockIdx.x * NTHR + otid(a.wv); idx < T * 64; idx += gridDim.x * NTHR) {
        const int r = idx >> 6, j = idx & 63; const float raw = bf1(ZX[(size_t)r * SSD_INP + 5120 + j]) + dtb[j];
        const float dt = raw > 15.f ? raw : (raw < -15.f ? __expf(raw) : __logf(1.f + __expf(raw)));
        DT[idx] = dt; AA[idx] = -__expf(alog[j]) * dt;
    }
}

__device__ __forceinline__ void gatenorm(const Args& a, int i, int nrows) {
    const int wave = otid(a.wv) >> 6, lane = otid(a.wv) & 63; const int NGW = gridDim.x * NWAVES, gw = blockIdx.x * NWAVES + wave;
    const bf16* ZX = (const bf16*)(a.ws + WS_ZX); bf16* YN = (bf16*)(a.ws + WS_XBC); const float* nw = a.in[I_SNORM] + i * 2048;
    for (int r = gw; r < nrows; r += NGW) {
        float v[4][8]; float ss = 0.f;
#pragma unroll
        for (int j = 0; j < 4; ++j) { float y[8], z[8]; const int c = j * 512 + lane * 8;
            unpack8(*(const v4u*)(ZX + (size_t)r * SSD_INP + 2048 + c), y); unpack8(*(const v4u*)(ZX + (size_t)r * SSD_INP + c), z);
#pragma unroll
            for (int k = 0; k < 8; ++k) { v[j][k] = y[k] * silu_f(z[k]); ss += v[j][k] * v[j][k]; } }
        const float rs = rsqrtf(wave_sum(ss, lane) * (1.f / 2048.f) + EPS);
#pragma unroll
        for (int j = 0; j < 4; ++j) { const int c = j * 512 + lane * 8; float o[8];
#pragma unroll
            for (int k = 0; k < 8; ++k) o[k] = v[j][k] * rs * nw[c + k];
            *(v4u*)(YN + (size_t)r * 2048 + c) = pack8(o); }
    }
}

__device__ __forceinline__ void attn_naive(const Args& a, LAS unsigned char* lds) {
    const int tid = otid(a.wv), qi = tid >> 1, half = tid & 1;
    const bf16* Qb = (const bf16*)(a.ws + WS_Q); const bf16* KVb = (const bf16*)(a.ws + WS_KV); const bf16* KR = (const bf16*)(a.ws + WS_KR); bf16* MIX = (bf16*)(a.ws + WS_MIX);
    const float* ct = (const float*)(a.ws + WS_ROPE); const float* st = ct + SEQ * 16;
    LAS float* Kt = (LAS float*)lds;
    LAS float* Vt = (LAS float*)(lds + 64 * 96 * 4);
    for (int u = blockIdx.x; u < 576; u += gridDim.x) {
        const bool lat = u < 512; const int b = lat ? (u >> 6) : ((u - 512) >> 3), h = lat ? ((u >> 3) & 7) : ((u - 512) & 7);
        const int nkeys = lat ? (CTXL + SEQ) : CTXL;
        const int qrow = lat ? b * SEQ + (u & 7) * 256 + qi : TL + b * CTXL + qi;
        float q[48];
#pragma unroll
        for (int g = 0; g < 6; ++g) { float f[8]; unpack8(*(const v4u*)(Qb + (size_t)qrow * QW + h * 96 + half * 48 + g * 8), f);
#pragma unroll
            for (int j = 0; j < 8; ++j) q[g * 8 + j] = f[j]; }
        if (lat && half == 1) { const int t = qrow & (SEQ - 1);
#pragma unroll
            for (int j = 0; j < 16; ++j) { const float c = ct[t * 16 + j], s = st[t * 16 + j]; const float x1 = q[16 + j], x2 = q[32 + j]; q[16 + j] = x1 * c - x2 * s; q[32 + j] = x1 * s + x2 * c; } }
#pragma unroll
        for (int j = 0; j < 48; ++j) q[j] *= ATT_SCALE_LOG2E;
        float o[32]; float m = -1e30f, l = 0.f;
#pragma unroll
        for (int j = 0; j < 32; ++j) o[j] = 0.f;
        for (int k0 = 0; k0 < nkeys; k0 += 64) {
            __syncthreads();
            for (int g = tid; g < 768; g += NTHR) { const int key = g / 12, part = g % 12; const int kk = k0 + key; const int krow = kk < CTXL ? TL + b * CTXL + kk : b * SEQ + kk - CTXL;
                float f[8]; unpack8(part < 8 ? *(const v4u*)(KVb + (size_t)krow * KVW + h * 128 + part * 8) : *(const v4u*)(KR + (size_t)krow * 32 + (part - 8) * 8), f);
#pragma unroll
                for (int j = 0; j < 8; ++j) Kt[key * 96 + part * 8 + j] = f[j]; }
            { const int key = tid >> 3, part = tid & 7; const int kk = k0 + key; const int krow = kk < CTXL ? TL + b * CTXL + kk : b * SEQ + kk - CTXL;
                float f[8]; unpack8(*(const v4u*)(KVb + (size_t)krow * KVW + h * 128 + 64 + part * 8), f);
#pragma unroll
                for (int j = 0; j < 8; ++j) Vt[key * 64 + part * 8 + j] = f[j]; }
            __syncthreads();
            for (int kg = 0; kg < 64; kg += 8) {
                float s[8]; float gm = -1e30f;
#pragma unroll
                for (int kk = 0; kk < 8; ++kk) { float acc = 0.f; const LAS f32x4* kp = (const LAS f32x4*)(Kt + (kg + kk) * 96 + half * 48);
#pragma unroll
                    for (int d4 = 0; d4 < 12; ++d4) { const f32x4 kv = kp[d4]; acc += q[d4 * 4] * kv[0] + q[d4 * 4 + 1] * kv[1] + q[d4 * 4 + 2] * kv[2] + q[d4 * 4 + 3] * kv[3]; }
                    acc += shx(acc, 1, tid & 63);
                    s[kk] = acc; gm = fmaxf(gm, acc); }
                const float mn = fmaxf(m, gm); const float alpha = exp2f(m - mn); m = mn; l *= alpha;
#pragma unroll
                for (int j = 0; j < 32; ++j) o[j] *= alpha;
#pragma unroll
                for (int kk = 0; kk < 8; ++kk) { const float p = exp2f(s[kk] - mn); l += p; const LAS f32x4* vp = (const LAS f32x4*)(Vt + (kg + kk) * 64 + half * 32);
#pragma unroll
                    for (int d4 = 0; d4 < 8; ++d4) { const f32x4 vv = vp[d4]; o[d4 * 4] += p * vv[0]; o[d4 * 4 + 1] += p * vv[1]; o[d4 * 4 + 2] += p * vv[2]; o[d4 * 4 + 3] += p * vv[3]; } }
            }
        }
        { const float inv = 1.f / l;
#pragma unroll
            for (int g = 0; g < 4; ++g) { float f[8];
#pragma unroll
                for (int j = 0; j < 8; ++j) f[j] = o[g * 8 + j] * inv;
                *(v4u*)(MIX + (size_t)qrow * D + h * 64 + half * 32 + g * 8) = pack8(f); } }
    }
}

__device__ __forceinline__ void ssd_scan_naive(const Args& a, int i, bool last, LAS unsigned char* lds) {
    const int tid = otid(a.wv), p = tid >> 3, nq = tid & 7;
    bf16* ZX = (bf16*)(a.ws + WS_ZX); const bf16* XBC = (const bf16*)(a.ws + WS_XBC); const float* DT = (const float*)(a.ws + WS_DT); const float* AA = (const float*)(a.ws + WS_AA);
    LAS float* xs = (LAS float*)lds;
    LAS float* Bs = (LAS float*)(lds + 16384);
    LAS float* Cs = (LAS float*)(lds + 16384 + 32768);
    LAS float* dts = (LAS float*)(lds + 16384 + 65536);
    LAS float* as = dts + 64;
    for (int it = blockIdx.x; it < NB * 32; it += gridDim.x) {
        const int b = it >> 5, h = it & 31, g = h >> 3; const float dsk = a.in[I_SD][i * 32 + h];
        for (int dir = 0; dir < 2; ++dir) {
            float stt[16];
#pragma unroll
            for (int n = 0; n < 16; ++n) stt[n] = 0.f;
            for (int seg = 0; seg < 2; ++seg) {
                const int len = seg == 0 ? CTXL : SEQ; const int base = seg == 0 ? TL + b * CTXL : b * SEQ; const bool want_y = !(last && seg == 0);
                for (int cc = 0; cc < len / 64; ++cc) {
                    const int t0 = dir == 0 ? cc * 64 : len - 64 - cc * 64;
                    __syncthreads();
                    { const int tt = tid >> 3, part = tid & 7; float f[8]; unpack8(*(const v4u*)(XBC + (size_t)(base + t0 + tt) * 3072 + h * 64 + part * 8), f);
#pragma unroll
                        for (int j = 0; j < 8; ++j) xs[tt * 64 + part * 8 + j] = f[j]; }
                    for (int q = tid; q < 1024; q += NTHR) { const int tt = q >> 4, part = q & 15; float f[8];
                        unpack8(*(const v4u*)(XBC + (size_t)(base + t0 + tt) * 3072 + 2048 + g * 128 + part * 8), f);
#pragma unroll
                        for (int j = 0; j < 8; ++j) Bs[tt * 128 + part * 8 + j] = f[j];
                        unpack8(*(const v4u*)(XBC + (size_t)(base + t0 + tt) * 3072 + 2560 + g * 128 + part * 8), f);
#pragma unroll
                        for (int j = 0; j < 8; ++j) Cs[tt * 128 + part * 8 + j] = f[j]; }
                    if (tid < 64) { dts[tid] = DT[(size_t)(base + t0 + tid) * 64 + dir * 32 + h]; as[tid] = AA[(size_t)(base + t0 + tid) * 64 + dir * 32 + h]; }
                    __syncthreads();
                    for (int s = 0; s < 64; ++s) {
                        const int tt = dir == 0 ? s : 63 - s;
                        const float dec = __expf(as[tt]); const float xv = xs[tt * 64 + p]; const float xd = xv * dts[tt];
                        const LAS f32x4* bp = (const LAS f32x4*)(Bs + tt * 128 + nq * 16); const LAS f32x4* cp = (const LAS f32x4*)(Cs + tt * 128 + nq * 16);
                        float acc = 0.f;
#pragma unroll
                        for (int n4 = 0; n4 < 4; ++n4) { const f32x4 bv = bp[n4], cv = cp[n4];
#pragma unroll
                            for (int k = 0; k < 4; ++k) { stt[n4 * 4 + k] = dec * stt[n4 * 4 + k] + xd * bv[k]; acc += cv[k] * stt[n4 * 4 + k]; } }
                        acc += shx(acc, 1, tid & 63); acc += shx(acc, 2, tid & 63); acc += shx(acc, 4, tid & 63);
                        if (want_y && nq == 0) { bf16* yp = ZX + (size_t)(base + t0 + tt) * SSD_INP + 2048 + h * 64 + p;
                            const float y = dir == 0 ? acc + dsk * xv : acc + bf1(*yp);
                            *yp = (bf16)f2bf(y); }
                    }
                }
            }
            __syncthreads();
            asm volatile("s_waitcnt vmcnt(0)" ::: "memory");
        }
    }
}

typedef short bf16x8 __attribute__((ext_vector_type(8)));
typedef float f32x16 __attribute__((ext_vector_type(16)));
typedef short v4i16_t __attribute__((ext_vector_type(4)));
__device__ __forceinline__ v2u trread(const LAS unsigned char* p) { return __builtin_bit_cast(v2u, __builtin_amdgcn_ds_read_tr16_b64_v4i16((LAS v4i16_t*)p)); }
__device__ __forceinline__ unsigned cvtpk(float lo, float hi) { return hw_cvtpk(lo, hi); }
constexpr int ATT_KP = 208, ATT_VP = 192, ATT_KB = 64 * ATT_KP, ATT_VB = 64 * ATT_VP, ATT_BUF = ATT_KB + ATT_VB;
#ifndef ATT_NQ
#define ATT_NQ 2
#endif
template <int NQ>
__device__ __forceinline__ void attn_unit3(const Args& a, LAS unsigned char* lds, const int b, const int h, const int q0, const int ntiles, const bool lat) {
    const int tid = otid(a.wv), wave = a.wv, lane = tid & 63, r32 = lane & 31, hh = lane >> 5;
    const int tq = (lane >> 2) & 3, tp = lane & 3, tblk = (lane >> 4) & 1;
    const bf16* Qb = (const bf16*)(a.ws + WS_Q); const bf16* KVb = (const bf16*)(a.ws + WS_KV); const bf16* KR = (const bf16*)(a.ws + WS_KR); bf16* MIX = (bf16*)(a.ws + WS_MIX);
    const float* ct = (const float*)(a.ws + WS_ROPE); const float* st = ct + SEQ * 16;
    bf16x8 qf[NQ][6];
#pragma unroll
    for (int nq = 0; nq < NQ; ++nq) { const int qrow = q0 + wave * (32 * NQ) + nq * 32 + r32;
#pragma unroll
        for (int s = 0; s < 6; ++s) qf[nq][s] = *(const bf16x8*)(Qb + (size_t)qrow * QW + h * 96 + 16 * s + 8 * hh);
        if (lat) { const int t = qrow & (SEQ - 1);
#pragma unroll
            for (int j = 0; j < 8; j += 2) { float x1[2], x2[2], y1[2], y2[2];
#pragma unroll
                for (int e = 0; e < 2; ++e) { x1[e] = bf1((bf16)qf[nq][4][j + e]); x2[e] = bf1((bf16)qf[nq][5][j + e]); const float c = ct[t * 16 + 8 * hh + j + e], s = st[t * 16 + 8 * hh + j + e];
                    y1[e] = x1[e] * c - x2[e] * s; y2[e] = x1[e] * s + x2[e] * c; }
                const unsigned w1 = pk2(y1[0], y1[1]), w2 = pk2(y2[0], y2[1]);
                qf[nq][4][j] = (short)(w1 & 0xffff); qf[nq][4][j + 1] = (short)(w1 >> 16); qf[nq][5][j] = (short)(w2 & 0xffff); qf[nq][5][j + 1] = (short)(w2 >> 16); } } }
    f32x16 o0[NQ], o1[NQ]; float m[NQ], l[NQ];
#pragma unroll
    for (int nq = 0; nq < NQ; ++nq) { m[nq] = -1e30f; l[nq] = 0.f;
#pragma unroll
        for (int i = 0; i < 16; ++i) { o0[nq][i] = 0.f; o1[nq][i] = 0.f; } }
    v4u kreg0, kreg1, vreg;
#define ATT_LOAD(it) do { const int rb_ = (it) < CTXL / 64 ? TL + b * CTXL + (it) * 64 : b * SEQ + ((it) - CTXL / 64) * 64; \
        const char* kvb_ = (const char*)(KVb + (size_t)rb_ * KVW); const char* krb_ = (const char*)(KR + (size_t)rb_ * 32); \
        kreg0 = *(const v4u*)(kvb_ + (tid >> 3) * 2048 + h * 256 + (tid & 7) * 16); if (tid < 256) kreg1 = *(const v4u*)(krb_ + (tid >> 2) * 64 + (tid & 3) * 16); vreg = *(const v4u*)(kvb_ + (tid >> 3) * 2048 + h * 256 + 128 + (tid & 7) * 16); } while (0)
#define ATT_WRITE(buf) do { LAS unsigned char* kb_ = lds + (buf) * ATT_BUF; LAS unsigned char* vb_ = kb_ + ATT_KB; \
        *(LAS v4u*)(kb_ + (tid >> 3) * ATT_KP + (tid & 7) * 16) = kreg0; if (tid < 256) *(LAS v4u*)(kb_ + (tid >> 2) * ATT_KP + 128 + (tid & 3) * 16) = kreg1; \
        *(LAS v4u*)(vb_ + (tid >> 3) * ATT_VP + (tid & 7) * 16) = vreg; } while (0)
    __syncthreads();
    ATT_LOAD(0); ATT_WRITE(0);
    __syncthreads();
    for (int it = 0; it < ntiles; ++it) {
#ifdef ATT_JITTER
        if (wave == ((it * 5 + (int)blockIdx.x) & 7)) __builtin_amdgcn_s_sleep(100);
#endif
#ifndef ATT_LOADMID
        if (it + 1 < ntiles) ATT_LOAD(it + 1);
#endif
#ifdef ATT_TZ
        int tz = tid; asm volatile("" : "+v"(tz));
        const int lane = tz & 63, r32 = lane & 31, hh = lane >> 5, tq = (lane >> 2) & 3, tp = lane & 3, tblk = (lane >> 4) & 1;
#endif
        const LAS unsigned char* kb = lds + (it & 1) * ATT_BUF; const LAS unsigned char* vb = kb + ATT_KB;
#pragma unroll
        for (int t = 0; t < 2; ++t) {
            f32x16 sc[NQ]; bf16x8 pf[NQ][2];
#pragma unroll
            for (int nq = 0; nq < NQ; ++nq)
#pragma unroll
                for (int i = 0; i < 16; ++i) sc[nq][i] = 0.f;
            bf16x8 kf[6];
#pragma unroll
            for (int s = 0; s < 6; ++s) kf[s] = *(const LAS bf16x8*)(kb + (32 * t + r32) * ATT_KP + (16 * s + 8 * hh) * 2);
            asm volatile("" : "+v"(kf[0]), "+v"(kf[1]), "+v"(kf[2]), "+v"(kf[3]), "+v"(kf[4]), "+v"(kf[5]));
#pragma unroll
            for (int s = 0; s < 6; ++s)
#pragma unroll
                for (int nq = 0; nq < NQ; ++nq) sc[nq] = __builtin_amdgcn_mfma_f32_32x32x16_bf16(kf[s], qf[nq][s], sc[nq], 0, 0, 0);
#ifdef ATT_LOADMID
            if (t == 0 && it + 1 < ntiles) ATT_LOAD(it + 1);
#endif
#pragma unroll
            for (int nq = 0; nq < NQ; ++nq) {
                float mx = sc[nq][0];
#pragma unroll
                for (int i = 1; i < 16; ++i) mx = fmaxf(mx, sc[nq][i]);
                mx = fmaxf(mx, shx(mx, 32, lane));
                const float mn = fmaxf(m[nq], mx * ATT_SCALE_LOG2E); const float alpha = __builtin_amdgcn_exp2f(m[nq] - mn); m[nq] = mn;
                float rs = 0.f;
#pragma unroll
                for (int i = 0; i < 16; ++i) { sc[nq][i] = __builtin_amdgcn_exp2f(sc[nq][i] * ATT_SCALE_LOG2E - mn); rs += sc[nq][i]; }
                l[nq] = l[nq] * alpha + rs;
#ifdef ATT_SKIPRS
                if (__builtin_amdgcn_ballot_w64(alpha != 1.0f) != 0ull)
#endif
                {
#pragma unroll
                    for (int i = 0; i < 16; ++i) { o0[nq][i] *= alpha; o1[nq][i] *= alpha; } }
#pragma unroll
                for (int s2 = 0; s2 < 2; ++s2) { v4u w0;
                    w0.x = cvtpk(sc[nq][8 * s2 + 0], sc[nq][8 * s2 + 1]); w0.y = cvtpk(sc[nq][8 * s2 + 2], sc[nq][8 * s2 + 3]); w0.z = cvtpk(sc[nq][8 * s2 + 4], sc[nq][8 * s2 + 5]); w0.w = cvtpk(sc[nq][8 * s2 + 6], sc[nq][8 * s2 + 7]);
                    pf[nq][s2] = __builtin_bit_cast(bf16x8, w0); }
            }
#ifdef ATT_VBATCH
            { v2u vlo[2][2], vhi[2][2];
#pragma unroll
              for (int s2 = 0; s2 < 2; ++s2)
#pragma unroll
                for (int dt = 0; dt < 2; ++dt) { const LAS unsigned char* tb = vb + (t * 32 + 16 * s2 + 4 * hh + tq) * ATT_VP + (32 * dt + 16 * tblk + 4 * tp) * 2; vlo[s2][dt] = trread(tb); vhi[s2][dt] = trread(tb + 8 * ATT_VP); }
#pragma unroll
              for (int s2 = 0; s2 < 2; ++s2)
#pragma unroll
                for (int nq = 0; nq < NQ; ++nq) {
                    o0[nq] = __builtin_amdgcn_mfma_f32_32x32x16_bf16(__builtin_bit_cast(bf16x8, (v4u){vlo[s2][0].x, vlo[s2][0].y, vhi[s2][0].x, vhi[s2][0].y}), pf[nq][s2], o0[nq], 0, 0, 0);
                    o1[nq] = __builtin_amdgcn_mfma_f32_32x32x16_bf16(__builtin_bit_cast(bf16x8, (v4u){vlo[s2][1].x, vlo[s2][1].y, vhi[s2][1].x, vhi[s2][1].y}), pf[nq][s2], o1[nq], 0, 0, 0); } }
#else
#pragma unroll
            for (int s2 = 0; s2 < 2; ++s2) { const int ko = t * 32 + 16 * s2 + 4 * hh;
                { const LAS unsigned char* tb = vb + (ko + tq) * ATT_VP + (16 * tblk + 4 * tp) * 2; const v2u lo = trread(tb), hi = trread(tb + 8 * ATT_VP); const bf16x8 vf = __builtin_bit_cast(bf16x8, (v4u){lo.x, lo.y, hi.x, hi.y});
#pragma unroll
                  for (int nq = 0; nq < NQ; ++nq) o0[nq] = __builtin_amdgcn_mfma_f32_32x32x16_bf16(vf, pf[nq][s2], o0[nq], 0, 0, 0); }
                { const LAS unsigned char* tb = vb + (ko + tq) * ATT_VP + (32 + 16 * tblk + 4 * tp) * 2; const v2u lo = trread(tb), hi = trread(tb + 8 * ATT_VP); const bf16x8 vf = __builtin_bit_cast(bf16x8, (v4u){lo.x, lo.y, hi.x, hi.y});
#pragma unroll
                  for (int nq = 0; nq < NQ; ++nq) o1[nq] = __builtin_amdgcn_mfma_f32_32x32x16_bf16(vf, pf[nq][s2], o1[nq], 0, 0, 0); } }
#endif
        }
        if (it + 1 < ntiles) ATT_WRITE((it + 1) & 1);
        __syncthreads();
    }
#undef ATT_LOAD
#undef ATT_WRITE
#pragma unroll
    for (int nq = 0; nq < NQ; ++nq) { const int qrow = q0 + wave * (32 * NQ) + nq * 32 + r32;
        const float lsum = l[nq] + shx(l[nq], 32, lane); const float inv = 1.f / lsum;
        bf16* orow = MIX + (size_t)qrow * D + h * 64 + 4 * hh;
#pragma unroll
        for (int g = 0; g < 4; ++g) {
            v2u w; w.x = pk2(o0[nq][4 * g] * inv, o0[nq][4 * g + 1] * inv); w.y = pk2(o0[nq][4 * g + 2] * inv, o0[nq][4 * g + 3] * inv); *(v2u*)(orow + 8 * g) = w;
            v2u x; x.x = pk2(o1[nq][4 * g] * inv, o1[nq][4 * g + 1] * inv); x.y = pk2(o1[nq][4 * g + 2] * inv, o1[nq][4 * g + 3] * inv); *(v2u*)(orow + 32 + 8 * g) = x; } }
}
__device__ __forceinline__ void attn_mfma(const Args& a, LAS unsigned char* lds) {
#if ATT_NQ == 2
    for (int u = blockIdx.x; u < 256; u += gridDim.x) attn_unit3<2>(a, lds, u >> 5, (u >> 2) & 7, (u >> 5) * SEQ + (u & 3) * 512, (CTXL + SEQ) / 64, true);
#else
    for (int u = blockIdx.x; u < 512; u += gridDim.x) attn_unit3<1>(a, lds, u >> 6, (u >> 3) & 7, (u >> 6) * SEQ + (u & 7) * 256, (CTXL + SEQ) / 64, true);
#endif
    for (int u = blockIdx.x; u < 64; u += gridDim.x) attn_unit3<1>(a, lds, u >> 3, u & 7, TL + (u >> 3) * CTXL, CTXL / 64, false);
}

#ifndef SSD_YREP
#define SSD_YREP 1
#endif
#ifndef SSD_WREP
#define SSD_WREP 1
#endif
constexpr int SP_B = 272, SP_X = 192;
constexpr int SO_B = 0, SO_C = SO_B + 128 * SP_B, SO_XD = SO_C + 128 * SP_B, SO_XW = SO_XD + 128 * SP_X, SO_S = SO_XW + 128 * SP_X, SO_V = SO_S + 64 * SP_B;
static_assert(SO_V + 2 * 2048 <= LDS_BYTES, "ssd lds map");
#ifdef SSD_DIAG
#define SSD_T(v) long long v = clock64()
#define SSD_ACC(k, v) do { const long long n_ = clock64(); dacc[k] += n_ - v; v = n_; } while (0)
#else
#define SSD_T(v) do {} while (0)
#define SSD_ACC(k, v) do {} while (0)
#endif
__device__ __forceinline__ void ssd_scan_mfma(const Args& a, int i, bool last, LAS unsigned char* lds) {
#ifdef SSD_DIAG
    long long dacc[12] = {0, 0, 0, 0, 0, 0, 0, 0, 0, 0, 0, 0};
#endif
    const int tid = otid(a.wv), wave = a.wv, lane = tid & 63, r32 = lane & 31, hh = lane >> 5;
    const int pt = wave >> 2, lt = pt ? 3 - (wave & 3) : (wave & 3);
    const int tq = (lane >> 2) & 3, tp = lane & 3, tblk = (lane >> 4) & 1;
    bf16* ZX = (bf16*)(a.ws + WS_ZX); const bf16* XBC = (const bf16*)(a.ws + WS_XBC); const float* DT = (const float*)(a.ws + WS_DT); const float* AA = (const float*)(a.ws + WS_AA);
    LAS unsigned char* Bl = lds + SO_B; LAS unsigned char* Cl = lds + SO_C; LAS unsigned char* XDl = lds + SO_XD; LAS unsigned char* XWl = lds + SO_XW; LAS unsigned char* Sl = lds + SO_S;
    const int brow = tid >> 4, bpart = tid & 15, xrow = tid >> 3, xpart = tid & 7;
    for (int it = blockIdx.x; it < NB * 32; it += gridDim.x) {
        const int b = it >> 5, h = it & 31, g = h >> 3; const float dsk = a.in[I_SD][i * 32 + h];
        for (int dir = 0; dir < 2; ++dir) {
            const int scanw = dir == 0 ? 0 : 3;
            f32x16 sacc;
#pragma unroll
            for (int k = 0; k < 16; ++k) sacc[k] = 0.f;
            SSD_T(tprev);
            v4u bq[4], cq[4], xq[2]; float pa0 = 0.f, pa1 = 0.f, pd0 = 0.f, pd1 = 0.f, qa0 = 0.f, qa1 = 0.f, qd0 = 0.f, qd1 = 0.f; v2u add[4];
#define SSD_ROWBASE(c) ((c) < 2 ? TL + b * CTXL + (dir == 0 ? (c) : 1 - (c)) * 128 : b * SEQ + (dir == 0 ? (c) - 2 : 17 - (c)) * 128)
#define SSD_PFB(c) do { const int rb_ = SSD_ROWBASE(c); _Pragma("unroll") for (int k_ = 0; k_ < 4; ++k_) bq[k_] = *(const v4u*)(XBC + (size_t)(rb_ + brow + 32 * k_) * 3072 + 2048 + g * 128 + bpart * 8); } while (0)
#define SSD_PFC(c) do { const int rb_ = SSD_ROWBASE(c); _Pragma("unroll") for (int k_ = 0; k_ < 4; ++k_) cq[k_] = *(const v4u*)(XBC + (size_t)(rb_ + brow + 32 * k_) * 3072 + 2560 + g * 128 + bpart * 8); } while (0)
#define SSD_PFX(c) do { const int rb_ = SSD_ROWBASE(c); _Pragma("unroll") for (int k_ = 0; k_ < 2; ++k_) xq[k_] = *(const v4u*)(XBC + (size_t)(rb_ + xrow + 64 * k_) * 3072 + h * 64 + xpart * 8); } while (0)
#define SSD_PF(c) do { SSD_PFB(c); SSD_PFC(c); SSD_PFX(c); } while (0)
#define SSD_PFV(c) do { if (wave == scanw) { const int rb_ = SSD_ROWBASE(c); const size_t o_ = (size_t)(rb_ + 2 * lane) * 64 + dir * 32 + h; qa0 = AA[o_]; qa1 = AA[o_ + 64]; qd0 = DT[o_]; qd1 = DT[o_ + 64]; } } while (0)
#define SSD_PFY(c) do { const int rb_ = SSD_ROWBASE(c); const size_t r_ = (size_t)(rb_ + 32 * lt + r32); \
                _Pragma("unroll") for (int q_ = 0; q_ < 4; ++q_) add[q_] = dir == 0 ? *(const v2u*)(XBC + r_ * 3072 + h * 64 + 32 * pt + 4 * hh + 8 * q_) : *(const v2u*)(ZX + r_ * SSD_INP + 2048 + h * 64 + 32 * pt + 4 * hh + 8 * q_); } while (0)
#define SSD_SCAN(vb_) do { if (wave == scanw) { LAS float* V_ = (LAS float*)(lds + SO_V + (vb_) * 2048); const float pair_ = pa0 + pa1; float ps_ = pair_; \
                _Pragma("unroll") for (int d_ = 1; d_ < 64; d_ <<= 1) { const int src_ = dir == 0 ? lane - d_ : lane + d_; const float t_ = __builtin_bit_cast(float, __builtin_amdgcn_ds_bpermute((src_ & 63) << 2, __builtin_bit_cast(int, ps_))); if (src_ >= 0 && src_ < 64) ps_ += t_; } \
                const float tot_ = __builtin_bit_cast(float, __builtin_amdgcn_ds_bpermute((dir == 0 ? 63 : 0) << 2, __builtin_bit_cast(int, ps_))); const float ex_ = ps_ - pair_; \
                float c0_, c1_; if (dir == 0) { c0_ = ex_ + pa0; c1_ = c0_ + pa1; } else { c1_ = ex_ + pa1; c0_ = c1_ + pa0; } \
                V_[2 * lane] = c0_; V_[2 * lane + 1] = c1_; V_[128 + 2 * lane] = pd0; V_[128 + 2 * lane + 1] = pd1; V_[256 + 2 * lane] = pd0 * __expf(tot_ - c0_); V_[256 + 2 * lane + 1] = pd1 * __expf(tot_ - c1_); \
                if (lane == 0) V_[384] = tot_; } } while (0)
#define SSD_WRITE(vb_) do { const LAS float* V_ = (const LAS float*)(lds + SO_V + (vb_) * 2048); \
                _Pragma("unroll") for (int k_ = 0; k_ < 4; ++k_) { *(LAS v4u*)(Bl + (brow + 32 * k_) * SP_B + bpart * 16) = bq[k_]; *(LAS v4u*)(Cl + (brow + 32 * k_) * SP_B + bpart * 16) = cq[k_]; } \
                _Pragma("unroll") for (int k_ = 0; k_ < 2; ++k_) { const int s_ = xrow + 64 * k_; const float dt_ = V_[128 + s_], w_ = V_[256 + s_]; float f_[8], g_[8]; unpack8(xq[k_], f_); \
                    _Pragma("unroll") for (int j_ = 0; j_ < 8; ++j_) { g_[j_] = f_[j_] * w_; f_[j_] *= dt_; } \
                    *(LAS v4u*)(XDl + s_ * SP_X + xpart * 16) = pack8(f_); *(LAS v4u*)(XWl + s_ * SP_X + xpart * 16) = pack8(g_); } } while (0)
            __syncthreads();
            SSD_PFV(0); pa0 = qa0; pa1 = qa1; pd0 = qd0; pd1 = qd1; SSD_PFV(1); SSD_PFY(0); SSD_PF(0);
            { const float t0_ = qa0, t1_ = qa1, t2_ = qd0, t3_ = qd1; SSD_SCAN(0); pa0 = t0_; pa1 = t1_; pd0 = t2_; pd1 = t3_; }
            __syncthreads();
            SSD_WRITE(0);
            { LAS v2u* sp = (LAS v2u*)(Sl + (32 * pt + r32) * SP_B + (32 * lt + 4 * hh) * 2);
#pragma unroll
              for (int q = 0; q < 4; ++q) sp[2 * q] = (v2u){0u, 0u}; }
            __syncthreads();
            SSD_ACC(0, tprev);
            for (int c = 0; c < 18; ++c) {
                const int cur = c & 1; const LAS float* V = (const LAS float*)(lds + SO_V + cur * 2048);
#ifdef SSD_JITTER
                if (wave == ((c * 3 + (int)blockIdx.x + dir) & 7)) __builtin_amdgcn_s_sleep(120);
#endif
                const int rowbase = SSD_ROWBASE(c); const bool want_y = !(last && c < 2);
                if (c > 0 && want_y) SSD_PFY(c);
                if (c + 1 < 18) { if (c + 2 < 18) SSD_PFV(c + 2); }
                SSD_ACC(1, tprev);
                for (int yrep = 0; yrep < SSD_YREP; ++yrep)
                if (!want_y && c + 1 < 18) { SSD_PFB(c + 1); SSD_PFC(c + 1); SSD_PFX(c + 1); }
                if (want_y) {
                    const int l = 32 * lt + r32; const float cl = V[l];
                    bf16* yptr = ZX + (size_t)(rowbase + l) * SSD_INP + 2048 + h * 64 + 32 * pt + 4 * hh;
                    bf16x8 cf[8];
#pragma unroll
                    for (int ks = 0; ks < 8; ++ks) cf[ks] = *(const LAS bf16x8*)(Cl + l * SP_B + (16 * ks + 8 * hh) * 2);
                    SSD_ACC(8, tprev);
                    f32x16 y1;
#pragma unroll
                    for (int k = 0; k < 16; ++k) y1[k] = 0.f;
#pragma unroll
                    for (int ks = 0; ks < 8; ++ks) { const bf16x8 sf = *(const LAS bf16x8*)(Sl + (32 * pt + r32) * SP_B + (16 * ks + 8 * hh) * 2); y1 = __builtin_amdgcn_mfma_f32_32x32x16_bf16(sf, cf[ks], y1, 0, 0, 0); }
                    { const float el = __expf(cl);
#pragma unroll
                      for (int k = 0; k < 16; ++k) y1[k] *= el; }
                    SSD_ACC(10, tprev);
                    const int st_lo = dir == 0 ? 0 : lt, st_hi = dir == 0 ? lt : 3;
#pragma unroll
                    for (int st = 0; st < 4; ++st) { if (c + 1 < 18) { if (st == 1) SSD_PFB(c + 1); if (st == 2) SSD_PFC(c + 1); if (st == 3) SSD_PFX(c + 1); }
                      if (st >= st_lo && st <= st_hi) {
                        f32x16 X;
#pragma unroll
                        for (int k = 0; k < 16; ++k) X[k] = 0.f;
#pragma unroll
                        for (int ks = 0; ks < 8; ++ks) { const bf16x8 af = *(const LAS bf16x8*)(Bl + (32 * st + r32) * SP_B + (16 * ks + 8 * hh) * 2); X = __builtin_amdgcn_mfma_f32_32x32x16_bf16(af, cf[ks], X, 0, 0, 0); }
                        if (st == lt) {
#pragma unroll
                            for (int q = 0; q < 4; ++q) { const f32x4 cs = *(const LAS f32x4*)(V + 32 * st + 8 * q + 4 * hh);
#pragma unroll
                                for (int e = 0; e < 4; ++e) { const int sl = 8 * q + 4 * hh + e; const bool ok = dir == 0 ? (sl <= r32) : (sl >= r32);
                                    X[4 * q + e] *= __expf(ok ? fminf(cl - cs[e], 0.f) : -1.0e30f); } }
                        } else {
#pragma unroll
                            for (int q = 0; q < 4; ++q) { const f32x4 cs = *(const LAS f32x4*)(V + 32 * st + 8 * q + 4 * hh);
#pragma unroll
                                for (int e = 0; e < 4; ++e) X[4 * q + e] *= __expf(fminf(cl - cs[e], 0.f)); }
                        }
#pragma unroll
                        for (int ks2 = 0; ks2 < 2; ++ks2) { v4u w; w.x = cvtpk(X[8 * ks2 + 0], X[8 * ks2 + 1]); w.y = cvtpk(X[8 * ks2 + 2], X[8 * ks2 + 3]); w.z = cvtpk(X[8 * ks2 + 4], X[8 * ks2 + 5]); w.w = cvtpk(X[8 * ks2 + 6], X[8 * ks2 + 7]);
                            const LAS unsigned char* tb = XDl + (32 * st + 16 * ks2 + 4 * hh + tq) * SP_X + (32 * pt + 16 * tblk + 4 * tp) * 2;
                            const v2u lo = trread(tb), hi = trread(tb + 8 * SP_X);
                            y1 = __builtin_amdgcn_mfma_f32_32x32x16_bf16(__builtin_bit_cast(bf16x8, (v4u){lo.x, lo.y, hi.x, hi.y}), __builtin_bit_cast(bf16x8, w), y1, 0, 0, 0); }
                    } }
                    asm volatile("" : "+v"(y1)); SSD_ACC(9, tprev);
#pragma unroll
                    for (int q = 0; q < 4; ++q) { float o[4];
#pragma unroll
                        for (int e = 0; e < 4; ++e) o[e] = y1[4 * q + e];
                        const float a0 = bflo(add[q].x), a1 = bfhi(add[q].x), a2 = bflo(add[q].y), a3 = bfhi(add[q].y);
                        if (dir == 0) { o[0] += dsk * a0; o[1] += dsk * a1; o[2] += dsk * a2; o[3] += dsk * a3; } else { o[0] += a0; o[1] += a1; o[2] += a2; o[3] += a3; }
                        v2u w; w.x = cvtpk(o[0], o[1]); w.y = cvtpk(o[2], o[3]); *(v2u*)(yptr + 8 * q) = w; }
                }
                SSD_ACC(2, tprev);
                if (c + 1 < 18) {
                    const float etot = __expf(V[384]);
#pragma unroll
                    for (int k = 0; k < 16; ++k) sacc[k] *= etot;
#pragma unroll
                    for (int kh = 0; kh < 2; ++kh) {
                        v2u alo[4], ahi[4], blo[4], bhi[4];
#pragma unroll
                        for (int k4 = 0; k4 < 4; ++k4) { const int ks = 4 * kh + k4;
                            const LAS unsigned char* ta = Bl + (16 * ks + 8 * hh + tq) * SP_B + (32 * lt + 16 * tblk + 4 * tp) * 2;
                            const LAS unsigned char* tb = XWl + (16 * ks + 8 * hh + tq) * SP_X + (32 * pt + 16 * tblk + 4 * tp) * 2;
                            alo[k4] = trread(ta); ahi[k4] = trread(ta + 4 * SP_B); blo[k4] = trread(tb); bhi[k4] = trread(tb + 4 * SP_X); }
                        asm volatile("" : "+v"(alo[0]), "+v"(alo[1]), "+v"(alo[2]), "+v"(alo[3]), "+v"(bhi[0]), "+v"(bhi[1]), "+v"(bhi[2]), "+v"(bhi[3]));
#pragma unroll
                        for (int k4 = 0; k4 < 4; ++k4)
                            sacc = __builtin_amdgcn_mfma_f32_32x32x16_bf16(__builtin_bit_cast(bf16x8, (v4u){alo[k4].x, alo[k4].y, ahi[k4].x, ahi[k4].y}), __builtin_bit_cast(bf16x8, (v4u){blo[k4].x, blo[k4].y, bhi[k4].x, bhi[k4].y}), sacc, 0, 0, 0); }
                    SSD_SCAN(cur ^ 1); pa0 = qa0; pa1 = qa1; pd0 = qd0; pd1 = qd1;
                }
#ifdef SSD_JITTER
                if (wave == ((c * 5 + 2 + (int)blockIdx.x) & 7)) __builtin_amdgcn_s_sleep(90);
#endif
                SSD_ACC(3, tprev);
                __syncthreads();
                SSD_ACC(4, tprev);
                if (c + 1 < 18) {
                    LAS v2u* sp = (LAS v2u*)(Sl + (32 * pt + r32) * SP_B + (32 * lt + 4 * hh) * 2);
#pragma unroll
                    for (int q = 0; q < 4; ++q) { v2u w; w.x = cvtpk(sacc[4 * q], sacc[4 * q + 1]); w.y = cvtpk(sacc[4 * q + 2], sacc[4 * q + 3]); sp[2 * q] = w; }
                    for (int wrep = 0; wrep < SSD_WREP; ++wrep) { SSD_WRITE(cur ^ 1); }
                }
                SSD_ACC(5, tprev);
                __syncthreads();
                SSD_ACC(6, tprev);
            }
#undef SSD_ROWBASE
#undef SSD_PF
#undef SSD_PFV
#undef SSD_PFY
#undef SSD_SCAN
#undef SSD_WRITE
            asm volatile("s_waitcnt vmcnt(0)" ::: "memory");
        }
    }
#ifdef SSD_DIAG
    if (blockIdx.x == 0 && wave == SSD_DIAG_WAVE && lane == 0 && i == 0) { float* dg = (float*)(a.ws + WS_MOD + 900 * 1024); long long tot = 0;
        for (int k = 0; k < 7; ++k) tot += dacc[k];
        tot += dacc[8] + dacc[9] + dacc[10];
        for (int k = 0; k < 12; ++k) dg[k] = (float)dacc[k]; dg[7] = (float)tot; }
#endif
}

constexpr int AT2_KP = 208, AT2_VP = 192, AT2_KB = 64 * AT2_KP, AT2_VB = 64 * AT2_VP, AT2_BUF = AT2_KB + AT2_VB;
template <int NQ>
__device__ __forceinline__ void attn_unit2(const Args& a, LAS unsigned char* lds, int b, int h, int q0, int ntiles, bool lat) {
    const int tid = otid(a.wv), wave = tid >> 6, lane = tid & 63, r32 = lane & 31, hh = lane >> 5;
    const int tq = (lane >> 2) & 3, tp = lane & 3, tblk = (lane >> 4) & 1;
    const bf16* Qb = (const bf16*)(a.ws + WS_Q); const bf16* KVb = (const bf16*)(a.ws + WS_KV); const bf16* KR = (const bf16*)(a.ws + WS_KR); bf16* MIX = (bf16*)(a.ws + WS_MIX);
    const float* ct = (const float*)(a.ws + WS_ROPE); const float* st = ct + SEQ * 16;
    bf16x8 qf[NQ][6];
#pragma unroll
    for (int nq = 0; nq < NQ; ++nq) { const int qrow = q0 + wave * (32 * NQ) + nq * 32 + r32;
#pragma unroll
        for (int s = 0; s < 6; ++s) qf[nq][s] = *(const bf16x8*)(Qb + (size_t)qrow * QW + h * 96 + 16 * s + 8 * hh);
        if (lat) { const int t = qrow & (SEQ - 1);
#pragma unroll
            for (int j = 0; j < 8; j += 2) { float y1[2], y2[2];
#pragma unroll
                for (int e = 0; e < 2; ++e) { const float x1 = bf1((bf16)qf[nq][4][j + e]), x2 = bf1((bf16)qf[nq][5][j + e]); const float c = ct[t * 16 + 8 * hh + j + e], s = st[t * 16 + 8 * hh + j + e];
                    y1[e] = x1 * c - x2 * s; y2[e] = x1 * s + x2 * c; }
                const unsigned w1 = pk2(y1[0], y1[1]), w2 = pk2(y2[0], y2[1]);
                qf[nq][4][j] = (short)(w1 & 0xffff); qf[nq][4][j + 1] = (short)(w1 >> 16); qf[nq][5][j] = (short)(w2 & 0xffff); qf[nq][5][j + 1] = (short)(w2 >> 16); } }
        asm volatile("" : "+v"(qf[nq][0]), "+v"(qf[nq][1]), "+v"(qf[nq][2]), "+v"(qf[nq][3]), "+v"(qf[nq][4]), "+v"(qf[nq][5]) :: "memory"); }
    f32x16 o[NQ][2]; float m[NQ], l[NQ];
#pragma unroll
    for (int nq = 0; nq < NQ; ++nq) { m[nq] = -1e30f; l[nq] = 0.f;
#pragma unroll
        for (int i = 0; i < 16; ++i) { o[nq][0][i] = 0.f; o[nq][1][i] = 0.f; } }
    v4u kreg0, kreg1, vreg;
#define AT2_LOAD(it, tt) do { const unsigned off_kv = (unsigned)(((tt) >> 3) * (KVW * 2) + h * 256 + ((tt) & 7) * 16), off_kr = (unsigned)(((tt) >> 2) * 64 + ((tt) & 3) * 16); const bool k1ok = (tt) < 256; const int rb_ = (it) < CTXL / 64 ? TL + b * CTXL + (it) * 64 : b * SEQ + ((it) - CTXL / 64) * 64; \
        const char* kvb_ = (const char*)(KVb + (size_t)rb_ * KVW); const char* krb_ = (const char*)(KR + (size_t)rb_ * 32); \
        kreg0 = *(const v4u*)(kvb_ + off_kv); vreg = *(const v4u*)(kvb_ + off_kv + 128); if (k1ok) kreg1 = *(const v4u*)(krb_ + off_kr); } while (0)
#define AT2_WRITE(buf, tt) do { LAS unsigned char* kb_ = lds + (buf) * AT2_BUF; \
        *(LAS v4u*)(kb_ + ((tt) >> 3) * AT2_KP + ((tt) & 7) * 16) = kreg0; if ((tt) < 256) *(LAS v4u*)(kb_ + ((tt) >> 2) * AT2_KP + 128 + ((tt) & 3) * 16) = kreg1; \
        *(LAS v4u*)(kb_ + AT2_KB + ((tt) >> 3) * AT2_VP + ((tt) & 7) * 16) = vreg; } while (0)
    __syncthreads();
    AT2_LOAD(0, tid); AT2_WRITE(0, tid);
    __syncthreads();
    for (int it = 0; it < ntiles; ++it) {
        int tz = tid; asm volatile("" : "+v"(tz));
        const int lane_ = tz & 63, r32_ = lane_ & 31, hh_ = lane_ >> 5, tq_ = (lane_ >> 2) & 3, tp_ = lane_ & 3, tblk_ = (lane_ >> 4) & 1;
#ifdef ATT_LOADTOP
        if (it + 1 < ntiles) AT2_LOAD(it + 1, tz);
#endif
        const LAS unsigned char* kb = lds + (it & 1) * AT2_BUF; const LAS unsigned char* vb = kb + AT2_KB;
        bf16x8 pf[NQ][2][2];
        f32x16 sc[NQ][2];
#pragma unroll
        for (int nq = 0; nq < NQ; ++nq)
#pragma unroll
            for (int i = 0; i < 16; ++i) { sc[nq][0][i] = 0.f; sc[nq][1][i] = 0.f; }
#pragma unroll
        for (int s = 0; s < 6; ++s) { const bf16x8 a0 = *(const LAS bf16x8*)(kb + r32_ * AT2_KP + (16 * s + 8 * hh_) * 2); const bf16x8 a1 = *(const LAS bf16x8*)(kb + (32 + r32_) * AT2_KP + (16 * s + 8 * hh_) * 2);
#pragma unroll
            for (int nq = 0; nq < NQ; ++nq) { sc[nq][0] = __builtin_amdgcn_mfma_f32_32x32x16_bf16(a0, qf[nq][s], sc[nq][0], 0, 0, 0); sc[nq][1] = __builtin_amdgcn_mfma_f32_32x32x16_bf16(a1, qf[nq][s], sc[nq][1], 0, 0, 0); } }
#pragma unroll
        for (int nq = 0; nq < NQ; ++nq) {
            f32x16& s0 = sc[nq][0]; f32x16& s1 = sc[nq][1];
            float mx = s0[0];
#pragma unroll
            for (int i = 1; i < 16; ++i) mx = fmaxf(mx, s0[i]);
#pragma unroll
            for (int i = 0; i < 16; ++i) mx = fmaxf(mx, s1[i]);
            mx = fmaxf(mx, shx(mx, 32, lane_));
            const float mn = fmaxf(m[nq], mx * ATT_SCALE_LOG2E); const float alpha = __builtin_amdgcn_exp2f(m[nq] - mn); m[nq] = mn;
            float rs = 0.f;
#pragma unroll
            for (int i = 0; i < 16; ++i) { s0[i] = __builtin_amdgcn_exp2f(s0[i] * ATT_SCALE_LOG2E - mn); s1[i] = __builtin_amdgcn_exp2f(s1[i] * ATT_SCALE_LOG2E - mn); rs += s0[i] + s1[i]; }
            l[nq] = l[nq] * alpha + rs;
#pragma unroll
            for (int i = 0; i < 16; ++i) { o[nq][0][i] *= alpha; o[nq][1][i] *= alpha; }
#pragma unroll
            for (int s2 = 0; s2 < 2; ++s2) { v4u w0, w1;
                w0.x = cvtpk(s0[8 * s2 + 0], s0[8 * s2 + 1]); w0.y = cvtpk(s0[8 * s2 + 2], s0[8 * s2 + 3]); w0.z = cvtpk(s0[8 * s2 + 4], s0[8 * s2 + 5]); w0.w = cvtpk(s0[8 * s2 + 6], s0[8 * s2 + 7]);
                w1.x = cvtpk(s1[8 * s2 + 0], s1[8 * s2 + 1]); w1.y = cvtpk(s1[8 * s2 + 2], s1[8 * s2 + 3]); w1.z = cvtpk(s1[8 * s2 + 4], s1[8 * s2 + 5]); w1.w = cvtpk(s1[8 * s2 + 6], s1[8 * s2 + 7]);
                pf[nq][0][s2] = __builtin_bit_cast(bf16x8, w0); pf[nq][1][s2] = __builtin_bit_cast(bf16x8, w1); }
        }
#ifndef ATT_LOADTOP
        if (it + 1 < ntiles) AT2_LOAD(it + 1, tz);
#endif
#pragma unroll
        for (int t = 0; t < 2; ++t)
#pragma unroll
            for (int s2 = 0; s2 < 2; ++s2)
#pragma unroll
                for (int dt = 0; dt < 2; ++dt) {
                    const LAS unsigned char* tb = vb + (t * 32 + 16 * s2 + 4 * hh_ + tq_) * AT2_VP + (32 * dt + 16 * tblk_ + 4 * tp_) * 2;
#ifdef ATT_NOTR
                    bf16x8 vf; { const LAS unsigned short* vp_ = (const LAS unsigned short*)(vb + (t * 32 + 16 * s2 + 4 * hh_) * AT2_VP + (32 * dt + r32_) * 2);
#pragma unroll
                      for (int j_ = 0; j_ < 8; ++j_) vf[j_] = (short)vp_[((j_ & 3) + 8 * (j_ >> 2)) * (AT2_VP / 2)]; }
#else
                    const v2u lo = trread(tb), hi = trread(tb + 8 * AT2_VP); const bf16x8 vf = __builtin_bit_cast(bf16x8, (v4u){lo.x, lo.y, hi.x, hi.y});
#endif
#pragma unroll
                    for (int nq = 0; nq < NQ; ++nq) o[nq][dt] = __builtin_amdgcn_mfma_f32_32x32x16_bf16(vf, pf[nq][t][s2], o[nq][dt], 0, 0, 0); }
        if (it + 1 < ntiles) AT2_WRITE((it + 1) & 1, tz);
        __syncthreads();
    }
#undef AT2_LOAD
#undef AT2_WRITE
#pragma unroll
    for (int nq = 0; nq < NQ; ++nq) { int qrow = q0 + wave * (32 * NQ) + nq * 32 + r32; asm volatile("" : "+v"(qrow));
        const float lt = l[nq] + shx(l[nq], 32, lane); const float inv = 1.f / lt;
        bf16* orow = MIX + (size_t)qrow * D + h * 64 + 4 * hh;
#pragma unroll
        for (int g = 0; g < 4; ++g) {
            v2u w; w.x = pk2(o[nq][0][4 * g] * inv, o[nq][0][4 * g + 1] * inv); w.y = pk2(o[nq][0][4 * g + 2] * inv, o[nq][0][4 * g + 3] * inv); *(v2u*)(orow + 8 * g) = w;
            v2u x; x.x = pk2(o[nq][1][4 * g] * inv, o[nq][1][4 * g + 1] * inv); x.y = pk2(o[nq][1][4 * g + 2] * inv, o[nq][1][4 * g + 3] * inv); *(v2u*)(orow + 32 + 8 * g) = x; } }
}
__device__ __forceinline__ void attn_mfma2(const Args& a, LAS unsigned char* lds) {
#ifdef ATT_NQ1
    for (int u = blockIdx.x; u < 512; u += gridDim.x) attn_unit2<1>(a, lds, u >> 6, (u >> 3) & 7, (u >> 6) * SEQ + (u & 7) * 256, (CTXL + SEQ) / 64, true);
#else
    for (int u = blockIdx.x; u < 256; u += gridDim.x) attn_unit2<2>(a, lds, u >> 5, (u >> 2) & 7, (u >> 5) * SEQ + (u & 3) * 512, (CTXL + SEQ) / 64, true);
#endif
    for (int u = blockIdx.x; u < 64; u += gridDim.x) attn_unit2<1>(a, lds, u >> 3, u & 7, TL + (u >> 3) * CTXL, CTXL / 64, false);
}

template <int R>
__device__ __forceinline__ void rowwise2(const float* xs_lat, const float* xs_ctx, float* xd_lat, float* xd_ctx, const bf16* Mb, const float* modg, const float* nwA,
                                         bf16* H, const float* modh, int sh_off, int sc_off, const float* nwB, int r_lo, int r_hi, int nb, int bi, int wv) {
    if (bi < 0 || bi >= nb) return;
    const int tid = otid(wv), wave = wv, lane = tid & 63; const int NGW = nb * NWAVES, gw = bi * NWAVES + wave;
    const int nr_ = r_hi - r_lo, base_ = nr_ / NGW, rem_ = nr_ % NGW; const int rbeg = r_lo + gw * base_ + min(gw, rem_), rend = rbeg + base_ + (gw < rem_ ? 1 : 0);
    for (int r0 = rbeg; r0 < rend; r0 += R) {
        f32x4 v[R][4]; v2u mm[R][4];
#pragma unroll
        for (int j = 0; j < R; ++j) { const int r = min(r0 + j, rend - 1); const float* xs = r < TL ? xs_lat + (size_t)r * D : xs_ctx + (size_t)(r - TL) * D;
#pragma unroll
            for (int q = 0; q < 4; ++q) v[j][q] = *(const f32x4*)(xs + q * 256 + lane * 4);
            if (Mb) {
#pragma unroll
                for (int q = 0; q < 4; ++q) mm[j][q] = *(const v2u*)(Mb + (size_t)r * D + q * 256 + lane * 4); } }
#pragma unroll
        for (int j = 0; j < R; ++j) { const int r = r0 + j; if (r < rend) {
            const bool lat = r < TL; const int cond = lat ? (r >> 11) : 8; float* xd = lat ? xd_lat + (size_t)r * D : xd_ctx + (size_t)(r - TL) * D;
            if (Mb) {
                f32x4 m[4]; float ss = 0.f;
#pragma unroll
                for (int q = 0; q < 4; ++q) { const v2u w = mm[j][q]; m[q] = (f32x4){bflo(w.x), bfhi(w.x), bflo(w.y), bfhi(w.y)}; ss += (m[q][0] * m[q][0] + m[q][1] * m[q][1]) + (m[q][2] * m[q][2] + m[q][3] * m[q][3]); }
                const float rs = rsqrtf(wave_sum(ss, lane) * (1.f / D) + EPS);
#pragma unroll
                for (int q = 0; q < 4; ++q) { const f32x4 g = *(const f32x4*)(modg + (size_t)cond * MODW + q * 256 + lane * 4); const f32x4 w = *(const f32x4*)(nwA + q * 256 + lane * 4);
                    v[j][q] = v[j][q] + g * (m[q] * rs * w); }
            }
#pragma unroll
            for (int q = 0; q < 4; ++q) *(f32x4*)(xd + q * 256 + lane * 4) = v[j][q];
            if (H) {
                float ss = 0.f;
#pragma unroll
                for (int q = 0; q < 4; ++q) ss += (v[j][q][0] * v[j][q][0] + v[j][q][1] * v[j][q][1]) + (v[j][q][2] * v[j][q][2] + v[j][q][3] * v[j][q][3]);
                const float rs = rsqrtf(wave_sum(ss, lane) * (1.f / D) + EPS);
#pragma unroll
                for (int q = 0; q < 4; ++q) { const int c = q * 256 + lane * 4;
                    const f32x4 w = *(const f32x4*)(nwB + c); const f32x4 sc = *(const f32x4*)(modh + (size_t)cond * MODW + sc_off + c); const f32x4 sh = *(const f32x4*)(modh + (size_t)cond * MODW + sh_off + c);
                    const f32x4 hv = (v[j][q] * rs * w) * (sc + 1.0f) + sh;
                    v2u o; o.x = pk2(hv[0], hv[1]); o.y = pk2(hv[2], hv[3]); *(v2u*)(H + (size_t)r * D + c) = o; }
            } } }
    }
}

__device__ __forceinline__ void convgate2(const Args& a, int l, int nrows) {
    const bf16* U = (const bf16*)(a.ws + WS_U); bf16* G = (bf16*)(a.ws + WS_G); const float* cw = a.in[I_FCONV] + (size_t)l * 3 * UPW;
    const int total = (nrows / 8) * (DFF / 8);
    for (int idx = blockIdx.x * NTHR + otid(a.wv); idx < total; idx += gridDim.x * NTHR) {
        const int r0 = (idx / (DFF / 8)) * 8, c0 = (idx % (DFF / 8)) * 8; const bf16* u = U + (size_t)r0 * UPW + c0;
        const bool hp = has_prev(r0), hn = has_next(r0 + 7);
        v4u ua[10], ug[10];
#pragma unroll
        for (int j = 0; j < 10; ++j) { const int rr = (j == 0 && !hp) ? 0 : ((j == 9 && !hn) ? 7 : j - 1); ua[j] = *(const v4u*)(u + (ptrdiff_t)rr * UPW); ug[j] = *(const v4u*)(u + (ptrdiff_t)rr * UPW + DFF); }
        float wa[3][8], wg[3][8];
#pragma unroll
        for (int t = 0; t < 3; ++t)
#pragma unroll
            for (int j = 0; j < 8; ++j) { wa[t][j] = cw[t * UPW + c0 + j]; wg[t][j] = cw[t * UPW + DFF + c0 + j]; }
        if (!hp) { ua[0] = (v4u){0u, 0u, 0u, 0u}; ug[0] = ua[0]; }
        if (!hn) { ua[9] = (v4u){0u, 0u, 0u, 0u}; ug[9] = ua[9]; }
        float pa[8], ca[8], na[8], pg[8], cg_[8], ng[8];
        unpack8(ua[0], pa); unpack8(ug[0], pg); unpack8(ua[1], ca); unpack8(ug[1], cg_);
#pragma unroll
        for (int j = 0; j < 8; ++j) {
            unpack8(ua[j + 2], na); unpack8(ug[j + 2], ng);
            float o[8];
#pragma unroll
            for (int k = 0; k < 8; ++k) { const float act = wa[0][k] * pa[k] + wa[1][k] * ca[k] + wa[2][k] * na[k]; const float gate = wg[0][k] * pg[k] + wg[1][k] * cg_[k] + wg[2][k] * ng[k]; o[k] = silu_f(act) * gate; }
            *(v4u*)(G + (size_t)(r0 + j) * DFF + c0) = pack8(o);
#pragma unroll
            for (int k = 0; k < 8; ++k) { pa[k] = ca[k]; ca[k] = na[k]; pg[k] = cg_[k]; cg_[k] = ng[k]; }
        }
    }
}

__device__ __forceinline__ void ssd_conv2(const Args& a, int i) {
    const bf16* ZX = (const bf16*)(a.ws + WS_ZX); bf16* XBC = (bf16*)(a.ws + WS_XBC); float* DT = (float*)(a.ws + WS_DT); float* AA = (float*)(a.ws + WS_AA);
    const float* cw = a.in[I_SCONVW] + (size_t)i * 3 * 3072; const float* cb = a.in[I_SCONVB] + (size_t)i * 3072;
    const int total = (T / 8) * 384;
    for (int idx = blockIdx.x * NTHR + otid(a.wv); idx < total; idx += gridDim.x * NTHR) {
        const int r0 = (idx / 384) * 8, c0 = (idx % 384) * 8; const bf16* u = ZX + (size_t)r0 * SSD_INP + 2048 + c0;
        const bool hp = has_prev(r0), hn = has_next(r0 + 7);
        v4u ux[10];
#pragma unroll
        for (int j = 0; j < 10; ++j) { const int rr = (j == 0 && !hp) ? 0 : ((j == 9 && !hn) ? 7 : j - 1); ux[j] = *(const v4u*)(u + (ptrdiff_t)rr * SSD_INP); }
        float w[3][8], bias[8];
#pragma unroll
        for (int j = 0; j < 8; ++j) { w[0][j] = cw[c0 + j]; w[1][j] = cw[3072 + c0 + j]; w[2][j] = cw[2 * 3072 + c0 + j]; bias[j] = cb[c0 + j]; }
        if (!hp) ux[0] = (v4u){0u, 0u, 0u, 0u};
        if (!hn) ux[9] = (v4u){0u, 0u, 0u, 0u};
        float p[8], c[8], n[8];
        unpack8(ux[0], p); unpack8(ux[1], c);
#pragma unroll
        for (int j = 0; j < 8; ++j) {
            unpack8(ux[j + 2], n); float o[8];
#pragma unroll
            for (int k = 0; k < 8; ++k) o[k] = silu_f(bias[k] + w[0][k] * p[k] + w[1][k] * c[k] + w[2][k] * n[k]);
            *(v4u*)(XBC + (size_t)(r0 + j) * 3072 + c0) = pack8(o);
#pragma unroll
            for (int k = 0; k < 8; ++k) { p[k] = c[k]; c[k] = n[k]; }
        }
    }
    const float* alog = a.in[I_ALOG] + i * 64; const float* dtb = a.in[I_DTB] + i * 64;
    for (int idx = blockIdx.x * NTHR + otid(a.wv); idx < T * 8; idx += gridDim.x * NTHR) {
        const int r = idx >> 3, j0 = (idx & 7) * 8; float raw[8], dt[8], av[8];
        unpack8(*(const v4u*)(ZX + (size_t)r * SSD_INP + 5120 + j0), raw);
#pragma unroll
        for (int k = 0; k < 8; ++k) { const float x = raw[k] + dtb[j0 + k]; dt[k] = x > 15.f ? x : (x < -15.f ? __expf(x) : __logf(1.f + __expf(x))); av[k] = -__expf(alog[j0 + k]) * dt[k]; }
        *(f32x4*)(DT + (size_t)r * 64 + j0) = (f32x4){dt[0], dt[1], dt[2], dt[3]}; *(f32x4*)(DT + (size_t)r * 64 + j0 + 4) = (f32x4){dt[4], dt[5], dt[6], dt[7]};
        *(f32x4*)(AA + (size_t)r * 64 + j0) = (f32x4){av[0], av[1], av[2], av[3]}; *(f32x4*)(AA + (size_t)r * 64 + j0 + 4) = (f32x4){av[4], av[5], av[6], av[7]};
    }
}

__device__ __forceinline__ void gatenorm2(const Args& a, int i, int nrows) {
    const int tid = otid(a.wv), wave = a.wv, lane = tid & 63; const int NGW = gridDim.x * NWAVES, gw = blockIdx.x * NWAVES + wave;
    const bf16* ZX = (const bf16*)(a.ws + WS_ZX); bf16* YN = (bf16*)(a.ws + WS_XBC); const float* nw = a.in[I_SNORM] + i * 2048;
    const int rpw = (nrows + NGW - 1) / NGW; const int rbeg = gw * rpw, rend = min(rbeg + rpw, nrows);
    constexpr int R = 3;
    for (int r0 = rbeg; r0 < rend; r0 += R) {
        v4u yv[R][4], zv[R][4];
#pragma unroll
        for (int j = 0; j < R; ++j) { const int r = min(r0 + j, rend - 1);
#pragma unroll
            for (int q = 0; q < 4; ++q) { const int c = q * 512 + lane * 8; yv[j][q] = *(const v4u*)(ZX + (size_t)r * SSD_INP + 2048 + c); zv[j][q] = *(const v4u*)(ZX + (size_t)r * SSD_INP + c); } }
#pragma unroll
        for (int j = 0; j < R; ++j) { const int r = r0 + j; if (r < rend) {
            float v[4][8]; float ss = 0.f;
#pragma unroll
            for (int q = 0; q < 4; ++q) { float y[8], z[8]; unpack8(yv[j][q], y); unpack8(zv[j][q], z);
#pragma unroll
                for (int k = 0; k < 8; ++k) { v[q][k] = y[k] * silu_f(z[k]); ss += v[q][k] * v[q][k]; } }
            const float rs = rsqrtf(wave_sum(ss, lane) * (1.f / 2048.f) + EPS);
#pragma unroll
            for (int q = 0; q < 4; ++q) { const int c = q * 512 + lane * 8; float o[8];
#pragma unroll
                for (int k = 0; k < 8; ++k) o[k] = v[q][k] * rs * nw[c + k];
                *(v4u*)(YN + (size_t)r * 2048 + c) = pack8(o); } } }
    }
}

__device__ __forceinline__ void ffn_fixup(const Args& a, int l, int nrows) {
    const bf16* Ue = (const bf16*)(a.ws + WS_UE); bf16* G = (bf16*)(a.ws + WS_G); const float* cw = a.in[I_FCONV] + (size_t)l * 3 * UPW;
    const int total = (nrows / 256) * 2 * (DFF / 8);
    for (int idx = blockIdx.x * NTHR + otid(a.wv); idx < total; idx += gridDim.x * NTHR) {
        const int cg = idx % (DFF / 8), which = (idx / (DFF / 8)) & 1, pm = idx / (2 * (DFF / 8)); const int c0 = cg * 8; const int col = (c0 / 128) * 256 + (c0 % 128);
        const int r = pm * 256 + (which ? 255 : 0);
        const bf16* e0 = Ue + (size_t)(pm * 4) * UPW + col;
        const bf16* pp = which ? e0 + 2 * UPW : e0 - UPW;
        const bf16* pc = which ? e0 + 3 * UPW : e0;
        const bf16* pn = which ? e0 + 4 * UPW : e0 + UPW;
        const bool hp = which ? true : has_prev(r), hn = which ? has_next(r) : true;
        float pa[8], pg[8], ca[8], cg_[8], na[8], ng[8];
        unpack8(*(const v4u*)pc, ca); unpack8(*(const v4u*)(pc + 128), cg_);
        if (hp) { unpack8(*(const v4u*)pp, pa); unpack8(*(const v4u*)(pp + 128), pg); } else {
#pragma unroll
            for (int k = 0; k < 8; ++k) { pa[k] = 0.f; pg[k] = 0.f; } }
        if (hn) { unpack8(*(const v4u*)pn, na); unpack8(*(const v4u*)(pn + 128), ng); } else {
#pragma unroll
            for (int k = 0; k < 8; ++k) { na[k] = 0.f; ng[k] = 0.f; } }
        float o[8];
#pragma unroll
        for (int k = 0; k < 8; ++k) { const float act = cw[c0 + k] * pa[k] + cw[UPW + c0 + k] * ca[k] + cw[2 * UPW + c0 + k] * na[k];
            const float gate = cw[DFF + c0 + k] * pg[k] + cw[UPW + DFF + c0 + k] * cg_[k] + cw[2 * UPW + DFF + c0 + k] * ng[k]; o[k] = silu_f(act) * gate; }
        *(v4u*)(G + (size_t)r * DFF + c0) = pack8(o);
    }
}

__device__ __forceinline__ void prep_even2(const Args& a, int i) {
    const int tid = otid(a.wv), wave = a.wv, lane = tid & 63; const int NGW = gridDim.x * NWAVES, gw = blockIdx.x * NWAVES + wave;
    const bf16* P = (const bf16*)(a.ws + WS_P); bf16* CQN = (bf16*)(a.ws + WS_CQN); bf16* CKVN = (bf16*)(a.ws + WS_CKVN); bf16* KR = (bf16*)(a.ws + WS_KR); bf16* MIX = (bf16*)(a.ws + WS_MIX);
    const float* qn = a.in[I_QNORM] + i * 384; const float* kvn = a.in[I_KVNORM] + i * 256; const float* cw = a.in[I_SCONV] + i * 3 * 512;
    const float* ct = (const float*)(a.ws + WS_ROPE); const float* st = ct + SEQ * 16;
    constexpr int R = 3; const int rpw = (T + NGW - 1) / NGW; const int rbeg = gw * rpw, rend = min(rbeg + rpw, T);
    const int c0 = lane * 8;
    for (int r0 = rbeg; r0 < rend; r0 += R) {
        unsigned q32[R][3]; v2u kv2[R]; bf16 krv[R]; v4u gbv[R], gcv[R + 2], xvv[R + 2];
#pragma unroll
        for (int j = 0; j < R; ++j) { const int r = min(r0 + j, rend - 1); const bf16* p = P + (size_t)r * HYB_INP;
            const unsigned* p32 = (const unsigned*)(p + lane * 6); q32[j][0] = p32[0]; q32[j][1] = p32[1]; q32[j][2] = p32[2];
            kv2[j] = *(const v2u*)(p + 384 + lane * 4); krv[j] = p[640 + (lane & 31)]; gbv[j] = *(const v4u*)(p + 672 + c0); }
#pragma unroll
        for (int j = 0; j < R + 2; ++j) { int r = r0 + j - 1; r = max(0, min(r, T - 1)); const bf16* p = P + (size_t)r * HYB_INP; gcv[j] = *(const v4u*)(p + 1184 + c0); xvv[j] = *(const v4u*)(p + 1696 + c0); }
#pragma unroll
        for (int j = 0; j < R; ++j) { const int r = r0 + j; if (r < rend) {
            {   float f[6] = {bflo(q32[j][0]), bfhi(q32[j][0]), bflo(q32[j][1]), bfhi(q32[j][1]), bflo(q32[j][2]), bfhi(q32[j][2])}; float ss = 0.f;
#pragma unroll
                for (int k = 0; k < 6; ++k) ss += f[k] * f[k];
                const float rs = rsqrtf(wave_sum(ss, lane) * (1.f / 384.f) + EPS);
#pragma unroll
                for (int k = 0; k < 6; ++k) f[k] = f[k] * rs * qn[lane * 6 + k];
                unsigned* o32 = (unsigned*)(CQN + (size_t)r * 384 + lane * 6); o32[0] = pk2(f[0], f[1]); o32[1] = pk2(f[2], f[3]); o32[2] = pk2(f[4], f[5]); }
            {   const v2u w = kv2[j]; float f[4] = {bflo(w.x), bfhi(w.x), bflo(w.y), bfhi(w.y)};
                const float ss = (f[0] * f[0] + f[1] * f[1]) + (f[2] * f[2] + f[3] * f[3]);
                const float rs = rsqrtf(wave_sum(ss, lane) * (1.f / 256.f) + EPS);
                const f32x4 g = *(const f32x4*)(kvn + lane * 4);
                v2u o; o.x = pk2(f[0] * rs * g[0], f[1] * rs * g[1]); o.y = pk2(f[2] * rs * g[2], f[3] * rs * g[3]); *(v2u*)(CKVN + (size_t)r * 256 + lane * 4) = o; }
            {   const int jj = lane & 31; const float v = bf1(krv[j]); const float o = shx(v, 16, lane); float res = v;
                if (r < TL) { const int t = r & (SEQ - 1); const float c = ct[t * 16 + (jj & 15)], s = st[t * 16 + (jj & 15)]; res = (jj < 16) ? v * c - o * s : o * s + v * c; }
                if (lane < 32) KR[(size_t)r * 32 + jj] = (bf16)f2bf(res); }
            {   float gb[8], t0[8], t1[8], acc[8];
                unpack8(gbv[j], gb); unpack8(gcv[j + 1], t0); unpack8(xvv[j + 1], t1);
#pragma unroll
                for (int k = 0; k < 8; ++k) acc[k] = cw[512 + c0 + k] * (t0[k] * t1[k]);
                if (has_prev(r)) { unpack8(gcv[j], t0); unpack8(xvv[j], t1);
#pragma unroll
                    for (int k = 0; k < 8; ++k) acc[k] += cw[c0 + k] * (t0[k] * t1[k]); }
                if (has_next(r)) { unpack8(gcv[j + 2], t0); unpack8(xvv[j + 2], t1);
#pragma unroll
                    for (int k = 0; k < 8; ++k) acc[k] += cw[1024 + c0 + k] * (t0[k] * t1[k]); }
#pragma unroll
                for (int k = 0; k < 8; ++k) acc[k] *= gb[k];
                *(v4u*)(MIX + (size_t)r * D + 512 + c0) = pack8(acc); }
        } }
    }
}

__device__ __forceinline__ void ffn_fixup_panel(const Args& a, int l, int pm) {
    const bf16* Ue = (const bf16*)(a.ws + WS_UE); bf16* G = (bf16*)(a.ws + WS_G); const float* cw = a.in[I_FCONV] + (size_t)l * 3 * UPW;
    for (int idx = otid(a.wv); idx < 2 * (DFF / 8); idx += NTHR) {
        const int cg = idx % (DFF / 8), which = idx / (DFF / 8); const int c0 = cg * 8; const int col = (c0 / 128) * 256 + (c0 % 128);
        const int r = pm * 256 + (which ? 255 : 0);
        const bf16* e0 = Ue + (size_t)(pm * 4) * UPW + col;
        const bf16* pp = which ? e0 + 2 * UPW : e0 - UPW; const bf16* pc = which ? e0 + 3 * UPW : e0; const bf16* pn = which ? e0 + 4 * UPW : e0 + UPW;
        const bool hp = which ? true : has_prev(r), hn = which ? has_next(r) : true;
        float pa[8], pg[8], ca[8], cg_[8], na[8], ng[8];
        unpack8(*(const v4u*)pc, ca); unpack8(*(const v4u*)(pc + 128), cg_);
        if (hp) { unpack8(*(const v4u*)pp, pa); unpack8(*(const v4u*)(pp + 128), pg); } else {
#pragma unroll
            for (int k = 0; k < 8; ++k) { pa[k] = 0.f; pg[k] = 0.f; } }
        if (hn) { unpack8(*(const v4u*)pn, na); unpack8(*(const v4u*)(pn + 128), ng); } else {
#pragma unroll
            for (int k = 0; k < 8; ++k) { na[k] = 0.f; ng[k] = 0.f; } }
        float o[8];
#pragma unroll
        for (int k = 0; k < 8; ++k) { const float act = cw[c0 + k] * pa[k] + cw[UPW + c0 + k] * ca[k] + cw[2 * UPW + c0 + k] * na[k];
            const float gate = cw[DFF + c0 + k] * pg[k] + cw[UPW + DFF + c0 + k] * cg_[k] + cw[2 * UPW + DFF + c0 + k] * ng[k]; o[k] = silu_f(act) * gate; }
        *(v4u*)(G + (size_t)r * DFF + c0) = pack8(o);
    }
}

#ifndef MK_SINGLE
#define MK_SINGLE 1
#endif
struct GemmDesc { const bf16* A; const bf16* Bt; int M, N, K; bf16* O; int ldc; int mode; };
struct RowDesc { const float* xs_lat; const float* xs_ctx; float* xd_lat; float* xd_ctx; const bf16* Mb; const float* modg; const float* nwA; bf16* H; const float* modh; int sh_off, sc_off; const float* nwB; int r_lo, r_hi, nb, bi; };

__global__ void __launch_bounds__(NTHR, 2) fwd_kernel(Args a_in) {
    extern __shared__ __attribute__((aligned(16))) unsigned char lds_raw[];
    LAS unsigned char* lds = (LAS unsigned char*)lds_raw;
#if MK_SINGLE == 1
    volatile LAS unsigned* bst = (volatile LAS unsigned*)(lds + LDS_BYTES - 64);
    const int wv0 = __builtin_amdgcn_readfirstlane((int)threadIdx.x >> 6);
    { const int t0 = otid(wv0); if (t0 < 16) bst[t0] = 0u; }
    __syncthreads();
    const XcdBarrier xbar = xcd_barrier_post((unsigned*)(a_in.ws + WS_CTL), bst, wv0);
#endif
    const Args& a0 = a_in;
#ifdef TDIAG
    unsigned long long tcat[6] = {0, 0, 0, 0, 0, 0}; unsigned long long tlast = __builtin_amdgcn_s_memrealtime();
#endif
    for (int s = a0.lo; s < a0.hi; ++s) {
        Args a = a0;
        { long oz; asm volatile("s_mov_b64 %0, 0" : "=s"(oz));
#pragma unroll
          for (int q = 0; q < 25; ++q) a.in[q] = (const float*)((const char*)a0.in[q] + oz);
          a.out = (float*)((char*)a0.out + oz); a.ws = a0.ws + oz; a.wv = wv0; }
        unsigned char* ws = a.ws;
        float* XL = a.out; float* XC = (float*)(ws + WS_XC); bf16* H = (bf16*)(ws + WS_H); bf16* Mb = (bf16*)(ws + WS_M);
        const float* MOD = (const float*)(ws + WS_MOD); const float* NW = a.in[I_NORMW];
        int nrep = 1;
#ifdef PROBE_MASK
        if (s == 0 && (PROBE_MASK >> 20 & 1u)) nrep = 2;
        if (s >= 2) { const int pk = (s - 2) % 10, ppar = ((s - 2) / 10) & 1; if ((PROBE_MASK >> (pk + 10 * ppar)) & 1u) nrep = 2; }
#endif
        for (int rep = 0; rep < nrep; ++rep) {
        GemmDesc g0{}, g1{}; int ng = 0, gG = (int)gridDim.x;
        RowDesc rd{}; bool do_row = false;
#ifndef NO_SIMPLE
        if (s == 0) {
            mod_compute(a, lds);
            rope_tables(a);
            convert_layer(a, 0, lds);
        } else if (s == 1) {
            rd = RowDesc{a.in[I_X], a.in[I_CTX], XL, XC, nullptr, nullptr, nullptr, H, MOD, 0, 1024, NW, 0, T, (int)gridDim.x, (int)blockIdx.x}; do_row = true;
        } else {
            const int l = (s - 2) / NK, k = (s - 2) % NK, i = l >> 1; const bool even = (l & 1) == 0, last = (l == 3);
            const int MR = last ? TL : T;
            const int NCG = 32;
            const float* mg1 = MOD + (size_t)l * 9 * MODW + 2048; const float* nA1 = NW + (l * 4 + 1) * D; const float* mh1 = MOD + (size_t)l * 9 * MODW; const float* nB1 = NW + (l * 4 + 2) * D;
            const float* mg2 = MOD + (size_t)l * 9 * MODW + 5120; const float* nA2 = NW + (l * 4 + 3) * D; const float* mh2 = MOD + (size_t)(l + 1) * 9 * MODW; const float* nB2 = NW + ((l + 1) * 4 + 0) * D;
            switch (k) {
            case 0:
                if (even) { g0 = GemmDesc{H, (const bf16*)(ws + W_IN), T, HYB_INP, D, (bf16*)(ws + WS_P), HYB_INP}; ng = 1; }
                else      { g0 = GemmDesc{H, (const bf16*)(ws + W_IN), T, SSD_INP, D, (bf16*)(ws + WS_ZX), SSD_INP}; ng = 1; }
                break;
            case 1: if (even) prep_even2(a, i); else ssd_conv2(a, i); break;
            case 2:
                if (even) { { g0 = GemmDesc{(const bf16*)(ws + WS_CQN), (const bf16*)(ws + W_UQ), T, QW, 384, (bf16*)(ws + WS_Q), QW}; ng = 1; }
                            g1 = GemmDesc{(const bf16*)(ws + WS_CKVN), (const bf16*)(ws + W_UKV), T, KVW, 256, (bf16*)(ws + WS_KV), KVW}; ng = 2; }
                else ssd_scan_mfma(a, i, last, lds);
                break;
            case 3: if (even) attn_mfma(a, lds); else gatenorm2(a, i, MR); break;
            case 4:
                if (even) { g0 = GemmDesc{(const bf16*)(ws + WS_MIX), (const bf16*)(ws + W_OUT), TL, D, D, Mb, D}; ng = 1; }
                else      { g0 = GemmDesc{(const bf16*)(ws + WS_XBC), (const bf16*)(ws + W_OUT), TL, D, 2048, Mb, D}; ng = 1; }
                break;
            case 5:
                if (!last) {
                    if (even) { g0 = GemmDesc{(const bf16*)(ws + WS_MIX) + (size_t)TL * D, (const bf16*)(ws + W_OUT), TC, D, D, Mb + (size_t)TL * D, D}; ng = 1; }
                    else      { g0 = GemmDesc{(const bf16*)(ws + WS_XBC) + (size_t)TL * 2048, (const bf16*)(ws + W_OUT), TC, D, 2048, Mb + (size_t)TL * D, D}; ng = 1; }
                    gG = NCG;
                    rd = RowDesc{XL, XC, XL, XC, Mb, mg1, nA1, H, mh1, 3072, 4096, nB1, 0, TL, (int)gridDim.x - NCG, (int)blockIdx.x - NCG}; do_row = true;
                } else { rd = RowDesc{XL, XC, XL, XC, Mb, mg1, nA1, H, mh1, 3072, 4096, nB1, 0, TL, (int)gridDim.x, (int)blockIdx.x}; do_row = true; }
                break;
            case 6:
                if (!last) { rd = RowDesc{XL, XC, XL, XC, Mb, mg1, nA1, H, mh1, 3072, 4096, nB1, TL, T, (int)gridDim.x, (int)blockIdx.x}; do_row = true; }
                break;
            case 7: { g0 = GemmDesc{H, (const bf16*)(ws + W_UP), MR, UPW, D, (bf16*)(ws + WS_G), DFF, 1}; ng = 1; } break;
            case 8:
                    { g0 = GemmDesc{(const bf16*)(ws + WS_G), (const bf16*)(ws + W_DN), TL, D, DFF, Mb, D}; ng = 1;
                      pg8::StaticOrder S0; S0.init(TL, D, (int)gridDim.x, (int)blockIdx.x); pg8::Unit u0; int lastpm = -1;
                      for (int ui0 = 0; S0.next(ui0, u0); ++ui0) if (u0.pm != lastpm) { ffn_fixup_panel(a, l, u0.pm); lastpm = u0.pm; }
                      asm volatile("s_waitcnt vmcnt(0)" ::: "memory"); __syncthreads(); } break;
            case 9:
                if (!last) {
                    g0 = GemmDesc{(const bf16*)(ws + WS_G) + (size_t)TL * DFF, (const bf16*)(ws + W_DN), TC, D, DFF, Mb + (size_t)TL * D, D}; ng = 1; gG = NCG;
                    { pg8::StaticOrder S0; S0.init(TC, D, NCG, (int)blockIdx.x); pg8::Unit u0; int lastpm = -1;
                      for (int ui0 = 0; S0.next(ui0, u0); ++ui0) if (u0.pm != lastpm) { ffn_fixup_panel(a, l, TL / 256 + u0.pm); lastpm = u0.pm; }
                      asm volatile("s_waitcnt vmcnt(0)" ::: "memory"); __syncthreads(); }
                    rd = RowDesc{XL, XC, XL, XC, Mb, mg2, nA2, H, mh2, 0, 1024, nB2, 0, TL, (int)gridDim.x - NCG, (int)blockIdx.x - NCG}; do_row = true;
                } else { rd = RowDesc{XL, XC, XL, XC, Mb, mg2, nA2, nullptr, MOD, 0, 0, NW, 0, TL, (int)gridDim.x, (int)blockIdx.x}; do_row = true; }
                break;
            case 10:
                if (!last) { rd = RowDesc{XL, XC, XL, XC, Mb, mg2, nA2, H, mh2, 0, 1024, nB2, TL, T, (int)gridDim.x, (int)blockIdx.x}; do_row = true; }
                break;
            }
        }
        if (do_row) rowwise2<3>(rd.xs_lat, rd.xs_ctx, rd.xd_lat, rd.xd_ctx, rd.Mb, rd.modg, rd.nwA, rd.H, rd.modh, rd.sh_off, rd.sc_off, rd.nwB, rd.r_lo, rd.r_hi, rd.nb, rd.bi, a.wv);
        if (s >= 2 && (s - 2) % NK == 10 && (s - 2) / NK < 3) convert_layer(a, (s - 2) / NK + 1, lds);
#else
        { g0 = GemmDesc{H, (const bf16*)(ws + W_IN), T, a.hi * 256, a.lo * 128, (bf16*)(ws + WS_P), HYB_INP}; ng = 1; }
#endif
        for (int gi = 0; gi < ng; ++gi) {
            const bool f = (gi == 0);
            pg8::Gemm g{f ? g0.A : g1.A, f ? g0.Bt : g1.Bt, f ? g0.M : g1.M, f ? g0.N : g1.N, f ? g0.K : g1.K, a.wv,
#ifdef GDIAG
                (s == GDIAG_STEP) ? (float*)(a0.ws + WS_MOD + 900 * 1024) : nullptr
#else
                nullptr
#endif
            }; pg8::StaticOrder S; S.init(g.M, g.N, gG, (int)blockIdx.x);
            pg8::EpiFfn E{f ? g0.O : g1.O, f ? g0.ldc : g1.ldc, f ? g0.mode : 0, (bf16*)(ws + WS_UE), a.in[I_FCONV] + (size_t)((s - 2) / NK) * 3 * UPW, (LAS pg8::f32x4*)(lds + 131072), a.wv};
#ifndef NO_GEMM
            pg8::gemm_phase<pg8::EpiFfn, pg8::StaticOrder, true, true>(lds, g, S, E);
#endif
            __syncthreads();
        }
        if (rep + 1 < nrep) __syncthreads();
        }
#ifdef GDIAG
        if (s + 1 == a0.hi) { __syncthreads(); asm volatile("s_waitcnt vmcnt(0)" ::: "memory"); if (blockIdx.x == 0 && otid(wv0) == 0) { const float* dg = (const float*)(a0.ws + WS_MOD + 900 * 1024); a0.out[0] += 25.0f * dg[GDIAG_SEL] / dg[3]; } }
#endif
#ifdef SSD_DIAG
        if (s + 1 == a0.hi) { __syncthreads(); asm volatile("s_waitcnt vmcnt(0)" ::: "memory"); if (blockIdx.x == 0 && otid(wv0) == 0) { const float* dg = (const float*)(a0.ws + WS_MOD + 900 * 1024); a0.out[0] += 25.0f * dg[SSD_DIAG_SEL] / dg[7]; } }
#endif
#ifdef TDIAG
        if (s + 1 == a0.hi) { __syncthreads(); }
#endif
#ifdef BLK_JITTER
        if ((((int)blockIdx.x * 7 + s * 3) % 11) == 0) { for (int q = 0; q < 40; ++q) __builtin_amdgcn_s_sleep(127); }
#endif
        if (s + 1 < a0.hi && !(s >= 2 && (s - 2) / NK == 3 && ((s - 2) % NK == 6 || (s - 2) % NK >= 9))) {
#if MK_SINGLE == 1
            xcd_barrier(xbar);
#ifdef PROBE_BAR2
            xcd_barrier(xbar);
#endif
#elif MK_SINGLE == 2
            cg::this_grid().sync();
#endif
        }
#ifdef TDIAG
        { const unsigned long long tn = __builtin_amdgcn_s_memrealtime(); int cat = 0;
          if (s >= 2) { const int k = (s - 2) % 10, par = ((s - 2) / 10) & 1; cat = (k == 0 || k == 4 || k == 6 || k == 8 || (k == 2 && par == 0)) ? 1 : ((k == 5 || k == 9) ? 2 : ((k == 3 && par == 0) ? 4 : ((k == 2 && par == 1) ? 5 : 3)));
#ifdef TDIAG_K
              cat = (k == TDIAG_K && (TDIAG_PAR == 2 || par == TDIAG_PAR)) ? 1 : 3;
#endif
          }
#pragma unroll
          for (int q = 0; q < 6; ++q) if (q == cat) tcat[q] += tn - tlast;
          tlast = tn;
          if (s + 1 == a0.hi) { asm volatile("s_waitcnt vmcnt(0)" ::: "memory"); if (blockIdx.x == 0 && otid(wv0) == 0) { unsigned long long tt = 0;
#pragma unroll
              for (int q = 0; q < 6; ++q) tt += tcat[q];
              a0.out[0] += (TDIAG == 6) ? (float)tt * (1.0f / 20000.0f) : 25.0f * (float)tcat[TDIAG < 6 ? TDIAG : 0] / (float)tt; } } }
#endif
    }
}

extern "C" void kernel_launch(void* const* d_in, const int* in_sizes, int n_in, void* d_out, int out_size, void* d_ws, size_t ws_size, hipStream_t stream) {
    static int grid = 0;
    if (grid == 0) {
        if (n_in != 25 || out_size != TL * D || ws_size < WS_END) { fprintf(stderr, "kernel_launch: unexpected problem (n_in %d out %d ws %zu need %zu)\n", n_in, out_size, ws_size, (size_t)WS_END); grid = -1; return; }
        if (hipFuncSetAttribute((const void*)fwd_kernel, hipFuncAttributeMaxDynamicSharedMemorySize, LDS_BYTES) != hipSuccess) { fprintf(stderr, "kernel_launch: hipFuncSetAttribute failed\n"); grid = -1; return; }
        int dev = 0, cus = 0, per_cu = 0;
        hipGetDevice(&dev); hipDeviceGetAttribute(&cus, hipDeviceAttributeMultiprocessorCount, dev);
        hipOccupancyMaxActiveBlocksPerMultiprocessor(&per_cu, (const void*)fwd_kernel, NTHR, LDS_BYTES);
        (void)hipGetLastError();
        if (per_cu < 1) { fprintf(stderr, "kernel_launch: occupancy query says %d blocks per CU\n", per_cu); }
        grid = cus;
    }
    if (grid < 0) return;
#if MK_SINGLE == 1
    if (hipMemsetAsync((char*)d_ws + WS_CTL, 0, CTL_ZERO_BYTES, stream) != hipSuccess) { fprintf(stderr, "kernel_launch: memset failed\n"); return; }
#endif
    Args a{};
    for (int i = 0; i < 25; ++i) a.in[i] = (const float*)d_in[i];
    a.out = (float*)d_out; a.ws = (unsigned char*)d_ws;
#if MK_SINGLE
    a.lo = 0; a.hi = NSTEP + 1;
    void* args[] = {&a};
    hipError_t e = hipLaunchCooperativeKernel((const void*)fwd_kernel, dim3(grid), dim3(NTHR), args, LDS_BYTES, stream);
    if (e != hipSuccess) fprintf(stderr, "cooperative launch failed: %s (grid %d)\n", hipGetErrorString(e), grid);
#else
    for (int s = 0; s < NSTEP + 1; ++s) { a.lo = s; a.hi = s + 1; hipLaunchKernelGGL(fwd_kernel, dim3(grid), dim3(NTHR), LDS_BYTES, stream, a); }
#endif
}
```

```cpp
#include <hip/hip_runtime.h>
#include <hip/hip_cooperative_groups.h>
#include <cstdio>
#include <cstdint>
namespace cg = cooperative_groups;
__device__ __forceinline__ int otid(int wv) { int l; asm volatile("v_mbcnt_lo_u32_b32 %0, -1, 0\n\tv_mbcnt_hi_u32_b32 %0, -1, %0" : "=v"(l)); return (wv << 6) | l; }
__device__ __forceinline__ float shx(float v, int mask, int lane) { return __builtin_bit_cast(float, __builtin_amdgcn_ds_bpermute((lane ^ mask) << 2, __builtin_bit_cast(int, v))); }
#define LAS __attribute__((address_space(3)))
typedef float f32x2_cv __attribute__((ext_vector_type(2))); typedef __bf16 bf16x2_cv __attribute__((ext_vector_type(2)));
__device__ __forceinline__ unsigned hw_cvtpk(float lo, float hi) { f32x2_cv v = {lo, hi}; bf16x2_cv b = __builtin_convertvector(v, bf16x2_cv); return __builtin_bit_cast(unsigned, b); }
#define XB_TMO      128
#define XB_XCNT(j)  (256  + 64 * (j))
#define XB_XSUB(j)  (1280 + 64 * (j))
#define XB_XGEN(j)  (2304 + 64 * (j))
#define XB_TOP      3328
#define XB_TOPGEN   3392
#define XCD_BAR_WORDS 3456
#define XB_SPIN_CAP (1u << 18)

__device__ __forceinline__ unsigned xb_ld(unsigned* p)              { return __hip_atomic_load(p, __ATOMIC_RELAXED, __HIP_MEMORY_SCOPE_AGENT); }
__device__ __forceinline__ unsigned xb_add(unsigned* p, unsigned v) { return __hip_atomic_fetch_add(p, v, __ATOMIC_RELAXED, __HIP_MEMORY_SCOPE_AGENT); }
__device__ __forceinline__ unsigned xb_xcc_id() { return (unsigned)__builtin_amdgcn_s_getreg((3 << 11) | 20) & 0xFu; }
#define XB_SPIN(cond, bar) do { unsigned _sp = 0; while (cond) { __builtin_amdgcn_s_sleep(1); \
    if ((++_sp & 255u) == 0u) { if (xb_ld(&(bar)[XB_TMO])) break; if (_sp > XB_SPIN_CAP) { atomicAdd(&(bar)[XB_TMO], 1u); break; } } } } while (0)

struct XcdBarrier {
    unsigned* bar; unsigned x; int wv;
    volatile LAS unsigned* st;
};

__device__ __forceinline__ XcdBarrier xcd_barrier_post(unsigned* bar, volatile LAS unsigned* st, int wv) {
    XcdBarrier b; b.bar = bar; b.x = xb_xcc_id(); b.st = st; b.wv = wv;
    if (otid(wv) == 0) (void)xb_add(&bar[XB_XCNT(b.x)], 1u);
    return b;
}
__device__ __forceinline__ void xcd_barrier_complete(unsigned* bar, unsigned x, unsigned& nloc, unsigned& nx) {
    const unsigned G = gridDim.x * gridDim.y * gridDim.z;
    unsigned sum, cnt, mine, sp = 0u;
    for (;;) {
        sum = 0u; cnt = 0u; mine = 0u;
#pragma unroll
        for (unsigned j = 0; j < 16; ++j) { const unsigned c = xb_ld(&bar[XB_XCNT(j)]); sum += c; cnt += (c > 0u) ? 1u : 0u; mine = (j == x) ? c : mine; }
        if (sum == G) break;
        __builtin_amdgcn_s_sleep(1);
        if ((++sp & 255u) == 0u) { if (xb_ld(&bar[XB_TMO])) break; if (sp > XB_SPIN_CAP) { atomicAdd(&bar[XB_TMO], 1u); break; } }
    }
    nloc = mine > 0u ? mine : 1u; nx = cnt > 0u ? cnt : 1u;
}

__device__ __forceinline__ void xcd_barrier(const XcdBarrier& b) {
    asm volatile("s_waitcnt vmcnt(0)" ::: "memory");
    __syncthreads();
    if (otid(b.wv) == 0) {
        unsigned* bar = b.bar;
        __builtin_amdgcn_s_waitcnt(0);
        unsigned nloc = b.st[0], nx = b.st[1];
        if (nloc == 0u) { xcd_barrier_complete(bar, b.x, nloc, nx); b.st[0] = nloc; b.st[1] = nx; }
        const unsigned old = xb_add(&bar[XB_XSUB(b.x)], 1u);
        const unsigned gen = old / nloc;
        if (old + 1u == (gen + 1u) * nloc) {
            __builtin_amdgcn_fence(__ATOMIC_RELEASE, "agent");
            asm volatile("s_waitcnt vmcnt(0)" ::: "memory");
            const unsigned og = xb_add(&bar[XB_TOP], 1u);
            const unsigned tg = og / nx;
            if (og + 1u == (tg + 1u) * nx) xb_add(&bar[XB_TOPGEN], 1u);
            else XB_SPIN(xb_ld(&bar[XB_TOPGEN]) == tg, bar);
            __builtin_amdgcn_fence(__ATOMIC_ACQUIRE, "agent");
            xb_add(&bar[XB_XGEN(b.x)], 1u);
            asm volatile("s_waitcnt vmcnt(0)" ::: "memory");
        } else {
            XB_SPIN(xb_ld(&bar[XB_XGEN(b.x)]) == gen, bar);
            __builtin_amdgcn_fence(__ATOMIC_ACQUIRE, "agent");
            asm volatile("s_waitcnt vmcnt(0)" ::: "memory");
        }
    }
    __syncthreads();
}
namespace pg8 {
#define PG8_LAS __attribute__((address_space(3)))
typedef unsigned short bf16_t;
typedef short bf16x8 __attribute__((ext_vector_type(8)));
typedef float f32x4 __attribute__((ext_vector_type(4)));
typedef unsigned u32x4 __attribute__((ext_vector_type(4)));
constexpr int BM = 256, BK = 64, HALF = 128, HTB = HALF * BK * 2  , STAGE_BYTES = 8 * HTB, NXCD = 8, WGM = 8;

__host__ __device__ __forceinline__ int lds_byte(int r, int c) { const int st = (r >> 4) * 2 + (c >> 5), rr = r & 15, cc = c & 31, ob = rr * 64 + cc * 2; return st * 1024 + (ob ^ (((ob >> 9) & 1) << 5)); }
__host__ __device__ __forceinline__ void stage_rc(int b, int& R, int& C) { const int st = b / 1024, sb = b % 1024, swz = sb ^ (((sb >> 9) & 1) << 5); R = (st >> 1) * 16 + swz / 64; C = (st & 1) * 32 + (swz % 64) / 2; }
__host__ __device__ __forceinline__ int perm32(int rho) { const int n = rho >> 4, i = rho & 15; return 8 * (i >> 2) + 4 * n + (i & 3); }

struct Unit { int pm, pn; };
struct Gemm { const bf16_t* A; const bf16_t* Bt; int M, N, K, wv; float* dg; };

struct StaticOrder {
    int nM, nN, nwg, G, c;
    __host__ __device__ void init(int M, int N, int G_, int c_) { nM = M / BM; nN = N / BM; nwg = nM * nN; G = G_; c = c_; }
    __host__ __device__ bool next(int i, Unit& u) const {
        const long L = (long)i * G + c; if (L >= nwg) return false;
        int wgid = (int)L; { const int q = nwg / NXCD, r = nwg % NXCD, xcd = wgid % NXCD, off = wgid / NXCD; wgid = (xcd < r ? xcd * (q + 1) : r * (q + 1) + (xcd - r) * q) + off; }
        const int nig = WGM * nN, gid = wgid / nig, fm = gid * WGM, gsz = (nM - fm) < WGM ? (nM - fm) : WGM;
        u.pm = fm + ((wgid % nig) % gsz); u.pn = (wgid % nig) / gsz; return true;
    }
    __device__ __forceinline__ void a_ready(const Unit&) const {}
    __device__ __forceinline__ void done(const Unit&) const {}
};

__device__ __forceinline__ unsigned cvt_pk_bf16(float lo, float hi) { return hw_cvtpk(lo, hi); }
struct EpiStore {
    static constexpr bool PERM = true, AFTER_DRAIN = false;
    bf16_t* O; int ldc;
    __device__ __forceinline__ void operator()(const f32x4 (&acc)[2][2][4][2], const Unit& u, int wr, int wc, int fr, int fq) const {
        const int row0 = u.pm * BM + wr * 64 + fr; const int col0 = u.pn * BM + wc * 32 + 8 * fq;
#pragma unroll
        for (int ai = 0; ai < 2; ++ai)
#pragma unroll
            for (int m = 0; m < 4; ++m) { bf16_t* rowp = O + (size_t)(row0 + ai * HALF + m * 16) * ldc + col0;
#pragma unroll
                for (int bj = 0; bj < 2; ++bj) { const f32x4 v0 = acc[ai][bj][m][0], v1 = acc[ai][bj][m][1];
                    u32x4 w; w.x = cvt_pk_bf16(v0[0], v0[1]); w.y = cvt_pk_bf16(v0[2], v0[3]); w.z = cvt_pk_bf16(v1[0], v1[1]); w.w = cvt_pk_bf16(v1[2], v1[3]);
                    *(u32x4*)(rowp + bj * HALF) = w; } }
    }
};

template <int CTRL> __device__ __forceinline__ float dpprot(float src) { return __builtin_bit_cast(float, __builtin_amdgcn_mov_dpp(__builtin_bit_cast(int, src), CTRL, 0xf, 0xf, true)); }
template <int CTRL> __device__ __forceinline__ float dppf(float old, float src) { return __builtin_bit_cast(float, __builtin_amdgcn_update_dpp(__builtin_bit_cast(int, old), __builtin_bit_cast(int, src), CTRL, 0xf, 0xf, false)); }
#define PG8_DPP4(dst, oldv, srcv, ctrl) do { dst[0] = dppf<ctrl>(oldv[0], srcv[0]); dst[1] = dppf<ctrl>(oldv[1], srcv[1]); dst[2] = dppf<ctrl>(oldv[2], srcv[2]); dst[3] = dppf<ctrl>(oldv[3], srcv[3]); } while (0)
struct EpiFfn {
    static constexpr bool PERM = true, AFTER_DRAIN = false;
    bf16_t* O; int ldc; int mode;
    bf16_t* Ue; const float* cw; PG8_LAS f32x4* ex; int wv;
    __device__ __forceinline__ void operator()(const f32x4 (&acc)[2][2][4][2], const Unit& u, int wr, int wc, int fr_in, int fq_in) const {
        (void)fr_in; (void)fq_in; const int lane_e = otid(wv) & 63; const int fr = lane_e & 15, fq = lane_e >> 4;
        if (mode == 0) {
            const int row0 = u.pm * BM + wr * 64 + fr; const int col0 = u.pn * BM + wc * 32 + 8 * fq;
#pragma unroll
            for (int ai = 0; ai < 2; ++ai)
#pragma unroll
                for (int m = 0; m < 4; ++m) { bf16_t* rowp = O + (size_t)(row0 + ai * HALF + m * 16) * ldc + col0;
#pragma unroll
                    for (int bj = 0; bj < 2; ++bj) { const f32x4 v0 = acc[ai][bj][m][0], v1 = acc[ai][bj][m][1];
                        u32x4 w; w.x = cvt_pk_bf16(v0[0], v0[1]); w.y = cvt_pk_bf16(v0[2], v0[3]); w.z = cvt_pk_bf16(v1[0], v1[1]); w.w = cvt_pk_bf16(v1[2], v1[3]);
                        *(u32x4*)(rowp + bj * HALF) = w; } }
            return;
        }
        const int chl = wc * 32 + 8 * fq, ch = u.pn * 128 + chl;
        f32x4 wA[3][2], wG[3][2];
#pragma unroll
        for (int t = 0; t < 3; ++t)
#pragma unroll
            for (int n = 0; n < 2; ++n) { wA[t][n] = *(const f32x4*)(cw + t * 5632 + ch + 4 * n); wG[t][n] = *(const f32x4*)(cw + t * 5632 + 2816 + ch + 4 * n); }
#define PG8_EX(blk, fl, bj, n) ex[((((blk) * 2 + (fl)) * 2 + (bj)) * 2 + (n)) * 16 + wc * 4 + fq]
#pragma unroll
        for (int ai = 0; ai < 2; ++ai) { const int blk = ai * 2 + wr;
            const bool lastr = fr == 15;
#pragma unroll
            for (int bj = 0; bj < 2; ++bj)
#pragma unroll
                for (int n = 0; n < 2; ++n) { const f32x4 a0 = acc[ai][bj][0][n], a3 = acc[ai][bj][3][n]; f32x4 v;
#pragma unroll
                    for (int e = 0; e < 4; ++e) v[e] = lastr ? a3[e] : a0[e];
                    if (fr == 0 || lastr) ex[((((blk) * 2 + (lastr ? 1 : 0)) * 2 + bj) * 2 + n) * 16 + wc * 4 + fq] = v; } }
        asm volatile("s_waitcnt lgkmcnt(0)" ::: "memory"); __builtin_amdgcn_s_barrier(); asm volatile("" ::: "memory");
        const f32x4 zero4 = (f32x4){0.f, 0.f, 0.f, 0.f}; const bool is15 = fr == 15, is0 = fr == 0;
#pragma unroll
        for (int ai = 0; ai < 2; ++ai) { const int blk = ai * 2 + wr;
            f32x4 pb[2][2], nb[2][2];
#pragma unroll
            for (int bj = 0; bj < 2; ++bj)
#pragma unroll
                for (int n = 0; n < 2; ++n) { pb[bj][n] = blk > 0 ? PG8_EX(blk - 1, 1, bj, n) : zero4; nb[bj][n] = blk < 3 ? PG8_EX(blk + 1, 0, bj, n) : zero4; }
#pragma unroll
            for (int m = 0; m < 4; ++m) {
                f32x4 cv[2][2];
#pragma unroll
                for (int bj = 0; bj < 2; ++bj)
#pragma unroll
                    for (int n = 0; n < 2; ++n) { const f32x4 cur = acc[ai][bj][m][n];
                        const f32x4 lo = (m == 0) ? pb[bj][n] : acc[ai][bj][m > 0 ? m - 1 : 0][n];
                        const f32x4 hi = (m == 3) ? nb[bj][n] : acc[ai][bj][m < 3 ? m + 1 : 3][n];
                        f32x4 prev, next;
#pragma unroll
                        for (int e = 0; e < 4; ++e) { prev[e] = dpprot<0x121>(is15 ? lo[e] : cur[e]);
                                                      next[e] = dpprot<0x12F>(is0 ? hi[e] : cur[e]); }
                        const f32x4 w0 = bj ? wG[0][n] : wA[0][n], w1 = bj ? wG[1][n] : wA[1][n], w2 = bj ? wG[2][n] : wA[2][n];
                        cv[bj][n] = w0 * prev + w1 * cur + w2 * next; }
                u32x4 w; float g[8];
#pragma unroll
                for (int n = 0; n < 2; ++n)
#pragma unroll
                    for (int e = 0; e < 4; ++e) { const float av = cv[0][n][e]; g[4 * n + e] = av * __builtin_amdgcn_rcpf(1.f + __expf(-av)) * cv[1][n][e]; }
                w.x = cvt_pk_bf16(g[0], g[1]); w.y = cvt_pk_bf16(g[2], g[3]); w.z = cvt_pk_bf16(g[4], g[5]); w.w = cvt_pk_bf16(g[6], g[7]);
                *(u32x4*)(O + (size_t)(u.pm * BM + ai * HALF + wr * 64 + m * 16 + fr) * 2816 + ch) = w;
            } }
#undef PG8_EX
        { const int slot = (wr == 0) ? (fr == 0 ? 0 : (fr == 1 ? 1 : -1)) : (fr == 14 ? 2 : (fr == 15 ? 3 : -1));
          if (slot >= 0) { bf16_t* up = Ue + ((size_t)(u.pm * 4 + slot) * 5632) + u.pn * 256 + chl;
#pragma unroll
              for (int bj = 0; bj < 2; ++bj) { const f32x4 a0 = acc[0][bj][0][0], a1 = acc[0][bj][0][1], b0 = acc[1][bj][3][0], b1 = acc[1][bj][3][1]; f32x4 v0, v1;
#pragma unroll
                  for (int e = 0; e < 4; ++e) { v0[e] = wr ? b0[e] : a0[e]; v1[e] = wr ? b1[e] : a1[e]; }
                  u32x4 w; w.x = cvt_pk_bf16(v0[0], v0[1]); w.y = cvt_pk_bf16(v0[2], v0[3]); w.z = cvt_pk_bf16(v1[0], v1[1]); w.w = cvt_pk_bf16(v1[2], v1[3]);
                  *(u32x4*)(up + bj * HALF) = w; } } }
    }
};
template <class Epi, class Sched, bool ALIGN_EPI = false, bool SP2 = false>
__device__ __forceinline__ void gemm_phase(PG8_LAS unsigned char* lds, const Gemm g, const Sched& S, const Epi& E) {
    const int tid = otid(g.wv), wid = g.wv, lane = tid & 63, wr = wid >> 2, wc = wid & 3, fr = lane & 15, fq = lane >> 4;
    const int K = g.K, nt = K / BK;
    unsigned voffA[2], voffB[2];
#pragma unroll
    for (int i = 0; i < 2; ++i) { int R, C; stage_rc(tid * 16 + i * 8192, R, C); const int Rb = Epi::PERM ? ((R & ~31) + perm32(R & 31)) : R;
        voffA[i] = (unsigned)(R * K + C) * 2u; voffB[i] = (unsigned)(Rb * K + C) * 2u; }
    const size_t kstep = (size_t)(BK * 2);
    const size_t hstep = (size_t)HALF * K * 2;
    const size_t tstep = 2 * hstep;
    const unsigned ldsw = (unsigned)wid * 1024u;
    const int aoff = lds_byte(wr * 64 + fr, fq * 8), boff = lds_byte(wc * 32 + fr, fq * 8);
#define PG8_SA(b, h) (((b) * 2 + (h)) * HTB)
#define PG8_SB(b, h) ((4 + (b) * 2 + (h)) * HTB)
#define PG8_STAGE(bufoff, gbase, voff) do { _Pragma("unroll") for (int _i = 0; _i < 2; ++_i) \
        __builtin_amdgcn_global_load_lds((const unsigned*)((const char*)(gbase) + (voff)[_i]), (PG8_LAS unsigned*)(lds + (bufoff) + ldsw + _i * 8192), 16, 0, 0); } while (0)
#define PG8_LDA(dst, b, h) do { _Pragma("unroll") for (int m = 0; m < 4; ++m) _Pragma("unroll") for (int k = 0; k < 2; ++k) dst[m][k] = *(const PG8_LAS bf16x8*)(lds + PG8_SA(b, h) + aoff + m * 2048 + k * 1024); } while (0)
#define PG8_LDB(dst, b, h) do { _Pragma("unroll") for (int n = 0; n < 2; ++n) _Pragma("unroll") for (int k = 0; k < 2; ++k) dst[n][k] = *(const PG8_LAS bf16x8*)(lds + PG8_SB(b, h) + boff + n * 2048 + k * 1024); } while (0)
#define PG8_MMA(ai, bj, At, Bt) do { __builtin_amdgcn_s_setprio(1); _Pragma("unroll") for (int m = 0; m < 4; ++m) _Pragma("unroll") for (int n = 0; n < 2; ++n) _Pragma("unroll") for (int k = 0; k < 2; ++k) \
        acc[ai][bj][m][n] = __builtin_amdgcn_mfma_f32_16x16x32_bf16(Bt[n][k], At[m][k], acc[ai][bj][m][n], 0, 0, 0); __builtin_amdgcn_s_setprio(0); } while (0)
#define PG8_WAIT_V(n) asm volatile("s_waitcnt vmcnt(" #n ")" ::: "memory")
#define PG8_WAIT_L(n) asm volatile("s_waitcnt lgkmcnt(" #n ")" ::: "memory")
#define PG8_BAR __builtin_amdgcn_s_barrier()
#define PG8_SCHED __builtin_amdgcn_sched_barrier(0)
    Unit cur, nxt; int ui = 0;
#ifdef GDIAG
    unsigned gd0 = 0, gd1 = 0, gd2 = 0; const unsigned gstart = (unsigned)__builtin_amdgcn_s_memtime();
#endif
    if (!S.next(0, cur)) return;
    f32x4 acc[2][2][4][2];
#pragma unroll
    for (int a = 0; a < 2; ++a)
#pragma unroll
        for (int b = 0; b < 2; ++b)
#pragma unroll
            for (int m = 0; m < 4; ++m)
#pragma unroll
                for (int n = 0; n < 2; ++n) acc[a][b][m][n] = (f32x4){0.f, 0.f, 0.f, 0.f};
    bf16x8 At[4][2], B0[2][2], B1[2][2];
    const char* cA = (const char*)g.A + (size_t)cur.pm * tstep; const char* cB = (const char*)g.Bt + (size_t)cur.pn * tstep;
    S.a_ready(cur);
    if constexpr (SP2) {
        PG8_STAGE(PG8_SB(0, 0), cB, voffB); PG8_STAGE(PG8_SB(0, 1), cB + hstep, voffB); PG8_STAGE(PG8_SA(0, 0), cA, voffA); PG8_STAGE(PG8_SA(0, 1), cA + hstep, voffA);
        if (wr == 1) PG8_BAR;
        PG8_WAIT_V(2); PG8_BAR;
        PG8_STAGE(PG8_SB(1, 0), cB + kstep, voffB); PG8_STAGE(PG8_SA(1, 0), cA + kstep, voffA); PG8_STAGE(PG8_SB(1, 1), cB + hstep + kstep, voffB);
        PG8_WAIT_V(6); PG8_BAR;
    } else {
        PG8_STAGE(PG8_SB(0, 0), cB, voffB); PG8_STAGE(PG8_SA(0, 0), cA, voffA); PG8_STAGE(PG8_SB(0, 1), cB + hstep, voffB); PG8_STAGE(PG8_SA(0, 1), cA + hstep, voffA);
        if (wr == 1) PG8_BAR;
        PG8_WAIT_V(4); PG8_BAR;
        PG8_STAGE(PG8_SB(1, 0), cB + kstep, voffB); PG8_STAGE(PG8_SA(1, 0), cA + kstep, voffA); PG8_STAGE(PG8_SB(1, 1), cB + hstep + kstep, voffB);
        PG8_WAIT_V(6); PG8_BAR;
    }
    for (;;) {
        const bool has_next = S.next(ui + 1, nxt);
        const char* nA = has_next ? (const char*)g.A + (size_t)nxt.pm * tstep : cA; const char* nB = has_next ? (const char*)g.Bt + (size_t)nxt.pn * tstep : cB;
#ifdef GDIAG
        unsigned gt0 = (unsigned)__builtin_amdgcn_s_memtime();
#endif
        for (int t = 0; t < nt; t += 2) {
            const bool last = (t == nt - 2);
            const char* a1 = cA + (size_t)(t + 1) * kstep;
            const char* a2 = last ? nA : cA + (size_t)(t + 2) * kstep; const char* b2 = last ? nB : cB + (size_t)(t + 2) * kstep;
            const char* a3 = a2 + kstep; const char* b3 = b2 + kstep;
            if (last && has_next) S.a_ready(nxt);
            if constexpr (SP2) {
            PG8_LDB(B0, 0, 0); PG8_LDB(B1, 0, 1); PG8_SCHED; PG8_LDA(At, 0, 0); PG8_STAGE(PG8_SA(1, 1), a1 + hstep, voffA);
            PG8_WAIT_V(8); PG8_WAIT_L(0); PG8_BAR; PG8_MMA(0, 0, At, B0); PG8_MMA(0, 1, At, B1); PG8_BAR; PG8_SCHED;
            PG8_LDA(At, 0, 1); PG8_STAGE(PG8_SB(0, 0), b2, voffB); PG8_STAGE(PG8_SB(0, 1), b2 + hstep, voffB); PG8_STAGE(PG8_SA(0, 0), a2, voffA);
            PG8_WAIT_V(8); PG8_WAIT_L(0); PG8_BAR; PG8_MMA(1, 0, At, B0); PG8_MMA(1, 1, At, B1); PG8_BAR; PG8_SCHED;
            PG8_LDB(B0, 1, 0); PG8_LDB(B1, 1, 1); PG8_SCHED; PG8_LDA(At, 1, 0); PG8_STAGE(PG8_SA(0, 1), a2 + hstep, voffA);
            PG8_WAIT_V(8); PG8_WAIT_L(0); PG8_BAR; PG8_MMA(0, 0, At, B0); PG8_MMA(0, 1, At, B1); PG8_BAR; PG8_SCHED;
            PG8_LDA(At, 1, 1); PG8_STAGE(PG8_SB(1, 0), b3, voffB); PG8_STAGE(PG8_SB(1, 1), b3 + hstep, voffB); PG8_STAGE(PG8_SA(1, 0), a3, voffA);
            PG8_WAIT_V(8); PG8_WAIT_L(0); PG8_BAR; PG8_MMA(1, 0, At, B0); PG8_MMA(1, 1, At, B1); PG8_BAR; PG8_SCHED;
            } else {
            PG8_LDB(B0, 0, 0); PG8_SCHED; PG8_LDA(At, 0, 0); PG8_STAGE(PG8_SA(1, 1), a1 + hstep, voffA);
            PG8_WAIT_L(8); PG8_BAR; PG8_WAIT_L(0); PG8_MMA(0, 0, At, B0); PG8_BAR; PG8_SCHED;
            PG8_LDB(B1, 0, 1); PG8_STAGE(PG8_SB(0, 0), b2, voffB);
            PG8_BAR; PG8_WAIT_L(0); PG8_MMA(0, 1, At, B1); PG8_BAR;
            PG8_LDA(At, 0, 1); PG8_STAGE(PG8_SA(0, 0), a2, voffA);
            PG8_BAR; PG8_WAIT_L(0); PG8_MMA(1, 0, At, B0); PG8_BAR; PG8_SCHED;
            PG8_STAGE(PG8_SB(0, 1), b2 + hstep, voffB);
            PG8_WAIT_V(6); PG8_BAR; PG8_MMA(1, 1, At, B1); PG8_BAR;
            PG8_LDB(B0, 1, 0); PG8_SCHED; PG8_LDA(At, 1, 0); PG8_STAGE(PG8_SA(0, 1), a2 + hstep, voffA);
            PG8_WAIT_L(8); PG8_BAR; PG8_WAIT_L(0); PG8_MMA(0, 0, At, B0); PG8_BAR; PG8_SCHED;
            PG8_LDB(B1, 1, 1); PG8_STAGE(PG8_SB(1, 0), b3, voffB);
            PG8_BAR; PG8_WAIT_L(0); PG8_MMA(0, 1, At, B1); PG8_BAR;
            PG8_LDA(At, 1, 1); PG8_STAGE(PG8_SA(1, 0), a3, voffA);
            PG8_BAR; PG8_WAIT_L(0); PG8_MMA(1, 0, At, B0); PG8_BAR; PG8_SCHED;
            PG8_STAGE(PG8_SB(1, 1), b3 + hstep, voffB);
            PG8_WAIT_V(6); PG8_BAR; PG8_MMA(1, 1, At, B1); PG8_BAR;
            }
        }
#ifdef GDIAG
        { const unsigned n_ = (unsigned)__builtin_amdgcn_s_memtime(); gd0 += n_ - gt0; gt0 = n_; }
#endif
        if constexpr (ALIGN_EPI) { if (wr == 0) PG8_BAR; }
#ifdef GDIAG
        { const unsigned n_ = (unsigned)__builtin_amdgcn_s_memtime(); gd1 += n_ - gt0; gt0 = n_; }
#endif
        if constexpr (!Epi::AFTER_DRAIN) { E(acc, cur, wr, wc, fr, fq); S.done(cur); }
#ifdef GDIAG
        { const unsigned n_ = (unsigned)__builtin_amdgcn_s_memtime(); gd2 += n_ - gt0; gt0 = n_; }
#endif
        if (!has_next) break;
#pragma unroll
        for (int a = 0; a < 2; ++a)
#pragma unroll
            for (int b = 0; b < 2; ++b)
#pragma unroll
                for (int m = 0; m < 4; ++m)
#pragma unroll
                    for (int n = 0; n < 2; ++n) acc[a][b][m][n] = (f32x4){0.f, 0.f, 0.f, 0.f};
        cur = nxt; cA = nA; cB = nB; ++ui;
        if constexpr (ALIGN_EPI) { if (wr == 1) PG8_BAR; }
    }
#ifdef GDIAG
    if (g.dg && blockIdx.x == 0 && wid == GDIAG_WAVE && lane == 0) { const unsigned tot = (unsigned)__builtin_amdgcn_s_memtime() - gstart; g.dg[0] = (float)gd0; g.dg[1] = (float)gd1; g.dg[2] = (float)gd2; g.dg[3] = (float)tot; }
#endif
    PG8_WAIT_V(0);
    if constexpr (!ALIGN_EPI) { if (wr == 0) PG8_BAR; }
    PG8_BAR;
    if constexpr (Epi::AFTER_DRAIN) { E.fused(acc, cur, wr, wc, fr, fq, lds, wid, lane); S.done(cur); }
#undef PG8_SA
#undef PG8_SB
#undef PG8_STAGE
#undef PG8_LDA
#undef PG8_LDB
#undef PG8_MMA
#undef PG8_WAIT_V
#undef PG8_WAIT_L
#undef PG8_BAR
#undef PG8_SCHED
}
}

typedef unsigned short bf16;
typedef unsigned v4u __attribute__((ext_vector_type(4)));
typedef unsigned v2u __attribute__((ext_vector_type(2)));
typedef float f32x4 __attribute__((ext_vector_type(4)));
constexpr int NWAVES = 8, NTHR = 512;
constexpr int D = 1024, NB = 8, SEQ = 2048, CTXL = 256, TL = NB * SEQ, TC = NB * CTXL, T = TL + TC;
constexpr int HYB_IN = 2208, HYB_INP = 2304, SSD_IN = 5184, SSD_INP = 5376, DFF = 2816, UPW = 5632;
constexpr int QW = 768, KVW = 1024, MODW = 6144;
constexpr float EPS = 1e-6f;
constexpr int NSTEP = 1 + 4 * 10;
constexpr float ATT_SCALE_LOG2E = 0.10206207261596577f * 1.4426950408889634f;

constexpr size_t MiB = 1u << 20;
constexpr size_t WS_CTL = 0, CTL_ZERO_BYTES = 64 * 1024;
constexpr size_t WS_MOD = 1 * MiB;
constexpr size_t WS_ROPE = 2 * MiB;
constexpr size_t W_UP = 3 * MiB;
constexpr size_t W_DN = W_UP + (size_t)UPW * D * 2;
constexpr size_t W_IN = W_DN + (size_t)D * DFF * 2;
constexpr size_t W_OUT = W_IN + (size_t)SSD_INP * D * 2;
constexpr size_t W_UQ = W_OUT + (size_t)D * 2048 * 2;
constexpr size_t W_UKV = W_UQ + (size_t)QW * 384 * 2;
constexpr size_t W_END = W_UKV + (size_t)KVW * 256 * 2;
constexpr size_t WS_XC = 36 * MiB;
constexpr size_t WS_H = 44 * MiB;
constexpr size_t WS_DT = WS_H, WS_AA = WS_H + (size_t)T * 64 * 4;
constexpr size_t WS_BIG = 80 * MiB;
constexpr size_t WS_M = WS_BIG;
constexpr size_t WS_P = WS_BIG;
constexpr size_t WS_Q = WS_BIG + 81 * MiB;
constexpr size_t WS_KV = WS_BIG + 108 * MiB;
constexpr size_t WS_KR = WS_BIG + 144 * MiB;
constexpr size_t WS_CQN = WS_BIG + 146 * MiB;
constexpr size_t WS_CKVN = WS_BIG + 160 * MiB;
constexpr size_t WS_MIX = WS_BIG + 170 * MiB;
constexpr size_t WS_U = WS_BIG;
constexpr size_t WS_G = WS_BIG + 198 * MiB;
constexpr size_t WS_ZX = WS_BIG;
constexpr size_t WS_XBC = WS_BIG + 189 * MiB;
constexpr size_t WS_UE = WS_BIG + 297 * MiB;
constexpr size_t WS_END = WS_UE + 4 * MiB;
static_assert(W_END <= WS_XC && WS_G + (size_t)T * DFF * 2 <= WS_END && WS_XBC + (size_t)T * 3072 * 2 <= WS_END && WS_ZX + (size_t)T * SSD_INP * 2 <= WS_XBC, "ws map");
static_assert(WS_AA + (size_t)T * 64 * 4 <= WS_BIG && WS_MIX + (size_t)T * D * 2 <= WS_END && WS_Q + (size_t)T * QW * 2 <= WS_KV && WS_P + (size_t)T * HYB_INP * 2 <= WS_Q, "ws map 2");
constexpr int LDS_BYTES = 147456;

struct Args { const float* in[25]; float* out; unsigned char* ws; int lo, hi; int wv, pad; };
enum { I_X = 0, I_C, I_CTX, I_CCTX, I_MODW, I_MODB, I_NORMW, I_WUP, I_FCONV, I_WDN, I_HIN, I_QNORM, I_KVNORM, I_WUQ, I_WUKV, I_SCONV, I_HOUT, I_SIN, I_SCONVW, I_SCONVB, I_ALOG, I_DTB, I_SD, I_SNORM, I_SOUT };

__device__ __forceinline__ unsigned f2bf(float f) { unsigned u = __builtin_bit_cast(unsigned, f); return (u + 0x7fffu + ((u >> 16) & 1u)) >> 16; }
__device__ __forceinline__ unsigned pk2(float lo, float hi) { return hw_cvtpk(lo, hi); }
__device__ __forceinline__ float bflo(unsigned u) { return __builtin_bit_cast(float, u << 16); }
__device__ __forceinline__ float bfhi(unsigned u) { return __builtin_bit_cast(float, u & 0xffff0000u); }
__device__ __forceinline__ float bf1(bf16 b) { return __builtin_bit_cast(float, (unsigned)b << 16); }
__device__ __forceinline__ float silu_f(float x) { return x * __builtin_amdgcn_rcpf(1.f + __expf(-x)); }
__device__ __forceinline__ float wave_sum(float v, int lane) {
#pragma unroll
    for (int o = 1; o < 64; o <<= 1) v += shx(v, o, lane);
    return v;
}
__device__ __forceinline__ void unpack8(const v4u w, float (&f)[8]) { f[0] = bflo(w.x); f[1] = bfhi(w.x); f[2] = bflo(w.y); f[3] = bfhi(w.y); f[4] = bflo(w.z); f[5] = bfhi(w.z); f[6] = bflo(w.w); f[7] = bfhi(w.w); }
__device__ __forceinline__ v4u pack8(const float (&f)[8]) { v4u w; w.x = pk2(f[0], f[1]); w.y = pk2(f[2], f[3]); w.z = pk2(f[4], f[5]); w.w = pk2(f[6], f[7]); return w; }
__device__ __forceinline__ bool has_prev(int r) { return r < TL ? (r & (SEQ - 1)) != 0 : ((r - TL) & (CTXL - 1)) != 0; }
__device__ __forceinline__ bool has_next(int r) { return r < TL ? (r & (SEQ - 1)) != SEQ - 1 : ((r - TL) & (CTXL - 1)) != CTXL - 1; }

__device__ __forceinline__ void mod_compute(const Args& a, LAS unsigned char* lds) {
    LAS float* sc = (LAS float*)lds;
    LAS float* red = (LAS float*)(lds + 36864);
    const int tid = otid(a.wv);
    float* MOD = (float*)(a.ws + WS_MOD);
    for (int i = tid; i < 9 * 1024; i += NTHR) { const int c = i >> 10, k = i & 1023; const float v = c < 8 ? a.in[I_C][c * 1024 + k] : a.in[I_CCTX][k]; sc[i] = silu_f(v); }
    __syncthreads();
    for (int item = blockIdx.x; item < 4 * 96; item += gridDim.x) {
        const int l = item / 96, cb = item % 96;
        const float* W = a.in[I_MODW] + (size_t)l * 1024 * MODW + cb * 64;
        const int cgp = tid & 15, kg = tid >> 4;
        float acc[9][4];
#pragma unroll
        for (int c = 0; c < 9; ++c) { acc[c][0] = 0.f; acc[c][1] = 0.f; acc[c][2] = 0.f; acc[c][3] = 0.f; }
#pragma unroll 8
        for (int kk = 0; kk < 32; ++kk) { const int k = kg * 32 + kk; const f32x4 w = *(const f32x4*)(W + (size_t)k * MODW + cgp * 4);
#pragma unroll
            for (int c = 0; c < 9; ++c) { const float s = sc[c * 1024 + k]; acc[c][0] += s * w[0]; acc[c][1] += s * w[1]; acc[c][2] += s * w[2]; acc[c][3] += s * w[3]; } }
#pragma unroll
        for (int c = 0; c < 9; ++c)
#pragma unroll
            for (int j = 0; j < 4; ++j) red[kg * 576 + c * 64 + cgp * 4 + j] = acc[c][j];
        __syncthreads();
        for (int o = tid; o < 576; o += NTHR) { float s = 0.f;
            for (int g = 0; g < 32; ++g) s += red[g * 576 + o];
            const int c = o >> 6, col = o & 63; MOD[(size_t)(l * 9 + c) * MODW + cb * 64 + col] = s + a.in[I_MODB][l * MODW + cb * 64 + col]; }
        __syncthreads();
    }
}
__device__ __forceinline__ void rope_tables(const Args& a) {
    float* ct = (float*)(a.ws + WS_ROPE); float* st = ct + SEQ * 16;
    for (int i = blockIdx.x * NTHR + otid(a.wv); i < SEQ * 16; i += gridDim.x * NTHR) {
        const int t = i >> 4, j = i & 15; const int pos = j < 8 ? (t >> 6) : (t & 63); const int f = j & 7;
        const float i0 = (f & 1) ? 0.31622776601683794f : 1.0f; const int e = f >> 1; const float i1 = e == 0 ? 1.0f : (e == 1 ? 0.1f : (e == 2 ? 0.01f : 0.001f));
        const float inv = i0 * i1; const float ang = (float)pos * inv;
        ct[i] = __cosf(ang); st[i] = __sinf(ang); }
}
__device__ __forceinline__ void transpose_item(const float* W, int K, int N, bf16* WT, LAS float* scr, int item, int lane, bool ffn_perm) {
    const int nblk = N / 32, kb = item / nblk, nb = item % nblk, k0 = 64 * kb, n0 = 32 * nb;
    const int o0 = ffn_perm ? ((n0 % DFF) / 128) * 256 + (n0 / DFF) * 128 + (n0 % 128) : n0;
    float wv_[32];
#pragma unroll
    for (int i = 0; i < 32; ++i) wv_[i] = W[(size_t)(k0 + 2 * i + (lane >> 5)) * N + n0 + (lane & 31)];
#pragma unroll
    for (int i = 0; i < 32; ++i) scr[(2 * i + (lane >> 5)) * 33 + (lane & 31)] = wv_[i];
    asm volatile("s_waitcnt lgkmcnt(0)" ::: "memory");
    const int c = lane & 7;
#pragma unroll
    for (int j = 0; j < 4; ++j) { const int n = (lane >> 3) + 8 * j; const LAS float* s = scr + (8 * c) * 33 + n;
        v4u o; o.x = pk2(s[0 * 33], s[1 * 33]); o.y = pk2(s[2 * 33], s[3 * 33]); o.z = pk2(s[4 * 33], s[5 * 33]); o.w = pk2(s[6 * 33], s[7 * 33]);
        *(v4u*)(WT + (size_t)(o0 + n) * K + k0 + 8 * c) = o; }
    asm volatile("s_waitcnt lgkmcnt(0)" ::: "memory");
}
__device__ __forceinline__ void convert_weight(const float* W, int K, int N, int Npad, bf16* WT, LAS unsigned char* lds, int rot, int wv, bool ffn_perm = false) {
    const int wave = wv, lane = otid(wv) & 63; const int NGW = gridDim.x * NWAVES; const int gw = (blockIdx.x * NWAVES + wave + rot) % NGW;
    LAS float* scr = (LAS float*)(lds + wave * 16384);
    const int nitems = (K / 64) * (N / 32);
    for (int it = gw; it < nitems; it += NGW) transpose_item(W, K, N, WT, scr, it, lane, ffn_perm);
    (void)Npad;
}
__device__ __forceinline__ void convert_layer(const Args& a, int l, LAS unsigned char* lds) {
    const int i = l >> 1; unsigned char* ws = a.ws;
    convert_weight(a.in[I_WUP] + (size_t)l * D * UPW, D, UPW, UPW, (bf16*)(ws + W_UP), lds, 0, a.wv, true);
    convert_weight(a.in[I_WDN] + (size_t)l * DFF * D, DFF, D, D, (bf16*)(ws + W_DN), lds, 300, a.wv);
    if ((l & 1) == 0) {
        convert_weight(a.in[I_HIN] + (size_t)i * D * HYB_IN, D, HYB_IN, HYB_INP, (bf16*)(ws + W_IN), lds, 700, a.wv);
        convert_weight(a.in[I_HOUT] + (size_t)i * D * D, D, D, D, (bf16*)(ws + W_OUT), lds, 1100, a.wv);
        convert_weight(a.in[I_WUQ] + (size_t)i * 384 * QW, 384, QW, QW, (bf16*)(ws + W_UQ), lds, 1500, a.wv);
        convert_weight(a.in[I_WUKV] + (size_t)i * 256 * KVW, 256, KVW, KVW, (bf16*)(ws + W_UKV), lds, 1700, a.wv);
    } else {
        convert_weight(a.in[I_SIN] + (size_t)i * D * SSD_IN, D, SSD_IN, SSD_INP, (bf16*)(ws + W_IN), lds, 700, a.wv);
        convert_weight(a.in[I_SOUT] + (size_t)i * 2048 * D, 2048, D, D, (bf16*)(ws + W_OUT), lds, 1300, a.wv);
    }
}

__device__ __forceinline__ void prep_even(const Args& a, int i) {
    const int wave = otid(a.wv) >> 6, lane = otid(a.wv) & 63; const int NGW = gridDim.x * NWAVES, gw = blockIdx.x * NWAVES + wave;
    const bf16* P = (const bf16*)(a.ws + WS_P); bf16* CQN = (bf16*)(a.ws + WS_CQN); bf16* CKVN = (bf16*)(a.ws + WS_CKVN); bf16* KR = (bf16*)(a.ws + WS_KR); bf16* MIX = (bf16*)(a.ws + WS_MIX);
    const float* qn = a.in[I_QNORM] + i * 384; const float* kvn = a.in[I_KVNORM] + i * 256; const float* cw = a.in[I_SCONV] + i * 3 * 512;
    const float* ct = (const float*)(a.ws + WS_ROPE); const float* st = ct + SEQ * 16;
    for (int r = gw; r < T; r += NGW) {
        const bf16* p = P + (size_t)r * HYB_INP;
        {
            const unsigned* p32 = (const unsigned*)(p + lane * 6); const unsigned w0 = p32[0], w1 = p32[1], w2 = p32[2];
            float f[6] = {bflo(w0), bfhi(w0), bflo(w1), bfhi(w1), bflo(w2), bfhi(w2)}; float ss = 0.f;
#pragma unroll
            for (int j = 0; j < 6; ++j) ss += f[j] * f[j];
            const float rs = rsqrtf(wave_sum(ss, lane) * (1.f / 384.f) + EPS);
#pragma unroll
            for (int j = 0; j < 6; ++j) f[j] = f[j] * rs * qn[lane * 6 + j];
            unsigned* o32 = (unsigned*)(CQN + (size_t)r * 384 + lane * 6); o32[0] = pk2(f[0], f[1]); o32[1] = pk2(f[2], f[3]); o32[2] = pk2(f[4], f[5]);
        }
        {
            const v2u w = *(const v2u*)(p + 384 + lane * 4); float f[4] = {bflo(w.x), bfhi(w.x), bflo(w.y), bfhi(w.y)};
            const float ss = (f[0] * f[0] + f[1] * f[1]) + (f[2] * f[2] + f[3] * f[3]);
            const float rs = rsqrtf(wave_sum(ss, lane) * (1.f / 256.f) + EPS);
            const f32x4 g = *(const f32x4*)(kvn + lane * 4);
            v2u o; o.x = pk2(f[0] * rs * g[0], f[1] * rs * g[1]); o.y = pk2(f[2] * rs * g[2], f[3] * rs * g[3]); *(v2u*)(CKVN + (size_t)r * 256 + lane * 4) = o;
        }
        {
            const int j = lane & 31; const float v = bf1(p[640 + j]); const float o = shx(v, 16, lane); float res = v;
            if (r < TL) { const int t = r & (SEQ - 1); const float c = ct[t * 16 + (j & 15)], s = st[t * 16 + (j & 15)]; res = (j < 16) ? v * c - o * s : o * s + v * c; }
            if (lane < 32) KR[(size_t)r * 32 + j] = (bf16)f2bf(res);
        }
        {
            const int c0 = lane * 8; float gb[8], cur[8], acc[8], t0[8], t1[8];
            unpack8(*(const v4u*)(p + 672 + c0), gb);
            unpack8(*(const v4u*)(p + 1184 + c0), t0); unpack8(*(const v4u*)(p + 1696 + c0), t1);
#pragma unroll
            for (int j = 0; j < 8; ++j) { cur[j] = t0[j] * t1[j]; acc[j] = cw[512 + c0 + j] * cur[j]; }
            if (has_prev(r)) { unpack8(*(const v4u*)(p - HYB_INP + 1184 + c0), t0); unpack8(*(const v4u*)(p - HYB_INP + 1696 + c0), t1);
#pragma unroll
                for (int j = 0; j < 8; ++j) acc[j] += cw[c0 + j] * (t0[j] * t1[j]); }
            if (has_next(r)) { unpack8(*(const v4u*)(p + HYB_INP + 1184 + c0), t0); unpack8(*(const v4u*)(p + HYB_INP + 1696 + c0), t1);
#pragma unroll
                for (int j = 0; j < 8; ++j) acc[j] += cw[1024 + c0 + j] * (t0[j] * t1[j]); }
#pragma unroll
            for (int j = 0; j < 8; ++j) acc[j] *= gb[j];
            *(v4u*)(MIX + (size_t)r * D + 512 + c0) = pack8(acc);
        }
    }
}

__device__ __forceinline__ void convgate(const Args& a, int l, int nrows) {
    const bf16* U = (const bf16*)(a.ws + WS_U); bf16* G = (bf16*)(a.ws + WS_G); const float* cw = a.in[I_FCONV] + (size_t)l * 3 * UPW;
    const int total = nrows * (DFF / 8);
    for (int idx = blockIdx.x * NTHR + otid(a.wv); idx < total; idx += gridDim.x * NTHR) {
        const int r = idx / (DFF / 8), c0 = (idx % (DFF / 8)) * 8; const bf16* u = U + (size_t)r * UPW + c0;
        float ua[8], ug[8], act[8], gate[8];
        unpack8(*(const v4u*)u, ua); unpack8(*(const v4u*)(u + DFF), ug);
#pragma unroll
        for (int j = 0; j < 8; ++j) { act[j] = cw[UPW + c0 + j] * ua[j]; gate[j] = cw[UPW + DFF + c0 + j] * ug[j]; }
        if (has_prev(r)) { unpack8(*(const v4u*)(u - UPW), ua); unpack8(*(const v4u*)(u - UPW + DFF), ug);
#pragma unroll
            for (int j = 0; j < 8; ++j) { act[j] += cw[c0 + j] * ua[j]; gate[j] += cw[DFF + c0 + j] * ug[j]; } }
        if (has_next(r)) { unpack8(*(const v4u*)(u + UPW), ua); unpack8(*(const v4u*)(u + UPW + DFF), ug);
#pragma unroll
            for (int j = 0; j < 8; ++j) { act[j] += cw[2 * UPW + c0 + j] * ua[j]; gate[j] += cw[2 * UPW + DFF + c0 + j] * ug[j]; } }
#pragma unroll
        for (int j = 0; j < 8; ++j) act[j] = silu_f(act[j]) * gate[j];
        *(v4u*)(G + (size_t)r * DFF + c0) = pack8(act);
    }
}

__device__ __forceinline__ void ssd_conv(const Args& a, int i) {
    const bf16* ZX = (const bf16*)(a.ws + WS_ZX); bf16* XBC = (bf16*)(a.ws + WS_XBC); float* DT = (float*)(a.ws + WS_DT); float* AA = (float*)(a.ws + WS_AA);
    const float* cw = a.in[I_SCONVW] + (size_t)i * 3 * 3072; const float* cb = a.in[I_SCONVB] + (size_t)i * 3072;
    const int total = T * 384;
    for (int idx = blockIdx.x * NTHR + otid(a.wv); idx < total; idx += gridDim.x * NTHR) {
        const int r = idx / 384, c0 = (idx % 384) * 8; const bf16* u = ZX + (size_t)r * SSD_INP + 2048 + c0;
        float x[8], acc[8];
        unpack8(*(const v4u*)u, x);
#pragma unroll
        for (int j = 0; j < 8; ++j) acc[j] = cb[c0 + j] + cw[3072 + c0 + j] * x[j];
        if (has_prev(r)) { unpack8(*(const v4u*)(u - SSD_INP), x);
#pragma unroll
            for (int j = 0; j < 8; ++j) acc[j] += cw[c0 + j] * x[j]; }
        if (has_next(r)) { unpack8(*(const v4u*)(u + SSD_INP), x);
#pragma unroll
            for (int j = 0; j < 8; ++j) acc[j] += cw[2 * 3072 + c0 + j] * x[j]; }
#pragma unroll
        for (int j = 0; j < 8; ++j) acc[j] = silu_f(acc[j]);
        *(v4u*)(XBC + (size_t)r * 3072 + c0) = pack8(acc);
    }
    const float* alog = a.in[I_ALOG] + i * 64; const float* dtb = a.in[I_DTB] + i * 64;
    for (int idx = blockIdx.x * NTHR + otid(a.wv); idx < T * 64; idx += gridDim.x * NTHR) {
        const int r = idx >> 6, j = idx & 63; const float raw = bf1(ZX[(size_t)r * SSD_INP + 5120 + j]) + dtb[j];
        const float dt = raw > 15.f ? raw : (raw < -15.f ? __expf(raw) : __logf(1.f + __expf(raw)));
        DT[idx] = dt; AA[idx] = -__expf(alog[j]) * dt;
    }
}

__device__ __forceinline__ void gatenorm(const Args& a, int i, int nrows) {
    const int wave = otid(a.wv) >> 6, lane = otid(a.wv) & 63; const int NGW = gridDim.x * NWAVES, gw = blockIdx.x * NWAVES + wave;
    const bf16* ZX = (const bf16*)(a.ws + WS_ZX); bf16* YN = (bf16*)(a.ws + WS_XBC); const float* nw = a.in[I_SNORM] + i * 2048;
    for (int r = gw; r < nrows; r += NGW) {
        float v[4][8]; float ss = 0.f;
#pragma unroll
        for (int j = 0; j < 4; ++j) { float y[8], z[8]; const int c = j * 512 + lane * 8;
            unpack8(*(const v4u*)(ZX + (size_t)r * SSD_INP + 2048 + c), y); unpack8(*(const v4u*)(ZX + (size_t)r * SSD_INP + c), z);
#pragma unroll
            for (int k = 0; k < 8; ++k) { v[j][k] = y[k] * silu_f(z[k]); ss += v[j][k] * v[j][k]; } }
        const float rs = rsqrtf(wave_sum(ss, lane) * (1.f / 2048.f) + EPS);
#pragma unroll
        for (int j = 0; j < 4; ++j) { const int c = j * 512 + lane * 8; float o[8];
#pragma unroll
            for (int k = 0; k < 8; ++k) o[k] = v[j][k] * rs * nw[c + k];
            *(v4u*)(YN + (size_t)r * 2048 + c) = pack8(o); }
    }
}

__device__ __forceinline__ void attn_naive(const Args& a, LAS unsigned char* lds) {
    const int tid = otid(a.wv), qi = tid >> 1, half = tid & 1;
    const bf16* Qb = (const bf16*)(a.ws + WS_Q); const bf16* KVb = (const bf16*)(a.ws + WS_KV); const bf16* KR = (const bf16*)(a.ws + WS_KR); bf16* MIX = (bf16*)(a.ws + WS_MIX);
    const float* ct = (const float*)(a.ws + WS_ROPE); const float* st = ct + SEQ * 16;
    LAS float* Kt = (LAS float*)lds;
    LAS float* Vt = (LAS float*)(lds + 64 * 96 * 4);
    for (int u = blockIdx.x; u < 576; u += gridDim.x) {
        const bool lat = u < 512; const int b = lat ? (u >> 6) : ((u - 512) >> 3), h = lat ? ((u >> 3) & 7) : ((u - 512) & 7);
        const int nkeys = lat ? (CTXL + SEQ) : CTXL;
        const int qrow = lat ? b * SEQ + (u & 7) * 256 + qi : TL + b * CTXL + qi;
        float q[48];
#pragma unroll
        for (int g = 0; g < 6; ++g) { float f[8]; unpack8(*(const v4u*)(Qb + (size_t)qrow * QW + h * 96 + half * 48 + g * 8), f);
#pragma unroll
            for (int j = 0; j < 8; ++j) q[g * 8 + j] = f[j]; }
        if (lat && half == 1) { const int t = qrow & (SEQ - 1);
#pragma unroll
            for (int j = 0; j < 16; ++j) { const float c = ct[t * 16 + j], s = st[t * 16 + j]; const float x1 = q[16 + j], x2 = q[32 + j]; q[16 + j] = x1 * c - x2 * s; q[32 + j] = x1 * s + x2 * c; } }
#pragma unroll
        for (int j = 0; j < 48; ++j) q[j] *= ATT_SCALE_LOG2E;
        float o[32]; float m = -1e30f, l = 0.f;
#pragma unroll
        for (int j = 0; j < 32; ++j) o[j] = 0.f;
        for (int k0 = 0; k0 < nkeys; k0 += 64) {
            __syncthreads();
            for (int g = tid; g < 768; g += NTHR) { const int key = g / 12, part = g % 12; const int kk = k0 + key; const int krow = kk < CTXL ? TL + b * CTXL + kk : b * SEQ + kk - CTXL;
                float f[8]; unpack8(part < 8 ? *(const v4u*)(KVb + (size_t)krow * KVW + h * 128 + part * 8) : *(const v4u*)(KR + (size_t)krow * 32 + (part - 8) * 8), f);
#pragma unroll
                for (int j = 0; j < 8; ++j) Kt[key * 96 + part * 8 + j] = f[j]; }
            { const int key = tid >> 3, part = tid & 7; const int kk = k0 + key; const int krow = kk < CTXL ? TL + b * CTXL + kk : b * SEQ + kk - CTXL;
                float f[8]; unpack8(*(const v4u*)(KVb + (size_t)krow * KVW + h * 128 + 64 + part * 8), f);
#pragma unroll
                for (int j = 0; j < 8; ++j) Vt[key * 64 + part * 8 + j] = f[j]; }
            __syncthreads();
            for (int kg = 0; kg < 64; kg += 8) {
                float s[8]; float gm = -1e30f;
#pragma unroll
                for (int kk = 0; kk < 8; ++kk) { float acc = 0.f; const LAS f32x4* kp = (const LAS f32x4*)(Kt + (kg + kk) * 96 + half * 48);
#pragma unroll
                    for (int d4 = 0; d4 < 12; ++d4) { const f32x4 kv = kp[d4]; acc += q[d4 * 4] * kv[0] + q[d4 * 4 + 1] * kv[1] + q[d4 * 4 + 2] * kv[2] + q[d4 * 4 + 3] * kv[3]; }
                    acc += shx(acc, 1, tid & 63);
                    s[kk] = acc; gm = fmaxf(gm, acc); }
                const float mn = fmaxf(m, gm); const float alpha = exp2f(m - mn); m = mn; l *= alpha;
#pragma unroll
                for (int j = 0; j < 32; ++j) o[j] *= alpha;
#pragma unroll
                for (int kk = 0; kk < 8; ++kk) { const float p = exp2f(s[kk] - mn); l += p; const LAS f32x4* vp = (const LAS f32x4*)(Vt + (kg + kk) * 64 + half * 32);
#pragma unroll
                    for (int d4 = 0; d4 < 8; ++d4) { const f32x4 vv = vp[d4]; o[d4 * 4] += p * vv[0]; o[d4 * 4 + 1] += p * vv[1]; o[d4 * 4 + 2] += p * vv[2]; o[d4 * 4 + 3] += p * vv[3]; } }
            }
        }
        { const float inv = 1.f / l;
#pragma unroll
            for (int g = 0; g < 4; ++g) { float f[8];
#pragma unroll
                for (int j = 0; j < 8; ++j) f[j] = o[g * 8 + j] * inv;
                *(v4u*)(MIX + (size_t)qrow * D + h * 64 + half * 32 + g * 8) = pack8(f); } }
    }
}

__device__ __forceinline__ void ssd_scan_naive(const Args& a, int i, bool last, LAS unsigned char* lds) {
    const int tid = otid(a.wv), p = tid >> 3, nq = tid & 7;
    bf16* ZX = (bf16*)(a.ws + WS_ZX); const bf16* XBC = (const bf16*)(a.ws + WS_XBC); const float* DT = (const float*)(a.ws + WS_DT); const float* AA = (const float*)(a.ws + WS_AA);
    LAS float* xs = (LAS float*)lds;
    LAS float* Bs = (LAS float*)(lds + 16384);
    LAS float* Cs = (LAS float*)(lds + 16384 + 32768);
    LAS float* dts = (LAS float*)(lds + 16384 + 65536);
    LAS float* as = dts + 64;
    for (int it = blockIdx.x; it < NB * 32; it += gridDim.x) {
        const int b = it >> 5, h = it & 31, g = h >> 3; const float dsk = a.in[I_SD][i * 32 + h];
        for (int dir = 0; dir < 2; ++dir) {
            float stt[16];
#pragma unroll
            for (int n = 0; n < 16; ++n) stt[n] = 0.f;
            for (int seg = 0; seg < 2; ++seg) {
                const int len = seg == 0 ? CTXL : SEQ; const int base = seg == 0 ? TL + b * CTXL : b * SEQ; const bool want_y = !(last && seg == 0);
                for (int cc = 0; cc < len / 64; ++cc) {
                    const int t0 = dir == 0 ? cc * 64 : len - 64 - cc * 64;
                    __syncthreads();
                    { const int tt = tid >> 3, part = tid & 7; float f[8]; unpack8(*(const v4u*)(XBC + (size_t)(base + t0 + tt) * 3072 + h * 64 + part * 8), f);
#pragma unroll
                        for (int j = 0; j < 8; ++j) xs[tt * 64 + part * 8 + j] = f[j]; }
                    for (int q = tid; q < 1024; q += NTHR) { const int tt = q >> 4, part = q & 15; float f[8];
                        unpack8(*(const v4u*)(XBC + (size_t)(base + t0 + tt) * 3072 + 2048 + g * 128 + part * 8), f);
#pragma unroll
                        for (int j = 0; j < 8; ++j) Bs[tt * 128 + part * 8 + j] = f[j];
                        unpack8(*(const v4u*)(XBC + (size_t)(base + t0 + tt) * 3072 + 2560 + g * 128 + part * 8), f);
#pragma unroll
                        for (int j = 0; j < 8; ++j) Cs[tt * 128 + part * 8 + j] = f[j]; }
                    if (tid < 64) { dts[tid] = DT[(size_t)(base + t0 + tid) * 64 + dir * 32 + h]; as[tid] = AA[(size_t)(base + t0 + tid) * 64 + dir * 32 + h]; }
                    __syncthreads();
                    for (int s = 0; s < 64; ++s) {
                        const int tt = dir == 0 ? s : 63 - s;
                        const float dec = __expf(as[tt]); const float xv = xs[tt * 64 + p]; const float xd = xv * dts[tt];
                        const LAS f32x4* bp = (const LAS f32x4*)(Bs + tt * 128 + nq * 16); const LAS f32x4* cp = (const LAS f32x4*)(Cs + tt * 128 + nq * 16);
                        float acc = 0.f;
#pragma unroll
                        for (int n4 = 0; n4 < 4; ++n4) { const f32x4 bv = bp[n4], cv = cp[n4];
#pragma unroll
                            for (int k = 0; k < 4; ++k) { stt[n4 * 4 + k] = dec * stt[n4 * 4 + k] + xd * bv[k]; acc += cv[k] * stt[n4 * 4 + k]; } }
                        acc += shx(acc, 1, tid & 63); acc += shx(acc, 2, tid & 63); acc += shx(acc, 4, tid & 63);
                        if (want_y && nq == 0) { bf16* yp = ZX + (size_t)(base + t0 + tt) * SSD_INP + 2048 + h * 64 + p;
                            const float y = dir == 0 ? acc + dsk * xv : acc + bf1(*yp);
                            *yp = (bf16)f2bf(y); }
                    }
                }
            }
            __syncthreads();
            asm volatile("s_waitcnt vmcnt(0)" ::: "memory");
        }
    }
}

typedef short bf16x8 __attribute__((ext_vector_type(8)));
typedef float f32x16 __attribute__((ext_vector_type(16)));
typedef short v4i16_t __attribute__((ext_vector_type(4)));
__device__ __forceinline__ v2u trread(const LAS unsigned char* p) { return __builtin_bit_cast(v2u, __builtin_amdgcn_ds_read_tr16_b64_v4i16((LAS v4i16_t*)p)); }
__device__ __forceinline__ unsigned cvtpk(float lo, float hi) { return hw_cvtpk(lo, hi); }
constexpr int ATT_KP = 208, ATT_VP = 192, ATT_KB = 64 * ATT_KP, ATT_VB = 64 * ATT_VP, ATT_BUF = ATT_KB + ATT_VB;
#ifndef ATT_NQ
#define ATT_NQ 2
#endif
#ifndef ATT_LAZY
#define ATT_LAZY 8
#endif
template <int NQ>
__device__ __forceinline__ void attn_unit3(const Args& a, LAS unsigned char* lds, const int b, const int h, const int q0, const int ntiles, const bool lat) {
    const int tid = otid(a.wv), wave = a.wv, lane = tid & 63, r32 = lane & 31, hh = lane >> 5;
    const int tq = (lane >> 2) & 3, tp = lane & 3, tblk = (lane >> 4) & 1;
    const bf16* Qb = (const bf16*)(a.ws + WS_Q); const bf16* KVb = (const bf16*)(a.ws + WS_KV); const bf16* KR = (const bf16*)(a.ws + WS_KR); bf16* MIX = (bf16*)(a.ws + WS_MIX);
    const float* ct = (const float*)(a.ws + WS_ROPE); const float* st = ct + SEQ * 16;
    bf16x8 qf[NQ][6];
#pragma unroll
    for (int nq = 0; nq < NQ; ++nq) { const int qrow = q0 + wave * (32 * NQ) + nq * 32 + r32;
#pragma unroll
        for (int s = 0; s < 6; ++s) qf[nq][s] = *(const bf16x8*)(Qb + (size_t)qrow * QW + h * 96 + 16 * s + 8 * hh);
        if (lat) { const int t = qrow & (SEQ - 1);
#pragma unroll
            for (int j = 0; j < 8; j += 2) { float x1[2], x2[2], y1[2], y2[2];
#pragma unroll
                for (int e = 0; e < 2; ++e) { x1[e] = bf1((bf16)qf[nq][4][j + e]); x2[e] = bf1((bf16)qf[nq][5][j + e]); const float c = ct[t * 16 + 8 * hh + j + e], s = st[t * 16 + 8 * hh + j + e];
                    y1[e] = x1[e] * c - x2[e] * s; y2[e] = x1[e] * s + x2[e] * c; }
                const unsigned w1 = pk2(y1[0], y1[1]), w2 = pk2(y2[0], y2[1]);
                qf[nq][4][j] = (short)(w1 & 0xffff); qf[nq][4][j + 1] = (short)(w1 >> 16); qf[nq][5][j] = (short)(w2 & 0xffff); qf[nq][5][j + 1] = (short)(w2 >> 16); } } }
    f32x16 o0[NQ], o1[NQ]; float m[NQ], l[NQ];
#pragma unroll
    for (int nq = 0; nq < NQ; ++nq) { m[nq] = -1e30f; l[nq] = 0.f;
#pragma unroll
        for (int i = 0; i < 16; ++i) { o0[nq][i] = 0.f; o1[nq][i] = 0.f; } }
    v4u kreg0, kreg1, vreg;
#define ATT_LOAD(it) do { const int rb_ = (it) < CTXL / 64 ? TL + b * CTXL + (it) * 64 : b * SEQ + ((it) - CTXL / 64) * 64; \
        const char* kvb_ = (const char*)(KVb + (size_t)rb_ * KVW); const char* krb_ = (const char*)(KR + (size_t)rb_ * 32); \
        kreg0 = *(const v4u*)(kvb_ + (tid >> 3) * 2048 + h * 256 + (tid & 7) * 16); if (tid < 256) kreg1 = *(const v4u*)(krb_ + (tid >> 2) * 64 + (tid & 3) * 16); vreg = *(const v4u*)(kvb_ + (tid >> 3) * 2048 + h * 256 + 128 + (tid & 7) * 16); } while (0)
#define ATT_WRITE(buf) do { LAS unsigned char* kb_ = lds + (buf) * ATT_BUF; LAS unsigned char* vb_ = kb_ + ATT_KB; \
        *(LAS v4u*)(kb_ + (tid >> 3) * ATT_KP + (tid & 7) * 16) = kreg0; if (tid < 256) *(LAS v4u*)(kb_ + (tid >> 2) * ATT_KP + 128 + (tid & 3) * 16) = kreg1; \
        *(LAS v4u*)(vb_ + (tid >> 3) * ATT_VP + (tid & 7) * 16) = vreg; } while (0)
    __syncthreads();
    ATT_LOAD(0); ATT_WRITE(0);
    __syncthreads();
    for (int it = 0; it < ntiles; ++it) {
#ifdef ATT_JITTER
        if (wave == ((it * 5 + (int)blockIdx.x) & 7)) __builtin_amdgcn_s_sleep(100);
#endif
#ifndef ATT_LOADMID
        if (it + 1 < ntiles) ATT_LOAD(it + 1);
#endif
#ifdef ATT_TZ
        int tz = tid; asm volatile("" : "+v"(tz));
        const int lane = tz & 63, r32 = lane & 31, hh = lane >> 5, tq = (lane >> 2) & 3, tp = lane & 3, tblk = (lane >> 4) & 1;
#endif
        const LAS unsigned char* kb = lds + (it & 1) * ATT_BUF; const LAS unsigned char* vb = kb + ATT_KB;
#pragma unroll
        for (int t = 0; t < 2; ++t) {
            f32x16 sc[NQ]; bf16x8 pf[NQ][2];
#pragma unroll
            for (int nq = 0; nq < NQ; ++nq)
#pragma unroll
                for (int i = 0; i < 16; ++i) sc[nq][i] = 0.f;
            bf16x8 kf[6];
#pragma unroll
            for (int s = 0; s < 6; ++s) kf[s] = *(const LAS bf16x8*)(kb + (32 * t + r32) * ATT_KP + (16 * s + 8 * hh) * 2);
            asm volatile("" : "+v"(kf[0]), "+v"(kf[1]), "+v"(kf[2]), "+v"(kf[3]), "+v"(kf[4]), "+v"(kf[5]));
#pragma unroll
            for (int s = 0; s < 6; ++s)
#pragma unroll
                for (int nq = 0; nq < NQ; ++nq) sc[nq] = __builtin_amdgcn_mfma_f32_32x32x16_bf16(kf[s], qf[nq][s], sc[nq], 0, 0, 0);
#ifdef ATT_LOADMID
            if (t == 0 && it + 1 < ntiles) ATT_LOAD(it + 1);
#endif
#pragma unroll
            for (int nq = 0; nq < NQ; ++nq) {
                float mx = sc[nq][0];
#pragma unroll
                for (int i = 1; i < 16; ++i) mx = fmaxf(mx, sc[nq][i]);
                mx = fmaxf(mx, shx(mx, 32, lane));
#ifdef ATT_LAZY
                const float mxs = mx * ATT_SCALE_LOG2E;
                if (__builtin_amdgcn_ballot_w64(mxs > m[nq] + (float)ATT_LAZY) != 0ull) {
                    const float mn = fmaxf(m[nq], mxs); const float alpha = __builtin_amdgcn_exp2f(m[nq] - mn); m[nq] = mn; l[nq] *= alpha;
#pragma unroll
                    for (int i = 0; i < 16; ++i) { o0[nq][i] *= alpha; o1[nq][i] *= alpha; } }
                { const float mn = m[nq]; float rs = 0.f;
#pragma unroll
                  for (int i = 0; i < 16; ++i) { sc[nq][i] = __builtin_amdgcn_exp2f(sc[nq][i] * ATT_SCALE_LOG2E - mn); rs += sc[nq][i]; }
                  l[nq] += rs; }
#else
                const float mn = fmaxf(m[nq], mx * ATT_SCALE_LOG2E); const float alpha = __builtin_amdgcn_exp2f(m[nq] - mn); m[nq] = mn;
                float rs = 0.f;
#pragma unroll
                for (int i = 0; i < 16; ++i) { sc[nq][i] = __builtin_amdgcn_exp2f(sc[nq][i] * ATT_SCALE_LOG2E - mn); rs += sc[nq][i]; }
                l[nq] = l[nq] * alpha + rs;
#ifdef ATT_SKIPRS
                if (__builtin_amdgcn_ballot_w64(alpha != 1.0f) != 0ull)
#endif
                {
#pragma unroll
                    for (int i = 0; i < 16; ++i) { o0[nq][i] *= alpha; o1[nq][i] *= alpha; } }
#endif
#pragma unroll
                for (int s2 = 0; s2 < 2; ++s2) { v4u w0;
                    w0.x = cvtpk(sc[nq][8 * s2 + 0], sc[nq][8 * s2 + 1]); w0.y = cvtpk(sc[nq][8 * s2 + 2], sc[nq][8 * s2 + 3]); w0.z = cvtpk(sc[nq][8 * s2 + 4], sc[nq][8 * s2 + 5]); w0.w = cvtpk(sc[nq][8 * s2 + 6], sc[nq][8 * s2 + 7]);
                    pf[nq][s2] = __builtin_bit_cast(bf16x8, w0); }
            }
#pragma unroll
            for (int s2 = 0; s2 < 2; ++s2) { const int ko = t * 32 + 16 * s2 + 4 * hh;
                { const LAS unsigned char* tb = vb + (ko + tq) * ATT_VP + (16 * tblk + 4 * tp) * 2; const v2u lo = trread(tb), hi = trread(tb + 8 * ATT_VP); const bf16x8 vf = __builtin_bit_cast(bf16x8, (v4u){lo.x, lo.y, hi.x, hi.y});
#pragma unroll
                  for (int nq = 0; nq < NQ; ++nq) o0[nq] = __builtin_amdgcn_mfma_f32_32x32x16_bf16(vf, pf[nq][s2], o0[nq], 0, 0, 0); }
                { const LAS unsigned char* tb = vb + (ko + tq) * ATT_VP + (32 + 16 * tblk + 4 * tp) * 2; const v2u lo = trread(tb), hi = trread(tb + 8 * ATT_VP); const bf16x8 vf = __builtin_bit_cast(bf16x8, (v4u){lo.x, lo.y, hi.x, hi.y});
#pragma unroll
                  for (int nq = 0; nq < NQ; ++nq) o1[nq] = __builtin_amdgcn_mfma_f32_32x32x16_bf16(vf, pf[nq][s2], o1[nq], 0, 0, 0); } }
        }
        if (it + 1 < ntiles) ATT_WRITE((it + 1) & 1);
        __syncthreads();
    }
#undef ATT_LOAD
#undef ATT_WRITE
#pragma unroll
    for (int nq = 0; nq < NQ; ++nq) { const int qrow = q0 + wave * (32 * NQ) + nq * 32 + r32;
        const float lsum = l[nq] + shx(l[nq], 32, lane); const float inv = 1.f / lsum;
        bf16* orow = MIX + (size_t)qrow * D + h * 64 + 4 * hh;
#pragma unroll
        for (int g = 0; g < 4; ++g) {
            v2u w; w.x = pk2(o0[nq][4 * g] * inv, o0[nq][4 * g + 1] * inv); w.y = pk2(o0[nq][4 * g + 2] * inv, o0[nq][4 * g + 3] * inv); *(v2u*)(orow + 8 * g) = w;
            v2u x; x.x = pk2(o1[nq][4 * g] * inv, o1[nq][4 * g + 1] * inv); x.y = pk2(o1[nq][4 * g + 2] * inv, o1[nq][4 * g + 3] * inv); *(v2u*)(orow + 32 + 8 * g) = x; } }
}
__device__ __forceinline__ void attn_mfma(const Args& a, LAS unsigned char* lds) {
#if ATT_NQ == 2
    for (int u = blockIdx.x; u < 256; u += gridDim.x) attn_unit3<2>(a, lds, u >> 5, (u >> 2) & 7, (u >> 5) * SEQ + (u & 3) * 512, (CTXL + SEQ) / 64, true);
#else
    for (int u = blockIdx.x; u < 512; u += gridDim.x) attn_unit3<1>(a, lds, u >> 6, (u >> 3) & 7, (u >> 6) * SEQ + (u & 7) * 256, (CTXL + SEQ) / 64, true);
#endif
    for (int u = blockIdx.x; u < 64; u += gridDim.x) attn_unit3<1>(a, lds, u >> 3, u & 7, TL + (u >> 3) * CTXL, CTXL / 64, false);
}

#ifndef SSD_YREP
#define SSD_YREP 1
#endif
#ifndef SSD_WREP
#define SSD_WREP 1
#endif
constexpr int SP_B = 272, SP_X = 192;
constexpr int SO_B = 0, SO_C = SO_B + 128 * SP_B, SO_XD = SO_C + 128 * SP_B, SO_XW = SO_XD + 128 * SP_X, SO_S = SO_XW + 128 * SP_X, SO_V = SO_S + 64 * SP_B;
static_assert(SO_V + 2 * 2048 <= LDS_BYTES, "ssd lds map");
#ifdef SSD_DIAG
#define SSD_T(v) long long v = clock64()
#define SSD_ACC(k, v) do { const long long n_ = clock64(); dacc[k] += n_ - v; v = n_; } while (0)
#else
#define SSD_T(v) do {} while (0)
#define SSD_ACC(k, v) do {} while (0)
#endif
__device__ __forceinline__ void ssd_scan_mfma(const Args& a, int i, bool last, LAS unsigned char* lds) {
#ifdef SSD_DIAG
    long long dacc[12] = {0, 0, 0, 0, 0, 0, 0, 0, 0, 0, 0, 0};
#endif
    const int tid = otid(a.wv), wave = a.wv, lane = tid & 63, r32 = lane & 31, hh = lane >> 5;
    const int pt = wave >> 2, lt = pt ? 3 - (wave & 3) : (wave & 3);
    const int tq = (lane >> 2) & 3, tp = lane & 3, tblk = (lane >> 4) & 1;
    bf16* ZX = (bf16*)(a.ws + WS_ZX); const bf16* XBC = (const bf16*)(a.ws + WS_XBC); const float* DT = (const float*)(a.ws + WS_DT); const float* AA = (const float*)(a.ws + WS_AA);
    LAS unsigned char* Bl = lds + SO_B; LAS unsigned char* Cl = lds + SO_C; LAS unsigned char* XDl = lds + SO_XD; LAS unsigned char* XWl = lds + SO_XW; LAS unsigned char* Sl = lds + SO_S;
    const int brow = tid >> 4, bpart = tid & 15, xrow = tid >> 3, xpart = tid & 7;
    for (int it = blockIdx.x; it < NB * 32; it += gridDim.x) {
        const int b = it >> 5, h = it & 31, g = h >> 3; const float dsk = a.in[I_SD][i * 32 + h];
        for (int dir = 0; dir < 2; ++dir) {
            const int scanw = dir == 0 ? 0 : 3;
            f32x16 sacc;
#pragma unroll
            for (int k = 0; k < 16; ++k) sacc[k] = 0.f;
            SSD_T(tprev);
            v4u bq[4], cq[4], xq[2]; float pa0 = 0.f, pa1 = 0.f, pd0 = 0.f, pd1 = 0.f, qa0 = 0.f, qa1 = 0.f, qd0 = 0.f, qd1 = 0.f; v2u add[4];
#define SSD_ROWBASE(c) ((c) < 2 ? TL + b * CTXL + (dir == 0 ? (c) : 1 - (c)) * 128 : b * SEQ + (dir == 0 ? (c) - 2 : 17 - (c)) * 128)
#define SSD_PFB(c) do { const int rb_ = SSD_ROWBASE(c); _Pragma("unroll") for (int k_ = 0; k_ < 4; ++k_) bq[k_] = *(const v4u*)(XBC + (size_t)(rb_ + brow + 32 * k_) * 3072 + 2048 + g * 128 + bpart * 8); } while (0)
#define SSD_PFC(c) do { const int rb_ = SSD_ROWBASE(c); _Pragma("unroll") for (int k_ = 0; k_ < 4; ++k_) cq[k_] = *(const v4u*)(XBC + (size_t)(rb_ + brow + 32 * k_) * 3072 + 2560 + g * 128 + bpart * 8); } while (0)
#define SSD_PFX(c) do { const int rb_ = SSD_ROWBASE(c); _Pragma("unroll") for (int k_ = 0; k_ < 2; ++k_) xq[k_] = *(const v4u*)(XBC + (size_t)(rb_ + xrow + 64 * k_) * 3072 + h * 64 + xpart * 8); } while (0)
#define SSD_PF(c) do { SSD_PFB(c); SSD_PFC(c); SSD_PFX(c); } while (0)
#define SSD_PFV(c) do { if (wave == scanw) { const int rb_ = SSD_ROWBASE(c); const size_t o_ = (size_t)(rb_ + 2 * lane) * 64 + dir * 32 + h; qa0 = AA[o_]; qa1 = AA[o_ + 64]; qd0 = DT[o_]; qd1 = DT[o_ + 64]; } } while (0)
#define SSD_PFY(c) do { const int rb_ = SSD_ROWBASE(c); const size_t r_ = (size_t)(rb_ + 32 * lt + r32); \
                _Pragma("unroll") for (int q_ = 0; q_ < 4; ++q_) add[q_] = dir == 0 ? *(const v2u*)(XBC + r_ * 3072 + h * 64 + 32 * pt + 4 * hh + 8 * q_) : *(const v2u*)(ZX + r_ * SSD_INP + 2048 + h * 64 + 32 * pt + 4 * hh + 8 * q_); } while (0)
#define SSD_SCAN(vb_) do { if (wave == scanw) { LAS float* V_ = (LAS float*)(lds + SO_V + (vb_) * 2048); const float pair_ = pa0 + pa1; float ps_ = pair_; \
                _Pragma("unroll") for (int d_ = 1; d_ < 64; d_ <<= 1) { const int src_ = dir == 0 ? lane - d_ : lane + d_; const float t_ = __builtin_bit_cast(float, __builtin_amdgcn_ds_bpermute((src_ & 63) << 2, __builtin_bit_cast(int, ps_))); if (src_ >= 0 && src_ < 64) ps_ += t_; } \
                const float tot_ = __builtin_bit_cast(float, __builtin_amdgcn_ds_bpermute((dir == 0 ? 63 : 0) << 2, __builtin_bit_cast(int, ps_))); const float ex_ = ps_ - pair_; \
                float c0_, c1_; if (dir == 0) { c0_ = ex_ + pa0; c1_ = c0_ + pa1; } else { c1_ = ex_ + pa1; c0_ = c1_ + pa0; } \
                V_[2 * lane] = c0_; V_[2 * lane + 1] = c1_; V_[128 + 2 * lane] = pd0; V_[128 + 2 * lane + 1] = pd1; V_[256 + 2 * lane] = pd0 * __expf(tot_ - c0_); V_[256 + 2 * lane + 1] = pd1 * __expf(tot_ - c1_); \
                if (lane == 0) V_[384] = tot_; } } while (0)
#define SSD_WRITE(vb_) do { const LAS float* V_ = (const LAS float*)(lds + SO_V + (vb_) * 2048); \
                _Pragma("unroll") for (int k_ = 0; k_ < 4; ++k_) { *(LAS v4u*)(Bl + (brow + 32 * k_) * SP_B + bpart * 16) = bq[k_]; *(LAS v4u*)(Cl + (brow + 32 * k_) * SP_B + bpart * 16) = cq[k_]; } \
                _Pragma("unroll") for (int k_ = 0; k_ < 2; ++k_) { const int s_ = xrow + 64 * k_; const float dt_ = V_[128 + s_], w_ = V_[256 + s_]; float f_[8], g_[8]; unpack8(xq[k_], f_); \
                    _Pragma("unroll") for (int j_ = 0; j_ < 8; ++j_) { g_[j_] = f_[j_] * w_; f_[j_] *= dt_; } \
                    *(LAS v4u*)(XDl + s_ * SP_X + xpart * 16) = pack8(f_); *(LAS v4u*)(XWl + s_ * SP_X + xpart * 16) = pack8(g_); } } while (0)
            __syncthreads();
            SSD_PFV(0); pa0 = qa0; pa1 = qa1; pd0 = qd0; pd1 = qd1; SSD_PFV(1); SSD_PFY(0); SSD_PF(0);
            { const float t0_ = qa0, t1_ = qa1, t2_ = qd0, t3_ = qd1; SSD_SCAN(0); pa0 = t0_; pa1 = t1_; pd0 = t2_; pd1 = t3_; }
            __syncthreads();
            SSD_WRITE(0);
            { LAS v2u* sp = (LAS v2u*)(Sl + (32 * pt + r32) * SP_B + (32 * lt + 4 * hh) * 2);
#pragma unroll
              for (int q = 0; q < 4; ++q) sp[2 * q] = (v2u){0u, 0u}; }
            __syncthreads();
            SSD_ACC(0, tprev);
            for (int c = 0; c < 18; ++c) {
                const int cur = c & 1; const LAS float* V = (const LAS float*)(lds + SO_V + cur * 2048);
#ifdef SSD_JITTER
                if (wave == ((c * 3 + (int)blockIdx.x + dir) & 7)) __builtin_amdgcn_s_sleep(120);
#endif
                const int rowbase = SSD_ROWBASE(c); const bool want_y = !(last && c < 2);
                if (c > 0 && want_y) SSD_PFY(c);
                if (c + 1 < 18) { if (c + 2 < 18) SSD_PFV(c + 2); }
                SSD_ACC(1, tprev);
                for (int yrep = 0; yrep < SSD_YREP; ++yrep)
                if (!want_y && c + 1 < 18) { SSD_PFB(c + 1); SSD_PFC(c + 1); SSD_PFX(c + 1); }
                if (want_y) {
                    const int l = 32 * lt + r32; const float cl = V[l];
                    bf16* yptr = ZX + (size_t)(rowbase + l) * SSD_INP + 2048 + h * 64 + 32 * pt + 4 * hh;
                    bf16x8 cf[8];
#pragma unroll
                    for (int ks = 0; ks < 8; ++ks) cf[ks] = *(const LAS bf16x8*)(Cl + l * SP_B + (16 * ks + 8 * hh) * 2);
                    SSD_ACC(8, tprev);
                    f32x16 y1;
#pragma unroll
                    for (int k = 0; k < 16; ++k) y1[k] = 0.f;
#pragma unroll
                    for (int ks = 0; ks < 8; ++ks) { const bf16x8 sf = *(const LAS bf16x8*)(Sl + (32 * pt + r32) * SP_B + (16 * ks + 8 * hh) * 2); y1 = __builtin_amdgcn_mfma_f32_32x32x16_bf16(sf, cf[ks], y1, 0, 0, 0); }
                    { const float el = __expf(cl);
#pragma unroll
                      for (int k = 0; k < 16; ++k) y1[k] *= el; }
                    SSD_ACC(10, tprev);
                    const int st_lo = dir == 0 ? 0 : lt, st_hi = dir == 0 ? lt : 3;
#pragma unroll
                    for (int st = 0; st < 4; ++st) { if (c + 1 < 18) { if (st == 1) SSD_PFB(c + 1); if (st == 2) SSD_PFC(c + 1); if (st == 3) SSD_PFX(c + 1); }
                      if (st >= st_lo && st <= st_hi) {
                        f32x16 X;
#pragma unroll
                        for (int k = 0; k < 16; ++k) X[k] = 0.f;
#pragma unroll
                        for (int ks = 0; ks < 8; ++ks) { const bf16x8 af = *(const LAS bf16x8*)(Bl + (32 * st + r32) * SP_B + (16 * ks + 8 * hh) * 2); X = __builtin_amdgcn_mfma_f32_32x32x16_bf16(af, cf[ks], X, 0, 0, 0); }
                        if (st == lt) {
#pragma unroll
                            for (int q = 0; q < 4; ++q) { const f32x4 cs = *(const LAS f32x4*)(V + 32 * st + 8 * q + 4 * hh);
#pragma unroll
                                for (int e = 0; e < 4; ++e) { const int sl = 8 * q + 4 * hh + e; const bool ok = dir == 0 ? (sl <= r32) : (sl >= r32);
                                    X[4 * q + e] *= __expf(ok ? fminf(cl - cs[e], 0.f) : -1.0e30f); } }
                        } else {
#pragma unroll
                            for (int q = 0; q < 4; ++q) { const f32x4 cs = *(const LAS f32x4*)(V + 32 * st + 8 * q + 4 * hh);
#pragma unroll
                                for (int e = 0; e < 4; ++e) X[4 * q + e] *= __expf(fminf(cl - cs[e], 0.f)); }
                        }
#pragma unroll
                        for (int ks2 = 0; ks2 < 2; ++ks2) { v4u w; w.x = cvtpk(X[8 * ks2 + 0], X[8 * ks2 + 1]); w.y = cvtpk(X[8 * ks2 + 2], X[8 * ks2 + 3]); w.z = cvtpk(X[8 * ks2 + 4], X[8 * ks2 + 5]); w.w = cvtpk(X[8 * ks2 + 6], X[8 * ks2 + 7]);
                            const LAS unsigned char* tb = XDl + (32 * st + 16 * ks2 + 4 * hh + tq) * SP_X + (32 * pt + 16 * tblk + 4 * tp) * 2;
                            const v2u lo = trread(tb), hi = trread(tb + 8 * SP_X);
                            y1 = __builtin_amdgcn_mfma_f32_32x32x16_bf16(__builtin_bit_cast(bf16x8, (v4u){lo.x, lo.y, hi.x, hi.y}), __builtin_bit_cast(bf16x8, w), y1, 0, 0, 0); }
                    } }
                    asm volatile("" : "+v"(y1)); SSD_ACC(9, tprev);
#pragma unroll
                    for (int q = 0; q < 4; ++q) { float o[4];
#pragma unroll
                        for (int e = 0; e < 4; ++e) o[e] = y1[4 * q + e];
                        const float a0 = bflo(add[q].x), a1 = bfhi(add[q].x), a2 = bflo(add[q].y), a3 = bfhi(add[q].y);
                        if (dir == 0) { o[0] += dsk * a0; o[1] += dsk * a1; o[2] += dsk * a2; o[3] += dsk * a3; } else { o[0] += a0; o[1] += a1; o[2] += a2; o[3] += a3; }
                        v2u w; w.x = cvtpk(o[0], o[1]); w.y = cvtpk(o[2], o[3]); *(v2u*)(yptr + 8 * q) = w; }
                }
                SSD_ACC(2, tprev);
                if (c + 1 < 18) {
                    const float etot = __expf(V[384]);
#pragma unroll
                    for (int k = 0; k < 16; ++k) sacc[k] *= etot;
#pragma unroll
                    for (int kh = 0; kh < 2; ++kh) {
                        v2u alo[4], ahi[4], blo[4], bhi[4];
#pragma unroll
                        for (int k4 = 0; k4 < 4; ++k4) { const int ks = 4 * kh + k4;
                            const LAS unsigned char* ta = Bl + (16 * ks + 8 * hh + tq) * SP_B + (32 * lt + 16 * tblk + 4 * tp) * 2;
                            const LAS unsigned char* tb = XWl + (16 * ks + 8 * hh + tq) * SP_X + (32 * pt + 16 * tblk + 4 * tp) * 2;
                            alo[k4] = trread(ta); ahi[k4] = trread(ta + 4 * SP_B); blo[k4] = trread(tb); bhi[k4] = trread(tb + 4 * SP_X); }
                        asm volatile("" : "+v"(alo[0]), "+v"(alo[1]), "+v"(alo[2]), "+v"(alo[3]), "+v"(bhi[0]), "+v"(bhi[1]), "+v"(bhi[2]), "+v"(bhi[3]));
#pragma unroll
                        for (int k4 = 0; k4 < 4; ++k4)
                            sacc = __builtin_amdgcn_mfma_f32_32x32x16_bf16(__builtin_bit_cast(bf16x8, (v4u){alo[k4].x, alo[k4].y, ahi[k4].x, ahi[k4].y}), __builtin_bit_cast(bf16x8, (v4u){blo[k4].x, blo[k4].y, bhi[k4].x, bhi[k4].y}), sacc, 0, 0, 0); }
                    SSD_SCAN(cur ^ 1); pa0 = qa0; pa1 = qa1; pd0 = qd0; pd1 = qd1;
                }
#ifdef SSD_JITTER
                if (wave == ((c * 5 + 2 + (int)blockIdx.x) & 7)) __builtin_amdgcn_s_sleep(90);
#endif
                SSD_ACC(3, tprev);
                __syncthreads();
                SSD_ACC(4, tprev);
                if (c + 1 < 18) {
                    LAS v2u* sp = (LAS v2u*)(Sl + (32 * pt + r32) * SP_B + (32 * lt + 4 * hh) * 2);
#pragma unroll
                    for (int q = 0; q < 4; ++q) { v2u w; w.x = cvtpk(sacc[4 * q], sacc[4 * q + 1]); w.y = cvtpk(sacc[4 * q + 2], sacc[4 * q + 3]); sp[2 * q] = w; }
                    for (int wrep = 0; wrep < SSD_WREP; ++wrep) { SSD_WRITE(cur ^ 1); }
                }
                SSD_ACC(5, tprev);
                __syncthreads();
                SSD_ACC(6, tprev);
            }
#undef SSD_ROWBASE
#undef SSD_PF
#undef SSD_PFV
#undef SSD_PFY
#undef SSD_SCAN
#undef SSD_WRITE
            asm volatile("s_waitcnt vmcnt(0)" ::: "memory");
        }
    }
#ifdef SSD_DIAG
    if (blockIdx.x == 0 && wave == SSD_DIAG_WAVE && lane == 0 && i == 0) { float* dg = (float*)(a.ws + WS_MOD + 900 * 1024); long long tot = 0;
        for (int k = 0; k < 7; ++k) tot += dacc[k];
        tot += dacc[8] + dacc[9] + dacc[10];
        for (int k = 0; k < 12; ++k) dg[k] = (float)dacc[k]; dg[7] = (float)tot; }
#endif
}

constexpr int AT2_KP = 208, AT2_VP = 192, AT2_KB = 64 * AT2_KP, AT2_VB = 64 * AT2_VP, AT2_BUF = AT2_KB + AT2_VB;
template <int NQ>
__device__ __forceinline__ void attn_unit2(const Args& a, LAS unsigned char* lds, int b, int h, int q0, int ntiles, bool lat) {
    const int tid = otid(a.wv), wave = tid >> 6, lane = tid & 63, r32 = lane & 31, hh = lane >> 5;
    const int tq = (lane >> 2) & 3, tp = lane & 3, tblk = (lane >> 4) & 1;
    const bf16* Qb = (const bf16*)(a.ws + WS_Q); const bf16* KVb = (const bf16*)(a.ws + WS_KV); const bf16* KR = (const bf16*)(a.ws + WS_KR); bf16* MIX = (bf16*)(a.ws + WS_MIX);
    const float* ct = (const float*)(a.ws + WS_ROPE); const float* st = ct + SEQ * 16;
    bf16x8 qf[NQ][6];
#pragma unroll
    for (int nq = 0; nq < NQ; ++nq) { const int qrow = q0 + wave * (32 * NQ) + nq * 32 + r32;
#pragma unroll
        for (int s = 0; s < 6; ++s) qf[nq][s] = *(const bf16x8*)(Qb + (size_t)qrow * QW + h * 96 + 16 * s + 8 * hh);
        if (lat) { const int t = qrow & (SEQ - 1);
#pragma unroll
            for (int j = 0; j < 8; j += 2) { float y1[2], y2[2];
#pragma unroll
                for (int e = 0; e < 2; ++e) { const float x1 = bf1((bf16)qf[nq][4][j + e]), x2 = bf1((bf16)qf[nq][5][j + e]); const float c = ct[t * 16 + 8 * hh + j + e], s = st[t * 16 + 8 * hh + j + e];
                    y1[e] = x1 * c - x2 * s; y2[e] = x1 * s + x2 * c; }
                const unsigned w1 = pk2(y1[0], y1[1]), w2 = pk2(y2[0], y2[1]);
                qf[nq][4][j] = (short)(w1 & 0xffff); qf[nq][4][j + 1] = (short)(w1 >> 16); qf[nq][5][j] = (short)(w2 & 0xffff); qf[nq][5][j + 1] = (short)(w2 >> 16); } }
        asm volatile("" : "+v"(qf[nq][0]), "+v"(qf[nq][1]), "+v"(qf[nq][2]), "+v"(qf[nq][3]), "+v"(qf[nq][4]), "+v"(qf[nq][5]) :: "memory"); }
    f32x16 o[NQ][2]; float m[NQ], l[NQ];
#pragma unroll
    for (int nq = 0; nq < NQ; ++nq) { m[nq] = -1e30f; l[nq] = 0.f;
#pragma unroll
        for (int i = 0; i < 16; ++i) { o[nq][0][i] = 0.f; o[nq][1][i] = 0.f; } }
    v4u kreg0, kreg1, vreg;
#define AT2_LOAD(it, tt) do { const unsigned off_kv = (unsigned)(((tt) >> 3) * (KVW * 2) + h * 256 + ((tt) & 7) * 16), off_kr = (unsigned)(((tt) >> 2) * 64 + ((tt) & 3) * 16); const bool k1ok = (tt) < 256; const int rb_ = (it) < CTXL / 64 ? TL + b * CTXL + (it) * 64 : b * SEQ + ((it) - CTXL / 64) * 64; \
        const char* kvb_ = (const char*)(KVb + (size_t)rb_ * KVW); const char* krb_ = (const char*)(KR + (size_t)rb_ * 32); \
        kreg0 = *(const v4u*)(kvb_ + off_kv); vreg = *(const v4u*)(kvb_ + off_kv + 128); if (k1ok) kreg1 = *(const v4u*)(krb_ + off_kr); } while (0)
#define AT2_WRITE(buf, tt) do { LAS unsigned char* kb_ = lds + (buf) * AT2_BUF; \
        *(LAS v4u*)(kb_ + ((tt) >> 3) * AT2_KP + ((tt) & 7) * 16) = kreg0; if ((tt) < 256) *(LAS v4u*)(kb_ + ((tt) >> 2) * AT2_KP + 128 + ((tt) & 3) * 16) = kreg1; \
        *(LAS v4u*)(kb_ + AT2_KB + ((tt) >> 3) * AT2_VP + ((tt) & 7) * 16) = vreg; } while (0)
    __syncthreads();
    AT2_LOAD(0, tid); AT2_WRITE(0, tid);
    __syncthreads();
    for (int it = 0; it < ntiles; ++it) {
        int tz = tid; asm volatile("" : "+v"(tz));
        const int lane_ = tz & 63, r32_ = lane_ & 31, hh_ = lane_ >> 5, tq_ = (lane_ >> 2) & 3, tp_ = lane_ & 3, tblk_ = (lane_ >> 4) & 1;
#ifdef ATT_LOADTOP
        if (it + 1 < ntiles) AT2_LOAD(it + 1, tz);
#endif
        const LAS unsigned char* kb = lds + (it & 1) * AT2_BUF; const LAS unsigned char* vb = kb + AT2_KB;
        bf16x8 pf[NQ][2][2];
        f32x16 sc[NQ][2];
#pragma unroll
        for (int nq = 0; nq < NQ; ++nq)
#pragma unroll
            for (int i = 0; i < 16; ++i) { sc[nq][0][i] = 0.f; sc[nq][1][i] = 0.f; }
#pragma unroll
        for (int s = 0; s < 6; ++s) { const bf16x8 a0 = *(const LAS bf16x8*)(kb + r32_ * AT2_KP + (16 * s + 8 * hh_) * 2); const bf16x8 a1 = *(const LAS bf16x8*)(kb + (32 + r32_) * AT2_KP + (16 * s + 8 * hh_) * 2);
#pragma unroll
            for (int nq = 0; nq < NQ; ++nq) { sc[nq][0] = __builtin_amdgcn_mfma_f32_32x32x16_bf16(a0, qf[nq][s], sc[nq][0], 0, 0, 0); sc[nq][1] = __builtin_amdgcn_mfma_f32_32x32x16_bf16(a1, qf[nq][s], sc[nq][1], 0, 0, 0); } }
#pragma unroll
        for (int nq = 0; nq < NQ; ++nq) {
            f32x16& s0 = sc[nq][0]; f32x16& s1 = sc[nq][1];
            float mx = s0[0];
#pragma unroll
            for (int i = 1; i < 16; ++i) mx = fmaxf(mx, s0[i]);
#pragma unroll
            for (int i = 0; i < 16; ++i) mx = fmaxf(mx, s1[i]);
            mx = fmaxf(mx, shx(mx, 32, lane_));
            const float mn = fmaxf(m[nq], mx * ATT_SCALE_LOG2E); const float alpha = __builtin_amdgcn_exp2f(m[nq] - mn); m[nq] = mn;
            float rs = 0.f;
#pragma unroll
            for (int i = 0; i < 16; ++i) { s0[i] = __builtin_amdgcn_exp2f(s0[i] * ATT_SCALE_LOG2E - mn); s1[i] = __builtin_amdgcn_exp2f(s1[i] * ATT_SCALE_LOG2E - mn); rs += s0[i] + s1[i]; }
            l[nq] = l[nq] * alpha + rs;
#pragma unroll
            for (int i = 0; i < 16; ++i) { o[nq][0][i] *= alpha; o[nq][1][i] *= alpha; }
#pragma unroll
            for (int s2 = 0; s2 < 2; ++s2) { v4u w0, w1;
                w0.x = cvtpk(s0[8 * s2 + 0], s0[8 * s2 + 1]); w0.y = cvtpk(s0[8 * s2 + 2], s0[8 * s2 + 3]); w0.z = cvtpk(s0[8 * s2 + 4], s0[8 * s2 + 5]); w0.w = cvtpk(s0[8 * s2 + 6], s0[8 * s2 + 7]);
                w1.x = cvtpk(s1[8 * s2 + 0], s1[8 * s2 + 1]); w1.y = cvtpk(s1[8 * s2 + 2], s1[8 * s2 + 3]); w1.z = cvtpk(s1[8 * s2 + 4], s1[8 * s2 + 5]); w1.w = cvtpk(s1[8 * s2 + 6], s1[8 * s2 + 7]);
                pf[nq][0][s2] = __builtin_bit_cast(bf16x8, w0); pf[nq][1][s2] = __builtin_bit_cast(bf16x8, w1); }
        }
#ifndef ATT_LOADTOP
        if (it + 1 < ntiles) AT2_LOAD(it + 1, tz);
#endif
#pragma unroll
        for (int t = 0; t < 2; ++t)
#pragma unroll
            for (int s2 = 0; s2 < 2; ++s2)
#pragma unroll
                for (int dt = 0; dt < 2; ++dt) {
                    const LAS unsigned char* tb = vb + (t * 32 + 16 * s2 + 4 * hh_ + tq_) * AT2_VP + (32 * dt + 16 * tblk_ + 4 * tp_) * 2;
#ifdef ATT_NOTR
                    bf16x8 vf; { const LAS unsigned short* vp_ = (const LAS unsigned short*)(vb + (t * 32 + 16 * s2 + 4 * hh_) * AT2_VP + (32 * dt + r32_) * 2);
#pragma unroll
                      for (int j_ = 0; j_ < 8; ++j_) vf[j_] = (short)vp_[((j_ & 3) + 8 * (j_ >> 2)) * (AT2_VP / 2)]; }
#else
                    const v2u lo = trread(tb), hi = trread(tb + 8 * AT2_VP); const bf16x8 vf = __builtin_bit_cast(bf16x8, (v4u){lo.x, lo.y, hi.x, hi.y});
#endif
#pragma unroll
                    for (int nq = 0; nq < NQ; ++nq) o[nq][dt] = __builtin_amdgcn_mfma_f32_32x32x16_bf16(vf, pf[nq][t][s2], o[nq][dt], 0, 0, 0); }
        if (it + 1 < ntiles) AT2_WRITE((it + 1) & 1, tz);
        __syncthreads();
    }
#undef AT2_LOAD
#undef AT2_WRITE
#pragma unroll
    for (int nq = 0; nq < NQ; ++nq) { int qrow = q0 + wave * (32 * NQ) + nq * 32 + r32; asm volatile("" : "+v"(qrow));
        const float lt = l[nq] + shx(l[nq], 32, lane); const float inv = 1.f / lt;
        bf16* orow = MIX + (size_t)qrow * D + h * 64 + 4 * hh;
#pragma unroll
        for (int g = 0; g < 4; ++g) {
            v2u w; w.x = pk2(o[nq][0][4 * g] * inv, o[nq][0][4 * g + 1] * inv); w.y = pk2(o[nq][0][4 * g + 2] * inv, o[nq][0][4 * g + 3] * inv); *(v2u*)(orow + 8 * g) = w;
            v2u x; x.x = pk2(o[nq][1][4 * g] * inv, o[nq][1][4 * g + 1] * inv); x.y = pk2(o[nq][1][4 * g + 2] * inv, o[nq][1][4 * g + 3] * inv); *(v2u*)(orow + 32 + 8 * g) = x; } }
}
__device__ __forceinline__ void attn_mfma2(const Args& a, LAS unsigned char* lds) {
#ifdef ATT_NQ1
    for (int u = blockIdx.x; u < 512; u += gridDim.x) attn_unit2<1>(a, lds, u >> 6, (u >> 3) & 7, (u >> 6) * SEQ + (u & 7) * 256, (CTXL + SEQ) / 64, true);
#else
    for (int u = blockIdx.x; u < 256; u += gridDim.x) attn_unit2<2>(a, lds, u >> 5, (u >> 2) & 7, (u >> 5) * SEQ + (u & 3) * 512, (CTXL + SEQ) / 64, true);
#endif
    for (int u = blockIdx.x; u < 64; u += gridDim.x) attn_unit2<1>(a, lds, u >> 3, u & 7, TL + (u >> 3) * CTXL, CTXL / 64, false);
}

template <int R>
__device__ __forceinline__ void rowwise2(const float* xs_lat, const float* xs_ctx, float* xd_lat, float* xd_ctx, const bf16* Mb, const float* modg, const float* nwA,
                                         bf16* H, const float* modh, int sh_off, int sc_off, const float* nwB, int nrows, int wv) {
    const int tid = otid(wv), wave = wv, lane = tid & 63; const int NGW = gridDim.x * NWAVES, gw = blockIdx.x * NWAVES + wave;
    const int rpw = (nrows + NGW - 1) / NGW; const int rbeg = gw * rpw, rend = min(rbeg + rpw, nrows);
    for (int r0 = rbeg; r0 < rend; r0 += R) {
        f32x4 v[R][4]; v2u mm[R][4];
#pragma unroll
        for (int j = 0; j < R; ++j) { const int r = min(r0 + j, rend - 1); const float* xs = r < TL ? xs_lat + (size_t)r * D : xs_ctx + (size_t)(r - TL) * D;
#pragma unroll
            for (int q = 0; q < 4; ++q) v[j][q] = *(const f32x4*)(xs + q * 256 + lane * 4);
            if (Mb) {
#pragma unroll
                for (int q = 0; q < 4; ++q) mm[j][q] = *(const v2u*)(Mb + (size_t)r * D + q * 256 + lane * 4); } }
#pragma unroll
        for (int j = 0; j < R; ++j) { const int r = r0 + j; if (r < rend) {
            const bool lat = r < TL; const int cond = lat ? (r >> 11) : 8; float* xd = lat ? xd_lat + (size_t)r * D : xd_ctx + (size_t)(r - TL) * D;
            if (Mb) {
                f32x4 m[4]; float ss = 0.f;
#pragma unroll
                for (int q = 0; q < 4; ++q) { const v2u w = mm[j][q]; m[q] = (f32x4){bflo(w.x), bfhi(w.x), bflo(w.y), bfhi(w.y)}; ss += (m[q][0] * m[q][0] + m[q][1] * m[q][1]) + (m[q][2] * m[q][2] + m[q][3] * m[q][3]); }
                const float rs = rsqrtf(wave_sum(ss, lane) * (1.f / D) + EPS);
#pragma unroll
                for (int q = 0; q < 4; ++q) { const f32x4 g = *(const f32x4*)(modg + (size_t)cond * MODW + q * 256 + lane * 4); const f32x4 w = *(const f32x4*)(nwA + q * 256 + lane * 4);
                    v[j][q] = v[j][q] + g * (m[q] * rs * w); }
            }
#pragma unroll
            for (int q = 0; q < 4; ++q) *(f32x4*)(xd + q * 256 + lane * 4) = v[j][q];
            if (H) {
                float ss = 0.f;
#pragma unroll
                for (int q = 0; q < 4; ++q) ss += (v[j][q][0] * v[j][q][0] + v[j][q][1] * v[j][q][1]) + (v[j][q][2] * v[j][q][2] + v[j][q][3] * v[j][q][3]);
                const float rs = rsqrtf(wave_sum(ss, lane) * (1.f / D) + EPS);
#pragma unroll
                for (int q = 0; q < 4; ++q) { const int c = q * 256 + lane * 4;
                    const f32x4 w = *(const f32x4*)(nwB + c); const f32x4 sc = *(const f32x4*)(modh + (size_t)cond * MODW + sc_off + c); const f32x4 sh = *(const f32x4*)(modh + (size_t)cond * MODW + sh_off + c);
                    const f32x4 hv = (v[j][q] * rs * w) * (sc + 1.0f) + sh;
                    v2u o; o.x = pk2(hv[0], hv[1]); o.y = pk2(hv[2], hv[3]); *(v2u*)(H + (size_t)r * D + c) = o; }
            } } }
    }
}

__device__ __forceinline__ void convgate2(const Args& a, int l, int nrows) {
    const bf16* U = (const bf16*)(a.ws + WS_U); bf16* G = (bf16*)(a.ws + WS_G); const float* cw = a.in[I_FCONV] + (size_t)l * 3 * UPW;
    const int total = (nrows / 8) * (DFF / 8);
    for (int idx = blockIdx.x * NTHR + otid(a.wv); idx < total; idx += gridDim.x * NTHR) {
        const int r0 = (idx / (DFF / 8)) * 8, c0 = (idx % (DFF / 8)) * 8; const bf16* u = U + (size_t)r0 * UPW + c0;
        const bool hp = has_prev(r0), hn = has_next(r0 + 7);
        v4u ua[10], ug[10];
#pragma unroll
        for (int j = 0; j < 10; ++j) { const int rr = (j == 0 && !hp) ? 0 : ((j == 9 && !hn) ? 7 : j - 1); ua[j] = *(const v4u*)(u + (ptrdiff_t)rr * UPW); ug[j] = *(const v4u*)(u + (ptrdiff_t)rr * UPW + DFF); }
        float wa[3][8], wg[3][8];
#pragma unroll
        for (int t = 0; t < 3; ++t)
#pragma unroll
            for (int j = 0; j < 8; ++j) { wa[t][j] = cw[t * UPW + c0 + j]; wg[t][j] = cw[t * UPW + DFF + c0 + j]; }
        if (!hp) { ua[0] = (v4u){0u, 0u, 0u, 0u}; ug[0] = ua[0]; }
        if (!hn) { ua[9] = (v4u){0u, 0u, 0u, 0u}; ug[9] = ua[9]; }
        float pa[8], ca[8], na[8], pg[8], cg_[8], ng[8];
        unpack8(ua[0], pa); unpack8(ug[0], pg); unpack8(ua[1], ca); unpack8(ug[1], cg_);
#pragma unroll
        for (int j = 0; j < 8; ++j) {
            unpack8(ua[j + 2], na); unpack8(ug[j + 2], ng);
            float o[8];
#pragma unroll
            for (int k = 0; k < 8; ++k) { const float act = wa[0][k] * pa[k] + wa[1][k] * ca[k] + wa[2][k] * na[k]; const float gate = wg[0][k] * pg[k] + wg[1][k] * cg_[k] + wg[2][k] * ng[k]; o[k] = silu_f(act) * gate; }
            *(v4u*)(G + (size_t)(r0 + j) * DFF + c0) = pack8(o);
#pragma unroll
            for (int k = 0; k < 8; ++k) { pa[k] = ca[k]; ca[k] = na[k]; pg[k] = cg_[k]; cg_[k] = ng[k]; }
        }
    }
}

__device__ __forceinline__ void ssd_conv2(const Args& a, int i) {
    const bf16* ZX = (const bf16*)(a.ws + WS_ZX); bf16* XBC = (bf16*)(a.ws + WS_XBC); float* DT = (float*)(a.ws + WS_DT); float* AA = (float*)(a.ws + WS_AA);
    const float* cw = a.in[I_SCONVW] + (size_t)i * 3 * 3072; const float* cb = a.in[I_SCONVB] + (size_t)i * 3072;
    const int total = (T / 8) * 384;
    for (int idx = blockIdx.x * NTHR + otid(a.wv); idx < total; idx += gridDim.x * NTHR) {
        const int r0 = (idx / 384) * 8, c0 = (idx % 384) * 8; const bf16* u = ZX + (size_t)r0 * SSD_INP + 2048 + c0;
        const bool hp = has_prev(r0), hn = has_next(r0 + 7);
        v4u ux[10];
#pragma unroll
        for (int j = 0; j < 10; ++j) { const int rr = (j == 0 && !hp) ? 0 : ((j == 9 && !hn) ? 7 : j - 1); ux[j] = *(const v4u*)(u + (ptrdiff_t)rr * SSD_INP); }
        float w[3][8], bias[8];
#pragma unroll
        for (int j = 0; j < 8; ++j) { w[0][j] = cw[c0 + j]; w[1][j] = cw[3072 + c0 + j]; w[2][j] = cw[2 * 3072 + c0 + j]; bias[j] = cb[c0 + j]; }
        if (!hp) ux[0] = (v4u){0u, 0u, 0u, 0u};
        if (!hn) ux[9] = (v4u){0u, 0u, 0u, 0u};
        float p[8], c[8], n[8];
        unpack8(ux[0], p); unpack8(ux[1], c);
#pragma unroll
        for (int j = 0; j < 8; ++j) {
            unpack8(ux[j + 2], n); float o[8];
#pragma unroll
            for (int k = 0; k < 8; ++k) o[k] = silu_f(bias[k] + w[0][k] * p[k] + w[1][k] * c[k] + w[2][k] * n[k]);
            *(v4u*)(XBC + (size_t)(r0 + j) * 3072 + c0) = pack8(o);
#pragma unroll
            for (int k = 0; k < 8; ++k) { p[k] = c[k]; c[k] = n[k]; }
        }
    }
    const float* alog = a.in[I_ALOG] + i * 64; const float* dtb = a.in[I_DTB] + i * 64;
    for (int idx = blockIdx.x * NTHR + otid(a.wv); idx < T * 8; idx += gridDim.x * NTHR) {
        const int r = idx >> 3, j0 = (idx & 7) * 8; float raw[8], dt[8], av[8];
        unpack8(*(const v4u*)(ZX + (size_t)r * SSD_INP + 5120 + j0), raw);
#pragma unroll
        for (int k = 0; k < 8; ++k) { const float x = raw[k] + dtb[j0 + k]; dt[k] = x > 15.f ? x : (x < -15.f ? __expf(x) : __logf(1.f + __expf(x))); av[k] = -__expf(alog[j0 + k]) * dt[k]; }
        *(f32x4*)(DT + (size_t)r * 64 + j0) = (f32x4){dt[0], dt[1], dt[2], dt[3]}; *(f32x4*)(DT + (size_t)r * 64 + j0 + 4) = (f32x4){dt[4], dt[5], dt[6], dt[7]};
        *(f32x4*)(AA + (size_t)r * 64 + j0) = (f32x4){av[0], av[1], av[2], av[3]}; *(f32x4*)(AA + (size_t)r * 64 + j0 + 4) = (f32x4){av[4], av[5], av[6], av[7]};
    }
}

__device__ __forceinline__ void gatenorm2(const Args& a, int i, int nrows) {
    const int tid = otid(a.wv), wave = a.wv, lane = tid & 63; const int NGW = gridDim.x * NWAVES, gw = blockIdx.x * NWAVES + wave;
    const bf16* ZX = (const bf16*)(a.ws + WS_ZX); bf16* YN = (bf16*)(a.ws + WS_XBC); const float* nw = a.in[I_SNORM] + i * 2048;
    const int rpw = (nrows + NGW - 1) / NGW; const int rbeg = gw * rpw, rend = min(rbeg + rpw, nrows);
    constexpr int R = 3;
    for (int r0 = rbeg; r0 < rend; r0 += R) {
        v4u yv[R][4], zv[R][4];
#pragma unroll
        for (int j = 0; j < R; ++j) { const int r = min(r0 + j, rend - 1);
#pragma unroll
            for (int q = 0; q < 4; ++q) { const int c = q * 512 + lane * 8; yv[j][q] = *(const v4u*)(ZX + (size_t)r * SSD_INP + 2048 + c); zv[j][q] = *(const v4u*)(ZX + (size_t)r * SSD_INP + c); } }
#pragma unroll
        for (int j = 0; j < R; ++j) { const int r = r0 + j; if (r < rend) {
            float v[4][8]; float ss = 0.f;
#pragma unroll
            for (int q = 0; q < 4; ++q) { float y[8], z[8]; unpack8(yv[j][q], y); unpack8(zv[j][q], z);
#pragma unroll
                for (int k = 0; k < 8; ++k) { v[q][k] = y[k] * silu_f(z[k]); ss += v[q][k] * v[q][k]; } }
            const float rs = rsqrtf(wave_sum(ss, lane) * (1.f / 2048.f) + EPS);
#pragma unroll
            for (int q = 0; q < 4; ++q) { const int c = q * 512 + lane * 8; float o[8];
#pragma unroll
                for (int k = 0; k < 8; ++k) o[k] = v[q][k] * rs * nw[c + k];
                *(v4u*)(YN + (size_t)r * 2048 + c) = pack8(o); } } }
    }
}

__device__ __forceinline__ void ffn_fixup(const Args& a, int l, int nrows) {
    const bf16* Ue = (const bf16*)(a.ws + WS_UE); bf16* G = (bf16*)(a.ws + WS_G); const float* cw = a.in[I_FCONV] + (size_t)l * 3 * UPW;
    const int total = (nrows / 256) * 2 * (DFF / 8);
    for (int idx = blockIdx.x * NTHR + otid(a.wv); idx < total; idx += gridDim.x * NTHR) {
        const int cg = idx % (DFF / 8), which = (idx / (DFF / 8)) & 1, pm = idx / (2 * (DFF / 8)); const int c0 = cg * 8; const int col = (c0 / 128) * 256 + (c0 % 128);
        const int r = pm * 256 + (which ? 255 : 0);
        const bf16* e0 = Ue + (size_t)(pm * 4) * UPW + col;
        const bf16* pp = which ? e0 + 2 * UPW : e0 - UPW;
        const bf16* pc = which ? e0 + 3 * UPW : e0;
        const bf16* pn = which ? e0 + 4 * UPW : e0 + UPW;
        const bool hp = which ? true : has_prev(r), hn = which ? has_next(r) : true;
        float pa[8], pg[8], ca[8], cg_[8], na[8], ng[8];
        unpack8(*(const v4u*)pc, ca); unpack8(*(const v4u*)(pc + 128), cg_);
        if (hp) { unpack8(*(const v4u*)pp, pa); unpack8(*(const v4u*)(pp + 128), pg); } else {
#pragma unroll
            for (int k = 0; k < 8; ++k) { pa[k] = 0.f; pg[k] = 0.f; } }
        if (hn) { unpack8(*(const v4u*)pn, na); unpack8(*(const v4u*)(pn + 128), ng); } else {
#pragma unroll
            for (int k = 0; k < 8; ++k) { na[k] = 0.f; ng[k] = 0.f; } }
        float o[8];
#pragma unroll
        for (int k = 0; k < 8; ++k) { const float act = cw[c0 + k] * pa[k] + cw[UPW + c0 + k] * ca[k] + cw[2 * UPW + c0 + k] * na[k];
            const float gate = cw[DFF + c0 + k] * pg[k] + cw[UPW + DFF + c0 + k] * cg_[k] + cw[2 * UPW + DFF + c0 + k] * ng[k]; o[k] = silu_f(act) * gate; }
        *(v4u*)(G + (size_t)r * DFF + c0) = pack8(o);
    }
}

__device__ __forceinline__ void prep_even2(const Args& a, int i) {
    const int tid = otid(a.wv), wave = a.wv, lane = tid & 63; const int NGW = gridDim.x * NWAVES, gw = blockIdx.x * NWAVES + wave;
    const bf16* P = (const bf16*)(a.ws + WS_P); bf16* CQN = (bf16*)(a.ws + WS_CQN); bf16* CKVN = (bf16*)(a.ws + WS_CKVN); bf16* KR = (bf16*)(a.ws + WS_KR); bf16* MIX = (bf16*)(a.ws + WS_MIX);
    const float* qn = a.in[I_QNORM] + i * 384; const float* kvn = a.in[I_KVNORM] + i * 256; const float* cw = a.in[I_SCONV] + i * 3 * 512;
    const float* ct = (const float*)(a.ws + WS_ROPE); const float* st = ct + SEQ * 16;
    constexpr int R = 3; const int rpw = (T + NGW - 1) / NGW; const int rbeg = gw * rpw, rend = min(rbeg + rpw, T);
    const int c0 = lane * 8;
    for (int r0 = rbeg; r0 < rend; r0 += R) {
        unsigned q32[R][3]; v2u kv2[R]; bf16 krv[R]; v4u gbv[R], gcv[R + 2], xvv[R + 2];
#pragma unroll
        for (int j = 0; j < R; ++j) { const int r = min(r0 + j, rend - 1); const bf16* p = P + (size_t)r * HYB_INP;
            const unsigned* p32 = (const unsigned*)(p + lane * 6); q32[j][0] = p32[0]; q32[j][1] = p32[1]; q32[j][2] = p32[2];
            kv2[j] = *(const v2u*)(p + 384 + lane * 4); krv[j] = p[640 + (lane & 31)]; gbv[j] = *(const v4u*)(p + 672 + c0); }
#pragma unroll
        for (int j = 0; j < R + 2; ++j) { int r = r0 + j - 1; r = max(0, min(r, T - 1)); const bf16* p = P + (size_t)r * HYB_INP; gcv[j] = *(const v4u*)(p + 1184 + c0); xvv[j] = *(const v4u*)(p + 1696 + c0); }
#pragma unroll
        for (int j = 0; j < R; ++j) { const int r = r0 + j; if (r < rend) {
            {   float f[6] = {bflo(q32[j][0]), bfhi(q32[j][0]), bflo(q32[j][1]), bfhi(q32[j][1]), bflo(q32[j][2]), bfhi(q32[j][2])}; float ss = 0.f;
#pragma unroll
                for (int k = 0; k < 6; ++k) ss += f[k] * f[k];
                const float rs = rsqrtf(wave_sum(ss, lane) * (1.f / 384.f) + EPS);
#pragma unroll
                for (int k = 0; k < 6; ++k) f[k] = f[k] * rs * qn[lane * 6 + k];
                unsigned* o32 = (unsigned*)(CQN + (size_t)r * 384 + lane * 6); o32[0] = pk2(f[0], f[1]); o32[1] = pk2(f[2], f[3]); o32[2] = pk2(f[4], f[5]); }
            {   const v2u w = kv2[j]; float f[4] = {bflo(w.x), bfhi(w.x), bflo(w.y), bfhi(w.y)};
                const float ss = (f[0] * f[0] + f[1] * f[1]) + (f[2] * f[2] + f[3] * f[3]);
                const float rs = rsqrtf(wave_sum(ss, lane) * (1.f / 256.f) + EPS);
                const f32x4 g = *(const f32x4*)(kvn + lane * 4);
                v2u o; o.x = pk2(f[0] * rs * g[0], f[1] * rs * g[1]); o.y = pk2(f[2] * rs * g[2], f[3] * rs * g[3]); *(v2u*)(CKVN + (size_t)r * 256 + lane * 4) = o; }
            {   const int jj = lane & 31; const float v = bf1(krv[j]); const float o = shx(v, 16, lane); float res = v;
                if (r < TL) { const int t = r & (SEQ - 1); const float c = ct[t * 16 + (jj & 15)], s = st[t * 16 + (jj & 15)]; res = (jj < 16) ? v * c - o * s : o * s + v * c; }
                if (lane < 32) KR[(size_t)r * 32 + jj] = (bf16)f2bf(res); }
            {   float gb[8], t0[8], t1[8], acc[8];
                unpack8(gbv[j], gb); unpack8(gcv[j + 1], t0); unpack8(xvv[j + 1], t1);
#pragma unroll
                for (int k = 0; k < 8; ++k) acc[k] = cw[512 + c0 + k] * (t0[k] * t1[k]);
                if (has_prev(r)) { unpack8(gcv[j], t0); unpack8(xvv[j], t1);
#pragma unroll
                    for (int k = 0; k < 8; ++k) acc[k] += cw[c0 + k] * (t0[k] * t1[k]); }
                if (has_next(r)) { unpack8(gcv[j + 2], t0); unpack8(xvv[j + 2], t1);
#pragma unroll
                    for (int k = 0; k < 8; ++k) acc[k] += cw[1024 + c0 + k] * (t0[k] * t1[k]); }
#pragma unroll
                for (int k = 0; k < 8; ++k) acc[k] *= gb[k];
                *(v4u*)(MIX + (size_t)r * D + 512 + c0) = pack8(acc); }
        } }
    }
}

__device__ __forceinline__ void ffn_fixup_panel(const Args& a, int l, int pm) {
    const bf16* Ue = (const bf16*)(a.ws + WS_UE); bf16* G = (bf16*)(a.ws + WS_G); const float* cw = a.in[I_FCONV] + (size_t)l * 3 * UPW;
    for (int idx = otid(a.wv); idx < 2 * (DFF / 8); idx += NTHR) {
        const int cg = idx % (DFF / 8), which = idx / (DFF / 8); const int c0 = cg * 8; const int col = (c0 / 128) * 256 + (c0 % 128);
        const int r = pm * 256 + (which ? 255 : 0);
        const bf16* e0 = Ue + (size_t)(pm * 4) * UPW + col;
        const bf16* pp = which ? e0 + 2 * UPW : e0 - UPW; const bf16* pc = which ? e0 + 3 * UPW : e0; const bf16* pn = which ? e0 + 4 * UPW : e0 + UPW;
        const bool hp = which ? true : has_prev(r), hn = which ? has_next(r) : true;
        float pa[8], pg[8], ca[8], cg_[8], na[8], ng[8];
        unpack8(*(const v4u*)pc, ca); unpack8(*(const v4u*)(pc + 128), cg_);
        if (hp) { unpack8(*(const v4u*)pp, pa); unpack8(*(const v4u*)(pp + 128), pg); } else {
#pragma unroll
            for (int k = 0; k < 8; ++k) { pa[k] = 0.f; pg[k] = 0.f; } }
        if (hn) { unpack8(*(const v4u*)pn, na); unpack8(*(const v4u*)(pn + 128), ng); } else {
#pragma unroll
            for (int k = 0; k < 8; ++k) { na[k] = 0.f; ng[k] = 0.f; } }
        float o[8];
#pragma unroll
        for (int k = 0; k < 8; ++k) { const float act = cw[c0 + k] * pa[k] + cw[UPW + c0 + k] * ca[k] + cw[2 * UPW + c0 + k] * na[k];
            const float gate = cw[DFF + c0 + k] * pg[k] + cw[UPW + DFF + c0 + k] * cg_[k] + cw[2 * UPW + DFF + c0 + k] * ng[k]; o[k] = silu_f(act) * gate; }
        *(v4u*)(G + (size_t)r * DFF + c0) = pack8(o);
    }
}

#ifndef MK_SINGLE
#define MK_SINGLE 1
#endif
struct GemmDesc { const bf16* A; const bf16* Bt; int M, N, K; bf16* O; int ldc; int mode; };

__global__ void __launch_bounds__(NTHR, 2) fwd_kernel(Args a_in) {
    extern __shared__ __attribute__((aligned(16))) unsigned char lds_raw[];
    LAS unsigned char* lds = (LAS unsigned char*)lds_raw;
#if MK_SINGLE == 1
    volatile LAS unsigned* bst = (volatile LAS unsigned*)(lds + LDS_BYTES - 64);
    const int wv0 = __builtin_amdgcn_readfirstlane((int)threadIdx.x >> 6);
    { const int t0 = otid(wv0); if (t0 < 16) bst[t0] = 0u; }
    __syncthreads();
    const XcdBarrier xbar = xcd_barrier_post((unsigned*)(a_in.ws + WS_CTL), bst, wv0);
#endif
    const Args& a0 = a_in;
#ifdef TDIAG
    unsigned long long tcat[6] = {0, 0, 0, 0, 0, 0}; unsigned long long tlast = __builtin_amdgcn_s_memrealtime();
#endif
    for (int s = a0.lo; s < a0.hi; ++s) {
        Args a = a0;
        { long oz; asm volatile("s_mov_b64 %0, 0" : "=s"(oz));
#pragma unroll
          for (int q = 0; q < 25; ++q) a.in[q] = (const float*)((const char*)a0.in[q] + oz);
          a.out = (float*)((char*)a0.out + oz); a.ws = a0.ws + oz; a.wv = wv0; }
        unsigned char* ws = a.ws;
        float* XL = a.out; float* XC = (float*)(ws + WS_XC); bf16* H = (bf16*)(ws + WS_H); bf16* Mb = (bf16*)(ws + WS_M);
        const float* MOD = (const float*)(ws + WS_MOD); const float* NW = a.in[I_NORMW];
        int nrep = 1;
#ifdef PROBE_MASK
        if (s == 0 && (PROBE_MASK >> 20 & 1u)) nrep = 2;
        if (s >= 2) { const int pk = (s - 2) % 10, ppar = ((s - 2) / 10) & 1; if ((PROBE_MASK >> (pk + 10 * ppar)) & 1u) nrep = 2; }
#endif
        for (int rep = 0; rep < nrep; ++rep) {
        GemmDesc g0{}, g1{}; int ng = 0;
#ifndef NO_SIMPLE
        if (s == 0) {
            mod_compute(a, lds);
            rope_tables(a);
            convert_layer(a, 0, lds);
        } else if (s == 1) {
            rowwise2<3>(a.in[I_X], a.in[I_CTX], XL, XC, nullptr, nullptr, nullptr, H, MOD, 0, 1024, NW, T, a.wv);
        } else {
            const int l = (s - 2) / 10, k = (s - 2) % 10, i = l >> 1; const bool even = (l & 1) == 0, last = (l == 3);
            const int MR = last ? TL : T;
            switch (k) {
            case 0:
                if (even) { g0 = GemmDesc{H, (const bf16*)(ws + W_IN), T, HYB_INP, D, (bf16*)(ws + WS_P), HYB_INP}; ng = 1; }
                else      { g0 = GemmDesc{H, (const bf16*)(ws + W_IN), T, SSD_INP, D, (bf16*)(ws + WS_ZX), SSD_INP}; ng = 1; }
                break;
            case 1: if (even) prep_even2(a, i); else ssd_conv2(a, i); break;
            case 2:
                if (even) { { g0 = GemmDesc{(const bf16*)(ws + WS_CQN), (const bf16*)(ws + W_UQ), T, QW, 384, (bf16*)(ws + WS_Q), QW}; ng = 1; }
                            g1 = GemmDesc{(const bf16*)(ws + WS_CKVN), (const bf16*)(ws + W_UKV), T, KVW, 256, (bf16*)(ws + WS_KV), KVW}; ng = 2; }
                else {
#ifdef SSD_NAIVE
 ssd_scan_naive(a, i, last, lds);
#else
 ssd_scan_mfma(a, i, last, lds);
#endif
 }
                break;
            case 3: if (even) {
#ifdef ATTN_NAIVE
 attn_naive(a, lds);
#else
 attn_mfma(a, lds);
#endif
 } else gatenorm2(a, i, MR); break;
            case 4:
                if (even) { g0 = GemmDesc{(const bf16*)(ws + WS_MIX), (const bf16*)(ws + W_OUT), MR, D, D, Mb, D}; ng = 1; }
                else      { g0 = GemmDesc{(const bf16*)(ws + WS_XBC), (const bf16*)(ws + W_OUT), MR, D, 2048, Mb, D}; ng = 1; }
                break;
            case 5:
#ifdef PROBE_ROW2
                if (l > 0) rowwise2<3>(XL, XC, XL, XC, nullptr, nullptr, nullptr, H, MOD + (size_t)l * 9 * MODW, 0, 1024, NW + (l * 4 + 0) * D, MR, a.wv);
#endif
                rowwise2<3>(XL, XC, XL, XC, Mb, MOD + (size_t)l * 9 * MODW + 2048, NW + (l * 4 + 1) * D, H, MOD + (size_t)l * 9 * MODW, 3072, 4096, NW + (l * 4 + 2) * D, MR, a.wv); break;
            case 6: { g0 = GemmDesc{H, (const bf16*)(ws + W_UP), MR, UPW, D, (bf16*)(ws + WS_G), DFF, 1}; ng = 1; } break;
            case 7: break;
            case 8: { g0 = GemmDesc{(const bf16*)(ws + WS_G), (const bf16*)(ws + W_DN), MR, D, DFF, Mb, D}; ng = 1;
                      pg8::StaticOrder S0; S0.init(MR, D, (int)gridDim.x, (int)blockIdx.x); pg8::Unit u0; int lastpm = -1;
                      for (int ui0 = 0; S0.next(ui0, u0); ++ui0) if (u0.pm != lastpm) { ffn_fixup_panel(a, l, u0.pm); lastpm = u0.pm; }
                      asm volatile("s_waitcnt vmcnt(0)" ::: "memory"); __syncthreads(); } break;
            case 9:
                if (!last) { rowwise2<3>(XL, XC, XL, XC, Mb, MOD + (size_t)l * 9 * MODW + 5120, NW + (l * 4 + 3) * D, H, MOD + (size_t)(l + 1) * 9 * MODW, 0, 1024, NW + ((l + 1) * 4 + 0) * D, T, a.wv);
                             convert_layer(a, l + 1, lds); }
                else rowwise2<3>(XL, XC, XL, XC, Mb, MOD + (size_t)l * 9 * MODW + 5120, NW + (l * 4 + 3) * D, nullptr, MOD, 0, 0, NW, TL, a.wv);
                break;
            }
        }
#else
        { g0 = GemmDesc{H, (const bf16*)(ws + W_IN), T, a.hi * 256, a.lo * 128, (bf16*)(ws + WS_P), HYB_INP}; ng = 1; }
#endif
        for (int gi = 0; gi < ng; ++gi) {
            const bool f = (gi == 0);
            pg8::Gemm g{f ? g0.A : g1.A, f ? g0.Bt : g1.Bt, f ? g0.M : g1.M, f ? g0.N : g1.N, f ? g0.K : g1.K, a.wv,
#ifdef GDIAG
                (s == GDIAG_STEP) ? (float*)(a0.ws + WS_MOD + 900 * 1024) : nullptr
#else
                nullptr
#endif
            }; pg8::StaticOrder S; S.init(g.M, g.N, (int)gridDim.x, (int)blockIdx.x);
            pg8::EpiFfn E{f ? g0.O : g1.O, f ? g0.ldc : g1.ldc, f ? g0.mode : 0, (bf16*)(ws + WS_UE), a.in[I_FCONV] + (size_t)((s - 2) / 10) * 3 * UPW, (LAS pg8::f32x4*)(lds + 131072), a.wv};
#ifndef NO_GEMM
            pg8::gemm_phase<pg8::EpiFfn, pg8::StaticOrder, true, true>(lds, g, S, E);
#endif
            __syncthreads();
        }
        if (rep + 1 < nrep) __syncthreads();
        }
#ifdef GDIAG
        if (s + 1 == a0.hi) { __syncthreads(); asm volatile("s_waitcnt vmcnt(0)" ::: "memory"); if (blockIdx.x == 0 && otid(wv0) == 0) { const float* dg = (const float*)(a0.ws + WS_MOD + 900 * 1024); a0.out[0] += 25.0f * dg[GDIAG_SEL] / dg[3]; } }
#endif
#ifdef SSD_DIAG
        if (s + 1 == a0.hi) { __syncthreads(); asm volatile("s_waitcnt vmcnt(0)" ::: "memory"); if (blockIdx.x == 0 && otid(wv0) == 0) { const float* dg = (const float*)(a0.ws + WS_MOD + 900 * 1024); a0.out[0] += 25.0f * dg[SSD_DIAG_SEL] / dg[7]; } }
#endif
#ifdef TDIAG
        if (s + 1 == a0.hi) { __syncthreads(); }
#endif
#ifdef BLK_JITTER
        if ((((int)blockIdx.x * 7 + s * 3) % 11) == 0) { for (int q = 0; q < 40; ++q) __builtin_amdgcn_s_sleep(127); }
#endif
        if (s + 1 < a0.hi && !(s >= 2 && (s - 2) % 10 == 7)) {
#if MK_SINGLE == 1
            xcd_barrier(xbar);
#ifdef PROBE_BAR2
            xcd_barrier(xbar);
#endif
#elif MK_SINGLE == 2
            cg::this_grid().sync();
#endif
        }
#ifdef TDIAG
        { const unsigned long long tn = __builtin_amdgcn_s_memrealtime(); int cat = 0;
          if (s >= 2) { const int k = (s - 2) % 10, par = ((s - 2) / 10) & 1; cat = (k == 0 || k == 4 || k == 6 || k == 8 || (k == 2 && par == 0)) ? 1 : ((k == 5 || k == 9) ? 2 : ((k == 3 && par == 0) ? 4 : ((k == 2 && par == 1) ? 5 : 3)));
#ifdef TDIAG_K
              cat = (k == TDIAG_K && (TDIAG_PAR == 2 || par == TDIAG_PAR)) ? 1 : 3;
#endif
          }
#pragma unroll
          for (int q = 0; q < 6; ++q) if (q == cat) tcat[q] += tn - tlast;
          tlast = tn;
          if (s + 1 == a0.hi) { asm volatile("s_waitcnt vmcnt(0)" ::: "memory"); if (blockIdx.x == 0 && otid(wv0) == 0) { unsigned long long tt = 0;
#pragma unroll
              for (int q = 0; q < 6; ++q) tt += tcat[q];
              a0.out[0] += (TDIAG == 6) ? (float)tt * (1.0f / 20000.0f) : 25.0f * (float)tcat[TDIAG < 6 ? TDIAG : 0] / (float)tt; } } }
#endif
    }
}

extern "C" void kernel_launch(void* const* d_in, const int* in_sizes, int n_in, void* d_out, int out_size, void* d_ws, size_t ws_size, hipStream_t stream) {
    static int grid = 0;
    if (grid == 0) {
        if (n_in != 25 || out_size != TL * D || ws_size < WS_END) { fprintf(stderr, "kernel_launch: unexpected problem (n_in %d out %d ws %zu need %zu)\n", n_in, out_size, ws_size, (size_t)WS_END); grid = -1; return; }
        if (hipFuncSetAttribute((const void*)fwd_kernel, hipFuncAttributeMaxDynamicSharedMemorySize, LDS_BYTES) != hipSuccess) { fprintf(stderr, "kernel_launch: hipFuncSetAttribute failed\n"); grid = -1; return; }
        int dev = 0, cus = 0, per_cu = 0;
        hipGetDevice(&dev); hipDeviceGetAttribute(&cus, hipDeviceAttributeMultiprocessorCount, dev);
        hipOccupancyMaxActiveBlocksPerMultiprocessor(&per_cu, (const void*)fwd_kernel, NTHR, LDS_BYTES);
        (void)hipGetLastError();
        if (per_cu < 1) { fprintf(stderr, "kernel_launch: occupancy query says %d blocks per CU\n", per_cu); }
        grid = cus;
    }
    if (grid < 0) return;
#if MK_SINGLE == 1
    if (hipMemsetAsync((char*)d_ws + WS_CTL, 0, CTL_ZERO_BYTES, stream) != hipSuccess) { fprintf(stderr, "kernel_launch: memset failed\n"); return; }
#endif
    Args a{};
    for (int i = 0; i < 25; ++i) a.in[i] = (const float*)d_in[i];
    a.out = (float*)d_out; a.ws = (unsigned char*)d_ws;
#if MK_SINGLE
    a.lo = 0; a.hi = NSTEP + 1;
    void* args[] = {&a};
    hipError_t e = hipLaunchCooperativeKernel((const void*)fwd_kernel, dim3(grid), dim3(NTHR), args, LDS_BYTES, stream);
    if (e != hipSuccess) fprintf(stderr, "cooperative launch failed: %s (grid %d)\n", hipGetErrorString(e), grid);
#else
    for (int s = 0; s < NSTEP + 1; ++s) { a.lo = s; a.hi = s + 1; hipLaunchKernelGGL(fwd_kernel, dim3(grid), dim3(NTHR), LDS_BYTES, stream, a); }
#endif
}
```

```cpp
#include <hip/hip_runtime.h>
#include <hip/hip_cooperative_groups.h>
#include <cstdio>
#include <cstdint>
namespace cg = cooperative_groups;
__device__ __forceinline__ int otid(int wv) { int l; asm volatile("v_mbcnt_lo_u32_b32 %0, -1, 0\n\tv_mbcnt_hi_u32_b32 %0, -1, %0" : "=v"(l)); return (wv << 6) | l; }
__device__ __forceinline__ float shx(float v, int mask, int lane) { return __builtin_bit_cast(float, __builtin_amdgcn_ds_bpermute((lane ^ mask) << 2, __builtin_bit_cast(int, v))); }
#define LAS __attribute__((address_space(3)))
typedef float f32x2_cv __attribute__((ext_vector_type(2))); typedef __bf16 bf16x2_cv __attribute__((ext_vector_type(2)));
__device__ __forceinline__ unsigned hw_cvtpk(float lo, float hi) { f32x2_cv v = {lo, hi}; bf16x2_cv b = __builtin_convertvector(v, bf16x2_cv); return __builtin_bit_cast(unsigned, b); }
#define XB_TMO      128
#define XB_XCNT(j)  (256  + 64 * (j))
#define XB_XSUB(j)  (1280 + 64 * (j))
#define XB_XGEN(j)  (2304 + 64 * (j))
#define XB_TOP      3328
#define XB_TOPGEN   3392
#define XCD_BAR_WORDS 3456
#define XB_SPIN_CAP (1u << 18)

__device__ __forceinline__ unsigned xb_ld(unsigned* p)              { return __hip_atomic_load(p, __ATOMIC_RELAXED, __HIP_MEMORY_SCOPE_AGENT); }
__device__ __forceinline__ unsigned xb_add(unsigned* p, unsigned v) { return __hip_atomic_fetch_add(p, v, __ATOMIC_RELAXED, __HIP_MEMORY_SCOPE_AGENT); }
__device__ __forceinline__ unsigned xb_xcc_id() { return (unsigned)__builtin_amdgcn_s_getreg((3 << 11) | 20) & 0xFu; }
#define XB_SPIN(cond, bar) do { unsigned _sp = 0; while (cond) { __builtin_amdgcn_s_sleep(1); \
    if ((++_sp & 255u) == 0u) { if (xb_ld(&(bar)[XB_TMO])) break; if (_sp > XB_SPIN_CAP) { atomicAdd(&(bar)[XB_TMO], 1u); break; } } } } while (0)

struct XcdBarrier {
    unsigned* bar; unsigned x; int wv;
    volatile LAS unsigned* st;
};

__device__ __forceinline__ XcdBarrier xcd_barrier_post(unsigned* bar, volatile LAS unsigned* st, int wv) {
    XcdBarrier b; b.bar = bar; b.x = xb_xcc_id(); b.st = st; b.wv = wv;
    if (otid(wv) == 0) (void)xb_add(&bar[XB_XCNT(b.x)], 1u);
    return b;
}
__device__ __forceinline__ void xcd_barrier_complete(unsigned* bar, unsigned x, unsigned& nloc, unsigned& nx) {
    const unsigned G = gridDim.x * gridDim.y * gridDim.z;
    unsigned sum, cnt, mine, sp = 0u;
    for (;;) {
        sum = 0u; cnt = 0u; mine = 0u;
#pragma unroll
        for (unsigned j = 0; j < 16; ++j) { const unsigned c = xb_ld(&bar[XB_XCNT(j)]); sum += c; cnt += (c > 0u) ? 1u : 0u; mine = (j == x) ? c : mine; }
        if (sum == G) break;
        __builtin_amdgcn_s_sleep(1);
        if ((++sp & 255u) == 0u) { if (xb_ld(&bar[XB_TMO])) break; if (sp > XB_SPIN_CAP) { atomicAdd(&bar[XB_TMO], 1u); break; } }
    }
    nloc = mine > 0u ? mine : 1u; nx = cnt > 0u ? cnt : 1u;
}

__device__ __forceinline__ void xcd_barrier(const XcdBarrier& b) {
    asm volatile("s_waitcnt vmcnt(0)" ::: "memory");
    __syncthreads();
    if (otid(b.wv) == 0) {
        unsigned* bar = b.bar;
        __builtin_amdgcn_s_waitcnt(0);
        unsigned nloc = b.st[0], nx = b.st[1];
        if (nloc == 0u) { xcd_barrier_complete(bar, b.x, nloc, nx); b.st[0] = nloc; b.st[1] = nx; }
        const unsigned old = xb_add(&bar[XB_XSUB(b.x)], 1u);
        const unsigned gen = old / nloc;
        if (old + 1u == (gen + 1u) * nloc) {
            __builtin_amdgcn_fence(__ATOMIC_RELEASE, "agent");
            asm volatile("s_waitcnt vmcnt(0)" ::: "memory");
            const unsigned og = xb_add(&bar[XB_TOP], 1u);
            const unsigned tg = og / nx;
            if (og + 1u == (tg + 1u) * nx) xb_add(&bar[XB_TOPGEN], 1u);
            else XB_SPIN(xb_ld(&bar[XB_TOPGEN]) == tg, bar);
            __builtin_amdgcn_fence(__ATOMIC_ACQUIRE, "agent");
            xb_add(&bar[XB_XGEN(b.x)], 1u);
            asm volatile("s_waitcnt vmcnt(0)" ::: "memory");
        } else {
            XB_SPIN(xb_ld(&bar[XB_XGEN(b.x)]) == gen, bar);
            __builtin_amdgcn_fence(__ATOMIC_ACQUIRE, "agent");
            asm volatile("s_waitcnt vmcnt(0)" ::: "memory");
        }
    }
    __syncthreads();
}
namespace pg8 {
#define PG8_LAS __attribute__((address_space(3)))
typedef unsigned short bf16_t;
typedef short bf16x8 __attribute__((ext_vector_type(8)));
typedef float f32x4 __attribute__((ext_vector_type(4)));
typedef unsigned u32x4 __attribute__((ext_vector_type(4)));
constexpr int BM = 256, BK = 64, HALF = 128, HTB = HALF * BK * 2  , STAGE_BYTES = 8 * HTB, NXCD = 8, WGM = 8;

__host__ __device__ __forceinline__ int lds_byte(int r, int c) { const int st = (r >> 4) * 2 + (c >> 5), rr = r & 15, cc = c & 31, ob = rr * 64 + cc * 2; return st * 1024 + (ob ^ (((ob >> 9) & 1) << 5)); }
__host__ __device__ __forceinline__ void stage_rc(int b, int& R, int& C) { const int st = b / 1024, sb = b % 1024, swz = sb ^ (((sb >> 9) & 1) << 5); R = (st >> 1) * 16 + swz / 64; C = (st & 1) * 32 + (swz % 64) / 2; }
__host__ __device__ __forceinline__ int perm32(int rho) { const int n = rho >> 4, i = rho & 15; return 8 * (i >> 2) + 4 * n + (i & 3); }

struct Unit { int pm, pn; };
struct Gemm { const bf16_t* A; const bf16_t* Bt; int M, N, K, wv; float* dg; int lda; };

struct StaticOrder {
    int nM, nN, nwg, G, c;
    __host__ __device__ void init(int M, int N, int G_, int c_) { nM = M / BM; nN = N / BM; nwg = nM * nN; G = G_; c = c_; }
    __host__ __device__ bool next(int i, Unit& u) const {
        const long L = (long)i * G + c; if (L >= nwg) return false;
        int wgid = (int)L; { const int q = nwg / NXCD, r = nwg % NXCD, xcd = wgid % NXCD, off = wgid / NXCD; wgid = (xcd < r ? xcd * (q + 1) : r * (q + 1) + (xcd - r) * q) + off; }
        const int nig = WGM * nN, gid = wgid / nig, fm = gid * WGM, gsz = (nM - fm) < WGM ? (nM - fm) : WGM;
        u.pm = fm + ((wgid % nig) % gsz); u.pn = (wgid % nig) / gsz; return true;
    }
    __device__ __forceinline__ void a_ready(const Unit&) const {}
    __device__ __forceinline__ void done(const Unit&) const {}
};

__device__ __forceinline__ unsigned cvt_pk_bf16(float lo, float hi) { return hw_cvtpk(lo, hi); }
struct EpiStore {
    static constexpr bool PERM = true, AFTER_DRAIN = false;
    bf16_t* O; int ldc;
    __device__ __forceinline__ void operator()(const f32x4 (&acc)[2][2][4][2], const Unit& u, int wr, int wc, int fr, int fq) const {
        const int row0 = u.pm * BM + wr * 64 + fr; const int col0 = u.pn * BM + wc * 32 + 8 * fq;
#pragma unroll
        for (int ai = 0; ai < 2; ++ai)
#pragma unroll
            for (int m = 0; m < 4; ++m) { bf16_t* rowp = O + (size_t)(row0 + ai * HALF + m * 16) * ldc + col0;
#pragma unroll
                for (int bj = 0; bj < 2; ++bj) { const f32x4 v0 = acc[ai][bj][m][0], v1 = acc[ai][bj][m][1];
                    u32x4 w; w.x = cvt_pk_bf16(v0[0], v0[1]); w.y = cvt_pk_bf16(v0[2], v0[3]); w.z = cvt_pk_bf16(v1[0], v1[1]); w.w = cvt_pk_bf16(v1[2], v1[3]);
                    *(u32x4*)(rowp + bj * HALF) = w; } }
    }
};

template <int CTRL> __device__ __forceinline__ float dpprot(float src) { return __builtin_bit_cast(float, __builtin_amdgcn_mov_dpp(__builtin_bit_cast(int, src), CTRL, 0xf, 0xf, true)); }
template <int CTRL> __device__ __forceinline__ float dppf(float old, float src) { return __builtin_bit_cast(float, __builtin_amdgcn_update_dpp(__builtin_bit_cast(int, old), __builtin_bit_cast(int, src), CTRL, 0xf, 0xf, false)); }
#define PG8_DPP4(dst, oldv, srcv, ctrl) do { dst[0] = dppf<ctrl>(oldv[0], srcv[0]); dst[1] = dppf<ctrl>(oldv[1], srcv[1]); dst[2] = dppf<ctrl>(oldv[2], srcv[2]); dst[3] = dppf<ctrl>(oldv[3], srcv[3]); } while (0)
struct EpiFfn {
    static constexpr bool PERM = true, AFTER_DRAIN = false;
    bf16_t* O; int ldc; int mode;
    const float* rs;
    bf16_t* Ue; const float* cw; PG8_LAS f32x4* ex; int wv;
    __device__ __forceinline__ void operator()(const f32x4 (&acc)[2][2][4][2], const Unit& u, int wr, int wc, int fr_in, int fq_in) const {
        (void)fr_in; (void)fq_in; const int lane_e = otid(wv) & 63; const int fr = lane_e & 15, fq = lane_e >> 4;
        if (mode != 1) {
            const int row0 = u.pm * BM + wr * 64 + fr; const int col0 = u.pn * BM + wc * 32 + 8 * fq;
#pragma unroll
            for (int ai = 0; ai < 2; ++ai)
#pragma unroll
                for (int m = 0; m < 4; ++m) { bf16_t* rowp = O + (size_t)(row0 + ai * HALF + m * 16) * ldc + col0;
                    const float rsc = (mode == 2) ? rs[row0 + ai * HALF + m * 16] : 1.0f;
#pragma unroll
                    for (int bj = 0; bj < 2; ++bj) { const f32x4 v0 = acc[ai][bj][m][0] * rsc, v1 = acc[ai][bj][m][1] * rsc;
                        u32x4 w; w.x = cvt_pk_bf16(v0[0], v0[1]); w.y = cvt_pk_bf16(v0[2], v0[3]); w.z = cvt_pk_bf16(v1[0], v1[1]); w.w = cvt_pk_bf16(v1[2], v1[3]);
                        *(u32x4*)(rowp + bj * HALF) = w; } }
            return;
        }
        const int chl = wc * 32 + 8 * fq, ch = u.pn * 128 + chl;
        f32x4 wA[3][2], wG[3][2];
#pragma unroll
        for (int t = 0; t < 3; ++t)
#pragma unroll
            for (int n = 0; n < 2; ++n) { wA[t][n] = *(const f32x4*)(cw + t * 5632 + ch + 4 * n); wG[t][n] = *(const f32x4*)(cw + t * 5632 + 2816 + ch + 4 * n); }
#define PG8_EX(blk, fl, bj, n) ex[((((blk) * 2 + (fl)) * 2 + (bj)) * 2 + (n)) * 16 + wc * 4 + fq]
#pragma unroll
        for (int ai = 0; ai < 2; ++ai) { const int blk = ai * 2 + wr;
            const bool lastr = fr == 15;
#pragma unroll
            for (int bj = 0; bj < 2; ++bj)
#pragma unroll
                for (int n = 0; n < 2; ++n) { const f32x4 a0 = acc[ai][bj][0][n], a3 = acc[ai][bj][3][n]; f32x4 v;
#pragma unroll
                    for (int e = 0; e < 4; ++e) v[e] = lastr ? a3[e] : a0[e];
                    if (fr == 0 || lastr) ex[((((blk) * 2 + (lastr ? 1 : 0)) * 2 + bj) * 2 + n) * 16 + wc * 4 + fq] = v; } }
        asm volatile("s_waitcnt lgkmcnt(0)" ::: "memory"); __builtin_amdgcn_s_barrier(); asm volatile("" ::: "memory");
        const f32x4 zero4 = (f32x4){0.f, 0.f, 0.f, 0.f}; const bool is15 = fr == 15, is0 = fr == 0;
#pragma unroll
        for (int ai = 0; ai < 2; ++ai) { const int blk = ai * 2 + wr;
            f32x4 pb[2][2], nb[2][2];
#pragma unroll
            for (int bj = 0; bj < 2; ++bj)
#pragma unroll
                for (int n = 0; n < 2; ++n) { pb[bj][n] = blk > 0 ? PG8_EX(blk - 1, 1, bj, n) : zero4; nb[bj][n] = blk < 3 ? PG8_EX(blk + 1, 0, bj, n) : zero4; }
#pragma unroll
            for (int m = 0; m < 4; ++m) {
                f32x4 cv[2][2];
#pragma unroll
                for (int bj = 0; bj < 2; ++bj)
#pragma unroll
                    for (int n = 0; n < 2; ++n) { const f32x4 cur = acc[ai][bj][m][n];
                        const f32x4 lo = (m == 0) ? pb[bj][n] : acc[ai][bj][m > 0 ? m - 1 : 0][n];
                        const f32x4 hi = (m == 3) ? nb[bj][n] : acc[ai][bj][m < 3 ? m + 1 : 3][n];
                        f32x4 prev, next;
#pragma unroll
                        for (int e = 0; e < 4; ++e) { prev[e] = dpprot<0x121>(is15 ? lo[e] : cur[e]);
                                                      next[e] = dpprot<0x12F>(is0 ? hi[e] : cur[e]); }
                        const f32x4 w0 = bj ? wG[0][n] : wA[0][n], w1 = bj ? wG[1][n] : wA[1][n], w2 = bj ? wG[2][n] : wA[2][n];
                        cv[bj][n] = w0 * prev + w1 * cur + w2 * next; }
                u32x4 w; float g[8];
#pragma unroll
                for (int n = 0; n < 2; ++n)
#pragma unroll
                    for (int e = 0; e < 4; ++e) { const float av = cv[0][n][e]; g[4 * n + e] = av * __builtin_amdgcn_rcpf(1.f + __expf(-av)) * cv[1][n][e]; }
                w.x = cvt_pk_bf16(g[0], g[1]); w.y = cvt_pk_bf16(g[2], g[3]); w.z = cvt_pk_bf16(g[4], g[5]); w.w = cvt_pk_bf16(g[6], g[7]);
                *(u32x4*)(O + (size_t)(u.pm * BM + ai * HALF + wr * 64 + m * 16 + fr) * 2816 + ch) = w;
            } }
#undef PG8_EX
        { const int slot = (wr == 0) ? (fr == 0 ? 0 : (fr == 1 ? 1 : -1)) : (fr == 14 ? 2 : (fr == 15 ? 3 : -1));
          if (slot >= 0) { bf16_t* up = Ue + ((size_t)(u.pm * 4 + slot) * 5632) + u.pn * 256 + chl;
#pragma unroll
              for (int bj = 0; bj < 2; ++bj) { const f32x4 a0 = acc[0][bj][0][0], a1 = acc[0][bj][0][1], b0 = acc[1][bj][3][0], b1 = acc[1][bj][3][1]; f32x4 v0, v1;
#pragma unroll
                  for (int e = 0; e < 4; ++e) { v0[e] = wr ? b0[e] : a0[e]; v1[e] = wr ? b1[e] : a1[e]; }
                  u32x4 w; w.x = cvt_pk_bf16(v0[0], v0[1]); w.y = cvt_pk_bf16(v0[2], v0[3]); w.z = cvt_pk_bf16(v1[0], v1[1]); w.w = cvt_pk_bf16(v1[2], v1[3]);
                  *(u32x4*)(up + bj * HALF) = w; } } }
    }
};
template <class Epi, class Sched, bool ALIGN_EPI = false, bool SP2 = false>
__device__ __forceinline__ void gemm_phase(PG8_LAS unsigned char* lds, const Gemm g, const Sched& S, const Epi& E) {
    const int tid = otid(g.wv), wid = g.wv, lane = tid & 63, wr = wid >> 2, wc = wid & 3, fr = lane & 15, fq = lane >> 4;
    const int K = g.K, nt = K / BK;
    unsigned voffA[2], voffB[2];
#pragma unroll
    for (int i = 0; i < 2; ++i) { int R, C; stage_rc(tid * 16 + i * 8192, R, C); const int Rb = Epi::PERM ? ((R & ~31) + perm32(R & 31)) : R;
        voffA[i] = (unsigned)(R * g.lda + C) * 2u; voffB[i] = (unsigned)(Rb * K + C) * 2u; }
    const size_t kstep = (size_t)(BK * 2);
    const size_t hstep = (size_t)HALF * K * 2;
    const size_t tstep = 2 * hstep;
    const size_t hstepA = (size_t)HALF * g.lda * 2, tstepA = 2 * hstepA;
    const unsigned ldsw = (unsigned)wid * 1024u;
    const int aoff = lds_byte(wr * 64 + fr, fq * 8), boff = lds_byte(wc * 32 + fr, fq * 8);
#define PG8_SA(b, h) (((b) * 2 + (h)) * HTB)
#define PG8_SB(b, h) ((4 + (b) * 2 + (h)) * HTB)
#define PG8_STAGE(bufoff, gbase, voff) do { _Pragma("unroll") for (int _i = 0; _i < 2; ++_i) \
        __builtin_amdgcn_global_load_lds((const unsigned*)((const char*)(gbase) + (voff)[_i]), (PG8_LAS unsigned*)(lds + (bufoff) + ldsw + _i * 8192), 16, 0, 0); } while (0)
#define PG8_LDA(dst, b, h) do { _Pragma("unroll") for (int m = 0; m < 4; ++m) _Pragma("unroll") for (int k = 0; k < 2; ++k) dst[m][k] = *(const PG8_LAS bf16x8*)(lds + PG8_SA(b, h) + aoff + m * 2048 + k * 1024); } while (0)
#define PG8_LDB(dst, b, h) do { _Pragma("unroll") for (int n = 0; n < 2; ++n) _Pragma("unroll") for (int k = 0; k < 2; ++k) dst[n][k] = *(const PG8_LAS bf16x8*)(lds + PG8_SB(b, h) + boff + n * 2048 + k * 1024); } while (0)
#define PG8_MMA(ai, bj, At, Bt) do { __builtin_amdgcn_s_setprio(1); _Pragma("unroll") for (int m = 0; m < 4; ++m) _Pragma("unroll") for (int n = 0; n < 2; ++n) _Pragma("unroll") for (int k = 0; k < 2; ++k) \
        acc[ai][bj][m][n] = __builtin_amdgcn_mfma_f32_16x16x32_bf16(Bt[n][k], At[m][k], acc[ai][bj][m][n], 0, 0, 0); __builtin_amdgcn_s_setprio(0); } while (0)
#define PG8_WAIT_V(n) asm volatile("s_waitcnt vmcnt(" #n ")" ::: "memory")
#define PG8_WAIT_L(n) asm volatile("s_waitcnt lgkmcnt(" #n ")" ::: "memory")
#define PG8_BAR __builtin_amdgcn_s_barrier()
#define PG8_SCHED __builtin_amdgcn_sched_barrier(0)
    Unit cur, nxt; int ui = 0;
#ifdef GDIAG
    unsigned gd0 = 0, gd1 = 0, gd2 = 0; const unsigned gstart = (unsigned)__builtin_amdgcn_s_memtime();
#endif
    if (!S.next(0, cur)) return;
    f32x4 acc[2][2][4][2];
#pragma unroll
    for (int a = 0; a < 2; ++a)
#pragma unroll
        for (int b = 0; b < 2; ++b)
#pragma unroll
            for (int m = 0; m < 4; ++m)
#pragma unroll
                for (int n = 0; n < 2; ++n) acc[a][b][m][n] = (f32x4){0.f, 0.f, 0.f, 0.f};
    bf16x8 At[4][2], B0[2][2], B1[2][2];
    const char* cA = (const char*)g.A + (size_t)cur.pm * tstepA; const char* cB = (const char*)g.Bt + (size_t)cur.pn * tstep;
    S.a_ready(cur);
    if constexpr (SP2) {
        PG8_STAGE(PG8_SB(0, 0), cB, voffB); PG8_STAGE(PG8_SB(0, 1), cB + hstep, voffB); PG8_STAGE(PG8_SA(0, 0), cA, voffA); PG8_STAGE(PG8_SA(0, 1), cA + hstepA, voffA);
        if (wr == 1) PG8_BAR;
        PG8_WAIT_V(2); PG8_BAR;
        PG8_STAGE(PG8_SB(1, 0), cB + kstep, voffB); PG8_STAGE(PG8_SA(1, 0), cA + kstep, voffA); PG8_STAGE(PG8_SB(1, 1), cB + hstep + kstep, voffB);
        PG8_WAIT_V(6); PG8_BAR;
    } else {
        PG8_STAGE(PG8_SB(0, 0), cB, voffB); PG8_STAGE(PG8_SA(0, 0), cA, voffA); PG8_STAGE(PG8_SB(0, 1), cB + hstep, voffB); PG8_STAGE(PG8_SA(0, 1), cA + hstepA, voffA);
        if (wr == 1) PG8_BAR;
        PG8_WAIT_V(4); PG8_BAR;
        PG8_STAGE(PG8_SB(1, 0), cB + kstep, voffB); PG8_STAGE(PG8_SA(1, 0), cA + kstep, voffA); PG8_STAGE(PG8_SB(1, 1), cB + hstep + kstep, voffB);
        PG8_WAIT_V(6); PG8_BAR;
    }
    for (;;) {
        const bool has_next = S.next(ui + 1, nxt);
        const char* nA = has_next ? (const char*)g.A + (size_t)nxt.pm * tstepA : cA; const char* nB = has_next ? (const char*)g.Bt + (size_t)nxt.pn * tstep : cB;
#ifdef GDIAG
        unsigned gt0 = (unsigned)__builtin_amdgcn_s_memtime();
#endif
        for (int t = 0; t < nt; t += 2) {
            const bool last = (t == nt - 2);
            const char* a1 = cA + (size_t)(t + 1) * kstep;
            const char* a2 = last ? nA : cA + (size_t)(t + 2) * kstep; const char* b2 = last ? nB : cB + (size_t)(t + 2) * kstep;
            const char* a3 = a2 + kstep; const char* b3 = b2 + kstep;
            if (last && has_next) S.a_ready(nxt);
            if constexpr (SP2) {
            PG8_LDB(B0, 0, 0); PG8_LDB(B1, 0, 1); PG8_SCHED; PG8_LDA(At, 0, 0); PG8_STAGE(PG8_SA(1, 1), a1 + hstepA, voffA);
            PG8_WAIT_V(8); PG8_WAIT_L(0); PG8_BAR; PG8_MMA(0, 0, At, B0); PG8_MMA(0, 1, At, B1); PG8_BAR; PG8_SCHED;
            PG8_LDA(At, 0, 1); PG8_STAGE(PG8_SB(0, 0), b2, voffB); PG8_STAGE(PG8_SB(0, 1), b2 + hstep, voffB); PG8_STAGE(PG8_SA(0, 0), a2, voffA);
            PG8_WAIT_V(8); PG8_WAIT_L(0); PG8_BAR; PG8_MMA(1, 0, At, B0); PG8_MMA(1, 1, At, B1); PG8_BAR; PG8_SCHED;
            PG8_LDB(B0, 1, 0); PG8_LDB(B1, 1, 1); PG8_SCHED; PG8_LDA(At, 1, 0); PG8_STAGE(PG8_SA(0, 1), a2 + hstepA, voffA);
            PG8_WAIT_V(8); PG8_WAIT_L(0); PG8_BAR; PG8_MMA(0, 0, At, B0); PG8_MMA(0, 1, At, B1); PG8_BAR; PG8_SCHED;
            PG8_LDA(At, 1, 1); PG8_STAGE(PG8_SB(1, 0), b3, voffB); PG8_STAGE(PG8_SB(1, 1), b3 + hstep, voffB); PG8_STAGE(PG8_SA(1, 0), a3, voffA);
            PG8_WAIT_V(8); PG8_WAIT_L(0); PG8_BAR; PG8_MMA(1, 0, At, B0); PG8_MMA(1, 1, At, B1); PG8_BAR; PG8_SCHED;
            } else {
            PG8_LDB(B0, 0, 0); PG8_SCHED; PG8_LDA(At, 0, 0); PG8_STAGE(PG8_SA(1, 1), a1 + hstepA, voffA);
            PG8_WAIT_L(8); PG8_BAR; PG8_WAIT_L(0); PG8_MMA(0, 0, At, B0); PG8_BAR; PG8_SCHED;
            PG8_LDB(B1, 0, 1); PG8_STAGE(PG8_SB(0, 0), b2, voffB);
            PG8_BAR; PG8_WAIT_L(0); PG8_MMA(0, 1, At, B1); PG8_BAR;
            PG8_LDA(At, 0, 1); PG8_STAGE(PG8_SA(0, 0), a2, voffA);
            PG8_BAR; PG8_WAIT_L(0); PG8_MMA(1, 0, At, B0); PG8_BAR; PG8_SCHED;
            PG8_STAGE(PG8_SB(0, 1), b2 + hstep, voffB);
            PG8_WAIT_V(6); PG8_BAR; PG8_MMA(1, 1, At, B1); PG8_BAR;
            PG8_LDB(B0, 1, 0); PG8_SCHED; PG8_LDA(At, 1, 0); PG8_STAGE(PG8_SA(0, 1), a2 + hstepA, voffA);
            PG8_WAIT_L(8); PG8_BAR; PG8_WAIT_L(0); PG8_MMA(0, 0, At, B0); PG8_BAR; PG8_SCHED;
            PG8_LDB(B1, 1, 1); PG8_STAGE(PG8_SB(1, 0), b3, voffB);
            PG8_BAR; PG8_WAIT_L(0); PG8_MMA(0, 1, At, B1); PG8_BAR;
            PG8_LDA(At, 1, 1); PG8_STAGE(PG8_SA(1, 0), a3, voffA);
            PG8_BAR; PG8_WAIT_L(0); PG8_MMA(1, 0, At, B0); PG8_BAR; PG8_SCHED;
            PG8_STAGE(PG8_SB(1, 1), b3 + hstep, voffB);
            PG8_WAIT_V(6); PG8_BAR; PG8_MMA(1, 1, At, B1); PG8_BAR;
            }
        }
#ifdef GDIAG
        { const unsigned n_ = (unsigned)__builtin_amdgcn_s_memtime(); gd0 += n_ - gt0; gt0 = n_; }
#endif
        if constexpr (ALIGN_EPI) { if (wr == 0) PG8_BAR; }
#ifdef GDIAG
        { const unsigned n_ = (unsigned)__builtin_amdgcn_s_memtime(); gd1 += n_ - gt0; gt0 = n_; }
#endif
        if constexpr (!Epi::AFTER_DRAIN) { E(acc, cur, wr, wc, fr, fq); S.done(cur); }
#ifdef GDIAG
        { const unsigned n_ = (unsigned)__builtin_amdgcn_s_memtime(); gd2 += n_ - gt0; gt0 = n_; }
#endif
        if (!has_next) break;
#pragma unroll
        for (int a = 0; a < 2; ++a)
#pragma unroll
            for (int b = 0; b < 2; ++b)
#pragma unroll
                for (int m = 0; m < 4; ++m)
#pragma unroll
                    for (int n = 0; n < 2; ++n) acc[a][b][m][n] = (f32x4){0.f, 0.f, 0.f, 0.f};
        cur = nxt; cA = nA; cB = nB; ++ui;
        if constexpr (ALIGN_EPI) { if (wr == 1) PG8_BAR; }
    }
#ifdef GDIAG
    if (g.dg && blockIdx.x == 0 && wid == GDIAG_WAVE && lane == 0) { const unsigned tot = (unsigned)__builtin_amdgcn_s_memtime() - gstart; g.dg[0] = (float)gd0; g.dg[1] = (float)gd1; g.dg[2] = (float)gd2; g.dg[3] = (float)tot; }
#endif
    PG8_WAIT_V(0);
    if constexpr (!ALIGN_EPI) { if (wr == 0) PG8_BAR; }
    PG8_BAR;
    if constexpr (Epi::AFTER_DRAIN) { E.fused(acc, cur, wr, wc, fr, fq, lds, wid, lane); S.done(cur); }
#undef PG8_SA
#undef PG8_SB
#undef PG8_STAGE
#undef PG8_LDA
#undef PG8_LDB
#undef PG8_MMA
#undef PG8_WAIT_V
#undef PG8_WAIT_L
#undef PG8_BAR
#undef PG8_SCHED
}
}

typedef unsigned short bf16;
typedef unsigned v4u __attribute__((ext_vector_type(4)));
typedef unsigned v2u __attribute__((ext_vector_type(2)));
typedef float f32x4 __attribute__((ext_vector_type(4)));
constexpr int NWAVES = 8, NTHR = 512;
constexpr int D = 1024, NB = 8, SEQ = 2048, CTXL = 256, TL = NB * SEQ, TC = NB * CTXL, T = TL + TC;
constexpr int HYB_IN = 2208, HYB_INP = 2304, SSD_IN = 5184, SSD_INP = 5376, DFF = 2816, UPW = 5632;
constexpr int QW = 768, KVW = 1024, MODW = 6144;
constexpr float EPS = 1e-6f;
constexpr int NSTEP = 1 + 4 * 10;
constexpr float ATT_SCALE_LOG2E = 0.10206207261596577f * 1.4426950408889634f;

constexpr size_t MiB = 1u << 20;
constexpr size_t WS_CTL = 0, CTL_ZERO_BYTES = 64 * 1024;
constexpr size_t WS_MOD = 1 * MiB;
constexpr size_t WS_ROPE = 2 * MiB;
constexpr size_t W_UP = 3 * MiB;
constexpr size_t W_DN = W_UP + (size_t)UPW * D * 2;
constexpr size_t W_IN = W_DN + (size_t)D * DFF * 2;
constexpr size_t W_OUT = W_IN + (size_t)SSD_INP * D * 2;
constexpr size_t W_UQ = W_OUT + (size_t)D * 2048 * 2;
constexpr size_t W_UKV = W_UQ + (size_t)QW * 384 * 2;
constexpr size_t W_END = W_UKV + (size_t)KVW * 256 * 2;
constexpr size_t WS_XC = 36 * MiB;
constexpr size_t WS_H = 44 * MiB;
constexpr size_t WS_DT = WS_H, WS_AA = WS_H + (size_t)T * 64 * 4;
constexpr size_t WS_SS = WS_AA + (size_t)T * 64 * 4;
constexpr size_t WS_RS = WS_SS + (size_t)T * 64 * 4;
constexpr size_t WS_BIG = 80 * MiB;
constexpr size_t WS_M = WS_BIG;
constexpr size_t WS_P = WS_BIG;
constexpr size_t WS_Q = WS_BIG + 81 * MiB;
constexpr size_t WS_KV = WS_BIG + 108 * MiB;
constexpr size_t WS_KR = WS_BIG + 144 * MiB;
constexpr size_t WS_CQN = WS_BIG + 146 * MiB;
constexpr size_t WS_CKVN = WS_BIG + 160 * MiB;
constexpr size_t WS_MIX = WS_BIG + 170 * MiB;
constexpr size_t WS_U = WS_BIG;
constexpr size_t WS_G = WS_BIG + 198 * MiB;
constexpr size_t WS_ZX = WS_BIG;
constexpr size_t WS_XBC = WS_BIG + 189 * MiB;
constexpr size_t WS_UE = WS_BIG + 297 * MiB;
constexpr size_t WS_END = WS_UE + 4 * MiB;
static_assert(W_END <= WS_XC && WS_G + (size_t)T * DFF * 2 <= WS_END && WS_XBC + (size_t)T * 3072 * 2 <= WS_END && WS_ZX + (size_t)T * SSD_INP * 2 <= WS_XBC, "ws map");
static_assert(WS_RS + (size_t)T * 4 <= WS_BIG && WS_MIX + (size_t)T * D * 2 <= WS_END && WS_Q + (size_t)T * QW * 2 <= WS_KV && WS_P + (size_t)T * HYB_INP * 2 <= WS_Q, "ws map 2");
constexpr int LDS_BYTES = 147456;

struct Args { const float* in[25]; float* out; unsigned char* ws; int lo, hi; int wv, pad; };
enum { I_X = 0, I_C, I_CTX, I_CCTX, I_MODW, I_MODB, I_NORMW, I_WUP, I_FCONV, I_WDN, I_HIN, I_QNORM, I_KVNORM, I_WUQ, I_WUKV, I_SCONV, I_HOUT, I_SIN, I_SCONVW, I_SCONVB, I_ALOG, I_DTB, I_SD, I_SNORM, I_SOUT };

__device__ __forceinline__ unsigned f2bf(float f) { unsigned u = __builtin_bit_cast(unsigned, f); return (u + 0x7fffu + ((u >> 16) & 1u)) >> 16; }
__device__ __forceinline__ unsigned pk2(float lo, float hi) { return hw_cvtpk(lo, hi); }
__device__ __forceinline__ float bflo(unsigned u) { return __builtin_bit_cast(float, u << 16); }
__device__ __forceinline__ float bfhi(unsigned u) { return __builtin_bit_cast(float, u & 0xffff0000u); }
__device__ __forceinline__ float bf1(bf16 b) { return __builtin_bit_cast(float, (unsigned)b << 16); }
__device__ __forceinline__ float silu_f(float x) { return x * __builtin_amdgcn_rcpf(1.f + __expf(-x)); }
__device__ __forceinline__ float wave_sum(float v, int lane) {
#pragma unroll
    for (int o = 1; o < 64; o <<= 1) v += shx(v, o, lane);
    return v;
}
__device__ __forceinline__ void unpack8(const v4u w, float (&f)[8]) { f[0] = bflo(w.x); f[1] = bfhi(w.x); f[2] = bflo(w.y); f[3] = bfhi(w.y); f[4] = bflo(w.z); f[5] = bfhi(w.z); f[6] = bflo(w.w); f[7] = bfhi(w.w); }
__device__ __forceinline__ v4u pack8(const float (&f)[8]) { v4u w; w.x = pk2(f[0], f[1]); w.y = pk2(f[2], f[3]); w.z = pk2(f[4], f[5]); w.w = pk2(f[6], f[7]); return w; }
__device__ __forceinline__ bool has_prev(int r) { return r < TL ? (r & (SEQ - 1)) != 0 : ((r - TL) & (CTXL - 1)) != 0; }
__device__ __forceinline__ bool has_next(int r) { return r < TL ? (r & (SEQ - 1)) != SEQ - 1 : ((r - TL) & (CTXL - 1)) != CTXL - 1; }

__device__ __forceinline__ void mod_compute(const Args& a, LAS unsigned char* lds) {
    LAS float* sc = (LAS float*)lds;
    LAS float* red = (LAS float*)(lds + 36864);
    const int tid = otid(a.wv);
    float* MOD = (float*)(a.ws + WS_MOD);
    for (int i = tid; i < 9 * 1024; i += NTHR) { const int c = i >> 10, k = i & 1023; const float v = c < 8 ? a.in[I_C][c * 1024 + k] : a.in[I_CCTX][k]; sc[i] = silu_f(v); }
    __syncthreads();
    for (int item = blockIdx.x; item < 4 * 96; item += gridDim.x) {
        const int l = item / 96, cb = item % 96;
        const float* W = a.in[I_MODW] + (size_t)l * 1024 * MODW + cb * 64;
        const int cgp = tid & 15, kg = tid >> 4;
        float acc[9][4];
#pragma unroll
        for (int c = 0; c < 9; ++c) { acc[c][0] = 0.f; acc[c][1] = 0.f; acc[c][2] = 0.f; acc[c][3] = 0.f; }
#pragma unroll 8
        for (int kk = 0; kk < 32; ++kk) { const int k = kg * 32 + kk; const f32x4 w = *(const f32x4*)(W + (size_t)k * MODW + cgp * 4);
#pragma unroll
            for (int c = 0; c < 9; ++c) { const float s = sc[c * 1024 + k]; acc[c][0] += s * w[0]; acc[c][1] += s * w[1]; acc[c][2] += s * w[2]; acc[c][3] += s * w[3]; } }
#pragma unroll
        for (int c = 0; c < 9; ++c)
#pragma unroll
            for (int j = 0; j < 4; ++j) red[kg * 576 + c * 64 + cgp * 4 + j] = acc[c][j];
        __syncthreads();
        for (int o = tid; o < 576; o += NTHR) { float s = 0.f;
            for (int g = 0; g < 32; ++g) s += red[g * 576 + o];
            const int c = o >> 6, col = o & 63; MOD[(size_t)(l * 9 + c) * MODW + cb * 64 + col] = s + a.in[I_MODB][l * MODW + cb * 64 + col]; }
        __syncthreads();
    }
}
__device__ __forceinline__ void rope_tables(const Args& a) {
    float* ct = (float*)(a.ws + WS_ROPE); float* st = ct + SEQ * 16;
    for (int i = blockIdx.x * NTHR + otid(a.wv); i < SEQ * 16; i += gridDim.x * NTHR) {
        const int t = i >> 4, j = i & 15; const int pos = j < 8 ? (t >> 6) : (t & 63); const int f = j & 7;
        const float i0 = (f & 1) ? 0.31622776601683794f : 1.0f; const int e = f >> 1; const float i1 = e == 0 ? 1.0f : (e == 1 ? 0.1f : (e == 2 ? 0.01f : 0.001f));
        const float inv = i0 * i1; const float ang = (float)pos * inv;
        ct[i] = __cosf(ang); st[i] = __sinf(ang); }
}
__device__ __forceinline__ void transpose_item(const float* W, int K, int N, bf16* WT, LAS float* scr, int item, int lane, bool ffn_perm, const float* ksc) {
    const int nblk = N / 32, kb = item / nblk, nb = item % nblk, k0 = 64 * kb, n0 = 32 * nb;
    const int o0 = ffn_perm ? ((n0 % DFF) / 128) * 256 + (n0 / DFF) * 128 + (n0 % 128) : n0;
    float wv_[32];
#pragma unroll
    for (int i = 0; i < 32; ++i) wv_[i] = W[(size_t)(k0 + 2 * i + (lane >> 5)) * N + n0 + (lane & 31)];
    if (ksc) {
#pragma unroll
        for (int i = 0; i < 32; ++i) wv_[i] *= ksc[k0 + 2 * i + (lane >> 5)]; }
#pragma unroll
    for (int i = 0; i < 32; ++i) scr[(2 * i + (lane >> 5)) * 33 + (lane & 31)] = wv_[i];
    asm volatile("s_waitcnt lgkmcnt(0)" ::: "memory");
    const int c = lane & 7;
#pragma unroll
    for (int j = 0; j < 4; ++j) { const int n = (lane >> 3) + 8 * j; const LAS float* s = scr + (8 * c) * 33 + n;
        v4u o; o.x = pk2(s[0 * 33], s[1 * 33]); o.y = pk2(s[2 * 33], s[3 * 33]); o.z = pk2(s[4 * 33], s[5 * 33]); o.w = pk2(s[6 * 33], s[7 * 33]);
        *(v4u*)(WT + (size_t)(o0 + n) * K + k0 + 8 * c) = o; }
    asm volatile("s_waitcnt lgkmcnt(0)" ::: "memory");
}
__device__ __forceinline__ void convert_weight(const float* W, int K, int N, int Npad, bf16* WT, LAS unsigned char* lds, int rot, int wv, bool ffn_perm = false, const float* ksc = nullptr) {
    const int wave = wv, lane = otid(wv) & 63; const int NGW = gridDim.x * NWAVES; const int gw = (blockIdx.x * NWAVES + wave + rot) % NGW;
    LAS float* scr = (LAS float*)(lds + wave * 16384);
    const int nitems = (K / 64) * (N / 32);
    for (int it = gw; it < nitems; it += NGW) transpose_item(W, K, N, WT, scr, it, lane, ffn_perm, ksc);
    (void)Npad;
}
__device__ __forceinline__ void convert_layer(const Args& a, int l, LAS unsigned char* lds) {
    const int i = l >> 1; unsigned char* ws = a.ws;
    convert_weight(a.in[I_WUP] + (size_t)l * D * UPW, D, UPW, UPW, (bf16*)(ws + W_UP), lds, 0, a.wv, true);
    convert_weight(a.in[I_WDN] + (size_t)l * DFF * D, DFF, D, D, (bf16*)(ws + W_DN), lds, 300, a.wv);
    if ((l & 1) == 0) {
        convert_weight(a.in[I_HIN] + (size_t)i * D * HYB_IN, D, HYB_IN, HYB_INP, (bf16*)(ws + W_IN), lds, 700, a.wv);
        convert_weight(a.in[I_HOUT] + (size_t)i * D * D, D, D, D, (bf16*)(ws + W_OUT), lds, 1100, a.wv);
        convert_weight(a.in[I_WUQ] + (size_t)i * 384 * QW, 384, QW, QW, (bf16*)(ws + W_UQ), lds, 1500, a.wv);
        convert_weight(a.in[I_WUKV] + (size_t)i * 256 * KVW, 256, KVW, KVW, (bf16*)(ws + W_UKV), lds, 1700, a.wv);
    } else {
        convert_weight(a.in[I_SIN] + (size_t)i * D * SSD_IN, D, SSD_IN, SSD_INP, (bf16*)(ws + W_IN), lds, 700, a.wv);
        convert_weight(a.in[I_SOUT] + (size_t)i * 2048 * D, 2048, D, D, (bf16*)(ws + W_OUT), lds, 1300, a.wv, false, a.in[I_SNORM] + i * 2048);
    }
}

__device__ __forceinline__ void prep_even(const Args& a, int i) {
    const int wave = otid(a.wv) >> 6, lane = otid(a.wv) & 63; const int NGW = gridDim.x * NWAVES, gw = blockIdx.x * NWAVES + wave;
    const bf16* P = (const bf16*)(a.ws + WS_P); bf16* CQN = (bf16*)(a.ws + WS_CQN); bf16* CKVN = (bf16*)(a.ws + WS_CKVN); bf16* KR = (bf16*)(a.ws + WS_KR); bf16* MIX = (bf16*)(a.ws + WS_MIX);
    const float* qn = a.in[I_QNORM] + i * 384; const float* kvn = a.in[I_KVNORM] + i * 256; const float* cw = a.in[I_SCONV] + i * 3 * 512;
    const float* ct = (const float*)(a.ws + WS_ROPE); const float* st = ct + SEQ * 16;
    for (int r = gw; r < T; r += NGW) {
        const bf16* p = P + (size_t)r * HYB_INP;
        {
            const unsigned* p32 = (const unsigned*)(p + lane * 6); const unsigned w0 = p32[0], w1 = p32[1], w2 = p32[2];
            float f[6] = {bflo(w0), bfhi(w0), bflo(w1), bfhi(w1), bflo(w2), bfhi(w2)}; float ss = 0.f;
#pragma unroll
            for (int j = 0; j < 6; ++j) ss += f[j] * f[j];
            const float rs = rsqrtf(wave_sum(ss, lane) * (1.f / 384.f) + EPS);
#pragma unroll
            for (int j = 0; j < 6; ++j) f[j] = f[j] * rs * qn[lane * 6 + j];
            unsigned* o32 = (unsigned*)(CQN + (size_t)r * 384 + lane * 6); o32[0] = pk2(f[0], f[1]); o32[1] = pk2(f[2], f[3]); o32[2] = pk2(f[4], f[5]);
        }
        {
            const v2u w = *(const v2u*)(p + 384 + lane * 4); float f[4] = {bflo(w.x), bfhi(w.x), bflo(w.y), bfhi(w.y)};
            const float ss = (f[0] * f[0] + f[1] * f[1]) + (f[2] * f[2] + f[3] * f[3]);
            const float rs = rsqrtf(wave_sum(ss, lane) * (1.f / 256.f) + EPS);
            const f32x4 g = *(const f32x4*)(kvn + lane * 4);
            v2u o; o.x = pk2(f[0] * rs * g[0], f[1] * rs * g[1]); o.y = pk2(f[2] * rs * g[2], f[3] * rs * g[3]); *(v2u*)(CKVN + (size_t)r * 256 + lane * 4) = o;
        }
        {
            const int j = lane & 31; const float v = bf1(p[640 + j]); const float o = shx(v, 16, lane); float res = v;
            if (r < TL) { const int t = r & (SEQ - 1); const float c = ct[t * 16 + (j & 15)], s = st[t * 16 + (j & 15)]; res = (j < 16) ? v * c - o * s : o * s + v * c; }
            if (lane < 32) KR[(size_t)r * 32 + j] = (bf16)f2bf(res);
        }
        {
            const int c0 = lane * 8; float gb[8], cur[8], acc[8], t0[8], t1[8];
            unpack8(*(const v4u*)(p + 672 + c0), gb);
            unpack8(*(const v4u*)(p + 1184 + c0), t0); unpack8(*(const v4u*)(p + 1696 + c0), t1);
#pragma unroll
            for (int j = 0; j < 8; ++j) { cur[j] = t0[j] * t1[j]; acc[j] = cw[512 + c0 + j] * cur[j]; }
            if (has_prev(r)) { unpack8(*(const v4u*)(p - HYB_INP + 1184 + c0), t0); unpack8(*(const v4u*)(p - HYB_INP + 1696 + c0), t1);
#pragma unroll
                for (int j = 0; j < 8; ++j) acc[j] += cw[c0 + j] * (t0[j] * t1[j]); }
            if (has_next(r)) { unpack8(*(const v4u*)(p + HYB_INP + 1184 + c0), t0); unpack8(*(const v4u*)(p + HYB_INP + 1696 + c0), t1);
#pragma unroll
                for (int j = 0; j < 8; ++j) acc[j] += cw[1024 + c0 + j] * (t0[j] * t1[j]); }
#pragma unroll
            for (int j = 0; j < 8; ++j) acc[j] *= gb[j];
            *(v4u*)(MIX + (size_t)r * D + 512 + c0) = pack8(acc);
        }
    }
}

__device__ __forceinline__ void convgate(const Args& a, int l, int nrows) {
    const bf16* U = (const bf16*)(a.ws + WS_U); bf16* G = (bf16*)(a.ws + WS_G); const float* cw = a.in[I_FCONV] + (size_t)l * 3 * UPW;
    const int total = nrows * (DFF / 8);
    for (int idx = blockIdx.x * NTHR + otid(a.wv); idx < total; idx += gridDim.x * NTHR) {
        const int r = idx / (DFF / 8), c0 = (idx % (DFF / 8)) * 8; const bf16* u = U + (size_t)r * UPW + c0;
        float ua[8], ug[8], act[8], gate[8];
        unpack8(*(const v4u*)u, ua); unpack8(*(const v4u*)(u + DFF), ug);
#pragma unroll
        for (int j = 0; j < 8; ++j) { act[j] = cw[UPW + c0 + j] * ua[j]; gate[j] = cw[UPW + DFF + c0 + j] * ug[j]; }
        if (has_prev(r)) { unpack8(*(const v4u*)(u - UPW), ua); unpack8(*(const v4u*)(u - UPW + DFF), ug);
#pragma unroll
            for (int j = 0; j < 8; ++j) { act[j] += cw[c0 + j] * ua[j]; gate[j] += cw[DFF + c0 + j] * ug[j]; } }
        if (has_next(r)) { unpack8(*(const v4u*)(u + UPW), ua); unpack8(*(const v4u*)(u + UPW + DFF), ug);
#pragma unroll
            for (int j = 0; j < 8; ++j) { act[j] += cw[2 * UPW + c0 + j] * ua[j]; gate[j] += cw[2 * UPW + DFF + c0 + j] * ug[j]; } }
#pragma unroll
        for (int j = 0; j < 8; ++j) act[j] = silu_f(act[j]) * gate[j];
        *(v4u*)(G + (size_t)r * DFF + c0) = pack8(act);
    }
}

__device__ __forceinline__ void ssd_conv(const Args& a, int i) {
    const bf16* ZX = (const bf16*)(a.ws + WS_ZX); bf16* XBC = (bf16*)(a.ws + WS_XBC); float* DT = (float*)(a.ws + WS_DT); float* AA = (float*)(a.ws + WS_AA);
    const float* cw = a.in[I_SCONVW] + (size_t)i * 3 * 3072; const float* cb = a.in[I_SCONVB] + (size_t)i * 3072;
    const int total = T * 384;
    for (int idx = blockIdx.x * NTHR + otid(a.wv); idx < total; idx += gridDim.x * NTHR) {
        const int r = idx / 384, c0 = (idx % 384) * 8; const bf16* u = ZX + (size_t)r * SSD_INP + 2048 + c0;
        float x[8], acc[8];
        unpack8(*(const v4u*)u, x);
#pragma unroll
        for (int j = 0; j < 8; ++j) acc[j] = cb[c0 + j] + cw[3072 + c0 + j] * x[j];
        if (has_prev(r)) { unpack8(*(const v4u*)(u - SSD_INP), x);
#pragma unroll
            for (int j = 0; j < 8; ++j) acc[j] += cw[c0 + j] * x[j]; }
        if (has_next(r)) { unpack8(*(const v4u*)(u + SSD_INP), x);
#pragma unroll
            for (int j = 0; j < 8; ++j) acc[j] += cw[2 * 3072 + c0 + j] * x[j]; }
#pragma unroll
        for (int j = 0; j < 8; ++j) acc[j] = silu_f(acc[j]);
        *(v4u*)(XBC + (size_t)r * 3072 + c0) = pack8(acc);
    }
    const float* alog = a.in[I_ALOG] + i * 64; const float* dtb = a.in[I_DTB] + i * 64;
    for (int idx = blockIdx.x * NTHR + otid(a.wv); idx < T * 64; idx += gridDim.x * NTHR) {
        const int r = idx >> 6, j = idx & 63; const float raw = bf1(ZX[(size_t)r * SSD_INP + 5120 + j]) + dtb[j];
        const float dt = raw > 15.f ? raw : (raw < -15.f ? __expf(raw) : __logf(1.f + __expf(raw)));
        DT[idx] = dt; AA[idx] = -__expf(alog[j]) * dt;
    }
}

__device__ __forceinline__ void gatenorm(const Args& a, int i, int nrows) {
    const int wave = otid(a.wv) >> 6, lane = otid(a.wv) & 63; const int NGW = gridDim.x * NWAVES, gw = blockIdx.x * NWAVES + wave;
    const bf16* ZX = (const bf16*)(a.ws + WS_ZX); bf16* YN = (bf16*)(a.ws + WS_XBC); const float* nw = a.in[I_SNORM] + i * 2048;
    for (int r = gw; r < nrows; r += NGW) {
        float v[4][8]; float ss = 0.f;
#pragma unroll
        for (int j = 0; j < 4; ++j) { float y[8], z[8]; const int c = j * 512 + lane * 8;
            unpack8(*(const v4u*)(ZX + (size_t)r * SSD_INP + 2048 + c), y); unpack8(*(const v4u*)(ZX + (size_t)r * SSD_INP + c), z);
#pragma unroll
            for (int k = 0; k < 8; ++k) { v[j][k] = y[k] * silu_f(z[k]); ss += v[j][k] * v[j][k]; } }
        const float rs = rsqrtf(wave_sum(ss, lane) * (1.f / 2048.f) + EPS);
#pragma unroll
        for (int j = 0; j < 4; ++j) { const int c = j * 512 + lane * 8; float o[8];
#pragma unroll
            for (int k = 0; k < 8; ++k) o[k] = v[j][k] * rs * nw[c + k];
            *(v4u*)(YN + (size_t)r * 2048 + c) = pack8(o); }
    }
}

__device__ __forceinline__ void attn_naive(const Args& a, LAS unsigned char* lds) {
    const int tid = otid(a.wv), qi = tid >> 1, half = tid & 1;
    const bf16* Qb = (const bf16*)(a.ws + WS_Q); const bf16* KVb = (const bf16*)(a.ws + WS_KV); const bf16* KR = (const bf16*)(a.ws + WS_KR); bf16* MIX = (bf16*)(a.ws + WS_MIX);
    const float* ct = (const float*)(a.ws + WS_ROPE); const float* st = ct + SEQ * 16;
    LAS float* Kt = (LAS float*)lds;
    LAS float* Vt = (LAS float*)(lds + 64 * 96 * 4);
    for (int u = blockIdx.x; u < 576; u += gridDim.x) {
        const bool lat = u < 512; const int b = lat ? (u >> 6) : ((u - 512) >> 3), h = lat ? ((u >> 3) & 7) : ((u - 512) & 7);
        const int nkeys = lat ? (CTXL + SEQ) : CTXL;
        const int qrow = lat ? b * SEQ + (u & 7) * 256 + qi : TL + b * CTXL + qi;
        float q[48];
#pragma unroll
        for (int g = 0; g < 6; ++g) { float f[8]; unpack8(*(const v4u*)(Qb + (size_t)qrow * QW + h * 96 + half * 48 + g * 8), f);
#pragma unroll
            for (int j = 0; j < 8; ++j) q[g * 8 + j] = f[j]; }
        if (lat && half == 1) { const int t = qrow & (SEQ - 1);
#pragma unroll
            for (int j = 0; j < 16; ++j) { const float c = ct[t * 16 + j], s = st[t * 16 + j]; const float x1 = q[16 + j], x2 = q[32 + j]; q[16 + j] = x1 * c - x2 * s; q[32 + j] = x1 * s + x2 * c; } }
#pragma unroll
        for (int j = 0; j < 48; ++j) q[j] *= ATT_SCALE_LOG2E;
        float o[32]; float m = -1e30f, l = 0.f;
#pragma unroll
        for (int j = 0; j < 32; ++j) o[j] = 0.f;
        for (int k0 = 0; k0 < nkeys; k0 += 64) {
            __syncthreads();
            for (int g = tid; g < 768; g += NTHR) { const int key = g / 12, part = g % 12; const int kk = k0 + key; const int krow = kk < CTXL ? TL + b * CTXL + kk : b * SEQ + kk - CTXL;
                float f[8]; unpack8(part < 8 ? *(const v4u*)(KVb + (size_t)krow * KVW + h * 128 + part * 8) : *(const v4u*)(KR + (size_t)krow * 32 + (part - 8) * 8), f);
#pragma unroll
                for (int j = 0; j < 8; ++j) Kt[key * 96 + part * 8 + j] = f[j]; }
            { const int key = tid >> 3, part = tid & 7; const int kk = k0 + key; const int krow = kk < CTXL ? TL + b * CTXL + kk : b * SEQ + kk - CTXL;
                float f[8]; unpack8(*(const v4u*)(KVb + (size_t)krow * KVW + h * 128 + 64 + part * 8), f);
#pragma unroll
                for (int j = 0; j < 8; ++j) Vt[key * 64 + part * 8 + j] = f[j]; }
            __syncthreads();
            for (int kg = 0; kg < 64; kg += 8) {
                float s[8]; float gm = -1e30f;
#pragma unroll
                for (int kk = 0; kk < 8; ++kk) { float acc = 0.f; const LAS f32x4* kp = (const LAS f32x4*)(Kt + (kg + kk) * 96 + half * 48);
#pragma unroll
                    for (int d4 = 0; d4 < 12; ++d4) { const f32x4 kv = kp[d4]; acc += q[d4 * 4] * kv[0] + q[d4 * 4 + 1] * kv[1] + q[d4 * 4 + 2] * kv[2] + q[d4 * 4 + 3] * kv[3]; }
                    acc += shx(acc, 1, tid & 63);
                    s[kk] = acc; gm = fmaxf(gm, acc); }
                const float mn = fmaxf(m, gm); const float alpha = exp2f(m - mn); m = mn; l *= alpha;
#pragma unroll
                for (int j = 0; j < 32; ++j) o[j] *= alpha;
#pragma unroll
                for (int kk = 0; kk < 8; ++kk) { const float p = exp2f(s[kk] - mn); l += p; const LAS f32x4* vp = (const LAS f32x4*)(Vt + (kg + kk) * 64 + half * 32);
#pragma unroll
                    for (int d4 = 0; d4 < 8; ++d4) { const f32x4 vv = vp[d4]; o[d4 * 4] += p * vv[0]; o[d4 * 4 + 1] += p * vv[1]; o[d4 * 4 + 2] += p * vv[2]; o[d4 * 4 + 3] += p * vv[3]; } }
            }
        }
        { const float inv = 1.f / l;
#pragma unroll
            for (int g = 0; g < 4; ++g) { float f[8];
#pragma unroll
                for (int j = 0; j < 8; ++j) f[j] = o[g * 8 + j] * inv;
                *(v4u*)(MIX + (size_t)qrow * D + h * 64 + half * 32 + g * 8) = pack8(f); } }
    }
}

__device__ __forceinline__ void ssd_scan_naive(const Args& a, int i, bool last, LAS unsigned char* lds) {
    const int tid = otid(a.wv), p = tid >> 3, nq = tid & 7;
    bf16* ZX = (bf16*)(a.ws + WS_ZX); const bf16* XBC = (const bf16*)(a.ws + WS_XBC); const float* DT = (const float*)(a.ws + WS_DT); const float* AA = (const float*)(a.ws + WS_AA);
    LAS float* xs = (LAS float*)lds;
    LAS float* Bs = (LAS float*)(lds + 16384);
    LAS float* Cs = (LAS float*)(lds + 16384 + 32768);
    LAS float* dts = (LAS float*)(lds + 16384 + 65536);
    LAS float* as = dts + 64;
    for (int it = blockIdx.x; it < NB * 32; it += gridDim.x) {
        const int b = it >> 5, h = it & 31, g = h >> 3; const float dsk = a.in[I_SD][i * 32 + h];
        for (int dir = 0; dir < 2; ++dir) {
            float stt[16];
#pragma unroll
            for (int n = 0; n < 16; ++n) stt[n] = 0.f;
            for (int seg = 0; seg < 2; ++seg) {
                const int len = seg == 0 ? CTXL : SEQ; const int base = seg == 0 ? TL + b * CTXL : b * SEQ; const bool want_y = !(last && seg == 0);
                for (int cc = 0; cc < len / 64; ++cc) {
                    const int t0 = dir == 0 ? cc * 64 : len - 64 - cc * 64;
                    __syncthreads();
                    { const int tt = tid >> 3, part = tid & 7; float f[8]; unpack8(*(const v4u*)(XBC + (size_t)(base + t0 + tt) * 3072 + h * 64 + part * 8), f);
#pragma unroll
                        for (int j = 0; j < 8; ++j) xs[tt * 64 + part * 8 + j] = f[j]; }
                    for (int q = tid; q < 1024; q += NTHR) { const int tt = q >> 4, part = q & 15; float f[8];
                        unpack8(*(const v4u*)(XBC + (size_t)(base + t0 + tt) * 3072 + 2048 + g * 128 + part * 8), f);
#pragma unroll
                        for (int j = 0; j < 8; ++j) Bs[tt * 128 + part * 8 + j] = f[j];
                        unpack8(*(const v4u*)(XBC + (size_t)(base + t0 + tt) * 3072 + 2560 + g * 128 + part * 8), f);
#pragma unroll
                        for (int j = 0; j < 8; ++j) Cs[tt * 128 + part * 8 + j] = f[j]; }
                    if (tid < 64) { dts[tid] = DT[(size_t)(base + t0 + tid) * 64 + dir * 32 + h]; as[tid] = AA[(size_t)(base + t0 + tid) * 64 + dir * 32 + h]; }
                    __syncthreads();
                    for (int s = 0; s < 64; ++s) {
                        const int tt = dir == 0 ? s : 63 - s;
                        const float dec = __expf(as[tt]); const float xv = xs[tt * 64 + p]; const float xd = xv * dts[tt];
                        const LAS f32x4* bp = (const LAS f32x4*)(Bs + tt * 128 + nq * 16); const LAS f32x4* cp = (const LAS f32x4*)(Cs + tt * 128 + nq * 16);
                        float acc = 0.f;
#pragma unroll
                        for (int n4 = 0; n4 < 4; ++n4) { const f32x4 bv = bp[n4], cv = cp[n4];
#pragma unroll
                            for (int k = 0; k < 4; ++k) { stt[n4 * 4 + k] = dec * stt[n4 * 4 + k] + xd * bv[k]; acc += cv[k] * stt[n4 * 4 + k]; } }
                        acc += shx(acc, 1, tid & 63); acc += shx(acc, 2, tid & 63); acc += shx(acc, 4, tid & 63);
                        if (want_y && nq == 0) { bf16* yp = ZX + (size_t)(base + t0 + tt) * SSD_INP + 2048 + h * 64 + p;
                            const float y = dir == 0 ? acc + dsk * xv : acc + bf1(*yp);
                            *yp = (bf16)f2bf(y); }
                    }
                }
            }
            __syncthreads();
            asm volatile("s_waitcnt vmcnt(0)" ::: "memory");
        }
    }
}

typedef short bf16x8 __attribute__((ext_vector_type(8)));
typedef float f32x16 __attribute__((ext_vector_type(16)));
typedef short v4i16_t __attribute__((ext_vector_type(4)));
__device__ __forceinline__ v2u trread(const LAS unsigned char* p) { return __builtin_bit_cast(v2u, __builtin_amdgcn_ds_read_tr16_b64_v4i16((LAS v4i16_t*)p)); }
__device__ __forceinline__ unsigned cvtpk(float lo, float hi) { return hw_cvtpk(lo, hi); }
constexpr int ATT_KP = 208, ATT_VP = 192, ATT_KB = 64 * ATT_KP, ATT_VB = 64 * ATT_VP, ATT_BUF = ATT_KB + ATT_VB;
#ifndef ATT_NQ
#define ATT_NQ 2
#endif
#ifndef ATT_LAZY
#define ATT_LAZY 8
#endif
template <int NQ>
__device__ __forceinline__ void attn_unit3(const Args& a, LAS unsigned char* lds, const int b, const int h, const int q0, const int ntiles, const bool lat) {
    const int tid = otid(a.wv), wave = a.wv, lane = tid & 63, r32 = lane & 31, hh = lane >> 5;
    const int tq = (lane >> 2) & 3, tp = lane & 3, tblk = (lane >> 4) & 1;
    const bf16* Qb = (const bf16*)(a.ws + WS_Q); const bf16* KVb = (const bf16*)(a.ws + WS_KV); const bf16* KR = (const bf16*)(a.ws + WS_KR); bf16* MIX = (bf16*)(a.ws + WS_MIX);
    const float* ct = (const float*)(a.ws + WS_ROPE); const float* st = ct + SEQ * 16;
    bf16x8 qf[NQ][6];
#pragma unroll
    for (int nq = 0; nq < NQ; ++nq) { const int qrow = q0 + wave * (32 * NQ) + nq * 32 + r32;
#pragma unroll
        for (int s = 0; s < 6; ++s) qf[nq][s] = *(const bf16x8*)(Qb + (size_t)qrow * QW + h * 96 + 16 * s + 8 * hh);
        if (lat) { const int t = qrow & (SEQ - 1);
#pragma unroll
            for (int j = 0; j < 8; j += 2) { float x1[2], x2[2], y1[2], y2[2];
#pragma unroll
                for (int e = 0; e < 2; ++e) { x1[e] = bf1((bf16)qf[nq][4][j + e]); x2[e] = bf1((bf16)qf[nq][5][j + e]); const float c = ct[t * 16 + 8 * hh + j + e], s = st[t * 16 + 8 * hh + j + e];
                    y1[e] = x1[e] * c - x2[e] * s; y2[e] = x1[e] * s + x2[e] * c; }
                const unsigned w1 = pk2(y1[0], y1[1]), w2 = pk2(y2[0], y2[1]);
                qf[nq][4][j] = (short)(w1 & 0xffff); qf[nq][4][j + 1] = (short)(w1 >> 16); qf[nq][5][j] = (short)(w2 & 0xffff); qf[nq][5][j + 1] = (short)(w2 >> 16); } } }
    f32x16 o0[NQ], o1[NQ]; float m[NQ], l[NQ];
#pragma unroll
    for (int nq = 0; nq < NQ; ++nq) { m[nq] = -1e30f; l[nq] = 0.f;
#pragma unroll
        for (int i = 0; i < 16; ++i) { o0[nq][i] = 0.f; o1[nq][i] = 0.f; } }
    v4u kreg0, kreg1, vreg;
#define ATT_LOAD(it) do { const int rb_ = (it) < CTXL / 64 ? TL + b * CTXL + (it) * 64 : b * SEQ + ((it) - CTXL / 64) * 64; \
        const char* kvb_ = (const char*)(KVb + (size_t)rb_ * KVW); const char* krb_ = (const char*)(KR + (size_t)rb_ * 32); \
        kreg0 = *(const v4u*)(kvb_ + (tid >> 3) * 2048 + h * 256 + (tid & 7) * 16); if (tid < 256) kreg1 = *(const v4u*)(krb_ + (tid >> 2) * 64 + (tid & 3) * 16); vreg = *(const v4u*)(kvb_ + (tid >> 3) * 2048 + h * 256 + 128 + (tid & 7) * 16); } while (0)
#define ATT_WRITE(buf) do { LAS unsigned char* kb_ = lds + (buf) * ATT_BUF; LAS unsigned char* vb_ = kb_ + ATT_KB; \
        *(LAS v4u*)(kb_ + (tid >> 3) * ATT_KP + (tid & 7) * 16) = kreg0; if (tid < 256) *(LAS v4u*)(kb_ + (tid >> 2) * ATT_KP + 128 + (tid & 3) * 16) = kreg1; \
        *(LAS v4u*)(vb_ + (tid >> 3) * ATT_VP + (tid & 7) * 16) = vreg; } while (0)
    __syncthreads();
    ATT_LOAD(0); ATT_WRITE(0);
    __syncthreads();
    for (int it = 0; it < ntiles; ++it) {
#ifdef ATT_JITTER
        if (wave == ((it * 5 + (int)blockIdx.x) & 7)) __builtin_amdgcn_s_sleep(100);
#endif
#ifndef ATT_LOADMID
        if (it + 1 < ntiles) ATT_LOAD(it + 1);
#endif
#ifdef ATT_TZ
        int tz = tid; asm volatile("" : "+v"(tz));
        const int lane = tz & 63, r32 = lane & 31, hh = lane >> 5, tq = (lane >> 2) & 3, tp = lane & 3, tblk = (lane >> 4) & 1;
#endif
        const LAS unsigned char* kb = lds + (it & 1) * ATT_BUF; const LAS unsigned char* vb = kb + ATT_KB;
#pragma unroll
        for (int t = 0; t < 2; ++t) {
            f32x16 sc[NQ]; bf16x8 pf[NQ][2];
#pragma unroll
            for (int nq = 0; nq < NQ; ++nq)
#pragma unroll
                for (int i = 0; i < 16; ++i) sc[nq][i] = 0.f;
            bf16x8 kf[6];
#pragma unroll
            for (int s = 0; s < 6; ++s) kf[s] = *(const LAS bf16x8*)(kb + (32 * t + r32) * ATT_KP + (16 * s + 8 * hh) * 2);
            asm volatile("" : "+v"(kf[0]), "+v"(kf[1]), "+v"(kf[2]), "+v"(kf[3]), "+v"(kf[4]), "+v"(kf[5]));
#pragma unroll
            for (int s = 0; s < 6; ++s)
#pragma unroll
                for (int nq = 0; nq < NQ; ++nq) sc[nq] = __builtin_amdgcn_mfma_f32_32x32x16_bf16(kf[s], qf[nq][s], sc[nq], 0, 0, 0);
#ifdef ATT_LOADMID
            if (t == 0 && it + 1 < ntiles) ATT_LOAD(it + 1);
#endif
#pragma unroll
            for (int nq = 0; nq < NQ; ++nq) {
                float mx = sc[nq][0];
#pragma unroll
                for (int i = 1; i < 16; ++i) mx = fmaxf(mx, sc[nq][i]);
                mx = fmaxf(mx, shx(mx, 32, lane));
#ifdef ATT_LAZY
                const float mxs = mx * ATT_SCALE_LOG2E;
                if (__builtin_amdgcn_ballot_w64(mxs > m[nq] + (float)ATT_LAZY) != 0ull) {
                    const float mn = fmaxf(m[nq], mxs); const float alpha = __builtin_amdgcn_exp2f(m[nq] - mn); m[nq] = mn; l[nq] *= alpha;
#pragma unroll
                    for (int i = 0; i < 16; ++i) { o0[nq][i] *= alpha; o1[nq][i] *= alpha; } }
                { const float mn = m[nq]; float rs = 0.f;
#pragma unroll
                  for (int i = 0; i < 16; ++i) { sc[nq][i] = __builtin_amdgcn_exp2f(sc[nq][i] * ATT_SCALE_LOG2E - mn); rs += sc[nq][i]; }
                  l[nq] += rs; }
#else
                const float mn = fmaxf(m[nq], mx * ATT_SCALE_LOG2E); const float alpha = __builtin_amdgcn_exp2f(m[nq] - mn); m[nq] = mn;
                float rs = 0.f;
#pragma unroll
                for (int i = 0; i < 16; ++i) { sc[nq][i] = __builtin_amdgcn_exp2f(sc[nq][i] * ATT_SCALE_LOG2E - mn); rs += sc[nq][i]; }
                l[nq] = l[nq] * alpha + rs;
#ifdef ATT_SKIPRS
                if (__builtin_amdgcn_ballot_w64(alpha != 1.0f) != 0ull)
#endif
                {
#pragma unroll
                    for (int i = 0; i < 16; ++i) { o0[nq][i] *= alpha; o1[nq][i] *= alpha; } }
#endif
#pragma unroll
                for (int s2 = 0; s2 < 2; ++s2) { v4u w0;
                    w0.x = cvtpk(sc[nq][8 * s2 + 0], sc[nq][8 * s2 + 1]); w0.y = cvtpk(sc[nq][8 * s2 + 2], sc[nq][8 * s2 + 3]); w0.z = cvtpk(sc[nq][8 * s2 + 4], sc[nq][8 * s2 + 5]); w0.w = cvtpk(sc[nq][8 * s2 + 6], sc[nq][8 * s2 + 7]);
                    pf[nq][s2] = __builtin_bit_cast(bf16x8, w0); }
            }
#pragma unroll
            for (int s2 = 0; s2 < 2; ++s2) { const int ko = t * 32 + 16 * s2 + 4 * hh;
                { const LAS unsigned char* tb = vb + (ko + tq) * ATT_VP + (16 * tblk + 4 * tp) * 2; const v2u lo = trread(tb), hi = trread(tb + 8 * ATT_VP); const bf16x8 vf = __builtin_bit_cast(bf16x8, (v4u){lo.x, lo.y, hi.x, hi.y});
#pragma unroll
                  for (int nq = 0; nq < NQ; ++nq) o0[nq] = __builtin_amdgcn_mfma_f32_32x32x16_bf16(vf, pf[nq][s2], o0[nq], 0, 0, 0); }
                { const LAS unsigned char* tb = vb + (ko + tq) * ATT_VP + (32 + 16 * tblk + 4 * tp) * 2; const v2u lo = trread(tb), hi = trread(tb + 8 * ATT_VP); const bf16x8 vf = __builtin_bit_cast(bf16x8, (v4u){lo.x, lo.y, hi.x, hi.y});
#pragma unroll
                  for (int nq = 0; nq < NQ; ++nq) o1[nq] = __builtin_amdgcn_mfma_f32_32x32x16_bf16(vf, pf[nq][s2], o1[nq], 0, 0, 0); } }
        }
        if (it + 1 < ntiles) ATT_WRITE((it + 1) & 1);
        __syncthreads();
    }
#undef ATT_LOAD
#undef ATT_WRITE
#pragma unroll
    for (int nq = 0; nq < NQ; ++nq) { const int qrow = q0 + wave * (32 * NQ) + nq * 32 + r32;
        const float lsum = l[nq] + shx(l[nq], 32, lane); const float inv = 1.f / lsum;
        bf16* orow = MIX + (size_t)qrow * D + h * 64 + 4 * hh;
#pragma unroll
        for (int g = 0; g < 4; ++g) {
            v2u w; w.x = pk2(o0[nq][4 * g] * inv, o0[nq][4 * g + 1] * inv); w.y = pk2(o0[nq][4 * g + 2] * inv, o0[nq][4 * g + 3] * inv); *(v2u*)(orow + 8 * g) = w;
            v2u x; x.x = pk2(o1[nq][4 * g] * inv, o1[nq][4 * g + 1] * inv); x.y = pk2(o1[nq][4 * g + 2] * inv, o1[nq][4 * g + 3] * inv); *(v2u*)(orow + 32 + 8 * g) = x; } }
}
__device__ __forceinline__ void attn_mfma(const Args& a, LAS unsigned char* lds) {
#if ATT_NQ == 2
    for (int u = blockIdx.x; u < 256; u += gridDim.x) attn_unit3<2>(a, lds, u >> 5, (u >> 2) & 7, (u >> 5) * SEQ + (u & 3) * 512, (CTXL + SEQ) / 64, true);
#else
    for (int u = blockIdx.x; u < 512; u += gridDim.x) attn_unit3<1>(a, lds, u >> 6, (u >> 3) & 7, (u >> 6) * SEQ + (u & 7) * 256, (CTXL + SEQ) / 64, true);
#endif
    for (int u = blockIdx.x; u < 64; u += gridDim.x) attn_unit3<1>(a, lds, u >> 3, u & 7, TL + (u >> 3) * CTXL, CTXL / 64, false);
}

#ifndef SSD_YREP
#define SSD_YREP 1
#endif
#ifndef SSD_WREP
#define SSD_WREP 1
#endif
constexpr int SP_B = 272, SP_X = 192;
constexpr int SO_B = 0, SO_C = SO_B + 128 * SP_B, SO_XD = SO_C + 128 * SP_B, SO_XW = SO_XD + 128 * SP_X, SO_S = SO_XW + 128 * SP_X, SO_V = SO_S + 64 * SP_B;
static_assert(SO_V + 2 * 2048 <= LDS_BYTES, "ssd lds map");
#ifdef SSD_DIAG
#define SSD_T(v) long long v = clock64()
#define SSD_ACC(k, v) do { const long long n_ = clock64(); dacc[k] += n_ - v; v = n_; } while (0)
#else
#define SSD_T(v) do {} while (0)
#define SSD_ACC(k, v) do {} while (0)
#endif
__device__ __forceinline__ void ssd_scan_mfma(const Args& a, int i, bool last, LAS unsigned char* lds) {
#ifdef SSD_DIAG
    long long dacc[12] = {0, 0, 0, 0, 0, 0, 0, 0, 0, 0, 0, 0};
#endif
    const int tid = otid(a.wv), wave = a.wv, lane = tid & 63, r32 = lane & 31, hh = lane >> 5;
    const int pt = wave >> 2, lt = pt ? 3 - (wave & 3) : (wave & 3);
    const int tq = (lane >> 2) & 3, tp = lane & 3, tblk = (lane >> 4) & 1;
    bf16* ZX = (bf16*)(a.ws + WS_ZX); const bf16* XBC = (const bf16*)(a.ws + WS_XBC); bf16* GX = (bf16*)(a.ws + WS_XBC); float* SSq = (float*)(a.ws + WS_SS); const float* DT = (const float*)(a.ws + WS_DT); const float* AA = (const float*)(a.ws + WS_AA);
    LAS unsigned char* Bl = lds + SO_B; LAS unsigned char* Cl = lds + SO_C; LAS unsigned char* XDl = lds + SO_XD; LAS unsigned char* XWl = lds + SO_XW; LAS unsigned char* Sl = lds + SO_S;
    const int brow = tid >> 4, bpart = tid & 15, xrow = tid >> 3, xpart = tid & 7;
    for (int it = blockIdx.x; it < NB * 32; it += gridDim.x) {
        const int b = it >> 5, h = it & 31, g = h >> 3; const float dsk = a.in[I_SD][i * 32 + h];
        for (int dir = 0; dir < 2; ++dir) {
            const int scanw = dir == 0 ? 0 : 3;
            f32x16 sacc;
#pragma unroll
            for (int k = 0; k < 16; ++k) sacc[k] = 0.f;
            SSD_T(tprev);
            v4u bq[4], cq[4], xq[2]; float pa0 = 0.f, pa1 = 0.f, pd0 = 0.f, pd1 = 0.f, qa0 = 0.f, qa1 = 0.f, qd0 = 0.f, qd1 = 0.f; v2u add[4], zq[4];
#define SSD_ROWBASE(c) ((c) < 2 ? TL + b * CTXL + (dir == 0 ? (c) : 1 - (c)) * 128 : b * SEQ + (dir == 0 ? (c) - 2 : 17 - (c)) * 128)
#define SSD_PFB(c) do { const int rb_ = SSD_ROWBASE(c); _Pragma("unroll") for (int k_ = 0; k_ < 4; ++k_) bq[k_] = *(const v4u*)(XBC + (size_t)(rb_ + brow + 32 * k_) * 3072 + 2048 + g * 128 + bpart * 8); } while (0)
#define SSD_PFC(c) do { const int rb_ = SSD_ROWBASE(c); _Pragma("unroll") for (int k_ = 0; k_ < 4; ++k_) cq[k_] = *(const v4u*)(XBC + (size_t)(rb_ + brow + 32 * k_) * 3072 + 2560 + g * 128 + bpart * 8); } while (0)
#define SSD_PFX(c) do { const int rb_ = SSD_ROWBASE(c); _Pragma("unroll") for (int k_ = 0; k_ < 2; ++k_) xq[k_] = *(const v4u*)(XBC + (size_t)(rb_ + xrow + 64 * k_) * 3072 + h * 64 + xpart * 8); } while (0)
#define SSD_PF(c) do { SSD_PFB(c); SSD_PFC(c); SSD_PFX(c); } while (0)
#define SSD_PFV(c) do { if (wave == scanw) { const int rb_ = SSD_ROWBASE(c); const size_t o_ = (size_t)(rb_ + 2 * lane) * 64 + dir * 32 + h; qa0 = AA[o_]; qa1 = AA[o_ + 64]; qd0 = DT[o_]; qd1 = DT[o_ + 64]; } } while (0)
#define SSD_PFY(c) do { const int rb_ = SSD_ROWBASE(c); const size_t r_ = (size_t)(rb_ + 32 * lt + r32); \
                _Pragma("unroll") for (int q_ = 0; q_ < 4; ++q_) { add[q_] = dir == 0 ? *(const v2u*)(XBC + r_ * 3072 + h * 64 + 32 * pt + 4 * hh + 8 * q_) : *(const v2u*)(ZX + r_ * SSD_INP + 2048 + h * 64 + 32 * pt + 4 * hh + 8 * q_); \
                    if (dir == 1) zq[q_] = *(const v2u*)(ZX + r_ * SSD_INP + h * 64 + 32 * pt + 4 * hh + 8 * q_); } } while (0)
#define SSD_SCAN(vb_) do { if (wave == scanw) { LAS float* V_ = (LAS float*)(lds + SO_V + (vb_) * 2048); const float pair_ = pa0 + pa1; float ps_ = pair_; \
                _Pragma("unroll") for (int d_ = 1; d_ < 64; d_ <<= 1) { const int src_ = dir == 0 ? lane - d_ : lane + d_; const float t_ = __builtin_bit_cast(float, __builtin_amdgcn_ds_bpermute((src_ & 63) << 2, __builtin_bit_cast(int, ps_))); if (src_ >= 0 && src_ < 64) ps_ += t_; } \
                const float tot_ = __builtin_bit_cast(float, __builtin_amdgcn_ds_bpermute((dir == 0 ? 63 : 0) << 2, __builtin_bit_cast(int, ps_))); const float ex_ = ps_ - pair_; \
                float c0_, c1_; if (dir == 0) { c0_ = ex_ + pa0; c1_ = c0_ + pa1; } else { c1_ = ex_ + pa1; c0_ = c1_ + pa0; } \
                V_[2 * lane] = c0_; V_[2 * lane + 1] = c1_; V_[128 + 2 * lane] = pd0; V_[128 + 2 * lane + 1] = pd1; V_[256 + 2 * lane] = pd0 * __expf(tot_ - c0_); V_[256 + 2 * lane + 1] = pd1 * __expf(tot_ - c1_); \
                if (lane == 0) V_[384] = tot_; } } while (0)
#define SSD_WRITE(vb_) do { const LAS float* V_ = (const LAS float*)(lds + SO_V + (vb_) * 2048); \
                _Pragma("unroll") for (int k_ = 0; k_ < 4; ++k_) { *(LAS v4u*)(Bl + (brow + 32 * k_) * SP_B + bpart * 16) = bq[k_]; *(LAS v4u*)(Cl + (brow + 32 * k_) * SP_B + bpart * 16) = cq[k_]; } \
                _Pragma("unroll") for (int k_ = 0; k_ < 2; ++k_) { const int s_ = xrow + 64 * k_; const float dt_ = V_[128 + s_], w_ = V_[256 + s_]; float f_[8], g_[8]; unpack8(xq[k_], f_); \
                    _Pragma("unroll") for (int j_ = 0; j_ < 8; ++j_) { g_[j_] = f_[j_] * w_; f_[j_] *= dt_; } \
                    *(LAS v4u*)(XDl + s_ * SP_X + xpart * 16) = pack8(f_); *(LAS v4u*)(XWl + s_ * SP_X + xpart * 16) = pack8(g_); } } while (0)
            __syncthreads();
            SSD_PFV(0); pa0 = qa0; pa1 = qa1; pd0 = qd0; pd1 = qd1; SSD_PFV(1); SSD_PFY(0); SSD_PF(0);
            { const float t0_ = qa0, t1_ = qa1, t2_ = qd0, t3_ = qd1; SSD_SCAN(0); pa0 = t0_; pa1 = t1_; pd0 = t2_; pd1 = t3_; }
            __syncthreads();
            SSD_WRITE(0);
            { LAS v2u* sp = (LAS v2u*)(Sl + (32 * pt + r32) * SP_B + (32 * lt + 4 * hh) * 2);
#pragma unroll
              for (int q = 0; q < 4; ++q) sp[2 * q] = (v2u){0u, 0u}; }
            __syncthreads();
            SSD_ACC(0, tprev);
            for (int c = 0; c < 18; ++c) {
                const int cur = c & 1; const LAS float* V = (const LAS float*)(lds + SO_V + cur * 2048);
#ifdef SSD_JITTER
                if (wave == ((c * 3 + (int)blockIdx.x + dir) & 7)) __builtin_amdgcn_s_sleep(120);
#endif
                const int rowbase = SSD_ROWBASE(c); const bool want_y = !(last && c < 2);
                if (c > 0 && want_y) SSD_PFY(c);
                if (c + 1 < 18) { if (c + 2 < 18) SSD_PFV(c + 2); }
                SSD_ACC(1, tprev);
                for (int yrep = 0; yrep < SSD_YREP; ++yrep)
                if (!want_y && c + 1 < 18) { SSD_PFB(c + 1); SSD_PFC(c + 1); SSD_PFX(c + 1); }
                if (want_y) {
                    const int l = 32 * lt + r32; const float cl = V[l];
                    bf16* yptr = ZX + (size_t)(rowbase + l) * SSD_INP + 2048 + h * 64 + 32 * pt + 4 * hh;
                    bf16x8 cf[8];
#pragma unroll
                    for (int ks = 0; ks < 8; ++ks) cf[ks] = *(const LAS bf16x8*)(Cl + l * SP_B + (16 * ks + 8 * hh) * 2);
                    SSD_ACC(8, tprev);
                    f32x16 y1;
#pragma unroll
                    for (int k = 0; k < 16; ++k) y1[k] = 0.f;
#pragma unroll
                    for (int ks = 0; ks < 8; ++ks) { const bf16x8 sf = *(const LAS bf16x8*)(Sl + (32 * pt + r32) * SP_B + (16 * ks + 8 * hh) * 2); y1 = __builtin_amdgcn_mfma_f32_32x32x16_bf16(sf, cf[ks], y1, 0, 0, 0); }
                    { const float el = __expf(cl);
#pragma unroll
                      for (int k = 0; k < 16; ++k) y1[k] *= el; }
                    SSD_ACC(10, tprev);
                    const int st_lo = dir == 0 ? 0 : lt, st_hi = dir == 0 ? lt : 3;
#pragma unroll
                    for (int st = 0; st < 4; ++st) { if (c + 1 < 18) { if (st == 1) SSD_PFB(c + 1); if (st == 2) SSD_PFC(c + 1); if (st == 3) SSD_PFX(c + 1); }
                      if (st >= st_lo && st <= st_hi) {
                        f32x16 X;
#pragma unroll
                        for (int k = 0; k < 16; ++k) X[k] = 0.f;
#pragma unroll
                        for (int ks = 0; ks < 8; ++ks) { const bf16x8 af = *(const LAS bf16x8*)(Bl + (32 * st + r32) * SP_B + (16 * ks + 8 * hh) * 2); X = __builtin_amdgcn_mfma_f32_32x32x16_bf16(af, cf[ks], X, 0, 0, 0); }
                        if (st == lt) {
#pragma unroll
                            for (int q = 0; q < 4; ++q) { const f32x4 cs = *(const LAS f32x4*)(V + 32 * st + 8 * q + 4 * hh);
#pragma unroll
                                for (int e = 0; e < 4; ++e) { const int sl = 8 * q + 4 * hh + e; const bool ok = dir == 0 ? (sl <= r32) : (sl >= r32);
                                    X[4 * q + e] *= __expf(ok ? fminf(cl - cs[e], 0.f) : -1.0e30f); } }
                        } else {
#pragma unroll
                            for (int q = 0; q < 4; ++q) { const f32x4 cs = *(const LAS f32x4*)(V + 32 * st + 8 * q + 4 * hh);
#pragma unroll
                                for (int e = 0; e < 4; ++e) X[4 * q + e] *= __expf(fminf(cl - cs[e], 0.f)); }
                        }
#pragma unroll
                        for (int ks2 = 0; ks2 < 2; ++ks2) { v4u w; w.x = cvtpk(X[8 * ks2 + 0], X[8 * ks2 + 1]); w.y = cvtpk(X[8 * ks2 + 2], X[8 * ks2 + 3]); w.z = cvtpk(X[8 * ks2 + 4], X[8 * ks2 + 5]); w.w = cvtpk(X[8 * ks2 + 6], X[8 * ks2 + 7]);
                            const LAS unsigned char* tb = XDl + (32 * st + 16 * ks2 + 4 * hh + tq) * SP_X + (32 * pt + 16 * tblk + 4 * tp) * 2;
                            const v2u lo = trread(tb), hi = trread(tb + 8 * SP_X);
                            y1 = __builtin_amdgcn_mfma_f32_32x32x16_bf16(__builtin_bit_cast(bf16x8, (v4u){lo.x, lo.y, hi.x, hi.y}), __builtin_bit_cast(bf16x8, w), y1, 0, 0, 0); }
                    } }
                    asm volatile("" : "+v"(y1)); SSD_ACC(9, tprev);
                    float ssq = 0.f; bf16* gptr = GX + (size_t)(rowbase + l) * 3072 + h * 64 + 32 * pt + 4 * hh;
#pragma unroll
                    for (int q = 0; q < 4; ++q) { float o[4];
#pragma unroll
                        for (int e = 0; e < 4; ++e) o[e] = y1[4 * q + e];
                        const float a0 = bflo(add[q].x), a1 = bfhi(add[q].x), a2 = bflo(add[q].y), a3 = bfhi(add[q].y);
                        if (dir == 0) { o[0] += dsk * a0; o[1] += dsk * a1; o[2] += dsk * a2; o[3] += dsk * a3;
                            v2u w; w.x = cvtpk(o[0], o[1]); w.y = cvtpk(o[2], o[3]); *(v2u*)(yptr + 8 * q) = w; }
                        else { o[0] += a0; o[1] += a1; o[2] += a2; o[3] += a3;
                            o[0] *= silu_f(bflo(zq[q].x)); o[1] *= silu_f(bfhi(zq[q].x)); o[2] *= silu_f(bflo(zq[q].y)); o[3] *= silu_f(bfhi(zq[q].y));
                            ssq += (o[0] * o[0] + o[1] * o[1]) + (o[2] * o[2] + o[3] * o[3]);
                            v2u w; w.x = cvtpk(o[0], o[1]); w.y = cvtpk(o[2], o[3]); *(v2u*)(gptr + 8 * q) = w; } }
                    if (dir == 1) { ssq += shx(ssq, 32, lane); if (hh == 0) SSq[(size_t)(rowbase + l) * 64 + 2 * h + pt] = ssq; }
                }
                SSD_ACC(2, tprev);
                if (c + 1 < 18) {
                    const float etot = __expf(V[384]);
#pragma unroll
                    for (int k = 0; k < 16; ++k) sacc[k] *= etot;
#pragma unroll
                    for (int kh = 0; kh < 2; ++kh) {
                        v2u alo[4], ahi[4], blo[4], bhi[4];
#pragma unroll
                        for (int k4 = 0; k4 < 4; ++k4) { const int ks = 4 * kh + k4;
                            const LAS unsigned char* ta = Bl + (16 * ks + 8 * hh + tq) * SP_B + (32 * lt + 16 * tblk + 4 * tp) * 2;
                            const LAS unsigned char* tb = XWl + (16 * ks + 8 * hh + tq) * SP_X + (32 * pt + 16 * tblk + 4 * tp) * 2;
                            alo[k4] = trread(ta); ahi[k4] = trread(ta + 4 * SP_B); blo[k4] = trread(tb); bhi[k4] = trread(tb + 4 * SP_X); }
                        asm volatile("" : "+v"(alo[0]), "+v"(alo[1]), "+v"(alo[2]), "+v"(alo[3]), "+v"(bhi[0]), "+v"(bhi[1]), "+v"(bhi[2]), "+v"(bhi[3]));
#pragma unroll
                        for (int k4 = 0; k4 < 4; ++k4)
                            sacc = __builtin_amdgcn_mfma_f32_32x32x16_bf16(__builtin_bit_cast(bf16x8, (v4u){alo[k4].x, alo[k4].y, ahi[k4].x, ahi[k4].y}), __builtin_bit_cast(bf16x8, (v4u){blo[k4].x, blo[k4].y, bhi[k4].x, bhi[k4].y}), sacc, 0, 0, 0); }
                    SSD_SCAN(cur ^ 1); pa0 = qa0; pa1 = qa1; pd0 = qd0; pd1 = qd1;
                }
#ifdef SSD_JITTER
                if (wave == ((c * 5 + 2 + (int)blockIdx.x) & 7)) __builtin_amdgcn_s_sleep(90);
#endif
                SSD_ACC(3, tprev);
                __syncthreads();
                SSD_ACC(4, tprev);
                if (c + 1 < 18) {
                    LAS v2u* sp = (LAS v2u*)(Sl + (32 * pt + r32) * SP_B + (32 * lt + 4 * hh) * 2);
#pragma unroll
                    for (int q = 0; q < 4; ++q) { v2u w; w.x = cvtpk(sacc[4 * q], sacc[4 * q + 1]); w.y = cvtpk(sacc[4 * q + 2], sacc[4 * q + 3]); sp[2 * q] = w; }
                    for (int wrep = 0; wrep < SSD_WREP; ++wrep) { SSD_WRITE(cur ^ 1); }
                }
                SSD_ACC(5, tprev);
                __syncthreads();
                SSD_ACC(6, tprev);
            }
#undef SSD_ROWBASE
#undef SSD_PF
#undef SSD_PFV
#undef SSD_PFY
#undef SSD_SCAN
#undef SSD_WRITE
            asm volatile("s_waitcnt vmcnt(0)" ::: "memory");
        }
    }
#ifdef SSD_DIAG
    if (blockIdx.x == 0 && wave == SSD_DIAG_WAVE && lane == 0 && i == 0) { float* dg = (float*)(a.ws + WS_MOD + 900 * 1024); long long tot = 0;
        for (int k = 0; k < 7; ++k) tot += dacc[k];
        tot += dacc[8] + dacc[9] + dacc[10];
        for (int k = 0; k < 12; ++k) dg[k] = (float)dacc[k]; dg[7] = (float)tot; }
#endif
}

constexpr int AT2_KP = 208, AT2_VP = 192, AT2_KB = 64 * AT2_KP, AT2_VB = 64 * AT2_VP, AT2_BUF = AT2_KB + AT2_VB;
template <int NQ>
__device__ __forceinline__ void attn_unit2(const Args& a, LAS unsigned char* lds, int b, int h, int q0, int ntiles, bool lat) {
    const int tid = otid(a.wv), wave = tid >> 6, lane = tid & 63, r32 = lane & 31, hh = lane >> 5;
    const int tq = (lane >> 2) & 3, tp = lane & 3, tblk = (lane >> 4) & 1;
    const bf16* Qb = (const bf16*)(a.ws + WS_Q); const bf16* KVb = (const bf16*)(a.ws + WS_KV); const bf16* KR = (const bf16*)(a.ws + WS_KR); bf16* MIX = (bf16*)(a.ws + WS_MIX);
    const float* ct = (const float*)(a.ws + WS_ROPE); const float* st = ct + SEQ * 16;
    bf16x8 qf[NQ][6];
#pragma unroll
    for (int nq = 0; nq < NQ; ++nq) { const int qrow = q0 + wave * (32 * NQ) + nq * 32 + r32;
#pragma unroll
        for (int s = 0; s < 6; ++s) qf[nq][s] = *(const bf16x8*)(Qb + (size_t)qrow * QW + h * 96 + 16 * s + 8 * hh);
        if (lat) { const int t = qrow & (SEQ - 1);
#pragma unroll
            for (int j = 0; j < 8; j += 2) { float y1[2], y2[2];
#pragma unroll
                for (int e = 0; e < 2; ++e) { const float x1 = bf1((bf16)qf[nq][4][j + e]), x2 = bf1((bf16)qf[nq][5][j + e]); const float c = ct[t * 16 + 8 * hh + j + e], s = st[t * 16 + 8 * hh + j + e];
                    y1[e] = x1 * c - x2 * s; y2[e] = x1 * s + x2 * c; }
                const unsigned w1 = pk2(y1[0], y1[1]), w2 = pk2(y2[0], y2[1]);
                qf[nq][4][j] = (short)(w1 & 0xffff); qf[nq][4][j + 1] = (short)(w1 >> 16); qf[nq][5][j] = (short)(w2 & 0xffff); qf[nq][5][j + 1] = (short)(w2 >> 16); } }
        asm volatile("" : "+v"(qf[nq][0]), "+v"(qf[nq][1]), "+v"(qf[nq][2]), "+v"(qf[nq][3]), "+v"(qf[nq][4]), "+v"(qf[nq][5]) :: "memory"); }
    f32x16 o[NQ][2]; float m[NQ], l[NQ];
#pragma unroll
    for (int nq = 0; nq < NQ; ++nq) { m[nq] = -1e30f; l[nq] = 0.f;
#pragma unroll
        for (int i = 0; i < 16; ++i) { o[nq][0][i] = 0.f; o[nq][1][i] = 0.f; } }
    v4u kreg0, kreg1, vreg;
#define AT2_LOAD(it, tt) do { const unsigned off_kv = (unsigned)(((tt) >> 3) * (KVW * 2) + h * 256 + ((tt) & 7) * 16), off_kr = (unsigned)(((tt) >> 2) * 64 + ((tt) & 3) * 16); const bool k1ok = (tt) < 256; const int rb_ = (it) < CTXL / 64 ? TL + b * CTXL + (it) * 64 : b * SEQ + ((it) - CTXL / 64) * 64; \
        const char* kvb_ = (const char*)(KVb + (size_t)rb_ * KVW); const char* krb_ = (const char*)(KR + (size_t)rb_ * 32); \
        kreg0 = *(const v4u*)(kvb_ + off_kv); vreg = *(const v4u*)(kvb_ + off_kv + 128); if (k1ok) kreg1 = *(const v4u*)(krb_ + off_kr); } while (0)
#define AT2_WRITE(buf, tt) do { LAS unsigned char* kb_ = lds + (buf) * AT2_BUF; \
        *(LAS v4u*)(kb_ + ((tt) >> 3) * AT2_KP + ((tt) & 7) * 16) = kreg0; if ((tt) < 256) *(LAS v4u*)(kb_ + ((tt) >> 2) * AT2_KP + 128 + ((tt) & 3) * 16) = kreg1; \
        *(LAS v4u*)(kb_ + AT2_KB + ((tt) >> 3) * AT2_VP + ((tt) & 7) * 16) = vreg; } while (0)
    __syncthreads();
    AT2_LOAD(0, tid); AT2_WRITE(0, tid);
    __syncthreads();
    for (int it = 0; it < ntiles; ++it) {
        int tz = tid; asm volatile("" : "+v"(tz));
        const int lane_ = tz & 63, r32_ = lane_ & 31, hh_ = lane_ >> 5, tq_ = (lane_ >> 2) & 3, tp_ = lane_ & 3, tblk_ = (lane_ >> 4) & 1;
#ifdef ATT_LOADTOP
        if (it + 1 < ntiles) AT2_LOAD(it + 1, tz);
#endif
        const LAS unsigned char* kb = lds + (it & 1) * AT2_BUF; const LAS unsigned char* vb = kb + AT2_KB;
        bf16x8 pf[NQ][2][2];
        f32x16 sc[NQ][2];
#pragma unroll
        for (int nq = 0; nq < NQ; ++nq)
#pragma unroll
            for (int i = 0; i < 16; ++i) { sc[nq][0][i] = 0.f; sc[nq][1][i] = 0.f; }
#pragma unroll
        for (int s = 0; s < 6; ++s) { const bf16x8 a0 = *(const LAS bf16x8*)(kb + r32_ * AT2_KP + (16 * s + 8 * hh_) * 2); const bf16x8 a1 = *(const LAS bf16x8*)(kb + (32 + r32_) * AT2_KP + (16 * s + 8 * hh_) * 2);
#pragma unroll
            for (int nq = 0; nq < NQ; ++nq) { sc[nq][0] = __builtin_amdgcn_mfma_f32_32x32x16_bf16(a0, qf[nq][s], sc[nq][0], 0, 0, 0); sc[nq][1] = __builtin_amdgcn_mfma_f32_32x32x16_bf16(a1, qf[nq][s], sc[nq][1], 0, 0, 0); } }
#pragma unroll
        for (int nq = 0; nq < NQ; ++nq) {
            f32x16& s0 = sc[nq][0]; f32x16& s1 = sc[nq][1];
            float mx = s0[0];
#pragma unroll
            for (int i = 1; i < 16; ++i) mx = fmaxf(mx, s0[i]);
#pragma unroll
            for (int i = 0; i < 16; ++i) mx = fmaxf(mx, s1[i]);
            mx = fmaxf(mx, shx(mx, 32, lane_));
            const float mn = fmaxf(m[nq], mx * ATT_SCALE_LOG2E); const float alpha = __builtin_amdgcn_exp2f(m[nq] - mn); m[nq] = mn;
            float rs = 0.f;
#pragma unroll
            for (int i = 0; i < 16; ++i) { s0[i] = __builtin_amdgcn_exp2f(s0[i] * ATT_SCALE_LOG2E - mn); s1[i] = __builtin_amdgcn_exp2f(s1[i] * ATT_SCALE_LOG2E - mn); rs += s0[i] + s1[i]; }
            l[nq] = l[nq] * alpha + rs;
#pragma unroll
            for (int i = 0; i < 16; ++i) { o[nq][0][i] *= alpha; o[nq][1][i] *= alpha; }
#pragma unroll
            for (int s2 = 0; s2 < 2; ++s2) { v4u w0, w1;
                w0.x = cvtpk(s0[8 * s2 + 0], s0[8 * s2 + 1]); w0.y = cvtpk(s0[8 * s2 + 2], s0[8 * s2 + 3]); w0.z = cvtpk(s0[8 * s2 + 4], s0[8 * s2 + 5]); w0.w = cvtpk(s0[8 * s2 + 6], s0[8 * s2 + 7]);
                w1.x = cvtpk(s1[8 * s2 + 0], s1[8 * s2 + 1]); w1.y = cvtpk(s1[8 * s2 + 2], s1[8 * s2 + 3]); w1.z = cvtpk(s1[8 * s2 + 4], s1[8 * s2 + 5]); w1.w = cvtpk(s1[8 * s2 + 6], s1[8 * s2 + 7]);
                pf[nq][0][s2] = __builtin_bit_cast(bf16x8, w0); pf[nq][1][s2] = __builtin_bit_cast(bf16x8, w1); }
        }
#ifndef ATT_LOADTOP
        if (it + 1 < ntiles) AT2_LOAD(it + 1, tz);
#endif
#pragma unroll
        for (int t = 0; t < 2; ++t)
#pragma unroll
            for (int s2 = 0; s2 < 2; ++s2)
#pragma unroll
                for (int dt = 0; dt < 2; ++dt) {
                    const LAS unsigned char* tb = vb + (t * 32 + 16 * s2 + 4 * hh_ + tq_) * AT2_VP + (32 * dt + 16 * tblk_ + 4 * tp_) * 2;
#ifdef ATT_NOTR
                    bf16x8 vf; { const LAS unsigned short* vp_ = (const LAS unsigned short*)(vb + (t * 32 + 16 * s2 + 4 * hh_) * AT2_VP + (32 * dt + r32_) * 2);
#pragma unroll
                      for (int j_ = 0; j_ < 8; ++j_) vf[j_] = (short)vp_[((j_ & 3) + 8 * (j_ >> 2)) * (AT2_VP / 2)]; }
#else
                    const v2u lo = trread(tb), hi = trread(tb + 8 * AT2_VP); const bf16x8 vf = __builtin_bit_cast(bf16x8, (v4u){lo.x, lo.y, hi.x, hi.y});
#endif
#pragma unroll
                    for (int nq = 0; nq < NQ; ++nq) o[nq][dt] = __builtin_amdgcn_mfma_f32_32x32x16_bf16(vf, pf[nq][t][s2], o[nq][dt], 0, 0, 0); }
        if (it + 1 < ntiles) AT2_WRITE((it + 1) & 1, tz);
        __syncthreads();
    }
#undef AT2_LOAD
#undef AT2_WRITE
#pragma unroll
    for (int nq = 0; nq < NQ; ++nq) { int qrow = q0 + wave * (32 * NQ) + nq * 32 + r32; asm volatile("" : "+v"(qrow));
        const float lt = l[nq] + shx(l[nq], 32, lane); const float inv = 1.f / lt;
        bf16* orow = MIX + (size_t)qrow * D + h * 64 + 4 * hh;
#pragma unroll
        for (int g = 0; g < 4; ++g) {
            v2u w; w.x = pk2(o[nq][0][4 * g] * inv, o[nq][0][4 * g + 1] * inv); w.y = pk2(o[nq][0][4 * g + 2] * inv, o[nq][0][4 * g + 3] * inv); *(v2u*)(orow + 8 * g) = w;
            v2u x; x.x = pk2(o[nq][1][4 * g] * inv, o[nq][1][4 * g + 1] * inv); x.y = pk2(o[nq][1][4 * g + 2] * inv, o[nq][1][4 * g + 3] * inv); *(v2u*)(orow + 32 + 8 * g) = x; } }
}
__device__ __forceinline__ void attn_mfma2(const Args& a, LAS unsigned char* lds) {
#ifdef ATT_NQ1
    for (int u = blockIdx.x; u < 512; u += gridDim.x) attn_unit2<1>(a, lds, u >> 6, (u >> 3) & 7, (u >> 6) * SEQ + (u & 7) * 256, (CTXL + SEQ) / 64, true);
#else
    for (int u = blockIdx.x; u < 256; u += gridDim.x) attn_unit2<2>(a, lds, u >> 5, (u >> 2) & 7, (u >> 5) * SEQ + (u & 3) * 512, (CTXL + SEQ) / 64, true);
#endif
    for (int u = blockIdx.x; u < 64; u += gridDim.x) attn_unit2<1>(a, lds, u >> 3, u & 7, TL + (u >> 3) * CTXL, CTXL / 64, false);
}

template <int R>
__device__ __forceinline__ void rowwise2(const float* xs_lat, const float* xs_ctx, float* xd_lat, float* xd_ctx, const bf16* Mb, const float* modg, const float* nwA,
                                         bf16* H, const float* modh, int sh_off, int sc_off, const float* nwB, int nrows, int wv) {
    const int tid = otid(wv), wave = wv, lane = tid & 63; const int NGW = gridDim.x * NWAVES, gw = blockIdx.x * NWAVES + wave;
    const int rpw = (nrows + NGW - 1) / NGW; const int rbeg = gw * rpw, rend = min(rbeg + rpw, nrows);
    for (int r0 = rbeg; r0 < rend; r0 += R) {
        f32x4 v[R][4]; v2u mm[R][4];
#pragma unroll
        for (int j = 0; j < R; ++j) { const int r = min(r0 + j, rend - 1); const float* xs = r < TL ? xs_lat + (size_t)r * D : xs_ctx + (size_t)(r - TL) * D;
#pragma unroll
            for (int q = 0; q < 4; ++q) v[j][q] = *(const f32x4*)(xs + q * 256 + lane * 4);
            if (Mb) {
#pragma unroll
                for (int q = 0; q < 4; ++q) mm[j][q] = *(const v2u*)(Mb + (size_t)r * D + q * 256 + lane * 4); } }
#pragma unroll
        for (int j = 0; j < R; ++j) { const int r = r0 + j; if (r < rend) {
            const bool lat = r < TL; const int cond = lat ? (r >> 11) : 8; float* xd = lat ? xd_lat + (size_t)r * D : xd_ctx + (size_t)(r - TL) * D;
            if (Mb) {
                f32x4 m[4]; float ss = 0.f;
#pragma unroll
                for (int q = 0; q < 4; ++q) { const v2u w = mm[j][q]; m[q] = (f32x4){bflo(w.x), bfhi(w.x), bflo(w.y), bfhi(w.y)}; ss += (m[q][0] * m[q][0] + m[q][1] * m[q][1]) + (m[q][2] * m[q][2] + m[q][3] * m[q][3]); }
                const float rs = rsqrtf(wave_sum(ss, lane) * (1.f / D) + EPS);
#pragma unroll
                for (int q = 0; q < 4; ++q) { const f32x4 g = *(const f32x4*)(modg + (size_t)cond * MODW + q * 256 + lane * 4); const f32x4 w = *(const f32x4*)(nwA + q * 256 + lane * 4);
                    v[j][q] = v[j][q] + g * (m[q] * rs * w); }
            }
#pragma unroll
            for (int q = 0; q < 4; ++q) *(f32x4*)(xd + q * 256 + lane * 4) = v[j][q];
            if (H) {
                float ss = 0.f;
#pragma unroll
                for (int q = 0; q < 4; ++q) ss += (v[j][q][0] * v[j][q][0] + v[j][q][1] * v[j][q][1]) + (v[j][q][2] * v[j][q][2] + v[j][q][3] * v[j][q][3]);
                const float rs = rsqrtf(wave_sum(ss, lane) * (1.f / D) + EPS);
#pragma unroll
                for (int q = 0; q < 4; ++q) { const int c = q * 256 + lane * 4;
                    const f32x4 w = *(const f32x4*)(nwB + c); const f32x4 sc = *(const f32x4*)(modh + (size_t)cond * MODW + sc_off + c); const f32x4 sh = *(const f32x4*)(modh + (size_t)cond * MODW + sh_off + c);
                    const f32x4 hv = (v[j][q] * rs * w) * (sc + 1.0f) + sh;
                    v2u o; o.x = pk2(hv[0], hv[1]); o.y = pk2(hv[2], hv[3]); *(v2u*)(H + (size_t)r * D + c) = o; }
            } } }
    }
}

__device__ __forceinline__ void convgate2(const Args& a, int l, int nrows) {
    const bf16* U = (const bf16*)(a.ws + WS_U); bf16* G = (bf16*)(a.ws + WS_G); const float* cw = a.in[I_FCONV] + (size_t)l * 3 * UPW;
    const int total = (nrows / 8) * (DFF / 8);
    for (int idx = blockIdx.x * NTHR + otid(a.wv); idx < total; idx += gridDim.x * NTHR) {
        const int r0 = (idx / (DFF / 8)) * 8, c0 = (idx % (DFF / 8)) * 8; const bf16* u = U + (size_t)r0 * UPW + c0;
        const bool hp = has_prev(r0), hn = has_next(r0 + 7);
        v4u ua[10], ug[10];
#pragma unroll
        for (int j = 0; j < 10; ++j) { const int rr = (j == 0 && !hp) ? 0 : ((j == 9 && !hn) ? 7 : j - 1); ua[j] = *(const v4u*)(u + (ptrdiff_t)rr * UPW); ug[j] = *(const v4u*)(u + (ptrdiff_t)rr * UPW + DFF); }
        float wa[3][8], wg[3][8];
#pragma unroll
        for (int t = 0; t < 3; ++t)
#pragma unroll
            for (int j = 0; j < 8; ++j) { wa[t][j] = cw[t * UPW + c0 + j]; wg[t][j] = cw[t * UPW + DFF + c0 + j]; }
        if (!hp) { ua[0] = (v4u){0u, 0u, 0u, 0u}; ug[0] = ua[0]; }
        if (!hn) { ua[9] = (v4u){0u, 0u, 0u, 0u}; ug[9] = ua[9]; }
        float pa[8], ca[8], na[8], pg[8], cg_[8], ng[8];
        unpack8(ua[0], pa); unpack8(ug[0], pg); unpack8(ua[1], ca); unpack8(ug[1], cg_);
#pragma unroll
        for (int j = 0; j < 8; ++j) {
            unpack8(ua[j + 2], na); unpack8(ug[j + 2], ng);
            float o[8];
#pragma unroll
            for (int k = 0; k < 8; ++k) { const float act = wa[0][k] * pa[k] + wa[1][k] * ca[k] + wa[2][k] * na[k]; const float gate = wg[0][k] * pg[k] + wg[1][k] * cg_[k] + wg[2][k] * ng[k]; o[k] = silu_f(act) * gate; }
            *(v4u*)(G + (size_t)(r0 + j) * DFF + c0) = pack8(o);
#pragma unroll
            for (int k = 0; k < 8; ++k) { pa[k] = ca[k]; ca[k] = na[k]; pg[k] = cg_[k]; cg_[k] = ng[k]; }
        }
    }
}

__device__ __forceinline__ void ssd_conv2(const Args& a, int i) {
    const bf16* ZX = (const bf16*)(a.ws + WS_ZX); bf16* XBC = (bf16*)(a.ws + WS_XBC); float* DT = (float*)(a.ws + WS_DT); float* AA = (float*)(a.ws + WS_AA);
    const float* cw = a.in[I_SCONVW] + (size_t)i * 3 * 3072; const float* cb = a.in[I_SCONVB] + (size_t)i * 3072;
    const int total = (T / 8) * 384;
    for (int idx = blockIdx.x * NTHR + otid(a.wv); idx < total; idx += gridDim.x * NTHR) {
        const int r0 = (idx / 384) * 8, c0 = (idx % 384) * 8; const bf16* u = ZX + (size_t)r0 * SSD_INP + 2048 + c0;
        const bool hp = has_prev(r0), hn = has_next(r0 + 7);
        v4u ux[10];
#pragma unroll
        for (int j = 0; j < 10; ++j) { const int rr = (j == 0 && !hp) ? 0 : ((j == 9 && !hn) ? 7 : j - 1); ux[j] = *(const v4u*)(u + (ptrdiff_t)rr * SSD_INP); }
        float w[3][8], bias[8];
#pragma unroll
        for (int j = 0; j < 8; ++j) { w[0][j] = cw[c0 + j]; w[1][j] = cw[3072 + c0 + j]; w[2][j] = cw[2 * 3072 + c0 + j]; bias[j] = cb[c0 + j]; }
        if (!hp) ux[0] = (v4u){0u, 0u, 0u, 0u};
        if (!hn) ux[9] = (v4u){0u, 0u, 0u, 0u};
        float p[8], c[8], n[8];
        unpack8(ux[0], p); unpack8(ux[1], c);
#pragma unroll
        for (int j = 0; j < 8; ++j) {
            unpack8(ux[j + 2], n); float o[8];
#pragma unroll
            for (int k = 0; k < 8; ++k) o[k] = silu_f(bias[k] + w[0][k] * p[k] + w[1][k] * c[k] + w[2][k] * n[k]);
            *(v4u*)(XBC + (size_t)(r0 + j) * 3072 + c0) = pack8(o);
#pragma unroll
            for (int k = 0; k < 8; ++k) { p[k] = c[k]; c[k] = n[k]; }
        }
    }
    const float* alog = a.in[I_ALOG] + i * 64; const float* dtb = a.in[I_DTB] + i * 64;
    for (int idx = blockIdx.x * NTHR + otid(a.wv); idx < T * 8; idx += gridDim.x * NTHR) {
        const int r = idx >> 3, j0 = (idx & 7) * 8; float raw[8], dt[8], av[8];
        unpack8(*(const v4u*)(ZX + (size_t)r * SSD_INP + 5120 + j0), raw);
#pragma unroll
        for (int k = 0; k < 8; ++k) { const float x = raw[k] + dtb[j0 + k]; dt[k] = x > 15.f ? x : (x < -15.f ? __expf(x) : __logf(1.f + __expf(x))); av[k] = -__expf(alog[j0 + k]) * dt[k]; }
        *(f32x4*)(DT + (size_t)r * 64 + j0) = (f32x4){dt[0], dt[1], dt[2], dt[3]}; *(f32x4*)(DT + (size_t)r * 64 + j0 + 4) = (f32x4){dt[4], dt[5], dt[6], dt[7]};
        *(f32x4*)(AA + (size_t)r * 64 + j0) = (f32x4){av[0], av[1], av[2], av[3]}; *(f32x4*)(AA + (size_t)r * 64 + j0 + 4) = (f32x4){av[4], av[5], av[6], av[7]};
    }
}

__device__ __forceinline__ void gatenorm2(const Args& a, int i, int nrows) {
    const int tid = otid(a.wv), wave = a.wv, lane = tid & 63; const int NGW = gridDim.x * NWAVES, gw = blockIdx.x * NWAVES + wave;
    const bf16* ZX = (const bf16*)(a.ws + WS_ZX); bf16* YN = (bf16*)(a.ws + WS_XBC); const float* nw = a.in[I_SNORM] + i * 2048;
    const int rpw = (nrows + NGW - 1) / NGW; const int rbeg = gw * rpw, rend = min(rbeg + rpw, nrows);
    constexpr int R = 3;
    for (int r0 = rbeg; r0 < rend; r0 += R) {
        v4u yv[R][4], zv[R][4];
#pragma unroll
        for (int j = 0; j < R; ++j) { const int r = min(r0 + j, rend - 1);
#pragma unroll
            for (int q = 0; q < 4; ++q) { const int c = q * 512 + lane * 8; yv[j][q] = *(const v4u*)(ZX + (size_t)r * SSD_INP + 2048 + c); zv[j][q] = *(const v4u*)(ZX + (size_t)r * SSD_INP + c); } }
#pragma unroll
        for (int j = 0; j < R; ++j) { const int r = r0 + j; if (r < rend) {
            float v[4][8]; float ss = 0.f;
#pragma unroll
            for (int q = 0; q < 4; ++q) { float y[8], z[8]; unpack8(yv[j][q], y); unpack8(zv[j][q], z);
#pragma unroll
                for (int k = 0; k < 8; ++k) { v[q][k] = y[k] * silu_f(z[k]); ss += v[q][k] * v[q][k]; } }
            const float rs = rsqrtf(wave_sum(ss, lane) * (1.f / 2048.f) + EPS);
#pragma unroll
            for (int q = 0; q < 4; ++q) { const int c = q * 512 + lane * 8; float o[8];
#pragma unroll
                for (int k = 0; k < 8; ++k) o[k] = v[q][k] * rs * nw[c + k];
                *(v4u*)(YN + (size_t)r * 2048 + c) = pack8(o); } } }
    }
}

__device__ __forceinline__ void ffn_fixup(const Args& a, int l, int nrows) {
    const bf16* Ue = (const bf16*)(a.ws + WS_UE); bf16* G = (bf16*)(a.ws + WS_G); const float* cw = a.in[I_FCONV] + (size_t)l * 3 * UPW;
    const int total = (nrows / 256) * 2 * (DFF / 8);
    for (int idx = blockIdx.x * NTHR + otid(a.wv); idx < total; idx += gridDim.x * NTHR) {
        const int cg = idx % (DFF / 8), which = (idx / (DFF / 8)) & 1, pm = idx / (2 * (DFF / 8)); const int c0 = cg * 8; const int col = (c0 / 128) * 256 + (c0 % 128);
        const int r = pm * 256 + (which ? 255 : 0);
        const bf16* e0 = Ue + (size_t)(pm * 4) * UPW + col;
        const bf16* pp = which ? e0 + 2 * UPW : e0 - UPW;
        const bf16* pc = which ? e0 + 3 * UPW : e0;
        const bf16* pn = which ? e0 + 4 * UPW : e0 + UPW;
        const bool hp = which ? true : has_prev(r), hn = which ? has_next(r) : true;
        float pa[8], pg[8], ca[8], cg_[8], na[8], ng[8];
        unpack8(*(const v4u*)pc, ca); unpack8(*(const v4u*)(pc + 128), cg_);
        if (hp) { unpack8(*(const v4u*)pp, pa); unpack8(*(const v4u*)(pp + 128), pg); } else {
#pragma unroll
            for (int k = 0; k < 8; ++k) { pa[k] = 0.f; pg[k] = 0.f; } }
        if (hn) { unpack8(*(const v4u*)pn, na); unpack8(*(const v4u*)(pn + 128), ng); } else {
#pragma unroll
            for (int k = 0; k < 8; ++k) { na[k] = 0.f; ng[k] = 0.f; } }
        float o[8];
#pragma unroll
        for (int k = 0; k < 8; ++k) { const float act = cw[c0 + k] * pa[k] + cw[UPW + c0 + k] * ca[k] + cw[2 * UPW + c0 + k] * na[k];
            const float gate = cw[DFF + c0 + k] * pg[k] + cw[UPW + DFF + c0 + k] * cg_[k] + cw[2 * UPW + DFF + c0 + k] * ng[k]; o[k] = silu_f(act) * gate; }
        *(v4u*)(G + (size_t)r * DFF + c0) = pack8(o);
    }
}

__device__ __forceinline__ void prep_even2(const Args& a, int i) {
    const int tid = otid(a.wv), wave = a.wv, lane = tid & 63; const int NGW = gridDim.x * NWAVES, gw = blockIdx.x * NWAVES + wave;
    const bf16* P = (const bf16*)(a.ws + WS_P); bf16* CQN = (bf16*)(a.ws + WS_CQN); bf16* CKVN = (bf16*)(a.ws + WS_CKVN); bf16* KR = (bf16*)(a.ws + WS_KR); bf16* MIX = (bf16*)(a.ws + WS_MIX);
    const float* qn = a.in[I_QNORM] + i * 384; const float* kvn = a.in[I_KVNORM] + i * 256; const float* cw = a.in[I_SCONV] + i * 3 * 512;
    const float* ct = (const float*)(a.ws + WS_ROPE); const float* st = ct + SEQ * 16;
    constexpr int R = 3; const int rpw = (T + NGW - 1) / NGW; const int rbeg = gw * rpw, rend = min(rbeg + rpw, T);
    const int c0 = lane * 8;
    for (int r0 = rbeg; r0 < rend; r0 += R) {
        unsigned q32[R][3]; v2u kv2[R]; bf16 krv[R]; v4u gbv[R], gcv[R + 2], xvv[R + 2];
#pragma unroll
        for (int j = 0; j < R; ++j) { const int r = min(r0 + j, rend - 1); const bf16* p = P + (size_t)r * HYB_INP;
            const unsigned* p32 = (const unsigned*)(p + lane * 6); q32[j][0] = p32[0]; q32[j][1] = p32[1]; q32[j][2] = p32[2];
            kv2[j] = *(const v2u*)(p + 384 + lane * 4); krv[j] = p[640 + (lane & 31)]; gbv[j] = *(const v4u*)(p + 672 + c0); }
#pragma unroll
        for (int j = 0; j < R + 2; ++j) { int r = r0 + j - 1; r = max(0, min(r, T - 1)); const bf16* p = P + (size_t)r * HYB_INP; gcv[j] = *(const v4u*)(p + 1184 + c0); xvv[j] = *(const v4u*)(p + 1696 + c0); }
#pragma unroll
        for (int j = 0; j < R; ++j) { const int r = r0 + j; if (r < rend) {
            {   float f[6] = {bflo(q32[j][0]), bfhi(q32[j][0]), bflo(q32[j][1]), bfhi(q32[j][1]), bflo(q32[j][2]), bfhi(q32[j][2])}; float ss = 0.f;
#pragma unroll
                for (int k = 0; k < 6; ++k) ss += f[k] * f[k];
                const float rs = rsqrtf(wave_sum(ss, lane) * (1.f / 384.f) + EPS);
#pragma unroll
                for (int k = 0; k < 6; ++k) f[k] = f[k] * rs * qn[lane * 6 + k];
                unsigned* o32 = (unsigned*)(CQN + (size_t)r * 384 + lane * 6); o32[0] = pk2(f[0], f[1]); o32[1] = pk2(f[2], f[3]); o32[2] = pk2(f[4], f[5]); }
            {   const v2u w = kv2[j]; float f[4] = {bflo(w.x), bfhi(w.x), bflo(w.y), bfhi(w.y)};
                const float ss = (f[0] * f[0] + f[1] * f[1]) + (f[2] * f[2] + f[3] * f[3]);
                const float rs = rsqrtf(wave_sum(ss, lane) * (1.f / 256.f) + EPS);
                const f32x4 g = *(const f32x4*)(kvn + lane * 4);
                v2u o; o.x = pk2(f[0] * rs * g[0], f[1] * rs * g[1]); o.y = pk2(f[2] * rs * g[2], f[3] * rs * g[3]); *(v2u*)(CKVN + (size_t)r * 256 + lane * 4) = o; }
            {   const int jj = lane & 31; const float v = bf1(krv[j]); const float o = shx(v, 16, lane); float res = v;
                if (r < TL) { const int t = r & (SEQ - 1); const float c = ct[t * 16 + (jj & 15)], s = st[t * 16 + (jj & 15)]; res = (jj < 16) ? v * c - o * s : o * s + v * c; }
                if (lane < 32) KR[(size_t)r * 32 + jj] = (bf16)f2bf(res); }
            {   float gb[8], t0[8], t1[8], acc[8];
                unpack8(gbv[j], gb); unpack8(gcv[j + 1], t0); unpack8(xvv[j + 1], t1);
#pragma unroll
                for (int k = 0; k < 8; ++k) acc[k] = cw[512 + c0 + k] * (t0[k] * t1[k]);
                if (has_prev(r)) { unpack8(gcv[j], t0); unpack8(xvv[j], t1);
#pragma unroll
                    for (int k = 0; k < 8; ++k) acc[k] += cw[c0 + k] * (t0[k] * t1[k]); }
                if (has_next(r)) { unpack8(gcv[j + 2], t0); unpack8(xvv[j + 2], t1);
#pragma unroll
                    for (int k = 0; k < 8; ++k) acc[k] += cw[1024 + c0 + k] * (t0[k] * t1[k]); }
#pragma unroll
                for (int k = 0; k < 8; ++k) acc[k] *= gb[k];
                *(v4u*)(MIX + (size_t)r * D + 512 + c0) = pack8(acc); }
        } }
    }
}

__device__ __forceinline__ void ffn_fixup_panel(const Args& a, int l, int pm) {
    const bf16* Ue = (const bf16*)(a.ws + WS_UE); bf16* G = (bf16*)(a.ws + WS_G); const float* cw = a.in[I_FCONV] + (size_t)l * 3 * UPW;
    for (int idx = otid(a.wv); idx < 2 * (DFF / 8); idx += NTHR) {
        const int cg = idx % (DFF / 8), which = idx / (DFF / 8); const int c0 = cg * 8; const int col = (c0 / 128) * 256 + (c0 % 128);
        const int r = pm * 256 + (which ? 255 : 0);
        const bf16* e0 = Ue + (size_t)(pm * 4) * UPW + col;
        const bf16* pp = which ? e0 + 2 * UPW : e0 - UPW; const bf16* pc = which ? e0 + 3 * UPW : e0; const bf16* pn = which ? e0 + 4 * UPW : e0 + UPW;
        const bool hp = which ? true : has_prev(r), hn = which ? has_next(r) : true;
        float pa[8], pg[8], ca[8], cg_[8], na[8], ng[8];
        unpack8(*(const v4u*)pc, ca); unpack8(*(const v4u*)(pc + 128), cg_);
        if (hp) { unpack8(*(const v4u*)pp, pa); unpack8(*(const v4u*)(pp + 128), pg); } else {
#pragma unroll
            for (int k = 0; k < 8; ++k) { pa[k] = 0.f; pg[k] = 0.f; } }
        if (hn) { unpack8(*(const v4u*)pn, na); unpack8(*(const v4u*)(pn + 128), ng); } else {
#pragma unroll
            for (int k = 0; k < 8; ++k) { na[k] = 0.f; ng[k] = 0.f; } }
        float o[8];
#pragma unroll
        for (int k = 0; k < 8; ++k) { const float act = cw[c0 + k] * pa[k] + cw[UPW + c0 + k] * ca[k] + cw[2 * UPW + c0 + k] * na[k];
            const float gate = cw[DFF + c0 + k] * pg[k] + cw[UPW + DFF + c0 + k] * cg_[k] + cw[2 * UPW + DFF + c0 + k] * ng[k]; o[k] = silu_f(act) * gate; }
        *(v4u*)(G + (size_t)r * DFF + c0) = pack8(o);
    }
}

__device__ __forceinline__ void ssd_rstd_panel(const Args& a, int pm) {
    const float* SS = (const float*)(a.ws + WS_SS); float* RS = (float*)(a.ws + WS_RS);
    const int t = otid(a.wv); const int row = pm * 256 + (t >> 1), half = t & 1;
    const f32x4* p = (const f32x4*)(SS + (size_t)row * 64 + half * 32);
    f32x4 s = p[0];
#pragma unroll
    for (int k = 1; k < 8; ++k) s = s + p[k];
    float v = (s[0] + s[1]) + (s[2] + s[3]); v += shx(v, 1, t & 63);
    if (!half) RS[row] = rsqrtf(v * (1.f / 2048.f) + EPS);
}

#ifndef MK_SINGLE
#define MK_SINGLE 1
#endif
struct GemmDesc { const bf16* A; const bf16* Bt; int M, N, K; bf16* O; int ldc; int mode; int lda; };

__global__ void __launch_bounds__(NTHR, 2) fwd_kernel(Args a_in) {
    extern __shared__ __attribute__((aligned(16))) unsigned char lds_raw[];
    LAS unsigned char* lds = (LAS unsigned char*)lds_raw;
#if MK_SINGLE == 1
    volatile LAS unsigned* bst = (volatile LAS unsigned*)(lds + LDS_BYTES - 64);
    const int wv0 = __builtin_amdgcn_readfirstlane((int)threadIdx.x >> 6);
    { const int t0 = otid(wv0); if (t0 < 16) bst[t0] = 0u; }
    __syncthreads();
    const XcdBarrier xbar = xcd_barrier_post((unsigned*)(a_in.ws + WS_CTL), bst, wv0);
#endif
    const Args& a0 = a_in;
#ifdef TDIAG
    unsigned long long tcat[6] = {0, 0, 0, 0, 0, 0}; unsigned long long tlast = __builtin_amdgcn_s_memrealtime();
#endif
    for (int s = a0.lo; s < a0.hi; ++s) {
        Args a = a0;
        { long oz; asm volatile("s_mov_b64 %0, 0" : "=s"(oz));
#pragma unroll
          for (int q = 0; q < 25; ++q) a.in[q] = (const float*)((const char*)a0.in[q] + oz);
          a.out = (float*)((char*)a0.out + oz); a.ws = a0.ws + oz; a.wv = wv0; }
        unsigned char* ws = a.ws;
        float* XL = a.out; float* XC = (float*)(ws + WS_XC); bf16* H = (bf16*)(ws + WS_H); bf16* Mb = (bf16*)(ws + WS_M);
        const float* MOD = (const float*)(ws + WS_MOD); const float* NW = a.in[I_NORMW];
        int nrep = 1;
#ifdef PROBE_MASK
        if (s == 0 && (PROBE_MASK >> 20 & 1u)) nrep = 2;
        if (s >= 2) { const int pk = (s - 2) % 10, ppar = ((s - 2) / 10) & 1; if ((PROBE_MASK >> (pk + 10 * ppar)) & 1u) nrep = 2; }
#endif
        for (int rep = 0; rep < nrep; ++rep) {
        GemmDesc g0{}, g1{}; int ng = 0;
#ifndef NO_SIMPLE
        if (s == 0) {
            mod_compute(a, lds);
            rope_tables(a);
            convert_layer(a, 0, lds);
        } else if (s == 1) {
            rowwise2<3>(a.in[I_X], a.in[I_CTX], XL, XC, nullptr, nullptr, nullptr, H, MOD, 0, 1024, NW, T, a.wv);
        } else {
            const int l = (s - 2) / 10, k = (s - 2) % 10, i = l >> 1; const bool even = (l & 1) == 0, last = (l == 3);
            const int MR = last ? TL : T;
            switch (k) {
            case 0:
                if (even) { g0 = GemmDesc{H, (const bf16*)(ws + W_IN), T, HYB_INP, D, (bf16*)(ws + WS_P), HYB_INP}; ng = 1; }
                else      { g0 = GemmDesc{H, (const bf16*)(ws + W_IN), T, SSD_INP, D, (bf16*)(ws + WS_ZX), SSD_INP}; ng = 1; }
                break;
            case 1: if (even) prep_even2(a, i); else ssd_conv2(a, i); break;
            case 2:
                if (even) { { g0 = GemmDesc{(const bf16*)(ws + WS_CQN), (const bf16*)(ws + W_UQ), T, QW, 384, (bf16*)(ws + WS_Q), QW}; ng = 1; }
                            g1 = GemmDesc{(const bf16*)(ws + WS_CKVN), (const bf16*)(ws + W_UKV), T, KVW, 256, (bf16*)(ws + WS_KV), KVW}; ng = 2; }
                else {
#ifdef SSD_NAIVE
 ssd_scan_naive(a, i, last, lds);
#else
 ssd_scan_mfma(a, i, last, lds);
#endif
 }
                break;
            case 3: if (even) {
#ifdef ATTN_NAIVE
 attn_naive(a, lds);
#else
 attn_mfma(a, lds);
#endif
 } break;
            case 4:
                if (even) { g0 = GemmDesc{(const bf16*)(ws + WS_MIX), (const bf16*)(ws + W_OUT), MR, D, D, Mb, D}; ng = 1; }
                else      { g0 = GemmDesc{(const bf16*)(ws + WS_XBC), (const bf16*)(ws + W_OUT), MR, D, 2048, Mb, D, 2, 3072}; ng = 1;
                            pg8::StaticOrder S0; S0.init(MR, D, (int)gridDim.x, (int)blockIdx.x); pg8::Unit u0; int lastpm = -1;
                            for (int ui0 = 0; S0.next(ui0, u0); ++ui0) if (u0.pm != lastpm) { ssd_rstd_panel(a, u0.pm); lastpm = u0.pm; }
                            asm volatile("s_waitcnt vmcnt(0)" ::: "memory"); __syncthreads(); }
                break;
            case 5:
#ifdef PROBE_ROW2
                if (l > 0) rowwise2<3>(XL, XC, XL, XC, nullptr, nullptr, nullptr, H, MOD + (size_t)l * 9 * MODW, 0, 1024, NW + (l * 4 + 0) * D, MR, a.wv);
#endif
                rowwise2<3>(XL, XC, XL, XC, Mb, MOD + (size_t)l * 9 * MODW + 2048, NW + (l * 4 + 1) * D, H, MOD + (size_t)l * 9 * MODW, 3072, 4096, NW + (l * 4 + 2) * D, MR, a.wv); break;
            case 6: { g0 = GemmDesc{H, (const bf16*)(ws + W_UP), MR, UPW, D, (bf16*)(ws + WS_G), DFF, 1}; ng = 1; } break;
            case 7: break;
            case 8: { g0 = GemmDesc{(const bf16*)(ws + WS_G), (const bf16*)(ws + W_DN), MR, D, DFF, Mb, D}; ng = 1;
                      pg8::StaticOrder S0; S0.init(MR, D, (int)gridDim.x, (int)blockIdx.x); pg8::Unit u0; int lastpm = -1;
                      for (int ui0 = 0; S0.next(ui0, u0); ++ui0) if (u0.pm != lastpm) { ffn_fixup_panel(a, l, u0.pm); lastpm = u0.pm; }
                      asm volatile("s_waitcnt vmcnt(0)" ::: "memory"); __syncthreads(); } break;
            case 9:
                if (!last) { rowwise2<3>(XL, XC, XL, XC, Mb, MOD + (size_t)l * 9 * MODW + 5120, NW + (l * 4 + 3) * D, H, MOD + (size_t)(l + 1) * 9 * MODW, 0, 1024, NW + ((l + 1) * 4 + 0) * D, T, a.wv);
                             convert_layer(a, l + 1, lds); }
                else rowwise2<3>(XL, XC, XL, XC, Mb, MOD + (size_t)l * 9 * MODW + 5120, NW + (l * 4 + 3) * D, nullptr, MOD, 0, 0, NW, TL, a.wv);
                break;
            }
        }
#else
        { g0 = GemmDesc{H, (const bf16*)(ws + W_IN), T, a.hi * 256, a.lo * 128, (bf16*)(ws + WS_P), HYB_INP}; ng = 1; }
#endif
        for (int gi = 0; gi < ng; ++gi) {
            const bool f = (gi == 0);
            const int lda_ = f ? g0.lda : g1.lda, K_ = f ? g0.K : g1.K;
            pg8::Gemm g{f ? g0.A : g1.A, f ? g0.Bt : g1.Bt, f ? g0.M : g1.M, f ? g0.N : g1.N, K_, a.wv,
#ifdef GDIAG
                (s == GDIAG_STEP) ? (float*)(a0.ws + WS_MOD + 900 * 1024) : nullptr
#else
                nullptr
#endif
                , lda_ ? lda_ : K_}; pg8::StaticOrder S; S.init(g.M, g.N, (int)gridDim.x, (int)blockIdx.x);
            pg8::EpiFfn E{f ? g0.O : g1.O, f ? g0.ldc : g1.ldc, f ? g0.mode : 0, (const float*)(ws + WS_RS), (bf16*)(ws + WS_UE), a.in[I_FCONV] + (size_t)((s - 2) / 10) * 3 * UPW, (LAS pg8::f32x4*)(lds + 131072), a.wv};
#ifndef NO_GEMM
            pg8::gemm_phase<pg8::EpiFfn, pg8::StaticOrder, true, true>(lds, g, S, E);
#endif
            __syncthreads();
        }
        if (rep + 1 < nrep) __syncthreads();
        }
#ifdef GDIAG
        if (s + 1 == a0.hi) { __syncthreads(); asm volatile("s_waitcnt vmcnt(0)" ::: "memory"); if (blockIdx.x == 0 && otid(wv0) == 0) { const float* dg = (const float*)(a0.ws + WS_MOD + 900 * 1024); a0.out[0] += 25.0f * dg[GDIAG_SEL] / dg[3]; } }
#endif
#ifdef SSD_DIAG
        if (s + 1 == a0.hi) { __syncthreads(); asm volatile("s_waitcnt vmcnt(0)" ::: "memory"); if (blockIdx.x == 0 && otid(wv0) == 0) { const float* dg = (const float*)(a0.ws + WS_MOD + 900 * 1024); a0.out[0] += 25.0f * dg[SSD_DIAG_SEL] / dg[7]; } }
#endif
#ifdef TDIAG
        if (s + 1 == a0.hi) { __syncthreads(); }
#endif
#ifdef BLK_JITTER
        if ((((int)blockIdx.x * 7 + s * 3) % 11) == 0) { for (int q = 0; q < 40; ++q) __builtin_amdgcn_s_sleep(127); }
#endif
        if (s + 1 < a0.hi && !(s >= 2 && ((s - 2) % 10 == 7 || ((s - 2) % 10 == 3 && (((s - 2) / 10) & 1))))) {
#if MK_SINGLE == 1
            xcd_barrier(xbar);
#ifdef PROBE_BAR2
            xcd_barrier(xbar);
#endif
#elif MK_SINGLE == 2
            cg::this_grid().sync();
#endif
        }
#ifdef TDIAG
        { const unsigned long long tn = __builtin_amdgcn_s_memrealtime(); int cat = 0;
          if (s >= 2) { const int k = (s - 2) % 10, par = ((s - 2) / 10) & 1; cat = (k == 0 || k == 4 || k == 6 || k == 8 || (k == 2 && par == 0)) ? 1 : ((k == 5 || k == 9) ? 2 : ((k == 3 && par == 0) ? 4 : ((k == 2 && par == 1) ? 5 : 3)));
#ifdef TDIAG_K
              cat = (k == TDIAG_K && (TDIAG_PAR == 2 || par == TDIAG_PAR)) ? 1 : 3;
#endif
          }
#pragma unroll
          for (int q = 0; q < 6; ++q) if (q == cat) tcat[q] += tn - tlast;
          tlast = tn;
          if (s + 1 == a0.hi) { asm volatile("s_waitcnt vmcnt(0)" ::: "memory"); if (blockIdx.x == 0 && otid(wv0) == 0) { unsigned long long tt = 0;
#pragma unroll
              for (int q = 0; q < 6; ++q) tt += tcat[q];
              a0.out[0] += (TDIAG == 6) ? (float)tt * (1.0f / 20000.0f) : 25.0f * (float)tcat[TDIAG < 6 ? TDIAG : 0] / (float)tt; } } }
#endif
    }
}

extern "C" void kernel_launch(void* const* d_in, const int* in_sizes, int n_in, void* d_out, int out_size, void* d_ws, size_t ws_size, hipStream_t stream) {
    static int grid = 0;
    if (grid == 0) {
        if (n_in != 25 || out_size != TL * D || ws_size < WS_END) { fprintf(stderr, "kernel_launch: unexpected problem (n_in %d out %d ws %zu need %zu)\n", n_in, out_size, ws_size, (size_t)WS_END); grid = -1; return; }
        if (hipFuncSetAttribute((const void*)fwd_kernel, hipFuncAttributeMaxDynamicSharedMemorySize, LDS_BYTES) != hipSuccess) { fprintf(stderr, "kernel_launch: hipFuncSetAttribute failed\n"); grid = -1; return; }
        int dev = 0, cus = 0, per_cu = 0;
        hipGetDevice(&dev); hipDeviceGetAttribute(&cus, hipDeviceAttributeMultiprocessorCount, dev);
        hipOccupancyMaxActiveBlocksPerMultiprocessor(&per_cu, (const void*)fwd_kernel, NTHR, LDS_BYTES);
        (void)hipGetLastError();
        if (per_cu < 1) { fprintf(stderr, "kernel_launch: occupancy query says %d blocks per CU\n", per_cu); }
        grid = cus;
    }
    if (grid < 0) return;
#if MK_SINGLE == 1
    if (hipMemsetAsync((char*)d_ws + WS_CTL, 0, CTL_ZERO_BYTES, stream) != hipSuccess) { fprintf(stderr, "kernel_launch: memset failed\n"); return; }
#endif
    Args a{};
    for (int i = 0; i < 25; ++i) a.in[i] = (const float*)d_in[i];
    a.out = (float*)d_out; a.ws = (unsigned char*)d_ws;
#if MK_SINGLE
    a.lo = 0; a.hi = NSTEP + 1;
    void* args[] = {&a};
    hipError_t e = hipLaunchCooperativeKernel((const void*)fwd_kernel, dim3(grid), dim3(NTHR), args, LDS_BYTES, stream);
    if (e != hipSuccess) fprintf(stderr, "cooperative launch failed: %s (grid %d)\n", hipGetErrorString(e), grid);
#else
    for (int s = 0; s < NSTEP + 1; ++s) { a.lo = s; a.hi = s + 1; hipLaunchKernelGGL(fwd_kernel, dim3(grid), dim3(NTHR), LDS_BYTES, stream, a); }
#endif
}
```

```cpp
#include <hip/hip_runtime.h>
#include <hip/hip_cooperative_groups.h>
#include <cstdio>
#include <cstdint>
namespace cg = cooperative_groups;
__device__ __forceinline__ int otid(int wv) { int l; asm volatile("v_mbcnt_lo_u32_b32 %0, -1, 0\n\tv_mbcnt_hi_u32_b32 %0, -1, %0" : "=v"(l)); return (wv << 6) | l; }
__device__ __forceinline__ float shx(float v, int mask, int lane) { return __builtin_bit_cast(float, __builtin_amdgcn_ds_bpermute((lane ^ mask) << 2, __builtin_bit_cast(int, v))); }
#define LAS __attribute__((address_space(3)))
typedef float f32x2_cv __attribute__((ext_vector_type(2))); typedef __bf16 bf16x2_cv __attribute__((ext_vector_type(2)));
__device__ __forceinline__ unsigned hw_cvtpk(float lo, float hi) { f32x2_cv v = {lo, hi}; bf16x2_cv b = __builtin_convertvector(v, bf16x2_cv); return __builtin_bit_cast(unsigned, b); }
__device__ __forceinline__ int xblk() { const int c = (int)blockIdx.x; return gridDim.x == 256 ? ((c & 7) * 32 + (c >> 3)) : c; }
#define XB_TMO      128
#define XB_XCNT(j)  (256  + 64 * (j))
#define XB_XSUB(j)  (1280 + 64 * (j))
#define XB_XGEN(j)  (2304 + 64 * (j))
#define XB_TOP      3328
#define XB_TOPGEN   3392
#define XCD_BAR_WORDS 3456
#define XB_SPIN_CAP (1u << 18)

__device__ __forceinline__ unsigned xb_ld(unsigned* p)              { return __hip_atomic_load(p, __ATOMIC_RELAXED, __HIP_MEMORY_SCOPE_AGENT); }
__device__ __forceinline__ unsigned xb_add(unsigned* p, unsigned v) { return __hip_atomic_fetch_add(p, v, __ATOMIC_RELAXED, __HIP_MEMORY_SCOPE_AGENT); }
__device__ __forceinline__ unsigned xb_xcc_id() { return (unsigned)__builtin_amdgcn_s_getreg((3 << 11) | 20) & 0xFu; }
#define XB_SPIN(cond, bar) do { unsigned _sp = 0; while (cond) { __builtin_amdgcn_s_sleep(1); \
    if ((++_sp & 255u) == 0u) { if (xb_ld(&(bar)[XB_TMO])) break; if (_sp > XB_SPIN_CAP) { atomicAdd(&(bar)[XB_TMO], 1u); break; } } } } while (0)

struct XcdBarrier {
    unsigned* bar; unsigned x; int wv;
    volatile LAS unsigned* st;
};

__device__ __forceinline__ XcdBarrier xcd_barrier_post(unsigned* bar, volatile LAS unsigned* st, int wv) {
    XcdBarrier b; b.bar = bar; b.x = xb_xcc_id(); b.st = st; b.wv = wv;
    if (otid(wv) == 0) (void)xb_add(&bar[XB_XCNT(b.x)], 1u);
    return b;
}
__device__ __forceinline__ void xcd_barrier_complete(unsigned* bar, unsigned x, unsigned& nloc, unsigned& nx) {
    const unsigned G = gridDim.x * gridDim.y * gridDim.z;
    unsigned sum, cnt, mine, sp = 0u;
    for (;;) {
        sum = 0u; cnt = 0u; mine = 0u;
#pragma unroll
        for (unsigned j = 0; j < 16; ++j) { const unsigned c = xb_ld(&bar[XB_XCNT(j)]); sum += c; cnt += (c > 0u) ? 1u : 0u; mine = (j == x) ? c : mine; }
        if (sum == G) break;
        __builtin_amdgcn_s_sleep(1);
        if ((++sp & 255u) == 0u) { if (xb_ld(&bar[XB_TMO])) break; if (sp > XB_SPIN_CAP) { atomicAdd(&bar[XB_TMO], 1u); break; } }
    }
    nloc = mine > 0u ? mine : 1u; nx = cnt > 0u ? cnt : 1u;
}

__device__ __forceinline__ void xcd_barrier(const XcdBarrier& b) {
    asm volatile("s_waitcnt vmcnt(0)" ::: "memory");
    __syncthreads();
    if (otid(b.wv) == 0) {
        unsigned* bar = b.bar;
        __builtin_amdgcn_s_waitcnt(0);
        unsigned nloc = b.st[0], nx = b.st[1];
        if (nloc == 0u) { xcd_barrier_complete(bar, b.x, nloc, nx); b.st[0] = nloc; b.st[1] = nx; }
        const unsigned old = xb_add(&bar[XB_XSUB(b.x)], 1u);
        const unsigned gen = old / nloc;
        if (old + 1u == (gen + 1u) * nloc) {
            __builtin_amdgcn_fence(__ATOMIC_RELEASE, "agent");
            asm volatile("s_waitcnt vmcnt(0)" ::: "memory");
            const unsigned og = xb_add(&bar[XB_TOP], 1u);
            const unsigned tg = og / nx;
            if (og + 1u == (tg + 1u) * nx) xb_add(&bar[XB_TOPGEN], 1u);
            else XB_SPIN(xb_ld(&bar[XB_TOPGEN]) == tg, bar);
            __builtin_amdgcn_fence(__ATOMIC_ACQUIRE, "agent");
            xb_add(&bar[XB_XGEN(b.x)], 1u);
            asm volatile("s_waitcnt vmcnt(0)" ::: "memory");
        } else {
            XB_SPIN(xb_ld(&bar[XB_XGEN(b.x)]) == gen, bar);
            __builtin_amdgcn_fence(__ATOMIC_ACQUIRE, "agent");
            asm volatile("s_waitcnt vmcnt(0)" ::: "memory");
        }
    }
    __syncthreads();
}
namespace pg8 {
#define PG8_LAS __attribute__((address_space(3)))
typedef unsigned short bf16_t;
typedef short bf16x8 __attribute__((ext_vector_type(8)));
typedef float f32x4 __attribute__((ext_vector_type(4)));
typedef unsigned u32x4 __attribute__((ext_vector_type(4)));
constexpr int BM = 256, BK = 64, HALF = 128, HTB = HALF * BK * 2  , STAGE_BYTES = 8 * HTB, NXCD = 8, WGM = 8;

__host__ __device__ __forceinline__ int lds_byte(int r, int c) { const int st = (r >> 4) * 2 + (c >> 5), rr = r & 15, cc = c & 31, ob = rr * 64 + cc * 2; return st * 1024 + (ob ^ (((ob >> 9) & 1) << 5)); }
__host__ __device__ __forceinline__ void stage_rc(int b, int& R, int& C) { const int st = b / 1024, sb = b % 1024, swz = sb ^ (((sb >> 9) & 1) << 5); R = (st >> 1) * 16 + swz / 64; C = (st & 1) * 32 + (swz % 64) / 2; }
__host__ __device__ __forceinline__ int perm32(int rho) { const int n = rho >> 4, i = rho & 15; return 8 * (i >> 2) + 4 * n + (i & 3); }

struct Unit { int pm, pn, kq; };
struct Gemm { const bf16_t* A; const bf16_t* Bt; int M, N, K, wv; float* dg; int lda, ldb; };

struct StaticOrder {
    int nM, nN, nwg, G, c, wgm, nNr;
    __host__ __device__ void init(int M, int N, int G_, int c_, int ksplit = 1) { nM = M / BM; nNr = N / BM; nN = nNr * ksplit; nwg = nM * nN; G = G_; c = c_; wgm = (nM % NXCD == 0) ? nM / NXCD : WGM; }
    __host__ __device__ bool next(int i, Unit& u) const {
        const long L = (long)i * G + c; if (L >= nwg) return false;
        int wgid = (int)L; { const int q = nwg / NXCD, r = nwg % NXCD, xcd = wgid % NXCD, off = wgid / NXCD; wgid = (xcd < r ? xcd * (q + 1) : r * (q + 1) + (xcd - r) * q) + off; }
        const int nig = wgm * nN, gid = wgid / nig, fm = gid * wgm, gsz = (nM - fm) < wgm ? (nM - fm) : wgm;
        u.pm = fm + ((wgid % nig) % gsz); const int pv = (wgid % nig) / gsz; u.kq = pv / nNr; u.pn = pv % nNr;
        if (nM == 9 * NXCD) { const int x_ = u.pm / 9, j_ = u.pm % 9; u.pm = j_ < 8 ? 8 * x_ + j_ : 8 * NXCD + x_; }
        return true;
    }
    __device__ __forceinline__ void a_ready(const Unit&) const {}
    __device__ __forceinline__ void done(const Unit&) const {}
};

__device__ __forceinline__ unsigned cvt_pk_bf16(float lo, float hi) { return hw_cvtpk(lo, hi); }
struct EpiStore {
    static constexpr bool PERM = true, AFTER_DRAIN = false;
    bf16_t* O; int ldc;
    __device__ __forceinline__ void operator()(const f32x4 (&acc)[2][2][4][2], const Unit& u, int wr, int wc, int fr, int fq) const {
        const int row0 = u.pm * BM + wr * 64 + fr; const int col0 = u.pn * BM + wc * 32 + 8 * fq;
#pragma unroll
        for (int ai = 0; ai < 2; ++ai)
#pragma unroll
            for (int m = 0; m < 4; ++m) { bf16_t* rowp = O + (size_t)(row0 + ai * HALF + m * 16) * ldc + col0;
#pragma unroll
                for (int bj = 0; bj < 2; ++bj) { const f32x4 v0 = acc[ai][bj][m][0], v1 = acc[ai][bj][m][1];
                    u32x4 w; w.x = cvt_pk_bf16(v0[0], v0[1]); w.y = cvt_pk_bf16(v0[2], v0[3]); w.z = cvt_pk_bf16(v1[0], v1[1]); w.w = cvt_pk_bf16(v1[2], v1[3]);
                    *(u32x4*)(rowp + bj * HALF) = w; } }
    }
};

template <int CTRL> __device__ __forceinline__ float dpprot(float src) { return __builtin_bit_cast(float, __builtin_amdgcn_mov_dpp(__builtin_bit_cast(int, src), CTRL, 0xf, 0xf, true)); }
template <int CTRL> __device__ __forceinline__ float dppf(float old, float src) { return __builtin_bit_cast(float, __builtin_amdgcn_update_dpp(__builtin_bit_cast(int, old), __builtin_bit_cast(int, src), CTRL, 0xf, 0xf, false)); }
#define PG8_DPP4(dst, oldv, srcv, ctrl) do { dst[0] = dppf<ctrl>(oldv[0], srcv[0]); dst[1] = dppf<ctrl>(oldv[1], srcv[1]); dst[2] = dppf<ctrl>(oldv[2], srcv[2]); dst[3] = dppf<ctrl>(oldv[3], srcv[3]); } while (0)
struct EpiFfn {
    static constexpr bool PERM = true, AFTER_DRAIN = false;
    bf16_t* O; int ldc; int mode;
    int kso;
    const float* rs;
    bf16_t* Ue; const float* cw; PG8_LAS f32x4* ex; int wv;
    __device__ __forceinline__ void operator()(const f32x4 (&acc)[2][2][4][2], const Unit& u, int wr, int wc, int fr_in, int fq_in) const {
        (void)fr_in; (void)fq_in; const int lane_e = otid(wv) & 63; const int fr = lane_e & 15, fq = lane_e >> 4;
        if (mode != 1) {
            const int row0 = u.pm * BM + wr * 64 + fr; const int col0 = u.pn * BM + wc * 32 + 8 * fq;
#pragma unroll
            for (int ai = 0; ai < 2; ++ai)
#pragma unroll
                for (int m = 0; m < 4; ++m) { bf16_t* rowp = O + (size_t)u.kq * kso + (size_t)(row0 + ai * HALF + m * 16) * ldc + col0;
                    const float rsc = (mode == 2) ? rs[row0 + ai * HALF + m * 16] : 1.0f;
#pragma unroll
                    for (int bj = 0; bj < 2; ++bj) { const f32x4 v0 = acc[ai][bj][m][0] * rsc, v1 = acc[ai][bj][m][1] * rsc;
                        u32x4 w; w.x = cvt_pk_bf16(v0[0], v0[1]); w.y = cvt_pk_bf16(v0[2], v0[3]); w.z = cvt_pk_bf16(v1[0], v1[1]); w.w = cvt_pk_bf16(v1[2], v1[3]);
                        *(u32x4*)(rowp + bj * HALF) = w; } }
            return;
        }
        const int chl = wc * 32 + 8 * fq, ch = u.pn * 128 + chl;
        f32x4 wA[3][2], wG[3][2];
#pragma unroll
        for (int t = 0; t < 3; ++t)
#pragma unroll
            for (int n = 0; n < 2; ++n) { wA[t][n] = *(const f32x4*)(cw + t * 5632 + ch + 4 * n); wG[t][n] = *(const f32x4*)(cw + t * 5632 + 2816 + ch + 4 * n); }
#define PG8_EX(blk, fl, bj, n) ex[((((blk) * 2 + (fl)) * 2 + (bj)) * 2 + (n)) * 16 + wc * 4 + fq]
#pragma unroll
        for (int ai = 0; ai < 2; ++ai) { const int blk = ai * 2 + wr;
            const bool lastr = fr == 15;
#pragma unroll
            for (int bj = 0; bj < 2; ++bj)
#pragma unroll
                for (int n = 0; n < 2; ++n) { const f32x4 a0 = acc[ai][bj][0][n], a3 = acc[ai][bj][3][n]; f32x4 v;
#pragma unroll
                    for (int e = 0; e < 4; ++e) v[e] = lastr ? a3[e] : a0[e];
                    if (fr == 0 || lastr) ex[((((blk) * 2 + (lastr ? 1 : 0)) * 2 + bj) * 2 + n) * 16 + wc * 4 + fq] = v; } }
        asm volatile("s_waitcnt lgkmcnt(0)" ::: "memory"); __builtin_amdgcn_s_barrier(); asm volatile("" ::: "memory");
        const f32x4 zero4 = (f32x4){0.f, 0.f, 0.f, 0.f}; const bool is15 = fr == 15, is0 = fr == 0;
#pragma unroll
        for (int ai = 0; ai < 2; ++ai) { const int blk = ai * 2 + wr;
            f32x4 pb[2][2], nb[2][2];
#pragma unroll
            for (int bj = 0; bj < 2; ++bj)
#pragma unroll
                for (int n = 0; n < 2; ++n) { pb[bj][n] = blk > 0 ? PG8_EX(blk - 1, 1, bj, n) : zero4; nb[bj][n] = blk < 3 ? PG8_EX(blk + 1, 0, bj, n) : zero4; }
#pragma unroll
            for (int m = 0; m < 4; ++m) {
                f32x4 cv[2][2];
#pragma unroll
                for (int bj = 0; bj < 2; ++bj)
#pragma unroll
                    for (int n = 0; n < 2; ++n) { const f32x4 cur = acc[ai][bj][m][n];
                        const f32x4 lo = (m == 0) ? pb[bj][n] : acc[ai][bj][m > 0 ? m - 1 : 0][n];
                        const f32x4 hi = (m == 3) ? nb[bj][n] : acc[ai][bj][m < 3 ? m + 1 : 3][n];
                        f32x4 prev, next;
#pragma unroll
                        for (int e = 0; e < 4; ++e) { prev[e] = dpprot<0x121>(is15 ? lo[e] : cur[e]);
                                                      next[e] = dpprot<0x12F>(is0 ? hi[e] : cur[e]); }
                        const f32x4 w0 = bj ? wG[0][n] : wA[0][n], w1 = bj ? wG[1][n] : wA[1][n], w2 = bj ? wG[2][n] : wA[2][n];
                        cv[bj][n] = w0 * prev + w1 * cur + w2 * next; }
                u32x4 w; float g[8];
#pragma unroll
                for (int n = 0; n < 2; ++n)
#pragma unroll
                    for (int e = 0; e < 4; ++e) { const float av = cv[0][n][e]; g[4 * n + e] = av * __builtin_amdgcn_rcpf(1.f + __expf(-av)) * cv[1][n][e]; }
                w.x = cvt_pk_bf16(g[0], g[1]); w.y = cvt_pk_bf16(g[2], g[3]); w.z = cvt_pk_bf16(g[4], g[5]); w.w = cvt_pk_bf16(g[6], g[7]);
                *(u32x4*)(O + (size_t)(u.pm * BM + ai * HALF + wr * 64 + m * 16 + fr) * 2816 + ch) = w;
            } }
#undef PG8_EX
        { const int slot = (wr == 0) ? (fr == 0 ? 0 : (fr == 1 ? 1 : -1)) : (fr == 14 ? 2 : (fr == 15 ? 3 : -1));
          if (slot >= 0) { bf16_t* up = Ue + ((size_t)(u.pm * 4 + slot) * 5632) + u.pn * 256 + chl;
#pragma unroll
              for (int bj = 0; bj < 2; ++bj) { const f32x4 a0 = acc[0][bj][0][0], a1 = acc[0][bj][0][1], b0 = acc[1][bj][3][0], b1 = acc[1][bj][3][1]; f32x4 v0, v1;
#pragma unroll
                  for (int e = 0; e < 4; ++e) { v0[e] = wr ? b0[e] : a0[e]; v1[e] = wr ? b1[e] : a1[e]; }
                  u32x4 w; w.x = cvt_pk_bf16(v0[0], v0[1]); w.y = cvt_pk_bf16(v0[2], v0[3]); w.z = cvt_pk_bf16(v1[0], v1[1]); w.w = cvt_pk_bf16(v1[2], v1[3]);
                  *(u32x4*)(up + bj * HALF) = w; } } }
    }
};
template <class Epi, class Sched, bool ALIGN_EPI = false, bool SP2 = false>
__device__ __forceinline__ void gemm_phase(PG8_LAS unsigned char* lds, const Gemm g, const Sched& S, const Epi& E) {
    const int tid = otid(g.wv), wid = g.wv, lane = tid & 63, wr = wid >> 2, wc = wid & 3, fr = lane & 15, fq = lane >> 4;
    const int K = g.K, nt = K / BK;
    unsigned voffA[2], voffB[2];
#pragma unroll
    for (int i = 0; i < 2; ++i) { int R, C; stage_rc(tid * 16 + i * 8192, R, C); const int Rb = Epi::PERM ? ((R & ~31) + perm32(R & 31)) : R;
        voffA[i] = (unsigned)(R * g.lda + C) * 2u; voffB[i] = (unsigned)(Rb * g.ldb + C) * 2u; }
    const size_t kstep = (size_t)(BK * 2);
    const size_t hstep = (size_t)HALF * g.ldb * 2;
    const size_t tstep = 2 * hstep;
    const size_t hstepA = (size_t)HALF * g.lda * 2, tstepA = 2 * hstepA;
    const unsigned ldsw = (unsigned)wid * 1024u;
    const int aoff = lds_byte(wr * 64 + fr, fq * 8), boff = lds_byte(wc * 32 + fr, fq * 8);
#define PG8_SA(b, h) (((b) * 2 + (h)) * HTB)
#define PG8_SB(b, h) ((4 + (b) * 2 + (h)) * HTB)
#define PG8_STAGE(bufoff, gbase, voff) do { _Pragma("unroll") for (int _i = 0; _i < 2; ++_i) \
        __builtin_amdgcn_global_load_lds((const unsigned*)((const char*)(gbase) + (voff)[_i]), (PG8_LAS unsigned*)(lds + (bufoff) + ldsw + _i * 8192), 16, 0, 0); } while (0)
#define PG8_LDA(dst, b, h) do { _Pragma("unroll") for (int m = 0; m < 4; ++m) _Pragma("unroll") for (int k = 0; k < 2; ++k) dst[m][k] = *(const PG8_LAS bf16x8*)(lds + PG8_SA(b, h) + aoff + m * 2048 + k * 1024); } while (0)
#define PG8_LDB(dst, b, h) do { _Pragma("unroll") for (int n = 0; n < 2; ++n) _Pragma("unroll") for (int k = 0; k < 2; ++k) dst[n][k] = *(const PG8_LAS bf16x8*)(lds + PG8_SB(b, h) + boff + n * 2048 + k * 1024); } while (0)
#define PG8_MMA(ai, bj, At, Bt) do { __builtin_amdgcn_s_setprio(1); _Pragma("unroll") for (int m = 0; m < 4; ++m) _Pragma("unroll") for (int n = 0; n < 2; ++n) _Pragma("unroll") for (int k = 0; k < 2; ++k) \
        acc[ai][bj][m][n] = __builtin_amdgcn_mfma_f32_16x16x32_bf16(Bt[n][k], At[m][k], acc[ai][bj][m][n], 0, 0, 0); __builtin_amdgcn_s_setprio(0); } while (0)
#define PG8_WAIT_V(n) asm volatile("s_waitcnt vmcnt(" #n ")" ::: "memory")
#define PG8_WAIT_L(n) asm volatile("s_waitcnt lgkmcnt(" #n ")" ::: "memory")
#define PG8_BAR __builtin_amdgcn_s_barrier()
#define PG8_SCHED __builtin_amdgcn_sched_barrier(0)
    Unit cur, nxt; int ui = 0;
#ifdef GDIAG
    unsigned gd0 = 0, gd1 = 0, gd2 = 0; const unsigned gstart = (unsigned)__builtin_amdgcn_s_memtime();
#endif
    if (!S.next(0, cur)) return;
    f32x4 acc[2][2][4][2];
#pragma unroll
    for (int a = 0; a < 2; ++a)
#pragma unroll
        for (int b = 0; b < 2; ++b)
#pragma unroll
            for (int m = 0; m < 4; ++m)
#pragma unroll
                for (int n = 0; n < 2; ++n) acc[a][b][m][n] = (f32x4){0.f, 0.f, 0.f, 0.f};
    bf16x8 At[4][2], B0[2][2], B1[2][2];
    const size_t kqstep = (size_t)K * 2;
    const char* cA = (const char*)g.A + (size_t)cur.pm * tstepA + (size_t)cur.kq * kqstep; const char* cB = (const char*)g.Bt + (size_t)cur.pn * tstep + (size_t)cur.kq * kqstep;
    S.a_ready(cur);
    if constexpr (SP2) {
        PG8_STAGE(PG8_SB(0, 0), cB, voffB); PG8_STAGE(PG8_SB(0, 1), cB + hstep, voffB); PG8_STAGE(PG8_SA(0, 0), cA, voffA); PG8_STAGE(PG8_SA(0, 1), cA + hstepA, voffA);
        if (wr == 1) PG8_BAR;
        PG8_WAIT_V(2); PG8_BAR;
        PG8_STAGE(PG8_SB(1, 0), cB + kstep, voffB); PG8_STAGE(PG8_SA(1, 0), cA + kstep, voffA); PG8_STAGE(PG8_SB(1, 1), cB + hstep + kstep, voffB);
        PG8_WAIT_V(6); PG8_BAR;
    } else {
        PG8_STAGE(PG8_SB(0, 0), cB, voffB); PG8_STAGE(PG8_SA(0, 0), cA, voffA); PG8_STAGE(PG8_SB(0, 1), cB + hstep, voffB); PG8_STAGE(PG8_SA(0, 1), cA + hstepA, voffA);
        if (wr == 1) PG8_BAR;
        PG8_WAIT_V(4); PG8_BAR;
        PG8_STAGE(PG8_SB(1, 0), cB + kstep, voffB); PG8_STAGE(PG8_SA(1, 0), cA + kstep, voffA); PG8_STAGE(PG8_SB(1, 1), cB + hstep + kstep, voffB);
        PG8_WAIT_V(6); PG8_BAR;
    }
    for (;;) {
        const bool has_next = S.next(ui + 1, nxt);
        const char* nA = has_next ? (const char*)g.A + (size_t)nxt.pm * tstepA + (size_t)nxt.kq * kqstep : cA; const char* nB = has_next ? (const char*)g.Bt + (size_t)nxt.pn * tstep + (size_t)nxt.kq * kqstep : cB;
#ifdef GDIAG
        unsigned gt0 = (unsigned)__builtin_amdgcn_s_memtime();
#endif
        for (int t = 0; t < nt; t += 2) {
            const bool last = (t == nt - 2);
            const char* a1 = cA + (size_t)(t + 1) * kstep;
            const char* a2 = last ? nA : cA + (size_t)(t + 2) * kstep; const char* b2 = last ? nB : cB + (size_t)(t + 2) * kstep;
            const char* a3 = a2 + kstep; const char* b3 = b2 + kstep;
            if (last && has_next) S.a_ready(nxt);
            if constexpr (SP2) {
            PG8_LDB(B0, 0, 0); PG8_LDB(B1, 0, 1); PG8_SCHED; PG8_LDA(At, 0, 0); PG8_STAGE(PG8_SA(1, 1), a1 + hstepA, voffA);
            PG8_WAIT_V(8); PG8_WAIT_L(0); PG8_BAR; PG8_MMA(0, 0, At, B0); PG8_MMA(0, 1, At, B1); PG8_BAR; PG8_SCHED;
            PG8_LDA(At, 0, 1); PG8_STAGE(PG8_SB(0, 0), b2, voffB); PG8_STAGE(PG8_SB(0, 1), b2 + hstep, voffB); PG8_STAGE(PG8_SA(0, 0), a2, voffA);
            PG8_WAIT_V(8); PG8_WAIT_L(0); PG8_BAR; PG8_MMA(1, 0, At, B0); PG8_MMA(1, 1, At, B1); PG8_BAR; PG8_SCHED;
            PG8_LDB(B0, 1, 0); PG8_LDB(B1, 1, 1); PG8_SCHED; PG8_LDA(At, 1, 0); PG8_STAGE(PG8_SA(0, 1), a2 + hstepA, voffA);
            PG8_WAIT_V(8); PG8_WAIT_L(0); PG8_BAR; PG8_MMA(0, 0, At, B0); PG8_MMA(0, 1, At, B1); PG8_BAR; PG8_SCHED;
            PG8_LDA(At, 1, 1); PG8_STAGE(PG8_SB(1, 0), b3, voffB); PG8_STAGE(PG8_SB(1, 1), b3 + hstep, voffB); PG8_STAGE(PG8_SA(1, 0), a3, voffA);
            PG8_WAIT_V(8); PG8_WAIT_L(0); PG8_BAR; PG8_MMA(1, 0, At, B0); PG8_MMA(1, 1, At, B1); PG8_BAR; PG8_SCHED;
            } else {
            PG8_LDB(B0, 0, 0); PG8_SCHED; PG8_LDA(At, 0, 0); PG8_STAGE(PG8_SA(1, 1), a1 + hstepA, voffA);
            PG8_WAIT_L(8); PG8_BAR; PG8_WAIT_L(0); PG8_MMA(0, 0, At, B0); PG8_BAR; PG8_SCHED;
            PG8_LDB(B1, 0, 1); PG8_STAGE(PG8_SB(0, 0), b2, voffB);
            PG8_BAR; PG8_WAIT_L(0); PG8_MMA(0, 1, At, B1); PG8_BAR;
            PG8_LDA(At, 0, 1); PG8_STAGE(PG8_SA(0, 0), a2, voffA);
            PG8_BAR; PG8_WAIT_L(0); PG8_MMA(1, 0, At, B0); PG8_BAR; PG8_SCHED;
            PG8_STAGE(PG8_SB(0, 1), b2 + hstep, voffB);
            PG8_WAIT_V(6); PG8_BAR; PG8_MMA(1, 1, At, B1); PG8_BAR;
            PG8_LDB(B0, 1, 0); PG8_SCHED; PG8_LDA(At, 1, 0); PG8_STAGE(PG8_SA(0, 1), a2 + hstepA, voffA);
            PG8_WAIT_L(8); PG8_BAR; PG8_WAIT_L(0); PG8_MMA(0, 0, At, B0); PG8_BAR; PG8_SCHED;
            PG8_LDB(B1, 1, 1); PG8_STAGE(PG8_SB(1, 0), b3, voffB);
            PG8_BAR; PG8_WAIT_L(0); PG8_MMA(0, 1, At, B1); PG8_BAR;
            PG8_LDA(At, 1, 1); PG8_STAGE(PG8_SA(1, 0), a3, voffA);
            PG8_BAR; PG8_WAIT_L(0); PG8_MMA(1, 0, At, B0); PG8_BAR; PG8_SCHED;
            PG8_STAGE(PG8_SB(1, 1), b3 + hstep, voffB);
            PG8_WAIT_V(6); PG8_BAR; PG8_MMA(1, 1, At, B1); PG8_BAR;
            }
        }
#ifdef GDIAG
        { const unsigned n_ = (unsigned)__builtin_amdgcn_s_memtime(); gd0 += n_ - gt0; gt0 = n_; }
#endif
        if constexpr (ALIGN_EPI) { if (wr == 0) PG8_BAR; }
#ifdef GDIAG
        { const unsigned n_ = (unsigned)__builtin_amdgcn_s_memtime(); gd1 += n_ - gt0; gt0 = n_; }
#endif
        if constexpr (!Epi::AFTER_DRAIN) { E(acc, cur, wr, wc, fr, fq); S.done(cur); }
#ifdef GDIAG
        { const unsigned n_ = (unsigned)__builtin_amdgcn_s_memtime(); gd2 += n_ - gt0; gt0 = n_; }
#endif
        if (!has_next) break;
#pragma unroll
        for (int a = 0; a < 2; ++a)
#pragma unroll
            for (int b = 0; b < 2; ++b)
#pragma unroll
                for (int m = 0; m < 4; ++m)
#pragma unroll
                    for (int n = 0; n < 2; ++n) acc[a][b][m][n] = (f32x4){0.f, 0.f, 0.f, 0.f};
        cur = nxt; cA = nA; cB = nB; ++ui;
        if constexpr (ALIGN_EPI) { if (wr == 1) PG8_BAR; }
    }
#ifdef GDIAG
    if (g.dg && blockIdx.x == 0 && wid == GDIAG_WAVE && lane == 0) { const unsigned tot = (unsigned)__builtin_amdgcn_s_memtime() - gstart; g.dg[0] = (float)gd0; g.dg[1] = (float)gd1; g.dg[2] = (float)gd2; g.dg[3] = (float)tot; }
#endif
    PG8_WAIT_V(0);
    if constexpr (!ALIGN_EPI) { if (wr == 0) PG8_BAR; }
    PG8_BAR;
    if constexpr (Epi::AFTER_DRAIN) { E.fused(acc, cur, wr, wc, fr, fq, lds, wid, lane); S.done(cur); }
#undef PG8_SA
#undef PG8_SB
#undef PG8_STAGE
#undef PG8_LDA
#undef PG8_LDB
#undef PG8_MMA
#undef PG8_WAIT_V
#undef PG8_WAIT_L
#undef PG8_BAR
#undef PG8_SCHED
}
}

typedef unsigned short bf16;
typedef unsigned v4u __attribute__((ext_vector_type(4)));
typedef unsigned v2u __attribute__((ext_vector_type(2)));
typedef float f32x4 __attribute__((ext_vector_type(4)));
constexpr int NWAVES = 8, NTHR = 512;
constexpr int D = 1024, NB = 8, SEQ = 2048, CTXL = 256, TL = NB * SEQ, TC = NB * CTXL, T = TL + TC;
constexpr int HYB_IN = 2208, HYB_INP = 2304, SSD_IN = 5184, SSD_INP = 5376, DFF = 2816, UPW = 5632;
constexpr int QW = 768, KVW = 1024, MODW = 6144;
constexpr float EPS = 1e-6f;
constexpr int NSTEP = 1 + 4 * 10;
constexpr float ATT_SCALE_LOG2E = 0.10206207261596577f * 1.4426950408889634f;

constexpr size_t MiB = 1u << 20;
constexpr size_t WS_CTL = 0, CTL_ZERO_BYTES = 64 * 1024;
constexpr size_t WS_MOD = 1 * MiB;
constexpr size_t WS_ROPE = 2 * MiB;
constexpr size_t W_UP = 3 * MiB;
constexpr size_t W_DN = W_UP + (size_t)UPW * D * 2;
constexpr size_t W_IN = W_DN + (size_t)D * DFF * 2;
constexpr size_t W_OUT = W_IN + (size_t)SSD_INP * D * 2;
constexpr size_t W_UQ = W_OUT + (size_t)D * 2048 * 2;
constexpr size_t W_UKV = W_UQ + (size_t)QW * 384 * 2;
constexpr size_t W_END = W_UKV + (size_t)KVW * 256 * 2;
constexpr size_t WS_XC = 36 * MiB;
constexpr size_t WS_H = 44 * MiB;
constexpr size_t WS_DT = WS_H, WS_AA = WS_H + (size_t)T * 64 * 4;
constexpr size_t WS_SS = WS_AA + (size_t)T * 64 * 4;
constexpr size_t WS_RS = WS_SS + (size_t)T * 64 * 4;
constexpr size_t WS_BIG = 80 * MiB;
constexpr size_t WS_M = WS_BIG;
constexpr size_t WS_P = WS_BIG;
constexpr size_t WS_Q = WS_BIG + 81 * MiB;
constexpr size_t WS_KV = WS_BIG + 108 * MiB;
constexpr size_t WS_KR = WS_BIG + 144 * MiB;
constexpr size_t WS_CQN = WS_BIG + 146 * MiB;
constexpr size_t WS_CKVN = WS_BIG + 160 * MiB;
constexpr size_t WS_MIX = WS_BIG + 170 * MiB;
constexpr size_t WS_MP = WS_BIG + 81 * MiB;
constexpr size_t WS_U = WS_BIG;
constexpr size_t WS_G = WS_BIG + 198 * MiB;
constexpr size_t WS_ZX = WS_BIG;
constexpr size_t WS_XBC = WS_BIG + 189 * MiB;
constexpr size_t WS_UE = WS_BIG + 297 * MiB;
constexpr size_t WS_END = WS_UE + 4 * MiB;
static_assert(W_END <= WS_XC && WS_G + (size_t)T * DFF * 2 <= WS_END && WS_XBC + (size_t)T * 3072 * 2 <= WS_END && WS_ZX + (size_t)T * SSD_INP * 2 <= WS_XBC, "ws map");
static_assert(WS_RS + (size_t)T * 4 <= WS_BIG && WS_MIX + (size_t)T * D * 2 <= WS_END && WS_Q + (size_t)T * QW * 2 <= WS_KV && WS_P + (size_t)T * HYB_INP * 2 <= WS_Q, "ws map 2");
constexpr int LDS_BYTES = 147456;

struct Args { const float* in[25]; float* out; unsigned char* ws; int lo, hi; int wv, pad; };
enum { I_X = 0, I_C, I_CTX, I_CCTX, I_MODW, I_MODB, I_NORMW, I_WUP, I_FCONV, I_WDN, I_HIN, I_QNORM, I_KVNORM, I_WUQ, I_WUKV, I_SCONV, I_HOUT, I_SIN, I_SCONVW, I_SCONVB, I_ALOG, I_DTB, I_SD, I_SNORM, I_SOUT };

__device__ __forceinline__ unsigned f2bf(float f) { unsigned u = __builtin_bit_cast(unsigned, f); return (u + 0x7fffu + ((u >> 16) & 1u)) >> 16; }
__device__ __forceinline__ unsigned pk2(float lo, float hi) { return hw_cvtpk(lo, hi); }
__device__ __forceinline__ float bflo(unsigned u) { return __builtin_bit_cast(float, u << 16); }
__device__ __forceinline__ float bfhi(unsigned u) { return __builtin_bit_cast(float, u & 0xffff0000u); }
__device__ __forceinline__ float bf1(bf16 b) { return __builtin_bit_cast(float, (unsigned)b << 16); }
__device__ __forceinline__ float silu_f(float x) { return x * __builtin_amdgcn_rcpf(1.f + __expf(-x)); }
__device__ __forceinline__ float wave_sum(float v, int lane) {
#pragma unroll
    for (int o = 1; o < 64; o <<= 1) v += shx(v, o, lane);
    return v;
}
__device__ __forceinline__ void unpack8(const v4u w, float (&f)[8]) { f[0] = bflo(w.x); f[1] = bfhi(w.x); f[2] = bflo(w.y); f[3] = bfhi(w.y); f[4] = bflo(w.z); f[5] = bfhi(w.z); f[6] = bflo(w.w); f[7] = bfhi(w.w); }
__device__ __forceinline__ v4u pack8(const float (&f)[8]) { v4u w; w.x = pk2(f[0], f[1]); w.y = pk2(f[2], f[3]); w.z = pk2(f[4], f[5]); w.w = pk2(f[6], f[7]); return w; }
__device__ __forceinline__ bool has_prev(int r) { return r < TL ? (r & (SEQ - 1)) != 0 : ((r - TL) & (CTXL - 1)) != 0; }
__device__ __forceinline__ bool has_next(int r) { return r < TL ? (r & (SEQ - 1)) != SEQ - 1 : ((r - TL) & (CTXL - 1)) != CTXL - 1; }

__device__ __forceinline__ void mod_compute(const Args& a, LAS unsigned char* lds, int l0, int l1, int nb, int bi) {
    if (bi < 0 || bi >= nb) return;
    LAS float* sc = (LAS float*)lds;
    LAS float* red = (LAS float*)(lds + 36864);
    const int tid = otid(a.wv);
    float* MOD = (float*)(a.ws + WS_MOD);
    for (int i = tid; i < 9 * 1024; i += NTHR) { const int c = i >> 10, k = i & 1023; const float v = c < 8 ? a.in[I_C][c * 1024 + k] : a.in[I_CCTX][k]; sc[i] = silu_f(v); }
    __syncthreads();
    for (int item = l0 * 96 + bi; item < l1 * 96; item += nb) {
        const int l = item / 96, cb = item % 96;
        const float* W = a.in[I_MODW] + (size_t)l * 1024 * MODW + cb * 64;
        const int cgp = tid & 15, kg = tid >> 4;
        float acc[9][4];
#pragma unroll
        for (int c = 0; c < 9; ++c) { acc[c][0] = 0.f; acc[c][1] = 0.f; acc[c][2] = 0.f; acc[c][3] = 0.f; }
#pragma unroll 8
        for (int kk = 0; kk < 32; ++kk) { const int k = kg * 32 + kk; const f32x4 w = *(const f32x4*)(W + (size_t)k * MODW + cgp * 4);
#pragma unroll
            for (int c = 0; c < 9; ++c) { const float s = sc[c * 1024 + k]; acc[c][0] += s * w[0]; acc[c][1] += s * w[1]; acc[c][2] += s * w[2]; acc[c][3] += s * w[3]; } }
#pragma unroll
        for (int c = 0; c < 9; ++c)
#pragma unroll
            for (int j = 0; j < 4; ++j) red[kg * 576 + c * 64 + cgp * 4 + j] = acc[c][j];
        __syncthreads();
        for (int o = tid; o < 576; o += NTHR) { float s = 0.f;
            for (int g = 0; g < 32; ++g) s += red[g * 576 + o];
            const int c = o >> 6, col = o & 63; MOD[(size_t)(l * 9 + c) * MODW + cb * 64 + col] = s + a.in[I_MODB][l * MODW + cb * 64 + col]; }
        __syncthreads();
    }
}
__device__ __forceinline__ void rope_tables(const Args& a) {
    float* ct = (float*)(a.ws + WS_ROPE); float* st = ct + SEQ * 16;
    for (int i = blockIdx.x * NTHR + otid(a.wv); i < SEQ * 16; i += gridDim.x * NTHR) {
        const int t = i >> 4, j = i & 15; const int pos = j < 8 ? (t >> 6) : (t & 63); const int f = j & 7;
        const float i0 = (f & 1) ? 0.31622776601683794f : 1.0f; const int e = f >> 1; const float i1 = e == 0 ? 1.0f : (e == 1 ? 0.1f : (e == 2 ? 0.01f : 0.001f));
        const float inv = i0 * i1; const float ang = (float)pos * inv;
        ct[i] = __cosf(ang); st[i] = __sinf(ang); }
}
__device__ __forceinline__ void transpose_item(const float* W, int K, int N, bf16* WT, LAS float* scr, int item, int lane, bool ffn_perm, const float* ksc) {
    const int nblk = N / 32, kb = item / nblk, nb = item % nblk, k0 = 64 * kb, n0 = 32 * nb;
    const int o0 = ffn_perm ? ((n0 % DFF) / 128) * 256 + (n0 / DFF) * 128 + (n0 % 128) : n0;
    float wv_[32];
#pragma unroll
    for (int i = 0; i < 32; ++i) wv_[i] = W[(size_t)(k0 + 2 * i + (lane >> 5)) * N + n0 + (lane & 31)];
    if (ksc) {
#pragma unroll
        for (int i = 0; i < 32; ++i) wv_[i] *= ksc[k0 + 2 * i + (lane >> 5)]; }
#pragma unroll
    for (int i = 0; i < 32; ++i) scr[(2 * i + (lane >> 5)) * 33 + (lane & 31)] = wv_[i];
    asm volatile("s_waitcnt lgkmcnt(0)" ::: "memory");
    const int c = lane & 7;
#pragma unroll
    for (int j = 0; j < 4; ++j) { const int n = (lane >> 3) + 8 * j; const LAS float* s = scr + (8 * c) * 33 + n;
        v4u o; o.x = pk2(s[0 * 33], s[1 * 33]); o.y = pk2(s[2 * 33], s[3 * 33]); o.z = pk2(s[4 * 33], s[5 * 33]); o.w = pk2(s[6 * 33], s[7 * 33]);
        *(v4u*)(WT + (size_t)(o0 + n) * K + k0 + 8 * c) = o; }
    asm volatile("s_waitcnt lgkmcnt(0)" ::: "memory");
}
__device__ __forceinline__ void convert_weight(const float* W, int K, int N, int Npad, bf16* WT, LAS unsigned char* lds, int rot, int wv, int nb, int bi, bool ffn_perm = false, const float* ksc = nullptr) {
    const int wave = wv, lane = otid(wv) & 63; const int NGW = nb * NWAVES; const int gw = (bi * NWAVES + wave + rot) % NGW;
    LAS float* scr = (LAS float*)(lds + wave * 16384);
    const int nitems = (K / 64) * (N / 32);
    for (int it = gw; it < nitems; it += NGW) transpose_item(W, K, N, WT, scr, it, lane, ffn_perm, ksc);
    (void)Npad;
}
__device__ __forceinline__ void convert_layer(const Args& a, int l, LAS unsigned char* lds, int mask, int nb, int bi) {
    if (bi < 0 || bi >= nb) return;
    const int i = l >> 1; unsigned char* ws = a.ws;
    if (mask & 1) {
        convert_weight(a.in[I_WUP] + (size_t)l * D * UPW, D, UPW, UPW, (bf16*)(ws + W_UP), lds, 0, a.wv, nb, bi, true);
        convert_weight(a.in[I_WDN] + (size_t)l * DFF * D, DFF, D, D, (bf16*)(ws + W_DN), lds, 300, a.wv, nb, bi); }
    if (mask & 2) {
        if ((l & 1) == 0) {
            convert_weight(a.in[I_HIN] + (size_t)i * D * HYB_IN, D, HYB_IN, HYB_INP, (bf16*)(ws + W_IN), lds, 700, a.wv, nb, bi);
            convert_weight(a.in[I_HOUT] + (size_t)i * D * D, D, D, D, (bf16*)(ws + W_OUT), lds, 1100, a.wv, nb, bi);
            convert_weight(a.in[I_WUQ] + (size_t)i * 384 * QW, 384, QW, QW, (bf16*)(ws + W_UQ), lds, 1500, a.wv, nb, bi);
            convert_weight(a.in[I_WUKV] + (size_t)i * 256 * KVW, 256, KVW, KVW, (bf16*)(ws + W_UKV), lds, 1700, a.wv, nb, bi);
        } else {
            convert_weight(a.in[I_SIN] + (size_t)i * D * SSD_IN, D, SSD_IN, SSD_INP, (bf16*)(ws + W_IN), lds, 700, a.wv, nb, bi);
            convert_weight(a.in[I_SOUT] + (size_t)i * 2048 * D, 2048, D, D, (bf16*)(ws + W_OUT), lds, 1300, a.wv, nb, bi, false, a.in[I_SNORM] + i * 2048);
        } }
}

__device__ __forceinline__ void prep_even(const Args& a, int i) {
    const int wave = otid(a.wv) >> 6, lane = otid(a.wv) & 63; const int NGW = gridDim.x * NWAVES, gw = blockIdx.x * NWAVES + wave;
    const bf16* P = (const bf16*)(a.ws + WS_P); bf16* CQN = (bf16*)(a.ws + WS_CQN); bf16* CKVN = (bf16*)(a.ws + WS_CKVN); bf16* KR = (bf16*)(a.ws + WS_KR); bf16* MIX = (bf16*)(a.ws + WS_MIX);
    const float* qn = a.in[I_QNORM] + i * 384; const float* kvn = a.in[I_KVNORM] + i * 256; const float* cw = a.in[I_SCONV] + i * 3 * 512;
    const float* ct = (const float*)(a.ws + WS_ROPE); const float* st = ct + SEQ * 16;
    for (int r = gw; r < T; r += NGW) {
        const bf16* p = P + (size_t)r * HYB_INP;
        {
            const unsigned* p32 = (const unsigned*)(p + lane * 6); const unsigned w0 = p32[0], w1 = p32[1], w2 = p32[2];
            float f[6] = {bflo(w0), bfhi(w0), bflo(w1), bfhi(w1), bflo(w2), bfhi(w2)}; float ss = 0.f;
#pragma unroll
            for (int j = 0; j < 6; ++j) ss += f[j] * f[j];
            const float rs = rsqrtf(wave_sum(ss, lane) * (1.f / 384.f) + EPS);
#pragma unroll
            for (int j = 0; j < 6; ++j) f[j] = f[j] * rs * qn[lane * 6 + j];
            unsigned* o32 = (unsigned*)(CQN + (size_t)r * 384 + lane * 6); o32[0] = pk2(f[0], f[1]); o32[1] = pk2(f[2], f[3]); o32[2] = pk2(f[4], f[5]);
        }
        {
            const v2u w = *(const v2u*)(p + 384 + lane * 4); float f[4] = {bflo(w.x), bfhi(w.x), bflo(w.y), bfhi(w.y)};
            const float ss = (f[0] * f[0] + f[1] * f[1]) + (f[2] * f[2] + f[3] * f[3]);
            const float rs = rsqrtf(wave_sum(ss, lane) * (1.f / 256.f) + EPS);
            const f32x4 g = *(const f32x4*)(kvn + lane * 4);
            v2u o; o.x = pk2(f[0] * rs * g[0], f[1] * rs * g[1]); o.y = pk2(f[2] * rs * g[2], f[3] * rs * g[3]); *(v2u*)(CKVN + (size_t)r * 256 + lane * 4) = o;
        }
        {
            const int j = lane & 31; const float v = bf1(p[640 + j]); const float o = shx(v, 16, lane); float res = v;
            if (r < TL) { const int t = r & (SEQ - 1); const float c = ct[t * 16 + (j & 15)], s = st[t * 16 + (j & 15)]; res = (j < 16) ? v * c - o * s : o * s + v * c; }
            if (lane < 32) KR[(size_t)r * 32 + j] = (bf16)f2bf(res);
        }
        {
            const int c0 = lane * 8; float gb[8], cur[8], acc[8], t0[8], t1[8];
            unpack8(*(const v4u*)(p + 672 + c0), gb);
            unpack8(*(const v4u*)(p + 1184 + c0), t0); unpack8(*(const v4u*)(p + 1696 + c0), t1);
#pragma unroll
            for (int j = 0; j < 8; ++j) { cur[j] = t0[j] * t1[j]; acc[j] = cw[512 + c0 + j] * cur[j]; }
            if (has_prev(r)) { unpack8(*(const v4u*)(p - HYB_INP + 1184 + c0), t0); unpack8(*(const v4u*)(p - HYB_INP + 1696 + c0), t1);
#pragma unroll
                for (int j = 0; j < 8; ++j) acc[j] += cw[c0 + j] * (t0[j] * t1[j]); }
            if (has_next(r)) { unpack8(*(const v4u*)(p + HYB_INP + 1184 + c0), t0); unpack8(*(const v4u*)(p + HYB_INP + 1696 + c0), t1);
#pragma unroll
                for (int j = 0; j < 8; ++j) acc[j] += cw[1024 + c0 + j] * (t0[j] * t1[j]); }
#pragma unroll
            for (int j = 0; j < 8; ++j) acc[j] *= gb[j];
            *(v4u*)(MIX + (size_t)r * D + 512 + c0) = pack8(acc);
        }
    }
}

__device__ __forceinline__ void convgate(const Args& a, int l, int nrows) {
    const bf16* U = (const bf16*)(a.ws + WS_U); bf16* G = (bf16*)(a.ws + WS_G); const float* cw = a.in[I_FCONV] + (size_t)l * 3 * UPW;
    const int total = nrows * (DFF / 8);
    for (int idx = blockIdx.x * NTHR + otid(a.wv); idx < total; idx += gridDim.x * NTHR) {
        const int r = idx / (DFF / 8), c0 = (idx % (DFF / 8)) * 8; const bf16* u = U + (size_t)r * UPW + c0;
        float ua[8], ug[8], act[8], gate[8];
        unpack8(*(const v4u*)u, ua); unpack8(*(const v4u*)(u + DFF), ug);
#pragma unroll
        for (int j = 0; j < 8; ++j) { act[j] = cw[UPW + c0 + j] * ua[j]; gate[j] = cw[UPW + DFF + c0 + j] * ug[j]; }
        if (has_prev(r)) { unpack8(*(const v4u*)(u - UPW), ua); unpack8(*(const v4u*)(u - UPW + DFF), ug);
#pragma unroll
            for (int j = 0; j < 8; ++j) { act[j] += cw[c0 + j] * ua[j]; gate[j] += cw[DFF + c0 + j] * ug[j]; } }
        if (has_next(r)) { unpack8(*(const v4u*)(u + UPW), ua); unpack8(*(const v4u*)(u + UPW + DFF), ug);
#pragma unroll
            for (int j = 0; j < 8; ++j) { act[j] += cw[2 * UPW + c0 + j] * ua[j]; gate[j] += cw[2 * UPW + DFF + c0 + j] * ug[j]; } }
#pragma unroll
        for (int j = 0; j < 8; ++j) act[j] = silu_f(act[j]) * gate[j];
        *(v4u*)(G + (size_t)r * DFF + c0) = pack8(act);
    }
}

__device__ __forceinline__ void ssd_conv(const Args& a, int i) {
    const bf16* ZX = (const bf16*)(a.ws + WS_ZX); bf16* XBC = (bf16*)(a.ws + WS_XBC); float* DT = (float*)(a.ws + WS_DT); float* AA = (float*)(a.ws + WS_AA);
    const float* cw = a.in[I_SCONVW] + (size_t)i * 3 * 3072; const float* cb = a.in[I_SCONVB] + (size_t)i * 3072;
    const int total = T * 384;
    for (int idx = blockIdx.x * NTHR + otid(a.wv); idx < total; idx += gridDim.x * NTHR) {
        const int r = idx / 384, c0 = (idx % 384) * 8; const bf16* u = ZX + (size_t)r * SSD_INP + 2048 + c0;
        float x[8], acc[8];
        unpack8(*(const v4u*)u, x);
#pragma unroll
        for (int j = 0; j < 8; ++j) acc[j] = cb[c0 + j] + cw[3072 + c0 + j] * x[j];
        if (has_prev(r)) { unpack8(*(const v4u*)(u - SSD_INP), x);
#pragma unroll
            for (int j = 0; j < 8; ++j) acc[j] += cw[c0 + j] * x[j]; }
        if (has_next(r)) { unpack8(*(const v4u*)(u + SSD_INP), x);
#pragma unroll
            for (int j = 0; j < 8; ++j) acc[j] += cw[2 * 3072 + c0 + j] * x[j]; }
#pragma unroll
        for (int j = 0; j < 8; ++j) acc[j] = silu_f(acc[j]);
        *(v4u*)(XBC + (size_t)r * 3072 + c0) = pack8(acc);
    }
    const float* alog = a.in[I_ALOG] + i * 64; const float* dtb = a.in[I_DTB] + i * 64;
    for (int idx = blockIdx.x * NTHR + otid(a.wv); idx < T * 64; idx += gridDim.x * NTHR) {
        const int r = idx >> 6, j = idx & 63; const float raw = bf1(ZX[(size_t)r * SSD_INP + 5120 + j]) + dtb[j];
        const float dt = raw > 15.f ? raw : (raw < -15.f ? __expf(raw) : __logf(1.f + __expf(raw)));
        DT[idx] = dt; AA[idx] = -__expf(alog[j]) * dt;
    }
}

__device__ __forceinline__ void gatenorm(const Args& a, int i, int nrows) {
    const int wave = otid(a.wv) >> 6, lane = otid(a.wv) & 63; const int NGW = gridDim.x * NWAVES, gw = blockIdx.x * NWAVES + wave;
    const bf16* ZX = (const bf16*)(a.ws + WS_ZX); bf16* YN = (bf16*)(a.ws + WS_XBC); const float* nw = a.in[I_SNORM] + i * 2048;
    for (int r = gw; r < nrows; r += NGW) {
        float v[4][8]; float ss = 0.f;
#pragma unroll
        for (int j = 0; j < 4; ++j) { float y[8], z[8]; const int c = j * 512 + lane * 8;
            unpack8(*(const v4u*)(ZX + (size_t)r * SSD_INP + 2048 + c), y); unpack8(*(const v4u*)(ZX + (size_t)r * SSD_INP + c), z);
#pragma unroll
            for (int k = 0; k < 8; ++k) { v[j][k] = y[k] * silu_f(z[k]); ss += v[j][k] * v[j][k]; } }
        const float rs = rsqrtf(wave_sum(ss, lane) * (1.f / 2048.f) + EPS);
#pragma unroll
        for (int j = 0; j < 4; ++j) { const int c = j * 512 + lane * 8; float o[8];
#pragma unroll
            for (int k = 0; k < 8; ++k) o[k] = v[j][k] * rs * nw[c + k];
            *(v4u*)(YN + (size_t)r * 2048 + c) = pack8(o); }
    }
}

__device__ __forceinline__ void attn_naive(const Args& a, LAS unsigned char* lds) {
    const int tid = otid(a.wv), qi = tid >> 1, half = tid & 1;
    const bf16* Qb = (const bf16*)(a.ws + WS_Q); const bf16* KVb = (const bf16*)(a.ws + WS_KV); const bf16* KR = (const bf16*)(a.ws + WS_KR); bf16* MIX = (bf16*)(a.ws + WS_MIX);
    const float* ct = (const float*)(a.ws + WS_ROPE); const float* st = ct + SEQ * 16;
    LAS float* Kt = (LAS float*)lds;
    LAS float* Vt = (LAS float*)(lds + 64 * 96 * 4);
    for (int u = blockIdx.x; u < 576; u += gridDim.x) {
        const bool lat = u < 512; const int b = lat ? (u >> 6) : ((u - 512) >> 3), h = lat ? ((u >> 3) & 7) : ((u - 512) & 7);
        const int nkeys = lat ? (CTXL + SEQ) : CTXL;
        const int qrow = lat ? b * SEQ + (u & 7) * 256 + qi : TL + b * CTXL + qi;
        float q[48];
#pragma unroll
        for (int g = 0; g < 6; ++g) { float f[8]; unpack8(*(const v4u*)(Qb + (size_t)qrow * QW + h * 96 + half * 48 + g * 8), f);
#pragma unroll
            for (int j = 0; j < 8; ++j) q[g * 8 + j] = f[j]; }
        if (lat && half == 1) { const int t = qrow & (SEQ - 1);
#pragma unroll
            for (int j = 0; j < 16; ++j) { const float c = ct[t * 16 + j], s = st[t * 16 + j]; const float x1 = q[16 + j], x2 = q[32 + j]; q[16 + j] = x1 * c - x2 * s; q[32 + j] = x1 * s + x2 * c; } }
#pragma unroll
        for (int j = 0; j < 48; ++j) q[j] *= ATT_SCALE_LOG2E;
        float o[32]; float m = -1e30f, l = 0.f;
#pragma unroll
        for (int j = 0; j < 32; ++j) o[j] = 0.f;
        for (int k0 = 0; k0 < nkeys; k0 += 64) {
            __syncthreads();
            for (int g = tid; g < 768; g += NTHR) { const int key = g / 12, part = g % 12; const int kk = k0 + key; const int krow = kk < CTXL ? TL + b * CTXL + kk : b * SEQ + kk - CTXL;
                float f[8]; unpack8(part < 8 ? *(const v4u*)(KVb + (size_t)krow * KVW + h * 128 + part * 8) : *(const v4u*)(KR + (size_t)krow * 32 + (part - 8) * 8), f);
#pragma unroll
                for (int j = 0; j < 8; ++j) Kt[key * 96 + part * 8 + j] = f[j]; }
            { const int key = tid >> 3, part = tid & 7; const int kk = k0 + key; const int krow = kk < CTXL ? TL + b * CTXL + kk : b * SEQ + kk - CTXL;
                float f[8]; unpack8(*(const v4u*)(KVb + (size_t)krow * KVW + h * 128 + 64 + part * 8), f);
#pragma unroll
                for (int j = 0; j < 8; ++j) Vt[key * 64 + part * 8 + j] = f[j]; }
            __syncthreads();
            for (int kg = 0; kg < 64; kg += 8) {
                float s[8]; float gm = -1e30f;
#pragma unroll
                for (int kk = 0; kk < 8; ++kk) { float acc = 0.f; const LAS f32x4* kp = (const LAS f32x4*)(Kt + (kg + kk) * 96 + half * 48);
#pragma unroll
                    for (int d4 = 0; d4 < 12; ++d4) { const f32x4 kv = kp[d4]; acc += q[d4 * 4] * kv[0] + q[d4 * 4 + 1] * kv[1] + q[d4 * 4 + 2] * kv[2] + q[d4 * 4 + 3] * kv[3]; }
                    acc += shx(acc, 1, tid & 63);
                    s[kk] = acc; gm = fmaxf(gm, acc); }
                const float mn = fmaxf(m, gm); const float alpha = exp2f(m - mn); m = mn; l *= alpha;
#pragma unroll
                for (int j = 0; j < 32; ++j) o[j] *= alpha;
#pragma unroll
                for (int kk = 0; kk < 8; ++kk) { const float p = exp2f(s[kk] - mn); l += p; const LAS f32x4* vp = (const LAS f32x4*)(Vt + (kg + kk) * 64 + half * 32);
#pragma unroll
                    for (int d4 = 0; d4 < 8; ++d4) { const f32x4 vv = vp[d4]; o[d4 * 4] += p * vv[0]; o[d4 * 4 + 1] += p * vv[1]; o[d4 * 4 + 2] += p * vv[2]; o[d4 * 4 + 3] += p * vv[3]; } }
            }
        }
        { const float inv = 1.f / l;
#pragma unroll
            for (int g = 0; g < 4; ++g) { float f[8];
#pragma unroll
                for (int j = 0; j < 8; ++j) f[j] = o[g * 8 + j] * inv;
                *(v4u*)(MIX + (size_t)qrow * D + h * 64 + half * 32 + g * 8) = pack8(f); } }
    }
}

__device__ __forceinline__ void ssd_scan_naive(const Args& a, int i, bool last, LAS unsigned char* lds) {
    const int tid = otid(a.wv), p = tid >> 3, nq = tid & 7;
    bf16* ZX = (bf16*)(a.ws + WS_ZX); const bf16* XBC = (const bf16*)(a.ws + WS_XBC); const float* DT = (const float*)(a.ws + WS_DT); const float* AA = (const float*)(a.ws + WS_AA);
    LAS float* xs = (LAS float*)lds;
    LAS float* Bs = (LAS float*)(lds + 16384);
    LAS float* Cs = (LAS float*)(lds + 16384 + 32768);
    LAS float* dts = (LAS float*)(lds + 16384 + 65536);
    LAS float* as = dts + 64;
    for (int it = blockIdx.x; it < NB * 32; it += gridDim.x) {
        const int b = it >> 5, h = it & 31, g = h >> 3; const float dsk = a.in[I_SD][i * 32 + h];
        for (int dir = 0; dir < 2; ++dir) {
            float stt[16];
#pragma unroll
            for (int n = 0; n < 16; ++n) stt[n] = 0.f;
            for (int seg = 0; seg < 2; ++seg) {
                const int len = seg == 0 ? CTXL : SEQ; const int base = seg == 0 ? TL + b * CTXL : b * SEQ; const bool want_y = !(last && seg == 0);
                for (int cc = 0; cc < len / 64; ++cc) {
                    const int t0 = dir == 0 ? cc * 64 : len - 64 - cc * 64;
                    __syncthreads();
                    { const int tt = tid >> 3, part = tid & 7; float f[8]; unpack8(*(const v4u*)(XBC + (size_t)(base + t0 + tt) * 3072 + h * 64 + part * 8), f);
#pragma unroll
                        for (int j = 0; j < 8; ++j) xs[tt * 64 + part * 8 + j] = f[j]; }
                    for (int q = tid; q < 1024; q += NTHR) { const int tt = q >> 4, part = q & 15; float f[8];
                        unpack8(*(const v4u*)(XBC + (size_t)(base + t0 + tt) * 3072 + 2048 + g * 128 + part * 8), f);
#pragma unroll
                        for (int j = 0; j < 8; ++j) Bs[tt * 128 + part * 8 + j] = f[j];
                        unpack8(*(const v4u*)(XBC + (size_t)(base + t0 + tt) * 3072 + 2560 + g * 128 + part * 8), f);
#pragma unroll
                        for (int j = 0; j < 8; ++j) Cs[tt * 128 + part * 8 + j] = f[j]; }
                    if (tid < 64) { dts[tid] = DT[(size_t)(base + t0 + tid) * 64 + dir * 32 + h]; as[tid] = AA[(size_t)(base + t0 + tid) * 64 + dir * 32 + h]; }
                    __syncthreads();
                    for (int s = 0; s < 64; ++s) {
                        const int tt = dir == 0 ? s : 63 - s;
                        const float dec = __expf(as[tt]); const float xv = xs[tt * 64 + p]; const float xd = xv * dts[tt];
                        const LAS f32x4* bp = (const LAS f32x4*)(Bs + tt * 128 + nq * 16); const LAS f32x4* cp = (const LAS f32x4*)(Cs + tt * 128 + nq * 16);
                        float acc = 0.f;
#pragma unroll
                        for (int n4 = 0; n4 < 4; ++n4) { const f32x4 bv = bp[n4], cv = cp[n4];
#pragma unroll
                            for (int k = 0; k < 4; ++k) { stt[n4 * 4 + k] = dec * stt[n4 * 4 + k] + xd * bv[k]; acc += cv[k] * stt[n4 * 4 + k]; } }
                        acc += shx(acc, 1, tid & 63); acc += shx(acc, 2, tid & 63); acc += shx(acc, 4, tid & 63);
                        if (want_y && nq == 0) { bf16* yp = ZX + (size_t)(base + t0 + tt) * SSD_INP + 2048 + h * 64 + p;
                            const float y = dir == 0 ? acc + dsk * xv : acc + bf1(*yp);
                            *yp = (bf16)f2bf(y); }
                    }
                }
            }
            __syncthreads();
            asm volatile("s_waitcnt vmcnt(0)" ::: "memory");
        }
    }
}

typedef short bf16x8 __attribute__((ext_vector_type(8)));
typedef float f32x16 __attribute__((ext_vector_type(16)));
typedef short v4i16_t __attribute__((ext_vector_type(4)));
__device__ __forceinline__ v2u trread(const LAS unsigned char* p) { return __builtin_bit_cast(v2u, __builtin_amdgcn_ds_read_tr16_b64_v4i16((LAS v4i16_t*)p)); }
__device__ __forceinline__ unsigned cvtpk(float lo, float hi) { return hw_cvtpk(lo, hi); }
constexpr int ATT_KP = 208, ATT_VP = 192, ATT_KB = 64 * ATT_KP, ATT_VB = 64 * ATT_VP, ATT_BUF = ATT_KB + ATT_VB;
#ifndef ATT_NQ
#define ATT_NQ 2
#endif
#ifndef ATT_XCDSWZ
#define ATT_XCDSWZ 1
#endif
#ifndef ATT_LAZY
#define ATT_LAZY 8
#endif
template <int NQ>
__device__ __forceinline__ void attn_unit3(const Args& a, LAS unsigned char* lds, const int b, const int h, const int q0, const int ntiles, const bool lat) {
    const int tid = otid(a.wv), wave = a.wv, lane = tid & 63, r32 = lane & 31, hh = lane >> 5;
    const int tq = (lane >> 2) & 3, tp = lane & 3, tblk = (lane >> 4) & 1;
    const bf16* Qb = (const bf16*)(a.ws + WS_Q); const bf16* KVb = (const bf16*)(a.ws + WS_KV); const bf16* KR = (const bf16*)(a.ws + WS_KR); bf16* MIX = (bf16*)(a.ws + WS_MIX);
    const float* ct = (const float*)(a.ws + WS_ROPE); const float* st = ct + SEQ * 16;
    bf16x8 qf[NQ][6];
#pragma unroll
    for (int nq = 0; nq < NQ; ++nq) { const int qrow = q0 + wave * (32 * NQ) + nq * 32 + r32;
#pragma unroll
        for (int s = 0; s < 6; ++s) qf[nq][s] = *(const bf16x8*)(Qb + (size_t)qrow * QW + h * 96 + 16 * s + 8 * hh);
        if (lat) { const int t = qrow & (SEQ - 1);
#pragma unroll
            for (int j = 0; j < 8; j += 2) { float x1[2], x2[2], y1[2], y2[2];
#pragma unroll
                for (int e = 0; e < 2; ++e) { x1[e] = bf1((bf16)qf[nq][4][j + e]); x2[e] = bf1((bf16)qf[nq][5][j + e]); const float c = ct[t * 16 + 8 * hh + j + e], s = st[t * 16 + 8 * hh + j + e];
                    y1[e] = x1[e] * c - x2[e] * s; y2[e] = x1[e] * s + x2[e] * c; }
                const unsigned w1 = pk2(y1[0], y1[1]), w2 = pk2(y2[0], y2[1]);
                qf[nq][4][j] = (short)(w1 & 0xffff); qf[nq][4][j + 1] = (short)(w1 >> 16); qf[nq][5][j] = (short)(w2 & 0xffff); qf[nq][5][j + 1] = (short)(w2 >> 16); } } }
    f32x16 o0[NQ], o1[NQ]; float m[NQ], l[NQ];
#pragma unroll
    for (int nq = 0; nq < NQ; ++nq) { m[nq] = -1e30f; l[nq] = 0.f;
#pragma unroll
        for (int i = 0; i < 16; ++i) { o0[nq][i] = 0.f; o1[nq][i] = 0.f; } }
    v4u kreg0, kreg1, vreg;
#define ATT_LOAD(it) do { const int rb_ = (it) < CTXL / 64 ? TL + b * CTXL + (it) * 64 : b * SEQ + ((it) - CTXL / 64) * 64; \
        const char* kvb_ = (const char*)(KVb + (size_t)rb_ * KVW); const char* krb_ = (const char*)(KR + (size_t)rb_ * 32); \
        kreg0 = *(const v4u*)(kvb_ + (tid >> 3) * 2048 + h * 256 + (tid & 7) * 16); if (tid < 256) kreg1 = *(const v4u*)(krb_ + (tid >> 2) * 64 + (tid & 3) * 16); vreg = *(const v4u*)(kvb_ + (tid >> 3) * 2048 + h * 256 + 128 + (tid & 7) * 16); } while (0)
#define ATT_WRITE(buf) do { LAS unsigned char* kb_ = lds + (buf) * ATT_BUF; LAS unsigned char* vb_ = kb_ + ATT_KB; \
        *(LAS v4u*)(kb_ + (tid >> 3) * ATT_KP + (tid & 7) * 16) = kreg0; if (tid < 256) *(LAS v4u*)(kb_ + (tid >> 2) * ATT_KP + 128 + (tid & 3) * 16) = kreg1; \
        *(LAS v4u*)(vb_ + (tid >> 3) * ATT_VP + (tid & 7) * 16) = vreg; } while (0)
    __syncthreads();
    ATT_LOAD(0); ATT_WRITE(0);
    __syncthreads();
    for (int it = 0; it < ntiles; ++it) {
#ifdef ATT_JITTER
        if (wave == ((it * 5 + (int)blockIdx.x) & 7)) __builtin_amdgcn_s_sleep(100);
#endif
#ifndef ATT_LOADMID
        if (it + 1 < ntiles) ATT_LOAD(it + 1);
#endif
#ifdef ATT_TZ
        int tz = tid; asm volatile("" : "+v"(tz));
        const int lane = tz & 63, r32 = lane & 31, hh = lane >> 5, tq = (lane >> 2) & 3, tp = lane & 3, tblk = (lane >> 4) & 1;
#endif
        const LAS unsigned char* kb = lds + (it & 1) * ATT_BUF; const LAS unsigned char* vb = kb + ATT_KB;
#pragma unroll
        for (int t = 0; t < 2; ++t) {
            f32x16 sc[NQ]; bf16x8 pf[NQ][2];
#pragma unroll
            for (int nq = 0; nq < NQ; ++nq)
#pragma unroll
                for (int i = 0; i < 16; ++i) sc[nq][i] = 0.f;
            bf16x8 kf[6];
#pragma unroll
            for (int s = 0; s < 6; ++s) kf[s] = *(const LAS bf16x8*)(kb + (32 * t + r32) * ATT_KP + (16 * s + 8 * hh) * 2);
            asm volatile("" : "+v"(kf[0]), "+v"(kf[1]), "+v"(kf[2]), "+v"(kf[3]), "+v"(kf[4]), "+v"(kf[5]));
#pragma unroll
            for (int s = 0; s < 6; ++s)
#pragma unroll
                for (int nq = 0; nq < NQ; ++nq) sc[nq] = __builtin_amdgcn_mfma_f32_32x32x16_bf16(kf[s], qf[nq][s], sc[nq], 0, 0, 0);
#ifdef ATT_LOADMID
            if (t == 0 && it + 1 < ntiles) ATT_LOAD(it + 1);
#endif
#pragma unroll
            for (int nq = 0; nq < NQ; ++nq) {
                float mx = sc[nq][0];
#pragma unroll
                for (int i = 1; i < 16; ++i) mx = fmaxf(mx, sc[nq][i]);
                mx = fmaxf(mx, shx(mx, 32, lane));
#ifdef ATT_LAZY
                const float mxs = mx * ATT_SCALE_LOG2E;
                if (__builtin_amdgcn_ballot_w64(mxs > m[nq] + (float)ATT_LAZY) != 0ull) {
                    const float mn = fmaxf(m[nq], mxs); const float alpha = __builtin_amdgcn_exp2f(m[nq] - mn); m[nq] = mn; l[nq] *= alpha;
#pragma unroll
                    for (int i = 0; i < 16; ++i) { o0[nq][i] *= alpha; o1[nq][i] *= alpha; } }
                { const float mn = m[nq]; float rs = 0.f;
#pragma unroll
                  for (int i = 0; i < 16; ++i) { sc[nq][i] = __builtin_amdgcn_exp2f(sc[nq][i] * ATT_SCALE_LOG2E - mn); rs += sc[nq][i]; }
                  l[nq] += rs; }
#else
                const float mn = fmaxf(m[nq], mx * ATT_SCALE_LOG2E); const float alpha = __builtin_amdgcn_exp2f(m[nq] - mn); m[nq] = mn;
                float rs = 0.f;
#pragma unroll
                for (int i = 0; i < 16; ++i) { sc[nq][i] = __builtin_amdgcn_exp2f(sc[nq][i] * ATT_SCALE_LOG2E - mn); rs += sc[nq][i]; }
                l[nq] = l[nq] * alpha + rs;
#ifdef ATT_SKIPRS
                if (__builtin_amdgcn_ballot_w64(alpha != 1.0f) != 0ull)
#endif
                {
#pragma unroll
                    for (int i = 0; i < 16; ++i) { o0[nq][i] *= alpha; o1[nq][i] *= alpha; } }
#endif
#pragma unroll
                for (int s2 = 0; s2 < 2; ++s2) { v4u w0;
                    w0.x = cvtpk(sc[nq][8 * s2 + 0], sc[nq][8 * s2 + 1]); w0.y = cvtpk(sc[nq][8 * s2 + 2], sc[nq][8 * s2 + 3]); w0.z = cvtpk(sc[nq][8 * s2 + 4], sc[nq][8 * s2 + 5]); w0.w = cvtpk(sc[nq][8 * s2 + 6], sc[nq][8 * s2 + 7]);
                    pf[nq][s2] = __builtin_bit_cast(bf16x8, w0); }
            }
#pragma unroll
            for (int s2 = 0; s2 < 2; ++s2) { const int ko = t * 32 + 16 * s2 + 4 * hh;
                { const LAS unsigned char* tb = vb + (ko + tq) * ATT_VP + (16 * tblk + 4 * tp) * 2; const v2u lo = trread(tb), hi = trread(tb + 8 * ATT_VP); const bf16x8 vf = __builtin_bit_cast(bf16x8, (v4u){lo.x, lo.y, hi.x, hi.y});
#pragma unroll
                  for (int nq = 0; nq < NQ; ++nq) o0[nq] = __builtin_amdgcn_mfma_f32_32x32x16_bf16(vf, pf[nq][s2], o0[nq], 0, 0, 0); }
                { const LAS unsigned char* tb = vb + (ko + tq) * ATT_VP + (32 + 16 * tblk + 4 * tp) * 2; const v2u lo = trread(tb), hi = trread(tb + 8 * ATT_VP); const bf16x8 vf = __builtin_bit_cast(bf16x8, (v4u){lo.x, lo.y, hi.x, hi.y});
#pragma unroll
                  for (int nq = 0; nq < NQ; ++nq) o1[nq] = __builtin_amdgcn_mfma_f32_32x32x16_bf16(vf, pf[nq][s2], o1[nq], 0, 0, 0); } }
        }
        if (it + 1 < ntiles) ATT_WRITE((it + 1) & 1);
        __syncthreads();
    }
#undef ATT_LOAD
#undef ATT_WRITE
#pragma unroll
    for (int nq = 0; nq < NQ; ++nq) { const int qrow = q0 + wave * (32 * NQ) + nq * 32 + r32;
        const float lsum = l[nq] + shx(l[nq], 32, lane); const float inv = 1.f / lsum;
        bf16* orow = MIX + (size_t)qrow * D + h * 64 + 4 * hh;
#pragma unroll
        for (int g = 0; g < 4; ++g) {
            v2u w; w.x = pk2(o0[nq][4 * g] * inv, o0[nq][4 * g + 1] * inv); w.y = pk2(o0[nq][4 * g + 2] * inv, o0[nq][4 * g + 3] * inv); *(v2u*)(orow + 8 * g) = w;
            v2u x; x.x = pk2(o1[nq][4 * g] * inv, o1[nq][4 * g + 1] * inv); x.y = pk2(o1[nq][4 * g + 2] * inv, o1[nq][4 * g + 3] * inv); *(v2u*)(orow + 32 + 8 * g) = x; } }
}
__device__ __forceinline__ void attn_mfma(const Args& a, LAS unsigned char* lds) {
#if ATT_NQ == 2
    for (int u0 = blockIdx.x; u0 < 256; u0 += gridDim.x) { const int u = (gridDim.x == 256 && ATT_XCDSWZ) ? ((u0 & 7) * 32 + (u0 >> 3)) : u0;
        attn_unit3<2>(a, lds, u >> 5, (u >> 2) & 7, (u >> 5) * SEQ + (u & 3) * 512, (CTXL + SEQ) / 64, true); }
#else
    for (int u = blockIdx.x; u < 512; u += gridDim.x) attn_unit3<1>(a, lds, u >> 6, (u >> 3) & 7, (u >> 6) * SEQ + (u & 7) * 256, (CTXL + SEQ) / 64, true);
#endif
    for (int u = blockIdx.x; u < 64; u += gridDim.x) attn_unit3<1>(a, lds, u >> 3, u & 7, TL + (u >> 3) * CTXL, CTXL / 64, false);
}

#ifndef SSD_PRIO
#define SSD_PRIO 1
#endif
#ifndef SSD_XCDSWZ
#define SSD_XCDSWZ 1
#endif
#ifndef SSD_PFEARLY
#define SSD_PFEARLY 0
#endif
#ifndef SSD_YREP
#define SSD_YREP 1
#endif
#ifndef SSD_WREP
#define SSD_WREP 1
#endif
constexpr int SP_B = 272, SP_X = 192;
constexpr int SO_B = 0, SO_C = SO_B + 128 * SP_B, SO_XD = SO_C + 128 * SP_B, SO_XW = SO_XD + 128 * SP_X, SO_S = SO_XW + 128 * SP_X, SO_V = SO_S + 64 * SP_B;
static_assert(SO_V + 2 * 2048 <= LDS_BYTES, "ssd lds map");
#ifdef SSD_DIAG
#define SSD_T(v) long long v = clock64()
#define SSD_ACC(k, v) do { const long long n_ = clock64(); dacc[k] += n_ - v; v = n_; } while (0)
#else
#define SSD_T(v) do {} while (0)
#define SSD_ACC(k, v) do {} while (0)
#endif
__device__ __forceinline__ void ssd_scan_mfma(const Args& a, int i, bool last, LAS unsigned char* lds) {
#ifdef SSD_DIAG
    long long dacc[12] = {0, 0, 0, 0, 0, 0, 0, 0, 0, 0, 0, 0};
#endif
    const int tid = otid(a.wv), wave = a.wv, lane = tid & 63, r32 = lane & 31, hh = lane >> 5;
    const int pt = wave >> 2, lt = pt ? 3 - (wave & 3) : (wave & 3);
    const int tq = (lane >> 2) & 3, tp = lane & 3, tblk = (lane >> 4) & 1;
    bf16* ZX = (bf16*)(a.ws + WS_ZX); const bf16* XBC = (const bf16*)(a.ws + WS_XBC); bf16* GX = (bf16*)(a.ws + WS_XBC); float* SSq = (float*)(a.ws + WS_SS); const float* DT = (const float*)(a.ws + WS_DT); const float* AA = (const float*)(a.ws + WS_AA);
    LAS unsigned char* Bl = lds + SO_B; LAS unsigned char* Cl = lds + SO_C; LAS unsigned char* XDl = lds + SO_XD; LAS unsigned char* XWl = lds + SO_XW; LAS unsigned char* Sl = lds + SO_S;
    const int brow = tid >> 4, bpart = tid & 15, xrow = tid >> 3, xpart = tid & 7;
    for (int it = blockIdx.x; it < NB * 32; it += gridDim.x) {
        const int itx = (gridDim.x == 256 && SSD_XCDSWZ) ? ((it & 7) * 32 + (it >> 3)) : it;
        const int b = itx >> 5, h = itx & 31, g = h >> 3; const float dsk = a.in[I_SD][i * 32 + h];
        for (int dir = 0; dir < 2; ++dir) {
            const int scanw = dir == 0 ? 0 : 3;
            f32x16 sacc;
#pragma unroll
            for (int k = 0; k < 16; ++k) sacc[k] = 0.f;
            SSD_T(tprev);
            v4u bq[4], cq[4], xq[2]; float pa0 = 0.f, pa1 = 0.f, pd0 = 0.f, pd1 = 0.f, qa0 = 0.f, qa1 = 0.f, qd0 = 0.f, qd1 = 0.f; v2u add[4], zq[4];
#define SSD_ROWBASE(c) ((c) < 2 ? TL + b * CTXL + (dir == 0 ? (c) : 1 - (c)) * 128 : b * SEQ + (dir == 0 ? (c) - 2 : 17 - (c)) * 128)
#define SSD_PFB(c) do { const int rb_ = SSD_ROWBASE(c); _Pragma("unroll") for (int k_ = 0; k_ < 4; ++k_) bq[k_] = *(const v4u*)(XBC + (size_t)(rb_ + brow + 32 * k_) * 3072 + 2048 + g * 128 + bpart * 8); } while (0)
#define SSD_PFC(c) do { const int rb_ = SSD_ROWBASE(c); _Pragma("unroll") for (int k_ = 0; k_ < 4; ++k_) cq[k_] = *(const v4u*)(XBC + (size_t)(rb_ + brow + 32 * k_) * 3072 + 2560 + g * 128 + bpart * 8); } while (0)
#define SSD_PFX(c) do { const int rb_ = SSD_ROWBASE(c); _Pragma("unroll") for (int k_ = 0; k_ < 2; ++k_) xq[k_] = *(const v4u*)(XBC + (size_t)(rb_ + xrow + 64 * k_) * 3072 + h * 64 + xpart * 8); } while (0)
#define SSD_PF(c) do { SSD_PFB(c); SSD_PFC(c); SSD_PFX(c); } while (0)
#define SSD_PFV(c) do { if (wave == scanw) { const int rb_ = SSD_ROWBASE(c); const size_t o_ = (size_t)(rb_ + 2 * lane) * 64 + dir * 32 + h; qa0 = AA[o_]; qa1 = AA[o_ + 64]; qd0 = DT[o_]; qd1 = DT[o_ + 64]; } } while (0)
#define SSD_PFY(c) do { const int rb_ = SSD_ROWBASE(c); const size_t r_ = (size_t)(rb_ + 32 * lt + r32); \
                _Pragma("unroll") for (int q_ = 0; q_ < 4; ++q_) { add[q_] = dir == 0 ? *(const v2u*)(XBC + r_ * 3072 + h * 64 + 32 * pt + 4 * hh + 8 * q_) : *(const v2u*)(ZX + r_ * SSD_INP + 2048 + h * 64 + 32 * pt + 4 * hh + 8 * q_); \
                    if (dir == 1) zq[q_] = *(const v2u*)(ZX + r_ * SSD_INP + h * 64 + 32 * pt + 4 * hh + 8 * q_); } } while (0)
#define SSD_SCAN(vb_) do { if (wave == scanw) { LAS float* V_ = (LAS float*)(lds + SO_V + (vb_) * 2048); const float pair_ = pa0 + pa1; float ps_ = pair_; \
                _Pragma("unroll") for (int d_ = 1; d_ < 64; d_ <<= 1) { const int src_ = dir == 0 ? lane - d_ : lane + d_; const float t_ = __builtin_bit_cast(float, __builtin_amdgcn_ds_bpermute((src_ & 63) << 2, __builtin_bit_cast(int, ps_))); if (src_ >= 0 && src_ < 64) ps_ += t_; } \
                const float tot_ = __builtin_bit_cast(float, __builtin_amdgcn_ds_bpermute((dir == 0 ? 63 : 0) << 2, __builtin_bit_cast(int, ps_))); const float ex_ = ps_ - pair_; \
                float c0_, c1_; if (dir == 0) { c0_ = ex_ + pa0; c1_ = c0_ + pa1; } else { c1_ = ex_ + pa1; c0_ = c1_ + pa0; } \
                V_[2 * lane] = c0_; V_[2 * lane + 1] = c1_; V_[128 + 2 * lane] = pd0; V_[128 + 2 * lane + 1] = pd1; V_[256 + 2 * lane] = pd0 * __expf(tot_ - c0_); V_[256 + 2 * lane + 1] = pd1 * __expf(tot_ - c1_); \
                if (lane == 0) V_[384] = tot_; } } while (0)
#define SSD_WRITE(vb_) do { const LAS float* V_ = (const LAS float*)(lds + SO_V + (vb_) * 2048); \
                _Pragma("unroll") for (int k_ = 0; k_ < 4; ++k_) { *(LAS v4u*)(Bl + (brow + 32 * k_) * SP_B + bpart * 16) = bq[k_]; *(LAS v4u*)(Cl + (brow + 32 * k_) * SP_B + bpart * 16) = cq[k_]; } \
                _Pragma("unroll") for (int k_ = 0; k_ < 2; ++k_) { const int s_ = xrow + 64 * k_; const float dt_ = V_[128 + s_], w_ = V_[256 + s_]; float f_[8], g_[8]; unpack8(xq[k_], f_); \
                    _Pragma("unroll") for (int j_ = 0; j_ < 8; ++j_) { g_[j_] = f_[j_] * w_; f_[j_] *= dt_; } \
                    *(LAS v4u*)(XDl + s_ * SP_X + xpart * 16) = pack8(f_); *(LAS v4u*)(XWl + s_ * SP_X + xpart * 16) = pack8(g_); } } while (0)
            __syncthreads();
            SSD_PFV(0); pa0 = qa0; pa1 = qa1; pd0 = qd0; pd1 = qd1; SSD_PFV(1); SSD_PFY(0); SSD_PF(0);
            { const float t0_ = qa0, t1_ = qa1, t2_ = qd0, t3_ = qd1; SSD_SCAN(0); pa0 = t0_; pa1 = t1_; pd0 = t2_; pd1 = t3_; }
            __syncthreads();
            SSD_WRITE(0);
            { LAS v2u* sp = (LAS v2u*)(Sl + (32 * pt + r32) * SP_B + (32 * lt + 4 * hh) * 2);
#pragma unroll
              for (int q = 0; q < 4; ++q) sp[2 * q] = (v2u){0u, 0u}; }
            __syncthreads();
            SSD_ACC(0, tprev);
            for (int c = 0; c < 18; ++c) {
                const int cur = c & 1; const LAS float* V = (const LAS float*)(lds + SO_V + cur * 2048);
#ifdef SSD_JITTER
                if (wave == ((c * 3 + (int)blockIdx.x + dir) & 7)) __builtin_amdgcn_s_sleep(120);
#endif
                const int rowbase = SSD_ROWBASE(c); const bool want_y = !(last && c < 2);
                if (c > 0 && want_y) SSD_PFY(c);
#if SSD_PFEARLY
                if (want_y && c + 1 < 18) SSD_PFB(c + 1);
#endif
                if (c + 1 < 18) { if (c + 2 < 18) SSD_PFV(c + 2); }
                SSD_ACC(1, tprev);
                for (int yrep = 0; yrep < SSD_YREP; ++yrep)
                if (!want_y && c + 1 < 18) { SSD_PFB(c + 1); SSD_PFC(c + 1); SSD_PFX(c + 1); }
                if (want_y) {
                    const int l = 32 * lt + r32; const float cl = V[l];
                    bf16* yptr = ZX + (size_t)(rowbase + l) * SSD_INP + 2048 + h * 64 + 32 * pt + 4 * hh;
                    bf16x8 cf[8];
#pragma unroll
                    for (int ks = 0; ks < 8; ++ks) cf[ks] = *(const LAS bf16x8*)(Cl + l * SP_B + (16 * ks + 8 * hh) * 2);
                    SSD_ACC(8, tprev);
                    f32x16 y1;
#pragma unroll
                    for (int k = 0; k < 16; ++k) y1[k] = 0.f;
#pragma unroll
                    for (int ks = 0; ks < 8; ++ks) { const bf16x8 sf = *(const LAS bf16x8*)(Sl + (32 * pt + r32) * SP_B + (16 * ks + 8 * hh) * 2); y1 = __builtin_amdgcn_mfma_f32_32x32x16_bf16(sf, cf[ks], y1, 0, 0, 0); }
                    { const float el = __expf(cl);
#pragma unroll
                      for (int k = 0; k < 16; ++k) y1[k] *= el; }
                    SSD_ACC(10, tprev);
                    const int st_lo = dir == 0 ? 0 : lt, st_hi = dir == 0 ? lt : 3;
#if SSD_PRIO
                    { const int nsub = st_hi - st_lo; if (nsub == 3) __builtin_amdgcn_s_setprio(3); else if (nsub == 2) __builtin_amdgcn_s_setprio(2); else if (nsub == 1) __builtin_amdgcn_s_setprio(1); }
#endif
#pragma unroll
                    for (int st = 0; st < 4; ++st) { if (c + 1 < 18) { if (st == 1 + SSD_PFEARLY && !SSD_PFEARLY) SSD_PFB(c + 1); if (st == 2 - SSD_PFEARLY) SSD_PFC(c + 1); if (st == 3 - SSD_PFEARLY) SSD_PFX(c + 1); }
                      if (st >= st_lo && st <= st_hi) {
                        f32x16 X;
#pragma unroll
                        for (int k = 0; k < 16; ++k) X[k] = 0.f;
#pragma unroll
                        for (int ks = 0; ks < 8; ++ks) { const bf16x8 af = *(const LAS bf16x8*)(Bl + (32 * st + r32) * SP_B + (16 * ks + 8 * hh) * 2); X = __builtin_amdgcn_mfma_f32_32x32x16_bf16(af, cf[ks], X, 0, 0, 0); }
                        if (st == lt) {
#pragma unroll
                            for (int q = 0; q < 4; ++q) { const f32x4 cs = *(const LAS f32x4*)(V + 32 * st + 8 * q + 4 * hh);
#pragma unroll
                                for (int e = 0; e < 4; ++e) { const int sl = 8 * q + 4 * hh + e; const bool ok = dir == 0 ? (sl <= r32) : (sl >= r32);
                                    X[4 * q + e] *= __expf(ok ? fminf(cl - cs[e], 0.f) : -1.0e30f); } }
                        } else {
#pragma unroll
                            for (int q = 0; q < 4; ++q) { const f32x4 cs = *(const LAS f32x4*)(V + 32 * st + 8 * q + 4 * hh);
#pragma unroll
                                for (int e = 0; e < 4; ++e) X[4 * q + e] *= __expf(fminf(cl - cs[e], 0.f)); }
                        }
#pragma unroll
                        for (int ks2 = 0; ks2 < 2; ++ks2) { v4u w; w.x = cvtpk(X[8 * ks2 + 0], X[8 * ks2 + 1]); w.y = cvtpk(X[8 * ks2 + 2], X[8 * ks2 + 3]); w.z = cvtpk(X[8 * ks2 + 4], X[8 * ks2 + 5]); w.w = cvtpk(X[8 * ks2 + 6], X[8 * ks2 + 7]);
                            const LAS unsigned char* tb = XDl + (32 * st + 16 * ks2 + 4 * hh + tq) * SP_X + (32 * pt + 16 * tblk + 4 * tp) * 2;
                            const v2u lo = trread(tb), hi = trread(tb + 8 * SP_X);
                            y1 = __builtin_amdgcn_mfma_f32_32x32x16_bf16(__builtin_bit_cast(bf16x8, (v4u){lo.x, lo.y, hi.x, hi.y}), __builtin_bit_cast(bf16x8, w), y1, 0, 0, 0); }
                    } }
                    asm volatile("" : "+v"(y1)); SSD_ACC(9, tprev);
                    float ssq = 0.f; bf16* gptr = GX + (size_t)(rowbase + l) * 3072 + h * 64 + 32 * pt + 4 * hh;
#pragma unroll
                    for (int q = 0; q < 4; ++q) { float o[4];
#pragma unroll
                        for (int e = 0; e < 4; ++e) o[e] = y1[4 * q + e];
                        const float a0 = bflo(add[q].x), a1 = bfhi(add[q].x), a2 = bflo(add[q].y), a3 = bfhi(add[q].y);
                        if (dir == 0) { o[0] += dsk * a0; o[1] += dsk * a1; o[2] += dsk * a2; o[3] += dsk * a3;
                            v2u w; w.x = cvtpk(o[0], o[1]); w.y = cvtpk(o[2], o[3]); *(v2u*)(yptr + 8 * q) = w; }
                        else { o[0] += a0; o[1] += a1; o[2] += a2; o[3] += a3;
                            o[0] *= silu_f(bflo(zq[q].x)); o[1] *= silu_f(bfhi(zq[q].x)); o[2] *= silu_f(bflo(zq[q].y)); o[3] *= silu_f(bfhi(zq[q].y));
                            ssq += (o[0] * o[0] + o[1] * o[1]) + (o[2] * o[2] + o[3] * o[3]);
                            v2u w; w.x = cvtpk(o[0], o[1]); w.y = cvtpk(o[2], o[3]); *(v2u*)(gptr + 8 * q) = w; } }
                    if (dir == 1) { ssq += shx(ssq, 32, lane); if (hh == 0) SSq[(size_t)(rowbase + l) * 64 + 2 * h + pt] = ssq; }
                }
#if SSD_PRIO
                __builtin_amdgcn_s_setprio(0);
#endif
                SSD_ACC(2, tprev);
                if (c + 1 < 18) {
                    const float etot = __expf(V[384]);
#pragma unroll
                    for (int k = 0; k < 16; ++k) sacc[k] *= etot;
#pragma unroll
                    for (int kh = 0; kh < 2; ++kh) {
                        v2u alo[4], ahi[4], blo[4], bhi[4];
#pragma unroll
                        for (int k4 = 0; k4 < 4; ++k4) { const int ks = 4 * kh + k4;
                            const LAS unsigned char* ta = Bl + (16 * ks + 8 * hh + tq) * SP_B + (32 * lt + 16 * tblk + 4 * tp) * 2;
                            const LAS unsigned char* tb = XWl + (16 * ks + 8 * hh + tq) * SP_X + (32 * pt + 16 * tblk + 4 * tp) * 2;
                            alo[k4] = trread(ta); ahi[k4] = trread(ta + 4 * SP_B); blo[k4] = trread(tb); bhi[k4] = trread(tb + 4 * SP_X); }
                        asm volatile("" : "+v"(alo[0]), "+v"(alo[1]), "+v"(alo[2]), "+v"(alo[3]), "+v"(bhi[0]), "+v"(bhi[1]), "+v"(bhi[2]), "+v"(bhi[3]));
#pragma unroll
                        for (int k4 = 0; k4 < 4; ++k4)
                            sacc = __builtin_amdgcn_mfma_f32_32x32x16_bf16(__builtin_bit_cast(bf16x8, (v4u){alo[k4].x, alo[k4].y, ahi[k4].x, ahi[k4].y}), __builtin_bit_cast(bf16x8, (v4u){blo[k4].x, blo[k4].y, bhi[k4].x, bhi[k4].y}), sacc, 0, 0, 0); }
                    SSD_SCAN(cur ^ 1); pa0 = qa0; pa1 = qa1; pd0 = qd0; pd1 = qd1;
                }
#ifdef SSD_JITTER
                if (wave == ((c * 5 + 2 + (int)blockIdx.x) & 7)) __builtin_amdgcn_s_sleep(90);
#endif
                SSD_ACC(3, tprev);
                __syncthreads();
                SSD_ACC(4, tprev);
                if (c + 1 < 18) {
                    LAS v2u* sp = (LAS v2u*)(Sl + (32 * pt + r32) * SP_B + (32 * lt + 4 * hh) * 2);
#pragma unroll
                    for (int q = 0; q < 4; ++q) { v2u w; w.x = cvtpk(sacc[4 * q], sacc[4 * q + 1]); w.y = cvtpk(sacc[4 * q + 2], sacc[4 * q + 3]); sp[2 * q] = w; }
                    for (int wrep = 0; wrep < SSD_WREP; ++wrep) { SSD_WRITE(cur ^ 1); }
                }
                SSD_ACC(5, tprev);
                __syncthreads();
                SSD_ACC(6, tprev);
            }
#undef SSD_ROWBASE
#undef SSD_PF
#undef SSD_PFV
#undef SSD_PFY
#undef SSD_SCAN
#undef SSD_WRITE
            asm volatile("s_waitcnt vmcnt(0)" ::: "memory");
        }
    }
#ifdef SSD_DIAG
    if (blockIdx.x == 0 && wave == SSD_DIAG_WAVE && lane == 0 && i == 0) { float* dg = (float*)(a.ws + WS_MOD + 900 * 1024); long long tot = 0;
        for (int k = 0; k < 7; ++k) tot += dacc[k];
        tot += dacc[8] + dacc[9] + dacc[10];
        for (int k = 0; k < 12; ++k) dg[k] = (float)dacc[k]; dg[7] = (float)tot; }
#endif
}

constexpr int AT2_KP = 208, AT2_VP = 192, AT2_KB = 64 * AT2_KP, AT2_VB = 64 * AT2_VP, AT2_BUF = AT2_KB + AT2_VB;
template <int NQ>
__device__ __forceinline__ void attn_unit2(const Args& a, LAS unsigned char* lds, int b, int h, int q0, int ntiles, bool lat) {
    const int tid = otid(a.wv), wave = tid >> 6, lane = tid & 63, r32 = lane & 31, hh = lane >> 5;
    const int tq = (lane >> 2) & 3, tp = lane & 3, tblk = (lane >> 4) & 1;
    const bf16* Qb = (const bf16*)(a.ws + WS_Q); const bf16* KVb = (const bf16*)(a.ws + WS_KV); const bf16* KR = (const bf16*)(a.ws + WS_KR); bf16* MIX = (bf16*)(a.ws + WS_MIX);
    const float* ct = (const float*)(a.ws + WS_ROPE); const float* st = ct + SEQ * 16;
    bf16x8 qf[NQ][6];
#pragma unroll
    for (int nq = 0; nq < NQ; ++nq) { const int qrow = q0 + wave * (32 * NQ) + nq * 32 + r32;
#pragma unroll
        for (int s = 0; s < 6; ++s) qf[nq][s] = *(const bf16x8*)(Qb + (size_t)qrow * QW + h * 96 + 16 * s + 8 * hh);
        if (lat) { const int t = qrow & (SEQ - 1);
#pragma unroll
            for (int j = 0; j < 8; j += 2) { float y1[2], y2[2];
#pragma unroll
                for (int e = 0; e < 2; ++e) { const float x1 = bf1((bf16)qf[nq][4][j + e]), x2 = bf1((bf16)qf[nq][5][j + e]); const float c = ct[t * 16 + 8 * hh + j + e], s = st[t * 16 + 8 * hh + j + e];
                    y1[e] = x1 * c - x2 * s; y2[e] = x1 * s + x2 * c; }
                const unsigned w1 = pk2(y1[0], y1[1]), w2 = pk2(y2[0], y2[1]);
                qf[nq][4][j] = (short)(w1 & 0xffff); qf[nq][4][j + 1] = (short)(w1 >> 16); qf[nq][5][j] = (short)(w2 & 0xffff); qf[nq][5][j + 1] = (short)(w2 >> 16); } }
        asm volatile("" : "+v"(qf[nq][0]), "+v"(qf[nq][1]), "+v"(qf[nq][2]), "+v"(qf[nq][3]), "+v"(qf[nq][4]), "+v"(qf[nq][5]) :: "memory"); }
    f32x16 o[NQ][2]; float m[NQ], l[NQ];
#pragma unroll
    for (int nq = 0; nq < NQ; ++nq) { m[nq] = -1e30f; l[nq] = 0.f;
#pragma unroll
        for (int i = 0; i < 16; ++i) { o[nq][0][i] = 0.f; o[nq][1][i] = 0.f; } }
    v4u kreg0, kreg1, vreg;
#define AT2_LOAD(it, tt) do { const unsigned off_kv = (unsigned)(((tt) >> 3) * (KVW * 2) + h * 256 + ((tt) & 7) * 16), off_kr = (unsigned)(((tt) >> 2) * 64 + ((tt) & 3) * 16); const bool k1ok = (tt) < 256; const int rb_ = (it) < CTXL / 64 ? TL + b * CTXL + (it) * 64 : b * SEQ + ((it) - CTXL / 64) * 64; \
        const char* kvb_ = (const char*)(KVb + (size_t)rb_ * KVW); const char* krb_ = (const char*)(KR + (size_t)rb_ * 32); \
        kreg0 = *(const v4u*)(kvb_ + off_kv); vreg = *(const v4u*)(kvb_ + off_kv + 128); if (k1ok) kreg1 = *(const v4u*)(krb_ + off_kr); } while (0)
#define AT2_WRITE(buf, tt) do { LAS unsigned char* kb_ = lds + (buf) * AT2_BUF; \
        *(LAS v4u*)(kb_ + ((tt) >> 3) * AT2_KP + ((tt) & 7) * 16) = kreg0; if ((tt) < 256) *(LAS v4u*)(kb_ + ((tt) >> 2) * AT2_KP + 128 + ((tt) & 3) * 16) = kreg1; \
        *(LAS v4u*)(kb_ + AT2_KB + ((tt) >> 3) * AT2_VP + ((tt) & 7) * 16) = vreg; } while (0)
    __syncthreads();
    AT2_LOAD(0, tid); AT2_WRITE(0, tid);
    __syncthreads();
    for (int it = 0; it < ntiles; ++it) {
        int tz = tid; asm volatile("" : "+v"(tz));
        const int lane_ = tz & 63, r32_ = lane_ & 31, hh_ = lane_ >> 5, tq_ = (lane_ >> 2) & 3, tp_ = lane_ & 3, tblk_ = (lane_ >> 4) & 1;
#ifdef ATT_LOADTOP
        if (it + 1 < ntiles) AT2_LOAD(it + 1, tz);
#endif
        const LAS unsigned char* kb = lds + (it & 1) * AT2_BUF; const LAS unsigned char* vb = kb + AT2_KB;
        bf16x8 pf[NQ][2][2];
        f32x16 sc[NQ][2];
#pragma unroll
        for (int nq = 0; nq < NQ; ++nq)
#pragma unroll
            for (int i = 0; i < 16; ++i) { sc[nq][0][i] = 0.f; sc[nq][1][i] = 0.f; }
#pragma unroll
        for (int s = 0; s < 6; ++s) { const bf16x8 a0 = *(const LAS bf16x8*)(kb + r32_ * AT2_KP + (16 * s + 8 * hh_) * 2); const bf16x8 a1 = *(const LAS bf16x8*)(kb + (32 + r32_) * AT2_KP + (16 * s + 8 * hh_) * 2);
#pragma unroll
            for (int nq = 0; nq < NQ; ++nq) { sc[nq][0] = __builtin_amdgcn_mfma_f32_32x32x16_bf16(a0, qf[nq][s], sc[nq][0], 0, 0, 0); sc[nq][1] = __builtin_amdgcn_mfma_f32_32x32x16_bf16(a1, qf[nq][s], sc[nq][1], 0, 0, 0); } }
#pragma unroll
        for (int nq = 0; nq < NQ; ++nq) {
            f32x16& s0 = sc[nq][0]; f32x16& s1 = sc[nq][1];
            float mx = s0[0];
#pragma unroll
            for (int i = 1; i < 16; ++i) mx = fmaxf(mx, s0[i]);
#pragma unroll
            for (int i = 0; i < 16; ++i) mx = fmaxf(mx, s1[i]);
            mx = fmaxf(mx, shx(mx, 32, lane_));
            const float mn = fmaxf(m[nq], mx * ATT_SCALE_LOG2E); const float alpha = __builtin_amdgcn_exp2f(m[nq] - mn); m[nq] = mn;
            float rs = 0.f;
#pragma unroll
            for (int i = 0; i < 16; ++i) { s0[i] = __builtin_amdgcn_exp2f(s0[i] * ATT_SCALE_LOG2E - mn); s1[i] = __builtin_amdgcn_exp2f(s1[i] * ATT_SCALE_LOG2E - mn); rs += s0[i] + s1[i]; }
            l[nq] = l[nq] * alpha + rs;
#pragma unroll
            for (int i = 0; i < 16; ++i) { o[nq][0][i] *= alpha; o[nq][1][i] *= alpha; }
#pragma unroll
            for (int s2 = 0; s2 < 2; ++s2) { v4u w0, w1;
                w0.x = cvtpk(s0[8 * s2 + 0], s0[8 * s2 + 1]); w0.y = cvtpk(s0[8 * s2 + 2], s0[8 * s2 + 3]); w0.z = cvtpk(s0[8 * s2 + 4], s0[8 * s2 + 5]); w0.w = cvtpk(s0[8 * s2 + 6], s0[8 * s2 + 7]);
                w1.x = cvtpk(s1[8 * s2 + 0], s1[8 * s2 + 1]); w1.y = cvtpk(s1[8 * s2 + 2], s1[8 * s2 + 3]); w1.z = cvtpk(s1[8 * s2 + 4], s1[8 * s2 + 5]); w1.w = cvtpk(s1[8 * s2 + 6], s1[8 * s2 + 7]);
                pf[nq][0][s2] = __builtin_bit_cast(bf16x8, w0); pf[nq][1][s2] = __builtin_bit_cast(bf16x8, w1); }
        }
#ifndef ATT_LOADTOP
        if (it + 1 < ntiles) AT2_LOAD(it + 1, tz);
#endif
#pragma unroll
        for (int t = 0; t < 2; ++t)
#pragma unroll
            for (int s2 = 0; s2 < 2; ++s2)
#pragma unroll
                for (int dt = 0; dt < 2; ++dt) {
                    const LAS unsigned char* tb = vb + (t * 32 + 16 * s2 + 4 * hh_ + tq_) * AT2_VP + (32 * dt + 16 * tblk_ + 4 * tp_) * 2;
#ifdef ATT_NOTR
                    bf16x8 vf; { const LAS unsigned short* vp_ = (const LAS unsigned short*)(vb + (t * 32 + 16 * s2 + 4 * hh_) * AT2_VP + (32 * dt + r32_) * 2);
#pragma unroll
                      for (int j_ = 0; j_ < 8; ++j_) vf[j_] = (short)vp_[((j_ & 3) + 8 * (j_ >> 2)) * (AT2_VP / 2)]; }
#else
                    const v2u lo = trread(tb), hi = trread(tb + 8 * AT2_VP); const bf16x8 vf = __builtin_bit_cast(bf16x8, (v4u){lo.x, lo.y, hi.x, hi.y});
#endif
#pragma unroll
                    for (int nq = 0; nq < NQ; ++nq) o[nq][dt] = __builtin_amdgcn_mfma_f32_32x32x16_bf16(vf, pf[nq][t][s2], o[nq][dt], 0, 0, 0); }
        if (it + 1 < ntiles) AT2_WRITE((it + 1) & 1, tz);
        __syncthreads();
    }
#undef AT2_LOAD
#undef AT2_WRITE
#pragma unroll
    for (int nq = 0; nq < NQ; ++nq) { int qrow = q0 + wave * (32 * NQ) + nq * 32 + r32; asm volatile("" : "+v"(qrow));
        const float lt = l[nq] + shx(l[nq], 32, lane); const float inv = 1.f / lt;
        bf16* orow = MIX + (size_t)qrow * D + h * 64 + 4 * hh;
#pragma unroll
        for (int g = 0; g < 4; ++g) {
            v2u w; w.x = pk2(o[nq][0][4 * g] * inv, o[nq][0][4 * g + 1] * inv); w.y = pk2(o[nq][0][4 * g + 2] * inv, o[nq][0][4 * g + 3] * inv); *(v2u*)(orow + 8 * g) = w;
            v2u x; x.x = pk2(o[nq][1][4 * g] * inv, o[nq][1][4 * g + 1] * inv); x.y = pk2(o[nq][1][4 * g + 2] * inv, o[nq][1][4 * g + 3] * inv); *(v2u*)(orow + 32 + 8 * g) = x; } }
}
__device__ __forceinline__ void attn_mfma2(const Args& a, LAS unsigned char* lds) {
#ifdef ATT_NQ1
    for (int u = blockIdx.x; u < 512; u += gridDim.x) attn_unit2<1>(a, lds, u >> 6, (u >> 3) & 7, (u >> 6) * SEQ + (u & 7) * 256, (CTXL + SEQ) / 64, true);
#else
    for (int u = blockIdx.x; u < 256; u += gridDim.x) attn_unit2<2>(a, lds, u >> 5, (u >> 2) & 7, (u >> 5) * SEQ + (u & 3) * 512, (CTXL + SEQ) / 64, true);
#endif
    for (int u = blockIdx.x; u < 64; u += gridDim.x) attn_unit2<1>(a, lds, u >> 3, u & 7, TL + (u >> 3) * CTXL, CTXL / 64, false);
}

template <int R, int PART = 0>
__device__ __forceinline__ void rowwise2(const float* xs_lat, const float* xs_ctx, float* xd_lat, float* xd_ctx, const bf16* Mb, const bf16* Mp, const float* modg, const float* nwA,
                                         bf16* H, const float* modh, int sh_off, int sc_off, const float* nwB, int nrows, int wv) {
    if (PART == 1 && blockIdx.x < 64) return;
    const int tid = otid(wv), wave = wv, lane = tid & 63; const int NGW = gridDim.x * NWAVES, gw = xblk() * NWAVES + wave;
    constexpr int JS = (PART == 2) ? 0 : R - 1;
    const int wq1 = (((int)blockIdx.x >> 3) - 8) * NWAVES + wave, rb1 = 2048 * ((int)blockIdx.x & 7) + wq1 * 10 + min(wq1, 128), cnt1 = 10 + (wq1 < 128 ? 1 : 0);
    const int nlat = min(nrows, TL), nctx = nrows - nlat; const bool even_ = (nlat % NGW == 0) && (nctx % NGW == 0);
    const int rpw = (nrows + NGW - 1) / NGW; const int lpw = even_ ? nlat / NGW : 0, cpw = even_ ? nctx / NGW : 0;
    const int rbeg = (PART != 0 || even_) ? 0 : gw * rpw, rend = PART == 1 ? cnt1 : (PART == 2 ? 1 : (even_ ? lpw + cpw : min(rbeg + rpw, nrows)));
#define RW_ROW(ii) (PART == 1 ? rb1 + (ii) : (PART == 2 ? TL + gw : (even_ ? ((ii) < lpw ? gw * lpw + (ii) : TL + gw * cpw + ((ii) - lpw)) : (ii))))
    for (int r0 = rbeg; r0 < rend; r0 += R) {
        f32x4 v[R][4]; v2u mm[R][4], mm2[4];
#pragma unroll
        for (int j = 0; j < R; ++j) { const int r = RW_ROW(min(r0 + j, rend - 1)); const float* xs = r < TL ? xs_lat + (size_t)r * D : xs_ctx + (size_t)(r - TL) * D;
#pragma unroll
            for (int q = 0; q < 4; ++q) v[j][q] = __builtin_nontemporal_load((const f32x4*)(xs + q * 256 + lane * 4));
            if (Mb) { const bool sp = Mp != nullptr && r >= TL; const bf16* m0 = sp ? Mp + (size_t)(r - TL) * D : Mb + (size_t)r * D;
#pragma unroll
                for (int q = 0; q < 4; ++q) mm[j][q] = *(const v2u*)(m0 + q * 256 + lane * 4);
                if (j == JS) {
                    if (sp) {
#pragma unroll
                        for (int q = 0; q < 4; ++q) mm2[q] = *(const v2u*)(m0 + (size_t)TC * D + q * 256 + lane * 4); }
                    else {
#pragma unroll
                        for (int q = 0; q < 4; ++q) mm2[q] = (v2u){0u, 0u}; } } } }
#pragma unroll
        for (int j = 0; j < R; ++j) { if (r0 + j < rend) { const int r = RW_ROW(r0 + j);
            const bool lat = r < TL; const int cond = lat ? (r >> 11) : 8; float* xd = lat ? xd_lat + (size_t)r * D : xd_ctx + (size_t)(r - TL) * D;
            if (Mb) {
                f32x4 m[4]; float ss = 0.f;
#pragma unroll
                for (int q = 0; q < 4; ++q) { const v2u w = mm[j][q]; m[q] = (f32x4){bflo(w.x), bfhi(w.x), bflo(w.y), bfhi(w.y)};
                    if (j == JS) { const v2u w2 = mm2[q]; m[q] = m[q] + (f32x4){bflo(w2.x), bfhi(w2.x), bflo(w2.y), bfhi(w2.y)}; } ss += (m[q][0] * m[q][0] + m[q][1] * m[q][1]) + (m[q][2] * m[q][2] + m[q][3] * m[q][3]); }
                const float rs = rsqrtf(wave_sum(ss, lane) * (1.f / D) + EPS);
#pragma unroll
                for (int q = 0; q < 4; ++q) { const f32x4 g = *(const f32x4*)(modg + (size_t)cond * MODW + q * 256 + lane * 4); const f32x4 w = *(const f32x4*)(nwA + q * 256 + lane * 4);
                    v[j][q] = v[j][q] + g * (m[q] * rs * w); }
            }
            if (xd_lat) {
#pragma unroll
            for (int q = 0; q < 4; ++q) __builtin_nontemporal_store(v[j][q], (f32x4*)(xd + q * 256 + lane * 4)); }
            if (H) {
                float ss = 0.f;
#pragma unroll
                for (int q = 0; q < 4; ++q) ss += (v[j][q][0] * v[j][q][0] + v[j][q][1] * v[j][q][1]) + (v[j][q][2] * v[j][q][2] + v[j][q][3] * v[j][q][3]);
                const float rs = rsqrtf(wave_sum(ss, lane) * (1.f / D) + EPS);
#pragma unroll
                for (int q = 0; q < 4; ++q) { const int c = q * 256 + lane * 4;
                    const f32x4 w = *(const f32x4*)(nwB + c); const f32x4 sc = *(const f32x4*)(modh + (size_t)cond * MODW + sc_off + c); const f32x4 sh = *(const f32x4*)(modh + (size_t)cond * MODW + sh_off + c);
                    const f32x4 hv = (v[j][q] * rs * w) * (sc + 1.0f) + sh;
                    v2u o; o.x = pk2(hv[0], hv[1]); o.y = pk2(hv[2], hv[3]); *(v2u*)(H + (size_t)r * D + c) = o; }
            } } }
    }
}
#undef RW_ROW

__device__ __forceinline__ void convgate2(const Args& a, int l, int nrows) {
    const bf16* U = (const bf16*)(a.ws + WS_U); bf16* G = (bf16*)(a.ws + WS_G); const float* cw = a.in[I_FCONV] + (size_t)l * 3 * UPW;
    const int total = (nrows / 8) * (DFF / 8);
    for (int idx = blockIdx.x * NTHR + otid(a.wv); idx < total; idx += gridDim.x * NTHR) {
        const int r0 = (idx / (DFF / 8)) * 8, c0 = (idx % (DFF / 8)) * 8; const bf16* u = U + (size_t)r0 * UPW + c0;
        const bool hp = has_prev(r0), hn = has_next(r0 + 7);
        v4u ua[10], ug[10];
#pragma unroll
        for (int j = 0; j < 10; ++j) { const int rr = (j == 0 && !hp) ? 0 : ((j == 9 && !hn) ? 7 : j - 1); ua[j] = *(const v4u*)(u + (ptrdiff_t)rr * UPW); ug[j] = *(const v4u*)(u + (ptrdiff_t)rr * UPW + DFF); }
        float wa[3][8], wg[3][8];
#pragma unroll
        for (int t = 0; t < 3; ++t)
#pragma unroll
            for (int j = 0; j < 8; ++j) { wa[t][j] = cw[t * UPW + c0 + j]; wg[t][j] = cw[t * UPW + DFF + c0 + j]; }
        if (!hp) { ua[0] = (v4u){0u, 0u, 0u, 0u}; ug[0] = ua[0]; }
        if (!hn) { ua[9] = (v4u){0u, 0u, 0u, 0u}; ug[9] = ua[9]; }
        float pa[8], ca[8], na[8], pg[8], cg_[8], ng[8];
        unpack8(ua[0], pa); unpack8(ug[0], pg); unpack8(ua[1], ca); unpack8(ug[1], cg_);
#pragma unroll
        for (int j = 0; j < 8; ++j) {
            unpack8(ua[j + 2], na); unpack8(ug[j + 2], ng);
            float o[8];
#pragma unroll
            for (int k = 0; k < 8; ++k) { const float act = wa[0][k] * pa[k] + wa[1][k] * ca[k] + wa[2][k] * na[k]; const float gate = wg[0][k] * pg[k] + wg[1][k] * cg_[k] + wg[2][k] * ng[k]; o[k] = silu_f(act) * gate; }
            *(v4u*)(G + (size_t)(r0 + j) * DFF + c0) = pack8(o);
#pragma unroll
            for (int k = 0; k < 8; ++k) { pa[k] = ca[k]; ca[k] = na[k]; pg[k] = cg_[k]; cg_[k] = ng[k]; }
        }
    }
}

__device__ __forceinline__ void ssd_conv2(const Args& a, int i) {
    const bf16* ZX = (const bf16*)(a.ws + WS_ZX); bf16* XBC = (bf16*)(a.ws + WS_XBC); float* DT = (float*)(a.ws + WS_DT); float* AA = (float*)(a.ws + WS_AA);
    const float* cw = a.in[I_SCONVW] + (size_t)i * 3 * 3072; const float* cb = a.in[I_SCONVB] + (size_t)i * 3072;
    const int total = (T / 8) * 384; const int per = (total + (int)gridDim.x - 1) / (int)gridDim.x, ibase = xblk() * per;
    for (int k_ = otid(a.wv); k_ < per; k_ += NTHR) { const int idx = ibase + k_; if (idx >= total) break;
        const int r0 = (idx / 384) * 8, c0 = (idx % 384) * 8; const bf16* u = ZX + (size_t)r0 * SSD_INP + 2048 + c0;
        const bool hp = has_prev(r0), hn = has_next(r0 + 7);
        v4u ux[10];
#pragma unroll
        for (int j = 0; j < 10; ++j) { const int rr = (j == 0 && !hp) ? 0 : ((j == 9 && !hn) ? 7 : j - 1); ux[j] = *(const v4u*)(u + (ptrdiff_t)rr * SSD_INP); }
        float w[3][8], bias[8];
#pragma unroll
        for (int j = 0; j < 8; ++j) { w[0][j] = cw[c0 + j]; w[1][j] = cw[3072 + c0 + j]; w[2][j] = cw[2 * 3072 + c0 + j]; bias[j] = cb[c0 + j]; }
        if (!hp) ux[0] = (v4u){0u, 0u, 0u, 0u};
        if (!hn) ux[9] = (v4u){0u, 0u, 0u, 0u};
        float p[8], c[8], n[8];
        unpack8(ux[0], p); unpack8(ux[1], c);
#pragma unroll
        for (int j = 0; j < 8; ++j) {
            unpack8(ux[j + 2], n); float o[8];
#pragma unroll
            for (int k = 0; k < 8; ++k) o[k] = silu_f(bias[k] + w[0][k] * p[k] + w[1][k] * c[k] + w[2][k] * n[k]);
            *(v4u*)(XBC + (size_t)(r0 + j) * 3072 + c0) = pack8(o);
#pragma unroll
            for (int k = 0; k < 8; ++k) { p[k] = c[k]; c[k] = n[k]; }
        }
    }
    const float* alog = a.in[I_ALOG] + i * 64; const float* dtb = a.in[I_DTB] + i * 64;
    const int per2 = (T * 8 + (int)gridDim.x - 1) / (int)gridDim.x, ibase2 = xblk() * per2;
    for (int k_ = otid(a.wv); k_ < per2; k_ += NTHR) { const int idx = ibase2 + k_; if (idx >= T * 8) break;
        const int r = idx >> 3, j0 = (idx & 7) * 8; float raw[8], dt[8], av[8];
        unpack8(*(const v4u*)(ZX + (size_t)r * SSD_INP + 5120 + j0), raw);
#pragma unroll
        for (int k = 0; k < 8; ++k) { const float x = raw[k] + dtb[j0 + k]; dt[k] = x > 15.f ? x : (x < -15.f ? __expf(x) : __logf(1.f + __expf(x))); av[k] = -__expf(alog[j0 + k]) * dt[k]; }
        *(f32x4*)(DT + (size_t)r * 64 + j0) = (f32x4){dt[0], dt[1], dt[2], dt[3]}; *(f32x4*)(DT + (size_t)r * 64 + j0 + 4) = (f32x4){dt[4], dt[5], dt[6], dt[7]};
        *(f32x4*)(AA + (size_t)r * 64 + j0) = (f32x4){av[0], av[1], av[2], av[3]}; *(f32x4*)(AA + (size_t)r * 64 + j0 + 4) = (f32x4){av[4], av[5], av[6], av[7]};
    }
}

__device__ __forceinline__ void gatenorm2(const Args& a, int i, int nrows) {
    const int tid = otid(a.wv), wave = a.wv, lane = tid & 63; const int NGW = gridDim.x * NWAVES, gw = blockIdx.x * NWAVES + wave;
    const bf16* ZX = (const bf16*)(a.ws + WS_ZX); bf16* YN = (bf16*)(a.ws + WS_XBC); const float* nw = a.in[I_SNORM] + i * 2048;
    const int rpw = (nrows + NGW - 1) / NGW; const int rbeg = gw * rpw, rend = min(rbeg + rpw, nrows);
    constexpr int R = 3;
    for (int r0 = rbeg; r0 < rend; r0 += R) {
        v4u yv[R][4], zv[R][4];
#pragma unroll
        for (int j = 0; j < R; ++j) { const int r = min(r0 + j, rend - 1);
#pragma unroll
            for (int q = 0; q < 4; ++q) { const int c = q * 512 + lane * 8; yv[j][q] = *(const v4u*)(ZX + (size_t)r * SSD_INP + 2048 + c); zv[j][q] = *(const v4u*)(ZX + (size_t)r * SSD_INP + c); } }
#pragma unroll
        for (int j = 0; j < R; ++j) { const int r = r0 + j; if (r < rend) {
            float v[4][8]; float ss = 0.f;
#pragma unroll
            for (int q = 0; q < 4; ++q) { float y[8], z[8]; unpack8(yv[j][q], y); unpack8(zv[j][q], z);
#pragma unroll
                for (int k = 0; k < 8; ++k) { v[q][k] = y[k] * silu_f(z[k]); ss += v[q][k] * v[q][k]; } }
            const float rs = rsqrtf(wave_sum(ss, lane) * (1.f / 2048.f) + EPS);
#pragma unroll
            for (int q = 0; q < 4; ++q) { const int c = q * 512 + lane * 8; float o[8];
#pragma unroll
                for (int k = 0; k < 8; ++k) o[k] = v[q][k] * rs * nw[c + k];
                *(v4u*)(YN + (size_t)r * 2048 + c) = pack8(o); } } }
    }
}

__device__ __forceinline__ void ffn_fixup(const Args& a, int l, int nrows) {
    const bf16* Ue = (const bf16*)(a.ws + WS_UE); bf16* G = (bf16*)(a.ws + WS_G); const float* cw = a.in[I_FCONV] + (size_t)l * 3 * UPW;
    const int total = (nrows / 256) * 2 * (DFF / 8);
    for (int idx = blockIdx.x * NTHR + otid(a.wv); idx < total; idx += gridDim.x * NTHR) {
        const int cg = idx % (DFF / 8), which = (idx / (DFF / 8)) & 1, pm = idx / (2 * (DFF / 8)); const int c0 = cg * 8; const int col = (c0 / 128) * 256 + (c0 % 128);
        const int r = pm * 256 + (which ? 255 : 0);
        const bf16* e0 = Ue + (size_t)(pm * 4) * UPW + col;
        const bf16* pp = which ? e0 + 2 * UPW : e0 - UPW;
        const bf16* pc = which ? e0 + 3 * UPW : e0;
        const bf16* pn = which ? e0 + 4 * UPW : e0 + UPW;
        const bool hp = which ? true : has_prev(r), hn = which ? has_next(r) : true;
        float pa[8], pg[8], ca[8], cg_[8], na[8], ng[8];
        unpack8(*(const v4u*)pc, ca); unpack8(*(const v4u*)(pc + 128), cg_);
        if (hp) { unpack8(*(const v4u*)pp, pa); unpack8(*(const v4u*)(pp + 128), pg); } else {
#pragma unroll
            for (int k = 0; k < 8; ++k) { pa[k] = 0.f; pg[k] = 0.f; } }
        if (hn) { unpack8(*(const v4u*)pn, na); unpack8(*(const v4u*)(pn + 128), ng); } else {
#pragma unroll
            for (int k = 0; k < 8; ++k) { na[k] = 0.f; ng[k] = 0.f; } }
        float o[8];
#pragma unroll
        for (int k = 0; k < 8; ++k) { const float act = cw[c0 + k] * pa[k] + cw[UPW + c0 + k] * ca[k] + cw[2 * UPW + c0 + k] * na[k];
            const float gate = cw[DFF + c0 + k] * pg[k] + cw[UPW + DFF + c0 + k] * cg_[k] + cw[2 * UPW + DFF + c0 + k] * ng[k]; o[k] = silu_f(act) * gate; }
        *(v4u*)(G + (size_t)r * DFF + c0) = pack8(o);
    }
}

__device__ __forceinline__ void prep_even2(const Args& a, int i) {
    const int tid = otid(a.wv), wave = a.wv, lane = tid & 63; const int NGW = gridDim.x * NWAVES, gw = xblk() * NWAVES + wave;
    const bf16* P = (const bf16*)(a.ws + WS_P); bf16* CQN = (bf16*)(a.ws + WS_CQN); bf16* CKVN = (bf16*)(a.ws + WS_CKVN); bf16* KR = (bf16*)(a.ws + WS_KR); bf16* MIX = (bf16*)(a.ws + WS_MIX);
    const float* qn = a.in[I_QNORM] + i * 384; const float* kvn = a.in[I_KVNORM] + i * 256; const float* cw = a.in[I_SCONV] + i * 3 * 512;
    const float* ct = (const float*)(a.ws + WS_ROPE); const float* st = ct + SEQ * 16;
    constexpr int R = 3; const int rpw = (T + NGW - 1) / NGW; const int rbeg = gw * rpw, rend = min(rbeg + rpw, T);
    const int c0 = lane * 8;
    for (int r0 = rbeg; r0 < rend; r0 += R) {
        unsigned q32[R][3]; v2u kv2[R]; bf16 krv[R]; v4u gbv[R], gcv[R + 2], xvv[R + 2];
#pragma unroll
        for (int j = 0; j < R; ++j) { const int r = min(r0 + j, rend - 1); const bf16* p = P + (size_t)r * HYB_INP;
            const unsigned* p32 = (const unsigned*)(p + lane * 6); q32[j][0] = p32[0]; q32[j][1] = p32[1]; q32[j][2] = p32[2];
            kv2[j] = *(const v2u*)(p + 384 + lane * 4); krv[j] = p[640 + (lane & 31)]; gbv[j] = *(const v4u*)(p + 672 + c0); }
#pragma unroll
        for (int j = 0; j < R + 2; ++j) { int r = r0 + j - 1; r = max(0, min(r, T - 1)); const bf16* p = P + (size_t)r * HYB_INP; gcv[j] = *(const v4u*)(p + 1184 + c0); xvv[j] = *(const v4u*)(p + 1696 + c0); }
#pragma unroll
        for (int j = 0; j < R; ++j) { const int r = r0 + j; if (r < rend) {
            {   float f[6] = {bflo(q32[j][0]), bfhi(q32[j][0]), bflo(q32[j][1]), bfhi(q32[j][1]), bflo(q32[j][2]), bfhi(q32[j][2])}; float ss = 0.f;
#pragma unroll
                for (int k = 0; k < 6; ++k) ss += f[k] * f[k];
                const float rs = rsqrtf(wave_sum(ss, lane) * (1.f / 384.f) + EPS);
#pragma unroll
                for (int k = 0; k < 6; ++k) f[k] = f[k] * rs * qn[lane * 6 + k];
                unsigned* o32 = (unsigned*)(CQN + (size_t)r * 384 + lane * 6); o32[0] = pk2(f[0], f[1]); o32[1] = pk2(f[2], f[3]); o32[2] = pk2(f[4], f[5]); }
            {   const v2u w = kv2[j]; float f[4] = {bflo(w.x), bfhi(w.x), bflo(w.y), bfhi(w.y)};
                const float ss = (f[0] * f[0] + f[1] * f[1]) + (f[2] * f[2] + f[3] * f[3]);
                const float rs = rsqrtf(wave_sum(ss, lane) * (1.f / 256.f) + EPS);
                const f32x4 g = *(const f32x4*)(kvn + lane * 4);
                v2u o; o.x = pk2(f[0] * rs * g[0], f[1] * rs * g[1]); o.y = pk2(f[2] * rs * g[2], f[3] * rs * g[3]); *(v2u*)(CKVN + (size_t)r * 256 + lane * 4) = o; }
            {   const int jj = lane & 31; const float v = bf1(krv[j]); const float o = shx(v, 16, lane); float res = v;
                if (r < TL) { const int t = r & (SEQ - 1); const float c = ct[t * 16 + (jj & 15)], s = st[t * 16 + (jj & 15)]; res = (jj < 16) ? v * c - o * s : o * s + v * c; }
                if (lane < 32) KR[(size_t)r * 32 + jj] = (bf16)f2bf(res); }
            {   float gb[8], t0[8], t1[8], acc[8];
                unpack8(gbv[j], gb); unpack8(gcv[j + 1], t0); unpack8(xvv[j + 1], t1);
#pragma unroll
                for (int k = 0; k < 8; ++k) acc[k] = cw[512 + c0 + k] * (t0[k] * t1[k]);
                if (has_prev(r)) { unpack8(gcv[j], t0); unpack8(xvv[j], t1);
#pragma unroll
                    for (int k = 0; k < 8; ++k) acc[k] += cw[c0 + k] * (t0[k] * t1[k]); }
                if (has_next(r)) { unpack8(gcv[j + 2], t0); unpack8(xvv[j + 2], t1);
#pragma unroll
                    for (int k = 0; k < 8; ++k) acc[k] += cw[1024 + c0 + k] * (t0[k] * t1[k]); }
#pragma unroll
                for (int k = 0; k < 8; ++k) acc[k] *= gb[k];
                *(v4u*)(MIX + (size_t)r * D + 512 + c0) = pack8(acc); }
        } }
    }
}

__device__ __forceinline__ void ffn_fixup_panel(const Args& a, int l, int pm) {
    const bf16* Ue = (const bf16*)(a.ws + WS_UE); bf16* G = (bf16*)(a.ws + WS_G); const float* cw = a.in[I_FCONV] + (size_t)l * 3 * UPW;
    for (int idx = otid(a.wv); idx < 2 * (DFF / 8); idx += NTHR) {
        const int cg = idx % (DFF / 8), which = idx / (DFF / 8); const int c0 = cg * 8; const int col = (c0 / 128) * 256 + (c0 % 128);
        const int r = pm * 256 + (which ? 255 : 0);
        const bf16* e0 = Ue + (size_t)(pm * 4) * UPW + col;
        const bf16* pp = which ? e0 + 2 * UPW : e0 - UPW; const bf16* pc = which ? e0 + 3 * UPW : e0; const bf16* pn = which ? e0 + 4 * UPW : e0 + UPW;
        const bool hp = which ? true : has_prev(r), hn = which ? has_next(r) : true;
        float pa[8], pg[8], ca[8], cg_[8], na[8], ng[8];
        unpack8(*(const v4u*)pc, ca); unpack8(*(const v4u*)(pc + 128), cg_);
        if (hp) { unpack8(*(const v4u*)pp, pa); unpack8(*(const v4u*)(pp + 128), pg); } else {
#pragma unroll
            for (int k = 0; k < 8; ++k) { pa[k] = 0.f; pg[k] = 0.f; } }
        if (hn) { unpack8(*(const v4u*)pn, na); unpack8(*(const v4u*)(pn + 128), ng); } else {
#pragma unroll
            for (int k = 0; k < 8; ++k) { na[k] = 0.f; ng[k] = 0.f; } }
        float o[8];
#pragma unroll
        for (int k = 0; k < 8; ++k) { const float act = cw[c0 + k] * pa[k] + cw[UPW + c0 + k] * ca[k] + cw[2 * UPW + c0 + k] * na[k];
            const float gate = cw[DFF + c0 + k] * pg[k] + cw[UPW + DFF + c0 + k] * cg_[k] + cw[2 * UPW + DFF + c0 + k] * ng[k]; o[k] = silu_f(act) * gate; }
        *(v4u*)(G + (size_t)r * DFF + c0) = pack8(o);
    }
}

__device__ __forceinline__ void ssd_rstd_panel(const Args& a, int pm) {
    const float* SS = (const float*)(a.ws + WS_SS); float* RS = (float*)(a.ws + WS_RS);
    const int t = otid(a.wv); const int row = pm * 256 + (t >> 1), half = t & 1;
    const f32x4* p = (const f32x4*)(SS + (size_t)row * 64 + half * 32);
    f32x4 s = p[0];
#pragma unroll
    for (int k = 1; k < 8; ++k) s = s + p[k];
    float v = (s[0] + s[1]) + (s[2] + s[3]); v += shx(v, 1, t & 63);
    if (!half) RS[row] = rsqrtf(v * (1.f / 2048.f) + EPS);
}

#ifndef MK_SINGLE
#define MK_SINGLE 1
#endif
struct GemmDesc { const bf16* A; const bf16* Bt; int M, N, K; bf16* O; int ldc; int mode; int lda; int ldb; int ksplit; int kso; int rsoff; int coff; int gG; };

__global__ void __launch_bounds__(NTHR, 2) fwd_kernel(Args a_in) {
    extern __shared__ __attribute__((aligned(16))) unsigned char lds_raw[];
    LAS unsigned char* lds = (LAS unsigned char*)lds_raw;
#if MK_SINGLE == 1
    volatile LAS unsigned* bst = (volatile LAS unsigned*)(lds + LDS_BYTES - 64);
    const int wv0 = __builtin_amdgcn_readfirstlane((int)threadIdx.x >> 6);
    { const int t0 = otid(wv0); if (t0 < 16) bst[t0] = 0u; }
    __syncthreads();
    const XcdBarrier xbar = xcd_barrier_post((unsigned*)(a_in.ws + WS_CTL), bst, wv0);
#endif
    const Args& a0 = a_in;
#ifdef TDIAG
    unsigned long long tcat[6] = {0, 0, 0, 0, 0, 0}; unsigned long long tlast = __builtin_amdgcn_s_memrealtime();
#endif
    for (int s = a0.lo; s < a0.hi; ++s) {
        Args a = a0;
        { long oz; asm volatile("s_mov_b64 %0, 0" : "=s"(oz));
#pragma unroll
          for (int q = 0; q < 25; ++q) a.in[q] = (const float*)((const char*)a0.in[q] + oz);
          a.out = (float*)((char*)a0.out + oz); a.ws = a0.ws + oz; a.wv = wv0; }
        unsigned char* ws = a.ws;
        float* XL = a.out; float* XC = (float*)(ws + WS_XC); bf16* H = (bf16*)(ws + WS_H); bf16* Mb = (bf16*)(ws + WS_M); bf16* Mp = (bf16*)(ws + WS_MP);
        const float* MOD = (const float*)(ws + WS_MOD); const float* NW = a.in[I_NORMW];
        int nrep = 1;
#ifdef PROBE_MASK
        if (s == 0 && (PROBE_MASK >> 20 & 1u)) nrep = 2;
        if (s >= 2) { const int pk = (s - 2) % 10, ppar = ((s - 2) / 10) & 1; if ((PROBE_MASK >> (pk + 10 * ppar)) & 1u) nrep = 2; }
#endif
        for (int rep = 0; rep < nrep; ++rep) {
        GemmDesc g0{}, g1{}; int ng = 0;
        int mdl0 = 0, mdl1 = 0, mdnb = 0, mdbi = 0, cvm = 0, cvl = 0, cvnb = 0, cvbi = 0;
        const bool svc = gridDim.x == 256; constexpr int NSV = 24;
#ifndef NO_SIMPLE
        if (s == 0) {
            mdl0 = 0; mdl1 = svc ? 1 : 4; mdnb = (int)gridDim.x; mdbi = (int)blockIdx.x;
            cvm = 3; cvl = 0; cvnb = (int)gridDim.x; cvbi = (int)blockIdx.x;
        } else if (s == 1) {
            rowwise2<3>(a.in[I_X], a.in[I_CTX], nullptr, nullptr, nullptr, nullptr, nullptr, nullptr, H, MOD, 0, 1024, NW, T, a.wv);
        } else {
            const int l = (s - 2) / 10, k = (s - 2) % 10, i = l >> 1; const bool even = (l & 1) == 0, last = (l == 3);
            const int MR = last ? TL : T;
            const bool splitk = !last && gridDim.x == 256;
            const int MG = splitk ? TL : MR;
            switch (k) {
            case 0:
                if (even) { g0 = GemmDesc{H, (const bf16*)(ws + W_IN), T, HYB_INP, D, (bf16*)(ws + WS_P), HYB_INP}; ng = 1; }
                else      { g0 = GemmDesc{H, (const bf16*)(ws + W_IN), T, SSD_INP, D, (bf16*)(ws + WS_ZX), SSD_INP}; ng = 1; }
                break;
            case 1: if (even) prep_even2(a, i); else ssd_conv2(a, i); break;
            case 2:
                if (even) { g0 = GemmDesc{(const bf16*)(ws + WS_CKVN), (const bf16*)(ws + W_UKV), T, KVW, 256, (bf16*)(ws + WS_KV), KVW};
                            g1 = GemmDesc{(const bf16*)(ws + WS_CQN), (const bf16*)(ws + W_UQ), T, QW, 384, (bf16*)(ws + WS_Q), QW}; g1.coff = (gridDim.x == 256) ? 216 : 0; ng = 2; }
                else {
#ifdef SSD_NAIVE
 ssd_scan_naive(a, i, last, lds);
#else
 ssd_scan_mfma(a, i, last, lds);
#endif
 }
                break;
            case 3: if (even) {
#ifdef ATTN_NAIVE
 attn_naive(a, lds);
#else
 attn_mfma(a, lds);
#endif
 } break;
            case 4:
                if (even) { g0 = GemmDesc{(const bf16*)(ws + WS_MIX), (const bf16*)(ws + W_OUT), MG, D, D, Mb, D}; ng = 1;
                            if (splitk) { g1 = GemmDesc{(const bf16*)(ws + WS_MIX) + (size_t)TL * D, (const bf16*)(ws + W_OUT), TC, D, D / 2, Mp, D, 0, D, D, 2, TC * D, 0}; ng = 2; } }
                else      { g0 = GemmDesc{(const bf16*)(ws + WS_XBC), (const bf16*)(ws + W_OUT), MG, D, 2048, Mb, D, 2, 3072}; ng = 1;
                            if (splitk) { g1 = GemmDesc{(const bf16*)(ws + WS_XBC) + (size_t)TL * 3072, (const bf16*)(ws + W_OUT), TC, D, 1024, Mp, D, 2, 3072, 2048, 2, TC * D, TL}; ng = 2; }
                            pg8::StaticOrder S0; pg8::Unit u0; int lastpm = -1; S0.init(MG, D, (int)gridDim.x, (int)blockIdx.x);
                            for (int ui0 = 0; S0.next(ui0, u0); ++ui0) if (u0.pm != lastpm) { ssd_rstd_panel(a, u0.pm); lastpm = u0.pm; }
                            if (splitk) { S0.init(TC, D, (int)gridDim.x, (int)blockIdx.x, 2); lastpm = -1;
                                for (int ui0 = 0; S0.next(ui0, u0); ++ui0) if (u0.pm != lastpm) { ssd_rstd_panel(a, TL / 256 + u0.pm); lastpm = u0.pm; } }
                            asm volatile("s_waitcnt vmcnt(0)" ::: "memory"); __syncthreads(); }
                break;
            case 5:
#ifdef PROBE_ROW2
                if (l > 0) rowwise2<3>(XL, XC, XL, XC, nullptr, nullptr, nullptr, nullptr, H, MOD + (size_t)l * 9 * MODW, 0, 1024, NW + (l * 4 + 0) * D, MR, a.wv);
#endif
                rowwise2<3>(l == 0 ? a.in[I_X] : XL, l == 0 ? a.in[I_CTX] : XC, XL, XC, Mb, splitk ? Mp : nullptr, MOD + (size_t)l * 9 * MODW + 2048, NW + (l * 4 + 1) * D, H, MOD + (size_t)l * 9 * MODW, 3072, 4096, NW + (l * 4 + 2) * D, MR, a.wv); break;
            case 6: { g0 = GemmDesc{H, (const bf16*)(ws + W_UP), MR, UPW, D, (bf16*)(ws + WS_G), DFF, 1}; ng = 1;
                      if (svc && !last) { g0.gG = (int)gridDim.x - NSV;
                          if ((int)blockIdx.x >= g0.gG) { ng = 0; mdl0 = l + 1; mdl1 = l + 2; mdnb = NSV; mdbi = (int)blockIdx.x - g0.gG; cvm = 2; cvl = l + 1; cvnb = NSV; cvbi = mdbi; } } } break;
            case 7:
                if (splitk) { g0 = GemmDesc{(const bf16*)(ws + WS_G), (const bf16*)(ws + W_DN), TL, D, DFF, Mb, D}; ng = 1;
                    pg8::StaticOrder S0; pg8::Unit u0; int lastpm = -1; S0.init(TL, D, (int)gridDim.x, (int)blockIdx.x);
                    for (int ui0 = 0; S0.next(ui0, u0); ++ui0) if (u0.pm != lastpm) { ffn_fixup_panel(a, l, u0.pm); lastpm = u0.pm; }
                    asm volatile("s_waitcnt vmcnt(0)" ::: "memory"); __syncthreads(); }
                break;
            case 8:
                if (splitk) {
                    g0 = GemmDesc{(const bf16*)(ws + WS_G) + (size_t)TL * DFF, (const bf16*)(ws + W_DN), TC, D, DFF / 2, Mp, D, 0, DFF, DFF, 2, TC * D, 0}; ng = 1;
                    { pg8::StaticOrder S0; pg8::Unit u0; int lastpm = -1; S0.init(TC, D, (int)gridDim.x, (int)blockIdx.x, 2);
                      for (int ui0 = 0; S0.next(ui0, u0); ++ui0) if (u0.pm != lastpm) { ffn_fixup_panel(a, l, TL / 256 + u0.pm); lastpm = u0.pm; }
                      asm volatile("s_waitcnt vmcnt(0)" ::: "memory"); __syncthreads(); }
                    rowwise2<3, 1>(XL, XC, XL, XC, Mb, nullptr, MOD + (size_t)l * 9 * MODW + 5120, NW + (l * 4 + 3) * D, H, MOD + (size_t)(l + 1) * 9 * MODW, 0, 1024, NW + ((l + 1) * 4 + 0) * D, TL, a.wv);
                } else { g0 = GemmDesc{(const bf16*)(ws + WS_G), (const bf16*)(ws + W_DN), MR, D, DFF, Mb, D}; ng = 1;
                    pg8::StaticOrder S0; pg8::Unit u0; int lastpm = -1; S0.init(MR, D, (int)gridDim.x, (int)blockIdx.x);
                    for (int ui0 = 0; S0.next(ui0, u0); ++ui0) if (u0.pm != lastpm) { ffn_fixup_panel(a, l, u0.pm); lastpm = u0.pm; }
                    asm volatile("s_waitcnt vmcnt(0)" ::: "memory"); __syncthreads(); }
                break;
            case 9:
                if (splitk) { rowwise2<3, 2>(XL, XC, XL, XC, Mb, Mp, MOD + (size_t)l * 9 * MODW + 5120, NW + (l * 4 + 3) * D, H, MOD + (size_t)(l + 1) * 9 * MODW, 0, 1024, NW + ((l + 1) * 4 + 0) * D, T, a.wv);
                              cvm = svc ? 1 : 3; cvl = l + 1; cvnb = (int)gridDim.x; cvbi = (int)blockIdx.x; }
                else if (!last) { rowwise2<3>(XL, XC, XL, XC, Mb, nullptr, MOD + (size_t)l * 9 * MODW + 5120, NW + (l * 4 + 3) * D, H, MOD + (size_t)(l + 1) * 9 * MODW, 0, 1024, NW + ((l + 1) * 4 + 0) * D, T, a.wv);
                             cvm = 3; cvl = l + 1; cvnb = (int)gridDim.x; cvbi = (int)blockIdx.x; }
                else rowwise2<3>(XL, XC, XL, XC, Mb, nullptr, MOD + (size_t)l * 9 * MODW + 5120, NW + (l * 4 + 3) * D, nullptr, MOD, 0, 0, NW, TL, a.wv);
                break;
            }
        }
#else
        { g0 = GemmDesc{H, (const bf16*)(ws + W_IN), T, a.hi * 256, a.lo * 128, (bf16*)(ws + WS_P), HYB_INP}; ng = 1; }
#endif
        if (mdl1 > mdl0) mod_compute(a, lds, mdl0, mdl1, mdnb, mdbi);
        if (s == 0) rope_tables(a);
        if (cvm) { __syncthreads(); convert_layer(a, cvl, lds, cvm, cvnb, cvbi); }
        for (int gi = 0; gi < ng; ++gi) {
            const bool f = (gi == 0);
            const int lda_ = f ? g0.lda : g1.lda, K_ = f ? g0.K : g1.K, ldb_ = f ? g0.ldb : g1.ldb, ksp_ = f ? g0.ksplit : g1.ksplit;
            pg8::Gemm g{f ? g0.A : g1.A, f ? g0.Bt : g1.Bt, f ? g0.M : g1.M, f ? g0.N : g1.N, K_, a.wv,
#ifdef GDIAG
                (s == GDIAG_STEP) ? (float*)(a0.ws + WS_MOD + 900 * 1024) : nullptr
#else
                nullptr
#endif
                , lda_ ? lda_ : K_, ldb_ ? ldb_ : K_}; const int gG_ = (f ? g0.gG : g1.gG) ? (f ? g0.gG : g1.gG) : (int)gridDim.x;
            pg8::StaticOrder S; S.init(g.M, g.N, gG_, ((int)blockIdx.x + (f ? g0.coff : g1.coff)) % (int)gridDim.x, ksp_ ? ksp_ : 1);
            pg8::EpiFfn E{f ? g0.O : g1.O, f ? g0.ldc : g1.ldc, f ? g0.mode : g1.mode, f ? g0.kso : g1.kso, (const float*)(ws + WS_RS) + (f ? g0.rsoff : g1.rsoff), (bf16*)(ws + WS_UE), a.in[I_FCONV] + (size_t)((s - 2) / 10) * 3 * UPW, (LAS pg8::f32x4*)(lds + 131072), a.wv};
#ifndef NO_GEMM
            pg8::gemm_phase<pg8::EpiFfn, pg8::StaticOrder, true, true>(lds, g, S, E);
#endif
            __syncthreads();
        }
        if (rep + 1 < nrep) __syncthreads();
        }
#ifdef GDIAG
        if (s + 1 == a0.hi) { __syncthreads(); asm volatile("s_waitcnt vmcnt(0)" ::: "memory"); if (blockIdx.x == 0 && otid(wv0) == 0) { const float* dg = (const float*)(a0.ws + WS_MOD + 900 * 1024); a0.out[0] += 25.0f * dg[GDIAG_SEL] / dg[3]; } }
#endif
#ifdef SSD_DIAG
        if (s + 1 == a0.hi) { __syncthreads(); asm volatile("s_waitcnt vmcnt(0)" ::: "memory"); if (blockIdx.x == 0 && otid(wv0) == 0) { const float* dg = (const float*)(a0.ws + WS_MOD + 900 * 1024); a0.out[0] += 25.0f * dg[SSD_DIAG_SEL] / dg[7]; } }
#endif
#ifdef TDIAG
        if (s + 1 == a0.hi) { __syncthreads(); }
#endif
#ifdef BLK_JITTER
        if ((((int)blockIdx.x * 7 + s * 3) % 11) == 0) { for (int q = 0; q < 40; ++q) __builtin_amdgcn_s_sleep(127); }
#endif
        if (s + 1 < a0.hi && !(s >= 2 && (((s - 2) % 10 == 7 && ((s - 2) / 10 == 3 || gridDim.x != 256)) || ((s - 2) % 10 == 3 && (((s - 2) / 10) & 1))))) {
#if MK_SINGLE == 1
            xcd_barrier(xbar);
#ifdef PROBE_BAR2
            xcd_barrier(xbar);
#endif
#elif MK_SINGLE == 2
            cg::this_grid().sync();
#endif
        }
#ifdef TDIAG
        { const unsigned long long tn = __builtin_amdgcn_s_memrealtime(); int cat = 0;
          if (s >= 2) { const int k = (s - 2) % 10, par = ((s - 2) / 10) & 1; cat = (k == 0 || k == 4 || k == 6 || k == 8 || (k == 2 && par == 0)) ? 1 : ((k == 5 || k == 9) ? 2 : ((k == 3 && par == 0) ? 4 : ((k == 2 && par == 1) ? 5 : 3)));
#ifdef TDIAG_K
              cat = (k == TDIAG_K && (TDIAG_PAR == 2 || par == TDIAG_PAR)) ? 1 : 3;
#endif
          }
#pragma unroll
          for (int q = 0; q < 6; ++q) if (q == cat) tcat[q] += tn - tlast;
          tlast = tn;
          if (s + 1 == a0.hi) { asm volatile("s_waitcnt vmcnt(0)" ::: "memory"); if (blockIdx.x == 0 && otid(wv0) == 0) { unsigned long long tt = 0;
#pragma unroll
              for (int q = 0; q < 6; ++q) tt += tcat[q];
              a0.out[0] += (TDIAG == 6) ? (float)tt * (1.0f / 20000.0f) : 25.0f * (float)tcat[TDIAG < 6 ? TDIAG : 0] / (float)tt; } } }
#endif
    }
}

extern "C" void kernel_launch(void* const* d_in, const int* in_sizes, int n_in, void* d_out, int out_size, void* d_ws, size_t ws_size, hipStream_t stream) {
    static int grid = 0;
    if (grid == 0) {
        if (n_in != 25 || out_size != TL * D || ws_size < WS_END) { fprintf(stderr, "kernel_launch: unexpected problem (n_in %d out %d ws %zu need %zu)\n", n_in, out_size, ws_size, (size_t)WS_END); grid = -1; return; }
        if (hipFuncSetAttribute((const void*)fwd_kernel, hipFuncAttributeMaxDynamicSharedMemorySize, LDS_BYTES) != hipSuccess) { fprintf(stderr, "kernel_launch: hipFuncSetAttribute failed\n"); grid = -1; return; }
        int dev = 0, cus = 0, per_cu = 0;
        hipGetDevice(&dev); hipDeviceGetAttribute(&cus, hipDeviceAttributeMultiprocessorCount, dev);
        hipOccupancyMaxActiveBlocksPerMultiprocessor(&per_cu, (const void*)fwd_kernel, NTHR, LDS_BYTES);
        (void)hipGetLastError();
        if (per_cu < 1) { fprintf(stderr, "kernel_launch: occupancy query says %d blocks per CU\n", per_cu); }
        grid = cus;
    }
    if (grid < 0) return;
#if MK_SINGLE == 1
    if (hipMemsetAsync((char*)d_ws + WS_CTL, 0, CTL_ZERO_BYTES, stream) != hipSuccess) { fprintf(stderr, "kernel_launch: memset failed\n"); return; }
#endif
    Args a{};
    for (int i = 0; i < 25; ++i) a.in[i] = (const float*)d_in[i];
    a.out = (float*)d_out; a.ws = (unsigned char*)d_ws;
#if MK_SINGLE
    a.lo = 0; a.hi = NSTEP + 1;
    void* args[] = {&a};
    hipError_t e = hipLaunchCooperativeKernel((const void*)fwd_kernel, dim3(grid), dim3(NTHR), args, LDS_BYTES, stream);
    if (e != hipSuccess) fprintf(stderr, "cooperative launch failed: %s (grid %d)\n", hipGetErrorString(e), grid);
#else
    for (int s = 0; s < NSTEP + 1; ++s) { a.lo = s; a.hi = s + 1; hipLaunchKernelGGL(fwd_kernel, dim3(grid), dim3(NTHR), LDS_BYTES, stream, a); }
#endif
}
```

```cpp
#include <hip/hip_runtime.h>
#include <hip/hip_cooperative_groups.h>
#include <cstdio>
#include <cstdint>
namespace cg = cooperative_groups;
__device__ __forceinline__ int otid(int wv) { int l; asm volatile("v_mbcnt_lo_u32_b32 %0, -1, 0\n\tv_mbcnt_hi_u32_b32 %0, -1, %0" : "=v"(l)); return (wv << 6) | l; }
__device__ __forceinline__ float shx(float v, int mask, int lane) { return __builtin_bit_cast(float, __builtin_amdgcn_ds_bpermute((lane ^ mask) << 2, __builtin_bit_cast(int, v))); }
#define LAS __attribute__((address_space(3)))
typedef float f32x2_cv __attribute__((ext_vector_type(2))); typedef __bf16 bf16x2_cv __attribute__((ext_vector_type(2)));
__device__ __forceinline__ unsigned hw_cvtpk(float lo, float hi) { f32x2_cv v = {lo, hi}; bf16x2_cv b = __builtin_convertvector(v, bf16x2_cv); return __builtin_bit_cast(unsigned, b); }
__device__ __forceinline__ int xblk() { const int c = (int)blockIdx.x; return gridDim.x == 256 ? ((c & 7) * 32 + (c >> 3)) : c; }
#define XB_TMO      128
#define XB_XCNT(j)  (256  + 64 * (j))
#define XB_XSUB(j)  (1280 + 64 * (j))
#define XB_XGEN(j)  (2304 + 64 * (j))
#define XB_TOP      3328
#define XB_TOPGEN   3392
#define XCD_BAR_WORDS 3456
#define XB_SPIN_CAP (1u << 18)

__device__ __forceinline__ unsigned xb_ld(unsigned* p)              { return __hip_atomic_load(p, __ATOMIC_RELAXED, __HIP_MEMORY_SCOPE_AGENT); }
__device__ __forceinline__ unsigned xb_add(unsigned* p, unsigned v) { return __hip_atomic_fetch_add(p, v, __ATOMIC_RELAXED, __HIP_MEMORY_SCOPE_AGENT); }
__device__ __forceinline__ unsigned xb_xcc_id() { return (unsigned)__builtin_amdgcn_s_getreg((3 << 11) | 20) & 0xFu; }
#define XB_SPIN(cond, bar) do { unsigned _sp = 0; while (cond) { __builtin_amdgcn_s_sleep(1); \
    if ((++_sp & 255u) == 0u) { if (xb_ld(&(bar)[XB_TMO])) break; if (_sp > XB_SPIN_CAP) { atomicAdd(&(bar)[XB_TMO], 1u); break; } } } } while (0)

struct XcdBarrier {
    unsigned* bar; unsigned x; int wv;
    volatile LAS unsigned* st;
};

__device__ __forceinline__ XcdBarrier xcd_barrier_post(unsigned* bar, volatile LAS unsigned* st, int wv) {
    XcdBarrier b; b.bar = bar; b.x = xb_xcc_id(); b.st = st; b.wv = wv;
    if (otid(wv) == 0) (void)xb_add(&bar[XB_XCNT(b.x)], 1u);
    return b;
}
__device__ __forceinline__ void xcd_barrier_complete(unsigned* bar, unsigned x, unsigned& nloc, unsigned& nx) {
    const unsigned G = gridDim.x * gridDim.y * gridDim.z;
    unsigned sum, cnt, mine, sp = 0u;
    for (;;) {
        sum = 0u; cnt = 0u; mine = 0u;
#pragma unroll
        for (unsigned j = 0; j < 16; ++j) { const unsigned c = xb_ld(&bar[XB_XCNT(j)]); sum += c; cnt += (c > 0u) ? 1u : 0u; mine = (j == x) ? c : mine; }
        if (sum == G) break;
        __builtin_amdgcn_s_sleep(1);
        if ((++sp & 255u) == 0u) { if (xb_ld(&bar[XB_TMO])) break; if (sp > XB_SPIN_CAP) { atomicAdd(&bar[XB_TMO], 1u); break; } }
    }
    nloc = mine > 0u ? mine : 1u; nx = cnt > 0u ? cnt : 1u;
}

__device__ __forceinline__ void xcd_barrier(const XcdBarrier& b) {
    asm volatile("s_waitcnt vmcnt(0)" ::: "memory");
    __syncthreads();
    if (otid(b.wv) == 0) {
        unsigned* bar = b.bar;
        __builtin_amdgcn_s_waitcnt(0);
        unsigned nloc = b.st[0], nx = b.st[1];
        if (nloc == 0u) { xcd_barrier_complete(bar, b.x, nloc, nx); b.st[0] = nloc; b.st[1] = nx; }
        const unsigned old = xb_add(&bar[XB_XSUB(b.x)], 1u);
        const unsigned gen = old / nloc;
        if (old + 1u == (gen + 1u) * nloc) {
            __builtin_amdgcn_fence(__ATOMIC_RELEASE, "agent");
            asm volatile("s_waitcnt vmcnt(0)" ::: "memory");
            const unsigned og = xb_add(&bar[XB_TOP], 1u);
            const unsigned tg = og / nx;
            if (og + 1u == (tg + 1u) * nx) xb_add(&bar[XB_TOPGEN], 1u);
            else XB_SPIN(xb_ld(&bar[XB_TOPGEN]) == tg, bar);
            __builtin_amdgcn_fence(__ATOMIC_ACQUIRE, "agent");
            xb_add(&bar[XB_XGEN(b.x)], 1u);
            asm volatile("s_waitcnt vmcnt(0)" ::: "memory");
        } else {
            XB_SPIN(xb_ld(&bar[XB_XGEN(b.x)]) == gen, bar);
            __builtin_amdgcn_fence(__ATOMIC_ACQUIRE, "agent");
            asm volatile("s_waitcnt vmcnt(0)" ::: "memory");
        }
    }
    __syncthreads();
}
namespace pg8 {
#define PG8_LAS __attribute__((address_space(3)))
typedef unsigned short bf16_t;
typedef short bf16x8 __attribute__((ext_vector_type(8)));
typedef float f32x4 __attribute__((ext_vector_type(4)));
typedef unsigned u32x4 __attribute__((ext_vector_type(4)));
constexpr int BM = 256, BK = 64, HALF = 128, HTB = HALF * BK * 2  , STAGE_BYTES = 8 * HTB, NXCD = 8, WGM = 8;

__host__ __device__ __forceinline__ int lds_byte(int r, int c) { const int st = (r >> 4) * 2 + (c >> 5), rr = r & 15, cc = c & 31, ob = rr * 64 + cc * 2; return st * 1024 + (ob ^ (((ob >> 9) & 1) << 5)); }
__host__ __device__ __forceinline__ void stage_rc(int b, int& R, int& C) { const int st = b / 1024, sb = b % 1024, swz = sb ^ (((sb >> 9) & 1) << 5); R = (st >> 1) * 16 + swz / 64; C = (st & 1) * 32 + (swz % 64) / 2; }
__host__ __device__ __forceinline__ int perm32(int rho) { const int n = rho >> 4, i = rho & 15; return 8 * (i >> 2) + 4 * n + (i & 3); }

struct Unit { int pm, pn, kq; };
struct Gemm { const bf16_t* A; const bf16_t* Bt; int M, N, K, wv; float* dg; int lda, ldb; };

struct StaticOrder {
    int nM, nN, nwg, G, c, wgm, nNr;
    __host__ __device__ void init(int M, int N, int G_, int c_, int ksplit = 1) { nM = M / BM; nNr = N / BM; nN = nNr * ksplit; nwg = nM * nN; G = G_; c = c_; wgm = (nM % NXCD == 0) ? nM / NXCD : WGM; }
    __host__ __device__ bool next(int i, Unit& u) const {
        const long L = (long)i * G + c; if (L >= nwg) return false;
        int wgid = (int)L; { const int q = nwg / NXCD, r = nwg % NXCD, xcd = wgid % NXCD, off = wgid / NXCD; wgid = (xcd < r ? xcd * (q + 1) : r * (q + 1) + (xcd - r) * q) + off; }
        const int nig = wgm * nN, gid = wgid / nig, fm = gid * wgm, gsz = (nM - fm) < wgm ? (nM - fm) : wgm;
        u.pm = fm + ((wgid % nig) % gsz); const int pv = (wgid % nig) / gsz; u.kq = pv / nNr; u.pn = pv % nNr;
        if (nM == 9 * NXCD) { const int x_ = u.pm / 9, j_ = u.pm % 9; u.pm = j_ < 8 ? 8 * x_ + j_ : 8 * NXCD + x_; }
        return true;
    }
    __device__ __forceinline__ void a_ready(const Unit&) const {}
    __device__ __forceinline__ void done(const Unit&) const {}
};

__device__ __forceinline__ unsigned cvt_pk_bf16(float lo, float hi) { return hw_cvtpk(lo, hi); }
struct EpiStore {
    static constexpr bool PERM = true, AFTER_DRAIN = false;
    bf16_t* O; int ldc;
    __device__ __forceinline__ void operator()(const f32x4 (&acc)[2][2][4][2], const Unit& u, int wr, int wc, int fr, int fq) const {
        const int row0 = u.pm * BM + wr * 64 + fr; const int col0 = u.pn * BM + wc * 32 + 8 * fq;
#pragma unroll
        for (int ai = 0; ai < 2; ++ai)
#pragma unroll
            for (int m = 0; m < 4; ++m) { bf16_t* rowp = O + (size_t)(row0 + ai * HALF + m * 16) * ldc + col0;
#pragma unroll
                for (int bj = 0; bj < 2; ++bj) { const f32x4 v0 = acc[ai][bj][m][0], v1 = acc[ai][bj][m][1];
                    u32x4 w; w.x = cvt_pk_bf16(v0[0], v0[1]); w.y = cvt_pk_bf16(v0[2], v0[3]); w.z = cvt_pk_bf16(v1[0], v1[1]); w.w = cvt_pk_bf16(v1[2], v1[3]);
                    *(u32x4*)(rowp + bj * HALF) = w; } }
    }
};

template <int CTRL> __device__ __forceinline__ float dpprot(float src) { return __builtin_bit_cast(float, __builtin_amdgcn_mov_dpp(__builtin_bit_cast(int, src), CTRL, 0xf, 0xf, true)); }
template <int CTRL> __device__ __forceinline__ float dppf(float old, float src) { return __builtin_bit_cast(float, __builtin_amdgcn_update_dpp(__builtin_bit_cast(int, old), __builtin_bit_cast(int, src), CTRL, 0xf, 0xf, false)); }
#define PG8_DPP4(dst, oldv, srcv, ctrl) do { dst[0] = dppf<ctrl>(oldv[0], srcv[0]); dst[1] = dppf<ctrl>(oldv[1], srcv[1]); dst[2] = dppf<ctrl>(oldv[2], srcv[2]); dst[3] = dppf<ctrl>(oldv[3], srcv[3]); } while (0)
struct EpiFfn {
    static constexpr bool PERM = true, AFTER_DRAIN = false;
    bf16_t* O; int ldc; int mode;
    int kso;
    const float* rs;
    bf16_t* Ue; const float* cw; PG8_LAS f32x4* ex; int wv;
    __device__ __forceinline__ void operator()(const f32x4 (&acc)[2][2][4][2], const Unit& u, int wr, int wc, int fr_in, int fq_in) const {
        (void)fr_in; (void)fq_in; const int lane_e = otid(wv) & 63; const int fr = lane_e & 15, fq = lane_e >> 4;
        if (mode != 1) {
            const int row0 = u.pm * BM + wr * 64 + fr; const int col0 = u.pn * BM + wc * 32 + 8 * fq;
#pragma unroll
            for (int ai = 0; ai < 2; ++ai)
#pragma unroll
                for (int m = 0; m < 4; ++m) { bf16_t* rowp = O + (size_t)u.kq * kso + (size_t)(row0 + ai * HALF + m * 16) * ldc + col0;
                    const float rsc = (mode == 2) ? rs[row0 + ai * HALF + m * 16] : 1.0f;
#pragma unroll
                    for (int bj = 0; bj < 2; ++bj) { const f32x4 v0 = acc[ai][bj][m][0] * rsc, v1 = acc[ai][bj][m][1] * rsc;
                        u32x4 w; w.x = cvt_pk_bf16(v0[0], v0[1]); w.y = cvt_pk_bf16(v0[2], v0[3]); w.z = cvt_pk_bf16(v1[0], v1[1]); w.w = cvt_pk_bf16(v1[2], v1[3]);
                        *(u32x4*)(rowp + bj * HALF) = w; } }
            return;
        }
        const int chl = wc * 32 + 8 * fq, ch = u.pn * 128 + chl;
        f32x4 wA[3][2], wG[3][2];
#pragma unroll
        for (int t = 0; t < 3; ++t)
#pragma unroll
            for (int n = 0; n < 2; ++n) { wA[t][n] = *(const f32x4*)(cw + t * 5632 + ch + 4 * n); wG[t][n] = *(const f32x4*)(cw + t * 5632 + 2816 + ch + 4 * n); }
#define PG8_EX(blk, fl, bj, n) ex[((((blk) * 2 + (fl)) * 2 + (bj)) * 2 + (n)) * 16 + wc * 4 + fq]
#pragma unroll
        for (int ai = 0; ai < 2; ++ai) { const int blk = ai * 2 + wr;
            const bool lastr = fr == 15;
#pragma unroll
            for (int bj = 0; bj < 2; ++bj)
#pragma unroll
                for (int n = 0; n < 2; ++n) { const f32x4 a0 = acc[ai][bj][0][n], a3 = acc[ai][bj][3][n]; f32x4 v;
#pragma unroll
                    for (int e = 0; e < 4; ++e) v[e] = lastr ? a3[e] : a0[e];
                    if (fr == 0 || lastr) ex[((((blk) * 2 + (lastr ? 1 : 0)) * 2 + bj) * 2 + n) * 16 + wc * 4 + fq] = v; } }
        asm volatile("s_waitcnt lgkmcnt(0)" ::: "memory"); __builtin_amdgcn_s_barrier(); asm volatile("" ::: "memory");
        const f32x4 zero4 = (f32x4){0.f, 0.f, 0.f, 0.f}; const bool is15 = fr == 15, is0 = fr == 0;
#pragma unroll
        for (int ai = 0; ai < 2; ++ai) { const int blk = ai * 2 + wr;
            f32x4 pb[2][2], nb[2][2];
#pragma unroll
            for (int bj = 0; bj < 2; ++bj)
#pragma unroll
                for (int n = 0; n < 2; ++n) { pb[bj][n] = blk > 0 ? PG8_EX(blk - 1, 1, bj, n) : zero4; nb[bj][n] = blk < 3 ? PG8_EX(blk + 1, 0, bj, n) : zero4; }
#pragma unroll
            for (int m = 0; m < 4; ++m) {
                f32x4 cv[2][2];
#pragma unroll
                for (int bj = 0; bj < 2; ++bj)
#pragma unroll
                    for (int n = 0; n < 2; ++n) { const f32x4 cur = acc[ai][bj][m][n];
                        const f32x4 lo = (m == 0) ? pb[bj][n] : acc[ai][bj][m > 0 ? m - 1 : 0][n];
                        const f32x4 hi = (m == 3) ? nb[bj][n] : acc[ai][bj][m < 3 ? m + 1 : 3][n];
                        f32x4 prev, next;
#pragma unroll
                        for (int e = 0; e < 4; ++e) { prev[e] = dpprot<0x121>(is15 ? lo[e] : cur[e]);
                                                      next[e] = dpprot<0x12F>(is0 ? hi[e] : cur[e]); }
                        const f32x4 w0 = bj ? wG[0][n] : wA[0][n], w1 = bj ? wG[1][n] : wA[1][n], w2 = bj ? wG[2][n] : wA[2][n];
                        cv[bj][n] = w0 * prev + w1 * cur + w2 * next; }
                u32x4 w; float g[8];
#pragma unroll
                for (int n = 0; n < 2; ++n)
#pragma unroll
                    for (int e = 0; e < 4; ++e) { const float av = cv[0][n][e]; g[4 * n + e] = av * __builtin_amdgcn_rcpf(1.f + __expf(-av)) * cv[1][n][e]; }
                w.x = cvt_pk_bf16(g[0], g[1]); w.y = cvt_pk_bf16(g[2], g[3]); w.z = cvt_pk_bf16(g[4], g[5]); w.w = cvt_pk_bf16(g[6], g[7]);
                *(u32x4*)(O + (size_t)(u.pm * BM + ai * HALF + wr * 64 + m * 16 + fr) * 2816 + ch) = w;
            } }
#undef PG8_EX
        { const int slot = (wr == 0) ? (fr == 0 ? 0 : (fr == 1 ? 1 : -1)) : (fr == 14 ? 2 : (fr == 15 ? 3 : -1));
          if (slot >= 0) { bf16_t* up = Ue + ((size_t)(u.pm * 4 + slot) * 5632) + u.pn * 256 + chl;
#pragma unroll
              for (int bj = 0; bj < 2; ++bj) { const f32x4 a0 = acc[0][bj][0][0], a1 = acc[0][bj][0][1], b0 = acc[1][bj][3][0], b1 = acc[1][bj][3][1]; f32x4 v0, v1;
#pragma unroll
                  for (int e = 0; e < 4; ++e) { v0[e] = wr ? b0[e] : a0[e]; v1[e] = wr ? b1[e] : a1[e]; }
                  u32x4 w; w.x = cvt_pk_bf16(v0[0], v0[1]); w.y = cvt_pk_bf16(v0[2], v0[3]); w.z = cvt_pk_bf16(v1[0], v1[1]); w.w = cvt_pk_bf16(v1[2], v1[3]);
                  *(u32x4*)(up + bj * HALF) = w; } } }
    }
};
template <class Epi, class Sched, bool ALIGN_EPI = false, bool SP2 = false>
__device__ __forceinline__ void gemm_phase(PG8_LAS unsigned char* lds, const Gemm g, const Sched& S, const Epi& E) {
    const int tid = otid(g.wv), wid = g.wv, lane = tid & 63, wr = wid >> 2, wc = wid & 3, fr = lane & 15, fq = lane >> 4;
    const int K = g.K, nt = K / BK;
    unsigned voffA[2], voffB[2];
#pragma unroll
    for (int i = 0; i < 2; ++i) { int R, C; stage_rc(tid * 16 + i * 8192, R, C); const int Rb = Epi::PERM ? ((R & ~31) + perm32(R & 31)) : R;
        voffA[i] = (unsigned)(R * g.lda + C) * 2u; voffB[i] = (unsigned)(Rb * g.ldb + C) * 2u; }
    const size_t kstep = (size_t)(BK * 2);
    const size_t hstep = (size_t)HALF * g.ldb * 2;
    const size_t tstep = 2 * hstep;
    const size_t hstepA = (size_t)HALF * g.lda * 2, tstepA = 2 * hstepA;
    const unsigned ldsw = (unsigned)wid * 1024u;
    const int aoff = lds_byte(wr * 64 + fr, fq * 8), boff = lds_byte(wc * 32 + fr, fq * 8);
#define PG8_SA(b, h) (((b) * 2 + (h)) * HTB)
#define PG8_SB(b, h) ((4 + (b) * 2 + (h)) * HTB)
#define PG8_STAGE(bufoff, gbase, voff) do { _Pragma("unroll") for (int _i = 0; _i < 2; ++_i) \
        __builtin_amdgcn_global_load_lds((const unsigned*)((const char*)(gbase) + (voff)[_i]), (PG8_LAS unsigned*)(lds + (bufoff) + ldsw + _i * 8192), 16, 0, 0); } while (0)
#define PG8_LDA(dst, b, h) do { _Pragma("unroll") for (int m = 0; m < 4; ++m) _Pragma("unroll") for (int k = 0; k < 2; ++k) dst[m][k] = *(const PG8_LAS bf16x8*)(lds + PG8_SA(b, h) + aoff + m * 2048 + k * 1024); } while (0)
#define PG8_LDB(dst, b, h) do { _Pragma("unroll") for (int n = 0; n < 2; ++n) _Pragma("unroll") for (int k = 0; k < 2; ++k) dst[n][k] = *(const PG8_LAS bf16x8*)(lds + PG8_SB(b, h) + boff + n * 2048 + k * 1024); } while (0)
#define PG8_MMA(ai, bj, At, Bt) do { __builtin_amdgcn_s_setprio(1); _Pragma("unroll") for (int m = 0; m < 4; ++m) _Pragma("unroll") for (int n = 0; n < 2; ++n) _Pragma("unroll") for (int k = 0; k < 2; ++k) \
        acc[ai][bj][m][n] = __builtin_amdgcn_mfma_f32_16x16x32_bf16(Bt[n][k], At[m][k], acc[ai][bj][m][n], 0, 0, 0); __builtin_amdgcn_s_setprio(0); } while (0)
#define PG8_WAIT_V(n) asm volatile("s_waitcnt vmcnt(" #n ")" ::: "memory")
#define PG8_WAIT_L(n) asm volatile("s_waitcnt lgkmcnt(" #n ")" ::: "memory")
#define PG8_BAR __builtin_amdgcn_s_barrier()
#define PG8_SCHED __builtin_amdgcn_sched_barrier(0)
    Unit cur, nxt; int ui = 0;
#ifdef GDIAG
    unsigned gd0 = 0, gd1 = 0, gd2 = 0; const unsigned gstart = (unsigned)__builtin_amdgcn_s_memtime();
#endif
    if (!S.next(0, cur)) return;
    f32x4 acc[2][2][4][2];
#pragma unroll
    for (int a = 0; a < 2; ++a)
#pragma unroll
        for (int b = 0; b < 2; ++b)
#pragma unroll
            for (int m = 0; m < 4; ++m)
#pragma unroll
                for (int n = 0; n < 2; ++n) acc[a][b][m][n] = (f32x4){0.f, 0.f, 0.f, 0.f};
    bf16x8 At[4][2], B0[2][2], B1[2][2];
    const size_t kqstep = (size_t)K * 2;
    const char* cA = (const char*)g.A + (size_t)cur.pm * tstepA + (size_t)cur.kq * kqstep; const char* cB = (const char*)g.Bt + (size_t)cur.pn * tstep + (size_t)cur.kq * kqstep;
    S.a_ready(cur);
    if constexpr (SP2) {
        PG8_STAGE(PG8_SB(0, 0), cB, voffB); PG8_STAGE(PG8_SB(0, 1), cB + hstep, voffB); PG8_STAGE(PG8_SA(0, 0), cA, voffA); PG8_STAGE(PG8_SA(0, 1), cA + hstepA, voffA);
        if (wr == 1) PG8_BAR;
        PG8_WAIT_V(2); PG8_BAR;
        PG8_STAGE(PG8_SB(1, 0), cB + kstep, voffB); PG8_STAGE(PG8_SA(1, 0), cA + kstep, voffA); PG8_STAGE(PG8_SB(1, 1), cB + hstep + kstep, voffB);
        PG8_WAIT_V(6); PG8_BAR;
    } else {
        PG8_STAGE(PG8_SB(0, 0), cB, voffB); PG8_STAGE(PG8_SA(0, 0), cA, voffA); PG8_STAGE(PG8_SB(0, 1), cB + hstep, voffB); PG8_STAGE(PG8_SA(0, 1), cA + hstepA, voffA);
        if (wr == 1) PG8_BAR;
        PG8_WAIT_V(4); PG8_BAR;
        PG8_STAGE(PG8_SB(1, 0), cB + kstep, voffB); PG8_STAGE(PG8_SA(1, 0), cA + kstep, voffA); PG8_STAGE(PG8_SB(1, 1), cB + hstep + kstep, voffB);
        PG8_WAIT_V(6); PG8_BAR;
    }
    for (;;) {
        const bool has_next = S.next(ui + 1, nxt);
        const char* nA = has_next ? (const char*)g.A + (size_t)nxt.pm * tstepA + (size_t)nxt.kq * kqstep : cA; const char* nB = has_next ? (const char*)g.Bt + (size_t)nxt.pn * tstep + (size_t)nxt.kq * kqstep : cB;
#ifdef GDIAG
        unsigned gt0 = (unsigned)__builtin_amdgcn_s_memtime();
#endif
        for (int t = 0; t < nt; t += 2) {
            const bool last = (t == nt - 2);
            const char* a1 = cA + (size_t)(t + 1) * kstep;
            const char* a2 = last ? nA : cA + (size_t)(t + 2) * kstep; const char* b2 = last ? nB : cB + (size_t)(t + 2) * kstep;
            const char* a3 = a2 + kstep; const char* b3 = b2 + kstep;
            if (last && has_next) S.a_ready(nxt);
            if constexpr (SP2) {
            PG8_LDB(B0, 0, 0); PG8_LDB(B1, 0, 1); PG8_SCHED; PG8_LDA(At, 0, 0); PG8_STAGE(PG8_SA(1, 1), a1 + hstepA, voffA);
            PG8_WAIT_V(8); PG8_WAIT_L(0); PG8_BAR; PG8_MMA(0, 0, At, B0); PG8_MMA(0, 1, At, B1); PG8_BAR; PG8_SCHED;
            PG8_LDA(At, 0, 1); PG8_STAGE(PG8_SB(0, 0), b2, voffB); PG8_STAGE(PG8_SB(0, 1), b2 + hstep, voffB); PG8_STAGE(PG8_SA(0, 0), a2, voffA);
            PG8_WAIT_V(8); PG8_WAIT_L(0); PG8_BAR; PG8_MMA(1, 0, At, B0); PG8_MMA(1, 1, At, B1); PG8_BAR; PG8_SCHED;
            PG8_LDB(B0, 1, 0); PG8_LDB(B1, 1, 1); PG8_SCHED; PG8_LDA(At, 1, 0); PG8_STAGE(PG8_SA(0, 1), a2 + hstepA, voffA);
            PG8_WAIT_V(8); PG8_WAIT_L(0); PG8_BAR; PG8_MMA(0, 0, At, B0); PG8_MMA(0, 1, At, B1); PG8_BAR; PG8_SCHED;
            PG8_LDA(At, 1, 1); PG8_STAGE(PG8_SB(1, 0), b3, voffB); PG8_STAGE(PG8_SB(1, 1), b3 + hstep, voffB); PG8_STAGE(PG8_SA(1, 0), a3, voffA);
            PG8_WAIT_V(8); PG8_WAIT_L(0); PG8_BAR; PG8_MMA(1, 0, At, B0); PG8_MMA(1, 1, At, B1); PG8_BAR; PG8_SCHED;
            } else {
            PG8_LDB(B0, 0, 0); PG8_SCHED; PG8_LDA(At, 0, 0); PG8_STAGE(PG8_SA(1, 1), a1 + hstepA, voffA);
            PG8_WAIT_L(8); PG8_BAR; PG8_WAIT_L(0); PG8_MMA(0, 0, At, B0); PG8_BAR; PG8_SCHED;
            PG8_LDB(B1, 0, 1); PG8_STAGE(PG8_SB(0, 0), b2, voffB);
            PG8_BAR; PG8_WAIT_L(0); PG8_MMA(0, 1, At, B1); PG8_BAR;
            PG8_LDA(At, 0, 1); PG8_STAGE(PG8_SA(0, 0), a2, voffA);
            PG8_BAR; PG8_WAIT_L(0); PG8_MMA(1, 0, At, B0); PG8_BAR; PG8_SCHED;
            PG8_STAGE(PG8_SB(0, 1), b2 + hstep, voffB);
            PG8_WAIT_V(6); PG8_BAR; PG8_MMA(1, 1, At, B1); PG8_BAR;
            PG8_LDB(B0, 1, 0); PG8_SCHED; PG8_LDA(At, 1, 0); PG8_STAGE(PG8_SA(0, 1), a2 + hstepA, voffA);
            PG8_WAIT_L(8); PG8_BAR; PG8_WAIT_L(0); PG8_MMA(0, 0, At, B0); PG8_BAR; PG8_SCHED;
            PG8_LDB(B1, 1, 1); PG8_STAGE(PG8_SB(1, 0), b3, voffB);
            PG8_BAR; PG8_WAIT_L(0); PG8_MMA(0, 1, At, B1); PG8_BAR;
            PG8_LDA(At, 1, 1); PG8_STAGE(PG8_SA(1, 0), a3, voffA);
            PG8_BAR; PG8_WAIT_L(0); PG8_MMA(1, 0, At, B0); PG8_BAR; PG8_SCHED;
            PG8_STAGE(PG8_SB(1, 1), b3 + hstep, voffB);
            PG8_WAIT_V(6); PG8_BAR; PG8_MMA(1, 1, At, B1); PG8_BAR;
            }
        }
#ifdef GDIAG
        { const unsigned n_ = (unsigned)__builtin_amdgcn_s_memtime(); gd0 += n_ - gt0; gt0 = n_; }
#endif
        if constexpr (ALIGN_EPI) { if (wr == 0) PG8_BAR; }
#ifdef GDIAG
        { const unsigned n_ = (unsigned)__builtin_amdgcn_s_memtime(); gd1 += n_ - gt0; gt0 = n_; }
#endif
        if constexpr (!Epi::AFTER_DRAIN) { E(acc, cur, wr, wc, fr, fq); S.done(cur); }
#ifdef GDIAG
        { const unsigned n_ = (unsigned)__builtin_amdgcn_s_memtime(); gd2 += n_ - gt0; gt0 = n_; }
#endif
        if (!has_next) break;
#pragma unroll
        for (int a = 0; a < 2; ++a)
#pragma unroll
            for (int b = 0; b < 2; ++b)
#pragma unroll
                for (int m = 0; m < 4; ++m)
#pragma unroll
                    for (int n = 0; n < 2; ++n) acc[a][b][m][n] = (f32x4){0.f, 0.f, 0.f, 0.f};
        cur = nxt; cA = nA; cB = nB; ++ui;
        if constexpr (ALIGN_EPI) { if (wr == 1) PG8_BAR; }
    }
#ifdef GDIAG
    if (g.dg && blockIdx.x == 0 && wid == GDIAG_WAVE && lane == 0) { const unsigned tot = (unsigned)__builtin_amdgcn_s_memtime() - gstart; g.dg[0] = (float)gd0; g.dg[1] = (float)gd1; g.dg[2] = (float)gd2; g.dg[3] = (float)tot; }
#endif
    PG8_WAIT_V(0);
    if constexpr (!ALIGN_EPI) { if (wr == 0) PG8_BAR; }
    PG8_BAR;
    if constexpr (Epi::AFTER_DRAIN) { E.fused(acc, cur, wr, wc, fr, fq, lds, wid, lane); S.done(cur); }
#undef PG8_SA
#undef PG8_SB
#undef PG8_STAGE
#undef PG8_LDA
#undef PG8_LDB
#undef PG8_MMA
#undef PG8_WAIT_V
#undef PG8_WAIT_L
#undef PG8_BAR
#undef PG8_SCHED
}
}

typedef unsigned short bf16;
typedef unsigned v4u __attribute__((ext_vector_type(4)));
typedef unsigned v2u __attribute__((ext_vector_type(2)));
typedef float f32x4 __attribute__((ext_vector_type(4)));
constexpr int NWAVES = 8, NTHR = 512;
constexpr int D = 1024, NB = 8, SEQ = 2048, CTXL = 256, TL = NB * SEQ, TC = NB * CTXL, T = TL + TC;
constexpr int HYB_IN = 2208, HYB_INP = 2304, SSD_IN = 5184, SSD_INP = 5376, DFF = 2816, UPW = 5632;
constexpr int QW = 768, KVW = 1024, MODW = 6144;
constexpr float EPS = 1e-6f;
constexpr int NSTEP = 1 + 4 * 10;
constexpr float ATT_SCALE_LOG2E = 0.10206207261596577f * 1.4426950408889634f;

constexpr size_t MiB = 1u << 20;
constexpr size_t WS_CTL = 0, CTL_ZERO_BYTES = 64 * 1024;
constexpr size_t WS_MOD = 1 * MiB;
constexpr size_t WS_ROPE = 2 * MiB;
constexpr size_t W_UP = 3 * MiB;
constexpr size_t W_DN = W_UP + (size_t)UPW * D * 2;
constexpr size_t W_IN = W_DN + (size_t)D * DFF * 2;
constexpr size_t W_OUT = W_IN + (size_t)SSD_INP * D * 2;
constexpr size_t W_UQ = W_OUT + (size_t)D * 2048 * 2;
constexpr size_t W_UKV = W_UQ + (size_t)QW * 384 * 2;
constexpr size_t W_END = W_UKV + (size_t)KVW * 256 * 2;
constexpr size_t WS_XC = 36 * MiB;
constexpr size_t WS_H = 44 * MiB;
constexpr size_t WS_DT = WS_H, WS_AA = WS_H + (size_t)T * 64 * 4;
constexpr size_t WS_SS = WS_AA + (size_t)T * 64 * 4;
constexpr size_t WS_RS = 512 * 1024;
constexpr size_t WS_BIG = 80 * MiB;
constexpr size_t WS_M = WS_BIG;
constexpr size_t WS_P = WS_BIG;
constexpr size_t WS_Q = WS_BIG + 81 * MiB;
constexpr size_t WS_KV = WS_BIG + 108 * MiB;
constexpr size_t WS_KR = WS_BIG + 144 * MiB;
constexpr size_t WS_CQN = WS_BIG + 146 * MiB;
constexpr size_t WS_CKVN = WS_BIG + 160 * MiB;
constexpr size_t WS_MIX = WS_BIG + 170 * MiB;
constexpr size_t WS_MP = WS_BIG + 81 * MiB;
constexpr size_t WS_U = WS_BIG;
constexpr size_t WS_G = WS_BIG + 198 * MiB;
constexpr size_t WS_ZX = WS_BIG;
constexpr size_t WS_XBC = WS_BIG + 189 * MiB;
constexpr size_t WS_UE = WS_BIG + 297 * MiB;
constexpr size_t WS_END = WS_UE + 4 * MiB;
static_assert(W_END <= WS_XC && WS_G + (size_t)T * DFF * 2 <= WS_END && WS_XBC + (size_t)T * 3072 * 2 <= WS_END && WS_ZX + (size_t)T * SSD_INP * 2 <= WS_XBC, "ws map");
static_assert(WS_SS + (size_t)T * 64 * 4 <= WS_BIG && CTL_ZERO_BYTES <= WS_RS && WS_RS + (size_t)T * 4 <= WS_MOD && WS_MIX + (size_t)T * D * 2 <= WS_END && WS_Q + (size_t)T * QW * 2 <= WS_KV && WS_P + (size_t)T * HYB_INP * 2 <= WS_Q, "ws map 2");
constexpr int LDS_BYTES = 147456;

struct Args { const float* in[25]; float* out; unsigned char* ws; int lo, hi; int wv, pad; };
enum { I_X = 0, I_C, I_CTX, I_CCTX, I_MODW, I_MODB, I_NORMW, I_WUP, I_FCONV, I_WDN, I_HIN, I_QNORM, I_KVNORM, I_WUQ, I_WUKV, I_SCONV, I_HOUT, I_SIN, I_SCONVW, I_SCONVB, I_ALOG, I_DTB, I_SD, I_SNORM, I_SOUT };

__device__ __forceinline__ unsigned f2bf(float f) { unsigned u = __builtin_bit_cast(unsigned, f); return (u + 0x7fffu + ((u >> 16) & 1u)) >> 16; }
__device__ __forceinline__ unsigned pk2(float lo, float hi) { return hw_cvtpk(lo, hi); }
__device__ __forceinline__ float bflo(unsigned u) { return __builtin_bit_cast(float, u << 16); }
__device__ __forceinline__ float bfhi(unsigned u) { return __builtin_bit_cast(float, u & 0xffff0000u); }
__device__ __forceinline__ float bf1(bf16 b) { return __builtin_bit_cast(float, (unsigned)b << 16); }
__device__ __forceinline__ float silu_f(float x) { return x * __builtin_amdgcn_rcpf(1.f + __expf(-x)); }
__device__ __forceinline__ float wave_sum(float v, int lane) {
#pragma unroll
    for (int o = 1; o < 64; o <<= 1) v += shx(v, o, lane);
    return v;
}
__device__ __forceinline__ void unpack8(const v4u w, float (&f)[8]) { f[0] = bflo(w.x); f[1] = bfhi(w.x); f[2] = bflo(w.y); f[3] = bfhi(w.y); f[4] = bflo(w.z); f[5] = bfhi(w.z); f[6] = bflo(w.w); f[7] = bfhi(w.w); }
__device__ __forceinline__ v4u pack8(const float (&f)[8]) { v4u w; w.x = pk2(f[0], f[1]); w.y = pk2(f[2], f[3]); w.z = pk2(f[4], f[5]); w.w = pk2(f[6], f[7]); return w; }
__device__ __forceinline__ bool has_prev(int r) { return r < TL ? (r & (SEQ - 1)) != 0 : ((r - TL) & (CTXL - 1)) != 0; }
__device__ __forceinline__ bool has_next(int r) { return r < TL ? (r & (SEQ - 1)) != SEQ - 1 : ((r - TL) & (CTXL - 1)) != CTXL - 1; }

__device__ __forceinline__ void mod_compute(const Args& a, LAS unsigned char* lds) {
    LAS float* sc = (LAS float*)lds;
    LAS float* red = (LAS float*)(lds + 36864);
    const int tid = otid(a.wv);
    float* MOD = (float*)(a.ws + WS_MOD);
    for (int i = tid; i < 9 * 1024; i += NTHR) { const int c = i >> 10, k = i & 1023; const float v = c < 8 ? a.in[I_C][c * 1024 + k] : a.in[I_CCTX][k]; sc[i] = silu_f(v); }
    __syncthreads();
    for (int item = blockIdx.x; item < 4 * 96; item += gridDim.x) {
        const int l = item / 96, cb = item % 96;
        const float* W = a.in[I_MODW] + (size_t)l * 1024 * MODW + cb * 64;
        const int cgp = tid & 15, kg = tid >> 4;
        float acc[9][4];
#pragma unroll
        for (int c = 0; c < 9; ++c) { acc[c][0] = 0.f; acc[c][1] = 0.f; acc[c][2] = 0.f; acc[c][3] = 0.f; }
#pragma unroll 8
        for (int kk = 0; kk < 32; ++kk) { const int k = kg * 32 + kk; const f32x4 w = *(const f32x4*)(W + (size_t)k * MODW + cgp * 4);
#pragma unroll
            for (int c = 0; c < 9; ++c) { const float s = sc[c * 1024 + k]; acc[c][0] += s * w[0]; acc[c][1] += s * w[1]; acc[c][2] += s * w[2]; acc[c][3] += s * w[3]; } }
#pragma unroll
        for (int c = 0; c < 9; ++c)
#pragma unroll
            for (int j = 0; j < 4; ++j) red[kg * 576 + c * 64 + cgp * 4 + j] = acc[c][j];
        __syncthreads();
        for (int o = tid; o < 576; o += NTHR) { float s = 0.f;
            for (int g = 0; g < 32; ++g) s += red[g * 576 + o];
            const int c = o >> 6, col = o & 63; MOD[(size_t)(l * 9 + c) * MODW + cb * 64 + col] = s + a.in[I_MODB][l * MODW + cb * 64 + col]; }
        __syncthreads();
    }
}
__device__ __forceinline__ void rope_tables(const Args& a) {
    float* ct = (float*)(a.ws + WS_ROPE); float* st = ct + SEQ * 16;
    for (int i = blockIdx.x * NTHR + otid(a.wv); i < SEQ * 16; i += gridDim.x * NTHR) {
        const int t = i >> 4, j = i & 15; const int pos = j < 8 ? (t >> 6) : (t & 63); const int f = j & 7;
        const float i0 = (f & 1) ? 0.31622776601683794f : 1.0f; const int e = f >> 1; const float i1 = e == 0 ? 1.0f : (e == 1 ? 0.1f : (e == 2 ? 0.01f : 0.001f));
        const float inv = i0 * i1; const float ang = (float)pos * inv;
        ct[i] = __cosf(ang); st[i] = __sinf(ang); }
}
__device__ __forceinline__ void transpose_item(const float* W, int K, int N, bf16* WT, LAS float* scr, int item, int lane, bool ffn_perm, const float* ksc) {
    const int nblk = N / 32, kb = item / nblk, nb = item % nblk, k0 = 64 * kb, n0 = 32 * nb;
    const int o0 = ffn_perm ? ((n0 % DFF) / 128) * 256 + (n0 / DFF) * 128 + (n0 % 128) : n0;
    float wv_[32];
#pragma unroll
    for (int i = 0; i < 32; ++i) wv_[i] = W[(size_t)(k0 + 2 * i + (lane >> 5)) * N + n0 + (lane & 31)];
    if (ksc) {
#pragma unroll
        for (int i = 0; i < 32; ++i) wv_[i] *= ksc[k0 + 2 * i + (lane >> 5)]; }
#pragma unroll
    for (int i = 0; i < 32; ++i) scr[(2 * i + (lane >> 5)) * 33 + (lane & 31)] = wv_[i];
    asm volatile("s_waitcnt lgkmcnt(0)" ::: "memory");
    const int c = lane & 7;
#pragma unroll
    for (int j = 0; j < 4; ++j) { const int n = (lane >> 3) + 8 * j; const LAS float* s = scr + (8 * c) * 33 + n;
        v4u o; o.x = pk2(s[0 * 33], s[1 * 33]); o.y = pk2(s[2 * 33], s[3 * 33]); o.z = pk2(s[4 * 33], s[5 * 33]); o.w = pk2(s[6 * 33], s[7 * 33]);
        *(v4u*)(WT + (size_t)(o0 + n) * K + k0 + 8 * c) = o; }
    asm volatile("s_waitcnt lgkmcnt(0)" ::: "memory");
}
__device__ __forceinline__ void convert_weight(const float* W, int K, int N, int Npad, bf16* WT, LAS unsigned char* lds, int rot, int wv, bool ffn_perm = false, const float* ksc = nullptr) {
    const int wave = wv, lane = otid(wv) & 63; const int NGW = gridDim.x * NWAVES; const int gw = (blockIdx.x * NWAVES + wave + rot) % NGW;
    LAS float* scr = (LAS float*)(lds + wave * 16384);
    const int nitems = (K / 64) * (N / 32);
    for (int it = gw; it < nitems; it += NGW) transpose_item(W, K, N, WT, scr, it, lane, ffn_perm, ksc);
    (void)Npad;
}
__device__ __forceinline__ void convert_layer(const Args& a, int l, LAS unsigned char* lds) {
    const int i = l >> 1; unsigned char* ws = a.ws;
    convert_weight(a.in[I_WUP] + (size_t)l * D * UPW, D, UPW, UPW, (bf16*)(ws + W_UP), lds, 0, a.wv, true);
    convert_weight(a.in[I_WDN] + (size_t)l * DFF * D, DFF, D, D, (bf16*)(ws + W_DN), lds, 300, a.wv);
    if ((l & 1) == 0) {
        convert_weight(a.in[I_HIN] + (size_t)i * D * HYB_IN, D, HYB_IN, HYB_INP, (bf16*)(ws + W_IN), lds, 700, a.wv);
        convert_weight(a.in[I_HOUT] + (size_t)i * D * D, D, D, D, (bf16*)(ws + W_OUT), lds, 1100, a.wv);
        convert_weight(a.in[I_WUQ] + (size_t)i * 384 * QW, 384, QW, QW, (bf16*)(ws + W_UQ), lds, 1500, a.wv);
        convert_weight(a.in[I_WUKV] + (size_t)i * 256 * KVW, 256, KVW, KVW, (bf16*)(ws + W_UKV), lds, 1700, a.wv);
    } else {
        convert_weight(a.in[I_SIN] + (size_t)i * D * SSD_IN, D, SSD_IN, SSD_INP, (bf16*)(ws + W_IN), lds, 700, a.wv);
        convert_weight(a.in[I_SOUT] + (size_t)i * 2048 * D, 2048, D, D, (bf16*)(ws + W_OUT), lds, 1300, a.wv, false, a.in[I_SNORM] + i * 2048);
    }
}

__device__ __forceinline__ void prep_even(const Args& a, int i) {
    const int wave = otid(a.wv) >> 6, lane = otid(a.wv) & 63; const int NGW = gridDim.x * NWAVES, gw = blockIdx.x * NWAVES + wave;
    const bf16* P = (const bf16*)(a.ws + WS_P); bf16* CQN = (bf16*)(a.ws + WS_CQN); bf16* CKVN = (bf16*)(a.ws + WS_CKVN); bf16* KR = (bf16*)(a.ws + WS_KR); bf16* MIX = (bf16*)(a.ws + WS_MIX);
    const float* qn = a.in[I_QNORM] + i * 384; const float* kvn = a.in[I_KVNORM] + i * 256; const float* cw = a.in[I_SCONV] + i * 3 * 512;
    const float* ct = (const float*)(a.ws + WS_ROPE); const float* st = ct + SEQ * 16;
    for (int r = gw; r < T; r += NGW) {
        const bf16* p = P + (size_t)r * HYB_INP;
        {
            const unsigned* p32 = (const unsigned*)(p + lane * 6); const unsigned w0 = p32[0], w1 = p32[1], w2 = p32[2];
            float f[6] = {bflo(w0), bfhi(w0), bflo(w1), bfhi(w1), bflo(w2), bfhi(w2)}; float ss = 0.f;
#pragma unroll
            for (int j = 0; j < 6; ++j) ss += f[j] * f[j];
            const float rs = rsqrtf(wave_sum(ss, lane) * (1.f / 384.f) + EPS);
#pragma unroll
            for (int j = 0; j < 6; ++j) f[j] = f[j] * rs * qn[lane * 6 + j];
            unsigned* o32 = (unsigned*)(CQN + (size_t)r * 384 + lane * 6); o32[0] = pk2(f[0], f[1]); o32[1] = pk2(f[2], f[3]); o32[2] = pk2(f[4], f[5]);
        }
        {
            const v2u w = *(const v2u*)(p + 384 + lane * 4); float f[4] = {bflo(w.x), bfhi(w.x), bflo(w.y), bfhi(w.y)};
            const float ss = (f[0] * f[0] + f[1] * f[1]) + (f[2] * f[2] + f[3] * f[3]);
            const float rs = rsqrtf(wave_sum(ss, lane) * (1.f / 256.f) + EPS);
            const f32x4 g = *(const f32x4*)(kvn + lane * 4);
            v2u o; o.x = pk2(f[0] * rs * g[0], f[1] * rs * g[1]); o.y = pk2(f[2] * rs * g[2], f[3] * rs * g[3]); *(v2u*)(CKVN + (size_t)r * 256 + lane * 4) = o;
        }
        {
            const int j = lane & 31; const float v = bf1(p[640 + j]); const float o = shx(v, 16, lane); float res = v;
            if (r < TL) { const int t = r & (SEQ - 1); const float c = ct[t * 16 + (j & 15)], s = st[t * 16 + (j & 15)]; res = (j < 16) ? v * c - o * s : o * s + v * c; }
            if (lane < 32) KR[(size_t)r * 32 + j] = (bf16)f2bf(res);
        }
        {
            const int c0 = lane * 8; float gb[8], cur[8], acc[8], t0[8], t1[8];
            unpack8(*(const v4u*)(p + 672 + c0), gb);
            unpack8(*(const v4u*)(p + 1184 + c0), t0); unpack8(*(const v4u*)(p + 1696 + c0), t1);
#pragma unroll
            for (int j = 0; j < 8; ++j) { cur[j] = t0[j] * t1[j]; acc[j] = cw[512 + c0 + j] * cur[j]; }
            if (has_prev(r)) { unpack8(*(const v4u*)(p - HYB_INP + 1184 + c0), t0); unpack8(*(const v4u*)(p - HYB_INP + 1696 + c0), t1);
#pragma unroll
                for (int j = 0; j < 8; ++j) acc[j] += cw[c0 + j] * (t0[j] * t1[j]); }
            if (has_next(r)) { unpack8(*(const v4u*)(p + HYB_INP + 1184 + c0), t0); unpack8(*(const v4u*)(p + HYB_INP + 1696 + c0), t1);
#pragma unroll
                for (int j = 0; j < 8; ++j) acc[j] += cw[1024 + c0 + j] * (t0[j] * t1[j]); }
#pragma unroll
            for (int j = 0; j < 8; ++j) acc[j] *= gb[j];
            *(v4u*)(MIX + (size_t)r * D + 512 + c0) = pack8(acc);
        }
    }
}

__device__ __forceinline__ void convgate(const Args& a, int l, int nrows) {
    const bf16* U = (const bf16*)(a.ws + WS_U); bf16* G = (bf16*)(a.ws + WS_G); const float* cw = a.in[I_FCONV] + (size_t)l * 3 * UPW;
    const int total = nrows * (DFF / 8);
    for (int idx = blockIdx.x * NTHR + otid(a.wv); idx < total; idx += gridDim.x * NTHR) {
        const int r = idx / (DFF / 8), c0 = (idx % (DFF / 8)) * 8; const bf16* u = U + (size_t)r * UPW + c0;
        float ua[8], ug[8], act[8], gate[8];
        unpack8(*(const v4u*)u, ua); unpack8(*(const v4u*)(u + DFF), ug);
#pragma unroll
        for (int j = 0; j < 8; ++j) { act[j] = cw[UPW + c0 + j] * ua[j]; gate[j] = cw[UPW + DFF + c0 + j] * ug[j]; }
        if (has_prev(r)) { unpack8(*(const v4u*)(u - UPW), ua); unpack8(*(const v4u*)(u - UPW + DFF), ug);
#pragma unroll
            for (int j = 0; j < 8; ++j) { act[j] += cw[c0 + j] * ua[j]; gate[j] += cw[DFF + c0 + j] * ug[j]; } }
        if (has_next(r)) { unpack8(*(const v4u*)(u + UPW), ua); unpack8(*(const v4u*)(u + UPW + DFF), ug);
#pragma unroll
            for (int j = 0; j < 8; ++j) { act[j] += cw[2 * UPW + c0 + j] * ua[j]; gate[j] += cw[2 * UPW + DFF + c0 + j] * ug[j]; } }
#pragma unroll
        for (int j = 0; j < 8; ++j) act[j] = silu_f(act[j]) * gate[j];
        *(v4u*)(G + (size_t)r * DFF + c0) = pack8(act);
    }
}

__device__ __forceinline__ void ssd_conv(const Args& a, int i) {
    const bf16* ZX = (const bf16*)(a.ws + WS_ZX); bf16* XBC = (bf16*)(a.ws + WS_XBC); float* DT = (float*)(a.ws + WS_DT); float* AA = (float*)(a.ws + WS_AA);
    const float* cw = a.in[I_SCONVW] + (size_t)i * 3 * 3072; const float* cb = a.in[I_SCONVB] + (size_t)i * 3072;
    const int total = T * 384;
    for (int idx = blockIdx.x * NTHR + otid(a.wv); idx < total; idx += gridDim.x * NTHR) {
        const int r = idx / 384, c0 = (idx % 384) * 8; const bf16* u = ZX + (size_t)r * SSD_INP + 2048 + c0;
        float x[8], acc[8];
        unpack8(*(const v4u*)u, x);
#pragma unroll
        for (int j = 0; j < 8; ++j) acc[j] = cb[c0 + j] + cw[3072 + c0 + j] * x[j];
        if (has_prev(r)) { unpack8(*(const v4u*)(u - SSD_INP), x);
#pragma unroll
            for (int j = 0; j < 8; ++j) acc[j] += cw[c0 + j] * x[j]; }
        if (has_next(r)) { unpack8(*(const v4u*)(u + SSD_INP), x);
#pragma unroll
            for (int j = 0; j < 8; ++j) acc[j] += cw[2 * 3072 + c0 + j] * x[j]; }
#pragma unroll
        for (int j = 0; j < 8; ++j) acc[j] = silu_f(acc[j]);
        *(v4u*)(XBC + (size_t)r * 3072 + c0) = pack8(acc);
    }
    const float* alog = a.in[I_ALOG] + i * 64; const float* dtb = a.in[I_DTB] + i * 64;
    for (int idx = blockIdx.x * NTHR + otid(a.wv); idx < T * 64; idx += gridDim.x * NTHR) {
        const int r = idx >> 6, j = idx & 63; const float raw = bf1(ZX[(size_t)r * SSD_INP + 5120 + j]) + dtb[j];
        const float dt = raw > 15.f ? raw : (raw < -15.f ? __expf(raw) : __logf(1.f + __expf(raw)));
        DT[idx] = dt; AA[idx] = -__expf(alog[j]) * dt;
    }
}

__device__ __forceinline__ void gatenorm(const Args& a, int i, int nrows) {
    const int wave = otid(a.wv) >> 6, lane = otid(a.wv) & 63; const int NGW = gridDim.x * NWAVES, gw = blockIdx.x * NWAVES + wave;
    const bf16* ZX = (const bf16*)(a.ws + WS_ZX); bf16* YN = (bf16*)(a.ws + WS_XBC); const float* nw = a.in[I_SNORM] + i * 2048;
    for (int r = gw; r < nrows; r += NGW) {
        float v[4][8]; float ss = 0.f;
#pragma unroll
        for (int j = 0; j < 4; ++j) { float y[8], z[8]; const int c = j * 512 + lane * 8;
            unpack8(*(const v4u*)(ZX + (size_t)r * SSD_INP + 2048 + c), y); unpack8(*(const v4u*)(ZX + (size_t)r * SSD_INP + c), z);
#pragma unroll
            for (int k = 0; k < 8; ++k) { v[j][k] = y[k] * silu_f(z[k]); ss += v[j][k] * v[j][k]; } }
        const float rs = rsqrtf(wave_sum(ss, lane) * (1.f / 2048.f) + EPS);
#pragma unroll
        for (int j = 0; j < 4; ++j) { const int c = j * 512 + lane * 8; float o[8];
#pragma unroll
            for (int k = 0; k < 8; ++k) o[k] = v[j][k] * rs * nw[c + k];
            *(v4u*)(YN + (size_t)r * 2048 + c) = pack8(o); }
    }
}

__device__ __forceinline__ void attn_naive(const Args& a, LAS unsigned char* lds) {
    const int tid = otid(a.wv), qi = tid >> 1, half = tid & 1;
    const bf16* Qb = (const bf16*)(a.ws + WS_Q); const bf16* KVb = (const bf16*)(a.ws + WS_KV); const bf16* KR = (const bf16*)(a.ws + WS_KR); bf16* MIX = (bf16*)(a.ws + WS_MIX);
    const float* ct = (const float*)(a.ws + WS_ROPE); const float* st = ct + SEQ * 16;
    LAS float* Kt = (LAS float*)lds;
    LAS float* Vt = (LAS float*)(lds + 64 * 96 * 4);
    for (int u = blockIdx.x; u < 576; u += gridDim.x) {
        const bool lat = u < 512; const int b = lat ? (u >> 6) : ((u - 512) >> 3), h = lat ? ((u >> 3) & 7) : ((u - 512) & 7);
        const int nkeys = lat ? (CTXL + SEQ) : CTXL;
        const int qrow = lat ? b * SEQ + (u & 7) * 256 + qi : TL + b * CTXL + qi;
        float q[48];
#pragma unroll
        for (int g = 0; g < 6; ++g) { float f[8]; unpack8(*(const v4u*)(Qb + (size_t)qrow * QW + h * 96 + half * 48 + g * 8), f);
#pragma unroll
            for (int j = 0; j < 8; ++j) q[g * 8 + j] = f[j]; }
        if (lat && half == 1) { const int t = qrow & (SEQ - 1);
#pragma unroll
            for (int j = 0; j < 16; ++j) { const float c = ct[t * 16 + j], s = st[t * 16 + j]; const float x1 = q[16 + j], x2 = q[32 + j]; q[16 + j] = x1 * c - x2 * s; q[32 + j] = x1 * s + x2 * c; } }
#pragma unroll
        for (int j = 0; j < 48; ++j) q[j] *= ATT_SCALE_LOG2E;
        float o[32]; float m = -1e30f, l = 0.f;
#pragma unroll
        for (int j = 0; j < 32; ++j) o[j] = 0.f;
        for (int k0 = 0; k0 < nkeys; k0 += 64) {
            __syncthreads();
            for (int g = tid; g < 768; g += NTHR) { const int key = g / 12, part = g % 12; const int kk = k0 + key; const int krow = kk < CTXL ? TL + b * CTXL + kk : b * SEQ + kk - CTXL;
                float f[8]; unpack8(part < 8 ? *(const v4u*)(KVb + (size_t)krow * KVW + h * 128 + part * 8) : *(const v4u*)(KR + (size_t)krow * 32 + (part - 8) * 8), f);
#pragma unroll
                for (int j = 0; j < 8; ++j) Kt[key * 96 + part * 8 + j] = f[j]; }
            { const int key = tid >> 3, part = tid & 7; const int kk = k0 + key; const int krow = kk < CTXL ? TL + b * CTXL + kk : b * SEQ + kk - CTXL;
                float f[8]; unpack8(*(const v4u*)(KVb + (size_t)krow * KVW + h * 128 + 64 + part * 8), f);
#pragma unroll
                for (int j = 0; j < 8; ++j) Vt[key * 64 + part * 8 + j] = f[j]; }
            __syncthreads();
            for (int kg = 0; kg < 64; kg += 8) {
                float s[8]; float gm = -1e30f;
#pragma unroll
                for (int kk = 0; kk < 8; ++kk) { float acc = 0.f; const LAS f32x4* kp = (const LAS f32x4*)(Kt + (kg + kk) * 96 + half * 48);
#pragma unroll
                    for (int d4 = 0; d4 < 12; ++d4) { const f32x4 kv = kp[d4]; acc += q[d4 * 4] * kv[0] + q[d4 * 4 + 1] * kv[1] + q[d4 * 4 + 2] * kv[2] + q[d4 * 4 + 3] * kv[3]; }
                    acc += shx(acc, 1, tid & 63);
                    s[kk] = acc; gm = fmaxf(gm, acc); }
                const float mn = fmaxf(m, gm); const float alpha = exp2f(m - mn); m = mn; l *= alpha;
#pragma unroll
                for (int j = 0; j < 32; ++j) o[j] *= alpha;
#pragma unroll
                for (int kk = 0; kk < 8; ++kk) { const float p = exp2f(s[kk] - mn); l += p; const LAS f32x4* vp = (const LAS f32x4*)(Vt + (kg + kk) * 64 + half * 32);
#pragma unroll
                    for (int d4 = 0; d4 < 8; ++d4) { const f32x4 vv = vp[d4]; o[d4 * 4] += p * vv[0]; o[d4 * 4 + 1] += p * vv[1]; o[d4 * 4 + 2] += p * vv[2]; o[d4 * 4 + 3] += p * vv[3]; } }
            }
        }
        { const float inv = 1.f / l;
#pragma unroll
            for (int g = 0; g < 4; ++g) { float f[8];
#pragma unroll
                for (int j = 0; j < 8; ++j) f[j] = o[g * 8 + j] * inv;
                *(v4u*)(MIX + (size_t)qrow * D + h * 64 + half * 32 + g * 8) = pack8(f); } }
    }
}

__device__ __forceinline__ void ssd_scan_naive(const Args& a, int i, bool last, LAS unsigned char* lds) {
    const int tid = otid(a.wv), p = tid >> 3, nq = tid & 7;
    bf16* ZX = (bf16*)(a.ws + WS_ZX); const bf16* XBC = (const bf16*)(a.ws + WS_XBC); const float* DT = (const float*)(a.ws + WS_DT); const float* AA = (const float*)(a.ws + WS_AA);
    LAS float* xs = (LAS float*)lds;
    LAS float* Bs = (LAS float*)(lds + 16384);
    LAS float* Cs = (LAS float*)(lds + 16384 + 32768);
    LAS float* dts = (LAS float*)(lds + 16384 + 65536);
    LAS float* as = dts + 64;
    for (int it = blockIdx.x; it < NB * 32; it += gridDim.x) {
        const int b = it >> 5, h = it & 31, g = h >> 3; const float dsk = a.in[I_SD][i * 32 + h];
        for (int dir = 0; dir < 2; ++dir) {
            float stt[16];
#pragma unroll
            for (int n = 0; n < 16; ++n) stt[n] = 0.f;
            for (int seg = 0; seg < 2; ++seg) {
                const int len = seg == 0 ? CTXL : SEQ; const int base = seg == 0 ? TL + b * CTXL : b * SEQ; const bool want_y = !(last && seg == 0);
                for (int cc = 0; cc < len / 64; ++cc) {
                    const int t0 = dir == 0 ? cc * 64 : len - 64 - cc * 64;
                    __syncthreads();
                    { const int tt = tid >> 3, part = tid & 7; float f[8]; unpack8(*(const v4u*)(XBC + (size_t)(base + t0 + tt) * 3072 + h * 64 + part * 8), f);
#pragma unroll
                        for (int j = 0; j < 8; ++j) xs[tt * 64 + part * 8 + j] = f[j]; }
                    for (int q = tid; q < 1024; q += NTHR) { const int tt = q >> 4, part = q & 15; float f[8];
                        unpack8(*(const v4u*)(XBC + (size_t)(base + t0 + tt) * 3072 + 2048 + g * 128 + part * 8), f);
#pragma unroll
                        for (int j = 0; j < 8; ++j) Bs[tt * 128 + part * 8 + j] = f[j];
                        unpack8(*(const v4u*)(XBC + (size_t)(base + t0 + tt) * 3072 + 2560 + g * 128 + part * 8), f);
#pragma unroll
                        for (int j = 0; j < 8; ++j) Cs[tt * 128 + part * 8 + j] = f[j]; }
                    if (tid < 64) { dts[tid] = DT[(size_t)(base + t0 + tid) * 64 + dir * 32 + h]; as[tid] = AA[(size_t)(base + t0 + tid) * 64 + dir * 32 + h]; }
                    __syncthreads();
                    for (int s = 0; s < 64; ++s) {
                        const int tt = dir == 0 ? s : 63 - s;
                        const float dec = __expf(as[tt]); const float xv = xs[tt * 64 + p]; const float xd = xv * dts[tt];
                        const LAS f32x4* bp = (const LAS f32x4*)(Bs + tt * 128 + nq * 16); const LAS f32x4* cp = (const LAS f32x4*)(Cs + tt * 128 + nq * 16);
                        float acc = 0.f;
#pragma unroll
                        for (int n4 = 0; n4 < 4; ++n4) { const f32x4 bv = bp[n4], cv = cp[n4];
#pragma unroll
                            for (int k = 0; k < 4; ++k) { stt[n4 * 4 + k] = dec * stt[n4 * 4 + k] + xd * bv[k]; acc += cv[k] * stt[n4 * 4 + k]; } }
                        acc += shx(acc, 1, tid & 63); acc += shx(acc, 2, tid & 63); acc += shx(acc, 4, tid & 63);
                        if (want_y && nq == 0) { bf16* yp = ZX + (size_t)(base + t0 + tt) * SSD_INP + 2048 + h * 64 + p;
                            const float y = dir == 0 ? acc + dsk * xv : acc + bf1(*yp);
                            *yp = (bf16)f2bf(y); }
                    }
                }
            }
            __syncthreads();
            asm volatile("s_waitcnt vmcnt(0)" ::: "memory");
        }
    }
}

typedef short bf16x8 __attribute__((ext_vector_type(8)));
typedef float f32x16 __attribute__((ext_vector_type(16)));
typedef short v4i16_t __attribute__((ext_vector_type(4)));
__device__ __forceinline__ v2u trread(const LAS unsigned char* p) { return __builtin_bit_cast(v2u, __builtin_amdgcn_ds_read_tr16_b64_v4i16((LAS v4i16_t*)p)); }
__device__ __forceinline__ unsigned cvtpk(float lo, float hi) { return hw_cvtpk(lo, hi); }
constexpr int ATT_KP = 208, ATT_VP = 192, ATT_KB = 64 * ATT_KP, ATT_VB = 64 * ATT_VP, ATT_BUF = ATT_KB + ATT_VB;
#ifndef ATT_NQ
#define ATT_NQ 2
#endif
#ifndef ATT_XCDSWZ
#define ATT_XCDSWZ 1
#endif
#ifndef ATT_LAZY
#define ATT_LAZY 8
#endif
template <int NQ>
__device__ __forceinline__ void attn_unit3(const Args& a, LAS unsigned char* lds, const int b, const int h, const int q0, const int ntiles, const bool lat) {
    const int tid = otid(a.wv), wave = a.wv, lane = tid & 63, r32 = lane & 31, hh = lane >> 5;
    const int tq = (lane >> 2) & 3, tp = lane & 3, tblk = (lane >> 4) & 1;
    const bf16* Qb = (const bf16*)(a.ws + WS_Q); const bf16* KVb = (const bf16*)(a.ws + WS_KV); const bf16* KR = (const bf16*)(a.ws + WS_KR); bf16* MIX = (bf16*)(a.ws + WS_MIX);
    const float* ct = (const float*)(a.ws + WS_ROPE); const float* st = ct + SEQ * 16;
    bf16x8 qf[NQ][6];
#pragma unroll
    for (int nq = 0; nq < NQ; ++nq) { const int qrow = q0 + wave * (32 * NQ) + nq * 32 + r32;
#pragma unroll
        for (int s = 0; s < 6; ++s) qf[nq][s] = *(const bf16x8*)(Qb + (size_t)qrow * QW + h * 96 + 16 * s + 8 * hh);
        if (lat) { const int t = qrow & (SEQ - 1);
#pragma unroll
            for (int j = 0; j < 8; j += 2) { float x1[2], x2[2], y1[2], y2[2];
#pragma unroll
                for (int e = 0; e < 2; ++e) { x1[e] = bf1((bf16)qf[nq][4][j + e]); x2[e] = bf1((bf16)qf[nq][5][j + e]); const float c = ct[t * 16 + 8 * hh + j + e], s = st[t * 16 + 8 * hh + j + e];
                    y1[e] = x1[e] * c - x2[e] * s; y2[e] = x1[e] * s + x2[e] * c; }
                const unsigned w1 = pk2(y1[0], y1[1]), w2 = pk2(y2[0], y2[1]);
                qf[nq][4][j] = (short)(w1 & 0xffff); qf[nq][4][j + 1] = (short)(w1 >> 16); qf[nq][5][j] = (short)(w2 & 0xffff); qf[nq][5][j + 1] = (short)(w2 >> 16); } } }
    f32x16 o0[NQ], o1[NQ]; float m[NQ], l[NQ];
#pragma unroll
    for (int nq = 0; nq < NQ; ++nq) { m[nq] = -1e30f; l[nq] = 0.f;
#pragma unroll
        for (int i = 0; i < 16; ++i) { o0[nq][i] = 0.f; o1[nq][i] = 0.f; } }
    v4u kreg0, kreg1, vreg;
#define ATT_LOAD(it) do { const int rb_ = (it) < CTXL / 64 ? TL + b * CTXL + (it) * 64 : b * SEQ + ((it) - CTXL / 64) * 64; \
        const char* kvb_ = (const char*)(KVb + (size_t)rb_ * KVW); const char* krb_ = (const char*)(KR + (size_t)rb_ * 32); \
        kreg0 = *(const v4u*)(kvb_ + (tid >> 3) * 2048 + h * 256 + (tid & 7) * 16); if (tid < 256) kreg1 = *(const v4u*)(krb_ + (tid >> 2) * 64 + (tid & 3) * 16); vreg = *(const v4u*)(kvb_ + (tid >> 3) * 2048 + h * 256 + 128 + (tid & 7) * 16); } while (0)
#define ATT_WRITE(buf) do { LAS unsigned char* kb_ = lds + (buf) * ATT_BUF; LAS unsigned char* vb_ = kb_ + ATT_KB; \
        *(LAS v4u*)(kb_ + (tid >> 3) * ATT_KP + (tid & 7) * 16) = kreg0; if (tid < 256) *(LAS v4u*)(kb_ + (tid >> 2) * ATT_KP + 128 + (tid & 3) * 16) = kreg1; \
        *(LAS v4u*)(vb_ + (tid >> 3) * ATT_VP + (tid & 7) * 16) = vreg; } while (0)
    __syncthreads();
    ATT_LOAD(0); ATT_WRITE(0);
    __syncthreads();
    for (int it = 0; it < ntiles; ++it) {
#ifdef ATT_JITTER
        if (wave == ((it * 5 + (int)blockIdx.x) & 7)) __builtin_amdgcn_s_sleep(100);
#endif
#ifndef ATT_LOADMID
        if (it + 1 < ntiles) ATT_LOAD(it + 1);
#endif
#ifdef ATT_TZ
        int tz = tid; asm volatile("" : "+v"(tz));
        const int lane = tz & 63, r32 = lane & 31, hh = lane >> 5, tq = (lane >> 2) & 3, tp = lane & 3, tblk = (lane >> 4) & 1;
#endif
        const LAS unsigned char* kb = lds + (it & 1) * ATT_BUF; const LAS unsigned char* vb = kb + ATT_KB;
#pragma unroll
        for (int t = 0; t < 2; ++t) {
            f32x16 sc[NQ]; bf16x8 pf[NQ][2];
#pragma unroll
            for (int nq = 0; nq < NQ; ++nq)
#pragma unroll
                for (int i = 0; i < 16; ++i) sc[nq][i] = 0.f;
            bf16x8 kf[6];
#pragma unroll
            for (int s = 0; s < 6; ++s) kf[s] = *(const LAS bf16x8*)(kb + (32 * t + r32) * ATT_KP + (16 * s + 8 * hh) * 2);
            asm volatile("" : "+v"(kf[0]), "+v"(kf[1]), "+v"(kf[2]), "+v"(kf[3]), "+v"(kf[4]), "+v"(kf[5]));
#pragma unroll
            for (int s = 0; s < 6; ++s)
#pragma unroll
                for (int nq = 0; nq < NQ; ++nq) sc[nq] = __builtin_amdgcn_mfma_f32_32x32x16_bf16(kf[s], qf[nq][s], sc[nq], 0, 0, 0);
#ifdef ATT_LOADMID
            if (t == 0 && it + 1 < ntiles) ATT_LOAD(it + 1);
#endif
#pragma unroll
            for (int nq = 0; nq < NQ; ++nq) {
                float mx = sc[nq][0];
#pragma unroll
                for (int i = 1; i < 16; ++i) mx = fmaxf(mx, sc[nq][i]);
                mx = fmaxf(mx, shx(mx, 32, lane));
#ifdef ATT_LAZY
                const float mxs = mx * ATT_SCALE_LOG2E;
                if (__builtin_amdgcn_ballot_w64(mxs > m[nq] + (float)ATT_LAZY) != 0ull) {
                    const float mn = fmaxf(m[nq], mxs); const float alpha = __builtin_amdgcn_exp2f(m[nq] - mn); m[nq] = mn; l[nq] *= alpha;
#pragma unroll
                    for (int i = 0; i < 16; ++i) { o0[nq][i] *= alpha; o1[nq][i] *= alpha; } }
                { const float mn = m[nq]; float rs = 0.f;
#pragma unroll
                  for (int i = 0; i < 16; ++i) { sc[nq][i] = __builtin_amdgcn_exp2f(sc[nq][i] * ATT_SCALE_LOG2E - mn); rs += sc[nq][i]; }
                  l[nq] += rs; }
#else
                const float mn = fmaxf(m[nq], mx * ATT_SCALE_LOG2E); const float alpha = __builtin_amdgcn_exp2f(m[nq] - mn); m[nq] = mn;
                float rs = 0.f;
#pragma unroll
                for (int i = 0; i < 16; ++i) { sc[nq][i] = __builtin_amdgcn_exp2f(sc[nq][i] * ATT_SCALE_LOG2E - mn); rs += sc[nq][i]; }
                l[nq] = l[nq] * alpha + rs;
#ifdef ATT_SKIPRS
                if (__builtin_amdgcn_ballot_w64(alpha != 1.0f) != 0ull)
#endif
                {
#pragma unroll
                    for (int i = 0; i < 16; ++i) { o0[nq][i] *= alpha; o1[nq][i] *= alpha; } }
#endif
#pragma unroll
                for (int s2 = 0; s2 < 2; ++s2) { v4u w0;
                    w0.x = cvtpk(sc[nq][8 * s2 + 0], sc[nq][8 * s2 + 1]); w0.y = cvtpk(sc[nq][8 * s2 + 2], sc[nq][8 * s2 + 3]); w0.z = cvtpk(sc[nq][8 * s2 + 4], sc[nq][8 * s2 + 5]); w0.w = cvtpk(sc[nq][8 * s2 + 6], sc[nq][8 * s2 + 7]);
                    pf[nq][s2] = __builtin_bit_cast(bf16x8, w0); }
            }
#pragma unroll
            for (int s2 = 0; s2 < 2; ++s2) { const int ko = t * 32 + 16 * s2 + 4 * hh;
                { const LAS unsigned char* tb = vb + (ko + tq) * ATT_VP + (16 * tblk + 4 * tp) * 2; const v2u lo = trread(tb), hi = trread(tb + 8 * ATT_VP); const bf16x8 vf = __builtin_bit_cast(bf16x8, (v4u){lo.x, lo.y, hi.x, hi.y});
#pragma unroll
                  for (int nq = 0; nq < NQ; ++nq) o0[nq] = __builtin_amdgcn_mfma_f32_32x32x16_bf16(vf, pf[nq][s2], o0[nq], 0, 0, 0); }
                { const LAS unsigned char* tb = vb + (ko + tq) * ATT_VP + (32 + 16 * tblk + 4 * tp) * 2; const v2u lo = trread(tb), hi = trread(tb + 8 * ATT_VP); const bf16x8 vf = __builtin_bit_cast(bf16x8, (v4u){lo.x, lo.y, hi.x, hi.y});
#pragma unroll
                  for (int nq = 0; nq < NQ; ++nq) o1[nq] = __builtin_amdgcn_mfma_f32_32x32x16_bf16(vf, pf[nq][s2], o1[nq], 0, 0, 0); } }
        }
        if (it + 1 < ntiles) ATT_WRITE((it + 1) & 1);
        __syncthreads();
    }
#undef ATT_LOAD
#undef ATT_WRITE
#pragma unroll
    for (int nq = 0; nq < NQ; ++nq) { const int qrow = q0 + wave * (32 * NQ) + nq * 32 + r32;
        const float lsum = l[nq] + shx(l[nq], 32, lane); const float inv = 1.f / lsum;
        bf16* orow = MIX + (size_t)qrow * D + h * 64 + 4 * hh;
#pragma unroll
        for (int g = 0; g < 4; ++g) {
            v2u w; w.x = pk2(o0[nq][4 * g] * inv, o0[nq][4 * g + 1] * inv); w.y = pk2(o0[nq][4 * g + 2] * inv, o0[nq][4 * g + 3] * inv); *(v2u*)(orow + 8 * g) = w;
            v2u x; x.x = pk2(o1[nq][4 * g] * inv, o1[nq][4 * g + 1] * inv); x.y = pk2(o1[nq][4 * g + 2] * inv, o1[nq][4 * g + 3] * inv); *(v2u*)(orow + 32 + 8 * g) = x; } }
}
__device__ __forceinline__ void attn_mfma(const Args& a, LAS unsigned char* lds) {
#if ATT_NQ == 2
    for (int u0 = blockIdx.x; u0 < 256; u0 += gridDim.x) { const int u = (gridDim.x == 256 && ATT_XCDSWZ) ? ((u0 & 7) * 32 + (u0 >> 3)) : u0;
        attn_unit3<2>(a, lds, u >> 5, (u >> 2) & 7, (u >> 5) * SEQ + (u & 3) * 512, (CTXL + SEQ) / 64, true); }
#else
    for (int u = blockIdx.x; u < 512; u += gridDim.x) attn_unit3<1>(a, lds, u >> 6, (u >> 3) & 7, (u >> 6) * SEQ + (u & 7) * 256, (CTXL + SEQ) / 64, true);
#endif
    for (int u = blockIdx.x; u < 64; u += gridDim.x) attn_unit3<1>(a, lds, u >> 3, u & 7, TL + (u >> 3) * CTXL, CTXL / 64, false);
}

#ifndef SSD_PRIO
#define SSD_PRIO 1
#endif
#ifndef SSD_XCDSWZ
#define SSD_XCDSWZ 1
#endif
#ifndef SSD_PFEARLY
#define SSD_PFEARLY 0
#endif
#ifndef SSD_YREP
#define SSD_YREP 1
#endif
#ifndef SSD_WREP
#define SSD_WREP 1
#endif
constexpr int SP_B = 272, SP_X = 192;
constexpr int SO_B = 0, SO_C = SO_B + 128 * SP_B, SO_XD = SO_C + 128 * SP_B, SO_XW = SO_XD + 128 * SP_X, SO_S = SO_XW + 128 * SP_X, SO_V = SO_S + 64 * SP_B;
static_assert(SO_V + 2 * 2048 <= LDS_BYTES, "ssd lds map");
#ifdef SSD_DIAG
#define SSD_T(v) long long v = clock64()
#define SSD_ACC(k, v) do { const long long n_ = clock64(); dacc[k] += n_ - v; v = n_; } while (0)
#else
#define SSD_T(v) do {} while (0)
#define SSD_ACC(k, v) do {} while (0)
#endif
__device__ __forceinline__ void ssd_scan_mfma(const Args& a, int i, bool last, LAS unsigned char* lds) {
#ifdef SSD_DIAG
    long long dacc[12] = {0, 0, 0, 0, 0, 0, 0, 0, 0, 0, 0, 0};
#endif
    const int tid = otid(a.wv), wave = a.wv, lane = tid & 63, r32 = lane & 31, hh = lane >> 5;
    const int pt = wave >> 2, lt = pt ? 3 - (wave & 3) : (wave & 3);
    const int tq = (lane >> 2) & 3, tp = lane & 3, tblk = (lane >> 4) & 1;
    bf16* ZX = (bf16*)(a.ws + WS_ZX); const bf16* XBC = (const bf16*)(a.ws + WS_XBC); bf16* GX = (bf16*)(a.ws + WS_XBC); float* SSq = (float*)(a.ws + WS_SS); const float* DT = (const float*)(a.ws + WS_DT); const float* AA = (const float*)(a.ws + WS_AA);
    LAS unsigned char* Bl = lds + SO_B; LAS unsigned char* Cl = lds + SO_C; LAS unsigned char* XDl = lds + SO_XD; LAS unsigned char* XWl = lds + SO_XW; LAS unsigned char* Sl = lds + SO_S;
    const int brow = tid >> 4, bpart = tid & 15, xrow = tid >> 3, xpart = tid & 7;
    for (int it = blockIdx.x; it < NB * 32; it += gridDim.x) {
        const int itx = (gridDim.x == 256 && SSD_XCDSWZ) ? ((it & 7) * 32 + (it >> 3)) : it;
        const int b = itx >> 5, h = itx & 31, g = h >> 3; const float dsk = a.in[I_SD][i * 32 + h];
        for (int dir = 0; dir < 2; ++dir) {
            const int scanw = dir == 0 ? 0 : 3;
            f32x16 sacc;
#pragma unroll
            for (int k = 0; k < 16; ++k) sacc[k] = 0.f;
            SSD_T(tprev);
            v4u bq[4], cq[4], xq[2]; float pa0 = 0.f, pa1 = 0.f, pd0 = 0.f, pd1 = 0.f, qa0 = 0.f, qa1 = 0.f, qd0 = 0.f, qd1 = 0.f; v2u add[4], zq[4];
#define SSD_ROWBASE(c) ((c) < 2 ? TL + b * CTXL + (dir == 0 ? (c) : 1 - (c)) * 128 : b * SEQ + (dir == 0 ? (c) - 2 : 17 - (c)) * 128)
#define SSD_PFB(c) do { const int rb_ = SSD_ROWBASE(c); _Pragma("unroll") for (int k_ = 0; k_ < 4; ++k_) bq[k_] = *(const v4u*)(XBC + (size_t)(rb_ + brow + 32 * k_) * 3072 + 2048 + g * 128 + bpart * 8); } while (0)
#define SSD_PFC(c) do { const int rb_ = SSD_ROWBASE(c); _Pragma("unroll") for (int k_ = 0; k_ < 4; ++k_) cq[k_] = *(const v4u*)(XBC + (size_t)(rb_ + brow + 32 * k_) * 3072 + 2560 + g * 128 + bpart * 8); } while (0)
#define SSD_PFX(c) do { const int rb_ = SSD_ROWBASE(c); _Pragma("unroll") for (int k_ = 0; k_ < 2; ++k_) xq[k_] = *(const v4u*)(XBC + (size_t)(rb_ + xrow + 64 * k_) * 3072 + h * 64 + xpart * 8); } while (0)
#define SSD_PF(c) do { SSD_PFB(c); SSD_PFC(c); SSD_PFX(c); } while (0)
#define SSD_PFV(c) do { if (wave == scanw) { const int rb_ = SSD_ROWBASE(c); const size_t o_ = (size_t)(rb_ + 2 * lane) * 64 + dir * 32 + h; qa0 = AA[o_]; qa1 = AA[o_ + 64]; qd0 = DT[o_]; qd1 = DT[o_ + 64]; } } while (0)
#define SSD_PFY(c) do { const int rb_ = SSD_ROWBASE(c); const size_t r_ = (size_t)(rb_ + 32 * lt + r32); \
                _Pragma("unroll") for (int q_ = 0; q_ < 4; ++q_) { add[q_] = dir == 0 ? *(const v2u*)(XBC + r_ * 3072 + h * 64 + 32 * pt + 4 * hh + 8 * q_) : *(const v2u*)(ZX + r_ * SSD_INP + 2048 + h * 64 + 32 * pt + 4 * hh + 8 * q_); \
                    if (dir == 1) zq[q_] = *(const v2u*)(ZX + r_ * SSD_INP + h * 64 + 32 * pt + 4 * hh + 8 * q_); } } while (0)
#define SSD_SCAN(vb_) do { if (wave == scanw) { LAS float* V_ = (LAS float*)(lds + SO_V + (vb_) * 2048); const float pair_ = pa0 + pa1; float ps_ = pair_; \
                _Pragma("unroll") for (int d_ = 1; d_ < 64; d_ <<= 1) { const int src_ = dir == 0 ? lane - d_ : lane + d_; const float t_ = __builtin_bit_cast(float, __builtin_amdgcn_ds_bpermute((src_ & 63) << 2, __builtin_bit_cast(int, ps_))); if (src_ >= 0 && src_ < 64) ps_ += t_; } \
                const float tot_ = __builtin_bit_cast(float, __builtin_amdgcn_ds_bpermute((dir == 0 ? 63 : 0) << 2, __builtin_bit_cast(int, ps_))); const float ex_ = ps_ - pair_; \
                float c0_, c1_; if (dir == 0) { c0_ = ex_ + pa0; c1_ = c0_ + pa1; } else { c1_ = ex_ + pa1; c0_ = c1_ + pa0; } \
                V_[2 * lane] = c0_; V_[2 * lane + 1] = c1_; V_[128 + 2 * lane] = pd0; V_[128 + 2 * lane + 1] = pd1; V_[256 + 2 * lane] = pd0 * __expf(tot_ - c0_); V_[256 + 2 * lane + 1] = pd1 * __expf(tot_ - c1_); \
                if (lane == 0) V_[384] = tot_; } } while (0)
#define SSD_WRITE(vb_) do { const LAS float* V_ = (const LAS float*)(lds + SO_V + (vb_) * 2048); \
                _Pragma("unroll") for (int k_ = 0; k_ < 4; ++k_) { *(LAS v4u*)(Bl + (brow + 32 * k_) * SP_B + bpart * 16) = bq[k_]; *(LAS v4u*)(Cl + (brow + 32 * k_) * SP_B + bpart * 16) = cq[k_]; } \
                _Pragma("unroll") for (int k_ = 0; k_ < 2; ++k_) { const int s_ = xrow + 64 * k_; const float dt_ = V_[128 + s_], w_ = V_[256 + s_]; float f_[8], g_[8]; unpack8(xq[k_], f_); \
                    _Pragma("unroll") for (int j_ = 0; j_ < 8; ++j_) { g_[j_] = f_[j_] * w_; f_[j_] *= dt_; } \
                    *(LAS v4u*)(XDl + s_ * SP_X + xpart * 16) = pack8(f_); *(LAS v4u*)(XWl + s_ * SP_X + xpart * 16) = pack8(g_); } } while (0)
            __syncthreads();
            SSD_PFV(0); pa0 = qa0; pa1 = qa1; pd0 = qd0; pd1 = qd1; SSD_PFV(1); SSD_PFY(0); SSD_PF(0);
            { const float t0_ = qa0, t1_ = qa1, t2_ = qd0, t3_ = qd1; SSD_SCAN(0); pa0 = t0_; pa1 = t1_; pd0 = t2_; pd1 = t3_; }
            __syncthreads();
            SSD_WRITE(0);
            { LAS v2u* sp = (LAS v2u*)(Sl + (32 * pt + r32) * SP_B + (32 * lt + 4 * hh) * 2);
#pragma unroll
              for (int q = 0; q < 4; ++q) sp[2 * q] = (v2u){0u, 0u}; }
            __syncthreads();
            SSD_ACC(0, tprev);
            for (int c = 0; c < 18; ++c) {
                const int cur = c & 1; const LAS float* V = (const LAS float*)(lds + SO_V + cur * 2048);
#ifdef SSD_JITTER
                if (wave == ((c * 3 + (int)blockIdx.x + dir) & 7)) __builtin_amdgcn_s_sleep(120);
#endif
                const int rowbase = SSD_ROWBASE(c); const bool want_y = !(last && c < 2);
                if (c > 0 && want_y) SSD_PFY(c);
#if SSD_PFEARLY
                if (want_y && c + 1 < 18) SSD_PFB(c + 1);
#endif
                if (c + 1 < 18) { if (c + 2 < 18) SSD_PFV(c + 2); }
                SSD_ACC(1, tprev);
                for (int yrep = 0; yrep < SSD_YREP; ++yrep)
                if (!want_y && c + 1 < 18) { SSD_PFB(c + 1); SSD_PFC(c + 1); SSD_PFX(c + 1); }
                if (want_y) {
                    const int l = 32 * lt + r32; const float cl = V[l];
                    bf16* yptr = ZX + (size_t)(rowbase + l) * SSD_INP + 2048 + h * 64 + 32 * pt + 4 * hh;
                    bf16x8 cf[8];
#pragma unroll
                    for (int ks = 0; ks < 8; ++ks) cf[ks] = *(const LAS bf16x8*)(Cl + l * SP_B + (16 * ks + 8 * hh) * 2);
                    SSD_ACC(8, tprev);
                    f32x16 y1;
#pragma unroll
                    for (int k = 0; k < 16; ++k) y1[k] = 0.f;
#pragma unroll
                    for (int ks = 0; ks < 8; ++ks) { const bf16x8 sf = *(const LAS bf16x8*)(Sl + (32 * pt + r32) * SP_B + (16 * ks + 8 * hh) * 2); y1 = __builtin_amdgcn_mfma_f32_32x32x16_bf16(sf, cf[ks], y1, 0, 0, 0); }
                    { const float el = __expf(cl);
#pragma unroll
                      for (int k = 0; k < 16; ++k) y1[k] *= el; }
                    SSD_ACC(10, tprev);
                    const int st_lo = dir == 0 ? 0 : lt, st_hi = dir == 0 ? lt : 3;
#if SSD_PRIO
                    { const int nsub = st_hi - st_lo; if (nsub == 3) __builtin_amdgcn_s_setprio(3); else if (nsub == 2) __builtin_amdgcn_s_setprio(2); else if (nsub == 1) __builtin_amdgcn_s_setprio(1); }
#endif
#pragma unroll
                    for (int st = 0; st < 4; ++st) { if (c + 1 < 18) { if (st == 1 + SSD_PFEARLY && !SSD_PFEARLY) SSD_PFB(c + 1); if (st == 2 - SSD_PFEARLY) SSD_PFC(c + 1); if (st == 3 - SSD_PFEARLY) SSD_PFX(c + 1); }
                      if (st >= st_lo && st <= st_hi) {
                        f32x16 X;
#pragma unroll
                        for (int k = 0; k < 16; ++k) X[k] = 0.f;
#pragma unroll
                        for (int ks = 0; ks < 8; ++ks) { const bf16x8 af = *(const LAS bf16x8*)(Bl + (32 * st + r32) * SP_B + (16 * ks + 8 * hh) * 2); X = __builtin_amdgcn_mfma_f32_32x32x16_bf16(af, cf[ks], X, 0, 0, 0); }
                        if (st == lt) {
#pragma unroll
                            for (int q = 0; q < 4; ++q) { const f32x4 cs = *(const LAS f32x4*)(V + 32 * st + 8 * q + 4 * hh);
#pragma unroll
                                for (int e = 0; e < 4; ++e) { const int sl = 8 * q + 4 * hh + e; const bool ok = dir == 0 ? (sl <= r32) : (sl >= r32);
                                    X[4 * q + e] *= __expf(ok ? fminf(cl - cs[e], 0.f) : -1.0e30f); } }
                        } else {
#pragma unroll
                            for (int q = 0; q < 4; ++q) { const f32x4 cs = *(const LAS f32x4*)(V + 32 * st + 8 * q + 4 * hh);
#pragma unroll
                                for (int e = 0; e < 4; ++e) X[4 * q + e] *= __expf(fminf(cl - cs[e], 0.f)); }
                        }
#pragma unroll
                        for (int ks2 = 0; ks2 < 2; ++ks2) { v4u w; w.x = cvtpk(X[8 * ks2 + 0], X[8 * ks2 + 1]); w.y = cvtpk(X[8 * ks2 + 2], X[8 * ks2 + 3]); w.z = cvtpk(X[8 * ks2 + 4], X[8 * ks2 + 5]); w.w = cvtpk(X[8 * ks2 + 6], X[8 * ks2 + 7]);
                            const LAS unsigned char* tb = XDl + (32 * st + 16 * ks2 + 4 * hh + tq) * SP_X + (32 * pt + 16 * tblk + 4 * tp) * 2;
                            const v2u lo = trread(tb), hi = trread(tb + 8 * SP_X);
                            y1 = __builtin_amdgcn_mfma_f32_32x32x16_bf16(__builtin_bit_cast(bf16x8, (v4u){lo.x, lo.y, hi.x, hi.y}), __builtin_bit_cast(bf16x8, w), y1, 0, 0, 0); }
                    } }
                    asm volatile("" : "+v"(y1)); SSD_ACC(9, tprev);
                    float ssq = 0.f; bf16* gptr = GX + (size_t)(rowbase + l) * 3072 + h * 64 + 32 * pt + 4 * hh;
#pragma unroll
                    for (int q = 0; q < 4; ++q) { float o[4];
#pragma unroll
                        for (int e = 0; e < 4; ++e) o[e] = y1[4 * q + e];
                        const float a0 = bflo(add[q].x), a1 = bfhi(add[q].x), a2 = bflo(add[q].y), a3 = bfhi(add[q].y);
                        if (dir == 0) { o[0] += dsk * a0; o[1] += dsk * a1; o[2] += dsk * a2; o[3] += dsk * a3;
                            v2u w; w.x = cvtpk(o[0], o[1]); w.y = cvtpk(o[2], o[3]); *(v2u*)(yptr + 8 * q) = w; }
                        else { o[0] += a0; o[1] += a1; o[2] += a2; o[3] += a3;
                            o[0] *= silu_f(bflo(zq[q].x)); o[1] *= silu_f(bfhi(zq[q].x)); o[2] *= silu_f(bflo(zq[q].y)); o[3] *= silu_f(bfhi(zq[q].y));
                            ssq += (o[0] * o[0] + o[1] * o[1]) + (o[2] * o[2] + o[3] * o[3]);
                            v2u w; w.x = cvtpk(o[0], o[1]); w.y = cvtpk(o[2], o[3]); *(v2u*)(gptr + 8 * q) = w; } }
                    if (dir == 1) { ssq += shx(ssq, 32, lane); if (hh == 0) SSq[(size_t)(rowbase + l) * 64 + 2 * h + pt] = ssq; }
                }
#if SSD_PRIO
                __builtin_amdgcn_s_setprio(0);
#endif
                SSD_ACC(2, tprev);
                if (c + 1 < 18) {
                    const float etot = __expf(V[384]);
#pragma unroll
                    for (int k = 0; k < 16; ++k) sacc[k] *= etot;
#pragma unroll
                    for (int kh = 0; kh < 2; ++kh) {
                        v2u alo[4], ahi[4], blo[4], bhi[4];
#pragma unroll
                        for (int k4 = 0; k4 < 4; ++k4) { const int ks = 4 * kh + k4;
                            const LAS unsigned char* ta = Bl + (16 * ks + 8 * hh + tq) * SP_B + (32 * lt + 16 * tblk + 4 * tp) * 2;
                            const LAS unsigned char* tb = XWl + (16 * ks + 8 * hh + tq) * SP_X + (32 * pt + 16 * tblk + 4 * tp) * 2;
                            alo[k4] = trread(ta); ahi[k4] = trread(ta + 4 * SP_B); blo[k4] = trread(tb); bhi[k4] = trread(tb + 4 * SP_X); }
                        asm volatile("" : "+v"(alo[0]), "+v"(alo[1]), "+v"(alo[2]), "+v"(alo[3]), "+v"(bhi[0]), "+v"(bhi[1]), "+v"(bhi[2]), "+v"(bhi[3]));
#pragma unroll
                        for (int k4 = 0; k4 < 4; ++k4)
                            sacc = __builtin_amdgcn_mfma_f32_32x32x16_bf16(__builtin_bit_cast(bf16x8, (v4u){alo[k4].x, alo[k4].y, ahi[k4].x, ahi[k4].y}), __builtin_bit_cast(bf16x8, (v4u){blo[k4].x, blo[k4].y, bhi[k4].x, bhi[k4].y}), sacc, 0, 0, 0); }
                    SSD_SCAN(cur ^ 1); pa0 = qa0; pa1 = qa1; pd0 = qd0; pd1 = qd1;
                }
#ifdef SSD_JITTER
                if (wave == ((c * 5 + 2 + (int)blockIdx.x) & 7)) __builtin_amdgcn_s_sleep(90);
#endif
                SSD_ACC(3, tprev);
                __syncthreads();
                SSD_ACC(4, tprev);
                if (c + 1 < 18) {
                    LAS v2u* sp = (LAS v2u*)(Sl + (32 * pt + r32) * SP_B + (32 * lt + 4 * hh) * 2);
#pragma unroll
                    for (int q = 0; q < 4; ++q) { v2u w; w.x = cvtpk(sacc[4 * q], sacc[4 * q + 1]); w.y = cvtpk(sacc[4 * q + 2], sacc[4 * q + 3]); sp[2 * q] = w; }
                    for (int wrep = 0; wrep < SSD_WREP; ++wrep) { SSD_WRITE(cur ^ 1); }
                }
                SSD_ACC(5, tprev);
                __syncthreads();
                SSD_ACC(6, tprev);
            }
#undef SSD_ROWBASE
#undef SSD_PF
#undef SSD_PFV
#undef SSD_PFY
#undef SSD_SCAN
#undef SSD_WRITE
            asm volatile("s_waitcnt vmcnt(0)" ::: "memory");
        }
    }
#ifdef SSD_DIAG
    if (blockIdx.x == 0 && wave == SSD_DIAG_WAVE && lane == 0 && i == 0) { float* dg = (float*)(a.ws + WS_MOD + 900 * 1024); long long tot = 0;
        for (int k = 0; k < 7; ++k) tot += dacc[k];
        tot += dacc[8] + dacc[9] + dacc[10];
        for (int k = 0; k < 12; ++k) dg[k] = (float)dacc[k]; dg[7] = (float)tot; }
#endif
}

constexpr int AT2_KP = 208, AT2_VP = 192, AT2_KB = 64 * AT2_KP, AT2_VB = 64 * AT2_VP, AT2_BUF = AT2_KB + AT2_VB;
template <int NQ>
__device__ __forceinline__ void attn_unit2(const Args& a, LAS unsigned char* lds, int b, int h, int q0, int ntiles, bool lat) {
    const int tid = otid(a.wv), wave = tid >> 6, lane = tid & 63, r32 = lane & 31, hh = lane >> 5;
    const int tq = (lane >> 2) & 3, tp = lane & 3, tblk = (lane >> 4) & 1;
    const bf16* Qb = (const bf16*)(a.ws + WS_Q); const bf16* KVb = (const bf16*)(a.ws + WS_KV); const bf16* KR = (const bf16*)(a.ws + WS_KR); bf16* MIX = (bf16*)(a.ws + WS_MIX);
    const float* ct = (const float*)(a.ws + WS_ROPE); const float* st = ct + SEQ * 16;
    bf16x8 qf[NQ][6];
#pragma unroll
    for (int nq = 0; nq < NQ; ++nq) { const int qrow = q0 + wave * (32 * NQ) + nq * 32 + r32;
#pragma unroll
        for (int s = 0; s < 6; ++s) qf[nq][s] = *(const bf16x8*)(Qb + (size_t)qrow * QW + h * 96 + 16 * s + 8 * hh);
        if (lat) { const int t = qrow & (SEQ - 1);
#pragma unroll
            for (int j = 0; j < 8; j += 2) { float y1[2], y2[2];
#pragma unroll
                for (int e = 0; e < 2; ++e) { const float x1 = bf1((bf16)qf[nq][4][j + e]), x2 = bf1((bf16)qf[nq][5][j + e]); const float c = ct[t * 16 + 8 * hh + j + e], s = st[t * 16 + 8 * hh + j + e];
                    y1[e] = x1 * c - x2 * s; y2[e] = x1 * s + x2 * c; }
                const unsigned w1 = pk2(y1[0], y1[1]), w2 = pk2(y2[0], y2[1]);
                qf[nq][4][j] = (short)(w1 & 0xffff); qf[nq][4][j + 1] = (short)(w1 >> 16); qf[nq][5][j] = (short)(w2 & 0xffff); qf[nq][5][j + 1] = (short)(w2 >> 16); } }
        asm volatile("" : "+v"(qf[nq][0]), "+v"(qf[nq][1]), "+v"(qf[nq][2]), "+v"(qf[nq][3]), "+v"(qf[nq][4]), "+v"(qf[nq][5]) :: "memory"); }
    f32x16 o[NQ][2]; float m[NQ], l[NQ];
#pragma unroll
    for (int nq = 0; nq < NQ; ++nq) { m[nq] = -1e30f; l[nq] = 0.f;
#pragma unroll
        for (int i = 0; i < 16; ++i) { o[nq][0][i] = 0.f; o[nq][1][i] = 0.f; } }
    v4u kreg0, kreg1, vreg;
#define AT2_LOAD(it, tt) do { const unsigned off_kv = (unsigned)(((tt) >> 3) * (KVW * 2) + h * 256 + ((tt) & 7) * 16), off_kr = (unsigned)(((tt) >> 2) * 64 + ((tt) & 3) * 16); const bool k1ok = (tt) < 256; const int rb_ = (it) < CTXL / 64 ? TL + b * CTXL + (it) * 64 : b * SEQ + ((it) - CTXL / 64) * 64; \
        const char* kvb_ = (const char*)(KVb + (size_t)rb_ * KVW); const char* krb_ = (const char*)(KR + (size_t)rb_ * 32); \
        kreg0 = *(const v4u*)(kvb_ + off_kv); vreg = *(const v4u*)(kvb_ + off_kv + 128); if (k1ok) kreg1 = *(const v4u*)(krb_ + off_kr); } while (0)
#define AT2_WRITE(buf, tt) do { LAS unsigned char* kb_ = lds + (buf) * AT2_BUF; \
        *(LAS v4u*)(kb_ + ((tt) >> 3) * AT2_KP + ((tt) & 7) * 16) = kreg0; if ((tt) < 256) *(LAS v4u*)(kb_ + ((tt) >> 2) * AT2_KP + 128 + ((tt) & 3) * 16) = kreg1; \
        *(LAS v4u*)(kb_ + AT2_KB + ((tt) >> 3) * AT2_VP + ((tt) & 7) * 16) = vreg; } while (0)
    __syncthreads();
    AT2_LOAD(0, tid); AT2_WRITE(0, tid);
    __syncthreads();
    for (int it = 0; it < ntiles; ++it) {
        int tz = tid; asm volatile("" : "+v"(tz));
        const int lane_ = tz & 63, r32_ = lane_ & 31, hh_ = lane_ >> 5, tq_ = (lane_ >> 2) & 3, tp_ = lane_ & 3, tblk_ = (lane_ >> 4) & 1;
#ifdef ATT_LOADTOP
        if (it + 1 < ntiles) AT2_LOAD(it + 1, tz);
#endif
        const LAS unsigned char* kb = lds + (it & 1) * AT2_BUF; const LAS unsigned char* vb = kb + AT2_KB;
        bf16x8 pf[NQ][2][2];
        f32x16 sc[NQ][2];
#pragma unroll
        for (int nq = 0; nq < NQ; ++nq)
#pragma unroll
            for (int i = 0; i < 16; ++i) { sc[nq][0][i] = 0.f; sc[nq][1][i] = 0.f; }
#pragma unroll
        for (int s = 0; s < 6; ++s) { const bf16x8 a0 = *(const LAS bf16x8*)(kb + r32_ * AT2_KP + (16 * s + 8 * hh_) * 2); const bf16x8 a1 = *(const LAS bf16x8*)(kb + (32 + r32_) * AT2_KP + (16 * s + 8 * hh_) * 2);
#pragma unroll
            for (int nq = 0; nq < NQ; ++nq) { sc[nq][0] = __builtin_amdgcn_mfma_f32_32x32x16_bf16(a0, qf[nq][s], sc[nq][0], 0, 0, 0); sc[nq][1] = __builtin_amdgcn_mfma_f32_32x32x16_bf16(a1, qf[nq][s], sc[nq][1], 0, 0, 0); } }
#pragma unroll
        for (int nq = 0; nq < NQ; ++nq) {
            f32x16& s0 = sc[nq][0]; f32x16& s1 = sc[nq][1];
            float mx = s0[0];
#pragma unroll
            for (int i = 1; i < 16; ++i) mx = fmaxf(mx, s0[i]);
#pragma unroll
            for (int i = 0; i < 16; ++i) mx = fmaxf(mx, s1[i]);
            mx = fmaxf(mx, shx(mx, 32, lane_));
            const float mn = fmaxf(m[nq], mx * ATT_SCALE_LOG2E); const float alpha = __builtin_amdgcn_exp2f(m[nq] - mn); m[nq] = mn;
            float rs = 0.f;
#pragma unroll
            for (int i = 0; i < 16; ++i) { s0[i] = __builtin_amdgcn_exp2f(s0[i] * ATT_SCALE_LOG2E - mn); s1[i] = __builtin_amdgcn_exp2f(s1[i] * ATT_SCALE_LOG2E - mn); rs += s0[i] + s1[i]; }
            l[nq] = l[nq] * alpha + rs;
#pragma unroll
            for (int i = 0; i < 16; ++i) { o[nq][0][i] *= alpha; o[nq][1][i] *= alpha; }
#pragma unroll
            for (int s2 = 0; s2 < 2; ++s2) { v4u w0, w1;
                w0.x = cvtpk(s0[8 * s2 + 0], s0[8 * s2 + 1]); w0.y = cvtpk(s0[8 * s2 + 2], s0[8 * s2 + 3]); w0.z = cvtpk(s0[8 * s2 + 4], s0[8 * s2 + 5]); w0.w = cvtpk(s0[8 * s2 + 6], s0[8 * s2 + 7]);
                w1.x = cvtpk(s1[8 * s2 + 0], s1[8 * s2 + 1]); w1.y = cvtpk(s1[8 * s2 + 2], s1[8 * s2 + 3]); w1.z = cvtpk(s1[8 * s2 + 4], s1[8 * s2 + 5]); w1.w = cvtpk(s1[8 * s2 + 6], s1[8 * s2 + 7]);
                pf[nq][0][s2] = __builtin_bit_cast(bf16x8, w0); pf[nq][1][s2] = __builtin_bit_cast(bf16x8, w1); }
        }
#ifndef ATT_LOADTOP
        if (it + 1 < ntiles) AT2_LOAD(it + 1, tz);
#endif
#pragma unroll
        for (int t = 0; t < 2; ++t)
#pragma unroll
            for (int s2 = 0; s2 < 2; ++s2)
#pragma unroll
                for (int dt = 0; dt < 2; ++dt) {
                    const LAS unsigned char* tb = vb + (t * 32 + 16 * s2 + 4 * hh_ + tq_) * AT2_VP + (32 * dt + 16 * tblk_ + 4 * tp_) * 2;
#ifdef ATT_NOTR
                    bf16x8 vf; { const LAS unsigned short* vp_ = (const LAS unsigned short*)(vb + (t * 32 + 16 * s2 + 4 * hh_) * AT2_VP + (32 * dt + r32_) * 2);
#pragma unroll
                      for (int j_ = 0; j_ < 8; ++j_) vf[j_] = (short)vp_[((j_ & 3) + 8 * (j_ >> 2)) * (AT2_VP / 2)]; }
#else
                    const v2u lo = trread(tb), hi = trread(tb + 8 * AT2_VP); const bf16x8 vf = __builtin_bit_cast(bf16x8, (v4u){lo.x, lo.y, hi.x, hi.y});
#endif
#pragma unroll
                    for (int nq = 0; nq < NQ; ++nq) o[nq][dt] = __builtin_amdgcn_mfma_f32_32x32x16_bf16(vf, pf[nq][t][s2], o[nq][dt], 0, 0, 0); }
        if (it + 1 < ntiles) AT2_WRITE((it + 1) & 1, tz);
        __syncthreads();
    }
#undef AT2_LOAD
#undef AT2_WRITE
#pragma unroll
    for (int nq = 0; nq < NQ; ++nq) { int qrow = q0 + wave * (32 * NQ) + nq * 32 + r32; asm volatile("" : "+v"(qrow));
        const float lt = l[nq] + shx(l[nq], 32, lane); const float inv = 1.f / lt;
        bf16* orow = MIX + (size_t)qrow * D + h * 64 + 4 * hh;
#pragma unroll
        for (int g = 0; g < 4; ++g) {
            v2u w; w.x = pk2(o[nq][0][4 * g] * inv, o[nq][0][4 * g + 1] * inv); w.y = pk2(o[nq][0][4 * g + 2] * inv, o[nq][0][4 * g + 3] * inv); *(v2u*)(orow + 8 * g) = w;
            v2u x; x.x = pk2(o[nq][1][4 * g] * inv, o[nq][1][4 * g + 1] * inv); x.y = pk2(o[nq][1][4 * g + 2] * inv, o[nq][1][4 * g + 3] * inv); *(v2u*)(orow + 32 + 8 * g) = x; } }
}
__device__ __forceinline__ void attn_mfma2(const Args& a, LAS unsigned char* lds) {
#ifdef ATT_NQ1
    for (int u = blockIdx.x; u < 512; u += gridDim.x) attn_unit2<1>(a, lds, u >> 6, (u >> 3) & 7, (u >> 6) * SEQ + (u & 7) * 256, (CTXL + SEQ) / 64, true);
#else
    for (int u = blockIdx.x; u < 256; u += gridDim.x) attn_unit2<2>(a, lds, u >> 5, (u >> 2) & 7, (u >> 5) * SEQ + (u & 3) * 512, (CTXL + SEQ) / 64, true);
#endif
    for (int u = blockIdx.x; u < 64; u += gridDim.x) attn_unit2<1>(a, lds, u >> 3, u & 7, TL + (u >> 3) * CTXL, CTXL / 64, false);
}

template <int R, int PART = 0>
__device__ __forceinline__ void rowwise2(const float* xs_lat, const float* xs_ctx, float* xd_lat, float* xd_ctx, const bf16* Mb, const bf16* Mp, const float* modg, const float* nwA,
                                         bf16* H, const float* modh, int sh_off, int sc_off, const float* nwB, int nrows, int wv) {
    if (PART == 1 && blockIdx.x < 64) return;
    const int tid = otid(wv), wave = wv, lane = tid & 63; const int NGW = gridDim.x * NWAVES, gw = xblk() * NWAVES + wave;
    constexpr int JS = (PART == 2) ? 0 : R - 1;
    const int wq1 = (((int)blockIdx.x >> 3) - 8) * NWAVES + wave, rb1 = 2048 * ((int)blockIdx.x & 7) + wq1 * 10 + min(wq1, 128), cnt1 = 10 + (wq1 < 128 ? 1 : 0);
    const int nlat = min(nrows, TL), nctx = nrows - nlat; const bool even_ = (nlat % NGW == 0) && (nctx % NGW == 0);
    const int rpw = (nrows + NGW - 1) / NGW; const int lpw = even_ ? nlat / NGW : 0, cpw = even_ ? nctx / NGW : 0;
    const int rbeg = (PART != 0 || even_) ? 0 : gw * rpw, rend = PART == 1 ? cnt1 : (PART == 2 ? 1 : (even_ ? lpw + cpw : min(rbeg + rpw, nrows)));
#define RW_ROW(ii) (PART == 1 ? rb1 + (ii) : (PART == 2 ? TL + gw : (even_ ? ((ii) < lpw ? gw * lpw + (ii) : TL + gw * cpw + ((ii) - lpw)) : (ii))))
    f32x4 wAh[4], wBh[4];
#pragma unroll
    for (int q = 0; q < 4; ++q) { wAh[q] = Mb ? *(const f32x4*)(nwA + q * 256 + lane * 4) : (f32x4){0.f, 0.f, 0.f, 0.f}; wBh[q] = H ? *(const f32x4*)(nwB + q * 256 + lane * 4) : (f32x4){0.f, 0.f, 0.f, 0.f}; }
    for (int r0 = rbeg; r0 < rend; r0 += R) {
        f32x4 v[R][4]; v2u mm[R][4], mm2[4];
#pragma unroll
        for (int j = 0; j < R; ++j) { const int r = RW_ROW(min(r0 + j, rend - 1)); const float* xs = r < TL ? xs_lat + (size_t)r * D : xs_ctx + (size_t)(r - TL) * D;
#pragma unroll
            for (int q = 0; q < 4; ++q) v[j][q] = __builtin_nontemporal_load((const f32x4*)(xs + q * 256 + lane * 4));
            if (Mb) { const bool sp = Mp != nullptr && r >= TL; const bf16* m0 = sp ? Mp + (size_t)(r - TL) * D : Mb + (size_t)r * D;
#pragma unroll
                for (int q = 0; q < 4; ++q) mm[j][q] = *(const v2u*)(m0 + q * 256 + lane * 4);
                if (j == JS) {
                    if (sp) {
#pragma unroll
                        for (int q = 0; q < 4; ++q) mm2[q] = *(const v2u*)(m0 + (size_t)TC * D + q * 256 + lane * 4); }
                    else {
#pragma unroll
                        for (int q = 0; q < 4; ++q) mm2[q] = (v2u){0u, 0u}; } } } }
#pragma unroll
        for (int j = 0; j < R; ++j) { if (r0 + j < rend) { const int r = RW_ROW(r0 + j);
            const bool lat = r < TL; const int cond = lat ? (r >> 11) : 8; float* xd = lat ? xd_lat + (size_t)r * D : xd_ctx + (size_t)(r - TL) * D;
            if (Mb) {
                f32x4 m[4]; float ss = 0.f;
#pragma unroll
                for (int q = 0; q < 4; ++q) { const v2u w = mm[j][q]; m[q] = (f32x4){bflo(w.x), bfhi(w.x), bflo(w.y), bfhi(w.y)};
                    if (j == JS) { const v2u w2 = mm2[q]; m[q] = m[q] + (f32x4){bflo(w2.x), bfhi(w2.x), bflo(w2.y), bfhi(w2.y)}; } ss += (m[q][0] * m[q][0] + m[q][1] * m[q][1]) + (m[q][2] * m[q][2] + m[q][3] * m[q][3]); }
                const float rs = rsqrtf(wave_sum(ss, lane) * (1.f / D) + EPS);
#pragma unroll
                for (int q = 0; q < 4; ++q) { const f32x4 g = *(const f32x4*)(modg + (size_t)cond * MODW + q * 256 + lane * 4); const f32x4 w = wAh[q];
                    v[j][q] = v[j][q] + g * (m[q] * rs * w); }
            }
            if (xd_lat) {
#pragma unroll
            for (int q = 0; q < 4; ++q) __builtin_nontemporal_store(v[j][q], (f32x4*)(xd + q * 256 + lane * 4)); }
            if (H) {
                float ss = 0.f;
#pragma unroll
                for (int q = 0; q < 4; ++q) ss += (v[j][q][0] * v[j][q][0] + v[j][q][1] * v[j][q][1]) + (v[j][q][2] * v[j][q][2] + v[j][q][3] * v[j][q][3]);
                const float rs = rsqrtf(wave_sum(ss, lane) * (1.f / D) + EPS);
#pragma unroll
                for (int q = 0; q < 4; ++q) { const int c = q * 256 + lane * 4;
                    const f32x4 w = wBh[q]; const f32x4 sc = *(const f32x4*)(modh + (size_t)cond * MODW + sc_off + c); const f32x4 sh = *(const f32x4*)(modh + (size_t)cond * MODW + sh_off + c);
                    const f32x4 hv = (v[j][q] * rs * w) * (sc + 1.0f) + sh;
                    v2u o; o.x = pk2(hv[0], hv[1]); o.y = pk2(hv[2], hv[3]); *(v2u*)(H + (size_t)r * D + c) = o; }
            } } }
    }
}
#undef RW_ROW

__device__ __forceinline__ void convgate2(const Args& a, int l, int nrows) {
    const bf16* U = (const bf16*)(a.ws + WS_U); bf16* G = (bf16*)(a.ws + WS_G); const float* cw = a.in[I_FCONV] + (size_t)l * 3 * UPW;
    const int total = (nrows / 8) * (DFF / 8);
    for (int idx = blockIdx.x * NTHR + otid(a.wv); idx < total; idx += gridDim.x * NTHR) {
        const int r0 = (idx / (DFF / 8)) * 8, c0 = (idx % (DFF / 8)) * 8; const bf16* u = U + (size_t)r0 * UPW + c0;
        const bool hp = has_prev(r0), hn = has_next(r0 + 7);
        v4u ua[10], ug[10];
#pragma unroll
        for (int j = 0; j < 10; ++j) { const int rr = (j == 0 && !hp) ? 0 : ((j == 9 && !hn) ? 7 : j - 1); ua[j] = *(const v4u*)(u + (ptrdiff_t)rr * UPW); ug[j] = *(const v4u*)(u + (ptrdiff_t)rr * UPW + DFF); }
        float wa[3][8], wg[3][8];
#pragma unroll
        for (int t = 0; t < 3; ++t)
#pragma unroll
            for (int j = 0; j < 8; ++j) { wa[t][j] = cw[t * UPW + c0 + j]; wg[t][j] = cw[t * UPW + DFF + c0 + j]; }
        if (!hp) { ua[0] = (v4u){0u, 0u, 0u, 0u}; ug[0] = ua[0]; }
        if (!hn) { ua[9] = (v4u){0u, 0u, 0u, 0u}; ug[9] = ua[9]; }
        float pa[8], ca[8], na[8], pg[8], cg_[8], ng[8];
        unpack8(ua[0], pa); unpack8(ug[0], pg); unpack8(ua[1], ca); unpack8(ug[1], cg_);
#pragma unroll
        for (int j = 0; j < 8; ++j) {
            unpack8(ua[j + 2], na); unpack8(ug[j + 2], ng);
            float o[8];
#pragma unroll
            for (int k = 0; k < 8; ++k) { const float act = wa[0][k] * pa[k] + wa[1][k] * ca[k] + wa[2][k] * na[k]; const float gate = wg[0][k] * pg[k] + wg[1][k] * cg_[k] + wg[2][k] * ng[k]; o[k] = silu_f(act) * gate; }
            *(v4u*)(G + (size_t)(r0 + j) * DFF + c0) = pack8(o);
#pragma unroll
            for (int k = 0; k < 8; ++k) { pa[k] = ca[k]; ca[k] = na[k]; pg[k] = cg_[k]; cg_[k] = ng[k]; }
        }
    }
}

__device__ __forceinline__ void ssd_conv2(const Args& a, int i) {
    const bf16* ZX = (const bf16*)(a.ws + WS_ZX); bf16* XBC = (bf16*)(a.ws + WS_XBC); float* DT = (float*)(a.ws + WS_DT); float* AA = (float*)(a.ws + WS_AA);
    const float* cw = a.in[I_SCONVW] + (size_t)i * 3 * 3072; const float* cb = a.in[I_SCONVB] + (size_t)i * 3072;
    const int total = (T / 8) * 384; const int per = (total + (int)gridDim.x - 1) / (int)gridDim.x, ibase = xblk() * per;
    for (int k_ = otid(a.wv); k_ < per; k_ += NTHR) { const int idx = ibase + k_; if (idx >= total) break;
        const int r0 = (idx / 384) * 8, c0 = (idx % 384) * 8; const bf16* u = ZX + (size_t)r0 * SSD_INP + 2048 + c0;
        const bool hp = has_prev(r0), hn = has_next(r0 + 7);
        v4u ux[10];
#pragma unroll
        for (int j = 0; j < 10; ++j) { const int rr = (j == 0 && !hp) ? 0 : ((j == 9 && !hn) ? 7 : j - 1); ux[j] = *(const v4u*)(u + (ptrdiff_t)rr * SSD_INP); }
        float w[3][8], bias[8];
#pragma unroll
        for (int j = 0; j < 8; ++j) { w[0][j] = cw[c0 + j]; w[1][j] = cw[3072 + c0 + j]; w[2][j] = cw[2 * 3072 + c0 + j]; bias[j] = cb[c0 + j]; }
        if (!hp) ux[0] = (v4u){0u, 0u, 0u, 0u};
        if (!hn) ux[9] = (v4u){0u, 0u, 0u, 0u};
        float p[8], c[8], n[8];
        unpack8(ux[0], p); unpack8(ux[1], c);
#pragma unroll
        for (int j = 0; j < 8; ++j) {
            unpack8(ux[j + 2], n); float o[8];
#pragma unroll
            for (int k = 0; k < 8; ++k) o[k] = silu_f(bias[k] + w[0][k] * p[k] + w[1][k] * c[k] + w[2][k] * n[k]);
            *(v4u*)(XBC + (size_t)(r0 + j) * 3072 + c0) = pack8(o);
#pragma unroll
            for (int k = 0; k < 8; ++k) { p[k] = c[k]; c[k] = n[k]; }
        }
    }
    const float* alog = a.in[I_ALOG] + i * 64; const float* dtb = a.in[I_DTB] + i * 64;
    const int per2 = (T * 8 + (int)gridDim.x - 1) / (int)gridDim.x, ibase2 = xblk() * per2;
    for (int k_ = otid(a.wv); k_ < per2; k_ += NTHR) { const int idx = ibase2 + k_; if (idx >= T * 8) break;
        const int r = idx >> 3, j0 = (idx & 7) * 8; float raw[8], dt[8], av[8];
        unpack8(*(const v4u*)(ZX + (size_t)r * SSD_INP + 5120 + j0), raw);
#pragma unroll
        for (int k = 0; k < 8; ++k) { const float x = raw[k] + dtb[j0 + k]; dt[k] = x > 15.f ? x : (x < -15.f ? __expf(x) : __logf(1.f + __expf(x))); av[k] = -__expf(alog[j0 + k]) * dt[k]; }
        *(f32x4*)(DT + (size_t)r * 64 + j0) = (f32x4){dt[0], dt[1], dt[2], dt[3]}; *(f32x4*)(DT + (size_t)r * 64 + j0 + 4) = (f32x4){dt[4], dt[5], dt[6], dt[7]};
        *(f32x4*)(AA + (size_t)r * 64 + j0) = (f32x4){av[0], av[1], av[2], av[3]}; *(f32x4*)(AA + (size_t)r * 64 + j0 + 4) = (f32x4){av[4], av[5], av[6], av[7]};
    }
}

__device__ __forceinline__ void gatenorm2(const Args& a, int i, int nrows) {
    const int tid = otid(a.wv), wave = a.wv, lane = tid & 63; const int NGW = gridDim.x * NWAVES, gw = blockIdx.x * NWAVES + wave;
    const bf16* ZX = (const bf16*)(a.ws + WS_ZX); bf16* YN = (bf16*)(a.ws + WS_XBC); const float* nw = a.in[I_SNORM] + i * 2048;
    const int rpw = (nrows + NGW - 1) / NGW; const int rbeg = gw * rpw, rend = min(rbeg + rpw, nrows);
    constexpr int R = 3;
    for (int r0 = rbeg; r0 < rend; r0 += R) {
        v4u yv[R][4], zv[R][4];
#pragma unroll
        for (int j = 0; j < R; ++j) { const int r = min(r0 + j, rend - 1);
#pragma unroll
            for (int q = 0; q < 4; ++q) { const int c = q * 512 + lane * 8; yv[j][q] = *(const v4u*)(ZX + (size_t)r * SSD_INP + 2048 + c); zv[j][q] = *(const v4u*)(ZX + (size_t)r * SSD_INP + c); } }
#pragma unroll
        for (int j = 0; j < R; ++j) { const int r = r0 + j; if (r < rend) {
            float v[4][8]; float ss = 0.f;
#pragma unroll
            for (int q = 0; q < 4; ++q) { float y[8], z[8]; unpack8(yv[j][q], y); unpack8(zv[j][q], z);
#pragma unroll
                for (int k = 0; k < 8; ++k) { v[q][k] = y[k] * silu_f(z[k]); ss += v[q][k] * v[q][k]; } }
            const float rs = rsqrtf(wave_sum(ss, lane) * (1.f / 2048.f) + EPS);
#pragma unroll
            for (int q = 0; q < 4; ++q) { const int c = q * 512 + lane * 8; float o[8];
#pragma unroll
                for (int k = 0; k < 8; ++k) o[k] = v[q][k] * rs * nw[c + k];
                *(v4u*)(YN + (size_t)r * 2048 + c) = pack8(o); } } }
    }
}

__device__ __forceinline__ void ffn_fixup(const Args& a, int l, int nrows) {
    const bf16* Ue = (const bf16*)(a.ws + WS_UE); bf16* G = (bf16*)(a.ws + WS_G); const float* cw = a.in[I_FCONV] + (size_t)l * 3 * UPW;
    const int total = (nrows / 256) * 2 * (DFF / 8);
    for (int idx = blockIdx.x * NTHR + otid(a.wv); idx < total; idx += gridDim.x * NTHR) {
        const int cg = idx % (DFF / 8), which = (idx / (DFF / 8)) & 1, pm = idx / (2 * (DFF / 8)); const int c0 = cg * 8; const int col = (c0 / 128) * 256 + (c0 % 128);
        const int r = pm * 256 + (which ? 255 : 0);
        const bf16* e0 = Ue + (size_t)(pm * 4) * UPW + col;
        const bf16* pp = which ? e0 + 2 * UPW : e0 - UPW;
        const bf16* pc = which ? e0 + 3 * UPW : e0;
        const bf16* pn = which ? e0 + 4 * UPW : e0 + UPW;
        const bool hp = which ? true : has_prev(r), hn = which ? has_next(r) : true;
        float pa[8], pg[8], ca[8], cg_[8], na[8], ng[8];
        unpack8(*(const v4u*)pc, ca); unpack8(*(const v4u*)(pc + 128), cg_);
        if (hp) { unpack8(*(const v4u*)pp, pa); unpack8(*(const v4u*)(pp + 128), pg); } else {
#pragma unroll
            for (int k = 0; k < 8; ++k) { pa[k] = 0.f; pg[k] = 0.f; } }
        if (hn) { unpack8(*(const v4u*)pn, na); unpack8(*(const v4u*)(pn + 128), ng); } else {
#pragma unroll
            for (int k = 0; k < 8; ++k) { na[k] = 0.f; ng[k] = 0.f; } }
        float o[8];
#pragma unroll
        for (int k = 0; k < 8; ++k) { const float act = cw[c0 + k] * pa[k] + cw[UPW + c0 + k] * ca[k] + cw[2 * UPW + c0 + k] * na[k];
            const float gate = cw[DFF + c0 + k] * pg[k] + cw[UPW + DFF + c0 + k] * cg_[k] + cw[2 * UPW + DFF + c0 + k] * ng[k]; o[k] = silu_f(act) * gate; }
        *(v4u*)(G + (size_t)r * DFF + c0) = pack8(o);
    }
}

__device__ __forceinline__ void prep_even2(const Args& a, int i) {
    const int tid = otid(a.wv), wave = a.wv, lane = tid & 63; const int NGW = gridDim.x * NWAVES, gw = xblk() * NWAVES + wave;
    const bf16* P = (const bf16*)(a.ws + WS_P); bf16* CQN = (bf16*)(a.ws + WS_CQN); bf16* CKVN = (bf16*)(a.ws + WS_CKVN); bf16* KR = (bf16*)(a.ws + WS_KR); bf16* MIX = (bf16*)(a.ws + WS_MIX);
    const float* qn = a.in[I_QNORM] + i * 384; const float* kvn = a.in[I_KVNORM] + i * 256; const float* cw = a.in[I_SCONV] + i * 3 * 512;
    const float* ct = (const float*)(a.ws + WS_ROPE); const float* st = ct + SEQ * 16;
    constexpr int R = 3; const int rpw = (T + NGW - 1) / NGW; const int rbeg = gw * rpw, rend = min(rbeg + rpw, T);
    const int c0 = lane * 8;
    for (int r0 = rbeg; r0 < rend; r0 += R) {
        unsigned q32[R][3]; v2u kv2[R]; bf16 krv[R]; v4u gbv[R], gcv[R + 2], xvv[R + 2];
#pragma unroll
        for (int j = 0; j < R; ++j) { const int r = min(r0 + j, rend - 1); const bf16* p = P + (size_t)r * HYB_INP;
            const unsigned* p32 = (const unsigned*)(p + lane * 6); q32[j][0] = p32[0]; q32[j][1] = p32[1]; q32[j][2] = p32[2];
            kv2[j] = *(const v2u*)(p + 384 + lane * 4); krv[j] = p[640 + (lane & 31)]; gbv[j] = *(const v4u*)(p + 672 + c0); }
#pragma unroll
        for (int j = 0; j < R + 2; ++j) { int r = r0 + j - 1; r = max(0, min(r, T - 1)); const bf16* p = P + (size_t)r * HYB_INP; gcv[j] = *(const v4u*)(p + 1184 + c0); xvv[j] = *(const v4u*)(p + 1696 + c0); }
#pragma unroll
        for (int j = 0; j < R; ++j) { const int r = r0 + j; if (r < rend) {
            {   float f[6] = {bflo(q32[j][0]), bfhi(q32[j][0]), bflo(q32[j][1]), bfhi(q32[j][1]), bflo(q32[j][2]), bfhi(q32[j][2])}; float ss = 0.f;
#pragma unroll
                for (int k = 0; k < 6; ++k) ss += f[k] * f[k];
                const float rs = rsqrtf(wave_sum(ss, lane) * (1.f / 384.f) + EPS);
#pragma unroll
                for (int k = 0; k < 6; ++k) f[k] = f[k] * rs * qn[lane * 6 + k];
                unsigned* o32 = (unsigned*)(CQN + (size_t)r * 384 + lane * 6); o32[0] = pk2(f[0], f[1]); o32[1] = pk2(f[2], f[3]); o32[2] = pk2(f[4], f[5]); }
            {   const v2u w = kv2[j]; float f[4] = {bflo(w.x), bfhi(w.x), bflo(w.y), bfhi(w.y)};
                const float ss = (f[0] * f[0] + f[1] * f[1]) + (f[2] * f[2] + f[3] * f[3]);
                const float rs = rsqrtf(wave_sum(ss, lane) * (1.f / 256.f) + EPS);
                const f32x4 g = *(const f32x4*)(kvn + lane * 4);
                v2u o; o.x = pk2(f[0] * rs * g[0], f[1] * rs * g[1]); o.y = pk2(f[2] * rs * g[2], f[3] * rs * g[3]); *(v2u*)(CKVN + (size_t)r * 256 + lane * 4) = o; }
            {   const int jj = lane & 31; const float v = bf1(krv[j]); const float o = shx(v, 16, lane); float res = v;
                if (r < TL) { const int t = r & (SEQ - 1); const float c = ct[t * 16 + (jj & 15)], s = st[t * 16 + (jj & 15)]; res = (jj < 16) ? v * c - o * s : o * s + v * c; }
                if (lane < 32) KR[(size_t)r * 32 + jj] = (bf16)f2bf(res); }
            {   float gb[8], t0[8], t1[8], acc[8];
                unpack8(gbv[j], gb); unpack8(gcv[j + 1], t0); unpack8(xvv[j + 1], t1);
#pragma unroll
                for (int k = 0; k < 8; ++k) acc[k] = cw[512 + c0 + k] * (t0[k] * t1[k]);
                if (has_prev(r)) { unpack8(gcv[j], t0); unpack8(xvv[j], t1);
#pragma unroll
                    for (int k = 0; k < 8; ++k) acc[k] += cw[c0 + k] * (t0[k] * t1[k]); }
                if (has_next(r)) { unpack8(gcv[j + 2], t0); unpack8(xvv[j + 2], t1);
#pragma unroll
                    for (int k = 0; k < 8; ++k) acc[k] += cw[1024 + c0 + k] * (t0[k] * t1[k]); }
#pragma unroll
                for (int k = 0; k < 8; ++k) acc[k] *= gb[k];
                *(v4u*)(MIX + (size_t)r * D + 512 + c0) = pack8(acc); }
        } }
    }
}

__device__ __forceinline__ void ffn_fixup_panel(const Args& a, int l, int pm) {
    const bf16* Ue = (const bf16*)(a.ws + WS_UE); bf16* G = (bf16*)(a.ws + WS_G); const float* cw = a.in[I_FCONV] + (size_t)l * 3 * UPW;
    for (int idx = otid(a.wv); idx < 2 * (DFF / 8); idx += NTHR) {
        const int cg = idx % (DFF / 8), which = idx / (DFF / 8); const int c0 = cg * 8; const int col = (c0 / 128) * 256 + (c0 % 128);
        const int r = pm * 256 + (which ? 255 : 0);
        const bf16* e0 = Ue + (size_t)(pm * 4) * UPW + col;
        const bf16* pp = which ? e0 + 2 * UPW : e0 - UPW; const bf16* pc = which ? e0 + 3 * UPW : e0; const bf16* pn = which ? e0 + 4 * UPW : e0 + UPW;
        const bool hp = which ? true : has_prev(r), hn = which ? has_next(r) : true;
        float pa[8], pg[8], ca[8], cg_[8], na[8], ng[8];
        unpack8(*(const v4u*)pc, ca); unpack8(*(const v4u*)(pc + 128), cg_);
        if (hp) { unpack8(*(const v4u*)pp, pa); unpack8(*(const v4u*)(pp + 128), pg); } else {
#pragma unroll
            for (int k = 0; k < 8; ++k) { pa[k] = 0.f; pg[k] = 0.f; } }
        if (hn) { unpack8(*(const v4u*)pn, na); unpack8(*(const v4u*)(pn + 128), ng); } else {
#pragma unroll
            for (int k = 0; k < 8; ++k) { na[k] = 0.f; ng[k] = 0.f; } }
        float o[8];
#pragma unroll
        for (int k = 0; k < 8; ++k) { const float act = cw[c0 + k] * pa[k] + cw[UPW + c0 + k] * ca[k] + cw[2 * UPW + c0 + k] * na[k];
            const float gate = cw[DFF + c0 + k] * pg[k] + cw[UPW + DFF + c0 + k] * cg_[k] + cw[2 * UPW + DFF + c0 + k] * ng[k]; o[k] = silu_f(act) * gate; }
        *(v4u*)(G + (size_t)r * DFF + c0) = pack8(o);
    }
}

__device__ __forceinline__ void ssd_rstd_panel(const Args& a, int pm) {
    const float* SS = (const float*)(a.ws + WS_SS); float* RS = (float*)(a.ws + WS_RS);
    const int t = otid(a.wv); const int row = pm * 256 + (t >> 1), half = t & 1;
    const f32x4* p = (const f32x4*)(SS + (size_t)row * 64 + half * 32);
    f32x4 s = p[0];
#pragma unroll
    for (int k = 1; k < 8; ++k) s = s + p[k];
    float v = (s[0] + s[1]) + (s[2] + s[3]); v += shx(v, 1, t & 63);
    if (!half) RS[row] = rsqrtf(v * (1.f / 2048.f) + EPS);
}

#ifndef MK_SINGLE
#define MK_SINGLE 1
#endif
struct GemmDesc { const bf16* A; const bf16* Bt; int M, N, K; bf16* O; int ldc; int mode; int lda; int ldb; int ksplit; int kso; int rsoff; int coff; };

__global__ void __launch_bounds__(NTHR, 2) fwd_kernel(Args a_in) {
    extern __shared__ __attribute__((aligned(16))) unsigned char lds_raw[];
    LAS unsigned char* lds = (LAS unsigned char*)lds_raw;
#if MK_SINGLE == 1
    volatile LAS unsigned* bst = (volatile LAS unsigned*)(lds + LDS_BYTES - 64);
    const int wv0 = __builtin_amdgcn_readfirstlane((int)threadIdx.x >> 6);
    { const int t0 = otid(wv0); if (t0 < 16) bst[t0] = 0u; }
    __syncthreads();
    const XcdBarrier xbar = xcd_barrier_post((unsigned*)(a_in.ws + WS_CTL), bst, wv0);
#endif
    const Args& a0 = a_in;
#ifdef TDIAG
    unsigned long long tcat[6] = {0, 0, 0, 0, 0, 0}; unsigned long long tlast = __builtin_amdgcn_s_memrealtime();
#endif
    for (int s = a0.lo; s < a0.hi; ++s) {
        Args a = a0;
        { long oz; asm volatile("s_mov_b64 %0, 0" : "=s"(oz));
#pragma unroll
          for (int q = 0; q < 25; ++q) a.in[q] = (const float*)((const char*)a0.in[q] + oz);
          a.out = (float*)((char*)a0.out + oz); a.ws = a0.ws + oz; a.wv = wv0; }
        unsigned char* ws = a.ws;
        float* XL = a.out; float* XC = (float*)(ws + WS_XC); bf16* H = (bf16*)(ws + WS_H); bf16* Mb = (bf16*)(ws + WS_M); bf16* Mp = (bf16*)(ws + WS_MP);
        const float* MOD = (const float*)(ws + WS_MOD); const float* NW = a.in[I_NORMW];
        int nrep = 1;
#ifdef PROBE_MASK
        if (s == 0 && (PROBE_MASK >> 20 & 1u)) nrep = 2;
        if (s >= 2) { const int pk = (s - 2) % 10, ppar = ((s - 2) / 10) & 1; if ((PROBE_MASK >> (pk + 10 * ppar)) & 1u) nrep = 2; }
#endif
        for (int rep = 0; rep < nrep; ++rep) {
        GemmDesc g0{}, g1{}; int ng = 0;
#ifndef NO_SIMPLE
        if (s == 0) {
            mod_compute(a, lds);
            rope_tables(a);
            convert_layer(a, 0, lds);
        } else if (s == 1) {
            rowwise2<3>(a.in[I_X], a.in[I_CTX], nullptr, nullptr, nullptr, nullptr, nullptr, nullptr, H, MOD, 0, 1024, NW, T, a.wv);
        } else {
            const int l = (s - 2) / 10, k = (s - 2) % 10, i = l >> 1; const bool even = (l & 1) == 0, last = (l == 3);
            const int MR = last ? TL : T;
            const bool splitk = !last && gridDim.x == 256;
            const int MG = splitk ? TL : MR;
            switch (k) {
            case 0:
                if (even) { g0 = GemmDesc{H, (const bf16*)(ws + W_IN), T, HYB_INP, D, (bf16*)(ws + WS_P), HYB_INP}; ng = 1; }
                else      { g0 = GemmDesc{H, (const bf16*)(ws + W_IN), T, SSD_INP, D, (bf16*)(ws + WS_ZX), SSD_INP}; ng = 1; }
                break;
            case 1: if (even) prep_even2(a, i); else ssd_conv2(a, i); break;
            case 2:
                if (even) { g0 = GemmDesc{(const bf16*)(ws + WS_CKVN), (const bf16*)(ws + W_UKV), T, KVW, 256, (bf16*)(ws + WS_KV), KVW};
                            g1 = GemmDesc{(const bf16*)(ws + WS_CQN), (const bf16*)(ws + W_UQ), T, QW, 384, (bf16*)(ws + WS_Q), QW}; g1.coff = (gridDim.x == 256) ? 216 : 0; ng = 2; }
                else {
#ifdef SSD_NAIVE
 ssd_scan_naive(a, i, last, lds);
#else
 ssd_scan_mfma(a, i, last, lds);
#endif
 }
                break;
            case 3: if (even) {
#ifdef ATTN_NAIVE
 attn_naive(a, lds);
#else
 attn_mfma(a, lds);
#endif
 } else if (splitk) {
                g0 = GemmDesc{(const bf16*)(ws + WS_XBC), (const bf16*)(ws + W_OUT), TL, D, 2048, Mb, D, 2, 3072}; ng = 1;
                pg8::StaticOrder S0; pg8::Unit u0; int lastpm = -1; S0.init(TL, D, (int)gridDim.x, (int)blockIdx.x);
                for (int ui0 = 0; S0.next(ui0, u0); ++ui0) if (u0.pm != lastpm) { ssd_rstd_panel(a, u0.pm); lastpm = u0.pm; }
                S0.init(TC, D, (int)gridDim.x, (int)blockIdx.x, 2); lastpm = -1;
                for (int ui0 = 0; S0.next(ui0, u0); ++ui0) if (u0.pm != lastpm) { ssd_rstd_panel(a, TL / 256 + u0.pm); lastpm = u0.pm; }
                asm volatile("s_waitcnt vmcnt(0)" ::: "memory"); __syncthreads(); }
                break;
            case 4:
                if (even) { g0 = GemmDesc{(const bf16*)(ws + WS_MIX), (const bf16*)(ws + W_OUT), MG, D, D, Mb, D}; ng = 1;
                            if (splitk) { g1 = GemmDesc{(const bf16*)(ws + WS_MIX) + (size_t)TL * D, (const bf16*)(ws + W_OUT), TC, D, D / 2, Mp, D, 0, D, D, 2, TC * D, 0}; ng = 2; } }
                else if (splitk) {
                            g0 = GemmDesc{(const bf16*)(ws + WS_XBC) + (size_t)TL * 3072, (const bf16*)(ws + W_OUT), TC, D, 1024, Mp, D, 2, 3072, 2048, 2, TC * D, TL}; ng = 1;
                            rowwise2<3, 1>(XL, XC, XL, XC, Mb, nullptr, MOD + (size_t)l * 9 * MODW + 2048, NW + (l * 4 + 1) * D, H, MOD + (size_t)l * 9 * MODW, 3072, 4096, NW + (l * 4 + 2) * D, TL, a.wv); }
                else      { g0 = GemmDesc{(const bf16*)(ws + WS_XBC), (const bf16*)(ws + W_OUT), MG, D, 2048, Mb, D, 2, 3072}; ng = 1;
                            if (splitk) { g1 = GemmDesc{(const bf16*)(ws + WS_XBC) + (size_t)TL * 3072, (const bf16*)(ws + W_OUT), TC, D, 1024, Mp, D, 2, 3072, 2048, 2, TC * D, TL}; ng = 2; }
                            pg8::StaticOrder S0; pg8::Unit u0; int lastpm = -1; S0.init(MG, D, (int)gridDim.x, (int)blockIdx.x);
                            for (int ui0 = 0; S0.next(ui0, u0); ++ui0) if (u0.pm != lastpm) { ssd_rstd_panel(a, u0.pm); lastpm = u0.pm; }
                            if (splitk) { S0.init(TC, D, (int)gridDim.x, (int)blockIdx.x, 2); lastpm = -1;
                                for (int ui0 = 0; S0.next(ui0, u0); ++ui0) if (u0.pm != lastpm) { ssd_rstd_panel(a, TL / 256 + u0.pm); lastpm = u0.pm; } }
                            asm volatile("s_waitcnt vmcnt(0)" ::: "memory"); __syncthreads(); }
                break;
            case 5:
#ifdef PROBE_ROW2
                if (l > 0) rowwise2<3>(XL, XC, XL, XC, nullptr, nullptr, nullptr, nullptr, H, MOD + (size_t)l * 9 * MODW, 0, 1024, NW + (l * 4 + 0) * D, MR, a.wv);
#endif
                if (!even && splitk) rowwise2<3, 2>(XL, XC, XL, XC, Mb, Mp, MOD + (size_t)l * 9 * MODW + 2048, NW + (l * 4 + 1) * D, H, MOD + (size_t)l * 9 * MODW, 3072, 4096, NW + (l * 4 + 2) * D, T, a.wv);
                else rowwise2<3>(l == 0 ? a.in[I_X] : XL, l == 0 ? a.in[I_CTX] : XC, XL, XC, Mb, splitk ? Mp : nullptr, MOD + (size_t)l * 9 * MODW + 2048, NW + (l * 4 + 1) * D, H, MOD + (size_t)l * 9 * MODW, 3072, 4096, NW + (l * 4 + 2) * D, MR, a.wv); break;
            case 6: { g0 = GemmDesc{H, (const bf16*)(ws + W_UP), MR, UPW, D, (bf16*)(ws + WS_G), DFF, 1}; ng = 1; } break;
            case 7:
                if (splitk) { g0 = GemmDesc{(const bf16*)(ws + WS_G), (const bf16*)(ws + W_DN), TL, D, DFF, Mb, D}; ng = 1;
                    pg8::StaticOrder S0; pg8::Unit u0; int lastpm = -1; S0.init(TL, D, (int)gridDim.x, (int)blockIdx.x);
                    for (int ui0 = 0; S0.next(ui0, u0); ++ui0) if (u0.pm != lastpm) { ffn_fixup_panel(a, l, u0.pm); lastpm = u0.pm; }
                    asm volatile("s_waitcnt vmcnt(0)" ::: "memory"); __syncthreads(); }
                break;
            case 8:
                if (splitk) {
                    g0 = GemmDesc{(const bf16*)(ws + WS_G) + (size_t)TL * DFF, (const bf16*)(ws + W_DN), TC, D, DFF / 2, Mp, D, 0, DFF, DFF, 2, TC * D, 0}; ng = 1;
                    { pg8::StaticOrder S0; pg8::Unit u0; int lastpm = -1; S0.init(TC, D, (int)gridDim.x, (int)blockIdx.x, 2);
                      for (int ui0 = 0; S0.next(ui0, u0); ++ui0) if (u0.pm != lastpm) { ffn_fixup_panel(a, l, TL / 256 + u0.pm); lastpm = u0.pm; }
                      asm volatile("s_waitcnt vmcnt(0)" ::: "memory"); __syncthreads(); }
                    rowwise2<3, 1>(XL, XC, XL, XC, Mb, nullptr, MOD + (size_t)l * 9 * MODW + 5120, NW + (l * 4 + 3) * D, H, MOD + (size_t)(l + 1) * 9 * MODW, 0, 1024, NW + ((l + 1) * 4 + 0) * D, TL, a.wv);
                } else { g0 = GemmDesc{(const bf16*)(ws + WS_G), (const bf16*)(ws + W_DN), MR, D, DFF, Mb, D}; ng = 1;
                    pg8::StaticOrder S0; pg8::Unit u0; int lastpm = -1; S0.init(MR, D, (int)gridDim.x, (int)blockIdx.x);
                    for (int ui0 = 0; S0.next(ui0, u0); ++ui0) if (u0.pm != lastpm) { ffn_fixup_panel(a, l, u0.pm); lastpm = u0.pm; }
                    asm volatile("s_waitcnt vmcnt(0)" ::: "memory"); __syncthreads(); }
                break;
            case 9:
                if (splitk) { rowwise2<3, 2>(XL, XC, XL, XC, Mb, Mp, MOD + (size_t)l * 9 * MODW + 5120, NW + (l * 4 + 3) * D, H, MOD + (size_t)(l + 1) * 9 * MODW, 0, 1024, NW + ((l + 1) * 4 + 0) * D, T, a.wv);
                              convert_layer(a, l + 1, lds); }
                else if (!last) { rowwise2<3>(XL, XC, XL, XC, Mb, nullptr, MOD + (size_t)l * 9 * MODW + 5120, NW + (l * 4 + 3) * D, H, MOD + (size_t)(l + 1) * 9 * MODW, 0, 1024, NW + ((l + 1) * 4 + 0) * D, T, a.wv);
                             convert_layer(a, l + 1, lds); }
                else rowwise2<3>(XL, XC, XL, XC, Mb, nullptr, MOD + (size_t)l * 9 * MODW + 5120, NW + (l * 4 + 3) * D, nullptr, MOD, 0, 0, NW, TL, a.wv);
                break;
            }
        }
#else
        { g0 = GemmDesc{H, (const bf16*)(ws + W_IN), T, a.hi * 256, a.lo * 128, (bf16*)(ws + WS_P), HYB_INP}; ng = 1; }
#endif
        for (int gi = 0; gi < ng; ++gi) {
            const bool f = (gi == 0);
            const int lda_ = f ? g0.lda : g1.lda, K_ = f ? g0.K : g1.K, ldb_ = f ? g0.ldb : g1.ldb, ksp_ = f ? g0.ksplit : g1.ksplit;
            pg8::Gemm g{f ? g0.A : g1.A, f ? g0.Bt : g1.Bt, f ? g0.M : g1.M, f ? g0.N : g1.N, K_, a.wv,
#ifdef GDIAG
                (s == GDIAG_STEP) ? (float*)(a0.ws + WS_MOD + 900 * 1024) : nullptr
#else
                nullptr
#endif
                , lda_ ? lda_ : K_, ldb_ ? ldb_ : K_}; pg8::StaticOrder S; S.init(g.M, g.N, (int)gridDim.x, ((int)blockIdx.x + (f ? g0.coff : g1.coff)) % (int)gridDim.x, ksp_ ? ksp_ : 1);
            pg8::EpiFfn E{f ? g0.O : g1.O, f ? g0.ldc : g1.ldc, f ? g0.mode : g1.mode, f ? g0.kso : g1.kso, (const float*)(ws + WS_RS) + (f ? g0.rsoff : g1.rsoff), (bf16*)(ws + WS_UE), a.in[I_FCONV] + (size_t)((s - 2) / 10) * 3 * UPW, (LAS pg8::f32x4*)(lds + 131072), a.wv};
#ifndef NO_GEMM
            pg8::gemm_phase<pg8::EpiFfn, pg8::StaticOrder, true, true>(lds, g, S, E);
#endif
            __syncthreads();
        }
        if (rep + 1 < nrep) __syncthreads();
        }
#ifdef GDIAG
        if (s + 1 == a0.hi) { __syncthreads(); asm volatile("s_waitcnt vmcnt(0)" ::: "memory"); if (blockIdx.x == 0 && otid(wv0) == 0) { const float* dg = (const float*)(a0.ws + WS_MOD + 900 * 1024); a0.out[0] += 25.0f * dg[GDIAG_SEL] / dg[3]; } }
#endif
#ifdef SSD_DIAG
        if (s + 1 == a0.hi) { __syncthreads(); asm volatile("s_waitcnt vmcnt(0)" ::: "memory"); if (blockIdx.x == 0 && otid(wv0) == 0) { const float* dg = (const float*)(a0.ws + WS_MOD + 900 * 1024); a0.out[0] += 25.0f * dg[SSD_DIAG_SEL] / dg[7]; } }
#endif
#ifdef TDIAG
        if (s + 1 == a0.hi) { __syncthreads(); }
#endif
#ifdef BLK_JITTER
        if ((((int)blockIdx.x * 7 + s * 3) % 11) == 0) { for (int q = 0; q < 40; ++q) __builtin_amdgcn_s_sleep(127); }
#endif
        if (s + 1 < a0.hi && !(s >= 2 && (((s - 2) % 10 == 7 && ((s - 2) / 10 == 3 || gridDim.x != 256)) || ((s - 2) % 10 == 3 && (((s - 2) / 10) & 1) && ((s - 2) / 10 == 3 || gridDim.x != 256))))) {
#if MK_SINGLE == 1
            xcd_barrier(xbar);
#ifdef PROBE_BAR2
            xcd_barrier(xbar);
#endif
#elif MK_SINGLE == 2
            cg::this_grid().sync();
#endif
        }
#ifdef TDIAG
        { const unsigned long long tn = __builtin_amdgcn_s_memrealtime(); int cat = 0;
          if (s >= 2) { const int k = (s - 2) % 10, par = ((s - 2) / 10) & 1; cat = (k == 0 || k == 4 || k == 6 || k == 8 || (k == 2 && par == 0)) ? 1 : ((k == 5 || k == 9) ? 2 : ((k == 3 && par == 0) ? 4 : ((k == 2 && par == 1) ? 5 : 3)));
#ifdef TDIAG_K
              cat = (k == TDIAG_K && (TDIAG_PAR == 2 || par == TDIAG_PAR)) ? 1 : 3;
#endif
          }
#pragma unroll
          for (int q = 0; q < 6; ++q) if (q == cat) tcat[q] += tn - tlast;
          tlast = tn;
          if (s + 1 == a0.hi) { asm volatile("s_waitcnt vmcnt(0)" ::: "memory"); if (blockIdx.x == 0 && otid(wv0) == 0) { unsigned long long tt = 0;
#pragma unroll
              for (int q = 0; q < 6; ++q) tt += tcat[q];
              a0.out[0] += (TDIAG == 6) ? (float)tt * (1.0f / 20000.0f) : 25.0f * (float)tcat[TDIAG < 6 ? TDIAG : 0] / (float)tt; } } }
#endif
    }
}

extern "C" void kernel_launch(void* const* d_in, const int* in_sizes, int n_in, void* d_out, int out_size, void* d_ws, size_t ws_size, hipStream_t stream) {
    static int grid = 0;
    if (grid == 0) {
        if (n_in != 25 || out_size != TL * D || ws_size < WS_END) { fprintf(stderr, "kernel_launch: unexpected problem (n_in %d out %d ws %zu need %zu)\n", n_in, out_size, ws_size, (size_t)WS_END); grid = -1; return; }
        if (hipFuncSetAttribute((const void*)fwd_kernel, hipFuncAttributeMaxDynamicSharedMemorySize, LDS_BYTES) != hipSuccess) { fprintf(stderr, "kernel_launch: hipFuncSetAttribute failed\n"); grid = -1; return; }
        int dev = 0, cus = 0, per_cu = 0;
        hipGetDevice(&dev); hipDeviceGetAttribute(&cus, hipDeviceAttributeMultiprocessorCount, dev);
        hipOccupancyMaxActiveBlocksPerMultiprocessor(&per_cu, (const void*)fwd_kernel, NTHR, LDS_BYTES);
        (void)hipGetLastError();
        if (per_cu < 1) { fprintf(stderr, "kernel_launch: occupancy query says %d blocks per CU\n", per_cu); }
        grid = cus;
    }
    if (grid < 0) return;
#if MK_SINGLE == 1
    if (hipMemsetAsync((char*)d_ws + WS_CTL, 0, CTL_ZERO_BYTES, stream) != hipSuccess) { fprintf(stderr, "kernel_launch: memset failed\n"); return; }
#endif
    Args a{};
    for (int i = 0; i < 25; ++i) a.in[i] = (const float*)d_in[i];
    a.out = (float*)d_out; a.ws = (unsigned char*)d_ws;
#if MK_SINGLE
    a.lo = 0; a.hi = NSTEP + 1;
    void* args[] = {&a};
    hipError_t e = hipLaunchCooperativeKernel((const void*)fwd_kernel, dim3(grid), dim3(NTHR), args, LDS_BYTES, stream);
    if (e != hipSuccess) fprintf(stderr, "cooperative launch failed: %s (grid %d)\n", hipGetErrorString(e), grid);
#else
    for (int s = 0; s < NSTEP + 1; ++s) { a.lo = s; a.hi = s + 1; hipLaunchKernelGGL(fwd_kernel, dim3(grid), dim3(NTHR), LDS_BYTES, stream, a); }
#endif
}
```

```cpp
#include <hip/hip_runtime.h>
#include <hip/hip_cooperative_groups.h>
#include <cstdio>
#include <cstdint>
namespace cg = cooperative_groups;
__device__ __forceinline__ int otid(int wv) { int l; asm volatile("v_mbcnt_lo_u32_b32 %0, -1, 0\n\tv_mbcnt_hi_u32_b32 %0, -1, %0" : "=v"(l)); return (wv << 6) | l; }
__device__ __forceinline__ float shx(float v, int mask, int lane) { return __builtin_bit_cast(float, __builtin_amdgcn_ds_bpermute((lane ^ mask) << 2, __builtin_bit_cast(int, v))); }
#define LAS __attribute__((address_space(3)))
typedef float f32x2_cv __attribute__((ext_vector_type(2))); typedef __bf16 bf16x2_cv __attribute__((ext_vector_type(2)));
__device__ __forceinline__ unsigned hw_cvtpk(float lo, float hi) { f32x2_cv v = {lo, hi}; bf16x2_cv b = __builtin_convertvector(v, bf16x2_cv); return __builtin_bit_cast(unsigned, b); }
__device__ __forceinline__ int xblk() { const int c = (int)blockIdx.x; return gridDim.x == 256 ? ((c & 7) * 32 + (c >> 3)) : c; }
#define XB_TMO      128
#define XB_XCNT(j)  (256  + 64 * (j))
#define XB_XSUB(j)  (1280 + 64 * (j))
#define XB_XGEN(j)  (2304 + 64 * (j))
#define XB_TOP      3328
#define XB_TOPGEN   3392
#define XCD_BAR_WORDS 3456
#define XB_SPIN_CAP (1u << 18)

__device__ __forceinline__ unsigned xb_ld(unsigned* p)              { return __hip_atomic_load(p, __ATOMIC_RELAXED, __HIP_MEMORY_SCOPE_AGENT); }
__device__ __forceinline__ unsigned xb_add(unsigned* p, unsigned v) { return __hip_atomic_fetch_add(p, v, __ATOMIC_RELAXED, __HIP_MEMORY_SCOPE_AGENT); }
__device__ __forceinline__ unsigned xb_xcc_id() { return (unsigned)__builtin_amdgcn_s_getreg((3 << 11) | 20) & 0xFu; }
#define XB_SPIN(cond, bar) do { unsigned _sp = 0; while (cond) { __builtin_amdgcn_s_sleep(1); \
    if ((++_sp & 255u) == 0u) { if (xb_ld(&(bar)[XB_TMO])) break; if (_sp > XB_SPIN_CAP) { atomicAdd(&(bar)[XB_TMO], 1u); break; } } } } while (0)

struct XcdBarrier {
    unsigned* bar; unsigned x; int wv;
    volatile LAS unsigned* st;
};

__device__ __forceinline__ XcdBarrier xcd_barrier_post(unsigned* bar, volatile LAS unsigned* st, int wv) {
    XcdBarrier b; b.bar = bar; b.x = xb_xcc_id(); b.st = st; b.wv = wv;
    if (otid(wv) == 0) (void)xb_add(&bar[XB_XCNT(b.x)], 1u);
    return b;
}
__device__ __forceinline__ void xcd_barrier_complete(unsigned* bar, unsigned x, unsigned& nloc, unsigned& nx) {
    const unsigned G = gridDim.x * gridDim.y * gridDim.z;
    unsigned sum, cnt, mine, sp = 0u;
    for (;;) {
        sum = 0u; cnt = 0u; mine = 0u;
#pragma unroll
        for (unsigned j = 0; j < 16; ++j) { const unsigned c = xb_ld(&bar[XB_XCNT(j)]); sum += c; cnt += (c > 0u) ? 1u : 0u; mine = (j == x) ? c : mine; }
        if (sum == G) break;
        __builtin_amdgcn_s_sleep(1);
        if ((++sp & 255u) == 0u) { if (xb_ld(&bar[XB_TMO])) break; if (sp > XB_SPIN_CAP) { atomicAdd(&bar[XB_TMO], 1u); break; } }
    }
    nloc = mine > 0u ? mine : 1u; nx = cnt > 0u ? cnt : 1u;
}

__device__ __forceinline__ void xcd_barrier(const XcdBarrier& b) {
    asm volatile("s_waitcnt vmcnt(0)" ::: "memory");
    __syncthreads();
    if (otid(b.wv) == 0) {
        unsigned* bar = b.bar;
        __builtin_amdgcn_s_waitcnt(0);
        unsigned nloc = b.st[0], nx = b.st[1];
        if (nloc == 0u) { xcd_barrier_complete(bar, b.x, nloc, nx); b.st[0] = nloc; b.st[1] = nx; }
        const unsigned old = xb_add(&bar[XB_XSUB(b.x)], 1u);
        const unsigned gen = old / nloc;
        if (old + 1u == (gen + 1u) * nloc) {
            __builtin_amdgcn_fence(__ATOMIC_RELEASE, "agent");
            asm volatile("s_waitcnt vmcnt(0)" ::: "memory");
            const unsigned og = xb_add(&bar[XB_TOP], 1u);
            const unsigned tg = og / nx;
            if (og + 1u == (tg + 1u) * nx) xb_add(&bar[XB_TOPGEN], 1u);
            else XB_SPIN(xb_ld(&bar[XB_TOPGEN]) == tg, bar);
            __builtin_amdgcn_fence(__ATOMIC_ACQUIRE, "agent");
            xb_add(&bar[XB_XGEN(b.x)], 1u);
            asm volatile("s_waitcnt vmcnt(0)" ::: "memory");
        } else {
            XB_SPIN(xb_ld(&bar[XB_XGEN(b.x)]) == gen, bar);
            __builtin_amdgcn_fence(__ATOMIC_ACQUIRE, "agent");
            asm volatile("s_waitcnt vmcnt(0)" ::: "memory");
        }
    }
    __syncthreads();
}
namespace pg8 {
#define PG8_LAS __attribute__((address_space(3)))
typedef unsigned short bf16_t;
typedef short bf16x8 __attribute__((ext_vector_type(8)));
typedef float f32x4 __attribute__((ext_vector_type(4)));
typedef unsigned u32x4 __attribute__((ext_vector_type(4)));
constexpr int BM = 256, BK = 64, HALF = 128, HTB = HALF * BK * 2  , STAGE_BYTES = 8 * HTB, NXCD = 8, WGM = 8;

__host__ __device__ __forceinline__ int lds_byte(int r, int c) { const int st = (r >> 4) * 2 + (c >> 5), rr = r & 15, cc = c & 31, ob = rr * 64 + cc * 2; return st * 1024 + (ob ^ (((ob >> 9) & 1) << 5)); }
__host__ __device__ __forceinline__ void stage_rc(int b, int& R, int& C) { const int st = b / 1024, sb = b % 1024, swz = sb ^ (((sb >> 9) & 1) << 5); R = (st >> 1) * 16 + swz / 64; C = (st & 1) * 32 + (swz % 64) / 2; }
__host__ __device__ __forceinline__ int perm32(int rho) { const int n = rho >> 4, i = rho & 15; return 8 * (i >> 2) + 4 * n + (i & 3); }

struct Unit { int pm, pn, kq; };
struct Gemm { const bf16_t* A; const bf16_t* Bt; int M, N, K, wv; float* dg; int lda, ldb; };

struct StaticOrder {
    int nM, nN, nwg, G, c, wgm, nNr;
    __host__ __device__ void init(int M, int N, int G_, int c_, int ksplit = 1) { nM = M / BM; nNr = N / BM; nN = nNr * ksplit; nwg = nM * nN; G = G_; c = c_; wgm = (nM % NXCD == 0) ? nM / NXCD : WGM; }
    __host__ __device__ bool next(int i, Unit& u) const {
        const long L = (long)i * G + c; if (L >= nwg) return false;
        int wgid = (int)L; { const int q = nwg / NXCD, r = nwg % NXCD, xcd = wgid % NXCD, off = wgid / NXCD; wgid = (xcd < r ? xcd * (q + 1) : r * (q + 1) + (xcd - r) * q) + off; }
        const int nig = wgm * nN, gid = wgid / nig, fm = gid * wgm, gsz = (nM - fm) < wgm ? (nM - fm) : wgm;
        u.pm = fm + ((wgid % nig) % gsz); const int pv = (wgid % nig) / gsz; u.kq = pv / nNr; u.pn = pv % nNr;
        if (nM == 9 * NXCD) { const int x_ = u.pm / 9, j_ = u.pm % 9; u.pm = j_ < 8 ? 8 * x_ + j_ : 8 * NXCD + x_; }
        return true;
    }
    __device__ __forceinline__ void a_ready(const Unit&) const {}
    __device__ __forceinline__ void done(const Unit&) const {}
};

__device__ __forceinline__ unsigned cvt_pk_bf16(float lo, float hi) { return hw_cvtpk(lo, hi); }
struct EpiStore {
    static constexpr bool PERM = true, AFTER_DRAIN = false;
    bf16_t* O; int ldc;
    __device__ __forceinline__ void operator()(const f32x4 (&acc)[2][2][4][2], const Unit& u, int wr, int wc, int fr, int fq) const {
        const int row0 = u.pm * BM + wr * 64 + fr; const int col0 = u.pn * BM + wc * 32 + 8 * fq;
#pragma unroll
        for (int ai = 0; ai < 2; ++ai)
#pragma unroll
            for (int m = 0; m < 4; ++m) { bf16_t* rowp = O + (size_t)(row0 + ai * HALF + m * 16) * ldc + col0;
#pragma unroll
                for (int bj = 0; bj < 2; ++bj) { const f32x4 v0 = acc[ai][bj][m][0], v1 = acc[ai][bj][m][1];
                    u32x4 w; w.x = cvt_pk_bf16(v0[0], v0[1]); w.y = cvt_pk_bf16(v0[2], v0[3]); w.z = cvt_pk_bf16(v1[0], v1[1]); w.w = cvt_pk_bf16(v1[2], v1[3]);
                    *(u32x4*)(rowp + bj * HALF) = w; } }
    }
};

template <int CTRL> __device__ __forceinline__ float dpprot(float src) { return __builtin_bit_cast(float, __builtin_amdgcn_mov_dpp(__builtin_bit_cast(int, src), CTRL, 0xf, 0xf, true)); }
template <int CTRL> __device__ __forceinline__ float dppf(float old, float src) { return __builtin_bit_cast(float, __builtin_amdgcn_update_dpp(__builtin_bit_cast(int, old), __builtin_bit_cast(int, src), CTRL, 0xf, 0xf, false)); }
#define PG8_DPP4(dst, oldv, srcv, ctrl) do { dst[0] = dppf<ctrl>(oldv[0], srcv[0]); dst[1] = dppf<ctrl>(oldv[1], srcv[1]); dst[2] = dppf<ctrl>(oldv[2], srcv[2]); dst[3] = dppf<ctrl>(oldv[3], srcv[3]); } while (0)
struct EpiFfn {
    static constexpr bool PERM = true, AFTER_DRAIN = false;
    bf16_t* O; int ldc; int mode;
    int kso;
    const float* rs;
    bf16_t* Ue; const float* cw; PG8_LAS f32x4* ex; int wv;
    __device__ __forceinline__ void operator()(const f32x4 (&acc)[2][2][4][2], const Unit& u, int wr, int wc, int fr_in, int fq_in) const {
        (void)fr_in; (void)fq_in; const int lane_e = otid(wv) & 63; const int fr = lane_e & 15, fq = lane_e >> 4;
        if (mode != 1) {
            const int row0 = u.pm * BM + wr * 64 + fr; const int col0 = u.pn * BM + wc * 32 + 8 * fq;
#pragma unroll
            for (int ai = 0; ai < 2; ++ai)
#pragma unroll
                for (int m = 0; m < 4; ++m) { bf16_t* rowp = O + (size_t)u.kq * kso + (size_t)(row0 + ai * HALF + m * 16) * ldc + col0;
                    const float rsc = (mode == 2) ? rs[row0 + ai * HALF + m * 16] : 1.0f;
#pragma unroll
                    for (int bj = 0; bj < 2; ++bj) { const f32x4 v0 = acc[ai][bj][m][0] * rsc, v1 = acc[ai][bj][m][1] * rsc;
                        u32x4 w; w.x = cvt_pk_bf16(v0[0], v0[1]); w.y = cvt_pk_bf16(v0[2], v0[3]); w.z = cvt_pk_bf16(v1[0], v1[1]); w.w = cvt_pk_bf16(v1[2], v1[3]);
                        *(u32x4*)(rowp + bj * HALF) = w; } }
            return;
        }
        const int chl = wc * 32 + 8 * fq, ch = u.pn * 128 + chl;
        f32x4 wA[3][2], wG[3][2];
#pragma unroll
        for (int t = 0; t < 3; ++t)
#pragma unroll
            for (int n = 0; n < 2; ++n) { wA[t][n] = *(const f32x4*)(cw + t * 5632 + ch + 4 * n); wG[t][n] = *(const f32x4*)(cw + t * 5632 + 2816 + ch + 4 * n); }
#define PG8_EX(blk, fl, bj, n) ex[((((blk) * 2 + (fl)) * 2 + (bj)) * 2 + (n)) * 16 + wc * 4 + fq]
#pragma unroll
        for (int ai = 0; ai < 2; ++ai) { const int blk = ai * 2 + wr;
            const bool lastr = fr == 15;
#pragma unroll
            for (int bj = 0; bj < 2; ++bj)
#pragma unroll
                for (int n = 0; n < 2; ++n) { const f32x4 a0 = acc[ai][bj][0][n], a3 = acc[ai][bj][3][n]; f32x4 v;
#pragma unroll
                    for (int e = 0; e < 4; ++e) v[e] = lastr ? a3[e] : a0[e];
                    if (fr == 0 || lastr) ex[((((blk) * 2 + (lastr ? 1 : 0)) * 2 + bj) * 2 + n) * 16 + wc * 4 + fq] = v; } }
        asm volatile("s_waitcnt lgkmcnt(0)" ::: "memory"); __builtin_amdgcn_s_barrier(); asm volatile("" ::: "memory");
        const f32x4 zero4 = (f32x4){0.f, 0.f, 0.f, 0.f}; const bool is15 = fr == 15, is0 = fr == 0;
#pragma unroll
        for (int ai = 0; ai < 2; ++ai) { const int blk = ai * 2 + wr;
            f32x4 pb[2][2], nb[2][2];
#pragma unroll
            for (int bj = 0; bj < 2; ++bj)
#pragma unroll
                for (int n = 0; n < 2; ++n) { pb[bj][n] = blk > 0 ? PG8_EX(blk - 1, 1, bj, n) : zero4; nb[bj][n] = blk < 3 ? PG8_EX(blk + 1, 0, bj, n) : zero4; }
#pragma unroll
            for (int m = 0; m < 4; ++m) {
                f32x4 cv[2][2];
#pragma unroll
                for (int bj = 0; bj < 2; ++bj)
#pragma unroll
                    for (int n = 0; n < 2; ++n) { const f32x4 cur = acc[ai][bj][m][n];
                        const f32x4 lo = (m == 0) ? pb[bj][n] : acc[ai][bj][m > 0 ? m - 1 : 0][n];
                        const f32x4 hi = (m == 3) ? nb[bj][n] : acc[ai][bj][m < 3 ? m + 1 : 3][n];
                        f32x4 prev, next;
#pragma unroll
                        for (int e = 0; e < 4; ++e) { prev[e] = dpprot<0x121>(is15 ? lo[e] : cur[e]);
                                                      next[e] = dpprot<0x12F>(is0 ? hi[e] : cur[e]); }
                        const f32x4 w0 = bj ? wG[0][n] : wA[0][n], w1 = bj ? wG[1][n] : wA[1][n], w2 = bj ? wG[2][n] : wA[2][n];
                        cv[bj][n] = w0 * prev + w1 * cur + w2 * next; }
                u32x4 w; float g[8];
#pragma unroll
                for (int n = 0; n < 2; ++n)
#pragma unroll
                    for (int e = 0; e < 4; ++e) { const float av = cv[0][n][e]; g[4 * n + e] = av * __builtin_amdgcn_rcpf(1.f + __expf(-av)) * cv[1][n][e]; }
                w.x = cvt_pk_bf16(g[0], g[1]); w.y = cvt_pk_bf16(g[2], g[3]); w.z = cvt_pk_bf16(g[4], g[5]); w.w = cvt_pk_bf16(g[6], g[7]);
                *(u32x4*)(O + (size_t)(u.pm * BM + ai * HALF + wr * 64 + m * 16 + fr) * 2816 + ch) = w;
            } }
#undef PG8_EX
        { const int slot = (wr == 0) ? (fr == 0 ? 0 : (fr == 1 ? 1 : -1)) : (fr == 14 ? 2 : (fr == 15 ? 3 : -1));
          if (slot >= 0) { bf16_t* up = Ue + ((size_t)(u.pm * 4 + slot) * 5632) + u.pn * 256 + chl;
#pragma unroll
              for (int bj = 0; bj < 2; ++bj) { const f32x4 a0 = acc[0][bj][0][0], a1 = acc[0][bj][0][1], b0 = acc[1][bj][3][0], b1 = acc[1][bj][3][1]; f32x4 v0, v1;
#pragma unroll
                  for (int e = 0; e < 4; ++e) { v0[e] = wr ? b0[e] : a0[e]; v1[e] = wr ? b1[e] : a1[e]; }
                  u32x4 w; w.x = cvt_pk_bf16(v0[0], v0[1]); w.y = cvt_pk_bf16(v0[2], v0[3]); w.z = cvt_pk_bf16(v1[0], v1[1]); w.w = cvt_pk_bf16(v1[2], v1[3]);
                  *(u32x4*)(up + bj * HALF) = w; } } }
    }
};
template <class Epi, class Sched, bool ALIGN_EPI = false, bool SP2 = false>
__device__ __forceinline__ void gemm_phase(PG8_LAS unsigned char* lds, const Gemm g, const Sched& S, const Epi& E) {
    const int tid = otid(g.wv), wid = g.wv, lane = tid & 63, wr = wid >> 2, wc = wid & 3, fr = lane & 15, fq = lane >> 4;
    const int K = g.K, nt = K / BK;
    unsigned voffA[2], voffB[2];
#pragma unroll
    for (int i = 0; i < 2; ++i) { int R, C; stage_rc(tid * 16 + i * 8192, R, C); const int Rb = Epi::PERM ? ((R & ~31) + perm32(R & 31)) : R;
        voffA[i] = (unsigned)(R * g.lda + C) * 2u; voffB[i] = (unsigned)(Rb * g.ldb + C) * 2u; }
    const size_t kstep = (size_t)(BK * 2);
    const size_t hstep = (size_t)HALF * g.ldb * 2;
    const size_t tstep = 2 * hstep;
    const size_t hstepA = (size_t)HALF * g.lda * 2, tstepA = 2 * hstepA;
    const unsigned ldsw = (unsigned)wid * 1024u;
    const int aoff = lds_byte(wr * 64 + fr, fq * 8), boff = lds_byte(wc * 32 + fr, fq * 8);
#define PG8_SA(b, h) (((b) * 2 + (h)) * HTB)
#define PG8_SB(b, h) ((4 + (b) * 2 + (h)) * HTB)
#define PG8_STAGE(bufoff, gbase, voff) do { _Pragma("unroll") for (int _i = 0; _i < 2; ++_i) \
        __builtin_amdgcn_global_load_lds((const unsigned*)((const char*)(gbase) + (voff)[_i]), (PG8_LAS unsigned*)(lds + (bufoff) + ldsw + _i * 8192), 16, 0, 0); } while (0)
#define PG8_LDA(dst, b, h) do { _Pragma("unroll") for (int m = 0; m < 4; ++m) _Pragma("unroll") for (int k = 0; k < 2; ++k) dst[m][k] = *(const PG8_LAS bf16x8*)(lds + PG8_SA(b, h) + aoff + m * 2048 + k * 1024); } while (0)
#define PG8_LDB(dst, b, h) do { _Pragma("unroll") for (int n = 0; n < 2; ++n) _Pragma("unroll") for (int k = 0; k < 2; ++k) dst[n][k] = *(const PG8_LAS bf16x8*)(lds + PG8_SB(b, h) + boff + n * 2048 + k * 1024); } while (0)
#define PG8_MMA(ai, bj, At, Bt) do { __builtin_amdgcn_s_setprio(1); _Pragma("unroll") for (int m = 0; m < 4; ++m) _Pragma("unroll") for (int n = 0; n < 2; ++n) _Pragma("unroll") for (int k = 0; k < 2; ++k) \
        acc[ai][bj][m][n] = __builtin_amdgcn_mfma_f32_16x16x32_bf16(Bt[n][k], At[m][k], acc[ai][bj][m][n], 0, 0, 0); __builtin_amdgcn_s_setprio(0); } while (0)
#define PG8_WAIT_V(n) asm volatile("s_waitcnt vmcnt(" #n ")" ::: "memory")
#define PG8_WAIT_L(n) asm volatile("s_waitcnt lgkmcnt(" #n ")" ::: "memory")
#define PG8_BAR __builtin_amdgcn_s_barrier()
#define PG8_SCHED __builtin_amdgcn_sched_barrier(0)
    Unit cur, nxt; int ui = 0;
#ifdef GDIAG
    unsigned gd0 = 0, gd1 = 0, gd2 = 0; const unsigned gstart = (unsigned)__builtin_amdgcn_s_memtime();
#endif
    if (!S.next(0, cur)) return;
    f32x4 acc[2][2][4][2];
#pragma unroll
    for (int a = 0; a < 2; ++a)
#pragma unroll
        for (int b = 0; b < 2; ++b)
#pragma unroll
            for (int m = 0; m < 4; ++m)
#pragma unroll
                for (int n = 0; n < 2; ++n) acc[a][b][m][n] = (f32x4){0.f, 0.f, 0.f, 0.f};
    bf16x8 At[4][2], B0[2][2], B1[2][2];
    const size_t kqstep = (size_t)K * 2;
    const char* cA = (const char*)g.A + (size_t)cur.pm * tstepA + (size_t)cur.kq * kqstep; const char* cB = (const char*)g.Bt + (size_t)cur.pn * tstep + (size_t)cur.kq * kqstep;
    S.a_ready(cur);
    if constexpr (SP2) {
        PG8_STAGE(PG8_SB(0, 0), cB, voffB); PG8_STAGE(PG8_SB(0, 1), cB + hstep, voffB); PG8_STAGE(PG8_SA(0, 0), cA, voffA); PG8_STAGE(PG8_SA(0, 1), cA + hstepA, voffA);
        if (wr == 1) PG8_BAR;
        PG8_WAIT_V(2); PG8_BAR;
        PG8_STAGE(PG8_SB(1, 0), cB + kstep, voffB); PG8_STAGE(PG8_SA(1, 0), cA + kstep, voffA); PG8_STAGE(PG8_SB(1, 1), cB + hstep + kstep, voffB);
        PG8_WAIT_V(6); PG8_BAR;
    } else {
        PG8_STAGE(PG8_SB(0, 0), cB, voffB); PG8_STAGE(PG8_SA(0, 0), cA, voffA); PG8_STAGE(PG8_SB(0, 1), cB + hstep, voffB); PG8_STAGE(PG8_SA(0, 1), cA + hstepA, voffA);
        if (wr == 1) PG8_BAR;
        PG8_WAIT_V(4); PG8_BAR;
        PG8_STAGE(PG8_SB(1, 0), cB + kstep, voffB); PG8_STAGE(PG8_SA(1, 0), cA + kstep, voffA); PG8_STAGE(PG8_SB(1, 1), cB + hstep + kstep, voffB);
        PG8_WAIT_V(6); PG8_BAR;
    }
    for (;;) {
        const bool has_next = S.next(ui + 1, nxt);
        const char* nA = has_next ? (const char*)g.A + (size_t)nxt.pm * tstepA + (size_t)nxt.kq * kqstep : cA; const char* nB = has_next ? (const char*)g.Bt + (size_t)nxt.pn * tstep + (size_t)nxt.kq * kqstep : cB;
#ifdef GDIAG
        unsigned gt0 = (unsigned)__builtin_amdgcn_s_memtime();
#endif
        for (int t = 0; t < nt; t += 2) {
            const bool last = (t == nt - 2);
            const char* a1 = cA + (size_t)(t + 1) * kstep;
            const char* a2 = last ? nA : cA + (size_t)(t + 2) * kstep; const char* b2 = last ? nB : cB + (size_t)(t + 2) * kstep;
            const char* a3 = a2 + kstep; const char* b3 = b2 + kstep;
            if (last && has_next) S.a_ready(nxt);
            if constexpr (SP2) {
            PG8_LDB(B0, 0, 0); PG8_LDB(B1, 0, 1); PG8_SCHED; PG8_LDA(At, 0, 0); PG8_STAGE(PG8_SA(1, 1), a1 + hstepA, voffA);
            PG8_WAIT_V(8); PG8_WAIT_L(0); PG8_BAR; PG8_MMA(0, 0, At, B0); PG8_MMA(0, 1, At, B1); PG8_BAR; PG8_SCHED;
            PG8_LDA(At, 0, 1); PG8_STAGE(PG8_SB(0, 0), b2, voffB); PG8_STAGE(PG8_SB(0, 1), b2 + hstep, voffB); PG8_STAGE(PG8_SA(0, 0), a2, voffA);
            PG8_WAIT_V(8); PG8_WAIT_L(0); PG8_BAR; PG8_MMA(1, 0, At, B0); PG8_MMA(1, 1, At, B1); PG8_BAR; PG8_SCHED;
            PG8_LDB(B0, 1, 0); PG8_LDB(B1, 1, 1); PG8_SCHED; PG8_LDA(At, 1, 0); PG8_STAGE(PG8_SA(0, 1), a2 + hstepA, voffA);
            PG8_WAIT_V(8); PG8_WAIT_L(0); PG8_BAR; PG8_MMA(0, 0, At, B0); PG8_MMA(0, 1, At, B1); PG8_BAR; PG8_SCHED;
            PG8_LDA(At, 1, 1); PG8_STAGE(PG8_SB(1, 0), b3, voffB); PG8_STAGE(PG8_SB(1, 1), b3 + hstep, voffB); PG8_STAGE(PG8_SA(1, 0), a3, voffA);
            PG8_WAIT_V(8); PG8_WAIT_L(0); PG8_BAR; PG8_MMA(1, 0, At, B0); PG8_MMA(1, 1, At, B1); PG8_BAR; PG8_SCHED;
            } else {
            PG8_LDB(B0, 0, 0); PG8_SCHED; PG8_LDA(At, 0, 0); PG8_STAGE(PG8_SA(1, 1), a1 + hstepA, voffA);
            PG8_WAIT_L(8); PG8_BAR; PG8_WAIT_L(0); PG8_MMA(0, 0, At, B0); PG8_BAR; PG8_SCHED;
            PG8_LDB(B1, 0, 1); PG8_STAGE(PG8_SB(0, 0), b2, voffB);
            PG8_BAR; PG8_WAIT_L(0); PG8_MMA(0, 1, At, B1); PG8_BAR;
            PG8_LDA(At, 0, 1); PG8_STAGE(PG8_SA(0, 0), a2, voffA);
            PG8_BAR; PG8_WAIT_L(0); PG8_MMA(1, 0, At, B0); PG8_BAR; PG8_SCHED;
            PG8_STAGE(PG8_SB(0, 1), b2 + hstep, voffB);
            PG8_WAIT_V(6); PG8_BAR; PG8_MMA(1, 1, At, B1); PG8_BAR;
            PG8_LDB(B0, 1, 0); PG8_SCHED; PG8_LDA(At, 1, 0); PG8_STAGE(PG8_SA(0, 1), a2 + hstepA, voffA);
            PG8_WAIT_L(8); PG8_BAR; PG8_WAIT_L(0); PG8_MMA(0, 0, At, B0); PG8_BAR; PG8_SCHED;
            PG8_LDB(B1, 1, 1); PG8_STAGE(PG8_SB(1, 0), b3, voffB);
            PG8_BAR; PG8_WAIT_L(0); PG8_MMA(0, 1, At, B1); PG8_BAR;
            PG8_LDA(At, 1, 1); PG8_STAGE(PG8_SA(1, 0), a3, voffA);
            PG8_BAR; PG8_WAIT_L(0); PG8_MMA(1, 0, At, B0); PG8_BAR; PG8_SCHED;
            PG8_STAGE(PG8_SB(1, 1), b3 + hstep, voffB);
            PG8_WAIT_V(6); PG8_BAR; PG8_MMA(1, 1, At, B1); PG8_BAR;
            }
        }
#ifdef GDIAG
        { const unsigned n_ = (unsigned)__builtin_amdgcn_s_memtime(); gd0 += n_ - gt0; gt0 = n_; }
#endif
        if constexpr (ALIGN_EPI) { if (wr == 0) PG8_BAR; }
#ifdef GDIAG
        { const unsigned n_ = (unsigned)__builtin_amdgcn_s_memtime(); gd1 += n_ - gt0; gt0 = n_; }
#endif
        if constexpr (!Epi::AFTER_DRAIN) { E(acc, cur, wr, wc, fr, fq); S.done(cur); }
#ifdef GDIAG
        { const unsigned n_ = (unsigned)__builtin_amdgcn_s_memtime(); gd2 += n_ - gt0; gt0 = n_; }
#endif
        if (!has_next) break;
#pragma unroll
        for (int a = 0; a < 2; ++a)
#pragma unroll
            for (int b = 0; b < 2; ++b)
#pragma unroll
                for (int m = 0; m < 4; ++m)
#pragma unroll
                    for (int n = 0; n < 2; ++n) acc[a][b][m][n] = (f32x4){0.f, 0.f, 0.f, 0.f};
        cur = nxt; cA = nA; cB = nB; ++ui;
        if constexpr (ALIGN_EPI) { if (wr == 1) PG8_BAR; }
    }
#ifdef GDIAG
    if (g.dg && blockIdx.x == 0 && wid == GDIAG_WAVE && lane == 0) { const unsigned tot = (unsigned)__builtin_amdgcn_s_memtime() - gstart; g.dg[0] = (float)gd0; g.dg[1] = (float)gd1; g.dg[2] = (float)gd2; g.dg[3] = (float)tot; }
#endif
    PG8_WAIT_V(0);
    if constexpr (!ALIGN_EPI) { if (wr == 0) PG8_BAR; }
    PG8_BAR;
    if constexpr (Epi::AFTER_DRAIN) { E.fused(acc, cur, wr, wc, fr, fq, lds, wid, lane); S.done(cur); }
#undef PG8_SA
#undef PG8_SB
#undef PG8_STAGE
#undef PG8_LDA
#undef PG8_LDB
#undef PG8_MMA
#undef PG8_WAIT_V
#undef PG8_WAIT_L
#undef PG8_BAR
#undef PG8_SCHED
}
}

typedef unsigned short bf16;
typedef unsigned v4u __attribute__((ext_vector_type(4)));
typedef unsigned v2u __attribute__((ext_vector_type(2)));
typedef float f32x4 __attribute__((ext_vector_type(4)));
constexpr int NWAVES = 8, NTHR = 512;
constexpr int D = 1024, NB = 8, SEQ = 2048, CTXL = 256, TL = NB * SEQ, TC = NB * CTXL, T = TL + TC;
constexpr int HYB_IN = 2208, HYB_INP = 2304, SSD_IN = 5184, SSD_INP = 5376, DFF = 2816, UPW = 5632;
constexpr int QW = 768, KVW = 1024, MODW = 6144;
constexpr float EPS = 1e-6f;
constexpr int NSTEP = 1 + 4 * 10;
constexpr float ATT_SCALE_LOG2E = 0.10206207261596577f * 1.4426950408889634f;

constexpr size_t MiB = 1u << 20;
constexpr size_t WS_CTL = 0, CTL_ZERO_BYTES = 64 * 1024;
constexpr size_t WS_MOD = 1 * MiB;
constexpr size_t WS_ROPE = 2 * MiB;
constexpr size_t W_UP = 3 * MiB;
constexpr size_t W_DN = W_UP + (size_t)UPW * D * 2;
constexpr size_t W_IN = W_DN + (size_t)D * DFF * 2;
constexpr size_t W_OUT = W_IN + (size_t)SSD_INP * D * 2;
constexpr size_t W_UQ = W_OUT + (size_t)D * 2048 * 2;
constexpr size_t W_UKV = W_UQ + (size_t)QW * 384 * 2;
constexpr size_t W_END = W_UKV + (size_t)KVW * 256 * 2;
constexpr size_t WS_XC = 36 * MiB;
constexpr size_t WS_H = 44 * MiB;
constexpr size_t WS_DT = WS_H, WS_AA = WS_H + (size_t)T * 64 * 4;
constexpr size_t WS_SS = WS_AA + (size_t)T * 64 * 4;
constexpr size_t WS_RS = WS_SS + (size_t)T * 64 * 4;
constexpr size_t WS_BIG = 80 * MiB;
constexpr size_t WS_M = WS_BIG;
constexpr size_t WS_P = WS_BIG;
constexpr size_t WS_Q = WS_BIG + 81 * MiB;
constexpr size_t WS_KV = WS_BIG + 108 * MiB;
constexpr size_t WS_KR = WS_BIG + 144 * MiB;
constexpr size_t WS_CQN = WS_BIG + 146 * MiB;
constexpr size_t WS_CKVN = WS_BIG + 160 * MiB;
constexpr size_t WS_MIX = WS_BIG + 170 * MiB;
constexpr size_t WS_MP = WS_BIG + 81 * MiB;
constexpr size_t WS_XALT = WS_BIG + 40 * MiB;
constexpr size_t WS_U = WS_BIG;
constexpr size_t WS_G = WS_BIG + 198 * MiB;
constexpr size_t WS_ZX = WS_BIG;
constexpr size_t WS_XBC = WS_BIG + 189 * MiB;
constexpr size_t WS_UE = WS_BIG + 297 * MiB;
constexpr size_t WS_END = WS_UE + 4 * MiB;
static_assert(W_END <= WS_XC && WS_G + (size_t)T * DFF * 2 <= WS_END && WS_XBC + (size_t)T * 3072 * 2 <= WS_END && WS_ZX + (size_t)T * SSD_INP * 2 <= WS_XBC, "ws map");
static_assert(WS_RS + (size_t)T * 4 <= WS_BIG && WS_MIX + (size_t)T * D * 2 <= WS_END && WS_Q + (size_t)T * QW * 2 <= WS_KV && WS_P + (size_t)T * HYB_INP * 2 <= WS_Q, "ws map 2");
constexpr int LDS_BYTES = 147456;

struct Args { const float* in[25]; float* out; unsigned char* ws; int lo, hi; int wv, pad; };
enum { I_X = 0, I_C, I_CTX, I_CCTX, I_MODW, I_MODB, I_NORMW, I_WUP, I_FCONV, I_WDN, I_HIN, I_QNORM, I_KVNORM, I_WUQ, I_WUKV, I_SCONV, I_HOUT, I_SIN, I_SCONVW, I_SCONVB, I_ALOG, I_DTB, I_SD, I_SNORM, I_SOUT };

__device__ __forceinline__ unsigned f2bf(float f) { unsigned u = __builtin_bit_cast(unsigned, f); return (u + 0x7fffu + ((u >> 16) & 1u)) >> 16; }
__device__ __forceinline__ unsigned pk2(float lo, float hi) { return hw_cvtpk(lo, hi); }
__device__ __forceinline__ float bflo(unsigned u) { return __builtin_bit_cast(float, u << 16); }
__device__ __forceinline__ float bfhi(unsigned u) { return __builtin_bit_cast(float, u & 0xffff0000u); }
__device__ __forceinline__ float bf1(bf16 b) { return __builtin_bit_cast(float, (unsigned)b << 16); }
__device__ __forceinline__ float silu_f(float x) { return x * __builtin_amdgcn_rcpf(1.f + __expf(-x)); }
__device__ __forceinline__ float wave_sum(float v, int lane) {
#pragma unroll
    for (int o = 1; o < 64; o <<= 1) v += shx(v, o, lane);
    return v;
}
__device__ __forceinline__ void unpack8(const v4u w, float (&f)[8]) { f[0] = bflo(w.x); f[1] = bfhi(w.x); f[2] = bflo(w.y); f[3] = bfhi(w.y); f[4] = bflo(w.z); f[5] = bfhi(w.z); f[6] = bflo(w.w); f[7] = bfhi(w.w); }
__device__ __forceinline__ v4u pack8(const float (&f)[8]) { v4u w; w.x = pk2(f[0], f[1]); w.y = pk2(f[2], f[3]); w.z = pk2(f[4], f[5]); w.w = pk2(f[6], f[7]); return w; }
__device__ __forceinline__ bool has_prev(int r) { return r < TL ? (r & (SEQ - 1)) != 0 : ((r - TL) & (CTXL - 1)) != 0; }
__device__ __forceinline__ bool has_next(int r) { return r < TL ? (r & (SEQ - 1)) != SEQ - 1 : ((r - TL) & (CTXL - 1)) != CTXL - 1; }

__device__ __forceinline__ void mod_compute(const Args& a, LAS unsigned char* lds) {
    LAS float* sc = (LAS float*)lds;
    LAS float* red = (LAS float*)(lds + 36864);
    const int tid = otid(a.wv);
    float* MOD = (float*)(a.ws + WS_MOD);
    for (int i = tid; i < 9 * 1024; i += NTHR) { const int c = i >> 10, k = i & 1023; const float v = c < 8 ? a.in[I_C][c * 1024 + k] : a.in[I_CCTX][k]; sc[i] = silu_f(v); }
    __syncthreads();
    for (int item = blockIdx.x; item < 4 * 96; item += gridDim.x) {
        const int l = item / 96, cb = item % 96;
        const float* W = a.in[I_MODW] + (size_t)l * 1024 * MODW + cb * 64;
        const int cgp = tid & 15, kg = tid >> 4;
        float acc[9][4];
#pragma unroll
        for (int c = 0; c < 9; ++c) { acc[c][0] = 0.f; acc[c][1] = 0.f; acc[c][2] = 0.f; acc[c][3] = 0.f; }
#pragma unroll 8
        for (int kk = 0; kk < 32; ++kk) { const int k = kg * 32 + kk; const f32x4 w = *(const f32x4*)(W + (size_t)k * MODW + cgp * 4);
#pragma unroll
            for (int c = 0; c < 9; ++c) { const float s = sc[c * 1024 + k]; acc[c][0] += s * w[0]; acc[c][1] += s * w[1]; acc[c][2] += s * w[2]; acc[c][3] += s * w[3]; } }
#pragma unroll
        for (int c = 0; c < 9; ++c)
#pragma unroll
            for (int j = 0; j < 4; ++j) red[kg * 576 + c * 64 + cgp * 4 + j] = acc[c][j];
        __syncthreads();
        for (int o = tid; o < 576; o += NTHR) { float s = 0.f;
            for (int g = 0; g < 32; ++g) s += red[g * 576 + o];
            const int c = o >> 6, col = o & 63; MOD[(size_t)(l * 9 + c) * MODW + cb * 64 + col] = s + a.in[I_MODB][l * MODW + cb * 64 + col]; }
        __syncthreads();
    }
}
__device__ __forceinline__ void rope_tables(const Args& a) {
    float* ct = (float*)(a.ws + WS_ROPE); float* st = ct + SEQ * 16;
    for (int i = blockIdx.x * NTHR + otid(a.wv); i < SEQ * 16; i += gridDim.x * NTHR) {
        const int t = i >> 4, j = i & 15; const int pos = j < 8 ? (t >> 6) : (t & 63); const int f = j & 7;
        const float i0 = (f & 1) ? 0.31622776601683794f : 1.0f; const int e = f >> 1; const float i1 = e == 0 ? 1.0f : (e == 1 ? 0.1f : (e == 2 ? 0.01f : 0.001f));
        const float inv = i0 * i1; const float ang = (float)pos * inv;
        ct[i] = __cosf(ang); st[i] = __sinf(ang); }
}
__device__ __forceinline__ void transpose_item(const float* W, int K, int N, bf16* WT, LAS float* scr, int item, int lane, bool ffn_perm, const float* ksc) {
    const int nblk = N / 32, kb = item / nblk, nb = item % nblk, k0 = 64 * kb, n0 = 32 * nb;
    const int o0 = ffn_perm ? ((n0 % DFF) / 128) * 256 + (n0 / DFF) * 128 + (n0 % 128) : n0;
    float wv_[32];
#pragma unroll
    for (int i = 0; i < 32; ++i) wv_[i] = W[(size_t)(k0 + 2 * i + (lane >> 5)) * N + n0 + (lane & 31)];
    if (ksc) {
#pragma unroll
        for (int i = 0; i < 32; ++i) wv_[i] *= ksc[k0 + 2 * i + (lane >> 5)]; }
#pragma unroll
    for (int i = 0; i < 32; ++i) scr[(2 * i + (lane >> 5)) * 33 + (lane & 31)] = wv_[i];
    asm volatile("s_waitcnt lgkmcnt(0)" ::: "memory");
    const int c = lane & 7;
#pragma unroll
    for (int j = 0; j < 4; ++j) { const int n = (lane >> 3) + 8 * j; const LAS float* s = scr + (8 * c) * 33 + n;
        v4u o; o.x = pk2(s[0 * 33], s[1 * 33]); o.y = pk2(s[2 * 33], s[3 * 33]); o.z = pk2(s[4 * 33], s[5 * 33]); o.w = pk2(s[6 * 33], s[7 * 33]);
        *(v4u*)(WT + (size_t)(o0 + n) * K + k0 + 8 * c) = o; }
    asm volatile("s_waitcnt lgkmcnt(0)" ::: "memory");
}
__device__ __forceinline__ void convert_weight(const float* W, int K, int N, int Npad, bf16* WT, LAS unsigned char* lds, int rot, int wv, bool ffn_perm = false, const float* ksc = nullptr) {
    const int wave = wv, lane = otid(wv) & 63; const int NGW = gridDim.x * NWAVES; const int gw = (blockIdx.x * NWAVES + wave + rot) % NGW;
    LAS float* scr = (LAS float*)(lds + wave * 16384);
    const int nitems = (K / 64) * (N / 32);
    for (int it = gw; it < nitems; it += NGW) transpose_item(W, K, N, WT, scr, it, lane, ffn_perm, ksc);
    (void)Npad;
}
__device__ __forceinline__ void convert_layer(const Args& a, int l, LAS unsigned char* lds) {
    const int i = l >> 1; unsigned char* ws = a.ws;
    convert_weight(a.in[I_WUP] + (size_t)l * D * UPW, D, UPW, UPW, (bf16*)(ws + W_UP), lds, 0, a.wv, true);
    convert_weight(a.in[I_WDN] + (size_t)l * DFF * D, DFF, D, D, (bf16*)(ws + W_DN), lds, 300, a.wv);
    if ((l & 1) == 0) {
        convert_weight(a.in[I_HIN] + (size_t)i * D * HYB_IN, D, HYB_IN, HYB_INP, (bf16*)(ws + W_IN), lds, 700, a.wv);
        convert_weight(a.in[I_HOUT] + (size_t)i * D * D, D, D, D, (bf16*)(ws + W_OUT), lds, 1100, a.wv);
        convert_weight(a.in[I_WUQ] + (size_t)i * 384 * QW, 384, QW, QW, (bf16*)(ws + W_UQ), lds, 1500, a.wv);
        convert_weight(a.in[I_WUKV] + (size_t)i * 256 * KVW, 256, KVW, KVW, (bf16*)(ws + W_UKV), lds, 1700, a.wv);
    } else {
        convert_weight(a.in[I_SIN] + (size_t)i * D * SSD_IN, D, SSD_IN, SSD_INP, (bf16*)(ws + W_IN), lds, 700, a.wv);
        convert_weight(a.in[I_SOUT] + (size_t)i * 2048 * D, 2048, D, D, (bf16*)(ws + W_OUT), lds, 1300, a.wv, false, a.in[I_SNORM] + i * 2048);
    }
}

__device__ __forceinline__ void prep_even(const Args& a, int i) {
    const int wave = otid(a.wv) >> 6, lane = otid(a.wv) & 63; const int NGW = gridDim.x * NWAVES, gw = blockIdx.x * NWAVES + wave;
    const bf16* P = (const bf16*)(a.ws + WS_P); bf16* CQN = (bf16*)(a.ws + WS_CQN); bf16* CKVN = (bf16*)(a.ws + WS_CKVN); bf16* KR = (bf16*)(a.ws + WS_KR); bf16* MIX = (bf16*)(a.ws + WS_MIX);
    const float* qn = a.in[I_QNORM] + i * 384; const float* kvn = a.in[I_KVNORM] + i * 256; const float* cw = a.in[I_SCONV] + i * 3 * 512;
    const float* ct = (const float*)(a.ws + WS_ROPE); const float* st = ct + SEQ * 16;
    for (int r = gw; r < T; r += NGW) {
        const bf16* p = P + (size_t)r * HYB_INP;
        {
            const unsigned* p32 = (const unsigned*)(p + lane * 6); const unsigned w0 = p32[0], w1 = p32[1], w2 = p32[2];
            float f[6] = {bflo(w0), bfhi(w0), bflo(w1), bfhi(w1), bflo(w2), bfhi(w2)}; float ss = 0.f;
#pragma unroll
            for (int j = 0; j < 6; ++j) ss += f[j] * f[j];
            const float rs = rsqrtf(wave_sum(ss, lane) * (1.f / 384.f) + EPS);
#pragma unroll
            for (int j = 0; j < 6; ++j) f[j] = f[j] * rs * qn[lane * 6 + j];
            unsigned* o32 = (unsigned*)(CQN + (size_t)r * 384 + lane * 6); o32[0] = pk2(f[0], f[1]); o32[1] = pk2(f[2], f[3]); o32[2] = pk2(f[4], f[5]);
        }
        {
            const v2u w = *(const v2u*)(p + 384 + lane * 4); float f[4] = {bflo(w.x), bfhi(w.x), bflo(w.y), bfhi(w.y)};
            const float ss = (f[0] * f[0] + f[1] * f[1]) + (f[2] * f[2] + f[3] * f[3]);
            const float rs = rsqrtf(wave_sum(ss, lane) * (1.f / 256.f) + EPS);
            const f32x4 g = *(const f32x4*)(kvn + lane * 4);
            v2u o; o.x = pk2(f[0] * rs * g[0], f[1] * rs * g[1]); o.y = pk2(f[2] * rs * g[2], f[3] * rs * g[3]); *(v2u*)(CKVN + (size_t)r * 256 + lane * 4) = o;
        }
        {
            const int j = lane & 31; const float v = bf1(p[640 + j]); const float o = shx(v, 16, lane); float res = v;
            if (r < TL) { const int t = r & (SEQ - 1); const float c = ct[t * 16 + (j & 15)], s = st[t * 16 + (j & 15)]; res = (j < 16) ? v * c - o * s : o * s + v * c; }
            if (lane < 32) KR[(size_t)r * 32 + j] = (bf16)f2bf(res);
        }
        {
            const int c0 = lane * 8; float gb[8], cur[8], acc[8], t0[8], t1[8];
            unpack8(*(const v4u*)(p + 672 + c0), gb);
            unpack8(*(const v4u*)(p + 1184 + c0), t0); unpack8(*(const v4u*)(p + 1696 + c0), t1);
#pragma unroll
            for (int j = 0; j < 8; ++j) { cur[j] = t0[j] * t1[j]; acc[j] = cw[512 + c0 + j] * cur[j]; }
            if (has_prev(r)) { unpack8(*(const v4u*)(p - HYB_INP + 1184 + c0), t0); unpack8(*(const v4u*)(p - HYB_INP + 1696 + c0), t1);
#pragma unroll
                for (int j = 0; j < 8; ++j) acc[j] += cw[c0 + j] * (t0[j] * t1[j]); }
            if (has_next(r)) { unpack8(*(const v4u*)(p + HYB_INP + 1184 + c0), t0); unpack8(*(const v4u*)(p + HYB_INP + 1696 + c0), t1);
#pragma unroll
                for (int j = 0; j < 8; ++j) acc[j] += cw[1024 + c0 + j] * (t0[j] * t1[j]); }
#pragma unroll
            for (int j = 0; j < 8; ++j) acc[j] *= gb[j];
            *(v4u*)(MIX + (size_t)r * D + 512 + c0) = pack8(acc);
        }
    }
}

__device__ __forceinline__ void convgate(const Args& a, int l, int nrows) {
    const bf16* U = (const bf16*)(a.ws + WS_U); bf16* G = (bf16*)(a.ws + WS_G); const float* cw = a.in[I_FCONV] + (size_t)l * 3 * UPW;
    const int total = nrows * (DFF / 8);
    for (int idx = blockIdx.x * NTHR + otid(a.wv); idx < total; idx += gridDim.x * NTHR) {
        const int r = idx / (DFF / 8), c0 = (idx % (DFF / 8)) * 8; const bf16* u = U + (size_t)r * UPW + c0;
        float ua[8], ug[8], act[8], gate[8];
        unpack8(*(const v4u*)u, ua); unpack8(*(const v4u*)(u + DFF), ug);
#pragma unroll
        for (int j = 0; j < 8; ++j) { act[j] = cw[UPW + c0 + j] * ua[j]; gate[j] = cw[UPW + DFF + c0 + j] * ug[j]; }
        if (has_prev(r)) { unpack8(*(const v4u*)(u - UPW), ua); unpack8(*(const v4u*)(u - UPW + DFF), ug);
#pragma unroll
            for (int j = 0; j < 8; ++j) { act[j] += cw[c0 + j] * ua[j]; gate[j] += cw[DFF + c0 + j] * ug[j]; } }
        if (has_next(r)) { unpack8(*(const v4u*)(u + UPW), ua); unpack8(*(const v4u*)(u + UPW + DFF), ug);
#pragma unroll
            for (int j = 0; j < 8; ++j) { act[j] += cw[2 * UPW + c0 + j] * ua[j]; gate[j] += cw[2 * UPW + DFF + c0 + j] * ug[j]; } }
#pragma unroll
        for (int j = 0; j < 8; ++j) act[j] = silu_f(act[j]) * gate[j];
        *(v4u*)(G + (size_t)r * DFF + c0) = pack8(act);
    }
}

__device__ __forceinline__ void ssd_conv(const Args& a, int i) {
    const bf16* ZX = (const bf16*)(a.ws + WS_ZX); bf16* XBC = (bf16*)(a.ws + WS_XBC); float* DT = (float*)(a.ws + WS_DT); float* AA = (float*)(a.ws + WS_AA);
    const float* cw = a.in[I_SCONVW] + (size_t)i * 3 * 3072; const float* cb = a.in[I_SCONVB] + (size_t)i * 3072;
    const int total = T * 384;
    for (int idx = blockIdx.x * NTHR + otid(a.wv); idx < total; idx += gridDim.x * NTHR) {
        const int r = idx / 384, c0 = (idx % 384) * 8; const bf16* u = ZX + (size_t)r * SSD_INP + 2048 + c0;
        float x[8], acc[8];
        unpack8(*(const v4u*)u, x);
#pragma unroll
        for (int j = 0; j < 8; ++j) acc[j] = cb[c0 + j] + cw[3072 + c0 + j] * x[j];
        if (has_prev(r)) { unpack8(*(const v4u*)(u - SSD_INP), x);
#pragma unroll
            for (int j = 0; j < 8; ++j) acc[j] += cw[c0 + j] * x[j]; }
        if (has_next(r)) { unpack8(*(const v4u*)(u + SSD_INP), x);
#pragma unroll
            for (int j = 0; j < 8; ++j) acc[j] += cw[2 * 3072 + c0 + j] * x[j]; }
#pragma unroll
        for (int j = 0; j < 8; ++j) acc[j] = silu_f(acc[j]);
        *(v4u*)(XBC + (size_t)r * 3072 + c0) = pack8(acc);
    }
    const float* alog = a.in[I_ALOG] + i * 64; const float* dtb = a.in[I_DTB] + i * 64;
    for (int idx = blockIdx.x * NTHR + otid(a.wv); idx < T * 64; idx += gridDim.x * NTHR) {
        const int r = idx >> 6, j = idx & 63; const float raw = bf1(ZX[(size_t)r * SSD_INP + 5120 + j]) + dtb[j];
        const float dt = raw > 15.f ? raw : (raw < -15.f ? __expf(raw) : __logf(1.f + __expf(raw)));
        DT[idx] = dt; AA[idx] = -__expf(alog[j]) * dt;
    }
}

__device__ __forceinline__ void gatenorm(const Args& a, int i, int nrows) {
    const int wave = otid(a.wv) >> 6, lane = otid(a.wv) & 63; const int NGW = gridDim.x * NWAVES, gw = blockIdx.x * NWAVES + wave;
    const bf16* ZX = (const bf16*)(a.ws + WS_ZX); bf16* YN = (bf16*)(a.ws + WS_XBC); const float* nw = a.in[I_SNORM] + i * 2048;
    for (int r = gw; r < nrows; r += NGW) {
        float v[4][8]; float ss = 0.f;
#pragma unroll
        for (int j = 0; j < 4; ++j) { float y[8], z[8]; const int c = j * 512 + lane * 8;
            unpack8(*(const v4u*)(ZX + (size_t)r * SSD_INP + 2048 + c), y); unpack8(*(const v4u*)(ZX + (size_t)r * SSD_INP + c), z);
#pragma unroll
            for (int k = 0; k < 8; ++k) { v[j][k] = y[k] * silu_f(z[k]); ss += v[j][k] * v[j][k]; } }
        const float rs = rsqrtf(wave_sum(ss, lane) * (1.f / 2048.f) + EPS);
#pragma unroll
        for (int j = 0; j < 4; ++j) { const int c = j * 512 + lane * 8; float o[8];
#pragma unroll
            for (int k = 0; k < 8; ++k) o[k] = v[j][k] * rs * nw[c + k];
            *(v4u*)(YN + (size_t)r * 2048 + c) = pack8(o); }
    }
}

__device__ __forceinline__ void attn_naive(const Args& a, LAS unsigned char* lds) {
    const int tid = otid(a.wv), qi = tid >> 1, half = tid & 1;
    const bf16* Qb = (const bf16*)(a.ws + WS_Q); const bf16* KVb = (const bf16*)(a.ws + WS_KV); const bf16* KR = (const bf16*)(a.ws + WS_KR); bf16* MIX = (bf16*)(a.ws + WS_MIX);
    const float* ct = (const float*)(a.ws + WS_ROPE); const float* st = ct + SEQ * 16;
    LAS float* Kt = (LAS float*)lds;
    LAS float* Vt = (LAS float*)(lds + 64 * 96 * 4);
    for (int u = blockIdx.x; u < 576; u += gridDim.x) {
        const bool lat = u < 512; const int b = lat ? (u >> 6) : ((u - 512) >> 3), h = lat ? ((u >> 3) & 7) : ((u - 512) & 7);
        const int nkeys = lat ? (CTXL + SEQ) : CTXL;
        const int qrow = lat ? b * SEQ + (u & 7) * 256 + qi : TL + b * CTXL + qi;
        float q[48];
#pragma unroll
        for (int g = 0; g < 6; ++g) { float f[8]; unpack8(*(const v4u*)(Qb + (size_t)qrow * QW + h * 96 + half * 48 + g * 8), f);
#pragma unroll
            for (int j = 0; j < 8; ++j) q[g * 8 + j] = f[j]; }
        if (lat && half == 1) { const int t = qrow & (SEQ - 1);
#pragma unroll
            for (int j = 0; j < 16; ++j) { const float c = ct[t * 16 + j], s = st[t * 16 + j]; const float x1 = q[16 + j], x2 = q[32 + j]; q[16 + j] = x1 * c - x2 * s; q[32 + j] = x1 * s + x2 * c; } }
#pragma unroll
        for (int j = 0; j < 48; ++j) q[j] *= ATT_SCALE_LOG2E;
        float o[32]; float m = -1e30f, l = 0.f;
#pragma unroll
        for (int j = 0; j < 32; ++j) o[j] = 0.f;
        for (int k0 = 0; k0 < nkeys; k0 += 64) {
            __syncthreads();
            for (int g = tid; g < 768; g += NTHR) { const int key = g / 12, part = g % 12; const int kk = k0 + key; const int krow = kk < CTXL ? TL + b * CTXL + kk : b * SEQ + kk - CTXL;
                float f[8]; unpack8(part < 8 ? *(const v4u*)(KVb + (size_t)krow * KVW + h * 128 + part * 8) : *(const v4u*)(KR + (size_t)krow * 32 + (part - 8) * 8), f);
#pragma unroll
                for (int j = 0; j < 8; ++j) Kt[key * 96 + part * 8 + j] = f[j]; }
            { const int key = tid >> 3, part = tid & 7; const int kk = k0 + key; const int krow = kk < CTXL ? TL + b * CTXL + kk : b * SEQ + kk - CTXL;
                float f[8]; unpack8(*(const v4u*)(KVb + (size_t)krow * KVW + h * 128 + 64 + part * 8), f);
#pragma unroll
                for (int j = 0; j < 8; ++j) Vt[key * 64 + part * 8 + j] = f[j]; }
            __syncthreads();
            for (int kg = 0; kg < 64; kg += 8) {
                float s[8]; float gm = -1e30f;
#pragma unroll
                for (int kk = 0; kk < 8; ++kk) { float acc = 0.f; const LAS f32x4* kp = (const LAS f32x4*)(Kt + (kg + kk) * 96 + half * 48);
#pragma unroll
                    for (int d4 = 0; d4 < 12; ++d4) { const f32x4 kv = kp[d4]; acc += q[d4 * 4] * kv[0] + q[d4 * 4 + 1] * kv[1] + q[d4 * 4 + 2] * kv[2] + q[d4 * 4 + 3] * kv[3]; }
                    acc += shx(acc, 1, tid & 63);
                    s[kk] = acc; gm = fmaxf(gm, acc); }
                const float mn = fmaxf(m, gm); const float alpha = exp2f(m - mn); m = mn; l *= alpha;
#pragma unroll
                for (int j = 0; j < 32; ++j) o[j] *= alpha;
#pragma unroll
                for (int kk = 0; kk < 8; ++kk) { const float p = exp2f(s[kk] - mn); l += p; const LAS f32x4* vp = (const LAS f32x4*)(Vt + (kg + kk) * 64 + half * 32);
#pragma unroll
                    for (int d4 = 0; d4 < 8; ++d4) { const f32x4 vv = vp[d4]; o[d4 * 4] += p * vv[0]; o[d4 * 4 + 1] += p * vv[1]; o[d4 * 4 + 2] += p * vv[2]; o[d4 * 4 + 3] += p * vv[3]; } }
            }
        }
        { const float inv = 1.f / l;
#pragma unroll
            for (int g = 0; g < 4; ++g) { float f[8];
#pragma unroll
                for (int j = 0; j < 8; ++j) f[j] = o[g * 8 + j] * inv;
                *(v4u*)(MIX + (size_t)qrow * D + h * 64 + half * 32 + g * 8) = pack8(f); } }
    }
}

__device__ __forceinline__ void ssd_scan_naive(const Args& a, int i, bool last, LAS unsigned char* lds) {
    const int tid = otid(a.wv), p = tid >> 3, nq = tid & 7;
    bf16* ZX = (bf16*)(a.ws + WS_ZX); const bf16* XBC = (const bf16*)(a.ws + WS_XBC); const float* DT = (const float*)(a.ws + WS_DT); const float* AA = (const float*)(a.ws + WS_AA);
    LAS float* xs = (LAS float*)lds;
    LAS float* Bs = (LAS float*)(lds + 16384);
    LAS float* Cs = (LAS float*)(lds + 16384 + 32768);
    LAS float* dts = (LAS float*)(lds + 16384 + 65536);
    LAS float* as = dts + 64;
    for (int it = blockIdx.x; it < NB * 32; it += gridDim.x) {
        const int b = it >> 5, h = it & 31, g = h >> 3; const float dsk = a.in[I_SD][i * 32 + h];
        for (int dir = 0; dir < 2; ++dir) {
            float stt[16];
#pragma unroll
            for (int n = 0; n < 16; ++n) stt[n] = 0.f;
            for (int seg = 0; seg < 2; ++seg) {
                const int len = seg == 0 ? CTXL : SEQ; const int base = seg == 0 ? TL + b * CTXL : b * SEQ; const bool want_y = !(last && seg == 0);
                for (int cc = 0; cc < len / 64; ++cc) {
                    const int t0 = dir == 0 ? cc * 64 : len - 64 - cc * 64;
                    __syncthreads();
                    { const int tt = tid >> 3, part = tid & 7; float f[8]; unpack8(*(const v4u*)(XBC + (size_t)(base + t0 + tt) * 3072 + h * 64 + part * 8), f);
#pragma unroll
                        for (int j = 0; j < 8; ++j) xs[tt * 64 + part * 8 + j] = f[j]; }
                    for (int q = tid; q < 1024; q += NTHR) { const int tt = q >> 4, part = q & 15; float f[8];
                        unpack8(*(const v4u*)(XBC + (size_t)(base + t0 + tt) * 3072 + 2048 + g * 128 + part * 8), f);
#pragma unroll
                        for (int j = 0; j < 8; ++j) Bs[tt * 128 + part * 8 + j] = f[j];
                        unpack8(*(const v4u*)(XBC + (size_t)(base + t0 + tt) * 3072 + 2560 + g * 128 + part * 8), f);
#pragma unroll
                        for (int j = 0; j < 8; ++j) Cs[tt * 128 + part * 8 + j] = f[j]; }
                    if (tid < 64) { dts[tid] = DT[(size_t)(base + t0 + tid) * 64 + dir * 32 + h]; as[tid] = AA[(size_t)(base + t0 + tid) * 64 + dir * 32 + h]; }
                    __syncthreads();
                    for (int s = 0; s < 64; ++s) {
                        const int tt = dir == 0 ? s : 63 - s;
                        const float dec = __expf(as[tt]); const float xv = xs[tt * 64 + p]; const float xd = xv * dts[tt];
                        const LAS f32x4* bp = (const LAS f32x4*)(Bs + tt * 128 + nq * 16); const LAS f32x4* cp = (const LAS f32x4*)(Cs + tt * 128 + nq * 16);
                        float acc = 0.f;
#pragma unroll
                        for (int n4 = 0; n4 < 4; ++n4) { const f32x4 bv = bp[n4], cv = cp[n4];
#pragma unroll
                            for (int k = 0; k < 4; ++k) { stt[n4 * 4 + k] = dec * stt[n4 * 4 + k] + xd * bv[k]; acc += cv[k] * stt[n4 * 4 + k]; } }
                        acc += shx(acc, 1, tid & 63); acc += shx(acc, 2, tid & 63); acc += shx(acc, 4, tid & 63);
                        if (want_y && nq == 0) { bf16* yp = ZX + (size_t)(base + t0 + tt) * SSD_INP + 2048 + h * 64 + p;
                            const float y = dir == 0 ? acc + dsk * xv : acc + bf1(*yp);
                            *yp = (bf16)f2bf(y); }
                    }
                }
            }
            __syncthreads();
            asm volatile("s_waitcnt vmcnt(0)" ::: "memory");
        }
    }
}

typedef short bf16x8 __attribute__((ext_vector_type(8)));
typedef float f32x16 __attribute__((ext_vector_type(16)));
typedef short v4i16_t __attribute__((ext_vector_type(4)));
__device__ __forceinline__ v2u trread(const LAS unsigned char* p) { return __builtin_bit_cast(v2u, __builtin_amdgcn_ds_read_tr16_b64_v4i16((LAS v4i16_t*)p)); }
__device__ __forceinline__ unsigned cvtpk(float lo, float hi) { return hw_cvtpk(lo, hi); }
constexpr int ATT_KP = 208, ATT_VP = 192, ATT_KB = 64 * ATT_KP, ATT_VB = 64 * ATT_VP, ATT_BUF = ATT_KB + ATT_VB;
#ifndef ATT_NQ
#define ATT_NQ 2
#endif
#ifndef ATT_XCDSWZ
#define ATT_XCDSWZ 1
#endif
#ifndef ATT_LAZY
#define ATT_LAZY 8
#endif
template <int NQ>
__device__ __forceinline__ void attn_unit3(const Args& a, LAS unsigned char* lds, const int b, const int h, const int q0, const int ntiles, const bool lat) {
    const int tid = otid(a.wv), wave = a.wv, lane = tid & 63, r32 = lane & 31, hh = lane >> 5;
    const int tq = (lane >> 2) & 3, tp = lane & 3, tblk = (lane >> 4) & 1;
    const bf16* Qb = (const bf16*)(a.ws + WS_Q); const bf16* KVb = (const bf16*)(a.ws + WS_KV); const bf16* KR = (const bf16*)(a.ws + WS_KR); bf16* MIX = (bf16*)(a.ws + WS_MIX);
    const float* ct = (const float*)(a.ws + WS_ROPE); const float* st = ct + SEQ * 16;
    bf16x8 qf[NQ][6];
#pragma unroll
    for (int nq = 0; nq < NQ; ++nq) { const int qrow = q0 + wave * (32 * NQ) + nq * 32 + r32;
#pragma unroll
        for (int s = 0; s < 6; ++s) qf[nq][s] = *(const bf16x8*)(Qb + (size_t)qrow * QW + h * 96 + 16 * s + 8 * hh);
        if (lat) { const int t = qrow & (SEQ - 1);
#pragma unroll
            for (int j = 0; j < 8; j += 2) { float x1[2], x2[2], y1[2], y2[2];
#pragma unroll
                for (int e = 0; e < 2; ++e) { x1[e] = bf1((bf16)qf[nq][4][j + e]); x2[e] = bf1((bf16)qf[nq][5][j + e]); const float c = ct[t * 16 + 8 * hh + j + e], s = st[t * 16 + 8 * hh + j + e];
                    y1[e] = x1[e] * c - x2[e] * s; y2[e] = x1[e] * s + x2[e] * c; }
                const unsigned w1 = pk2(y1[0], y1[1]), w2 = pk2(y2[0], y2[1]);
                qf[nq][4][j] = (short)(w1 & 0xffff); qf[nq][4][j + 1] = (short)(w1 >> 16); qf[nq][5][j] = (short)(w2 & 0xffff); qf[nq][5][j + 1] = (short)(w2 >> 16); } } }
    f32x16 o0[NQ], o1[NQ]; float m[NQ], l[NQ];
#pragma unroll
    for (int nq = 0; nq < NQ; ++nq) { m[nq] = -1e30f; l[nq] = 0.f;
#pragma unroll
        for (int i = 0; i < 16; ++i) { o0[nq][i] = 0.f; o1[nq][i] = 0.f; } }
    v4u kreg0, kreg1, vreg;
#define ATT_LOAD(it) do { const int rb_ = (it) < CTXL / 64 ? TL + b * CTXL + (it) * 64 : b * SEQ + ((it) - CTXL / 64) * 64; \
        const char* kvb_ = (const char*)(KVb + (size_t)rb_ * KVW); const char* krb_ = (const char*)(KR + (size_t)rb_ * 32); \
        kreg0 = *(const v4u*)(kvb_ + (tid >> 3) * 2048 + h * 256 + (tid & 7) * 16); if (tid < 256) kreg1 = *(const v4u*)(krb_ + (tid >> 2) * 64 + (tid & 3) * 16); vreg = *(const v4u*)(kvb_ + (tid >> 3) * 2048 + h * 256 + 128 + (tid & 7) * 16); } while (0)
#define ATT_WRITE(buf) do { LAS unsigned char* kb_ = lds + (buf) * ATT_BUF; LAS unsigned char* vb_ = kb_ + ATT_KB; \
        *(LAS v4u*)(kb_ + (tid >> 3) * ATT_KP + (tid & 7) * 16) = kreg0; if (tid < 256) *(LAS v4u*)(kb_ + (tid >> 2) * ATT_KP + 128 + (tid & 3) * 16) = kreg1; \
        *(LAS v4u*)(vb_ + (tid >> 3) * ATT_VP + (tid & 7) * 16) = vreg; } while (0)
    __syncthreads();
    ATT_LOAD(0); ATT_WRITE(0);
    __syncthreads();
    for (int it = 0; it < ntiles; ++it) {
#ifdef ATT_JITTER
        if (wave == ((it * 5 + (int)blockIdx.x) & 7)) __builtin_amdgcn_s_sleep(100);
#endif
#ifndef ATT_LOADMID
        if (it + 1 < ntiles) ATT_LOAD(it + 1);
#endif
#ifdef ATT_TZ
        int tz = tid; asm volatile("" : "+v"(tz));
        const int lane = tz & 63, r32 = lane & 31, hh = lane >> 5, tq = (lane >> 2) & 3, tp = lane & 3, tblk = (lane >> 4) & 1;
#endif
        const LAS unsigned char* kb = lds + (it & 1) * ATT_BUF; const LAS unsigned char* vb = kb + ATT_KB;
#pragma unroll
        for (int t = 0; t < 2; ++t) {
            f32x16 sc[NQ]; bf16x8 pf[NQ][2];
#pragma unroll
            for (int nq = 0; nq < NQ; ++nq)
#pragma unroll
                for (int i = 0; i < 16; ++i) sc[nq][i] = 0.f;
            bf16x8 kf[6];
#pragma unroll
            for (int s = 0; s < 6; ++s) kf[s] = *(const LAS bf16x8*)(kb + (32 * t + r32) * ATT_KP + (16 * s + 8 * hh) * 2);
            asm volatile("" : "+v"(kf[0]), "+v"(kf[1]), "+v"(kf[2]), "+v"(kf[3]), "+v"(kf[4]), "+v"(kf[5]));
#pragma unroll
            for (int s = 0; s < 6; ++s)
#pragma unroll
                for (int nq = 0; nq < NQ; ++nq) sc[nq] = __builtin_amdgcn_mfma_f32_32x32x16_bf16(kf[s], qf[nq][s], sc[nq], 0, 0, 0);
#ifdef ATT_LOADMID
            if (t == 0 && it + 1 < ntiles) ATT_LOAD(it + 1);
#endif
#pragma unroll
            for (int nq = 0; nq < NQ; ++nq) {
                float mx = sc[nq][0];
#pragma unroll
                for (int i = 1; i < 16; ++i) mx = fmaxf(mx, sc[nq][i]);
                mx = fmaxf(mx, shx(mx, 32, lane));
#ifdef ATT_LAZY
                const float mxs = mx * ATT_SCALE_LOG2E;
                if (__builtin_amdgcn_ballot_w64(mxs > m[nq] + (float)ATT_LAZY) != 0ull) {
                    const float mn = fmaxf(m[nq], mxs); const float alpha = __builtin_amdgcn_exp2f(m[nq] - mn); m[nq] = mn; l[nq] *= alpha;
#pragma unroll
                    for (int i = 0; i < 16; ++i) { o0[nq][i] *= alpha; o1[nq][i] *= alpha; } }
                { const float mn = m[nq]; float rs = 0.f;
#pragma unroll
                  for (int i = 0; i < 16; ++i) { sc[nq][i] = __builtin_amdgcn_exp2f(sc[nq][i] * ATT_SCALE_LOG2E - mn); rs += sc[nq][i]; }
                  l[nq] += rs; }
#else
                const float mn = fmaxf(m[nq], mx * ATT_SCALE_LOG2E); const float alpha = __builtin_amdgcn_exp2f(m[nq] - mn); m[nq] = mn;
                float rs = 0.f;
#pragma unroll
                for (int i = 0; i < 16; ++i) { sc[nq][i] = __builtin_amdgcn_exp2f(sc[nq][i] * ATT_SCALE_LOG2E - mn); rs += sc[nq][i]; }
                l[nq] = l[nq] * alpha + rs;
#ifdef ATT_SKIPRS
                if (__builtin_amdgcn_ballot_w64(alpha != 1.0f) != 0ull)
#endif
                {
#pragma unroll
                    for (int i = 0; i < 16; ++i) { o0[nq][i] *= alpha; o1[nq][i] *= alpha; } }
#endif
#pragma unroll
                for (int s2 = 0; s2 < 2; ++s2) { v4u w0;
                    w0.x = cvtpk(sc[nq][8 * s2 + 0], sc[nq][8 * s2 + 1]); w0.y = cvtpk(sc[nq][8 * s2 + 2], sc[nq][8 * s2 + 3]); w0.z = cvtpk(sc[nq][8 * s2 + 4], sc[nq][8 * s2 + 5]); w0.w = cvtpk(sc[nq][8 * s2 + 6], sc[nq][8 * s2 + 7]);
                    pf[nq][s2] = __builtin_bit_cast(bf16x8, w0); }
            }
#pragma unroll
            for (int s2 = 0; s2 < 2; ++s2) { const int ko = t * 32 + 16 * s2 + 4 * hh;
                { const LAS unsigned char* tb = vb + (ko + tq) * ATT_VP + (16 * tblk + 4 * tp) * 2; const v2u lo = trread(tb), hi = trread(tb + 8 * ATT_VP); const bf16x8 vf = __builtin_bit_cast(bf16x8, (v4u){lo.x, lo.y, hi.x, hi.y});
#pragma unroll
                  for (int nq = 0; nq < NQ; ++nq) o0[nq] = __builtin_amdgcn_mfma_f32_32x32x16_bf16(vf, pf[nq][s2], o0[nq], 0, 0, 0); }
                { const LAS unsigned char* tb = vb + (ko + tq) * ATT_VP + (32 + 16 * tblk + 4 * tp) * 2; const v2u lo = trread(tb), hi = trread(tb + 8 * ATT_VP); const bf16x8 vf = __builtin_bit_cast(bf16x8, (v4u){lo.x, lo.y, hi.x, hi.y});
#pragma unroll
                  for (int nq = 0; nq < NQ; ++nq) o1[nq] = __builtin_amdgcn_mfma_f32_32x32x16_bf16(vf, pf[nq][s2], o1[nq], 0, 0, 0); } }
        }
        if (it + 1 < ntiles) ATT_WRITE((it + 1) & 1);
        __syncthreads();
    }
#undef ATT_LOAD
#undef ATT_WRITE
#pragma unroll
    for (int nq = 0; nq < NQ; ++nq) { const int qrow = q0 + wave * (32 * NQ) + nq * 32 + r32;
        const float lsum = l[nq] + shx(l[nq], 32, lane); const float inv = 1.f / lsum;
        bf16* orow = MIX + (size_t)qrow * D + h * 64 + 4 * hh;
#pragma unroll
        for (int g = 0; g < 4; ++g) {
            v2u w; w.x = pk2(o0[nq][4 * g] * inv, o0[nq][4 * g + 1] * inv); w.y = pk2(o0[nq][4 * g + 2] * inv, o0[nq][4 * g + 3] * inv); *(v2u*)(orow + 8 * g) = w;
            v2u x; x.x = pk2(o1[nq][4 * g] * inv, o1[nq][4 * g + 1] * inv); x.y = pk2(o1[nq][4 * g + 2] * inv, o1[nq][4 * g + 3] * inv); *(v2u*)(orow + 32 + 8 * g) = x; } }
}
__device__ __forceinline__ void attn_mfma(const Args& a, LAS unsigned char* lds) {
#if ATT_NQ == 2
    for (int u0 = blockIdx.x; u0 < 256; u0 += gridDim.x) { const int u = (gridDim.x == 256 && ATT_XCDSWZ) ? ((u0 & 7) * 32 + (u0 >> 3)) : u0;
        attn_unit3<2>(a, lds, u >> 5, (u >> 2) & 7, (u >> 5) * SEQ + (u & 3) * 512, (CTXL + SEQ) / 64, true); }
#else
    for (int u = blockIdx.x; u < 512; u += gridDim.x) attn_unit3<1>(a, lds, u >> 6, (u >> 3) & 7, (u >> 6) * SEQ + (u & 7) * 256, (CTXL + SEQ) / 64, true);
#endif
    for (int u = blockIdx.x; u < 64; u += gridDim.x) attn_unit3<1>(a, lds, u >> 3, u & 7, TL + (u >> 3) * CTXL, CTXL / 64, false);
}

#ifndef SSD_PRIO
#define SSD_PRIO 1
#endif
#ifndef SSD_XCDSWZ
#define SSD_XCDSWZ 1
#endif
#ifndef SSD_PFEARLY
#define SSD_PFEARLY 0
#endif
#ifndef SSD_YREP
#define SSD_YREP 1
#endif
#ifndef SSD_WREP
#define SSD_WREP 1
#endif
constexpr int SP_B = 272, SP_X = 192;
constexpr int SO_B = 0, SO_C = SO_B + 128 * SP_B, SO_XD = SO_C + 128 * SP_B, SO_XW = SO_XD + 128 * SP_X, SO_S = SO_XW + 128 * SP_X, SO_V = SO_S + 64 * SP_B;
static_assert(SO_V + 2 * 2048 <= LDS_BYTES, "ssd lds map");
#ifdef SSD_DIAG
#define SSD_T(v) long long v = clock64()
#define SSD_ACC(k, v) do { const long long n_ = clock64(); dacc[k] += n_ - v; v = n_; } while (0)
#else
#define SSD_T(v) do {} while (0)
#define SSD_ACC(k, v) do {} while (0)
#endif
__device__ __forceinline__ void ssd_scan_mfma(const Args& a, int i, bool last, LAS unsigned char* lds) {
#ifdef SSD_DIAG
    long long dacc[12] = {0, 0, 0, 0, 0, 0, 0, 0, 0, 0, 0, 0};
#endif
    const int tid = otid(a.wv), wave = a.wv, lane = tid & 63, r32 = lane & 31, hh = lane >> 5;
    const int pt = wave >> 2, lt = pt ? 3 - (wave & 3) : (wave & 3);
    const int tq = (lane >> 2) & 3, tp = lane & 3, tblk = (lane >> 4) & 1;
    bf16* ZX = (bf16*)(a.ws + WS_ZX); const bf16* XBC = (const bf16*)(a.ws + WS_XBC); bf16* GX = (bf16*)(a.ws + WS_XBC); float* SSq = (float*)(a.ws + WS_SS); const float* DT = (const float*)(a.ws + WS_DT); const float* AA = (const float*)(a.ws + WS_AA);
    LAS unsigned char* Bl = lds + SO_B; LAS unsigned char* Cl = lds + SO_C; LAS unsigned char* XDl = lds + SO_XD; LAS unsigned char* XWl = lds + SO_XW; LAS unsigned char* Sl = lds + SO_S;
    const int brow = tid >> 4, bpart = tid & 15, xrow = tid >> 3, xpart = tid & 7;
    for (int it = blockIdx.x; it < NB * 32; it += gridDim.x) {
        const int itx = (gridDim.x == 256 && SSD_XCDSWZ) ? ((it & 7) * 32 + (it >> 3)) : it;
        const int b = itx >> 5, h = itx & 31, g = h >> 3; const float dsk = a.in[I_SD][i * 32 + h];
        for (int dir = 0; dir < 2; ++dir) {
            const int scanw = dir == 0 ? 0 : 3;
            f32x16 sacc;
#pragma unroll
            for (int k = 0; k < 16; ++k) sacc[k] = 0.f;
            SSD_T(tprev);
            v4u bq[4], cq[4], xq[2]; float pa0 = 0.f, pa1 = 0.f, pd0 = 0.f, pd1 = 0.f, qa0 = 0.f, qa1 = 0.f, qd0 = 0.f, qd1 = 0.f; v2u add[4], zq[4];
#define SSD_ROWBASE(c) ((c) < 2 ? TL + b * CTXL + (dir == 0 ? (c) : 1 - (c)) * 128 : b * SEQ + (dir == 0 ? (c) - 2 : 17 - (c)) * 128)
#define SSD_PFB(c) do { const int rb_ = SSD_ROWBASE(c); _Pragma("unroll") for (int k_ = 0; k_ < 4; ++k_) bq[k_] = *(const v4u*)(XBC + (size_t)(rb_ + brow + 32 * k_) * 3072 + 2048 + g * 128 + bpart * 8); } while (0)
#define SSD_PFC(c) do { const int rb_ = SSD_ROWBASE(c); _Pragma("unroll") for (int k_ = 0; k_ < 4; ++k_) cq[k_] = *(const v4u*)(XBC + (size_t)(rb_ + brow + 32 * k_) * 3072 + 2560 + g * 128 + bpart * 8); } while (0)
#define SSD_PFX(c) do { const int rb_ = SSD_ROWBASE(c); _Pragma("unroll") for (int k_ = 0; k_ < 2; ++k_) xq[k_] = *(const v4u*)(XBC + (size_t)(rb_ + xrow + 64 * k_) * 3072 + h * 64 + xpart * 8); } while (0)
#define SSD_PF(c) do { SSD_PFB(c); SSD_PFC(c); SSD_PFX(c); } while (0)
#define SSD_PFV(c) do { if (wave == scanw) { const int rb_ = SSD_ROWBASE(c); const size_t o_ = (size_t)(rb_ + 2 * lane) * 64 + dir * 32 + h; qa0 = AA[o_]; qa1 = AA[o_ + 64]; qd0 = DT[o_]; qd1 = DT[o_ + 64]; } } while (0)
#define SSD_PFY(c) do { const int rb_ = SSD_ROWBASE(c); const size_t r_ = (size_t)(rb_ + 32 * lt + r32); \
                _Pragma("unroll") for (int q_ = 0; q_ < 4; ++q_) { add[q_] = dir == 0 ? *(const v2u*)(XBC + r_ * 3072 + h * 64 + 32 * pt + 4 * hh + 8 * q_) : *(const v2u*)(ZX + r_ * SSD_INP + 2048 + h * 64 + 32 * pt + 4 * hh + 8 * q_); \
                    if (dir == 1) zq[q_] = *(const v2u*)(ZX + r_ * SSD_INP + h * 64 + 32 * pt + 4 * hh + 8 * q_); } } while (0)
#define SSD_SCAN(vb_) do { if (wave == scanw) { LAS float* V_ = (LAS float*)(lds + SO_V + (vb_) * 2048); const float pair_ = pa0 + pa1; float ps_ = pair_; \
                _Pragma("unroll") for (int d_ = 1; d_ < 64; d_ <<= 1) { const int src_ = dir == 0 ? lane - d_ : lane + d_; const float t_ = __builtin_bit_cast(float, __builtin_amdgcn_ds_bpermute((src_ & 63) << 2, __builtin_bit_cast(int, ps_))); if (src_ >= 0 && src_ < 64) ps_ += t_; } \
                const float tot_ = __builtin_bit_cast(float, __builtin_amdgcn_ds_bpermute((dir == 0 ? 63 : 0) << 2, __builtin_bit_cast(int, ps_))); const float ex_ = ps_ - pair_; \
                float c0_, c1_; if (dir == 0) { c0_ = ex_ + pa0; c1_ = c0_ + pa1; } else { c1_ = ex_ + pa1; c0_ = c1_ + pa0; } \
                V_[2 * lane] = c0_; V_[2 * lane + 1] = c1_; V_[128 + 2 * lane] = pd0; V_[128 + 2 * lane + 1] = pd1; V_[256 + 2 * lane] = pd0 * __expf(tot_ - c0_); V_[256 + 2 * lane + 1] = pd1 * __expf(tot_ - c1_); \
                if (lane == 0) V_[384] = tot_; } } while (0)
#define SSD_WRITE(vb_) do { const LAS float* V_ = (const LAS float*)(lds + SO_V + (vb_) * 2048); \
                _Pragma("unroll") for (int k_ = 0; k_ < 4; ++k_) { *(LAS v4u*)(Bl + (brow + 32 * k_) * SP_B + bpart * 16) = bq[k_]; *(LAS v4u*)(Cl + (brow + 32 * k_) * SP_B + bpart * 16) = cq[k_]; } \
                _Pragma("unroll") for (int k_ = 0; k_ < 2; ++k_) { const int s_ = xrow + 64 * k_; const float dt_ = V_[128 + s_], w_ = V_[256 + s_]; float f_[8], g_[8]; unpack8(xq[k_], f_); \
                    _Pragma("unroll") for (int j_ = 0; j_ < 8; ++j_) { g_[j_] = f_[j_] * w_; f_[j_] *= dt_; } \
                    *(LAS v4u*)(XDl + s_ * SP_X + xpart * 16) = pack8(f_); *(LAS v4u*)(XWl + s_ * SP_X + xpart * 16) = pack8(g_); } } while (0)
            __syncthreads();
            SSD_PFV(0); pa0 = qa0; pa1 = qa1; pd0 = qd0; pd1 = qd1; SSD_PFV(1); SSD_PFY(0); SSD_PF(0);
            { const float t0_ = qa0, t1_ = qa1, t2_ = qd0, t3_ = qd1; SSD_SCAN(0); pa0 = t0_; pa1 = t1_; pd0 = t2_; pd1 = t3_; }
            __syncthreads();
            SSD_WRITE(0);
            { LAS v2u* sp = (LAS v2u*)(Sl + (32 * pt + r32) * SP_B + (32 * lt + 4 * hh) * 2);
#pragma unroll
              for (int q = 0; q < 4; ++q) sp[2 * q] = (v2u){0u, 0u}; }
            __syncthreads();
            SSD_ACC(0, tprev);
            for (int c = 0; c < 18; ++c) {
                const int cur = c & 1; const LAS float* V = (const LAS float*)(lds + SO_V + cur * 2048);
#ifdef SSD_JITTER
                if (wave == ((c * 3 + (int)blockIdx.x + dir) & 7)) __builtin_amdgcn_s_sleep(120);
#endif
                const int rowbase = SSD_ROWBASE(c); const bool want_y = !(last && c < 2);
                if (c > 0 && want_y) SSD_PFY(c);
#if SSD_PFEARLY
                if (want_y && c + 1 < 18) SSD_PFB(c + 1);
#endif
                if (c + 1 < 18) { if (c + 2 < 18) SSD_PFV(c + 2); }
                SSD_ACC(1, tprev);
                for (int yrep = 0; yrep < SSD_YREP; ++yrep)
                if (!want_y && c + 1 < 18) { SSD_PFB(c + 1); SSD_PFC(c + 1); SSD_PFX(c + 1); }
                if (want_y) {
                    const int l = 32 * lt + r32; const float cl = V[l];
                    bf16* yptr = ZX + (size_t)(rowbase + l) * SSD_INP + 2048 + h * 64 + 32 * pt + 4 * hh;
                    bf16x8 cf[8];
#pragma unroll
                    for (int ks = 0; ks < 8; ++ks) cf[ks] = *(const LAS bf16x8*)(Cl + l * SP_B + (16 * ks + 8 * hh) * 2);
                    SSD_ACC(8, tprev);
                    f32x16 y1;
#pragma unroll
                    for (int k = 0; k < 16; ++k) y1[k] = 0.f;
#pragma unroll
                    for (int ks = 0; ks < 8; ++ks) { const bf16x8 sf = *(const LAS bf16x8*)(Sl + (32 * pt + r32) * SP_B + (16 * ks + 8 * hh) * 2); y1 = __builtin_amdgcn_mfma_f32_32x32x16_bf16(sf, cf[ks], y1, 0, 0, 0); }
                    { const float el = __expf(cl);
#pragma unroll
                      for (int k = 0; k < 16; ++k) y1[k] *= el; }
                    SSD_ACC(10, tprev);
                    const int st_lo = dir == 0 ? 0 : lt, st_hi = dir == 0 ? lt : 3;
#if SSD_PRIO
                    { const int nsub = st_hi - st_lo; if (nsub == 3) __builtin_amdgcn_s_setprio(3); else if (nsub == 2) __builtin_amdgcn_s_setprio(2); else if (nsub == 1) __builtin_amdgcn_s_setprio(1); }
#endif
#pragma unroll
                    for (int st = 0; st < 4; ++st) { if (c + 1 < 18) { if (st == 1 + SSD_PFEARLY && !SSD_PFEARLY) SSD_PFB(c + 1); if (st == 2 - SSD_PFEARLY) SSD_PFC(c + 1); if (st == 3 - SSD_PFEARLY) SSD_PFX(c + 1); }
                      if (st >= st_lo && st <= st_hi) {
                        f32x16 X;
#pragma unroll
                        for (int k = 0; k < 16; ++k) X[k] = 0.f;
#pragma unroll
                        for (int ks = 0; ks < 8; ++ks) { const bf16x8 af = *(const LAS bf16x8*)(Bl + (32 * st + r32) * SP_B + (16 * ks + 8 * hh) * 2); X = __builtin_amdgcn_mfma_f32_32x32x16_bf16(af, cf[ks], X, 0, 0, 0); }
                        if (st == lt) {
#pragma unroll
                            for (int q = 0; q < 4; ++q) { const f32x4 cs = *(const LAS f32x4*)(V + 32 * st + 8 * q + 4 * hh);
#pragma unroll
                                for (int e = 0; e < 4; ++e) { const int sl = 8 * q + 4 * hh + e; const bool ok = dir == 0 ? (sl <= r32) : (sl >= r32);
                                    X[4 * q + e] *= __expf(ok ? fminf(cl - cs[e], 0.f) : -1.0e30f); } }
                        } else {
#pragma unroll
                            for (int q = 0; q < 4; ++q) { const f32x4 cs = *(const LAS f32x4*)(V + 32 * st + 8 * q + 4 * hh);
#pragma unroll
                                for (int e = 0; e < 4; ++e) X[4 * q + e] *= __expf(fminf(cl - cs[e], 0.f)); }
                        }
#pragma unroll
                        for (int ks2 = 0; ks2 < 2; ++ks2) { v4u w; w.x = cvtpk(X[8 * ks2 + 0], X[8 * ks2 + 1]); w.y = cvtpk(X[8 * ks2 + 2], X[8 * ks2 + 3]); w.z = cvtpk(X[8 * ks2 + 4], X[8 * ks2 + 5]); w.w = cvtpk(X[8 * ks2 + 6], X[8 * ks2 + 7]);
                            const LAS unsigned char* tb = XDl + (32 * st + 16 * ks2 + 4 * hh + tq) * SP_X + (32 * pt + 16 * tblk + 4 * tp) * 2;
                            const v2u lo = trread(tb), hi = trread(tb + 8 * SP_X);
                            y1 = __builtin_amdgcn_mfma_f32_32x32x16_bf16(__builtin_bit_cast(bf16x8, (v4u){lo.x, lo.y, hi.x, hi.y}), __builtin_bit_cast(bf16x8, w), y1, 0, 0, 0); }
                    } }
                    asm volatile("" : "+v"(y1)); SSD_ACC(9, tprev);
                    float ssq = 0.f; bf16* gptr = GX + (size_t)(rowbase + l) * 3072 + h * 64 + 32 * pt + 4 * hh;
#pragma unroll
                    for (int q = 0; q < 4; ++q) { float o[4];
#pragma unroll
                        for (int e = 0; e < 4; ++e) o[e] = y1[4 * q + e];
                        const float a0 = bflo(add[q].x), a1 = bfhi(add[q].x), a2 = bflo(add[q].y), a3 = bfhi(add[q].y);
                        if (dir == 0) { o[0] += dsk * a0; o[1] += dsk * a1; o[2] += dsk * a2; o[3] += dsk * a3;
                            v2u w; w.x = cvtpk(o[0], o[1]); w.y = cvtpk(o[2], o[3]); *(v2u*)(yptr + 8 * q) = w; }
                        else { o[0] += a0; o[1] += a1; o[2] += a2; o[3] += a3;
                            o[0] *= silu_f(bflo(zq[q].x)); o[1] *= silu_f(bfhi(zq[q].x)); o[2] *= silu_f(bflo(zq[q].y)); o[3] *= silu_f(bfhi(zq[q].y));
                            ssq += (o[0] * o[0] + o[1] * o[1]) + (o[2] * o[2] + o[3] * o[3]);
                            v2u w; w.x = cvtpk(o[0], o[1]); w.y = cvtpk(o[2], o[3]); *(v2u*)(gptr + 8 * q) = w; } }
                    if (dir == 1) { ssq += shx(ssq, 32, lane); if (hh == 0) SSq[(size_t)(rowbase + l) * 64 + 2 * h + pt] = ssq; }
                }
#if SSD_PRIO
                __builtin_amdgcn_s_setprio(0);
#endif
                SSD_ACC(2, tprev);
                if (c + 1 < 18) {
                    const float etot = __expf(V[384]);
#pragma unroll
                    for (int k = 0; k < 16; ++k) sacc[k] *= etot;
#pragma unroll
                    for (int kh = 0; kh < 2; ++kh) {
                        v2u alo[4], ahi[4], blo[4], bhi[4];
#pragma unroll
                        for (int k4 = 0; k4 < 4; ++k4) { const int ks = 4 * kh + k4;
                            const LAS unsigned char* ta = Bl + (16 * ks + 8 * hh + tq) * SP_B + (32 * lt + 16 * tblk + 4 * tp) * 2;
                            const LAS unsigned char* tb = XWl + (16 * ks + 8 * hh + tq) * SP_X + (32 * pt + 16 * tblk + 4 * tp) * 2;
                            alo[k4] = trread(ta); ahi[k4] = trread(ta + 4 * SP_B); blo[k4] = trread(tb); bhi[k4] = trread(tb + 4 * SP_X); }
                        asm volatile("" : "+v"(alo[0]), "+v"(alo[1]), "+v"(alo[2]), "+v"(alo[3]), "+v"(bhi[0]), "+v"(bhi[1]), "+v"(bhi[2]), "+v"(bhi[3]));
#pragma unroll
                        for (int k4 = 0; k4 < 4; ++k4)
                            sacc = __builtin_amdgcn_mfma_f32_32x32x16_bf16(__builtin_bit_cast(bf16x8, (v4u){alo[k4].x, alo[k4].y, ahi[k4].x, ahi[k4].y}), __builtin_bit_cast(bf16x8, (v4u){blo[k4].x, blo[k4].y, bhi[k4].x, bhi[k4].y}), sacc, 0, 0, 0); }
                    SSD_SCAN(cur ^ 1); pa0 = qa0; pa1 = qa1; pd0 = qd0; pd1 = qd1;
                }
#ifdef SSD_JITTER
                if (wave == ((c * 5 + 2 + (int)blockIdx.x) & 7)) __builtin_amdgcn_s_sleep(90);
#endif
                SSD_ACC(3, tprev);
                __syncthreads();
                SSD_ACC(4, tprev);
                if (c + 1 < 18) {
                    LAS v2u* sp = (LAS v2u*)(Sl + (32 * pt + r32) * SP_B + (32 * lt + 4 * hh) * 2);
#pragma unroll
                    for (int q = 0; q < 4; ++q) { v2u w; w.x = cvtpk(sacc[4 * q], sacc[4 * q + 1]); w.y = cvtpk(sacc[4 * q + 2], sacc[4 * q + 3]); sp[2 * q] = w; }
                    for (int wrep = 0; wrep < SSD_WREP; ++wrep) { SSD_WRITE(cur ^ 1); }
                }
                SSD_ACC(5, tprev);
                __syncthreads();
                SSD_ACC(6, tprev);
            }
#undef SSD_ROWBASE
#undef SSD_PF
#undef SSD_PFV
#undef SSD_PFY
#undef SSD_SCAN
#undef SSD_WRITE
            asm volatile("s_waitcnt vmcnt(0)" ::: "memory");
        }
    }
#ifdef SSD_DIAG
    if (blockIdx.x == 0 && wave == SSD_DIAG_WAVE && lane == 0 && i == 0) { float* dg = (float*)(a.ws + WS_MOD + 900 * 1024); long long tot = 0;
        for (int k = 0; k < 7; ++k) tot += dacc[k];
        tot += dacc[8] + dacc[9] + dacc[10];
        for (int k = 0; k < 12; ++k) dg[k] = (float)dacc[k]; dg[7] = (float)tot; }
#endif
}

constexpr int AT2_KP = 208, AT2_VP = 192, AT2_KB = 64 * AT2_KP, AT2_VB = 64 * AT2_VP, AT2_BUF = AT2_KB + AT2_VB;
template <int NQ>
__device__ __forceinline__ void attn_unit2(const Args& a, LAS unsigned char* lds, int b, int h, int q0, int ntiles, bool lat) {
    const int tid = otid(a.wv), wave = tid >> 6, lane = tid & 63, r32 = lane & 31, hh = lane >> 5;
    const int tq = (lane >> 2) & 3, tp = lane & 3, tblk = (lane >> 4) & 1;
    const bf16* Qb = (const bf16*)(a.ws + WS_Q); const bf16* KVb = (const bf16*)(a.ws + WS_KV); const bf16* KR = (const bf16*)(a.ws + WS_KR); bf16* MIX = (bf16*)(a.ws + WS_MIX);
    const float* ct = (const float*)(a.ws + WS_ROPE); const float* st = ct + SEQ * 16;
    bf16x8 qf[NQ][6];
#pragma unroll
    for (int nq = 0; nq < NQ; ++nq) { const int qrow = q0 + wave * (32 * NQ) + nq * 32 + r32;
#pragma unroll
        for (int s = 0; s < 6; ++s) qf[nq][s] = *(const bf16x8*)(Qb + (size_t)qrow * QW + h * 96 + 16 * s + 8 * hh);
        if (lat) { const int t = qrow & (SEQ - 1);
#pragma unroll
            for (int j = 0; j < 8; j += 2) { float y1[2], y2[2];
#pragma unroll
                for (int e = 0; e < 2; ++e) { const float x1 = bf1((bf16)qf[nq][4][j + e]), x2 = bf1((bf16)qf[nq][5][j + e]); const float c = ct[t * 16 + 8 * hh + j + e], s = st[t * 16 + 8 * hh + j + e];
                    y1[e] = x1 * c - x2 * s; y2[e] = x1 * s + x2 * c; }
                const unsigned w1 = pk2(y1[0], y1[1]), w2 = pk2(y2[0], y2[1]);
                qf[nq][4][j] = (short)(w1 & 0xffff); qf[nq][4][j + 1] = (short)(w1 >> 16); qf[nq][5][j] = (short)(w2 & 0xffff); qf[nq][5][j + 1] = (short)(w2 >> 16); } }
        asm volatile("" : "+v"(qf[nq][0]), "+v"(qf[nq][1]), "+v"(qf[nq][2]), "+v"(qf[nq][3]), "+v"(qf[nq][4]), "+v"(qf[nq][5]) :: "memory"); }
    f32x16 o[NQ][2]; float m[NQ], l[NQ];
#pragma unroll
    for (int nq = 0; nq < NQ; ++nq) { m[nq] = -1e30f; l[nq] = 0.f;
#pragma unroll
        for (int i = 0; i < 16; ++i) { o[nq][0][i] = 0.f; o[nq][1][i] = 0.f; } }
    v4u kreg0, kreg1, vreg;
#define AT2_LOAD(it, tt) do { const unsigned off_kv = (unsigned)(((tt) >> 3) * (KVW * 2) + h * 256 + ((tt) & 7) * 16), off_kr = (unsigned)(((tt) >> 2) * 64 + ((tt) & 3) * 16); const bool k1ok = (tt) < 256; const int rb_ = (it) < CTXL / 64 ? TL + b * CTXL + (it) * 64 : b * SEQ + ((it) - CTXL / 64) * 64; \
        const char* kvb_ = (const char*)(KVb + (size_t)rb_ * KVW); const char* krb_ = (const char*)(KR + (size_t)rb_ * 32); \
        kreg0 = *(const v4u*)(kvb_ + off_kv); vreg = *(const v4u*)(kvb_ + off_kv + 128); if (k1ok) kreg1 = *(const v4u*)(krb_ + off_kr); } while (0)
#define AT2_WRITE(buf, tt) do { LAS unsigned char* kb_ = lds + (buf) * AT2_BUF; \
        *(LAS v4u*)(kb_ + ((tt) >> 3) * AT2_KP + ((tt) & 7) * 16) = kreg0; if ((tt) < 256) *(LAS v4u*)(kb_ + ((tt) >> 2) * AT2_KP + 128 + ((tt) & 3) * 16) = kreg1; \
        *(LAS v4u*)(kb_ + AT2_KB + ((tt) >> 3) * AT2_VP + ((tt) & 7) * 16) = vreg; } while (0)
    __syncthreads();
    AT2_LOAD(0, tid); AT2_WRITE(0, tid);
    __syncthreads();
    for (int it = 0; it < ntiles; ++it) {
        int tz = tid; asm volatile("" : "+v"(tz));
        const int lane_ = tz & 63, r32_ = lane_ & 31, hh_ = lane_ >> 5, tq_ = (lane_ >> 2) & 3, tp_ = lane_ & 3, tblk_ = (lane_ >> 4) & 1;
#ifdef ATT_LOADTOP
        if (it + 1 < ntiles) AT2_LOAD(it + 1, tz);
#endif
        const LAS unsigned char* kb = lds + (it & 1) * AT2_BUF; const LAS unsigned char* vb = kb + AT2_KB;
        bf16x8 pf[NQ][2][2];
        f32x16 sc[NQ][2];
#pragma unroll
        for (int nq = 0; nq < NQ; ++nq)
#pragma unroll
            for (int i = 0; i < 16; ++i) { sc[nq][0][i] = 0.f; sc[nq][1][i] = 0.f; }
#pragma unroll
        for (int s = 0; s < 6; ++s) { const bf16x8 a0 = *(const LAS bf16x8*)(kb + r32_ * AT2_KP + (16 * s + 8 * hh_) * 2); const bf16x8 a1 = *(const LAS bf16x8*)(kb + (32 + r32_) * AT2_KP + (16 * s + 8 * hh_) * 2);
#pragma unroll
            for (int nq = 0; nq < NQ; ++nq) { sc[nq][0] = __builtin_amdgcn_mfma_f32_32x32x16_bf16(a0, qf[nq][s], sc[nq][0], 0, 0, 0); sc[nq][1] = __builtin_amdgcn_mfma_f32_32x32x16_bf16(a1, qf[nq][s], sc[nq][1], 0, 0, 0); } }
#pragma unroll
        for (int nq = 0; nq < NQ; ++nq) {
            f32x16& s0 = sc[nq][0]; f32x16& s1 = sc[nq][1];
            float mx = s0[0];
#pragma unroll
            for (int i = 1; i < 16; ++i) mx = fmaxf(mx, s0[i]);
#pragma unroll
            for (int i = 0; i < 16; ++i) mx = fmaxf(mx, s1[i]);
            mx = fmaxf(mx, shx(mx, 32, lane_));
            const float mn = fmaxf(m[nq], mx * ATT_SCALE_LOG2E); const float alpha = __builtin_amdgcn_exp2f(m[nq] - mn); m[nq] = mn;
            float rs = 0.f;
#pragma unroll
            for (int i = 0; i < 16; ++i) { s0[i] = __builtin_amdgcn_exp2f(s0[i] * ATT_SCALE_LOG2E - mn); s1[i] = __builtin_amdgcn_exp2f(s1[i] * ATT_SCALE_LOG2E - mn); rs += s0[i] + s1[i]; }
            l[nq] = l[nq] * alpha + rs;
#pragma unroll
            for (int i = 0; i < 16; ++i) { o[nq][0][i] *= alpha; o[nq][1][i] *= alpha; }
#pragma unroll
            for (int s2 = 0; s2 < 2; ++s2) { v4u w0, w1;
                w0.x = cvtpk(s0[8 * s2 + 0], s0[8 * s2 + 1]); w0.y = cvtpk(s0[8 * s2 + 2], s0[8 * s2 + 3]); w0.z = cvtpk(s0[8 * s2 + 4], s0[8 * s2 + 5]); w0.w = cvtpk(s0[8 * s2 + 6], s0[8 * s2 + 7]);
                w1.x = cvtpk(s1[8 * s2 + 0], s1[8 * s2 + 1]); w1.y = cvtpk(s1[8 * s2 + 2], s1[8 * s2 + 3]); w1.z = cvtpk(s1[8 * s2 + 4], s1[8 * s2 + 5]); w1.w = cvtpk(s1[8 * s2 + 6], s1[8 * s2 + 7]);
                pf[nq][0][s2] = __builtin_bit_cast(bf16x8, w0); pf[nq][1][s2] = __builtin_bit_cast(bf16x8, w1); }
        }
#ifndef ATT_LOADTOP
        if (it + 1 < ntiles) AT2_LOAD(it + 1, tz);
#endif
#pragma unroll
        for (int t = 0; t < 2; ++t)
#pragma unroll
            for (int s2 = 0; s2 < 2; ++s2)
#pragma unroll
                for (int dt = 0; dt < 2; ++dt) {
                    const LAS unsigned char* tb = vb + (t * 32 + 16 * s2 + 4 * hh_ + tq_) * AT2_VP + (32 * dt + 16 * tblk_ + 4 * tp_) * 2;
#ifdef ATT_NOTR
                    bf16x8 vf; { const LAS unsigned short* vp_ = (const LAS unsigned short*)(vb + (t * 32 + 16 * s2 + 4 * hh_) * AT2_VP + (32 * dt + r32_) * 2);
#pragma unroll
                      for (int j_ = 0; j_ < 8; ++j_) vf[j_] = (short)vp_[((j_ & 3) + 8 * (j_ >> 2)) * (AT2_VP / 2)]; }
#else
                    const v2u lo = trread(tb), hi = trread(tb + 8 * AT2_VP); const bf16x8 vf = __builtin_bit_cast(bf16x8, (v4u){lo.x, lo.y, hi.x, hi.y});
#endif
#pragma unroll
                    for (int nq = 0; nq < NQ; ++nq) o[nq][dt] = __builtin_amdgcn_mfma_f32_32x32x16_bf16(vf, pf[nq][t][s2], o[nq][dt], 0, 0, 0); }
        if (it + 1 < ntiles) AT2_WRITE((it + 1) & 1, tz);
        __syncthreads();
    }
#undef AT2_LOAD
#undef AT2_WRITE
#pragma unroll
    for (int nq = 0; nq < NQ; ++nq) { int qrow = q0 + wave * (32 * NQ) + nq * 32 + r32; asm volatile("" : "+v"(qrow));
        const float lt = l[nq] + shx(l[nq], 32, lane); const float inv = 1.f / lt;
        bf16* orow = MIX + (size_t)qrow * D + h * 64 + 4 * hh;
#pragma unroll
        for (int g = 0; g < 4; ++g) {
            v2u w; w.x = pk2(o[nq][0][4 * g] * inv, o[nq][0][4 * g + 1] * inv); w.y = pk2(o[nq][0][4 * g + 2] * inv, o[nq][0][4 * g + 3] * inv); *(v2u*)(orow + 8 * g) = w;
            v2u x; x.x = pk2(o[nq][1][4 * g] * inv, o[nq][1][4 * g + 1] * inv); x.y = pk2(o[nq][1][4 * g + 2] * inv, o[nq][1][4 * g + 3] * inv); *(v2u*)(orow + 32 + 8 * g) = x; } }
}
__device__ __forceinline__ void attn_mfma2(const Args& a, LAS unsigned char* lds) {
#ifdef ATT_NQ1
    for (int u = blockIdx.x; u < 512; u += gridDim.x) attn_unit2<1>(a, lds, u >> 6, (u >> 3) & 7, (u >> 6) * SEQ + (u & 7) * 256, (CTXL + SEQ) / 64, true);
#else
    for (int u = blockIdx.x; u < 256; u += gridDim.x) attn_unit2<2>(a, lds, u >> 5, (u >> 2) & 7, (u >> 5) * SEQ + (u & 3) * 512, (CTXL + SEQ) / 64, true);
#endif
    for (int u = blockIdx.x; u < 64; u += gridDim.x) attn_unit2<1>(a, lds, u >> 3, u & 7, TL + (u >> 3) * CTXL, CTXL / 64, false);
}

template <int R, int PART = 0>
__device__ __forceinline__ void rowwise2(const float* xs_lat, const float* xs_ctx, float* xd_lat, float* xd_ctx, const bf16* Mb, const bf16* Mp, const float* modg, const float* nwA,
                                         bf16* H, const float* modh, int sh_off, int sc_off, const float* nwB, int nrows, int wv, int sfmt = 0, int dfmt = 0) {
    if (PART == 1 && blockIdx.x < 64) return;
    const int tid = otid(wv), wave = wv, lane = tid & 63; const int NGW = gridDim.x * NWAVES, gw = xblk() * NWAVES + wave;
    constexpr int JS = (PART == 2) ? 0 : R - 1;
    const int wq1 = (((int)blockIdx.x >> 3) - 8) * NWAVES + wave, rb1 = 2048 * ((int)blockIdx.x & 7) + wq1 * 10 + min(wq1, 128), cnt1 = 10 + (wq1 < 128 ? 1 : 0);
    const int nlat = min(nrows, TL), nctx = nrows - nlat; const bool even_ = (nlat % NGW == 0) && (nctx % NGW == 0);
    const int rpw = (nrows + NGW - 1) / NGW; const int lpw = even_ ? nlat / NGW : 0, cpw = even_ ? nctx / NGW : 0;
    const int rbeg = (PART != 0 || even_) ? 0 : gw * rpw, rend = PART == 1 ? cnt1 : (PART == 2 ? 1 : (even_ ? lpw + cpw : min(rbeg + rpw, nrows)));
#define RW_ROW(ii) (PART == 1 ? rb1 + (ii) : (PART == 2 ? TL + gw : (even_ ? ((ii) < lpw ? gw * lpw + (ii) : TL + gw * cpw + ((ii) - lpw)) : (ii))))
    for (int r0 = rbeg; r0 < rend; r0 += R) {
        f32x4 v[R][4]; v4u vr[R][4]; v2u mm[R][4], mm2[4];
#pragma unroll
        for (int j = 0; j < R; ++j) { const int r = RW_ROW(min(r0 + j, rend - 1)); const float* xs = r < TL ? xs_lat + (size_t)r * D : xs_ctx + (size_t)(r - TL) * D;
#pragma unroll
            for (int q = 0; q < 4; ++q) {
                if (((r < TL) ? (sfmt & 1) : (sfmt & 2)) == 0) vr[j][q] = __builtin_nontemporal_load((const v4u*)(xs + q * 256 + lane * 4));
                else { const bool lt_ = r < TL; const int rr_ = lt_ ? r : r - TL; const char* b_ = (const char*)(lt_ ? xs_lat : xs_ctx); const size_t nr_ = lt_ ? TL : TC;
                    const v2u hi_ = *(const v2u*)(b_ + (size_t)rr_ * 2048 + (q * 256 + lane * 4) * 2); const unsigned lo_ = *(const unsigned*)(b_ + nr_ * 2048 + (size_t)rr_ * 1024 + q * 256 + lane * 4);
                    vr[j][q] = (v4u){hi_.x, hi_.y, lo_, 0u}; } }
            if (Mb) { const bool sp = Mp != nullptr && r >= TL; const bf16* m0 = sp ? Mp + (size_t)(r - TL) * D : Mb + (size_t)r * D;
#pragma unroll
                for (int q = 0; q < 4; ++q) mm[j][q] = *(const v2u*)(m0 + q * 256 + lane * 4);
                if (j == JS) {
                    if (sp) {
#pragma unroll
                        for (int q = 0; q < 4; ++q) mm2[q] = *(const v2u*)(m0 + (size_t)TC * D + q * 256 + lane * 4); }
                    else {
#pragma unroll
                        for (int q = 0; q < 4; ++q) mm2[q] = (v2u){0u, 0u}; } } } }
#pragma unroll
        for (int j = 0; j < R; ++j) { if (r0 + j < rend) { const int r = RW_ROW(r0 + j);
            const bool lat = r < TL; const int cond = lat ? (r >> 11) : 8; float* xd = lat ? xd_lat + (size_t)r * D : xd_ctx + (size_t)(r - TL) * D;
            if ((lat ? (sfmt & 1) : (sfmt & 2)) != 0) {
#pragma unroll
                for (int q = 0; q < 4; ++q) { const unsigned hx = vr[j][q].x, hy = vr[j][q].y, lo = vr[j][q].z;
                    const unsigned h0 = hx & 0xFFFFu, h1 = hx >> 16, h2 = hy & 0xFFFFu, h3 = hy >> 16, l0 = lo & 0xFFu, l1 = (lo >> 8) & 0xFFu, l2 = (lo >> 16) & 0xFFu, l3 = lo >> 24;
                    v[j][q][0] = __builtin_bit_cast(float, (h0 << 16) | (l0 << 8)); v[j][q][1] = __builtin_bit_cast(float, (h1 << 16) | (l1 << 8));
                    v[j][q][2] = __builtin_bit_cast(float, (h2 << 16) | (l2 << 8)); v[j][q][3] = __builtin_bit_cast(float, (h3 << 16) | (l3 << 8)); } }
            else {
#pragma unroll
                for (int q = 0; q < 4; ++q) v[j][q] = __builtin_bit_cast(f32x4, vr[j][q]); }
            if (Mb) {
                f32x4 m[4]; float ss = 0.f;
#pragma unroll
                for (int q = 0; q < 4; ++q) { const v2u w = mm[j][q]; m[q] = (f32x4){bflo(w.x), bfhi(w.x), bflo(w.y), bfhi(w.y)};
                    if (j == JS) { const v2u w2 = mm2[q]; m[q] = m[q] + (f32x4){bflo(w2.x), bfhi(w2.x), bflo(w2.y), bfhi(w2.y)}; } ss += (m[q][0] * m[q][0] + m[q][1] * m[q][1]) + (m[q][2] * m[q][2] + m[q][3] * m[q][3]); }
                const float rs = rsqrtf(wave_sum(ss, lane) * (1.f / D) + EPS);
#pragma unroll
                for (int q = 0; q < 4; ++q) { const f32x4 g = *(const f32x4*)(modg + (size_t)cond * MODW + q * 256 + lane * 4); const f32x4 w = *(const f32x4*)(nwA + q * 256 + lane * 4);
                    v[j][q] = v[j][q] + g * (m[q] * rs * w); }
            }
            if (xd_lat) {
                if ((lat ? (dfmt & 1) : (dfmt & 2)) == 0) {
#pragma unroll
                    for (int q = 0; q < 4; ++q) __builtin_nontemporal_store(v[j][q], (f32x4*)(xd + q * 256 + lane * 4)); }
                else { const int rr_ = lat ? r : r - TL; char* b_ = (char*)(lat ? xd_lat : xd_ctx); const size_t nr_ = lat ? TL : TC;
#pragma unroll
                    for (int q = 0; q < 4; ++q) { const float f0_ = v[j][q][0], f1_ = v[j][q][1], f2_ = v[j][q][2], f3_ = v[j][q][3];
                        const unsigned b0 = __builtin_bit_cast(unsigned, f0_) + 0x80u, b1 = __builtin_bit_cast(unsigned, f1_) + 0x80u, b2 = __builtin_bit_cast(unsigned, f2_) + 0x80u, b3 = __builtin_bit_cast(unsigned, f3_) + 0x80u;
                        const unsigned h0 = b0 >> 16, h1 = b1 >> 16, h2 = b2 >> 16, h3 = b3 >> 16, l0 = (b0 >> 8) & 0xFFu, l1 = (b1 >> 8) & 0xFFu, l2 = (b2 >> 8) & 0xFFu, l3 = (b3 >> 8) & 0xFFu;
                        v2u hi_; hi_.x = h0 | (h1 << 16); hi_.y = h2 | (h3 << 16);
                        const unsigned lo_ = l0 | (l1 << 8) | (l2 << 16) | (l3 << 24);
                        *(v2u*)(b_ + (size_t)rr_ * 2048 + (q * 256 + lane * 4) * 2) = hi_; *(unsigned*)(b_ + nr_ * 2048 + (size_t)rr_ * 1024 + q * 256 + lane * 4) = lo_; } } }
            if (H) {
                float ss = 0.f;
#pragma unroll
                for (int q = 0; q < 4; ++q) ss += (v[j][q][0] * v[j][q][0] + v[j][q][1] * v[j][q][1]) + (v[j][q][2] * v[j][q][2] + v[j][q][3] * v[j][q][3]);
                const float rs = rsqrtf(wave_sum(ss, lane) * (1.f / D) + EPS);
#pragma unroll
                for (int q = 0; q < 4; ++q) { const int c = q * 256 + lane * 4;
                    const f32x4 w = *(const f32x4*)(nwB + c); const f32x4 sc = *(const f32x4*)(modh + (size_t)cond * MODW + sc_off + c); const f32x4 sh = *(const f32x4*)(modh + (size_t)cond * MODW + sh_off + c);
                    const f32x4 hv = (v[j][q] * rs * w) * (sc + 1.0f) + sh;
                    v2u o; o.x = pk2(hv[0], hv[1]); o.y = pk2(hv[2], hv[3]); *(v2u*)(H + (size_t)r * D + c) = o; }
            } } }
    }
}
#undef RW_ROW

__device__ __forceinline__ void convgate2(const Args& a, int l, int nrows) {
    const bf16* U = (const bf16*)(a.ws + WS_U); bf16* G = (bf16*)(a.ws + WS_G); const float* cw = a.in[I_FCONV] + (size_t)l * 3 * UPW;
    const int total = (nrows / 8) * (DFF / 8);
    for (int idx = blockIdx.x * NTHR + otid(a.wv); idx < total; idx += gridDim.x * NTHR) {
        const int r0 = (idx / (DFF / 8)) * 8, c0 = (idx % (DFF / 8)) * 8; const bf16* u = U + (size_t)r0 * UPW + c0;
        const bool hp = has_prev(r0), hn = has_next(r0 + 7);
        v4u ua[10], ug[10];
#pragma unroll
        for (int j = 0; j < 10; ++j) { const int rr = (j == 0 && !hp) ? 0 : ((j == 9 && !hn) ? 7 : j - 1); ua[j] = *(const v4u*)(u + (ptrdiff_t)rr * UPW); ug[j] = *(const v4u*)(u + (ptrdiff_t)rr * UPW + DFF); }
        float wa[3][8], wg[3][8];
#pragma unroll
        for (int t = 0; t < 3; ++t)
#pragma unroll
            for (int j = 0; j < 8; ++j) { wa[t][j] = cw[t * UPW + c0 + j]; wg[t][j] = cw[t * UPW + DFF + c0 + j]; }
        if (!hp) { ua[0] = (v4u){0u, 0u, 0u, 0u}; ug[0] = ua[0]; }
        if (!hn) { ua[9] = (v4u){0u, 0u, 0u, 0u}; ug[9] = ua[9]; }
        float pa[8], ca[8], na[8], pg[8], cg_[8], ng[8];
        unpack8(ua[0], pa); unpack8(ug[0], pg); unpack8(ua[1], ca); unpack8(ug[1], cg_);
#pragma unroll
        for (int j = 0; j < 8; ++j) {
            unpack8(ua[j + 2], na); unpack8(ug[j + 2], ng);
            float o[8];
#pragma unroll
            for (int k = 0; k < 8; ++k) { const float act = wa[0][k] * pa[k] + wa[1][k] * ca[k] + wa[2][k] * na[k]; const float gate = wg[0][k] * pg[k] + wg[1][k] * cg_[k] + wg[2][k] * ng[k]; o[k] = silu_f(act) * gate; }
            *(v4u*)(G + (size_t)(r0 + j) * DFF + c0) = pack8(o);
#pragma unroll
            for (int k = 0; k < 8; ++k) { pa[k] = ca[k]; ca[k] = na[k]; pg[k] = cg_[k]; cg_[k] = ng[k]; }
        }
    }
}

__device__ __forceinline__ void ssd_conv2(const Args& a, int i) {
    const bf16* ZX = (const bf16*)(a.ws + WS_ZX); bf16* XBC = (bf16*)(a.ws + WS_XBC); float* DT = (float*)(a.ws + WS_DT); float* AA = (float*)(a.ws + WS_AA);
    const float* cw = a.in[I_SCONVW] + (size_t)i * 3 * 3072; const float* cb = a.in[I_SCONVB] + (size_t)i * 3072;
    const int total = (T / 8) * 384; const int per = (total + (int)gridDim.x - 1) / (int)gridDim.x, ibase = xblk() * per;
    for (int k_ = otid(a.wv); k_ < per; k_ += NTHR) { const int idx = ibase + k_; if (idx >= total) break;
        const int r0 = (idx / 384) * 8, c0 = (idx % 384) * 8; const bf16* u = ZX + (size_t)r0 * SSD_INP + 2048 + c0;
        const bool hp = has_prev(r0), hn = has_next(r0 + 7);
        v4u ux[10];
#pragma unroll
        for (int j = 0; j < 10; ++j) { const int rr = (j == 0 && !hp) ? 0 : ((j == 9 && !hn) ? 7 : j - 1); ux[j] = *(const v4u*)(u + (ptrdiff_t)rr * SSD_INP); }
        float w[3][8], bias[8];
#pragma unroll
        for (int j = 0; j < 8; ++j) { w[0][j] = cw[c0 + j]; w[1][j] = cw[3072 + c0 + j]; w[2][j] = cw[2 * 3072 + c0 + j]; bias[j] = cb[c0 + j]; }
        if (!hp) ux[0] = (v4u){0u, 0u, 0u, 0u};
        if (!hn) ux[9] = (v4u){0u, 0u, 0u, 0u};
        float p[8], c[8], n[8];
        unpack8(ux[0], p); unpack8(ux[1], c);
#pragma unroll
        for (int j = 0; j < 8; ++j) {
            unpack8(ux[j + 2], n); float o[8];
#pragma unroll
            for (int k = 0; k < 8; ++k) o[k] = silu_f(bias[k] + w[0][k] * p[k] + w[1][k] * c[k] + w[2][k] * n[k]);
            *(v4u*)(XBC + (size_t)(r0 + j) * 3072 + c0) = pack8(o);
#pragma unroll
            for (int k = 0; k < 8; ++k) { p[k] = c[k]; c[k] = n[k]; }
        }
    }
    const float* alog = a.in[I_ALOG] + i * 64; const float* dtb = a.in[I_DTB] + i * 64;
    const int per2 = (T * 8 + (int)gridDim.x - 1) / (int)gridDim.x, ibase2 = xblk() * per2;
    for (int k_ = otid(a.wv); k_ < per2; k_ += NTHR) { const int idx = ibase2 + k_; if (idx >= T * 8) break;
        const int r = idx >> 3, j0 = (idx & 7) * 8; float raw[8], dt[8], av[8];
        unpack8(*(const v4u*)(ZX + (size_t)r * SSD_INP + 5120 + j0), raw);
#pragma unroll
        for (int k = 0; k < 8; ++k) { const float x = raw[k] + dtb[j0 + k]; dt[k] = x > 15.f ? x : (x < -15.f ? __expf(x) : __logf(1.f + __expf(x))); av[k] = -__expf(alog[j0 + k]) * dt[k]; }
        *(f32x4*)(DT + (size_t)r * 64 + j0) = (f32x4){dt[0], dt[1], dt[2], dt[3]}; *(f32x4*)(DT + (size_t)r * 64 + j0 + 4) = (f32x4){dt[4], dt[5], dt[6], dt[7]};
        *(f32x4*)(AA + (size_t)r * 64 + j0) = (f32x4){av[0], av[1], av[2], av[3]}; *(f32x4*)(AA + (size_t)r * 64 + j0 + 4) = (f32x4){av[4], av[5], av[6], av[7]};
    }
}

__device__ __forceinline__ void gatenorm2(const Args& a, int i, int nrows) {
    const int tid = otid(a.wv), wave = a.wv, lane = tid & 63; const int NGW = gridDim.x * NWAVES, gw = blockIdx.x * NWAVES + wave;
    const bf16* ZX = (const bf16*)(a.ws + WS_ZX); bf16* YN = (bf16*)(a.ws + WS_XBC); const float* nw = a.in[I_SNORM] + i * 2048;
    const int rpw = (nrows + NGW - 1) / NGW; const int rbeg = gw * rpw, rend = min(rbeg + rpw, nrows);
    constexpr int R = 3;
    for (int r0 = rbeg; r0 < rend; r0 += R) {
        v4u yv[R][4], zv[R][4];
#pragma unroll
        for (int j = 0; j < R; ++j) { const int r = min(r0 + j, rend - 1);
#pragma unroll
            for (int q = 0; q < 4; ++q) { const int c = q * 512 + lane * 8; yv[j][q] = *(const v4u*)(ZX + (size_t)r * SSD_INP + 2048 + c); zv[j][q] = *(const v4u*)(ZX + (size_t)r * SSD_INP + c); } }
#pragma unroll
        for (int j = 0; j < R; ++j) { const int r = r0 + j; if (r < rend) {
            float v[4][8]; float ss = 0.f;
#pragma unroll
            for (int q = 0; q < 4; ++q) { float y[8], z[8]; unpack8(yv[j][q], y); unpack8(zv[j][q], z);
#pragma unroll
                for (int k = 0; k < 8; ++k) { v[q][k] = y[k] * silu_f(z[k]); ss += v[q][k] * v[q][k]; } }
            const float rs = rsqrtf(wave_sum(ss, lane) * (1.f / 2048.f) + EPS);
#pragma unroll
            for (int q = 0; q < 4; ++q) { const int c = q * 512 + lane * 8; float o[8];
#pragma unroll
                for (int k = 0; k < 8; ++k) o[k] = v[q][k] * rs * nw[c + k];
                *(v4u*)(YN + (size_t)r * 2048 + c) = pack8(o); } } }
    }
}

__device__ __forceinline__ void ffn_fixup(const Args& a, int l, int nrows) {
    const bf16* Ue = (const bf16*)(a.ws + WS_UE); bf16* G = (bf16*)(a.ws + WS_G); const float* cw = a.in[I_FCONV] + (size_t)l * 3 * UPW;
    const int total = (nrows / 256) * 2 * (DFF / 8);
    for (int idx = blockIdx.x * NTHR + otid(a.wv); idx < total; idx += gridDim.x * NTHR) {
        const int cg = idx % (DFF / 8), which = (idx / (DFF / 8)) & 1, pm = idx / (2 * (DFF / 8)); const int c0 = cg * 8; const int col = (c0 / 128) * 256 + (c0 % 128);
        const int r = pm * 256 + (which ? 255 : 0);
        const bf16* e0 = Ue + (size_t)(pm * 4) * UPW + col;
        const bf16* pp = which ? e0 + 2 * UPW : e0 - UPW;
        const bf16* pc = which ? e0 + 3 * UPW : e0;
        const bf16* pn = which ? e0 + 4 * UPW : e0 + UPW;
        const bool hp = which ? true : has_prev(r), hn = which ? has_next(r) : true;
        float pa[8], pg[8], ca[8], cg_[8], na[8], ng[8];
        unpack8(*(const v4u*)pc, ca); unpack8(*(const v4u*)(pc + 128), cg_);
        if (hp) { unpack8(*(const v4u*)pp, pa); unpack8(*(const v4u*)(pp + 128), pg); } else {
#pragma unroll
            for (int k = 0; k < 8; ++k) { pa[k] = 0.f; pg[k] = 0.f; } }
        if (hn) { unpack8(*(const v4u*)pn, na); unpack8(*(const v4u*)(pn + 128), ng); } else {
#pragma unroll
            for (int k = 0; k < 8; ++k) { na[k] = 0.f; ng[k] = 0.f; } }
        float o[8];
#pragma unroll
        for (int k = 0; k < 8; ++k) { const float act = cw[c0 + k] * pa[k] + cw[UPW + c0 + k] * ca[k] + cw[2 * UPW + c0 + k] * na[k];
            const float gate = cw[DFF + c0 + k] * pg[k] + cw[UPW + DFF + c0 + k] * cg_[k] + cw[2 * UPW + DFF + c0 + k] * ng[k]; o[k] = silu_f(act) * gate; }
        *(v4u*)(G + (size_t)r * DFF + c0) = pack8(o);
    }
}

__device__ __forceinline__ void prep_even2(const Args& a, int i) {
    const int tid = otid(a.wv), wave = a.wv, lane = tid & 63; const int NGW = gridDim.x * NWAVES, gw = xblk() * NWAVES + wave;
    const bf16* P = (const bf16*)(a.ws + WS_P); bf16* CQN = (bf16*)(a.ws + WS_CQN); bf16* CKVN = (bf16*)(a.ws + WS_CKVN); bf16* KR = (bf16*)(a.ws + WS_KR); bf16* MIX = (bf16*)(a.ws + WS_MIX);
    const float* qn = a.in[I_QNORM] + i * 384; const float* kvn = a.in[I_KVNORM] + i * 256; const float* cw = a.in[I_SCONV] + i * 3 * 512;
    const float* ct = (const float*)(a.ws + WS_ROPE); const float* st = ct + SEQ * 16;
    constexpr int R = 3; const int rpw = (T + NGW - 1) / NGW; const int rbeg = gw * rpw, rend = min(rbeg + rpw, T);
    const int c0 = lane * 8;
    for (int r0 = rbeg; r0 < rend; r0 += R) {
        unsigned q32[R][3]; v2u kv2[R]; bf16 krv[R]; v4u gbv[R], gcv[R + 2], xvv[R + 2];
#pragma unroll
        for (int j = 0; j < R; ++j) { const int r = min(r0 + j, rend - 1); const bf16* p = P + (size_t)r * HYB_INP;
            const unsigned* p32 = (const unsigned*)(p + lane * 6); q32[j][0] = p32[0]; q32[j][1] = p32[1]; q32[j][2] = p32[2];
            kv2[j] = *(const v2u*)(p + 384 + lane * 4); krv[j] = p[640 + (lane & 31)]; gbv[j] = *(const v4u*)(p + 672 + c0); }
#pragma unroll
        for (int j = 0; j < R + 2; ++j) { int r = r0 + j - 1; r = max(0, min(r, T - 1)); const bf16* p = P + (size_t)r * HYB_INP; gcv[j] = *(const v4u*)(p + 1184 + c0); xvv[j] = *(const v4u*)(p + 1696 + c0); }
#pragma unroll
        for (int j = 0; j < R; ++j) { const int r = r0 + j; if (r < rend) {
            {   float f[6] = {bflo(q32[j][0]), bfhi(q32[j][0]), bflo(q32[j][1]), bfhi(q32[j][1]), bflo(q32[j][2]), bfhi(q32[j][2])}; float ss = 0.f;
#pragma unroll
                for (int k = 0; k < 6; ++k) ss += f[k] * f[k];
                const float rs = rsqrtf(wave_sum(ss, lane) * (1.f / 384.f) + EPS);
#pragma unroll
                for (int k = 0; k < 6; ++k) f[k] = f[k] * rs * qn[lane * 6 + k];
                unsigned* o32 = (unsigned*)(CQN + (size_t)r * 384 + lane * 6); o32[0] = pk2(f[0], f[1]); o32[1] = pk2(f[2], f[3]); o32[2] = pk2(f[4], f[5]); }
            {   const v2u w = kv2[j]; float f[4] = {bflo(w.x), bfhi(w.x), bflo(w.y), bfhi(w.y)};
                const float ss = (f[0] * f[0] + f[1] * f[1]) + (f[2] * f[2] + f[3] * f[3]);
                const float rs = rsqrtf(wave_sum(ss, lane) * (1.f / 256.f) + EPS);
                const f32x4 g = *(const f32x4*)(kvn + lane * 4);
                v2u o; o.x = pk2(f[0] * rs * g[0], f[1] * rs * g[1]); o.y = pk2(f[2] * rs * g[2], f[3] * rs * g[3]); *(v2u*)(CKVN + (size_t)r * 256 + lane * 4) = o; }
            {   const int jj = lane & 31; const float v = bf1(krv[j]); const float o = shx(v, 16, lane); float res = v;
                if (r < TL) { const int t = r & (SEQ - 1); const float c = ct[t * 16 + (jj & 15)], s = st[t * 16 + (jj & 15)]; res = (jj < 16) ? v * c - o * s : o * s + v * c; }
                if (lane < 32) KR[(size_t)r * 32 + jj] = (bf16)f2bf(res); }
            {   float gb[8], t0[8], t1[8], acc[8];
                unpack8(gbv[j], gb); unpack8(gcv[j + 1], t0); unpack8(xvv[j + 1], t1);
#pragma unroll
                for (int k = 0; k < 8; ++k) acc[k] = cw[512 + c0 + k] * (t0[k] * t1[k]);
                if (has_prev(r)) { unpack8(gcv[j], t0); unpack8(xvv[j], t1);
#pragma unroll
                    for (int k = 0; k < 8; ++k) acc[k] += cw[c0 + k] * (t0[k] * t1[k]); }
                if (has_next(r)) { unpack8(gcv[j + 2], t0); unpack8(xvv[j + 2], t1);
#pragma unroll
                    for (int k = 0; k < 8; ++k) acc[k] += cw[1024 + c0 + k] * (t0[k] * t1[k]); }
#pragma unroll
                for (int k = 0; k < 8; ++k) acc[k] *= gb[k];
                *(v4u*)(MIX + (size_t)r * D + 512 + c0) = pack8(acc); }
        } }
    }
}

__device__ __forceinline__ void ffn_fixup_panel(const Args& a, int l, int pm) {
    const bf16* Ue = (const bf16*)(a.ws + WS_UE); bf16* G = (bf16*)(a.ws + WS_G); const float* cw = a.in[I_FCONV] + (size_t)l * 3 * UPW;
    for (int idx = otid(a.wv); idx < 2 * (DFF / 8); idx += NTHR) {
        const int cg = idx % (DFF / 8), which = idx / (DFF / 8); const int c0 = cg * 8; const int col = (c0 / 128) * 256 + (c0 % 128);
        const int r = pm * 256 + (which ? 255 : 0);
        const bf16* e0 = Ue + (size_t)(pm * 4) * UPW + col;
        const bf16* pp = which ? e0 + 2 * UPW : e0 - UPW; const bf16* pc = which ? e0 + 3 * UPW : e0; const bf16* pn = which ? e0 + 4 * UPW : e0 + UPW;
        const bool hp = which ? true : has_prev(r), hn = which ? has_next(r) : true;
        float pa[8], pg[8], ca[8], cg_[8], na[8], ng[8];
        unpack8(*(const v4u*)pc, ca); unpack8(*(const v4u*)(pc + 128), cg_);
        if (hp) { unpack8(*(const v4u*)pp, pa); unpack8(*(const v4u*)(pp + 128), pg); } else {
#pragma unroll
            for (int k = 0; k < 8; ++k) { pa[k] = 0.f; pg[k] = 0.f; } }
        if (hn) { unpack8(*(const v4u*)pn, na); unpack8(*(const v4u*)(pn + 128), ng); } else {
#pragma unroll
            for (int k = 0; k < 8; ++k) { na[k] = 0.f; ng[k] = 0.f; } }
        float o[8];
#pragma unroll
        for (int k = 0; k < 8; ++k) { const float act = cw[c0 + k] * pa[k] + cw[UPW + c0 + k] * ca[k] + cw[2 * UPW + c0 + k] * na[k];
            const float gate = cw[DFF + c0 + k] * pg[k] + cw[UPW + DFF + c0 + k] * cg_[k] + cw[2 * UPW + DFF + c0 + k] * ng[k]; o[k] = silu_f(act) * gate; }
        *(v4u*)(G + (size_t)r * DFF + c0) = pack8(o);
    }
}

__device__ __forceinline__ void ssd_rstd_panel(const Args& a, int pm) {
    const float* SS = (const float*)(a.ws + WS_SS); float* RS = (float*)(a.ws + WS_RS);
    const int t = otid(a.wv); const int row = pm * 256 + (t >> 1), half = t & 1;
    const f32x4* p = (const f32x4*)(SS + (size_t)row * 64 + half * 32);
    f32x4 s = p[0];
#pragma unroll
    for (int k = 1; k < 8; ++k) s = s + p[k];
    float v = (s[0] + s[1]) + (s[2] + s[3]); v += shx(v, 1, t & 63);
    if (!half) RS[row] = rsqrtf(v * (1.f / 2048.f) + EPS);
}

#ifndef MK_SINGLE
#define MK_SINGLE 1
#endif
#ifndef XF
#define XF 3
#endif
struct GemmDesc { const bf16* A; const bf16* Bt; int M, N, K; bf16* O; int ldc; int mode; int lda; int ldb; int ksplit; int kso; int rsoff; int coff; };

__global__ void __launch_bounds__(NTHR, 2) fwd_kernel(Args a_in) {
    extern __shared__ __attribute__((aligned(16))) unsigned char lds_raw[];
    LAS unsigned char* lds = (LAS unsigned char*)lds_raw;
#if MK_SINGLE == 1
    volatile LAS unsigned* bst = (volatile LAS unsigned*)(lds + LDS_BYTES - 64);
    const int wv0 = __builtin_amdgcn_readfirstlane((int)threadIdx.x >> 6);
    { const int t0 = otid(wv0); if (t0 < 16) bst[t0] = 0u; }
    __syncthreads();
    const XcdBarrier xbar = xcd_barrier_post((unsigned*)(a_in.ws + WS_CTL), bst, wv0);
#endif
    const Args& a0 = a_in;
#ifdef TDIAG
    unsigned long long tcat[6] = {0, 0, 0, 0, 0, 0}; unsigned long long tlast = __builtin_amdgcn_s_memrealtime();
#endif
    for (int s = a0.lo; s < a0.hi; ++s) {
        Args a = a0;
        { long oz; asm volatile("s_mov_b64 %0, 0" : "=s"(oz));
#pragma unroll
          for (int q = 0; q < 25; ++q) a.in[q] = (const float*)((const char*)a0.in[q] + oz);
          a.out = (float*)((char*)a0.out + oz); a.ws = a0.ws + oz; a.wv = wv0; }
        unsigned char* ws = a.ws;
        float* XL = a.out; float* XC = (float*)(ws + WS_XC); bf16* H = (bf16*)(ws + WS_H); bf16* Mb = (bf16*)(ws + WS_M); bf16* Mp = (bf16*)(ws + WS_MP);
        const float* MOD = (const float*)(ws + WS_MOD); const float* NW = a.in[I_NORMW];
        int nrep = 1;
#ifdef PROBE_MASK
        if (s == 0 && (PROBE_MASK >> 20 & 1u)) nrep = 2;
        if (s >= 2) { const int pk = (s - 2) % 10, ppar = ((s - 2) / 10) & 1; if ((PROBE_MASK >> (pk + 10 * ppar)) & 1u) nrep = 2; }
#endif
        for (int rep = 0; rep < nrep; ++rep) {
        GemmDesc g0{}, g1{}; int ng = 0;
#ifndef NO_SIMPLE
        if (s == 0) {
            mod_compute(a, lds);
            rope_tables(a);
            convert_layer(a, 0, lds);
        } else if (s == 1) {
            rowwise2<3>(a.in[I_X], a.in[I_CTX], nullptr, nullptr, nullptr, nullptr, nullptr, nullptr, H, MOD, 0, 1024, NW, T, a.wv);
        } else {
            const int l = (s - 2) / 10, k = (s - 2) % 10, i = l >> 1; const bool even = (l & 1) == 0, last = (l == 3);
            const int MR = last ? TL : T;
            const bool splitk = !last && gridDim.x == 256;
            const int MG = splitk ? TL : MR;
            switch (k) {
            case 0:
                if (even) { g0 = GemmDesc{H, (const bf16*)(ws + W_IN), T, HYB_INP, D, (bf16*)(ws + WS_P), HYB_INP}; ng = 1; }
                else      { g0 = GemmDesc{H, (const bf16*)(ws + W_IN), T, SSD_INP, D, (bf16*)(ws + WS_ZX), SSD_INP}; ng = 1; }
                break;
            case 1: if (even) prep_even2(a, i); else ssd_conv2(a, i); break;
            case 2:
                if (even) { g0 = GemmDesc{(const bf16*)(ws + WS_CKVN), (const bf16*)(ws + W_UKV), T, KVW, 256, (bf16*)(ws + WS_KV), KVW};
                            g1 = GemmDesc{(const bf16*)(ws + WS_CQN), (const bf16*)(ws + W_UQ), T, QW, 384, (bf16*)(ws + WS_Q), QW}; g1.coff = (gridDim.x == 256) ? 216 : 0; ng = 2; }
                else {
#ifdef SSD_NAIVE
 ssd_scan_naive(a, i, last, lds);
#else
 ssd_scan_mfma(a, i, last, lds);
#endif
 }
                break;
            case 3: if (even) {
#ifdef ATTN_NAIVE
 attn_naive(a, lds);
#else
 attn_mfma(a, lds);
#endif
 } break;
            case 4:
                if (even) { g0 = GemmDesc{(const bf16*)(ws + WS_MIX), (const bf16*)(ws + W_OUT), MG, D, D, Mb, D}; ng = 1;
                            if (splitk) { g1 = GemmDesc{(const bf16*)(ws + WS_MIX) + (size_t)TL * D, (const bf16*)(ws + W_OUT), TC, D, D / 2, Mp, D, 0, D, D, 2, TC * D, 0}; ng = 2; } }
                else      { g0 = GemmDesc{(const bf16*)(ws + WS_XBC), (const bf16*)(ws + W_OUT), MG, D, 2048, Mb, D, 2, 3072}; ng = 1;
                            if (splitk) { g1 = GemmDesc{(const bf16*)(ws + WS_XBC) + (size_t)TL * 3072, (const bf16*)(ws + W_OUT), TC, D, 1024, Mp, D, 2, 3072, 2048, 2, TC * D, TL}; ng = 2; }
                            pg8::StaticOrder S0; pg8::Unit u0; int lastpm = -1; S0.init(MG, D, (int)gridDim.x, (int)blockIdx.x);
                            for (int ui0 = 0; S0.next(ui0, u0); ++ui0) if (u0.pm != lastpm) { ssd_rstd_panel(a, u0.pm); lastpm = u0.pm; }
                            if (splitk) { S0.init(TC, D, (int)gridDim.x, (int)blockIdx.x, 2); lastpm = -1;
                                for (int ui0 = 0; S0.next(ui0, u0); ++ui0) if (u0.pm != lastpm) { ssd_rstd_panel(a, TL / 256 + u0.pm); lastpm = u0.pm; } }
                            asm volatile("s_waitcnt vmcnt(0)" ::: "memory"); __syncthreads(); }
                break;
            case 5:
#ifdef PROBE_ROW2
                if (l > 0) rowwise2<3>(XL, XC, XL, XC, nullptr, nullptr, nullptr, nullptr, H, MOD + (size_t)l * 9 * MODW, 0, 1024, NW + (l * 4 + 0) * D, MR, a.wv);
#endif
                rowwise2<3>(l == 0 ? a.in[I_X] : XL, l == 0 ? a.in[I_CTX] : XC, (last && (XF & 1)) ? (float*)(ws + WS_XALT) : XL, XC, Mb, splitk ? Mp : nullptr, MOD + (size_t)l * 9 * MODW + 2048, NW + (l * 4 + 1) * D, H, MOD + (size_t)l * 9 * MODW, 3072, 4096, NW + (l * 4 + 2) * D, MR, a.wv, l == 0 ? 0 : XF, XF); break;
            case 6: { g0 = GemmDesc{H, (const bf16*)(ws + W_UP), MR, UPW, D, (bf16*)(ws + WS_G), DFF, 1}; ng = 1; } break;
            case 7:
                if (splitk) { g0 = GemmDesc{(const bf16*)(ws + WS_G), (const bf16*)(ws + W_DN), TL, D, DFF, Mb, D}; ng = 1;
                    pg8::StaticOrder S0; pg8::Unit u0; int lastpm = -1; S0.init(TL, D, (int)gridDim.x, (int)blockIdx.x);
                    for (int ui0 = 0; S0.next(ui0, u0); ++ui0) if (u0.pm != lastpm) { ffn_fixup_panel(a, l, u0.pm); lastpm = u0.pm; }
                    asm volatile("s_waitcnt vmcnt(0)" ::: "memory"); __syncthreads(); }
                break;
            case 8:
                if (splitk) {
                    g0 = GemmDesc{(const bf16*)(ws + WS_G) + (size_t)TL * DFF, (const bf16*)(ws + W_DN), TC, D, DFF / 2, Mp, D, 0, DFF, DFF, 2, TC * D, 0}; ng = 1;
                    { pg8::StaticOrder S0; pg8::Unit u0; int lastpm = -1; S0.init(TC, D, (int)gridDim.x, (int)blockIdx.x, 2);
                      for (int ui0 = 0; S0.next(ui0, u0); ++ui0) if (u0.pm != lastpm) { ffn_fixup_panel(a, l, TL / 256 + u0.pm); lastpm = u0.pm; }
                      asm volatile("s_waitcnt vmcnt(0)" ::: "memory"); __syncthreads(); }
                    rowwise2<3, 1>(XL, XC, XL, XC, Mb, nullptr, MOD + (size_t)l * 9 * MODW + 5120, NW + (l * 4 + 3) * D, H, MOD + (size_t)(l + 1) * 9 * MODW, 0, 1024, NW + ((l + 1) * 4 + 0) * D, TL, a.wv, XF, XF);
                } else { g0 = GemmDesc{(const bf16*)(ws + WS_G), (const bf16*)(ws + W_DN), MR, D, DFF, Mb, D}; ng = 1;
                    pg8::StaticOrder S0; pg8::Unit u0; int lastpm = -1; S0.init(MR, D, (int)gridDim.x, (int)blockIdx.x);
                    for (int ui0 = 0; S0.next(ui0, u0); ++ui0) if (u0.pm != lastpm) { ffn_fixup_panel(a, l, u0.pm); lastpm = u0.pm; }
                    asm volatile("s_waitcnt vmcnt(0)" ::: "memory"); __syncthreads(); }
                break;
            case 9:
                if (splitk) { rowwise2<3, 2>(XL, XC, XL, XC, Mb, Mp, MOD + (size_t)l * 9 * MODW + 5120, NW + (l * 4 + 3) * D, H, MOD + (size_t)(l + 1) * 9 * MODW, 0, 1024, NW + ((l + 1) * 4 + 0) * D, T, a.wv, XF, XF);
                              convert_layer(a, l + 1, lds); }
                else if (!last) { rowwise2<3>(XL, XC, XL, XC, Mb, nullptr, MOD + (size_t)l * 9 * MODW + 5120, NW + (l * 4 + 3) * D, H, MOD + (size_t)(l + 1) * 9 * MODW, 0, 1024, NW + ((l + 1) * 4 + 0) * D, T, a.wv, XF, XF);
                             convert_layer(a, l + 1, lds); }
                else rowwise2<3>((XF & 1) ? (const float*)(ws + WS_XALT) : XL, XC, XL, XC, Mb, nullptr, MOD + (size_t)l * 9 * MODW + 5120, NW + (l * 4 + 3) * D, nullptr, MOD, 0, 0, NW, TL, a.wv, XF, 0);
                break;
            }
        }
#else
        { g0 = GemmDesc{H, (const bf16*)(ws + W_IN), T, a.hi * 256, a.lo * 128, (bf16*)(ws + WS_P), HYB_INP}; ng = 1; }
#endif
        for (int gi = 0; gi < ng; ++gi) {
            const bool f = (gi == 0);
            const int lda_ = f ? g0.lda : g1.lda, K_ = f ? g0.K : g1.K, ldb_ = f ? g0.ldb : g1.ldb, ksp_ = f ? g0.ksplit : g1.ksplit;
            pg8::Gemm g{f ? g0.A : g1.A, f ? g0.Bt : g1.Bt, f ? g0.M : g1.M, f ? g0.N : g1.N, K_, a.wv,
#ifdef GDIAG
                (s == GDIAG_STEP) ? (float*)(a0.ws + WS_MOD + 900 * 1024) : nullptr
#else
                nullptr
#endif
                , lda_ ? lda_ : K_, ldb_ ? ldb_ : K_}; pg8::StaticOrder S; S.init(g.M, g.N, (int)gridDim.x, ((int)blockIdx.x + (f ? g0.coff : g1.coff)) % (int)gridDim.x, ksp_ ? ksp_ : 1);
            pg8::EpiFfn E{f ? g0.O : g1.O, f ? g0.ldc : g1.ldc, f ? g0.mode : g1.mode, f ? g0.kso : g1.kso, (const float*)(ws + WS_RS) + (f ? g0.rsoff : g1.rsoff), (bf16*)(ws + WS_UE), a.in[I_FCONV] + (size_t)((s - 2) / 10) * 3 * UPW, (LAS pg8::f32x4*)(lds + 131072), a.wv};
#ifndef NO_GEMM
            pg8::gemm_phase<pg8::EpiFfn, pg8::StaticOrder, true, true>(lds, g, S, E);
#endif
            __syncthreads();
        }
        if (rep + 1 < nrep) __syncthreads();
        }
#ifdef GDIAG
        if (s + 1 == a0.hi) { __syncthreads(); asm volatile("s_waitcnt vmcnt(0)" ::: "memory"); if (blockIdx.x == 0 && otid(wv0) == 0) { const float* dg = (const float*)(a0.ws + WS_MOD + 900 * 1024); a0.out[0] += 25.0f * dg[GDIAG_SEL] / dg[3]; } }
#endif
#ifdef SSD_DIAG
        if (s + 1 == a0.hi) { __syncthreads(); asm volatile("s_waitcnt vmcnt(0)" ::: "memory"); if (blockIdx.x == 0 && otid(wv0) == 0) { const float* dg = (const float*)(a0.ws + WS_MOD + 900 * 1024); a0.out[0] += 25.0f * dg[SSD_DIAG_SEL] / dg[7]; } }
#endif
#ifdef TDIAG
        if (s + 1 == a0.hi) { __syncthreads(); }
#endif
#ifdef BLK_JITTER
        if ((((int)blockIdx.x * 7 + s * 3) % 11) == 0) { for (int q = 0; q < 40; ++q) __builtin_amdgcn_s_sleep(127); }
#endif
        if (s + 1 < a0.hi && !(s >= 2 && (((s - 2) % 10 == 7 && ((s - 2) / 10 == 3 || gridDim.x != 256)) || ((s - 2) % 10 == 3 && (((s - 2) / 10) & 1))))) {
#if MK_SINGLE == 1
            xcd_barrier(xbar);
#ifdef PROBE_BAR2
            xcd_barrier(xbar);
#endif
#elif MK_SINGLE == 2
            cg::this_grid().sync();
#endif
        }
#ifdef TDIAG
        { const unsigned long long tn = __builtin_amdgcn_s_memrealtime(); int cat = 0;
          if (s >= 2) { const int k = (s - 2) % 10, par = ((s - 2) / 10) & 1; cat = (k == 0 || k == 4 || k == 6 || k == 8 || (k == 2 && par == 0)) ? 1 : ((k == 5 || k == 9) ? 2 : ((k == 3 && par == 0) ? 4 : ((k == 2 && par == 1) ? 5 : 3)));
#ifdef TDIAG_K
              cat = (k == TDIAG_K && (TDIAG_PAR == 2 || par == TDIAG_PAR)) ? 1 : 3;
#endif
          }
#pragma unroll
          for (int q = 0; q < 6; ++q) if (q == cat) tcat[q] += tn - tlast;
          tlast = tn;
          if (s + 1 == a0.hi) { asm volatile("s_waitcnt vmcnt(0)" ::: "memory"); if (blockIdx.x == 0 && otid(wv0) == 0) { unsigned long long tt = 0;
#pragma unroll
              for (int q = 0; q < 6; ++q) tt += tcat[q];
              a0.out[0] += (TDIAG == 6) ? (float)tt * (1.0f / 20000.0f) : 25.0f * (float)tcat[TDIAG < 6 ? TDIAG : 0] / (float)tt; } } }
#endif
    }
}

extern "C" void kernel_launch(void* const* d_in, const int* in_sizes, int n_in, void* d_out, int out_size, void* d_ws, size_t ws_size, hipStream_t stream) {
    static int grid = 0;
    if (grid == 0) {
        if (n_in != 25 || out_size != TL * D || ws_size < WS_END) { fprintf(stderr, "kernel_launch: unexpected problem (n_in %d out %d ws %zu need %zu)\n", n_in, out_size, ws_size, (size_t)WS_END); grid = -1; return; }
        if (hipFuncSetAttribute((const void*)fwd_kernel, hipFuncAttributeMaxDynamicSharedMemorySize, LDS_BYTES) != hipSuccess) { fprintf(stderr, "kernel_launch: hipFuncSetAttribute failed\n"); grid = -1; return; }
        int dev = 0, cus = 0, per_cu = 0;
        hipGetDevice(&dev); hipDeviceGetAttribute(&cus, hipDeviceAttributeMultiprocessorCount, dev);
        hipOccupancyMaxActiveBlocksPerMultiprocessor(&per_cu, (const void*)fwd_kernel, NTHR, LDS_BYTES);
        (void)hipGetLastError();
        if (per_cu < 1) { fprintf(stderr, "kernel_launch: occupancy query says %d blocks per CU\n", per_cu); }
        grid = cus;
    }
    if (grid < 0) return;
#if MK_SINGLE == 1
    if (hipMemsetAsync((char*)d_ws + WS_CTL, 0, CTL_ZERO_BYTES, stream) != hipSuccess) { fprintf(stderr, "kernel_launch: memset failed\n"); return; }
#endif
    Args a{};
    for (int i = 0; i < 25; ++i) a.in[i] = (const float*)d_in[i];
    a.out = (float*)d_out; a.ws = (unsigned char*)d_ws;
#if MK_SINGLE
    a.lo = 0; a.hi = NSTEP + 1;
    void* args[] = {&a};
    hipError_t e = hipLaunchCooperativeKernel((const void*)fwd_kernel, dim3(grid), dim3(NTHR), args, LDS_BYTES, stream);
    if (e != hipSuccess) fprintf(stderr, "cooperative launch failed: %s (grid %d)\n", hipGetErrorString(e), grid);
#else
    for (int s = 0; s < NSTEP + 1; ++s) { a.lo = s; a.hi = s + 1; hipLaunchKernelGGL(fwd_kernel, dim3(grid), dim3(NTHR), LDS_BYTES, stream, a); }
#endif
}
```
